# Optimizing an MI355X kernel written in HIP

```python
import math
import jax, jax.numpy as jnp
from jax import lax
import numpy as np

D_MODEL = 1024
BATCH = 4
SEQ = 8192
DEPTH = 1

SB_WIDTH = D_MODEL // 2
SB_HEADS = 8
SB_HEAD_DIM = SB_WIDTH // SB_HEADS
ML_WIDTH = D_MODEL - SB_WIDTH
ML_HEADS = 4
ML_HEAD_DIM = ML_WIDTH // ML_HEADS
MIX_WIDTH = SB_WIDTH + ML_WIDTH
Q_BLOCK = 128
ML_CHUNK = 64
CONV_K = 4
PROJ_COLS = 3 * SB_WIDTH + 4 * ML_WIDTH + 2 * ML_HEADS
N_EXPERTS = 256
TOP_K = 8
N_GROUPS = 8
TOPK_GROUPS = 4
EXPERT_FF = D_MODEL // 4
SHARED_FF = D_MODEL // 4
ROUTED_SCALE = 2.5
DISPATCH_BLOCK = 128
DN_ALPHA = (2 * DEPTH) ** 0.25
DN_BETA = (8 * DEPTH) ** -0.25
LN_EPS = 1e-5

kernel_name = 'hymba_sb_mlstm_moe_deepnorm_adaln'


def layer_norm(x, g=None, b=None):
    xf = x.astype(jnp.float32)
    mu = xf.mean(-1, keepdims=True)
    var = jnp.square(xf - mu).mean(-1, keepdims=True)
    y = (xf - mu) * lax.rsqrt(var + LN_EPS)
    if g is not None:
        y = y * g.astype(jnp.float32) + b.astype(jnp.float32)
    return y.astype(x.dtype)


def causal_depthwise_conv(x, w, b):
    C = x.shape[-1]
    y = lax.conv_general_dilated(x, w[:, None, :].astype(x.dtype), window_strides=(1,),
                                 padding=[(CONV_K - 1, 0)],
                                 dimension_numbers=('NWC', 'WIO', 'NWC'),
                                 feature_group_count=C)
    return y + b


def stick_breaking_attention(q, k, v):
    B, H, S, dh = q.shape
    nq = S // Q_BLOCK
    scale = dh ** -0.5
    kf = k.astype(jnp.float32)
    vf = v.astype(jnp.float32)
    qb = jnp.moveaxis(q.astype(jnp.float32).reshape(B, H, nq, Q_BLOCK, dh), 2, 0)
    key_pos = jnp.arange(S)

    def block(args):
        q_blk, q0 = args
        z = jnp.einsum('bhqd,bhkd->bhqk', q_blk, kf) * scale
        q_pos = q0 + jnp.arange(Q_BLOCK)
        mask = key_pos[None, :] < q_pos[:, None]
        log_beta = jax.nn.log_sigmoid(z)
        log_1m = jnp.where(mask, log_beta - z, 0.0)
        after = lax.cumsum(log_1m, axis=3, reverse=True) - log_1m
        a = jnp.where(mask, jnp.exp(log_beta + after), 0.0)
        return jnp.einsum('bhqk,bhkd->bhqd', a, vf)

    out = lax.map(block, (qb, jnp.arange(nq) * Q_BLOCK))
    return jnp.moveaxis(out, 0, 2).reshape(B, H, S, dh)


def mlstm_chunkwise(q, k, v, i_pre, logf):
    B, H, S, dk = q.shape
    dv = v.shape[-1]
    L = ML_CHUNK
    nc = S // L
    k = k * dk ** -0.5

    def chunks(t):
        return jnp.moveaxis(t.reshape((B, H, nc, L) + t.shape[3:]), 2, 0)

    bcum = lax.cumsum(logf.reshape(B, H, nc, L), axis=3)
    causal = jnp.tril(jnp.ones((L, L), dtype=bool))

    def step(carry, xs):
        C, n, m = carry
        qc, kc, vc, ic, bc = xs
        log_d = jnp.where(causal, bc[..., :, None] - bc[..., None, :] + ic[..., None, :], -jnp.inf)
        inter = bc + m[..., None]
        m_t = jnp.maximum(inter, log_d.max(-1))
        w = jnp.einsum('bhtd,bhsd->bhts', qc, kc) * jnp.exp(log_d - m_t[..., None])
        s_inter = jnp.exp(inter - m_t)
        num = (s_inter[..., None] * jnp.einsum('bhtk,bhvk->bhtv', qc, C)
               + jnp.einsum('bhts,bhsv->bhtv', w, vc))
        den = s_inter * jnp.einsum('bhtk,bhk->bht', qc, n) + w.sum(-1)
        h = num / jnp.maximum(jnp.abs(den), jnp.exp(-m_t))[..., None]
        b_last = bc[..., -1]
        log_w = b_last[..., None] - bc + ic
        m_new = jnp.maximum(b_last + m, log_w.max(-1))
        wk = jnp.exp(log_w - m_new[..., None])
        decay = jnp.exp(b_last + m - m_new)
        C = decay[..., None, None] * C + jnp.einsum('bhs,bhsv,bhsk->bhvk', wk, vc, kc)
        n = decay[..., None] * n + jnp.einsum('bhs,bhsk->bhk', wk, kc)
        return (C, n, m_new), h

    init = (jnp.zeros((B, H, dv, dk), jnp.float32), jnp.zeros((B, H, dk), jnp.float32),
            jnp.zeros((B, H), jnp.float32))
    _, h = lax.scan(step, init, (chunks(q), chunks(k), chunks(v), chunks(i_pre), jnp.moveaxis(bcum, 2, 0)))
    return jnp.moveaxis(h, 0, 2).reshape(B, H, S, dv)


def hybrid_mixer(u, w_in, ml_conv_w, ml_conv_b, ml_gate_b, ml_norm_g, w_out):
    B, S, _ = u.shape
    proj = u @ w_in
    cuts = [SB_WIDTH, 2 * SB_WIDTH, 3 * SB_WIDTH, 3 * SB_WIDTH + ML_WIDTH,
            3 * SB_WIDTH + 2 * ML_WIDTH, 3 * SB_WIDTH + 3 * ML_WIDTH, 3 * SB_WIDTH + 4 * ML_WIDTH]
    sb_q, sb_k, sb_v, ml_q, ml_k, ml_v, ml_o, ml_if = jnp.split(proj, cuts, axis=-1)

    def heads(t, h):
        return t.reshape(B, S, h, -1).transpose(0, 2, 1, 3)

    sb = stick_breaking_attention(heads(sb_q, SB_HEADS), heads(sb_k, SB_HEADS), heads(sb_v, SB_HEADS))
    sb = sb.transpose(0, 2, 1, 3).reshape(B, S, SB_WIDTH).astype(u.dtype)

    qk = jax.nn.silu(causal_depthwise_conv(jnp.concatenate([ml_q, ml_k], -1), ml_conv_w, ml_conv_b))
    ml_q, ml_k = jnp.split(qk, 2, axis=-1)
    gates = ml_if.astype(jnp.float32) + ml_gate_b.astype(jnp.float32)
    i_pre = gates[..., :ML_HEADS].transpose(0, 2, 1)
    logf = jax.nn.log_sigmoid(gates[..., ML_HEADS:]).transpose(0, 2, 1)
    h = mlstm_chunkwise(heads(ml_q, ML_HEADS).astype(jnp.float32), heads(ml_k, ML_HEADS).astype(jnp.float32),
                        heads(ml_v, ML_HEADS).astype(jnp.float32), i_pre, logf)
    h = layer_norm(h).transpose(0, 2, 1, 3).reshape(B, S, ML_WIDTH) * ml_norm_g.astype(jnp.float32)
    ml = jax.nn.sigmoid(ml_o) * h.astype(u.dtype)

    return jnp.concatenate([sb, ml], axis=-1) @ w_out


def moe_ffn(u, w_router, router_bias, moe_w1, moe_w3, moe_w2, sh_w1, sh_w3, sh_w2):
    B, S, D = u.shape
    T = B * S
    xt = u.reshape(T, D)
    scores = jax.nn.sigmoid((xt @ w_router).astype(jnp.float32))
    sel = scores + router_bias.astype(jnp.float32)
    grp_score = lax.top_k(sel.reshape(T, N_GROUPS, -1), 2)[0].sum(-1)
    _, top_g = lax.top_k(grp_score, TOPK_GROUPS)
    gmask = jnp.any(top_g[..., None] == jnp.arange(N_GROUPS), axis=1)
    sel = jnp.where(jnp.repeat(gmask, N_EXPERTS // N_GROUPS, axis=1), sel, -jnp.inf)
    _, top_e = lax.top_k(sel, TOP_K)
    g = jnp.take_along_axis(scores, top_e, axis=1)
    g = g / g.sum(-1, keepdims=True) * ROUTED_SCALE

    TK = T * TOP_K
    e_flat = top_e.reshape(-1)
    tok_flat = jnp.repeat(jnp.arange(T, dtype=jnp.int32), TOP_K)
    order = jnp.argsort(e_flat)
    se, stok, sw = e_flat[order], tok_flat[order], g.reshape(-1)[order]
    counts = jax.ops.segment_sum(jnp.ones((TK,), jnp.int32), e_flat, num_segments=N_EXPERTS)
    offsets = jnp.cumsum(counts) - counts
    pcounts = (counts + DISPATCH_BLOCK - 1) // DISPATCH_BLOCK * DISPATCH_BLOCK
    pend = jnp.cumsum(pcounts)
    poffsets = pend - pcounts
    dest = poffsets[se] + (jnp.arange(TK, dtype=jnp.int32) - offsets[se])
    R = -(-TK // DISPATCH_BLOCK) * DISPATCH_BLOCK + N_EXPERTS * DISPATCH_BLOCK
    nb = R // DISPATCH_BLOCK
    buf_tok = jnp.full((R,), T, jnp.int32).at[dest].set(stok)
    buf_w = jnp.zeros((R,), xt.dtype).at[dest].set(sw.astype(xt.dtype))
    block_e = jnp.minimum(jnp.searchsorted(pend, jnp.arange(nb) * DISPATCH_BLOCK, side='right'),
                          N_EXPERTS - 1)
    x_pad = jnp.concatenate([xt, jnp.zeros((1, D), xt.dtype)], axis=0)

    def expert_block(y, blk):
        tok_b, w_b, e_b = blk
        xb = x_pad[tok_b]
        h = jax.nn.silu(xb @ moe_w1[e_b]) * (xb @ moe_w3[e_b])
        return y.at[tok_b].add((h @ moe_w2[e_b]) * w_b[:, None]), None

    y, _ = lax.scan(expert_block, jnp.zeros((T + 1, D), xt.dtype),
                    (buf_tok.reshape(nb, DISPATCH_BLOCK), buf_w.reshape(nb, DISPATCH_BLOCK), block_e))
    shared = (jax.nn.silu(xt @ sh_w1) * (xt @ sh_w3)) @ sh_w2
    return (y[:T] + shared).reshape(B, S, D)


def setup_inputs(seed: int = 0) -> dict:
    key = jax.random.key(seed)
    ks = jax.random.split(key, 24)
    f32 = jnp.float32
    D, L = D_MODEL, DEPTH

    def nrm(k, shape, scale):
        return jax.random.normal(k, shape, f32) * scale

    x = nrm(ks[0], (BATCH, SEQ, D), 1.0)
    c = nrm(ks[1], (BATCH, D), 1.0)
    w_ada = nrm(ks[2], (L, D, 6 * D), 0.5 * D ** -0.5)
    b_ada = nrm(ks[3], (L, 6 * D), 0.02)
    s_in = D ** -0.5
    w_in = jnp.concatenate([
        nrm(ks[4], (L, D, 2 * SB_WIDTH), s_in),
        nrm(ks[5], (L, D, SB_WIDTH), s_in * DN_BETA),
        nrm(ks[6], (L, D, 2 * ML_WIDTH), s_in),
        nrm(ks[7], (L, D, ML_WIDTH), s_in * DN_BETA),
        nrm(ks[8], (L, D, ML_WIDTH + 2 * ML_HEADS), s_in),
    ], axis=-1)
    ml_conv_w = nrm(ks[9], (L, CONV_K, 2 * ML_WIDTH), CONV_K ** -0.5)
    ml_conv_b = nrm(ks[10], (L, 2 * ML_WIDTH), 0.02)
    f_bias = jnp.linspace(3.0, 6.0, ML_HEADS, dtype=f32)
    ml_gate_b = jnp.concatenate([nrm(ks[11], (L, ML_HEADS), 0.1),
                                 f_bias[None, :] + nrm(ks[12], (L, ML_HEADS), 0.01)], axis=-1)
    ml_norm_g = 1.0 + nrm(ks[13], (L, ML_WIDTH), 0.02)
    w_out = nrm(ks[14], (L, MIX_WIDTH, D), MIX_WIDTH ** -0.5 * DN_BETA)
    ln1_g = 1.0 + nrm(ks[15], (L, D), 0.02)
    ln1_b = nrm(ks[16], (L, D), 0.02)
    w_router = nrm(ks[17], (L, D, N_EXPERTS), D ** -0.5)
    router_bias = nrm(ks[18], (L, N_EXPERTS), 0.01)
    kk = jax.random.split(ks[19], 6)
    moe_w1 = nrm(kk[0], (L, N_EXPERTS, D, EXPERT_FF), D ** -0.5)
    moe_w3 = nrm(kk[1], (L, N_EXPERTS, D, EXPERT_FF), D ** -0.5)
    moe_w2 = nrm(kk[2], (L, N_EXPERTS, EXPERT_FF, D), EXPERT_FF ** -0.5 * DN_BETA)
    sh_w1 = nrm(kk[3], (L, D, SHARED_FF), D ** -0.5)
    sh_w3 = nrm(kk[4], (L, D, SHARED_FF), D ** -0.5)
    sh_w2 = nrm(kk[5], (L, SHARED_FF, D), SHARED_FF ** -0.5 * DN_BETA)
    ln2_g = 1.0 + nrm(ks[20], (L, D), 0.02)
    ln2_b = nrm(ks[21], (L, D), 0.02)
    return {'x': x, 'c': c, 'w_ada': w_ada, 'b_ada': b_ada, 'w_in': w_in,
            'ml_conv_w': ml_conv_w, 'ml_conv_b': ml_conv_b, 'ml_gate_b': ml_gate_b,
            'ml_norm_g': ml_norm_g, 'w_out': w_out, 'ln1_g': ln1_g, 'ln1_b': ln1_b,
            'w_router': w_router, 'router_bias': router_bias, 'moe_w1': moe_w1,
            'moe_w3': moe_w3, 'moe_w2': moe_w2, 'sh_w1': sh_w1, 'sh_w3': sh_w3, 'sh_w2': sh_w2,
            'ln2_g': ln2_g, 'ln2_b': ln2_b}


def reference(x, c, w_ada, b_ada, w_in, ml_conv_w, ml_conv_b, ml_gate_b, ml_norm_g, w_out,
              ln1_g, ln1_b, w_router, router_bias, moe_w1, moe_w3, moe_w2, sh_w1, sh_w3, sh_w2,
              ln2_g, ln2_b):
    for l in range(DEPTH):
        mod = jax.nn.silu(c) @ w_ada[l] + b_ada[l]
        sh1, sc1, g1, sh2, sc2, g2 = [m[:, None, :] for m in jnp.split(mod, 6, axis=-1)]
        u = layer_norm(x) * (1.0 + sc1) + sh1
        mix = hybrid_mixer(u, w_in[l], ml_conv_w[l], ml_conv_b[l], ml_gate_b[l], ml_norm_g[l], w_out[l])
        x = layer_norm(DN_ALPHA * x + g1 * mix, ln1_g[l], ln1_b[l])
        u = layer_norm(x) * (1.0 + sc2) + sh2
        ffn = moe_ffn(u, w_router[l], router_bias[l], moe_w1[l], moe_w3[l], moe_w2[l],
                      sh_w1[l], sh_w3[l], sh_w2[l])
        x = layer_norm(DN_ALPHA * x + g2 * ffn, ln2_g[l], ln2_b[l])
    return x
```

```cpp
#include <hip/hip_runtime.h>
#include <cstdio>
#include <cstdint>

typedef unsigned short bf16;
typedef unsigned v4u __attribute__((ext_vector_type(4)));
typedef float f32x4 __attribute__((ext_vector_type(4)));

constexpr int D = 1024, NB = 4, S = 8192, T = NB * S;
constexpr int NPROJ = 3584, WIN_LD = 3592;
constexpr int C_SBQ = 0, C_SBK = 512, C_SBV = 1024, C_MLQ = 1536, C_MLK = 2048, C_MLV = 2560, C_MLO = 3072, C_GATE = 3584;
constexpr int NE = 256, NEX = 257, TOPK = 8, FF = 256;
constexpr float LN_EPS = 1e-5f;
constexpr float DN_ALPHA = 1.189207115002721f;
constexpr float LOG2E = 1.4426950408889634f;
constexpr float QSCALE = 0.125f * LOG2E;
constexpr float SB_THRESH = 48.0f;

constexpr size_t MiB = 1u << 20;
constexpr size_t WS_CTL = 0;
constexpr size_t WS_MOD = 1 * MiB;
constexpr size_t WS_WTIN = 2 * MiB;
constexpr size_t WS_WTOUT = 10 * MiB;
constexpr size_t WS_WTR = 12 * MiB;
constexpr size_t WS_PLAN = 13 * MiB;
constexpr size_t WS_WT2 = 16 * MiB;
constexpr size_t WS_YS = 145 * MiB;
constexpr size_t WS_WT13 = 145 * MiB;
constexpr size_t WS_PROJ = 402 * MiB;
constexpr size_t WS_GATES = 626 * MiB;
constexpr size_t WS_HRAW = 630 * MiB;
constexpr size_t WS_LOGITS = 630 * MiB;
constexpr size_t WS_STATES = 657 * MiB;
constexpr size_t WS_H = 657 * MiB;
constexpr size_t WS_U1 = 725 * MiB;
constexpr size_t WS_MIX = 725 * MiB;
constexpr size_t WS_MIXOUT = 789 * MiB;
constexpr size_t WS_U2 = 853 * MiB;
constexpr size_t WS_YSH = 853 * MiB;
constexpr size_t WS_ROUTE = 917 * MiB;
constexpr size_t WS_END = 951 * MiB;
constexpr int CW_CNT = 1024;
constexpr int PL_SLOT = 0, PL_T64 = 512, PL_T256 = 1024;

__device__ __forceinline__ unsigned f2bf(float f) { unsigned u = __builtin_bit_cast(unsigned, f); return (u + 0x7fffu + ((u >> 16) & 1u)) >> 16; }
__device__ __forceinline__ float bf2f(unsigned b) { return __builtin_bit_cast(float, b << 16); }
__device__ __forceinline__ unsigned pk2(float lo, float hi) { return f2bf(lo) | (f2bf(hi) << 16); }
__device__ __forceinline__ float wave_sum(float v) {
#pragma unroll
    for (int o = 1; o < 64; o <<= 1) v += __shfl_xor(v, o);
    return v;
}
__device__ __forceinline__ float sigmoidf_(float x) { return 1.f / (1.f + __expf(-x)); }
__device__ __forceinline__ float siluf_(float x) { return x / (1.f + __expf(-x)); }

__global__ void __launch_bounds__(512) k_mod(const float* __restrict__ c, const float* __restrict__ w_ada, const float* __restrict__ b_ada, float* __restrict__ mod) {
    __shared__ float sc[NB][D];
    __shared__ float red[16][NB][32];
    const int tid = threadIdx.x;
    for (int i = tid; i < NB * D; i += 512) sc[i / D][i % D] = siluf_(c[i]);
    __syncthreads();
    const int kq = tid >> 5, jl = tid & 31, j = blockIdx.x * 32 + jl;
    float a0 = 0.f, a1 = 0.f, a2 = 0.f, a3 = 0.f;
#pragma unroll 16
    for (int kk = 0; kk < 64; ++kk) { const int k = kq * 64 + kk; const float w = w_ada[(size_t)k * 6144 + j];
        a0 += sc[0][k] * w; a1 += sc[1][k] * w; a2 += sc[2][k] * w; a3 += sc[3][k] * w; }
    red[kq][0][jl] = a0; red[kq][1][jl] = a1; red[kq][2][jl] = a2; red[kq][3][jl] = a3;
    __syncthreads();
    if (tid < 128) { const int b = tid >> 5; float s = b_ada[j];
#pragma unroll
        for (int q = 0; q < 16; ++q) s += red[q][b][jl];
        mod[b * 6144 + j] = s; }
}

__device__ __forceinline__ void transpose_item(const float* __restrict__ W, int ldw, bf16* __restrict__ WT, int ldt, int k0, int n0, int rowmap, int lane) {
    const int g = lane >> 4, i = lane & 15;
    f32x4 v[8];
#pragma unroll
    for (int r = 0; r < 8; ++r) v[r] = *(const f32x4*)(W + (size_t)(k0 + 8 * g + r) * ldw + n0 + 4 * i);
#pragma unroll
    for (int nn = 0; nn < 4; ++nn) {
        const int n = n0 + 4 * i + nn;
        const int dr = rowmap == 0 ? n : ((n >> 7) * 256 + (rowmap == 2 ? 128 : 0) + (n & 127));
        v4u o; o.x = pk2(v[0][nn], v[1][nn]); o.y = pk2(v[2][nn], v[3][nn]); o.z = pk2(v[4][nn], v[5][nn]); o.w = pk2(v[6][nn], v[7][nn]);
        *(v4u*)(WT + (size_t)dr * ldt + k0 + 8 * g) = o;
    }
}
struct PrepArgs { const float *w_in, *w_out, *w_router, *w1, *w3, *w2, *sw1, *sw3, *sw2; bf16 *wtin, *wtout, *wtr, *wt13, *wt2; };
constexpr int IT_IN = 32 * 56, IT_OUT = 32 * 16, IT_R = 32 * 4, IT_E = 384, IT_TOTAL = IT_IN + IT_OUT + IT_R + NEX * IT_E;
__device__ __forceinline__ void prep_item(const PrepArgs& a, int it, int lane) {
    if (it < IT_IN) { transpose_item(a.w_in, WIN_LD, a.wtin, D, (it / 56) * 32, (it % 56) * 64, 0, lane); return; } it -= IT_IN;
    if (it < IT_OUT) { transpose_item(a.w_out, D, a.wtout, D, (it / 16) * 32, (it % 16) * 64, 0, lane); return; } it -= IT_OUT;
    if (it < IT_R) { transpose_item(a.w_router, NE, a.wtr, D, (it / 4) * 32, (it % 4) * 64, 0, lane); return; } it -= IT_R;
    const int e = it / IT_E, r = it % IT_E;
    const float* p1 = e < NE ? a.w1 + (size_t)e * D * FF : a.sw1; const float* p3 = e < NE ? a.w3 + (size_t)e * D * FF : a.sw3; const float* p2 = e < NE ? a.w2 + (size_t)e * FF * D : a.sw2;
    bf16* d13 = a.wt13 + (size_t)e * 512 * D; bf16* d2 = a.wt2 + (size_t)e * D * FF;
    if (r < 128) { transpose_item(p1, FF, d13, D, (r / 4) * 32, (r % 4) * 64, 1, lane); return; }
    if (r < 256) { const int q = r - 128; transpose_item(p3, FF, d13, D, (q / 4) * 32, (q % 4) * 64, 2, lane); return; }
    { const int q = r - 256; transpose_item(p2, D, d2, FF, (q / 16) * 32, (q % 16) * 64, 0, lane); }
}
__global__ void __launch_bounds__(512) k_prep(PrepArgs a) {
    const int lane = threadIdx.x & 63, gw = blockIdx.x * 8 + (threadIdx.x >> 6), ngw = gridDim.x * 8;
    for (int it = gw; it < IT_TOTAL; it += ngw) prep_item(a, it, lane);
}

__global__ void __launch_bounds__(512) k_ln1(const float* __restrict__ x, const float* __restrict__ mod, const float* __restrict__ w_in, const float* __restrict__ gate_b,
                                              bf16* __restrict__ u1, float* __restrict__ ipre, float* __restrict__ logf) {
    __shared__ float wg[D][8];
    const int tid = threadIdx.x, lane = tid & 63, wave = tid >> 6;
    for (int i = tid; i < D * 8; i += 512) wg[i >> 3][i & 7] = w_in[(size_t)(i >> 3) * WIN_LD + C_GATE + (i & 7)];
    __syncthreads();
    const int row0 = blockIdx.x * 128, b = row0 / S;
    f32x4 sh[4], sc[4];
#pragma unroll
    for (int j = 0; j < 4; ++j) { sh[j] = *(const f32x4*)(mod + b * 6144 + 4 * lane + 256 * j); sc[j] = *(const f32x4*)(mod + b * 6144 + 1024 + 4 * lane + 256 * j); }
    for (int rr = wave; rr < 128; rr += 8) {
        const int row = row0 + rr;
        const f32x4* xr = (const f32x4*)(x + (size_t)row * D) + lane;
        f32x4 v[4]; float s = 0.f;
#pragma unroll
        for (int j = 0; j < 4; ++j) { v[j] = xr[64 * j]; s += (v[j].x + v[j].y) + (v[j].z + v[j].w); }
        const float mean = wave_sum(s) * (1.f / D); float s2 = 0.f;
#pragma unroll
        for (int j = 0; j < 4; ++j) { v[j] = v[j] - mean; s2 += (v[j].x * v[j].x + v[j].y * v[j].y) + (v[j].z * v[j].z + v[j].w * v[j].w); }
        const float rstd = 1.f / sqrtf(wave_sum(s2) * (1.f / D) + LN_EPS);
        float ga[8];
#pragma unroll
        for (int q = 0; q < 8; ++q) ga[q] = 0.f;
        unsigned long long* o8 = (unsigned long long*)(u1 + (size_t)row * D) + lane;
#pragma unroll
        for (int j = 0; j < 4; ++j) {
            f32x4 u = v[j] * rstd * (sc[j] + 1.0f) + sh[j];
            o8[64 * j] = (unsigned long long)pk2(u.x, u.y) | ((unsigned long long)pk2(u.z, u.w) << 32);
#pragma unroll
            for (int e = 0; e < 4; ++e) { const int k = 4 * lane + 256 * j + e;
#pragma unroll
                for (int q = 0; q < 8; ++q) ga[q] += u[e] * wg[k][q]; }
        }
#pragma unroll
        for (int q = 0; q < 8; ++q) ga[q] = wave_sum(ga[q]);
        if (lane < 8) {
            float gv = 0.f;
#pragma unroll
            for (int q = 0; q < 8; ++q) gv = (lane == q) ? ga[q] : gv;
            gv += gate_b[lane];
            const int h = lane & 3, s_ = row % S;
            if (lane < 4) ipre[(size_t)(b * 4 + h) * S + s_] = gv;
            else { const float ls = fminf(gv, 0.f) - log1pf(__expf(-fabsf(gv))); logf[(size_t)(b * 4 + h) * S + s_] = ls; }
        }
    }
}

template <class ARow, class BRow>
__device__ __forceinline__ void ngemm_tile(ARow arow, BRow brow, int K, float (&acc)[4][4], float* sA, float* sB) {
    const int tid = threadIdx.x, ty = tid >> 4, tx = tid & 15;
    const int lr = tid >> 2, lk = (tid & 3) * 8;
    const bf16* ap = arow(lr); const bf16* bp = brow(lr);
#pragma unroll
    for (int i = 0; i < 4; ++i)
#pragma unroll
        for (int j = 0; j < 4; ++j) acc[i][j] = 0.f;
    for (int k0 = 0; k0 < K; k0 += 32) {
        v4u av = {0u, 0u, 0u, 0u}, bv = {0u, 0u, 0u, 0u};
        if (ap) av = *(const v4u*)(ap + k0 + lk);
        if (bp) bv = *(const v4u*)(bp + k0 + lk);
        __syncthreads();
#pragma unroll
        for (int q = 0; q < 4; ++q) {
            sA[(lk + 2 * q) * 68 + lr] = bf2f(av[q] & 0xffffu); sA[(lk + 2 * q + 1) * 68 + lr] = bf2f(av[q] >> 16);
            sB[(lk + 2 * q) * 68 + lr] = bf2f(bv[q] & 0xffffu); sB[(lk + 2 * q + 1) * 68 + lr] = bf2f(bv[q] >> 16);
        }
        __syncthreads();
#pragma unroll 8
        for (int kk = 0; kk < 32; ++kk) {
            const f32x4 a = *(const f32x4*)(sA + kk * 68 + ty * 4), b = *(const f32x4*)(sB + kk * 68 + tx * 4);
#pragma unroll
            for (int i = 0; i < 4; ++i)
#pragma unroll
                for (int j = 0; j < 4; ++j) acc[i][j] += a[i] * b[j];
        }
    }
}

template <int MODE>
__global__ void __launch_bounds__(256) k_ngemm(const bf16* __restrict__ A, const bf16* __restrict__ Bt, void* __restrict__ C, int M, int N, int K, int ldc, int scale_cols, float scale) {
    __shared__ __attribute__((aligned(16))) float sA[32 * 68];
    __shared__ __attribute__((aligned(16))) float sB[32 * 68];
    const int m0 = blockIdx.y * 64, n0 = blockIdx.x * 64;
    float acc[4][4];
    ngemm_tile([&](int r) { return A + (size_t)(m0 + r) * K; }, [&](int r) { return Bt + (size_t)(n0 + r) * K; }, K, acc, sA, sB);
    const int ty = threadIdx.x >> 4, tx = threadIdx.x & 15;
#pragma unroll
    for (int i = 0; i < 4; ++i) { const int m = m0 + ty * 4 + i, n = n0 + tx * 4;
        if (MODE == 0) { const float sc = n < scale_cols ? scale : 1.f;
            *(unsigned long long*)((bf16*)C + (size_t)m * ldc + n) = (unsigned long long)pk2(acc[i][0] * sc, acc[i][1] * sc) | ((unsigned long long)pk2(acc[i][2] * sc, acc[i][3] * sc) << 32); }
        else *(f32x4*)((float*)C + (size_t)m * ldc + n) = (f32x4){acc[i][0], acc[i][1], acc[i][2], acc[i][3]}; }
}

__global__ void __launch_bounds__(256) k_attn_naive(const bf16* __restrict__ proj, bf16* __restrict__ mix) {
    const int gid = blockIdx.x * 256 + threadIdx.x;
    const int t = gid % S, bh = gid / S, h = bh & 7, b = bh >> 3;
    const bf16* base = proj + (size_t)b * S * NPROJ;
    float q[64], o[64];
    { const v4u* qp = (const v4u*)(base + (size_t)t * NPROJ + C_SBQ + h * 64);
#pragma unroll
      for (int i = 0; i < 8; ++i) { const v4u w = qp[i];
#pragma unroll
          for (int e = 0; e < 4; ++e) { q[i * 8 + 2 * e] = bf2f(w[e] & 0xffffu); q[i * 8 + 2 * e + 1] = bf2f(w[e] >> 16); } } }
#pragma unroll
    for (int d = 0; d < 64; ++d) o[d] = 0.f;
    float carry = 0.f;
    for (int s = t - 1; s >= 0; --s) {
        const v4u* kp = (const v4u*)(base + (size_t)s * NPROJ + C_SBK + h * 64);
        float z = 0.f;
#pragma unroll
        for (int i = 0; i < 8; ++i) { const v4u w = kp[i];
#pragma unroll
            for (int e = 0; e < 4; ++e) { z += q[i * 8 + 2 * e] * bf2f(w[e] & 0xffffu); z += q[i * 8 + 2 * e + 1] * bf2f(w[e] >> 16); } }
        const float sp = fmaxf(z, 0.f) + __log2f(1.f + exp2f(-fabsf(z)));
        carry += sp;
        const float a = exp2f(z - carry);
        const v4u* vp = (const v4u*)(base + (size_t)s * NPROJ + C_SBV + h * 64);
#pragma unroll
        for (int i = 0; i < 8; ++i) { const v4u w = vp[i];
#pragma unroll
            for (int e = 0; e < 4; ++e) { o[i * 8 + 2 * e] += a * bf2f(w[e] & 0xffffu); o[i * 8 + 2 * e + 1] += a * bf2f(w[e] >> 16); } }
        if (carry > SB_THRESH) break;
    }
    v4u* op = (v4u*)(mix + (size_t)(b * S + t) * D + h * 64);
#pragma unroll
    for (int i = 0; i < 8; ++i) { v4u w; w.x = pk2(o[i * 8], o[i * 8 + 1]); w.y = pk2(o[i * 8 + 2], o[i * 8 + 3]); w.z = pk2(o[i * 8 + 4], o[i * 8 + 5]); w.w = pk2(o[i * 8 + 6], o[i * 8 + 7]); op[i] = w; }
}

__global__ void __launch_bounds__(256) k_mlstm_naive(const bf16* __restrict__ proj, const float* __restrict__ conv_w, const float* __restrict__ conv_b,
                                                      const float* __restrict__ ipre, const float* __restrict__ logf, float* __restrict__ hraw) {
    __shared__ float sq[32][128], sk[32][128], sv[32][16], sf[32], si[32];
    const int tid = threadIdx.x, bh = blockIdx.x >> 3, sl = blockIdx.x & 7, b = bh >> 2, h = bh & 3;
    const int r = tid >> 4, c = tid & 15;
    const bf16* base = proj + (size_t)b * S * NPROJ;
    float Cst[8], nst[8];
#pragma unroll
    for (int e = 0; e < 8; ++e) { Cst[e] = 0.f; nst[e] = 0.f; }
    for (int t0 = 0; t0 < S; t0 += 32) {
        __syncthreads();
        for (int i = tid; i < 32 * 128; i += 256) {
            const int tt = i >> 7, d = i & 127, t = t0 + tt, ch = h * 128 + d;
            float yq = conv_b[ch], yk = conv_b[512 + ch];
#pragma unroll
            for (int j = 0; j < 4; ++j) { const int ts = t - 3 + j;
                if (ts >= 0) { yq += conv_w[j * 1024 + ch] * bf2f(base[(size_t)ts * NPROJ + C_MLQ + ch]); yk += conv_w[j * 1024 + 512 + ch] * bf2f(base[(size_t)ts * NPROJ + C_MLK + ch]); } }
            sq[tt][d] = siluf_(yq); sk[tt][d] = siluf_(yk) * 0.08838834764831845f;
        }
        for (int i = tid; i < 32 * 16; i += 256) { const int tt = i >> 4, d = i & 15; sv[tt][d] = bf2f(base[(size_t)(t0 + tt) * NPROJ + C_MLV + h * 128 + sl * 16 + d]); }
        if (tid < 32) { sf[tid] = __expf(logf[(size_t)bh * S + t0 + tid]); si[tid] = __expf(ipre[(size_t)bh * S + t0 + tid]); }
        __syncthreads();
        for (int tt = 0; tt < 32; ++tt) {
            const float f = sf[tt], iv = si[tt] * sv[tt][r], ii = si[tt];
            float pn = 0.f, pd = 0.f;
#pragma unroll
            for (int e = 0; e < 8; ++e) { const float kk = sk[tt][c * 8 + e], qq = sq[tt][c * 8 + e];
                Cst[e] = f * Cst[e] + iv * kk; nst[e] = f * nst[e] + ii * kk; pn += Cst[e] * qq; pd += nst[e] * qq; }
#pragma unroll
            for (int o = 1; o < 16; o <<= 1) { pn += __shfl_xor(pn, o); pd += __shfl_xor(pd, o); }
            if (c == 0) hraw[(size_t)(b * S + t0 + tt) * 512 + h * 128 + sl * 16 + r] = pn / fmaxf(fabsf(pd), 1.f);
        }
    }
}
__global__ void __launch_bounds__(256) k_mlnorm_naive(const float* __restrict__ hraw, const bf16* __restrict__ proj, const float* __restrict__ norm_g, bf16* __restrict__ mix) {
    const int gw = blockIdx.x * 4 + (threadIdx.x >> 6), lane = threadIdx.x & 63, t = gw >> 2, h = gw & 3;
    const float a = hraw[(size_t)t * 512 + h * 128 + 2 * lane], bq = hraw[(size_t)t * 512 + h * 128 + 2 * lane + 1];
    const float mean = wave_sum(a + bq) * (1.f / 128.f);
    const float da = a - mean, db = bq - mean;
    const float rstd = 1.f / sqrtf(wave_sum(da * da + db * db) * (1.f / 128.f) + LN_EPS);
    const unsigned ow = *(const unsigned*)(proj + (size_t)t * NPROJ + C_MLO + h * 128 + 2 * lane);
    const float o0 = sigmoidf_(bf2f(ow & 0xffffu)), o1 = sigmoidf_(bf2f(ow >> 16));
    const float g0 = norm_g[h * 128 + 2 * lane], g1 = norm_g[h * 128 + 2 * lane + 1];
    *(unsigned*)(mix + (size_t)t * D + 512 + h * 128 + 2 * lane) = pk2(da * rstd * g0 * o0, db * rstd * g1 * o1);
}

__global__ void __launch_bounds__(512) k_ln2(const float* __restrict__ x, const bf16* __restrict__ mixout, const float* __restrict__ mod, const float* __restrict__ ln1_g, const float* __restrict__ ln1_b,
                                              float* __restrict__ x1, bf16* __restrict__ u2) {
    const int tid = threadIdx.x, lane = tid & 63, wave = tid >> 6;
    const int row0 = blockIdx.x * 128, b = row0 / S;
    for (int rr = wave; rr < 128; rr += 8) {
        const int row = row0 + rr;
        f32x4 v[4]; float s = 0.f;
#pragma unroll
        for (int j = 0; j < 4; ++j) {
            const int col = 4 * lane + 256 * j;
            const f32x4 xv = *(const f32x4*)(x + (size_t)row * D + col);
            const unsigned long long mw = *(const unsigned long long*)(mixout + (size_t)row * D + col);
            const f32x4 g1 = *(const f32x4*)(mod + b * 6144 + 2048 + col);
            f32x4 mo = {bf2f((unsigned)mw & 0xffffu), bf2f(((unsigned)mw) >> 16), bf2f((unsigned)(mw >> 32) & 0xffffu), bf2f((unsigned)(mw >> 48))};
            v[j] = xv * DN_ALPHA + g1 * mo; s += (v[j].x + v[j].y) + (v[j].z + v[j].w);
        }
        float mean = wave_sum(s) * (1.f / D), s2 = 0.f;
#pragma unroll
        for (int j = 0; j < 4; ++j) { v[j] = v[j] - mean; s2 += (v[j].x * v[j].x + v[j].y * v[j].y) + (v[j].z * v[j].z + v[j].w * v[j].w); }
        float rstd = 1.f / sqrtf(wave_sum(s2) * (1.f / D) + LN_EPS);
        s = 0.f;
#pragma unroll
        for (int j = 0; j < 4; ++j) { const int col = 4 * lane + 256 * j;
            v[j] = v[j] * rstd * *(const f32x4*)(ln1_g + col) + *(const f32x4*)(ln1_b + col);
            *(f32x4*)(x1 + (size_t)row * D + col) = v[j]; s += (v[j].x + v[j].y) + (v[j].z + v[j].w); }
        mean = wave_sum(s) * (1.f / D); s2 = 0.f;
#pragma unroll
        for (int j = 0; j < 4; ++j) { v[j] = v[j] - mean; s2 += (v[j].x * v[j].x + v[j].y * v[j].y) + (v[j].z * v[j].z + v[j].w * v[j].w); }
        rstd = 1.f / sqrtf(wave_sum(s2) * (1.f / D) + LN_EPS);
#pragma unroll
        for (int j = 0; j < 4; ++j) { const int col = 4 * lane + 256 * j;
            const f32x4 u = v[j] * rstd * (*(const f32x4*)(mod + b * 6144 + 4096 + col) + 1.0f) + *(const f32x4*)(mod + b * 6144 + 3072 + col);
            *(unsigned long long*)(u2 + (size_t)row * D + col) = (unsigned long long)pk2(u.x, u.y) | ((unsigned long long)pk2(u.z, u.w) << 32); }
    }
}

__global__ void __launch_bounds__(256) k_route(const float* __restrict__ logits, const float* __restrict__ rbias, int* __restrict__ tope, float* __restrict__ topg, int* __restrict__ cnt, int* __restrict__ list) {
    const int t = blockIdx.x * 256 + threadIdx.x;
    const float* lg = logits + (size_t)t * NE;
    float gs[8];
#pragma unroll
    for (int g = 0; g < 8; ++g) { float m1 = -INFINITY, m2 = -INFINITY;
        for (int i = 0; i < 32; ++i) { const int e = g * 32 + i; const float v = sigmoidf_(lg[e]) + rbias[e]; if (v > m1) { m2 = m1; m1 = v; } else if (v > m2) m2 = v; }
        gs[g] = m1 + m2; }
    unsigned gmask = 0;
#pragma unroll
    for (int r = 0; r < 4; ++r) { int bi = 0; float bv = -INFINITY;
#pragma unroll
        for (int g = 0; g < 8; ++g) if (!((gmask >> g) & 1u) && gs[g] > bv) { bv = gs[g]; bi = g; }
        gmask |= 1u << bi; }
    float pv = INFINITY; int pi = -1; float gsum = 0.f;
    for (int r = 0; r < 8; ++r) { int bi = 0; float bv = -INFINITY, bs = 0.f;
        for (int e = 0; e < NE; ++e) { if (!((gmask >> (e >> 5)) & 1u)) continue;
            const float sc = sigmoidf_(lg[e]), v = sc + rbias[e];
            const bool elig = (v < pv) || (v == pv && e > pi);
            if (elig && v > bv) { bv = v; bi = e; bs = sc; } }
        pv = bv; pi = bi; gsum += bs;
        tope[t * 8 + r] = bi; topg[t * 8 + r] = bs;
        const int pos = atomicAdd(cnt + bi, 1); list[(size_t)bi * T + pos] = t * 8 + r; }
    const float inv = 2.5f / gsum;
    for (int r = 0; r < 8; ++r) topg[t * 8 + r] *= inv;
}
__global__ void k_plan(const int* __restrict__ cnt, int* __restrict__ plan) {
    if (threadIdx.x == 0) { int s = 0, t64 = 0, t256 = 0;
        for (int e = 0; e <= NEX; ++e) { plan[PL_SLOT + e] = s; plan[PL_T64 + e] = t64; plan[PL_T256 + e] = t256;
            if (e < NEX) { const int n = e < NE ? cnt[e] : T; s += ((n + 255) / 256) * 256; t64 += (n + 63) / 64; t256 += (n + 255) / 256; } } }
}
__device__ __forceinline__ int find_expert(const int* base, int tile) { int lo = 0, hi = NEX;
    while (hi - lo > 1) { const int mid = (lo + hi) >> 1; if (base[mid] <= tile) lo = mid; else hi = mid; } return lo; }

__global__ void __launch_bounds__(256) k_moe1_naive(const bf16* __restrict__ u2, const bf16* __restrict__ wt13, const int* __restrict__ cnt, const int* __restrict__ plan, const int* __restrict__ list, bf16* __restrict__ H) {
    __shared__ __attribute__((aligned(16))) float sA[32 * 68];
    __shared__ __attribute__((aligned(16))) float sB[32 * 68];
    const int tile = blockIdx.y; if (tile >= plan[PL_T64 + NEX]) return;
    const int e = find_expert(plan + PL_T64, tile), mt = tile - plan[PL_T64 + e], n = e < NE ? cnt[e] : T, j0 = blockIdx.x * 64;
    const bf16* w = wt13 + (size_t)e * 512 * D;
    auto arow = [&](int r) -> const bf16* { const int rr = mt * 64 + r; if (rr >= n) return nullptr; const int tok = e < NE ? (list[(size_t)e * T + rr] >> 3) : rr; return u2 + (size_t)tok * D; };
    float a1[4][4], a3[4][4];
    ngemm_tile(arow, [&](int r) { const int j = j0 + r; return w + (size_t)((j >> 7) * 256 + (j & 127)) * D; }, D, a1, sA, sB);
    __syncthreads();
    ngemm_tile(arow, [&](int r) { const int j = j0 + r; return w + (size_t)((j >> 7) * 256 + 128 + (j & 127)) * D; }, D, a3, sA, sB);
    const int ty = threadIdx.x >> 4, tx = threadIdx.x & 15;
#pragma unroll
    for (int i = 0; i < 4; ++i) { const int rr = mt * 64 + ty * 4 + i; if (rr >= n) continue;
        float hv[4];
#pragma unroll
        for (int j = 0; j < 4; ++j) hv[j] = siluf_(a1[i][j]) * a3[i][j];
        *(unsigned long long*)(H + (size_t)(plan[PL_SLOT + e] + rr) * FF + j0 + tx * 4) = (unsigned long long)pk2(hv[0], hv[1]) | ((unsigned long long)pk2(hv[2], hv[3]) << 32); }
}
__global__ void __launch_bounds__(256) k_moe2_naive(const bf16* __restrict__ H, const bf16* __restrict__ wt2, const int* __restrict__ cnt, const int* __restrict__ plan, const int* __restrict__ list,
                                                     const float* __restrict__ topg, bf16* __restrict__ ys, bf16* __restrict__ ysh) {
    __shared__ __attribute__((aligned(16))) float sA[32 * 68];
    __shared__ __attribute__((aligned(16))) float sB[32 * 68];
    const int tile = blockIdx.y; if (tile >= plan[PL_T64 + NEX]) return;
    const int e = find_expert(plan + PL_T64, tile), mt = tile - plan[PL_T64 + e], n = e < NE ? cnt[e] : T, n0 = blockIdx.x * 64;
    const bf16* w = wt2 + (size_t)e * D * FF; const bf16* hb = H + (size_t)plan[PL_SLOT + e] * FF;
    float acc[4][4];
    ngemm_tile([&](int r) -> const bf16* { const int rr = mt * 64 + r; return rr < n ? hb + (size_t)rr * FF : nullptr; }, [&](int r) { return w + (size_t)(n0 + r) * FF; }, FF, acc, sA, sB);
    const int ty = threadIdx.x >> 4, tx = threadIdx.x & 15;
#pragma unroll
    for (int i = 0; i < 4; ++i) { const int rr = mt * 64 + ty * 4 + i; if (rr >= n) continue;
        bf16* dst; float g = 1.f;
        if (e < NE) { const int id = list[(size_t)e * T + rr]; g = topg[id]; dst = ys + (size_t)id * D; } else dst = ysh + (size_t)rr * D;
        *(unsigned long long*)(dst + n0 + tx * 4) = (unsigned long long)pk2(acc[i][0] * g, acc[i][1] * g) | ((unsigned long long)pk2(acc[i][2] * g, acc[i][3] * g) << 32); }
}

__device__ __forceinline__ f32x4 ld_bf4(const bf16* p) { const unsigned long long w = *(const unsigned long long*)p;
    return (f32x4){bf2f((unsigned)w & 0xffffu), bf2f(((unsigned)w) >> 16), bf2f((unsigned)(w >> 32) & 0xffffu), bf2f((unsigned)(w >> 48))}; }
__global__ void __launch_bounds__(512) k_final(float* __restrict__ out, const bf16* __restrict__ ys, const bf16* __restrict__ ysh, const float* __restrict__ mod, const float* __restrict__ ln2_g, const float* __restrict__ ln2_b) {
    const int tid = threadIdx.x, lane = tid & 63, wave = tid >> 6;
    const int row0 = blockIdx.x * 128, b = row0 / S;
    for (int rr = wave; rr < 128; rr += 8) {
        const int row = row0 + rr;
        f32x4 v[4]; float s = 0.f;
#pragma unroll
        for (int j = 0; j < 4; ++j) { const int col = 4 * lane + 256 * j;
            f32x4 y = ld_bf4(ysh + (size_t)row * D + col);
#pragma unroll
            for (int k = 0; k < 8; ++k) y = y + ld_bf4(ys + ((size_t)row * 8 + k) * D + col);
            v[j] = *(const f32x4*)(out + (size_t)row * D + col) * DN_ALPHA + *(const f32x4*)(mod + b * 6144 + 5120 + col) * y;
            s += (v[j].x + v[j].y) + (v[j].z + v[j].w); }
        const float mean = wave_sum(s) * (1.f / D); float s2 = 0.f;
#pragma unroll
        for (int j = 0; j < 4; ++j) { v[j] = v[j] - mean; s2 += (v[j].x * v[j].x + v[j].y * v[j].y) + (v[j].z * v[j].z + v[j].w * v[j].w); }
        const float rstd = 1.f / sqrtf(wave_sum(s2) * (1.f / D) + LN_EPS);
#pragma unroll
        for (int j = 0; j < 4; ++j) { const int col = 4 * lane + 256 * j;
            *(f32x4*)(out + (size_t)row * D + col) = v[j] * rstd * *(const f32x4*)(ln2_g + col) + *(const f32x4*)(ln2_b + col); }
    }
}

extern "C" void kernel_launch(void* const* d_in, const int* in_sizes, int n_in, void* d_out, int out_size, void* d_ws, size_t ws_size, hipStream_t stream) {
    if (n_in != 22 || out_size != T * D || ws_size < WS_END) { fprintf(stderr, "kernel_launch: unexpected shapes (n_in %d out %d ws %zu)\n", n_in, out_size, ws_size); return; }
    const float* x = (const float*)d_in[0]; const float* c = (const float*)d_in[1]; const float* w_ada = (const float*)d_in[2]; const float* b_ada = (const float*)d_in[3];
    const float* w_in = (const float*)d_in[4]; const float* conv_w = (const float*)d_in[5]; const float* conv_b = (const float*)d_in[6]; const float* gate_b = (const float*)d_in[7];
    const float* norm_g = (const float*)d_in[8]; const float* w_out = (const float*)d_in[9]; const float* ln1_g = (const float*)d_in[10]; const float* ln1_b = (const float*)d_in[11];
    const float* w_router = (const float*)d_in[12]; const float* rbias = (const float*)d_in[13];
    const float* ln2_g = (const float*)d_in[20]; const float* ln2_b = (const float*)d_in[21];
    char* ws = (char*)d_ws; float* out = (float*)d_out;
    float* mod = (float*)(ws + WS_MOD); bf16* wtin = (bf16*)(ws + WS_WTIN); bf16* wtout = (bf16*)(ws + WS_WTOUT); bf16* wtr = (bf16*)(ws + WS_WTR);
    bf16* wt13 = (bf16*)(ws + WS_WT13); bf16* wt2 = (bf16*)(ws + WS_WT2); int* plan = (int*)(ws + WS_PLAN);
    bf16* u1 = (bf16*)(ws + WS_U1); bf16* proj = (bf16*)(ws + WS_PROJ); float* ipre = (float*)(ws + WS_GATES); float* logf = ipre + 16 * S;
    float* hraw = (float*)(ws + WS_HRAW); bf16* mix = (bf16*)(ws + WS_MIX); bf16* mixout = (bf16*)(ws + WS_MIXOUT); bf16* u2 = (bf16*)(ws + WS_U2);
    float* logits = (float*)(ws + WS_LOGITS); int* tope = (int*)(ws + WS_ROUTE); float* topg = (float*)(ws + WS_ROUTE + 1 * MiB); int* list = (int*)(ws + WS_ROUTE + 2 * MiB);
    bf16* H = (bf16*)(ws + WS_H); bf16* ys = (bf16*)(ws + WS_YS); bf16* ysh = (bf16*)(ws + WS_YSH);
    int* cnt = (int*)(ws + WS_CTL) + CW_CNT;
    hipMemsetAsync(ws + WS_CTL, 0, 1 * MiB, stream);
    k_mod<<<192, 512, 0, stream>>>(c, w_ada, b_ada, mod);
    PrepArgs pa{w_in, w_out, w_router, (const float*)d_in[14], (const float*)d_in[15], (const float*)d_in[16], (const float*)d_in[17], (const float*)d_in[18], (const float*)d_in[19], wtin, wtout, wtr, wt13, wt2};
    k_prep<<<2048, 512, 0, stream>>>(pa);
    k_ln1<<<T / 128, 512, 0, stream>>>(x, mod, w_in, gate_b, u1, ipre, logf);
    k_ngemm<0><<<dim3(NPROJ / 64, T / 64), 256, 0, stream>>>(u1, wtin, proj, T, NPROJ, D, NPROJ, 512, QSCALE);
    k_attn_naive<<<NB * 8 * S / 256, 256, 0, stream>>>(proj, mix);
    k_mlstm_naive<<<128, 256, 0, stream>>>(proj, conv_w, conv_b, ipre, logf, hraw);
    k_mlnorm_naive<<<T, 256, 0, stream>>>(hraw, proj, norm_g, mix);
    k_ngemm<0><<<dim3(D / 64, T / 64), 256, 0, stream>>>(mix, wtout, mixout, T, D, D, D, 0, 1.f);
    k_ln2<<<T / 128, 512, 0, stream>>>(x, mixout, mod, ln1_g, ln1_b, out, u2);
    k_ngemm<1><<<dim3(NE / 64, T / 64), 256, 0, stream>>>(u2, wtr, logits, T, NE, D, NE, 0, 1.f);
    k_route<<<T / 256, 256, 0, stream>>>(logits, rbias, tope, topg, cnt, list);
    k_plan<<<1, 64, 0, stream>>>(cnt, plan);
    constexpr int MAXT64 = T * TOPK / 64 + NE + T / 64;
    k_moe1_naive<<<dim3(4, MAXT64), 256, 0, stream>>>(u2, wt13, cnt, plan, list, H);
    k_moe2_naive<<<dim3(16, MAXT64), 256, 0, stream>>>(H, wt2, cnt, plan, list, topg, ys, ysh);
    k_final<<<T / 128, 512, 0, stream>>>(out, ys, ysh, mod, ln2_g, ln2_b);
}
```

```cpp
#include <hip/hip_runtime.h>
#include <cstdio>
#include <cstdint>

typedef unsigned short bf16;
typedef unsigned v4u __attribute__((ext_vector_type(4)));
typedef float f32x4 __attribute__((ext_vector_type(4)));
typedef int i32x2 __attribute__((ext_vector_type(2)));

constexpr int D = 1024, NB = 4, S = 8192, T = NB * S;
constexpr int NPROJ = 3584, WIN_LD = 3592;
constexpr int C_SBQ = 0, C_SBK = 512, C_SBV = 1024, C_MLQ = 1536, C_MLK = 2048, C_MLV = 2560, C_MLO = 3072, C_GATE = 3584;
constexpr int NE = 256, NEX = 257, TOPK = 8, FF = 256;
constexpr float LN_EPS = 1e-5f;
constexpr float DN_ALPHA = 1.189207115002721f;
constexpr float LOG2E = 1.4426950408889634f;
constexpr float QSCALE = 0.125f * LOG2E;
constexpr float SB_THRESH = 48.0f;

constexpr size_t MiB = 1u << 20;
constexpr size_t WS_CTL = 0;
constexpr size_t WS_MOD = 1 * MiB;
constexpr size_t WS_WTIN = 2 * MiB;
constexpr size_t WS_WTOUT = 10 * MiB;
constexpr size_t WS_WTR = 12 * MiB;
constexpr size_t WS_PLAN = 13 * MiB;
constexpr size_t WS_WT2 = 16 * MiB;
constexpr size_t WS_YS = 145 * MiB;
constexpr size_t WS_WT13 = 145 * MiB;
constexpr size_t WS_PROJ = 402 * MiB;
constexpr size_t WS_GATES = 626 * MiB;
constexpr size_t WS_H = 657 * MiB;
constexpr size_t WS_STATES = 657 * MiB;
constexpr size_t WS_MIXOUT = 657 * MiB;
constexpr size_t WS_LOGITS = 657 * MiB;
constexpr size_t WS_U1 = 725 * MiB;
constexpr size_t WS_MIX = 725 * MiB;
constexpr size_t WS_U2 = 833 * MiB;
constexpr size_t WS_YSH = 833 * MiB;
constexpr size_t WS_HRAW = 833 * MiB;
constexpr size_t WS_ROUTE = 897 * MiB;
constexpr size_t WS_END = 902 * MiB;
constexpr int CW_CNT = 1024;
constexpr int CW_FILL = 1536;
constexpr int PL_SLOT = 0, PL_T64 = 512, PL_T256 = 1024;

__device__ __forceinline__ unsigned f2bf(float f) { unsigned u = __builtin_bit_cast(unsigned, f); return (u + 0x7fffu + ((u >> 16) & 1u)) >> 16; }
__device__ __forceinline__ float bf2f(unsigned b) { return __builtin_bit_cast(float, b << 16); }
__device__ __forceinline__ unsigned pk2(float lo, float hi) { return f2bf(lo) | (f2bf(hi) << 16); }
__device__ __forceinline__ float wave_sum(float v) {
#pragma unroll
    for (int o = 1; o < 64; o <<= 1) v += __shfl_xor(v, o);
    return v;
}
__device__ __forceinline__ float sigmoidf_(float x) { return 1.f / (1.f + __expf(-x)); }
__device__ __forceinline__ float siluf_(float x) { return x / (1.f + __expf(-x)); }

__global__ void __launch_bounds__(512) k_mod(const float* __restrict__ c, const float* __restrict__ w_ada, const float* __restrict__ b_ada, float* __restrict__ mod) {
    __shared__ float sc[NB][D];
    __shared__ float red[16][NB][32];
    const int tid = threadIdx.x;
    for (int i = tid; i < NB * D; i += 512) sc[i / D][i % D] = siluf_(c[i]);
    __syncthreads();
    const int kq = tid >> 5, jl = tid & 31, j = blockIdx.x * 32 + jl;
    float a0 = 0.f, a1 = 0.f, a2 = 0.f, a3 = 0.f;
#pragma unroll 16
    for (int kk = 0; kk < 64; ++kk) { const int k = kq * 64 + kk; const float w = w_ada[(size_t)k * 6144 + j];
        a0 += sc[0][k] * w; a1 += sc[1][k] * w; a2 += sc[2][k] * w; a3 += sc[3][k] * w; }
    red[kq][0][jl] = a0; red[kq][1][jl] = a1; red[kq][2][jl] = a2; red[kq][3][jl] = a3;
    __syncthreads();
    if (tid < 128) { const int b = tid >> 5; float s = b_ada[j];
#pragma unroll
        for (int q = 0; q < 16; ++q) s += red[q][b][jl];
        mod[b * 6144 + j] = s; }
}

__device__ __forceinline__ void transpose_item(const float* __restrict__ W, int ldw, bf16* __restrict__ WT, int ldt, int k0, int n0, int rowmap, int lane) {
    const int g = lane >> 4, i = lane & 15;
    f32x4 v[8];
#pragma unroll
    for (int r = 0; r < 8; ++r) v[r] = *(const f32x4*)(W + (size_t)(k0 + 8 * g + r) * ldw + n0 + 4 * i);
#pragma unroll
    for (int nn = 0; nn < 4; ++nn) {
        const int n = n0 + 4 * i + nn;
        const int dr = rowmap == 0 ? n : ((n >> 7) * 256 + (rowmap == 2 ? 128 : 0) + (n & 127));
        v4u o; o.x = pk2(v[0][nn], v[1][nn]); o.y = pk2(v[2][nn], v[3][nn]); o.z = pk2(v[4][nn], v[5][nn]); o.w = pk2(v[6][nn], v[7][nn]);
        *(v4u*)(WT + (size_t)dr * ldt + k0 + 8 * g) = o;
    }
}
struct PrepArgs { const float *w_in, *w_out, *w_router, *w1, *w3, *w2, *sw1, *sw3, *sw2; bf16 *wtin, *wtout, *wtr, *wt13, *wt2; };
constexpr int IT_IN = 32 * 56, IT_OUT = 32 * 16, IT_R = 32 * 4, IT_E = 384, IT_TOTAL = IT_IN + IT_OUT + IT_R + NEX * IT_E;
__device__ __forceinline__ void prep_item(const PrepArgs& a, int it, int lane) {
    if (it < IT_IN) { transpose_item(a.w_in, WIN_LD, a.wtin, D, (it / 56) * 32, (it % 56) * 64, 0, lane); return; } it -= IT_IN;
    if (it < IT_OUT) { transpose_item(a.w_out, D, a.wtout, D, (it / 16) * 32, (it % 16) * 64, 0, lane); return; } it -= IT_OUT;
    if (it < IT_R) { transpose_item(a.w_router, NE, a.wtr, D, (it / 4) * 32, (it % 4) * 64, 0, lane); return; } it -= IT_R;
    const int e = it / IT_E, r = it % IT_E;
    const float* p1 = e < NE ? a.w1 + (size_t)e * D * FF : a.sw1; const float* p3 = e < NE ? a.w3 + (size_t)e * D * FF : a.sw3; const float* p2 = e < NE ? a.w2 + (size_t)e * FF * D : a.sw2;
    bf16* d13 = a.wt13 + (size_t)e * 512 * D; bf16* d2 = a.wt2 + (size_t)e * D * FF;
    if (r < 128) { transpose_item(p1, FF, d13, D, (r / 4) * 32, (r % 4) * 64, 1, lane); return; }
    if (r < 256) { const int q = r - 128; transpose_item(p3, FF, d13, D, (q / 4) * 32, (q % 4) * 64, 2, lane); return; }
    { const int q = r - 256; transpose_item(p2, D, d2, FF, (q / 16) * 32, (q % 16) * 64, 0, lane); }
}
__global__ void __launch_bounds__(512) k_prep(PrepArgs a) {
    const int lane = threadIdx.x & 63, gw = blockIdx.x * 8 + (threadIdx.x >> 6), ngw = gridDim.x * 8;
    for (int it = gw; it < IT_TOTAL; it += ngw) prep_item(a, it, lane);
}

__global__ void __launch_bounds__(512) k_ln1(const float* __restrict__ x, const float* __restrict__ mod, const float* __restrict__ w_in, const float* __restrict__ gate_b,
                                              bf16* __restrict__ u1, float* __restrict__ ipre, float* __restrict__ logf) {
    __shared__ float wg[D][8];
    const int tid = threadIdx.x, lane = tid & 63, wave = tid >> 6;
    for (int i = tid; i < D * 8; i += 512) wg[i >> 3][i & 7] = w_in[(size_t)(i >> 3) * WIN_LD + C_GATE + (i & 7)];
    __syncthreads();
    const int row0 = blockIdx.x * 128, b = row0 / S;
    f32x4 sh[4], sc[4];
#pragma unroll
    for (int j = 0; j < 4; ++j) { sh[j] = *(const f32x4*)(mod + b * 6144 + 4 * lane + 256 * j); sc[j] = *(const f32x4*)(mod + b * 6144 + 1024 + 4 * lane + 256 * j); }
    for (int rr = wave; rr < 128; rr += 8) {
        const int row = row0 + rr;
        const f32x4* xr = (const f32x4*)(x + (size_t)row * D) + lane;
        f32x4 v[4]; float s = 0.f;
#pragma unroll
        for (int j = 0; j < 4; ++j) { v[j] = xr[64 * j]; s += (v[j].x + v[j].y) + (v[j].z + v[j].w); }
        const float mean = wave_sum(s) * (1.f / D); float s2 = 0.f;
#pragma unroll
        for (int j = 0; j < 4; ++j) { v[j] = v[j] - mean; s2 += (v[j].x * v[j].x + v[j].y * v[j].y) + (v[j].z * v[j].z + v[j].w * v[j].w); }
        const float rstd = 1.f / sqrtf(wave_sum(s2) * (1.f / D) + LN_EPS);
        float ga[8];
#pragma unroll
        for (int q = 0; q < 8; ++q) ga[q] = 0.f;
        unsigned long long* o8 = (unsigned long long*)(u1 + (size_t)row * D) + lane;
#pragma unroll
        for (int j = 0; j < 4; ++j) {
            f32x4 u = v[j] * rstd * (sc[j] + 1.0f) + sh[j];
            o8[64 * j] = (unsigned long long)pk2(u.x, u.y) | ((unsigned long long)pk2(u.z, u.w) << 32);
#pragma unroll
            for (int e = 0; e < 4; ++e) { const int k = 4 * lane + 256 * j + e;
#pragma unroll
                for (int q = 0; q < 8; ++q) ga[q] += u[e] * wg[k][q]; }
        }
#pragma unroll
        for (int q = 0; q < 8; ++q) ga[q] = wave_sum(ga[q]);
        if (lane < 8) {
            float gv = 0.f;
#pragma unroll
            for (int q = 0; q < 8; ++q) gv = (lane == q) ? ga[q] : gv;
            gv += gate_b[lane];
            const int h = lane & 3, s_ = row % S;
            if (lane < 4) ipre[(size_t)(b * 4 + h) * S + s_] = gv;
            else { const float ls = fminf(gv, 0.f) - log1pf(__expf(-fabsf(gv))); logf[(size_t)(b * 4 + h) * S + s_] = ls; }
        }
    }
}

template <class ARow, class BRow>
__device__ __forceinline__ void ngemm_tile(ARow arow, BRow brow, int K, float (&acc)[4][4], float* sA, float* sB) {
    const int tid = threadIdx.x, ty = tid >> 4, tx = tid & 15;
    const int lr = tid >> 2, lk = (tid & 3) * 8;
    const bf16* ap = arow(lr); const bf16* bp = brow(lr);
#pragma unroll
    for (int i = 0; i < 4; ++i)
#pragma unroll
        for (int j = 0; j < 4; ++j) acc[i][j] = 0.f;
    for (int k0 = 0; k0 < K; k0 += 32) {
        v4u av = {0u, 0u, 0u, 0u}, bv = {0u, 0u, 0u, 0u};
        if (ap) av = *(const v4u*)(ap + k0 + lk);
        if (bp) bv = *(const v4u*)(bp + k0 + lk);
        __syncthreads();
#pragma unroll
        for (int q = 0; q < 4; ++q) {
            sA[(lk + 2 * q) * 68 + lr] = bf2f(av[q] & 0xffffu); sA[(lk + 2 * q + 1) * 68 + lr] = bf2f(av[q] >> 16);
            sB[(lk + 2 * q) * 68 + lr] = bf2f(bv[q] & 0xffffu); sB[(lk + 2 * q + 1) * 68 + lr] = bf2f(bv[q] >> 16);
        }
        __syncthreads();
#pragma unroll 8
        for (int kk = 0; kk < 32; ++kk) {
            const f32x4 a = *(const f32x4*)(sA + kk * 68 + ty * 4), b = *(const f32x4*)(sB + kk * 68 + tx * 4);
#pragma unroll
            for (int i = 0; i < 4; ++i)
#pragma unroll
                for (int j = 0; j < 4; ++j) acc[i][j] += a[i] * b[j];
        }
    }
}

template <int MODE>
__global__ void __launch_bounds__(256) k_ngemm(const bf16* __restrict__ A, const bf16* __restrict__ Bt, void* __restrict__ C, int M, int N, int K, int ldc, int scale_cols, float scale) {
    __shared__ __attribute__((aligned(16))) float sA[32 * 68];
    __shared__ __attribute__((aligned(16))) float sB[32 * 68];
    const int m0 = blockIdx.y * 64, n0 = blockIdx.x * 64;
    float acc[4][4];
    ngemm_tile([&](int r) { return A + (size_t)(m0 + r) * K; }, [&](int r) { return Bt + (size_t)(n0 + r) * K; }, K, acc, sA, sB);
    const int ty = threadIdx.x >> 4, tx = threadIdx.x & 15;
#pragma unroll
    for (int i = 0; i < 4; ++i) { const int m = m0 + ty * 4 + i, n = n0 + tx * 4;
        if (MODE == 0) { const float sc = n < scale_cols ? scale : 1.f;
            *(unsigned long long*)((bf16*)C + (size_t)m * ldc + n) = (unsigned long long)pk2(acc[i][0] * sc, acc[i][1] * sc) | ((unsigned long long)pk2(acc[i][2] * sc, acc[i][3] * sc) << 32); }
        else *(f32x4*)((float*)C + (size_t)m * ldc + n) = (f32x4){acc[i][0], acc[i][1], acc[i][2], acc[i][3]}; }
}

__global__ void __launch_bounds__(256) k_attn_naive(const bf16* __restrict__ proj, bf16* __restrict__ mix) {
    const int gid = blockIdx.x * 256 + threadIdx.x;
    const int t = gid % S, bh = gid / S, h = bh & 7, b = bh >> 3;
    const bf16* base = proj + (size_t)b * S * NPROJ;
    float q[64], o[64];
    { const v4u* qp = (const v4u*)(base + (size_t)t * NPROJ + C_SBQ + h * 64);
#pragma unroll
      for (int i = 0; i < 8; ++i) { const v4u w = qp[i];
#pragma unroll
          for (int e = 0; e < 4; ++e) { q[i * 8 + 2 * e] = bf2f(w[e] & 0xffffu); q[i * 8 + 2 * e + 1] = bf2f(w[e] >> 16); } } }
#pragma unroll
    for (int d = 0; d < 64; ++d) o[d] = 0.f;
    float carry = 0.f;
    for (int s = t - 1; s >= 0; --s) {
        const v4u* kp = (const v4u*)(base + (size_t)s * NPROJ + C_SBK + h * 64);
        float z = 0.f;
#pragma unroll
        for (int i = 0; i < 8; ++i) { const v4u w = kp[i];
#pragma unroll
            for (int e = 0; e < 4; ++e) { z += q[i * 8 + 2 * e] * bf2f(w[e] & 0xffffu); z += q[i * 8 + 2 * e + 1] * bf2f(w[e] >> 16); } }
        const float sp = fmaxf(z, 0.f) + __log2f(1.f + exp2f(-fabsf(z)));
        carry += sp;
        const float a = exp2f(z - carry);
        const v4u* vp = (const v4u*)(base + (size_t)s * NPROJ + C_SBV + h * 64);
#pragma unroll
        for (int i = 0; i < 8; ++i) { const v4u w = vp[i];
#pragma unroll
            for (int e = 0; e < 4; ++e) { o[i * 8 + 2 * e] += a * bf2f(w[e] & 0xffffu); o[i * 8 + 2 * e + 1] += a * bf2f(w[e] >> 16); } }
        if (carry > SB_THRESH) break;
    }
    v4u* op = (v4u*)(mix + (size_t)(b * S + t) * D + h * 64);
#pragma unroll
    for (int i = 0; i < 8; ++i) { v4u w; w.x = pk2(o[i * 8], o[i * 8 + 1]); w.y = pk2(o[i * 8 + 2], o[i * 8 + 3]); w.z = pk2(o[i * 8 + 4], o[i * 8 + 5]); w.w = pk2(o[i * 8 + 6], o[i * 8 + 7]); op[i] = w; }
}

__global__ void __launch_bounds__(256) k_mlstm_naive(const bf16* __restrict__ proj, const float* __restrict__ conv_w, const float* __restrict__ conv_b,
                                                      const float* __restrict__ ipre, const float* __restrict__ logf, float* __restrict__ hraw) {
    __shared__ float sq[32][128], sk[32][128], sv[32][16], sf[32], si[32];
    const int tid = threadIdx.x, bh = blockIdx.x >> 3, sl = blockIdx.x & 7, b = bh >> 2, h = bh & 3;
    const int r = tid >> 4, c = tid & 15;
    const bf16* base = proj + (size_t)b * S * NPROJ;
    float Cst[8], nst[8];
#pragma unroll
    for (int e = 0; e < 8; ++e) { Cst[e] = 0.f; nst[e] = 0.f; }
    for (int t0 = 0; t0 < S; t0 += 32) {
        __syncthreads();
        for (int i = tid; i < 32 * 128; i += 256) {
            const int tt = i >> 7, d = i & 127, t = t0 + tt, ch = h * 128 + d;
            float yq = conv_b[ch], yk = conv_b[512 + ch];
#pragma unroll
            for (int j = 0; j < 4; ++j) { const int ts = t - 3 + j;
                if (ts >= 0) { yq += conv_w[j * 1024 + ch] * bf2f(base[(size_t)ts * NPROJ + C_MLQ + ch]); yk += conv_w[j * 1024 + 512 + ch] * bf2f(base[(size_t)ts * NPROJ + C_MLK + ch]); } }
            sq[tt][d] = siluf_(yq); sk[tt][d] = siluf_(yk) * 0.08838834764831845f;
        }
        for (int i = tid; i < 32 * 16; i += 256) { const int tt = i >> 4, d = i & 15; sv[tt][d] = bf2f(base[(size_t)(t0 + tt) * NPROJ + C_MLV + h * 128 + sl * 16 + d]); }
        if (tid < 32) { sf[tid] = __expf(logf[(size_t)bh * S + t0 + tid]); si[tid] = __expf(ipre[(size_t)bh * S + t0 + tid]); }
        __syncthreads();
        for (int tt = 0; tt < 32; ++tt) {
            const float f = sf[tt], iv = si[tt] * sv[tt][r], ii = si[tt];
            float pn = 0.f, pd = 0.f;
#pragma unroll
            for (int e = 0; e < 8; ++e) { const float kk = sk[tt][c * 8 + e], qq = sq[tt][c * 8 + e];
                Cst[e] = f * Cst[e] + iv * kk; nst[e] = f * nst[e] + ii * kk; pn += Cst[e] * qq; pd += nst[e] * qq; }
#pragma unroll
            for (int o = 1; o < 16; o <<= 1) { pn += __shfl_xor(pn, o); pd += __shfl_xor(pd, o); }
            if (c == 0) hraw[(size_t)(b * S + t0 + tt) * 512 + h * 128 + sl * 16 + r] = pn / fmaxf(fabsf(pd), 1.f);
        }
    }
}
__global__ void __launch_bounds__(256) k_mlnorm_naive(const float* __restrict__ hraw, const bf16* __restrict__ proj, const float* __restrict__ norm_g, bf16* __restrict__ mix) {
    const int gw = blockIdx.x * 4 + (threadIdx.x >> 6), lane = threadIdx.x & 63, t = gw >> 2, h = gw & 3;
    const float a = hraw[(size_t)t * 512 + h * 128 + 2 * lane], bq = hraw[(size_t)t * 512 + h * 128 + 2 * lane + 1];
    const float mean = wave_sum(a + bq) * (1.f / 128.f);
    const float da = a - mean, db = bq - mean;
    const float rstd = 1.f / sqrtf(wave_sum(da * da + db * db) * (1.f / 128.f) + LN_EPS);
    const unsigned ow = *(const unsigned*)(proj + (size_t)t * NPROJ + C_MLO + h * 128 + 2 * lane);
    const float o0 = sigmoidf_(bf2f(ow & 0xffffu)), o1 = sigmoidf_(bf2f(ow >> 16));
    const float g0 = norm_g[h * 128 + 2 * lane], g1 = norm_g[h * 128 + 2 * lane + 1];
    *(unsigned*)(mix + (size_t)t * D + 512 + h * 128 + 2 * lane) = pk2(da * rstd * g0 * o0, db * rstd * g1 * o1);
}

__global__ void __launch_bounds__(512) k_ln2(const float* __restrict__ x, const bf16* __restrict__ mixout, const float* __restrict__ mod, const float* __restrict__ ln1_g, const float* __restrict__ ln1_b,
                                              float* __restrict__ x1, bf16* __restrict__ u2) {
    const int tid = threadIdx.x, lane = tid & 63, wave = tid >> 6;
    const int row0 = blockIdx.x * 128, b = row0 / S;
    for (int rr = wave; rr < 128; rr += 8) {
        const int row = row0 + rr;
        f32x4 v[4]; float s = 0.f;
#pragma unroll
        for (int j = 0; j < 4; ++j) {
            const int col = 4 * lane + 256 * j;
            const f32x4 xv = *(const f32x4*)(x + (size_t)row * D + col);
            const unsigned long long mw = *(const unsigned long long*)(mixout + (size_t)row * D + col);
            const f32x4 g1 = *(const f32x4*)(mod + b * 6144 + 2048 + col);
            f32x4 mo = {bf2f((unsigned)mw & 0xffffu), bf2f(((unsigned)mw) >> 16), bf2f((unsigned)(mw >> 32) & 0xffffu), bf2f((unsigned)(mw >> 48))};
            v[j] = xv * DN_ALPHA + g1 * mo; s += (v[j].x + v[j].y) + (v[j].z + v[j].w);
        }
        float mean = wave_sum(s) * (1.f / D), s2 = 0.f;
#pragma unroll
        for (int j = 0; j < 4; ++j) { v[j] = v[j] - mean; s2 += (v[j].x * v[j].x + v[j].y * v[j].y) + (v[j].z * v[j].z + v[j].w * v[j].w); }
        float rstd = 1.f / sqrtf(wave_sum(s2) * (1.f / D) + LN_EPS);
        s = 0.f;
#pragma unroll
        for (int j = 0; j < 4; ++j) { const int col = 4 * lane + 256 * j;
            v[j] = v[j] * rstd * *(const f32x4*)(ln1_g + col) + *(const f32x4*)(ln1_b + col);
            *(f32x4*)(x1 + (size_t)row * D + col) = v[j]; s += (v[j].x + v[j].y) + (v[j].z + v[j].w); }
        mean = wave_sum(s) * (1.f / D); s2 = 0.f;
#pragma unroll
        for (int j = 0; j < 4; ++j) { v[j] = v[j] - mean; s2 += (v[j].x * v[j].x + v[j].y * v[j].y) + (v[j].z * v[j].z + v[j].w * v[j].w); }
        rstd = 1.f / sqrtf(wave_sum(s2) * (1.f / D) + LN_EPS);
#pragma unroll
        for (int j = 0; j < 4; ++j) { const int col = 4 * lane + 256 * j;
            const f32x4 u = v[j] * rstd * (*(const f32x4*)(mod + b * 6144 + 4096 + col) + 1.0f) + *(const f32x4*)(mod + b * 6144 + 3072 + col);
            *(unsigned long long*)(u2 + (size_t)row * D + col) = (unsigned long long)pk2(u.x, u.y) | ((unsigned long long)pk2(u.z, u.w) << 32); }
    }
}

__global__ void __launch_bounds__(256) k_route(const float* __restrict__ logits, const float* __restrict__ rbias, int* __restrict__ tope, float* __restrict__ topg, int* __restrict__ cnt) {
    const int t = blockIdx.x * 256 + threadIdx.x;
    const float* lg = logits + (size_t)t * NE;
    float gs[8];
#pragma unroll
    for (int g = 0; g < 8; ++g) { float m1 = -INFINITY, m2 = -INFINITY;
        for (int i = 0; i < 32; ++i) { const int e = g * 32 + i; const float v = sigmoidf_(lg[e]) + rbias[e]; if (v > m1) { m2 = m1; m1 = v; } else if (v > m2) m2 = v; }
        gs[g] = m1 + m2; }
    unsigned gmask = 0;
#pragma unroll
    for (int r = 0; r < 4; ++r) { int bi = 0; float bv = -INFINITY;
#pragma unroll
        for (int g = 0; g < 8; ++g) if (!((gmask >> g) & 1u) && gs[g] > bv) { bv = gs[g]; bi = g; }
        gmask |= 1u << bi; }
    float pv = INFINITY; int pi = -1; float gsum = 0.f;
    for (int r = 0; r < 8; ++r) { int bi = 0; float bv = -INFINITY, bs = 0.f;
        for (int e = 0; e < NE; ++e) { if (!((gmask >> (e >> 5)) & 1u)) continue;
            const float sc = sigmoidf_(lg[e]), v = sc + rbias[e];
            const bool elig = (v < pv) || (v == pv && e > pi);
            if (elig && v > bv) { bv = v; bi = e; bs = sc; } }
        pv = bv; pi = bi; gsum += bs;
        tope[t * 8 + r] = bi; topg[t * 8 + r] = bs;
        atomicAdd(cnt + bi, 1); }
    const float inv = 2.5f / gsum;
    for (int r = 0; r < 8; ++r) topg[t * 8 + r] *= inv;
}
__global__ void k_plan(const int* __restrict__ cnt, int* __restrict__ plan) {
    if (threadIdx.x == 0) { int s = 0, t64 = 0, t256 = 0;
        for (int e = 0; e <= NEX; ++e) { plan[PL_SLOT + e] = s; plan[PL_T64 + e] = t64; plan[PL_T256 + e] = t256;
            if (e < NEX) { const int n = e < NE ? cnt[e] : T; s += ((n + 255) / 256) * 256; t64 += (n + 63) / 64; t256 += (n + 255) / 256; } } }
}
__global__ void __launch_bounds__(256) k_fill(const int* __restrict__ tope, const float* __restrict__ topg, const int* __restrict__ plan, int* __restrict__ fill, i32x2* __restrict__ list) {
    const int id = blockIdx.x * 256 + threadIdx.x; const int e = tope[id];
    const int pos = atomicAdd(fill + e, 1); list[plan[PL_SLOT + e] + pos] = (i32x2){id, __float_as_int(topg[id])};
}
__device__ __forceinline__ int find_expert(const int* base, int tile) { int lo = 0, hi = NEX;
    while (hi - lo > 1) { const int mid = (lo + hi) >> 1; if (base[mid] <= tile) lo = mid; else hi = mid; } return lo; }

__global__ void __launch_bounds__(256) k_moe1_naive(const bf16* __restrict__ u2, const bf16* __restrict__ wt13, const int* __restrict__ cnt, const int* __restrict__ plan, const i32x2* __restrict__ list, bf16* __restrict__ H) {
    __shared__ __attribute__((aligned(16))) float sA[32 * 68];
    __shared__ __attribute__((aligned(16))) float sB[32 * 68];
    const int tile = blockIdx.y; if (tile >= plan[PL_T64 + NEX]) return;
    const int e = find_expert(plan + PL_T64, tile), mt = tile - plan[PL_T64 + e], n = e < NE ? cnt[e] : T, j0 = blockIdx.x * 64;
    const bf16* w = wt13 + (size_t)e * 512 * D;
    auto arow = [&](int r) -> const bf16* { const int rr = mt * 64 + r; if (rr >= n) return nullptr; const int tok = e < NE ? (list[plan[PL_SLOT + e] + rr].x >> 3) : rr; return u2 + (size_t)tok * D; };
    float a1[4][4], a3[4][4];
    ngemm_tile(arow, [&](int r) { const int j = j0 + r; return w + (size_t)((j >> 7) * 256 + (j & 127)) * D; }, D, a1, sA, sB);
    __syncthreads();
    ngemm_tile(arow, [&](int r) { const int j = j0 + r; return w + (size_t)((j >> 7) * 256 + 128 + (j & 127)) * D; }, D, a3, sA, sB);
    const int ty = threadIdx.x >> 4, tx = threadIdx.x & 15;
#pragma unroll
    for (int i = 0; i < 4; ++i) { const int rr = mt * 64 + ty * 4 + i; if (rr >= n) continue;
        float hv[4];
#pragma unroll
        for (int j = 0; j < 4; ++j) hv[j] = siluf_(a1[i][j]) * a3[i][j];
        *(unsigned long long*)(H + (size_t)(plan[PL_SLOT + e] + rr) * FF + j0 + tx * 4) = (unsigned long long)pk2(hv[0], hv[1]) | ((unsigned long long)pk2(hv[2], hv[3]) << 32); }
}
__global__ void __launch_bounds__(256) k_moe2_naive(const bf16* __restrict__ H, const bf16* __restrict__ wt2, const int* __restrict__ cnt, const int* __restrict__ plan, const i32x2* __restrict__ list,
                                                     const float* __restrict__ topg, bf16* __restrict__ ys, bf16* __restrict__ ysh) {
    __shared__ __attribute__((aligned(16))) float sA[32 * 68];
    __shared__ __attribute__((aligned(16))) float sB[32 * 68];
    const int tile = blockIdx.y; if (tile >= plan[PL_T64 + NEX]) return;
    const int e = find_expert(plan + PL_T64, tile), mt = tile - plan[PL_T64 + e], n = e < NE ? cnt[e] : T, n0 = blockIdx.x * 64;
    const bf16* w = wt2 + (size_t)e * D * FF; const bf16* hb = H + (size_t)plan[PL_SLOT + e] * FF;
    float acc[4][4];
    ngemm_tile([&](int r) -> const bf16* { const int rr = mt * 64 + r; return rr < n ? hb + (size_t)rr * FF : nullptr; }, [&](int r) { return w + (size_t)(n0 + r) * FF; }, FF, acc, sA, sB);
    const int ty = threadIdx.x >> 4, tx = threadIdx.x & 15;
#pragma unroll
    for (int i = 0; i < 4; ++i) { const int rr = mt * 64 + ty * 4 + i; if (rr >= n) continue;
        bf16* dst; float g = 1.f;
        if (e < NE) { const i32x2 en = list[plan[PL_SLOT + e] + rr]; g = __int_as_float(en.y); dst = ys + (size_t)en.x * D; } else dst = ysh + (size_t)rr * D;
        *(unsigned long long*)(dst + n0 + tx * 4) = (unsigned long long)pk2(acc[i][0] * g, acc[i][1] * g) | ((unsigned long long)pk2(acc[i][2] * g, acc[i][3] * g) << 32); }
}

__device__ __forceinline__ f32x4 ld_bf4(const bf16* p) { const unsigned long long w = *(const unsigned long long*)p;
    return (f32x4){bf2f((unsigned)w & 0xffffu), bf2f(((unsigned)w) >> 16), bf2f((unsigned)(w >> 32) & 0xffffu), bf2f((unsigned)(w >> 48))}; }
__global__ void __launch_bounds__(512) k_final(float* __restrict__ out, const bf16* __restrict__ ys, const bf16* __restrict__ ysh, const float* __restrict__ mod, const float* __restrict__ ln2_g, const float* __restrict__ ln2_b) {
    const int tid = threadIdx.x, lane = tid & 63, wave = tid >> 6;
    const int row0 = blockIdx.x * 128, b = row0 / S;
    for (int rr = wave; rr < 128; rr += 8) {
        const int row = row0 + rr;
        f32x4 v[4]; float s = 0.f;
#pragma unroll
        for (int j = 0; j < 4; ++j) { const int col = 4 * lane + 256 * j;
            f32x4 y = ld_bf4(ysh + (size_t)row * D + col);
#pragma unroll
            for (int k = 0; k < 8; ++k) y = y + ld_bf4(ys + ((size_t)row * 8 + k) * D + col);
            v[j] = *(const f32x4*)(out + (size_t)row * D + col) * DN_ALPHA + *(const f32x4*)(mod + b * 6144 + 5120 + col) * y;
            s += (v[j].x + v[j].y) + (v[j].z + v[j].w); }
        const float mean = wave_sum(s) * (1.f / D); float s2 = 0.f;
#pragma unroll
        for (int j = 0; j < 4; ++j) { v[j] = v[j] - mean; s2 += (v[j].x * v[j].x + v[j].y * v[j].y) + (v[j].z * v[j].z + v[j].w * v[j].w); }
        const float rstd = 1.f / sqrtf(wave_sum(s2) * (1.f / D) + LN_EPS);
#pragma unroll
        for (int j = 0; j < 4; ++j) { const int col = 4 * lane + 256 * j;
            *(f32x4*)(out + (size_t)row * D + col) = v[j] * rstd * *(const f32x4*)(ln2_g + col) + *(const f32x4*)(ln2_b + col); }
    }
}

#define LAS __attribute__((address_space(3)))
#define GAS __attribute__((address_space(1)))
namespace pg8 {
typedef short bf16x8 __attribute__((ext_vector_type(8)));
constexpr int BM = 256, BK = 64, HALF = 128, HTB = HALF * BK * 2, STAGE_BYTES = 8 * HTB, NXCD = 8, WGM = 8;
__host__ __device__ __forceinline__ int lds_byte(int r, int c) { const int st = (r >> 4) * 2 + (c >> 5), rr = r & 15, cc = c & 31, ob = rr * 64 + cc * 2; return st * 1024 + (ob ^ (((ob >> 9) & 1) << 5)); }
__host__ __device__ __forceinline__ void stage_rc(int b, int& R, int& C) { const int st = b / 1024, sb = b % 1024, swz = sb ^ (((sb >> 9) & 1) << 5); R = (st >> 1) * 16 + swz / 64; C = (st & 1) * 32 + (swz % 64) / 2; }
__host__ __device__ __forceinline__ int perm32(int rho) { const int n = rho >> 4, i = rho & 15; return 8 * (i >> 2) + 4 * n + (i & 3); }

struct Unit { int pm, pn, e, mt; const char* A; const char* B; };

__device__ __forceinline__ long unit_index(int i, int G, int c) { return (G % 8 == 0) ? ((long)(i * 8 + (c & 7)) * (G / 8) + (c >> 3)) : ((long)i * G + c); }

struct StaticOrder {
    int nM, nN, nwg, G, c; const char* A; const char* B; size_t tstep;
    __device__ void init(const void* A_, const void* B_, int M, int N, int K, int G_, int c_) { nM = M / BM; nN = N / BM; nwg = nM * nN; G = G_; c = c_; A = (const char*)A_; B = (const char*)B_; tstep = (size_t)BM * K * 2; }
    __device__ __forceinline__ bool next(int i, Unit& u) const {
        const long L = (long)i * G + c; if (L >= nwg) return false;
        int wgid = (int)L; { const int q = nwg / NXCD, r = nwg % NXCD, xcd = wgid % NXCD, off = wgid / NXCD; wgid = (xcd < r ? xcd * (q + 1) : r * (q + 1) + (xcd - r) * q) + off; }
        const int nig = WGM * nN, gid = wgid / nig, fm = gid * WGM, gsz = (nM - fm) < WGM ? (nM - fm) : WGM;
        u.pm = fm + ((wgid % nig) % gsz); u.pn = (wgid % nig) / gsz; u.e = 0; u.mt = u.pm; u.A = A + (size_t)u.pm * tstep; u.B = B + (size_t)u.pn * tstep; return true;
    }
    __device__ __forceinline__ int row_token(const Unit&, int) const { return 0; }
};

struct MoeOrder {
    int G, c, total, shift; const LAS int* tb; const LAS int* nn; const i32x2* list;
    const char* Abase; size_t a_tile_stride; const char* Bbase; size_t b_exp_stride, b_pn_stride;
    __device__ __forceinline__ bool next(int i, Unit& u) const {
        const long L = unit_index(i, G, c); if (L >= total) return false;
        const int tile = (int)(L >> shift); u.pn = (int)(L & ((1 << shift) - 1));
        int lo = 0, hi = NEX; while (hi - lo > 1) { const int mid = (lo + hi) >> 1; if (tb[mid] <= tile) lo = mid; else hi = mid; }
        u.e = lo; u.mt = tile - tb[lo]; u.pm = tile;
        u.A = Abase + (size_t)tile * a_tile_stride; u.B = Bbase + (size_t)lo * b_exp_stride + (size_t)u.pn * b_pn_stride; return true;
    }
    __device__ __forceinline__ int row_token(const Unit& u, int row) const {
        const int rr = u.mt * 256 + row;
        if (u.e >= NE) return rr;
        return rr < nn[u.e] ? (list[u.pm * 256 + row].x >> 3) : 0;
    }
};

__device__ __forceinline__ unsigned cvt_pk_bf16(float lo, float hi) { unsigned r; asm volatile("v_cvt_pk_bf16_f32 %0, %1, %2" : "=v"(r) : "v"(lo), "v"(hi)); return r; }

struct EpiBf16 {
    static constexpr bool PERM = true; bf16* O; int ldc; int scale_tiles; float scale;
    __device__ __forceinline__ void operator()(const f32x4 (&acc)[2][2][4][2], const Unit& u, int wr, int wc, int fr, int fq) const {
        const int row0 = u.pm * BM + wr * 64 + fr, col0 = u.pn * BM + wc * 32 + 8 * fq; const float sc = u.pn < scale_tiles ? scale : 1.f;
#pragma unroll
        for (int ai = 0; ai < 2; ++ai)
#pragma unroll
            for (int m = 0; m < 4; ++m) { bf16* rowp = O + (size_t)(row0 + ai * HALF + m * 16) * ldc + col0;
#pragma unroll
                for (int bj = 0; bj < 2; ++bj) { const f32x4 v0 = acc[ai][bj][m][0] * sc, v1 = acc[ai][bj][m][1] * sc;
                    v4u w; w.x = cvt_pk_bf16(v0[0], v0[1]); w.y = cvt_pk_bf16(v0[2], v0[3]); w.z = cvt_pk_bf16(v1[0], v1[1]); w.w = cvt_pk_bf16(v1[2], v1[3]);
                    *(v4u*)(rowp + bj * HALF) = w; } }
    }
};
struct EpiF32 {
    static constexpr bool PERM = false; float* C; int ldc;
    __device__ __forceinline__ void operator()(const f32x4 (&acc)[2][2][4][2], const Unit& u, int wr, int wc, int fr, int fq) const {
        const int row0 = u.pm * BM + wr * 64 + fr, col0 = u.pn * BM + wc * 32 + 4 * fq;
#pragma unroll
        for (int ai = 0; ai < 2; ++ai)
#pragma unroll
            for (int m = 0; m < 4; ++m) { float* rowp = C + (size_t)(row0 + ai * HALF + m * 16) * ldc + col0;
#pragma unroll
                for (int bj = 0; bj < 2; ++bj)
#pragma unroll
                    for (int n = 0; n < 2; ++n) *(f32x4*)(rowp + bj * HALF + n * 16) = acc[ai][bj][m][n]; }
    }
};
struct EpiGlu {
    static constexpr bool PERM = true; bf16* H;
    __device__ __forceinline__ void operator()(const f32x4 (&acc)[2][2][4][2], const Unit& u, int wr, int wc, int fr, int fq) const {
        const int row0 = u.pm * BM + wr * 64 + fr, col0 = u.pn * HALF + wc * 32 + 8 * fq;
#pragma unroll
        for (int ai = 0; ai < 2; ++ai)
#pragma unroll
            for (int m = 0; m < 4; ++m) { float h[8];
#pragma unroll
                for (int n = 0; n < 2; ++n)
#pragma unroll
                    for (int q = 0; q < 4; ++q) { const float a = acc[ai][0][m][n][q]; h[n * 4 + q] = a * __builtin_amdgcn_rcpf(1.f + __expf(-a)) * acc[ai][1][m][n][q]; }
                v4u w; w.x = cvt_pk_bf16(h[0], h[1]); w.y = cvt_pk_bf16(h[2], h[3]); w.z = cvt_pk_bf16(h[4], h[5]); w.w = cvt_pk_bf16(h[6], h[7]);
                *(v4u*)(H + (size_t)(row0 + ai * HALF + m * 16) * FF + col0) = w; }
    }
};
struct EpiScatter {
    static constexpr bool PERM = true; bf16* ys; bf16* ysh; const i32x2* list; const LAS int* nn;
    __device__ __forceinline__ void operator()(const f32x4 (&acc)[2][2][4][2], const Unit& u, int wr, int wc, int fr, int fq) const {
        const int col0 = u.pn * BM + wc * 32 + 8 * fq; const int n = nn[u.e]; const bool routed = u.e < NE;
        const i32x2* lp = list + (size_t)(u.pm - u.mt) * 256;
#pragma unroll
        for (int ai = 0; ai < 2; ++ai) {
            i32x2 en[4];
#pragma unroll
            for (int m = 0; m < 4; ++m) { const int rr = u.mt * 256 + ai * HALF + wr * 64 + m * 16 + fr; en[m] = (i32x2){rr, 0x3f800000};
                if (routed && rr < n) en[m] = lp[rr]; }
#pragma unroll
            for (int m = 0; m < 4; ++m) { const int rr = u.mt * 256 + ai * HALF + wr * 64 + m * 16 + fr;
                if (rr < n) { bf16* dst = (routed ? ys : ysh) + (size_t)en[m].x * D + col0; const float g = __int_as_float(en[m].y);
#pragma unroll
                    for (int bj = 0; bj < 2; ++bj) { const f32x4 v0 = acc[ai][bj][m][0] * g, v1 = acc[ai][bj][m][1] * g;
                        v4u w; w.x = cvt_pk_bf16(v0[0], v0[1]); w.y = cvt_pk_bf16(v0[2], v0[3]); w.z = cvt_pk_bf16(v1[0], v1[1]); w.w = cvt_pk_bf16(v1[2], v1[3]);
                        *(v4u*)(dst + bj * HALF) = w; } } }
            __builtin_amdgcn_sched_barrier(0);
        }
    }
};

template <class Epi, class Sched, bool GATHER>
__device__ __forceinline__ void gemm_phase(LAS unsigned char* lds, const int K, const Sched& S, const Epi& E) {
    const int tid = threadIdx.x, wid = __builtin_amdgcn_readfirstlane(tid >> 6), lane = tid & 63, wr = wid >> 2, wc = wid & 3, fr = lane & 15, fq = lane >> 4;
    const int nt = K / BK;
    int sR[2], sC[2];
    unsigned voffA[2], voffB[2];
#pragma unroll
    for (int i = 0; i < 2; ++i) { stage_rc(tid * 16 + i * 8192, sR[i], sC[i]); const int Rb = Epi::PERM ? ((sR[i] & ~31) + perm32(sR[i] & 31)) : sR[i];
        voffA[i] = (unsigned)(sR[i] * K + sC[i]) * 2u; voffB[i] = (unsigned)(Rb * K + sC[i]) * 2u; }
    const size_t kstep = (size_t)(BK * 2);
    const size_t hstep = (size_t)HALF * K * 2;
    const unsigned ldsw = (unsigned)wid * 1024u;
    const int aoff = lds_byte(wr * 64 + fr, fq * 8), boff = lds_byte(wc * 32 + fr, fq * 8);
    unsigned gc[2][2], gn[2][2];
#define PG8_SA(b, h) (((b) * 2 + (h)) * HTB)
#define PG8_SB(b, h) ((4 + (b) * 2 + (h)) * HTB)
#define PG8_GLDS(src, bufoff, i) __builtin_amdgcn_global_load_lds((const unsigned*)(src), (LAS unsigned*)(lds + (bufoff) + ldsw + (i) * 8192), 16, 0, 0)
#define PG8_STAGE_B(bufoff, gbase) do { PG8_GLDS((const char*)(gbase) + voffB[0], bufoff, 0); PG8_GLDS((const char*)(gbase) + voffB[1], bufoff, 1); } while (0)
#define PG8_STAGE_A(bufoff, gbase, h, nx) do { if constexpr (GATHER) { const unsigned _o0 = (nx) ? gn[h][0] : gc[h][0], _o1 = (nx) ? gn[h][1] : gc[h][1]; \
            PG8_GLDS((const char*)(gbase) + _o0, bufoff, 0); PG8_GLDS((const char*)(gbase) + _o1, bufoff, 1); } \
        else { PG8_GLDS((const char*)(gbase) + (h) * hstep + voffA[0], bufoff, 0); PG8_GLDS((const char*)(gbase) + (h) * hstep + voffA[1], bufoff, 1); } } while (0)
#define PG8_LDA(dst, b, h) do { _Pragma("unroll") for (int m = 0; m < 4; ++m) _Pragma("unroll") for (int k = 0; k < 2; ++k) dst[m][k] = *(const LAS bf16x8*)(lds + PG8_SA(b, h) + aoff + m * 2048 + k * 1024); } while (0)
#define PG8_LDB(dst, b, h) do { _Pragma("unroll") for (int n = 0; n < 2; ++n) _Pragma("unroll") for (int k = 0; k < 2; ++k) dst[n][k] = *(const LAS bf16x8*)(lds + PG8_SB(b, h) + boff + n * 2048 + k * 1024); } while (0)
#define PG8_MMA(ai, bj, At, Bt) do { __builtin_amdgcn_s_setprio(1); _Pragma("unroll") for (int m = 0; m < 4; ++m) _Pragma("unroll") for (int n = 0; n < 2; ++n) _Pragma("unroll") for (int k = 0; k < 2; ++k) \
        acc[ai][bj][m][n] = __builtin_amdgcn_mfma_f32_16x16x32_bf16(Bt[n][k], At[m][k], acc[ai][bj][m][n], 0, 0, 0); __builtin_amdgcn_s_setprio(0); } while (0)
#define PG8_WAIT_V(n) asm volatile("s_waitcnt vmcnt(" #n ")" ::: "memory")
#define PG8_WAIT_L(n) asm volatile("s_waitcnt lgkmcnt(" #n ")" ::: "memory")
#define PG8_BAR __builtin_amdgcn_s_barrier()
#define PG8_SCHED __builtin_amdgcn_sched_barrier(0)
#define PG8_GATHER(dst, u) do { _Pragma("unroll") for (int _h = 0; _h < 2; ++_h) _Pragma("unroll") for (int _i = 0; _i < 2; ++_i) \
        dst[_h][_i] = (unsigned)(S.row_token(u, _h * HALF + sR[_i]) * K + sC[_i]) * 2u; } while (0)
    Unit cur, nxt; int ui = 0;
    if (!S.next(0, cur)) return;
    f32x4 acc[2][2][4][2];
#pragma unroll
    for (int a = 0; a < 2; ++a)
#pragma unroll
        for (int b = 0; b < 2; ++b)
#pragma unroll
            for (int m = 0; m < 4; ++m)
#pragma unroll
                for (int n = 0; n < 2; ++n) acc[a][b][m][n] = (f32x4){0.f, 0.f, 0.f, 0.f};
    bf16x8 At[4][2], B0[2][2], B1[2][2];
    const char* cA = cur.A; const char* cB = cur.B;
    if constexpr (GATHER) { PG8_GATHER(gc, cur); }
    PG8_STAGE_B(PG8_SB(0, 0), cB); PG8_STAGE_A(PG8_SA(0, 0), cA, 0, false); PG8_STAGE_B(PG8_SB(0, 1), cB + hstep); PG8_STAGE_A(PG8_SA(0, 1), cA, 1, false);
    if (wr == 1) PG8_BAR;
    PG8_WAIT_V(4); PG8_BAR;
    PG8_STAGE_B(PG8_SB(1, 0), cB + kstep); PG8_STAGE_A(PG8_SA(1, 0), cA + kstep, 0, false); PG8_STAGE_B(PG8_SB(1, 1), cB + hstep + kstep);
    PG8_WAIT_V(6); PG8_BAR;
    for (;;) {
        const bool has_next = S.next(ui + 1, nxt);
        const char* nA = has_next ? nxt.A : cA; const char* nB = has_next ? nxt.B : cB;
        if constexpr (GATHER) { if (has_next) { PG8_GATHER(gn, nxt); } else {
#pragma unroll
            for (int h = 0; h < 2; ++h) { gn[h][0] = gc[h][0]; gn[h][1] = gc[h][1]; } } }
#pragma unroll 1
        for (int t = 0; t < nt; t += 2) {
            const bool last = (t == nt - 2);
            const char* a1 = cA + (size_t)(t + 1) * kstep;
            const char* a2 = last ? nA : cA + (size_t)(t + 2) * kstep; const char* b2 = last ? nB : cB + (size_t)(t + 2) * kstep;
            const char* a3 = a2 + kstep; const char* b3 = b2 + kstep;
            PG8_LDB(B0, 0, 0); PG8_SCHED; PG8_LDA(At, 0, 0); PG8_STAGE_A(PG8_SA(1, 1), a1, 1, false);
            PG8_WAIT_L(8); PG8_BAR; PG8_WAIT_L(0); PG8_MMA(0, 0, At, B0); PG8_BAR; PG8_SCHED;
            PG8_LDB(B1, 0, 1); PG8_STAGE_B(PG8_SB(0, 0), b2);
            PG8_BAR; PG8_WAIT_L(0); PG8_MMA(0, 1, At, B1); PG8_BAR;
            PG8_LDA(At, 0, 1); PG8_STAGE_A(PG8_SA(0, 0), a2, 0, last);
            PG8_BAR; PG8_WAIT_L(0); PG8_MMA(1, 0, At, B0); PG8_BAR; PG8_SCHED;
            PG8_STAGE_B(PG8_SB(0, 1), b2 + hstep);
            PG8_WAIT_V(6); PG8_BAR; PG8_MMA(1, 1, At, B1); PG8_BAR;
            PG8_LDB(B0, 1, 0); PG8_SCHED; PG8_LDA(At, 1, 0); PG8_STAGE_A(PG8_SA(0, 1), a2, 1, last);
            PG8_WAIT_L(8); PG8_BAR; PG8_WAIT_L(0); PG8_MMA(0, 0, At, B0); PG8_BAR; PG8_SCHED;
            PG8_LDB(B1, 1, 1); PG8_STAGE_B(PG8_SB(1, 0), b3);
            PG8_BAR; PG8_WAIT_L(0); PG8_MMA(0, 1, At, B1); PG8_BAR;
            PG8_LDA(At, 1, 1); PG8_STAGE_A(PG8_SA(1, 0), a3, 0, last);
            PG8_BAR; PG8_WAIT_L(0); PG8_MMA(1, 0, At, B0); PG8_BAR; PG8_SCHED;
            PG8_STAGE_B(PG8_SB(1, 1), b3 + hstep);
            PG8_WAIT_V(6); PG8_BAR; PG8_MMA(1, 1, At, B1); PG8_BAR;
        }
        E(acc, cur, wr, wc, fr, fq);
        if (!has_next) break;
#pragma unroll
        for (int a = 0; a < 2; ++a)
#pragma unroll
            for (int b = 0; b < 2; ++b)
#pragma unroll
                for (int m = 0; m < 4; ++m)
#pragma unroll
                    for (int n = 0; n < 2; ++n) acc[a][b][m][n] = (f32x4){0.f, 0.f, 0.f, 0.f};
        cur = nxt; cA = nA; cB = nB; ++ui;
        if constexpr (GATHER) {
#pragma unroll
            for (int h = 0; h < 2; ++h) { gc[h][0] = gn[h][0]; gc[h][1] = gn[h][1]; } }
    }
    PG8_WAIT_V(0);
    if (wr == 0) PG8_BAR;
    PG8_BAR;
#undef PG8_SA
#undef PG8_SB
#undef PG8_GLDS
#undef PG8_STAGE_A
#undef PG8_STAGE_B
#undef PG8_LDA
#undef PG8_LDB
#undef PG8_MMA
#undef PG8_WAIT_V
#undef PG8_WAIT_L
#undef PG8_BAR
#undef PG8_SCHED
#undef PG8_GATHER
}
}

#define XB_TMO      128
#define XB_XCNT(j)  (256  + 64 * (j))
#define XB_XSUB(j)  (1280 + 64 * (j))
#define XB_XGEN(j)  (2304 + 64 * (j))
#define XB_TOP      3328
#define XB_TOPGEN   3392
#define XCD_BAR_WORDS 3456
#define XB_SPIN_CAP (1u << 22)
__device__ __forceinline__ unsigned xb_ld(unsigned* p)              { return __hip_atomic_load(p, __ATOMIC_RELAXED, __HIP_MEMORY_SCOPE_AGENT); }
__device__ __forceinline__ unsigned xb_add(unsigned* p, unsigned v) { return __hip_atomic_fetch_add(p, v, __ATOMIC_RELAXED, __HIP_MEMORY_SCOPE_AGENT); }
__device__ __forceinline__ unsigned xb_xcc_id() { return (unsigned)__builtin_amdgcn_s_getreg((3 << 11) | 20) & 0xFu; }
#define XB_SPIN(cond, bar) do { unsigned _sp = 0; while (cond) { __builtin_amdgcn_s_sleep(1); \
    if ((++_sp & 255u) == 0u) { if (xb_ld(&(bar)[XB_TMO])) break; if (_sp > XB_SPIN_CAP) { atomicAdd(&(bar)[XB_TMO], 1u); break; } } } } while (0)
struct XcdBarrier { unsigned* bar; unsigned x; volatile LAS unsigned* st; };
__device__ __forceinline__ XcdBarrier xcd_barrier_post(unsigned* bar, volatile LAS unsigned* st) {
    XcdBarrier b; b.bar = bar; b.x = xb_xcc_id(); b.st = st;
    if (threadIdx.x == 0) (void)xb_add(&bar[XB_XCNT(b.x)], 1u);
    return b;
}
__device__ __forceinline__ void xcd_barrier_complete(unsigned* bar, unsigned x, unsigned& nloc, unsigned& nx) {
    const unsigned G = gridDim.x * gridDim.y * gridDim.z;
    unsigned sum, cnt, mine, sp = 0u;
    for (;;) {
        sum = 0u; cnt = 0u; mine = 0u;
#pragma unroll
        for (unsigned j = 0; j < 16; ++j) { const unsigned c = xb_ld(&bar[XB_XCNT(j)]); sum += c; cnt += (c > 0u) ? 1u : 0u; mine = (j == x) ? c : mine; }
        if (sum == G) break;
        __builtin_amdgcn_s_sleep(1);
        if ((++sp & 255u) == 0u) { if (xb_ld(&bar[XB_TMO])) break; if (sp > XB_SPIN_CAP) { atomicAdd(&bar[XB_TMO], 1u); break; } }
    }
    nloc = mine > 0u ? mine : 1u; nx = cnt > 0u ? cnt : 1u;
}
__device__ __forceinline__ void xcd_barrier(const XcdBarrier& b) {
    asm volatile("s_waitcnt vmcnt(0)" ::: "memory");
    __syncthreads();
    if (threadIdx.x == 0) {
        unsigned* bar = b.bar;
        __builtin_amdgcn_s_waitcnt(0);
        unsigned nloc = b.st[0], nx = b.st[1];
        if (nloc == 0u) { xcd_barrier_complete(bar, b.x, nloc, nx); b.st[0] = nloc; b.st[1] = nx; }
        const unsigned old = xb_add(&bar[XB_XSUB(b.x)], 1u);
        const unsigned gen = old / nloc;
        if (old + 1u == (gen + 1u) * nloc) {
            __builtin_amdgcn_fence(__ATOMIC_RELEASE, "agent");
            asm volatile("s_waitcnt vmcnt(0)" ::: "memory");
            const unsigned og = xb_add(&bar[XB_TOP], 1u);
            const unsigned tg = og / nx;
            if (og + 1u == (tg + 1u) * nx) xb_add(&bar[XB_TOPGEN], 1u);
            else XB_SPIN(xb_ld(&bar[XB_TOPGEN]) == tg, bar);
            __builtin_amdgcn_fence(__ATOMIC_ACQUIRE, "agent");
            xb_add(&bar[XB_XGEN(b.x)], 1u);
            asm volatile("s_waitcnt vmcnt(0)" ::: "memory");
        } else {
            XB_SPIN(xb_ld(&bar[XB_XGEN(b.x)]) == gen, bar);
            __builtin_amdgcn_fence(__ATOMIC_ACQUIRE, "agent");
            asm volatile("s_waitcnt vmcnt(0)" ::: "memory");
        }
    }
    __syncthreads();
}

constexpr int NWAVES = 8, NTHR = 512;
constexpr int RING_BYTES = 131072, XTRA_OFF = RING_BYTES, LDS_BYTES = 147456;
constexpr int X_MISC = 0, X_TB = 256, X_NN = 1536;
constexpr int CW_BAR = 4096;
constexpr int N_PHASES = 13;
struct MArgs { const float* in[22]; float* out; unsigned char* ws; int ph_lo, ph_hi; };

__device__ __forceinline__ void ph_mod_prep(const MArgs& a, unsigned char* smem, int G) {
    const int tid = threadIdx.x;
    unsigned char* ws = a.ws;
    if ((int)blockIdx.x < 192) {
        float* sc = (float*)smem; float* red = sc + NB * D;
        const float* c = a.in[1]; const float* w_ada = a.in[2]; const float* b_ada = a.in[3]; float* mod = (float*)(ws + WS_MOD);
        for (int i = tid; i < NB * D; i += NTHR) sc[i] = siluf_(c[i]);
        __syncthreads();
        for (int it = blockIdx.x; it < 192; it += G) {
            const int kq = tid >> 5, jl = tid & 31, j = it * 32 + jl;
            float a0 = 0.f, a1 = 0.f, a2 = 0.f, a3 = 0.f;
#pragma unroll 16
            for (int kk = 0; kk < 64; ++kk) { const int k = kq * 64 + kk; const float w = w_ada[(size_t)k * 6144 + j];
                a0 += sc[k] * w; a1 += sc[D + k] * w; a2 += sc[2 * D + k] * w; a3 += sc[3 * D + k] * w; }
            red[(kq * 4 + 0) * 32 + jl] = a0; red[(kq * 4 + 1) * 32 + jl] = a1; red[(kq * 4 + 2) * 32 + jl] = a2; red[(kq * 4 + 3) * 32 + jl] = a3;
            __syncthreads();
            if (tid < 128) { const int b = tid >> 5; float s = b_ada[j];
#pragma unroll
                for (int q = 0; q < 16; ++q) s += red[(q * 4 + b) * 32 + jl];
                mod[b * 6144 + j] = s; }
            __syncthreads();
        }
    }
    PrepArgs pa{a.in[4], a.in[9], a.in[12], a.in[14], a.in[15], a.in[16], a.in[17], a.in[18], a.in[19],
                (bf16*)(ws + WS_WTIN), (bf16*)(ws + WS_WTOUT), (bf16*)(ws + WS_WTR), (bf16*)(ws + WS_WT13), (bf16*)(ws + WS_WT2)};
    const int lane = tid & 63, gw = blockIdx.x * NWAVES + (tid >> 6), ngw = G * NWAVES;
    for (int it = gw; it < IT_TOTAL; it += ngw) prep_item(pa, it, lane);
}

__device__ __forceinline__ void ph_ln1(const MArgs& a, unsigned char* smem, int G) {
    const int tid = threadIdx.x, lane = tid & 63, wave = tid >> 6;
    const float* x = a.in[0]; const float* w_in = a.in[4]; const float* gate_b = a.in[7];
    const float* mod = (const float*)(a.ws + WS_MOD); bf16* u1 = (bf16*)(a.ws + WS_U1); float* ipre = (float*)(a.ws + WS_GATES); float* logf = ipre + 16 * S;
    float* wg = (float*)smem;
    for (int i = tid; i < D * 8; i += NTHR) wg[i] = w_in[(size_t)(i >> 3) * WIN_LD + C_GATE + (i & 7)];
    __syncthreads();
    for (int it = blockIdx.x; it < T / 128; it += G) {
        const int row0 = it * 128, b = row0 / S;
        f32x4 sh[4], sc[4];
#pragma unroll
        for (int j = 0; j < 4; ++j) { sh[j] = *(const f32x4*)(mod + b * 6144 + 4 * lane + 256 * j); sc[j] = *(const f32x4*)(mod + b * 6144 + 1024 + 4 * lane + 256 * j); }
        for (int rr = wave; rr < 128; rr += NWAVES) {
            const int row = row0 + rr;
            const f32x4* xr = (const f32x4*)(x + (size_t)row * D) + lane;
            f32x4 v[4]; float s = 0.f;
#pragma unroll
            for (int j = 0; j < 4; ++j) { v[j] = xr[64 * j]; s += (v[j].x + v[j].y) + (v[j].z + v[j].w); }
            const float mean = wave_sum(s) * (1.f / D); float s2 = 0.f;
#pragma unroll
            for (int j = 0; j < 4; ++j) { v[j] = v[j] - mean; s2 += (v[j].x * v[j].x + v[j].y * v[j].y) + (v[j].z * v[j].z + v[j].w * v[j].w); }
            const float rstd = 1.f / sqrtf(wave_sum(s2) * (1.f / D) + LN_EPS);
            float ga[8];
#pragma unroll
            for (int q = 0; q < 8; ++q) ga[q] = 0.f;
            unsigned long long* o8 = (unsigned long long*)(u1 + (size_t)row * D) + lane;
#pragma unroll
            for (int j = 0; j < 4; ++j) {
                const f32x4 u = v[j] * rstd * (sc[j] + 1.0f) + sh[j];
                o8[64 * j] = (unsigned long long)pk2(u.x, u.y) | ((unsigned long long)pk2(u.z, u.w) << 32);
#pragma unroll
                for (int e = 0; e < 4; ++e) { const int k = 4 * lane + 256 * j + e;
                    const f32x4 w0 = *(const f32x4*)(wg + k * 8), w1 = *(const f32x4*)(wg + k * 8 + 4);
                    ga[0] += u[e] * w0.x; ga[1] += u[e] * w0.y; ga[2] += u[e] * w0.z; ga[3] += u[e] * w0.w;
                    ga[4] += u[e] * w1.x; ga[5] += u[e] * w1.y; ga[6] += u[e] * w1.z; ga[7] += u[e] * w1.w; }
            }
#pragma unroll
            for (int q = 0; q < 8; ++q) ga[q] = wave_sum(ga[q]);
            if (lane < 8) {
                float gv = 0.f;
#pragma unroll
                for (int q = 0; q < 8; ++q) gv = (lane == q) ? ga[q] : gv;
                gv += gate_b[lane];
                const int h = lane & 3, s_ = row % S;
                if (lane < 4) ipre[(size_t)(b * 4 + h) * S + s_] = gv;
                else logf[(size_t)(b * 4 + h) * S + s_] = fminf(gv, 0.f) - log1pf(__expf(-fabsf(gv)));
            }
        }
    }
}

__device__ __forceinline__ void ph_attn_simple(const bf16* __restrict__ proj, bf16* __restrict__ mix, int vb0, int nvb) {
    for (int gid = vb0 * NTHR + threadIdx.x; gid < NB * 8 * S; gid += nvb * NTHR) {
        const int t = gid % S, bh = gid / S, h = bh & 7, b = bh >> 3;
        const bf16* base = proj + (size_t)b * S * NPROJ;
        float q[64], o[64];
        { const v4u* qp = (const v4u*)(base + (size_t)t * NPROJ + C_SBQ + h * 64);
#pragma unroll
          for (int i = 0; i < 8; ++i) { const v4u w = qp[i];
#pragma unroll
              for (int e = 0; e < 4; ++e) { q[i * 8 + 2 * e] = bf2f(w[e] & 0xffffu); q[i * 8 + 2 * e + 1] = bf2f(w[e] >> 16); } } }
#pragma unroll
        for (int d = 0; d < 64; ++d) o[d] = 0.f;
        float carry = 0.f;
        for (int s = t - 1; s >= 0; --s) {
            const v4u* kp = (const v4u*)(base + (size_t)s * NPROJ + C_SBK + h * 64);
            float z = 0.f;
#pragma unroll
            for (int i = 0; i < 8; ++i) { const v4u w = kp[i];
#pragma unroll
                for (int e = 0; e < 4; ++e) { z += q[i * 8 + 2 * e] * bf2f(w[e] & 0xffffu); z += q[i * 8 + 2 * e + 1] * bf2f(w[e] >> 16); } }
            const float sp = fmaxf(z, 0.f) + __log2f(1.f + exp2f(-fabsf(z)));
            carry += sp;
            const float p = exp2f(z - carry);
            const v4u* vp = (const v4u*)(base + (size_t)s * NPROJ + C_SBV + h * 64);
#pragma unroll
            for (int i = 0; i < 8; ++i) { const v4u w = vp[i];
#pragma unroll
                for (int e = 0; e < 4; ++e) { o[i * 8 + 2 * e] += p * bf2f(w[e] & 0xffffu); o[i * 8 + 2 * e + 1] += p * bf2f(w[e] >> 16); } }
            if (carry > SB_THRESH) break;
        }
        v4u* op = (v4u*)(mix + (size_t)(b * S + t) * D + h * 64);
#pragma unroll
        for (int i = 0; i < 8; ++i) { v4u w; w.x = pk2(o[i * 8], o[i * 8 + 1]); w.y = pk2(o[i * 8 + 2], o[i * 8 + 3]); w.z = pk2(o[i * 8 + 4], o[i * 8 + 5]); w.w = pk2(o[i * 8 + 6], o[i * 8 + 7]); op[i] = w; }
    }
}
__device__ __forceinline__ void ph_mlstm_simple(const MArgs& a, unsigned char* smem, int vb0, int nvb) {
    const bf16* proj = (const bf16*)(a.ws + WS_PROJ); const float* conv_w = a.in[5]; const float* conv_b = a.in[6];
    const float* ipre = (const float*)(a.ws + WS_GATES); const float* logf = ipre + 16 * S; float* hraw = (float*)(a.ws + WS_HRAW);
    const int half = threadIdx.x >> 8, tid = threadIdx.x & 255;
    float* sq = (float*)smem + half * 8768; float* sk = sq + 4096; float* sv = sk + 4096; float* sf = sv + 512; float* si = sf + 32;
    for (int it0 = vb0 * 2; it0 < 128; it0 += nvb * 2) {
        const int item = it0 + half, bh = item >> 3, sl = item & 7, b = bh >> 2, h = bh & 3;
        const int r = tid >> 4, c = tid & 15;
        const bf16* base = proj + (size_t)b * S * NPROJ;
        float Cst[8], nst[8];
#pragma unroll
        for (int e = 0; e < 8; ++e) { Cst[e] = 0.f; nst[e] = 0.f; }
        for (int t0 = 0; t0 < S; t0 += 32) {
            __syncthreads();
            for (int i = tid; i < 32 * 128; i += 256) {
                const int tt = i >> 7, d = i & 127, t = t0 + tt, ch = h * 128 + d;
                float yq = conv_b[ch], yk = conv_b[512 + ch];
#pragma unroll
                for (int j = 0; j < 4; ++j) { const int ts = t - 3 + j;
                    if (ts >= 0) { yq += conv_w[j * 1024 + ch] * bf2f(base[(size_t)ts * NPROJ + C_MLQ + ch]); yk += conv_w[j * 1024 + 512 + ch] * bf2f(base[(size_t)ts * NPROJ + C_MLK + ch]); } }
                sq[tt * 128 + d] = siluf_(yq); sk[tt * 128 + d] = siluf_(yk) * 0.08838834764831845f;
            }
            for (int i = tid; i < 32 * 16; i += 256) { const int tt = i >> 4, d = i & 15; sv[tt * 16 + d] = bf2f(base[(size_t)(t0 + tt) * NPROJ + C_MLV + h * 128 + sl * 16 + d]); }
            if (tid < 32) { sf[tid] = __expf(logf[(size_t)bh * S + t0 + tid]); si[tid] = __expf(ipre[(size_t)bh * S + t0 + tid]); }
            __syncthreads();
            for (int tt = 0; tt < 32; ++tt) {
                const float f = sf[tt], iv = si[tt] * sv[tt * 16 + r], ii = si[tt];
                float pn = 0.f, pd = 0.f;
#pragma unroll
                for (int e = 0; e < 8; ++e) { const float kk = sk[tt * 128 + c * 8 + e], qq = sq[tt * 128 + c * 8 + e];
                    Cst[e] = f * Cst[e] + iv * kk; nst[e] = f * nst[e] + ii * kk; pn += Cst[e] * qq; pd += nst[e] * qq; }
#pragma unroll
                for (int o = 1; o < 16; o <<= 1) { pn += __shfl_xor(pn, o); pd += __shfl_xor(pd, o); }
                if (c == 0) hraw[(size_t)(b * S + t0 + tt) * 512 + h * 128 + sl * 16 + r] = pn / fmaxf(fabsf(pd), 1.f);
            }
        }
    }
}
__device__ __forceinline__ void ph_mlnorm(const MArgs& a, int G) {
    const float* hraw = (const float*)(a.ws + WS_HRAW); const bf16* proj = (const bf16*)(a.ws + WS_PROJ); const float* norm_g = a.in[8]; bf16* mix = (bf16*)(a.ws + WS_MIX);
    const int lane = threadIdx.x & 63;
    for (int gw = blockIdx.x * NWAVES + (threadIdx.x >> 6); gw < T * 4; gw += G * NWAVES) {
        const int t = gw >> 2, h = gw & 3;
        const float va = hraw[(size_t)t * 512 + h * 128 + 2 * lane], vb = hraw[(size_t)t * 512 + h * 128 + 2 * lane + 1];
        const float mean = wave_sum(va + vb) * (1.f / 128.f);
        const float da = va - mean, db = vb - mean;
        const float rstd = 1.f / sqrtf(wave_sum(da * da + db * db) * (1.f / 128.f) + LN_EPS);
        const unsigned ow = *(const unsigned*)(proj + (size_t)t * NPROJ + C_MLO + h * 128 + 2 * lane);
        const float o0 = sigmoidf_(bf2f(ow & 0xffffu)), o1 = sigmoidf_(bf2f(ow >> 16));
        const float g0 = norm_g[h * 128 + 2 * lane], g1 = norm_g[h * 128 + 2 * lane + 1];
        *(unsigned*)(mix + (size_t)t * D + 512 + h * 128 + 2 * lane) = pk2(da * rstd * g0 * o0, db * rstd * g1 * o1);
    }
}
__device__ __forceinline__ void ph_ln2(const MArgs& a, int G) {
    const float* x = a.in[0]; const bf16* mixout = (const bf16*)(a.ws + WS_MIXOUT); const float* mod = (const float*)(a.ws + WS_MOD); const float* ln1_g = a.in[10]; const float* ln1_b = a.in[11];
    float* x1 = a.out; bf16* u2 = (bf16*)(a.ws + WS_U2);
    const int tid = threadIdx.x, lane = tid & 63, wave = tid >> 6;
    for (int it = blockIdx.x; it < T / 128; it += G) {
        const int row0 = it * 128, b = row0 / S;
        for (int rr = wave; rr < 128; rr += NWAVES) {
            const int row = row0 + rr;
            f32x4 v[4]; float s = 0.f;
#pragma unroll
            for (int j = 0; j < 4; ++j) {
                const int col = 4 * lane + 256 * j;
                const f32x4 xv = *(const f32x4*)(x + (size_t)row * D + col);
                const f32x4 mo = ld_bf4(mixout + (size_t)row * D + col);
                const f32x4 g1 = *(const f32x4*)(mod + b * 6144 + 2048 + col);
                v[j] = xv * DN_ALPHA + g1 * mo; s += (v[j].x + v[j].y) + (v[j].z + v[j].w);
            }
            float mean = wave_sum(s) * (1.f / D), s2 = 0.f;
#pragma unroll
            for (int j = 0; j < 4; ++j) { v[j] = v[j] - mean; s2 += (v[j].x * v[j].x + v[j].y * v[j].y) + (v[j].z * v[j].z + v[j].w * v[j].w); }
            float rstd = 1.f / sqrtf(wave_sum(s2) * (1.f / D) + LN_EPS);
            s = 0.f;
#pragma unroll
            for (int j = 0; j < 4; ++j) { const int col = 4 * lane + 256 * j;
                v[j] = v[j] * rstd * *(const f32x4*)(ln1_g + col) + *(const f32x4*)(ln1_b + col);
                *(f32x4*)(x1 + (size_t)row * D + col) = v[j]; s += (v[j].x + v[j].y) + (v[j].z + v[j].w); }
            mean = wave_sum(s) * (1.f / D); s2 = 0.f;
#pragma unroll
            for (int j = 0; j < 4; ++j) { v[j] = v[j] - mean; s2 += (v[j].x * v[j].x + v[j].y * v[j].y) + (v[j].z * v[j].z + v[j].w * v[j].w); }
            rstd = 1.f / sqrtf(wave_sum(s2) * (1.f / D) + LN_EPS);
#pragma unroll
            for (int j = 0; j < 4; ++j) { const int col = 4 * lane + 256 * j;
                const f32x4 u = v[j] * rstd * (*(const f32x4*)(mod + b * 6144 + 4096 + col) + 1.0f) + *(const f32x4*)(mod + b * 6144 + 3072 + col);
                *(unsigned long long*)(u2 + (size_t)row * D + col) = (unsigned long long)pk2(u.x, u.y) | ((unsigned long long)pk2(u.z, u.w) << 32); }
        }
    }
}
__device__ __forceinline__ void route_token(int t, const float* __restrict__ logits, const float* __restrict__ rbias, int* __restrict__ tope, float* __restrict__ topg, int* __restrict__ cnt) {
    const float* lg = logits + (size_t)t * NE;
    float gs[8];
#pragma unroll
    for (int g = 0; g < 8; ++g) { float m1 = -INFINITY, m2 = -INFINITY;
        for (int i = 0; i < 32; ++i) { const int e = g * 32 + i; const float v = sigmoidf_(lg[e]) + rbias[e]; if (v > m1) { m2 = m1; m1 = v; } else if (v > m2) m2 = v; }
        gs[g] = m1 + m2; }
    unsigned gmask = 0;
#pragma unroll
    for (int r = 0; r < 4; ++r) { int bi = 0; float bv = -INFINITY;
#pragma unroll
        for (int g = 0; g < 8; ++g) if (!((gmask >> g) & 1u) && gs[g] > bv) { bv = gs[g]; bi = g; }
        gmask |= 1u << bi; }
    float pv = INFINITY; int pi = -1; float gsum = 0.f; int se[8]; float sg[8];
#pragma unroll
    for (int r = 0; r < 8; ++r) { int bi = 0; float bv = -INFINITY, bs = 0.f;
        for (int e = 0; e < NE; ++e) { if (!((gmask >> (e >> 5)) & 1u)) continue;
            const float sc = sigmoidf_(lg[e]), v = sc + rbias[e];
            const bool elig = (v < pv) || (v == pv && e > pi);
            if (elig && v > bv) { bv = v; bi = e; bs = sc; } }
        pv = bv; pi = bi; gsum += bs; se[r] = bi; sg[r] = bs; }
    const float inv = 2.5f / gsum;
#pragma unroll
    for (int r = 0; r < 8; ++r) { const int e = se[r]; tope[t * 8 + r] = e; topg[t * 8 + r] = sg[r] * inv; atomicAdd(cnt + e, 1); }
}
__device__ __forceinline__ void moe_tables(const int* cnt, LAS int* tb, LAS int* nn) {
    if (threadIdx.x < 64) {
        const int lane = threadIdx.x; int n[4], tl[4], loc = 0;
#pragma unroll
        for (int j = 0; j < 4; ++j) { n[j] = cnt[4 * lane + j]; tl[j] = (n[j] + 255) >> 8; loc += tl[j]; }
        int inc = loc;
#pragma unroll
        for (int o = 1; o < 64; o <<= 1) { const int v = __shfl_up(inc, o); if (lane >= o) inc += v; }
        int base = inc - loc;
#pragma unroll
        for (int j = 0; j < 4; ++j) { tb[4 * lane + j] = base; nn[4 * lane + j] = n[j]; base += tl[j]; }
        if (lane == 63) { tb[NE] = base; nn[NE] = T; tb[NEX] = base + T / 256; }
    }
    __syncthreads();
}
__device__ __forceinline__ void ph_final(const MArgs& a, int G) {
    float* out = a.out; const bf16* ys = (const bf16*)(a.ws + WS_YS); const bf16* ysh = (const bf16*)(a.ws + WS_YSH); const float* mod = (const float*)(a.ws + WS_MOD);
    const float* ln2_g = a.in[20]; const float* ln2_b = a.in[21];
    const int tid = threadIdx.x, lane = tid & 63, wave = tid >> 6;
    for (int it = blockIdx.x; it < T / 128; it += G) {
        const int row0 = it * 128, b = row0 / S;
        for (int rr = wave; rr < 128; rr += NWAVES) {
            const int row = row0 + rr;
            f32x4 v[4]; float s = 0.f;
#pragma unroll
            for (int j = 0; j < 4; ++j) { const int col = 4 * lane + 256 * j;
                f32x4 y = ld_bf4(ysh + (size_t)row * D + col);
#pragma unroll
                for (int k = 0; k < 8; ++k) y = y + ld_bf4(ys + ((size_t)row * 8 + k) * D + col);
                v[j] = *(const f32x4*)(out + (size_t)row * D + col) * DN_ALPHA + *(const f32x4*)(mod + b * 6144 + 5120 + col) * y;
                s += (v[j].x + v[j].y) + (v[j].z + v[j].w); }
            const float mean = wave_sum(s) * (1.f / D); float s2 = 0.f;
#pragma unroll
            for (int j = 0; j < 4; ++j) { v[j] = v[j] - mean; s2 += (v[j].x * v[j].x + v[j].y * v[j].y) + (v[j].z * v[j].z + v[j].w * v[j].w); }
            const float rstd = 1.f / sqrtf(wave_sum(s2) * (1.f / D) + LN_EPS);
#pragma unroll
            for (int j = 0; j < 4; ++j) { const int col = 4 * lane + 256 * j;
                *(f32x4*)(out + (size_t)row * D + col) = v[j] * rstd * *(const f32x4*)(ln2_g + col) + *(const f32x4*)(ln2_b + col); }
        }
    }
}

__global__ void __launch_bounds__(NTHR, 2) mega_fwd(MArgs args) {
    extern __shared__ __attribute__((aligned(16))) unsigned char lds[];
    LAS unsigned char* ldsl = (LAS unsigned char*)lds;
    const int tid = threadIdx.x, G = gridDim.x;
    volatile LAS unsigned* MISC = (volatile LAS unsigned*)(ldsl + XTRA_OFF + X_MISC);
    LAS int* tb = (LAS int*)(ldsl + XTRA_OFF + X_TB); LAS int* nn = (LAS int*)(ldsl + XTRA_OFF + X_NN);
    for (int u = tid; u < (LDS_BYTES - XTRA_OFF) / 4; u += NTHR) ((LAS unsigned*)(ldsl + XTRA_OFF))[u] = 0u;
    __syncthreads();
    unsigned char* ws = args.ws;
    unsigned* ctl = (unsigned*)(ws + WS_CTL);
    XcdBarrier bar = xcd_barrier_post(ctl + CW_BAR, MISC + 8);
    const int lo = args.ph_lo, hi = args.ph_hi;
#define IN(k) (lo <= (k) && (k) < hi)
#define SEAM(k) do { if (IN(k) && IN((k) + 1)) xcd_barrier(bar); } while (0)
    if (IN(0)) ph_mod_prep(args, lds, G);
    SEAM(0);
    if (IN(1)) ph_ln1(args, lds, G);
    SEAM(1);
    if (IN(2)) { pg8::StaticOrder So; So.init(ws + WS_U1, ws + WS_WTIN, T, NPROJ, D, G, blockIdx.x);
        pg8::EpiBf16 E{(bf16*)(ws + WS_PROJ), NPROJ, 2, QSCALE};
        pg8::gemm_phase<pg8::EpiBf16, pg8::StaticOrder, false>(ldsl, D, So, E); }
    SEAM(2);
    if (IN(3)) {
        if (G >= 128) { if ((int)blockIdx.x < 64) ph_mlstm_simple(args, lds, blockIdx.x, 64); else ph_attn_simple((const bf16*)(ws + WS_PROJ), (bf16*)(ws + WS_MIX), blockIdx.x - 64, G - 64); }
        else { ph_mlstm_simple(args, lds, blockIdx.x, G); ph_attn_simple((const bf16*)(ws + WS_PROJ), (bf16*)(ws + WS_MIX), blockIdx.x, G); }
    }
    SEAM(3);
    if (IN(4)) ph_mlnorm(args, G);
    SEAM(4);
    if (IN(5)) { pg8::StaticOrder So; So.init(ws + WS_MIX, ws + WS_WTOUT, T, D, D, G, blockIdx.x);
        pg8::EpiBf16 E{(bf16*)(ws + WS_MIXOUT), D, 0, 1.f};
        pg8::gemm_phase<pg8::EpiBf16, pg8::StaticOrder, false>(ldsl, D, So, E); }
    SEAM(5);
    if (IN(6)) ph_ln2(args, G);
    SEAM(6);
    if (IN(7)) { pg8::StaticOrder So; So.init(ws + WS_U2, ws + WS_WTR, T, NE, D, G, blockIdx.x);
        pg8::EpiF32 E{(float*)(ws + WS_LOGITS), NE};
        pg8::gemm_phase<pg8::EpiF32, pg8::StaticOrder, false>(ldsl, D, So, E); }
    SEAM(7);
    int* cnt = (int*)ctl + CW_CNT; i32x2* list = (i32x2*)(ws + WS_ROUTE + 2 * MiB); float* topg = (float*)(ws + WS_ROUTE + 1 * MiB);
    if (IN(8)) { for (int t = blockIdx.x * NTHR + tid; t < T; t += G * NTHR) route_token(t, (const float*)(ws + WS_LOGITS), args.in[13], (int*)(ws + WS_ROUTE), topg, cnt); }
    SEAM(8);
    if (IN(9)) { moe_tables(cnt, tb, nn); const int* tope = (const int*)(ws + WS_ROUTE); int* fill = (int*)ctl + CW_FILL;
        for (int id = blockIdx.x * NTHR + tid; id < T * TOPK; id += G * NTHR) { const int e = tope[id]; const int pos = atomicAdd(fill + e, 1);
            list[tb[e] * 256 + pos] = (i32x2){id, __float_as_int(topg[id])}; } }
    SEAM(9);
    if (IN(10)) { moe_tables(cnt, tb, nn);
        pg8::MoeOrder So{G, (int)blockIdx.x, tb[NEX] * 2, 1, tb, nn, list, (const char*)(ws + WS_U2), 0, (const char*)(ws + WS_WT13), (size_t)512 * D * 2, (size_t)256 * D * 2};
        pg8::EpiGlu E{(bf16*)(ws + WS_H)};
        pg8::gemm_phase<pg8::EpiGlu, pg8::MoeOrder, true>(ldsl, D, So, E); }
    SEAM(10);
    if (IN(11)) { moe_tables(cnt, tb, nn);
        pg8::MoeOrder So{G, (int)blockIdx.x, tb[NEX] * 4, 2, tb, nn, list, (const char*)(ws + WS_H), (size_t)256 * FF * 2, (const char*)(ws + WS_WT2), (size_t)D * FF * 2, (size_t)256 * FF * 2};
        pg8::EpiScatter E{(bf16*)(ws + WS_YS), (bf16*)(ws + WS_YSH), list, nn};
        pg8::gemm_phase<pg8::EpiScatter, pg8::MoeOrder, false>(ldsl, FF, So, E); }
    SEAM(11);
    if (IN(12)) ph_final(args, G);
#undef IN
#undef SEAM
}

#ifndef MK_UPTO
#define MK_UPTO 13
#endif
__global__ void k_nan_fill(float* out, int n) { for (int i = blockIdx.x * blockDim.x + threadIdx.x; i < n; i += gridDim.x * blockDim.x) out[i] = __builtin_nanf(""); }
extern "C" void kernel_launch(void* const* d_in, const int* in_sizes, int n_in, void* d_out, int out_size, void* d_ws, size_t ws_size, hipStream_t stream) {
    static int grid = 0;
    if (grid == 0) {
        int dev = 0, cus = 0, per_cu = 0; grid = -1;
        if (n_in != 22 || out_size != T * D || ws_size < WS_END) fprintf(stderr, "kernel_launch: unexpected shapes (n_in %d out %d ws %zu, need %zu)\n", n_in, out_size, ws_size, (size_t)WS_END);
        else if (hipGetDevice(&dev) != hipSuccess || hipDeviceGetAttribute(&cus, hipDeviceAttributeMultiprocessorCount, dev) != hipSuccess) fprintf(stderr, "kernel_launch: device query failed\n");
        else if (hipFuncSetAttribute((const void*)mega_fwd, hipFuncAttributeMaxDynamicSharedMemorySize, LDS_BYTES) != hipSuccess) fprintf(stderr, "kernel_launch: hipFuncSetAttribute failed\n");
        else if (hipOccupancyMaxActiveBlocksPerMultiprocessor(&per_cu, (const void*)mega_fwd, NTHR, LDS_BYTES) != hipSuccess || per_cu < 1) fprintf(stderr, "kernel_launch: occupancy query says %d blocks per CU\n", per_cu);
        else grid = cus;
        (void)hipGetLastError();
    }
    if (grid < 0) { k_nan_fill<<<1024, 256, 0, stream>>>((float*)d_out, out_size); return; }
    const float* x = (const float*)d_in[0];
    const float* conv_w = (const float*)d_in[5]; const float* conv_b = (const float*)d_in[6];
    const float* norm_g = (const float*)d_in[8]; const float* ln1_g = (const float*)d_in[10]; const float* ln1_b = (const float*)d_in[11];
    const float* rbias = (const float*)d_in[13]; const float* ln2_g = (const float*)d_in[20]; const float* ln2_b = (const float*)d_in[21];
    char* ws = (char*)d_ws; float* out = (float*)d_out;
    float* mod = (float*)(ws + WS_MOD); bf16* wtin = (bf16*)(ws + WS_WTIN); bf16* wtout = (bf16*)(ws + WS_WTOUT); bf16* wtr = (bf16*)(ws + WS_WTR);
    bf16* wt13 = (bf16*)(ws + WS_WT13); bf16* wt2 = (bf16*)(ws + WS_WT2); int* plan = (int*)(ws + WS_PLAN);
    bf16* u1 = (bf16*)(ws + WS_U1); bf16* proj = (bf16*)(ws + WS_PROJ); float* ipre = (float*)(ws + WS_GATES); float* logf = ipre + 16 * S;
    float* hraw = (float*)(ws + WS_HRAW); bf16* mix = (bf16*)(ws + WS_MIX); bf16* mixout = (bf16*)(ws + WS_MIXOUT); bf16* u2 = (bf16*)(ws + WS_U2);
    float* logits = (float*)(ws + WS_LOGITS); int* tope = (int*)(ws + WS_ROUTE); float* topg = (float*)(ws + WS_ROUTE + 1 * MiB); i32x2* list = (i32x2*)(ws + WS_ROUTE + 2 * MiB);
    bf16* H = (bf16*)(ws + WS_H); bf16* ys = (bf16*)(ws + WS_YS); bf16* ysh = (bf16*)(ws + WS_YSH);
    int* cnt = (int*)(ws + WS_CTL) + CW_CNT;
    (void)hipMemsetAsync(ws + WS_CTL, 0, 1 * MiB, stream);
    if (MK_UPTO > 0) {
        MArgs a{};
        for (int i = 0; i < 22; ++i) a.in[i] = (const float*)d_in[i];
        a.out = out; a.ws = (unsigned char*)d_ws; a.ph_lo = 0; a.ph_hi = MK_UPTO;
        hipLaunchKernelGGL(mega_fwd, dim3(grid), dim3(NTHR), LDS_BYTES, stream, a);
    }
    if (MK_UPTO <= 0) { k_mod<<<192, 512, 0, stream>>>((const float*)d_in[1], (const float*)d_in[2], (const float*)d_in[3], mod);
        PrepArgs pa{(const float*)d_in[4], (const float*)d_in[9], (const float*)d_in[12], (const float*)d_in[14], (const float*)d_in[15], (const float*)d_in[16], (const float*)d_in[17], (const float*)d_in[18], (const float*)d_in[19], wtin, wtout, wtr, wt13, wt2};
        k_prep<<<2048, 512, 0, stream>>>(pa); }
    if (MK_UPTO <= 1) k_ln1<<<T / 128, 512, 0, stream>>>(x, mod, (const float*)d_in[4], (const float*)d_in[7], u1, ipre, logf);
    if (MK_UPTO <= 2) k_ngemm<0><<<dim3(NPROJ / 64, T / 64), 256, 0, stream>>>(u1, wtin, proj, T, NPROJ, D, NPROJ, 512, QSCALE);
    if (MK_UPTO <= 3) { k_attn_naive<<<NB * 8 * S / 256, 256, 0, stream>>>(proj, mix); k_mlstm_naive<<<128, 256, 0, stream>>>(proj, conv_w, conv_b, ipre, logf, hraw); }
    if (MK_UPTO <= 4) k_mlnorm_naive<<<T, 256, 0, stream>>>(hraw, proj, norm_g, mix);
    if (MK_UPTO <= 5) k_ngemm<0><<<dim3(D / 64, T / 64), 256, 0, stream>>>(mix, wtout, mixout, T, D, D, D, 0, 1.f);
    if (MK_UPTO <= 6) k_ln2<<<T / 128, 512, 0, stream>>>(x, mixout, mod, ln1_g, ln1_b, out, u2);
    if (MK_UPTO <= 7) k_ngemm<1><<<dim3(NE / 64, T / 64), 256, 0, stream>>>(u2, wtr, logits, T, NE, D, NE, 0, 1.f);
    if (MK_UPTO <= 8) k_route<<<T / 256, 256, 0, stream>>>(logits, rbias, tope, topg, cnt);
    constexpr int MAXT64 = T * TOPK / 64 + NE + T / 64;
    if (MK_UPTO <= 11) k_plan<<<1, 64, 0, stream>>>(cnt, plan);
    if (MK_UPTO <= 9) k_fill<<<T * TOPK / 256, 256, 0, stream>>>(tope, topg, plan, cnt + (CW_FILL - CW_CNT), list);
    if (MK_UPTO <= 10) k_moe1_naive<<<dim3(4, MAXT64), 256, 0, stream>>>(u2, wt13, cnt, plan, list, H);
    if (MK_UPTO <= 11) k_moe2_naive<<<dim3(16, MAXT64), 256, 0, stream>>>(H, wt2, cnt, plan, list, topg, ys, ysh);
    if (MK_UPTO <= 12) k_final<<<T / 128, 512, 0, stream>>>(out, ys, ysh, mod, ln2_g, ln2_b);
}
```

```cpp
#include <hip/hip_runtime.h>
#include <cstdio>
#include <cstdint>

typedef unsigned short bf16;
typedef unsigned v4u __attribute__((ext_vector_type(4)));
typedef float f32x4 __attribute__((ext_vector_type(4)));
typedef int i32x2 __attribute__((ext_vector_type(2)));

constexpr int D = 1024, NB = 4, S = 8192, T = NB * S;
constexpr int NPROJ = 3584, WIN_LD = 3592;
constexpr int C_SBQ = 0, C_SBK = 512, C_SBV = 1024, C_MLQ = 1536, C_MLK = 2048, C_MLV = 2560, C_MLO = 3072, C_GATE = 3584;
constexpr int NE = 256, NEX = 257, TOPK = 8, FF = 256;
constexpr float LN_EPS = 1e-5f;
constexpr float DN_ALPHA = 1.189207115002721f;
constexpr float LOG2E = 1.4426950408889634f;
constexpr float QSCALE = 0.125f * LOG2E;
constexpr float SB_THRESH = 48.0f;

constexpr size_t MiB = 1u << 20;
constexpr size_t WS_CTL = 0;
constexpr size_t WS_MOD = 1 * MiB;
constexpr size_t WS_WTIN = 2 * MiB;
constexpr size_t WS_WTOUT = 10 * MiB;
constexpr size_t WS_WTR = 12 * MiB;
constexpr size_t WS_PLAN = 13 * MiB;
constexpr size_t WS_WT2 = 16 * MiB;
constexpr size_t WS_YS = 145 * MiB;
constexpr size_t WS_WT13 = 145 * MiB;
constexpr size_t WS_PROJ = 402 * MiB;
constexpr size_t WS_GATES = 626 * MiB;
constexpr size_t WS_H = 657 * MiB;
constexpr size_t WS_STATES = 657 * MiB;
constexpr size_t WS_MIXOUT = 657 * MiB;
constexpr size_t WS_LOGITS = 657 * MiB;
constexpr size_t WS_U1 = 725 * MiB;
constexpr size_t WS_MIX = 725 * MiB;
constexpr size_t WS_U2 = 833 * MiB;
constexpr size_t WS_YSH = 833 * MiB;
constexpr size_t WS_HRAW = 833 * MiB;
constexpr size_t WS_ROUTE = 897 * MiB;
constexpr size_t WS_END = 902 * MiB;
constexpr int CW_CNT = 1024;
constexpr int CW_FILL = 1536;
constexpr int PL_SLOT = 0, PL_T64 = 512, PL_T256 = 1024;

__device__ __forceinline__ unsigned f2bf(float f) { unsigned u = __builtin_bit_cast(unsigned, f); return (u + 0x7fffu + ((u >> 16) & 1u)) >> 16; }
__device__ __forceinline__ float bf2f(unsigned b) { return __builtin_bit_cast(float, b << 16); }
__device__ __forceinline__ unsigned pk2(float lo, float hi) { return f2bf(lo) | (f2bf(hi) << 16); }
__device__ __forceinline__ float wave_sum(float v) {
#pragma unroll
    for (int o = 1; o < 64; o <<= 1) v += __shfl_xor(v, o);
    return v;
}
__device__ __forceinline__ float sigmoidf_(float x) { return 1.f / (1.f + __expf(-x)); }
__device__ __forceinline__ float siluf_(float x) { return x / (1.f + __expf(-x)); }

__global__ void __launch_bounds__(512) k_mod(const float* __restrict__ c, const float* __restrict__ w_ada, const float* __restrict__ b_ada, float* __restrict__ mod) {
    __shared__ float sc[NB][D];
    __shared__ float red[16][NB][32];
    const int tid = threadIdx.x;
    for (int i = tid; i < NB * D; i += 512) sc[i / D][i % D] = siluf_(c[i]);
    __syncthreads();
    const int kq = tid >> 5, jl = tid & 31, j = blockIdx.x * 32 + jl;
    float a0 = 0.f, a1 = 0.f, a2 = 0.f, a3 = 0.f;
#pragma unroll 16
    for (int kk = 0; kk < 64; ++kk) { const int k = kq * 64 + kk; const float w = w_ada[(size_t)k * 6144 + j];
        a0 += sc[0][k] * w; a1 += sc[1][k] * w; a2 += sc[2][k] * w; a3 += sc[3][k] * w; }
    red[kq][0][jl] = a0; red[kq][1][jl] = a1; red[kq][2][jl] = a2; red[kq][3][jl] = a3;
    __syncthreads();
    if (tid < 128) { const int b = tid >> 5; float s = b_ada[j];
#pragma unroll
        for (int q = 0; q < 16; ++q) s += red[q][b][jl];
        mod[b * 6144 + j] = s; }
}

__device__ __forceinline__ void transpose_item(const float* __restrict__ W, int ldw, bf16* __restrict__ WT, int ldt, int k0, int n0, int rowmap, int lane) {
    const int g = lane >> 4, i = lane & 15;
    f32x4 v[8];
#pragma unroll
    for (int r = 0; r < 8; ++r) v[r] = *(const f32x4*)(W + (size_t)(k0 + 8 * g + r) * ldw + n0 + 4 * i);
#pragma unroll
    for (int nn = 0; nn < 4; ++nn) {
        const int n = n0 + 4 * i + nn;
        const int dr = rowmap == 0 ? n : ((n >> 7) * 256 + (rowmap == 2 ? 128 : 0) + (n & 127));
        v4u o; o.x = pk2(v[0][nn], v[1][nn]); o.y = pk2(v[2][nn], v[3][nn]); o.z = pk2(v[4][nn], v[5][nn]); o.w = pk2(v[6][nn], v[7][nn]);
        *(v4u*)(WT + (size_t)dr * ldt + k0 + 8 * g) = o;
    }
}
struct PrepArgs { const float *w_in, *w_out, *w_router, *w1, *w3, *w2, *sw1, *sw3, *sw2; bf16 *wtin, *wtout, *wtr, *wt13, *wt2; };
constexpr int IT_IN = 32 * 56, IT_OUT = 32 * 16, IT_R = 32 * 4, IT_E = 384, IT_TOTAL = IT_IN + IT_OUT + IT_R + NEX * IT_E;
__device__ __forceinline__ void prep_item(const PrepArgs& a, int it, int lane) {
    if (it < IT_IN) { transpose_item(a.w_in, WIN_LD, a.wtin, D, (it / 56) * 32, (it % 56) * 64, 0, lane); return; } it -= IT_IN;
    if (it < IT_OUT) { transpose_item(a.w_out, D, a.wtout, D, (it / 16) * 32, (it % 16) * 64, 0, lane); return; } it -= IT_OUT;
    if (it < IT_R) { transpose_item(a.w_router, NE, a.wtr, D, (it / 4) * 32, (it % 4) * 64, 0, lane); return; } it -= IT_R;
    const int e = it / IT_E, r = it % IT_E;
    const float* p1 = e < NE ? a.w1 + (size_t)e * D * FF : a.sw1; const float* p3 = e < NE ? a.w3 + (size_t)e * D * FF : a.sw3; const float* p2 = e < NE ? a.w2 + (size_t)e * FF * D : a.sw2;
    bf16* d13 = a.wt13 + (size_t)e * 512 * D; bf16* d2 = a.wt2 + (size_t)e * D * FF;
    if (r < 128) { transpose_item(p1, FF, d13, D, (r / 4) * 32, (r % 4) * 64, 1, lane); return; }
    if (r < 256) { const int q = r - 128; transpose_item(p3, FF, d13, D, (q / 4) * 32, (q % 4) * 64, 2, lane); return; }
    { const int q = r - 256; transpose_item(p2, D, d2, FF, (q / 16) * 32, (q % 16) * 64, 0, lane); }
}
__global__ void __launch_bounds__(512) k_prep(PrepArgs a) {
    const int lane = threadIdx.x & 63, gw = blockIdx.x * 8 + (threadIdx.x >> 6), ngw = gridDim.x * 8;
    for (int it = gw; it < IT_TOTAL; it += ngw) prep_item(a, it, lane);
}

__global__ void __launch_bounds__(512) k_ln1(const float* __restrict__ x, const float* __restrict__ mod, const float* __restrict__ w_in, const float* __restrict__ gate_b,
                                              bf16* __restrict__ u1, float* __restrict__ ipre, float* __restrict__ logf) {
    __shared__ float wg[D][8];
    const int tid = threadIdx.x, lane = tid & 63, wave = tid >> 6;
    for (int i = tid; i < D * 8; i += 512) wg[i >> 3][i & 7] = w_in[(size_t)(i >> 3) * WIN_LD + C_GATE + (i & 7)];
    __syncthreads();
    const int row0 = blockIdx.x * 128, b = row0 / S;
    f32x4 sh[4], sc[4];
#pragma unroll
    for (int j = 0; j < 4; ++j) { sh[j] = *(const f32x4*)(mod + b * 6144 + 4 * lane + 256 * j); sc[j] = *(const f32x4*)(mod + b * 6144 + 1024 + 4 * lane + 256 * j); }
    for (int rr = wave; rr < 128; rr += 8) {
        const int row = row0 + rr;
        const f32x4* xr = (const f32x4*)(x + (size_t)row * D) + lane;
        f32x4 v[4]; float s = 0.f;
#pragma unroll
        for (int j = 0; j < 4; ++j) { v[j] = xr[64 * j]; s += (v[j].x + v[j].y) + (v[j].z + v[j].w); }
        const float mean = wave_sum(s) * (1.f / D); float s2 = 0.f;
#pragma unroll
        for (int j = 0; j < 4; ++j) { v[j] = v[j] - mean; s2 += (v[j].x * v[j].x + v[j].y * v[j].y) + (v[j].z * v[j].z + v[j].w * v[j].w); }
        const float rstd = 1.f / sqrtf(wave_sum(s2) * (1.f / D) + LN_EPS);
        float ga[8];
#pragma unroll
        for (int q = 0; q < 8; ++q) ga[q] = 0.f;
        unsigned long long* o8 = (unsigned long long*)(u1 + (size_t)row * D) + lane;
#pragma unroll
        for (int j = 0; j < 4; ++j) {
            f32x4 u = v[j] * rstd * (sc[j] + 1.0f) + sh[j];
            o8[64 * j] = (unsigned long long)pk2(u.x, u.y) | ((unsigned long long)pk2(u.z, u.w) << 32);
#pragma unroll
            for (int e = 0; e < 4; ++e) { const int k = 4 * lane + 256 * j + e;
#pragma unroll
                for (int q = 0; q < 8; ++q) ga[q] += u[e] * wg[k][q]; }
        }
#pragma unroll
        for (int q = 0; q < 8; ++q) ga[q] = wave_sum(ga[q]);
        if (lane < 8) {
            float gv = 0.f;
#pragma unroll
            for (int q = 0; q < 8; ++q) gv = (lane == q) ? ga[q] : gv;
            gv += gate_b[lane];
            const int h = lane & 3, s_ = row % S;
            if (lane < 4) ipre[(size_t)(b * 4 + h) * S + s_] = gv;
            else { const float ls = fminf(gv, 0.f) - log1pf(__expf(-fabsf(gv))); logf[(size_t)(b * 4 + h) * S + s_] = ls; }
        }
    }
}

template <class ARow, class BRow>
__device__ __forceinline__ void ngemm_tile(ARow arow, BRow brow, int K, float (&acc)[4][4], float* sA, float* sB) {
    const int tid = threadIdx.x, ty = tid >> 4, tx = tid & 15;
    const int lr = tid >> 2, lk = (tid & 3) * 8;
    const bf16* ap = arow(lr); const bf16* bp = brow(lr);
#pragma unroll
    for (int i = 0; i < 4; ++i)
#pragma unroll
        for (int j = 0; j < 4; ++j) acc[i][j] = 0.f;
    for (int k0 = 0; k0 < K; k0 += 32) {
        v4u av = {0u, 0u, 0u, 0u}, bv = {0u, 0u, 0u, 0u};
        if (ap) av = *(const v4u*)(ap + k0 + lk);
        if (bp) bv = *(const v4u*)(bp + k0 + lk);
        __syncthreads();
#pragma unroll
        for (int q = 0; q < 4; ++q) {
            sA[(lk + 2 * q) * 68 + lr] = bf2f(av[q] & 0xffffu); sA[(lk + 2 * q + 1) * 68 + lr] = bf2f(av[q] >> 16);
            sB[(lk + 2 * q) * 68 + lr] = bf2f(bv[q] & 0xffffu); sB[(lk + 2 * q + 1) * 68 + lr] = bf2f(bv[q] >> 16);
        }
        __syncthreads();
#pragma unroll 8
        for (int kk = 0; kk < 32; ++kk) {
            const f32x4 a = *(const f32x4*)(sA + kk * 68 + ty * 4), b = *(const f32x4*)(sB + kk * 68 + tx * 4);
#pragma unroll
            for (int i = 0; i < 4; ++i)
#pragma unroll
                for (int j = 0; j < 4; ++j) acc[i][j] += a[i] * b[j];
        }
    }
}

template <int MODE>
__global__ void __launch_bounds__(256) k_ngemm(const bf16* __restrict__ A, const bf16* __restrict__ Bt, void* __restrict__ C, int M, int N, int K, int ldc, int scale_cols, float scale) {
    __shared__ __attribute__((aligned(16))) float sA[32 * 68];
    __shared__ __attribute__((aligned(16))) float sB[32 * 68];
    const int m0 = blockIdx.y * 64, n0 = blockIdx.x * 64;
    float acc[4][4];
    ngemm_tile([&](int r) { return A + (size_t)(m0 + r) * K; }, [&](int r) { return Bt + (size_t)(n0 + r) * K; }, K, acc, sA, sB);
    const int ty = threadIdx.x >> 4, tx = threadIdx.x & 15;
#pragma unroll
    for (int i = 0; i < 4; ++i) { const int m = m0 + ty * 4 + i, n = n0 + tx * 4;
        if (MODE == 0) { const float sc = n < scale_cols ? scale : 1.f;
            *(unsigned long long*)((bf16*)C + (size_t)m * ldc + n) = (unsigned long long)pk2(acc[i][0] * sc, acc[i][1] * sc) | ((unsigned long long)pk2(acc[i][2] * sc, acc[i][3] * sc) << 32); }
        else *(f32x4*)((float*)C + (size_t)m * ldc + n) = (f32x4){acc[i][0], acc[i][1], acc[i][2], acc[i][3]}; }
}

__global__ void __launch_bounds__(256) k_attn_naive(const bf16* __restrict__ proj, bf16* __restrict__ mix) {
    const int gid = blockIdx.x * 256 + threadIdx.x;
    const int t = gid % S, bh = gid / S, h = bh & 7, b = bh >> 3;
    const bf16* base = proj + (size_t)b * S * NPROJ;
    float q[64], o[64];
    { const v4u* qp = (const v4u*)(base + (size_t)t * NPROJ + C_SBQ + h * 64);
#pragma unroll
      for (int i = 0; i < 8; ++i) { const v4u w = qp[i];
#pragma unroll
          for (int e = 0; e < 4; ++e) { q[i * 8 + 2 * e] = bf2f(w[e] & 0xffffu); q[i * 8 + 2 * e + 1] = bf2f(w[e] >> 16); } } }
#pragma unroll
    for (int d = 0; d < 64; ++d) o[d] = 0.f;
    float carry = 0.f;
    for (int s = t - 1; s >= 0; --s) {
        const v4u* kp = (const v4u*)(base + (size_t)s * NPROJ + C_SBK + h * 64);
        float z = 0.f;
#pragma unroll
        for (int i = 0; i < 8; ++i) { const v4u w = kp[i];
#pragma unroll
            for (int e = 0; e < 4; ++e) { z += q[i * 8 + 2 * e] * bf2f(w[e] & 0xffffu); z += q[i * 8 + 2 * e + 1] * bf2f(w[e] >> 16); } }
        const float sp = fmaxf(z, 0.f) + __log2f(1.f + exp2f(-fabsf(z)));
        carry += sp;
        const float a = exp2f(z - carry);
        const v4u* vp = (const v4u*)(base + (size_t)s * NPROJ + C_SBV + h * 64);
#pragma unroll
        for (int i = 0; i < 8; ++i) { const v4u w = vp[i];
#pragma unroll
            for (int e = 0; e < 4; ++e) { o[i * 8 + 2 * e] += a * bf2f(w[e] & 0xffffu); o[i * 8 + 2 * e + 1] += a * bf2f(w[e] >> 16); } }
        if (carry > SB_THRESH) break;
    }
    v4u* op = (v4u*)(mix + (size_t)(b * S + t) * D + h * 64);
#pragma unroll
    for (int i = 0; i < 8; ++i) { v4u w; w.x = pk2(o[i * 8], o[i * 8 + 1]); w.y = pk2(o[i * 8 + 2], o[i * 8 + 3]); w.z = pk2(o[i * 8 + 4], o[i * 8 + 5]); w.w = pk2(o[i * 8 + 6], o[i * 8 + 7]); op[i] = w; }
}

__global__ void __launch_bounds__(256) k_mlstm_naive(const bf16* __restrict__ proj, const float* __restrict__ conv_w, const float* __restrict__ conv_b,
                                                      const float* __restrict__ ipre, const float* __restrict__ logf, float* __restrict__ hraw) {
    __shared__ float sq[32][128], sk[32][128], sv[32][16], sf[32], si[32];
    const int tid = threadIdx.x, bh = blockIdx.x >> 3, sl = blockIdx.x & 7, b = bh >> 2, h = bh & 3;
    const int r = tid >> 4, c = tid & 15;
    const bf16* base = proj + (size_t)b * S * NPROJ;
    float Cst[8], nst[8];
#pragma unroll
    for (int e = 0; e < 8; ++e) { Cst[e] = 0.f; nst[e] = 0.f; }
    for (int t0 = 0; t0 < S; t0 += 32) {
        __syncthreads();
        for (int i = tid; i < 32 * 128; i += 256) {
            const int tt = i >> 7, d = i & 127, t = t0 + tt, ch = h * 128 + d;
            float yq = conv_b[ch], yk = conv_b[512 + ch];
#pragma unroll
            for (int j = 0; j < 4; ++j) { const int ts = t - 3 + j;
                if (ts >= 0) { yq += conv_w[j * 1024 + ch] * bf2f(base[(size_t)ts * NPROJ + C_MLQ + ch]); yk += conv_w[j * 1024 + 512 + ch] * bf2f(base[(size_t)ts * NPROJ + C_MLK + ch]); } }
            sq[tt][d] = siluf_(yq); sk[tt][d] = siluf_(yk) * 0.08838834764831845f;
        }
        for (int i = tid; i < 32 * 16; i += 256) { const int tt = i >> 4, d = i & 15; sv[tt][d] = bf2f(base[(size_t)(t0 + tt) * NPROJ + C_MLV + h * 128 + sl * 16 + d]); }
        if (tid < 32) { sf[tid] = __expf(logf[(size_t)bh * S + t0 + tid]); si[tid] = __expf(ipre[(size_t)bh * S + t0 + tid]); }
        __syncthreads();
        for (int tt = 0; tt < 32; ++tt) {
            const float f = sf[tt], iv = si[tt] * sv[tt][r], ii = si[tt];
            float pn = 0.f, pd = 0.f;
#pragma unroll
            for (int e = 0; e < 8; ++e) { const float kk = sk[tt][c * 8 + e], qq = sq[tt][c * 8 + e];
                Cst[e] = f * Cst[e] + iv * kk; nst[e] = f * nst[e] + ii * kk; pn += Cst[e] * qq; pd += nst[e] * qq; }
#pragma unroll
            for (int o = 1; o < 16; o <<= 1) { pn += __shfl_xor(pn, o); pd += __shfl_xor(pd, o); }
            if (c == 0) hraw[(size_t)(b * S + t0 + tt) * 512 + h * 128 + sl * 16 + r] = pn / fmaxf(fabsf(pd), 1.f);
        }
    }
}
__global__ void __launch_bounds__(256) k_mlnorm_naive(const float* __restrict__ hraw, const bf16* __restrict__ proj, const float* __restrict__ norm_g, bf16* __restrict__ mix) {
    const int gw = blockIdx.x * 4 + (threadIdx.x >> 6), lane = threadIdx.x & 63, t = gw >> 2, h = gw & 3;
    const float a = hraw[(size_t)t * 512 + h * 128 + 2 * lane], bq = hraw[(size_t)t * 512 + h * 128 + 2 * lane + 1];
    const float mean = wave_sum(a + bq) * (1.f / 128.f);
    const float da = a - mean, db = bq - mean;
    const float rstd = 1.f / sqrtf(wave_sum(da * da + db * db) * (1.f / 128.f) + LN_EPS);
    const unsigned ow = *(const unsigned*)(proj + (size_t)t * NPROJ + C_MLO + h * 128 + 2 * lane);
    const float o0 = sigmoidf_(bf2f(ow & 0xffffu)), o1 = sigmoidf_(bf2f(ow >> 16));
    const float g0 = norm_g[h * 128 + 2 * lane], g1 = norm_g[h * 128 + 2 * lane + 1];
    *(unsigned*)(mix + (size_t)t * D + 512 + h * 128 + 2 * lane) = pk2(da * rstd * g0 * o0, db * rstd * g1 * o1);
}

__global__ void __launch_bounds__(512) k_ln2(const float* __restrict__ x, const bf16* __restrict__ mixout, const float* __restrict__ mod, const float* __restrict__ ln1_g, const float* __restrict__ ln1_b,
                                              float* __restrict__ x1, bf16* __restrict__ u2) {
    const int tid = threadIdx.x, lane = tid & 63, wave = tid >> 6;
    const int row0 = blockIdx.x * 128, b = row0 / S;
    for (int rr = wave; rr < 128; rr += 8) {
        const int row = row0 + rr;
        f32x4 v[4]; float s = 0.f;
#pragma unroll
        for (int j = 0; j < 4; ++j) {
            const int col = 4 * lane + 256 * j;
            const f32x4 xv = *(const f32x4*)(x + (size_t)row * D + col);
            const unsigned long long mw = *(const unsigned long long*)(mixout + (size_t)row * D + col);
            const f32x4 g1 = *(const f32x4*)(mod + b * 6144 + 2048 + col);
            f32x4 mo = {bf2f((unsigned)mw & 0xffffu), bf2f(((unsigned)mw) >> 16), bf2f((unsigned)(mw >> 32) & 0xffffu), bf2f((unsigned)(mw >> 48))};
            v[j] = xv * DN_ALPHA + g1 * mo; s += (v[j].x + v[j].y) + (v[j].z + v[j].w);
        }
        float mean = wave_sum(s) * (1.f / D), s2 = 0.f;
#pragma unroll
        for (int j = 0; j < 4; ++j) { v[j] = v[j] - mean; s2 += (v[j].x * v[j].x + v[j].y * v[j].y) + (v[j].z * v[j].z + v[j].w * v[j].w); }
        float rstd = 1.f / sqrtf(wave_sum(s2) * (1.f / D) + LN_EPS);
        s = 0.f;
#pragma unroll
        for (int j = 0; j < 4; ++j) { const int col = 4 * lane + 256 * j;
            v[j] = v[j] * rstd * *(const f32x4*)(ln1_g + col) + *(const f32x4*)(ln1_b + col);
            *(f32x4*)(x1 + (size_t)row * D + col) = v[j]; s += (v[j].x + v[j].y) + (v[j].z + v[j].w); }
        mean = wave_sum(s) * (1.f / D); s2 = 0.f;
#pragma unroll
        for (int j = 0; j < 4; ++j) { v[j] = v[j] - mean; s2 += (v[j].x * v[j].x + v[j].y * v[j].y) + (v[j].z * v[j].z + v[j].w * v[j].w); }
        rstd = 1.f / sqrtf(wave_sum(s2) * (1.f / D) + LN_EPS);
#pragma unroll
        for (int j = 0; j < 4; ++j) { const int col = 4 * lane + 256 * j;
            const f32x4 u = v[j] * rstd * (*(const f32x4*)(mod + b * 6144 + 4096 + col) + 1.0f) + *(const f32x4*)(mod + b * 6144 + 3072 + col);
            *(unsigned long long*)(u2 + (size_t)row * D + col) = (unsigned long long)pk2(u.x, u.y) | ((unsigned long long)pk2(u.z, u.w) << 32); }
    }
}

__global__ void __launch_bounds__(256) k_route(const float* __restrict__ logits, const float* __restrict__ rbias, int* __restrict__ tope, float* __restrict__ topg, int* __restrict__ cnt) {
    const int t = blockIdx.x * 256 + threadIdx.x;
    const float* lg = logits + (size_t)t * NE;
    float gs[8];
#pragma unroll
    for (int g = 0; g < 8; ++g) { float m1 = -INFINITY, m2 = -INFINITY;
        for (int i = 0; i < 32; ++i) { const int e = g * 32 + i; const float v = sigmoidf_(lg[e]) + rbias[e]; if (v > m1) { m2 = m1; m1 = v; } else if (v > m2) m2 = v; }
        gs[g] = m1 + m2; }
    unsigned gmask = 0;
#pragma unroll
    for (int r = 0; r < 4; ++r) { int bi = 0; float bv = -INFINITY;
#pragma unroll
        for (int g = 0; g < 8; ++g) if (!((gmask >> g) & 1u) && gs[g] > bv) { bv = gs[g]; bi = g; }
        gmask |= 1u << bi; }
    float pv = INFINITY; int pi = -1; float gsum = 0.f;
    for (int r = 0; r < 8; ++r) { int bi = 0; float bv = -INFINITY, bs = 0.f;
        for (int e = 0; e < NE; ++e) { if (!((gmask >> (e >> 5)) & 1u)) continue;
            const float sc = sigmoidf_(lg[e]), v = sc + rbias[e];
            const bool elig = (v < pv) || (v == pv && e > pi);
            if (elig && v > bv) { bv = v; bi = e; bs = sc; } }
        pv = bv; pi = bi; gsum += bs;
        tope[t * 8 + r] = bi; topg[t * 8 + r] = bs;
        atomicAdd(cnt + bi, 1); }
    const float inv = 2.5f / gsum;
    for (int r = 0; r < 8; ++r) topg[t * 8 + r] *= inv;
}
__global__ void k_plan(const int* __restrict__ cnt, int* __restrict__ plan) {
    if (threadIdx.x == 0) { int s = 0, t64 = 0, t256 = 0;
        for (int e = 0; e <= NEX; ++e) { plan[PL_SLOT + e] = s; plan[PL_T64 + e] = t64; plan[PL_T256 + e] = t256;
            if (e < NEX) { const int n = e < NE ? cnt[e] : T; s += ((n + 255) / 256) * 256; t64 += (n + 63) / 64; t256 += (n + 255) / 256; } } }
}
__global__ void __launch_bounds__(256) k_fill(const int* __restrict__ tope, const float* __restrict__ topg, const int* __restrict__ plan, int* __restrict__ fill, i32x2* __restrict__ list) {
    const int id = blockIdx.x * 256 + threadIdx.x; const int e = tope[id];
    const int pos = atomicAdd(fill + e, 1); list[plan[PL_SLOT + e] + pos] = (i32x2){id, __float_as_int(topg[id])};
}
__device__ __forceinline__ int find_expert(const int* base, int tile) { int lo = 0, hi = NEX;
    while (hi - lo > 1) { const int mid = (lo + hi) >> 1; if (base[mid] <= tile) lo = mid; else hi = mid; } return lo; }

__global__ void __launch_bounds__(256) k_moe1_naive(const bf16* __restrict__ u2, const bf16* __restrict__ wt13, const int* __restrict__ cnt, const int* __restrict__ plan, const i32x2* __restrict__ list, bf16* __restrict__ H) {
    __shared__ __attribute__((aligned(16))) float sA[32 * 68];
    __shared__ __attribute__((aligned(16))) float sB[32 * 68];
    const int tile = blockIdx.y; if (tile >= plan[PL_T64 + NEX]) return;
    const int e = find_expert(plan + PL_T64, tile), mt = tile - plan[PL_T64 + e], n = e < NE ? cnt[e] : T, j0 = blockIdx.x * 64;
    const bf16* w = wt13 + (size_t)e * 512 * D;
    auto arow = [&](int r) -> const bf16* { const int rr = mt * 64 + r; if (rr >= n) return nullptr; const int tok = e < NE ? (list[plan[PL_SLOT + e] + rr].x >> 3) : rr; return u2 + (size_t)tok * D; };
    float a1[4][4], a3[4][4];
    ngemm_tile(arow, [&](int r) { const int j = j0 + r; return w + (size_t)((j >> 7) * 256 + (j & 127)) * D; }, D, a1, sA, sB);
    __syncthreads();
    ngemm_tile(arow, [&](int r) { const int j = j0 + r; return w + (size_t)((j >> 7) * 256 + 128 + (j & 127)) * D; }, D, a3, sA, sB);
    const int ty = threadIdx.x >> 4, tx = threadIdx.x & 15;
#pragma unroll
    for (int i = 0; i < 4; ++i) { const int rr = mt * 64 + ty * 4 + i; if (rr >= n) continue;
        float hv[4];
#pragma unroll
        for (int j = 0; j < 4; ++j) hv[j] = siluf_(a1[i][j]) * a3[i][j];
        *(unsigned long long*)(H + (size_t)(plan[PL_SLOT + e] + rr) * FF + j0 + tx * 4) = (unsigned long long)pk2(hv[0], hv[1]) | ((unsigned long long)pk2(hv[2], hv[3]) << 32); }
}
__global__ void __launch_bounds__(256) k_moe2_naive(const bf16* __restrict__ H, const bf16* __restrict__ wt2, const int* __restrict__ cnt, const int* __restrict__ plan, const i32x2* __restrict__ list,
                                                     const float* __restrict__ topg, bf16* __restrict__ ys, bf16* __restrict__ ysh) {
    __shared__ __attribute__((aligned(16))) float sA[32 * 68];
    __shared__ __attribute__((aligned(16))) float sB[32 * 68];
    const int tile = blockIdx.y; if (tile >= plan[PL_T64 + NEX]) return;
    const int e = find_expert(plan + PL_T64, tile), mt = tile - plan[PL_T64 + e], n = e < NE ? cnt[e] : T, n0 = blockIdx.x * 64;
    const bf16* w = wt2 + (size_t)e * D * FF; const bf16* hb = H + (size_t)plan[PL_SLOT + e] * FF;
    float acc[4][4];
    ngemm_tile([&](int r) -> const bf16* { const int rr = mt * 64 + r; return rr < n ? hb + (size_t)rr * FF : nullptr; }, [&](int r) { return w + (size_t)(n0 + r) * FF; }, FF, acc, sA, sB);
    const int ty = threadIdx.x >> 4, tx = threadIdx.x & 15;
#pragma unroll
    for (int i = 0; i < 4; ++i) { const int rr = mt * 64 + ty * 4 + i; if (rr >= n) continue;
        bf16* dst; float g = 1.f;
        if (e < NE) { const i32x2 en = list[plan[PL_SLOT + e] + rr]; g = __int_as_float(en.y); dst = ys + (size_t)en.x * D; } else dst = ysh + (size_t)rr * D;
        *(unsigned long long*)(dst + n0 + tx * 4) = (unsigned long long)pk2(acc[i][0] * g, acc[i][1] * g) | ((unsigned long long)pk2(acc[i][2] * g, acc[i][3] * g) << 32); }
}

__device__ __forceinline__ f32x4 ld_bf4(const bf16* p) { const unsigned long long w = *(const unsigned long long*)p;
    return (f32x4){bf2f((unsigned)w & 0xffffu), bf2f(((unsigned)w) >> 16), bf2f((unsigned)(w >> 32) & 0xffffu), bf2f((unsigned)(w >> 48))}; }
__global__ void __launch_bounds__(512) k_final(float* __restrict__ out, const bf16* __restrict__ ys, const bf16* __restrict__ ysh, const float* __restrict__ mod, const float* __restrict__ ln2_g, const float* __restrict__ ln2_b) {
    const int tid = threadIdx.x, lane = tid & 63, wave = tid >> 6;
    const int row0 = blockIdx.x * 128, b = row0 / S;
    for (int rr = wave; rr < 128; rr += 8) {
        const int row = row0 + rr;
        f32x4 v[4]; float s = 0.f;
#pragma unroll
        for (int j = 0; j < 4; ++j) { const int col = 4 * lane + 256 * j;
            f32x4 y = ld_bf4(ysh + (size_t)row * D + col);
#pragma unroll
            for (int k = 0; k < 8; ++k) y = y + ld_bf4(ys + ((size_t)row * 8 + k) * D + col);
            v[j] = *(const f32x4*)(out + (size_t)row * D + col) * DN_ALPHA + *(const f32x4*)(mod + b * 6144 + 5120 + col) * y;
            s += (v[j].x + v[j].y) + (v[j].z + v[j].w); }
        const float mean = wave_sum(s) * (1.f / D); float s2 = 0.f;
#pragma unroll
        for (int j = 0; j < 4; ++j) { v[j] = v[j] - mean; s2 += (v[j].x * v[j].x + v[j].y * v[j].y) + (v[j].z * v[j].z + v[j].w * v[j].w); }
        const float rstd = 1.f / sqrtf(wave_sum(s2) * (1.f / D) + LN_EPS);
#pragma unroll
        for (int j = 0; j < 4; ++j) { const int col = 4 * lane + 256 * j;
            *(f32x4*)(out + (size_t)row * D + col) = v[j] * rstd * *(const f32x4*)(ln2_g + col) + *(const f32x4*)(ln2_b + col); }
    }
}

#define LAS __attribute__((address_space(3)))
#define GAS __attribute__((address_space(1)))
namespace pg8 {
typedef short bf16x8 __attribute__((ext_vector_type(8)));
constexpr int BM = 256, BK = 64, HALF = 128, HTB = HALF * BK * 2, STAGE_BYTES = 8 * HTB, NXCD = 8, WGM = 8;
__host__ __device__ __forceinline__ int lds_byte(int r, int c) { const int st = (r >> 4) * 2 + (c >> 5), rr = r & 15, cc = c & 31, ob = rr * 64 + cc * 2; return st * 1024 + (ob ^ (((ob >> 9) & 1) << 5)); }
__host__ __device__ __forceinline__ void stage_rc(int b, int& R, int& C) { const int st = b / 1024, sb = b % 1024, swz = sb ^ (((sb >> 9) & 1) << 5); R = (st >> 1) * 16 + swz / 64; C = (st & 1) * 32 + (swz % 64) / 2; }
__host__ __device__ __forceinline__ int perm32(int rho) { const int n = rho >> 4, i = rho & 15; return 8 * (i >> 2) + 4 * n + (i & 3); }

struct Unit { int pm, pn, e, mt; const char* A; const char* B; };

__device__ __forceinline__ long unit_index(int i, int G, int c) { return (G % 8 == 0) ? ((long)(i * 8 + (c & 7)) * (G / 8) + (c >> 3)) : ((long)i * G + c); }

struct StaticOrder {
    int nM, nN, nwg, G, c; const char* A; const char* B; size_t tstep;
    __device__ void init(const void* A_, const void* B_, int M, int N, int K, int G_, int c_) { nM = M / BM; nN = N / BM; nwg = nM * nN; G = G_; c = c_; A = (const char*)A_; B = (const char*)B_; tstep = (size_t)BM * K * 2; }
    __device__ __forceinline__ bool next(int i, Unit& u) const {
        const long L = (long)i * G + c; if (L >= nwg) return false;
        int wgid = (int)L; { const int q = nwg / NXCD, r = nwg % NXCD, xcd = wgid % NXCD, off = wgid / NXCD; wgid = (xcd < r ? xcd * (q + 1) : r * (q + 1) + (xcd - r) * q) + off; }
        const int nig = WGM * nN, gid = wgid / nig, fm = gid * WGM, gsz = (nM - fm) < WGM ? (nM - fm) : WGM;
        u.pm = fm + ((wgid % nig) % gsz); u.pn = (wgid % nig) / gsz; u.e = 0; u.mt = u.pm; u.A = A + (size_t)u.pm * tstep; u.B = B + (size_t)u.pn * tstep; return true;
    }
    __device__ __forceinline__ int row_token(const Unit&, int) const { return 0; }
};

struct MoeOrder {
    int G, c, total, shift; const LAS int* tb; const LAS int* nn; const i32x2* list;
    const char* Abase; size_t a_tile_stride; const char* Bbase; size_t b_exp_stride, b_pn_stride;
    __device__ __forceinline__ bool next(int i, Unit& u) const {
        const long L = unit_index(i, G, c); if (L >= total) return false;
        const int tile = (int)(L >> shift); u.pn = (int)(L & ((1 << shift) - 1));
        int lo = 0, hi = NEX; while (hi - lo > 1) { const int mid = (lo + hi) >> 1; if (tb[mid] <= tile) lo = mid; else hi = mid; }
        u.e = lo; u.mt = tile - tb[lo]; u.pm = tile;
        u.A = Abase + (size_t)tile * a_tile_stride; u.B = Bbase + (size_t)lo * b_exp_stride + (size_t)u.pn * b_pn_stride; return true;
    }
    __device__ __forceinline__ int row_token(const Unit& u, int row) const {
        const int rr = u.mt * 256 + row;
        if (u.e >= NE) return rr;
        return rr < nn[u.e] ? (list[u.pm * 256 + row].x >> 3) : 0;
    }
};

__device__ __forceinline__ unsigned cvt_pk_bf16(float lo, float hi) { unsigned r; asm volatile("v_cvt_pk_bf16_f32 %0, %1, %2" : "=v"(r) : "v"(lo), "v"(hi)); return r; }

struct EpiBf16 {
    static constexpr bool PERM = true; bf16* O; int ldc; int scale_tiles; float scale;
    __device__ __forceinline__ void operator()(const f32x4 (&acc)[2][2][4][2], const Unit& u, int wr, int wc, int fr, int fq) const {
        const int row0 = u.pm * BM + wr * 64 + fr, col0 = u.pn * BM + wc * 32 + 8 * fq; const float sc = u.pn < scale_tiles ? scale : 1.f;
#pragma unroll
        for (int ai = 0; ai < 2; ++ai)
#pragma unroll
            for (int m = 0; m < 4; ++m) { bf16* rowp = O + (size_t)(row0 + ai * HALF + m * 16) * ldc + col0;
#pragma unroll
                for (int bj = 0; bj < 2; ++bj) { const f32x4 v0 = acc[ai][bj][m][0] * sc, v1 = acc[ai][bj][m][1] * sc;
                    v4u w; w.x = cvt_pk_bf16(v0[0], v0[1]); w.y = cvt_pk_bf16(v0[2], v0[3]); w.z = cvt_pk_bf16(v1[0], v1[1]); w.w = cvt_pk_bf16(v1[2], v1[3]);
                    *(v4u*)(rowp + bj * HALF) = w; } }
    }
};
struct EpiF32 {
    static constexpr bool PERM = false; float* C; int ldc;
    __device__ __forceinline__ void operator()(const f32x4 (&acc)[2][2][4][2], const Unit& u, int wr, int wc, int fr, int fq) const {
        const int row0 = u.pm * BM + wr * 64 + fr, col0 = u.pn * BM + wc * 32 + 4 * fq;
#pragma unroll
        for (int ai = 0; ai < 2; ++ai)
#pragma unroll
            for (int m = 0; m < 4; ++m) { float* rowp = C + (size_t)(row0 + ai * HALF + m * 16) * ldc + col0;
#pragma unroll
                for (int bj = 0; bj < 2; ++bj)
#pragma unroll
                    for (int n = 0; n < 2; ++n) *(f32x4*)(rowp + bj * HALF + n * 16) = acc[ai][bj][m][n]; }
    }
};
struct EpiGlu {
    static constexpr bool PERM = true; bf16* H;
    __device__ __forceinline__ void operator()(const f32x4 (&acc)[2][2][4][2], const Unit& u, int wr, int wc, int fr, int fq) const {
        const int row0 = u.pm * BM + wr * 64 + fr, col0 = u.pn * HALF + wc * 32 + 8 * fq;
#pragma unroll
        for (int ai = 0; ai < 2; ++ai)
#pragma unroll
            for (int m = 0; m < 4; ++m) { float h[8];
#pragma unroll
                for (int n = 0; n < 2; ++n)
#pragma unroll
                    for (int q = 0; q < 4; ++q) { const float a = acc[ai][0][m][n][q]; h[n * 4 + q] = a * __builtin_amdgcn_rcpf(1.f + __expf(-a)) * acc[ai][1][m][n][q]; }
                v4u w; w.x = cvt_pk_bf16(h[0], h[1]); w.y = cvt_pk_bf16(h[2], h[3]); w.z = cvt_pk_bf16(h[4], h[5]); w.w = cvt_pk_bf16(h[6], h[7]);
                *(v4u*)(H + (size_t)(row0 + ai * HALF + m * 16) * FF + col0) = w; }
    }
};
struct EpiScatter {
    static constexpr bool PERM = true; bf16* ys; bf16* ysh; const i32x2* list; const LAS int* nn;
    __device__ __forceinline__ void operator()(const f32x4 (&acc)[2][2][4][2], const Unit& u, int wr, int wc, int fr, int fq) const {
        const int col0 = u.pn * BM + wc * 32 + 8 * fq; const int n = nn[u.e]; const bool routed = u.e < NE;
        const i32x2* lp = list + (size_t)(u.pm - u.mt) * 256;
#pragma unroll
        for (int ai = 0; ai < 2; ++ai) {
            i32x2 en[4];
#pragma unroll
            for (int m = 0; m < 4; ++m) { const int rr = u.mt * 256 + ai * HALF + wr * 64 + m * 16 + fr; en[m] = (i32x2){rr, 0x3f800000};
                if (routed && rr < n) en[m] = lp[rr]; }
#pragma unroll
            for (int m = 0; m < 4; ++m) { const int rr = u.mt * 256 + ai * HALF + wr * 64 + m * 16 + fr;
                if (rr < n) { bf16* dst = (routed ? ys : ysh) + (size_t)en[m].x * D + col0; const float g = __int_as_float(en[m].y);
#pragma unroll
                    for (int bj = 0; bj < 2; ++bj) { const f32x4 v0 = acc[ai][bj][m][0] * g, v1 = acc[ai][bj][m][1] * g;
                        v4u w; w.x = cvt_pk_bf16(v0[0], v0[1]); w.y = cvt_pk_bf16(v0[2], v0[3]); w.z = cvt_pk_bf16(v1[0], v1[1]); w.w = cvt_pk_bf16(v1[2], v1[3]);
                        *(v4u*)(dst + bj * HALF) = w; } } }
            __builtin_amdgcn_sched_barrier(0);
        }
    }
};

template <class Epi, class Sched, bool GATHER>
__device__ __forceinline__ void gemm_phase(LAS unsigned char* lds, const int K, const Sched& S, const Epi& E) {
    const int tid = threadIdx.x, wid = __builtin_amdgcn_readfirstlane(tid >> 6), lane = tid & 63, wr = wid >> 2, wc = wid & 3, fr = lane & 15, fq = lane >> 4;
    const int nt = K / BK;
    int sR[2], sC[2];
    unsigned voffA[2], voffB[2];
#pragma unroll
    for (int i = 0; i < 2; ++i) { stage_rc(tid * 16 + i * 8192, sR[i], sC[i]); const int Rb = Epi::PERM ? ((sR[i] & ~31) + perm32(sR[i] & 31)) : sR[i];
        voffA[i] = (unsigned)(sR[i] * K + sC[i]) * 2u; voffB[i] = (unsigned)(Rb * K + sC[i]) * 2u; }
    const size_t kstep = (size_t)(BK * 2);
    const size_t hstep = (size_t)HALF * K * 2;
    const unsigned ldsw = (unsigned)wid * 1024u;
    const int aoff = lds_byte(wr * 64 + fr, fq * 8), boff = lds_byte(wc * 32 + fr, fq * 8);
    unsigned gc[2][2], gn[2][2];
#define PG8_SA(b, h) (((b) * 2 + (h)) * HTB)
#define PG8_SB(b, h) ((4 + (b) * 2 + (h)) * HTB)
#define PG8_GLDS(src, bufoff, i) __builtin_amdgcn_global_load_lds((const unsigned*)(src), (LAS unsigned*)(lds + (bufoff) + ldsw + (i) * 8192), 16, 0, 0)
#define PG8_STAGE_B(bufoff, gbase) do { PG8_GLDS((const char*)(gbase) + voffB[0], bufoff, 0); PG8_GLDS((const char*)(gbase) + voffB[1], bufoff, 1); } while (0)
#define PG8_STAGE_A(bufoff, gbase, h, nx) do { if constexpr (GATHER) { const unsigned _o0 = (nx) ? gn[h][0] : gc[h][0], _o1 = (nx) ? gn[h][1] : gc[h][1]; \
            PG8_GLDS((const char*)(gbase) + _o0, bufoff, 0); PG8_GLDS((const char*)(gbase) + _o1, bufoff, 1); } \
        else { PG8_GLDS((const char*)(gbase) + (h) * hstep + voffA[0], bufoff, 0); PG8_GLDS((const char*)(gbase) + (h) * hstep + voffA[1], bufoff, 1); } } while (0)
#define PG8_LDA(dst, b, h) do { _Pragma("unroll") for (int m = 0; m < 4; ++m) _Pragma("unroll") for (int k = 0; k < 2; ++k) dst[m][k] = *(const LAS bf16x8*)(lds + PG8_SA(b, h) + aoff + m * 2048 + k * 1024); } while (0)
#define PG8_LDB(dst, b, h) do { _Pragma("unroll") for (int n = 0; n < 2; ++n) _Pragma("unroll") for (int k = 0; k < 2; ++k) dst[n][k] = *(const LAS bf16x8*)(lds + PG8_SB(b, h) + boff + n * 2048 + k * 1024); } while (0)
#define PG8_MMA(ai, bj, At, Bt) do { __builtin_amdgcn_s_setprio(1); _Pragma("unroll") for (int m = 0; m < 4; ++m) _Pragma("unroll") for (int n = 0; n < 2; ++n) _Pragma("unroll") for (int k = 0; k < 2; ++k) \
        acc[ai][bj][m][n] = __builtin_amdgcn_mfma_f32_16x16x32_bf16(Bt[n][k], At[m][k], acc[ai][bj][m][n], 0, 0, 0); __builtin_amdgcn_s_setprio(0); } while (0)
#define PG8_WAIT_V(n) asm volatile("s_waitcnt vmcnt(" #n ")" ::: "memory")
#define PG8_WAIT_L(n) asm volatile("s_waitcnt lgkmcnt(" #n ")" ::: "memory")
#define PG8_BAR __builtin_amdgcn_s_barrier()
#define PG8_SCHED __builtin_amdgcn_sched_barrier(0)
#define PG8_GATHER(dst, u) do { _Pragma("unroll") for (int _h = 0; _h < 2; ++_h) _Pragma("unroll") for (int _i = 0; _i < 2; ++_i) \
        dst[_h][_i] = (unsigned)(S.row_token(u, _h * HALF + sR[_i]) * K + sC[_i]) * 2u; } while (0)
    Unit cur, nxt; int ui = 0;
    if (!S.next(0, cur)) return;
    f32x4 acc[2][2][4][2];
#pragma unroll
    for (int a = 0; a < 2; ++a)
#pragma unroll
        for (int b = 0; b < 2; ++b)
#pragma unroll
            for (int m = 0; m < 4; ++m)
#pragma unroll
                for (int n = 0; n < 2; ++n) acc[a][b][m][n] = (f32x4){0.f, 0.f, 0.f, 0.f};
    bf16x8 At[4][2], B0[2][2], B1[2][2];
    const char* cA = cur.A; const char* cB = cur.B;
    if constexpr (GATHER) { PG8_GATHER(gc, cur); }
    PG8_STAGE_B(PG8_SB(0, 0), cB); PG8_STAGE_A(PG8_SA(0, 0), cA, 0, false); PG8_STAGE_B(PG8_SB(0, 1), cB + hstep); PG8_STAGE_A(PG8_SA(0, 1), cA, 1, false);
    if (wr == 1) PG8_BAR;
    PG8_WAIT_V(4); PG8_BAR;
    PG8_STAGE_B(PG8_SB(1, 0), cB + kstep); PG8_STAGE_A(PG8_SA(1, 0), cA + kstep, 0, false); PG8_STAGE_B(PG8_SB(1, 1), cB + hstep + kstep);
    PG8_WAIT_V(6); PG8_BAR;
    for (;;) {
        const bool has_next = S.next(ui + 1, nxt);
        const char* nA = has_next ? nxt.A : cA; const char* nB = has_next ? nxt.B : cB;
        if constexpr (GATHER) { if (has_next) { PG8_GATHER(gn, nxt); } else {
#pragma unroll
            for (int h = 0; h < 2; ++h) { gn[h][0] = gc[h][0]; gn[h][1] = gc[h][1]; } } }
#pragma unroll 1
        for (int t = 0; t < nt; t += 2) {
            const bool last = (t == nt - 2);
            const char* a1 = cA + (size_t)(t + 1) * kstep;
            const char* a2 = last ? nA : cA + (size_t)(t + 2) * kstep; const char* b2 = last ? nB : cB + (size_t)(t + 2) * kstep;
            const char* a3 = a2 + kstep; const char* b3 = b2 + kstep;
            PG8_LDB(B0, 0, 0); PG8_SCHED; PG8_LDA(At, 0, 0); PG8_STAGE_A(PG8_SA(1, 1), a1, 1, false);
            PG8_WAIT_L(8); PG8_BAR; PG8_WAIT_L(0); PG8_MMA(0, 0, At, B0); PG8_BAR; PG8_SCHED;
            PG8_LDB(B1, 0, 1); PG8_STAGE_B(PG8_SB(0, 0), b2);
            PG8_BAR; PG8_WAIT_L(0); PG8_MMA(0, 1, At, B1); PG8_BAR;
            PG8_LDA(At, 0, 1); PG8_STAGE_A(PG8_SA(0, 0), a2, 0, last);
            PG8_BAR; PG8_WAIT_L(0); PG8_MMA(1, 0, At, B0); PG8_BAR; PG8_SCHED;
            PG8_STAGE_B(PG8_SB(0, 1), b2 + hstep);
            PG8_WAIT_V(6); PG8_BAR; PG8_MMA(1, 1, At, B1); PG8_BAR;
            PG8_LDB(B0, 1, 0); PG8_SCHED; PG8_LDA(At, 1, 0); PG8_STAGE_A(PG8_SA(0, 1), a2, 1, last);
            PG8_WAIT_L(8); PG8_BAR; PG8_WAIT_L(0); PG8_MMA(0, 0, At, B0); PG8_BAR; PG8_SCHED;
            PG8_LDB(B1, 1, 1); PG8_STAGE_B(PG8_SB(1, 0), b3);
            PG8_BAR; PG8_WAIT_L(0); PG8_MMA(0, 1, At, B1); PG8_BAR;
            PG8_LDA(At, 1, 1); PG8_STAGE_A(PG8_SA(1, 0), a3, 0, last);
            PG8_BAR; PG8_WAIT_L(0); PG8_MMA(1, 0, At, B0); PG8_BAR; PG8_SCHED;
            PG8_STAGE_B(PG8_SB(1, 1), b3 + hstep);
            PG8_WAIT_V(6); PG8_BAR; PG8_MMA(1, 1, At, B1); PG8_BAR;
        }
        E(acc, cur, wr, wc, fr, fq);
        if (!has_next) break;
#pragma unroll
        for (int a = 0; a < 2; ++a)
#pragma unroll
            for (int b = 0; b < 2; ++b)
#pragma unroll
                for (int m = 0; m < 4; ++m)
#pragma unroll
                    for (int n = 0; n < 2; ++n) acc[a][b][m][n] = (f32x4){0.f, 0.f, 0.f, 0.f};
        cur = nxt; cA = nA; cB = nB; ++ui;
        if constexpr (GATHER) {
#pragma unroll
            for (int h = 0; h < 2; ++h) { gc[h][0] = gn[h][0]; gc[h][1] = gn[h][1]; } }
    }
    PG8_WAIT_V(0);
    if (wr == 0) PG8_BAR;
    PG8_BAR;
#undef PG8_SA
#undef PG8_SB
#undef PG8_GLDS
#undef PG8_STAGE_A
#undef PG8_STAGE_B
#undef PG8_LDA
#undef PG8_LDB
#undef PG8_MMA
#undef PG8_WAIT_V
#undef PG8_WAIT_L
#undef PG8_BAR
#undef PG8_SCHED
#undef PG8_GATHER
}
}

#define XB_TMO      128
#define XB_XCNT(j)  (256  + 64 * (j))
#define XB_XSUB(j)  (1280 + 64 * (j))
#define XB_XGEN(j)  (2304 + 64 * (j))
#define XB_TOP      3328
#define XB_TOPGEN   3392
#define XCD_BAR_WORDS 3456
#define XB_SPIN_CAP (1u << 22)
__device__ __forceinline__ unsigned xb_ld(unsigned* p)              { return __hip_atomic_load(p, __ATOMIC_RELAXED, __HIP_MEMORY_SCOPE_AGENT); }
__device__ __forceinline__ unsigned xb_add(unsigned* p, unsigned v) { return __hip_atomic_fetch_add(p, v, __ATOMIC_RELAXED, __HIP_MEMORY_SCOPE_AGENT); }
__device__ __forceinline__ unsigned xb_xcc_id() { return (unsigned)__builtin_amdgcn_s_getreg((3 << 11) | 20) & 0xFu; }
#define XB_SPIN(cond, bar) do { unsigned _sp = 0; while (cond) { __builtin_amdgcn_s_sleep(1); \
    if ((++_sp & 255u) == 0u) { if (xb_ld(&(bar)[XB_TMO])) break; if (_sp > XB_SPIN_CAP) { atomicAdd(&(bar)[XB_TMO], 1u); break; } } } } while (0)
struct XcdBarrier { unsigned* bar; unsigned x; volatile LAS unsigned* st; };
__device__ __forceinline__ XcdBarrier xcd_barrier_post(unsigned* bar, volatile LAS unsigned* st) {
    XcdBarrier b; b.bar = bar; b.x = xb_xcc_id(); b.st = st;
    if (threadIdx.x == 0) (void)xb_add(&bar[XB_XCNT(b.x)], 1u);
    return b;
}
__device__ __forceinline__ void xcd_barrier_complete(unsigned* bar, unsigned x, unsigned& nloc, unsigned& nx) {
    const unsigned G = gridDim.x * gridDim.y * gridDim.z;
    unsigned sum, cnt, mine, sp = 0u;
    for (;;) {
        sum = 0u; cnt = 0u; mine = 0u;
#pragma unroll
        for (unsigned j = 0; j < 16; ++j) { const unsigned c = xb_ld(&bar[XB_XCNT(j)]); sum += c; cnt += (c > 0u) ? 1u : 0u; mine = (j == x) ? c : mine; }
        if (sum == G) break;
        __builtin_amdgcn_s_sleep(1);
        if ((++sp & 255u) == 0u) { if (xb_ld(&bar[XB_TMO])) break; if (sp > XB_SPIN_CAP) { atomicAdd(&bar[XB_TMO], 1u); break; } }
    }
    nloc = mine > 0u ? mine : 1u; nx = cnt > 0u ? cnt : 1u;
}
__device__ __forceinline__ void xcd_barrier(const XcdBarrier& b) {
    asm volatile("s_waitcnt vmcnt(0)" ::: "memory");
    __syncthreads();
    if (threadIdx.x == 0) {
        unsigned* bar = b.bar;
        __builtin_amdgcn_s_waitcnt(0);
        unsigned nloc = b.st[0], nx = b.st[1];
        if (nloc == 0u) { xcd_barrier_complete(bar, b.x, nloc, nx); b.st[0] = nloc; b.st[1] = nx; }
        const unsigned old = xb_add(&bar[XB_XSUB(b.x)], 1u);
        const unsigned gen = old / nloc;
        if (old + 1u == (gen + 1u) * nloc) {
            __builtin_amdgcn_fence(__ATOMIC_RELEASE, "agent");
            asm volatile("s_waitcnt vmcnt(0)" ::: "memory");
            const unsigned og = xb_add(&bar[XB_TOP], 1u);
            const unsigned tg = og / nx;
            if (og + 1u == (tg + 1u) * nx) xb_add(&bar[XB_TOPGEN], 1u);
            else XB_SPIN(xb_ld(&bar[XB_TOPGEN]) == tg, bar);
            __builtin_amdgcn_fence(__ATOMIC_ACQUIRE, "agent");
            xb_add(&bar[XB_XGEN(b.x)], 1u);
            asm volatile("s_waitcnt vmcnt(0)" ::: "memory");
        } else {
            XB_SPIN(xb_ld(&bar[XB_XGEN(b.x)]) == gen, bar);
            __builtin_amdgcn_fence(__ATOMIC_ACQUIRE, "agent");
            asm volatile("s_waitcnt vmcnt(0)" ::: "memory");
        }
    }
    __syncthreads();
}

constexpr int NWAVES = 8, NTHR = 512;
constexpr int RING_BYTES = 131072, XTRA_OFF = RING_BYTES, LDS_BYTES = 147456;
constexpr int X_MISC = 0, X_TB = 256, X_NN = 1536;
constexpr int CW_BAR = 4096;
constexpr int N_PHASES = 14;
struct MArgs { const float* in[22]; float* out; unsigned char* ws; int ph_lo, ph_hi; };

__device__ __forceinline__ void ph_mod_prep(const MArgs& a, unsigned char* smem, int G) {
    const int tid = threadIdx.x;
    unsigned char* ws = a.ws;
    if ((int)blockIdx.x < 192) {
        float* sc = (float*)smem; float* red = sc + NB * D;
        const float* c = a.in[1]; const float* w_ada = a.in[2]; const float* b_ada = a.in[3]; float* mod = (float*)(ws + WS_MOD);
        for (int i = tid; i < NB * D; i += NTHR) sc[i] = siluf_(c[i]);
        __syncthreads();
        for (int it = blockIdx.x; it < 192; it += G) {
            const int kq = tid >> 5, jl = tid & 31, j = it * 32 + jl;
            float a0 = 0.f, a1 = 0.f, a2 = 0.f, a3 = 0.f;
#pragma unroll 16
            for (int kk = 0; kk < 64; ++kk) { const int k = kq * 64 + kk; const float w = w_ada[(size_t)k * 6144 + j];
                a0 += sc[k] * w; a1 += sc[D + k] * w; a2 += sc[2 * D + k] * w; a3 += sc[3 * D + k] * w; }
            red[(kq * 4 + 0) * 32 + jl] = a0; red[(kq * 4 + 1) * 32 + jl] = a1; red[(kq * 4 + 2) * 32 + jl] = a2; red[(kq * 4 + 3) * 32 + jl] = a3;
            __syncthreads();
            if (tid < 128) { const int b = tid >> 5; float s = b_ada[j];
#pragma unroll
                for (int q = 0; q < 16; ++q) s += red[(q * 4 + b) * 32 + jl];
                mod[b * 6144 + j] = s; }
            __syncthreads();
        }
    }
    PrepArgs pa{a.in[4], a.in[9], a.in[12], a.in[14], a.in[15], a.in[16], a.in[17], a.in[18], a.in[19],
                (bf16*)(ws + WS_WTIN), (bf16*)(ws + WS_WTOUT), (bf16*)(ws + WS_WTR), (bf16*)(ws + WS_WT13), (bf16*)(ws + WS_WT2)};
    const int lane = tid & 63, gw = blockIdx.x * NWAVES + (tid >> 6), ngw = G * NWAVES;
    for (int it = gw; it < IT_TOTAL; it += ngw) prep_item(pa, it, lane);
}

__device__ __forceinline__ void ph_ln1(const MArgs& a, unsigned char* smem, int G) {
    const int tid = threadIdx.x, lane = tid & 63, wave = tid >> 6;
    const float* x = a.in[0]; const float* w_in = a.in[4]; const float* gate_b = a.in[7];
    const float* mod = (const float*)(a.ws + WS_MOD); bf16* u1 = (bf16*)(a.ws + WS_U1); float* ipre = (float*)(a.ws + WS_GATES); float* logf = ipre + 16 * S;
    float* wg = (float*)smem;
    for (int i = tid; i < D * 8; i += NTHR) wg[i] = w_in[(size_t)(i >> 3) * WIN_LD + C_GATE + (i & 7)];
    __syncthreads();
    for (int it = blockIdx.x; it < T / 128; it += G) {
        const int row0 = it * 128, b = row0 / S;
        f32x4 sh[4], sc[4];
#pragma unroll
        for (int j = 0; j < 4; ++j) { sh[j] = *(const f32x4*)(mod + b * 6144 + 4 * lane + 256 * j); sc[j] = *(const f32x4*)(mod + b * 6144 + 1024 + 4 * lane + 256 * j); }
        for (int rr = wave; rr < 128; rr += NWAVES) {
            const int row = row0 + rr;
            const f32x4* xr = (const f32x4*)(x + (size_t)row * D) + lane;
            f32x4 v[4]; float s = 0.f;
#pragma unroll
            for (int j = 0; j < 4; ++j) { v[j] = xr[64 * j]; s += (v[j].x + v[j].y) + (v[j].z + v[j].w); }
            const float mean = wave_sum(s) * (1.f / D); float s2 = 0.f;
#pragma unroll
            for (int j = 0; j < 4; ++j) { v[j] = v[j] - mean; s2 += (v[j].x * v[j].x + v[j].y * v[j].y) + (v[j].z * v[j].z + v[j].w * v[j].w); }
            const float rstd = 1.f / sqrtf(wave_sum(s2) * (1.f / D) + LN_EPS);
            float ga[8];
#pragma unroll
            for (int q = 0; q < 8; ++q) ga[q] = 0.f;
            unsigned long long* o8 = (unsigned long long*)(u1 + (size_t)row * D) + lane;
#pragma unroll
            for (int j = 0; j < 4; ++j) {
                const f32x4 u = v[j] * rstd * (sc[j] + 1.0f) + sh[j];
                o8[64 * j] = (unsigned long long)pk2(u.x, u.y) | ((unsigned long long)pk2(u.z, u.w) << 32);
#pragma unroll
                for (int e = 0; e < 4; ++e) { const int k = 4 * lane + 256 * j + e;
                    const f32x4 w0 = *(const f32x4*)(wg + k * 8), w1 = *(const f32x4*)(wg + k * 8 + 4);
                    ga[0] += u[e] * w0.x; ga[1] += u[e] * w0.y; ga[2] += u[e] * w0.z; ga[3] += u[e] * w0.w;
                    ga[4] += u[e] * w1.x; ga[5] += u[e] * w1.y; ga[6] += u[e] * w1.z; ga[7] += u[e] * w1.w; }
            }
#pragma unroll
            for (int q = 0; q < 8; ++q) ga[q] = wave_sum(ga[q]);
            if (lane < 8) {
                float gv = 0.f;
#pragma unroll
                for (int q = 0; q < 8; ++q) gv = (lane == q) ? ga[q] : gv;
                gv += gate_b[lane];
                const int h = lane & 3, s_ = row % S;
                if (lane < 4) ipre[(size_t)(b * 4 + h) * S + s_] = gv;
                else logf[(size_t)(b * 4 + h) * S + s_] = fminf(gv, 0.f) - log1pf(__expf(-fabsf(gv)));
            }
        }
    }
}

__device__ __forceinline__ void ph_attn_simple(const bf16* __restrict__ proj, bf16* __restrict__ mix, int vb0, int nvb) {
    for (int gid = vb0 * NTHR + threadIdx.x; gid < NB * 8 * S; gid += nvb * NTHR) {
        const int t = gid % S, bh = gid / S, h = bh & 7, b = bh >> 3;
        const bf16* base = proj + (size_t)b * S * NPROJ;
        float q[64], o[64];
        { const v4u* qp = (const v4u*)(base + (size_t)t * NPROJ + C_SBQ + h * 64);
#pragma unroll
          for (int i = 0; i < 8; ++i) { const v4u w = qp[i];
#pragma unroll
              for (int e = 0; e < 4; ++e) { q[i * 8 + 2 * e] = bf2f(w[e] & 0xffffu); q[i * 8 + 2 * e + 1] = bf2f(w[e] >> 16); } } }
#pragma unroll
        for (int d = 0; d < 64; ++d) o[d] = 0.f;
        float carry = 0.f;
        for (int s = t - 1; s >= 0; --s) {
            const v4u* kp = (const v4u*)(base + (size_t)s * NPROJ + C_SBK + h * 64);
            float z = 0.f;
#pragma unroll
            for (int i = 0; i < 8; ++i) { const v4u w = kp[i];
#pragma unroll
                for (int e = 0; e < 4; ++e) { z += q[i * 8 + 2 * e] * bf2f(w[e] & 0xffffu); z += q[i * 8 + 2 * e + 1] * bf2f(w[e] >> 16); } }
            const float sp = fmaxf(z, 0.f) + __log2f(1.f + exp2f(-fabsf(z)));
            carry += sp;
            const float p = exp2f(z - carry);
            const v4u* vp = (const v4u*)(base + (size_t)s * NPROJ + C_SBV + h * 64);
#pragma unroll
            for (int i = 0; i < 8; ++i) { const v4u w = vp[i];
#pragma unroll
                for (int e = 0; e < 4; ++e) { o[i * 8 + 2 * e] += p * bf2f(w[e] & 0xffffu); o[i * 8 + 2 * e + 1] += p * bf2f(w[e] >> 16); } }
            if (carry > SB_THRESH) break;
        }
        v4u* op = (v4u*)(mix + (size_t)(b * S + t) * D + h * 64);
#pragma unroll
        for (int i = 0; i < 8; ++i) { v4u w; w.x = pk2(o[i * 8], o[i * 8 + 1]); w.y = pk2(o[i * 8 + 2], o[i * 8 + 3]); w.z = pk2(o[i * 8 + 4], o[i * 8 + 5]); w.w = pk2(o[i * 8 + 6], o[i * 8 + 7]); op[i] = w; }
    }
}
__device__ __forceinline__ void ph_mlstm_simple(const MArgs& a, unsigned char* smem, int vb0, int nvb) {
    const bf16* proj = (const bf16*)(a.ws + WS_PROJ); const float* conv_w = a.in[5]; const float* conv_b = a.in[6];
    const float* ipre = (const float*)(a.ws + WS_GATES); const float* logf = ipre + 16 * S; float* hraw = (float*)(a.ws + WS_HRAW);
    const int half = threadIdx.x >> 8, tid = threadIdx.x & 255;
    float* sq = (float*)smem + half * 8768; float* sk = sq + 4096; float* sv = sk + 4096; float* sf = sv + 512; float* si = sf + 32;
    for (int it0 = vb0 * 2; it0 < 128; it0 += nvb * 2) {
        const int item = it0 + half, bh = item >> 3, sl = item & 7, b = bh >> 2, h = bh & 3;
        const int r = tid >> 4, c = tid & 15;
        const bf16* base = proj + (size_t)b * S * NPROJ;
        float Cst[8], nst[8];
#pragma unroll
        for (int e = 0; e < 8; ++e) { Cst[e] = 0.f; nst[e] = 0.f; }
        for (int t0 = 0; t0 < S; t0 += 32) {
            __syncthreads();
            for (int i = tid; i < 32 * 128; i += 256) {
                const int tt = i >> 7, d = i & 127, t = t0 + tt, ch = h * 128 + d;
                float yq = conv_b[ch], yk = conv_b[512 + ch];
#pragma unroll
                for (int j = 0; j < 4; ++j) { const int ts = t - 3 + j;
                    if (ts >= 0) { yq += conv_w[j * 1024 + ch] * bf2f(base[(size_t)ts * NPROJ + C_MLQ + ch]); yk += conv_w[j * 1024 + 512 + ch] * bf2f(base[(size_t)ts * NPROJ + C_MLK + ch]); } }
                sq[tt * 128 + d] = siluf_(yq); sk[tt * 128 + d] = siluf_(yk) * 0.08838834764831845f;
            }
            for (int i = tid; i < 32 * 16; i += 256) { const int tt = i >> 4, d = i & 15; sv[tt * 16 + d] = bf2f(base[(size_t)(t0 + tt) * NPROJ + C_MLV + h * 128 + sl * 16 + d]); }
            if (tid < 32) { sf[tid] = __expf(logf[(size_t)bh * S + t0 + tid]); si[tid] = __expf(ipre[(size_t)bh * S + t0 + tid]); }
            __syncthreads();
            for (int tt = 0; tt < 32; ++tt) {
                const float f = sf[tt], iv = si[tt] * sv[tt * 16 + r], ii = si[tt];
                float pn = 0.f, pd = 0.f;
#pragma unroll
                for (int e = 0; e < 8; ++e) { const float kk = sk[tt * 128 + c * 8 + e], qq = sq[tt * 128 + c * 8 + e];
                    Cst[e] = f * Cst[e] + iv * kk; nst[e] = f * nst[e] + ii * kk; pn += Cst[e] * qq; pd += nst[e] * qq; }
#pragma unroll
                for (int o = 1; o < 16; o <<= 1) { pn += __shfl_xor(pn, o); pd += __shfl_xor(pd, o); }
                if (c == 0) hraw[(size_t)(b * S + t0 + tt) * 512 + h * 128 + sl * 16 + r] = pn / fmaxf(fabsf(pd), 1.f);
            }
        }
    }
}
__device__ __forceinline__ void ph_mlnorm(const MArgs& a, int G) {
    const float* hraw = (const float*)(a.ws + WS_HRAW); const bf16* proj = (const bf16*)(a.ws + WS_PROJ); const float* norm_g = a.in[8]; bf16* mix = (bf16*)(a.ws + WS_MIX);
    const int lane = threadIdx.x & 63;
    for (int gw = blockIdx.x * NWAVES + (threadIdx.x >> 6); gw < T * 4; gw += G * NWAVES) {
        const int t = gw >> 2, h = gw & 3;
        const float va = hraw[(size_t)t * 512 + h * 128 + 2 * lane], vb = hraw[(size_t)t * 512 + h * 128 + 2 * lane + 1];
        const float mean = wave_sum(va + vb) * (1.f / 128.f);
        const float da = va - mean, db = vb - mean;
        const float rstd = 1.f / sqrtf(wave_sum(da * da + db * db) * (1.f / 128.f) + LN_EPS);
        const unsigned ow = *(const unsigned*)(proj + (size_t)t * NPROJ + C_MLO + h * 128 + 2 * lane);
        const float o0 = sigmoidf_(bf2f(ow & 0xffffu)), o1 = sigmoidf_(bf2f(ow >> 16));
        const float g0 = norm_g[h * 128 + 2 * lane], g1 = norm_g[h * 128 + 2 * lane + 1];
        *(unsigned*)(mix + (size_t)t * D + 512 + h * 128 + 2 * lane) = pk2(da * rstd * g0 * o0, db * rstd * g1 * o1);
    }
}
__device__ __forceinline__ void ph_ln2(const MArgs& a, int G) {
    const float* x = a.in[0]; const bf16* mixout = (const bf16*)(a.ws + WS_MIXOUT); const float* mod = (const float*)(a.ws + WS_MOD); const float* ln1_g = a.in[10]; const float* ln1_b = a.in[11];
    float* x1 = a.out; bf16* u2 = (bf16*)(a.ws + WS_U2);
    const int tid = threadIdx.x, lane = tid & 63, wave = tid >> 6;
    for (int it = blockIdx.x; it < T / 128; it += G) {
        const int row0 = it * 128, b = row0 / S;
        for (int rr = wave; rr < 128; rr += NWAVES) {
            const int row = row0 + rr;
            f32x4 v[4]; float s = 0.f;
#pragma unroll
            for (int j = 0; j < 4; ++j) {
                const int col = 4 * lane + 256 * j;
                const f32x4 xv = *(const f32x4*)(x + (size_t)row * D + col);
                const f32x4 mo = ld_bf4(mixout + (size_t)row * D + col);
                const f32x4 g1 = *(const f32x4*)(mod + b * 6144 + 2048 + col);
                v[j] = xv * DN_ALPHA + g1 * mo; s += (v[j].x + v[j].y) + (v[j].z + v[j].w);
            }
            float mean = wave_sum(s) * (1.f / D), s2 = 0.f;
#pragma unroll
            for (int j = 0; j < 4; ++j) { v[j] = v[j] - mean; s2 += (v[j].x * v[j].x + v[j].y * v[j].y) + (v[j].z * v[j].z + v[j].w * v[j].w); }
            float rstd = 1.f / sqrtf(wave_sum(s2) * (1.f / D) + LN_EPS);
            s = 0.f;
#pragma unroll
            for (int j = 0; j < 4; ++j) { const int col = 4 * lane + 256 * j;
                v[j] = v[j] * rstd * *(const f32x4*)(ln1_g + col) + *(const f32x4*)(ln1_b + col);
                *(f32x4*)(x1 + (size_t)row * D + col) = v[j]; s += (v[j].x + v[j].y) + (v[j].z + v[j].w); }
            mean = wave_sum(s) * (1.f / D); s2 = 0.f;
#pragma unroll
            for (int j = 0; j < 4; ++j) { v[j] = v[j] - mean; s2 += (v[j].x * v[j].x + v[j].y * v[j].y) + (v[j].z * v[j].z + v[j].w * v[j].w); }
            rstd = 1.f / sqrtf(wave_sum(s2) * (1.f / D) + LN_EPS);
#pragma unroll
            for (int j = 0; j < 4; ++j) { const int col = 4 * lane + 256 * j;
                const f32x4 u = v[j] * rstd * (*(const f32x4*)(mod + b * 6144 + 4096 + col) + 1.0f) + *(const f32x4*)(mod + b * 6144 + 3072 + col);
                *(unsigned long long*)(u2 + (size_t)row * D + col) = (unsigned long long)pk2(u.x, u.y) | ((unsigned long long)pk2(u.z, u.w) << 32); }
        }
    }
}
__device__ __forceinline__ void route_token(int t, const float* __restrict__ logits, const float* __restrict__ rbias, int* __restrict__ tope, float* __restrict__ topg, int* __restrict__ cnt) {
    const float* lg = logits + (size_t)t * NE;
    float gs[8];
#pragma unroll
    for (int g = 0; g < 8; ++g) { float m1 = -INFINITY, m2 = -INFINITY;
        for (int i = 0; i < 32; ++i) { const int e = g * 32 + i; const float v = sigmoidf_(lg[e]) + rbias[e]; if (v > m1) { m2 = m1; m1 = v; } else if (v > m2) m2 = v; }
        gs[g] = m1 + m2; }
    unsigned gmask = 0;
#pragma unroll
    for (int r = 0; r < 4; ++r) { int bi = 0; float bv = -INFINITY;
#pragma unroll
        for (int g = 0; g < 8; ++g) if (!((gmask >> g) & 1u) && gs[g] > bv) { bv = gs[g]; bi = g; }
        gmask |= 1u << bi; }
    float pv = INFINITY; int pi = -1; float gsum = 0.f; int se[8]; float sg[8];
#pragma unroll
    for (int r = 0; r < 8; ++r) { int bi = 0; float bv = -INFINITY, bs = 0.f;
        for (int e = 0; e < NE; ++e) { if (!((gmask >> (e >> 5)) & 1u)) continue;
            const float sc = sigmoidf_(lg[e]), v = sc + rbias[e];
            const bool elig = (v < pv) || (v == pv && e > pi);
            if (elig && v > bv) { bv = v; bi = e; bs = sc; } }
        pv = bv; pi = bi; gsum += bs; se[r] = bi; sg[r] = bs; }
    const float inv = 2.5f / gsum;
#pragma unroll
    for (int r = 0; r < 8; ++r) { const int e = se[r]; tope[t * 8 + r] = e; topg[t * 8 + r] = sg[r] * inv; atomicAdd(cnt + e, 1); }
}
__device__ __forceinline__ void moe_tables(const int* cnt, LAS int* tb, LAS int* nn) {
    if (threadIdx.x < 64) {
        const int lane = threadIdx.x; int n[4], tl[4], loc = 0;
#pragma unroll
        for (int j = 0; j < 4; ++j) { n[j] = cnt[4 * lane + j]; tl[j] = (n[j] + 255) >> 8; loc += tl[j]; }
        int inc = loc;
#pragma unroll
        for (int o = 1; o < 64; o <<= 1) { const int v = __shfl_up(inc, o); if (lane >= o) inc += v; }
        int base = inc - loc;
#pragma unroll
        for (int j = 0; j < 4; ++j) { tb[4 * lane + j] = base; nn[4 * lane + j] = n[j]; base += tl[j]; }
        if (lane == 63) { tb[NE] = base; nn[NE] = T; tb[NEX] = base + T / 256; }
    }
    __syncthreads();
}
__device__ __forceinline__ void ph_final(const MArgs& a, int G) {
    float* out = a.out; const bf16* ys = (const bf16*)(a.ws + WS_YS); const bf16* ysh = (const bf16*)(a.ws + WS_YSH); const float* mod = (const float*)(a.ws + WS_MOD);
    const float* ln2_g = a.in[20]; const float* ln2_b = a.in[21];
    const int tid = threadIdx.x, lane = tid & 63, wave = tid >> 6;
    for (int it = blockIdx.x; it < T / 128; it += G) {
        const int row0 = it * 128, b = row0 / S;
        for (int rr = wave; rr < 128; rr += NWAVES) {
            const int row = row0 + rr;
            f32x4 v[4]; float s = 0.f;
#pragma unroll
            for (int j = 0; j < 4; ++j) { const int col = 4 * lane + 256 * j;
                f32x4 y = ld_bf4(ysh + (size_t)row * D + col);
#pragma unroll
                for (int k = 0; k < 8; ++k) y = y + ld_bf4(ys + ((size_t)row * 8 + k) * D + col);
                v[j] = *(const f32x4*)(out + (size_t)row * D + col) * DN_ALPHA + *(const f32x4*)(mod + b * 6144 + 5120 + col) * y;
                s += (v[j].x + v[j].y) + (v[j].z + v[j].w); }
            const float mean = wave_sum(s) * (1.f / D); float s2 = 0.f;
#pragma unroll
            for (int j = 0; j < 4; ++j) { v[j] = v[j] - mean; s2 += (v[j].x * v[j].x + v[j].y * v[j].y) + (v[j].z * v[j].z + v[j].w * v[j].w); }
            const float rstd = 1.f / sqrtf(wave_sum(s2) * (1.f / D) + LN_EPS);
#pragma unroll
            for (int j = 0; j < 4; ++j) { const int col = 4 * lane + 256 * j;
                *(f32x4*)(out + (size_t)row * D + col) = v[j] * rstd * *(const f32x4*)(ln2_g + col) + *(const f32x4*)(ln2_b + col); }
        }
    }
}


typedef short s16x4 __attribute__((ext_vector_type(4)));
typedef short bf16x8v __attribute__((ext_vector_type(8)));
typedef float f32x16 __attribute__((ext_vector_type(16)));
constexpr int MLP = 320;
constexpr int NCH = S / 64;
constexpr int ST_ELEMS = 129 * 128;
constexpr size_t WS_CHK = WS_GATES + 1 * MiB;
constexpr size_t WS_MPREV = WS_GATES + 1 * MiB + 65536;
constexpr size_t WS_KC = WS_U2;
__device__ __forceinline__ s16x4 tr_read(const LAS unsigned char* p) { return __builtin_bit_cast(s16x4, __builtin_amdgcn_ds_read_tr16_b64_v4i16((LAS s16x4*)p)); }
__device__ __forceinline__ bf16x8v tr_frag(const LAS unsigned char* tile, int row0, int col0, int lane) {
    const int i = lane & 15; const LAS unsigned char* p = tile + (row0 + (i >> 2)) * MLP + (col0 + 4 * (i & 3)) * 2;
    const s16x4 lo = tr_read(p), hi = tr_read(p + 4 * MLP);
    return __builtin_shufflevector(lo, hi, 0, 1, 2, 3, 4, 5, 6, 7);
}
__device__ __forceinline__ bf16x8v tr_frag_perm(const LAS unsigned char* tile, int row0, int col0, int lane) {
    const int i = lane & 15; const LAS unsigned char* p = tile + (row0 + (i >> 2)) * MLP + (col0 + 4 * (i & 3)) * 2;
    const s16x4 lo = tr_read(p), hi = tr_read(p + 8 * MLP);
    return __builtin_shufflevector(lo, hi, 0, 1, 2, 3, 4, 5, 6, 7);
}
__device__ __forceinline__ float wave_incl_sum(float v, int lane) {
#pragma unroll
    for (int o = 1; o < 64; o <<= 1) { const float u = __shfl_up(v, o); if (lane >= o) v += u; }
    return v;
}
__device__ __forceinline__ float wave_incl_max(float v, int lane) {
#pragma unroll
    for (int o = 1; o < 64; o <<= 1) { const float u = __shfl_up(v, o); if (lane >= o) v = fmaxf(v, u); }
    return v;
}
__device__ __forceinline__ float wave_max(float v) {
#pragma unroll
    for (int o = 1; o < 64; o <<= 1) v = fmaxf(v, __shfl_xor(v, o));
    return v;
}
__device__ __forceinline__ void conv8(const bf16* __restrict__ rowp, int spos, const float* __restrict__ cw, const float* __restrict__ cb, float scale, float (&y)[8]) {
    const f32x4 b0 = *(const f32x4*)cb, b1 = *(const f32x4*)(cb + 4);
    y[0] = b0.x; y[1] = b0.y; y[2] = b0.z; y[3] = b0.w; y[4] = b1.x; y[5] = b1.y; y[6] = b1.z; y[7] = b1.w;
#pragma unroll
    for (int j = 0; j < 4; ++j) {
        if (spos - 3 + j >= 0) {
            const v4u xr = *(const v4u*)(rowp + (ptrdiff_t)(j - 3) * NPROJ);
            const f32x4 w0 = *(const f32x4*)(cw + j * 1024), w1 = *(const f32x4*)(cw + j * 1024 + 4);
            y[0] += w0.x * bf2f(xr.x & 0xffffu); y[1] += w0.y * bf2f(xr.x >> 16); y[2] += w0.z * bf2f(xr.y & 0xffffu); y[3] += w0.w * bf2f(xr.y >> 16);
            y[4] += w1.x * bf2f(xr.z & 0xffffu); y[5] += w1.y * bf2f(xr.z >> 16); y[6] += w1.z * bf2f(xr.w & 0xffffu); y[7] += w1.w * bf2f(xr.w >> 16);
        }
    }
#pragma unroll
    for (int e = 0; e < 8; ++e) y[e] = siluf_(y[e]) * scale;
}
__device__ __forceinline__ v4u pack8(const float (&y)[8]) { v4u o; o.x = pk2(y[0], y[1]); o.y = pk2(y[2], y[3]); o.z = pk2(y[4], y[5]); o.w = pk2(y[6], y[7]); return o; }

__device__ __forceinline__ void ml_phaseA(const MArgs& a, LAS unsigned char* lds, int vb0, int nvb) {
    const int tid = threadIdx.x, lane = tid & 63, wave = __builtin_amdgcn_readfirstlane(tid >> 6);
    const bf16* proj = (const bf16*)(a.ws + WS_PROJ); const float* conv_w = a.in[5]; const float* conv_b = a.in[6];
    const float* ipre = (const float*)(a.ws + WS_GATES); const float* logf = ipre + 16 * S;
    bf16* kcg = (bf16*)(a.ws + WS_KC); bf16* st = (bf16*)(a.ws + WS_STATES); float* chk = (float*)(a.ws + WS_CHK);
    LAS unsigned char* Kt = lds; LAS unsigned char* Vt = lds + 64 * MLP; LAS float* wkL = (LAS float*)(lds + 128 * MLP);
    for (int unit = vb0; unit < 16 * NCH; unit += nvb) {
        const int bh = unit >> 7, c = unit & (NCH - 1), b = bh >> 2, h = bh & 3, s0 = c * 64; const size_t row0 = (size_t)b * S + s0;
        if (wave == 0) {
            const float lf = logf[(size_t)bh * S + s0 + lane], ic = ipre[(size_t)bh * S + s0 + lane];
            const float bc = wave_incl_sum(lf, lane), g = ic - bc, gmax = wave_max(g), blast = __shfl(bc, 63);
            wkL[lane] = __expf(g - gmax);
            if (lane == 0) { chk[(size_t)unit * 2] = blast; chk[(size_t)unit * 2 + 1] = blast + gmax; }
        }
#pragma unroll
        for (int q = 0; q < 2; ++q) { const int it = tid + q * NTHR, tt = it >> 4, c8 = it & 15, ch = h * 128 + c8 * 8;
            float y[8]; conv8(proj + (row0 + tt) * NPROJ + C_MLK + ch, s0 + tt, conv_w + 512 + ch, conv_b + 512 + ch, 0.08838834764831845f, y);
            const v4u o = pack8(y);
            *(LAS v4u*)(Kt + tt * MLP + c8 * 16) = o; *(v4u*)(kcg + (row0 + tt) * 512 + ch) = o; }
        __syncthreads();
#pragma unroll
        for (int q = 0; q < 2; ++q) { const int it = tid + q * NTHR, tt = it >> 4, c8 = it & 15;
            const v4u xr = *(const v4u*)(proj + (row0 + tt) * NPROJ + C_MLV + h * 128 + c8 * 8); const float w = wkL[tt];
            float y[8] = {bf2f(xr.x & 0xffffu) * w, bf2f(xr.x >> 16) * w, bf2f(xr.y & 0xffffu) * w, bf2f(xr.y >> 16) * w, bf2f(xr.z & 0xffffu) * w, bf2f(xr.z >> 16) * w, bf2f(xr.w & 0xffffu) * w, bf2f(xr.w >> 16) * w};
            *(LAS v4u*)(Vt + tt * MLP + c8 * 16) = pack8(y); }
        __syncthreads();
        {
            const int dvb = wave >> 1, dkh = wave & 1, hh = lane >> 5, gsel = (lane >> 4) & 1;
            f32x16 acc[2];
#pragma unroll
            for (int nb = 0; nb < 2; ++nb)
#pragma unroll
                for (int i = 0; i < 16; ++i) acc[nb][i] = 0.f;
#pragma unroll
            for (int kk = 0; kk < 4; ++kk) {
                const bf16x8v Bv = tr_frag(Vt, 16 * kk + 8 * hh, 32 * dvb + 16 * gsel, lane);
#pragma unroll
                for (int nb = 0; nb < 2; ++nb) { const bf16x8v Ak = tr_frag(Kt, 16 * kk + 8 * hh, 32 * (2 * dkh + nb) + 16 * gsel, lane);
                    acc[nb] = __builtin_amdgcn_mfma_f32_32x32x16_bf16(Ak, Bv, acc[nb], 0, 0, 0); }
            }
            bf16* stc = st + (size_t)unit * ST_ELEMS;
#pragma unroll
            for (int nb = 0; nb < 2; ++nb)
#pragma unroll
                for (int g4 = 0; g4 < 4; ++g4) { const int dk = 32 * (2 * dkh + nb) + 8 * g4 + 4 * hh, dv = 32 * dvb + (lane & 31);
                    *(unsigned long long*)(stc + (size_t)dv * 128 + dk) = (unsigned long long)pk2(acc[nb][4 * g4], acc[nb][4 * g4 + 1]) | ((unsigned long long)pk2(acc[nb][4 * g4 + 2], acc[nb][4 * g4 + 3]) << 32); }
        }
        if (tid < 128) { float s = 0.f;
#pragma unroll 8
            for (int t = 0; t < 64; ++t) s += wkL[t] * bf2f(*(const LAS unsigned short*)(Kt + t * MLP + tid * 2));
            st[(size_t)unit * ST_ELEMS + 128 * 128 + tid] = (bf16)f2bf(s); }
        __syncthreads();
    }
}

__device__ __forceinline__ void ml_phaseB(const MArgs& a, LAS unsigned char* lds, int G) {
    const int tid = threadIdx.x;
    bf16* st = (bf16*)(a.ws + WS_STATES); const float* chk = (const float*)(a.ws + WS_CHK); float* mprev = (float*)(a.ws + WS_MPREV);
    LAS float* al = (LAS float*)lds; LAS float* be = al + NCH;
    constexpr int NSL = (ST_ELEMS + 1023) / 1024;
    for (int item = blockIdx.x; item < 16 * NSL; item += G) {
        const int bh = item / NSL, sl = item % NSL;
        __syncthreads();
        if (tid == 0) { float m = 0.f;
            for (int c = 0; c < NCH; ++c) { const float bl = chk[(size_t)(bh * NCH + c) * 2], M = chk[(size_t)(bh * NCH + c) * 2 + 1];
                const float mn = fmaxf(bl + m, M); al[c] = __expf(bl + m - mn); be[c] = __expf(M - mn);
                if (sl == 0) mprev[bh * NCH + c] = m;
                m = mn; } }
        __syncthreads();
        const int off = sl * 1024 + tid * 2;
        if (off < ST_ELEMS) {
            unsigned* p = (unsigned*)(st + (size_t)bh * NCH * ST_ELEMS + off);
            float c0 = 0.f, c1 = 0.f;
            for (int cb = 0; cb < NCH; cb += 16) { unsigned d[16];
#pragma unroll
                for (int j = 0; j < 16; ++j) d[j] = p[(size_t)(cb + j) * (ST_ELEMS / 2)];
#pragma unroll
                for (int j = 0; j < 16; ++j) { p[(size_t)(cb + j) * (ST_ELEMS / 2)] = pk2(c0, c1);
                    c0 = al[cb + j] * c0 + be[cb + j] * bf2f(d[j] & 0xffffu); c1 = al[cb + j] * c1 + be[cb + j] * bf2f(d[j] >> 16); } }
        }
    }
}

__device__ __forceinline__ void ml_phaseC(const MArgs& a, LAS unsigned char* lds, int G) {
    const int tid = threadIdx.x, lane = tid & 63, wave = __builtin_amdgcn_readfirstlane(tid >> 6);
    const bf16* proj = (const bf16*)(a.ws + WS_PROJ); const float* conv_w = a.in[5]; const float* conv_b = a.in[6]; const float* norm_g = a.in[8];
    const float* ipre = (const float*)(a.ws + WS_GATES); const float* logf = ipre + 16 * S;
    const bf16* kcg = (const bf16*)(a.ws + WS_KC); const bf16* st = (const bf16*)(a.ws + WS_STATES); const float* mprev = (const float*)(a.ws + WS_MPREV);
    bf16* mix = (bf16*)(a.ws + WS_MIX);
    LAS unsigned char* Qt = lds; LAS unsigned char* Kt = lds + 64 * MLP; LAS unsigned char* Vt = lds + 128 * MLP; LAS unsigned char* Ct = lds + 192 * MLP;
    LAS float* sc = (LAS float*)(lds + 320 * MLP);
    LAS float* gL = sc; LAS float* mmL = sc + 64; LAS float* siL = sc + 128; LAS float* emL = sc + 192; LAS float* npv = sc + 256; LAS float* lnS = sc + 384;
    const int tb = wave >> 2, dvb = wave & 3, r = lane & 31, hh = lane >> 5, gsel = (lane >> 4) & 1;
    for (int unit = blockIdx.x; unit < 16 * NCH; unit += G) {
        const int bh = unit >> 7, c = unit & (NCH - 1), b = bh >> 2, h = bh & 3, s0 = c * 64; const size_t row0 = (size_t)b * S + s0;
        if (wave == 0) {
            const float lf = logf[(size_t)bh * S + s0 + lane], ic = ipre[(size_t)bh * S + s0 + lane], mp = mprev[unit];
            const float bc = wave_incl_sum(lf, lane), g = ic - bc, pm = wave_incl_max(g, lane), mm = fmaxf(mp, pm);
            gL[lane] = g; mmL[lane] = mm; siL[lane] = __expf(mp - mm); emL[lane] = __expf(-(bc + mm));
        }
        const bf16* stc = st + (size_t)unit * ST_ELEMS;
#pragma unroll
        for (int q = 0; q < 2; ++q) { const int it = tid + q * NTHR, tt = it >> 4, c8 = it & 15, ch = h * 128 + c8 * 8;
            float y[8]; conv8(proj + (row0 + tt) * NPROJ + C_MLQ + ch, s0 + tt, conv_w + ch, conv_b + ch, 1.f, y);
            *(LAS v4u*)(Qt + tt * MLP + c8 * 16) = pack8(y);
            *(LAS v4u*)(Kt + tt * MLP + c8 * 16) = *(const v4u*)(kcg + (row0 + tt) * 512 + ch);
            *(LAS v4u*)(Vt + tt * MLP + c8 * 16) = *(const v4u*)(proj + (row0 + tt) * NPROJ + C_MLV + ch); }
#pragma unroll
        for (int q = 0; q < 4; ++q) { const int it = tid + q * NTHR, dv = it >> 4, c8 = it & 15;
            *(LAS v4u*)(Ct + dv * MLP + c8 * 16) = *(const v4u*)(stc + dv * 128 + c8 * 8); }
        if (tid < 128) npv[tid] = bf2f(stc[128 * 128 + tid]);
        __syncthreads();
        bf16x8v qf[8];
#pragma unroll
        for (int kk = 0; kk < 8; ++kk) qf[kk] = *(const LAS bf16x8v*)(Qt + (32 * tb + r) * MLP + (16 * kk + 8 * hh) * 2);
        const float mm_t = mmL[32 * tb + r], si_t = siL[32 * tb + r], em_t = emL[32 * tb + r];
        float nq = 0.f;
#pragma unroll
        for (int kk = 0; kk < 8; ++kk) { const f32x4 n0 = *(const LAS f32x4*)(npv + 16 * kk + 8 * hh), n1 = *(const LAS f32x4*)(npv + 16 * kk + 8 * hh + 4);
            nq += n0.x * bf2f((unsigned short)qf[kk][0]) + n0.y * bf2f((unsigned short)qf[kk][1]) + n0.z * bf2f((unsigned short)qf[kk][2]) + n0.w * bf2f((unsigned short)qf[kk][3])
                + n1.x * bf2f((unsigned short)qf[kk][4]) + n1.y * bf2f((unsigned short)qf[kk][5]) + n1.z * bf2f((unsigned short)qf[kk][6]) + n1.w * bf2f((unsigned short)qf[kk][7]); }
        nq += __shfl_xor(nq, 32);
        f32x16 num;
#pragma unroll
        for (int i = 0; i < 16; ++i) num[i] = 0.f;
#pragma unroll
        for (int kk = 0; kk < 8; ++kk) { const bf16x8v Ac = *(const LAS bf16x8v*)(Ct + (32 * dvb + r) * MLP + (16 * kk + 8 * hh) * 2);
            num = __builtin_amdgcn_mfma_f32_32x32x16_bf16(Ac, qf[kk], num, 0, 0, 0); }
#pragma unroll
        for (int i = 0; i < 16; ++i) num[i] *= si_t;
        float wsum = 0.f;
        for (int sb = 0; sb <= tb; ++sb) {
            f32x16 sT;
#pragma unroll
            for (int i = 0; i < 16; ++i) sT[i] = 0.f;
#pragma unroll
            for (int kk = 0; kk < 8; ++kk) { const bf16x8v Ak = *(const LAS bf16x8v*)(Kt + (32 * sb + r) * MLP + (16 * kk + 8 * hh) * 2);
                sT = __builtin_amdgcn_mfma_f32_32x32x16_bf16(Ak, qf[kk], sT, 0, 0, 0); }
            unsigned wp[8];
#pragma unroll
            for (int g4 = 0; g4 < 4; ++g4) { const f32x4 gv = *(const LAS f32x4*)(gL + 32 * sb + 8 * g4 + 4 * hh);
                float w[4];
#pragma unroll
                for (int e = 0; e < 4; ++e) { const int srow = 32 * sb + 8 * g4 + 4 * hh + e; const bool valid = srow <= 32 * tb + r;
                    w[e] = valid ? sT[4 * g4 + e] * __expf(gv[e] - mm_t) : 0.f; wsum += w[e]; }
                wp[2 * g4] = pk2(w[0], w[1]); wp[2 * g4 + 1] = pk2(w[2], w[3]); }
#pragma unroll
            for (int s2 = 0; s2 < 2; ++s2) {
                const bf16x8v Av = tr_frag_perm(Vt, 32 * sb + 16 * s2 + 4 * hh, 32 * dvb + 16 * gsel, lane);
                v4u bw; bw.x = wp[4 * s2]; bw.y = wp[4 * s2 + 1]; bw.z = wp[4 * s2 + 2]; bw.w = wp[4 * s2 + 3];
                num = __builtin_amdgcn_mfma_f32_32x32x16_bf16(Av, __builtin_bit_cast(bf16x8v, bw), num, 0, 0, 0); }
        }
        wsum += __shfl_xor(wsum, 32);
        const float den = si_t * nq + wsum, rden = 1.f / fmaxf(fabsf(den), em_t);
        float ps = 0.f, pq = 0.f;
#pragma unroll
        for (int i = 0; i < 16; ++i) { num[i] *= rden; ps += num[i]; pq += num[i] * num[i]; }
        ps += __shfl_xor(ps, 32); pq += __shfl_xor(pq, 32);
        if (hh == 0) { lnS[((tb * 4 + dvb) * 32 + r) * 2] = ps; lnS[((tb * 4 + dvb) * 32 + r) * 2 + 1] = pq; }
        __syncthreads();
        float ts = 0.f, tq = 0.f;
#pragma unroll
        for (int d = 0; d < 4; ++d) { ts += lnS[((tb * 4 + d) * 32 + r) * 2]; tq += lnS[((tb * 4 + d) * 32 + r) * 2 + 1]; }
        const float mean = ts * (1.f / 128.f), rstd = 1.f / sqrtf(fmaxf(tq * (1.f / 128.f) - mean * mean, 0.f) + LN_EPS);
        const size_t trow = row0 + 32 * tb + r;
#pragma unroll
        for (int g4 = 0; g4 < 4; ++g4) { const int dv = 32 * dvb + 8 * g4 + 4 * hh;
            const f32x4 ng = *(const f32x4*)(norm_g + h * 128 + dv); const f32x4 og = ld_bf4(proj + trow * NPROJ + C_MLO + h * 128 + dv);
            float o[4];
#pragma unroll
            for (int e = 0; e < 4; ++e) o[e] = (num[4 * g4 + e] - mean) * rstd * ng[e] * sigmoidf_(og[e]);
            *(unsigned long long*)(mix + trow * D + 512 + h * 128 + dv) = (unsigned long long)pk2(o[0], o[1]) | ((unsigned long long)pk2(o[2], o[3]) << 32); }
        __syncthreads();
    }
}

__global__ void __launch_bounds__(NTHR, 2) mega_fwd(MArgs args) {
    extern __shared__ __attribute__((aligned(16))) unsigned char lds[];
    LAS unsigned char* ldsl = (LAS unsigned char*)lds;
    const int tid = threadIdx.x, G = gridDim.x;
    volatile LAS unsigned* MISC = (volatile LAS unsigned*)(ldsl + XTRA_OFF + X_MISC);
    LAS int* tb = (LAS int*)(ldsl + XTRA_OFF + X_TB); LAS int* nn = (LAS int*)(ldsl + XTRA_OFF + X_NN);
    for (int u = tid; u < (LDS_BYTES - XTRA_OFF) / 4; u += NTHR) ((LAS unsigned*)(ldsl + XTRA_OFF))[u] = 0u;
    __syncthreads();
    unsigned char* ws = args.ws;
    unsigned* ctl = (unsigned*)(ws + WS_CTL);
    XcdBarrier bar = xcd_barrier_post(ctl + CW_BAR, MISC + 8);
    const int lo = args.ph_lo, hi = args.ph_hi;
#define IN(k) (lo <= (k) && (k) < hi)
#define SEAM(k) do { if (IN(k) && IN((k) + 1)) xcd_barrier(bar); } while (0)
    if (IN(0)) ph_mod_prep(args, lds, G);
    SEAM(0);
    if (IN(1)) ph_ln1(args, lds, G);
    SEAM(1);
    if (IN(2)) { pg8::StaticOrder So; So.init(ws + WS_U1, ws + WS_WTIN, T, NPROJ, D, G, blockIdx.x);
        pg8::EpiBf16 E{(bf16*)(ws + WS_PROJ), NPROJ, 2, QSCALE};
        pg8::gemm_phase<pg8::EpiBf16, pg8::StaticOrder, false>(ldsl, D, So, E); }
    SEAM(2);
    if (IN(3)) { ml_phaseA(args, ldsl, blockIdx.x, G); ph_attn_simple((const bf16*)(ws + WS_PROJ), (bf16*)(ws + WS_MIX), blockIdx.x, G); }
    SEAM(3);
    if (IN(4)) ml_phaseB(args, ldsl, G);
    SEAM(4);
    if (IN(5)) ml_phaseC(args, ldsl, G);
    SEAM(5);
    if (IN(6)) { pg8::StaticOrder So; So.init(ws + WS_MIX, ws + WS_WTOUT, T, D, D, G, blockIdx.x);
        pg8::EpiBf16 E{(bf16*)(ws + WS_MIXOUT), D, 0, 1.f};
        pg8::gemm_phase<pg8::EpiBf16, pg8::StaticOrder, false>(ldsl, D, So, E); }
    SEAM(6);
    if (IN(7)) ph_ln2(args, G);
    SEAM(7);
    if (IN(8)) { pg8::StaticOrder So; So.init(ws + WS_U2, ws + WS_WTR, T, NE, D, G, blockIdx.x);
        pg8::EpiF32 E{(float*)(ws + WS_LOGITS), NE};
        pg8::gemm_phase<pg8::EpiF32, pg8::StaticOrder, false>(ldsl, D, So, E); }
    SEAM(8);
    int* cnt = (int*)ctl + CW_CNT; i32x2* list = (i32x2*)(ws + WS_ROUTE + 2 * MiB); float* topg = (float*)(ws + WS_ROUTE + 1 * MiB);
    if (IN(9)) { for (int t = blockIdx.x * NTHR + tid; t < T; t += G * NTHR) route_token(t, (const float*)(ws + WS_LOGITS), args.in[13], (int*)(ws + WS_ROUTE), topg, cnt); }
    SEAM(9);
    if (IN(10)) { moe_tables(cnt, tb, nn); const int* tope = (const int*)(ws + WS_ROUTE); int* fill = (int*)ctl + CW_FILL;
        for (int id = blockIdx.x * NTHR + tid; id < T * TOPK; id += G * NTHR) { const int e = tope[id]; const int pos = atomicAdd(fill + e, 1);
            list[tb[e] * 256 + pos] = (i32x2){id, __float_as_int(topg[id])}; } }
    SEAM(10);
    if (IN(11)) { moe_tables(cnt, tb, nn);
        pg8::MoeOrder So{G, (int)blockIdx.x, tb[NEX] * 2, 1, tb, nn, list, (const char*)(ws + WS_U2), 0, (const char*)(ws + WS_WT13), (size_t)512 * D * 2, (size_t)256 * D * 2};
        pg8::EpiGlu E{(bf16*)(ws + WS_H)};
        pg8::gemm_phase<pg8::EpiGlu, pg8::MoeOrder, true>(ldsl, D, So, E); }
    SEAM(11);
    if (IN(12)) { moe_tables(cnt, tb, nn);
        pg8::MoeOrder So{G, (int)blockIdx.x, tb[NEX] * 4, 2, tb, nn, list, (const char*)(ws + WS_H), (size_t)256 * FF * 2, (const char*)(ws + WS_WT2), (size_t)D * FF * 2, (size_t)256 * FF * 2};
        pg8::EpiScatter E{(bf16*)(ws + WS_YS), (bf16*)(ws + WS_YSH), list, nn};
        pg8::gemm_phase<pg8::EpiScatter, pg8::MoeOrder, false>(ldsl, FF, So, E); }
    SEAM(12);
    if (IN(13)) ph_final(args, G);
#undef IN
#undef SEAM
}

#ifndef MK_UPTO
#define MK_UPTO 14
#endif
__global__ void k_nan_fill(float* out, int n) { for (int i = blockIdx.x * blockDim.x + threadIdx.x; i < n; i += gridDim.x * blockDim.x) out[i] = __builtin_nanf(""); }
extern "C" void kernel_launch(void* const* d_in, const int* in_sizes, int n_in, void* d_out, int out_size, void* d_ws, size_t ws_size, hipStream_t stream) {
    static int grid = 0;
    if (grid == 0) {
        int dev = 0, cus = 0, per_cu = 0; grid = -1;
        if (n_in != 22 || out_size != T * D || ws_size < WS_END) fprintf(stderr, "kernel_launch: unexpected shapes (n_in %d out %d ws %zu, need %zu)\n", n_in, out_size, ws_size, (size_t)WS_END);
        else if (hipGetDevice(&dev) != hipSuccess || hipDeviceGetAttribute(&cus, hipDeviceAttributeMultiprocessorCount, dev) != hipSuccess) fprintf(stderr, "kernel_launch: device query failed\n");
        else if (hipFuncSetAttribute((const void*)mega_fwd, hipFuncAttributeMaxDynamicSharedMemorySize, LDS_BYTES) != hipSuccess) fprintf(stderr, "kernel_launch: hipFuncSetAttribute failed\n");
        else if (hipOccupancyMaxActiveBlocksPerMultiprocessor(&per_cu, (const void*)mega_fwd, NTHR, LDS_BYTES) != hipSuccess || per_cu < 1) fprintf(stderr, "kernel_launch: occupancy query says %d blocks per CU\n", per_cu);
        else grid = cus;
        (void)hipGetLastError();
    }
    if (grid < 0) { k_nan_fill<<<1024, 256, 0, stream>>>((float*)d_out, out_size); return; }
    const float* x = (const float*)d_in[0];
    const float* conv_w = (const float*)d_in[5]; const float* conv_b = (const float*)d_in[6];
    const float* norm_g = (const float*)d_in[8]; const float* ln1_g = (const float*)d_in[10]; const float* ln1_b = (const float*)d_in[11];
    const float* rbias = (const float*)d_in[13]; const float* ln2_g = (const float*)d_in[20]; const float* ln2_b = (const float*)d_in[21];
    char* ws = (char*)d_ws; float* out = (float*)d_out;
    float* mod = (float*)(ws + WS_MOD); bf16* wtin = (bf16*)(ws + WS_WTIN); bf16* wtout = (bf16*)(ws + WS_WTOUT); bf16* wtr = (bf16*)(ws + WS_WTR);
    bf16* wt13 = (bf16*)(ws + WS_WT13); bf16* wt2 = (bf16*)(ws + WS_WT2); int* plan = (int*)(ws + WS_PLAN);
    bf16* u1 = (bf16*)(ws + WS_U1); bf16* proj = (bf16*)(ws + WS_PROJ); float* ipre = (float*)(ws + WS_GATES); float* logf = ipre + 16 * S;
    float* hraw = (float*)(ws + WS_HRAW); bf16* mix = (bf16*)(ws + WS_MIX); bf16* mixout = (bf16*)(ws + WS_MIXOUT); bf16* u2 = (bf16*)(ws + WS_U2);
    float* logits = (float*)(ws + WS_LOGITS); int* tope = (int*)(ws + WS_ROUTE); float* topg = (float*)(ws + WS_ROUTE + 1 * MiB); i32x2* list = (i32x2*)(ws + WS_ROUTE + 2 * MiB);
    bf16* H = (bf16*)(ws + WS_H); bf16* ys = (bf16*)(ws + WS_YS); bf16* ysh = (bf16*)(ws + WS_YSH);
    int* cnt = (int*)(ws + WS_CTL) + CW_CNT;
    (void)hipMemsetAsync(ws + WS_CTL, 0, 1 * MiB, stream);
    if (MK_UPTO > 0) {
        MArgs a{};
        for (int i = 0; i < 22; ++i) a.in[i] = (const float*)d_in[i];
        a.out = out; a.ws = (unsigned char*)d_ws; a.ph_lo = 0; a.ph_hi = MK_UPTO;
        hipLaunchKernelGGL(mega_fwd, dim3(grid), dim3(NTHR), LDS_BYTES, stream, a);
    }
    if (MK_UPTO <= 0) { k_mod<<<192, 512, 0, stream>>>((const float*)d_in[1], (const float*)d_in[2], (const float*)d_in[3], mod);
        PrepArgs pa{(const float*)d_in[4], (const float*)d_in[9], (const float*)d_in[12], (const float*)d_in[14], (const float*)d_in[15], (const float*)d_in[16], (const float*)d_in[17], (const float*)d_in[18], (const float*)d_in[19], wtin, wtout, wtr, wt13, wt2};
        k_prep<<<2048, 512, 0, stream>>>(pa); }
    if (MK_UPTO <= 1) k_ln1<<<T / 128, 512, 0, stream>>>(x, mod, (const float*)d_in[4], (const float*)d_in[7], u1, ipre, logf);
    if (MK_UPTO <= 2) k_ngemm<0><<<dim3(NPROJ / 64, T / 64), 256, 0, stream>>>(u1, wtin, proj, T, NPROJ, D, NPROJ, 512, QSCALE);
    if (MK_UPTO <= 3) { k_attn_naive<<<NB * 8 * S / 256, 256, 0, stream>>>(proj, mix); k_mlstm_naive<<<128, 256, 0, stream>>>(proj, conv_w, conv_b, ipre, logf, hraw);
        k_mlnorm_naive<<<T, 256, 0, stream>>>(hraw, proj, norm_g, mix); }
    if (MK_UPTO <= 6) k_ngemm<0><<<dim3(D / 64, T / 64), 256, 0, stream>>>(mix, wtout, mixout, T, D, D, D, 0, 1.f);
    if (MK_UPTO <= 7) k_ln2<<<T / 128, 512, 0, stream>>>(x, mixout, mod, ln1_g, ln1_b, out, u2);
    if (MK_UPTO <= 8) k_ngemm<1><<<dim3(NE / 64, T / 64), 256, 0, stream>>>(u2, wtr, logits, T, NE, D, NE, 0, 1.f);
    if (MK_UPTO <= 9) k_route<<<T / 256, 256, 0, stream>>>(logits, rbias, tope, topg, cnt);
    constexpr int MAXT64 = T * TOPK / 64 + NE + T / 64;
    if (MK_UPTO <= 12) k_plan<<<1, 64, 0, stream>>>(cnt, plan);
    if (MK_UPTO <= 10) k_fill<<<T * TOPK / 256, 256, 0, stream>>>(tope, topg, plan, cnt + (CW_FILL - CW_CNT), list);
    if (MK_UPTO <= 11) k_moe1_naive<<<dim3(4, MAXT64), 256, 0, stream>>>(u2, wt13, cnt, plan, list, H);
    if (MK_UPTO <= 12) k_moe2_naive<<<dim3(16, MAXT64), 256, 0, stream>>>(H, wt2, cnt, plan, list, topg, ys, ysh);
    if (MK_UPTO <= 13) k_final<<<T / 128, 512, 0, stream>>>(out, ys, ysh, mod, ln2_g, ln2_b);
}
```

```cpp
#include <hip/hip_runtime.h>
#include <cstdio>
#include <cstdint>

typedef unsigned short bf16;
typedef unsigned v4u __attribute__((ext_vector_type(4)));
typedef float f32x4 __attribute__((ext_vector_type(4)));
typedef int i32x2 __attribute__((ext_vector_type(2)));

constexpr int D = 1024, NB = 4, S = 8192, T = NB * S;
constexpr int NPROJ = 3584, WIN_LD = 3592;
constexpr int C_SBQ = 0, C_SBK = 512, C_SBV = 1024, C_MLQ = 1536, C_MLK = 2048, C_MLV = 2560, C_MLO = 3072, C_GATE = 3584;
constexpr int NE = 256, NEX = 257, TOPK = 8, FF = 256;
constexpr float LN_EPS = 1e-5f;
constexpr float DN_ALPHA = 1.189207115002721f;
constexpr float LOG2E = 1.4426950408889634f;
constexpr float QSCALE = 0.125f * LOG2E;
constexpr float SB_THRESH = 48.0f;

constexpr size_t MiB = 1u << 20;
constexpr size_t WS_CTL = 0;
constexpr size_t WS_MOD = 1 * MiB;
constexpr size_t WS_WTIN = 2 * MiB;
constexpr size_t WS_WTOUT = 10 * MiB;
constexpr size_t WS_WTR = 12 * MiB;
constexpr size_t WS_PLAN = 13 * MiB;
constexpr size_t WS_WT2 = 16 * MiB;
constexpr size_t WS_YS = 145 * MiB;
constexpr size_t WS_WT13 = 145 * MiB;
constexpr size_t WS_PROJ = 402 * MiB;
constexpr size_t WS_GATES = 626 * MiB;
constexpr size_t WS_H = 657 * MiB;
constexpr size_t WS_STATES = 657 * MiB;
constexpr size_t WS_MIXOUT = 657 * MiB;
constexpr size_t WS_LOGITS = 657 * MiB;
constexpr size_t WS_U1 = 725 * MiB;
constexpr size_t WS_MIX = 725 * MiB;
constexpr size_t WS_U2 = 833 * MiB;
constexpr size_t WS_YSH = 833 * MiB;
constexpr size_t WS_HRAW = 833 * MiB;
constexpr size_t WS_ROUTE = 897 * MiB;
constexpr size_t WS_END = 902 * MiB;
constexpr int CW_CNT = 1024;
constexpr int CW_FILL = 1536;
constexpr int PL_SLOT = 0, PL_T64 = 512, PL_T256 = 1024;

__device__ __forceinline__ unsigned f2bf(float f) { unsigned u = __builtin_bit_cast(unsigned, f); return (u + 0x7fffu + ((u >> 16) & 1u)) >> 16; }
__device__ __forceinline__ float bf2f(unsigned b) { return __builtin_bit_cast(float, b << 16); }
__device__ __forceinline__ unsigned pk2(float lo, float hi) { return f2bf(lo) | (f2bf(hi) << 16); }
__device__ __forceinline__ float wave_sum(float v) {
#pragma unroll
    for (int o = 1; o < 64; o <<= 1) v += __shfl_xor(v, o);
    return v;
}
__device__ __forceinline__ float sigmoidf_(float x) { return 1.f / (1.f + __expf(-x)); }
__device__ __forceinline__ float siluf_(float x) { return x / (1.f + __expf(-x)); }

__global__ void __launch_bounds__(512) k_mod(const float* __restrict__ c, const float* __restrict__ w_ada, const float* __restrict__ b_ada, float* __restrict__ mod) {
    __shared__ float sc[NB][D];
    __shared__ float red[16][NB][32];
    const int tid = threadIdx.x;
    for (int i = tid; i < NB * D; i += 512) sc[i / D][i % D] = siluf_(c[i]);
    __syncthreads();
    const int kq = tid >> 5, jl = tid & 31, j = blockIdx.x * 32 + jl;
    float a0 = 0.f, a1 = 0.f, a2 = 0.f, a3 = 0.f;
#pragma unroll 16
    for (int kk = 0; kk < 64; ++kk) { const int k = kq * 64 + kk; const float w = w_ada[(size_t)k * 6144 + j];
        a0 += sc[0][k] * w; a1 += sc[1][k] * w; a2 += sc[2][k] * w; a3 += sc[3][k] * w; }
    red[kq][0][jl] = a0; red[kq][1][jl] = a1; red[kq][2][jl] = a2; red[kq][3][jl] = a3;
    __syncthreads();
    if (tid < 128) { const int b = tid >> 5; float s = b_ada[j];
#pragma unroll
        for (int q = 0; q < 16; ++q) s += red[q][b][jl];
        mod[b * 6144 + j] = s; }
}

__device__ __forceinline__ void transpose_item(const float* __restrict__ W, int ldw, bf16* __restrict__ WT, int ldt, int k0, int n0, int rowmap, int lane) {
    const int g = lane >> 4, i = lane & 15;
    f32x4 v[8];
#pragma unroll
    for (int r = 0; r < 8; ++r) v[r] = *(const f32x4*)(W + (size_t)(k0 + 8 * g + r) * ldw + n0 + 4 * i);
#pragma unroll
    for (int nn = 0; nn < 4; ++nn) {
        const int n = n0 + 4 * i + nn;
        const int dr = rowmap == 0 ? n : ((n >> 7) * 256 + (rowmap == 2 ? 128 : 0) + (n & 127));
        v4u o; o.x = pk2(v[0][nn], v[1][nn]); o.y = pk2(v[2][nn], v[3][nn]); o.z = pk2(v[4][nn], v[5][nn]); o.w = pk2(v[6][nn], v[7][nn]);
        *(v4u*)(WT + (size_t)dr * ldt + k0 + 8 * g) = o;
    }
}
struct PrepArgs { const float *w_in, *w_out, *w_router, *w1, *w3, *w2, *sw1, *sw3, *sw2; bf16 *wtin, *wtout, *wtr, *wt13, *wt2; };
constexpr int IT_IN = 32 * 56, IT_OUT = 32 * 16, IT_R = 32 * 4, IT_E = 384, IT_TOTAL = IT_IN + IT_OUT + IT_R + NEX * IT_E;
__device__ __forceinline__ void prep_item(const PrepArgs& a, int it, int lane) {
    if (it < IT_IN) { transpose_item(a.w_in, WIN_LD, a.wtin, D, (it / 56) * 32, (it % 56) * 64, 0, lane); return; } it -= IT_IN;
    if (it < IT_OUT) { transpose_item(a.w_out, D, a.wtout, D, (it / 16) * 32, (it % 16) * 64, 0, lane); return; } it -= IT_OUT;
    if (it < IT_R) { transpose_item(a.w_router, NE, a.wtr, D, (it / 4) * 32, (it % 4) * 64, 0, lane); return; } it -= IT_R;
    const int e = it / IT_E, r = it % IT_E;
    const float* p1 = e < NE ? a.w1 + (size_t)e * D * FF : a.sw1; const float* p3 = e < NE ? a.w3 + (size_t)e * D * FF : a.sw3; const float* p2 = e < NE ? a.w2 + (size_t)e * FF * D : a.sw2;
    bf16* d13 = a.wt13 + (size_t)e * 512 * D; bf16* d2 = a.wt2 + (size_t)e * D * FF;
    if (r < 128) { transpose_item(p1, FF, d13, D, (r / 4) * 32, (r % 4) * 64, 1, lane); return; }
    if (r < 256) { const int q = r - 128; transpose_item(p3, FF, d13, D, (q / 4) * 32, (q % 4) * 64, 2, lane); return; }
    { const int q = r - 256; transpose_item(p2, D, d2, FF, (q / 16) * 32, (q % 16) * 64, 0, lane); }
}
__global__ void __launch_bounds__(512) k_prep(PrepArgs a) {
    const int lane = threadIdx.x & 63, gw = blockIdx.x * 8 + (threadIdx.x >> 6), ngw = gridDim.x * 8;
    for (int it = gw; it < IT_TOTAL; it += ngw) prep_item(a, it, lane);
}

__global__ void __launch_bounds__(512) k_ln1(const float* __restrict__ x, const float* __restrict__ mod, const float* __restrict__ w_in, const float* __restrict__ gate_b,
                                              bf16* __restrict__ u1, float* __restrict__ ipre, float* __restrict__ logf) {
    __shared__ float wg[D][8];
    const int tid = threadIdx.x, lane = tid & 63, wave = tid >> 6;
    for (int i = tid; i < D * 8; i += 512) wg[i >> 3][i & 7] = w_in[(size_t)(i >> 3) * WIN_LD + C_GATE + (i & 7)];
    __syncthreads();
    const int row0 = blockIdx.x * 128, b = row0 / S;
    f32x4 sh[4], sc[4];
#pragma unroll
    for (int j = 0; j < 4; ++j) { sh[j] = *(const f32x4*)(mod + b * 6144 + 4 * lane + 256 * j); sc[j] = *(const f32x4*)(mod + b * 6144 + 1024 + 4 * lane + 256 * j); }
    for (int rr = wave; rr < 128; rr += 8) {
        const int row = row0 + rr;
        const f32x4* xr = (const f32x4*)(x + (size_t)row * D) + lane;
        f32x4 v[4]; float s = 0.f;
#pragma unroll
        for (int j = 0; j < 4; ++j) { v[j] = xr[64 * j]; s += (v[j].x + v[j].y) + (v[j].z + v[j].w); }
        const float mean = wave_sum(s) * (1.f / D); float s2 = 0.f;
#pragma unroll
        for (int j = 0; j < 4; ++j) { v[j] = v[j] - mean; s2 += (v[j].x * v[j].x + v[j].y * v[j].y) + (v[j].z * v[j].z + v[j].w * v[j].w); }
        const float rstd = 1.f / sqrtf(wave_sum(s2) * (1.f / D) + LN_EPS);
        float ga[8];
#pragma unroll
        for (int q = 0; q < 8; ++q) ga[q] = 0.f;
        unsigned long long* o8 = (unsigned long long*)(u1 + (size_t)row * D) + lane;
#pragma unroll
        for (int j = 0; j < 4; ++j) {
            f32x4 u = v[j] * rstd * (sc[j] + 1.0f) + sh[j];
            o8[64 * j] = (unsigned long long)pk2(u.x, u.y) | ((unsigned long long)pk2(u.z, u.w) << 32);
#pragma unroll
            for (int e = 0; e < 4; ++e) { const int k = 4 * lane + 256 * j + e;
#pragma unroll
                for (int q = 0; q < 8; ++q) ga[q] += u[e] * wg[k][q]; }
        }
#pragma unroll
        for (int q = 0; q < 8; ++q) ga[q] = wave_sum(ga[q]);
        if (lane < 8) {
            float gv = 0.f;
#pragma unroll
            for (int q = 0; q < 8; ++q) gv = (lane == q) ? ga[q] : gv;
            gv += gate_b[lane];
            const int h = lane & 3, s_ = row % S;
            if (lane < 4) ipre[(size_t)(b * 4 + h) * S + s_] = gv;
            else { const float ls = fminf(gv, 0.f) - log1pf(__expf(-fabsf(gv))); logf[(size_t)(b * 4 + h) * S + s_] = ls; }
        }
    }
}

template <class ARow, class BRow>
__device__ __forceinline__ void ngemm_tile(ARow arow, BRow brow, int K, float (&acc)[4][4], float* sA, float* sB) {
    const int tid = threadIdx.x, ty = tid >> 4, tx = tid & 15;
    const int lr = tid >> 2, lk = (tid & 3) * 8;
    const bf16* ap = arow(lr); const bf16* bp = brow(lr);
#pragma unroll
    for (int i = 0; i < 4; ++i)
#pragma unroll
        for (int j = 0; j < 4; ++j) acc[i][j] = 0.f;
    for (int k0 = 0; k0 < K; k0 += 32) {
        v4u av = {0u, 0u, 0u, 0u}, bv = {0u, 0u, 0u, 0u};
        if (ap) av = *(const v4u*)(ap + k0 + lk);
        if (bp) bv = *(const v4u*)(bp + k0 + lk);
        __syncthreads();
#pragma unroll
        for (int q = 0; q < 4; ++q) {
            sA[(lk + 2 * q) * 68 + lr] = bf2f(av[q] & 0xffffu); sA[(lk + 2 * q + 1) * 68 + lr] = bf2f(av[q] >> 16);
            sB[(lk + 2 * q) * 68 + lr] = bf2f(bv[q] & 0xffffu); sB[(lk + 2 * q + 1) * 68 + lr] = bf2f(bv[q] >> 16);
        }
        __syncthreads();
#pragma unroll 8
        for (int kk = 0; kk < 32; ++kk) {
            const f32x4 a = *(const f32x4*)(sA + kk * 68 + ty * 4), b = *(const f32x4*)(sB + kk * 68 + tx * 4);
#pragma unroll
            for (int i = 0; i < 4; ++i)
#pragma unroll
                for (int j = 0; j < 4; ++j) acc[i][j] += a[i] * b[j];
        }
    }
}

template <int MODE>
__global__ void __launch_bounds__(256) k_ngemm(const bf16* __restrict__ A, const bf16* __restrict__ Bt, void* __restrict__ C, int M, int N, int K, int ldc, int scale_cols, float scale) {
    __shared__ __attribute__((aligned(16))) float sA[32 * 68];
    __shared__ __attribute__((aligned(16))) float sB[32 * 68];
    const int m0 = blockIdx.y * 64, n0 = blockIdx.x * 64;
    float acc[4][4];
    ngemm_tile([&](int r) { return A + (size_t)(m0 + r) * K; }, [&](int r) { return Bt + (size_t)(n0 + r) * K; }, K, acc, sA, sB);
    const int ty = threadIdx.x >> 4, tx = threadIdx.x & 15;
#pragma unroll
    for (int i = 0; i < 4; ++i) { const int m = m0 + ty * 4 + i, n = n0 + tx * 4;
        if (MODE == 0) { const float sc = n < scale_cols ? scale : 1.f;
            *(unsigned long long*)((bf16*)C + (size_t)m * ldc + n) = (unsigned long long)pk2(acc[i][0] * sc, acc[i][1] * sc) | ((unsigned long long)pk2(acc[i][2] * sc, acc[i][3] * sc) << 32); }
        else *(f32x4*)((float*)C + (size_t)m * ldc + n) = (f32x4){acc[i][0], acc[i][1], acc[i][2], acc[i][3]}; }
}

__global__ void __launch_bounds__(256) k_attn_naive(const bf16* __restrict__ proj, bf16* __restrict__ mix) {
    const int gid = blockIdx.x * 256 + threadIdx.x;
    const int t = gid % S, bh = gid / S, h = bh & 7, b = bh >> 3;
    const bf16* base = proj + (size_t)b * S * NPROJ;
    float q[64], o[64];
    { const v4u* qp = (const v4u*)(base + (size_t)t * NPROJ + C_SBQ + h * 64);
#pragma unroll
      for (int i = 0; i < 8; ++i) { const v4u w = qp[i];
#pragma unroll
          for (int e = 0; e < 4; ++e) { q[i * 8 + 2 * e] = bf2f(w[e] & 0xffffu); q[i * 8 + 2 * e + 1] = bf2f(w[e] >> 16); } } }
#pragma unroll
    for (int d = 0; d < 64; ++d) o[d] = 0.f;
    float carry = 0.f;
    for (int s = t - 1; s >= 0; --s) {
        const v4u* kp = (const v4u*)(base + (size_t)s * NPROJ + C_SBK + h * 64);
        float z = 0.f;
#pragma unroll
        for (int i = 0; i < 8; ++i) { const v4u w = kp[i];
#pragma unroll
            for (int e = 0; e < 4; ++e) { z += q[i * 8 + 2 * e] * bf2f(w[e] & 0xffffu); z += q[i * 8 + 2 * e + 1] * bf2f(w[e] >> 16); } }
        const float sp = fmaxf(z, 0.f) + __log2f(1.f + exp2f(-fabsf(z)));
        carry += sp;
        const float a = exp2f(z - carry);
        const v4u* vp = (const v4u*)(base + (size_t)s * NPROJ + C_SBV + h * 64);
#pragma unroll
        for (int i = 0; i < 8; ++i) { const v4u w = vp[i];
#pragma unroll
            for (int e = 0; e < 4; ++e) { o[i * 8 + 2 * e] += a * bf2f(w[e] & 0xffffu); o[i * 8 + 2 * e + 1] += a * bf2f(w[e] >> 16); } }
        if (carry > SB_THRESH) break;
    }
    v4u* op = (v4u*)(mix + (size_t)(b * S + t) * D + h * 64);
#pragma unroll
    for (int i = 0; i < 8; ++i) { v4u w; w.x = pk2(o[i * 8], o[i * 8 + 1]); w.y = pk2(o[i * 8 + 2], o[i * 8 + 3]); w.z = pk2(o[i * 8 + 4], o[i * 8 + 5]); w.w = pk2(o[i * 8 + 6], o[i * 8 + 7]); op[i] = w; }
}

__global__ void __launch_bounds__(256) k_mlstm_naive(const bf16* __restrict__ proj, const float* __restrict__ conv_w, const float* __restrict__ conv_b,
                                                      const float* __restrict__ ipre, const float* __restrict__ logf, float* __restrict__ hraw) {
    __shared__ float sq[32][128], sk[32][128], sv[32][16], sf[32], si[32];
    const int tid = threadIdx.x, bh = blockIdx.x >> 3, sl = blockIdx.x & 7, b = bh >> 2, h = bh & 3;
    const int r = tid >> 4, c = tid & 15;
    const bf16* base = proj + (size_t)b * S * NPROJ;
    float Cst[8], nst[8];
#pragma unroll
    for (int e = 0; e < 8; ++e) { Cst[e] = 0.f; nst[e] = 0.f; }
    for (int t0 = 0; t0 < S; t0 += 32) {
        __syncthreads();
        for (int i = tid; i < 32 * 128; i += 256) {
            const int tt = i >> 7, d = i & 127, t = t0 + tt, ch = h * 128 + d;
            float yq = conv_b[ch], yk = conv_b[512 + ch];
#pragma unroll
            for (int j = 0; j < 4; ++j) { const int ts = t - 3 + j;
                if (ts >= 0) { yq += conv_w[j * 1024 + ch] * bf2f(base[(size_t)ts * NPROJ + C_MLQ + ch]); yk += conv_w[j * 1024 + 512 + ch] * bf2f(base[(size_t)ts * NPROJ + C_MLK + ch]); } }
            sq[tt][d] = siluf_(yq); sk[tt][d] = siluf_(yk) * 0.08838834764831845f;
        }
        for (int i = tid; i < 32 * 16; i += 256) { const int tt = i >> 4, d = i & 15; sv[tt][d] = bf2f(base[(size_t)(t0 + tt) * NPROJ + C_MLV + h * 128 + sl * 16 + d]); }
        if (tid < 32) { sf[tid] = __expf(logf[(size_t)bh * S + t0 + tid]); si[tid] = __expf(ipre[(size_t)bh * S + t0 + tid]); }
        __syncthreads();
        for (int tt = 0; tt < 32; ++tt) {
            const float f = sf[tt], iv = si[tt] * sv[tt][r], ii = si[tt];
            float pn = 0.f, pd = 0.f;
#pragma unroll
            for (int e = 0; e < 8; ++e) { const float kk = sk[tt][c * 8 + e], qq = sq[tt][c * 8 + e];
                Cst[e] = f * Cst[e] + iv * kk; nst[e] = f * nst[e] + ii * kk; pn += Cst[e] * qq; pd += nst[e] * qq; }
#pragma unroll
            for (int o = 1; o < 16; o <<= 1) { pn += __shfl_xor(pn, o); pd += __shfl_xor(pd, o); }
            if (c == 0) hraw[(size_t)(b * S + t0 + tt) * 512 + h * 128 + sl * 16 + r] = pn / fmaxf(fabsf(pd), 1.f);
        }
    }
}
__global__ void __launch_bounds__(256) k_mlnorm_naive(const float* __restrict__ hraw, const bf16* __restrict__ proj, const float* __restrict__ norm_g, bf16* __restrict__ mix) {
    const int gw = blockIdx.x * 4 + (threadIdx.x >> 6), lane = threadIdx.x & 63, t = gw >> 2, h = gw & 3;
    const float a = hraw[(size_t)t * 512 + h * 128 + 2 * lane], bq = hraw[(size_t)t * 512 + h * 128 + 2 * lane + 1];
    const float mean = wave_sum(a + bq) * (1.f / 128.f);
    const float da = a - mean, db = bq - mean;
    const float rstd = 1.f / sqrtf(wave_sum(da * da + db * db) * (1.f / 128.f) + LN_EPS);
    const unsigned ow = *(const unsigned*)(proj + (size_t)t * NPROJ + C_MLO + h * 128 + 2 * lane);
    const float o0 = sigmoidf_(bf2f(ow & 0xffffu)), o1 = sigmoidf_(bf2f(ow >> 16));
    const float g0 = norm_g[h * 128 + 2 * lane], g1 = norm_g[h * 128 + 2 * lane + 1];
    *(unsigned*)(mix + (size_t)t * D + 512 + h * 128 + 2 * lane) = pk2(da * rstd * g0 * o0, db * rstd * g1 * o1);
}

__global__ void __launch_bounds__(512) k_ln2(const float* __restrict__ x, const bf16* __restrict__ mixout, const float* __restrict__ mod, const float* __restrict__ ln1_g, const float* __restrict__ ln1_b,
                                              float* __restrict__ x1, bf16* __restrict__ u2) {
    const int tid = threadIdx.x, lane = tid & 63, wave = tid >> 6;
    const int row0 = blockIdx.x * 128, b = row0 / S;
    for (int rr = wave; rr < 128; rr += 8) {
        const int row = row0 + rr;
        f32x4 v[4]; float s = 0.f;
#pragma unroll
        for (int j = 0; j < 4; ++j) {
            const int col = 4 * lane + 256 * j;
            const f32x4 xv = *(const f32x4*)(x + (size_t)row * D + col);
            const unsigned long long mw = *(const unsigned long long*)(mixout + (size_t)row * D + col);
            const f32x4 g1 = *(const f32x4*)(mod + b * 6144 + 2048 + col);
            f32x4 mo = {bf2f((unsigned)mw & 0xffffu), bf2f(((unsigned)mw) >> 16), bf2f((unsigned)(mw >> 32) & 0xffffu), bf2f((unsigned)(mw >> 48))};
            v[j] = xv * DN_ALPHA + g1 * mo; s += (v[j].x + v[j].y) + (v[j].z + v[j].w);
        }
        float mean = wave_sum(s) * (1.f / D), s2 = 0.f;
#pragma unroll
        for (int j = 0; j < 4; ++j) { v[j] = v[j] - mean; s2 += (v[j].x * v[j].x + v[j].y * v[j].y) + (v[j].z * v[j].z + v[j].w * v[j].w); }
        float rstd = 1.f / sqrtf(wave_sum(s2) * (1.f / D) + LN_EPS);
        s = 0.f;
#pragma unroll
        for (int j = 0; j < 4; ++j) { const int col = 4 * lane + 256 * j;
            v[j] = v[j] * rstd * *(const f32x4*)(ln1_g + col) + *(const f32x4*)(ln1_b + col);
            *(f32x4*)(x1 + (size_t)row * D + col) = v[j]; s += (v[j].x + v[j].y) + (v[j].z + v[j].w); }
        mean = wave_sum(s) * (1.f / D); s2 = 0.f;
#pragma unroll
        for (int j = 0; j < 4; ++j) { v[j] = v[j] - mean; s2 += (v[j].x * v[j].x + v[j].y * v[j].y) + (v[j].z * v[j].z + v[j].w * v[j].w); }
        rstd = 1.f / sqrtf(wave_sum(s2) * (1.f / D) + LN_EPS);
#pragma unroll
        for (int j = 0; j < 4; ++j) { const int col = 4 * lane + 256 * j;
            const f32x4 u = v[j] * rstd * (*(const f32x4*)(mod + b * 6144 + 4096 + col) + 1.0f) + *(const f32x4*)(mod + b * 6144 + 3072 + col);
            *(unsigned long long*)(u2 + (size_t)row * D + col) = (unsigned long long)pk2(u.x, u.y) | ((unsigned long long)pk2(u.z, u.w) << 32); }
    }
}

__global__ void __launch_bounds__(256) k_route(const float* __restrict__ logits, const float* __restrict__ rbias, int* __restrict__ tope, float* __restrict__ topg, int* __restrict__ cnt) {
    const int t = blockIdx.x * 256 + threadIdx.x;
    const float* lg = logits + (size_t)t * NE;
    float gs[8];
#pragma unroll
    for (int g = 0; g < 8; ++g) { float m1 = -INFINITY, m2 = -INFINITY;
        for (int i = 0; i < 32; ++i) { const int e = g * 32 + i; const float v = sigmoidf_(lg[e]) + rbias[e]; if (v > m1) { m2 = m1; m1 = v; } else if (v > m2) m2 = v; }
        gs[g] = m1 + m2; }
    unsigned gmask = 0;
#pragma unroll
    for (int r = 0; r < 4; ++r) { int bi = 0; float bv = -INFINITY;
#pragma unroll
        for (int g = 0; g < 8; ++g) if (!((gmask >> g) & 1u) && gs[g] > bv) { bv = gs[g]; bi = g; }
        gmask |= 1u << bi; }
    float pv = INFINITY; int pi = -1; float gsum = 0.f;
    for (int r = 0; r < 8; ++r) { int bi = 0; float bv = -INFINITY, bs = 0.f;
        for (int e = 0; e < NE; ++e) { if (!((gmask >> (e >> 5)) & 1u)) continue;
            const float sc = sigmoidf_(lg[e]), v = sc + rbias[e];
            const bool elig = (v < pv) || (v == pv && e > pi);
            if (elig && v > bv) { bv = v; bi = e; bs = sc; } }
        pv = bv; pi = bi; gsum += bs;
        tope[t * 8 + r] = bi; topg[t * 8 + r] = bs;
        atomicAdd(cnt + bi, 1); }
    const float inv = 2.5f / gsum;
    for (int r = 0; r < 8; ++r) topg[t * 8 + r] *= inv;
}
__global__ void k_plan(const int* __restrict__ cnt, int* __restrict__ plan) {
    if (threadIdx.x == 0) { int s = 0, t64 = 0, t256 = 0;
        for (int e = 0; e <= NEX; ++e) { plan[PL_SLOT + e] = s; plan[PL_T64 + e] = t64; plan[PL_T256 + e] = t256;
            if (e < NEX) { const int n = e < NE ? cnt[e] : T; s += ((n + 255) / 256) * 256; t64 += (n + 63) / 64; t256 += (n + 255) / 256; } } }
}
__global__ void __launch_bounds__(256) k_fill(const int* __restrict__ tope, const float* __restrict__ topg, const int* __restrict__ plan, int* __restrict__ fill, i32x2* __restrict__ list) {
    const int id = blockIdx.x * 256 + threadIdx.x; const int e = tope[id];
    const int pos = atomicAdd(fill + e, 1); list[plan[PL_SLOT + e] + pos] = (i32x2){id, __float_as_int(topg[id])};
}
__device__ __forceinline__ int find_expert(const int* base, int tile) { int lo = 0, hi = NEX;
    while (hi - lo > 1) { const int mid = (lo + hi) >> 1; if (base[mid] <= tile) lo = mid; else hi = mid; } return lo; }

__global__ void __launch_bounds__(256) k_moe1_naive(const bf16* __restrict__ u2, const bf16* __restrict__ wt13, const int* __restrict__ cnt, const int* __restrict__ plan, const i32x2* __restrict__ list, bf16* __restrict__ H) {
    __shared__ __attribute__((aligned(16))) float sA[32 * 68];
    __shared__ __attribute__((aligned(16))) float sB[32 * 68];
    const int tile = blockIdx.y; if (tile >= plan[PL_T64 + NEX]) return;
    const int e = find_expert(plan + PL_T64, tile), mt = tile - plan[PL_T64 + e], n = e < NE ? cnt[e] : T, j0 = blockIdx.x * 64;
    const bf16* w = wt13 + (size_t)e * 512 * D;
    auto arow = [&](int r) -> const bf16* { const int rr = mt * 64 + r; if (rr >= n) return nullptr; const int tok = e < NE ? (list[plan[PL_SLOT + e] + rr].x >> 3) : rr; return u2 + (size_t)tok * D; };
    float a1[4][4], a3[4][4];
    ngemm_tile(arow, [&](int r) { const int j = j0 + r; return w + (size_t)((j >> 7) * 256 + (j & 127)) * D; }, D, a1, sA, sB);
    __syncthreads();
    ngemm_tile(arow, [&](int r) { const int j = j0 + r; return w + (size_t)((j >> 7) * 256 + 128 + (j & 127)) * D; }, D, a3, sA, sB);
    const int ty = threadIdx.x >> 4, tx = threadIdx.x & 15;
#pragma unroll
    for (int i = 0; i < 4; ++i) { const int rr = mt * 64 + ty * 4 + i; if (rr >= n) continue;
        float hv[4];
#pragma unroll
        for (int j = 0; j < 4; ++j) hv[j] = siluf_(a1[i][j]) * a3[i][j];
        *(unsigned long long*)(H + (size_t)(plan[PL_SLOT + e] + rr) * FF + j0 + tx * 4) = (unsigned long long)pk2(hv[0], hv[1]) | ((unsigned long long)pk2(hv[2], hv[3]) << 32); }
}
__global__ void __launch_bounds__(256) k_moe2_naive(const bf16* __restrict__ H, const bf16* __restrict__ wt2, const int* __restrict__ cnt, const int* __restrict__ plan, const i32x2* __restrict__ list,
                                                     const float* __restrict__ topg, bf16* __restrict__ ys, bf16* __restrict__ ysh) {
    __shared__ __attribute__((aligned(16))) float sA[32 * 68];
    __shared__ __attribute__((aligned(16))) float sB[32 * 68];
    const int tile = blockIdx.y; if (tile >= plan[PL_T64 + NEX]) return;
    const int e = find_expert(plan + PL_T64, tile), mt = tile - plan[PL_T64 + e], n = e < NE ? cnt[e] : T, n0 = blockIdx.x * 64;
    const bf16* w = wt2 + (size_t)e * D * FF; const bf16* hb = H + (size_t)plan[PL_SLOT + e] * FF;
    float acc[4][4];
    ngemm_tile([&](int r) -> const bf16* { const int rr = mt * 64 + r; return rr < n ? hb + (size_t)rr * FF : nullptr; }, [&](int r) { return w + (size_t)(n0 + r) * FF; }, FF, acc, sA, sB);
    const int ty = threadIdx.x >> 4, tx = threadIdx.x & 15;
#pragma unroll
    for (int i = 0; i < 4; ++i) { const int rr = mt * 64 + ty * 4 + i; if (rr >= n) continue;
        bf16* dst; float g = 1.f;
        if (e < NE) { const i32x2 en = list[plan[PL_SLOT + e] + rr]; g = __int_as_float(en.y); dst = ys + (size_t)en.x * D; } else dst = ysh + (size_t)rr * D;
        *(unsigned long long*)(dst + n0 + tx * 4) = (unsigned long long)pk2(acc[i][0] * g, acc[i][1] * g) | ((unsigned long long)pk2(acc[i][2] * g, acc[i][3] * g) << 32); }
}

__device__ __forceinline__ f32x4 ld_bf4(const bf16* p) { const unsigned long long w = *(const unsigned long long*)p;
    return (f32x4){bf2f((unsigned)w & 0xffffu), bf2f(((unsigned)w) >> 16), bf2f((unsigned)(w >> 32) & 0xffffu), bf2f((unsigned)(w >> 48))}; }
__global__ void __launch_bounds__(512) k_final(float* __restrict__ out, const bf16* __restrict__ ys, const bf16* __restrict__ ysh, const float* __restrict__ mod, const float* __restrict__ ln2_g, const float* __restrict__ ln2_b) {
    const int tid = threadIdx.x, lane = tid & 63, wave = tid >> 6;
    const int row0 = blockIdx.x * 128, b = row0 / S;
    for (int rr = wave; rr < 128; rr += 8) {
        const int row = row0 + rr;
        f32x4 v[4]; float s = 0.f;
#pragma unroll
        for (int j = 0; j < 4; ++j) { const int col = 4 * lane + 256 * j;
            f32x4 y = ld_bf4(ysh + (size_t)row * D + col);
#pragma unroll
            for (int k = 0; k < 8; ++k) y = y + ld_bf4(ys + ((size_t)row * 8 + k) * D + col);
            v[j] = *(const f32x4*)(out + (size_t)row * D + col) * DN_ALPHA + *(const f32x4*)(mod + b * 6144 + 5120 + col) * y;
            s += (v[j].x + v[j].y) + (v[j].z + v[j].w); }
        const float mean = wave_sum(s) * (1.f / D); float s2 = 0.f;
#pragma unroll
        for (int j = 0; j < 4; ++j) { v[j] = v[j] - mean; s2 += (v[j].x * v[j].x + v[j].y * v[j].y) + (v[j].z * v[j].z + v[j].w * v[j].w); }
        const float rstd = 1.f / sqrtf(wave_sum(s2) * (1.f / D) + LN_EPS);
#pragma unroll
        for (int j = 0; j < 4; ++j) { const int col = 4 * lane + 256 * j;
            *(f32x4*)(out + (size_t)row * D + col) = v[j] * rstd * *(const f32x4*)(ln2_g + col) + *(const f32x4*)(ln2_b + col); }
    }
}

#define LAS __attribute__((address_space(3)))
#define GAS __attribute__((address_space(1)))
namespace pg8 {
typedef short bf16x8 __attribute__((ext_vector_type(8)));
constexpr int BM = 256, BK = 64, HALF = 128, HTB = HALF * BK * 2, STAGE_BYTES = 8 * HTB, NXCD = 8, WGM = 8;
__host__ __device__ __forceinline__ int lds_byte(int r, int c) { const int st = (r >> 4) * 2 + (c >> 5), rr = r & 15, cc = c & 31, ob = rr * 64 + cc * 2; return st * 1024 + (ob ^ (((ob >> 9) & 1) << 5)); }
__host__ __device__ __forceinline__ void stage_rc(int b, int& R, int& C) { const int st = b / 1024, sb = b % 1024, swz = sb ^ (((sb >> 9) & 1) << 5); R = (st >> 1) * 16 + swz / 64; C = (st & 1) * 32 + (swz % 64) / 2; }
__host__ __device__ __forceinline__ int perm32(int rho) { const int n = rho >> 4, i = rho & 15; return 8 * (i >> 2) + 4 * n + (i & 3); }

struct Unit { int pm, pn, e, mt; const char* A; const char* B; };

__device__ __forceinline__ long unit_index(int i, int G, int c) { return (G % 8 == 0) ? ((long)(i * 8 + (c & 7)) * (G / 8) + (c >> 3)) : ((long)i * G + c); }

struct StaticOrder {
    int nM, nN, nwg, G, c; const char* A; const char* B; size_t tstep;
    __device__ void init(const void* A_, const void* B_, int M, int N, int K, int G_, int c_) { nM = M / BM; nN = N / BM; nwg = nM * nN; G = G_; c = c_; A = (const char*)A_; B = (const char*)B_; tstep = (size_t)BM * K * 2; }
    __device__ __forceinline__ bool next(int i, Unit& u) const {
        const long L = (long)i * G + c; if (L >= nwg) return false;
        int wgid = (int)L; { const int q = nwg / NXCD, r = nwg % NXCD, xcd = wgid % NXCD, off = wgid / NXCD; wgid = (xcd < r ? xcd * (q + 1) : r * (q + 1) + (xcd - r) * q) + off; }
        const int nig = WGM * nN, gid = wgid / nig, fm = gid * WGM, gsz = (nM - fm) < WGM ? (nM - fm) : WGM;
        u.pm = fm + ((wgid % nig) % gsz); u.pn = (wgid % nig) / gsz; u.e = 0; u.mt = u.pm; u.A = A + (size_t)u.pm * tstep; u.B = B + (size_t)u.pn * tstep; return true;
    }
    __device__ __forceinline__ int row_token(const Unit&, int) const { return 0; }
};

struct MoeOrder {
    int G, c, total, shift; const LAS int* tb; const LAS int* nn; const i32x2* list;
    const char* Abase; size_t a_tile_stride; const char* Bbase; size_t b_exp_stride, b_pn_stride;
    __device__ __forceinline__ bool next(int i, Unit& u) const {
        const long L = unit_index(i, G, c); if (L >= total) return false;
        const int tile = (int)(L >> shift); u.pn = (int)(L & ((1 << shift) - 1));
        int lo = 0, hi = NEX; while (hi - lo > 1) { const int mid = (lo + hi) >> 1; if (tb[mid] <= tile) lo = mid; else hi = mid; }
        u.e = lo; u.mt = tile - tb[lo]; u.pm = tile;
        u.A = Abase + (size_t)tile * a_tile_stride; u.B = Bbase + (size_t)lo * b_exp_stride + (size_t)u.pn * b_pn_stride; return true;
    }
    __device__ __forceinline__ int row_token(const Unit& u, int row) const {
        const int rr = u.mt * 256 + row;
        if (u.e >= NE) return rr;
        return rr < nn[u.e] ? (list[u.pm * 256 + row].x >> 3) : 0;
    }
};

__device__ __forceinline__ unsigned cvt_pk_bf16(float lo, float hi) { unsigned r; asm volatile("v_cvt_pk_bf16_f32 %0, %1, %2" : "=v"(r) : "v"(lo), "v"(hi)); return r; }

struct EpiBf16 {
    static constexpr bool PERM = true; bf16* O; int ldc; int scale_tiles; float scale;
    __device__ __forceinline__ void operator()(const f32x4 (&acc)[2][2][4][2], const Unit& u, int wr, int wc, int fr, int fq) const {
        const int row0 = u.pm * BM + wr * 64 + fr, col0 = u.pn * BM + wc * 32 + 8 * fq; const float sc = u.pn < scale_tiles ? scale : 1.f;
#pragma unroll
        for (int ai = 0; ai < 2; ++ai)
#pragma unroll
            for (int m = 0; m < 4; ++m) { bf16* rowp = O + (size_t)(row0 + ai * HALF + m * 16) * ldc + col0;
#pragma unroll
                for (int bj = 0; bj < 2; ++bj) { const f32x4 v0 = acc[ai][bj][m][0] * sc, v1 = acc[ai][bj][m][1] * sc;
                    v4u w; w.x = cvt_pk_bf16(v0[0], v0[1]); w.y = cvt_pk_bf16(v0[2], v0[3]); w.z = cvt_pk_bf16(v1[0], v1[1]); w.w = cvt_pk_bf16(v1[2], v1[3]);
                    *(v4u*)(rowp + bj * HALF) = w; } }
    }
};
struct EpiF32 {
    static constexpr bool PERM = false; float* C; int ldc;
    __device__ __forceinline__ void operator()(const f32x4 (&acc)[2][2][4][2], const Unit& u, int wr, int wc, int fr, int fq) const {
        const int row0 = u.pm * BM + wr * 64 + fr, col0 = u.pn * BM + wc * 32 + 4 * fq;
#pragma unroll
        for (int ai = 0; ai < 2; ++ai)
#pragma unroll
            for (int m = 0; m < 4; ++m) { float* rowp = C + (size_t)(row0 + ai * HALF + m * 16) * ldc + col0;
#pragma unroll
                for (int bj = 0; bj < 2; ++bj)
#pragma unroll
                    for (int n = 0; n < 2; ++n) *(f32x4*)(rowp + bj * HALF + n * 16) = acc[ai][bj][m][n]; }
    }
};
struct EpiGlu {
    static constexpr bool PERM = true; bf16* H;
    __device__ __forceinline__ void operator()(const f32x4 (&acc)[2][2][4][2], const Unit& u, int wr, int wc, int fr, int fq) const {
        const int row0 = u.pm * BM + wr * 64 + fr, col0 = u.pn * HALF + wc * 32 + 8 * fq;
#pragma unroll
        for (int ai = 0; ai < 2; ++ai)
#pragma unroll
            for (int m = 0; m < 4; ++m) { float h[8];
#pragma unroll
                for (int n = 0; n < 2; ++n)
#pragma unroll
                    for (int q = 0; q < 4; ++q) { const float a = acc[ai][0][m][n][q]; h[n * 4 + q] = a * __builtin_amdgcn_rcpf(1.f + __expf(-a)) * acc[ai][1][m][n][q]; }
                v4u w; w.x = cvt_pk_bf16(h[0], h[1]); w.y = cvt_pk_bf16(h[2], h[3]); w.z = cvt_pk_bf16(h[4], h[5]); w.w = cvt_pk_bf16(h[6], h[7]);
                *(v4u*)(H + (size_t)(row0 + ai * HALF + m * 16) * FF + col0) = w; }
    }
};
struct EpiScatter {
    static constexpr bool PERM = true; bf16* ys; bf16* ysh; const i32x2* list; const LAS int* nn;
    __device__ __forceinline__ void operator()(const f32x4 (&acc)[2][2][4][2], const Unit& u, int wr, int wc, int fr, int fq) const {
        const int col0 = u.pn * BM + wc * 32 + 8 * fq; const int n = nn[u.e]; const bool routed = u.e < NE;
        const i32x2* lp = list + (size_t)(u.pm - u.mt) * 256;
#pragma unroll
        for (int ai = 0; ai < 2; ++ai) {
            i32x2 en[4];
#pragma unroll
            for (int m = 0; m < 4; ++m) { const int rr = u.mt * 256 + ai * HALF + wr * 64 + m * 16 + fr; en[m] = (i32x2){rr, 0x3f800000};
                if (routed && rr < n) en[m] = lp[rr]; }
#pragma unroll
            for (int m = 0; m < 4; ++m) { const int rr = u.mt * 256 + ai * HALF + wr * 64 + m * 16 + fr;
                if (rr < n) { bf16* dst = (routed ? ys : ysh) + (size_t)en[m].x * D + col0; const float g = __int_as_float(en[m].y);
#pragma unroll
                    for (int bj = 0; bj < 2; ++bj) { const f32x4 v0 = acc[ai][bj][m][0] * g, v1 = acc[ai][bj][m][1] * g;
                        v4u w; w.x = cvt_pk_bf16(v0[0], v0[1]); w.y = cvt_pk_bf16(v0[2], v0[3]); w.z = cvt_pk_bf16(v1[0], v1[1]); w.w = cvt_pk_bf16(v1[2], v1[3]);
                        *(v4u*)(dst + bj * HALF) = w; } } }
            __builtin_amdgcn_sched_barrier(0);
        }
    }
};

template <class Epi, class Sched, bool GATHER>
__device__ __forceinline__ void gemm_phase(LAS unsigned char* lds, const int K, const Sched& S, const Epi& E) {
    const int tid = threadIdx.x, wid = __builtin_amdgcn_readfirstlane(tid >> 6), lane = tid & 63, wr = wid >> 2, wc = wid & 3, fr = lane & 15, fq = lane >> 4;
    const int nt = K / BK;
    int sR[2], sC[2];
    unsigned voffA[2], voffB[2];
#pragma unroll
    for (int i = 0; i < 2; ++i) { stage_rc(tid * 16 + i * 8192, sR[i], sC[i]); const int Rb = Epi::PERM ? ((sR[i] & ~31) + perm32(sR[i] & 31)) : sR[i];
        voffA[i] = (unsigned)(sR[i] * K + sC[i]) * 2u; voffB[i] = (unsigned)(Rb * K + sC[i]) * 2u; }
    const size_t kstep = (size_t)(BK * 2);
    const size_t hstep = (size_t)HALF * K * 2;
    const unsigned ldsw = (unsigned)wid * 1024u;
    const int aoff = lds_byte(wr * 64 + fr, fq * 8), boff = lds_byte(wc * 32 + fr, fq * 8);
    unsigned gc[2][2], gn[2][2];
#define PG8_SA(b, h) (((b) * 2 + (h)) * HTB)
#define PG8_SB(b, h) ((4 + (b) * 2 + (h)) * HTB)
#define PG8_GLDS(src, bufoff, i) __builtin_amdgcn_global_load_lds((const unsigned*)(src), (LAS unsigned*)(lds + (bufoff) + ldsw + (i) * 8192), 16, 0, 0)
#define PG8_STAGE_B(bufoff, gbase) do { PG8_GLDS((const char*)(gbase) + voffB[0], bufoff, 0); PG8_GLDS((const char*)(gbase) + voffB[1], bufoff, 1); } while (0)
#define PG8_STAGE_A(bufoff, gbase, h, nx) do { if constexpr (GATHER) { const unsigned _o0 = (nx) ? gn[h][0] : gc[h][0], _o1 = (nx) ? gn[h][1] : gc[h][1]; \
            PG8_GLDS((const char*)(gbase) + _o0, bufoff, 0); PG8_GLDS((const char*)(gbase) + _o1, bufoff, 1); } \
        else { PG8_GLDS((const char*)(gbase) + (h) * hstep + voffA[0], bufoff, 0); PG8_GLDS((const char*)(gbase) + (h) * hstep + voffA[1], bufoff, 1); } } while (0)
#define PG8_LDA(dst, b, h) do { _Pragma("unroll") for (int m = 0; m < 4; ++m) _Pragma("unroll") for (int k = 0; k < 2; ++k) dst[m][k] = *(const LAS bf16x8*)(lds + PG8_SA(b, h) + aoff + m * 2048 + k * 1024); } while (0)
#define PG8_LDB(dst, b, h) do { _Pragma("unroll") for (int n = 0; n < 2; ++n) _Pragma("unroll") for (int k = 0; k < 2; ++k) dst[n][k] = *(const LAS bf16x8*)(lds + PG8_SB(b, h) + boff + n * 2048 + k * 1024); } while (0)
#define PG8_MMA(ai, bj, At, Bt) do { __builtin_amdgcn_s_setprio(1); _Pragma("unroll") for (int m = 0; m < 4; ++m) _Pragma("unroll") for (int n = 0; n < 2; ++n) _Pragma("unroll") for (int k = 0; k < 2; ++k) \
        acc[ai][bj][m][n] = __builtin_amdgcn_mfma_f32_16x16x32_bf16(Bt[n][k], At[m][k], acc[ai][bj][m][n], 0, 0, 0); __builtin_amdgcn_s_setprio(0); } while (0)
#define PG8_WAIT_V(n) asm volatile("s_waitcnt vmcnt(" #n ")" ::: "memory")
#define PG8_WAIT_L(n) asm volatile("s_waitcnt lgkmcnt(" #n ")" ::: "memory")
#define PG8_BAR __builtin_amdgcn_s_barrier()
#define PG8_SCHED __builtin_amdgcn_sched_barrier(0)
#define PG8_GATHER(dst, u) do { _Pragma("unroll") for (int _h = 0; _h < 2; ++_h) _Pragma("unroll") for (int _i = 0; _i < 2; ++_i) \
        dst[_h][_i] = (unsigned)(S.row_token(u, _h * HALF + sR[_i]) * K + sC[_i]) * 2u; } while (0)
    Unit cur, nxt; int ui = 0;
    if (!S.next(0, cur)) return;
    f32x4 acc[2][2][4][2];
#pragma unroll
    for (int a = 0; a < 2; ++a)
#pragma unroll
        for (int b = 0; b < 2; ++b)
#pragma unroll
            for (int m = 0; m < 4; ++m)
#pragma unroll
                for (int n = 0; n < 2; ++n) acc[a][b][m][n] = (f32x4){0.f, 0.f, 0.f, 0.f};
    bf16x8 At[4][2], B0[2][2], B1[2][2];
    const char* cA = cur.A; const char* cB = cur.B;
    if constexpr (GATHER) { PG8_GATHER(gc, cur); }
    PG8_STAGE_B(PG8_SB(0, 0), cB); PG8_STAGE_A(PG8_SA(0, 0), cA, 0, false); PG8_STAGE_B(PG8_SB(0, 1), cB + hstep); PG8_STAGE_A(PG8_SA(0, 1), cA, 1, false);
    if (wr == 1) PG8_BAR;
    PG8_WAIT_V(4); PG8_BAR;
    PG8_STAGE_B(PG8_SB(1, 0), cB + kstep); PG8_STAGE_A(PG8_SA(1, 0), cA + kstep, 0, false); PG8_STAGE_B(PG8_SB(1, 1), cB + hstep + kstep);
    PG8_WAIT_V(6); PG8_BAR;
    for (;;) {
        const bool has_next = S.next(ui + 1, nxt);
        const char* nA = has_next ? nxt.A : cA; const char* nB = has_next ? nxt.B : cB;
        if constexpr (GATHER) { if (has_next) { PG8_GATHER(gn, nxt); } else {
#pragma unroll
            for (int h = 0; h < 2; ++h) { gn[h][0] = gc[h][0]; gn[h][1] = gc[h][1]; } } }
#pragma unroll 1
        for (int t = 0; t < nt; t += 2) {
            const bool last = (t == nt - 2);
            const char* a1 = cA + (size_t)(t + 1) * kstep;
            const char* a2 = last ? nA : cA + (size_t)(t + 2) * kstep; const char* b2 = last ? nB : cB + (size_t)(t + 2) * kstep;
            const char* a3 = a2 + kstep; const char* b3 = b2 + kstep;
            PG8_LDB(B0, 0, 0); PG8_SCHED; PG8_LDA(At, 0, 0); PG8_STAGE_A(PG8_SA(1, 1), a1, 1, false);
            PG8_WAIT_L(8); PG8_BAR; PG8_WAIT_L(0); PG8_MMA(0, 0, At, B0); PG8_BAR; PG8_SCHED;
            PG8_LDB(B1, 0, 1); PG8_STAGE_B(PG8_SB(0, 0), b2);
            PG8_BAR; PG8_WAIT_L(0); PG8_MMA(0, 1, At, B1); PG8_BAR;
            PG8_LDA(At, 0, 1); PG8_STAGE_A(PG8_SA(0, 0), a2, 0, last);
            PG8_BAR; PG8_WAIT_L(0); PG8_MMA(1, 0, At, B0); PG8_BAR; PG8_SCHED;
            PG8_STAGE_B(PG8_SB(0, 1), b2 + hstep);
            PG8_WAIT_V(6); PG8_BAR; PG8_MMA(1, 1, At, B1); PG8_BAR;
            PG8_LDB(B0, 1, 0); PG8_SCHED; PG8_LDA(At, 1, 0); PG8_STAGE_A(PG8_SA(0, 1), a2, 1, last);
            PG8_WAIT_L(8); PG8_BAR; PG8_WAIT_L(0); PG8_MMA(0, 0, At, B0); PG8_BAR; PG8_SCHED;
            PG8_LDB(B1, 1, 1); PG8_STAGE_B(PG8_SB(1, 0), b3);
            PG8_BAR; PG8_WAIT_L(0); PG8_MMA(0, 1, At, B1); PG8_BAR;
            PG8_LDA(At, 1, 1); PG8_STAGE_A(PG8_SA(1, 0), a3, 0, last);
            PG8_BAR; PG8_WAIT_L(0); PG8_MMA(1, 0, At, B0); PG8_BAR; PG8_SCHED;
            PG8_STAGE_B(PG8_SB(1, 1), b3 + hstep);
            PG8_WAIT_V(6); PG8_BAR; PG8_MMA(1, 1, At, B1); PG8_BAR;
        }
        E(acc, cur, wr, wc, fr, fq);
        if (!has_next) break;
#pragma unroll
        for (int a = 0; a < 2; ++a)
#pragma unroll
            for (int b = 0; b < 2; ++b)
#pragma unroll
                for (int m = 0; m < 4; ++m)
#pragma unroll
                    for (int n = 0; n < 2; ++n) acc[a][b][m][n] = (f32x4){0.f, 0.f, 0.f, 0.f};
        cur = nxt; cA = nA; cB = nB; ++ui;
        if constexpr (GATHER) {
#pragma unroll
            for (int h = 0; h < 2; ++h) { gc[h][0] = gn[h][0]; gc[h][1] = gn[h][1]; } }
    }
    PG8_WAIT_V(0);
    if (wr == 0) PG8_BAR;
    PG8_BAR;
#undef PG8_SA
#undef PG8_SB
#undef PG8_GLDS
#undef PG8_STAGE_A
#undef PG8_STAGE_B
#undef PG8_LDA
#undef PG8_LDB
#undef PG8_MMA
#undef PG8_WAIT_V
#undef PG8_WAIT_L
#undef PG8_BAR
#undef PG8_SCHED
#undef PG8_GATHER
}
}

#define XB_TMO      128
#define XB_XCNT(j)  (256  + 64 * (j))
#define XB_XSUB(j)  (1280 + 64 * (j))
#define XB_XGEN(j)  (2304 + 64 * (j))
#define XB_TOP      3328
#define XB_TOPGEN   3392
#define XCD_BAR_WORDS 3456
#define XB_SPIN_CAP (1u << 22)
__device__ __forceinline__ unsigned xb_ld(unsigned* p)              { return __hip_atomic_load(p, __ATOMIC_RELAXED, __HIP_MEMORY_SCOPE_AGENT); }
__device__ __forceinline__ unsigned xb_add(unsigned* p, unsigned v) { return __hip_atomic_fetch_add(p, v, __ATOMIC_RELAXED, __HIP_MEMORY_SCOPE_AGENT); }
__device__ __forceinline__ unsigned xb_xcc_id() { return (unsigned)__builtin_amdgcn_s_getreg((3 << 11) | 20) & 0xFu; }
#define XB_SPIN(cond, bar) do { unsigned _sp = 0; while (cond) { __builtin_amdgcn_s_sleep(1); \
    if ((++_sp & 255u) == 0u) { if (xb_ld(&(bar)[XB_TMO])) break; if (_sp > XB_SPIN_CAP) { atomicAdd(&(bar)[XB_TMO], 1u); break; } } } } while (0)
struct XcdBarrier { unsigned* bar; unsigned x; volatile LAS unsigned* st; };
__device__ __forceinline__ XcdBarrier xcd_barrier_post(unsigned* bar, volatile LAS unsigned* st) {
    XcdBarrier b; b.bar = bar; b.x = xb_xcc_id(); b.st = st;
    if (threadIdx.x == 0) (void)xb_add(&bar[XB_XCNT(b.x)], 1u);
    return b;
}
__device__ __forceinline__ void xcd_barrier_complete(unsigned* bar, unsigned x, unsigned& nloc, unsigned& nx) {
    const unsigned G = gridDim.x * gridDim.y * gridDim.z;
    unsigned sum, cnt, mine, sp = 0u;
    for (;;) {
        sum = 0u; cnt = 0u; mine = 0u;
#pragma unroll
        for (unsigned j = 0; j < 16; ++j) { const unsigned c = xb_ld(&bar[XB_XCNT(j)]); sum += c; cnt += (c > 0u) ? 1u : 0u; mine = (j == x) ? c : mine; }
        if (sum == G) break;
        __builtin_amdgcn_s_sleep(1);
        if ((++sp & 255u) == 0u) { if (xb_ld(&bar[XB_TMO])) break; if (sp > XB_SPIN_CAP) { atomicAdd(&bar[XB_TMO], 1u); break; } }
    }
    nloc = mine > 0u ? mine : 1u; nx = cnt > 0u ? cnt : 1u;
}
__device__ __forceinline__ void xcd_barrier(const XcdBarrier& b) {
    asm volatile("s_waitcnt vmcnt(0)" ::: "memory");
    __syncthreads();
    if (threadIdx.x == 0) {
        unsigned* bar = b.bar;
        __builtin_amdgcn_s_waitcnt(0);
        unsigned nloc = b.st[0], nx = b.st[1];
        if (nloc == 0u) { xcd_barrier_complete(bar, b.x, nloc, nx); b.st[0] = nloc; b.st[1] = nx; }
        const unsigned old = xb_add(&bar[XB_XSUB(b.x)], 1u);
        const unsigned gen = old / nloc;
        if (old + 1u == (gen + 1u) * nloc) {
            __builtin_amdgcn_fence(__ATOMIC_RELEASE, "agent");
            asm volatile("s_waitcnt vmcnt(0)" ::: "memory");
            const unsigned og = xb_add(&bar[XB_TOP], 1u);
            const unsigned tg = og / nx;
            if (og + 1u == (tg + 1u) * nx) xb_add(&bar[XB_TOPGEN], 1u);
            else XB_SPIN(xb_ld(&bar[XB_TOPGEN]) == tg, bar);
            __builtin_amdgcn_fence(__ATOMIC_ACQUIRE, "agent");
            xb_add(&bar[XB_XGEN(b.x)], 1u);
            asm volatile("s_waitcnt vmcnt(0)" ::: "memory");
        } else {
            XB_SPIN(xb_ld(&bar[XB_XGEN(b.x)]) == gen, bar);
            __builtin_amdgcn_fence(__ATOMIC_ACQUIRE, "agent");
            asm volatile("s_waitcnt vmcnt(0)" ::: "memory");
        }
    }
    __syncthreads();
}

constexpr int NWAVES = 8, NTHR = 512;
constexpr int RING_BYTES = 131072, XTRA_OFF = RING_BYTES, LDS_BYTES = 147456;
constexpr int X_MISC = 0, X_TB = 256, X_NN = 1536;
constexpr int CW_BAR = 4096;
constexpr int N_PHASES = 14;
struct MArgs { const float* in[22]; float* out; unsigned char* ws; int ph_lo, ph_hi; };

__device__ __forceinline__ void ph_mod_prep(const MArgs& a, unsigned char* smem, int G) {
    const int tid = threadIdx.x;
    unsigned char* ws = a.ws;
    if ((int)blockIdx.x < 192) {
        float* sc = (float*)smem; float* red = sc + NB * D;
        const float* c = a.in[1]; const float* w_ada = a.in[2]; const float* b_ada = a.in[3]; float* mod = (float*)(ws + WS_MOD);
        for (int i = tid; i < NB * D; i += NTHR) sc[i] = siluf_(c[i]);
        __syncthreads();
        for (int it = blockIdx.x; it < 192; it += G) {
            const int kq = tid >> 5, jl = tid & 31, j = it * 32 + jl;
            float a0 = 0.f, a1 = 0.f, a2 = 0.f, a3 = 0.f;
#pragma unroll 16
            for (int kk = 0; kk < 64; ++kk) { const int k = kq * 64 + kk; const float w = w_ada[(size_t)k * 6144 + j];
                a0 += sc[k] * w; a1 += sc[D + k] * w; a2 += sc[2 * D + k] * w; a3 += sc[3 * D + k] * w; }
            red[(kq * 4 + 0) * 32 + jl] = a0; red[(kq * 4 + 1) * 32 + jl] = a1; red[(kq * 4 + 2) * 32 + jl] = a2; red[(kq * 4 + 3) * 32 + jl] = a3;
            __syncthreads();
            if (tid < 128) { const int b = tid >> 5; float s = b_ada[j];
#pragma unroll
                for (int q = 0; q < 16; ++q) s += red[(q * 4 + b) * 32 + jl];
                mod[b * 6144 + j] = s; }
            __syncthreads();
        }
    }
    PrepArgs pa{a.in[4], a.in[9], a.in[12], a.in[14], a.in[15], a.in[16], a.in[17], a.in[18], a.in[19],
                (bf16*)(ws + WS_WTIN), (bf16*)(ws + WS_WTOUT), (bf16*)(ws + WS_WTR), (bf16*)(ws + WS_WT13), (bf16*)(ws + WS_WT2)};
    const int lane = tid & 63, gw = blockIdx.x * NWAVES + (tid >> 6), ngw = G * NWAVES;
    for (int it = gw; it < IT_TOTAL; it += ngw) prep_item(pa, it, lane);
}

__device__ __forceinline__ void ph_ln1(const MArgs& a, unsigned char* smem, int G) {
    const int tid = threadIdx.x, lane = tid & 63, wave = tid >> 6;
    const float* x = a.in[0]; const float* w_in = a.in[4]; const float* gate_b = a.in[7];
    const float* mod = (const float*)(a.ws + WS_MOD); bf16* u1 = (bf16*)(a.ws + WS_U1); float* ipre = (float*)(a.ws + WS_GATES); float* logf = ipre + 16 * S;
    float* wg = (float*)smem;
    for (int i = tid; i < D * 8; i += NTHR) wg[i] = w_in[(size_t)(i >> 3) * WIN_LD + C_GATE + (i & 7)];
    __syncthreads();
    for (int it = blockIdx.x; it < T / 128; it += G) {
        const int row0 = it * 128, b = row0 / S;
        f32x4 sh[4], sc[4];
#pragma unroll
        for (int j = 0; j < 4; ++j) { sh[j] = *(const f32x4*)(mod + b * 6144 + 4 * lane + 256 * j); sc[j] = *(const f32x4*)(mod + b * 6144 + 1024 + 4 * lane + 256 * j); }
        for (int rr = wave; rr < 128; rr += NWAVES) {
            const int row = row0 + rr;
            const f32x4* xr = (const f32x4*)(x + (size_t)row * D) + lane;
            f32x4 v[4]; float s = 0.f;
#pragma unroll
            for (int j = 0; j < 4; ++j) { v[j] = xr[64 * j]; s += (v[j].x + v[j].y) + (v[j].z + v[j].w); }
            const float mean = wave_sum(s) * (1.f / D); float s2 = 0.f;
#pragma unroll
            for (int j = 0; j < 4; ++j) { v[j] = v[j] - mean; s2 += (v[j].x * v[j].x + v[j].y * v[j].y) + (v[j].z * v[j].z + v[j].w * v[j].w); }
            const float rstd = 1.f / sqrtf(wave_sum(s2) * (1.f / D) + LN_EPS);
            float ga[8];
#pragma unroll
            for (int q = 0; q < 8; ++q) ga[q] = 0.f;
            unsigned long long* o8 = (unsigned long long*)(u1 + (size_t)row * D) + lane;
#pragma unroll
            for (int j = 0; j < 4; ++j) {
                const f32x4 u = v[j] * rstd * (sc[j] + 1.0f) + sh[j];
                o8[64 * j] = (unsigned long long)pk2(u.x, u.y) | ((unsigned long long)pk2(u.z, u.w) << 32);
#pragma unroll
                for (int e = 0; e < 4; ++e) { const int k = 4 * lane + 256 * j + e;
                    const f32x4 w0 = *(const f32x4*)(wg + k * 8), w1 = *(const f32x4*)(wg + k * 8 + 4);
                    ga[0] += u[e] * w0.x; ga[1] += u[e] * w0.y; ga[2] += u[e] * w0.z; ga[3] += u[e] * w0.w;
                    ga[4] += u[e] * w1.x; ga[5] += u[e] * w1.y; ga[6] += u[e] * w1.z; ga[7] += u[e] * w1.w; }
            }
#pragma unroll
            for (int q = 0; q < 8; ++q) ga[q] = wave_sum(ga[q]);
            if (lane < 8) {
                float gv = 0.f;
#pragma unroll
                for (int q = 0; q < 8; ++q) gv = (lane == q) ? ga[q] : gv;
                gv += gate_b[lane];
                const int h = lane & 3, s_ = row % S;
                if (lane < 4) ipre[(size_t)(b * 4 + h) * S + s_] = gv;
                else logf[(size_t)(b * 4 + h) * S + s_] = fminf(gv, 0.f) - log1pf(__expf(-fabsf(gv)));
            }
        }
    }
}

__device__ __forceinline__ void ph_attn_simple(const bf16* __restrict__ proj, bf16* __restrict__ mix, int vb0, int nvb) {
    for (int gid = vb0 * NTHR + threadIdx.x; gid < NB * 8 * S; gid += nvb * NTHR) {
        const int t = gid % S, bh = gid / S, h = bh & 7, b = bh >> 3;
        const bf16* base = proj + (size_t)b * S * NPROJ;
        float q[64], o[64];
        { const v4u* qp = (const v4u*)(base + (size_t)t * NPROJ + C_SBQ + h * 64);
#pragma unroll
          for (int i = 0; i < 8; ++i) { const v4u w = qp[i];
#pragma unroll
              for (int e = 0; e < 4; ++e) { q[i * 8 + 2 * e] = bf2f(w[e] & 0xffffu); q[i * 8 + 2 * e + 1] = bf2f(w[e] >> 16); } } }
#pragma unroll
        for (int d = 0; d < 64; ++d) o[d] = 0.f;
        float carry = 0.f;
        for (int s = t - 1; s >= 0; --s) {
            const v4u* kp = (const v4u*)(base + (size_t)s * NPROJ + C_SBK + h * 64);
            float z = 0.f;
#pragma unroll
            for (int i = 0; i < 8; ++i) { const v4u w = kp[i];
#pragma unroll
                for (int e = 0; e < 4; ++e) { z += q[i * 8 + 2 * e] * bf2f(w[e] & 0xffffu); z += q[i * 8 + 2 * e + 1] * bf2f(w[e] >> 16); } }
            const float sp = fmaxf(z, 0.f) + __log2f(1.f + exp2f(-fabsf(z)));
            carry += sp;
            const float p = exp2f(z - carry);
            const v4u* vp = (const v4u*)(base + (size_t)s * NPROJ + C_SBV + h * 64);
#pragma unroll
            for (int i = 0; i < 8; ++i) { const v4u w = vp[i];
#pragma unroll
                for (int e = 0; e < 4; ++e) { o[i * 8 + 2 * e] += p * bf2f(w[e] & 0xffffu); o[i * 8 + 2 * e + 1] += p * bf2f(w[e] >> 16); } }
            if (carry > SB_THRESH) break;
        }
        v4u* op = (v4u*)(mix + (size_t)(b * S + t) * D + h * 64);
#pragma unroll
        for (int i = 0; i < 8; ++i) { v4u w; w.x = pk2(o[i * 8], o[i * 8 + 1]); w.y = pk2(o[i * 8 + 2], o[i * 8 + 3]); w.z = pk2(o[i * 8 + 4], o[i * 8 + 5]); w.w = pk2(o[i * 8 + 6], o[i * 8 + 7]); op[i] = w; }
    }
}
__device__ __forceinline__ void ph_mlstm_simple(const MArgs& a, unsigned char* smem, int vb0, int nvb) {
    const bf16* proj = (const bf16*)(a.ws + WS_PROJ); const float* conv_w = a.in[5]; const float* conv_b = a.in[6];
    const float* ipre = (const float*)(a.ws + WS_GATES); const float* logf = ipre + 16 * S; float* hraw = (float*)(a.ws + WS_HRAW);
    const int half = threadIdx.x >> 8, tid = threadIdx.x & 255;
    float* sq = (float*)smem + half * 8768; float* sk = sq + 4096; float* sv = sk + 4096; float* sf = sv + 512; float* si = sf + 32;
    for (int it0 = vb0 * 2; it0 < 128; it0 += nvb * 2) {
        const int item = it0 + half, bh = item >> 3, sl = item & 7, b = bh >> 2, h = bh & 3;
        const int r = tid >> 4, c = tid & 15;
        const bf16* base = proj + (size_t)b * S * NPROJ;
        float Cst[8], nst[8];
#pragma unroll
        for (int e = 0; e < 8; ++e) { Cst[e] = 0.f; nst[e] = 0.f; }
        for (int t0 = 0; t0 < S; t0 += 32) {
            __syncthreads();
            for (int i = tid; i < 32 * 128; i += 256) {
                const int tt = i >> 7, d = i & 127, t = t0 + tt, ch = h * 128 + d;
                float yq = conv_b[ch], yk = conv_b[512 + ch];
#pragma unroll
                for (int j = 0; j < 4; ++j) { const int ts = t - 3 + j;
                    if (ts >= 0) { yq += conv_w[j * 1024 + ch] * bf2f(base[(size_t)ts * NPROJ + C_MLQ + ch]); yk += conv_w[j * 1024 + 512 + ch] * bf2f(base[(size_t)ts * NPROJ + C_MLK + ch]); } }
                sq[tt * 128 + d] = siluf_(yq); sk[tt * 128 + d] = siluf_(yk) * 0.08838834764831845f;
            }
            for (int i = tid; i < 32 * 16; i += 256) { const int tt = i >> 4, d = i & 15; sv[tt * 16 + d] = bf2f(base[(size_t)(t0 + tt) * NPROJ + C_MLV + h * 128 + sl * 16 + d]); }
            if (tid < 32) { sf[tid] = __expf(logf[(size_t)bh * S + t0 + tid]); si[tid] = __expf(ipre[(size_t)bh * S + t0 + tid]); }
            __syncthreads();
            for (int tt = 0; tt < 32; ++tt) {
                const float f = sf[tt], iv = si[tt] * sv[tt * 16 + r], ii = si[tt];
                float pn = 0.f, pd = 0.f;
#pragma unroll
                for (int e = 0; e < 8; ++e) { const float kk = sk[tt * 128 + c * 8 + e], qq = sq[tt * 128 + c * 8 + e];
                    Cst[e] = f * Cst[e] + iv * kk; nst[e] = f * nst[e] + ii * kk; pn += Cst[e] * qq; pd += nst[e] * qq; }
#pragma unroll
                for (int o = 1; o < 16; o <<= 1) { pn += __shfl_xor(pn, o); pd += __shfl_xor(pd, o); }
                if (c == 0) hraw[(size_t)(b * S + t0 + tt) * 512 + h * 128 + sl * 16 + r] = pn / fmaxf(fabsf(pd), 1.f);
            }
        }
    }
}
__device__ __forceinline__ void ph_mlnorm(const MArgs& a, int G) {
    const float* hraw = (const float*)(a.ws + WS_HRAW); const bf16* proj = (const bf16*)(a.ws + WS_PROJ); const float* norm_g = a.in[8]; bf16* mix = (bf16*)(a.ws + WS_MIX);
    const int lane = threadIdx.x & 63;
    for (int gw = blockIdx.x * NWAVES + (threadIdx.x >> 6); gw < T * 4; gw += G * NWAVES) {
        const int t = gw >> 2, h = gw & 3;
        const float va = hraw[(size_t)t * 512 + h * 128 + 2 * lane], vb = hraw[(size_t)t * 512 + h * 128 + 2 * lane + 1];
        const float mean = wave_sum(va + vb) * (1.f / 128.f);
        const float da = va - mean, db = vb - mean;
        const float rstd = 1.f / sqrtf(wave_sum(da * da + db * db) * (1.f / 128.f) + LN_EPS);
        const unsigned ow = *(const unsigned*)(proj + (size_t)t * NPROJ + C_MLO + h * 128 + 2 * lane);
        const float o0 = sigmoidf_(bf2f(ow & 0xffffu)), o1 = sigmoidf_(bf2f(ow >> 16));
        const float g0 = norm_g[h * 128 + 2 * lane], g1 = norm_g[h * 128 + 2 * lane + 1];
        *(unsigned*)(mix + (size_t)t * D + 512 + h * 128 + 2 * lane) = pk2(da * rstd * g0 * o0, db * rstd * g1 * o1);
    }
}
__device__ __forceinline__ void ph_ln2(const MArgs& a, int G) {
    const float* x = a.in[0]; const bf16* mixout = (const bf16*)(a.ws + WS_MIXOUT); const float* mod = (const float*)(a.ws + WS_MOD); const float* ln1_g = a.in[10]; const float* ln1_b = a.in[11];
    float* x1 = a.out; bf16* u2 = (bf16*)(a.ws + WS_U2);
    const int tid = threadIdx.x, lane = tid & 63, wave = tid >> 6;
    for (int it = blockIdx.x; it < T / 128; it += G) {
        const int row0 = it * 128, b = row0 / S;
        for (int rr = wave; rr < 128; rr += NWAVES) {
            const int row = row0 + rr;
            f32x4 v[4]; float s = 0.f;
#pragma unroll
            for (int j = 0; j < 4; ++j) {
                const int col = 4 * lane + 256 * j;
                const f32x4 xv = *(const f32x4*)(x + (size_t)row * D + col);
                const f32x4 mo = ld_bf4(mixout + (size_t)row * D + col);
                const f32x4 g1 = *(const f32x4*)(mod + b * 6144 + 2048 + col);
                v[j] = xv * DN_ALPHA + g1 * mo; s += (v[j].x + v[j].y) + (v[j].z + v[j].w);
            }
            float mean = wave_sum(s) * (1.f / D), s2 = 0.f;
#pragma unroll
            for (int j = 0; j < 4; ++j) { v[j] = v[j] - mean; s2 += (v[j].x * v[j].x + v[j].y * v[j].y) + (v[j].z * v[j].z + v[j].w * v[j].w); }
            float rstd = 1.f / sqrtf(wave_sum(s2) * (1.f / D) + LN_EPS);
            s = 0.f;
#pragma unroll
            for (int j = 0; j < 4; ++j) { const int col = 4 * lane + 256 * j;
                v[j] = v[j] * rstd * *(const f32x4*)(ln1_g + col) + *(const f32x4*)(ln1_b + col);
                *(f32x4*)(x1 + (size_t)row * D + col) = v[j]; s += (v[j].x + v[j].y) + (v[j].z + v[j].w); }
            mean = wave_sum(s) * (1.f / D); s2 = 0.f;
#pragma unroll
            for (int j = 0; j < 4; ++j) { v[j] = v[j] - mean; s2 += (v[j].x * v[j].x + v[j].y * v[j].y) + (v[j].z * v[j].z + v[j].w * v[j].w); }
            rstd = 1.f / sqrtf(wave_sum(s2) * (1.f / D) + LN_EPS);
#pragma unroll
            for (int j = 0; j < 4; ++j) { const int col = 4 * lane + 256 * j;
                const f32x4 u = v[j] * rstd * (*(const f32x4*)(mod + b * 6144 + 4096 + col) + 1.0f) + *(const f32x4*)(mod + b * 6144 + 3072 + col);
                *(unsigned long long*)(u2 + (size_t)row * D + col) = (unsigned long long)pk2(u.x, u.y) | ((unsigned long long)pk2(u.z, u.w) << 32); }
        }
    }
}
__device__ __forceinline__ void route_token(int t, const float* __restrict__ logits, const float* __restrict__ rbias, int* __restrict__ tope, float* __restrict__ topg, int* __restrict__ cnt) {
    const float* lg = logits + (size_t)t * NE;
    float gs[8];
#pragma unroll
    for (int g = 0; g < 8; ++g) { float m1 = -INFINITY, m2 = -INFINITY;
        for (int i = 0; i < 32; ++i) { const int e = g * 32 + i; const float v = sigmoidf_(lg[e]) + rbias[e]; if (v > m1) { m2 = m1; m1 = v; } else if (v > m2) m2 = v; }
        gs[g] = m1 + m2; }
    unsigned gmask = 0;
#pragma unroll
    for (int r = 0; r < 4; ++r) { int bi = 0; float bv = -INFINITY;
#pragma unroll
        for (int g = 0; g < 8; ++g) if (!((gmask >> g) & 1u) && gs[g] > bv) { bv = gs[g]; bi = g; }
        gmask |= 1u << bi; }
    float pv = INFINITY; int pi = -1; float gsum = 0.f; int se[8]; float sg[8];
#pragma unroll
    for (int r = 0; r < 8; ++r) { int bi = 0; float bv = -INFINITY, bs = 0.f;
        for (int e = 0; e < NE; ++e) { if (!((gmask >> (e >> 5)) & 1u)) continue;
            const float sc = sigmoidf_(lg[e]), v = sc + rbias[e];
            const bool elig = (v < pv) || (v == pv && e > pi);
            if (elig && v > bv) { bv = v; bi = e; bs = sc; } }
        pv = bv; pi = bi; gsum += bs; se[r] = bi; sg[r] = bs; }
    const float inv = 2.5f / gsum;
#pragma unroll
    for (int r = 0; r < 8; ++r) { const int e = se[r]; tope[t * 8 + r] = e; topg[t * 8 + r] = sg[r] * inv; atomicAdd(cnt + e, 1); }
}
__device__ __forceinline__ void moe_tables(const int* cnt, LAS int* tb, LAS int* nn) {
    if (threadIdx.x < 64) {
        const int lane = threadIdx.x; int n[4], tl[4], loc = 0;
#pragma unroll
        for (int j = 0; j < 4; ++j) { n[j] = cnt[4 * lane + j]; tl[j] = (n[j] + 255) >> 8; loc += tl[j]; }
        int inc = loc;
#pragma unroll
        for (int o = 1; o < 64; o <<= 1) { const int v = __shfl_up(inc, o); if (lane >= o) inc += v; }
        int base = inc - loc;
#pragma unroll
        for (int j = 0; j < 4; ++j) { tb[4 * lane + j] = base; nn[4 * lane + j] = n[j]; base += tl[j]; }
        if (lane == 63) { tb[NE] = base; nn[NE] = T; tb[NEX] = base + T / 256; }
    }
    __syncthreads();
}
__device__ __forceinline__ void ph_final(const MArgs& a, int G) {
    float* out = a.out; const bf16* ys = (const bf16*)(a.ws + WS_YS); const bf16* ysh = (const bf16*)(a.ws + WS_YSH); const float* mod = (const float*)(a.ws + WS_MOD);
    const float* ln2_g = a.in[20]; const float* ln2_b = a.in[21];
    const int tid = threadIdx.x, lane = tid & 63, wave = tid >> 6;
    for (int it = blockIdx.x; it < T / 128; it += G) {
        const int row0 = it * 128, b = row0 / S;
        for (int rr = wave; rr < 128; rr += NWAVES) {
            const int row = row0 + rr;
            f32x4 v[4]; float s = 0.f;
#pragma unroll
            for (int j = 0; j < 4; ++j) { const int col = 4 * lane + 256 * j;
                f32x4 y = ld_bf4(ysh + (size_t)row * D + col);
#pragma unroll
                for (int k = 0; k < 8; ++k) y = y + ld_bf4(ys + ((size_t)row * 8 + k) * D + col);
                v[j] = *(const f32x4*)(out + (size_t)row * D + col) * DN_ALPHA + *(const f32x4*)(mod + b * 6144 + 5120 + col) * y;
                s += (v[j].x + v[j].y) + (v[j].z + v[j].w); }
            const float mean = wave_sum(s) * (1.f / D); float s2 = 0.f;
#pragma unroll
            for (int j = 0; j < 4; ++j) { v[j] = v[j] - mean; s2 += (v[j].x * v[j].x + v[j].y * v[j].y) + (v[j].z * v[j].z + v[j].w * v[j].w); }
            const float rstd = 1.f / sqrtf(wave_sum(s2) * (1.f / D) + LN_EPS);
#pragma unroll
            for (int j = 0; j < 4; ++j) { const int col = 4 * lane + 256 * j;
                *(f32x4*)(out + (size_t)row * D + col) = v[j] * rstd * *(const f32x4*)(ln2_g + col) + *(const f32x4*)(ln2_b + col); }
        }
    }
}


typedef short s16x4 __attribute__((ext_vector_type(4)));
typedef short bf16x8v __attribute__((ext_vector_type(8)));
typedef float f32x16 __attribute__((ext_vector_type(16)));
constexpr int MLP = 320;
constexpr int NCH = S / 64;
constexpr int ST_ELEMS = 129 * 128;
constexpr size_t WS_CHK = WS_GATES + 1 * MiB;
constexpr size_t WS_MPREV = WS_GATES + 1 * MiB + 65536;
constexpr size_t WS_KC = WS_U2;
__device__ __forceinline__ s16x4 tr_read(const LAS unsigned char* p) { return __builtin_bit_cast(s16x4, __builtin_amdgcn_ds_read_tr16_b64_v4i16((LAS s16x4*)p)); }
__device__ __forceinline__ bf16x8v tr_frag(const LAS unsigned char* tile, int row0, int col0, int lane) {
    const int i = lane & 15; const LAS unsigned char* p = tile + (row0 + (i >> 2)) * MLP + (col0 + 4 * (i & 3)) * 2;
    const s16x4 lo = tr_read(p), hi = tr_read(p + 4 * MLP);
    return __builtin_shufflevector(lo, hi, 0, 1, 2, 3, 4, 5, 6, 7);
}
__device__ __forceinline__ bf16x8v tr_frag_perm(const LAS unsigned char* tile, int row0, int col0, int lane) {
    const int i = lane & 15; const LAS unsigned char* p = tile + (row0 + (i >> 2)) * MLP + (col0 + 4 * (i & 3)) * 2;
    const s16x4 lo = tr_read(p), hi = tr_read(p + 8 * MLP);
    return __builtin_shufflevector(lo, hi, 0, 1, 2, 3, 4, 5, 6, 7);
}
__device__ __forceinline__ float wave_incl_sum(float v, int lane) {
#pragma unroll
    for (int o = 1; o < 64; o <<= 1) { const float u = __shfl_up(v, o); if (lane >= o) v += u; }
    return v;
}
__device__ __forceinline__ float wave_incl_max(float v, int lane) {
#pragma unroll
    for (int o = 1; o < 64; o <<= 1) { const float u = __shfl_up(v, o); if (lane >= o) v = fmaxf(v, u); }
    return v;
}
__device__ __forceinline__ float wave_max(float v) {
#pragma unroll
    for (int o = 1; o < 64; o <<= 1) v = fmaxf(v, __shfl_xor(v, o));
    return v;
}
__device__ __forceinline__ void conv8(const bf16* __restrict__ rowp, int spos, const float* __restrict__ cw, const float* __restrict__ cb, float scale, float (&y)[8]) {
    const f32x4 b0 = *(const f32x4*)cb, b1 = *(const f32x4*)(cb + 4);
    y[0] = b0.x; y[1] = b0.y; y[2] = b0.z; y[3] = b0.w; y[4] = b1.x; y[5] = b1.y; y[6] = b1.z; y[7] = b1.w;
#pragma unroll
    for (int j = 0; j < 4; ++j) {
        if (spos - 3 + j >= 0) {
            const v4u xr = *(const v4u*)(rowp + (ptrdiff_t)(j - 3) * NPROJ);
            const f32x4 w0 = *(const f32x4*)(cw + j * 1024), w1 = *(const f32x4*)(cw + j * 1024 + 4);
            y[0] += w0.x * bf2f(xr.x & 0xffffu); y[1] += w0.y * bf2f(xr.x >> 16); y[2] += w0.z * bf2f(xr.y & 0xffffu); y[3] += w0.w * bf2f(xr.y >> 16);
            y[4] += w1.x * bf2f(xr.z & 0xffffu); y[5] += w1.y * bf2f(xr.z >> 16); y[6] += w1.z * bf2f(xr.w & 0xffffu); y[7] += w1.w * bf2f(xr.w >> 16);
        }
    }
#pragma unroll
    for (int e = 0; e < 8; ++e) y[e] = siluf_(y[e]) * scale;
}
__device__ __forceinline__ v4u pack8(const float (&y)[8]) { v4u o; o.x = pk2(y[0], y[1]); o.y = pk2(y[2], y[3]); o.z = pk2(y[4], y[5]); o.w = pk2(y[6], y[7]); return o; }

__device__ __forceinline__ void ml_phaseA(const MArgs& a, LAS unsigned char* lds, int vb0, int nvb) {
    const int tid = threadIdx.x, lane = tid & 63, wave = __builtin_amdgcn_readfirstlane(tid >> 6);
    const bf16* proj = (const bf16*)(a.ws + WS_PROJ); const float* conv_w = a.in[5]; const float* conv_b = a.in[6];
    const float* ipre = (const float*)(a.ws + WS_GATES); const float* logf = ipre + 16 * S;
    bf16* kcg = (bf16*)(a.ws + WS_KC); bf16* st = (bf16*)(a.ws + WS_STATES); float* chk = (float*)(a.ws + WS_CHK);
    LAS unsigned char* Kt = lds; LAS unsigned char* Vt = lds + 64 * MLP; LAS float* wkL = (LAS float*)(lds + 128 * MLP);
    for (int unit = vb0; unit < 16 * NCH; unit += nvb) {
        const int bh = unit >> 7, c = unit & (NCH - 1), b = bh >> 2, h = bh & 3, s0 = c * 64; const size_t row0 = (size_t)b * S + s0;
        if (wave == 0) {
            const float lf = logf[(size_t)bh * S + s0 + lane], ic = ipre[(size_t)bh * S + s0 + lane];
            const float bc = wave_incl_sum(lf, lane), g = ic - bc, gmax = wave_max(g), blast = __shfl(bc, 63);
            wkL[lane] = __expf(g - gmax);
            if (lane == 0) { chk[(size_t)unit * 2] = blast; chk[(size_t)unit * 2 + 1] = blast + gmax; }
        }
#pragma unroll
        for (int q = 0; q < 2; ++q) { const int it = tid + q * NTHR, tt = it >> 4, c8 = it & 15, ch = h * 128 + c8 * 8;
            float y[8]; conv8(proj + (row0 + tt) * NPROJ + C_MLK + ch, s0 + tt, conv_w + 512 + ch, conv_b + 512 + ch, 0.08838834764831845f, y);
            const v4u o = pack8(y);
            *(LAS v4u*)(Kt + tt * MLP + c8 * 16) = o; *(v4u*)(kcg + (row0 + tt) * 512 + ch) = o; }
        __syncthreads();
#pragma unroll
        for (int q = 0; q < 2; ++q) { const int it = tid + q * NTHR, tt = it >> 4, c8 = it & 15;
            const v4u xr = *(const v4u*)(proj + (row0 + tt) * NPROJ + C_MLV + h * 128 + c8 * 8); const float w = wkL[tt];
            float y[8] = {bf2f(xr.x & 0xffffu) * w, bf2f(xr.x >> 16) * w, bf2f(xr.y & 0xffffu) * w, bf2f(xr.y >> 16) * w, bf2f(xr.z & 0xffffu) * w, bf2f(xr.z >> 16) * w, bf2f(xr.w & 0xffffu) * w, bf2f(xr.w >> 16) * w};
            *(LAS v4u*)(Vt + tt * MLP + c8 * 16) = pack8(y); }
        __syncthreads();
        {
            const int dvb = wave >> 1, dkh = wave & 1, hh = lane >> 5, gsel = (lane >> 4) & 1;
            f32x16 acc[2];
#pragma unroll
            for (int nb = 0; nb < 2; ++nb)
#pragma unroll
                for (int i = 0; i < 16; ++i) acc[nb][i] = 0.f;
#pragma unroll
            for (int kk = 0; kk < 4; ++kk) {
                const bf16x8v Bv = tr_frag(Vt, 16 * kk + 8 * hh, 32 * dvb + 16 * gsel, lane);
#pragma unroll
                for (int nb = 0; nb < 2; ++nb) { const bf16x8v Ak = tr_frag(Kt, 16 * kk + 8 * hh, 32 * (2 * dkh + nb) + 16 * gsel, lane);
                    acc[nb] = __builtin_amdgcn_mfma_f32_32x32x16_bf16(Ak, Bv, acc[nb], 0, 0, 0); }
            }
            bf16* stc = st + (size_t)unit * ST_ELEMS;
#pragma unroll
            for (int nb = 0; nb < 2; ++nb)
#pragma unroll
                for (int g4 = 0; g4 < 4; ++g4) { const int dk = 32 * (2 * dkh + nb) + 8 * g4 + 4 * hh, dv = 32 * dvb + (lane & 31);
                    *(unsigned long long*)(stc + (size_t)dv * 128 + dk) = (unsigned long long)pk2(acc[nb][4 * g4], acc[nb][4 * g4 + 1]) | ((unsigned long long)pk2(acc[nb][4 * g4 + 2], acc[nb][4 * g4 + 3]) << 32); }
        }
        if (tid < 128) { float s = 0.f;
#pragma unroll 8
            for (int t = 0; t < 64; ++t) s += wkL[t] * bf2f(*(const LAS unsigned short*)(Kt + t * MLP + tid * 2));
            st[(size_t)unit * ST_ELEMS + 128 * 128 + tid] = (bf16)f2bf(s); }
        __syncthreads();
    }
}

__device__ __forceinline__ void ml_phaseB(const MArgs& a, LAS unsigned char* lds, int G) {
    const int tid = threadIdx.x;
    bf16* st = (bf16*)(a.ws + WS_STATES); const float* chk = (const float*)(a.ws + WS_CHK); float* mprev = (float*)(a.ws + WS_MPREV);
    LAS float* al = (LAS float*)lds; LAS float* be = al + NCH;
    constexpr int NSL = (ST_ELEMS + 1023) / 1024;
    for (int item = blockIdx.x; item < 16 * NSL; item += G) {
        const int bh = item / NSL, sl = item % NSL;
        __syncthreads();
        if (tid == 0) { float m = 0.f;
            for (int c = 0; c < NCH; ++c) { const float bl = chk[(size_t)(bh * NCH + c) * 2], M = chk[(size_t)(bh * NCH + c) * 2 + 1];
                const float mn = fmaxf(bl + m, M); al[c] = __expf(bl + m - mn); be[c] = __expf(M - mn);
                if (sl == 0) mprev[bh * NCH + c] = m;
                m = mn; } }
        __syncthreads();
        const int off = sl * 1024 + tid * 2;
        if (off < ST_ELEMS) {
            unsigned* p = (unsigned*)(st + (size_t)bh * NCH * ST_ELEMS + off);
            float c0 = 0.f, c1 = 0.f;
            for (int cb = 0; cb < NCH; cb += 16) { unsigned d[16];
#pragma unroll
                for (int j = 0; j < 16; ++j) d[j] = p[(size_t)(cb + j) * (ST_ELEMS / 2)];
#pragma unroll
                for (int j = 0; j < 16; ++j) { p[(size_t)(cb + j) * (ST_ELEMS / 2)] = pk2(c0, c1);
                    c0 = al[cb + j] * c0 + be[cb + j] * bf2f(d[j] & 0xffffu); c1 = al[cb + j] * c1 + be[cb + j] * bf2f(d[j] >> 16); } }
        }
    }
}

__device__ __forceinline__ void ml_phaseC(const MArgs& a, LAS unsigned char* lds, int G) {
    const int tid = threadIdx.x, lane = tid & 63, wave = __builtin_amdgcn_readfirstlane(tid >> 6);
    const bf16* proj = (const bf16*)(a.ws + WS_PROJ); const float* conv_w = a.in[5]; const float* conv_b = a.in[6]; const float* norm_g = a.in[8];
    const float* ipre = (const float*)(a.ws + WS_GATES); const float* logf = ipre + 16 * S;
    const bf16* kcg = (const bf16*)(a.ws + WS_KC); const bf16* st = (const bf16*)(a.ws + WS_STATES); const float* mprev = (const float*)(a.ws + WS_MPREV);
    bf16* mix = (bf16*)(a.ws + WS_MIX);
    LAS unsigned char* Qt = lds; LAS unsigned char* Kt = lds + 64 * MLP; LAS unsigned char* Vt = lds + 128 * MLP; LAS unsigned char* Ct = lds + 192 * MLP;
    LAS float* sc = (LAS float*)(lds + 320 * MLP);
    LAS float* gL = sc; LAS float* mmL = sc + 64; LAS float* siL = sc + 128; LAS float* emL = sc + 192; LAS float* npv = sc + 256; LAS float* lnS = sc + 384;
    const int tb = wave >> 2, dvb = wave & 3, r = lane & 31, hh = lane >> 5, gsel = (lane >> 4) & 1;
    for (int unit = blockIdx.x; unit < 16 * NCH; unit += G) {
        const int bh = unit >> 7, c = unit & (NCH - 1), b = bh >> 2, h = bh & 3, s0 = c * 64; const size_t row0 = (size_t)b * S + s0;
        if (wave == 0) {
            const float lf = logf[(size_t)bh * S + s0 + lane], ic = ipre[(size_t)bh * S + s0 + lane], mp = mprev[unit];
            const float bc = wave_incl_sum(lf, lane), g = ic - bc, pm = wave_incl_max(g, lane), mm = fmaxf(mp, pm);
            gL[lane] = g; mmL[lane] = mm; siL[lane] = __expf(mp - mm); emL[lane] = __expf(-(bc + mm));
        }
        const bf16* stc = st + (size_t)unit * ST_ELEMS;
#pragma unroll
        for (int q = 0; q < 2; ++q) { const int it = tid + q * NTHR, tt = it >> 4, c8 = it & 15, ch = h * 128 + c8 * 8;
            float y[8]; conv8(proj + (row0 + tt) * NPROJ + C_MLQ + ch, s0 + tt, conv_w + ch, conv_b + ch, 1.f, y);
            *(LAS v4u*)(Qt + tt * MLP + c8 * 16) = pack8(y);
            *(LAS v4u*)(Kt + tt * MLP + c8 * 16) = *(const v4u*)(kcg + (row0 + tt) * 512 + ch);
            *(LAS v4u*)(Vt + tt * MLP + c8 * 16) = *(const v4u*)(proj + (row0 + tt) * NPROJ + C_MLV + ch); }
#pragma unroll
        for (int q = 0; q < 4; ++q) { const int it = tid + q * NTHR, dv = it >> 4, c8 = it & 15;
            *(LAS v4u*)(Ct + dv * MLP + c8 * 16) = *(const v4u*)(stc + dv * 128 + c8 * 8); }
        if (tid < 128) npv[tid] = bf2f(stc[128 * 128 + tid]);
        __syncthreads();
        bf16x8v qf[8];
#pragma unroll
        for (int kk = 0; kk < 8; ++kk) qf[kk] = *(const LAS bf16x8v*)(Qt + (32 * tb + r) * MLP + (16 * kk + 8 * hh) * 2);
        const float mm_t = mmL[32 * tb + r], si_t = siL[32 * tb + r], em_t = emL[32 * tb + r];
        float nq = 0.f;
#pragma unroll
        for (int kk = 0; kk < 8; ++kk) { const f32x4 n0 = *(const LAS f32x4*)(npv + 16 * kk + 8 * hh), n1 = *(const LAS f32x4*)(npv + 16 * kk + 8 * hh + 4);
            nq += n0.x * bf2f((unsigned short)qf[kk][0]) + n0.y * bf2f((unsigned short)qf[kk][1]) + n0.z * bf2f((unsigned short)qf[kk][2]) + n0.w * bf2f((unsigned short)qf[kk][3])
                + n1.x * bf2f((unsigned short)qf[kk][4]) + n1.y * bf2f((unsigned short)qf[kk][5]) + n1.z * bf2f((unsigned short)qf[kk][6]) + n1.w * bf2f((unsigned short)qf[kk][7]); }
        nq += __shfl_xor(nq, 32);
        f32x16 num;
#pragma unroll
        for (int i = 0; i < 16; ++i) num[i] = 0.f;
#pragma unroll
        for (int kk = 0; kk < 8; ++kk) { const bf16x8v Ac = *(const LAS bf16x8v*)(Ct + (32 * dvb + r) * MLP + (16 * kk + 8 * hh) * 2);
            num = __builtin_amdgcn_mfma_f32_32x32x16_bf16(Ac, qf[kk], num, 0, 0, 0); }
#pragma unroll
        for (int i = 0; i < 16; ++i) num[i] *= si_t;
        float wsum = 0.f;
        for (int sb = 0; sb <= tb; ++sb) {
            f32x16 sT;
#pragma unroll
            for (int i = 0; i < 16; ++i) sT[i] = 0.f;
#pragma unroll
            for (int kk = 0; kk < 8; ++kk) { const bf16x8v Ak = *(const LAS bf16x8v*)(Kt + (32 * sb + r) * MLP + (16 * kk + 8 * hh) * 2);
                sT = __builtin_amdgcn_mfma_f32_32x32x16_bf16(Ak, qf[kk], sT, 0, 0, 0); }
            unsigned wp[8];
#pragma unroll
            for (int g4 = 0; g4 < 4; ++g4) { const f32x4 gv = *(const LAS f32x4*)(gL + 32 * sb + 8 * g4 + 4 * hh);
                float w[4];
#pragma unroll
                for (int e = 0; e < 4; ++e) { const int srow = 32 * sb + 8 * g4 + 4 * hh + e; const bool valid = srow <= 32 * tb + r;
                    w[e] = valid ? sT[4 * g4 + e] * __expf(gv[e] - mm_t) : 0.f; wsum += w[e]; }
                wp[2 * g4] = pk2(w[0], w[1]); wp[2 * g4 + 1] = pk2(w[2], w[3]); }
#pragma unroll
            for (int s2 = 0; s2 < 2; ++s2) {
                const bf16x8v Av = tr_frag_perm(Vt, 32 * sb + 16 * s2 + 4 * hh, 32 * dvb + 16 * gsel, lane);
                v4u bw; bw.x = wp[4 * s2]; bw.y = wp[4 * s2 + 1]; bw.z = wp[4 * s2 + 2]; bw.w = wp[4 * s2 + 3];
                num = __builtin_amdgcn_mfma_f32_32x32x16_bf16(Av, __builtin_bit_cast(bf16x8v, bw), num, 0, 0, 0); }
        }
        wsum += __shfl_xor(wsum, 32);
        const float den = si_t * nq + wsum, rden = 1.f / fmaxf(fabsf(den), em_t);
        float ps = 0.f, pq = 0.f;
#pragma unroll
        for (int i = 0; i < 16; ++i) { num[i] *= rden; ps += num[i]; pq += num[i] * num[i]; }
        ps += __shfl_xor(ps, 32); pq += __shfl_xor(pq, 32);
        if (hh == 0) { lnS[((tb * 4 + dvb) * 32 + r) * 2] = ps; lnS[((tb * 4 + dvb) * 32 + r) * 2 + 1] = pq; }
        __syncthreads();
        float ts = 0.f, tq = 0.f;
#pragma unroll
        for (int d = 0; d < 4; ++d) { ts += lnS[((tb * 4 + d) * 32 + r) * 2]; tq += lnS[((tb * 4 + d) * 32 + r) * 2 + 1]; }
        const float mean = ts * (1.f / 128.f), rstd = 1.f / sqrtf(fmaxf(tq * (1.f / 128.f) - mean * mean, 0.f) + LN_EPS);
        const size_t trow = row0 + 32 * tb + r;
#pragma unroll
        for (int g4 = 0; g4 < 4; ++g4) { const int dv = 32 * dvb + 8 * g4 + 4 * hh;
            const f32x4 ng = *(const f32x4*)(norm_g + h * 128 + dv); const f32x4 og = ld_bf4(proj + trow * NPROJ + C_MLO + h * 128 + dv);
            float o[4];
#pragma unroll
            for (int e = 0; e < 4; ++e) o[e] = (num[4 * g4 + e] - mean) * rstd * ng[e] * sigmoidf_(og[e]);
            *(unsigned long long*)(mix + trow * D + 512 + h * 128 + dv) = (unsigned long long)pk2(o[0], o[1]) | ((unsigned long long)pk2(o[2], o[3]) << 32); }
        __syncthreads();
    }
}


constexpr int VTP = 192;
template <int PITCH> __device__ __forceinline__ bf16x8v tr_frag_perm_p(const LAS unsigned char* tile, int row0, int col0, int lane) {
    const int i = lane & 15; const LAS unsigned char* p = tile + (row0 + (i >> 2)) * PITCH + (col0 + 4 * (i & 3)) * 2;
    const s16x4 lo = tr_read(p), hi = tr_read(p + 8 * PITCH);
    return __builtin_shufflevector(lo, hi, 0, 1, 2, 3, 4, 5, 6, 7);
}
__device__ __forceinline__ void attn_phase(const bf16* __restrict__ proj, bf16* __restrict__ mix, LAS unsigned char* lds, int vb0, int nvb) {
    const int tid = threadIdx.x, lane = tid & 63, wave = __builtin_amdgcn_readfirstlane(tid >> 6);
    const int r = lane & 31, hh = lane >> 5, gsel = (lane >> 4) & 1;
    LAS unsigned char* Vt = lds + wave * (64 * VTP);
    bf16x8v ntri[2], nones;
#pragma unroll
    for (int s2 = 0; s2 < 2; ++s2)
#pragma unroll
        for (int j = 0; j < 8; ++j) { const int k = 16 * s2 + 8 * (j >> 2) + 4 * hh + (j & 3); ntri[s2][j] = (k >= r) ? (short)0xBF80 : (short)0; }
#pragma unroll
    for (int j = 0; j < 8; ++j) nones[j] = (short)0xBF80;
    for (int unit = vb0 * NWAVES + wave; unit < NB * 8 * (S / 32); unit += nvb * NWAVES) {
        const int bh = unit / (S / 32), qb = unit % (S / 32), b = bh >> 3, h = bh & 7, q0 = qb * 32;
        const bf16* base = proj + (size_t)b * S * NPROJ + h * 64;
        bf16x8v qf[4];
#pragma unroll
        for (int s = 0; s < 4; ++s) qf[s] = *(const bf16x8v*)(base + (size_t)(q0 + r) * NPROJ + C_SBQ + 16 * s + 8 * hh);
        f32x16 o[2];
#pragma unroll
        for (int d = 0; d < 2; ++d)
#pragma unroll
            for (int i = 0; i < 16; ++i) o[d][i] = 0.f;
        float carry = 0.f;
        const int qpos = q0 + r;
        for (int k0 = q0 - 32; ; k0 -= 64) {
            bf16x8v kf[2][4];
#pragma unroll
            for (int kb = 0; kb < 2; ++kb) { int key = k0 + 32 * kb + r; key = key < 0 ? 0 : key;
#pragma unroll
                for (int s = 0; s < 4; ++s) kf[kb][s] = *(const bf16x8v*)(base + (size_t)key * NPROJ + C_SBK + 16 * s + 8 * hh); }
#pragma unroll
            for (int i = 0; i < 8; ++i) { int key = k0 + (lane >> 3) + 8 * i; key = key < 0 ? 0 : key;
                *(LAS v4u*)(Vt + ((lane >> 3) + 8 * i) * VTP + (lane & 7) * 16) = *(const v4u*)(base + (size_t)key * NPROJ + C_SBV + (lane & 7) * 8); }
            f32x16 z[2];
#pragma unroll
            for (int kb = 0; kb < 2; ++kb) {
#pragma unroll
                for (int i = 0; i < 16; ++i) z[kb][i] = 0.f;
#pragma unroll
                for (int s = 0; s < 4; ++s) z[kb] = __builtin_amdgcn_mfma_f32_32x32x16_bf16(kf[kb][s], qf[s], z[kb], 0, 0, 0); }
            const bool need_mask = (k0 + 63 >= q0) || (k0 < 0);
            unsigned xp[2][8];
#pragma unroll
            for (int kb = 0; kb < 2; ++kb)
#pragma unroll
                for (int g4 = 0; g4 < 4; ++g4) { float sp[4];
#pragma unroll
                    for (int e = 0; e < 4; ++e) { const float zz = z[kb][4 * g4 + e];
                        float v = fmaxf(zz, 0.f) + __builtin_amdgcn_logf(1.f + __builtin_amdgcn_exp2f(-fabsf(zz)));
                        if (need_mask) { const int key = k0 + 32 * kb + 8 * g4 + 4 * hh + e; v = (key >= 0 && key < qpos) ? v : 0.f; }
                        sp[e] = v; }
                    xp[kb][2 * g4] = pk2(sp[0], sp[1]); xp[kb][2 * g4 + 1] = pk2(sp[2], sp[3]); }
            const float z00 = z[0][0];
#pragma unroll
            for (int s2 = 0; s2 < 2; ++s2) { v4u b1; b1.x = xp[1][4 * s2]; b1.y = xp[1][4 * s2 + 1]; b1.z = xp[1][4 * s2 + 2]; b1.w = xp[1][4 * s2 + 3];
                v4u b0; b0.x = xp[0][4 * s2]; b0.y = xp[0][4 * s2 + 1]; b0.z = xp[0][4 * s2 + 2]; b0.w = xp[0][4 * s2 + 3];
                z[1] = __builtin_amdgcn_mfma_f32_32x32x16_bf16(ntri[s2], __builtin_bit_cast(bf16x8v, b1), z[1], 0, 0, 0);
                z[0] = __builtin_amdgcn_mfma_f32_32x32x16_bf16(ntri[s2], __builtin_bit_cast(bf16x8v, b0), z[0], 0, 0, 0);
                z[0] = __builtin_amdgcn_mfma_f32_32x32x16_bf16(nones, __builtin_bit_cast(bf16x8v, b1), z[0], 0, 0, 0); }
            float tot = z00 - z[0][0];
            tot = __shfl(tot, r);
#pragma unroll
            for (int kb = 0; kb < 2; ++kb)
#pragma unroll
                for (int g4 = 0; g4 < 4; ++g4) { float p[4];
#pragma unroll
                    for (int e = 0; e < 4; ++e) { float v = __builtin_amdgcn_exp2f(z[kb][4 * g4 + e] - carry);
                        if (need_mask) { const int key = k0 + 32 * kb + 8 * g4 + 4 * hh + e; v = (key >= 0 && key < qpos) ? v : 0.f; }
                        p[e] = v; }
                    xp[kb][2 * g4] = pk2(p[0], p[1]); xp[kb][2 * g4 + 1] = pk2(p[2], p[3]); }
#pragma unroll
            for (int kb = 0; kb < 2; ++kb)
#pragma unroll
                for (int s2 = 0; s2 < 2; ++s2) { v4u bp; bp.x = xp[kb][4 * s2]; bp.y = xp[kb][4 * s2 + 1]; bp.z = xp[kb][4 * s2 + 2]; bp.w = xp[kb][4 * s2 + 3];
#pragma unroll
                    for (int d = 0; d < 2; ++d) { const bf16x8v Av = tr_frag_perm_p<VTP>(Vt, 32 * kb + 16 * s2 + 4 * hh, 32 * d + 16 * gsel, lane);
                        o[d] = __builtin_amdgcn_mfma_f32_32x32x16_bf16(Av, __builtin_bit_cast(bf16x8v, bp), o[d], 0, 0, 0); } }
            carry += tot;
            if (k0 <= 0) break;
            if (__all(carry > SB_THRESH)) break;
        }
        bf16* op = mix + (size_t)(b * S + q0 + r) * D + h * 64;
#pragma unroll
        for (int d = 0; d < 2; ++d)
#pragma unroll
            for (int g4 = 0; g4 < 4; ++g4)
                *(unsigned long long*)(op + 32 * d + 8 * g4 + 4 * hh) = (unsigned long long)pk2(o[d][4 * g4], o[d][4 * g4 + 1]) | ((unsigned long long)pk2(o[d][4 * g4 + 2], o[d][4 * g4 + 3]) << 32);
    }
}

__global__ void __launch_bounds__(NTHR, 2) mega_fwd(MArgs args) {
    extern __shared__ __attribute__((aligned(16))) unsigned char lds[];
    LAS unsigned char* ldsl = (LAS unsigned char*)lds;
    const int tid = threadIdx.x, G = gridDim.x;
    volatile LAS unsigned* MISC = (volatile LAS unsigned*)(ldsl + XTRA_OFF + X_MISC);
    LAS int* tb = (LAS int*)(ldsl + XTRA_OFF + X_TB); LAS int* nn = (LAS int*)(ldsl + XTRA_OFF + X_NN);
    for (int u = tid; u < (LDS_BYTES - XTRA_OFF) / 4; u += NTHR) ((LAS unsigned*)(ldsl + XTRA_OFF))[u] = 0u;
    __syncthreads();
    unsigned char* ws = args.ws;
    unsigned* ctl = (unsigned*)(ws + WS_CTL);
    XcdBarrier bar = xcd_barrier_post(ctl + CW_BAR, MISC + 8);
    const int lo = args.ph_lo, hi = args.ph_hi;
#define IN(k) (lo <= (k) && (k) < hi)
#ifndef REP_MASK
#define REP_MASK 0
#endif
#define PHASE(k, ...) do { if (IN(k)) { for (int rep_ = 0; rep_ < (((REP_MASK >> (k)) & 1) ? 2 : 1); ++rep_) { if (rep_) xcd_barrier(bar); __VA_ARGS__ } } if (IN(k) && IN((k) + 1)) xcd_barrier(bar); } while (0)
    int* cnt = (int*)ctl + CW_CNT; i32x2* list = (i32x2*)(ws + WS_ROUTE + 2 * MiB); float* topg = (float*)(ws + WS_ROUTE + 1 * MiB);
    PHASE(0, ph_mod_prep(args, lds, G););
    PHASE(1, ph_ln1(args, lds, G););
    PHASE(2, { pg8::StaticOrder So; So.init(ws + WS_U1, ws + WS_WTIN, T, NPROJ, D, G, blockIdx.x);
        pg8::EpiBf16 E{(bf16*)(ws + WS_PROJ), NPROJ, 2, QSCALE};
        pg8::gemm_phase<pg8::EpiBf16, pg8::StaticOrder, false>(ldsl, D, So, E); });
    PHASE(3, ml_phaseA(args, ldsl, blockIdx.x, G); attn_phase((const bf16*)(ws + WS_PROJ), (bf16*)(ws + WS_MIX), ldsl, blockIdx.x, G););
    PHASE(4, ml_phaseB(args, ldsl, G););
    PHASE(5, ml_phaseC(args, ldsl, G););
    PHASE(6, { pg8::StaticOrder So; So.init(ws + WS_MIX, ws + WS_WTOUT, T, D, D, G, blockIdx.x);
        pg8::EpiBf16 E{(bf16*)(ws + WS_MIXOUT), D, 0, 1.f};
        pg8::gemm_phase<pg8::EpiBf16, pg8::StaticOrder, false>(ldsl, D, So, E); });
    PHASE(7, ph_ln2(args, G););
    PHASE(8, { pg8::StaticOrder So; So.init(ws + WS_U2, ws + WS_WTR, T, NE, D, G, blockIdx.x);
        pg8::EpiF32 E{(float*)(ws + WS_LOGITS), NE};
        pg8::gemm_phase<pg8::EpiF32, pg8::StaticOrder, false>(ldsl, D, So, E); });
    PHASE(9, { for (int t = blockIdx.x * NTHR + tid; t < T; t += G * NTHR) route_token(t, (const float*)(ws + WS_LOGITS), args.in[13], (int*)(ws + WS_ROUTE), topg, cnt); });
    PHASE(10, { moe_tables(cnt, tb, nn); const int* tope = (const int*)(ws + WS_ROUTE); int* fill = (int*)ctl + CW_FILL;
        for (int id = blockIdx.x * NTHR + tid; id < T * TOPK; id += G * NTHR) { const int e = tope[id]; const int pos = atomicAdd(fill + e, 1);
            list[tb[e] * 256 + pos] = (i32x2){id, __float_as_int(topg[id])}; } });
    PHASE(11, { moe_tables(cnt, tb, nn);
        pg8::MoeOrder So{G, (int)blockIdx.x, tb[NEX] * 2, 1, tb, nn, list, (const char*)(ws + WS_U2), 0, (const char*)(ws + WS_WT13), (size_t)512 * D * 2, (size_t)256 * D * 2};
        pg8::EpiGlu E{(bf16*)(ws + WS_H)};
        pg8::gemm_phase<pg8::EpiGlu, pg8::MoeOrder, true>(ldsl, D, So, E); });
    PHASE(12, { moe_tables(cnt, tb, nn);
        pg8::MoeOrder So{G, (int)blockIdx.x, tb[NEX] * 4, 2, tb, nn, list, (const char*)(ws + WS_H), (size_t)256 * FF * 2, (const char*)(ws + WS_WT2), (size_t)D * FF * 2, (size_t)256 * FF * 2};
        pg8::EpiScatter E{(bf16*)(ws + WS_YS), (bf16*)(ws + WS_YSH), list, nn};
        pg8::gemm_phase<pg8::EpiScatter, pg8::MoeOrder, false>(ldsl, FF, So, E); });
    PHASE(13, ph_final(args, G););
#undef PHASE
#undef IN
}

#ifndef MK_UPTO
#define MK_UPTO 14
#endif
__global__ void k_nan_fill(float* out, int n) { for (int i = blockIdx.x * blockDim.x + threadIdx.x; i < n; i += gridDim.x * blockDim.x) out[i] = __builtin_nanf(""); }
extern "C" void kernel_launch(void* const* d_in, const int* in_sizes, int n_in, void* d_out, int out_size, void* d_ws, size_t ws_size, hipStream_t stream) {
    static int grid = 0;
    if (grid == 0) {
        int dev = 0, cus = 0, per_cu = 0; grid = -1;
        if (n_in != 22 || out_size != T * D || ws_size < WS_END) fprintf(stderr, "kernel_launch: unexpected shapes (n_in %d out %d ws %zu, need %zu)\n", n_in, out_size, ws_size, (size_t)WS_END);
        else if (hipGetDevice(&dev) != hipSuccess || hipDeviceGetAttribute(&cus, hipDeviceAttributeMultiprocessorCount, dev) != hipSuccess) fprintf(stderr, "kernel_launch: device query failed\n");
        else if (hipFuncSetAttribute((const void*)mega_fwd, hipFuncAttributeMaxDynamicSharedMemorySize, LDS_BYTES) != hipSuccess) fprintf(stderr, "kernel_launch: hipFuncSetAttribute failed\n");
        else if (hipOccupancyMaxActiveBlocksPerMultiprocessor(&per_cu, (const void*)mega_fwd, NTHR, LDS_BYTES) != hipSuccess || per_cu < 1) fprintf(stderr, "kernel_launch: occupancy query says %d blocks per CU\n", per_cu);
        else grid = cus;
        (void)hipGetLastError();
    }
    if (grid < 0) { k_nan_fill<<<1024, 256, 0, stream>>>((float*)d_out, out_size); return; }
    const float* x = (const float*)d_in[0];
    const float* conv_w = (const float*)d_in[5]; const float* conv_b = (const float*)d_in[6];
    const float* norm_g = (const float*)d_in[8]; const float* ln1_g = (const float*)d_in[10]; const float* ln1_b = (const float*)d_in[11];
    const float* rbias = (const float*)d_in[13]; const float* ln2_g = (const float*)d_in[20]; const float* ln2_b = (const float*)d_in[21];
    char* ws = (char*)d_ws; float* out = (float*)d_out;
    float* mod = (float*)(ws + WS_MOD); bf16* wtin = (bf16*)(ws + WS_WTIN); bf16* wtout = (bf16*)(ws + WS_WTOUT); bf16* wtr = (bf16*)(ws + WS_WTR);
    bf16* wt13 = (bf16*)(ws + WS_WT13); bf16* wt2 = (bf16*)(ws + WS_WT2); int* plan = (int*)(ws + WS_PLAN);
    bf16* u1 = (bf16*)(ws + WS_U1); bf16* proj = (bf16*)(ws + WS_PROJ); float* ipre = (float*)(ws + WS_GATES); float* logf = ipre + 16 * S;
    float* hraw = (float*)(ws + WS_HRAW); bf16* mix = (bf16*)(ws + WS_MIX); bf16* mixout = (bf16*)(ws + WS_MIXOUT); bf16* u2 = (bf16*)(ws + WS_U2);
    float* logits = (float*)(ws + WS_LOGITS); int* tope = (int*)(ws + WS_ROUTE); float* topg = (float*)(ws + WS_ROUTE + 1 * MiB); i32x2* list = (i32x2*)(ws + WS_ROUTE + 2 * MiB);
    bf16* H = (bf16*)(ws + WS_H); bf16* ys = (bf16*)(ws + WS_YS); bf16* ysh = (bf16*)(ws + WS_YSH);
    int* cnt = (int*)(ws + WS_CTL) + CW_CNT;
    (void)hipMemsetAsync(ws + WS_CTL, 0, 1 * MiB, stream);
    if (MK_UPTO > 0) {
        MArgs a{};
        for (int i = 0; i < 22; ++i) a.in[i] = (const float*)d_in[i];
        a.out = out; a.ws = (unsigned char*)d_ws; a.ph_lo = 0; a.ph_hi = MK_UPTO;
        hipLaunchKernelGGL(mega_fwd, dim3(grid), dim3(NTHR), LDS_BYTES, stream, a);
    }
    if (MK_UPTO <= 0) { k_mod<<<192, 512, 0, stream>>>((const float*)d_in[1], (const float*)d_in[2], (const float*)d_in[3], mod);
        PrepArgs pa{(const float*)d_in[4], (const float*)d_in[9], (const float*)d_in[12], (const float*)d_in[14], (const float*)d_in[15], (const float*)d_in[16], (const float*)d_in[17], (const float*)d_in[18], (const float*)d_in[19], wtin, wtout, wtr, wt13, wt2};
        k_prep<<<2048, 512, 0, stream>>>(pa); }
    if (MK_UPTO <= 1) k_ln1<<<T / 128, 512, 0, stream>>>(x, mod, (const float*)d_in[4], (const float*)d_in[7], u1, ipre, logf);
    if (MK_UPTO <= 2) k_ngemm<0><<<dim3(NPROJ / 64, T / 64), 256, 0, stream>>>(u1, wtin, proj, T, NPROJ, D, NPROJ, 512, QSCALE);
    if (MK_UPTO <= 3) { k_attn_naive<<<NB * 8 * S / 256, 256, 0, stream>>>(proj, mix); k_mlstm_naive<<<128, 256, 0, stream>>>(proj, conv_w, conv_b, ipre, logf, hraw);
        k_mlnorm_naive<<<T, 256, 0, stream>>>(hraw, proj, norm_g, mix); }
    if (MK_UPTO <= 6) k_ngemm<0><<<dim3(D / 64, T / 64), 256, 0, stream>>>(mix, wtout, mixout, T, D, D, D, 0, 1.f);
    if (MK_UPTO <= 7) k_ln2<<<T / 128, 512, 0, stream>>>(x, mixout, mod, ln1_g, ln1_b, out, u2);
    if (MK_UPTO <= 8) k_ngemm<1><<<dim3(NE / 64, T / 64), 256, 0, stream>>>(u2, wtr, logits, T, NE, D, NE, 0, 1.f);
    if (MK_UPTO <= 9) k_route<<<T / 256, 256, 0, stream>>>(logits, rbias, tope, topg, cnt);
    constexpr int MAXT64 = T * TOPK / 64 + NE + T / 64;
    if (MK_UPTO <= 12) k_plan<<<1, 64, 0, stream>>>(cnt, plan);
    if (MK_UPTO <= 10) k_fill<<<T * TOPK / 256, 256, 0, stream>>>(tope, topg, plan, cnt + (CW_FILL - CW_CNT), list);
    if (MK_UPTO <= 11) k_moe1_naive<<<dim3(4, MAXT64), 256, 0, stream>>>(u2, wt13, cnt, plan, list, H);
    if (MK_UPTO <= 12) k_moe2_naive<<<dim3(16, MAXT64), 256, 0, stream>>>(H, wt2, cnt, plan, list, topg, ys, ysh);
    if (MK_UPTO <= 13) k_final<<<T / 128, 512, 0, stream>>>(out, ys, ysh, mod, ln2_g, ln2_b);
}
```

```cpp
#include <hip/hip_runtime.h>
#include <cstdio>
#include <cstdint>

typedef unsigned short bf16;
typedef unsigned v4u __attribute__((ext_vector_type(4)));
typedef float f32x4 __attribute__((ext_vector_type(4)));
typedef int i32x2 __attribute__((ext_vector_type(2)));

constexpr int D = 1024, NB = 4, S = 8192, T = NB * S;
constexpr int NPROJ = 3584, WIN_LD = 3592;
constexpr int C_SBQ = 0, C_SBK = 512, C_SBV = 1024, C_MLQ = 1536, C_MLK = 2048, C_MLV = 2560, C_MLO = 3072, C_GATE = 3584;
constexpr int NE = 256, NEX = 257, TOPK = 8, FF = 256;
constexpr float LN_EPS = 1e-5f;
constexpr float DN_ALPHA = 1.189207115002721f;
constexpr float LOG2E = 1.4426950408889634f;
constexpr float QSCALE = 0.125f * LOG2E;
constexpr float SB_THRESH = 48.0f;

constexpr size_t MiB = 1u << 20;
constexpr size_t WS_CTL = 0;
constexpr size_t WS_MOD = 1 * MiB;
constexpr size_t WS_WTIN = 2 * MiB;
constexpr size_t WS_WTOUT = 10 * MiB;
constexpr size_t WS_WTR = 12 * MiB;
constexpr size_t WS_PLAN = 13 * MiB;
constexpr size_t WS_WT2 = 16 * MiB;
constexpr size_t WS_YS = 145 * MiB;
constexpr size_t WS_WT13 = 145 * MiB;
constexpr size_t WS_PROJ = 402 * MiB;
constexpr size_t WS_GATES = 626 * MiB;
constexpr size_t WS_H = 657 * MiB;
constexpr size_t WS_STATES = 657 * MiB;
constexpr size_t WS_MIXOUT = 657 * MiB;
constexpr size_t WS_LOGITS = 657 * MiB;
constexpr size_t WS_U1 = 725 * MiB;
constexpr size_t WS_MIX = 725 * MiB;
constexpr size_t WS_U2 = 833 * MiB;
constexpr size_t WS_YSH = 833 * MiB;
constexpr size_t WS_HRAW = 833 * MiB;
constexpr size_t WS_ROUTE = 897 * MiB;
constexpr size_t WS_END = 902 * MiB;
constexpr int CW_CNT = 1024;
constexpr int CW_FILL = 1536;
constexpr int PL_SLOT = 0, PL_T64 = 512, PL_T256 = 1024;

__device__ __forceinline__ unsigned f2bf(float f) { unsigned u = __builtin_bit_cast(unsigned, f); return (u + 0x7fffu + ((u >> 16) & 1u)) >> 16; }
__device__ __forceinline__ float bf2f(unsigned b) { return __builtin_bit_cast(float, b << 16); }
__device__ __forceinline__ unsigned pk2(float lo, float hi) { return f2bf(lo) | (f2bf(hi) << 16); }
__device__ __forceinline__ float wave_sum(float v) {
#pragma unroll
    for (int o = 1; o < 64; o <<= 1) v += __shfl_xor(v, o);
    return v;
}
__device__ __forceinline__ float sigmoidf_(float x) { return 1.f / (1.f + __expf(-x)); }
__device__ __forceinline__ float siluf_(float x) { return x / (1.f + __expf(-x)); }

__global__ void __launch_bounds__(512) k_mod(const float* __restrict__ c, const float* __restrict__ w_ada, const float* __restrict__ b_ada, float* __restrict__ mod) {
    __shared__ float sc[NB][D];
    __shared__ float red[16][NB][32];
    const int tid = threadIdx.x;
    for (int i = tid; i < NB * D; i += 512) sc[i / D][i % D] = siluf_(c[i]);
    __syncthreads();
    const int kq = tid >> 5, jl = tid & 31, j = blockIdx.x * 32 + jl;
    float a0 = 0.f, a1 = 0.f, a2 = 0.f, a3 = 0.f;
#pragma unroll 16
    for (int kk = 0; kk < 64; ++kk) { const int k = kq * 64 + kk; const float w = w_ada[(size_t)k * 6144 + j];
        a0 += sc[0][k] * w; a1 += sc[1][k] * w; a2 += sc[2][k] * w; a3 += sc[3][k] * w; }
    red[kq][0][jl] = a0; red[kq][1][jl] = a1; red[kq][2][jl] = a2; red[kq][3][jl] = a3;
    __syncthreads();
    if (tid < 128) { const int b = tid >> 5; float s = b_ada[j];
#pragma unroll
        for (int q = 0; q < 16; ++q) s += red[q][b][jl];
        mod[b * 6144 + j] = s; }
}

__device__ __forceinline__ void transpose_item(const float* __restrict__ W, int ldw, bf16* __restrict__ WT, int ldt, int k0, int n0, int rowmap, int lane) {
    const int g = lane >> 4, i = lane & 15;
    f32x4 v[16];
#pragma unroll
    for (int r = 0; r < 16; ++r) v[r] = __builtin_nontemporal_load((const f32x4*)(W + (size_t)(k0 + 16 * g + r) * ldw + n0 + 4 * i));
#pragma unroll
    for (int nn = 0; nn < 4; ++nn) {
        const int n = n0 + 4 * i + nn;
        const int dr = rowmap == 0 ? n : ((n >> 7) * 256 + (rowmap == 2 ? 128 : 0) + (n & 127));
        v4u o0, o1; o0.x = pk2(v[0][nn], v[1][nn]); o0.y = pk2(v[2][nn], v[3][nn]); o0.z = pk2(v[4][nn], v[5][nn]); o0.w = pk2(v[6][nn], v[7][nn]);
        o1.x = pk2(v[8][nn], v[9][nn]); o1.y = pk2(v[10][nn], v[11][nn]); o1.z = pk2(v[12][nn], v[13][nn]); o1.w = pk2(v[14][nn], v[15][nn]);
        v4u* dp = (v4u*)(WT + (size_t)dr * ldt + k0 + 16 * g); dp[0] = o0; dp[1] = o1;
    }
}
struct PrepArgs { const float *w_in, *w_out, *w_router, *w1, *w3, *w2, *sw1, *sw3, *sw2; bf16 *wtin, *wtout, *wtr, *wt13, *wt2; };
constexpr int IT_IN = 16 * 56, IT_OUT = 16 * 16, IT_R = 16 * 4, IT_E = 192, IT_TOTAL = IT_IN + IT_OUT + IT_R + NEX * IT_E;
__device__ __forceinline__ void prep_item(const PrepArgs& a, int it, int lane) {
    if (it < IT_IN) { transpose_item(a.w_in, WIN_LD, a.wtin, D, (it / 56) * 64, (it % 56) * 64, 0, lane); return; } it -= IT_IN;
    if (it < IT_OUT) { transpose_item(a.w_out, D, a.wtout, D, (it / 16) * 64, (it % 16) * 64, 0, lane); return; } it -= IT_OUT;
    if (it < IT_R) { transpose_item(a.w_router, NE, a.wtr, D, (it / 4) * 64, (it % 4) * 64, 0, lane); return; } it -= IT_R;
    const int e = it / IT_E, r = it % IT_E;
    const float* p1 = e < NE ? a.w1 + (size_t)e * D * FF : a.sw1; const float* p3 = e < NE ? a.w3 + (size_t)e * D * FF : a.sw3; const float* p2 = e < NE ? a.w2 + (size_t)e * FF * D : a.sw2;
    bf16* d13 = a.wt13 + (size_t)e * 512 * D; bf16* d2 = a.wt2 + (size_t)e * D * FF;
    if (r < 64) { transpose_item(p1, FF, d13, D, (r / 4) * 64, (r % 4) * 64, 1, lane); return; }
    if (r < 128) { const int q = r - 64; transpose_item(p3, FF, d13, D, (q / 4) * 64, (q % 4) * 64, 2, lane); return; }
    { const int q = r - 128; transpose_item(p2, D, d2, FF, (q / 16) * 64, (q % 16) * 64, 0, lane); }
}
__global__ void __launch_bounds__(512) k_prep(PrepArgs a) {
    const int lane = threadIdx.x & 63, gw = blockIdx.x * 8 + (threadIdx.x >> 6), ngw = gridDim.x * 8;
    for (int it = gw; it < IT_TOTAL; it += ngw) prep_item(a, it, lane);
}

__global__ void __launch_bounds__(512) k_ln1(const float* __restrict__ x, const float* __restrict__ mod, const float* __restrict__ w_in, const float* __restrict__ gate_b,
                                              bf16* __restrict__ u1, float* __restrict__ ipre, float* __restrict__ logf) {
    __shared__ float wg[D][8];
    const int tid = threadIdx.x, lane = tid & 63, wave = tid >> 6;
    for (int i = tid; i < D * 8; i += 512) wg[i >> 3][i & 7] = w_in[(size_t)(i >> 3) * WIN_LD + C_GATE + (i & 7)];
    __syncthreads();
    const int row0 = blockIdx.x * 128, b = row0 / S;
    f32x4 sh[4], sc[4];
#pragma unroll
    for (int j = 0; j < 4; ++j) { sh[j] = *(const f32x4*)(mod + b * 6144 + 4 * lane + 256 * j); sc[j] = *(const f32x4*)(mod + b * 6144 + 1024 + 4 * lane + 256 * j); }
    for (int rr = wave; rr < 128; rr += 8) {
        const int row = row0 + rr;
        const f32x4* xr = (const f32x4*)(x + (size_t)row * D) + lane;
        f32x4 v[4]; float s = 0.f;
#pragma unroll
        for (int j = 0; j < 4; ++j) { v[j] = xr[64 * j]; s += (v[j].x + v[j].y) + (v[j].z + v[j].w); }
        const float mean = wave_sum(s) * (1.f / D); float s2 = 0.f;
#pragma unroll
        for (int j = 0; j < 4; ++j) { v[j] = v[j] - mean; s2 += (v[j].x * v[j].x + v[j].y * v[j].y) + (v[j].z * v[j].z + v[j].w * v[j].w); }
        const float rstd = 1.f / sqrtf(wave_sum(s2) * (1.f / D) + LN_EPS);
        float ga[8];
#pragma unroll
        for (int q = 0; q < 8; ++q) ga[q] = 0.f;
        unsigned long long* o8 = (unsigned long long*)(u1 + (size_t)row * D) + lane;
#pragma unroll
        for (int j = 0; j < 4; ++j) {
            f32x4 u = v[j] * rstd * (sc[j] + 1.0f) + sh[j];
            o8[64 * j] = (unsigned long long)pk2(u.x, u.y) | ((unsigned long long)pk2(u.z, u.w) << 32);
#pragma unroll
            for (int e = 0; e < 4; ++e) { const int k = 4 * lane + 256 * j + e;
#pragma unroll
                for (int q = 0; q < 8; ++q) ga[q] += u[e] * wg[k][q]; }
        }
#pragma unroll
        for (int q = 0; q < 8; ++q) ga[q] = wave_sum(ga[q]);
        if (lane < 8) {
            float gv = 0.f;
#pragma unroll
            for (int q = 0; q < 8; ++q) gv = (lane == q) ? ga[q] : gv;
            gv += gate_b[lane];
            const int h = lane & 3, s_ = row % S;
            if (lane < 4) ipre[(size_t)(b * 4 + h) * S + s_] = gv;
            else { const float ls = fminf(gv, 0.f) - log1pf(__expf(-fabsf(gv))); logf[(size_t)(b * 4 + h) * S + s_] = ls; }
        }
    }
}

template <class ARow, class BRow>
__device__ __forceinline__ void ngemm_tile(ARow arow, BRow brow, int K, float (&acc)[4][4], float* sA, float* sB) {
    const int tid = threadIdx.x, ty = tid >> 4, tx = tid & 15;
    const int lr = tid >> 2, lk = (tid & 3) * 8;
    const bf16* ap = arow(lr); const bf16* bp = brow(lr);
#pragma unroll
    for (int i = 0; i < 4; ++i)
#pragma unroll
        for (int j = 0; j < 4; ++j) acc[i][j] = 0.f;
    for (int k0 = 0; k0 < K; k0 += 32) {
        v4u av = {0u, 0u, 0u, 0u}, bv = {0u, 0u, 0u, 0u};
        if (ap) av = *(const v4u*)(ap + k0 + lk);
        if (bp) bv = *(const v4u*)(bp + k0 + lk);
        __syncthreads();
#pragma unroll
        for (int q = 0; q < 4; ++q) {
            sA[(lk + 2 * q) * 68 + lr] = bf2f(av[q] & 0xffffu); sA[(lk + 2 * q + 1) * 68 + lr] = bf2f(av[q] >> 16);
            sB[(lk + 2 * q) * 68 + lr] = bf2f(bv[q] & 0xffffu); sB[(lk + 2 * q + 1) * 68 + lr] = bf2f(bv[q] >> 16);
        }
        __syncthreads();
#pragma unroll 8
        for (int kk = 0; kk < 32; ++kk) {
            const f32x4 a = *(const f32x4*)(sA + kk * 68 + ty * 4), b = *(const f32x4*)(sB + kk * 68 + tx * 4);
#pragma unroll
            for (int i = 0; i < 4; ++i)
#pragma unroll
                for (int j = 0; j < 4; ++j) acc[i][j] += a[i] * b[j];
        }
    }
}

template <int MODE>
__global__ void __launch_bounds__(256) k_ngemm(const bf16* __restrict__ A, const bf16* __restrict__ Bt, void* __restrict__ C, int M, int N, int K, int ldc, int scale_cols, float scale) {
    __shared__ __attribute__((aligned(16))) float sA[32 * 68];
    __shared__ __attribute__((aligned(16))) float sB[32 * 68];
    const int m0 = blockIdx.y * 64, n0 = blockIdx.x * 64;
    float acc[4][4];
    ngemm_tile([&](int r) { return A + (size_t)(m0 + r) * K; }, [&](int r) { return Bt + (size_t)(n0 + r) * K; }, K, acc, sA, sB);
    const int ty = threadIdx.x >> 4, tx = threadIdx.x & 15;
#pragma unroll
    for (int i = 0; i < 4; ++i) { const int m = m0 + ty * 4 + i, n = n0 + tx * 4;
        if (MODE == 0) { const float sc = n < scale_cols ? scale : 1.f;
            *(unsigned long long*)((bf16*)C + (size_t)m * ldc + n) = (unsigned long long)pk2(acc[i][0] * sc, acc[i][1] * sc) | ((unsigned long long)pk2(acc[i][2] * sc, acc[i][3] * sc) << 32); }
        else *(f32x4*)((float*)C + (size_t)m * ldc + n) = (f32x4){acc[i][0], acc[i][1], acc[i][2], acc[i][3]}; }
}

__global__ void __launch_bounds__(256) k_attn_naive(const bf16* __restrict__ proj, bf16* __restrict__ mix) {
    const int gid = blockIdx.x * 256 + threadIdx.x;
    const int t = gid % S, bh = gid / S, h = bh & 7, b = bh >> 3;
    const bf16* base = proj + (size_t)b * S * NPROJ;
    float q[64], o[64];
    { const v4u* qp = (const v4u*)(base + (size_t)t * NPROJ + C_SBQ + h * 64);
#pragma unroll
      for (int i = 0; i < 8; ++i) { const v4u w = qp[i];
#pragma unroll
          for (int e = 0; e < 4; ++e) { q[i * 8 + 2 * e] = bf2f(w[e] & 0xffffu); q[i * 8 + 2 * e + 1] = bf2f(w[e] >> 16); } } }
#pragma unroll
    for (int d = 0; d < 64; ++d) o[d] = 0.f;
    float carry = 0.f;
    for (int s = t - 1; s >= 0; --s) {
        const v4u* kp = (const v4u*)(base + (size_t)s * NPROJ + C_SBK + h * 64);
        float z = 0.f;
#pragma unroll
        for (int i = 0; i < 8; ++i) { const v4u w = kp[i];
#pragma unroll
            for (int e = 0; e < 4; ++e) { z += q[i * 8 + 2 * e] * bf2f(w[e] & 0xffffu); z += q[i * 8 + 2 * e + 1] * bf2f(w[e] >> 16); } }
        const float sp = fmaxf(z, 0.f) + __log2f(1.f + exp2f(-fabsf(z)));
        carry += sp;
        const float a = exp2f(z - carry);
        const v4u* vp = (const v4u*)(base + (size_t)s * NPROJ + C_SBV + h * 64);
#pragma unroll
        for (int i = 0; i < 8; ++i) { const v4u w = vp[i];
#pragma unroll
            for (int e = 0; e < 4; ++e) { o[i * 8 + 2 * e] += a * bf2f(w[e] & 0xffffu); o[i * 8 + 2 * e + 1] += a * bf2f(w[e] >> 16); } }
        if (carry > SB_THRESH) break;
    }
    v4u* op = (v4u*)(mix + (size_t)(b * S + t) * D + h * 64);
#pragma unroll
    for (int i = 0; i < 8; ++i) { v4u w; w.x = pk2(o[i * 8], o[i * 8 + 1]); w.y = pk2(o[i * 8 + 2], o[i * 8 + 3]); w.z = pk2(o[i * 8 + 4], o[i * 8 + 5]); w.w = pk2(o[i * 8 + 6], o[i * 8 + 7]); op[i] = w; }
}

__global__ void __launch_bounds__(256) k_mlstm_naive(const bf16* __restrict__ proj, const float* __restrict__ conv_w, const float* __restrict__ conv_b,
                                                      const float* __restrict__ ipre, const float* __restrict__ logf, float* __restrict__ hraw) {
    __shared__ float sq[32][128], sk[32][128], sv[32][16], sf[32], si[32];
    const int tid = threadIdx.x, bh = blockIdx.x >> 3, sl = blockIdx.x & 7, b = bh >> 2, h = bh & 3;
    const int r = tid >> 4, c = tid & 15;
    const bf16* base = proj + (size_t)b * S * NPROJ;
    float Cst[8], nst[8];
#pragma unroll
    for (int e = 0; e < 8; ++e) { Cst[e] = 0.f; nst[e] = 0.f; }
    for (int t0 = 0; t0 < S; t0 += 32) {
        __syncthreads();
        for (int i = tid; i < 32 * 128; i += 256) {
            const int tt = i >> 7, d = i & 127, t = t0 + tt, ch = h * 128 + d;
            float yq = conv_b[ch], yk = conv_b[512 + ch];
#pragma unroll
            for (int j = 0; j < 4; ++j) { const int ts = t - 3 + j;
                if (ts >= 0) { yq += conv_w[j * 1024 + ch] * bf2f(base[(size_t)ts * NPROJ + C_MLQ + ch]); yk += conv_w[j * 1024 + 512 + ch] * bf2f(base[(size_t)ts * NPROJ + C_MLK + ch]); } }
            sq[tt][d] = siluf_(yq); sk[tt][d] = siluf_(yk) * 0.08838834764831845f;
        }
        for (int i = tid; i < 32 * 16; i += 256) { const int tt = i >> 4, d = i & 15; sv[tt][d] = bf2f(base[(size_t)(t0 + tt) * NPROJ + C_MLV + h * 128 + sl * 16 + d]); }
        if (tid < 32) { sf[tid] = __expf(logf[(size_t)bh * S + t0 + tid]); si[tid] = __expf(ipre[(size_t)bh * S + t0 + tid]); }
        __syncthreads();
        for (int tt = 0; tt < 32; ++tt) {
            const float f = sf[tt], iv = si[tt] * sv[tt][r], ii = si[tt];
            float pn = 0.f, pd = 0.f;
#pragma unroll
            for (int e = 0; e < 8; ++e) { const float kk = sk[tt][c * 8 + e], qq = sq[tt][c * 8 + e];
                Cst[e] = f * Cst[e] + iv * kk; nst[e] = f * nst[e] + ii * kk; pn += Cst[e] * qq; pd += nst[e] * qq; }
#pragma unroll
            for (int o = 1; o < 16; o <<= 1) { pn += __shfl_xor(pn, o); pd += __shfl_xor(pd, o); }
            if (c == 0) hraw[(size_t)(b * S + t0 + tt) * 512 + h * 128 + sl * 16 + r] = pn / fmaxf(fabsf(pd), 1.f);
        }
    }
}
__global__ void __launch_bounds__(256) k_mlnorm_naive(const float* __restrict__ hraw, const bf16* __restrict__ proj, const float* __restrict__ norm_g, bf16* __restrict__ mix) {
    const int gw = blockIdx.x * 4 + (threadIdx.x >> 6), lane = threadIdx.x & 63, t = gw >> 2, h = gw & 3;
    const float a = hraw[(size_t)t * 512 + h * 128 + 2 * lane], bq = hraw[(size_t)t * 512 + h * 128 + 2 * lane + 1];
    const float mean = wave_sum(a + bq) * (1.f / 128.f);
    const float da = a - mean, db = bq - mean;
    const float rstd = 1.f / sqrtf(wave_sum(da * da + db * db) * (1.f / 128.f) + LN_EPS);
    const unsigned ow = *(const unsigned*)(proj + (size_t)t * NPROJ + C_MLO + h * 128 + 2 * lane);
    const float o0 = sigmoidf_(bf2f(ow & 0xffffu)), o1 = sigmoidf_(bf2f(ow >> 16));
    const float g0 = norm_g[h * 128 + 2 * lane], g1 = norm_g[h * 128 + 2 * lane + 1];
    *(unsigned*)(mix + (size_t)t * D + 512 + h * 128 + 2 * lane) = pk2(da * rstd * g0 * o0, db * rstd * g1 * o1);
}

__global__ void __launch_bounds__(512) k_ln2(const float* __restrict__ x, const bf16* __restrict__ mixout, const float* __restrict__ mod, const float* __restrict__ ln1_g, const float* __restrict__ ln1_b,
                                              float* __restrict__ x1, bf16* __restrict__ u2) {
    const int tid = threadIdx.x, lane = tid & 63, wave = tid >> 6;
    const int row0 = blockIdx.x * 128, b = row0 / S;
    for (int rr = wave; rr < 128; rr += 8) {
        const int row = row0 + rr;
        f32x4 v[4]; float s = 0.f;
#pragma unroll
        for (int j = 0; j < 4; ++j) {
            const int col = 4 * lane + 256 * j;
            const f32x4 xv = *(const f32x4*)(x + (size_t)row * D + col);
            const unsigned long long mw = *(const unsigned long long*)(mixout + (size_t)row * D + col);
            const f32x4 g1 = *(const f32x4*)(mod + b * 6144 + 2048 + col);
            f32x4 mo = {bf2f((unsigned)mw & 0xffffu), bf2f(((unsigned)mw) >> 16), bf2f((unsigned)(mw >> 32) & 0xffffu), bf2f((unsigned)(mw >> 48))};
            v[j] = xv * DN_ALPHA + g1 * mo; s += (v[j].x + v[j].y) + (v[j].z + v[j].w);
        }
        float mean = wave_sum(s) * (1.f / D), s2 = 0.f;
#pragma unroll
        for (int j = 0; j < 4; ++j) { v[j] = v[j] - mean; s2 += (v[j].x * v[j].x + v[j].y * v[j].y) + (v[j].z * v[j].z + v[j].w * v[j].w); }
        float rstd = 1.f / sqrtf(wave_sum(s2) * (1.f / D) + LN_EPS);
        s = 0.f;
#pragma unroll
        for (int j = 0; j < 4; ++j) { const int col = 4 * lane + 256 * j;
            v[j] = v[j] * rstd * *(const f32x4*)(ln1_g + col) + *(const f32x4*)(ln1_b + col);
            *(f32x4*)(x1 + (size_t)row * D + col) = v[j]; s += (v[j].x + v[j].y) + (v[j].z + v[j].w); }
        mean = wave_sum(s) * (1.f / D); s2 = 0.f;
#pragma unroll
        for (int j = 0; j < 4; ++j) { v[j] = v[j] - mean; s2 += (v[j].x * v[j].x + v[j].y * v[j].y) + (v[j].z * v[j].z + v[j].w * v[j].w); }
        rstd = 1.f / sqrtf(wave_sum(s2) * (1.f / D) + LN_EPS);
#pragma unroll
        for (int j = 0; j < 4; ++j) { const int col = 4 * lane + 256 * j;
            const f32x4 u = v[j] * rstd * (*(const f32x4*)(mod + b * 6144 + 4096 + col) + 1.0f) + *(const f32x4*)(mod + b * 6144 + 3072 + col);
            *(unsigned long long*)(u2 + (size_t)row * D + col) = (unsigned long long)pk2(u.x, u.y) | ((unsigned long long)pk2(u.z, u.w) << 32); }
    }
}

__global__ void __launch_bounds__(256) k_route(const float* __restrict__ logits, const float* __restrict__ rbias, int* __restrict__ tope, float* __restrict__ topg, int* __restrict__ cnt) {
    const int t = blockIdx.x * 256 + threadIdx.x;
    const float* lg = logits + (size_t)t * NE;
    float gs[8];
#pragma unroll
    for (int g = 0; g < 8; ++g) { float m1 = -INFINITY, m2 = -INFINITY;
        for (int i = 0; i < 32; ++i) { const int e = g * 32 + i; const float v = sigmoidf_(lg[e]) + rbias[e]; if (v > m1) { m2 = m1; m1 = v; } else if (v > m2) m2 = v; }
        gs[g] = m1 + m2; }
    unsigned gmask = 0;
#pragma unroll
    for (int r = 0; r < 4; ++r) { int bi = 0; float bv = -INFINITY;
#pragma unroll
        for (int g = 0; g < 8; ++g) if (!((gmask >> g) & 1u) && gs[g] > bv) { bv = gs[g]; bi = g; }
        gmask |= 1u << bi; }
    float pv = INFINITY; int pi = -1; float gsum = 0.f;
    for (int r = 0; r < 8; ++r) { int bi = 0; float bv = -INFINITY, bs = 0.f;
        for (int e = 0; e < NE; ++e) { if (!((gmask >> (e >> 5)) & 1u)) continue;
            const float sc = sigmoidf_(lg[e]), v = sc + rbias[e];
            const bool elig = (v < pv) || (v == pv && e > pi);
            if (elig && v > bv) { bv = v; bi = e; bs = sc; } }
        pv = bv; pi = bi; gsum += bs;
        tope[t * 8 + r] = bi; topg[t * 8 + r] = bs;
        atomicAdd(cnt + bi, 1); }
    const float inv = 2.5f / gsum;
    for (int r = 0; r < 8; ++r) topg[t * 8 + r] *= inv;
}
__global__ void k_plan(const int* __restrict__ cnt, int* __restrict__ plan) {
    if (threadIdx.x == 0) { int s = 0, t64 = 0, t256 = 0;
        for (int e = 0; e <= NEX; ++e) { plan[PL_SLOT + e] = s; plan[PL_T64 + e] = t64; plan[PL_T256 + e] = t256;
            if (e < NEX) { const int n = e < NE ? cnt[e] : T; s += ((n + 255) / 256) * 256; t64 += (n + 63) / 64; t256 += (n + 255) / 256; } } }
}
__global__ void __launch_bounds__(256) k_fill(const int* __restrict__ tope, const float* __restrict__ topg, const int* __restrict__ plan, int* __restrict__ fill, i32x2* __restrict__ list) {
    const int id = blockIdx.x * 256 + threadIdx.x; const int e = tope[id];
    const int pos = atomicAdd(fill + e, 1); list[plan[PL_SLOT + e] + pos] = (i32x2){id, __float_as_int(topg[id])};
}
__device__ __forceinline__ int find_expert(const int* base, int tile) { int lo = 0, hi = NEX;
    while (hi - lo > 1) { const int mid = (lo + hi) >> 1; if (base[mid] <= tile) lo = mid; else hi = mid; } return lo; }

__global__ void __launch_bounds__(256) k_moe1_naive(const bf16* __restrict__ u2, const bf16* __restrict__ wt13, const int* __restrict__ cnt, const int* __restrict__ plan, const i32x2* __restrict__ list, bf16* __restrict__ H) {
    __shared__ __attribute__((aligned(16))) float sA[32 * 68];
    __shared__ __attribute__((aligned(16))) float sB[32 * 68];
    const int tile = blockIdx.y; if (tile >= plan[PL_T64 + NEX]) return;
    const int e = find_expert(plan + PL_T64, tile), mt = tile - plan[PL_T64 + e], n = e < NE ? cnt[e] : T, j0 = blockIdx.x * 64;
    const bf16* w = wt13 + (size_t)e * 512 * D;
    auto arow = [&](int r) -> const bf16* { const int rr = mt * 64 + r; if (rr >= n) return nullptr; const int tok = e < NE ? (list[plan[PL_SLOT + e] + rr].x >> 3) : rr; return u2 + (size_t)tok * D; };
    float a1[4][4], a3[4][4];
    ngemm_tile(arow, [&](int r) { const int j = j0 + r; return w + (size_t)((j >> 7) * 256 + (j & 127)) * D; }, D, a1, sA, sB);
    __syncthreads();
    ngemm_tile(arow, [&](int r) { const int j = j0 + r; return w + (size_t)((j >> 7) * 256 + 128 + (j & 127)) * D; }, D, a3, sA, sB);
    const int ty = threadIdx.x >> 4, tx = threadIdx.x & 15;
#pragma unroll
    for (int i = 0; i < 4; ++i) { const int rr = mt * 64 + ty * 4 + i; if (rr >= n) continue;
        float hv[4];
#pragma unroll
        for (int j = 0; j < 4; ++j) hv[j] = siluf_(a1[i][j]) * a3[i][j];
        *(unsigned long long*)(H + (size_t)(plan[PL_SLOT + e] + rr) * FF + j0 + tx * 4) = (unsigned long long)pk2(hv[0], hv[1]) | ((unsigned long long)pk2(hv[2], hv[3]) << 32); }
}
__global__ void __launch_bounds__(256) k_moe2_naive(const bf16* __restrict__ H, const bf16* __restrict__ wt2, const int* __restrict__ cnt, const int* __restrict__ plan, const i32x2* __restrict__ list,
                                                     const float* __restrict__ topg, bf16* __restrict__ ys, bf16* __restrict__ ysh) {
    __shared__ __attribute__((aligned(16))) float sA[32 * 68];
    __shared__ __attribute__((aligned(16))) float sB[32 * 68];
    const int tile = blockIdx.y; if (tile >= plan[PL_T64 + NEX]) return;
    const int e = find_expert(plan + PL_T64, tile), mt = tile - plan[PL_T64 + e], n = e < NE ? cnt[e] : T, n0 = blockIdx.x * 64;
    const bf16* w = wt2 + (size_t)e * D * FF; const bf16* hb = H + (size_t)plan[PL_SLOT + e] * FF;
    float acc[4][4];
    ngemm_tile([&](int r) -> const bf16* { const int rr = mt * 64 + r; return rr < n ? hb + (size_t)rr * FF : nullptr; }, [&](int r) { return w + (size_t)(n0 + r) * FF; }, FF, acc, sA, sB);
    const int ty = threadIdx.x >> 4, tx = threadIdx.x & 15;
#pragma unroll
    for (int i = 0; i < 4; ++i) { const int rr = mt * 64 + ty * 4 + i; if (rr >= n) continue;
        bf16* dst; float g = 1.f;
        if (e < NE) { const i32x2 en = list[plan[PL_SLOT + e] + rr]; g = __int_as_float(en.y); dst = ys + (size_t)en.x * D; } else dst = ysh + (size_t)rr * D;
        *(unsigned long long*)(dst + n0 + tx * 4) = (unsigned long long)pk2(acc[i][0] * g, acc[i][1] * g) | ((unsigned long long)pk2(acc[i][2] * g, acc[i][3] * g) << 32); }
}

__device__ __forceinline__ f32x4 ld_bf4(const bf16* p) { const unsigned long long w = *(const unsigned long long*)p;
    return (f32x4){bf2f((unsigned)w & 0xffffu), bf2f(((unsigned)w) >> 16), bf2f((unsigned)(w >> 32) & 0xffffu), bf2f((unsigned)(w >> 48))}; }
__global__ void __launch_bounds__(512) k_final(float* __restrict__ out, const bf16* __restrict__ ys, const bf16* __restrict__ ysh, const float* __restrict__ mod, const float* __restrict__ ln2_g, const float* __restrict__ ln2_b) {
    const int tid = threadIdx.x, lane = tid & 63, wave = tid >> 6;
    const int row0 = blockIdx.x * 128, b = row0 / S;
    for (int rr = wave; rr < 128; rr += 8) {
        const int row = row0 + rr;
        f32x4 v[4]; float s = 0.f;
#pragma unroll
        for (int j = 0; j < 4; ++j) { const int col = 4 * lane + 256 * j;
            f32x4 y = ld_bf4(ysh + (size_t)row * D + col);
#pragma unroll
            for (int k = 0; k < 8; ++k) y = y + ld_bf4(ys + ((size_t)row * 8 + k) * D + col);
            v[j] = *(const f32x4*)(out + (size_t)row * D + col) * DN_ALPHA + *(const f32x4*)(mod + b * 6144 + 5120 + col) * y;
            s += (v[j].x + v[j].y) + (v[j].z + v[j].w); }
        const float mean = wave_sum(s) * (1.f / D); float s2 = 0.f;
#pragma unroll
        for (int j = 0; j < 4; ++j) { v[j] = v[j] - mean; s2 += (v[j].x * v[j].x + v[j].y * v[j].y) + (v[j].z * v[j].z + v[j].w * v[j].w); }
        const float rstd = 1.f / sqrtf(wave_sum(s2) * (1.f / D) + LN_EPS);
#pragma unroll
        for (int j = 0; j < 4; ++j) { const int col = 4 * lane + 256 * j;
            *(f32x4*)(out + (size_t)row * D + col) = v[j] * rstd * *(const f32x4*)(ln2_g + col) + *(const f32x4*)(ln2_b + col); }
    }
}

#define LAS __attribute__((address_space(3)))
#define GAS __attribute__((address_space(1)))
namespace pg8 {
typedef short bf16x8 __attribute__((ext_vector_type(8)));
constexpr int BM = 256, BK = 64, HALF = 128, HTB = HALF * BK * 2, STAGE_BYTES = 8 * HTB, NXCD = 8, WGM = 8;
__host__ __device__ __forceinline__ int lds_byte(int r, int c) { const int st = (r >> 4) * 2 + (c >> 5), rr = r & 15, cc = c & 31, ob = rr * 64 + cc * 2; return st * 1024 + (ob ^ (((ob >> 9) & 1) << 5)); }
__host__ __device__ __forceinline__ void stage_rc(int b, int& R, int& C) { const int st = b / 1024, sb = b % 1024, swz = sb ^ (((sb >> 9) & 1) << 5); R = (st >> 1) * 16 + swz / 64; C = (st & 1) * 32 + (swz % 64) / 2; }
__host__ __device__ __forceinline__ int perm32(int rho) { const int n = rho >> 4, i = rho & 15; return 8 * (i >> 2) + 4 * n + (i & 3); }

struct Unit { int pm, pn, e, mt; const char* A; const char* B; };

__device__ __forceinline__ long unit_index(int i, int G, int c) { return (G % 8 == 0) ? ((long)(i * 8 + (c & 7)) * (G / 8) + (c >> 3)) : ((long)i * G + c); }

struct StaticOrder {
    int nM, nN, nwg, G, c; const char* A; const char* B; size_t tstep;
    __device__ void init(const void* A_, const void* B_, int M, int N, int K, int G_, int c_) { nM = M / BM; nN = N / BM; nwg = nM * nN; G = G_; c = c_; A = (const char*)A_; B = (const char*)B_; tstep = (size_t)BM * K * 2; }
    __device__ __forceinline__ bool next(int i, Unit& u) const {
        const long L = (long)i * G + c; if (L >= nwg) return false;
        int wgid = (int)L; { const int q = nwg / NXCD, r = nwg % NXCD, xcd = wgid % NXCD, off = wgid / NXCD; wgid = (xcd < r ? xcd * (q + 1) : r * (q + 1) + (xcd - r) * q) + off; }
        const int nig = WGM * nN, gid = wgid / nig, fm = gid * WGM, gsz = (nM - fm) < WGM ? (nM - fm) : WGM;
        u.pm = fm + ((wgid % nig) % gsz); u.pn = (wgid % nig) / gsz; u.e = 0; u.mt = u.pm; u.A = A + (size_t)u.pm * tstep; u.B = B + (size_t)u.pn * tstep; return true;
    }
    __device__ __forceinline__ int row_token(const Unit&, int) const { return 0; }
};

struct MoeOrder {
    int G, c, total, shift; const LAS int* tb; const LAS int* nn; const i32x2* list;
    const char* Abase; size_t a_tile_stride; const char* Bbase; size_t b_exp_stride, b_pn_stride;
    __device__ __forceinline__ bool next(int i, Unit& u) const {
        const long L = unit_index(i, G, c); if (L >= total) return false;
        const int tile = (int)(L >> shift); u.pn = (int)(L & ((1 << shift) - 1));
        int lo = 0, hi = NEX; while (hi - lo > 1) { const int mid = (lo + hi) >> 1; if (tb[mid] <= tile) lo = mid; else hi = mid; }
        u.e = lo; u.mt = tile - tb[lo]; u.pm = tile;
        u.A = Abase + (size_t)tile * a_tile_stride; u.B = Bbase + (size_t)lo * b_exp_stride + (size_t)u.pn * b_pn_stride; return true;
    }
    __device__ __forceinline__ int row_token(const Unit& u, int row) const {
        const int rr = u.mt * 256 + row;
        if (u.e >= NE) return rr;
        return rr < nn[u.e] ? (list[u.pm * 256 + row].x >> 3) : 0;
    }
};

__device__ __forceinline__ unsigned cvt_pk_bf16(float lo, float hi) { unsigned r; asm volatile("v_cvt_pk_bf16_f32 %0, %1, %2" : "=v"(r) : "v"(lo), "v"(hi)); return r; }

struct EpiBf16 {
    static constexpr bool PERM = true; bf16* O; int ldc; int scale_tiles; float scale;
    __device__ __forceinline__ void operator()(const f32x4 (&acc)[2][2][4][2], const Unit& u, int wr, int wc, int fr, int fq) const {
        const int row0 = u.pm * BM + wr * 64 + fr, col0 = u.pn * BM + wc * 32 + 8 * fq; const float sc = u.pn < scale_tiles ? scale : 1.f;
#pragma unroll
        for (int ai = 0; ai < 2; ++ai)
#pragma unroll
            for (int m = 0; m < 4; ++m) { bf16* rowp = O + (size_t)(row0 + ai * HALF + m * 16) * ldc + col0;
#pragma unroll
                for (int bj = 0; bj < 2; ++bj) { const f32x4 v0 = acc[ai][bj][m][0] * sc, v1 = acc[ai][bj][m][1] * sc;
                    v4u w; w.x = cvt_pk_bf16(v0[0], v0[1]); w.y = cvt_pk_bf16(v0[2], v0[3]); w.z = cvt_pk_bf16(v1[0], v1[1]); w.w = cvt_pk_bf16(v1[2], v1[3]);
                    *(v4u*)(rowp + bj * HALF) = w; } }
    }
};
struct EpiF32 {
    static constexpr bool PERM = false; float* C; int ldc;
    __device__ __forceinline__ void operator()(const f32x4 (&acc)[2][2][4][2], const Unit& u, int wr, int wc, int fr, int fq) const {
        const int row0 = u.pm * BM + wr * 64 + fr, col0 = u.pn * BM + wc * 32 + 4 * fq;
#pragma unroll
        for (int ai = 0; ai < 2; ++ai)
#pragma unroll
            for (int m = 0; m < 4; ++m) { float* rowp = C + (size_t)(row0 + ai * HALF + m * 16) * ldc + col0;
#pragma unroll
                for (int bj = 0; bj < 2; ++bj)
#pragma unroll
                    for (int n = 0; n < 2; ++n) *(f32x4*)(rowp + bj * HALF + n * 16) = acc[ai][bj][m][n]; }
    }
};
struct EpiGlu {
    static constexpr bool PERM = true; bf16* H;
    __device__ __forceinline__ void operator()(const f32x4 (&acc)[2][2][4][2], const Unit& u, int wr, int wc, int fr, int fq) const {
        const int row0 = u.pm * BM + wr * 64 + fr, col0 = u.pn * HALF + wc * 32 + 8 * fq;
#pragma unroll
        for (int ai = 0; ai < 2; ++ai)
#pragma unroll
            for (int m = 0; m < 4; ++m) { float h[8];
#pragma unroll
                for (int n = 0; n < 2; ++n)
#pragma unroll
                    for (int q = 0; q < 4; ++q) { const float a = acc[ai][0][m][n][q]; h[n * 4 + q] = a * __builtin_amdgcn_rcpf(1.f + __expf(-a)) * acc[ai][1][m][n][q]; }
                v4u w; w.x = cvt_pk_bf16(h[0], h[1]); w.y = cvt_pk_bf16(h[2], h[3]); w.z = cvt_pk_bf16(h[4], h[5]); w.w = cvt_pk_bf16(h[6], h[7]);
                *(v4u*)(H + (size_t)(row0 + ai * HALF + m * 16) * FF + col0) = w; }
    }
};
struct EpiScatter {
    static constexpr bool PERM = true; bf16* ys; bf16* ysh; const i32x2* list; const LAS int* nn;
    __device__ __forceinline__ void operator()(const f32x4 (&acc)[2][2][4][2], const Unit& u, int wr, int wc, int fr, int fq) const {
        const int col0 = u.pn * BM + wc * 32 + 8 * fq; const int n = nn[u.e]; const bool routed = u.e < NE;
        const i32x2* lp = list + (size_t)(u.pm - u.mt) * 256;
#pragma unroll
        for (int ai = 0; ai < 2; ++ai) {
            i32x2 en[4];
#pragma unroll
            for (int m = 0; m < 4; ++m) { const int rr = u.mt * 256 + ai * HALF + wr * 64 + m * 16 + fr; en[m] = (i32x2){rr, 0x3f800000};
                if (routed && rr < n) en[m] = lp[rr]; }
#pragma unroll
            for (int m = 0; m < 4; ++m) { const int rr = u.mt * 256 + ai * HALF + wr * 64 + m * 16 + fr;
                if (rr < n) { bf16* dst = (routed ? ys : ysh) + (size_t)en[m].x * D + col0; const float g = __int_as_float(en[m].y);
#pragma unroll
                    for (int bj = 0; bj < 2; ++bj) { const f32x4 v0 = acc[ai][bj][m][0] * g, v1 = acc[ai][bj][m][1] * g;
                        v4u w; w.x = cvt_pk_bf16(v0[0], v0[1]); w.y = cvt_pk_bf16(v0[2], v0[3]); w.z = cvt_pk_bf16(v1[0], v1[1]); w.w = cvt_pk_bf16(v1[2], v1[3]);
                        *(v4u*)(dst + bj * HALF) = w; } } }
            __builtin_amdgcn_sched_barrier(0);
        }
    }
};

template <class Epi, class Sched, bool GATHER>
__device__ __forceinline__ void gemm_phase(LAS unsigned char* lds, const int K, const Sched& S, const Epi& E) {
    const int tid = threadIdx.x, wid = __builtin_amdgcn_readfirstlane(tid >> 6), lane = tid & 63, wr = wid >> 2, wc = wid & 3, fr = lane & 15, fq = lane >> 4;
    const int nt = K / BK;
    int sR[2], sC[2];
    unsigned voffA[2], voffB[2];
#pragma unroll
    for (int i = 0; i < 2; ++i) { stage_rc(tid * 16 + i * 8192, sR[i], sC[i]); const int Rb = Epi::PERM ? ((sR[i] & ~31) + perm32(sR[i] & 31)) : sR[i];
        voffA[i] = (unsigned)(sR[i] * K + sC[i]) * 2u; voffB[i] = (unsigned)(Rb * K + sC[i]) * 2u; }
    const size_t kstep = (size_t)(BK * 2);
    const size_t hstep = (size_t)HALF * K * 2;
    const unsigned ldsw = (unsigned)wid * 1024u;
    const int aoff = lds_byte(wr * 64 + fr, fq * 8), boff = lds_byte(wc * 32 + fr, fq * 8);
    unsigned gc[2][2], gn[2][2];
#define PG8_SA(b, h) (((b) * 2 + (h)) * HTB)
#define PG8_SB(b, h) ((4 + (b) * 2 + (h)) * HTB)
#define PG8_GLDS(src, bufoff, i) __builtin_amdgcn_global_load_lds((const unsigned*)(src), (LAS unsigned*)(lds + (bufoff) + ldsw + (i) * 8192), 16, 0, 0)
#define PG8_STAGE_B(bufoff, gbase) do { PG8_GLDS((const char*)(gbase) + voffB[0], bufoff, 0); PG8_GLDS((const char*)(gbase) + voffB[1], bufoff, 1); } while (0)
#define PG8_STAGE_A(bufoff, gbase, h, nx) do { if constexpr (GATHER) { const unsigned _o0 = (nx) ? gn[h][0] : gc[h][0], _o1 = (nx) ? gn[h][1] : gc[h][1]; \
            PG8_GLDS((const char*)(gbase) + _o0, bufoff, 0); PG8_GLDS((const char*)(gbase) + _o1, bufoff, 1); } \
        else { PG8_GLDS((const char*)(gbase) + (h) * hstep + voffA[0], bufoff, 0); PG8_GLDS((const char*)(gbase) + (h) * hstep + voffA[1], bufoff, 1); } } while (0)
#define PG8_LDA(dst, b, h) do { _Pragma("unroll") for (int m = 0; m < 4; ++m) _Pragma("unroll") for (int k = 0; k < 2; ++k) dst[m][k] = *(const LAS bf16x8*)(lds + PG8_SA(b, h) + aoff + m * 2048 + k * 1024); } while (0)
#define PG8_LDB(dst, b, h) do { _Pragma("unroll") for (int n = 0; n < 2; ++n) _Pragma("unroll") for (int k = 0; k < 2; ++k) dst[n][k] = *(const LAS bf16x8*)(lds + PG8_SB(b, h) + boff + n * 2048 + k * 1024); } while (0)
#define PG8_MMA(ai, bj, At, Bt) do { __builtin_amdgcn_s_setprio(1); _Pragma("unroll") for (int m = 0; m < 4; ++m) _Pragma("unroll") for (int n = 0; n < 2; ++n) _Pragma("unroll") for (int k = 0; k < 2; ++k) \
        acc[ai][bj][m][n] = __builtin_amdgcn_mfma_f32_16x16x32_bf16(Bt[n][k], At[m][k], acc[ai][bj][m][n], 0, 0, 0); __builtin_amdgcn_s_setprio(0); } while (0)
#define PG8_WAIT_V(n) asm volatile("s_waitcnt vmcnt(" #n ")" ::: "memory")
#define PG8_WAIT_L(n) asm volatile("s_waitcnt lgkmcnt(" #n ")" ::: "memory")
#define PG8_BAR __builtin_amdgcn_s_barrier()
#define PG8_SCHED __builtin_amdgcn_sched_barrier(0)
#define PG8_GATHER(dst, u) do { _Pragma("unroll") for (int _h = 0; _h < 2; ++_h) _Pragma("unroll") for (int _i = 0; _i < 2; ++_i) \
        dst[_h][_i] = (unsigned)(S.row_token(u, _h * HALF + sR[_i]) * K + sC[_i]) * 2u; } while (0)
    Unit cur, nxt; int ui = 0;
    if (!S.next(0, cur)) return;
    f32x4 acc[2][2][4][2];
#pragma unroll
    for (int a = 0; a < 2; ++a)
#pragma unroll
        for (int b = 0; b < 2; ++b)
#pragma unroll
            for (int m = 0; m < 4; ++m)
#pragma unroll
                for (int n = 0; n < 2; ++n) acc[a][b][m][n] = (f32x4){0.f, 0.f, 0.f, 0.f};
    bf16x8 At[4][2], B0[2][2], B1[2][2];
    const char* cA = cur.A; const char* cB = cur.B;
    if constexpr (GATHER) { PG8_GATHER(gc, cur); }
    PG8_STAGE_B(PG8_SB(0, 0), cB); PG8_STAGE_A(PG8_SA(0, 0), cA, 0, false); PG8_STAGE_B(PG8_SB(0, 1), cB + hstep); PG8_STAGE_A(PG8_SA(0, 1), cA, 1, false);
    if (wr == 1) PG8_BAR;
    PG8_WAIT_V(4); PG8_BAR;
    PG8_STAGE_B(PG8_SB(1, 0), cB + kstep); PG8_STAGE_A(PG8_SA(1, 0), cA + kstep, 0, false); PG8_STAGE_B(PG8_SB(1, 1), cB + hstep + kstep);
    PG8_WAIT_V(6); PG8_BAR;
    for (;;) {
        const bool has_next = S.next(ui + 1, nxt);
        const char* nA = has_next ? nxt.A : cA; const char* nB = has_next ? nxt.B : cB;
        if constexpr (GATHER) { if (has_next) { PG8_GATHER(gn, nxt); } else {
#pragma unroll
            for (int h = 0; h < 2; ++h) { gn[h][0] = gc[h][0]; gn[h][1] = gc[h][1]; } } }
#pragma unroll 1
        for (int t = 0; t < nt; t += 2) {
            const bool last = (t == nt - 2);
            const char* a1 = cA + (size_t)(t + 1) * kstep;
            const char* a2 = last ? nA : cA + (size_t)(t + 2) * kstep; const char* b2 = last ? nB : cB + (size_t)(t + 2) * kstep;
            const char* a3 = a2 + kstep; const char* b3 = b2 + kstep;
            PG8_LDB(B0, 0, 0); PG8_SCHED; PG8_LDA(At, 0, 0); PG8_STAGE_A(PG8_SA(1, 1), a1, 1, false);
            PG8_WAIT_L(8); PG8_BAR; PG8_WAIT_L(0); PG8_MMA(0, 0, At, B0); PG8_BAR; PG8_SCHED;
            PG8_LDB(B1, 0, 1); PG8_STAGE_B(PG8_SB(0, 0), b2);
            PG8_BAR; PG8_WAIT_L(0); PG8_MMA(0, 1, At, B1); PG8_BAR;
            PG8_LDA(At, 0, 1); PG8_STAGE_A(PG8_SA(0, 0), a2, 0, last);
            PG8_BAR; PG8_WAIT_L(0); PG8_MMA(1, 0, At, B0); PG8_BAR; PG8_SCHED;
            PG8_STAGE_B(PG8_SB(0, 1), b2 + hstep);
            PG8_WAIT_V(6); PG8_BAR; PG8_MMA(1, 1, At, B1); PG8_BAR;
            PG8_LDB(B0, 1, 0); PG8_SCHED; PG8_LDA(At, 1, 0); PG8_STAGE_A(PG8_SA(0, 1), a2, 1, last);
            PG8_WAIT_L(8); PG8_BAR; PG8_WAIT_L(0); PG8_MMA(0, 0, At, B0); PG8_BAR; PG8_SCHED;
            PG8_LDB(B1, 1, 1); PG8_STAGE_B(PG8_SB(1, 0), b3);
            PG8_BAR; PG8_WAIT_L(0); PG8_MMA(0, 1, At, B1); PG8_BAR;
            PG8_LDA(At, 1, 1); PG8_STAGE_A(PG8_SA(1, 0), a3, 0, last);
            PG8_BAR; PG8_WAIT_L(0); PG8_MMA(1, 0, At, B0); PG8_BAR; PG8_SCHED;
            PG8_STAGE_B(PG8_SB(1, 1), b3 + hstep);
            PG8_WAIT_V(6); PG8_BAR; PG8_MMA(1, 1, At, B1); PG8_BAR;
        }
        E(acc, cur, wr, wc, fr, fq);
        if (!has_next) break;
#pragma unroll
        for (int a = 0; a < 2; ++a)
#pragma unroll
            for (int b = 0; b < 2; ++b)
#pragma unroll
                for (int m = 0; m < 4; ++m)
#pragma unroll
                    for (int n = 0; n < 2; ++n) acc[a][b][m][n] = (f32x4){0.f, 0.f, 0.f, 0.f};
        cur = nxt; cA = nA; cB = nB; ++ui;
        if constexpr (GATHER) {
#pragma unroll
            for (int h = 0; h < 2; ++h) { gc[h][0] = gn[h][0]; gc[h][1] = gn[h][1]; } }
    }
    PG8_WAIT_V(0);
    if (wr == 0) PG8_BAR;
    PG8_BAR;
#undef PG8_SA
#undef PG8_SB
#undef PG8_GLDS
#undef PG8_STAGE_A
#undef PG8_STAGE_B
#undef PG8_LDA
#undef PG8_LDB
#undef PG8_MMA
#undef PG8_WAIT_V
#undef PG8_WAIT_L
#undef PG8_BAR
#undef PG8_SCHED
#undef PG8_GATHER
}
}

#define XB_TMO      128
#define XB_XCNT(j)  (256  + 64 * (j))
#define XB_XSUB(j)  (1280 + 64 * (j))
#define XB_XGEN(j)  (2304 + 64 * (j))
#define XB_TOP      3328
#define XB_TOPGEN   3392
#define XCD_BAR_WORDS 3456
#define XB_SPIN_CAP (1u << 22)
__device__ __forceinline__ unsigned xb_ld(unsigned* p)              { return __hip_atomic_load(p, __ATOMIC_RELAXED, __HIP_MEMORY_SCOPE_AGENT); }
__device__ __forceinline__ unsigned xb_add(unsigned* p, unsigned v) { return __hip_atomic_fetch_add(p, v, __ATOMIC_RELAXED, __HIP_MEMORY_SCOPE_AGENT); }
__device__ __forceinline__ unsigned xb_xcc_id() { return (unsigned)__builtin_amdgcn_s_getreg((3 << 11) | 20) & 0xFu; }
#define XB_SPIN(cond, bar) do { unsigned _sp = 0; while (cond) { __builtin_amdgcn_s_sleep(1); \
    if ((++_sp & 255u) == 0u) { if (xb_ld(&(bar)[XB_TMO])) break; if (_sp > XB_SPIN_CAP) { atomicAdd(&(bar)[XB_TMO], 1u); break; } } } } while (0)
struct XcdBarrier { unsigned* bar; unsigned x; volatile LAS unsigned* st; };
__device__ __forceinline__ XcdBarrier xcd_barrier_post(unsigned* bar, volatile LAS unsigned* st) {
    XcdBarrier b; b.bar = bar; b.x = xb_xcc_id(); b.st = st;
    if (threadIdx.x == 0) (void)xb_add(&bar[XB_XCNT(b.x)], 1u);
    return b;
}
__device__ __forceinline__ void xcd_barrier_complete(unsigned* bar, unsigned x, unsigned& nloc, unsigned& nx) {
    const unsigned G = gridDim.x * gridDim.y * gridDim.z;
    unsigned sum, cnt, mine, sp = 0u;
    for (;;) {
        sum = 0u; cnt = 0u; mine = 0u;
#pragma unroll
        for (unsigned j = 0; j < 16; ++j) { const unsigned c = xb_ld(&bar[XB_XCNT(j)]); sum += c; cnt += (c > 0u) ? 1u : 0u; mine = (j == x) ? c : mine; }
        if (sum == G) break;
        __builtin_amdgcn_s_sleep(1);
        if ((++sp & 255u) == 0u) { if (xb_ld(&bar[XB_TMO])) break; if (sp > XB_SPIN_CAP) { atomicAdd(&bar[XB_TMO], 1u); break; } }
    }
    nloc = mine > 0u ? mine : 1u; nx = cnt > 0u ? cnt : 1u;
}
__device__ __forceinline__ void xcd_barrier(const XcdBarrier& b) {
    asm volatile("s_waitcnt vmcnt(0)" ::: "memory");
    __syncthreads();
    if (threadIdx.x == 0) {
        unsigned* bar = b.bar;
        __builtin_amdgcn_s_waitcnt(0);
        unsigned nloc = b.st[0], nx = b.st[1];
        if (nloc == 0u) { xcd_barrier_complete(bar, b.x, nloc, nx); b.st[0] = nloc; b.st[1] = nx; }
        const unsigned old = xb_add(&bar[XB_XSUB(b.x)], 1u);
        const unsigned gen = old / nloc;
        if (old + 1u == (gen + 1u) * nloc) {
            __builtin_amdgcn_fence(__ATOMIC_RELEASE, "agent");
            asm volatile("s_waitcnt vmcnt(0)" ::: "memory");
            const unsigned og = xb_add(&bar[XB_TOP], 1u);
            const unsigned tg = og / nx;
            if (og + 1u == (tg + 1u) * nx) xb_add(&bar[XB_TOPGEN], 1u);
            else XB_SPIN(xb_ld(&bar[XB_TOPGEN]) == tg, bar);
            __builtin_amdgcn_fence(__ATOMIC_ACQUIRE, "agent");
            xb_add(&bar[XB_XGEN(b.x)], 1u);
            asm volatile("s_waitcnt vmcnt(0)" ::: "memory");
        } else {
            XB_SPIN(xb_ld(&bar[XB_XGEN(b.x)]) == gen, bar);
            __builtin_amdgcn_fence(__ATOMIC_ACQUIRE, "agent");
            asm volatile("s_waitcnt vmcnt(0)" ::: "memory");
        }
    }
    __syncthreads();
}

constexpr int NWAVES = 8, NTHR = 512;
constexpr int RING_BYTES = 131072, XTRA_OFF = RING_BYTES, LDS_BYTES = 147456;
constexpr int X_MISC = 0, X_TB = 256, X_NN = 1536;
constexpr int CW_BAR = 4096;
constexpr int N_PHASES = 14;
struct MArgs { const float* in[22]; float* out; unsigned char* ws; int ph_lo, ph_hi; };

__device__ __forceinline__ void ph_mod_prep(const MArgs& a, unsigned char* smem, int G) {
    const int tid = threadIdx.x;
    unsigned char* ws = a.ws;
    if ((int)blockIdx.x < 192) {
        float* sc = (float*)smem; float* red = sc + NB * D;
        const float* c = a.in[1]; const float* w_ada = a.in[2]; const float* b_ada = a.in[3]; float* mod = (float*)(ws + WS_MOD);
        for (int i = tid; i < NB * D; i += NTHR) sc[i] = siluf_(c[i]);
        __syncthreads();
        for (int it = blockIdx.x; it < 192; it += G) {
            const int kq = tid >> 5, jl = tid & 31, j = it * 32 + jl;
            float a0 = 0.f, a1 = 0.f, a2 = 0.f, a3 = 0.f;
#pragma unroll 16
            for (int kk = 0; kk < 64; ++kk) { const int k = kq * 64 + kk; const float w = w_ada[(size_t)k * 6144 + j];
                a0 += sc[k] * w; a1 += sc[D + k] * w; a2 += sc[2 * D + k] * w; a3 += sc[3 * D + k] * w; }
            red[(kq * 4 + 0) * 32 + jl] = a0; red[(kq * 4 + 1) * 32 + jl] = a1; red[(kq * 4 + 2) * 32 + jl] = a2; red[(kq * 4 + 3) * 32 + jl] = a3;
            __syncthreads();
            if (tid < 128) { const int b = tid >> 5; float s = b_ada[j];
#pragma unroll
                for (int q = 0; q < 16; ++q) s += red[(q * 4 + b) * 32 + jl];
                mod[b * 6144 + j] = s; }
            __syncthreads();
        }
    }
    PrepArgs pa{a.in[4], a.in[9], a.in[12], a.in[14], a.in[15], a.in[16], a.in[17], a.in[18], a.in[19],
                (bf16*)(ws + WS_WTIN), (bf16*)(ws + WS_WTOUT), (bf16*)(ws + WS_WTR), (bf16*)(ws + WS_WT13), (bf16*)(ws + WS_WT2)};
    const int lane = tid & 63, gw = blockIdx.x * NWAVES + (tid >> 6), ngw = G * NWAVES;
    for (int it = gw; it < IT_TOTAL; it += ngw) prep_item(pa, it, lane);
}

__device__ __forceinline__ void ph_ln1(const MArgs& a, unsigned char* smem, int G) {
    const int tid = threadIdx.x, lane = tid & 63, wave = tid >> 6;
    const float* x = a.in[0]; const float* w_in = a.in[4]; const float* gate_b = a.in[7];
    const float* mod = (const float*)(a.ws + WS_MOD); bf16* u1 = (bf16*)(a.ws + WS_U1); float* ipre = (float*)(a.ws + WS_GATES); float* logf = ipre + 16 * S;
    float* wg = (float*)smem;
    for (int i = tid; i < D * 8; i += NTHR) wg[i] = w_in[(size_t)(i >> 3) * WIN_LD + C_GATE + (i & 7)];
    __syncthreads();
    for (int it = blockIdx.x; it < T / 128; it += G) {
        const int row0 = it * 128, b = row0 / S;
        f32x4 sh[4], sc[4];
#pragma unroll
        for (int j = 0; j < 4; ++j) { sh[j] = *(const f32x4*)(mod + b * 6144 + 4 * lane + 256 * j); sc[j] = *(const f32x4*)(mod + b * 6144 + 1024 + 4 * lane + 256 * j); }
        for (int rr = wave; rr < 128; rr += NWAVES) {
            const int row = row0 + rr;
            const f32x4* xr = (const f32x4*)(x + (size_t)row * D) + lane;
            f32x4 v[4]; float s = 0.f;
#pragma unroll
            for (int j = 0; j < 4; ++j) { v[j] = xr[64 * j]; s += (v[j].x + v[j].y) + (v[j].z + v[j].w); }
            const float mean = wave_sum(s) * (1.f / D); float s2 = 0.f;
#pragma unroll
            for (int j = 0; j < 4; ++j) { v[j] = v[j] - mean; s2 += (v[j].x * v[j].x + v[j].y * v[j].y) + (v[j].z * v[j].z + v[j].w * v[j].w); }
            const float rstd = 1.f / sqrtf(wave_sum(s2) * (1.f / D) + LN_EPS);
            float ga[8];
#pragma unroll
            for (int q = 0; q < 8; ++q) ga[q] = 0.f;
            unsigned long long* o8 = (unsigned long long*)(u1 + (size_t)row * D) + lane;
#pragma unroll
            for (int j = 0; j < 4; ++j) {
                const f32x4 u = v[j] * rstd * (sc[j] + 1.0f) + sh[j];
                o8[64 * j] = (unsigned long long)pk2(u.x, u.y) | ((unsigned long long)pk2(u.z, u.w) << 32);
#pragma unroll
                for (int e = 0; e < 4; ++e) { const int k = 4 * lane + 256 * j + e;
                    const f32x4 w0 = *(const f32x4*)(wg + k * 8), w1 = *(const f32x4*)(wg + k * 8 + 4);
                    ga[0] += u[e] * w0.x; ga[1] += u[e] * w0.y; ga[2] += u[e] * w0.z; ga[3] += u[e] * w0.w;
                    ga[4] += u[e] * w1.x; ga[5] += u[e] * w1.y; ga[6] += u[e] * w1.z; ga[7] += u[e] * w1.w; }
            }
#pragma unroll
            for (int q = 0; q < 8; ++q) ga[q] = wave_sum(ga[q]);
            if (lane < 8) {
                float gv = 0.f;
#pragma unroll
                for (int q = 0; q < 8; ++q) gv = (lane == q) ? ga[q] : gv;
                gv += gate_b[lane];
                const int h = lane & 3, s_ = row % S;
                if (lane < 4) ipre[(size_t)(b * 4 + h) * S + s_] = gv;
                else logf[(size_t)(b * 4 + h) * S + s_] = fminf(gv, 0.f) - log1pf(__expf(-fabsf(gv)));
            }
        }
    }
}

__device__ __forceinline__ void ph_attn_simple(const bf16* __restrict__ proj, bf16* __restrict__ mix, int vb0, int nvb) {
    for (int gid = vb0 * NTHR + threadIdx.x; gid < NB * 8 * S; gid += nvb * NTHR) {
        const int t = gid % S, bh = gid / S, h = bh & 7, b = bh >> 3;
        const bf16* base = proj + (size_t)b * S * NPROJ;
        float q[64], o[64];
        { const v4u* qp = (const v4u*)(base + (size_t)t * NPROJ + C_SBQ + h * 64);
#pragma unroll
          for (int i = 0; i < 8; ++i) { const v4u w = qp[i];
#pragma unroll
              for (int e = 0; e < 4; ++e) { q[i * 8 + 2 * e] = bf2f(w[e] & 0xffffu); q[i * 8 + 2 * e + 1] = bf2f(w[e] >> 16); } } }
#pragma unroll
        for (int d = 0; d < 64; ++d) o[d] = 0.f;
        float carry = 0.f;
        for (int s = t - 1; s >= 0; --s) {
            const v4u* kp = (const v4u*)(base + (size_t)s * NPROJ + C_SBK + h * 64);
            float z = 0.f;
#pragma unroll
            for (int i = 0; i < 8; ++i) { const v4u w = kp[i];
#pragma unroll
                for (int e = 0; e < 4; ++e) { z += q[i * 8 + 2 * e] * bf2f(w[e] & 0xffffu); z += q[i * 8 + 2 * e + 1] * bf2f(w[e] >> 16); } }
            const float sp = fmaxf(z, 0.f) + __log2f(1.f + exp2f(-fabsf(z)));
            carry += sp;
            const float p = exp2f(z - carry);
            const v4u* vp = (const v4u*)(base + (size_t)s * NPROJ + C_SBV + h * 64);
#pragma unroll
            for (int i = 0; i < 8; ++i) { const v4u w = vp[i];
#pragma unroll
                for (int e = 0; e < 4; ++e) { o[i * 8 + 2 * e] += p * bf2f(w[e] & 0xffffu); o[i * 8 + 2 * e + 1] += p * bf2f(w[e] >> 16); } }
            if (carry > SB_THRESH) break;
        }
        v4u* op = (v4u*)(mix + (size_t)(b * S + t) * D + h * 64);
#pragma unroll
        for (int i = 0; i < 8; ++i) { v4u w; w.x = pk2(o[i * 8], o[i * 8 + 1]); w.y = pk2(o[i * 8 + 2], o[i * 8 + 3]); w.z = pk2(o[i * 8 + 4], o[i * 8 + 5]); w.w = pk2(o[i * 8 + 6], o[i * 8 + 7]); op[i] = w; }
    }
}
__device__ __forceinline__ void ph_mlstm_simple(const MArgs& a, unsigned char* smem, int vb0, int nvb) {
    const bf16* proj = (const bf16*)(a.ws + WS_PROJ); const float* conv_w = a.in[5]; const float* conv_b = a.in[6];
    const float* ipre = (const float*)(a.ws + WS_GATES); const float* logf = ipre + 16 * S; float* hraw = (float*)(a.ws + WS_HRAW);
    const int half = threadIdx.x >> 8, tid = threadIdx.x & 255;
    float* sq = (float*)smem + half * 8768; float* sk = sq + 4096; float* sv = sk + 4096; float* sf = sv + 512; float* si = sf + 32;
    for (int it0 = vb0 * 2; it0 < 128; it0 += nvb * 2) {
        const int item = it0 + half, bh = item >> 3, sl = item & 7, b = bh >> 2, h = bh & 3;
        const int r = tid >> 4, c = tid & 15;
        const bf16* base = proj + (size_t)b * S * NPROJ;
        float Cst[8], nst[8];
#pragma unroll
        for (int e = 0; e < 8; ++e) { Cst[e] = 0.f; nst[e] = 0.f; }
        for (int t0 = 0; t0 < S; t0 += 32) {
            __syncthreads();
            for (int i = tid; i < 32 * 128; i += 256) {
                const int tt = i >> 7, d = i & 127, t = t0 + tt, ch = h * 128 + d;
                float yq = conv_b[ch], yk = conv_b[512 + ch];
#pragma unroll
                for (int j = 0; j < 4; ++j) { const int ts = t - 3 + j;
                    if (ts >= 0) { yq += conv_w[j * 1024 + ch] * bf2f(base[(size_t)ts * NPROJ + C_MLQ + ch]); yk += conv_w[j * 1024 + 512 + ch] * bf2f(base[(size_t)ts * NPROJ + C_MLK + ch]); } }
                sq[tt * 128 + d] = siluf_(yq); sk[tt * 128 + d] = siluf_(yk) * 0.08838834764831845f;
            }
            for (int i = tid; i < 32 * 16; i += 256) { const int tt = i >> 4, d = i & 15; sv[tt * 16 + d] = bf2f(base[(size_t)(t0 + tt) * NPROJ + C_MLV + h * 128 + sl * 16 + d]); }
            if (tid < 32) { sf[tid] = __expf(logf[(size_t)bh * S + t0 + tid]); si[tid] = __expf(ipre[(size_t)bh * S + t0 + tid]); }
            __syncthreads();
            for (int tt = 0; tt < 32; ++tt) {
                const float f = sf[tt], iv = si[tt] * sv[tt * 16 + r], ii = si[tt];
                float pn = 0.f, pd = 0.f;
#pragma unroll
                for (int e = 0; e < 8; ++e) { const float kk = sk[tt * 128 + c * 8 + e], qq = sq[tt * 128 + c * 8 + e];
                    Cst[e] = f * Cst[e] + iv * kk; nst[e] = f * nst[e] + ii * kk; pn += Cst[e] * qq; pd += nst[e] * qq; }
#pragma unroll
                for (int o = 1; o < 16; o <<= 1) { pn += __shfl_xor(pn, o); pd += __shfl_xor(pd, o); }
                if (c == 0) hraw[(size_t)(b * S + t0 + tt) * 512 + h * 128 + sl * 16 + r] = pn / fmaxf(fabsf(pd), 1.f);
            }
        }
    }
}
__device__ __forceinline__ void ph_mlnorm(const MArgs& a, int G) {
    const float* hraw = (const float*)(a.ws + WS_HRAW); const bf16* proj = (const bf16*)(a.ws + WS_PROJ); const float* norm_g = a.in[8]; bf16* mix = (bf16*)(a.ws + WS_MIX);
    const int lane = threadIdx.x & 63;
    for (int gw = blockIdx.x * NWAVES + (threadIdx.x >> 6); gw < T * 4; gw += G * NWAVES) {
        const int t = gw >> 2, h = gw & 3;
        const float va = hraw[(size_t)t * 512 + h * 128 + 2 * lane], vb = hraw[(size_t)t * 512 + h * 128 + 2 * lane + 1];
        const float mean = wave_sum(va + vb) * (1.f / 128.f);
        const float da = va - mean, db = vb - mean;
        const float rstd = 1.f / sqrtf(wave_sum(da * da + db * db) * (1.f / 128.f) + LN_EPS);
        const unsigned ow = *(const unsigned*)(proj + (size_t)t * NPROJ + C_MLO + h * 128 + 2 * lane);
        const float o0 = sigmoidf_(bf2f(ow & 0xffffu)), o1 = sigmoidf_(bf2f(ow >> 16));
        const float g0 = norm_g[h * 128 + 2 * lane], g1 = norm_g[h * 128 + 2 * lane + 1];
        *(unsigned*)(mix + (size_t)t * D + 512 + h * 128 + 2 * lane) = pk2(da * rstd * g0 * o0, db * rstd * g1 * o1);
    }
}
__device__ __forceinline__ void ph_ln2(const MArgs& a, int G) {
    const float* x = a.in[0]; const bf16* mixout = (const bf16*)(a.ws + WS_MIXOUT); const float* mod = (const float*)(a.ws + WS_MOD); const float* ln1_g = a.in[10]; const float* ln1_b = a.in[11];
    float* x1 = a.out; bf16* u2 = (bf16*)(a.ws + WS_U2);
    const int tid = threadIdx.x, lane = tid & 63, wave = tid >> 6;
    for (int it = blockIdx.x; it < T / 128; it += G) {
        const int row0 = it * 128, b = row0 / S;
        for (int rr = wave; rr < 128; rr += NWAVES) {
            const int row = row0 + rr;
            f32x4 v[4]; float s = 0.f;
#pragma unroll
            for (int j = 0; j < 4; ++j) {
                const int col = 4 * lane + 256 * j;
                const f32x4 xv = *(const f32x4*)(x + (size_t)row * D + col);
                const f32x4 mo = ld_bf4(mixout + (size_t)row * D + col);
                const f32x4 g1 = *(const f32x4*)(mod + b * 6144 + 2048 + col);
                v[j] = xv * DN_ALPHA + g1 * mo; s += (v[j].x + v[j].y) + (v[j].z + v[j].w);
            }
            float mean = wave_sum(s) * (1.f / D), s2 = 0.f;
#pragma unroll
            for (int j = 0; j < 4; ++j) { v[j] = v[j] - mean; s2 += (v[j].x * v[j].x + v[j].y * v[j].y) + (v[j].z * v[j].z + v[j].w * v[j].w); }
            float rstd = 1.f / sqrtf(wave_sum(s2) * (1.f / D) + LN_EPS);
            s = 0.f;
#pragma unroll
            for (int j = 0; j < 4; ++j) { const int col = 4 * lane + 256 * j;
                v[j] = v[j] * rstd * *(const f32x4*)(ln1_g + col) + *(const f32x4*)(ln1_b + col);
                *(f32x4*)(x1 + (size_t)row * D + col) = v[j]; s += (v[j].x + v[j].y) + (v[j].z + v[j].w); }
            mean = wave_sum(s) * (1.f / D); s2 = 0.f;
#pragma unroll
            for (int j = 0; j < 4; ++j) { v[j] = v[j] - mean; s2 += (v[j].x * v[j].x + v[j].y * v[j].y) + (v[j].z * v[j].z + v[j].w * v[j].w); }
            rstd = 1.f / sqrtf(wave_sum(s2) * (1.f / D) + LN_EPS);
#pragma unroll
            for (int j = 0; j < 4; ++j) { const int col = 4 * lane + 256 * j;
                const f32x4 u = v[j] * rstd * (*(const f32x4*)(mod + b * 6144 + 4096 + col) + 1.0f) + *(const f32x4*)(mod + b * 6144 + 3072 + col);
                *(unsigned long long*)(u2 + (size_t)row * D + col) = (unsigned long long)pk2(u.x, u.y) | ((unsigned long long)pk2(u.z, u.w) << 32); }
        }
    }
}
__device__ __forceinline__ void route_token(int t, const float* __restrict__ logits, const float* __restrict__ rbias, int* __restrict__ tope, float* __restrict__ topg, int* __restrict__ cnt) {
    const float* lg = logits + (size_t)t * NE;
    float gs[8];
#pragma unroll
    for (int g = 0; g < 8; ++g) { float m1 = -INFINITY, m2 = -INFINITY;
        for (int i = 0; i < 32; ++i) { const int e = g * 32 + i; const float v = sigmoidf_(lg[e]) + rbias[e]; if (v > m1) { m2 = m1; m1 = v; } else if (v > m2) m2 = v; }
        gs[g] = m1 + m2; }
    unsigned gmask = 0;
#pragma unroll
    for (int r = 0; r < 4; ++r) { int bi = 0; float bv = -INFINITY;
#pragma unroll
        for (int g = 0; g < 8; ++g) if (!((gmask >> g) & 1u) && gs[g] > bv) { bv = gs[g]; bi = g; }
        gmask |= 1u << bi; }
    float pv = INFINITY; int pi = -1; float gsum = 0.f; int se[8]; float sg[8];
#pragma unroll
    for (int r = 0; r < 8; ++r) { int bi = 0; float bv = -INFINITY, bs = 0.f;
        for (int e = 0; e < NE; ++e) { if (!((gmask >> (e >> 5)) & 1u)) continue;
            const float sc = sigmoidf_(lg[e]), v = sc + rbias[e];
            const bool elig = (v < pv) || (v == pv && e > pi);
            if (elig && v > bv) { bv = v; bi = e; bs = sc; } }
        pv = bv; pi = bi; gsum += bs; se[r] = bi; sg[r] = bs; }
    const float inv = 2.5f / gsum;
#pragma unroll
    for (int r = 0; r < 8; ++r) { const int e = se[r]; tope[t * 8 + r] = e; topg[t * 8 + r] = sg[r] * inv; atomicAdd(cnt + e, 1); }
}

__device__ __forceinline__ void route_wave(int t, int lane, const float* __restrict__ logits, const f32x4 bias4, int* __restrict__ tope, float* __restrict__ topg, int* __restrict__ cnt) {
    const f32x4 lg = *(const f32x4*)(logits + (size_t)t * NE + 4 * lane);
    float sc[4], v[4];
#pragma unroll
    for (int j = 0; j < 4; ++j) { sc[j] = 1.f / (1.f + __expf(-lg[j])); v[j] = sc[j] + bias4[j]; }
    float m1 = fmaxf(fmaxf(v[0], v[1]), fmaxf(v[2], v[3]));
    float m2; { const float a = fmaxf(v[0], v[1]), b = fminf(v[0], v[1]), c = fmaxf(v[2], v[3]), d = fminf(v[2], v[3]); m2 = fmaxf(fminf(a, c), fmaxf(b, d)); }
#pragma unroll
    for (int o = 1; o < 8; o <<= 1) { const float o1 = __shfl_xor(m1, o), o2 = __shfl_xor(m2, o); const float n1 = fmaxf(m1, o1); m2 = fmaxf(fminf(m1, o1), fmaxf(m2, o2)); m1 = n1; }
    const float gs = m1 + m2; const int myg = lane >> 3; int rank = 0;
#pragma unroll
    for (int gg = 0; gg < 8; ++gg) { const float og = __shfl(gs, gg * 8); rank += (og > gs || (og == gs && gg < myg)) ? 1 : 0; }
    if (rank >= 4) {
#pragma unroll
        for (int j = 0; j < 4; ++j) v[j] = -INFINITY; }
    int myE = 0; float myS = 0.f, gsum = 0.f;
#pragma unroll
    for (int rd = 0; rd < 8; ++rd) {
        float bv = v[0]; int bi = 4 * lane;
#pragma unroll
        for (int j = 1; j < 4; ++j) if (v[j] > bv) { bv = v[j]; bi = 4 * lane + j; }
#pragma unroll
        for (int o = 1; o < 64; o <<= 1) { const float ov = __shfl_xor(bv, o); const int oi = __shfl_xor(bi, o); if (ov > bv || (ov == bv && oi < bi)) { bv = ov; bi = oi; } }
        float ss = 0.f;
#pragma unroll
        for (int j = 0; j < 4; ++j) if (bi == 4 * lane + j) { ss = sc[j]; v[j] = -INFINITY; }
        ss = __shfl(ss, bi >> 2);
        gsum += ss;
        if (lane == rd) { myE = bi; myS = ss; }
    }
    if (lane < 8) { tope[t * 8 + lane] = myE; topg[t * 8 + lane] = myS * (2.5f / gsum); atomicAdd(cnt + myE, 1); }
}
__device__ __forceinline__ void moe_tables(const int* cnt, LAS int* tb, LAS int* nn) {
    if (threadIdx.x < 64) {
        const int lane = threadIdx.x; int n[4], tl[4], loc = 0;
#pragma unroll
        for (int j = 0; j < 4; ++j) { n[j] = cnt[4 * lane + j]; tl[j] = (n[j] + 255) >> 8; loc += tl[j]; }
        int inc = loc;
#pragma unroll
        for (int o = 1; o < 64; o <<= 1) { const int v = __shfl_up(inc, o); if (lane >= o) inc += v; }
        int base = inc - loc;
#pragma unroll
        for (int j = 0; j < 4; ++j) { tb[4 * lane + j] = base; nn[4 * lane + j] = n[j]; base += tl[j]; }
        if (lane == 63) { tb[NE] = base; nn[NE] = T; tb[NEX] = base + T / 256; }
    }
    __syncthreads();
}
__device__ __forceinline__ void ph_final(const MArgs& a, int G) {
    float* out = a.out; const bf16* ys = (const bf16*)(a.ws + WS_YS); const bf16* ysh = (const bf16*)(a.ws + WS_YSH); const float* mod = (const float*)(a.ws + WS_MOD);
    const float* ln2_g = a.in[20]; const float* ln2_b = a.in[21];
    const int tid = threadIdx.x, lane = tid & 63, wave = tid >> 6;
    for (int it = blockIdx.x; it < T / 128; it += G) {
        const int row0 = it * 128, b = row0 / S;
        for (int rr = wave; rr < 128; rr += NWAVES) {
            const int row = row0 + rr;
            f32x4 v[4]; float s = 0.f;
#pragma unroll
            for (int j = 0; j < 4; ++j) { const int col = 4 * lane + 256 * j;
                f32x4 y = ld_bf4(ysh + (size_t)row * D + col);
#pragma unroll
                for (int k = 0; k < 8; ++k) y = y + ld_bf4(ys + ((size_t)row * 8 + k) * D + col);
                v[j] = *(const f32x4*)(out + (size_t)row * D + col) * DN_ALPHA + *(const f32x4*)(mod + b * 6144 + 5120 + col) * y;
                s += (v[j].x + v[j].y) + (v[j].z + v[j].w); }
            const float mean = wave_sum(s) * (1.f / D); float s2 = 0.f;
#pragma unroll
            for (int j = 0; j < 4; ++j) { v[j] = v[j] - mean; s2 += (v[j].x * v[j].x + v[j].y * v[j].y) + (v[j].z * v[j].z + v[j].w * v[j].w); }
            const float rstd = 1.f / sqrtf(wave_sum(s2) * (1.f / D) + LN_EPS);
#pragma unroll
            for (int j = 0; j < 4; ++j) { const int col = 4 * lane + 256 * j;
                *(f32x4*)(out + (size_t)row * D + col) = v[j] * rstd * *(const f32x4*)(ln2_g + col) + *(const f32x4*)(ln2_b + col); }
        }
    }
}


typedef short s16x4 __attribute__((ext_vector_type(4)));
typedef short bf16x8v __attribute__((ext_vector_type(8)));
typedef float f32x16 __attribute__((ext_vector_type(16)));
constexpr int MLP = 320;
constexpr int NCH = S / 64;
constexpr int ST_ELEMS = 129 * 128;
constexpr size_t WS_CHK = WS_GATES + 1 * MiB;
constexpr size_t WS_MPREV = WS_GATES + 1 * MiB + 65536;
constexpr size_t WS_KC = WS_U2;
__device__ __forceinline__ s16x4 tr_read(const LAS unsigned char* p) { return __builtin_bit_cast(s16x4, __builtin_amdgcn_ds_read_tr16_b64_v4i16((LAS s16x4*)p)); }
__device__ __forceinline__ bf16x8v tr_frag(const LAS unsigned char* tile, int row0, int col0, int lane) {
    const int i = lane & 15; const LAS unsigned char* p = tile + (row0 + (i >> 2)) * MLP + (col0 + 4 * (i & 3)) * 2;
    const s16x4 lo = tr_read(p), hi = tr_read(p + 4 * MLP);
    return __builtin_shufflevector(lo, hi, 0, 1, 2, 3, 4, 5, 6, 7);
}
__device__ __forceinline__ bf16x8v tr_frag_perm(const LAS unsigned char* tile, int row0, int col0, int lane) {
    const int i = lane & 15; const LAS unsigned char* p = tile + (row0 + (i >> 2)) * MLP + (col0 + 4 * (i & 3)) * 2;
    const s16x4 lo = tr_read(p), hi = tr_read(p + 8 * MLP);
    return __builtin_shufflevector(lo, hi, 0, 1, 2, 3, 4, 5, 6, 7);
}
__device__ __forceinline__ float wave_incl_sum(float v, int lane) {
#pragma unroll
    for (int o = 1; o < 64; o <<= 1) { const float u = __shfl_up(v, o); if (lane >= o) v += u; }
    return v;
}
__device__ __forceinline__ float wave_incl_max(float v, int lane) {
#pragma unroll
    for (int o = 1; o < 64; o <<= 1) { const float u = __shfl_up(v, o); if (lane >= o) v = fmaxf(v, u); }
    return v;
}
__device__ __forceinline__ float wave_max(float v) {
#pragma unroll
    for (int o = 1; o < 64; o <<= 1) v = fmaxf(v, __shfl_xor(v, o));
    return v;
}
__device__ __forceinline__ void conv8(const bf16* __restrict__ rowp, int spos, const float* __restrict__ cw, const float* __restrict__ cb, float scale, float (&y)[8]) {
    const f32x4 b0 = *(const f32x4*)cb, b1 = *(const f32x4*)(cb + 4);
    y[0] = b0.x; y[1] = b0.y; y[2] = b0.z; y[3] = b0.w; y[4] = b1.x; y[5] = b1.y; y[6] = b1.z; y[7] = b1.w;
#pragma unroll
    for (int j = 0; j < 4; ++j) {
        if (spos - 3 + j >= 0) {
            const v4u xr = *(const v4u*)(rowp + (ptrdiff_t)(j - 3) * NPROJ);
            const f32x4 w0 = *(const f32x4*)(cw + j * 1024), w1 = *(const f32x4*)(cw + j * 1024 + 4);
            y[0] += w0.x * bf2f(xr.x & 0xffffu); y[1] += w0.y * bf2f(xr.x >> 16); y[2] += w0.z * bf2f(xr.y & 0xffffu); y[3] += w0.w * bf2f(xr.y >> 16);
            y[4] += w1.x * bf2f(xr.z & 0xffffu); y[5] += w1.y * bf2f(xr.z >> 16); y[6] += w1.z * bf2f(xr.w & 0xffffu); y[7] += w1.w * bf2f(xr.w >> 16);
        }
    }
#pragma unroll
    for (int e = 0; e < 8; ++e) y[e] = siluf_(y[e]) * scale;
}
__device__ __forceinline__ v4u pack8(const float (&y)[8]) { v4u o; o.x = pk2(y[0], y[1]); o.y = pk2(y[2], y[3]); o.z = pk2(y[4], y[5]); o.w = pk2(y[6], y[7]); return o; }

__device__ __forceinline__ void ml_phaseA(const MArgs& a, LAS unsigned char* lds, int vb0, int nvb) {
    const int tid = threadIdx.x, lane = tid & 63, wave = __builtin_amdgcn_readfirstlane(tid >> 6);
    const bf16* proj = (const bf16*)(a.ws + WS_PROJ); const float* conv_w = a.in[5]; const float* conv_b = a.in[6];
    const float* ipre = (const float*)(a.ws + WS_GATES); const float* logf = ipre + 16 * S;
    bf16* kcg = (bf16*)(a.ws + WS_KC); bf16* st = (bf16*)(a.ws + WS_STATES); float* chk = (float*)(a.ws + WS_CHK);
    LAS unsigned char* Kt = lds; LAS unsigned char* Vt = lds + 64 * MLP; LAS float* wkL = (LAS float*)(lds + 128 * MLP);
    for (int unit = vb0; unit < 16 * NCH; unit += nvb) {
        const int bh = unit >> 7, c = unit & (NCH - 1), b = bh >> 2, h = bh & 3, s0 = c * 64; const size_t row0 = (size_t)b * S + s0;
        if (wave == 0) {
            const float lf = logf[(size_t)bh * S + s0 + lane], ic = ipre[(size_t)bh * S + s0 + lane];
            const float bc = wave_incl_sum(lf, lane), g = ic - bc, gmax = wave_max(g), blast = __shfl(bc, 63);
            wkL[lane] = __expf(g - gmax);
            if (lane == 0) { chk[(size_t)unit * 2] = blast; chk[(size_t)unit * 2 + 1] = blast + gmax; }
        }
#pragma unroll
        for (int q = 0; q < 2; ++q) { const int it = tid + q * NTHR, tt = it >> 4, c8 = it & 15, ch = h * 128 + c8 * 8;
            float y[8]; conv8(proj + (row0 + tt) * NPROJ + C_MLK + ch, s0 + tt, conv_w + 512 + ch, conv_b + 512 + ch, 0.08838834764831845f, y);
            const v4u o = pack8(y);
            *(LAS v4u*)(Kt + tt * MLP + c8 * 16) = o; *(v4u*)(kcg + (row0 + tt) * 512 + ch) = o; }
        __syncthreads();
#pragma unroll
        for (int q = 0; q < 2; ++q) { const int it = tid + q * NTHR, tt = it >> 4, c8 = it & 15;
            const v4u xr = *(const v4u*)(proj + (row0 + tt) * NPROJ + C_MLV + h * 128 + c8 * 8); const float w = wkL[tt];
            float y[8] = {bf2f(xr.x & 0xffffu) * w, bf2f(xr.x >> 16) * w, bf2f(xr.y & 0xffffu) * w, bf2f(xr.y >> 16) * w, bf2f(xr.z & 0xffffu) * w, bf2f(xr.z >> 16) * w, bf2f(xr.w & 0xffffu) * w, bf2f(xr.w >> 16) * w};
            *(LAS v4u*)(Vt + tt * MLP + c8 * 16) = pack8(y); }
        __syncthreads();
        {
            const int dvb = wave >> 1, dkh = wave & 1, hh = lane >> 5, gsel = (lane >> 4) & 1;
            f32x16 acc[2];
#pragma unroll
            for (int nb = 0; nb < 2; ++nb)
#pragma unroll
                for (int i = 0; i < 16; ++i) acc[nb][i] = 0.f;
#pragma unroll
            for (int kk = 0; kk < 4; ++kk) {
                const bf16x8v Bv = tr_frag(Vt, 16 * kk + 8 * hh, 32 * dvb + 16 * gsel, lane);
#pragma unroll
                for (int nb = 0; nb < 2; ++nb) { const bf16x8v Ak = tr_frag(Kt, 16 * kk + 8 * hh, 32 * (2 * dkh + nb) + 16 * gsel, lane);
                    acc[nb] = __builtin_amdgcn_mfma_f32_32x32x16_bf16(Ak, Bv, acc[nb], 0, 0, 0); }
            }
            bf16* stc = st + (size_t)unit * ST_ELEMS;
#pragma unroll
            for (int nb = 0; nb < 2; ++nb)
#pragma unroll
                for (int g4 = 0; g4 < 4; ++g4) { const int dk = 32 * (2 * dkh + nb) + 8 * g4 + 4 * hh, dv = 32 * dvb + (lane & 31);
                    *(unsigned long long*)(stc + (size_t)dv * 128 + dk) = (unsigned long long)pk2(acc[nb][4 * g4], acc[nb][4 * g4 + 1]) | ((unsigned long long)pk2(acc[nb][4 * g4 + 2], acc[nb][4 * g4 + 3]) << 32); }
        }
        if (tid < 128) { float s = 0.f;
#pragma unroll 8
            for (int t = 0; t < 64; ++t) s += wkL[t] * bf2f(*(const LAS unsigned short*)(Kt + t * MLP + tid * 2));
            st[(size_t)unit * ST_ELEMS + 128 * 128 + tid] = (bf16)f2bf(s); }
        __syncthreads();
    }
}

__device__ __forceinline__ void ml_phaseB(const MArgs& a, LAS unsigned char* lds, int vb0, int nvb) {
    const int tid = threadIdx.x;
    bf16* st = (bf16*)(a.ws + WS_STATES); const float* chk = (const float*)(a.ws + WS_CHK); float* mprev = (float*)(a.ws + WS_MPREV);
    LAS float* al = (LAS float*)lds; LAS float* be = al + NCH;
    constexpr int NSL = 16, SLE = ST_ELEMS / NSL;
    for (int item = vb0; item < 16 * NSL; item += nvb) {
        const int bh = item / NSL, sl = item % NSL;
        __syncthreads();
        if (tid == 0) { float m = 0.f;
            for (int c = 0; c < NCH; ++c) { const float bl = chk[(size_t)(bh * NCH + c) * 2], M = chk[(size_t)(bh * NCH + c) * 2 + 1];
                const float mn = fmaxf(bl + m, M); al[c] = __expf(bl + m - mn); be[c] = __expf(M - mn);
                if (sl == 0) mprev[bh * NCH + c] = m;
                m = mn; } }
        __syncthreads();
        if (tid * 4 < SLE) {
            unsigned long long* p = (unsigned long long*)(st + (size_t)bh * NCH * ST_ELEMS + sl * SLE + tid * 4);
            float c0 = 0.f, c1 = 0.f, c2 = 0.f, c3 = 0.f;
            for (int cb = 0; cb < NCH; cb += 16) { unsigned long long d[16];
#pragma unroll
                for (int j = 0; j < 16; ++j) d[j] = p[(size_t)(cb + j) * (ST_ELEMS / 4)];
#pragma unroll
                for (int j = 0; j < 16; ++j) { p[(size_t)(cb + j) * (ST_ELEMS / 4)] = (unsigned long long)pk2(c0, c1) | ((unsigned long long)pk2(c2, c3) << 32);
                    const float A = al[cb + j], Bq = be[cb + j]; const unsigned lo = (unsigned)d[j], hi = (unsigned)(d[j] >> 32);
                    c0 = A * c0 + Bq * bf2f(lo & 0xffffu); c1 = A * c1 + Bq * bf2f(lo >> 16); c2 = A * c2 + Bq * bf2f(hi & 0xffffu); c3 = A * c3 + Bq * bf2f(hi >> 16); } }
        }
    }
}

__device__ __forceinline__ void ml_phaseC(const MArgs& a, LAS unsigned char* lds, int G) {
    const int tid = threadIdx.x, lane = tid & 63, wave = __builtin_amdgcn_readfirstlane(tid >> 6);
    const bf16* proj = (const bf16*)(a.ws + WS_PROJ); const float* conv_w = a.in[5]; const float* conv_b = a.in[6]; const float* norm_g = a.in[8];
    const float* ipre = (const float*)(a.ws + WS_GATES); const float* logf = ipre + 16 * S;
    const bf16* kcg = (const bf16*)(a.ws + WS_KC); const bf16* st = (const bf16*)(a.ws + WS_STATES); const float* mprev = (const float*)(a.ws + WS_MPREV);
    bf16* mix = (bf16*)(a.ws + WS_MIX);
    LAS unsigned char* Qt = lds; LAS unsigned char* Kt = lds + 64 * MLP; LAS unsigned char* Vt = lds + 128 * MLP; LAS unsigned char* Ct = lds + 192 * MLP;
    LAS float* sc = (LAS float*)(lds + 320 * MLP);
    LAS float* gL = sc; LAS float* mmL = sc + 64; LAS float* siL = sc + 128; LAS float* emL = sc + 192; LAS float* npv = sc + 256; LAS float* lnS = sc + 384;
    const int tb = wave >> 2, dvb = wave & 3, r = lane & 31, hh = lane >> 5, gsel = (lane >> 4) & 1;
    for (int unit = blockIdx.x; unit < 16 * NCH; unit += G) {
        const int bh = unit >> 7, c = unit & (NCH - 1), b = bh >> 2, h = bh & 3, s0 = c * 64; const size_t row0 = (size_t)b * S + s0;
        if (wave == 0) {
            const float lf = logf[(size_t)bh * S + s0 + lane], ic = ipre[(size_t)bh * S + s0 + lane], mp = mprev[unit];
            const float bc = wave_incl_sum(lf, lane), g = ic - bc, pm = wave_incl_max(g, lane), mm = fmaxf(mp, pm);
            gL[lane] = g; mmL[lane] = mm; siL[lane] = __expf(mp - mm); emL[lane] = __expf(-(bc + mm));
        }
        const bf16* stc = st + (size_t)unit * ST_ELEMS;
#pragma unroll
        for (int q = 0; q < 2; ++q) { const int it = tid + q * NTHR, tt = it >> 4, c8 = it & 15, ch = h * 128 + c8 * 8;
            float y[8]; conv8(proj + (row0 + tt) * NPROJ + C_MLQ + ch, s0 + tt, conv_w + ch, conv_b + ch, 1.f, y);
            *(LAS v4u*)(Qt + tt * MLP + c8 * 16) = pack8(y);
            *(LAS v4u*)(Kt + tt * MLP + c8 * 16) = *(const v4u*)(kcg + (row0 + tt) * 512 + ch);
            *(LAS v4u*)(Vt + tt * MLP + c8 * 16) = *(const v4u*)(proj + (row0 + tt) * NPROJ + C_MLV + ch); }
#pragma unroll
        for (int q = 0; q < 4; ++q) { const int it = tid + q * NTHR, dv = it >> 4, c8 = it & 15;
            *(LAS v4u*)(Ct + dv * MLP + c8 * 16) = *(const v4u*)(stc + dv * 128 + c8 * 8); }
        if (tid < 128) npv[tid] = bf2f(stc[128 * 128 + tid]);
        __syncthreads();
        bf16x8v qf[8];
#pragma unroll
        for (int kk = 0; kk < 8; ++kk) qf[kk] = *(const LAS bf16x8v*)(Qt + (32 * tb + r) * MLP + (16 * kk + 8 * hh) * 2);
        const float mm_t = mmL[32 * tb + r], si_t = siL[32 * tb + r], em_t = emL[32 * tb + r];
        float nq = 0.f;
#pragma unroll
        for (int kk = 0; kk < 8; ++kk) { const f32x4 n0 = *(const LAS f32x4*)(npv + 16 * kk + 8 * hh), n1 = *(const LAS f32x4*)(npv + 16 * kk + 8 * hh + 4);
            nq += n0.x * bf2f((unsigned short)qf[kk][0]) + n0.y * bf2f((unsigned short)qf[kk][1]) + n0.z * bf2f((unsigned short)qf[kk][2]) + n0.w * bf2f((unsigned short)qf[kk][3])
                + n1.x * bf2f((unsigned short)qf[kk][4]) + n1.y * bf2f((unsigned short)qf[kk][5]) + n1.z * bf2f((unsigned short)qf[kk][6]) + n1.w * bf2f((unsigned short)qf[kk][7]); }
        nq += __shfl_xor(nq, 32);
        f32x16 num;
#pragma unroll
        for (int i = 0; i < 16; ++i) num[i] = 0.f;
#pragma unroll
        for (int kk = 0; kk < 8; ++kk) { const bf16x8v Ac = *(const LAS bf16x8v*)(Ct + (32 * dvb + r) * MLP + (16 * kk + 8 * hh) * 2);
            num = __builtin_amdgcn_mfma_f32_32x32x16_bf16(Ac, qf[kk], num, 0, 0, 0); }
#pragma unroll
        for (int i = 0; i < 16; ++i) num[i] *= si_t;
        float wsum = 0.f;
        for (int sb = 0; sb <= tb; ++sb) {
            f32x16 sT;
#pragma unroll
            for (int i = 0; i < 16; ++i) sT[i] = 0.f;
#pragma unroll
            for (int kk = 0; kk < 8; ++kk) { const bf16x8v Ak = *(const LAS bf16x8v*)(Kt + (32 * sb + r) * MLP + (16 * kk + 8 * hh) * 2);
                sT = __builtin_amdgcn_mfma_f32_32x32x16_bf16(Ak, qf[kk], sT, 0, 0, 0); }
            unsigned wp[8];
#pragma unroll
            for (int g4 = 0; g4 < 4; ++g4) { const f32x4 gv = *(const LAS f32x4*)(gL + 32 * sb + 8 * g4 + 4 * hh);
                float w[4];
#pragma unroll
                for (int e = 0; e < 4; ++e) { const int srow = 32 * sb + 8 * g4 + 4 * hh + e; const bool valid = srow <= 32 * tb + r;
                    w[e] = valid ? sT[4 * g4 + e] * __expf(gv[e] - mm_t) : 0.f; wsum += w[e]; }
                wp[2 * g4] = pk2(w[0], w[1]); wp[2 * g4 + 1] = pk2(w[2], w[3]); }
#pragma unroll
            for (int s2 = 0; s2 < 2; ++s2) {
                const bf16x8v Av = tr_frag_perm(Vt, 32 * sb + 16 * s2 + 4 * hh, 32 * dvb + 16 * gsel, lane);
                v4u bw; bw.x = wp[4 * s2]; bw.y = wp[4 * s2 + 1]; bw.z = wp[4 * s2 + 2]; bw.w = wp[4 * s2 + 3];
                num = __builtin_amdgcn_mfma_f32_32x32x16_bf16(Av, __builtin_bit_cast(bf16x8v, bw), num, 0, 0, 0); }
        }
        wsum += __shfl_xor(wsum, 32);
        const float den = si_t * nq + wsum, rden = 1.f / fmaxf(fabsf(den), em_t);
        float ps = 0.f, pq = 0.f;
#pragma unroll
        for (int i = 0; i < 16; ++i) { num[i] *= rden; ps += num[i]; pq += num[i] * num[i]; }
        ps += __shfl_xor(ps, 32); pq += __shfl_xor(pq, 32);
        if (hh == 0) { lnS[((tb * 4 + dvb) * 32 + r) * 2] = ps; lnS[((tb * 4 + dvb) * 32 + r) * 2 + 1] = pq; }
        __syncthreads();
        float ts = 0.f, tq = 0.f;
#pragma unroll
        for (int d = 0; d < 4; ++d) { ts += lnS[((tb * 4 + d) * 32 + r) * 2]; tq += lnS[((tb * 4 + d) * 32 + r) * 2 + 1]; }
        const float mean = ts * (1.f / 128.f), rstd = 1.f / sqrtf(fmaxf(tq * (1.f / 128.f) - mean * mean, 0.f) + LN_EPS);
        const size_t trow = row0 + 32 * tb + r;
#pragma unroll
        for (int g4 = 0; g4 < 4; ++g4) { const int dv = 32 * dvb + 8 * g4 + 4 * hh;
            const f32x4 ng = *(const f32x4*)(norm_g + h * 128 + dv); const f32x4 og = ld_bf4(proj + trow * NPROJ + C_MLO + h * 128 + dv);
            float o[4];
#pragma unroll
            for (int e = 0; e < 4; ++e) o[e] = (num[4 * g4 + e] - mean) * rstd * ng[e] * sigmoidf_(og[e]);
            *(unsigned long long*)(mix + trow * D + 512 + h * 128 + dv) = (unsigned long long)pk2(o[0], o[1]) | ((unsigned long long)pk2(o[2], o[3]) << 32); }
        __syncthreads();
    }
}


constexpr int VTP = 192;
template <int PITCH> __device__ __forceinline__ bf16x8v tr_frag_perm_p(const LAS unsigned char* tile, int row0, int col0, int lane) {
    const int i = lane & 15; const LAS unsigned char* p = tile + (row0 + (i >> 2)) * PITCH + (col0 + 4 * (i & 3)) * 2;
    const s16x4 lo = tr_read(p), hi = tr_read(p + 8 * PITCH);
    return __builtin_shufflevector(lo, hi, 0, 1, 2, 3, 4, 5, 6, 7);
}
__device__ __forceinline__ void attn_phase(const bf16* __restrict__ proj, bf16* __restrict__ mix, LAS unsigned char* lds, int vb0, int nvb) {
    const int tid = threadIdx.x, lane = tid & 63, wave = __builtin_amdgcn_readfirstlane(tid >> 6);
    const int r = lane & 31, hh = lane >> 5, gsel = (lane >> 4) & 1;
    LAS unsigned char* Vt = lds + wave * (64 * VTP);
    bf16x8v ntri[2], nones;
#pragma unroll
    for (int s2 = 0; s2 < 2; ++s2)
#pragma unroll
        for (int j = 0; j < 8; ++j) { const int k = 16 * s2 + 8 * (j >> 2) + 4 * hh + (j & 3); ntri[s2][j] = (k >= r) ? (short)0xBF80 : (short)0; }
#pragma unroll
    for (int j = 0; j < 8; ++j) nones[j] = (short)0xBF80;
    for (int unit = vb0 * NWAVES + wave; unit < NB * 8 * (S / 32); unit += nvb * NWAVES) {
        const int bh = unit / (S / 32), qb = unit % (S / 32), b = bh >> 3, h = bh & 7, q0 = qb * 32;
        const bf16* base = proj + (size_t)b * S * NPROJ + h * 64;
        bf16x8v qf[4];
#pragma unroll
        for (int s = 0; s < 4; ++s) qf[s] = *(const bf16x8v*)(base + (size_t)(q0 + r) * NPROJ + C_SBQ + 16 * s + 8 * hh);
        f32x16 o[2];
#pragma unroll
        for (int d = 0; d < 2; ++d)
#pragma unroll
            for (int i = 0; i < 16; ++i) o[d][i] = 0.f;
        float carry = 0.f;
        const int qpos = q0 + r;
        for (int k0 = q0 - 32; ; k0 -= 64) {
            bf16x8v kf[2][4];
#pragma unroll
            for (int kb = 0; kb < 2; ++kb) { int key = k0 + 32 * kb + r; key = key < 0 ? 0 : key;
#pragma unroll
                for (int s = 0; s < 4; ++s) kf[kb][s] = *(const bf16x8v*)(base + (size_t)key * NPROJ + C_SBK + 16 * s + 8 * hh); }
#pragma unroll
            for (int i = 0; i < 8; ++i) { int key = k0 + (lane >> 3) + 8 * i; key = key < 0 ? 0 : key;
                *(LAS v4u*)(Vt + ((lane >> 3) + 8 * i) * VTP + (lane & 7) * 16) = *(const v4u*)(base + (size_t)key * NPROJ + C_SBV + (lane & 7) * 8); }
            f32x16 z[2];
#pragma unroll
            for (int kb = 0; kb < 2; ++kb) {
#pragma unroll
                for (int i = 0; i < 16; ++i) z[kb][i] = 0.f;
#pragma unroll
                for (int s = 0; s < 4; ++s) z[kb] = __builtin_amdgcn_mfma_f32_32x32x16_bf16(kf[kb][s], qf[s], z[kb], 0, 0, 0); }
            const bool need_mask = (k0 + 63 >= q0) || (k0 < 0);
            unsigned xp[2][8];
#pragma unroll
            for (int kb = 0; kb < 2; ++kb)
#pragma unroll
                for (int g4 = 0; g4 < 4; ++g4) { float sp[4];
#pragma unroll
                    for (int e = 0; e < 4; ++e) { const float zz = z[kb][4 * g4 + e];
                        float v = fmaxf(zz, 0.f) + __builtin_amdgcn_logf(1.f + __builtin_amdgcn_exp2f(-fabsf(zz)));
                        if (need_mask) { const int key = k0 + 32 * kb + 8 * g4 + 4 * hh + e; v = (key >= 0 && key < qpos) ? v : 0.f; }
                        sp[e] = v; }
                    xp[kb][2 * g4] = pk2(sp[0], sp[1]); xp[kb][2 * g4 + 1] = pk2(sp[2], sp[3]); }
            const float z00 = z[0][0];
#pragma unroll
            for (int s2 = 0; s2 < 2; ++s2) { v4u b1; b1.x = xp[1][4 * s2]; b1.y = xp[1][4 * s2 + 1]; b1.z = xp[1][4 * s2 + 2]; b1.w = xp[1][4 * s2 + 3];
                v4u b0; b0.x = xp[0][4 * s2]; b0.y = xp[0][4 * s2 + 1]; b0.z = xp[0][4 * s2 + 2]; b0.w = xp[0][4 * s2 + 3];
                z[1] = __builtin_amdgcn_mfma_f32_32x32x16_bf16(ntri[s2], __builtin_bit_cast(bf16x8v, b1), z[1], 0, 0, 0);
                z[0] = __builtin_amdgcn_mfma_f32_32x32x16_bf16(ntri[s2], __builtin_bit_cast(bf16x8v, b0), z[0], 0, 0, 0);
                z[0] = __builtin_amdgcn_mfma_f32_32x32x16_bf16(nones, __builtin_bit_cast(bf16x8v, b1), z[0], 0, 0, 0); }
            float tot = z00 - z[0][0];
            tot = __shfl(tot, r);
#pragma unroll
            for (int kb = 0; kb < 2; ++kb)
#pragma unroll
                for (int g4 = 0; g4 < 4; ++g4) { float p[4];
#pragma unroll
                    for (int e = 0; e < 4; ++e) { float v = __builtin_amdgcn_exp2f(z[kb][4 * g4 + e] - carry);
                        if (need_mask) { const int key = k0 + 32 * kb + 8 * g4 + 4 * hh + e; v = (key >= 0 && key < qpos) ? v : 0.f; }
                        p[e] = v; }
                    xp[kb][2 * g4] = pk2(p[0], p[1]); xp[kb][2 * g4 + 1] = pk2(p[2], p[3]); }
#pragma unroll
            for (int kb = 0; kb < 2; ++kb)
#pragma unroll
                for (int s2 = 0; s2 < 2; ++s2) { v4u bp; bp.x = xp[kb][4 * s2]; bp.y = xp[kb][4 * s2 + 1]; bp.z = xp[kb][4 * s2 + 2]; bp.w = xp[kb][4 * s2 + 3];
#pragma unroll
                    for (int d = 0; d < 2; ++d) { const bf16x8v Av = tr_frag_perm_p<VTP>(Vt, 32 * kb + 16 * s2 + 4 * hh, 32 * d + 16 * gsel, lane);
                        o[d] = __builtin_amdgcn_mfma_f32_32x32x16_bf16(Av, __builtin_bit_cast(bf16x8v, bp), o[d], 0, 0, 0); } }
            carry += tot;
            if (k0 <= 0) break;
            if (__all(carry > SB_THRESH)) break;
        }
        bf16* op = mix + (size_t)(b * S + q0 + r) * D + h * 64;
#pragma unroll
        for (int d = 0; d < 2; ++d)
#pragma unroll
            for (int g4 = 0; g4 < 4; ++g4)
                *(unsigned long long*)(op + 32 * d + 8 * g4 + 4 * hh) = (unsigned long long)pk2(o[d][4 * g4], o[d][4 * g4 + 1]) | ((unsigned long long)pk2(o[d][4 * g4 + 2], o[d][4 * g4 + 3]) << 32);
    }
}

__global__ void __launch_bounds__(NTHR, 2) mega_fwd(MArgs args) {
    extern __shared__ __attribute__((aligned(16))) unsigned char lds[];
    LAS unsigned char* ldsl = (LAS unsigned char*)lds;
    const int tid = threadIdx.x, G = gridDim.x;
    volatile LAS unsigned* MISC = (volatile LAS unsigned*)(ldsl + XTRA_OFF + X_MISC);
    LAS int* tb = (LAS int*)(ldsl + XTRA_OFF + X_TB); LAS int* nn = (LAS int*)(ldsl + XTRA_OFF + X_NN);
    for (int u = tid; u < (LDS_BYTES - XTRA_OFF) / 4; u += NTHR) ((LAS unsigned*)(ldsl + XTRA_OFF))[u] = 0u;
    __syncthreads();
    unsigned char* ws = args.ws;
    unsigned* ctl = (unsigned*)(ws + WS_CTL);
    XcdBarrier bar = xcd_barrier_post(ctl + CW_BAR, MISC + 8);
    const int lo = args.ph_lo, hi = args.ph_hi;
#define IN(k) (lo <= (k) && (k) < hi)
#ifndef REP_MASK
#define REP_MASK 0
#endif
#define PHASE(k, ...) do { if (IN(k)) { for (int rep_ = 0; rep_ < (((REP_MASK >> (k)) & 1) ? 2 : 1); ++rep_) { if (rep_) xcd_barrier(bar); __VA_ARGS__ } } if (IN(k) && IN((k) + 1)) xcd_barrier(bar); } while (0)
    int* cnt = (int*)ctl + CW_CNT; i32x2* list = (i32x2*)(ws + WS_ROUTE + 2 * MiB); float* topg = (float*)(ws + WS_ROUTE + 1 * MiB);
    PHASE(0, ph_mod_prep(args, lds, G););
    PHASE(1, ph_ln1(args, lds, G););
    PHASE(2, { pg8::StaticOrder So; So.init(ws + WS_U1, ws + WS_WTIN, T, NPROJ, D, G, blockIdx.x);
        pg8::EpiBf16 E{(bf16*)(ws + WS_PROJ), NPROJ, 2, QSCALE};
        pg8::gemm_phase<pg8::EpiBf16, pg8::StaticOrder, false>(ldsl, D, So, E); });
    PHASE(3, ml_phaseA(args, ldsl, blockIdx.x, G););
    PHASE(4, ml_phaseB(args, ldsl, blockIdx.x, G); __syncthreads(); attn_phase((const bf16*)(ws + WS_PROJ), (bf16*)(ws + WS_MIX), ldsl, blockIdx.x, G););
    PHASE(5, ml_phaseC(args, ldsl, G););
    PHASE(6, { pg8::StaticOrder So; So.init(ws + WS_MIX, ws + WS_WTOUT, T, D, D, G, blockIdx.x);
        pg8::EpiBf16 E{(bf16*)(ws + WS_MIXOUT), D, 0, 1.f};
        pg8::gemm_phase<pg8::EpiBf16, pg8::StaticOrder, false>(ldsl, D, So, E); });
    PHASE(7, ph_ln2(args, G););
    PHASE(8, { pg8::StaticOrder So; So.init(ws + WS_U2, ws + WS_WTR, T, NE, D, G, blockIdx.x);
        pg8::EpiF32 E{(float*)(ws + WS_LOGITS), NE};
        pg8::gemm_phase<pg8::EpiF32, pg8::StaticOrder, false>(ldsl, D, So, E); });
    PHASE(9, { const int lane_ = tid & 63; const f32x4 bias4 = *(const f32x4*)(args.in[13] + 4 * lane_);
        for (int t = blockIdx.x * NWAVES + (tid >> 6); t < T; t += G * NWAVES) route_wave(t, lane_, (const float*)(ws + WS_LOGITS), bias4, (int*)(ws + WS_ROUTE), topg, cnt); });
    PHASE(10, { moe_tables(cnt, tb, nn); const int* tope = (const int*)(ws + WS_ROUTE); int* fill = (int*)ctl + CW_FILL;
        for (int id = blockIdx.x * NTHR + tid; id < T * TOPK; id += G * NTHR) { const int e = tope[id]; const int pos = atomicAdd(fill + e, 1);
            list[tb[e] * 256 + pos] = (i32x2){id, __float_as_int(topg[id])}; } });
    PHASE(11, { moe_tables(cnt, tb, nn);
        pg8::MoeOrder So{G, (int)blockIdx.x, tb[NEX] * 2, 1, tb, nn, list, (const char*)(ws + WS_U2), 0, (const char*)(ws + WS_WT13), (size_t)512 * D * 2, (size_t)256 * D * 2};
        pg8::EpiGlu E{(bf16*)(ws + WS_H)};
        pg8::gemm_phase<pg8::EpiGlu, pg8::MoeOrder, true>(ldsl, D, So, E); });
    PHASE(12, { moe_tables(cnt, tb, nn);
        pg8::MoeOrder So{G, (int)blockIdx.x, tb[NEX] * 4, 2, tb, nn, list, (const char*)(ws + WS_H), (size_t)256 * FF * 2, (const char*)(ws + WS_WT2), (size_t)D * FF * 2, (size_t)256 * FF * 2};
        pg8::EpiScatter E{(bf16*)(ws + WS_YS), (bf16*)(ws + WS_YSH), list, nn};
        pg8::gemm_phase<pg8::EpiScatter, pg8::MoeOrder, false>(ldsl, FF, So, E); });
    PHASE(13, ph_final(args, G););
#undef PHASE
#undef IN
}

#ifndef MK_UPTO
#define MK_UPTO 14
#endif
__global__ void k_nan_fill(float* out, int n) { for (int i = blockIdx.x * blockDim.x + threadIdx.x; i < n; i += gridDim.x * blockDim.x) out[i] = __builtin_nanf(""); }
extern "C" void kernel_launch(void* const* d_in, const int* in_sizes, int n_in, void* d_out, int out_size, void* d_ws, size_t ws_size, hipStream_t stream) {
    static int grid = 0;
    if (grid == 0) {
        int dev = 0, cus = 0, per_cu = 0; grid = -1;
        if (n_in != 22 || out_size != T * D || ws_size < WS_END) fprintf(stderr, "kernel_launch: unexpected shapes (n_in %d out %d ws %zu, need %zu)\n", n_in, out_size, ws_size, (size_t)WS_END);
        else if (hipGetDevice(&dev) != hipSuccess || hipDeviceGetAttribute(&cus, hipDeviceAttributeMultiprocessorCount, dev) != hipSuccess) fprintf(stderr, "kernel_launch: device query failed\n");
        else if (hipFuncSetAttribute((const void*)mega_fwd, hipFuncAttributeMaxDynamicSharedMemorySize, LDS_BYTES) != hipSuccess) fprintf(stderr, "kernel_launch: hipFuncSetAttribute failed\n");
        else if (hipOccupancyMaxActiveBlocksPerMultiprocessor(&per_cu, (const void*)mega_fwd, NTHR, LDS_BYTES) != hipSuccess || per_cu < 1) fprintf(stderr, "kernel_launch: occupancy query says %d blocks per CU\n", per_cu);
        else grid = cus;
        (void)hipGetLastError();
    }
    if (grid < 0) { k_nan_fill<<<1024, 256, 0, stream>>>((float*)d_out, out_size); return; }
    const float* x = (const float*)d_in[0];
    const float* conv_w = (const float*)d_in[5]; const float* conv_b = (const float*)d_in[6];
    const float* norm_g = (const float*)d_in[8]; const float* ln1_g = (const float*)d_in[10]; const float* ln1_b = (const float*)d_in[11];
    const float* rbias = (const float*)d_in[13]; const float* ln2_g = (const float*)d_in[20]; const float* ln2_b = (const float*)d_in[21];
    char* ws = (char*)d_ws; float* out = (float*)d_out;
    float* mod = (float*)(ws + WS_MOD); bf16* wtin = (bf16*)(ws + WS_WTIN); bf16* wtout = (bf16*)(ws + WS_WTOUT); bf16* wtr = (bf16*)(ws + WS_WTR);
    bf16* wt13 = (bf16*)(ws + WS_WT13); bf16* wt2 = (bf16*)(ws + WS_WT2); int* plan = (int*)(ws + WS_PLAN);
    bf16* u1 = (bf16*)(ws + WS_U1); bf16* proj = (bf16*)(ws + WS_PROJ); float* ipre = (float*)(ws + WS_GATES); float* logf = ipre + 16 * S;
    float* hraw = (float*)(ws + WS_HRAW); bf16* mix = (bf16*)(ws + WS_MIX); bf16* mixout = (bf16*)(ws + WS_MIXOUT); bf16* u2 = (bf16*)(ws + WS_U2);
    float* logits = (float*)(ws + WS_LOGITS); int* tope = (int*)(ws + WS_ROUTE); float* topg = (float*)(ws + WS_ROUTE + 1 * MiB); i32x2* list = (i32x2*)(ws + WS_ROUTE + 2 * MiB);
    bf16* H = (bf16*)(ws + WS_H); bf16* ys = (bf16*)(ws + WS_YS); bf16* ysh = (bf16*)(ws + WS_YSH);
    int* cnt = (int*)(ws + WS_CTL) + CW_CNT;
    (void)hipMemsetAsync(ws + WS_CTL, 0, 1 * MiB, stream);
    if (MK_UPTO > 0) {
        MArgs a{};
        for (int i = 0; i < 22; ++i) a.in[i] = (const float*)d_in[i];
        a.out = out; a.ws = (unsigned char*)d_ws; a.ph_lo = 0; a.ph_hi = MK_UPTO;
        hipLaunchKernelGGL(mega_fwd, dim3(grid), dim3(NTHR), LDS_BYTES, stream, a);
    }
    if (MK_UPTO <= 0) { k_mod<<<192, 512, 0, stream>>>((const float*)d_in[1], (const float*)d_in[2], (const float*)d_in[3], mod);
        PrepArgs pa{(const float*)d_in[4], (const float*)d_in[9], (const float*)d_in[12], (const float*)d_in[14], (const float*)d_in[15], (const float*)d_in[16], (const float*)d_in[17], (const float*)d_in[18], (const float*)d_in[19], wtin, wtout, wtr, wt13, wt2};
        k_prep<<<2048, 512, 0, stream>>>(pa); }
    if (MK_UPTO <= 1) k_ln1<<<T / 128, 512, 0, stream>>>(x, mod, (const float*)d_in[4], (const float*)d_in[7], u1, ipre, logf);
    if (MK_UPTO <= 2) k_ngemm<0><<<dim3(NPROJ / 64, T / 64), 256, 0, stream>>>(u1, wtin, proj, T, NPROJ, D, NPROJ, 512, QSCALE);
    if (MK_UPTO <= 3) { k_attn_naive<<<NB * 8 * S / 256, 256, 0, stream>>>(proj, mix); k_mlstm_naive<<<128, 256, 0, stream>>>(proj, conv_w, conv_b, ipre, logf, hraw);
        k_mlnorm_naive<<<T, 256, 0, stream>>>(hraw, proj, norm_g, mix); }
    if (MK_UPTO <= 6) k_ngemm<0><<<dim3(D / 64, T / 64), 256, 0, stream>>>(mix, wtout, mixout, T, D, D, D, 0, 1.f);
    if (MK_UPTO <= 7) k_ln2<<<T / 128, 512, 0, stream>>>(x, mixout, mod, ln1_g, ln1_b, out, u2);
    if (MK_UPTO <= 8) k_ngemm<1><<<dim3(NE / 64, T / 64), 256, 0, stream>>>(u2, wtr, logits, T, NE, D, NE, 0, 1.f);
    if (MK_UPTO <= 9) k_route<<<T / 256, 256, 0, stream>>>(logits, rbias, tope, topg, cnt);
    constexpr int MAXT64 = T * TOPK / 64 + NE + T / 64;
    if (MK_UPTO <= 12) k_plan<<<1, 64, 0, stream>>>(cnt, plan);
    if (MK_UPTO <= 10) k_fill<<<T * TOPK / 256, 256, 0, stream>>>(tope, topg, plan, cnt + (CW_FILL - CW_CNT), list);
    if (MK_UPTO <= 11) k_moe1_naive<<<dim3(4, MAXT64), 256, 0, stream>>>(u2, wt13, cnt, plan, list, H);
    if (MK_UPTO <= 12) k_moe2_naive<<<dim3(16, MAXT64), 256, 0, stream>>>(H, wt2, cnt, plan, list, topg, ys, ysh);
    if (MK_UPTO <= 13) k_final<<<T / 128, 512, 0, stream>>>(out, ys, ysh, mod, ln2_g, ln2_b);
}
```

```cpp
#include <hip/hip_runtime.h>
#include <cstdio>
#include <cstdint>

typedef unsigned short bf16;
typedef unsigned v4u __attribute__((ext_vector_type(4)));
typedef float f32x4 __attribute__((ext_vector_type(4)));
typedef int i32x2 __attribute__((ext_vector_type(2)));

constexpr int D = 1024, NB = 4, S = 8192, T = NB * S;
constexpr int NPROJ = 3584, WIN_LD = 3592;
constexpr int C_SBQ = 0, C_SBK = 512, C_SBV = 1024, C_MLQ = 1536, C_MLK = 2048, C_MLV = 2560, C_MLO = 3072, C_GATE = 3584;
constexpr int NE = 256, NEX = 257, TOPK = 8, FF = 256;
constexpr float LN_EPS = 1e-5f;
constexpr float DN_ALPHA = 1.189207115002721f;
constexpr float LOG2E = 1.4426950408889634f;
constexpr float QSCALE = 0.125f * LOG2E;
constexpr float SB_THRESH = 48.0f;

constexpr size_t MiB = 1u << 20;
constexpr size_t WS_CTL = 0;
constexpr size_t WS_MOD = 1 * MiB;
constexpr size_t WS_WTIN = 2 * MiB;
constexpr size_t WS_WTOUT = 10 * MiB;
constexpr size_t WS_WTR = 12 * MiB;
constexpr size_t WS_PLAN = 13 * MiB;
constexpr size_t WS_WT2 = 16 * MiB;
constexpr size_t WS_YS = 145 * MiB;
constexpr size_t WS_WT13 = 145 * MiB;
constexpr size_t WS_U2F8 = 274 * MiB;
constexpr size_t WS_PROJ = 402 * MiB;
constexpr size_t WS_GATES = 626 * MiB;
constexpr size_t WS_H = 657 * MiB;
constexpr size_t WS_STATES = 657 * MiB;
constexpr size_t WS_MIXOUT = 657 * MiB;
constexpr size_t WS_LOGITS = 657 * MiB;
constexpr size_t WS_U1 = 725 * MiB;
constexpr size_t WS_MIX = 725 * MiB;
constexpr size_t WS_U2 = 833 * MiB;
constexpr size_t WS_YSH = 833 * MiB;
constexpr size_t WS_HRAW = 833 * MiB;
constexpr size_t WS_ROUTE = 897 * MiB;
constexpr size_t WS_END = 902 * MiB;
constexpr int CW_CNT = 1024;
constexpr int CW_FILL = 1536;
constexpr int PL_SLOT = 0, PL_T64 = 512, PL_T256 = 1024;

__device__ __forceinline__ unsigned f2bf(float f) { unsigned u = __builtin_bit_cast(unsigned, f); return (u + 0x7fffu + ((u >> 16) & 1u)) >> 16; }
__device__ __forceinline__ float bf2f(unsigned b) { return __builtin_bit_cast(float, b << 16); }
__device__ __forceinline__ unsigned pk2(float lo, float hi) { return f2bf(lo) | (f2bf(hi) << 16); }
__device__ __forceinline__ unsigned pk4_fp8(float a, float b, float c, float d) { int w = 0; w = __builtin_amdgcn_cvt_pk_fp8_f32(a, b, w, false); w = __builtin_amdgcn_cvt_pk_fp8_f32(c, d, w, true); return (unsigned)w; }
__device__ __forceinline__ float wave_sum(float v) {
#pragma unroll
    for (int o = 1; o < 64; o <<= 1) v += __shfl_xor(v, o);
    return v;
}
__device__ __forceinline__ float sigmoidf_(float x) { return 1.f / (1.f + __expf(-x)); }
__device__ __forceinline__ float siluf_(float x) { return x / (1.f + __expf(-x)); }


template <bool F8>
__device__ __forceinline__ void transpose_item(const float* __restrict__ W, int ldw, void* __restrict__ WTv, int ldt, int k0, int n0, int rowmap, int lane) {
    const int g = lane >> 4, i = lane & 15;
    f32x4 v[16];
#pragma unroll
    for (int r = 0; r < 16; ++r) v[r] = __builtin_nontemporal_load((const f32x4*)(W + (size_t)(k0 + 16 * g + r) * ldw + n0 + 4 * i));
#pragma unroll
    for (int nn = 0; nn < 4; ++nn) {
        const int n = n0 + 4 * i + nn;
        const int dr = rowmap == 0 ? n : ((n >> 7) * 256 + (rowmap == 2 ? 128 : 0) + (n & 127));
        if constexpr (F8) {
            v4u o; o.x = pk4_fp8(v[0][nn] * 64.f, v[1][nn] * 64.f, v[2][nn] * 64.f, v[3][nn] * 64.f); o.y = pk4_fp8(v[4][nn] * 64.f, v[5][nn] * 64.f, v[6][nn] * 64.f, v[7][nn] * 64.f);
            o.z = pk4_fp8(v[8][nn] * 64.f, v[9][nn] * 64.f, v[10][nn] * 64.f, v[11][nn] * 64.f); o.w = pk4_fp8(v[12][nn] * 64.f, v[13][nn] * 64.f, v[14][nn] * 64.f, v[15][nn] * 64.f);
            *(v4u*)((unsigned char*)WTv + (size_t)dr * ldt + k0 + 16 * g) = o;
        } else {
            v4u o0, o1; o0.x = pk2(v[0][nn], v[1][nn]); o0.y = pk2(v[2][nn], v[3][nn]); o0.z = pk2(v[4][nn], v[5][nn]); o0.w = pk2(v[6][nn], v[7][nn]);
            o1.x = pk2(v[8][nn], v[9][nn]); o1.y = pk2(v[10][nn], v[11][nn]); o1.z = pk2(v[12][nn], v[13][nn]); o1.w = pk2(v[14][nn], v[15][nn]);
            v4u* dp = (v4u*)((bf16*)WTv + (size_t)dr * ldt + k0 + 16 * g); dp[0] = o0; dp[1] = o1;
        }
    }
}
struct PrepArgs { const float *w_in, *w_out, *w_router, *w1, *w3, *w2, *sw1, *sw3, *sw2; unsigned char* wtin; bf16 *wtout, *wtr; unsigned char* wt13; bf16* wt2; };
constexpr int IT_IN = 16 * 56, IT_OUT = 16 * 16, IT_R = 16 * 4, IT_E = 192, IT_TOTAL = IT_IN + IT_OUT + IT_R + NEX * IT_E;
__device__ __forceinline__ void prep_item(const PrepArgs& a, int it, int lane) {
    if (it < IT_IN) { transpose_item<true>(a.w_in, WIN_LD, a.wtin, D, (it / 56) * 64, (it % 56) * 64, 0, lane); return; } it -= IT_IN;
    if (it < IT_OUT) { transpose_item<false>(a.w_out, D, a.wtout, D, (it / 16) * 64, (it % 16) * 64, 0, lane); return; } it -= IT_OUT;
    if (it < IT_R) { transpose_item<false>(a.w_router, NE, a.wtr, D, (it / 4) * 64, (it % 4) * 64, 0, lane); return; } it -= IT_R;
    const int e = it / IT_E, r = it % IT_E;
    const float* p1 = e < NE ? a.w1 + (size_t)e * D * FF : a.sw1; const float* p3 = e < NE ? a.w3 + (size_t)e * D * FF : a.sw3; const float* p2 = e < NE ? a.w2 + (size_t)e * FF * D : a.sw2;
    unsigned char* d13 = a.wt13 + (size_t)e * 512 * D; bf16* d2 = a.wt2 + (size_t)e * D * FF;
    if (r < 64) { transpose_item<true>(p1, FF, d13, D, (r / 4) * 64, (r % 4) * 64, 1, lane); return; }
    if (r < 128) { const int q = r - 64; transpose_item<true>(p3, FF, d13, D, (q / 4) * 64, (q % 4) * 64, 2, lane); return; }
    { const int q = r - 128; transpose_item<false>(p2, D, d2, FF, (q / 16) * 64, (q % 16) * 64, 0, lane); }
}


__device__ __forceinline__ f32x4 ld_bf4(const bf16* p) { const unsigned long long w = *(const unsigned long long*)p;
    return (f32x4){bf2f((unsigned)w & 0xffffu), bf2f(((unsigned)w) >> 16), bf2f((unsigned)(w >> 32) & 0xffffu), bf2f((unsigned)(w >> 48))}; }

#define LAS __attribute__((address_space(3)))
#define GAS __attribute__((address_space(1)))
namespace pg8 {
typedef short bf16x8 __attribute__((ext_vector_type(8)));
constexpr int F8_SCALE_W = 121;
constexpr int BM = 256, BK = 64, HALF = 128, HTB = HALF * BK * 2, STAGE_BYTES = 8 * HTB, NXCD = 8, WGM = 8;
__host__ __device__ __forceinline__ int lds_byte(int r, int c) { const int st = (r >> 4) * 2 + (c >> 5), rr = r & 15, cc = c & 31, ob = rr * 64 + cc * 2; return st * 1024 + (ob ^ (((ob >> 9) & 1) << 5)); }
__host__ __device__ __forceinline__ void stage_rc(int b, int& R, int& C) { const int st = b / 1024, sb = b % 1024, swz = sb ^ (((sb >> 9) & 1) << 5); R = (st >> 1) * 16 + swz / 64; C = (st & 1) * 32 + (swz % 64) / 2; }
__host__ __device__ __forceinline__ int perm32(int rho) { const int n = rho >> 4, i = rho & 15; return 8 * (i >> 2) + 4 * n + (i & 3); }

struct Unit { int pm, pn, e, mt; const char* A; const char* B; };

__device__ __forceinline__ long unit_index(int i, int G, int c) { return (G % 8 == 0) ? ((long)(i * 8 + (c & 7)) * (G / 8) + (c >> 3)) : ((long)i * G + c); }

struct StaticOrder {
    int nM, nN, nwg, G, c; const char* A; const char* B; size_t tstep;
    __device__ void init(const void* A_, const void* B_, int M, int N, int Kb, int G_, int c_) { nM = M / BM; nN = N / BM; nwg = nM * nN; G = G_; c = c_; A = (const char*)A_; B = (const char*)B_; tstep = (size_t)BM * Kb; }
    __device__ __forceinline__ bool next(int i, Unit& u) const {
        const long L = (long)i * G + c; if (L >= nwg) return false;
        int wgid = (int)L; { const int q = nwg / NXCD, r = nwg % NXCD, xcd = wgid % NXCD, off = wgid / NXCD; wgid = (xcd < r ? xcd * (q + 1) : r * (q + 1) + (xcd - r) * q) + off; }
        const int nig = WGM * nN, gid = wgid / nig, fm = gid * WGM, gsz = (nM - fm) < WGM ? (nM - fm) : WGM;
        u.pm = fm + ((wgid % nig) % gsz); u.pn = (wgid % nig) / gsz; u.e = 0; u.mt = u.pm; u.A = A + (size_t)u.pm * tstep; u.B = B + (size_t)u.pn * tstep; return true;
    }
    __device__ __forceinline__ int row_token(const Unit&, int) const { return 0; }
};

struct MoeOrder {
    int G, c, total, shift; const LAS int* tb; const LAS int* nn; const i32x2* list;
    const char* Abase; size_t a_tile_stride; const char* Bbase; size_t b_exp_stride, b_pn_stride;
    __device__ __forceinline__ bool next(int i, Unit& u) const {
        const long L = unit_index(i, G, c); if (L >= total) return false;
        const int tile = (int)(L >> shift); u.pn = (int)(L & ((1 << shift) - 1));
        int lo = 0, hi = NEX; while (hi - lo > 1) { const int mid = (lo + hi) >> 1; if (tb[mid] <= tile) lo = mid; else hi = mid; }
        u.e = lo; u.mt = tile - tb[lo]; u.pm = tile;
        u.A = Abase + (size_t)tile * a_tile_stride; u.B = Bbase + (size_t)lo * b_exp_stride + (size_t)u.pn * b_pn_stride; return true;
    }
    __device__ __forceinline__ int row_token(const Unit& u, int row) const {
        const int rr = u.mt * 256 + row;
        if (u.e >= NE) return rr;
        return rr < nn[u.e] ? (list[u.pm * 256 + row].x >> 3) : 0;
    }
};

__device__ __forceinline__ unsigned cvt_pk_bf16(float lo, float hi) { unsigned r; asm volatile("v_cvt_pk_bf16_f32 %0, %1, %2" : "=v"(r) : "v"(lo), "v"(hi)); return r; }

struct EpiBf16 {
    static constexpr bool PERM = true; bf16* O; int ldc; int scale_tiles; float scale; float gscale;
    __device__ __forceinline__ void operator()(const f32x4 (&acc)[2][2][4][2], const Unit& u, int wr, int wc, int fr, int fq) const {
        const int row0 = u.pm * BM + wr * 64 + fr, col0 = u.pn * BM + wc * 32 + 8 * fq; const float sc = (u.pn < scale_tiles ? scale : 1.f) * gscale;
#pragma unroll
        for (int ai = 0; ai < 2; ++ai)
#pragma unroll
            for (int m = 0; m < 4; ++m) { bf16* rowp = O + (size_t)(row0 + ai * HALF + m * 16) * ldc + col0;
#pragma unroll
                for (int bj = 0; bj < 2; ++bj) { const f32x4 v0 = acc[ai][bj][m][0] * sc, v1 = acc[ai][bj][m][1] * sc;
                    v4u w; w.x = cvt_pk_bf16(v0[0], v0[1]); w.y = cvt_pk_bf16(v0[2], v0[3]); w.z = cvt_pk_bf16(v1[0], v1[1]); w.w = cvt_pk_bf16(v1[2], v1[3]);
                    *(v4u*)(rowp + bj * HALF) = w; } }
    }
};
struct EpiF32 {
    static constexpr bool PERM = false; float* C; int ldc;
    __device__ __forceinline__ void operator()(const f32x4 (&acc)[2][2][4][2], const Unit& u, int wr, int wc, int fr, int fq) const {
        const int row0 = u.pm * BM + wr * 64 + fr, col0 = u.pn * BM + wc * 32 + 4 * fq;
#pragma unroll
        for (int ai = 0; ai < 2; ++ai)
#pragma unroll
            for (int m = 0; m < 4; ++m) { float* rowp = C + (size_t)(row0 + ai * HALF + m * 16) * ldc + col0;
#pragma unroll
                for (int bj = 0; bj < 2; ++bj)
#pragma unroll
                    for (int n = 0; n < 2; ++n) *(f32x4*)(rowp + bj * HALF + n * 16) = acc[ai][bj][m][n]; }
    }
};
struct EpiGlu {
    static constexpr bool PERM = true; bf16* H; float gscale;
    __device__ __forceinline__ void operator()(const f32x4 (&acc)[2][2][4][2], const Unit& u, int wr, int wc, int fr, int fq) const {
        const int row0 = u.pm * BM + wr * 64 + fr, col0 = u.pn * HALF + wc * 32 + 8 * fq;
#pragma unroll
        for (int ai = 0; ai < 2; ++ai)
#pragma unroll
            for (int m = 0; m < 4; ++m) { float h[8];
#pragma unroll
                for (int n = 0; n < 2; ++n)
#pragma unroll
                    for (int q = 0; q < 4; ++q) { const float a = acc[ai][0][m][n][q] * gscale; h[n * 4 + q] = a * __builtin_amdgcn_rcpf(1.f + __expf(-a)) * (acc[ai][1][m][n][q] * gscale); }
                v4u w; w.x = cvt_pk_bf16(h[0], h[1]); w.y = cvt_pk_bf16(h[2], h[3]); w.z = cvt_pk_bf16(h[4], h[5]); w.w = cvt_pk_bf16(h[6], h[7]);
                *(v4u*)(H + (size_t)(row0 + ai * HALF + m * 16) * FF + col0) = w; }
    }
};
struct EpiScatter {
    static constexpr bool PERM = true; bf16* ys; bf16* ysh; const i32x2* list; const LAS int* nn;
    __device__ __forceinline__ void operator()(const f32x4 (&acc)[2][2][4][2], const Unit& u, int wr, int wc, int fr, int fq) const {
        const int col0 = u.pn * BM + wc * 32 + 8 * fq; const int n = nn[u.e]; const bool routed = u.e < NE;
        const i32x2* lp = list + (size_t)(u.pm - u.mt) * 256;
#pragma unroll
        for (int ai = 0; ai < 2; ++ai) {
            i32x2 en[4];
#pragma unroll
            for (int m = 0; m < 4; ++m) { const int rr = u.mt * 256 + ai * HALF + wr * 64 + m * 16 + fr; en[m] = (i32x2){rr, 0x3f800000};
                if (routed && rr < n) en[m] = lp[rr]; }
#pragma unroll
            for (int m = 0; m < 4; ++m) { const int rr = u.mt * 256 + ai * HALF + wr * 64 + m * 16 + fr;
                if (rr < n) { bf16* dst = (routed ? ys : ysh) + (size_t)en[m].x * D + col0; const float g = __int_as_float(en[m].y);
#pragma unroll
                    for (int bj = 0; bj < 2; ++bj) { const f32x4 v0 = acc[ai][bj][m][0] * g, v1 = acc[ai][bj][m][1] * g;
                        v4u w; w.x = cvt_pk_bf16(v0[0], v0[1]); w.y = cvt_pk_bf16(v0[2], v0[3]); w.z = cvt_pk_bf16(v1[0], v1[1]); w.w = cvt_pk_bf16(v1[2], v1[3]);
                        *(v4u*)(dst + bj * HALF) = w; } } }
            __builtin_amdgcn_sched_barrier(0);
        }
    }
};

typedef int i32x8 __attribute__((ext_vector_type(8)));
typedef int i32x4 __attribute__((ext_vector_type(4)));
template <bool FP8> struct FragT { struct A4 { bf16x8 v[4][2]; }; struct B2 { bf16x8 v[2][2]; }; };
template <> struct FragT<true> { struct A4 { i32x8 v[4]; }; struct B2 { i32x8 v[2]; }; };
template <class Epi, class Sched, bool GATHER, bool FP8>
__device__ __forceinline__ void gemm_phase(LAS unsigned char* lds, const int Kb, const Sched& S, const Epi& E) {
    const int tid = threadIdx.x, wid = __builtin_amdgcn_readfirstlane(tid >> 6), lane = tid & 63, wr = wid >> 2, wc = wid & 3, fr = lane & 15, fq = lane >> 4;
    const int nt = Kb / 128;
    int sR[2], sC[2];
    unsigned voffA[2], voffB[2];
#pragma unroll
    for (int i = 0; i < 2; ++i) { stage_rc(tid * 16 + i * 8192, sR[i], sC[i]); const int Rb = Epi::PERM ? ((sR[i] & ~31) + perm32(sR[i] & 31)) : sR[i];
        voffA[i] = (unsigned)(sR[i] * Kb + sC[i] * 2); voffB[i] = (unsigned)(Rb * Kb + sC[i] * 2); }
    const size_t kstep = (size_t)(BK * 2);
    const size_t hstep = (size_t)HALF * Kb;
    const unsigned ldsw = (unsigned)wid * 1024u;
    const int aoff = lds_byte(wr * 64 + fr, fq * 8), boff = lds_byte(wc * 32 + fr, fq * 8);
    unsigned gc[2][2], gn[2][2];
#define PG8_SA(b, h) (((b) * 2 + (h)) * HTB)
#define PG8_SB(b, h) ((4 + (b) * 2 + (h)) * HTB)
#define PG8_GLDS(src, bufoff, i) __builtin_amdgcn_global_load_lds((const unsigned*)(src), (LAS unsigned*)(lds + (bufoff) + ldsw + (i) * 8192), 16, 0, 0)
#define PG8_STAGE_B(bufoff, gbase) do { PG8_GLDS((const char*)(gbase) + voffB[0], bufoff, 0); PG8_GLDS((const char*)(gbase) + voffB[1], bufoff, 1); } while (0)
#define PG8_STAGE_A(bufoff, gbase, h, nx) do { if constexpr (GATHER) { const unsigned _o0 = (nx) ? gn[h][0] : gc[h][0], _o1 = (nx) ? gn[h][1] : gc[h][1]; \
            PG8_GLDS((const char*)(gbase) + _o0, bufoff, 0); PG8_GLDS((const char*)(gbase) + _o1, bufoff, 1); } \
        else { PG8_GLDS((const char*)(gbase) + (h) * hstep + voffA[0], bufoff, 0); PG8_GLDS((const char*)(gbase) + (h) * hstep + voffA[1], bufoff, 1); } } while (0)
#define PG8_LD2(dstv, p) do { if constexpr (FP8) { const i32x4 _lo = *(const LAS i32x4*)(p), _hi = *(const LAS i32x4*)((p) + 1024); dstv = __builtin_shufflevector(_lo, _hi, 0, 1, 2, 3, 4, 5, 6, 7); } } while (0)
#define PG8_LDA(dst, b, h) do { _Pragma("unroll") for (int m = 0; m < 4; ++m) { if constexpr (FP8) { PG8_LD2(dst.v[m], lds + PG8_SA(b, h) + aoff + m * 2048); } \
        else { _Pragma("unroll") for (int k = 0; k < 2; ++k) dst.v[m][k] = *(const LAS bf16x8*)(lds + PG8_SA(b, h) + aoff + m * 2048 + k * 1024); } } } while (0)
#define PG8_LDB(dst, b, h) do { _Pragma("unroll") for (int n = 0; n < 2; ++n) { if constexpr (FP8) { PG8_LD2(dst.v[n], lds + PG8_SB(b, h) + boff + n * 2048); } \
        else { _Pragma("unroll") for (int k = 0; k < 2; ++k) dst.v[n][k] = *(const LAS bf16x8*)(lds + PG8_SB(b, h) + boff + n * 2048 + k * 1024); } } } while (0)
#define PG8_MMA(ai, bj, At, Bt) do { __builtin_amdgcn_s_setprio(1); _Pragma("unroll") for (int m = 0; m < 4; ++m) _Pragma("unroll") for (int n = 0; n < 2; ++n) { \
        if constexpr (FP8) asm volatile("s_nop 1\n\tv_mfma_scale_f32_16x16x128_f8f6f4 %0, %1, %2, %0, %3, %3 op_sel_hi:[0,0,0]" : "+v"(acc[ai][bj][m][n]) : "v"(Bt.v[n]), "v"(At.v[m]), "v"(f8scale)); \
        else { _Pragma("unroll") for (int k = 0; k < 2; ++k) acc[ai][bj][m][n] = __builtin_amdgcn_mfma_f32_16x16x32_bf16(Bt.v[n][k], At.v[m][k], acc[ai][bj][m][n], 0, 0, 0); } } \
        __builtin_amdgcn_s_setprio(0); } while (0)
#define PG8_WAIT_V(n) asm volatile("s_waitcnt vmcnt(" #n ")" ::: "memory")
#define PG8_WAIT_L(n) asm volatile("s_waitcnt lgkmcnt(" #n ")" ::: "memory")
#define PG8_BAR __builtin_amdgcn_s_barrier()
#define PG8_SCHED __builtin_amdgcn_sched_barrier(0)
#define PG8_GATHER(dst, u) do { _Pragma("unroll") for (int _h = 0; _h < 2; ++_h) _Pragma("unroll") for (int _i = 0; _i < 2; ++_i) \
        dst[_h][_i] = (unsigned)(S.row_token(u, _h * HALF + sR[_i]) * Kb + sC[_i] * 2); } while (0)
    Unit cur, nxt; int ui = 0;
    if (!S.next(0, cur)) return;
    f32x4 acc[2][2][4][2];
#pragma unroll
    for (int a = 0; a < 2; ++a)
#pragma unroll
        for (int b = 0; b < 2; ++b)
#pragma unroll
            for (int m = 0; m < 4; ++m)
#pragma unroll
                for (int n = 0; n < 2; ++n) acc[a][b][m][n] = (f32x4){0.f, 0.f, 0.f, 0.f};
    const int f8scale = 0x7f7f7f7f;
    typedef typename FragT<FP8>::A4 FragA; typedef typename FragT<FP8>::B2 FragB;
    FragA At; FragB B0, B1;
    const char* cA = cur.A; const char* cB = cur.B;
    if constexpr (GATHER) { PG8_GATHER(gc, cur); }
    PG8_STAGE_B(PG8_SB(0, 0), cB); PG8_STAGE_A(PG8_SA(0, 0), cA, 0, false); PG8_STAGE_B(PG8_SB(0, 1), cB + hstep); PG8_STAGE_A(PG8_SA(0, 1), cA, 1, false);
    if (wr == 1) PG8_BAR;
    PG8_WAIT_V(4); PG8_BAR;
    PG8_STAGE_B(PG8_SB(1, 0), cB + kstep); PG8_STAGE_A(PG8_SA(1, 0), cA + kstep, 0, false); PG8_STAGE_B(PG8_SB(1, 1), cB + hstep + kstep);
    PG8_WAIT_V(6); PG8_BAR;
    for (;;) {
        const bool has_next = S.next(ui + 1, nxt);
        const char* nA = has_next ? nxt.A : cA; const char* nB = has_next ? nxt.B : cB;
        if constexpr (GATHER) { if (has_next) { PG8_GATHER(gn, nxt); } else {
#pragma unroll
            for (int h = 0; h < 2; ++h) { gn[h][0] = gc[h][0]; gn[h][1] = gc[h][1]; } } }
#pragma unroll 1
        for (int t = 0; t < nt; t += 2) {
            const bool last = (t == nt - 2);
            const char* a1 = cA + (size_t)(t + 1) * kstep;
            const char* a2 = last ? nA : cA + (size_t)(t + 2) * kstep; const char* b2 = last ? nB : cB + (size_t)(t + 2) * kstep;
            const char* a3 = a2 + kstep; const char* b3 = b2 + kstep;
            PG8_LDB(B0, 0, 0); PG8_SCHED; PG8_LDA(At, 0, 0); PG8_STAGE_A(PG8_SA(1, 1), a1, 1, false);
            PG8_WAIT_L(8); PG8_BAR; PG8_WAIT_L(0); PG8_MMA(0, 0, At, B0); PG8_BAR; PG8_SCHED;
            PG8_LDB(B1, 0, 1); PG8_STAGE_B(PG8_SB(0, 0), b2);
            PG8_BAR; PG8_WAIT_L(0); PG8_MMA(0, 1, At, B1); PG8_BAR;
            PG8_LDA(At, 0, 1); PG8_STAGE_A(PG8_SA(0, 0), a2, 0, last);
            PG8_BAR; PG8_WAIT_L(0); PG8_MMA(1, 0, At, B0); PG8_BAR; PG8_SCHED;
            PG8_STAGE_B(PG8_SB(0, 1), b2 + hstep);
            PG8_WAIT_V(6); PG8_BAR; PG8_MMA(1, 1, At, B1); PG8_BAR;
            PG8_LDB(B0, 1, 0); PG8_SCHED; PG8_LDA(At, 1, 0); PG8_STAGE_A(PG8_SA(0, 1), a2, 1, last);
            PG8_WAIT_L(8); PG8_BAR; PG8_WAIT_L(0); PG8_MMA(0, 0, At, B0); PG8_BAR; PG8_SCHED;
            PG8_LDB(B1, 1, 1); PG8_STAGE_B(PG8_SB(1, 0), b3);
            PG8_BAR; PG8_WAIT_L(0); PG8_MMA(0, 1, At, B1); PG8_BAR;
            PG8_LDA(At, 1, 1); PG8_STAGE_A(PG8_SA(1, 0), a3, 0, last);
            PG8_BAR; PG8_WAIT_L(0); PG8_MMA(1, 0, At, B0); PG8_BAR; PG8_SCHED;
            PG8_STAGE_B(PG8_SB(1, 1), b3 + hstep);
            PG8_WAIT_V(6); PG8_BAR; PG8_MMA(1, 1, At, B1); PG8_BAR;
        }
        if constexpr (FP8) { __builtin_amdgcn_sched_barrier(0); asm volatile("s_nop 15\n\ts_nop 7" ::: "memory"); __builtin_amdgcn_sched_barrier(0); }
        E(acc, cur, wr, wc, fr, fq);
        if (!has_next) break;
#pragma unroll
        for (int a = 0; a < 2; ++a)
#pragma unroll
            for (int b = 0; b < 2; ++b)
#pragma unroll
                for (int m = 0; m < 4; ++m)
#pragma unroll
                    for (int n = 0; n < 2; ++n) acc[a][b][m][n] = (f32x4){0.f, 0.f, 0.f, 0.f};
        cur = nxt; cA = nA; cB = nB; ++ui;
        if constexpr (GATHER) {
#pragma unroll
            for (int h = 0; h < 2; ++h) { gc[h][0] = gn[h][0]; gc[h][1] = gn[h][1]; } }
    }
    PG8_WAIT_V(0);
    if (wr == 0) PG8_BAR;
    PG8_BAR;
#undef PG8_SA
#undef PG8_SB
#undef PG8_GLDS
#undef PG8_STAGE_A
#undef PG8_STAGE_B
#undef PG8_LDA
#undef PG8_LDB
#undef PG8_MMA
#undef PG8_WAIT_V
#undef PG8_WAIT_L
#undef PG8_BAR
#undef PG8_SCHED
#undef PG8_GATHER
}
}

#define XB_TMO      128
#define XB_XCNT(j)  (256  + 64 * (j))
#define XB_XSUB(j)  (1280 + 64 * (j))
#define XB_XGEN(j)  (2304 + 64 * (j))
#define XB_TOP      3328
#define XB_TOPGEN   3392
#define XCD_BAR_WORDS 3456
#define XB_SPIN_CAP (1u << 22)
__device__ __forceinline__ unsigned xb_ld(unsigned* p)              { return __hip_atomic_load(p, __ATOMIC_RELAXED, __HIP_MEMORY_SCOPE_AGENT); }
__device__ __forceinline__ unsigned xb_add(unsigned* p, unsigned v) { return __hip_atomic_fetch_add(p, v, __ATOMIC_RELAXED, __HIP_MEMORY_SCOPE_AGENT); }
__device__ __forceinline__ unsigned xb_xcc_id() { return (unsigned)__builtin_amdgcn_s_getreg((3 << 11) | 20) & 0xFu; }
#define XB_SPIN(cond, bar) do { unsigned _sp = 0; while (cond) { __builtin_amdgcn_s_sleep(1); \
    if ((++_sp & 255u) == 0u) { if (xb_ld(&(bar)[XB_TMO])) break; if (_sp > XB_SPIN_CAP) { atomicAdd(&(bar)[XB_TMO], 1u); break; } } } } while (0)
struct XcdBarrier { unsigned* bar; unsigned x; volatile LAS unsigned* st; };
__device__ __forceinline__ XcdBarrier xcd_barrier_post(unsigned* bar, volatile LAS unsigned* st) {
    XcdBarrier b; b.bar = bar; b.x = xb_xcc_id(); b.st = st;
    if (threadIdx.x == 0) (void)xb_add(&bar[XB_XCNT(b.x)], 1u);
    return b;
}
__device__ __forceinline__ void xcd_barrier_complete(unsigned* bar, unsigned x, unsigned& nloc, unsigned& nx) {
    const unsigned G = gridDim.x * gridDim.y * gridDim.z;
    unsigned sum, cnt, mine, sp = 0u;
    for (;;) {
        sum = 0u; cnt = 0u; mine = 0u;
#pragma unroll
        for (unsigned j = 0; j < 16; ++j) { const unsigned c = xb_ld(&bar[XB_XCNT(j)]); sum += c; cnt += (c > 0u) ? 1u : 0u; mine = (j == x) ? c : mine; }
        if (sum == G) break;
        __builtin_amdgcn_s_sleep(1);
        if ((++sp & 255u) == 0u) { if (xb_ld(&bar[XB_TMO])) break; if (sp > XB_SPIN_CAP) { atomicAdd(&bar[XB_TMO], 1u); break; } }
    }
    nloc = mine > 0u ? mine : 1u; nx = cnt > 0u ? cnt : 1u;
}
__device__ __forceinline__ void xcd_barrier(const XcdBarrier& b) {
    asm volatile("s_waitcnt vmcnt(0)" ::: "memory");
    __syncthreads();
    if (threadIdx.x == 0) {
        unsigned* bar = b.bar;
        __builtin_amdgcn_s_waitcnt(0);
        unsigned nloc = b.st[0], nx = b.st[1];
        if (nloc == 0u) { xcd_barrier_complete(bar, b.x, nloc, nx); b.st[0] = nloc; b.st[1] = nx; }
        const unsigned old = xb_add(&bar[XB_XSUB(b.x)], 1u);
        const unsigned gen = old / nloc;
        if (old + 1u == (gen + 1u) * nloc) {
            __builtin_amdgcn_fence(__ATOMIC_RELEASE, "agent");
            asm volatile("s_waitcnt vmcnt(0)" ::: "memory");
            const unsigned og = xb_add(&bar[XB_TOP], 1u);
            const unsigned tg = og / nx;
            if (og + 1u == (tg + 1u) * nx) xb_add(&bar[XB_TOPGEN], 1u);
            else XB_SPIN(xb_ld(&bar[XB_TOPGEN]) == tg, bar);
            __builtin_amdgcn_fence(__ATOMIC_ACQUIRE, "agent");
            xb_add(&bar[XB_XGEN(b.x)], 1u);
            asm volatile("s_waitcnt vmcnt(0)" ::: "memory");
        } else {
            XB_SPIN(xb_ld(&bar[XB_XGEN(b.x)]) == gen, bar);
            __builtin_amdgcn_fence(__ATOMIC_ACQUIRE, "agent");
            asm volatile("s_waitcnt vmcnt(0)" ::: "memory");
        }
    }
    __syncthreads();
}

constexpr int NWAVES = 8, NTHR = 512;
constexpr int RING_BYTES = 131072, XTRA_OFF = RING_BYTES, LDS_BYTES = 147456;
constexpr int X_MISC = 0, X_TB = 256, X_NN = 1536;
constexpr int CW_BAR = 4096;
constexpr int N_PHASES = 14;
struct MArgs { const float* in[22]; float* out; unsigned char* ws; int ph_lo, ph_hi; };

__device__ __forceinline__ void ph_mod_prep(const MArgs& a, unsigned char* smem, int G) {
    const int tid = threadIdx.x;
    unsigned char* ws = a.ws;
    if ((int)blockIdx.x < 192) {
        float* sc = (float*)smem; float* red = sc + NB * D;
        const float* c = a.in[1]; const float* w_ada = a.in[2]; const float* b_ada = a.in[3]; float* mod = (float*)(ws + WS_MOD);
        for (int i = tid; i < NB * D; i += NTHR) sc[i] = siluf_(c[i]);
        __syncthreads();
        for (int it = blockIdx.x; it < 192; it += G) {
            const int kq = tid >> 5, jl = tid & 31, j = it * 32 + jl;
            float a0 = 0.f, a1 = 0.f, a2 = 0.f, a3 = 0.f;
#pragma unroll 16
            for (int kk = 0; kk < 64; ++kk) { const int k = kq * 64 + kk; const float w = w_ada[(size_t)k * 6144 + j];
                a0 += sc[k] * w; a1 += sc[D + k] * w; a2 += sc[2 * D + k] * w; a3 += sc[3 * D + k] * w; }
            red[(kq * 4 + 0) * 32 + jl] = a0; red[(kq * 4 + 1) * 32 + jl] = a1; red[(kq * 4 + 2) * 32 + jl] = a2; red[(kq * 4 + 3) * 32 + jl] = a3;
            __syncthreads();
            if (tid < 128) { const int b = tid >> 5; float s = b_ada[j];
#pragma unroll
                for (int q = 0; q < 16; ++q) s += red[(q * 4 + b) * 32 + jl];
                mod[b * 6144 + j] = s; }
            __syncthreads();
        }
    }
    PrepArgs pa{a.in[4], a.in[9], a.in[12], a.in[14], a.in[15], a.in[16], a.in[17], a.in[18], a.in[19],
                (unsigned char*)(ws + WS_WTIN), (bf16*)(ws + WS_WTOUT), (bf16*)(ws + WS_WTR), (unsigned char*)(ws + WS_WT13), (bf16*)(ws + WS_WT2)};
    const int lane = tid & 63, gw = blockIdx.x * NWAVES + (tid >> 6), ngw = G * NWAVES;
    for (int it = gw; it < IT_TOTAL; it += ngw) prep_item(pa, it, lane);
}

__device__ __forceinline__ void ph_ln1(const MArgs& a, unsigned char* smem, int G) {
    const int tid = threadIdx.x, lane = tid & 63, wave = tid >> 6;
    const float* x = a.in[0]; const float* w_in = a.in[4]; const float* gate_b = a.in[7];
    const float* mod = (const float*)(a.ws + WS_MOD); unsigned char* u1 = (unsigned char*)(a.ws + WS_U1); float* ipre = (float*)(a.ws + WS_GATES); float* logf = ipre + 16 * S;
    float* wg = (float*)smem;
    for (int i = tid; i < D * 8; i += NTHR) wg[i] = w_in[(size_t)(i >> 3) * WIN_LD + C_GATE + (i & 7)];
    __syncthreads();
    for (int it = blockIdx.x; it < T / 128; it += G) {
        const int row0 = it * 128, b = row0 / S;
        f32x4 sh[4], sc[4];
#pragma unroll
        for (int j = 0; j < 4; ++j) { sh[j] = *(const f32x4*)(mod + b * 6144 + 4 * lane + 256 * j); sc[j] = *(const f32x4*)(mod + b * 6144 + 1024 + 4 * lane + 256 * j); }
        for (int rr = wave; rr < 128; rr += NWAVES) {
            const int row = row0 + rr;
            const f32x4* xr = (const f32x4*)(x + (size_t)row * D) + lane;
            f32x4 v[4]; float s = 0.f;
#pragma unroll
            for (int j = 0; j < 4; ++j) { v[j] = xr[64 * j]; s += (v[j].x + v[j].y) + (v[j].z + v[j].w); }
            const float mean = wave_sum(s) * (1.f / D); float s2 = 0.f;
#pragma unroll
            for (int j = 0; j < 4; ++j) { v[j] = v[j] - mean; s2 += (v[j].x * v[j].x + v[j].y * v[j].y) + (v[j].z * v[j].z + v[j].w * v[j].w); }
            const float rstd = 1.f / sqrtf(wave_sum(s2) * (1.f / D) + LN_EPS);
            float ga[8];
#pragma unroll
            for (int q = 0; q < 8; ++q) ga[q] = 0.f;
            unsigned* o4 = (unsigned*)(u1 + (size_t)row * D) + lane;
#pragma unroll
            for (int j = 0; j < 4; ++j) {
                const f32x4 u = v[j] * rstd * (sc[j] + 1.0f) + sh[j];
                o4[64 * j] = pk4_fp8(u.x, u.y, u.z, u.w);
#pragma unroll
                for (int e = 0; e < 4; ++e) { const int k = 4 * lane + 256 * j + e;
                    const f32x4 w0 = *(const f32x4*)(wg + k * 8), w1 = *(const f32x4*)(wg + k * 8 + 4);
                    ga[0] += u[e] * w0.x; ga[1] += u[e] * w0.y; ga[2] += u[e] * w0.z; ga[3] += u[e] * w0.w;
                    ga[4] += u[e] * w1.x; ga[5] += u[e] * w1.y; ga[6] += u[e] * w1.z; ga[7] += u[e] * w1.w; }
            }
#pragma unroll
            for (int q = 0; q < 8; ++q) ga[q] = wave_sum(ga[q]);
            if (lane < 8) {
                float gv = 0.f;
#pragma unroll
                for (int q = 0; q < 8; ++q) gv = (lane == q) ? ga[q] : gv;
                gv += gate_b[lane];
                const int h = lane & 3, s_ = row % S;
                if (lane < 4) ipre[(size_t)(b * 4 + h) * S + s_] = gv;
                else logf[(size_t)(b * 4 + h) * S + s_] = fminf(gv, 0.f) - log1pf(__expf(-fabsf(gv)));
            }
        }
    }
}

__device__ __forceinline__ void ph_ln2(const MArgs& a, int G) {
    const float* x = a.in[0]; const bf16* mixout = (const bf16*)(a.ws + WS_MIXOUT); const float* mod = (const float*)(a.ws + WS_MOD); const float* ln1_g = a.in[10]; const float* ln1_b = a.in[11];
    float* x1 = a.out; bf16* u2 = (bf16*)(a.ws + WS_U2); unsigned char* u2f8 = (unsigned char*)(a.ws + WS_U2F8);
    const int tid = threadIdx.x, lane = tid & 63, wave = tid >> 6;
    for (int it = blockIdx.x; it < T / 128; it += G) {
        const int row0 = it * 128, b = row0 / S;
        for (int rr = wave; rr < 128; rr += NWAVES) {
            const int row = row0 + rr;
            f32x4 v[4]; float s = 0.f;
#pragma unroll
            for (int j = 0; j < 4; ++j) {
                const int col = 4 * lane + 256 * j;
                const f32x4 xv = *(const f32x4*)(x + (size_t)row * D + col);
                const f32x4 mo = ld_bf4(mixout + (size_t)row * D + col);
                const f32x4 g1 = *(const f32x4*)(mod + b * 6144 + 2048 + col);
                v[j] = xv * DN_ALPHA + g1 * mo; s += (v[j].x + v[j].y) + (v[j].z + v[j].w);
            }
            float mean = wave_sum(s) * (1.f / D), s2 = 0.f;
#pragma unroll
            for (int j = 0; j < 4; ++j) { v[j] = v[j] - mean; s2 += (v[j].x * v[j].x + v[j].y * v[j].y) + (v[j].z * v[j].z + v[j].w * v[j].w); }
            float rstd = 1.f / sqrtf(wave_sum(s2) * (1.f / D) + LN_EPS);
            s = 0.f;
#pragma unroll
            for (int j = 0; j < 4; ++j) { const int col = 4 * lane + 256 * j;
                v[j] = v[j] * rstd * *(const f32x4*)(ln1_g + col) + *(const f32x4*)(ln1_b + col);
                *(f32x4*)(x1 + (size_t)row * D + col) = v[j]; s += (v[j].x + v[j].y) + (v[j].z + v[j].w); }
            mean = wave_sum(s) * (1.f / D); s2 = 0.f;
#pragma unroll
            for (int j = 0; j < 4; ++j) { v[j] = v[j] - mean; s2 += (v[j].x * v[j].x + v[j].y * v[j].y) + (v[j].z * v[j].z + v[j].w * v[j].w); }
            rstd = 1.f / sqrtf(wave_sum(s2) * (1.f / D) + LN_EPS);
#pragma unroll
            for (int j = 0; j < 4; ++j) { const int col = 4 * lane + 256 * j;
                const f32x4 u = v[j] * rstd * (*(const f32x4*)(mod + b * 6144 + 4096 + col) + 1.0f) + *(const f32x4*)(mod + b * 6144 + 3072 + col);
                *(unsigned long long*)(u2 + (size_t)row * D + col) = (unsigned long long)pk2(u.x, u.y) | ((unsigned long long)pk2(u.z, u.w) << 32);
                *(unsigned*)(u2f8 + (size_t)row * D + col) = pk4_fp8(u.x, u.y, u.z, u.w); }
        }
    }
}

__device__ __forceinline__ void route_wave(int t, int lane, const float* __restrict__ logits, const f32x4 bias4, int* __restrict__ tope, float* __restrict__ topg, int* __restrict__ cnt) {
    const f32x4 lg = *(const f32x4*)(logits + (size_t)t * NE + 4 * lane);
    float sc[4], v[4];
#pragma unroll
    for (int j = 0; j < 4; ++j) { sc[j] = 1.f / (1.f + __expf(-lg[j])); v[j] = sc[j] + bias4[j]; }
    float m1 = fmaxf(fmaxf(v[0], v[1]), fmaxf(v[2], v[3]));
    float m2; { const float a = fmaxf(v[0], v[1]), b = fminf(v[0], v[1]), c = fmaxf(v[2], v[3]), d = fminf(v[2], v[3]); m2 = fmaxf(fminf(a, c), fmaxf(b, d)); }
#pragma unroll
    for (int o = 1; o < 8; o <<= 1) { const float o1 = __shfl_xor(m1, o), o2 = __shfl_xor(m2, o); const float n1 = fmaxf(m1, o1); m2 = fmaxf(fminf(m1, o1), fmaxf(m2, o2)); m1 = n1; }
    const float gs = m1 + m2; const int myg = lane >> 3; int rank = 0;
#pragma unroll
    for (int gg = 0; gg < 8; ++gg) { const float og = __shfl(gs, gg * 8); rank += (og > gs || (og == gs && gg < myg)) ? 1 : 0; }
    if (rank >= 4) {
#pragma unroll
        for (int j = 0; j < 4; ++j) v[j] = -INFINITY; }
    int myE = 0; float myS = 0.f, gsum = 0.f;
#pragma unroll
    for (int rd = 0; rd < 8; ++rd) {
        float bv = v[0]; int bi = 4 * lane;
#pragma unroll
        for (int j = 1; j < 4; ++j) if (v[j] > bv) { bv = v[j]; bi = 4 * lane + j; }
#pragma unroll
        for (int o = 1; o < 64; o <<= 1) { const float ov = __shfl_xor(bv, o); const int oi = __shfl_xor(bi, o); if (ov > bv || (ov == bv && oi < bi)) { bv = ov; bi = oi; } }
        float ss = 0.f;
#pragma unroll
        for (int j = 0; j < 4; ++j) if (bi == 4 * lane + j) { ss = sc[j]; v[j] = -INFINITY; }
        ss = __shfl(ss, bi >> 2);
        gsum += ss;
        if (lane == rd) { myE = bi; myS = ss; }
    }
    if (lane < 8) { tope[t * 8 + lane] = myE; topg[t * 8 + lane] = myS * (2.5f / gsum); atomicAdd(cnt + myE, 1); }
}
__device__ __forceinline__ void moe_tables(const int* cnt, LAS int* tb, LAS int* nn) {
    if (threadIdx.x < 64) {
        const int lane = threadIdx.x; int n[4], tl[4], loc = 0;
#pragma unroll
        for (int j = 0; j < 4; ++j) { n[j] = cnt[4 * lane + j]; tl[j] = (n[j] + 255) >> 8; loc += tl[j]; }
        int inc = loc;
#pragma unroll
        for (int o = 1; o < 64; o <<= 1) { const int v = __shfl_up(inc, o); if (lane >= o) inc += v; }
        int base = inc - loc;
#pragma unroll
        for (int j = 0; j < 4; ++j) { tb[4 * lane + j] = base; nn[4 * lane + j] = n[j]; base += tl[j]; }
        if (lane == 63) { tb[NE] = base; nn[NE] = T; tb[NEX] = base + T / 256; }
    }
    __syncthreads();
}
__device__ __forceinline__ void ph_final(const MArgs& a, int G) {
    float* out = a.out; const bf16* ys = (const bf16*)(a.ws + WS_YS); const bf16* ysh = (const bf16*)(a.ws + WS_YSH); const float* mod = (const float*)(a.ws + WS_MOD);
    const float* ln2_g = a.in[20]; const float* ln2_b = a.in[21];
    const int tid = threadIdx.x, lane = tid & 63, wave = tid >> 6;
    for (int it = blockIdx.x; it < T / 128; it += G) {
        const int row0 = it * 128, b = row0 / S;
        for (int rr = wave; rr < 128; rr += NWAVES) {
            const int row = row0 + rr;
            f32x4 v[4]; float s = 0.f;
#pragma unroll
            for (int j = 0; j < 4; ++j) { const int col = 4 * lane + 256 * j;
                f32x4 y = ld_bf4(ysh + (size_t)row * D + col);
#pragma unroll
                for (int k = 0; k < 8; ++k) y = y + ld_bf4(ys + ((size_t)row * 8 + k) * D + col);
                v[j] = *(const f32x4*)(out + (size_t)row * D + col) * DN_ALPHA + *(const f32x4*)(mod + b * 6144 + 5120 + col) * y;
                s += (v[j].x + v[j].y) + (v[j].z + v[j].w); }
            const float mean = wave_sum(s) * (1.f / D); float s2 = 0.f;
#pragma unroll
            for (int j = 0; j < 4; ++j) { v[j] = v[j] - mean; s2 += (v[j].x * v[j].x + v[j].y * v[j].y) + (v[j].z * v[j].z + v[j].w * v[j].w); }
            const float rstd = 1.f / sqrtf(wave_sum(s2) * (1.f / D) + LN_EPS);
#pragma unroll
            for (int j = 0; j < 4; ++j) { const int col = 4 * lane + 256 * j;
                *(f32x4*)(out + (size_t)row * D + col) = v[j] * rstd * *(const f32x4*)(ln2_g + col) + *(const f32x4*)(ln2_b + col); }
        }
    }
}


typedef short s16x4 __attribute__((ext_vector_type(4)));
typedef short bf16x8v __attribute__((ext_vector_type(8)));
typedef float f32x16 __attribute__((ext_vector_type(16)));
constexpr int MLP = 320;
constexpr int NCH = S / 64;
constexpr int ST_ELEMS = 129 * 128;
constexpr size_t WS_CHK = WS_GATES + 1 * MiB;
constexpr size_t WS_MPREV = WS_GATES + 1 * MiB + 65536;
constexpr size_t WS_KC = WS_U2;
__device__ __forceinline__ s16x4 tr_read(const LAS unsigned char* p) { return __builtin_bit_cast(s16x4, __builtin_amdgcn_ds_read_tr16_b64_v4i16((LAS s16x4*)p)); }
__device__ __forceinline__ bf16x8v tr_frag(const LAS unsigned char* tile, int row0, int col0, int lane) {
    const int i = lane & 15; const LAS unsigned char* p = tile + (row0 + (i >> 2)) * MLP + (col0 + 4 * (i & 3)) * 2;
    const s16x4 lo = tr_read(p), hi = tr_read(p + 4 * MLP);
    return __builtin_shufflevector(lo, hi, 0, 1, 2, 3, 4, 5, 6, 7);
}
__device__ __forceinline__ bf16x8v tr_frag_perm(const LAS unsigned char* tile, int row0, int col0, int lane) {
    const int i = lane & 15; const LAS unsigned char* p = tile + (row0 + (i >> 2)) * MLP + (col0 + 4 * (i & 3)) * 2;
    const s16x4 lo = tr_read(p), hi = tr_read(p + 8 * MLP);
    return __builtin_shufflevector(lo, hi, 0, 1, 2, 3, 4, 5, 6, 7);
}
__device__ __forceinline__ float wave_incl_sum(float v, int lane) {
#pragma unroll
    for (int o = 1; o < 64; o <<= 1) { const float u = __shfl_up(v, o); if (lane >= o) v += u; }
    return v;
}
__device__ __forceinline__ float wave_incl_max(float v, int lane) {
#pragma unroll
    for (int o = 1; o < 64; o <<= 1) { const float u = __shfl_up(v, o); if (lane >= o) v = fmaxf(v, u); }
    return v;
}
__device__ __forceinline__ float wave_max(float v) {
#pragma unroll
    for (int o = 1; o < 64; o <<= 1) v = fmaxf(v, __shfl_xor(v, o));
    return v;
}
__device__ __forceinline__ void conv8(const bf16* __restrict__ rowp, int spos, const float* __restrict__ cw, const float* __restrict__ cb, float scale, float (&y)[8]) {
    const f32x4 b0 = *(const f32x4*)cb, b1 = *(const f32x4*)(cb + 4);
    y[0] = b0.x; y[1] = b0.y; y[2] = b0.z; y[3] = b0.w; y[4] = b1.x; y[5] = b1.y; y[6] = b1.z; y[7] = b1.w;
#pragma unroll
    for (int j = 0; j < 4; ++j) {
        if (spos - 3 + j >= 0) {
            const v4u xr = *(const v4u*)(rowp + (ptrdiff_t)(j - 3) * NPROJ);
            const f32x4 w0 = *(const f32x4*)(cw + j * 1024), w1 = *(const f32x4*)(cw + j * 1024 + 4);
            y[0] += w0.x * bf2f(xr.x & 0xffffu); y[1] += w0.y * bf2f(xr.x >> 16); y[2] += w0.z * bf2f(xr.y & 0xffffu); y[3] += w0.w * bf2f(xr.y >> 16);
            y[4] += w1.x * bf2f(xr.z & 0xffffu); y[5] += w1.y * bf2f(xr.z >> 16); y[6] += w1.z * bf2f(xr.w & 0xffffu); y[7] += w1.w * bf2f(xr.w >> 16);
        }
    }
#pragma unroll
    for (int e = 0; e < 8; ++e) y[e] = siluf_(y[e]) * scale;
}
__device__ __forceinline__ v4u pack8(const float (&y)[8]) { v4u o; o.x = pk2(y[0], y[1]); o.y = pk2(y[2], y[3]); o.z = pk2(y[4], y[5]); o.w = pk2(y[6], y[7]); return o; }

__device__ __forceinline__ void ml_phaseA(const MArgs& a, LAS unsigned char* lds, int vb0, int nvb) {
    const int tid = threadIdx.x, lane = tid & 63, wave = __builtin_amdgcn_readfirstlane(tid >> 6);
    const bf16* proj = (const bf16*)(a.ws + WS_PROJ); const float* conv_w = a.in[5]; const float* conv_b = a.in[6];
    const float* ipre = (const float*)(a.ws + WS_GATES); const float* logf = ipre + 16 * S;
    bf16* kcg = (bf16*)(a.ws + WS_KC); bf16* st = (bf16*)(a.ws + WS_STATES); float* chk = (float*)(a.ws + WS_CHK);
    LAS unsigned char* Kt = lds; LAS unsigned char* Vt = lds + 64 * MLP; LAS float* wkL = (LAS float*)(lds + 128 * MLP);
    for (int unit = vb0; unit < 16 * NCH; unit += nvb) {
        const int bh = unit >> 7, c = unit & (NCH - 1), b = bh >> 2, h = bh & 3, s0 = c * 64; const size_t row0 = (size_t)b * S + s0;
        if (wave == 0) {
            const float lf = logf[(size_t)bh * S + s0 + lane], ic = ipre[(size_t)bh * S + s0 + lane];
            const float bc = wave_incl_sum(lf, lane), g = ic - bc, gmax = wave_max(g), blast = __shfl(bc, 63);
            wkL[lane] = __expf(g - gmax);
            if (lane == 0) { chk[(size_t)unit * 2] = blast; chk[(size_t)unit * 2 + 1] = blast + gmax; }
        }
#pragma unroll
        for (int q = 0; q < 2; ++q) { const int it = tid + q * NTHR, tt = it >> 4, c8 = it & 15, ch = h * 128 + c8 * 8;
            float y[8]; conv8(proj + (row0 + tt) * NPROJ + C_MLK + ch, s0 + tt, conv_w + 512 + ch, conv_b + 512 + ch, 0.08838834764831845f, y);
            const v4u o = pack8(y);
            *(LAS v4u*)(Kt + tt * MLP + c8 * 16) = o; *(v4u*)(kcg + (row0 + tt) * 512 + ch) = o; }
        __syncthreads();
#pragma unroll
        for (int q = 0; q < 2; ++q) { const int it = tid + q * NTHR, tt = it >> 4, c8 = it & 15;
            const v4u xr = *(const v4u*)(proj + (row0 + tt) * NPROJ + C_MLV + h * 128 + c8 * 8); const float w = wkL[tt];
            float y[8] = {bf2f(xr.x & 0xffffu) * w, bf2f(xr.x >> 16) * w, bf2f(xr.y & 0xffffu) * w, bf2f(xr.y >> 16) * w, bf2f(xr.z & 0xffffu) * w, bf2f(xr.z >> 16) * w, bf2f(xr.w & 0xffffu) * w, bf2f(xr.w >> 16) * w};
            *(LAS v4u*)(Vt + tt * MLP + c8 * 16) = pack8(y); }
        __syncthreads();
        {
            const int dvb = wave >> 1, dkh = wave & 1, hh = lane >> 5, gsel = (lane >> 4) & 1;
            f32x16 acc[2];
#pragma unroll
            for (int nb = 0; nb < 2; ++nb)
#pragma unroll
                for (int i = 0; i < 16; ++i) acc[nb][i] = 0.f;
#pragma unroll
            for (int kk = 0; kk < 4; ++kk) {
                const bf16x8v Bv = tr_frag(Vt, 16 * kk + 8 * hh, 32 * dvb + 16 * gsel, lane);
#pragma unroll
                for (int nb = 0; nb < 2; ++nb) { const bf16x8v Ak = tr_frag(Kt, 16 * kk + 8 * hh, 32 * (2 * dkh + nb) + 16 * gsel, lane);
                    acc[nb] = __builtin_amdgcn_mfma_f32_32x32x16_bf16(Ak, Bv, acc[nb], 0, 0, 0); }
            }
            bf16* stc = st + (size_t)unit * ST_ELEMS;
#pragma unroll
            for (int nb = 0; nb < 2; ++nb)
#pragma unroll
                for (int g4 = 0; g4 < 4; ++g4) { const int dk = 32 * (2 * dkh + nb) + 8 * g4 + 4 * hh, dv = 32 * dvb + (lane & 31);
                    *(unsigned long long*)(stc + (size_t)dv * 128 + dk) = (unsigned long long)pk2(acc[nb][4 * g4], acc[nb][4 * g4 + 1]) | ((unsigned long long)pk2(acc[nb][4 * g4 + 2], acc[nb][4 * g4 + 3]) << 32); }
        }
        if (tid < 128) { float s = 0.f;
#pragma unroll 8
            for (int t = 0; t < 64; ++t) s += wkL[t] * bf2f(*(const LAS unsigned short*)(Kt + t * MLP + tid * 2));
            st[(size_t)unit * ST_ELEMS + 128 * 128 + tid] = (bf16)f2bf(s); }
        __syncthreads();
    }
}

__device__ __forceinline__ void ml_phaseB(const MArgs& a, LAS unsigned char* lds, int vb0, int nvb) {
    const int tid = threadIdx.x;
    bf16* st = (bf16*)(a.ws + WS_STATES); const float* chk = (const float*)(a.ws + WS_CHK); float* mprev = (float*)(a.ws + WS_MPREV);
    LAS float* al = (LAS float*)lds; LAS float* be = al + NCH;
    constexpr int NSL = 16, SLE = ST_ELEMS / NSL;
    for (int item = vb0; item < 16 * NSL; item += nvb) {
        const int bh = item / NSL, sl = item % NSL;
        __syncthreads();
        if (tid == 0) { float m = 0.f;
            for (int c = 0; c < NCH; ++c) { const float bl = chk[(size_t)(bh * NCH + c) * 2], M = chk[(size_t)(bh * NCH + c) * 2 + 1];
                const float mn = fmaxf(bl + m, M); al[c] = __expf(bl + m - mn); be[c] = __expf(M - mn);
                if (sl == 0) mprev[bh * NCH + c] = m;
                m = mn; } }
        __syncthreads();
        if (tid * 4 < SLE) {
            unsigned long long* p = (unsigned long long*)(st + (size_t)bh * NCH * ST_ELEMS + sl * SLE + tid * 4);
            float c0 = 0.f, c1 = 0.f, c2 = 0.f, c3 = 0.f;
            for (int cb = 0; cb < NCH; cb += 16) { unsigned long long d[16];
#pragma unroll
                for (int j = 0; j < 16; ++j) d[j] = p[(size_t)(cb + j) * (ST_ELEMS / 4)];
#pragma unroll
                for (int j = 0; j < 16; ++j) { p[(size_t)(cb + j) * (ST_ELEMS / 4)] = (unsigned long long)pk2(c0, c1) | ((unsigned long long)pk2(c2, c3) << 32);
                    const float A = al[cb + j], Bq = be[cb + j]; const unsigned lo = (unsigned)d[j], hi = (unsigned)(d[j] >> 32);
                    c0 = A * c0 + Bq * bf2f(lo & 0xffffu); c1 = A * c1 + Bq * bf2f(lo >> 16); c2 = A * c2 + Bq * bf2f(hi & 0xffffu); c3 = A * c3 + Bq * bf2f(hi >> 16); } }
        }
    }
}

__device__ __forceinline__ void ml_phaseC(const MArgs& a, LAS unsigned char* lds, int G) {
    const int tid = threadIdx.x, lane = tid & 63, wave = __builtin_amdgcn_readfirstlane(tid >> 6);
    const bf16* proj = (const bf16*)(a.ws + WS_PROJ); const float* conv_w = a.in[5]; const float* conv_b = a.in[6]; const float* norm_g = a.in[8];
    const float* ipre = (const float*)(a.ws + WS_GATES); const float* logf = ipre + 16 * S;
    const bf16* kcg = (const bf16*)(a.ws + WS_KC); const bf16* st = (const bf16*)(a.ws + WS_STATES); const float* mprev = (const float*)(a.ws + WS_MPREV);
    bf16* mix = (bf16*)(a.ws + WS_MIX);
    LAS unsigned char* Qt = lds; LAS unsigned char* Kt = lds + 64 * MLP; LAS unsigned char* Vt = lds + 128 * MLP; LAS unsigned char* Ct = lds + 192 * MLP;
    LAS float* sc = (LAS float*)(lds + 320 * MLP);
    LAS float* gL = sc; LAS float* mmL = sc + 64; LAS float* siL = sc + 128; LAS float* emL = sc + 192; LAS float* npv = sc + 256; LAS float* lnS = sc + 384;
    const int tb = wave >> 2, dvb = wave & 3, r = lane & 31, hh = lane >> 5, gsel = (lane >> 4) & 1;
    for (int unit = blockIdx.x; unit < 16 * NCH; unit += G) {
        const int bh = unit >> 7, c = unit & (NCH - 1), b = bh >> 2, h = bh & 3, s0 = c * 64; const size_t row0 = (size_t)b * S + s0;
        if (wave == 0) {
            const float lf = logf[(size_t)bh * S + s0 + lane], ic = ipre[(size_t)bh * S + s0 + lane], mp = mprev[unit];
            const float bc = wave_incl_sum(lf, lane), g = ic - bc, pm = wave_incl_max(g, lane), mm = fmaxf(mp, pm);
            gL[lane] = g; mmL[lane] = mm; siL[lane] = __expf(mp - mm); emL[lane] = __expf(-(bc + mm));
        }
        const bf16* stc = st + (size_t)unit * ST_ELEMS;
#pragma unroll
        for (int q = 0; q < 2; ++q) { const int it = tid + q * NTHR, tt = it >> 4, c8 = it & 15, ch = h * 128 + c8 * 8;
            float y[8]; conv8(proj + (row0 + tt) * NPROJ + C_MLQ + ch, s0 + tt, conv_w + ch, conv_b + ch, 1.f, y);
            *(LAS v4u*)(Qt + tt * MLP + c8 * 16) = pack8(y);
            *(LAS v4u*)(Kt + tt * MLP + c8 * 16) = *(const v4u*)(kcg + (row0 + tt) * 512 + ch);
            *(LAS v4u*)(Vt + tt * MLP + c8 * 16) = *(const v4u*)(proj + (row0 + tt) * NPROJ + C_MLV + ch); }
#pragma unroll
        for (int q = 0; q < 4; ++q) { const int it = tid + q * NTHR, dv = it >> 4, c8 = it & 15;
            *(LAS v4u*)(Ct + dv * MLP + c8 * 16) = *(const v4u*)(stc + dv * 128 + c8 * 8); }
        if (tid < 128) npv[tid] = bf2f(stc[128 * 128 + tid]);
        __syncthreads();
        bf16x8v qf[8];
#pragma unroll
        for (int kk = 0; kk < 8; ++kk) qf[kk] = *(const LAS bf16x8v*)(Qt + (32 * tb + r) * MLP + (16 * kk + 8 * hh) * 2);
        const float mm_t = mmL[32 * tb + r], si_t = siL[32 * tb + r], em_t = emL[32 * tb + r];
        float nq = 0.f;
#pragma unroll
        for (int kk = 0; kk < 8; ++kk) { const f32x4 n0 = *(const LAS f32x4*)(npv + 16 * kk + 8 * hh), n1 = *(const LAS f32x4*)(npv + 16 * kk + 8 * hh + 4);
            nq += n0.x * bf2f((unsigned short)qf[kk][0]) + n0.y * bf2f((unsigned short)qf[kk][1]) + n0.z * bf2f((unsigned short)qf[kk][2]) + n0.w * bf2f((unsigned short)qf[kk][3])
                + n1.x * bf2f((unsigned short)qf[kk][4]) + n1.y * bf2f((unsigned short)qf[kk][5]) + n1.z * bf2f((unsigned short)qf[kk][6]) + n1.w * bf2f((unsigned short)qf[kk][7]); }
        nq += __shfl_xor(nq, 32);
        f32x16 num;
#pragma unroll
        for (int i = 0; i < 16; ++i) num[i] = 0.f;
#pragma unroll
        for (int kk = 0; kk < 8; ++kk) { const bf16x8v Ac = *(const LAS bf16x8v*)(Ct + (32 * dvb + r) * MLP + (16 * kk + 8 * hh) * 2);
            num = __builtin_amdgcn_mfma_f32_32x32x16_bf16(Ac, qf[kk], num, 0, 0, 0); }
#pragma unroll
        for (int i = 0; i < 16; ++i) num[i] *= si_t;
        float wsum = 0.f;
        for (int sb = 0; sb <= tb; ++sb) {
            f32x16 sT;
#pragma unroll
            for (int i = 0; i < 16; ++i) sT[i] = 0.f;
#pragma unroll
            for (int kk = 0; kk < 8; ++kk) { const bf16x8v Ak = *(const LAS bf16x8v*)(Kt + (32 * sb + r) * MLP + (16 * kk + 8 * hh) * 2);
                sT = __builtin_amdgcn_mfma_f32_32x32x16_bf16(Ak, qf[kk], sT, 0, 0, 0); }
            unsigned wp[8];
#pragma unroll
            for (int g4 = 0; g4 < 4; ++g4) { const f32x4 gv = *(const LAS f32x4*)(gL + 32 * sb + 8 * g4 + 4 * hh);
                float w[4];
#pragma unroll
                for (int e = 0; e < 4; ++e) { const int srow = 32 * sb + 8 * g4 + 4 * hh + e; const bool valid = srow <= 32 * tb + r;
                    w[e] = valid ? sT[4 * g4 + e] * __expf(gv[e] - mm_t) : 0.f; wsum += w[e]; }
                wp[2 * g4] = pk2(w[0], w[1]); wp[2 * g4 + 1] = pk2(w[2], w[3]); }
#pragma unroll
            for (int s2 = 0; s2 < 2; ++s2) {
                const bf16x8v Av = tr_frag_perm(Vt, 32 * sb + 16 * s2 + 4 * hh, 32 * dvb + 16 * gsel, lane);
                v4u bw; bw.x = wp[4 * s2]; bw.y = wp[4 * s2 + 1]; bw.z = wp[4 * s2 + 2]; bw.w = wp[4 * s2 + 3];
                num = __builtin_amdgcn_mfma_f32_32x32x16_bf16(Av, __builtin_bit_cast(bf16x8v, bw), num, 0, 0, 0); }
        }
        wsum += __shfl_xor(wsum, 32);
        const float den = si_t * nq + wsum, rden = 1.f / fmaxf(fabsf(den), em_t);
        float ps = 0.f, pq = 0.f;
#pragma unroll
        for (int i = 0; i < 16; ++i) { num[i] *= rden; ps += num[i]; pq += num[i] * num[i]; }
        ps += __shfl_xor(ps, 32); pq += __shfl_xor(pq, 32);
        if (hh == 0) { lnS[((tb * 4 + dvb) * 32 + r) * 2] = ps; lnS[((tb * 4 + dvb) * 32 + r) * 2 + 1] = pq; }
        __syncthreads();
        float ts = 0.f, tq = 0.f;
#pragma unroll
        for (int d = 0; d < 4; ++d) { ts += lnS[((tb * 4 + d) * 32 + r) * 2]; tq += lnS[((tb * 4 + d) * 32 + r) * 2 + 1]; }
        const float mean = ts * (1.f / 128.f), rstd = 1.f / sqrtf(fmaxf(tq * (1.f / 128.f) - mean * mean, 0.f) + LN_EPS);
        const size_t trow = row0 + 32 * tb + r;
#pragma unroll
        for (int g4 = 0; g4 < 4; ++g4) { const int dv = 32 * dvb + 8 * g4 + 4 * hh;
            const f32x4 ng = *(const f32x4*)(norm_g + h * 128 + dv); const f32x4 og = ld_bf4(proj + trow * NPROJ + C_MLO + h * 128 + dv);
            float o[4];
#pragma unroll
            for (int e = 0; e < 4; ++e) o[e] = (num[4 * g4 + e] - mean) * rstd * ng[e] * sigmoidf_(og[e]);
            *(unsigned long long*)(mix + trow * D + 512 + h * 128 + dv) = (unsigned long long)pk2(o[0], o[1]) | ((unsigned long long)pk2(o[2], o[3]) << 32); }
        __syncthreads();
    }
}


constexpr int VTP = 192;
template <int PITCH> __device__ __forceinline__ bf16x8v tr_frag_perm_p(const LAS unsigned char* tile, int row0, int col0, int lane) {
    const int i = lane & 15; const LAS unsigned char* p = tile + (row0 + (i >> 2)) * PITCH + (col0 + 4 * (i & 3)) * 2;
    const s16x4 lo = tr_read(p), hi = tr_read(p + 8 * PITCH);
    return __builtin_shufflevector(lo, hi, 0, 1, 2, 3, 4, 5, 6, 7);
}
__device__ __forceinline__ void attn_phase(const bf16* __restrict__ proj, bf16* __restrict__ mix, LAS unsigned char* lds, int vb0, int nvb) {
    const int tid = threadIdx.x, lane = tid & 63, wave = __builtin_amdgcn_readfirstlane(tid >> 6);
    const int r = lane & 31, hh = lane >> 5, gsel = (lane >> 4) & 1;
    LAS unsigned char* Vt = lds + wave * (64 * VTP);
    bf16x8v ntri[2], nones;
#pragma unroll
    for (int s2 = 0; s2 < 2; ++s2)
#pragma unroll
        for (int j = 0; j < 8; ++j) { const int k = 16 * s2 + 8 * (j >> 2) + 4 * hh + (j & 3); ntri[s2][j] = (k >= r) ? (short)0xBF80 : (short)0; }
#pragma unroll
    for (int j = 0; j < 8; ++j) nones[j] = (short)0xBF80;
    for (int unit = vb0 * NWAVES + wave; unit < NB * 8 * (S / 32); unit += nvb * NWAVES) {
        const int bh = unit / (S / 32), qb = unit % (S / 32), b = bh >> 3, h = bh & 7, q0 = qb * 32;
        const bf16* base = proj + (size_t)b * S * NPROJ + h * 64;
        bf16x8v qf[4];
#pragma unroll
        for (int s = 0; s < 4; ++s) qf[s] = *(const bf16x8v*)(base + (size_t)(q0 + r) * NPROJ + C_SBQ + 16 * s + 8 * hh);
        f32x16 o[2];
#pragma unroll
        for (int d = 0; d < 2; ++d)
#pragma unroll
            for (int i = 0; i < 16; ++i) o[d][i] = 0.f;
        float carry = 0.f;
        const int qpos = q0 + r;
        for (int k0 = q0 - 32; ; k0 -= 64) {
            bf16x8v kf[2][4];
#pragma unroll
            for (int kb = 0; kb < 2; ++kb) { int key = k0 + 32 * kb + r; key = key < 0 ? 0 : key;
#pragma unroll
                for (int s = 0; s < 4; ++s) kf[kb][s] = *(const bf16x8v*)(base + (size_t)key * NPROJ + C_SBK + 16 * s + 8 * hh); }
#pragma unroll
            for (int i = 0; i < 8; ++i) { int key = k0 + (lane >> 3) + 8 * i; key = key < 0 ? 0 : key;
                *(LAS v4u*)(Vt + ((lane >> 3) + 8 * i) * VTP + (lane & 7) * 16) = *(const v4u*)(base + (size_t)key * NPROJ + C_SBV + (lane & 7) * 8); }
            f32x16 z[2];
#pragma unroll
            for (int kb = 0; kb < 2; ++kb) {
#pragma unroll
                for (int i = 0; i < 16; ++i) z[kb][i] = 0.f;
#pragma unroll
                for (int s = 0; s < 4; ++s) z[kb] = __builtin_amdgcn_mfma_f32_32x32x16_bf16(kf[kb][s], qf[s], z[kb], 0, 0, 0); }
            const bool need_mask = (k0 + 63 >= q0) || (k0 < 0);
            unsigned xp[2][8];
#pragma unroll
            for (int kb = 0; kb < 2; ++kb)
#pragma unroll
                for (int g4 = 0; g4 < 4; ++g4) { float sp[4];
#pragma unroll
                    for (int e = 0; e < 4; ++e) { const float zz = z[kb][4 * g4 + e];
                        float v = fmaxf(zz, 0.f) + __builtin_amdgcn_logf(1.f + __builtin_amdgcn_exp2f(-fabsf(zz)));
                        if (need_mask) { const int key = k0 + 32 * kb + 8 * g4 + 4 * hh + e; v = (key >= 0 && key < qpos) ? v : 0.f; }
                        sp[e] = v; }
                    xp[kb][2 * g4] = pk2(sp[0], sp[1]); xp[kb][2 * g4 + 1] = pk2(sp[2], sp[3]); }
            const float z00 = z[0][0];
#pragma unroll
            for (int s2 = 0; s2 < 2; ++s2) { v4u b1; b1.x = xp[1][4 * s2]; b1.y = xp[1][4 * s2 + 1]; b1.z = xp[1][4 * s2 + 2]; b1.w = xp[1][4 * s2 + 3];
                v4u b0; b0.x = xp[0][4 * s2]; b0.y = xp[0][4 * s2 + 1]; b0.z = xp[0][4 * s2 + 2]; b0.w = xp[0][4 * s2 + 3];
                z[1] = __builtin_amdgcn_mfma_f32_32x32x16_bf16(ntri[s2], __builtin_bit_cast(bf16x8v, b1), z[1], 0, 0, 0);
                z[0] = __builtin_amdgcn_mfma_f32_32x32x16_bf16(ntri[s2], __builtin_bit_cast(bf16x8v, b0), z[0], 0, 0, 0);
                z[0] = __builtin_amdgcn_mfma_f32_32x32x16_bf16(nones, __builtin_bit_cast(bf16x8v, b1), z[0], 0, 0, 0); }
            float tot = z00 - z[0][0];
            tot = __shfl(tot, r);
#pragma unroll
            for (int kb = 0; kb < 2; ++kb)
#pragma unroll
                for (int g4 = 0; g4 < 4; ++g4) { float p[4];
#pragma unroll
                    for (int e = 0; e < 4; ++e) { float v = __builtin_amdgcn_exp2f(z[kb][4 * g4 + e] - carry);
                        if (need_mask) { const int key = k0 + 32 * kb + 8 * g4 + 4 * hh + e; v = (key >= 0 && key < qpos) ? v : 0.f; }
                        p[e] = v; }
                    xp[kb][2 * g4] = pk2(p[0], p[1]); xp[kb][2 * g4 + 1] = pk2(p[2], p[3]); }
#pragma unroll
            for (int kb = 0; kb < 2; ++kb)
#pragma unroll
                for (int s2 = 0; s2 < 2; ++s2) { v4u bp; bp.x = xp[kb][4 * s2]; bp.y = xp[kb][4 * s2 + 1]; bp.z = xp[kb][4 * s2 + 2]; bp.w = xp[kb][4 * s2 + 3];
#pragma unroll
                    for (int d = 0; d < 2; ++d) { const bf16x8v Av = tr_frag_perm_p<VTP>(Vt, 32 * kb + 16 * s2 + 4 * hh, 32 * d + 16 * gsel, lane);
                        o[d] = __builtin_amdgcn_mfma_f32_32x32x16_bf16(Av, __builtin_bit_cast(bf16x8v, bp), o[d], 0, 0, 0); } }
            carry += tot;
            if (k0 <= 0) break;
            if (__all(carry > SB_THRESH)) break;
        }
        bf16* op = mix + (size_t)(b * S + q0 + r) * D + h * 64;
#pragma unroll
        for (int d = 0; d < 2; ++d)
#pragma unroll
            for (int g4 = 0; g4 < 4; ++g4)
                *(unsigned long long*)(op + 32 * d + 8 * g4 + 4 * hh) = (unsigned long long)pk2(o[d][4 * g4], o[d][4 * g4 + 1]) | ((unsigned long long)pk2(o[d][4 * g4 + 2], o[d][4 * g4 + 3]) << 32);
    }
}

__global__ void __launch_bounds__(NTHR, 2) mega_fwd(MArgs args) {
    extern __shared__ __attribute__((aligned(16))) unsigned char lds[];
    LAS unsigned char* ldsl = (LAS unsigned char*)lds;
    const int tid = threadIdx.x, G = gridDim.x;
    volatile LAS unsigned* MISC = (volatile LAS unsigned*)(ldsl + XTRA_OFF + X_MISC);
    LAS int* tb = (LAS int*)(ldsl + XTRA_OFF + X_TB); LAS int* nn = (LAS int*)(ldsl + XTRA_OFF + X_NN);
    for (int u = tid; u < (LDS_BYTES - XTRA_OFF) / 4; u += NTHR) ((LAS unsigned*)(ldsl + XTRA_OFF))[u] = 0u;
    __syncthreads();
    unsigned char* ws = args.ws;
    unsigned* ctl = (unsigned*)(ws + WS_CTL);
    XcdBarrier bar = xcd_barrier_post(ctl + CW_BAR, MISC + 8);
    const int lo = args.ph_lo, hi = args.ph_hi;
#define IN(k) (lo <= (k) && (k) < hi)
#ifndef REP_MASK
#define REP_MASK 0
#endif
#define PHASE(k, ...) do { if (IN(k)) { for (int rep_ = 0; rep_ < (((REP_MASK >> (k)) & 1) ? 2 : 1); ++rep_) { if (rep_) xcd_barrier(bar); __VA_ARGS__ } } if (IN(k) && IN((k) + 1)) xcd_barrier(bar); } while (0)
    int* cnt = (int*)ctl + CW_CNT; i32x2* list = (i32x2*)(ws + WS_ROUTE + 2 * MiB); float* topg = (float*)(ws + WS_ROUTE + 1 * MiB);
    PHASE(0, ph_mod_prep(args, lds, G););
    PHASE(1, ph_ln1(args, lds, G););
    PHASE(2, { pg8::StaticOrder So; So.init(ws + WS_U1, ws + WS_WTIN, T, NPROJ, D, G, blockIdx.x);
        pg8::EpiBf16 E{(bf16*)(ws + WS_PROJ), NPROJ, 2, QSCALE, 1.f / 64.f};
        pg8::gemm_phase<pg8::EpiBf16, pg8::StaticOrder, false, true>(ldsl, D, So, E); });
    PHASE(3, ml_phaseA(args, ldsl, blockIdx.x, G););
    PHASE(4, ml_phaseB(args, ldsl, blockIdx.x, G); __syncthreads(); attn_phase((const bf16*)(ws + WS_PROJ), (bf16*)(ws + WS_MIX), ldsl, blockIdx.x, G););
    PHASE(5, ml_phaseC(args, ldsl, G););
    PHASE(6, { pg8::StaticOrder So; So.init(ws + WS_MIX, ws + WS_WTOUT, T, D, 2 * D, G, blockIdx.x);
        pg8::EpiBf16 E{(bf16*)(ws + WS_MIXOUT), D, 0, 1.f, 1.f};
        pg8::gemm_phase<pg8::EpiBf16, pg8::StaticOrder, false, false>(ldsl, 2 * D, So, E); });
    PHASE(7, ph_ln2(args, G););
    PHASE(8, { pg8::StaticOrder So; So.init(ws + WS_U2, ws + WS_WTR, T, NE, 2 * D, G, blockIdx.x);
        pg8::EpiF32 E{(float*)(ws + WS_LOGITS), NE};
        pg8::gemm_phase<pg8::EpiF32, pg8::StaticOrder, false, false>(ldsl, 2 * D, So, E); });
    PHASE(9, { const int lane_ = tid & 63; const f32x4 bias4 = *(const f32x4*)(args.in[13] + 4 * lane_);
        for (int t = blockIdx.x * NWAVES + (tid >> 6); t < T; t += G * NWAVES) route_wave(t, lane_, (const float*)(ws + WS_LOGITS), bias4, (int*)(ws + WS_ROUTE), topg, cnt); });
    PHASE(10, { moe_tables(cnt, tb, nn); const int* tope = (const int*)(ws + WS_ROUTE); int* fill = (int*)ctl + CW_FILL;
        for (int id = blockIdx.x * NTHR + tid; id < T * TOPK; id += G * NTHR) { const int e = tope[id]; const int pos = atomicAdd(fill + e, 1);
            list[tb[e] * 256 + pos] = (i32x2){id, __float_as_int(topg[id])}; } });
    PHASE(11, { moe_tables(cnt, tb, nn);
        pg8::MoeOrder So{G, (int)blockIdx.x, tb[NEX] * 2, 1, tb, nn, list, (const char*)(ws + WS_U2F8), 0, (const char*)(ws + WS_WT13), (size_t)512 * D, (size_t)256 * D};
        pg8::EpiGlu E{(bf16*)(ws + WS_H), 1.f / 64.f};
        pg8::gemm_phase<pg8::EpiGlu, pg8::MoeOrder, true, true>(ldsl, D, So, E); });
    PHASE(12, { moe_tables(cnt, tb, nn);
        pg8::MoeOrder So{G, (int)blockIdx.x, tb[NEX] * 4, 2, tb, nn, list, (const char*)(ws + WS_H), (size_t)256 * FF * 2, (const char*)(ws + WS_WT2), (size_t)D * FF * 2, (size_t)256 * FF * 2};
        pg8::EpiScatter E{(bf16*)(ws + WS_YS), (bf16*)(ws + WS_YSH), list, nn};
        pg8::gemm_phase<pg8::EpiScatter, pg8::MoeOrder, false, false>(ldsl, 2 * FF, So, E); });
    PHASE(13, ph_final(args, G););
#undef PHASE
#undef IN
}

#ifndef MK_UPTO
#define MK_UPTO 14
#endif
__global__ void k_nan_fill(float* out, int n) { for (int i = blockIdx.x * blockDim.x + threadIdx.x; i < n; i += gridDim.x * blockDim.x) out[i] = __builtin_nanf(""); }
extern "C" void kernel_launch(void* const* d_in, const int* in_sizes, int n_in, void* d_out, int out_size, void* d_ws, size_t ws_size, hipStream_t stream) {
    static int grid = 0;
    if (grid == 0) {
        int dev = 0, cus = 0, per_cu = 0; grid = -1;
        if (n_in != 22 || out_size != T * D || ws_size < WS_END) fprintf(stderr, "kernel_launch: unexpected shapes (n_in %d out %d ws %zu, need %zu)\n", n_in, out_size, ws_size, (size_t)WS_END);
        else if (hipGetDevice(&dev) != hipSuccess || hipDeviceGetAttribute(&cus, hipDeviceAttributeMultiprocessorCount, dev) != hipSuccess) fprintf(stderr, "kernel_launch: device query failed\n");
        else if (hipFuncSetAttribute((const void*)mega_fwd, hipFuncAttributeMaxDynamicSharedMemorySize, LDS_BYTES) != hipSuccess) fprintf(stderr, "kernel_launch: hipFuncSetAttribute failed\n");
        else if (hipOccupancyMaxActiveBlocksPerMultiprocessor(&per_cu, (const void*)mega_fwd, NTHR, LDS_BYTES) != hipSuccess || per_cu < 1) fprintf(stderr, "kernel_launch: occupancy query says %d blocks per CU\n", per_cu);
        else grid = cus;
        (void)hipGetLastError();
    }
    if (grid < 0) { k_nan_fill<<<1024, 256, 0, stream>>>((float*)d_out, out_size); return; }
    const float* x = (const float*)d_in[0];
    const float* conv_w = (const float*)d_in[5]; const float* conv_b = (const float*)d_in[6];
    const float* norm_g = (const float*)d_in[8]; const float* ln1_g = (const float*)d_in[10]; const float* ln1_b = (const float*)d_in[11];
    const float* rbias = (const float*)d_in[13]; const float* ln2_g = (const float*)d_in[20]; const float* ln2_b = (const float*)d_in[21];
    char* ws = (char*)d_ws; float* out = (float*)d_out;
    float* mod = (float*)(ws + WS_MOD); bf16* wtin = (bf16*)(ws + WS_WTIN); bf16* wtout = (bf16*)(ws + WS_WTOUT); bf16* wtr = (bf16*)(ws + WS_WTR);
    bf16* wt13 = (bf16*)(ws + WS_WT13); bf16* wt2 = (bf16*)(ws + WS_WT2); int* plan = (int*)(ws + WS_PLAN);
    bf16* u1 = (bf16*)(ws + WS_U1); bf16* proj = (bf16*)(ws + WS_PROJ); float* ipre = (float*)(ws + WS_GATES); float* logf = ipre + 16 * S;
    float* hraw = (float*)(ws + WS_HRAW); bf16* mix = (bf16*)(ws + WS_MIX); bf16* mixout = (bf16*)(ws + WS_MIXOUT); bf16* u2 = (bf16*)(ws + WS_U2);
    float* logits = (float*)(ws + WS_LOGITS); int* tope = (int*)(ws + WS_ROUTE); float* topg = (float*)(ws + WS_ROUTE + 1 * MiB); i32x2* list = (i32x2*)(ws + WS_ROUTE + 2 * MiB);
    bf16* H = (bf16*)(ws + WS_H); bf16* ys = (bf16*)(ws + WS_YS); bf16* ysh = (bf16*)(ws + WS_YSH);
    int* cnt = (int*)(ws + WS_CTL) + CW_CNT;
    (void)hipMemsetAsync(ws + WS_CTL, 0, 1 * MiB, stream);
    if (MK_UPTO > 0) {
        MArgs a{};
        for (int i = 0; i < 22; ++i) a.in[i] = (const float*)d_in[i];
        a.out = out; a.ws = (unsigned char*)d_ws; a.ph_lo = 0; a.ph_hi = MK_UPTO;
        hipLaunchKernelGGL(mega_fwd, dim3(grid), dim3(NTHR), LDS_BYTES, stream, a);
    }
}
```

```cpp
#include <hip/hip_runtime.h>
#include <cstdio>
#include <cstdint>

typedef unsigned short bf16;
typedef unsigned v4u __attribute__((ext_vector_type(4)));
typedef float f32x4 __attribute__((ext_vector_type(4)));
typedef int i32x2 __attribute__((ext_vector_type(2)));

constexpr int D = 1024, NB = 4, S = 8192, T = NB * S;
constexpr int NPROJ = 3584, WIN_LD = 3592;
constexpr int C_SBQ = 0, C_SBK = 512, C_SBV = 1024, C_MLQ = 1536, C_MLK = 2048, C_MLV = 2560, C_MLO = 3072, C_GATE = 3584;
constexpr int NE = 256, NEX = 257, TOPK = 8, FF = 256;
constexpr float LN_EPS = 1e-5f;
constexpr float DN_ALPHA = 1.189207115002721f;
constexpr float LOG2E = 1.4426950408889634f;
constexpr float QSCALE = 0.125f * LOG2E;
constexpr float SB_THRESH = 48.0f;

constexpr size_t MiB = 1u << 20;
constexpr size_t WS_CTL = 0;
constexpr size_t WS_MOD = 1 * MiB;
constexpr size_t WS_WTIN = 2 * MiB;
constexpr size_t WS_WTOUT = 10 * MiB;
constexpr size_t WS_WTR = 12 * MiB;
constexpr size_t WS_PLAN = 13 * MiB;
constexpr size_t WS_WT2 = 16 * MiB;
constexpr size_t WS_YS = 145 * MiB;
constexpr size_t WS_WT13 = 145 * MiB;
constexpr size_t WS_U2F8 = 274 * MiB;
constexpr size_t WS_PROJ = 402 * MiB;
constexpr size_t WS_GATES = 626 * MiB;
constexpr size_t WS_H = 657 * MiB;
constexpr size_t WS_STATES = 657 * MiB;
constexpr size_t WS_MIXOUT = 657 * MiB;
constexpr size_t WS_LOGITS = 657 * MiB;
constexpr size_t WS_U1 = 725 * MiB;
constexpr size_t WS_MIX = 725 * MiB;
constexpr size_t WS_U2 = 833 * MiB;
constexpr size_t WS_YSH = 833 * MiB;
constexpr size_t WS_HRAW = 833 * MiB;
constexpr size_t WS_ROUTE = 897 * MiB;
constexpr size_t WS_END = 902 * MiB;
constexpr int CW_CNT = 1024;
constexpr int CW_FILL = 1536;
constexpr int PL_SLOT = 0, PL_T64 = 512, PL_T256 = 1024;

__device__ __forceinline__ unsigned f2bf(float f) { unsigned u = __builtin_bit_cast(unsigned, f); return (u + 0x7fffu + ((u >> 16) & 1u)) >> 16; }
__device__ __forceinline__ float bf2f(unsigned b) { return __builtin_bit_cast(float, b << 16); }
__device__ __forceinline__ unsigned pk2(float lo, float hi) { return f2bf(lo) | (f2bf(hi) << 16); }
__device__ __forceinline__ unsigned pk4_fp8(float a, float b, float c, float d) { int w = 0; w = __builtin_amdgcn_cvt_pk_fp8_f32(a, b, w, false); w = __builtin_amdgcn_cvt_pk_fp8_f32(c, d, w, true); return (unsigned)w; }
__device__ __forceinline__ float wave_sum(float v) {
    v += __builtin_bit_cast(float, __builtin_amdgcn_update_dpp(0, __builtin_bit_cast(int, v), 0xB1, 0xF, 0xF, true));
    v += __builtin_bit_cast(float, __builtin_amdgcn_update_dpp(0, __builtin_bit_cast(int, v), 0x4E, 0xF, 0xF, true));
    v += __builtin_bit_cast(float, __builtin_amdgcn_update_dpp(0, __builtin_bit_cast(int, v), 0x141, 0xF, 0xF, true));
    v += __builtin_bit_cast(float, __builtin_amdgcn_update_dpp(0, __builtin_bit_cast(int, v), 0x140, 0xF, 0xF, true));
    const int iv = __builtin_bit_cast(int, v);
    const float r0 = __builtin_bit_cast(float, __builtin_amdgcn_readlane(iv, 0)), r1 = __builtin_bit_cast(float, __builtin_amdgcn_readlane(iv, 16));
    const float r2 = __builtin_bit_cast(float, __builtin_amdgcn_readlane(iv, 32)), r3 = __builtin_bit_cast(float, __builtin_amdgcn_readlane(iv, 48));
    return (r0 + r1) + (r2 + r3);
}
__device__ __forceinline__ float sigmoidf_(float x) { return 1.f / (1.f + __expf(-x)); }
__device__ __forceinline__ float siluf_(float x) { return x / (1.f + __expf(-x)); }


struct PrepArgs { const float *w_in, *w_out, *w_router, *w1, *w3, *w2, *sw1, *sw3, *sw2; unsigned char* wtin; bf16 *wtout, *wtr; unsigned char* wt13; bf16* wt2; };
struct PrepDesc { const float* src; unsigned char* dst; int ldw, ldt, k0, n0, rowmap, f8; };
constexpr int IT_IN = 16 * 56, IT_OUT = 16 * 16, IT_R = 16 * 4, IT_E = 192, IT_TOTAL = IT_IN + IT_OUT + IT_R + NEX * IT_E;
__device__ __forceinline__ PrepDesc prep_decode(const PrepArgs& a, int it) {
    if (it < IT_IN) return PrepDesc{a.w_in, a.wtin, WIN_LD, D, (it / 112) * 128, (it % 112) * 32, 0, 1}; it -= IT_IN;
    if (it < IT_OUT) return PrepDesc{a.w_out, (unsigned char*)a.wtout, D, D, (it / 16) * 64, (it % 16) * 64, 0, 0}; it -= IT_OUT;
    if (it < IT_R) return PrepDesc{a.w_router, (unsigned char*)a.wtr, NE, D, (it / 4) * 64, (it % 4) * 64, 0, 0}; it -= IT_R;
    const int e = it / IT_E, r = it % IT_E;
    if (r < 64) return PrepDesc{e < NE ? a.w1 + (size_t)e * D * FF : a.sw1, a.wt13 + (size_t)e * 512 * D, FF, D, (r / 8) * 128, (r % 8) * 32, 1, 1};
    if (r < 128) { const int q = r - 64; return PrepDesc{e < NE ? a.w3 + (size_t)e * D * FF : a.sw3, a.wt13 + (size_t)e * 512 * D, FF, D, (q / 8) * 128, (q % 8) * 32, 2, 1}; }
    const int q = r - 128; return PrepDesc{e < NE ? a.w2 + (size_t)e * FF * D : a.sw2, (unsigned char*)(a.wt2 + (size_t)e * D * FF), D, FF, (q / 16) * 64, (q % 16) * 64, 0, 0};
}
__device__ __forceinline__ void prep_load(const PrepDesc& d, int lane, f32x4 (&v)[16]) {
    const int g = d.f8 ? (lane >> 3) : (lane >> 4), i = d.f8 ? (lane & 7) : (lane & 15);
#pragma unroll
    for (int r = 0; r < 16; ++r) v[r] = __builtin_nontemporal_load((const f32x4*)(d.src + (size_t)(d.k0 + 16 * g + r) * d.ldw + d.n0 + 4 * i));
}
__device__ __forceinline__ void prep_store(const PrepDesc& d, int lane, const f32x4 (&v)[16]) {
    const int g = d.f8 ? (lane >> 3) : (lane >> 4), i = d.f8 ? (lane & 7) : (lane & 15);
#pragma unroll
    for (int nn = 0; nn < 4; ++nn) {
        const int n = d.n0 + 4 * i + nn;
        const int dr = d.rowmap == 0 ? n : ((n >> 7) * 256 + (d.rowmap == 2 ? 128 : 0) + (n & 127));
        if (d.f8) {
            v4u o; o.x = pk4_fp8(v[0][nn] * 64.f, v[1][nn] * 64.f, v[2][nn] * 64.f, v[3][nn] * 64.f); o.y = pk4_fp8(v[4][nn] * 64.f, v[5][nn] * 64.f, v[6][nn] * 64.f, v[7][nn] * 64.f);
            o.z = pk4_fp8(v[8][nn] * 64.f, v[9][nn] * 64.f, v[10][nn] * 64.f, v[11][nn] * 64.f); o.w = pk4_fp8(v[12][nn] * 64.f, v[13][nn] * 64.f, v[14][nn] * 64.f, v[15][nn] * 64.f);
            *(v4u*)(d.dst + (size_t)dr * d.ldt + d.k0 + 16 * g) = o;
        } else {
            v4u o0, o1; o0.x = pk2(v[0][nn], v[1][nn]); o0.y = pk2(v[2][nn], v[3][nn]); o0.z = pk2(v[4][nn], v[5][nn]); o0.w = pk2(v[6][nn], v[7][nn]);
            o1.x = pk2(v[8][nn], v[9][nn]); o1.y = pk2(v[10][nn], v[11][nn]); o1.z = pk2(v[12][nn], v[13][nn]); o1.w = pk2(v[14][nn], v[15][nn]);
            v4u* dp = (v4u*)((bf16*)d.dst + (size_t)dr * d.ldt + d.k0 + 16 * g); dp[0] = o0; dp[1] = o1;
        }
    }
}
__device__ __forceinline__ void prep_run(const PrepArgs& a, int it0, int stride, int lane) {
    int it = it0; if (it >= IT_TOTAL) return;
    PrepDesc dA = prep_decode(a, it), dB = dA; f32x4 va[16], vb[16]; prep_load(dA, lane, va);
    for (;;) {
        const int itB = it + stride; const bool hasB = itB < IT_TOTAL;
        if (hasB) { dB = prep_decode(a, itB); prep_load(dB, lane, vb); }
        prep_store(dA, lane, va);
        if (!hasB) break;
        const int itA = itB + stride; const bool hasA = itA < IT_TOTAL;
        if (hasA) { dA = prep_decode(a, itA); prep_load(dA, lane, va); }
        prep_store(dB, lane, vb);
        if (!hasA) break;
        it = itA;
    }
}


__device__ __forceinline__ f32x4 ld_bf4(const bf16* p) { const unsigned long long w = *(const unsigned long long*)p;
    return (f32x4){bf2f((unsigned)w & 0xffffu), bf2f(((unsigned)w) >> 16), bf2f((unsigned)(w >> 32) & 0xffffu), bf2f((unsigned)(w >> 48))}; }

#define LAS __attribute__((address_space(3)))
#define GAS __attribute__((address_space(1)))
namespace pg8 {
typedef short bf16x8 __attribute__((ext_vector_type(8)));
constexpr int F8_SCALE_W = 121;
constexpr int BM = 256, BK = 64, HALF = 128, HTB = HALF * BK * 2, STAGE_BYTES = 8 * HTB, NXCD = 8, WGM = 8;
__host__ __device__ __forceinline__ int lds_byte(int r, int c) { const int st = (r >> 4) * 2 + (c >> 5), rr = r & 15, cc = c & 31, ob = rr * 64 + cc * 2; return st * 1024 + (ob ^ (((ob >> 9) & 1) << 5)); }
__host__ __device__ __forceinline__ void stage_rc(int b, int& R, int& C) { const int st = b / 1024, sb = b % 1024, swz = sb ^ (((sb >> 9) & 1) << 5); R = (st >> 1) * 16 + swz / 64; C = (st & 1) * 32 + (swz % 64) / 2; }
__host__ __device__ __forceinline__ int perm32(int rho) { const int n = rho >> 4, i = rho & 15; return 8 * (i >> 2) + 4 * n + (i & 3); }

struct Unit { int pm, pn, e, mt; const char* A; const char* B; };

__device__ __forceinline__ long unit_index(int i, int G, int c) { return (G % 8 == 0) ? ((long)(i * 8 + (c & 7)) * (G / 8) + (c >> 3)) : ((long)i * G + c); }

struct StaticOrder {
    int nM, nN, nwg, G, c; const char* A; const char* B; size_t tstep;
    __device__ void init(const void* A_, const void* B_, int M, int N, int Kb, int G_, int c_) { nM = M / BM; nN = N / BM; nwg = nM * nN; G = G_; c = c_; A = (const char*)A_; B = (const char*)B_; tstep = (size_t)BM * Kb; }
    __device__ __forceinline__ bool next(int i, Unit& u) const {
        const long L = (long)i * G + c; if (L >= nwg) return false;
        int wgid = (int)L; { const int q = nwg / NXCD, r = nwg % NXCD, xcd = wgid % NXCD, off = wgid / NXCD; wgid = (xcd < r ? xcd * (q + 1) : r * (q + 1) + (xcd - r) * q) + off; }
        const int nig = WGM * nN, gid = wgid / nig, fm = gid * WGM, gsz = (nM - fm) < WGM ? (nM - fm) : WGM;
        u.pm = fm + ((wgid % nig) % gsz); u.pn = (wgid % nig) / gsz; u.e = 0; u.mt = u.pm; u.A = A + (size_t)u.pm * tstep; u.B = B + (size_t)u.pn * tstep; return true;
    }
    __device__ __forceinline__ int row_token(const Unit&, int) const { return 0; }
};

struct MoeOrder {
    int G, c, total, shift; const LAS int* tb; const LAS int* nn; const i32x2* list;
    const char* Abase; size_t a_tile_stride; const char* Bbase; size_t b_exp_stride, b_pn_stride;
    __device__ __forceinline__ bool next(int i, Unit& u) const {
        const long L = unit_index(i, G, c); if (L >= total) return false;
        const int tile = (int)(L >> shift); u.pn = (int)(L & ((1 << shift) - 1));
        int lo = 0, hi = NEX; while (hi - lo > 1) { const int mid = (lo + hi) >> 1; if (tb[mid] <= tile) lo = mid; else hi = mid; }
        u.e = lo; u.mt = tile - tb[lo]; u.pm = tile;
        u.A = Abase + (size_t)tile * a_tile_stride; u.B = Bbase + (size_t)lo * b_exp_stride + (size_t)u.pn * b_pn_stride; return true;
    }
    __device__ __forceinline__ int row_token(const Unit& u, int row) const {
        const int rr = u.mt * 256 + row;
        if (u.e >= NE) return rr;
        return rr < nn[u.e] ? (list[u.pm * 256 + row].x >> 3) : 0;
    }
};

__device__ __forceinline__ unsigned cvt_pk_bf16(float lo, float hi) { unsigned r; asm volatile("v_cvt_pk_bf16_f32 %0, %1, %2" : "=v"(r) : "v"(lo), "v"(hi)); return r; }

struct EpiBf16 {
    static constexpr bool PERM = true; bf16* O; int ldc; int scale_tiles; float scale; float gscale;
    __device__ __forceinline__ void operator()(const f32x4 (&acc)[2][2][4][2], const Unit& u, int wr, int wc, int fr, int fq) const {
        const int row0 = u.pm * BM + wr * 64 + fr, col0 = u.pn * BM + wc * 32 + 8 * fq; const float sc = (u.pn < scale_tiles ? scale : 1.f) * gscale;
#pragma unroll
        for (int ai = 0; ai < 2; ++ai)
#pragma unroll
            for (int m = 0; m < 4; ++m) { bf16* rowp = O + (size_t)(row0 + ai * HALF + m * 16) * ldc + col0;
#pragma unroll
                for (int bj = 0; bj < 2; ++bj) { const f32x4 v0 = acc[ai][bj][m][0] * sc, v1 = acc[ai][bj][m][1] * sc;
                    v4u w; w.x = cvt_pk_bf16(v0[0], v0[1]); w.y = cvt_pk_bf16(v0[2], v0[3]); w.z = cvt_pk_bf16(v1[0], v1[1]); w.w = cvt_pk_bf16(v1[2], v1[3]);
                    *(v4u*)(rowp + bj * HALF) = w; } }
    }
};
struct EpiF32 {
    static constexpr bool PERM = false; float* C; int ldc;
    __device__ __forceinline__ void operator()(const f32x4 (&acc)[2][2][4][2], const Unit& u, int wr, int wc, int fr, int fq) const {
        const int row0 = u.pm * BM + wr * 64 + fr, col0 = u.pn * BM + wc * 32 + 4 * fq;
#pragma unroll
        for (int ai = 0; ai < 2; ++ai)
#pragma unroll
            for (int m = 0; m < 4; ++m) { float* rowp = C + (size_t)(row0 + ai * HALF + m * 16) * ldc + col0;
#pragma unroll
                for (int bj = 0; bj < 2; ++bj)
#pragma unroll
                    for (int n = 0; n < 2; ++n) *(f32x4*)(rowp + bj * HALF + n * 16) = acc[ai][bj][m][n]; }
    }
};
struct EpiGlu {
    static constexpr bool PERM = true; bf16* H; float gscale;
    __device__ __forceinline__ void operator()(const f32x4 (&acc)[2][2][4][2], const Unit& u, int wr, int wc, int fr, int fq) const {
        const int row0 = u.pm * BM + wr * 64 + fr, col0 = u.pn * HALF + wc * 32 + 8 * fq;
#pragma unroll
        for (int ai = 0; ai < 2; ++ai)
#pragma unroll
            for (int m = 0; m < 4; ++m) { float h[8];
#pragma unroll
                for (int n = 0; n < 2; ++n)
#pragma unroll
                    for (int q = 0; q < 4; ++q) { const float a = acc[ai][0][m][n][q] * gscale; h[n * 4 + q] = a * __builtin_amdgcn_rcpf(1.f + __expf(-a)) * (acc[ai][1][m][n][q] * gscale); }
                v4u w; w.x = cvt_pk_bf16(h[0], h[1]); w.y = cvt_pk_bf16(h[2], h[3]); w.z = cvt_pk_bf16(h[4], h[5]); w.w = cvt_pk_bf16(h[6], h[7]);
                *(v4u*)(H + (size_t)(row0 + ai * HALF + m * 16) * FF + col0) = w; }
    }
};
struct EpiScatter {
    static constexpr bool PERM = true; bf16* ys; bf16* ysh; const i32x2* list; const LAS int* nn;
    __device__ __forceinline__ void operator()(const f32x4 (&acc)[2][2][4][2], const Unit& u, int wr, int wc, int fr, int fq) const {
        const int col0 = u.pn * BM + wc * 32 + 8 * fq; const int n = nn[u.e]; const bool routed = u.e < NE;
        const i32x2* lp = list + (size_t)(u.pm - u.mt) * 256;
#pragma unroll
        for (int ai = 0; ai < 2; ++ai) {
            i32x2 en[4];
#pragma unroll
            for (int m = 0; m < 4; ++m) { const int rr = u.mt * 256 + ai * HALF + wr * 64 + m * 16 + fr; en[m] = (i32x2){rr, 0x3f800000};
                if (routed && rr < n) en[m] = lp[rr]; }
#pragma unroll
            for (int m = 0; m < 4; ++m) { const int rr = u.mt * 256 + ai * HALF + wr * 64 + m * 16 + fr;
                if (rr < n) { bf16* dst = (routed ? ys : ysh) + (size_t)en[m].x * D + col0; const float g = __int_as_float(en[m].y);
#pragma unroll
                    for (int bj = 0; bj < 2; ++bj) { const f32x4 v0 = acc[ai][bj][m][0] * g, v1 = acc[ai][bj][m][1] * g;
                        v4u w; w.x = cvt_pk_bf16(v0[0], v0[1]); w.y = cvt_pk_bf16(v0[2], v0[3]); w.z = cvt_pk_bf16(v1[0], v1[1]); w.w = cvt_pk_bf16(v1[2], v1[3]);
                        *(v4u*)(dst + bj * HALF) = w; } } }
            __builtin_amdgcn_sched_barrier(0);
        }
    }
};

typedef int i32x8 __attribute__((ext_vector_type(8)));
typedef int i32x4 __attribute__((ext_vector_type(4)));
template <bool FP8> struct FragT { struct A4 { bf16x8 v[4][2]; }; struct B2 { bf16x8 v[2][2]; }; };
template <> struct FragT<true> { struct A4 { i32x8 v[4]; }; struct B2 { i32x8 v[2]; }; };
template <class Epi, class Sched, bool GATHER, bool FP8>
__device__ __forceinline__ void gemm_phase(LAS unsigned char* lds, const int Kb, const Sched& S, const Epi& E) {
    const int tid = threadIdx.x, wid = __builtin_amdgcn_readfirstlane(tid >> 6), lane = tid & 63, wr = wid >> 2, wc = wid & 3, fr = lane & 15, fq = lane >> 4;
    const int nt = Kb / 128;
    int sR[2], sC[2];
    unsigned voffA[2], voffB[2];
#pragma unroll
    for (int i = 0; i < 2; ++i) { stage_rc(tid * 16 + i * 8192, sR[i], sC[i]); const int Rb = Epi::PERM ? ((sR[i] & ~31) + perm32(sR[i] & 31)) : sR[i];
        voffA[i] = (unsigned)(sR[i] * Kb + sC[i] * 2); voffB[i] = (unsigned)(Rb * Kb + sC[i] * 2); }
    const size_t kstep = (size_t)(BK * 2);
    const size_t hstep = (size_t)HALF * Kb;
    const unsigned ldsw = (unsigned)wid * 1024u;
    const int aoff = lds_byte(wr * 64 + fr, fq * 8), boff = lds_byte(wc * 32 + fr, fq * 8);
    unsigned gc[2][2], gn[2][2];
#define PG8_SA(b, h) (((b) * 2 + (h)) * HTB)
#define PG8_SB(b, h) ((4 + (b) * 2 + (h)) * HTB)
#define PG8_GLDS(src, bufoff, i) __builtin_amdgcn_global_load_lds((const unsigned*)(src), (LAS unsigned*)(lds + (bufoff) + ldsw + (i) * 8192), 16, 0, 0)
#define PG8_STAGE_B(bufoff, gbase) do { PG8_GLDS((const char*)(gbase) + voffB[0], bufoff, 0); PG8_GLDS((const char*)(gbase) + voffB[1], bufoff, 1); } while (0)
#define PG8_STAGE_A(bufoff, gbase, h, nx) do { if constexpr (GATHER) { const unsigned _o0 = (nx) ? gn[h][0] : gc[h][0], _o1 = (nx) ? gn[h][1] : gc[h][1]; \
            PG8_GLDS((const char*)(gbase) + _o0, bufoff, 0); PG8_GLDS((const char*)(gbase) + _o1, bufoff, 1); } \
        else { PG8_GLDS((const char*)(gbase) + (h) * hstep + voffA[0], bufoff, 0); PG8_GLDS((const char*)(gbase) + (h) * hstep + voffA[1], bufoff, 1); } } while (0)
#define PG8_LD2(dstv, p) do { if constexpr (FP8) { const i32x4 _lo = *(const LAS i32x4*)(p), _hi = *(const LAS i32x4*)((p) + 1024); dstv = __builtin_shufflevector(_lo, _hi, 0, 1, 2, 3, 4, 5, 6, 7); } } while (0)
#define PG8_LDA(dst, b, h) do { _Pragma("unroll") for (int m = 0; m < 4; ++m) { if constexpr (FP8) { PG8_LD2(dst.v[m], lds + PG8_SA(b, h) + aoff + m * 2048); } \
        else { _Pragma("unroll") for (int k = 0; k < 2; ++k) dst.v[m][k] = *(const LAS bf16x8*)(lds + PG8_SA(b, h) + aoff + m * 2048 + k * 1024); } } } while (0)
#define PG8_LDB(dst, b, h) do { _Pragma("unroll") for (int n = 0; n < 2; ++n) { if constexpr (FP8) { PG8_LD2(dst.v[n], lds + PG8_SB(b, h) + boff + n * 2048); } \
        else { _Pragma("unroll") for (int k = 0; k < 2; ++k) dst.v[n][k] = *(const LAS bf16x8*)(lds + PG8_SB(b, h) + boff + n * 2048 + k * 1024); } } } while (0)
#define PG8_MMA(ai, bj, At, Bt) do { __builtin_amdgcn_s_setprio(1); _Pragma("unroll") for (int m = 0; m < 4; ++m) _Pragma("unroll") for (int n = 0; n < 2; ++n) { \
        if constexpr (FP8) asm volatile("s_nop 1\n\tv_mfma_scale_f32_16x16x128_f8f6f4 %0, %1, %2, %0, %3, %3 op_sel_hi:[0,0,0]" : "+v"(acc[ai][bj][m][n]) : "v"(Bt.v[n]), "v"(At.v[m]), "v"(f8scale)); \
        else { _Pragma("unroll") for (int k = 0; k < 2; ++k) acc[ai][bj][m][n] = __builtin_amdgcn_mfma_f32_16x16x32_bf16(Bt.v[n][k], At.v[m][k], acc[ai][bj][m][n], 0, 0, 0); } } \
        __builtin_amdgcn_s_setprio(0); } while (0)
#define PG8_WAIT_V(n) asm volatile("s_waitcnt vmcnt(" #n ")" ::: "memory")
#define PG8_WAIT_L(n) asm volatile("s_waitcnt lgkmcnt(" #n ")" ::: "memory")
#define PG8_BAR __builtin_amdgcn_s_barrier()
#define PG8_SCHED __builtin_amdgcn_sched_barrier(0)
#define PG8_GATHER(dst, u) do { _Pragma("unroll") for (int _h = 0; _h < 2; ++_h) _Pragma("unroll") for (int _i = 0; _i < 2; ++_i) \
        dst[_h][_i] = (unsigned)(S.row_token(u, _h * HALF + sR[_i]) * Kb + sC[_i] * 2); } while (0)
    Unit cur, nxt; int ui = 0;
    if (!S.next(0, cur)) return;
    f32x4 acc[2][2][4][2];
#pragma unroll
    for (int a = 0; a < 2; ++a)
#pragma unroll
        for (int b = 0; b < 2; ++b)
#pragma unroll
            for (int m = 0; m < 4; ++m)
#pragma unroll
                for (int n = 0; n < 2; ++n) acc[a][b][m][n] = (f32x4){0.f, 0.f, 0.f, 0.f};
    const int f8scale = 0x7f7f7f7f;
    typedef typename FragT<FP8>::A4 FragA; typedef typename FragT<FP8>::B2 FragB;
    FragA At; FragB B0, B1;
    const char* cA = cur.A; const char* cB = cur.B;
    if constexpr (GATHER) { PG8_GATHER(gc, cur); }
    PG8_STAGE_B(PG8_SB(0, 0), cB); PG8_STAGE_A(PG8_SA(0, 0), cA, 0, false); PG8_STAGE_B(PG8_SB(0, 1), cB + hstep); PG8_STAGE_A(PG8_SA(0, 1), cA, 1, false);
    if (wr == 1) PG8_BAR;
    PG8_WAIT_V(4); PG8_BAR;
    PG8_STAGE_B(PG8_SB(1, 0), cB + kstep); PG8_STAGE_A(PG8_SA(1, 0), cA + kstep, 0, false); PG8_STAGE_B(PG8_SB(1, 1), cB + hstep + kstep);
    PG8_WAIT_V(6); PG8_BAR;
    for (;;) {
        const bool has_next = S.next(ui + 1, nxt);
        const char* nA = has_next ? nxt.A : cA; const char* nB = has_next ? nxt.B : cB;
        if constexpr (GATHER) { if (has_next) { PG8_GATHER(gn, nxt); } else {
#pragma unroll
            for (int h = 0; h < 2; ++h) { gn[h][0] = gc[h][0]; gn[h][1] = gc[h][1]; } } }
#pragma unroll 1
        for (int t = 0; t < nt; t += 2) {
            const bool last = (t == nt - 2);
            const char* a1 = cA + (size_t)(t + 1) * kstep;
            const char* a2 = last ? nA : cA + (size_t)(t + 2) * kstep; const char* b2 = last ? nB : cB + (size_t)(t + 2) * kstep;
            const char* a3 = a2 + kstep; const char* b3 = b2 + kstep;
            PG8_LDB(B0, 0, 0); PG8_SCHED; PG8_LDA(At, 0, 0); PG8_STAGE_A(PG8_SA(1, 1), a1, 1, false);
            PG8_WAIT_L(8); PG8_BAR; PG8_WAIT_L(0); PG8_MMA(0, 0, At, B0); PG8_BAR; PG8_SCHED;
            PG8_LDB(B1, 0, 1); PG8_STAGE_B(PG8_SB(0, 0), b2);
            PG8_BAR; PG8_WAIT_L(0); PG8_MMA(0, 1, At, B1); PG8_BAR;
            PG8_LDA(At, 0, 1); PG8_STAGE_A(PG8_SA(0, 0), a2, 0, last);
            PG8_BAR; PG8_WAIT_L(0); PG8_MMA(1, 0, At, B0); PG8_BAR; PG8_SCHED;
            PG8_STAGE_B(PG8_SB(0, 1), b2 + hstep);
            PG8_WAIT_V(6); PG8_BAR; PG8_MMA(1, 1, At, B1); PG8_BAR;
            PG8_LDB(B0, 1, 0); PG8_SCHED; PG8_LDA(At, 1, 0); PG8_STAGE_A(PG8_SA(0, 1), a2, 1, last);
            PG8_WAIT_L(8); PG8_BAR; PG8_WAIT_L(0); PG8_MMA(0, 0, At, B0); PG8_BAR; PG8_SCHED;
            PG8_LDB(B1, 1, 1); PG8_STAGE_B(PG8_SB(1, 0), b3);
            PG8_BAR; PG8_WAIT_L(0); PG8_MMA(0, 1, At, B1); PG8_BAR;
            PG8_LDA(At, 1, 1); PG8_STAGE_A(PG8_SA(1, 0), a3, 0, last);
            PG8_BAR; PG8_WAIT_L(0); PG8_MMA(1, 0, At, B0); PG8_BAR; PG8_SCHED;
            PG8_STAGE_B(PG8_SB(1, 1), b3 + hstep);
            PG8_WAIT_V(6); PG8_BAR; PG8_MMA(1, 1, At, B1); PG8_BAR;
        }
        if constexpr (FP8) { __builtin_amdgcn_sched_barrier(0); asm volatile("s_nop 15\n\ts_nop 7" ::: "memory"); __builtin_amdgcn_sched_barrier(0); }
        E(acc, cur, wr, wc, fr, fq);
        if (!has_next) break;
#pragma unroll
        for (int a = 0; a < 2; ++a)
#pragma unroll
            for (int b = 0; b < 2; ++b)
#pragma unroll
                for (int m = 0; m < 4; ++m)
#pragma unroll
                    for (int n = 0; n < 2; ++n) acc[a][b][m][n] = (f32x4){0.f, 0.f, 0.f, 0.f};
        cur = nxt; cA = nA; cB = nB; ++ui;
        if constexpr (GATHER) {
#pragma unroll
            for (int h = 0; h < 2; ++h) { gc[h][0] = gn[h][0]; gc[h][1] = gn[h][1]; } }
    }
    PG8_WAIT_V(0);
    if (wr == 0) PG8_BAR;
    PG8_BAR;
#undef PG8_SA
#undef PG8_SB
#undef PG8_GLDS
#undef PG8_STAGE_A
#undef PG8_STAGE_B
#undef PG8_LDA
#undef PG8_LDB
#undef PG8_MMA
#undef PG8_WAIT_V
#undef PG8_WAIT_L
#undef PG8_BAR
#undef PG8_SCHED
#undef PG8_GATHER
}
}

#define XB_TMO      128
#define XB_XCNT(j)  (256  + 64 * (j))
#define XB_XSUB(j)  (1280 + 64 * (j))
#define XB_XGEN(j)  (2304 + 64 * (j))
#define XB_TOP      3328
#define XB_TOPGEN   3392
#define XCD_BAR_WORDS 3456
#define XB_SPIN_CAP (1u << 22)
__device__ __forceinline__ unsigned xb_ld(unsigned* p)              { return __hip_atomic_load(p, __ATOMIC_RELAXED, __HIP_MEMORY_SCOPE_AGENT); }
__device__ __forceinline__ unsigned xb_add(unsigned* p, unsigned v) { return __hip_atomic_fetch_add(p, v, __ATOMIC_RELAXED, __HIP_MEMORY_SCOPE_AGENT); }
__device__ __forceinline__ unsigned xb_xcc_id() { return (unsigned)__builtin_amdgcn_s_getreg((3 << 11) | 20) & 0xFu; }
#define XB_SPIN(cond, bar) do { unsigned _sp = 0; while (cond) { __builtin_amdgcn_s_sleep(1); \
    if ((++_sp & 255u) == 0u) { if (xb_ld(&(bar)[XB_TMO])) break; if (_sp > XB_SPIN_CAP) { atomicAdd(&(bar)[XB_TMO], 1u); break; } } } } while (0)
struct XcdBarrier { unsigned* bar; unsigned x; volatile LAS unsigned* st; };
__device__ __forceinline__ XcdBarrier xcd_barrier_post(unsigned* bar, volatile LAS unsigned* st) {
    XcdBarrier b; b.bar = bar; b.x = xb_xcc_id(); b.st = st;
    if (threadIdx.x == 0) (void)xb_add(&bar[XB_XCNT(b.x)], 1u);
    return b;
}
__device__ __forceinline__ void xcd_barrier_complete(unsigned* bar, unsigned x, unsigned& nloc, unsigned& nx) {
    const unsigned G = gridDim.x * gridDim.y * gridDim.z;
    unsigned sum, cnt, mine, sp = 0u;
    for (;;) {
        sum = 0u; cnt = 0u; mine = 0u;
#pragma unroll
        for (unsigned j = 0; j < 16; ++j) { const unsigned c = xb_ld(&bar[XB_XCNT(j)]); sum += c; cnt += (c > 0u) ? 1u : 0u; mine = (j == x) ? c : mine; }
        if (sum == G) break;
        __builtin_amdgcn_s_sleep(1);
        if ((++sp & 255u) == 0u) { if (xb_ld(&bar[XB_TMO])) break; if (sp > XB_SPIN_CAP) { atomicAdd(&bar[XB_TMO], 1u); break; } }
    }
    nloc = mine > 0u ? mine : 1u; nx = cnt > 0u ? cnt : 1u;
}
__device__ __forceinline__ void xcd_barrier(const XcdBarrier& b) {
    asm volatile("s_waitcnt vmcnt(0)" ::: "memory");
    __syncthreads();
    if (threadIdx.x == 0) {
        unsigned* bar = b.bar;
        __builtin_amdgcn_s_waitcnt(0);
        unsigned nloc = b.st[0], nx = b.st[1];
        if (nloc == 0u) { xcd_barrier_complete(bar, b.x, nloc, nx); b.st[0] = nloc; b.st[1] = nx; }
        const unsigned old = xb_add(&bar[XB_XSUB(b.x)], 1u);
        const unsigned gen = old / nloc;
        if (old + 1u == (gen + 1u) * nloc) {
            __builtin_amdgcn_fence(__ATOMIC_RELEASE, "agent");
            asm volatile("s_waitcnt vmcnt(0)" ::: "memory");
            const unsigned og = xb_add(&bar[XB_TOP], 1u);
            const unsigned tg = og / nx;
            if (og + 1u == (tg + 1u) * nx) xb_add(&bar[XB_TOPGEN], 1u);
            else XB_SPIN(xb_ld(&bar[XB_TOPGEN]) == tg, bar);
            __builtin_amdgcn_fence(__ATOMIC_ACQUIRE, "agent");
            xb_add(&bar[XB_XGEN(b.x)], 1u);
            asm volatile("s_waitcnt vmcnt(0)" ::: "memory");
        } else {
            XB_SPIN(xb_ld(&bar[XB_XGEN(b.x)]) == gen, bar);
            __builtin_amdgcn_fence(__ATOMIC_ACQUIRE, "agent");
            asm volatile("s_waitcnt vmcnt(0)" ::: "memory");
        }
    }
    __syncthreads();
}

constexpr int NWAVES = 8, NTHR = 512;
constexpr int RING_BYTES = 131072, XTRA_OFF = RING_BYTES, LDS_BYTES = 147456;
constexpr int X_MISC = 0, X_TB = 256, X_NN = 1536;
constexpr int CW_BAR = 4096;
constexpr int N_PHASES = 14;
struct MArgs { const float* in[22]; float* out; unsigned char* ws; int ph_lo, ph_hi; };

__device__ __forceinline__ void ph_mod_prep(const MArgs& a, unsigned char* smem, int G) {
    const int tid = threadIdx.x;
    unsigned char* ws = a.ws;
    if ((int)blockIdx.x < 192) {
        float* sc = (float*)smem; float* red = sc + NB * D;
        const float* c = a.in[1]; const float* w_ada = a.in[2]; const float* b_ada = a.in[3]; float* mod = (float*)(ws + WS_MOD);
        for (int i = tid; i < NB * D; i += NTHR) sc[i] = siluf_(c[i]);
        __syncthreads();
        for (int it = blockIdx.x; it < 192; it += G) {
            const int kq = tid >> 5, jl = tid & 31, j = it * 32 + jl;
            float a0 = 0.f, a1 = 0.f, a2 = 0.f, a3 = 0.f;
#pragma unroll 16
            for (int kk = 0; kk < 64; ++kk) { const int k = kq * 64 + kk; const float w = w_ada[(size_t)k * 6144 + j];
                a0 += sc[k] * w; a1 += sc[D + k] * w; a2 += sc[2 * D + k] * w; a3 += sc[3 * D + k] * w; }
            red[(kq * 4 + 0) * 32 + jl] = a0; red[(kq * 4 + 1) * 32 + jl] = a1; red[(kq * 4 + 2) * 32 + jl] = a2; red[(kq * 4 + 3) * 32 + jl] = a3;
            __syncthreads();
            if (tid < 128) { const int b = tid >> 5; float s = b_ada[j];
#pragma unroll
                for (int q = 0; q < 16; ++q) s += red[(q * 4 + b) * 32 + jl];
                mod[b * 6144 + j] = s; }
            __syncthreads();
        }
    }
    PrepArgs pa{a.in[4], a.in[9], a.in[12], a.in[14], a.in[15], a.in[16], a.in[17], a.in[18], a.in[19],
                (unsigned char*)(ws + WS_WTIN), (bf16*)(ws + WS_WTOUT), (bf16*)(ws + WS_WTR), (unsigned char*)(ws + WS_WT13), (bf16*)(ws + WS_WT2)};
    const int lane = tid & 63, gw = blockIdx.x * NWAVES + (tid >> 6), ngw = G * NWAVES;
    prep_run(pa, gw, ngw, lane);
}

__device__ __forceinline__ void ph_ln1(const MArgs& a, unsigned char* smem, int G) {
    const int tid = threadIdx.x, lane = tid & 63, wave = tid >> 6;
    const float* x = a.in[0]; const float* w_in = a.in[4]; const float* gate_b = a.in[7];
    const float* mod = (const float*)(a.ws + WS_MOD); unsigned char* u1 = (unsigned char*)(a.ws + WS_U1); float* ipre = (float*)(a.ws + WS_GATES); float* logf = ipre + 16 * S;
    float* wg = (float*)smem;
    for (int i = tid; i < D * 8; i += NTHR) wg[i] = w_in[(size_t)(i >> 3) * WIN_LD + C_GATE + (i & 7)];
    __syncthreads();
    for (int it = blockIdx.x; it < T / 128; it += G) {
        const int row0 = it * 128, b = row0 / S;
        f32x4 sh[4], sc[4];
#pragma unroll
        for (int j = 0; j < 4; ++j) { sh[j] = *(const f32x4*)(mod + b * 6144 + 4 * lane + 256 * j); sc[j] = *(const f32x4*)(mod + b * 6144 + 1024 + 4 * lane + 256 * j); }
        for (int rr = wave; rr < 128; rr += NWAVES) {
            const int row = row0 + rr;
            const f32x4* xr = (const f32x4*)(x + (size_t)row * D) + lane;
            f32x4 v[4]; float s = 0.f;
#pragma unroll
            for (int j = 0; j < 4; ++j) { v[j] = xr[64 * j]; s += (v[j].x + v[j].y) + (v[j].z + v[j].w); }
            const float mean = wave_sum(s) * (1.f / D); float s2 = 0.f;
#pragma unroll
            for (int j = 0; j < 4; ++j) { v[j] = v[j] - mean; s2 += (v[j].x * v[j].x + v[j].y * v[j].y) + (v[j].z * v[j].z + v[j].w * v[j].w); }
            const float rstd = 1.f / sqrtf(wave_sum(s2) * (1.f / D) + LN_EPS);
            float ga[8];
#pragma unroll
            for (int q = 0; q < 8; ++q) ga[q] = 0.f;
            unsigned* o4 = (unsigned*)(u1 + (size_t)row * D) + lane;
#pragma unroll
            for (int j = 0; j < 4; ++j) {
                const f32x4 u = v[j] * rstd * (sc[j] + 1.0f) + sh[j];
                o4[64 * j] = pk4_fp8(u.x, u.y, u.z, u.w);
#pragma unroll
                for (int e = 0; e < 4; ++e) { const int k = 4 * lane + 256 * j + e;
                    const f32x4 w0 = *(const f32x4*)(wg + k * 8), w1 = *(const f32x4*)(wg + k * 8 + 4);
                    ga[0] += u[e] * w0.x; ga[1] += u[e] * w0.y; ga[2] += u[e] * w0.z; ga[3] += u[e] * w0.w;
                    ga[4] += u[e] * w1.x; ga[5] += u[e] * w1.y; ga[6] += u[e] * w1.z; ga[7] += u[e] * w1.w; }
            }
#pragma unroll
            for (int q = 0; q < 8; ++q) ga[q] = wave_sum(ga[q]);
            if (lane < 8) {
                float gv = 0.f;
#pragma unroll
                for (int q = 0; q < 8; ++q) gv = (lane == q) ? ga[q] : gv;
                gv += gate_b[lane];
                const int h = lane & 3, s_ = row % S;
                if (lane < 4) ipre[(size_t)(b * 4 + h) * S + s_] = gv;
                else logf[(size_t)(b * 4 + h) * S + s_] = fminf(gv, 0.f) - log1pf(__expf(-fabsf(gv)));
            }
        }
    }
}

__device__ __forceinline__ void ph_ln2(const MArgs& a, int G) {
    const float* x = a.in[0]; const bf16* mixout = (const bf16*)(a.ws + WS_MIXOUT); const float* mod = (const float*)(a.ws + WS_MOD); const float* ln1_g = a.in[10]; const float* ln1_b = a.in[11];
    float* x1 = a.out; bf16* u2 = (bf16*)(a.ws + WS_U2); unsigned char* u2f8 = (unsigned char*)(a.ws + WS_U2F8);
    const int tid = threadIdx.x, lane = tid & 63, wave = tid >> 6;
    for (int it = blockIdx.x; it < T / 128; it += G) {
        const int row0 = it * 128, b = row0 / S;
        for (int rr = wave; rr < 128; rr += NWAVES) {
            const int row = row0 + rr;
            f32x4 v[4]; float s = 0.f;
#pragma unroll
            for (int j = 0; j < 4; ++j) {
                const int col = 4 * lane + 256 * j;
                const f32x4 xv = *(const f32x4*)(x + (size_t)row * D + col);
                const f32x4 mo = ld_bf4(mixout + (size_t)row * D + col);
                const f32x4 g1 = *(const f32x4*)(mod + b * 6144 + 2048 + col);
                v[j] = xv * DN_ALPHA + g1 * mo; s += (v[j].x + v[j].y) + (v[j].z + v[j].w);
            }
            float mean = wave_sum(s) * (1.f / D), s2 = 0.f;
#pragma unroll
            for (int j = 0; j < 4; ++j) { v[j] = v[j] - mean; s2 += (v[j].x * v[j].x + v[j].y * v[j].y) + (v[j].z * v[j].z + v[j].w * v[j].w); }
            float rstd = 1.f / sqrtf(wave_sum(s2) * (1.f / D) + LN_EPS);
            s = 0.f;
#pragma unroll
            for (int j = 0; j < 4; ++j) { const int col = 4 * lane + 256 * j;
                v[j] = v[j] * rstd * *(const f32x4*)(ln1_g + col) + *(const f32x4*)(ln1_b + col);
                *(f32x4*)(x1 + (size_t)row * D + col) = v[j]; s += (v[j].x + v[j].y) + (v[j].z + v[j].w); }
            mean = wave_sum(s) * (1.f / D); s2 = 0.f;
#pragma unroll
            for (int j = 0; j < 4; ++j) { v[j] = v[j] - mean; s2 += (v[j].x * v[j].x + v[j].y * v[j].y) + (v[j].z * v[j].z + v[j].w * v[j].w); }
            rstd = 1.f / sqrtf(wave_sum(s2) * (1.f / D) + LN_EPS);
#pragma unroll
            for (int j = 0; j < 4; ++j) { const int col = 4 * lane + 256 * j;
                const f32x4 u = v[j] * rstd * (*(const f32x4*)(mod + b * 6144 + 4096 + col) + 1.0f) + *(const f32x4*)(mod + b * 6144 + 3072 + col);
                *(unsigned long long*)(u2 + (size_t)row * D + col) = (unsigned long long)pk2(u.x, u.y) | ((unsigned long long)pk2(u.z, u.w) << 32);
                *(unsigned*)(u2f8 + (size_t)row * D + col) = pk4_fp8(u.x, u.y, u.z, u.w); }
        }
    }
}

__device__ __forceinline__ void route_wave(int t, int lane, const float* __restrict__ logits, const f32x4 bias4, int* __restrict__ tope, float* __restrict__ topg, int* __restrict__ cnt) {
    const f32x4 lg = *(const f32x4*)(logits + (size_t)t * NE + 4 * lane);
    float sc[4], v[4];
#pragma unroll
    for (int j = 0; j < 4; ++j) { sc[j] = 1.f / (1.f + __expf(-lg[j])); v[j] = sc[j] + bias4[j]; }
    float m1 = fmaxf(fmaxf(v[0], v[1]), fmaxf(v[2], v[3]));
    float m2; { const float a = fmaxf(v[0], v[1]), b = fminf(v[0], v[1]), c = fmaxf(v[2], v[3]), d = fminf(v[2], v[3]); m2 = fmaxf(fminf(a, c), fmaxf(b, d)); }
#pragma unroll
    for (int o = 1; o < 8; o <<= 1) { const float o1 = __shfl_xor(m1, o), o2 = __shfl_xor(m2, o); const float n1 = fmaxf(m1, o1); m2 = fmaxf(fminf(m1, o1), fmaxf(m2, o2)); m1 = n1; }
    const float gs = m1 + m2; const int myg = lane >> 3; int rank = 0;
#pragma unroll
    for (int gg = 0; gg < 8; ++gg) { const float og = __shfl(gs, gg * 8); rank += (og > gs || (og == gs && gg < myg)) ? 1 : 0; }
    if (rank >= 4) {
#pragma unroll
        for (int j = 0; j < 4; ++j) v[j] = -INFINITY; }
    int myE = 0; float myS = 0.f, gsum = 0.f;
#pragma unroll
    for (int rd = 0; rd < 8; ++rd) {
        float bv = v[0]; int bi = 4 * lane;
#pragma unroll
        for (int j = 1; j < 4; ++j) if (v[j] > bv) { bv = v[j]; bi = 4 * lane + j; }
#pragma unroll
        for (int o = 1; o < 64; o <<= 1) { const float ov = __shfl_xor(bv, o); const int oi = __shfl_xor(bi, o); if (ov > bv || (ov == bv && oi < bi)) { bv = ov; bi = oi; } }
        float ss = 0.f;
#pragma unroll
        for (int j = 0; j < 4; ++j) if (bi == 4 * lane + j) { ss = sc[j]; v[j] = -INFINITY; }
        ss = __shfl(ss, bi >> 2);
        gsum += ss;
        if (lane == rd) { myE = bi; myS = ss; }
    }
    if (lane < 8) { tope[t * 8 + lane] = myE; topg[t * 8 + lane] = myS * (2.5f / gsum); atomicAdd(cnt + myE, 1); }
}
__device__ __forceinline__ void moe_tables(const int* cnt, LAS int* tb, LAS int* nn) {
    if (threadIdx.x < 64) {
        const int lane = threadIdx.x; int n[4], tl[4], loc = 0;
#pragma unroll
        for (int j = 0; j < 4; ++j) { n[j] = cnt[4 * lane + j]; tl[j] = (n[j] + 255) >> 8; loc += tl[j]; }
        int inc = loc;
#pragma unroll
        for (int o = 1; o < 64; o <<= 1) { const int v = __shfl_up(inc, o); if (lane >= o) inc += v; }
        int base = inc - loc;
#pragma unroll
        for (int j = 0; j < 4; ++j) { tb[4 * lane + j] = base; nn[4 * lane + j] = n[j]; base += tl[j]; }
        if (lane == 63) { tb[NE] = base; nn[NE] = T; tb[NEX] = base + T / 256; }
    }
    __syncthreads();
}
__device__ __forceinline__ void ph_final(const MArgs& a, int G) {
    float* out = a.out; const bf16* ys = (const bf16*)(a.ws + WS_YS); const bf16* ysh = (const bf16*)(a.ws + WS_YSH); const float* mod = (const float*)(a.ws + WS_MOD);
    const float* ln2_g = a.in[20]; const float* ln2_b = a.in[21];
    const int tid = threadIdx.x, lane = tid & 63, wave = tid >> 6;
    for (int it = blockIdx.x; it < T / 128; it += G) {
        const int row0 = it * 128, b = row0 / S;
        for (int rr = wave; rr < 128; rr += NWAVES) {
            const int row = row0 + rr;
            f32x4 v[4]; float s = 0.f;
#pragma unroll
            for (int j = 0; j < 4; ++j) { const int col = 4 * lane + 256 * j;
                f32x4 y = ld_bf4(ysh + (size_t)row * D + col);
#pragma unroll
                for (int k = 0; k < 8; ++k) y = y + ld_bf4(ys + ((size_t)row * 8 + k) * D + col);
                v[j] = *(const f32x4*)(out + (size_t)row * D + col) * DN_ALPHA + *(const f32x4*)(mod + b * 6144 + 5120 + col) * y;
                s += (v[j].x + v[j].y) + (v[j].z + v[j].w); }
            const float mean = wave_sum(s) * (1.f / D); float s2 = 0.f;
#pragma unroll
            for (int j = 0; j < 4; ++j) { v[j] = v[j] - mean; s2 += (v[j].x * v[j].x + v[j].y * v[j].y) + (v[j].z * v[j].z + v[j].w * v[j].w); }
            const float rstd = 1.f / sqrtf(wave_sum(s2) * (1.f / D) + LN_EPS);
#pragma unroll
            for (int j = 0; j < 4; ++j) { const int col = 4 * lane + 256 * j;
                *(f32x4*)(out + (size_t)row * D + col) = v[j] * rstd * *(const f32x4*)(ln2_g + col) + *(const f32x4*)(ln2_b + col); }
        }
    }
}


typedef short s16x4 __attribute__((ext_vector_type(4)));
typedef short bf16x8v __attribute__((ext_vector_type(8)));
typedef float f32x16 __attribute__((ext_vector_type(16)));
constexpr int MLP = 320;
constexpr int NCH = S / 64;
constexpr int ST_ELEMS = 129 * 128;
constexpr size_t WS_CHK = WS_GATES + 1 * MiB;
constexpr size_t WS_MPREV = WS_GATES + 1 * MiB + 65536;
constexpr size_t WS_KC = WS_U2;
__device__ __forceinline__ s16x4 tr_read(const LAS unsigned char* p) { return __builtin_bit_cast(s16x4, __builtin_amdgcn_ds_read_tr16_b64_v4i16((LAS s16x4*)p)); }
__device__ __forceinline__ bf16x8v tr_frag(const LAS unsigned char* tile, int row0, int col0, int lane) {
    const int i = lane & 15; const LAS unsigned char* p = tile + (row0 + (i >> 2)) * MLP + (col0 + 4 * (i & 3)) * 2;
    const s16x4 lo = tr_read(p), hi = tr_read(p + 4 * MLP);
    return __builtin_shufflevector(lo, hi, 0, 1, 2, 3, 4, 5, 6, 7);
}
__device__ __forceinline__ bf16x8v tr_frag_perm(const LAS unsigned char* tile, int row0, int col0, int lane) {
    const int i = lane & 15; const LAS unsigned char* p = tile + (row0 + (i >> 2)) * MLP + (col0 + 4 * (i & 3)) * 2;
    const s16x4 lo = tr_read(p), hi = tr_read(p + 8 * MLP);
    return __builtin_shufflevector(lo, hi, 0, 1, 2, 3, 4, 5, 6, 7);
}
__device__ __forceinline__ float wave_incl_sum(float v, int lane) {
#pragma unroll
    for (int o = 1; o < 64; o <<= 1) { const float u = __shfl_up(v, o); if (lane >= o) v += u; }
    return v;
}
__device__ __forceinline__ float wave_incl_max(float v, int lane) {
#pragma unroll
    for (int o = 1; o < 64; o <<= 1) { const float u = __shfl_up(v, o); if (lane >= o) v = fmaxf(v, u); }
    return v;
}
__device__ __forceinline__ float wave_max(float v) {
#pragma unroll
    for (int o = 1; o < 64; o <<= 1) v = fmaxf(v, __shfl_xor(v, o));
    return v;
}
__device__ __forceinline__ void conv8(const bf16* __restrict__ rowp, int spos, const float* __restrict__ cw, const float* __restrict__ cb, float scale, float (&y)[8]) {
    const f32x4 b0 = *(const f32x4*)cb, b1 = *(const f32x4*)(cb + 4);
    y[0] = b0.x; y[1] = b0.y; y[2] = b0.z; y[3] = b0.w; y[4] = b1.x; y[5] = b1.y; y[6] = b1.z; y[7] = b1.w;
#pragma unroll
    for (int j = 0; j < 4; ++j) {
        if (spos - 3 + j >= 0) {
            const v4u xr = *(const v4u*)(rowp + (ptrdiff_t)(j - 3) * NPROJ);
            const f32x4 w0 = *(const f32x4*)(cw + j * 1024), w1 = *(const f32x4*)(cw + j * 1024 + 4);
            y[0] += w0.x * bf2f(xr.x & 0xffffu); y[1] += w0.y * bf2f(xr.x >> 16); y[2] += w0.z * bf2f(xr.y & 0xffffu); y[3] += w0.w * bf2f(xr.y >> 16);
            y[4] += w1.x * bf2f(xr.z & 0xffffu); y[5] += w1.y * bf2f(xr.z >> 16); y[6] += w1.z * bf2f(xr.w & 0xffffu); y[7] += w1.w * bf2f(xr.w >> 16);
        }
    }
#pragma unroll
    for (int e = 0; e < 8; ++e) y[e] = siluf_(y[e]) * scale;
}
__device__ __forceinline__ v4u pack8(const float (&y)[8]) { v4u o; o.x = pk2(y[0], y[1]); o.y = pk2(y[2], y[3]); o.z = pk2(y[4], y[5]); o.w = pk2(y[6], y[7]); return o; }

__device__ __forceinline__ void ml_phaseA(const MArgs& a, LAS unsigned char* lds, int vb0, int nvb) {
    const int tid = threadIdx.x, lane = tid & 63, wave = __builtin_amdgcn_readfirstlane(tid >> 6);
    const bf16* proj = (const bf16*)(a.ws + WS_PROJ); const float* conv_w = a.in[5]; const float* conv_b = a.in[6];
    const float* ipre = (const float*)(a.ws + WS_GATES); const float* logf = ipre + 16 * S;
    bf16* kcg = (bf16*)(a.ws + WS_KC); bf16* st = (bf16*)(a.ws + WS_STATES); float* chk = (float*)(a.ws + WS_CHK);
    LAS unsigned char* Kt = lds; LAS unsigned char* Vt = lds + 64 * MLP; LAS float* wkL = (LAS float*)(lds + 128 * MLP);
    for (int unit = vb0; unit < 16 * NCH; unit += nvb) {
        const int bh = unit >> 7, c = unit & (NCH - 1), b = bh >> 2, h = bh & 3, s0 = c * 64; const size_t row0 = (size_t)b * S + s0;
        if (wave == 0) {
            const float lf = logf[(size_t)bh * S + s0 + lane], ic = ipre[(size_t)bh * S + s0 + lane];
            const float bc = wave_incl_sum(lf, lane), g = ic - bc, gmax = wave_max(g), blast = __shfl(bc, 63);
            wkL[lane] = __expf(g - gmax);
            if (lane == 0) { chk[(size_t)unit * 2] = blast; chk[(size_t)unit * 2 + 1] = blast + gmax; }
        }
#pragma unroll
        for (int q = 0; q < 2; ++q) { const int it = tid + q * NTHR, tt = it >> 4, c8 = it & 15, ch = h * 128 + c8 * 8;
            float y[8]; conv8(proj + (row0 + tt) * NPROJ + C_MLK + ch, s0 + tt, conv_w + 512 + ch, conv_b + 512 + ch, 0.08838834764831845f, y);
            const v4u o = pack8(y);
            *(LAS v4u*)(Kt + tt * MLP + c8 * 16) = o; *(v4u*)(kcg + (row0 + tt) * 512 + ch) = o; }
        __syncthreads();
#pragma unroll
        for (int q = 0; q < 2; ++q) { const int it = tid + q * NTHR, tt = it >> 4, c8 = it & 15;
            const v4u xr = *(const v4u*)(proj + (row0 + tt) * NPROJ + C_MLV + h * 128 + c8 * 8); const float w = wkL[tt];
            float y[8] = {bf2f(xr.x & 0xffffu) * w, bf2f(xr.x >> 16) * w, bf2f(xr.y & 0xffffu) * w, bf2f(xr.y >> 16) * w, bf2f(xr.z & 0xffffu) * w, bf2f(xr.z >> 16) * w, bf2f(xr.w & 0xffffu) * w, bf2f(xr.w >> 16) * w};
            *(LAS v4u*)(Vt + tt * MLP + c8 * 16) = pack8(y); }
        __syncthreads();
        {
            const int dvb = wave >> 1, dkh = wave & 1, hh = lane >> 5, gsel = (lane >> 4) & 1;
            f32x16 acc[2];
#pragma unroll
            for (int nb = 0; nb < 2; ++nb)
#pragma unroll
                for (int i = 0; i < 16; ++i) acc[nb][i] = 0.f;
#pragma unroll
            for (int kk = 0; kk < 4; ++kk) {
                const bf16x8v Bv = tr_frag(Vt, 16 * kk + 8 * hh, 32 * dvb + 16 * gsel, lane);
#pragma unroll
                for (int nb = 0; nb < 2; ++nb) { const bf16x8v Ak = tr_frag(Kt, 16 * kk + 8 * hh, 32 * (2 * dkh + nb) + 16 * gsel, lane);
                    acc[nb] = __builtin_amdgcn_mfma_f32_32x32x16_bf16(Ak, Bv, acc[nb], 0, 0, 0); }
            }
            bf16* stc = st + (size_t)unit * ST_ELEMS;
#pragma unroll
            for (int nb = 0; nb < 2; ++nb)
#pragma unroll
                for (int g4 = 0; g4 < 4; ++g4) { const int dk = 32 * (2 * dkh + nb) + 8 * g4 + 4 * hh, dv = 32 * dvb + (lane & 31);
                    *(unsigned long long*)(stc + (size_t)dv * 128 + dk) = (unsigned long long)pk2(acc[nb][4 * g4], acc[nb][4 * g4 + 1]) | ((unsigned long long)pk2(acc[nb][4 * g4 + 2], acc[nb][4 * g4 + 3]) << 32); }
        }
        if (tid < 128) { float s = 0.f;
#pragma unroll 8
            for (int t = 0; t < 64; ++t) s += wkL[t] * bf2f(*(const LAS unsigned short*)(Kt + t * MLP + tid * 2));
            st[(size_t)unit * ST_ELEMS + 128 * 128 + tid] = (bf16)f2bf(s); }
        __syncthreads();
    }
}

__device__ __forceinline__ void ml_phaseB(const MArgs& a, LAS unsigned char* lds, int vb0, int nvb) {
    const int tid = threadIdx.x;
    bf16* st = (bf16*)(a.ws + WS_STATES); const float* chk = (const float*)(a.ws + WS_CHK); float* mprev = (float*)(a.ws + WS_MPREV);
    LAS float* al = (LAS float*)lds; LAS float* be = al + NCH;
    constexpr int NSL = 16, SLE = ST_ELEMS / NSL;
    for (int item = vb0; item < 16 * NSL; item += nvb) {
        const int bh = item / NSL, sl = item % NSL;
        __syncthreads();
        if (tid == 0) { float m = 0.f;
            for (int c = 0; c < NCH; ++c) { const float bl = chk[(size_t)(bh * NCH + c) * 2], M = chk[(size_t)(bh * NCH + c) * 2 + 1];
                const float mn = fmaxf(bl + m, M); al[c] = __expf(bl + m - mn); be[c] = __expf(M - mn);
                if (sl == 0) mprev[bh * NCH + c] = m;
                m = mn; } }
        __syncthreads();
        if (tid * 4 < SLE) {
            unsigned long long* p = (unsigned long long*)(st + (size_t)bh * NCH * ST_ELEMS + sl * SLE + tid * 4);
            float c0 = 0.f, c1 = 0.f, c2 = 0.f, c3 = 0.f;
            for (int cb = 0; cb < NCH; cb += 16) { unsigned long long d[16];
#pragma unroll
                for (int j = 0; j < 16; ++j) d[j] = p[(size_t)(cb + j) * (ST_ELEMS / 4)];
#pragma unroll
                for (int j = 0; j < 16; ++j) { p[(size_t)(cb + j) * (ST_ELEMS / 4)] = (unsigned long long)pk2(c0, c1) | ((unsigned long long)pk2(c2, c3) << 32);
                    const float A = al[cb + j], Bq = be[cb + j]; const unsigned lo = (unsigned)d[j], hi = (unsigned)(d[j] >> 32);
                    c0 = A * c0 + Bq * bf2f(lo & 0xffffu); c1 = A * c1 + Bq * bf2f(lo >> 16); c2 = A * c2 + Bq * bf2f(hi & 0xffffu); c3 = A * c3 + Bq * bf2f(hi >> 16); } }
        }
    }
}

__device__ __forceinline__ void ml_phaseC(const MArgs& a, LAS unsigned char* lds, int G) {
    const int tid = threadIdx.x, lane = tid & 63, wave = __builtin_amdgcn_readfirstlane(tid >> 6);
    const bf16* proj = (const bf16*)(a.ws + WS_PROJ); const float* conv_w = a.in[5]; const float* conv_b = a.in[6]; const float* norm_g = a.in[8];
    const float* ipre = (const float*)(a.ws + WS_GATES); const float* logf = ipre + 16 * S;
    const bf16* kcg = (const bf16*)(a.ws + WS_KC); const bf16* st = (const bf16*)(a.ws + WS_STATES); const float* mprev = (const float*)(a.ws + WS_MPREV);
    bf16* mix = (bf16*)(a.ws + WS_MIX);
    LAS unsigned char* Qt = lds; LAS unsigned char* Kt = lds + 64 * MLP; LAS unsigned char* Vt = lds + 128 * MLP; LAS unsigned char* Ct = lds + 192 * MLP;
    LAS float* sc = (LAS float*)(lds + 320 * MLP);
    LAS float* gL = sc; LAS float* mmL = sc + 64; LAS float* siL = sc + 128; LAS float* emL = sc + 192; LAS float* npv = sc + 256; LAS float* lnS = sc + 384;
    const int tb = wave >> 2, dvb = wave & 3, r = lane & 31, hh = lane >> 5, gsel = (lane >> 4) & 1;
    for (int unit = blockIdx.x; unit < 16 * NCH; unit += G) {
        const int bh = unit >> 7, c = unit & (NCH - 1), b = bh >> 2, h = bh & 3, s0 = c * 64; const size_t row0 = (size_t)b * S + s0;
        if (wave == 0) {
            const float lf = logf[(size_t)bh * S + s0 + lane], ic = ipre[(size_t)bh * S + s0 + lane], mp = mprev[unit];
            const float bc = wave_incl_sum(lf, lane), g = ic - bc, pm = wave_incl_max(g, lane), mm = fmaxf(mp, pm);
            gL[lane] = g; mmL[lane] = mm; siL[lane] = __expf(mp - mm); emL[lane] = __expf(-(bc + mm));
        }
        const bf16* stc = st + (size_t)unit * ST_ELEMS;
#pragma unroll
        for (int q = 0; q < 2; ++q) { const int it = tid + q * NTHR, tt = it >> 4, c8 = it & 15, ch = h * 128 + c8 * 8;
            float y[8]; conv8(proj + (row0 + tt) * NPROJ + C_MLQ + ch, s0 + tt, conv_w + ch, conv_b + ch, 1.f, y);
            *(LAS v4u*)(Qt + tt * MLP + c8 * 16) = pack8(y);
            *(LAS v4u*)(Kt + tt * MLP + c8 * 16) = *(const v4u*)(kcg + (row0 + tt) * 512 + ch);
            *(LAS v4u*)(Vt + tt * MLP + c8 * 16) = *(const v4u*)(proj + (row0 + tt) * NPROJ + C_MLV + ch); }
#pragma unroll
        for (int q = 0; q < 4; ++q) { const int it = tid + q * NTHR, dv = it >> 4, c8 = it & 15;
            *(LAS v4u*)(Ct + dv * MLP + c8 * 16) = *(const v4u*)(stc + dv * 128 + c8 * 8); }
        if (tid < 128) npv[tid] = bf2f(stc[128 * 128 + tid]);
        __syncthreads();
        bf16x8v qf[8];
#pragma unroll
        for (int kk = 0; kk < 8; ++kk) qf[kk] = *(const LAS bf16x8v*)(Qt + (32 * tb + r) * MLP + (16 * kk + 8 * hh) * 2);
        const float mm_t = mmL[32 * tb + r], si_t = siL[32 * tb + r], em_t = emL[32 * tb + r];
        float nq = 0.f;
#pragma unroll
        for (int kk = 0; kk < 8; ++kk) { const f32x4 n0 = *(const LAS f32x4*)(npv + 16 * kk + 8 * hh), n1 = *(const LAS f32x4*)(npv + 16 * kk + 8 * hh + 4);
            nq += n0.x * bf2f((unsigned short)qf[kk][0]) + n0.y * bf2f((unsigned short)qf[kk][1]) + n0.z * bf2f((unsigned short)qf[kk][2]) + n0.w * bf2f((unsigned short)qf[kk][3])
                + n1.x * bf2f((unsigned short)qf[kk][4]) + n1.y * bf2f((unsigned short)qf[kk][5]) + n1.z * bf2f((unsigned short)qf[kk][6]) + n1.w * bf2f((unsigned short)qf[kk][7]); }
        nq += __shfl_xor(nq, 32);
        f32x16 num;
#pragma unroll
        for (int i = 0; i < 16; ++i) num[i] = 0.f;
#pragma unroll
        for (int kk = 0; kk < 8; ++kk) { const bf16x8v Ac = *(const LAS bf16x8v*)(Ct + (32 * dvb + r) * MLP + (16 * kk + 8 * hh) * 2);
            num = __builtin_amdgcn_mfma_f32_32x32x16_bf16(Ac, qf[kk], num, 0, 0, 0); }
#pragma unroll
        for (int i = 0; i < 16; ++i) num[i] *= si_t;
        float wsum = 0.f;
        for (int sb = 0; sb <= tb; ++sb) {
            f32x16 sT;
#pragma unroll
            for (int i = 0; i < 16; ++i) sT[i] = 0.f;
#pragma unroll
            for (int kk = 0; kk < 8; ++kk) { const bf16x8v Ak = *(const LAS bf16x8v*)(Kt + (32 * sb + r) * MLP + (16 * kk + 8 * hh) * 2);
                sT = __builtin_amdgcn_mfma_f32_32x32x16_bf16(Ak, qf[kk], sT, 0, 0, 0); }
            unsigned wp[8];
#pragma unroll
            for (int g4 = 0; g4 < 4; ++g4) { const f32x4 gv = *(const LAS f32x4*)(gL + 32 * sb + 8 * g4 + 4 * hh);
                float w[4];
#pragma unroll
                for (int e = 0; e < 4; ++e) { const int srow = 32 * sb + 8 * g4 + 4 * hh + e; const bool valid = srow <= 32 * tb + r;
                    w[e] = valid ? sT[4 * g4 + e] * __expf(gv[e] - mm_t) : 0.f; wsum += w[e]; }
                wp[2 * g4] = pk2(w[0], w[1]); wp[2 * g4 + 1] = pk2(w[2], w[3]); }
#pragma unroll
            for (int s2 = 0; s2 < 2; ++s2) {
                const bf16x8v Av = tr_frag_perm(Vt, 32 * sb + 16 * s2 + 4 * hh, 32 * dvb + 16 * gsel, lane);
                v4u bw; bw.x = wp[4 * s2]; bw.y = wp[4 * s2 + 1]; bw.z = wp[4 * s2 + 2]; bw.w = wp[4 * s2 + 3];
                num = __builtin_amdgcn_mfma_f32_32x32x16_bf16(Av, __builtin_bit_cast(bf16x8v, bw), num, 0, 0, 0); }
        }
        wsum += __shfl_xor(wsum, 32);
        const float den = si_t * nq + wsum, rden = 1.f / fmaxf(fabsf(den), em_t);
        float ps = 0.f, pq = 0.f;
#pragma unroll
        for (int i = 0; i < 16; ++i) { num[i] *= rden; ps += num[i]; pq += num[i] * num[i]; }
        ps += __shfl_xor(ps, 32); pq += __shfl_xor(pq, 32);
        if (hh == 0) { lnS[((tb * 4 + dvb) * 32 + r) * 2] = ps; lnS[((tb * 4 + dvb) * 32 + r) * 2 + 1] = pq; }
        __syncthreads();
        float ts = 0.f, tq = 0.f;
#pragma unroll
        for (int d = 0; d < 4; ++d) { ts += lnS[((tb * 4 + d) * 32 + r) * 2]; tq += lnS[((tb * 4 + d) * 32 + r) * 2 + 1]; }
        const float mean = ts * (1.f / 128.f), rstd = 1.f / sqrtf(fmaxf(tq * (1.f / 128.f) - mean * mean, 0.f) + LN_EPS);
        const size_t trow = row0 + 32 * tb + r;
#pragma unroll
        for (int g4 = 0; g4 < 4; ++g4) { const int dv = 32 * dvb + 8 * g4 + 4 * hh;
            const f32x4 ng = *(const f32x4*)(norm_g + h * 128 + dv); const f32x4 og = ld_bf4(proj + trow * NPROJ + C_MLO + h * 128 + dv);
            float o[4];
#pragma unroll
            for (int e = 0; e < 4; ++e) o[e] = (num[4 * g4 + e] - mean) * rstd * ng[e] * sigmoidf_(og[e]);
            *(unsigned long long*)(mix + trow * D + 512 + h * 128 + dv) = (unsigned long long)pk2(o[0], o[1]) | ((unsigned long long)pk2(o[2], o[3]) << 32); }
        __syncthreads();
    }
}


constexpr int VTP = 192;
template <int PITCH> __device__ __forceinline__ bf16x8v tr_frag_perm_p(const LAS unsigned char* tile, int row0, int col0, int lane) {
    const int i = lane & 15; const LAS unsigned char* p = tile + (row0 + (i >> 2)) * PITCH + (col0 + 4 * (i & 3)) * 2;
    const s16x4 lo = tr_read(p), hi = tr_read(p + 8 * PITCH);
    return __builtin_shufflevector(lo, hi, 0, 1, 2, 3, 4, 5, 6, 7);
}
__device__ __forceinline__ void attn_phase(const bf16* __restrict__ proj, bf16* __restrict__ mix, LAS unsigned char* lds, int vb0, int nvb) {
    const int tid = threadIdx.x, lane = tid & 63, wave = __builtin_amdgcn_readfirstlane(tid >> 6);
    const int r = lane & 31, hh = lane >> 5, gsel = (lane >> 4) & 1;
    LAS unsigned char* Vt = lds + wave * (64 * VTP);
    bf16x8v ntri[2], nones;
#pragma unroll
    for (int s2 = 0; s2 < 2; ++s2)
#pragma unroll
        for (int j = 0; j < 8; ++j) { const int k = 16 * s2 + 8 * (j >> 2) + 4 * hh + (j & 3); ntri[s2][j] = (k >= r) ? (short)0xBF80 : (short)0; }
#pragma unroll
    for (int j = 0; j < 8; ++j) nones[j] = (short)0xBF80;
    for (int unit = vb0 * NWAVES + wave; unit < NB * 8 * (S / 32); unit += nvb * NWAVES) {
        const int bh = unit / (S / 32), qb = unit % (S / 32), b = bh >> 3, h = bh & 7, q0 = qb * 32;
        const bf16* base = proj + (size_t)b * S * NPROJ + h * 64;
        bf16x8v qf[4];
#pragma unroll
        for (int s = 0; s < 4; ++s) qf[s] = *(const bf16x8v*)(base + (size_t)(q0 + r) * NPROJ + C_SBQ + 16 * s + 8 * hh);
        f32x16 o[2];
#pragma unroll
        for (int d = 0; d < 2; ++d)
#pragma unroll
            for (int i = 0; i < 16; ++i) o[d][i] = 0.f;
        float carry = 0.f;
        const int qpos = q0 + r;
        for (int k0 = q0 - 32; ; k0 -= 64) {
            bf16x8v kf[2][4];
#pragma unroll
            for (int kb = 0; kb < 2; ++kb) { int key = k0 + 32 * kb + r; key = key < 0 ? 0 : key;
#pragma unroll
                for (int s = 0; s < 4; ++s) kf[kb][s] = *(const bf16x8v*)(base + (size_t)key * NPROJ + C_SBK + 16 * s + 8 * hh); }
#pragma unroll
            for (int i = 0; i < 8; ++i) { int key = k0 + (lane >> 3) + 8 * i; key = key < 0 ? 0 : key;
                *(LAS v4u*)(Vt + ((lane >> 3) + 8 * i) * VTP + (lane & 7) * 16) = *(const v4u*)(base + (size_t)key * NPROJ + C_SBV + (lane & 7) * 8); }
            f32x16 z[2];
#pragma unroll
            for (int kb = 0; kb < 2; ++kb) {
#pragma unroll
                for (int i = 0; i < 16; ++i) z[kb][i] = 0.f;
#pragma unroll
                for (int s = 0; s < 4; ++s) z[kb] = __builtin_amdgcn_mfma_f32_32x32x16_bf16(kf[kb][s], qf[s], z[kb], 0, 0, 0); }
            const bool need_mask = (k0 + 63 >= q0) || (k0 < 0);
            unsigned xp[2][8];
#pragma unroll
            for (int kb = 0; kb < 2; ++kb)
#pragma unroll
                for (int g4 = 0; g4 < 4; ++g4) { float sp[4];
#pragma unroll
                    for (int e = 0; e < 4; ++e) { const float zz = z[kb][4 * g4 + e];
                        float v = fmaxf(zz, 0.f) + __builtin_amdgcn_logf(1.f + __builtin_amdgcn_exp2f(-fabsf(zz)));
                        if (need_mask) { const int key = k0 + 32 * kb + 8 * g4 + 4 * hh + e; v = (key >= 0 && key < qpos) ? v : 0.f; }
                        sp[e] = v; }
                    xp[kb][2 * g4] = pk2(sp[0], sp[1]); xp[kb][2 * g4 + 1] = pk2(sp[2], sp[3]); }
            const float z00 = z[0][0];
#pragma unroll
            for (int s2 = 0; s2 < 2; ++s2) { v4u b1; b1.x = xp[1][4 * s2]; b1.y = xp[1][4 * s2 + 1]; b1.z = xp[1][4 * s2 + 2]; b1.w = xp[1][4 * s2 + 3];
                v4u b0; b0.x = xp[0][4 * s2]; b0.y = xp[0][4 * s2 + 1]; b0.z = xp[0][4 * s2 + 2]; b0.w = xp[0][4 * s2 + 3];
                z[1] = __builtin_amdgcn_mfma_f32_32x32x16_bf16(ntri[s2], __builtin_bit_cast(bf16x8v, b1), z[1], 0, 0, 0);
                z[0] = __builtin_amdgcn_mfma_f32_32x32x16_bf16(ntri[s2], __builtin_bit_cast(bf16x8v, b0), z[0], 0, 0, 0);
                z[0] = __builtin_amdgcn_mfma_f32_32x32x16_bf16(nones, __builtin_bit_cast(bf16x8v, b1), z[0], 0, 0, 0); }
            float tot = z00 - z[0][0];
            tot = __shfl(tot, r);
#pragma unroll
            for (int kb = 0; kb < 2; ++kb)
#pragma unroll
                for (int g4 = 0; g4 < 4; ++g4) { float p[4];
#pragma unroll
                    for (int e = 0; e < 4; ++e) { float v = __builtin_amdgcn_exp2f(z[kb][4 * g4 + e] - carry);
                        if (need_mask) { const int key = k0 + 32 * kb + 8 * g4 + 4 * hh + e; v = (key >= 0 && key < qpos) ? v : 0.f; }
                        p[e] = v; }
                    xp[kb][2 * g4] = pk2(p[0], p[1]); xp[kb][2 * g4 + 1] = pk2(p[2], p[3]); }
#pragma unroll
            for (int kb = 0; kb < 2; ++kb)
#pragma unroll
                for (int s2 = 0; s2 < 2; ++s2) { v4u bp; bp.x = xp[kb][4 * s2]; bp.y = xp[kb][4 * s2 + 1]; bp.z = xp[kb][4 * s2 + 2]; bp.w = xp[kb][4 * s2 + 3];
#pragma unroll
                    for (int d = 0; d < 2; ++d) { const bf16x8v Av = tr_frag_perm_p<VTP>(Vt, 32 * kb + 16 * s2 + 4 * hh, 32 * d + 16 * gsel, lane);
                        o[d] = __builtin_amdgcn_mfma_f32_32x32x16_bf16(Av, __builtin_bit_cast(bf16x8v, bp), o[d], 0, 0, 0); } }
            carry += tot;
            if (k0 <= 0) break;
            if (__all(carry > SB_THRESH)) break;
        }
        bf16* op = mix + (size_t)(b * S + q0 + r) * D + h * 64;
#pragma unroll
        for (int d = 0; d < 2; ++d)
#pragma unroll
            for (int g4 = 0; g4 < 4; ++g4)
                *(unsigned long long*)(op + 32 * d + 8 * g4 + 4 * hh) = (unsigned long long)pk2(o[d][4 * g4], o[d][4 * g4 + 1]) | ((unsigned long long)pk2(o[d][4 * g4 + 2], o[d][4 * g4 + 3]) << 32);
    }
}

__global__ void __launch_bounds__(NTHR, 2) mega_fwd(MArgs args) {
    extern __shared__ __attribute__((aligned(16))) unsigned char lds[];
    LAS unsigned char* ldsl = (LAS unsigned char*)lds;
    const int tid = threadIdx.x, G = gridDim.x;
    volatile LAS unsigned* MISC = (volatile LAS unsigned*)(ldsl + XTRA_OFF + X_MISC);
    LAS int* tb = (LAS int*)(ldsl + XTRA_OFF + X_TB); LAS int* nn = (LAS int*)(ldsl + XTRA_OFF + X_NN);
    for (int u = tid; u < (LDS_BYTES - XTRA_OFF) / 4; u += NTHR) ((LAS unsigned*)(ldsl + XTRA_OFF))[u] = 0u;
    __syncthreads();
    unsigned char* ws = args.ws;
    unsigned* ctl = (unsigned*)(ws + WS_CTL);
    XcdBarrier bar = xcd_barrier_post(ctl + CW_BAR, MISC + 8);
    const int lo = args.ph_lo, hi = args.ph_hi;
#define IN(k) (lo <= (k) && (k) < hi)
#ifndef REP_MASK
#define REP_MASK 0
#endif
#define PHASE(k, ...) do { if (IN(k)) { for (int rep_ = 0; rep_ < (((REP_MASK >> (k)) & 1) ? 2 : 1); ++rep_) { if (rep_) xcd_barrier(bar); __VA_ARGS__ } } if (IN(k) && IN((k) + 1)) xcd_barrier(bar); } while (0)
    int* cnt = (int*)ctl + CW_CNT; i32x2* list = (i32x2*)(ws + WS_ROUTE + 2 * MiB); float* topg = (float*)(ws + WS_ROUTE + 1 * MiB);
    PHASE(0, ph_mod_prep(args, lds, G););
    PHASE(1, ph_ln1(args, lds, G););
    PHASE(2, { pg8::StaticOrder So; So.init(ws + WS_U1, ws + WS_WTIN, T, NPROJ, D, G, blockIdx.x);
        pg8::EpiBf16 E{(bf16*)(ws + WS_PROJ), NPROJ, 2, QSCALE, 1.f / 64.f};
        pg8::gemm_phase<pg8::EpiBf16, pg8::StaticOrder, false, true>(ldsl, D, So, E); });
    PHASE(3, ml_phaseA(args, ldsl, blockIdx.x, G););
    PHASE(4, ml_phaseB(args, ldsl, blockIdx.x, G); __syncthreads(); attn_phase((const bf16*)(ws + WS_PROJ), (bf16*)(ws + WS_MIX), ldsl, blockIdx.x, G););
    PHASE(5, ml_phaseC(args, ldsl, G););
    PHASE(6, { pg8::StaticOrder So; So.init(ws + WS_MIX, ws + WS_WTOUT, T, D, 2 * D, G, blockIdx.x);
        pg8::EpiBf16 E{(bf16*)(ws + WS_MIXOUT), D, 0, 1.f, 1.f};
        pg8::gemm_phase<pg8::EpiBf16, pg8::StaticOrder, false, false>(ldsl, 2 * D, So, E); });
    PHASE(7, ph_ln2(args, G););
    PHASE(8, { pg8::StaticOrder So; So.init(ws + WS_U2, ws + WS_WTR, T, NE, 2 * D, G, blockIdx.x);
        pg8::EpiF32 E{(float*)(ws + WS_LOGITS), NE};
        pg8::gemm_phase<pg8::EpiF32, pg8::StaticOrder, false, false>(ldsl, 2 * D, So, E); });
    PHASE(9, { const int lane_ = tid & 63; const f32x4 bias4 = *(const f32x4*)(args.in[13] + 4 * lane_);
        for (int t = blockIdx.x * NWAVES + (tid >> 6); t < T; t += G * NWAVES) route_wave(t, lane_, (const float*)(ws + WS_LOGITS), bias4, (int*)(ws + WS_ROUTE), topg, cnt); });
    PHASE(10, { moe_tables(cnt, tb, nn); const int* tope = (const int*)(ws + WS_ROUTE); int* fill = (int*)ctl + CW_FILL;
        for (int id = blockIdx.x * NTHR + tid; id < T * TOPK; id += G * NTHR) { const int e = tope[id]; const int pos = atomicAdd(fill + e, 1);
            list[tb[e] * 256 + pos] = (i32x2){id, __float_as_int(topg[id])}; } });
    PHASE(11, { moe_tables(cnt, tb, nn);
        pg8::MoeOrder So{G, (int)blockIdx.x, tb[NEX] * 2, 1, tb, nn, list, (const char*)(ws + WS_U2F8), 0, (const char*)(ws + WS_WT13), (size_t)512 * D, (size_t)256 * D};
        pg8::EpiGlu E{(bf16*)(ws + WS_H), 1.f / 64.f};
        pg8::gemm_phase<pg8::EpiGlu, pg8::MoeOrder, true, true>(ldsl, D, So, E); });
    PHASE(12, { moe_tables(cnt, tb, nn);
        pg8::MoeOrder So{G, (int)blockIdx.x, tb[NEX] * 4, 2, tb, nn, list, (const char*)(ws + WS_H), (size_t)256 * FF * 2, (const char*)(ws + WS_WT2), (size_t)D * FF * 2, (size_t)256 * FF * 2};
        pg8::EpiScatter E{(bf16*)(ws + WS_YS), (bf16*)(ws + WS_YSH), list, nn};
        pg8::gemm_phase<pg8::EpiScatter, pg8::MoeOrder, false, false>(ldsl, 2 * FF, So, E); });
    PHASE(13, ph_final(args, G););
#undef PHASE
#undef IN
}

#ifndef MK_UPTO
#define MK_UPTO 14
#endif
__global__ void k_nan_fill(float* out, int n) { for (int i = blockIdx.x * blockDim.x + threadIdx.x; i < n; i += gridDim.x * blockDim.x) out[i] = __builtin_nanf(""); }
extern "C" void kernel_launch(void* const* d_in, const int* in_sizes, int n_in, void* d_out, int out_size, void* d_ws, size_t ws_size, hipStream_t stream) {
    static int grid = 0;
    if (grid == 0) {
        int dev = 0, cus = 0, per_cu = 0; grid = -1;
        if (n_in != 22 || out_size != T * D || ws_size < WS_END) fprintf(stderr, "kernel_launch: unexpected shapes (n_in %d out %d ws %zu, need %zu)\n", n_in, out_size, ws_size, (size_t)WS_END);
        else if (hipGetDevice(&dev) != hipSuccess || hipDeviceGetAttribute(&cus, hipDeviceAttributeMultiprocessorCount, dev) != hipSuccess) fprintf(stderr, "kernel_launch: device query failed\n");
        else if (hipFuncSetAttribute((const void*)mega_fwd, hipFuncAttributeMaxDynamicSharedMemorySize, LDS_BYTES) != hipSuccess) fprintf(stderr, "kernel_launch: hipFuncSetAttribute failed\n");
        else if (hipOccupancyMaxActiveBlocksPerMultiprocessor(&per_cu, (const void*)mega_fwd, NTHR, LDS_BYTES) != hipSuccess || per_cu < 1) fprintf(stderr, "kernel_launch: occupancy query says %d blocks per CU\n", per_cu);
        else grid = cus;
        (void)hipGetLastError();
    }
    if (grid < 0) { k_nan_fill<<<1024, 256, 0, stream>>>((float*)d_out, out_size); return; }
    const float* x = (const float*)d_in[0];
    const float* conv_w = (const float*)d_in[5]; const float* conv_b = (const float*)d_in[6];
    const float* norm_g = (const float*)d_in[8]; const float* ln1_g = (const float*)d_in[10]; const float* ln1_b = (const float*)d_in[11];
    const float* rbias = (const float*)d_in[13]; const float* ln2_g = (const float*)d_in[20]; const float* ln2_b = (const float*)d_in[21];
    char* ws = (char*)d_ws; float* out = (float*)d_out;
    float* mod = (float*)(ws + WS_MOD); bf16* wtin = (bf16*)(ws + WS_WTIN); bf16* wtout = (bf16*)(ws + WS_WTOUT); bf16* wtr = (bf16*)(ws + WS_WTR);
    bf16* wt13 = (bf16*)(ws + WS_WT13); bf16* wt2 = (bf16*)(ws + WS_WT2); int* plan = (int*)(ws + WS_PLAN);
    bf16* u1 = (bf16*)(ws + WS_U1); bf16* proj = (bf16*)(ws + WS_PROJ); float* ipre = (float*)(ws + WS_GATES); float* logf = ipre + 16 * S;
    float* hraw = (float*)(ws + WS_HRAW); bf16* mix = (bf16*)(ws + WS_MIX); bf16* mixout = (bf16*)(ws + WS_MIXOUT); bf16* u2 = (bf16*)(ws + WS_U2);
    float* logits = (float*)(ws + WS_LOGITS); int* tope = (int*)(ws + WS_ROUTE); float* topg = (float*)(ws + WS_ROUTE + 1 * MiB); i32x2* list = (i32x2*)(ws + WS_ROUTE + 2 * MiB);
    bf16* H = (bf16*)(ws + WS_H); bf16* ys = (bf16*)(ws + WS_YS); bf16* ysh = (bf16*)(ws + WS_YSH);
    int* cnt = (int*)(ws + WS_CTL) + CW_CNT;
    (void)hipMemsetAsync(ws + WS_CTL, 0, 1 * MiB, stream);
    if (MK_UPTO > 0) {
        MArgs a{};
        for (int i = 0; i < 22; ++i) a.in[i] = (const float*)d_in[i];
        a.out = out; a.ws = (unsigned char*)d_ws; a.ph_lo = 0; a.ph_hi = MK_UPTO;
        hipLaunchKernelGGL(mega_fwd, dim3(grid), dim3(NTHR), LDS_BYTES, stream, a);
    }
}
```

```cpp
#include <hip/hip_runtime.h>
#include <cstdio>
#include <cstdint>

typedef unsigned short bf16;
typedef unsigned v4u __attribute__((ext_vector_type(4)));
typedef float f32x4 __attribute__((ext_vector_type(4)));
typedef int i32x2 __attribute__((ext_vector_type(2)));

constexpr int D = 1024, NB = 4, S = 8192, T = NB * S;
constexpr int NPROJ = 3584, WIN_LD = 3592;
constexpr int C_SBQ = 0, C_SBK = 512, C_SBV = 1024, C_MLQ = 1536, C_MLK = 2048, C_MLV = 2560, C_MLO = 3072, C_GATE = 3584;
constexpr int NE = 256, NEX = 257, TOPK = 8, FF = 256;
constexpr float LN_EPS = 1e-5f;
constexpr float DN_ALPHA = 1.189207115002721f;
constexpr float LOG2E = 1.4426950408889634f;
constexpr float QSCALE = 0.125f * LOG2E;
constexpr float SB_THRESH = 48.0f;

constexpr size_t MiB = 1u << 20;
constexpr size_t WS_CTL = 0;
constexpr size_t WS_MOD = 1 * MiB;
constexpr size_t WS_WTIN = 2 * MiB;
constexpr size_t WS_WTOUT = 10 * MiB;
constexpr size_t WS_WTR = 12 * MiB;
constexpr size_t WS_PLAN = 13 * MiB;
constexpr size_t WS_WT2 = 16 * MiB;
constexpr size_t WS_YS = 145 * MiB;
constexpr size_t WS_WT13 = 145 * MiB;
constexpr size_t WS_U2F8 = 274 * MiB;
constexpr size_t WS_PROJ = 402 * MiB;
constexpr size_t WS_GATES = 626 * MiB;
constexpr size_t WS_H = 657 * MiB;
constexpr size_t WS_STATES = 657 * MiB;
constexpr size_t WS_MIXOUT = 657 * MiB;
constexpr size_t WS_LOGITS = 657 * MiB;
constexpr size_t WS_U1 = 725 * MiB;
constexpr size_t WS_MIX = 725 * MiB;
constexpr size_t WS_U2 = 833 * MiB;
constexpr size_t WS_YSH = 833 * MiB;
constexpr size_t WS_HRAW = 833 * MiB;
constexpr size_t WS_ROUTE = 897 * MiB;
constexpr size_t WS_END = 902 * MiB;
constexpr int CW_CNT = 1024;
constexpr int CW_FILL = 1536;
constexpr int PL_SLOT = 0, PL_T64 = 512, PL_T256 = 1024;

__device__ __forceinline__ unsigned f2bf(float f) { unsigned u = __builtin_bit_cast(unsigned, f); return (u + 0x7fffu + ((u >> 16) & 1u)) >> 16; }
__device__ __forceinline__ float bf2f(unsigned b) { return __builtin_bit_cast(float, b << 16); }
__device__ __forceinline__ unsigned pk2(float lo, float hi) { return f2bf(lo) | (f2bf(hi) << 16); }
__device__ __forceinline__ unsigned pk4_fp8(float a, float b, float c, float d) { int w = 0; w = __builtin_amdgcn_cvt_pk_fp8_f32(a, b, w, false); w = __builtin_amdgcn_cvt_pk_fp8_f32(c, d, w, true); return (unsigned)w; }
__device__ __forceinline__ float wave_sum(float v) {
    v += __builtin_bit_cast(float, __builtin_amdgcn_update_dpp(0, __builtin_bit_cast(int, v), 0xB1, 0xF, 0xF, true));
    v += __builtin_bit_cast(float, __builtin_amdgcn_update_dpp(0, __builtin_bit_cast(int, v), 0x4E, 0xF, 0xF, true));
    v += __builtin_bit_cast(float, __builtin_amdgcn_update_dpp(0, __builtin_bit_cast(int, v), 0x141, 0xF, 0xF, true));
    v += __builtin_bit_cast(float, __builtin_amdgcn_update_dpp(0, __builtin_bit_cast(int, v), 0x140, 0xF, 0xF, true));
    const int iv = __builtin_bit_cast(int, v);
    const float r0 = __builtin_bit_cast(float, __builtin_amdgcn_readlane(iv, 0)), r1 = __builtin_bit_cast(float, __builtin_amdgcn_readlane(iv, 16));
    const float r2 = __builtin_bit_cast(float, __builtin_amdgcn_readlane(iv, 32)), r3 = __builtin_bit_cast(float, __builtin_amdgcn_readlane(iv, 48));
    return (r0 + r1) + (r2 + r3);
}
__device__ __forceinline__ float sigmoidf_(float x) { return 1.f / (1.f + __expf(-x)); }
__device__ __forceinline__ float siluf_(float x) { return x / (1.f + __expf(-x)); }


struct PrepArgs { const float *w_in, *w_out, *w_router, *w1, *w3, *w2, *sw1, *sw3, *sw2; unsigned char* wtin; bf16 *wtout, *wtr; unsigned char* wt13; bf16* wt2; };
struct PrepDesc { const float* src; unsigned char* dst; int ldw, ldt, k0, n0, rowmap, f8; };
constexpr int IT_IN = 16 * 56, IT_OUT = 16 * 16, IT_R = 16 * 4, IT_E = 192, IT_TOTAL = IT_IN + IT_OUT + IT_R + NEX * IT_E;
__device__ __forceinline__ PrepDesc prep_decode(const PrepArgs& a, int it) {
    if (it < IT_IN) return PrepDesc{a.w_in, a.wtin, WIN_LD, D, (it / 112) * 128, (it % 112) * 32, 0, 1}; it -= IT_IN;
    if (it < IT_OUT) return PrepDesc{a.w_out, (unsigned char*)a.wtout, D, D, (it / 16) * 64, (it % 16) * 64, 0, 0}; it -= IT_OUT;
    if (it < IT_R) return PrepDesc{a.w_router, (unsigned char*)a.wtr, NE, D, (it / 4) * 64, (it % 4) * 64, 0, 0}; it -= IT_R;
    const int e = it / IT_E, r = it % IT_E;
    if (r < 64) return PrepDesc{e < NE ? a.w1 + (size_t)e * D * FF : a.sw1, a.wt13 + (size_t)e * 512 * D, FF, D, (r / 8) * 128, (r % 8) * 32, 1, 1};
    if (r < 128) { const int q = r - 64; return PrepDesc{e < NE ? a.w3 + (size_t)e * D * FF : a.sw3, a.wt13 + (size_t)e * 512 * D, FF, D, (q / 8) * 128, (q % 8) * 32, 2, 1}; }
    const int q = r - 128; return PrepDesc{e < NE ? a.w2 + (size_t)e * FF * D : a.sw2, (unsigned char*)(a.wt2 + (size_t)e * D * FF), D, FF, (q / 16) * 64, (q % 16) * 64, 0, 0};
}
__device__ __forceinline__ void prep_load(const PrepDesc& d, int lane, f32x4 (&v)[16]) {
    const int g = d.f8 ? (lane >> 3) : (lane >> 4), i = d.f8 ? (lane & 7) : (lane & 15);
#pragma unroll
    for (int r = 0; r < 16; ++r) v[r] = __builtin_nontemporal_load((const f32x4*)(d.src + (size_t)(d.k0 + 16 * g + r) * d.ldw + d.n0 + 4 * i));
}
__device__ __forceinline__ void prep_store(const PrepDesc& d, int lane, const f32x4 (&v)[16]) {
    const int g = d.f8 ? (lane >> 3) : (lane >> 4), i = d.f8 ? (lane & 7) : (lane & 15);
#pragma unroll
    for (int nn = 0; nn < 4; ++nn) {
        const int n = d.n0 + 4 * i + nn;
        const int dr = d.rowmap == 0 ? n : ((n >> 7) * 256 + (d.rowmap == 2 ? 128 : 0) + (n & 127));
        if (d.f8) {
            v4u o; o.x = pk4_fp8(v[0][nn] * 64.f, v[1][nn] * 64.f, v[2][nn] * 64.f, v[3][nn] * 64.f); o.y = pk4_fp8(v[4][nn] * 64.f, v[5][nn] * 64.f, v[6][nn] * 64.f, v[7][nn] * 64.f);
            o.z = pk4_fp8(v[8][nn] * 64.f, v[9][nn] * 64.f, v[10][nn] * 64.f, v[11][nn] * 64.f); o.w = pk4_fp8(v[12][nn] * 64.f, v[13][nn] * 64.f, v[14][nn] * 64.f, v[15][nn] * 64.f);
            *(v4u*)(d.dst + (size_t)dr * d.ldt + d.k0 + 16 * g) = o;
        } else {
            v4u o0, o1; o0.x = pk2(v[0][nn], v[1][nn]); o0.y = pk2(v[2][nn], v[3][nn]); o0.z = pk2(v[4][nn], v[5][nn]); o0.w = pk2(v[6][nn], v[7][nn]);
            o1.x = pk2(v[8][nn], v[9][nn]); o1.y = pk2(v[10][nn], v[11][nn]); o1.z = pk2(v[12][nn], v[13][nn]); o1.w = pk2(v[14][nn], v[15][nn]);
            v4u* dp = (v4u*)((bf16*)d.dst + (size_t)dr * d.ldt + d.k0 + 16 * g); dp[0] = o0; dp[1] = o1;
        }
    }
}
__device__ __forceinline__ void prep_run(const PrepArgs& a, int it0, int stride, int lane) {
    int it = it0; if (it >= IT_TOTAL) return;
    PrepDesc dA = prep_decode(a, it), dB = dA; f32x4 va[16], vb[16]; prep_load(dA, lane, va);
    for (;;) {
        const int itB = it + stride; const bool hasB = itB < IT_TOTAL;
        if (hasB) { dB = prep_decode(a, itB); prep_load(dB, lane, vb); }
        prep_store(dA, lane, va);
        if (!hasB) break;
        const int itA = itB + stride; const bool hasA = itA < IT_TOTAL;
        if (hasA) { dA = prep_decode(a, itA); prep_load(dA, lane, va); }
        prep_store(dB, lane, vb);
        if (!hasA) break;
        it = itA;
    }
}


__device__ __forceinline__ f32x4 ld_bf4(const bf16* p) { const unsigned long long w = *(const unsigned long long*)p;
    return (f32x4){bf2f((unsigned)w & 0xffffu), bf2f(((unsigned)w) >> 16), bf2f((unsigned)(w >> 32) & 0xffffu), bf2f((unsigned)(w >> 48))}; }

#define LAS __attribute__((address_space(3)))
#define GAS __attribute__((address_space(1)))
namespace pg8 {
typedef short bf16x8 __attribute__((ext_vector_type(8)));
constexpr int F8_SCALE_W = 121;
constexpr int BM = 256, BK = 64, HALF = 128, HTB = HALF * BK * 2, STAGE_BYTES = 8 * HTB, NXCD = 8, WGM = 8;
__host__ __device__ __forceinline__ int lds_byte(int r, int c) { const int st = (r >> 4) * 2 + (c >> 5), rr = r & 15, cc = c & 31, ob = rr * 64 + cc * 2; return st * 1024 + (ob ^ (((ob >> 9) & 1) << 5)); }
__host__ __device__ __forceinline__ void stage_rc(int b, int& R, int& C) { const int st = b / 1024, sb = b % 1024, swz = sb ^ (((sb >> 9) & 1) << 5); R = (st >> 1) * 16 + swz / 64; C = (st & 1) * 32 + (swz % 64) / 2; }
__host__ __device__ __forceinline__ int perm32(int rho) { const int n = rho >> 4, i = rho & 15; return 8 * (i >> 2) + 4 * n + (i & 3); }

struct Unit { int pm, pn, e, mt; const char* A; const char* B; };

__device__ __forceinline__ long unit_index(int i, int G, int c) { return (G % 8 == 0) ? ((long)(i * 8 + (c & 7)) * (G / 8) + (c >> 3)) : ((long)i * G + c); }

struct StaticOrder {
    int nM, nN, nwg, G, c; const char* A; const char* B; size_t tstep;
    __device__ void init(const void* A_, const void* B_, int M, int N, int Kb, int G_, int c_) { nM = M / BM; nN = N / BM; nwg = nM * nN; G = G_; c = c_; A = (const char*)A_; B = (const char*)B_; tstep = (size_t)BM * Kb; }
    __device__ __forceinline__ bool next(int i, Unit& u) const {
        const long L = (long)i * G + c; if (L >= nwg) return false;
        int wgid = (int)L; { const int q = nwg / NXCD, r = nwg % NXCD, xcd = wgid % NXCD, off = wgid / NXCD; wgid = (xcd < r ? xcd * (q + 1) : r * (q + 1) + (xcd - r) * q) + off; }
        const int nig = WGM * nN, gid = wgid / nig, fm = gid * WGM, gsz = (nM - fm) < WGM ? (nM - fm) : WGM;
        u.pm = fm + ((wgid % nig) % gsz); u.pn = (wgid % nig) / gsz; u.e = 0; u.mt = u.pm; u.A = A + (size_t)u.pm * tstep; u.B = B + (size_t)u.pn * tstep; return true;
    }
    __device__ __forceinline__ int row_token(const Unit&, int) const { return 0; }
};

struct MoeOrder {
    int G, c, total, shift; const LAS int* tb; const LAS int* nn; const i32x2* list;
    const char* Abase; size_t a_tile_stride; const char* Bbase; size_t b_exp_stride, b_pn_stride;
    __device__ __forceinline__ bool next(int i, Unit& u) const {
        const long L = unit_index(i, G, c); if (L >= total) return false;
        const int tile = (int)(L >> shift); u.pn = (int)(L & ((1 << shift) - 1));
        int lo = 0, hi = NEX; while (hi - lo > 1) { const int mid = (lo + hi) >> 1; if (tb[mid] <= tile) lo = mid; else hi = mid; }
        u.e = lo; u.mt = tile - tb[lo]; u.pm = tile;
        u.A = Abase + (size_t)tile * a_tile_stride; u.B = Bbase + (size_t)lo * b_exp_stride + (size_t)u.pn * b_pn_stride; return true;
    }
    __device__ __forceinline__ int row_token(const Unit& u, int row) const {
        const int rr = u.mt * 256 + row;
        const int tok = list[u.pm * 256 + row].x >> 3;
        return u.e >= NE ? rr : (rr < nn[u.e] ? tok : 0);
    }
};

__device__ __forceinline__ unsigned cvt_pk_bf16(float lo, float hi) { unsigned r; asm volatile("v_cvt_pk_bf16_f32 %0, %1, %2" : "=v"(r) : "v"(lo), "v"(hi)); return r; }

struct EpiBf16 {
    static constexpr bool PERM = true; bf16* O; int ldc; int scale_tiles; float scale; float gscale;
    __device__ __forceinline__ void operator()(const f32x4 (&acc)[2][2][4][2], const Unit& u, int wr, int wc, int fr, int fq) const {
        const int row0 = u.pm * BM + wr * 64 + fr, col0 = u.pn * BM + wc * 32 + 8 * fq; const float sc = (u.pn < scale_tiles ? scale : 1.f) * gscale;
#pragma unroll
        for (int ai = 0; ai < 2; ++ai)
#pragma unroll
            for (int m = 0; m < 4; ++m) { bf16* rowp = O + (size_t)(row0 + ai * HALF + m * 16) * ldc + col0;
#pragma unroll
                for (int bj = 0; bj < 2; ++bj) { const f32x4 v0 = acc[ai][bj][m][0] * sc, v1 = acc[ai][bj][m][1] * sc;
                    v4u w; w.x = cvt_pk_bf16(v0[0], v0[1]); w.y = cvt_pk_bf16(v0[2], v0[3]); w.z = cvt_pk_bf16(v1[0], v1[1]); w.w = cvt_pk_bf16(v1[2], v1[3]);
                    *(v4u*)(rowp + bj * HALF) = w; } }
    }
};
struct EpiF32 {
    static constexpr bool PERM = false; float* C; int ldc;
    __device__ __forceinline__ void operator()(const f32x4 (&acc)[2][2][4][2], const Unit& u, int wr, int wc, int fr, int fq) const {
        const int row0 = u.pm * BM + wr * 64 + fr, col0 = u.pn * BM + wc * 32 + 4 * fq;
#pragma unroll
        for (int ai = 0; ai < 2; ++ai)
#pragma unroll
            for (int m = 0; m < 4; ++m) { float* rowp = C + (size_t)(row0 + ai * HALF + m * 16) * ldc + col0;
#pragma unroll
                for (int bj = 0; bj < 2; ++bj)
#pragma unroll
                    for (int n = 0; n < 2; ++n) *(f32x4*)(rowp + bj * HALF + n * 16) = acc[ai][bj][m][n]; }
    }
};
struct EpiGlu {
    static constexpr bool PERM = true; bf16* H; float gscale;
    __device__ __forceinline__ void operator()(const f32x4 (&acc)[2][2][4][2], const Unit& u, int wr, int wc, int fr, int fq) const {
        const int row0 = u.pm * BM + wr * 64 + fr, col0 = u.pn * HALF + wc * 32 + 8 * fq;
#pragma unroll
        for (int ai = 0; ai < 2; ++ai)
#pragma unroll
            for (int m = 0; m < 4; ++m) { float h[8];
#pragma unroll
                for (int n = 0; n < 2; ++n)
#pragma unroll
                    for (int q = 0; q < 4; ++q) { const float a = acc[ai][0][m][n][q] * gscale; h[n * 4 + q] = a * __builtin_amdgcn_rcpf(1.f + __expf(-a)) * (acc[ai][1][m][n][q] * gscale); }
                v4u w; w.x = cvt_pk_bf16(h[0], h[1]); w.y = cvt_pk_bf16(h[2], h[3]); w.z = cvt_pk_bf16(h[4], h[5]); w.w = cvt_pk_bf16(h[6], h[7]);
                *(v4u*)(H + (size_t)(row0 + ai * HALF + m * 16) * FF + col0) = w; }
    }
};
struct EpiScatter {
    static constexpr bool PERM = true; bf16* ys; bf16* ysh; const i32x2* list; const LAS int* nn;
    __device__ __forceinline__ void operator()(const f32x4 (&acc)[2][2][4][2], const Unit& u, int wr, int wc, int fr, int fq) const {
        const int col0 = u.pn * BM + wc * 32 + 8 * fq; const int n = nn[u.e]; const bool routed = u.e < NE;
        const i32x2* lp = list + (size_t)(u.pm - u.mt) * 256;
#pragma unroll
        for (int ai = 0; ai < 2; ++ai) {
            i32x2 en[4];
#pragma unroll
            for (int m = 0; m < 4; ++m) { const int rr = u.mt * 256 + ai * HALF + wr * 64 + m * 16 + fr; const i32x2 ld = lp[rr];
                en[m].x = routed ? ld.x : rr; en[m].y = routed ? ld.y : 0x3f800000; }
#pragma unroll
            for (int m = 0; m < 4; ++m) { const int rr = u.mt * 256 + ai * HALF + wr * 64 + m * 16 + fr;
                if (rr < n) { bf16* dst = (routed ? ys : ysh) + (size_t)en[m].x * D + col0; const float g = __int_as_float(en[m].y);
#pragma unroll
                    for (int bj = 0; bj < 2; ++bj) { const f32x4 v0 = acc[ai][bj][m][0] * g, v1 = acc[ai][bj][m][1] * g;
                        v4u w; w.x = cvt_pk_bf16(v0[0], v0[1]); w.y = cvt_pk_bf16(v0[2], v0[3]); w.z = cvt_pk_bf16(v1[0], v1[1]); w.w = cvt_pk_bf16(v1[2], v1[3]);
                        *(v4u*)(dst + bj * HALF) = w; } } }
            __builtin_amdgcn_sched_barrier(0);
        }
    }
};

typedef int i32x8 __attribute__((ext_vector_type(8)));
typedef int i32x4 __attribute__((ext_vector_type(4)));
template <bool FP8> struct FragT { struct A4 { bf16x8 v[4][2]; }; struct B2 { bf16x8 v[2][2]; }; };
template <> struct FragT<true> { struct A4 { i32x8 v[4]; }; struct B2 { i32x8 v[2]; }; };
template <class Epi, class Sched, bool GATHER, bool FP8>
__device__ __forceinline__ void gemm_phase(LAS unsigned char* lds, const int Kb, const Sched& S, const Epi& E) {
    const int tid = threadIdx.x, wid = __builtin_amdgcn_readfirstlane(tid >> 6), lane = tid & 63, wr = wid >> 2, wc = wid & 3, fr = lane & 15, fq = lane >> 4;
    const int nt = Kb / 128;
    int sR[2], sC[2];
    unsigned voffA[2], voffB[2];
#pragma unroll
    for (int i = 0; i < 2; ++i) { stage_rc(tid * 16 + i * 8192, sR[i], sC[i]); const int Rb = Epi::PERM ? ((sR[i] & ~31) + perm32(sR[i] & 31)) : sR[i];
        voffA[i] = (unsigned)(sR[i] * Kb + sC[i] * 2); voffB[i] = (unsigned)(Rb * Kb + sC[i] * 2); }
    const size_t kstep = (size_t)(BK * 2);
    const size_t hstep = (size_t)HALF * Kb;
    const unsigned ldsw = (unsigned)wid * 1024u;
    const int aoff = lds_byte(wr * 64 + fr, fq * 8), boff = lds_byte(wc * 32 + fr, fq * 8);
    unsigned gc[2][2], gn[2][2];
#define PG8_SA(b, h) (((b) * 2 + (h)) * HTB)
#define PG8_SB(b, h) ((4 + (b) * 2 + (h)) * HTB)
#define PG8_GLDS(src, bufoff, i) __builtin_amdgcn_global_load_lds((const unsigned*)(src), (LAS unsigned*)(lds + (bufoff) + ldsw + (i) * 8192), 16, 0, 0)
#define PG8_STAGE_B(bufoff, gbase) do { PG8_GLDS((const char*)(gbase) + voffB[0], bufoff, 0); PG8_GLDS((const char*)(gbase) + voffB[1], bufoff, 1); } while (0)
#define PG8_STAGE_A(bufoff, gbase, h, nx) do { if constexpr (GATHER) { const unsigned _o0 = (nx) ? gn[h][0] : gc[h][0], _o1 = (nx) ? gn[h][1] : gc[h][1]; \
            PG8_GLDS((const char*)(gbase) + _o0, bufoff, 0); PG8_GLDS((const char*)(gbase) + _o1, bufoff, 1); } \
        else { PG8_GLDS((const char*)(gbase) + (h) * hstep + voffA[0], bufoff, 0); PG8_GLDS((const char*)(gbase) + (h) * hstep + voffA[1], bufoff, 1); } } while (0)
#define PG8_LD2(dstv, p) do { if constexpr (FP8) { const i32x4 _lo = *(const LAS i32x4*)(p), _hi = *(const LAS i32x4*)((p) + 1024); dstv = __builtin_shufflevector(_lo, _hi, 0, 1, 2, 3, 4, 5, 6, 7); } } while (0)
#define PG8_LDA(dst, b, h) do { _Pragma("unroll") for (int m = 0; m < 4; ++m) { if constexpr (FP8) { PG8_LD2(dst.v[m], lds + PG8_SA(b, h) + aoff + m * 2048); } \
        else { _Pragma("unroll") for (int k = 0; k < 2; ++k) dst.v[m][k] = *(const LAS bf16x8*)(lds + PG8_SA(b, h) + aoff + m * 2048 + k * 1024); } } } while (0)
#define PG8_LDB(dst, b, h) do { _Pragma("unroll") for (int n = 0; n < 2; ++n) { if constexpr (FP8) { PG8_LD2(dst.v[n], lds + PG8_SB(b, h) + boff + n * 2048); } \
        else { _Pragma("unroll") for (int k = 0; k < 2; ++k) dst.v[n][k] = *(const LAS bf16x8*)(lds + PG8_SB(b, h) + boff + n * 2048 + k * 1024); } } } while (0)
#define PG8_MMA(ai, bj, At, Bt) do { __builtin_amdgcn_s_setprio(1); _Pragma("unroll") for (int m = 0; m < 4; ++m) _Pragma("unroll") for (int n = 0; n < 2; ++n) { \
        if constexpr (FP8) asm volatile("s_nop 1\n\tv_mfma_scale_f32_16x16x128_f8f6f4 %0, %1, %2, %0, %3, %3 op_sel_hi:[0,0,0]" : "+v"(acc[ai][bj][m][n]) : "v"(Bt.v[n]), "v"(At.v[m]), "v"(f8scale)); \
        else { _Pragma("unroll") for (int k = 0; k < 2; ++k) acc[ai][bj][m][n] = __builtin_amdgcn_mfma_f32_16x16x32_bf16(Bt.v[n][k], At.v[m][k], acc[ai][bj][m][n], 0, 0, 0); } } \
        __builtin_amdgcn_s_setprio(0); } while (0)
#define PG8_WAIT_V(n) asm volatile("s_waitcnt vmcnt(" #n ")" ::: "memory")
#define PG8_WAIT_L(n) asm volatile("s_waitcnt lgkmcnt(" #n ")" ::: "memory")
#define PG8_BAR __builtin_amdgcn_s_barrier()
#define PG8_SCHED __builtin_amdgcn_sched_barrier(0)
#define PG8_GATHER(dst, u) do { _Pragma("unroll") for (int _h = 0; _h < 2; ++_h) _Pragma("unroll") for (int _i = 0; _i < 2; ++_i) \
        dst[_h][_i] = (unsigned)(S.row_token(u, _h * HALF + sR[_i]) * Kb + sC[_i] * 2); } while (0)
    Unit cur, nxt; int ui = 0;
    if (!S.next(0, cur)) return;
    f32x4 acc[2][2][4][2];
#pragma unroll
    for (int a = 0; a < 2; ++a)
#pragma unroll
        for (int b = 0; b < 2; ++b)
#pragma unroll
            for (int m = 0; m < 4; ++m)
#pragma unroll
                for (int n = 0; n < 2; ++n) acc[a][b][m][n] = (f32x4){0.f, 0.f, 0.f, 0.f};
    const int f8scale = 0x7f7f7f7f;
    typedef typename FragT<FP8>::A4 FragA; typedef typename FragT<FP8>::B2 FragB;
    FragA At; FragB B0, B1;
    const char* cA = cur.A; const char* cB = cur.B;
    if constexpr (GATHER) { PG8_GATHER(gc, cur); }
    PG8_STAGE_B(PG8_SB(0, 0), cB); PG8_STAGE_A(PG8_SA(0, 0), cA, 0, false); PG8_STAGE_B(PG8_SB(0, 1), cB + hstep); PG8_STAGE_A(PG8_SA(0, 1), cA, 1, false);
    if (wr == 1) PG8_BAR;
    PG8_WAIT_V(4); PG8_BAR;
    PG8_STAGE_B(PG8_SB(1, 0), cB + kstep); PG8_STAGE_A(PG8_SA(1, 0), cA + kstep, 0, false); PG8_STAGE_B(PG8_SB(1, 1), cB + hstep + kstep);
    PG8_WAIT_V(6); PG8_BAR;
    for (;;) {
        const bool has_next = S.next(ui + 1, nxt);
        const char* nA = has_next ? nxt.A : cA; const char* nB = has_next ? nxt.B : cB;
        if constexpr (GATHER) { if (has_next) { PG8_GATHER(gn, nxt); } else {
#pragma unroll
            for (int h = 0; h < 2; ++h) { gn[h][0] = gc[h][0]; gn[h][1] = gc[h][1]; } } }
#pragma unroll 1
        for (int t = 0; t < nt; t += 2) {
            const bool last = (t == nt - 2);
            const char* a1 = cA + (size_t)(t + 1) * kstep;
            const char* a2 = last ? nA : cA + (size_t)(t + 2) * kstep; const char* b2 = last ? nB : cB + (size_t)(t + 2) * kstep;
            const char* a3 = a2 + kstep; const char* b3 = b2 + kstep;
            PG8_LDB(B0, 0, 0); PG8_SCHED; PG8_LDA(At, 0, 0); PG8_STAGE_A(PG8_SA(1, 1), a1, 1, false);
            PG8_WAIT_L(8); PG8_BAR; PG8_WAIT_L(0); PG8_MMA(0, 0, At, B0); PG8_BAR; PG8_SCHED;
            PG8_LDB(B1, 0, 1); PG8_STAGE_B(PG8_SB(0, 0), b2);
            PG8_BAR; PG8_WAIT_L(0); PG8_MMA(0, 1, At, B1); PG8_BAR;
            PG8_LDA(At, 0, 1); PG8_STAGE_A(PG8_SA(0, 0), a2, 0, last);
            PG8_BAR; PG8_WAIT_L(0); PG8_MMA(1, 0, At, B0); PG8_BAR; PG8_SCHED;
            PG8_STAGE_B(PG8_SB(0, 1), b2 + hstep);
            PG8_WAIT_V(6); PG8_BAR; PG8_MMA(1, 1, At, B1); PG8_BAR;
            PG8_LDB(B0, 1, 0); PG8_SCHED; PG8_LDA(At, 1, 0); PG8_STAGE_A(PG8_SA(0, 1), a2, 1, last);
            PG8_WAIT_L(8); PG8_BAR; PG8_WAIT_L(0); PG8_MMA(0, 0, At, B0); PG8_BAR; PG8_SCHED;
            PG8_LDB(B1, 1, 1); PG8_STAGE_B(PG8_SB(1, 0), b3);
            PG8_BAR; PG8_WAIT_L(0); PG8_MMA(0, 1, At, B1); PG8_BAR;
            PG8_LDA(At, 1, 1); PG8_STAGE_A(PG8_SA(1, 0), a3, 0, last);
            PG8_BAR; PG8_WAIT_L(0); PG8_MMA(1, 0, At, B0); PG8_BAR; PG8_SCHED;
            PG8_STAGE_B(PG8_SB(1, 1), b3 + hstep);
            PG8_WAIT_V(6); PG8_BAR; PG8_MMA(1, 1, At, B1); PG8_BAR;
        }
        if (wr == 0) PG8_BAR;
        if constexpr (FP8) { __builtin_amdgcn_sched_barrier(0); asm volatile("s_nop 15\n\ts_nop 7" ::: "memory"); __builtin_amdgcn_sched_barrier(0); }
        E(acc, cur, wr, wc, fr, fq);
        if (!has_next) break;
#pragma unroll
        for (int a = 0; a < 2; ++a)
#pragma unroll
            for (int b = 0; b < 2; ++b)
#pragma unroll
                for (int m = 0; m < 4; ++m)
#pragma unroll
                    for (int n = 0; n < 2; ++n) acc[a][b][m][n] = (f32x4){0.f, 0.f, 0.f, 0.f};
        cur = nxt; cA = nA; cB = nB; ++ui;
        if (wr == 1) PG8_BAR;
        if constexpr (GATHER) {
#pragma unroll
            for (int h = 0; h < 2; ++h) { gc[h][0] = gn[h][0]; gc[h][1] = gn[h][1]; } }
    }
    PG8_WAIT_V(0);
    PG8_BAR;
#undef PG8_SA
#undef PG8_SB
#undef PG8_GLDS
#undef PG8_STAGE_A
#undef PG8_STAGE_B
#undef PG8_LDA
#undef PG8_LDB
#undef PG8_MMA
#undef PG8_WAIT_V
#undef PG8_WAIT_L
#undef PG8_BAR
#undef PG8_SCHED
#undef PG8_GATHER
}
}

#define XB_TMO      128
#define XB_XCNT(j)  (256  + 64 * (j))
#define XB_XSUB(j)  (1280 + 64 * (j))
#define XB_XGEN(j)  (2304 + 64 * (j))
#define XB_TOP      3328
#define XB_TOPGEN   3392
#define XCD_BAR_WORDS 3456
#define XB_SPIN_CAP (1u << 22)
__device__ __forceinline__ unsigned xb_ld(unsigned* p)              { return __hip_atomic_load(p, __ATOMIC_RELAXED, __HIP_MEMORY_SCOPE_AGENT); }
__device__ __forceinline__ unsigned xb_add(unsigned* p, unsigned v) { return __hip_atomic_fetch_add(p, v, __ATOMIC_RELAXED, __HIP_MEMORY_SCOPE_AGENT); }
__device__ __forceinline__ unsigned xb_xcc_id() { return (unsigned)__builtin_amdgcn_s_getreg((3 << 11) | 20) & 0xFu; }
#define XB_SPIN(cond, bar) do { unsigned _sp = 0; while (cond) { __builtin_amdgcn_s_sleep(1); \
    if ((++_sp & 255u) == 0u) { if (xb_ld(&(bar)[XB_TMO])) break; if (_sp > XB_SPIN_CAP) { atomicAdd(&(bar)[XB_TMO], 1u); break; } } } } while (0)
struct XcdBarrier { unsigned* bar; unsigned x; volatile LAS unsigned* st; };
__device__ __forceinline__ XcdBarrier xcd_barrier_post(unsigned* bar, volatile LAS unsigned* st) {
    XcdBarrier b; b.bar = bar; b.x = xb_xcc_id(); b.st = st;
    if (threadIdx.x == 0) (void)xb_add(&bar[XB_XCNT(b.x)], 1u);
    return b;
}
__device__ __forceinline__ void xcd_barrier_complete(unsigned* bar, unsigned x, unsigned& nloc, unsigned& nx) {
    const unsigned G = gridDim.x * gridDim.y * gridDim.z;
    unsigned sum, cnt, mine, sp = 0u;
    for (;;) {
        sum = 0u; cnt = 0u; mine = 0u;
#pragma unroll
        for (unsigned j = 0; j < 16; ++j) { const unsigned c = xb_ld(&bar[XB_XCNT(j)]); sum += c; cnt += (c > 0u) ? 1u : 0u; mine = (j == x) ? c : mine; }
        if (sum == G) break;
        __builtin_amdgcn_s_sleep(1);
        if ((++sp & 255u) == 0u) { if (xb_ld(&bar[XB_TMO])) break; if (sp > XB_SPIN_CAP) { atomicAdd(&bar[XB_TMO], 1u); break; } }
    }
    nloc = mine > 0u ? mine : 1u; nx = cnt > 0u ? cnt : 1u;
}
__device__ __forceinline__ void xcd_barrier(const XcdBarrier& b) {
    asm volatile("s_waitcnt vmcnt(0)" ::: "memory");
    __syncthreads();
    if (threadIdx.x == 0) {
        unsigned* bar = b.bar;
        __builtin_amdgcn_s_waitcnt(0);
        unsigned nloc = b.st[0], nx = b.st[1];
        if (nloc == 0u) { xcd_barrier_complete(bar, b.x, nloc, nx); b.st[0] = nloc; b.st[1] = nx; }
        const unsigned old = xb_add(&bar[XB_XSUB(b.x)], 1u);
        const unsigned gen = old / nloc;
        if (old + 1u == (gen + 1u) * nloc) {
            __builtin_amdgcn_fence(__ATOMIC_RELEASE, "agent");
            asm volatile("s_waitcnt vmcnt(0)" ::: "memory");
            const unsigned og = xb_add(&bar[XB_TOP], 1u);
            const unsigned tg = og / nx;
            if (og + 1u == (tg + 1u) * nx) xb_add(&bar[XB_TOPGEN], 1u);
            else XB_SPIN(xb_ld(&bar[XB_TOPGEN]) == tg, bar);
            __builtin_amdgcn_fence(__ATOMIC_ACQUIRE, "agent");
            xb_add(&bar[XB_XGEN(b.x)], 1u);
            asm volatile("s_waitcnt vmcnt(0)" ::: "memory");
        } else {
            XB_SPIN(xb_ld(&bar[XB_XGEN(b.x)]) == gen, bar);
            __builtin_amdgcn_fence(__ATOMIC_ACQUIRE, "agent");
            asm volatile("s_waitcnt vmcnt(0)" ::: "memory");
        }
    }
    __syncthreads();
}

constexpr int NWAVES = 8, NTHR = 512;
constexpr int RING_BYTES = 131072, XTRA_OFF = RING_BYTES, LDS_BYTES = 147456;
constexpr int X_MISC = 0, X_TB = 256, X_NN = 1536;
constexpr int CW_BAR = 4096;
constexpr int N_PHASES = 14;
struct MArgs { const float* in[22]; float* out; unsigned char* ws; int ph_lo, ph_hi; };

__device__ __forceinline__ void ph_mod_prep(const MArgs& a, unsigned char* smem, int G) {
    const int tid = threadIdx.x;
    unsigned char* ws = a.ws;
    if ((int)blockIdx.x < 192) {
        float* sc = (float*)smem; float* red = sc + NB * D;
        const float* c = a.in[1]; const float* w_ada = a.in[2]; const float* b_ada = a.in[3]; float* mod = (float*)(ws + WS_MOD);
        for (int i = tid; i < NB * D; i += NTHR) sc[i] = siluf_(c[i]);
        __syncthreads();
        for (int it = blockIdx.x; it < 192; it += G) {
            const int kq = tid >> 5, jl = tid & 31, j = it * 32 + jl;
            float a0 = 0.f, a1 = 0.f, a2 = 0.f, a3 = 0.f;
#pragma unroll 16
            for (int kk = 0; kk < 64; ++kk) { const int k = kq * 64 + kk; const float w = w_ada[(size_t)k * 6144 + j];
                a0 += sc[k] * w; a1 += sc[D + k] * w; a2 += sc[2 * D + k] * w; a3 += sc[3 * D + k] * w; }
            red[(kq * 4 + 0) * 32 + jl] = a0; red[(kq * 4 + 1) * 32 + jl] = a1; red[(kq * 4 + 2) * 32 + jl] = a2; red[(kq * 4 + 3) * 32 + jl] = a3;
            __syncthreads();
            if (tid < 128) { const int b = tid >> 5; float s = b_ada[j];
#pragma unroll
                for (int q = 0; q < 16; ++q) s += red[(q * 4 + b) * 32 + jl];
                mod[b * 6144 + j] = s; }
            __syncthreads();
        }
    }
    PrepArgs pa{a.in[4], a.in[9], a.in[12], a.in[14], a.in[15], a.in[16], a.in[17], a.in[18], a.in[19],
                (unsigned char*)(ws + WS_WTIN), (bf16*)(ws + WS_WTOUT), (bf16*)(ws + WS_WTR), (unsigned char*)(ws + WS_WT13), (bf16*)(ws + WS_WT2)};
    const int lane = tid & 63, gw = blockIdx.x * NWAVES + (tid >> 6), ngw = G * NWAVES;
    prep_run(pa, gw, ngw, lane);
}

__device__ __forceinline__ void ph_ln1(const MArgs& a, unsigned char* smem, int G) {
    const int tid = threadIdx.x, lane = tid & 63, wave = tid >> 6;
    const float* x = a.in[0]; const float* w_in = a.in[4]; const float* gate_b = a.in[7];
    const float* mod = (const float*)(a.ws + WS_MOD); unsigned char* u1 = (unsigned char*)(a.ws + WS_U1); float* ipre = (float*)(a.ws + WS_GATES); float* logf = ipre + 16 * S;
    float* wg = (float*)smem;
    for (int i = tid; i < D * 8; i += NTHR) wg[i] = w_in[(size_t)(i >> 3) * WIN_LD + C_GATE + (i & 7)];
    __syncthreads();
    for (int it = blockIdx.x; it < T / 128; it += G) {
        const int row0 = it * 128, b = row0 / S;
        f32x4 sh[4], sc[4];
#pragma unroll
        for (int j = 0; j < 4; ++j) { sh[j] = *(const f32x4*)(mod + b * 6144 + 4 * lane + 256 * j); sc[j] = *(const f32x4*)(mod + b * 6144 + 1024 + 4 * lane + 256 * j); }
        for (int rr = wave; rr < 128; rr += NWAVES) {
            const int row = row0 + rr;
            const f32x4* xr = (const f32x4*)(x + (size_t)row * D) + lane;
            f32x4 v[4]; float s = 0.f;
#pragma unroll
            for (int j = 0; j < 4; ++j) { v[j] = xr[64 * j]; s += (v[j].x + v[j].y) + (v[j].z + v[j].w); }
            const float mean = wave_sum(s) * (1.f / D); float s2 = 0.f;
#pragma unroll
            for (int j = 0; j < 4; ++j) { v[j] = v[j] - mean; s2 += (v[j].x * v[j].x + v[j].y * v[j].y) + (v[j].z * v[j].z + v[j].w * v[j].w); }
            const float rstd = 1.f / sqrtf(wave_sum(s2) * (1.f / D) + LN_EPS);
            float ga[8];
#pragma unroll
            for (int q = 0; q < 8; ++q) ga[q] = 0.f;
            unsigned* o4 = (unsigned*)(u1 + (size_t)row * D) + lane;
#pragma unroll
            for (int j = 0; j < 4; ++j) {
                const f32x4 u = v[j] * rstd * (sc[j] + 1.0f) + sh[j];
                o4[64 * j] = pk4_fp8(u.x, u.y, u.z, u.w);
#pragma unroll
                for (int e = 0; e < 4; ++e) { const int k = 4 * lane + 256 * j + e;
                    const f32x4 w0 = *(const f32x4*)(wg + k * 8), w1 = *(const f32x4*)(wg + k * 8 + 4);
                    ga[0] += u[e] * w0.x; ga[1] += u[e] * w0.y; ga[2] += u[e] * w0.z; ga[3] += u[e] * w0.w;
                    ga[4] += u[e] * w1.x; ga[5] += u[e] * w1.y; ga[6] += u[e] * w1.z; ga[7] += u[e] * w1.w; }
            }
#pragma unroll
            for (int q = 0; q < 8; ++q) ga[q] = wave_sum(ga[q]);
            if (lane < 8) {
                float gv = 0.f;
#pragma unroll
                for (int q = 0; q < 8; ++q) gv = (lane == q) ? ga[q] : gv;
                gv += gate_b[lane];
                const int h = lane & 3, s_ = row % S;
                if (lane < 4) ipre[(size_t)(b * 4 + h) * S + s_] = gv;
                else logf[(size_t)(b * 4 + h) * S + s_] = fminf(gv, 0.f) - log1pf(__expf(-fabsf(gv)));
            }
        }
    }
}

__device__ __forceinline__ void ph_ln2(const MArgs& a, int G) {
    const float* x = a.in[0]; const bf16* mixout = (const bf16*)(a.ws + WS_MIXOUT); const float* mod = (const float*)(a.ws + WS_MOD); const float* ln1_g = a.in[10]; const float* ln1_b = a.in[11];
    float* x1 = a.out; bf16* u2 = (bf16*)(a.ws + WS_U2); unsigned char* u2f8 = (unsigned char*)(a.ws + WS_U2F8);
    const int tid = threadIdx.x, lane = tid & 63, wave = tid >> 6;
    for (int it = blockIdx.x; it < T / 128; it += G) {
        const int row0 = it * 128, b = row0 / S;
        f32x4 g1[4], lg[4], lb[4], sc2[4], sh2[4];
#pragma unroll
        for (int j = 0; j < 4; ++j) { const int col = 4 * lane + 256 * j;
            g1[j] = *(const f32x4*)(mod + b * 6144 + 2048 + col); lg[j] = *(const f32x4*)(ln1_g + col); lb[j] = *(const f32x4*)(ln1_b + col);
            sc2[j] = *(const f32x4*)(mod + b * 6144 + 4096 + col) + 1.0f; sh2[j] = *(const f32x4*)(mod + b * 6144 + 3072 + col); }
        for (int rr = wave; rr < 128; rr += NWAVES) {
            const int row = row0 + rr;
            f32x4 v[4]; float s = 0.f;
#pragma unroll
            for (int j = 0; j < 4; ++j) {
                const int col = 4 * lane + 256 * j;
                const f32x4 xv = __builtin_nontemporal_load((const f32x4*)(x + (size_t)row * D + col));
                const f32x4 mo = ld_bf4(mixout + (size_t)row * D + col);
                v[j] = xv * DN_ALPHA + g1[j] * mo; s += (v[j].x + v[j].y) + (v[j].z + v[j].w);
            }
            float mean = wave_sum(s) * (1.f / D), s2 = 0.f;
#pragma unroll
            for (int j = 0; j < 4; ++j) { v[j] = v[j] - mean; s2 += (v[j].x * v[j].x + v[j].y * v[j].y) + (v[j].z * v[j].z + v[j].w * v[j].w); }
            float rstd = 1.f / sqrtf(wave_sum(s2) * (1.f / D) + LN_EPS);
            s = 0.f;
#pragma unroll
            for (int j = 0; j < 4; ++j) { const int col = 4 * lane + 256 * j;
                v[j] = v[j] * rstd * lg[j] + lb[j];
                *(f32x4*)(x1 + (size_t)row * D + col) = v[j]; s += (v[j].x + v[j].y) + (v[j].z + v[j].w); }
            mean = wave_sum(s) * (1.f / D); s2 = 0.f;
#pragma unroll
            for (int j = 0; j < 4; ++j) { v[j] = v[j] - mean; s2 += (v[j].x * v[j].x + v[j].y * v[j].y) + (v[j].z * v[j].z + v[j].w * v[j].w); }
            rstd = 1.f / sqrtf(wave_sum(s2) * (1.f / D) + LN_EPS);
#pragma unroll
            for (int j = 0; j < 4; ++j) { const int col = 4 * lane + 256 * j;
                const f32x4 u = v[j] * rstd * sc2[j] + sh2[j];
                *(unsigned long long*)(u2 + (size_t)row * D + col) = (unsigned long long)pk2(u.x, u.y) | ((unsigned long long)pk2(u.z, u.w) << 32);
                *(unsigned*)(u2f8 + (size_t)row * D + col) = pk4_fp8(u.x, u.y, u.z, u.w); }
        }
    }
}
__device__ __forceinline__ void route_wave(int t, int lane, const float* __restrict__ logits, const f32x4 bias4, int* __restrict__ tope, float* __restrict__ topg, int* __restrict__ cnt) {
    const f32x4 lg = *(const f32x4*)(logits + (size_t)t * NE + 4 * lane);
    float sc[4], v[4];
#pragma unroll
    for (int j = 0; j < 4; ++j) { sc[j] = 1.f / (1.f + __expf(-lg[j])); v[j] = sc[j] + bias4[j]; }
    float m1 = fmaxf(fmaxf(v[0], v[1]), fmaxf(v[2], v[3]));
    float m2; { const float a = fmaxf(v[0], v[1]), b = fminf(v[0], v[1]), c = fmaxf(v[2], v[3]), d = fminf(v[2], v[3]); m2 = fmaxf(fminf(a, c), fmaxf(b, d)); }
#pragma unroll
    for (int o = 1; o < 8; o <<= 1) { const float o1 = __shfl_xor(m1, o), o2 = __shfl_xor(m2, o); const float n1 = fmaxf(m1, o1); m2 = fmaxf(fminf(m1, o1), fmaxf(m2, o2)); m1 = n1; }
    const float gs = m1 + m2; const int myg = lane >> 3; int rank = 0;
#pragma unroll
    for (int gg = 0; gg < 8; ++gg) { const float og = __shfl(gs, gg * 8); rank += (og > gs || (og == gs && gg < myg)) ? 1 : 0; }
    if (rank >= 4) {
#pragma unroll
        for (int j = 0; j < 4; ++j) v[j] = -INFINITY; }
    int myE = 0; float myS = 0.f, gsum = 0.f;
#pragma unroll
    for (int rd = 0; rd < 8; ++rd) {
        float bv = v[0]; int bi = 4 * lane;
#pragma unroll
        for (int j = 1; j < 4; ++j) if (v[j] > bv) { bv = v[j]; bi = 4 * lane + j; }
#pragma unroll
        for (int o = 1; o < 64; o <<= 1) { const float ov = __shfl_xor(bv, o); const int oi = __shfl_xor(bi, o); if (ov > bv || (ov == bv && oi < bi)) { bv = ov; bi = oi; } }
        float ss = 0.f;
#pragma unroll
        for (int j = 0; j < 4; ++j) if (bi == 4 * lane + j) { ss = sc[j]; v[j] = -INFINITY; }
        ss = __shfl(ss, bi >> 2);
        gsum += ss;
        if (lane == rd) { myE = bi; myS = ss; }
    }
    if (lane < 8) { tope[t * 8 + lane] = myE; topg[t * 8 + lane] = myS * (2.5f / gsum); atomicAdd(cnt + myE, 1); }
}
__device__ __forceinline__ void moe_tables(const int* cnt, LAS int* tb, LAS int* nn) {
    if (threadIdx.x < 64) {
        const int lane = threadIdx.x; int n[4], tl[4], loc = 0;
#pragma unroll
        for (int j = 0; j < 4; ++j) { n[j] = cnt[4 * lane + j]; tl[j] = (n[j] + 255) >> 8; loc += tl[j]; }
        int inc = loc;
#pragma unroll
        for (int o = 1; o < 64; o <<= 1) { const int v = __shfl_up(inc, o); if (lane >= o) inc += v; }
        int base = inc - loc;
#pragma unroll
        for (int j = 0; j < 4; ++j) { tb[4 * lane + j] = base; nn[4 * lane + j] = n[j]; base += tl[j]; }
        if (lane == 63) { tb[NE] = base; nn[NE] = T; tb[NEX] = base + T / 256; }
    }
    __syncthreads();
}
__device__ __forceinline__ void ph_final(const MArgs& a, int G) {
    float* out = a.out; const bf16* ys = (const bf16*)(a.ws + WS_YS); const bf16* ysh = (const bf16*)(a.ws + WS_YSH); const float* mod = (const float*)(a.ws + WS_MOD);
    const float* ln2_g = a.in[20]; const float* ln2_b = a.in[21];
    const int tid = threadIdx.x, lane = tid & 63, wave = tid >> 6;
    for (int it = blockIdx.x; it < T / 128; it += G) {
        const int row0 = it * 128, b = row0 / S;
        f32x4 g2[4], lg[4], lb[4];
#pragma unroll
        for (int j = 0; j < 4; ++j) { const int col = 4 * lane + 256 * j; g2[j] = *(const f32x4*)(mod + b * 6144 + 5120 + col); lg[j] = *(const f32x4*)(ln2_g + col); lb[j] = *(const f32x4*)(ln2_b + col); }
        for (int rr = wave; rr < 128; rr += NWAVES) {
            const int row = row0 + rr;
            f32x4 v[4]; float s = 0.f;
#pragma unroll
            for (int j = 0; j < 4; ++j) { const int col = 4 * lane + 256 * j;
                f32x4 y = ld_bf4(ysh + (size_t)row * D + col);
#pragma unroll
                for (int k = 0; k < 8; ++k) y = y + ld_bf4(ys + ((size_t)row * 8 + k) * D + col);
                v[j] = *(const f32x4*)(out + (size_t)row * D + col) * DN_ALPHA + g2[j] * y;
                s += (v[j].x + v[j].y) + (v[j].z + v[j].w); }
            const float mean = wave_sum(s) * (1.f / D); float s2 = 0.f;
#pragma unroll
            for (int j = 0; j < 4; ++j) { v[j] = v[j] - mean; s2 += (v[j].x * v[j].x + v[j].y * v[j].y) + (v[j].z * v[j].z + v[j].w * v[j].w); }
            const float rstd = 1.f / sqrtf(wave_sum(s2) * (1.f / D) + LN_EPS);
#pragma unroll
            for (int j = 0; j < 4; ++j) { const int col = 4 * lane + 256 * j;
                __builtin_nontemporal_store(v[j] * rstd * lg[j] + lb[j], (f32x4*)(out + (size_t)row * D + col)); }
        }
    }
}


typedef short s16x4 __attribute__((ext_vector_type(4)));
typedef short bf16x8v __attribute__((ext_vector_type(8)));
typedef float f32x16 __attribute__((ext_vector_type(16)));
constexpr int MLP = 320;
constexpr int NCH = S / 64;
constexpr int ST_ELEMS = 129 * 128;
constexpr size_t WS_CHK = WS_GATES + 1 * MiB;
constexpr size_t WS_MPREV = WS_GATES + 1 * MiB + 65536;
constexpr size_t WS_KC = WS_U2;
__device__ __forceinline__ s16x4 tr_read(const LAS unsigned char* p) { return __builtin_bit_cast(s16x4, __builtin_amdgcn_ds_read_tr16_b64_v4i16((LAS s16x4*)p)); }
__device__ __forceinline__ bf16x8v tr_frag(const LAS unsigned char* tile, int row0, int col0, int lane) {
    const int i = lane & 15; const LAS unsigned char* p = tile + (row0 + (i >> 2)) * MLP + (col0 + 4 * (i & 3)) * 2;
    const s16x4 lo = tr_read(p), hi = tr_read(p + 4 * MLP);
    return __builtin_shufflevector(lo, hi, 0, 1, 2, 3, 4, 5, 6, 7);
}
__device__ __forceinline__ bf16x8v tr_frag_perm(const LAS unsigned char* tile, int row0, int col0, int lane) {
    const int i = lane & 15; const LAS unsigned char* p = tile + (row0 + (i >> 2)) * MLP + (col0 + 4 * (i & 3)) * 2;
    const s16x4 lo = tr_read(p), hi = tr_read(p + 8 * MLP);
    return __builtin_shufflevector(lo, hi, 0, 1, 2, 3, 4, 5, 6, 7);
}
__device__ __forceinline__ float wave_incl_sum(float v, int lane) {
#pragma unroll
    for (int o = 1; o < 64; o <<= 1) { const float u = __shfl_up(v, o); if (lane >= o) v += u; }
    return v;
}
__device__ __forceinline__ float wave_incl_max(float v, int lane) {
#pragma unroll
    for (int o = 1; o < 64; o <<= 1) { const float u = __shfl_up(v, o); if (lane >= o) v = fmaxf(v, u); }
    return v;
}
__device__ __forceinline__ float wave_max(float v) {
#pragma unroll
    for (int o = 1; o < 64; o <<= 1) v = fmaxf(v, __shfl_xor(v, o));
    return v;
}
__device__ __forceinline__ void conv8(const bf16* __restrict__ rowp, int spos, const float* __restrict__ cw, const float* __restrict__ cb, float scale, float (&y)[8]) {
    const f32x4 b0 = *(const f32x4*)cb, b1 = *(const f32x4*)(cb + 4);
    y[0] = b0.x; y[1] = b0.y; y[2] = b0.z; y[3] = b0.w; y[4] = b1.x; y[5] = b1.y; y[6] = b1.z; y[7] = b1.w;
#pragma unroll
    for (int j = 0; j < 4; ++j) {
        if (spos - 3 + j >= 0) {
            const v4u xr = *(const v4u*)(rowp + (ptrdiff_t)(j - 3) * NPROJ);
            const f32x4 w0 = *(const f32x4*)(cw + j * 1024), w1 = *(const f32x4*)(cw + j * 1024 + 4);
            y[0] += w0.x * bf2f(xr.x & 0xffffu); y[1] += w0.y * bf2f(xr.x >> 16); y[2] += w0.z * bf2f(xr.y & 0xffffu); y[3] += w0.w * bf2f(xr.y >> 16);
            y[4] += w1.x * bf2f(xr.z & 0xffffu); y[5] += w1.y * bf2f(xr.z >> 16); y[6] += w1.z * bf2f(xr.w & 0xffffu); y[7] += w1.w * bf2f(xr.w >> 16);
        }
    }
#pragma unroll
    for (int e = 0; e < 8; ++e) y[e] = siluf_(y[e]) * scale;
}
__device__ __forceinline__ v4u pack8(const float (&y)[8]) { v4u o; o.x = pk2(y[0], y[1]); o.y = pk2(y[2], y[3]); o.z = pk2(y[4], y[5]); o.w = pk2(y[6], y[7]); return o; }

__device__ __forceinline__ void ml_phaseA(const MArgs& a, LAS unsigned char* lds, int vb0, int nvb) {
    const int tid = threadIdx.x, lane = tid & 63, wave = __builtin_amdgcn_readfirstlane(tid >> 6);
    const bf16* proj = (const bf16*)(a.ws + WS_PROJ); const float* conv_w = a.in[5]; const float* conv_b = a.in[6];
    const float* ipre = (const float*)(a.ws + WS_GATES); const float* logf = ipre + 16 * S;
    bf16* kcg = (bf16*)(a.ws + WS_KC); bf16* st = (bf16*)(a.ws + WS_STATES); float* chk = (float*)(a.ws + WS_CHK);
    LAS unsigned char* Kt = lds; LAS unsigned char* Vt = lds + 64 * MLP; LAS float* wkL = (LAS float*)(lds + 128 * MLP);
    for (int unit = vb0; unit < 16 * NCH; unit += nvb) {
        const int bh = unit >> 7, c = unit & (NCH - 1), b = bh >> 2, h = bh & 3, s0 = c * 64; const size_t row0 = (size_t)b * S + s0;
        if (wave == 0) {
            const float lf = logf[(size_t)bh * S + s0 + lane], ic = ipre[(size_t)bh * S + s0 + lane];
            const float bc = wave_incl_sum(lf, lane), g = ic - bc, gmax = wave_max(g), blast = __shfl(bc, 63);
            wkL[lane] = __expf(g - gmax);
            if (lane == 0) { chk[(size_t)unit * 2] = blast; chk[(size_t)unit * 2 + 1] = blast + gmax; }
        }
#pragma unroll
        for (int q = 0; q < 2; ++q) { const int it = tid + q * NTHR, tt = it >> 4, c8 = it & 15, ch = h * 128 + c8 * 8;
            float y[8]; conv8(proj + (row0 + tt) * NPROJ + C_MLK + ch, s0 + tt, conv_w + 512 + ch, conv_b + 512 + ch, 0.08838834764831845f, y);
            const v4u o = pack8(y);
            *(LAS v4u*)(Kt + tt * MLP + c8 * 16) = o; *(v4u*)(kcg + (row0 + tt) * 512 + ch) = o; }
        __syncthreads();
#pragma unroll
        for (int q = 0; q < 2; ++q) { const int it = tid + q * NTHR, tt = it >> 4, c8 = it & 15;
            const v4u xr = *(const v4u*)(proj + (row0 + tt) * NPROJ + C_MLV + h * 128 + c8 * 8); const float w = wkL[tt];
            float y[8] = {bf2f(xr.x & 0xffffu) * w, bf2f(xr.x >> 16) * w, bf2f(xr.y & 0xffffu) * w, bf2f(xr.y >> 16) * w, bf2f(xr.z & 0xffffu) * w, bf2f(xr.z >> 16) * w, bf2f(xr.w & 0xffffu) * w, bf2f(xr.w >> 16) * w};
            *(LAS v4u*)(Vt + tt * MLP + c8 * 16) = pack8(y); }
        __syncthreads();
        {
            const int dvb = wave >> 1, dkh = wave & 1, hh = lane >> 5, gsel = (lane >> 4) & 1;
            f32x16 acc[2];
#pragma unroll
            for (int nb = 0; nb < 2; ++nb)
#pragma unroll
                for (int i = 0; i < 16; ++i) acc[nb][i] = 0.f;
#pragma unroll
            for (int kk = 0; kk < 4; ++kk) {
                const bf16x8v Bv = tr_frag(Vt, 16 * kk + 8 * hh, 32 * dvb + 16 * gsel, lane);
#pragma unroll
                for (int nb = 0; nb < 2; ++nb) { const bf16x8v Ak = tr_frag(Kt, 16 * kk + 8 * hh, 32 * (2 * dkh + nb) + 16 * gsel, lane);
                    acc[nb] = __builtin_amdgcn_mfma_f32_32x32x16_bf16(Ak, Bv, acc[nb], 0, 0, 0); }
            }
            bf16* stc = st + (size_t)unit * ST_ELEMS;
#pragma unroll
            for (int nb = 0; nb < 2; ++nb)
#pragma unroll
                for (int g4 = 0; g4 < 4; ++g4) { const int dk = 32 * (2 * dkh + nb) + 8 * g4 + 4 * hh, dv = 32 * dvb + (lane & 31);
                    *(unsigned long long*)(stc + (size_t)dv * 128 + dk) = (unsigned long long)pk2(acc[nb][4 * g4], acc[nb][4 * g4 + 1]) | ((unsigned long long)pk2(acc[nb][4 * g4 + 2], acc[nb][4 * g4 + 3]) << 32); }
        }
        if (tid < 128) { float s = 0.f;
#pragma unroll 8
            for (int t = 0; t < 64; ++t) s += wkL[t] * bf2f(*(const LAS unsigned short*)(Kt + t * MLP + tid * 2));
            st[(size_t)unit * ST_ELEMS + 128 * 128 + tid] = (bf16)f2bf(s); }
        __syncthreads();
    }
}

__device__ __forceinline__ void ml_phaseB(const MArgs& a, LAS unsigned char* lds, int vb0, int nvb) {
    const int tid = threadIdx.x;
    bf16* st = (bf16*)(a.ws + WS_STATES); const float* chk = (const float*)(a.ws + WS_CHK); float* mprev = (float*)(a.ws + WS_MPREV);
    LAS float* al = (LAS float*)lds; LAS float* be = al + NCH;
    constexpr int NSL = 16, SLE = ST_ELEMS / NSL;
    for (int item = vb0; item < 16 * NSL; item += nvb) {
        const int bh = item / NSL, sl = item % NSL;
        __syncthreads();
        if (tid == 0) { float m = 0.f;
            for (int c = 0; c < NCH; ++c) { const float bl = chk[(size_t)(bh * NCH + c) * 2], M = chk[(size_t)(bh * NCH + c) * 2 + 1];
                const float mn = fmaxf(bl + m, M); al[c] = __expf(bl + m - mn); be[c] = __expf(M - mn);
                if (sl == 0) mprev[bh * NCH + c] = m;
                m = mn; } }
        __syncthreads();
        if (tid * 4 < SLE) {
            unsigned long long* p = (unsigned long long*)(st + (size_t)bh * NCH * ST_ELEMS + sl * SLE + tid * 4);
            float c0 = 0.f, c1 = 0.f, c2 = 0.f, c3 = 0.f;
            for (int cb = 0; cb < NCH; cb += 16) { unsigned long long d[16];
#pragma unroll
                for (int j = 0; j < 16; ++j) d[j] = p[(size_t)(cb + j) * (ST_ELEMS / 4)];
#pragma unroll
                for (int j = 0; j < 16; ++j) { p[(size_t)(cb + j) * (ST_ELEMS / 4)] = (unsigned long long)pk2(c0, c1) | ((unsigned long long)pk2(c2, c3) << 32);
                    const float A = al[cb + j], Bq = be[cb + j]; const unsigned lo = (unsigned)d[j], hi = (unsigned)(d[j] >> 32);
                    c0 = A * c0 + Bq * bf2f(lo & 0xffffu); c1 = A * c1 + Bq * bf2f(lo >> 16); c2 = A * c2 + Bq * bf2f(hi & 0xffffu); c3 = A * c3 + Bq * bf2f(hi >> 16); } }
        }
    }
}

__device__ __forceinline__ void ml_phaseC(const MArgs& a, LAS unsigned char* lds, int G) {
    const int tid = threadIdx.x, lane = tid & 63, wave = __builtin_amdgcn_readfirstlane(tid >> 6);
    const bf16* proj = (const bf16*)(a.ws + WS_PROJ); const float* conv_w = a.in[5]; const float* conv_b = a.in[6]; const float* norm_g = a.in[8];
    const float* ipre = (const float*)(a.ws + WS_GATES); const float* logf = ipre + 16 * S;
    const bf16* kcg = (const bf16*)(a.ws + WS_KC); const bf16* st = (const bf16*)(a.ws + WS_STATES); const float* mprev = (const float*)(a.ws + WS_MPREV);
    bf16* mix = (bf16*)(a.ws + WS_MIX);
    LAS unsigned char* Qt = lds; LAS unsigned char* Kt = lds + 64 * MLP; LAS unsigned char* Vt = lds + 128 * MLP; LAS unsigned char* Ct = lds + 192 * MLP;
    LAS float* sc = (LAS float*)(lds + 320 * MLP);
    LAS float* gL = sc; LAS float* mmL = sc + 64; LAS float* siL = sc + 128; LAS float* emL = sc + 192; LAS float* npv = sc + 256; LAS float* lnS = sc + 384;
    const int tb = wave >> 2, dvb = wave & 3, r = lane & 31, hh = lane >> 5, gsel = (lane >> 4) & 1;
    for (int unit = blockIdx.x; unit < 16 * NCH; unit += G) {
        const int bh = unit >> 7, c = unit & (NCH - 1), b = bh >> 2, h = bh & 3, s0 = c * 64; const size_t row0 = (size_t)b * S + s0;
        if (wave == 0) {
            const float lf = logf[(size_t)bh * S + s0 + lane], ic = ipre[(size_t)bh * S + s0 + lane], mp = mprev[unit];
            const float bc = wave_incl_sum(lf, lane), g = ic - bc, pm = wave_incl_max(g, lane), mm = fmaxf(mp, pm);
            gL[lane] = g; mmL[lane] = mm; siL[lane] = __expf(mp - mm); emL[lane] = __expf(-(bc + mm));
        }
        const bf16* stc = st + (size_t)unit * ST_ELEMS;
#pragma unroll
        for (int q = 0; q < 2; ++q) { const int it = tid + q * NTHR, tt = it >> 4, c8 = it & 15, ch = h * 128 + c8 * 8;
            float y[8]; conv8(proj + (row0 + tt) * NPROJ + C_MLQ + ch, s0 + tt, conv_w + ch, conv_b + ch, 1.f, y);
            *(LAS v4u*)(Qt + tt * MLP + c8 * 16) = pack8(y);
            *(LAS v4u*)(Kt + tt * MLP + c8 * 16) = *(const v4u*)(kcg + (row0 + tt) * 512 + ch);
            *(LAS v4u*)(Vt + tt * MLP + c8 * 16) = *(const v4u*)(proj + (row0 + tt) * NPROJ + C_MLV + ch); }
#pragma unroll
        for (int q = 0; q < 4; ++q) { const int it = tid + q * NTHR, dv = it >> 4, c8 = it & 15;
            *(LAS v4u*)(Ct + dv * MLP + c8 * 16) = *(const v4u*)(stc + dv * 128 + c8 * 8); }
        if (tid < 128) npv[tid] = bf2f(stc[128 * 128 + tid]);
        __syncthreads();
        bf16x8v qf[8];
#pragma unroll
        for (int kk = 0; kk < 8; ++kk) qf[kk] = *(const LAS bf16x8v*)(Qt + (32 * tb + r) * MLP + (16 * kk + 8 * hh) * 2);
        const float mm_t = mmL[32 * tb + r], si_t = siL[32 * tb + r], em_t = emL[32 * tb + r];
        float nq = 0.f;
#pragma unroll
        for (int kk = 0; kk < 8; ++kk) { const f32x4 n0 = *(const LAS f32x4*)(npv + 16 * kk + 8 * hh), n1 = *(const LAS f32x4*)(npv + 16 * kk + 8 * hh + 4);
            nq += n0.x * bf2f((unsigned short)qf[kk][0]) + n0.y * bf2f((unsigned short)qf[kk][1]) + n0.z * bf2f((unsigned short)qf[kk][2]) + n0.w * bf2f((unsigned short)qf[kk][3])
                + n1.x * bf2f((unsigned short)qf[kk][4]) + n1.y * bf2f((unsigned short)qf[kk][5]) + n1.z * bf2f((unsigned short)qf[kk][6]) + n1.w * bf2f((unsigned short)qf[kk][7]); }
        nq += __shfl_xor(nq, 32);
        f32x16 num;
#pragma unroll
        for (int i = 0; i < 16; ++i) num[i] = 0.f;
#pragma unroll
        for (int kk = 0; kk < 8; ++kk) { const bf16x8v Ac = *(const LAS bf16x8v*)(Ct + (32 * dvb + r) * MLP + (16 * kk + 8 * hh) * 2);
            num = __builtin_amdgcn_mfma_f32_32x32x16_bf16(Ac, qf[kk], num, 0, 0, 0); }
#pragma unroll
        for (int i = 0; i < 16; ++i) num[i] *= si_t;
        float wsum = 0.f;
        for (int sb = 0; sb <= tb; ++sb) {
            f32x16 sT;
#pragma unroll
            for (int i = 0; i < 16; ++i) sT[i] = 0.f;
#pragma unroll
            for (int kk = 0; kk < 8; ++kk) { const bf16x8v Ak = *(const LAS bf16x8v*)(Kt + (32 * sb + r) * MLP + (16 * kk + 8 * hh) * 2);
                sT = __builtin_amdgcn_mfma_f32_32x32x16_bf16(Ak, qf[kk], sT, 0, 0, 0); }
            unsigned wp[8];
#pragma unroll
            for (int g4 = 0; g4 < 4; ++g4) { const f32x4 gv = *(const LAS f32x4*)(gL + 32 * sb + 8 * g4 + 4 * hh);
                float w[4];
#pragma unroll
                for (int e = 0; e < 4; ++e) { const int srow = 32 * sb + 8 * g4 + 4 * hh + e; const bool valid = srow <= 32 * tb + r;
                    w[e] = valid ? sT[4 * g4 + e] * __expf(gv[e] - mm_t) : 0.f; wsum += w[e]; }
                wp[2 * g4] = pk2(w[0], w[1]); wp[2 * g4 + 1] = pk2(w[2], w[3]); }
#pragma unroll
            for (int s2 = 0; s2 < 2; ++s2) {
                const bf16x8v Av = tr_frag_perm(Vt, 32 * sb + 16 * s2 + 4 * hh, 32 * dvb + 16 * gsel, lane);
                v4u bw; bw.x = wp[4 * s2]; bw.y = wp[4 * s2 + 1]; bw.z = wp[4 * s2 + 2]; bw.w = wp[4 * s2 + 3];
                num = __builtin_amdgcn_mfma_f32_32x32x16_bf16(Av, __builtin_bit_cast(bf16x8v, bw), num, 0, 0, 0); }
        }
        wsum += __shfl_xor(wsum, 32);
        const float den = si_t * nq + wsum, rden = 1.f / fmaxf(fabsf(den), em_t);
        float ps = 0.f, pq = 0.f;
#pragma unroll
        for (int i = 0; i < 16; ++i) { num[i] *= rden; ps += num[i]; pq += num[i] * num[i]; }
        ps += __shfl_xor(ps, 32); pq += __shfl_xor(pq, 32);
        if (hh == 0) { lnS[((tb * 4 + dvb) * 32 + r) * 2] = ps; lnS[((tb * 4 + dvb) * 32 + r) * 2 + 1] = pq; }
        __syncthreads();
        float ts = 0.f, tq = 0.f;
#pragma unroll
        for (int d = 0; d < 4; ++d) { ts += lnS[((tb * 4 + d) * 32 + r) * 2]; tq += lnS[((tb * 4 + d) * 32 + r) * 2 + 1]; }
        const float mean = ts * (1.f / 128.f), rstd = 1.f / sqrtf(fmaxf(tq * (1.f / 128.f) - mean * mean, 0.f) + LN_EPS);
        const size_t trow = row0 + 32 * tb + r;
#pragma unroll
        for (int g4 = 0; g4 < 4; ++g4) { const int dv = 32 * dvb + 8 * g4 + 4 * hh;
            const f32x4 ng = *(const f32x4*)(norm_g + h * 128 + dv); const f32x4 og = ld_bf4(proj + trow * NPROJ + C_MLO + h * 128 + dv);
            float o[4];
#pragma unroll
            for (int e = 0; e < 4; ++e) o[e] = (num[4 * g4 + e] - mean) * rstd * ng[e] * sigmoidf_(og[e]);
            *(unsigned long long*)(mix + trow * D + 512 + h * 128 + dv) = (unsigned long long)pk2(o[0], o[1]) | ((unsigned long long)pk2(o[2], o[3]) << 32); }
        __syncthreads();
    }
}


constexpr int VTP = 192;
template <int PITCH> __device__ __forceinline__ bf16x8v tr_frag_perm_p(const LAS unsigned char* tile, int row0, int col0, int lane) {
    const int i = lane & 15; const LAS unsigned char* p = tile + (row0 + (i >> 2)) * PITCH + (col0 + 4 * (i & 3)) * 2;
    const s16x4 lo = tr_read(p), hi = tr_read(p + 8 * PITCH);
    return __builtin_shufflevector(lo, hi, 0, 1, 2, 3, 4, 5, 6, 7);
}
__device__ __forceinline__ void attn_phase(const bf16* __restrict__ proj, bf16* __restrict__ mix, LAS unsigned char* lds, int vb0, int nvb) {
    const int tid = threadIdx.x, lane = tid & 63, wave = __builtin_amdgcn_readfirstlane(tid >> 6);
    const int r = lane & 31, hh = lane >> 5, gsel = (lane >> 4) & 1;
    LAS unsigned char* Vt = lds + wave * (64 * VTP);
    bf16x8v ntri[2], nones;
#pragma unroll
    for (int s2 = 0; s2 < 2; ++s2)
#pragma unroll
        for (int j = 0; j < 8; ++j) { const int k = 16 * s2 + 8 * (j >> 2) + 4 * hh + (j & 3); ntri[s2][j] = (k >= r) ? (short)0xBF80 : (short)0; }
#pragma unroll
    for (int j = 0; j < 8; ++j) nones[j] = (short)0xBF80;
    for (int unit = vb0 * NWAVES + wave; unit < NB * 8 * (S / 32); unit += nvb * NWAVES) {
        const int bh = unit / (S / 32), qb = unit % (S / 32), b = bh >> 3, h = bh & 7, q0 = qb * 32;
        const bf16* base = proj + (size_t)b * S * NPROJ + h * 64;
        bf16x8v qf[4];
#pragma unroll
        for (int s = 0; s < 4; ++s) qf[s] = *(const bf16x8v*)(base + (size_t)(q0 + r) * NPROJ + C_SBQ + 16 * s + 8 * hh);
        f32x16 o[2];
#pragma unroll
        for (int d = 0; d < 2; ++d)
#pragma unroll
            for (int i = 0; i < 16; ++i) o[d][i] = 0.f;
        float carry = 0.f;
        const int qpos = q0 + r;
        for (int k0 = q0 - 32; ; k0 -= 64) {
            bf16x8v kf[2][4];
#pragma unroll
            for (int kb = 0; kb < 2; ++kb) { int key = k0 + 32 * kb + r; key = key < 0 ? 0 : key;
#pragma unroll
                for (int s = 0; s < 4; ++s) kf[kb][s] = *(const bf16x8v*)(base + (size_t)key * NPROJ + C_SBK + 16 * s + 8 * hh); }
#pragma unroll
            for (int i = 0; i < 8; ++i) { int key = k0 + (lane >> 3) + 8 * i; key = key < 0 ? 0 : key;
                *(LAS v4u*)(Vt + ((lane >> 3) + 8 * i) * VTP + (lane & 7) * 16) = *(const v4u*)(base + (size_t)key * NPROJ + C_SBV + (lane & 7) * 8); }
            f32x16 z[2];
#pragma unroll
            for (int kb = 0; kb < 2; ++kb) {
#pragma unroll
                for (int i = 0; i < 16; ++i) z[kb][i] = 0.f;
#pragma unroll
                for (int s = 0; s < 4; ++s) z[kb] = __builtin_amdgcn_mfma_f32_32x32x16_bf16(kf[kb][s], qf[s], z[kb], 0, 0, 0); }
            const bool need_mask = (k0 + 63 >= q0) || (k0 < 0);
            unsigned xp[2][8];
#pragma unroll
            for (int kb = 0; kb < 2; ++kb)
#pragma unroll
                for (int g4 = 0; g4 < 4; ++g4) { float sp[4];
#pragma unroll
                    for (int e = 0; e < 4; ++e) { const float zz = z[kb][4 * g4 + e];
                        float v = fmaxf(zz, 0.f) + __builtin_amdgcn_logf(1.f + __builtin_amdgcn_exp2f(-fabsf(zz)));
                        if (need_mask) { const int key = k0 + 32 * kb + 8 * g4 + 4 * hh + e; v = (key >= 0 && key < qpos) ? v : 0.f; }
                        sp[e] = v; }
                    xp[kb][2 * g4] = pk2(sp[0], sp[1]); xp[kb][2 * g4 + 1] = pk2(sp[2], sp[3]); }
            const float z00 = z[0][0];
#pragma unroll
            for (int s2 = 0; s2 < 2; ++s2) { v4u b1; b1.x = xp[1][4 * s2]; b1.y = xp[1][4 * s2 + 1]; b1.z = xp[1][4 * s2 + 2]; b1.w = xp[1][4 * s2 + 3];
                v4u b0; b0.x = xp[0][4 * s2]; b0.y = xp[0][4 * s2 + 1]; b0.z = xp[0][4 * s2 + 2]; b0.w = xp[0][4 * s2 + 3];
                z[1] = __builtin_amdgcn_mfma_f32_32x32x16_bf16(ntri[s2], __builtin_bit_cast(bf16x8v, b1), z[1], 0, 0, 0);
                z[0] = __builtin_amdgcn_mfma_f32_32x32x16_bf16(ntri[s2], __builtin_bit_cast(bf16x8v, b0), z[0], 0, 0, 0);
                z[0] = __builtin_amdgcn_mfma_f32_32x32x16_bf16(nones, __builtin_bit_cast(bf16x8v, b1), z[0], 0, 0, 0); }
            float tot = z00 - z[0][0];
            tot = __shfl(tot, r);
#pragma unroll
            for (int kb = 0; kb < 2; ++kb)
#pragma unroll
                for (int g4 = 0; g4 < 4; ++g4) { float p[4];
#pragma unroll
                    for (int e = 0; e < 4; ++e) { float v = __builtin_amdgcn_exp2f(z[kb][4 * g4 + e] - carry);
                        if (need_mask) { const int key = k0 + 32 * kb + 8 * g4 + 4 * hh + e; v = (key >= 0 && key < qpos) ? v : 0.f; }
                        p[e] = v; }
                    xp[kb][2 * g4] = pk2(p[0], p[1]); xp[kb][2 * g4 + 1] = pk2(p[2], p[3]); }
#pragma unroll
            for (int kb = 0; kb < 2; ++kb)
#pragma unroll
                for (int s2 = 0; s2 < 2; ++s2) { v4u bp; bp.x = xp[kb][4 * s2]; bp.y = xp[kb][4 * s2 + 1]; bp.z = xp[kb][4 * s2 + 2]; bp.w = xp[kb][4 * s2 + 3];
#pragma unroll
                    for (int d = 0; d < 2; ++d) { const bf16x8v Av = tr_frag_perm_p<VTP>(Vt, 32 * kb + 16 * s2 + 4 * hh, 32 * d + 16 * gsel, lane);
                        o[d] = __builtin_amdgcn_mfma_f32_32x32x16_bf16(Av, __builtin_bit_cast(bf16x8v, bp), o[d], 0, 0, 0); } }
            carry += tot;
            if (k0 <= 0) break;
            if (__all(carry > SB_THRESH)) break;
        }
        bf16* op = mix + (size_t)(b * S + q0 + r) * D + h * 64;
#pragma unroll
        for (int d = 0; d < 2; ++d)
#pragma unroll
            for (int g4 = 0; g4 < 4; ++g4)
                *(unsigned long long*)(op + 32 * d + 8 * g4 + 4 * hh) = (unsigned long long)pk2(o[d][4 * g4], o[d][4 * g4 + 1]) | ((unsigned long long)pk2(o[d][4 * g4 + 2], o[d][4 * g4 + 3]) << 32);
    }
}

__global__ void __launch_bounds__(NTHR, 2) mega_fwd(MArgs args) {
    extern __shared__ __attribute__((aligned(16))) unsigned char lds[];
    LAS unsigned char* ldsl = (LAS unsigned char*)lds;
    const int tid = threadIdx.x, G = gridDim.x;
    volatile LAS unsigned* MISC = (volatile LAS unsigned*)(ldsl + XTRA_OFF + X_MISC);
    LAS int* tb = (LAS int*)(ldsl + XTRA_OFF + X_TB); LAS int* nn = (LAS int*)(ldsl + XTRA_OFF + X_NN);
    for (int u = tid; u < (LDS_BYTES - XTRA_OFF) / 4; u += NTHR) ((LAS unsigned*)(ldsl + XTRA_OFF))[u] = 0u;
    __syncthreads();
    unsigned char* ws = args.ws;
    unsigned* ctl = (unsigned*)(ws + WS_CTL);
    XcdBarrier bar = xcd_barrier_post(ctl + CW_BAR, MISC + 8);
    const int lo = args.ph_lo, hi = args.ph_hi;
#define IN(k) (lo <= (k) && (k) < hi)
#ifndef REP_MASK
#define REP_MASK 0
#endif
#define PHASE(k, ...) do { if (IN(k)) { for (int rep_ = 0; rep_ < (((REP_MASK >> (k)) & 1) ? 2 : 1); ++rep_) { if (rep_) xcd_barrier(bar); __VA_ARGS__ } } if (IN(k) && IN((k) + 1)) xcd_barrier(bar); } while (0)
    int* cnt = (int*)ctl + CW_CNT; i32x2* list = (i32x2*)(ws + WS_ROUTE + 2 * MiB); float* topg = (float*)(ws + WS_ROUTE + 1 * MiB);
    PHASE(0, ph_mod_prep(args, lds, G););
    PHASE(1, ph_ln1(args, lds, G););
    PHASE(2, { pg8::StaticOrder So; So.init(ws + WS_U1, ws + WS_WTIN, T, NPROJ, D, G, blockIdx.x);
        pg8::EpiBf16 E{(bf16*)(ws + WS_PROJ), NPROJ, 2, QSCALE, 1.f / 64.f};
        pg8::gemm_phase<pg8::EpiBf16, pg8::StaticOrder, false, true>(ldsl, D, So, E); });
    PHASE(3, ml_phaseA(args, ldsl, blockIdx.x, G););
    PHASE(4, ml_phaseB(args, ldsl, blockIdx.x, G); __syncthreads(); attn_phase((const bf16*)(ws + WS_PROJ), (bf16*)(ws + WS_MIX), ldsl, blockIdx.x, G););
    PHASE(5, ml_phaseC(args, ldsl, G););
    PHASE(6, { pg8::StaticOrder So; So.init(ws + WS_MIX, ws + WS_WTOUT, T, D, 2 * D, G, blockIdx.x);
        pg8::EpiBf16 E{(bf16*)(ws + WS_MIXOUT), D, 0, 1.f, 1.f};
        pg8::gemm_phase<pg8::EpiBf16, pg8::StaticOrder, false, false>(ldsl, 2 * D, So, E); });
    PHASE(7, ph_ln2(args, G););
    PHASE(8, { pg8::StaticOrder So; So.init(ws + WS_U2, ws + WS_WTR, T, NE, 2 * D, G, blockIdx.x);
        pg8::EpiF32 E{(float*)(ws + WS_LOGITS), NE};
        pg8::gemm_phase<pg8::EpiF32, pg8::StaticOrder, false, false>(ldsl, 2 * D, So, E); });
    PHASE(9, { const int lane_ = tid & 63; const f32x4 bias4 = *(const f32x4*)(args.in[13] + 4 * lane_);
        for (int t = blockIdx.x * NWAVES + (tid >> 6); t < T; t += G * NWAVES) route_wave(t, lane_, (const float*)(ws + WS_LOGITS), bias4, (int*)(ws + WS_ROUTE), topg, cnt); });
    PHASE(10, { moe_tables(cnt, tb, nn); const int* tope = (const int*)(ws + WS_ROUTE); int* fill = (int*)ctl + CW_FILL;
        for (int id = blockIdx.x * NTHR + tid; id < T * TOPK; id += G * NTHR) { const int e = tope[id]; const int pos = atomicAdd(fill + e, 1);
            list[tb[e] * 256 + pos] = (i32x2){id, __float_as_int(topg[id])}; } });
    PHASE(11, { moe_tables(cnt, tb, nn);
        pg8::MoeOrder So{G, (int)blockIdx.x, tb[NEX] * 2, 1, tb, nn, list, (const char*)(ws + WS_U2F8), 0, (const char*)(ws + WS_WT13), (size_t)512 * D, (size_t)256 * D};
        pg8::EpiGlu E{(bf16*)(ws + WS_H), 1.f / 64.f};
        pg8::gemm_phase<pg8::EpiGlu, pg8::MoeOrder, true, true>(ldsl, D, So, E); });
    PHASE(12, { moe_tables(cnt, tb, nn);
        pg8::MoeOrder So{G, (int)blockIdx.x, tb[NEX] * 4, 2, tb, nn, list, (const char*)(ws + WS_H), (size_t)256 * FF * 2, (const char*)(ws + WS_WT2), (size_t)D * FF * 2, (size_t)256 * FF * 2};
        pg8::EpiScatter E{(bf16*)(ws + WS_YS), (bf16*)(ws + WS_YSH), list, nn};
        pg8::gemm_phase<pg8::EpiScatter, pg8::MoeOrder, false, false>(ldsl, 2 * FF, So, E); });
    PHASE(13, ph_final(args, G););
#undef PHASE
#undef IN
}

#ifndef MK_UPTO
#define MK_UPTO 14
#endif
__global__ void k_nan_fill(float* out, int n) { for (int i = blockIdx.x * blockDim.x + threadIdx.x; i < n; i += gridDim.x * blockDim.x) out[i] = __builtin_nanf(""); }
extern "C" void kernel_launch(void* const* d_in, const int* in_sizes, int n_in, void* d_out, int out_size, void* d_ws, size_t ws_size, hipStream_t stream) {
    static int grid = 0;
    if (grid == 0) {
        int dev = 0, cus = 0, per_cu = 0; grid = -1;
        if (n_in != 22 || out_size != T * D || ws_size < WS_END) fprintf(stderr, "kernel_launch: unexpected shapes (n_in %d out %d ws %zu, need %zu)\n", n_in, out_size, ws_size, (size_t)WS_END);
        else if (hipGetDevice(&dev) != hipSuccess || hipDeviceGetAttribute(&cus, hipDeviceAttributeMultiprocessorCount, dev) != hipSuccess) fprintf(stderr, "kernel_launch: device query failed\n");
        else if (hipFuncSetAttribute((const void*)mega_fwd, hipFuncAttributeMaxDynamicSharedMemorySize, LDS_BYTES) != hipSuccess) fprintf(stderr, "kernel_launch: hipFuncSetAttribute failed\n");
        else if (hipOccupancyMaxActiveBlocksPerMultiprocessor(&per_cu, (const void*)mega_fwd, NTHR, LDS_BYTES) != hipSuccess || per_cu < 1) fprintf(stderr, "kernel_launch: occupancy query says %d blocks per CU\n", per_cu);
        else grid = cus;
        (void)hipGetLastError();
    }
    if (grid < 0) { k_nan_fill<<<1024, 256, 0, stream>>>((float*)d_out, out_size); return; }
    const float* x = (const float*)d_in[0];
    const float* conv_w = (const float*)d_in[5]; const float* conv_b = (const float*)d_in[6];
    const float* norm_g = (const float*)d_in[8]; const float* ln1_g = (const float*)d_in[10]; const float* ln1_b = (const float*)d_in[11];
    const float* rbias = (const float*)d_in[13]; const float* ln2_g = (const float*)d_in[20]; const float* ln2_b = (const float*)d_in[21];
    char* ws = (char*)d_ws; float* out = (float*)d_out;
    float* mod = (float*)(ws + WS_MOD); bf16* wtin = (bf16*)(ws + WS_WTIN); bf16* wtout = (bf16*)(ws + WS_WTOUT); bf16* wtr = (bf16*)(ws + WS_WTR);
    bf16* wt13 = (bf16*)(ws + WS_WT13); bf16* wt2 = (bf16*)(ws + WS_WT2); int* plan = (int*)(ws + WS_PLAN);
    bf16* u1 = (bf16*)(ws + WS_U1); bf16* proj = (bf16*)(ws + WS_PROJ); float* ipre = (float*)(ws + WS_GATES); float* logf = ipre + 16 * S;
    float* hraw = (float*)(ws + WS_HRAW); bf16* mix = (bf16*)(ws + WS_MIX); bf16* mixout = (bf16*)(ws + WS_MIXOUT); bf16* u2 = (bf16*)(ws + WS_U2);
    float* logits = (float*)(ws + WS_LOGITS); int* tope = (int*)(ws + WS_ROUTE); float* topg = (float*)(ws + WS_ROUTE + 1 * MiB); i32x2* list = (i32x2*)(ws + WS_ROUTE + 2 * MiB);
    bf16* H = (bf16*)(ws + WS_H); bf16* ys = (bf16*)(ws + WS_YS); bf16* ysh = (bf16*)(ws + WS_YSH);
    int* cnt = (int*)(ws + WS_CTL) + CW_CNT;
    (void)hipMemsetAsync(ws + WS_CTL, 0, 1 * MiB, stream);
    if (MK_UPTO > 0) {
        MArgs a{};
        for (int i = 0; i < 22; ++i) a.in[i] = (const float*)d_in[i];
        a.out = out; a.ws = (unsigned char*)d_ws; a.ph_lo = 0; a.ph_hi = MK_UPTO;
        hipLaunchKernelGGL(mega_fwd, dim3(grid), dim3(NTHR), LDS_BYTES, stream, a);
    }
}
```

```cpp
#include <hip/hip_runtime.h>
#include <cstdio>
#include <cstdint>

typedef unsigned short bf16;
typedef unsigned v4u __attribute__((ext_vector_type(4)));
typedef float f32x4 __attribute__((ext_vector_type(4)));
typedef int i32x2 __attribute__((ext_vector_type(2)));
typedef float f32x2 __attribute__((ext_vector_type(2)));

constexpr int D = 1024, NB = 4, S = 8192, T = NB * S;
constexpr int NPROJ = 3584, WIN_LD = 3592;
constexpr int C_SBQ = 0, C_SBK = 512, C_SBV = 1024, C_MLQ = 1536, C_MLK = 2048, C_MLV = 2560, C_MLO = 3072, C_GATE = 3584;
constexpr int NE = 256, NEX = 257, TOPK = 8, FF = 256;
constexpr float LN_EPS = 1e-5f;
constexpr float DN_ALPHA = 1.189207115002721f;
constexpr float LOG2E = 1.4426950408889634f;
constexpr float QSCALE = 0.125f * LOG2E;
constexpr float SB_THRESH = 48.0f;

constexpr size_t MiB = 1u << 20;
constexpr size_t WS_CTL = 0;
constexpr size_t WS_MOD = 1 * MiB;
constexpr size_t WS_WTIN = 2 * MiB;
constexpr size_t WS_WTOUT = 10 * MiB;
constexpr size_t WS_WTR = 12 * MiB;
constexpr size_t WS_PLAN = 13 * MiB;
constexpr size_t WS_WT2 = 16 * MiB;
constexpr size_t WS_YS = 145 * MiB;
constexpr size_t WS_WT13 = 145 * MiB;
constexpr size_t WS_U2F8 = 274 * MiB;
constexpr size_t WS_PROJ = 402 * MiB;
constexpr size_t WS_GATES = 626 * MiB;
constexpr size_t WS_H = 657 * MiB;
constexpr size_t WS_STATES = 657 * MiB;
constexpr size_t WS_MIXOUT = 657 * MiB;
constexpr size_t WS_LOGITS = 657 * MiB;
constexpr size_t WS_U1 = 725 * MiB;
constexpr size_t WS_MIX = 725 * MiB;
constexpr size_t WS_U2 = 833 * MiB;
constexpr size_t WS_YSH = 833 * MiB;
constexpr size_t WS_HRAW = 833 * MiB;
constexpr size_t WS_ROUTE = 897 * MiB;
constexpr size_t WS_END = 902 * MiB;
constexpr int CW_CNT = 1024;
constexpr int CW_FILL = 1536;
constexpr int PL_SLOT = 0, PL_T64 = 512, PL_T256 = 1024;

__device__ __forceinline__ unsigned f2bf(float f) { unsigned u = __builtin_bit_cast(unsigned, f); return (u + 0x7fffu + ((u >> 16) & 1u)) >> 16; }
__device__ __forceinline__ float bf2f(unsigned b) { return __builtin_bit_cast(float, b << 16); }
__device__ __forceinline__ unsigned pk2(float lo, float hi) { return f2bf(lo) | (f2bf(hi) << 16); }
__device__ __forceinline__ unsigned pk4_fp8(float a, float b, float c, float d) { int w = 0; w = __builtin_amdgcn_cvt_pk_fp8_f32(a, b, w, false); w = __builtin_amdgcn_cvt_pk_fp8_f32(c, d, w, true); return (unsigned)w; }
__device__ __forceinline__ float wave_sum(float v) {
    v += __builtin_bit_cast(float, __builtin_amdgcn_update_dpp(0, __builtin_bit_cast(int, v), 0xB1, 0xF, 0xF, true));
    v += __builtin_bit_cast(float, __builtin_amdgcn_update_dpp(0, __builtin_bit_cast(int, v), 0x4E, 0xF, 0xF, true));
    v += __builtin_bit_cast(float, __builtin_amdgcn_update_dpp(0, __builtin_bit_cast(int, v), 0x141, 0xF, 0xF, true));
    v += __builtin_bit_cast(float, __builtin_amdgcn_update_dpp(0, __builtin_bit_cast(int, v), 0x140, 0xF, 0xF, true));
    const int iv = __builtin_bit_cast(int, v);
    const float r0 = __builtin_bit_cast(float, __builtin_amdgcn_readlane(iv, 0)), r1 = __builtin_bit_cast(float, __builtin_amdgcn_readlane(iv, 16));
    const float r2 = __builtin_bit_cast(float, __builtin_amdgcn_readlane(iv, 32)), r3 = __builtin_bit_cast(float, __builtin_amdgcn_readlane(iv, 48));
    return (r0 + r1) + (r2 + r3);
}
__device__ __forceinline__ float sigmoidf_(float x) { return 1.f / (1.f + __expf(-x)); }
__device__ __forceinline__ float siluf_(float x) { return x / (1.f + __expf(-x)); }


struct PrepArgs { const float *w_in, *w_out, *w_router, *w1, *w3, *w2, *sw1, *sw3, *sw2; unsigned char* wtin; bf16 *wtout, *wtr; unsigned char* wt13; bf16* wt2; };
struct PrepDesc { const float* src; unsigned char* dst; int ldw, ldt, k0, n0, rowmap, f8; };
constexpr int IT_IN = 16 * 56, IT_OUT = 16 * 16, IT_R = 16 * 4, IT_E = 192, IT_TOTAL = IT_IN + IT_OUT + IT_R + NEX * IT_E;
__device__ __forceinline__ PrepDesc prep_decode(const PrepArgs& a, int it) {
    if (it < IT_IN) return PrepDesc{a.w_in, a.wtin, WIN_LD, D, (it / 112) * 128, (it % 112) * 32, 0, 1}; it -= IT_IN;
    if (it < IT_OUT) return PrepDesc{a.w_out, (unsigned char*)a.wtout, D, D, (it / 16) * 64, (it % 16) * 64, 0, 0}; it -= IT_OUT;
    if (it < IT_R) return PrepDesc{a.w_router, (unsigned char*)a.wtr, NE, D, (it / 4) * 64, (it % 4) * 64, 0, 0}; it -= IT_R;
    const int e = it / IT_E, r = it % IT_E;
    if (r < 64) return PrepDesc{e < NE ? a.w1 + (size_t)e * D * FF : a.sw1, a.wt13 + (size_t)e * 512 * D, FF, D, (r / 8) * 128, (r % 8) * 32, 1, 1};
    if (r < 128) { const int q = r - 64; return PrepDesc{e < NE ? a.w3 + (size_t)e * D * FF : a.sw3, a.wt13 + (size_t)e * 512 * D, FF, D, (q / 8) * 128, (q % 8) * 32, 2, 1}; }
    const int q = r - 128; return PrepDesc{e < NE ? a.w2 + (size_t)e * FF * D : a.sw2, (unsigned char*)(a.wt2 + (size_t)e * D * FF), D, FF, (q / 16) * 64, (q % 16) * 64, 0, 0};
}
__device__ __forceinline__ void prep_load(const PrepDesc& d, int lane, f32x4 (&v)[16]) {
    const int g = d.f8 ? (lane >> 3) : (lane >> 4), i = d.f8 ? (lane & 7) : (lane & 15);
#pragma unroll
    for (int r = 0; r < 16; ++r) v[r] = __builtin_nontemporal_load((const f32x4*)(d.src + (size_t)(d.k0 + 16 * g + r) * d.ldw + d.n0 + 4 * i));
}
__device__ __forceinline__ void prep_store(const PrepDesc& d, int lane, const f32x4 (&v)[16]) {
    const int g = d.f8 ? (lane >> 3) : (lane >> 4), i = d.f8 ? (lane & 7) : (lane & 15);
#pragma unroll
    for (int nn = 0; nn < 4; ++nn) {
        const int n = d.n0 + 4 * i + nn;
        const int dr = d.rowmap == 0 ? n : ((n >> 7) * 256 + (d.rowmap == 2 ? 128 : 0) + (n & 127));
        if (d.f8) {
            v4u o; o.x = pk4_fp8(v[0][nn] * 64.f, v[1][nn] * 64.f, v[2][nn] * 64.f, v[3][nn] * 64.f); o.y = pk4_fp8(v[4][nn] * 64.f, v[5][nn] * 64.f, v[6][nn] * 64.f, v[7][nn] * 64.f);
            o.z = pk4_fp8(v[8][nn] * 64.f, v[9][nn] * 64.f, v[10][nn] * 64.f, v[11][nn] * 64.f); o.w = pk4_fp8(v[12][nn] * 64.f, v[13][nn] * 64.f, v[14][nn] * 64.f, v[15][nn] * 64.f);
            *(v4u*)(d.dst + (size_t)dr * d.ldt + d.k0 + 16 * g) = o;
        } else {
            v4u o0, o1; o0.x = pk2(v[0][nn], v[1][nn]); o0.y = pk2(v[2][nn], v[3][nn]); o0.z = pk2(v[4][nn], v[5][nn]); o0.w = pk2(v[6][nn], v[7][nn]);
            o1.x = pk2(v[8][nn], v[9][nn]); o1.y = pk2(v[10][nn], v[11][nn]); o1.z = pk2(v[12][nn], v[13][nn]); o1.w = pk2(v[14][nn], v[15][nn]);
            v4u* dp = (v4u*)((bf16*)d.dst + (size_t)dr * d.ldt + d.k0 + 16 * g); dp[0] = o0; dp[1] = o1;
        }
    }
}
__device__ __forceinline__ void prep_run(const PrepArgs& a, int it0, int stride, int lane) {
    int it = it0; if (it >= IT_TOTAL) return;
    PrepDesc dA = prep_decode(a, it), dB = dA; f32x4 va[16], vb[16]; prep_load(dA, lane, va);
    for (;;) {
        const int itB = it + stride; const bool hasB = itB < IT_TOTAL;
        if (hasB) { dB = prep_decode(a, itB); prep_load(dB, lane, vb); }
        prep_store(dA, lane, va);
        if (!hasB) break;
        const int itA = itB + stride; const bool hasA = itA < IT_TOTAL;
        if (hasA) { dA = prep_decode(a, itA); prep_load(dA, lane, va); }
        prep_store(dB, lane, vb);
        if (!hasA) break;
        it = itA;
    }
}


__device__ __forceinline__ f32x4 ld_bf4(const bf16* p) { const unsigned long long w = *(const unsigned long long*)p;
    return (f32x4){bf2f((unsigned)w & 0xffffu), bf2f(((unsigned)w) >> 16), bf2f((unsigned)(w >> 32) & 0xffffu), bf2f((unsigned)(w >> 48))}; }

#define LAS __attribute__((address_space(3)))
#define GAS __attribute__((address_space(1)))
namespace pg8 {
typedef short bf16x8 __attribute__((ext_vector_type(8)));
constexpr int F8_SCALE_W = 121;
constexpr int BM = 256, BK = 64, HALF = 128, HTB = HALF * BK * 2, STAGE_BYTES = 8 * HTB, NXCD = 8, WGM = 8;
__host__ __device__ __forceinline__ int lds_byte(int r, int c) { const int st = (r >> 4) * 2 + (c >> 5), rr = r & 15, cc = c & 31, ob = rr * 64 + cc * 2; return st * 1024 + (ob ^ (((ob >> 9) & 1) << 5)); }
__host__ __device__ __forceinline__ void stage_rc(int b, int& R, int& C) { const int st = b / 1024, sb = b % 1024, swz = sb ^ (((sb >> 9) & 1) << 5); R = (st >> 1) * 16 + swz / 64; C = (st & 1) * 32 + (swz % 64) / 2; }
__host__ __device__ __forceinline__ int perm32(int rho) { const int n = rho >> 4, i = rho & 15; return 8 * (i >> 2) + 4 * n + (i & 3); }

struct Unit { int pm, pn, e, mt; const char* A; const char* B; };

__device__ __forceinline__ long unit_index(int i, int G, int c) { return (G % 8 == 0) ? ((long)(i * 8 + (c & 7)) * (G / 8) + (c >> 3)) : ((long)i * G + c); }

struct StaticOrder {
    int nM, nN, nwg, G, c; const char* A; const char* B; size_t tstep;
    __device__ void init(const void* A_, const void* B_, int M, int N, int Kb, int G_, int c_) { nM = M / BM; nN = N / BM; nwg = nM * nN; G = G_; c = c_; A = (const char*)A_; B = (const char*)B_; tstep = (size_t)BM * Kb; }
    __device__ __forceinline__ bool next(int i, Unit& u) const {
        const long L = (long)i * G + c; if (L >= nwg) return false;
        int wgid = (int)L; { const int q = nwg / NXCD, r = nwg % NXCD, xcd = wgid % NXCD, off = wgid / NXCD; wgid = (xcd < r ? xcd * (q + 1) : r * (q + 1) + (xcd - r) * q) + off; }
        const int nig = WGM * nN, gid = wgid / nig, fm = gid * WGM, gsz = (nM - fm) < WGM ? (nM - fm) : WGM;
        u.pm = fm + ((wgid % nig) % gsz); u.pn = (wgid % nig) / gsz; u.e = 0; u.mt = u.pm; u.A = A + (size_t)u.pm * tstep; u.B = B + (size_t)u.pn * tstep; return true;
    }
    __device__ __forceinline__ int row_token(const Unit&, int) const { return 0; }
};

struct MoeOrder {
    int G, c, total, shift; const LAS int* tb; const LAS int* nn; const i32x2* list;
    const char* Abase; size_t a_tile_stride; const char* Bbase; size_t b_exp_stride, b_pn_stride;
    __device__ __forceinline__ bool next(int i, Unit& u) const {
        const long L = unit_index(i, G, c); if (L >= total) return false;
        const int tile = (int)(L >> shift); u.pn = (int)(L & ((1 << shift) - 1));
        int lo = 0, hi = NEX; while (hi - lo > 1) { const int mid = (lo + hi) >> 1; if (tb[mid] <= tile) lo = mid; else hi = mid; }
        u.e = lo; u.mt = tile - tb[lo]; u.pm = tile;
        u.A = Abase + (size_t)tile * a_tile_stride; u.B = Bbase + (size_t)lo * b_exp_stride + (size_t)u.pn * b_pn_stride; return true;
    }
    __device__ __forceinline__ int row_token(const Unit& u, int row) const {
        const int rr = u.mt * 256 + row;
        const int tok = list[u.pm * 256 + row].x >> 3;
        return u.e >= NE ? rr : (rr < nn[u.e] ? tok : 0);
    }
};

__device__ __forceinline__ unsigned cvt_pk_bf16(float lo, float hi) { unsigned r; asm volatile("v_cvt_pk_bf16_f32 %0, %1, %2" : "=v"(r) : "v"(lo), "v"(hi)); return r; }

struct EpiBf16 {
    static constexpr bool PERM = true; bf16* O; int ldc; int scale_tiles; float scale; float gscale;
    __device__ __forceinline__ void operator()(const f32x4 (&acc)[2][2][4][2], const Unit& u, int wr, int wc, int fr, int fq) const {
        const int row0 = u.pm * BM + wr * 64 + fr, col0 = u.pn * BM + wc * 32 + 8 * fq; const float sc = (u.pn < scale_tiles ? scale : 1.f) * gscale;
#pragma unroll
        for (int ai = 0; ai < 2; ++ai)
#pragma unroll
            for (int m = 0; m < 4; ++m) { bf16* rowp = O + (size_t)(row0 + ai * HALF + m * 16) * ldc + col0;
#pragma unroll
                for (int bj = 0; bj < 2; ++bj) { const f32x4 v0 = acc[ai][bj][m][0] * sc, v1 = acc[ai][bj][m][1] * sc;
                    v4u w; w.x = cvt_pk_bf16(v0[0], v0[1]); w.y = cvt_pk_bf16(v0[2], v0[3]); w.z = cvt_pk_bf16(v1[0], v1[1]); w.w = cvt_pk_bf16(v1[2], v1[3]);
                    *(v4u*)(rowp + bj * HALF) = w; } }
    }
};
struct EpiF32 {
    static constexpr bool PERM = false; float* C; int ldc;
    __device__ __forceinline__ void operator()(const f32x4 (&acc)[2][2][4][2], const Unit& u, int wr, int wc, int fr, int fq) const {
        const int row0 = u.pm * BM + wr * 64 + fr, col0 = u.pn * BM + wc * 32 + 4 * fq;
#pragma unroll
        for (int ai = 0; ai < 2; ++ai)
#pragma unroll
            for (int m = 0; m < 4; ++m) { float* rowp = C + (size_t)(row0 + ai * HALF + m * 16) * ldc + col0;
#pragma unroll
                for (int bj = 0; bj < 2; ++bj)
#pragma unroll
                    for (int n = 0; n < 2; ++n) *(f32x4*)(rowp + bj * HALF + n * 16) = acc[ai][bj][m][n]; }
    }
};
struct EpiGlu {
    static constexpr bool PERM = true; bf16* H; float gscale;
    __device__ __forceinline__ void operator()(const f32x4 (&acc)[2][2][4][2], const Unit& u, int wr, int wc, int fr, int fq) const {
        const int row0 = u.pm * BM + wr * 64 + fr, col0 = u.pn * HALF + wc * 32 + 8 * fq;
#pragma unroll
        for (int ai = 0; ai < 2; ++ai)
#pragma unroll
            for (int m = 0; m < 4; ++m) { float h[8];
#pragma unroll
                for (int n = 0; n < 2; ++n)
#pragma unroll
                    for (int q = 0; q < 4; ++q) { const float a = acc[ai][0][m][n][q] * gscale; h[n * 4 + q] = a * __builtin_amdgcn_rcpf(1.f + __expf(-a)) * (acc[ai][1][m][n][q] * gscale); }
                v4u w; w.x = cvt_pk_bf16(h[0], h[1]); w.y = cvt_pk_bf16(h[2], h[3]); w.z = cvt_pk_bf16(h[4], h[5]); w.w = cvt_pk_bf16(h[6], h[7]);
                *(v4u*)(H + (size_t)(row0 + ai * HALF + m * 16) * FF + col0) = w; }
    }
};
struct EpiScatter {
    static constexpr bool PERM = true; unsigned char* ys8; bf16* ysh; const i32x2* list; const LAS int* nn;
    __device__ __forceinline__ void operator()(const f32x4 (&acc)[2][2][4][2], const Unit& u, int wr, int wc, int fr, int fq) const {
        const int col0 = u.pn * BM + wc * 32 + 8 * fq; const int n = nn[u.e]; const bool routed = u.e < NE;
        const i32x2* lp = list + (size_t)(u.pm - u.mt) * 256;
#pragma unroll
        for (int ai = 0; ai < 2; ++ai) {
            i32x2 en[4];
#pragma unroll
            for (int m = 0; m < 4; ++m) { const int rr = u.mt * 256 + ai * HALF + wr * 64 + m * 16 + fr; const i32x2 ld = lp[rr];
                en[m].x = routed ? ld.x : rr; en[m].y = routed ? ld.y : 0x3f800000; }
#pragma unroll
            for (int m = 0; m < 4; ++m) { const int rr = u.mt * 256 + ai * HALF + wr * 64 + m * 16 + fr;
                if (rr < n) {
                    if (routed) { unsigned char* dst = ys8 + (size_t)en[m].x * D + col0; const float g = __int_as_float(en[m].y) * 16.f;
#pragma unroll
                        for (int bj = 0; bj < 2; ++bj) { const f32x4 v0 = acc[ai][bj][m][0] * g, v1 = acc[ai][bj][m][1] * g;
                            *(unsigned long long*)(dst + bj * HALF) = (unsigned long long)pk4_fp8(v0[0], v0[1], v0[2], v0[3]) | ((unsigned long long)pk4_fp8(v1[0], v1[1], v1[2], v1[3]) << 32); } }
                    else { bf16* dst = ysh + (size_t)rr * D + col0;
#pragma unroll
                        for (int bj = 0; bj < 2; ++bj) { const f32x4 v0 = acc[ai][bj][m][0], v1 = acc[ai][bj][m][1];
                            v4u w; w.x = cvt_pk_bf16(v0[0], v0[1]); w.y = cvt_pk_bf16(v0[2], v0[3]); w.z = cvt_pk_bf16(v1[0], v1[1]); w.w = cvt_pk_bf16(v1[2], v1[3]);
                            *(v4u*)(dst + bj * HALF) = w; } } } }
            __builtin_amdgcn_sched_barrier(0);
        }
    }
};

typedef int i32x8 __attribute__((ext_vector_type(8)));
typedef int i32x4 __attribute__((ext_vector_type(4)));
template <bool FP8> struct FragT { struct A4 { bf16x8 v[4][2]; }; struct B2 { bf16x8 v[2][2]; }; };
template <> struct FragT<true> { struct A4 { i32x8 v[4]; }; struct B2 { i32x8 v[2]; }; };
template <class Epi, class Sched, bool GATHER, bool FP8>
__device__ __forceinline__ void gemm_phase(LAS unsigned char* lds, const int Kb, const Sched& S, const Epi& E) {
    const int tid = threadIdx.x, wid = __builtin_amdgcn_readfirstlane(tid >> 6), lane = tid & 63, wr = wid >> 2, wc = wid & 3, fr = lane & 15, fq = lane >> 4;
    const int nt = Kb / 128;
    int sR[2], sC[2];
    unsigned voffA[2], voffB[2];
#pragma unroll
    for (int i = 0; i < 2; ++i) { stage_rc(tid * 16 + i * 8192, sR[i], sC[i]); const int Rb = Epi::PERM ? ((sR[i] & ~31) + perm32(sR[i] & 31)) : sR[i];
        voffA[i] = (unsigned)(sR[i] * Kb + sC[i] * 2); voffB[i] = (unsigned)(Rb * Kb + sC[i] * 2); }
    const size_t kstep = (size_t)(BK * 2);
    const size_t hstep = (size_t)HALF * Kb;
    const unsigned ldsw = (unsigned)wid * 1024u;
    const int aoff = lds_byte(wr * 64 + fr, fq * 8), boff = lds_byte(wc * 32 + fr, fq * 8);
    unsigned gc[2][2], gn[2][2];
#define PG8_SA(b, h) (((b) * 2 + (h)) * HTB)
#define PG8_SB(b, h) ((4 + (b) * 2 + (h)) * HTB)
#define PG8_GLDS(src, bufoff, i) __builtin_amdgcn_global_load_lds((const unsigned*)(src), (LAS unsigned*)(lds + (bufoff) + ldsw + (i) * 8192), 16, 0, 0)
#define PG8_STAGE_B(bufoff, gbase) do { PG8_GLDS((const char*)(gbase) + voffB[0], bufoff, 0); PG8_GLDS((const char*)(gbase) + voffB[1], bufoff, 1); } while (0)
#define PG8_STAGE_A(bufoff, gbase, h, nx) do { if constexpr (GATHER) { const unsigned _o0 = (nx) ? gn[h][0] : gc[h][0], _o1 = (nx) ? gn[h][1] : gc[h][1]; \
            PG8_GLDS((const char*)(gbase) + _o0, bufoff, 0); PG8_GLDS((const char*)(gbase) + _o1, bufoff, 1); } \
        else { PG8_GLDS((const char*)(gbase) + (h) * hstep + voffA[0], bufoff, 0); PG8_GLDS((const char*)(gbase) + (h) * hstep + voffA[1], bufoff, 1); } } while (0)
#define PG8_LD2(dstv, p) do { if constexpr (FP8) { const i32x4 _lo = *(const LAS i32x4*)(p), _hi = *(const LAS i32x4*)((p) + 1024); dstv = __builtin_shufflevector(_lo, _hi, 0, 1, 2, 3, 4, 5, 6, 7); } } while (0)
#define PG8_LDA(dst, b, h) do { _Pragma("unroll") for (int m = 0; m < 4; ++m) { if constexpr (FP8) { PG8_LD2(dst.v[m], lds + PG8_SA(b, h) + aoff + m * 2048); } \
        else { _Pragma("unroll") for (int k = 0; k < 2; ++k) dst.v[m][k] = *(const LAS bf16x8*)(lds + PG8_SA(b, h) + aoff + m * 2048 + k * 1024); } } } while (0)
#define PG8_LDB(dst, b, h) do { _Pragma("unroll") for (int n = 0; n < 2; ++n) { if constexpr (FP8) { PG8_LD2(dst.v[n], lds + PG8_SB(b, h) + boff + n * 2048); } \
        else { _Pragma("unroll") for (int k = 0; k < 2; ++k) dst.v[n][k] = *(const LAS bf16x8*)(lds + PG8_SB(b, h) + boff + n * 2048 + k * 1024); } } } while (0)
#define PG8_MMA(ai, bj, At, Bt) do { __builtin_amdgcn_s_setprio(1); _Pragma("unroll") for (int m = 0; m < 4; ++m) _Pragma("unroll") for (int n = 0; n < 2; ++n) { \
        if constexpr (FP8) asm volatile("s_nop 1\n\tv_mfma_scale_f32_16x16x128_f8f6f4 %0, %1, %2, %0, %3, %3 op_sel_hi:[0,0,0]" : "+v"(acc[ai][bj][m][n]) : "v"(Bt.v[n]), "v"(At.v[m]), "v"(f8scale)); \
        else { _Pragma("unroll") for (int k = 0; k < 2; ++k) acc[ai][bj][m][n] = __builtin_amdgcn_mfma_f32_16x16x32_bf16(Bt.v[n][k], At.v[m][k], acc[ai][bj][m][n], 0, 0, 0); } } \
        __builtin_amdgcn_s_setprio(0); } while (0)
#define PG8_WAIT_V(n) asm volatile("s_waitcnt vmcnt(" #n ")" ::: "memory")
#define PG8_WAIT_L(n) asm volatile("s_waitcnt lgkmcnt(" #n ")" ::: "memory")
#define PG8_BAR __builtin_amdgcn_s_barrier()
#define PG8_SCHED __builtin_amdgcn_sched_barrier(0)
#define PG8_GATHER(dst, u) do { _Pragma("unroll") for (int _h = 0; _h < 2; ++_h) _Pragma("unroll") for (int _i = 0; _i < 2; ++_i) \
        dst[_h][_i] = (unsigned)(S.row_token(u, _h * HALF + sR[_i]) * Kb + sC[_i] * 2); } while (0)
    Unit cur, nxt; int ui = 0;
    if (!S.next(0, cur)) return;
    f32x4 acc[2][2][4][2];
#pragma unroll
    for (int a = 0; a < 2; ++a)
#pragma unroll
        for (int b = 0; b < 2; ++b)
#pragma unroll
            for (int m = 0; m < 4; ++m)
#pragma unroll
                for (int n = 0; n < 2; ++n) acc[a][b][m][n] = (f32x4){0.f, 0.f, 0.f, 0.f};
    const int f8scale = 0x7f7f7f7f;
    typedef typename FragT<FP8>::A4 FragA; typedef typename FragT<FP8>::B2 FragB;
    FragA At; FragB B0, B1;
    const char* cA = cur.A; const char* cB = cur.B;
    if constexpr (GATHER) { PG8_GATHER(gc, cur); }
    PG8_STAGE_B(PG8_SB(0, 0), cB); PG8_STAGE_A(PG8_SA(0, 0), cA, 0, false); PG8_STAGE_B(PG8_SB(0, 1), cB + hstep); PG8_STAGE_A(PG8_SA(0, 1), cA, 1, false);
    if (wr == 1) PG8_BAR;
    PG8_WAIT_V(4); PG8_BAR;
    PG8_STAGE_B(PG8_SB(1, 0), cB + kstep); PG8_STAGE_A(PG8_SA(1, 0), cA + kstep, 0, false); PG8_STAGE_B(PG8_SB(1, 1), cB + hstep + kstep);
    PG8_WAIT_V(6); PG8_BAR;
    for (;;) {
        const bool has_next = S.next(ui + 1, nxt);
        const char* nA = has_next ? nxt.A : cA; const char* nB = has_next ? nxt.B : cB;
        if constexpr (GATHER) { if (has_next) { PG8_GATHER(gn, nxt); } else {
#pragma unroll
            for (int h = 0; h < 2; ++h) { gn[h][0] = gc[h][0]; gn[h][1] = gc[h][1]; } } }
#pragma unroll 1
        for (int t = 0; t < nt; t += 2) {
            const bool last = (t == nt - 2);
            const char* a1 = cA + (size_t)(t + 1) * kstep;
            const char* a2 = last ? nA : cA + (size_t)(t + 2) * kstep; const char* b2 = last ? nB : cB + (size_t)(t + 2) * kstep;
            const char* a3 = a2 + kstep; const char* b3 = b2 + kstep;
            PG8_LDB(B0, 0, 0); PG8_SCHED; PG8_LDA(At, 0, 0); PG8_STAGE_A(PG8_SA(1, 1), a1, 1, false);
            PG8_WAIT_L(8); PG8_BAR; PG8_WAIT_L(0); PG8_MMA(0, 0, At, B0); PG8_BAR; PG8_SCHED;
            PG8_LDB(B1, 0, 1); PG8_STAGE_B(PG8_SB(0, 0), b2);
            PG8_BAR; PG8_WAIT_L(0); PG8_MMA(0, 1, At, B1); PG8_BAR;
            PG8_LDA(At, 0, 1); PG8_STAGE_A(PG8_SA(0, 0), a2, 0, last);
            PG8_BAR; PG8_WAIT_L(0); PG8_MMA(1, 0, At, B0); PG8_BAR; PG8_SCHED;
            PG8_STAGE_B(PG8_SB(0, 1), b2 + hstep);
            PG8_WAIT_V(6); PG8_BAR; PG8_MMA(1, 1, At, B1); PG8_BAR;
            PG8_LDB(B0, 1, 0); PG8_SCHED; PG8_LDA(At, 1, 0); PG8_STAGE_A(PG8_SA(0, 1), a2, 1, last);
            PG8_WAIT_L(8); PG8_BAR; PG8_WAIT_L(0); PG8_MMA(0, 0, At, B0); PG8_BAR; PG8_SCHED;
            PG8_LDB(B1, 1, 1); PG8_STAGE_B(PG8_SB(1, 0), b3);
            PG8_BAR; PG8_WAIT_L(0); PG8_MMA(0, 1, At, B1); PG8_BAR;
            PG8_LDA(At, 1, 1); PG8_STAGE_A(PG8_SA(1, 0), a3, 0, last);
            PG8_BAR; PG8_WAIT_L(0); PG8_MMA(1, 0, At, B0); PG8_BAR; PG8_SCHED;
            PG8_STAGE_B(PG8_SB(1, 1), b3 + hstep);
            PG8_WAIT_V(6); PG8_BAR; PG8_MMA(1, 1, At, B1); PG8_BAR;
        }
        if (wr == 0) PG8_BAR;
        if constexpr (FP8) { __builtin_amdgcn_sched_barrier(0); asm volatile("s_nop 15\n\ts_nop 7" ::: "memory"); __builtin_amdgcn_sched_barrier(0); }
        E(acc, cur, wr, wc, fr, fq);
        if (!has_next) break;
#pragma unroll
        for (int a = 0; a < 2; ++a)
#pragma unroll
            for (int b = 0; b < 2; ++b)
#pragma unroll
                for (int m = 0; m < 4; ++m)
#pragma unroll
                    for (int n = 0; n < 2; ++n) acc[a][b][m][n] = (f32x4){0.f, 0.f, 0.f, 0.f};
        cur = nxt; cA = nA; cB = nB; ++ui;
        if (wr == 1) PG8_BAR;
        if constexpr (GATHER) {
#pragma unroll
            for (int h = 0; h < 2; ++h) { gc[h][0] = gn[h][0]; gc[h][1] = gn[h][1]; } }
    }
    PG8_WAIT_V(0);
    PG8_BAR;
#undef PG8_SA
#undef PG8_SB
#undef PG8_GLDS
#undef PG8_STAGE_A
#undef PG8_STAGE_B
#undef PG8_LDA
#undef PG8_LDB
#undef PG8_MMA
#undef PG8_WAIT_V
#undef PG8_WAIT_L
#undef PG8_BAR
#undef PG8_SCHED
#undef PG8_GATHER
}
}

#define XB_TMO      128
#define XB_XCNT(j)  (256  + 64 * (j))
#define XB_XSUB(j)  (1280 + 64 * (j))
#define XB_XGEN(j)  (2304 + 64 * (j))
#define XB_TOP      3328
#define XB_TOPGEN   3392
#define XCD_BAR_WORDS 3456
#define XB_SPIN_CAP (1u << 22)
__device__ __forceinline__ unsigned xb_ld(unsigned* p)              { return __hip_atomic_load(p, __ATOMIC_RELAXED, __HIP_MEMORY_SCOPE_AGENT); }
__device__ __forceinline__ unsigned xb_add(unsigned* p, unsigned v) { return __hip_atomic_fetch_add(p, v, __ATOMIC_RELAXED, __HIP_MEMORY_SCOPE_AGENT); }
__device__ __forceinline__ unsigned xb_xcc_id() { return (unsigned)__builtin_amdgcn_s_getreg((3 << 11) | 20) & 0xFu; }
#define XB_SPIN(cond, bar) do { unsigned _sp = 0; while (cond) { __builtin_amdgcn_s_sleep(1); \
    if ((++_sp & 255u) == 0u) { if (xb_ld(&(bar)[XB_TMO])) break; if (_sp > XB_SPIN_CAP) { atomicAdd(&(bar)[XB_TMO], 1u); break; } } } } while (0)
struct XcdBarrier { unsigned* bar; unsigned x; volatile LAS unsigned* st; };
__device__ __forceinline__ XcdBarrier xcd_barrier_post(unsigned* bar, volatile LAS unsigned* st) {
    XcdBarrier b; b.bar = bar; b.x = xb_xcc_id(); b.st = st;
    if (threadIdx.x == 0) (void)xb_add(&bar[XB_XCNT(b.x)], 1u);
    return b;
}
__device__ __forceinline__ void xcd_barrier_complete(unsigned* bar, unsigned x, unsigned& nloc, unsigned& nx) {
    const unsigned G = gridDim.x * gridDim.y * gridDim.z;
    unsigned sum, cnt, mine, sp = 0u;
    for (;;) {
        sum = 0u; cnt = 0u; mine = 0u;
#pragma unroll
        for (unsigned j = 0; j < 16; ++j) { const unsigned c = xb_ld(&bar[XB_XCNT(j)]); sum += c; cnt += (c > 0u) ? 1u : 0u; mine = (j == x) ? c : mine; }
        if (sum == G) break;
        __builtin_amdgcn_s_sleep(1);
        if ((++sp & 255u) == 0u) { if (xb_ld(&bar[XB_TMO])) break; if (sp > XB_SPIN_CAP) { atomicAdd(&bar[XB_TMO], 1u); break; } }
    }
    nloc = mine > 0u ? mine : 1u; nx = cnt > 0u ? cnt : 1u;
}
__device__ __forceinline__ void xcd_barrier(const XcdBarrier& b) {
    asm volatile("s_waitcnt vmcnt(0)" ::: "memory");
    __syncthreads();
    if (threadIdx.x == 0) {
        unsigned* bar = b.bar;
        __builtin_amdgcn_s_waitcnt(0);
        unsigned nloc = b.st[0], nx = b.st[1];
        if (nloc == 0u) { xcd_barrier_complete(bar, b.x, nloc, nx); b.st[0] = nloc; b.st[1] = nx; }
        const unsigned old = xb_add(&bar[XB_XSUB(b.x)], 1u);
        const unsigned gen = old / nloc;
        if (old + 1u == (gen + 1u) * nloc) {
            __builtin_amdgcn_fence(__ATOMIC_RELEASE, "agent");
            asm volatile("s_waitcnt vmcnt(0)" ::: "memory");
            const unsigned og = xb_add(&bar[XB_TOP], 1u);
            const unsigned tg = og / nx;
            if (og + 1u == (tg + 1u) * nx) xb_add(&bar[XB_TOPGEN], 1u);
            else XB_SPIN(xb_ld(&bar[XB_TOPGEN]) == tg, bar);
            __builtin_amdgcn_fence(__ATOMIC_ACQUIRE, "agent");
            xb_add(&bar[XB_XGEN(b.x)], 1u);
            asm volatile("s_waitcnt vmcnt(0)" ::: "memory");
        } else {
            XB_SPIN(xb_ld(&bar[XB_XGEN(b.x)]) == gen, bar);
            __builtin_amdgcn_fence(__ATOMIC_ACQUIRE, "agent");
            asm volatile("s_waitcnt vmcnt(0)" ::: "memory");
        }
    }
    __syncthreads();
}

constexpr int NWAVES = 8, NTHR = 512;
constexpr int RING_BYTES = 131072, XTRA_OFF = RING_BYTES, LDS_BYTES = 147456;
constexpr int X_MISC = 0, X_TB = 256, X_NN = 1536;
constexpr int CW_BAR = 4096;
constexpr int N_PHASES = 14;
struct MArgs { const float* in[22]; float* out; unsigned char* ws; int ph_lo, ph_hi; };

__device__ __forceinline__ void ph_mod_prep(const MArgs& a, unsigned char* smem, int G) {
    const int tid = threadIdx.x;
    unsigned char* ws = a.ws;
    if ((int)blockIdx.x < 192) {
        float* sc = (float*)smem; float* red = sc + NB * D;
        const float* c = a.in[1]; const float* w_ada = a.in[2]; const float* b_ada = a.in[3]; float* mod = (float*)(ws + WS_MOD);
        for (int i = tid; i < NB * D; i += NTHR) sc[i] = siluf_(c[i]);
        __syncthreads();
        for (int it = blockIdx.x; it < 192; it += G) {
            const int kq = tid >> 5, jl = tid & 31, j = it * 32 + jl;
            float a0 = 0.f, a1 = 0.f, a2 = 0.f, a3 = 0.f;
#pragma unroll 16
            for (int kk = 0; kk < 64; ++kk) { const int k = kq * 64 + kk; const float w = w_ada[(size_t)k * 6144 + j];
                a0 += sc[k] * w; a1 += sc[D + k] * w; a2 += sc[2 * D + k] * w; a3 += sc[3 * D + k] * w; }
            red[(kq * 4 + 0) * 32 + jl] = a0; red[(kq * 4 + 1) * 32 + jl] = a1; red[(kq * 4 + 2) * 32 + jl] = a2; red[(kq * 4 + 3) * 32 + jl] = a3;
            __syncthreads();
            if (tid < 128) { const int b = tid >> 5; float s = b_ada[j];
#pragma unroll
                for (int q = 0; q < 16; ++q) s += red[(q * 4 + b) * 32 + jl];
                mod[b * 6144 + j] = s; }
            __syncthreads();
        }
    }
    PrepArgs pa{a.in[4], a.in[9], a.in[12], a.in[14], a.in[15], a.in[16], a.in[17], a.in[18], a.in[19],
                (unsigned char*)(ws + WS_WTIN), (bf16*)(ws + WS_WTOUT), (bf16*)(ws + WS_WTR), (unsigned char*)(ws + WS_WT13), (bf16*)(ws + WS_WT2)};
    const int lane = tid & 63, gw = blockIdx.x * NWAVES + (tid >> 6), ngw = G * NWAVES;
    prep_run(pa, gw, ngw, lane);
}

__device__ __forceinline__ void ph_ln1(const MArgs& a, unsigned char* smem, int G) {
    const int tid = threadIdx.x, lane = tid & 63, wave = tid >> 6;
    const float* x = a.in[0]; const float* w_in = a.in[4]; const float* gate_b = a.in[7];
    const float* mod = (const float*)(a.ws + WS_MOD); unsigned char* u1 = (unsigned char*)(a.ws + WS_U1); float* ipre = (float*)(a.ws + WS_GATES); float* logf = ipre + 16 * S;
    float* wg = (float*)smem;
    for (int i = tid; i < D * 8; i += NTHR) wg[i] = w_in[(size_t)(i >> 3) * WIN_LD + C_GATE + (i & 7)];
    __syncthreads();
    for (int it = blockIdx.x; it < T / 128; it += G) {
        const int row0 = it * 128, b = row0 / S;
        f32x4 sh[4], sc[4];
#pragma unroll
        for (int j = 0; j < 4; ++j) { sh[j] = *(const f32x4*)(mod + b * 6144 + 4 * lane + 256 * j); sc[j] = *(const f32x4*)(mod + b * 6144 + 1024 + 4 * lane + 256 * j); }
        for (int rr = wave; rr < 128; rr += NWAVES) {
            const int row = row0 + rr;
            const f32x4* xr = (const f32x4*)(x + (size_t)row * D) + lane;
            f32x4 v[4]; float s = 0.f;
#pragma unroll
            for (int j = 0; j < 4; ++j) { v[j] = xr[64 * j]; s += (v[j].x + v[j].y) + (v[j].z + v[j].w); }
            const float mean = wave_sum(s) * (1.f / D); float s2 = 0.f;
#pragma unroll
            for (int j = 0; j < 4; ++j) { v[j] = v[j] - mean; s2 += (v[j].x * v[j].x + v[j].y * v[j].y) + (v[j].z * v[j].z + v[j].w * v[j].w); }
            const float rstd = 1.f / sqrtf(wave_sum(s2) * (1.f / D) + LN_EPS);
            float ga[8];
#pragma unroll
            for (int q = 0; q < 8; ++q) ga[q] = 0.f;
            unsigned* o4 = (unsigned*)(u1 + (size_t)row * D) + lane;
#pragma unroll
            for (int j = 0; j < 4; ++j) {
                const f32x4 u = v[j] * rstd * (sc[j] + 1.0f) + sh[j];
                o4[64 * j] = pk4_fp8(u.x, u.y, u.z, u.w);
#pragma unroll
                for (int e = 0; e < 4; ++e) { const int k = 4 * lane + 256 * j + e;
                    const f32x4 w0 = *(const f32x4*)(wg + k * 8), w1 = *(const f32x4*)(wg + k * 8 + 4);
                    ga[0] += u[e] * w0.x; ga[1] += u[e] * w0.y; ga[2] += u[e] * w0.z; ga[3] += u[e] * w0.w;
                    ga[4] += u[e] * w1.x; ga[5] += u[e] * w1.y; ga[6] += u[e] * w1.z; ga[7] += u[e] * w1.w; }
            }
#pragma unroll
            for (int q = 0; q < 8; ++q) ga[q] = wave_sum(ga[q]);
            if (lane < 8) {
                float gv = 0.f;
#pragma unroll
                for (int q = 0; q < 8; ++q) gv = (lane == q) ? ga[q] : gv;
                gv += gate_b[lane];
                const int h = lane & 3, s_ = row % S;
                if (lane < 4) ipre[(size_t)(b * 4 + h) * S + s_] = gv;
                else logf[(size_t)(b * 4 + h) * S + s_] = fminf(gv, 0.f) - log1pf(__expf(-fabsf(gv)));
            }
        }
    }
}

__device__ __forceinline__ void ph_ln2(const MArgs& a, int G) {
    const float* x = a.in[0]; const bf16* mixout = (const bf16*)(a.ws + WS_MIXOUT); const float* mod = (const float*)(a.ws + WS_MOD); const float* ln1_g = a.in[10]; const float* ln1_b = a.in[11];
    float* x1 = a.out; bf16* u2 = (bf16*)(a.ws + WS_U2); unsigned char* u2f8 = (unsigned char*)(a.ws + WS_U2F8);
    const int tid = threadIdx.x, lane = tid & 63, wave = tid >> 6;
    for (int it = blockIdx.x; it < T / 128; it += G) {
        const int row0 = it * 128, b = row0 / S;
        f32x4 g1[4], lg[4], lb[4], sc2[4], sh2[4];
#pragma unroll
        for (int j = 0; j < 4; ++j) { const int col = 4 * lane + 256 * j;
            g1[j] = *(const f32x4*)(mod + b * 6144 + 2048 + col); lg[j] = *(const f32x4*)(ln1_g + col); lb[j] = *(const f32x4*)(ln1_b + col);
            sc2[j] = *(const f32x4*)(mod + b * 6144 + 4096 + col) + 1.0f; sh2[j] = *(const f32x4*)(mod + b * 6144 + 3072 + col); }
        for (int rr = wave; rr < 128; rr += NWAVES) {
            const int row = row0 + rr;
            f32x4 v[4]; float s = 0.f;
#pragma unroll
            for (int j = 0; j < 4; ++j) {
                const int col = 4 * lane + 256 * j;
                const f32x4 xv = __builtin_nontemporal_load((const f32x4*)(x + (size_t)row * D + col));
                const f32x4 mo = ld_bf4(mixout + (size_t)row * D + col);
                v[j] = xv * DN_ALPHA + g1[j] * mo; s += (v[j].x + v[j].y) + (v[j].z + v[j].w);
            }
            float mean = wave_sum(s) * (1.f / D), s2 = 0.f;
#pragma unroll
            for (int j = 0; j < 4; ++j) { v[j] = v[j] - mean; s2 += (v[j].x * v[j].x + v[j].y * v[j].y) + (v[j].z * v[j].z + v[j].w * v[j].w); }
            float rstd = 1.f / sqrtf(wave_sum(s2) * (1.f / D) + LN_EPS);
            s = 0.f;
#pragma unroll
            for (int j = 0; j < 4; ++j) { const int col = 4 * lane + 256 * j;
                v[j] = v[j] * rstd * lg[j] + lb[j];
                *(f32x4*)(x1 + (size_t)row * D + col) = v[j]; s += (v[j].x + v[j].y) + (v[j].z + v[j].w); }
            mean = wave_sum(s) * (1.f / D); s2 = 0.f;
#pragma unroll
            for (int j = 0; j < 4; ++j) { v[j] = v[j] - mean; s2 += (v[j].x * v[j].x + v[j].y * v[j].y) + (v[j].z * v[j].z + v[j].w * v[j].w); }
            rstd = 1.f / sqrtf(wave_sum(s2) * (1.f / D) + LN_EPS);
#pragma unroll
            for (int j = 0; j < 4; ++j) { const int col = 4 * lane + 256 * j;
                const f32x4 u = v[j] * rstd * sc2[j] + sh2[j];
                *(unsigned long long*)(u2 + (size_t)row * D + col) = (unsigned long long)pk2(u.x, u.y) | ((unsigned long long)pk2(u.z, u.w) << 32);
                *(unsigned*)(u2f8 + (size_t)row * D + col) = pk4_fp8(u.x, u.y, u.z, u.w); }
        }
    }
}
__device__ __forceinline__ void route_wave(int t, int lane, const float* __restrict__ logits, const f32x4 bias4, int* __restrict__ tope, float* __restrict__ topg, int* __restrict__ cnt) {
    const f32x4 lg = *(const f32x4*)(logits + (size_t)t * NE + 4 * lane);
    float sc[4], v[4];
#pragma unroll
    for (int j = 0; j < 4; ++j) { sc[j] = 1.f / (1.f + __expf(-lg[j])); v[j] = sc[j] + bias4[j]; }
    float m1 = fmaxf(fmaxf(v[0], v[1]), fmaxf(v[2], v[3]));
    float m2; { const float a = fmaxf(v[0], v[1]), b = fminf(v[0], v[1]), c = fmaxf(v[2], v[3]), d = fminf(v[2], v[3]); m2 = fmaxf(fminf(a, c), fmaxf(b, d)); }
#pragma unroll
    for (int o = 1; o < 8; o <<= 1) { const float o1 = __shfl_xor(m1, o), o2 = __shfl_xor(m2, o); const float n1 = fmaxf(m1, o1); m2 = fmaxf(fminf(m1, o1), fmaxf(m2, o2)); m1 = n1; }
    const float gs = m1 + m2; const int myg = lane >> 3; int rank = 0;
#pragma unroll
    for (int gg = 0; gg < 8; ++gg) { const float og = __shfl(gs, gg * 8); rank += (og > gs || (og == gs && gg < myg)) ? 1 : 0; }
    if (rank >= 4) {
#pragma unroll
        for (int j = 0; j < 4; ++j) v[j] = -INFINITY; }
    int myE = 0; float myS = 0.f, gsum = 0.f;
#pragma unroll
    for (int rd = 0; rd < 8; ++rd) {
        float bv = v[0]; int bi = 4 * lane;
#pragma unroll
        for (int j = 1; j < 4; ++j) if (v[j] > bv) { bv = v[j]; bi = 4 * lane + j; }
#pragma unroll
        for (int o = 1; o < 64; o <<= 1) { const float ov = __shfl_xor(bv, o); const int oi = __shfl_xor(bi, o); if (ov > bv || (ov == bv && oi < bi)) { bv = ov; bi = oi; } }
        float ss = 0.f;
#pragma unroll
        for (int j = 0; j < 4; ++j) if (bi == 4 * lane + j) { ss = sc[j]; v[j] = -INFINITY; }
        ss = __shfl(ss, bi >> 2);
        gsum += ss;
        if (lane == rd) { myE = bi; myS = ss; }
    }
    if (lane < 8) { tope[t * 8 + lane] = myE; topg[t * 8 + lane] = myS * (2.5f / gsum); atomicAdd(cnt + myE, 1); }
}
__device__ __forceinline__ void moe_tables(const int* cnt, LAS int* tb, LAS int* nn) {
    if (threadIdx.x < 64) {
        const int lane = threadIdx.x; int n[4], tl[4], loc = 0;
#pragma unroll
        for (int j = 0; j < 4; ++j) { n[j] = cnt[4 * lane + j]; tl[j] = (n[j] + 255) >> 8; loc += tl[j]; }
        int inc = loc;
#pragma unroll
        for (int o = 1; o < 64; o <<= 1) { const int v = __shfl_up(inc, o); if (lane >= o) inc += v; }
        int base = inc - loc;
#pragma unroll
        for (int j = 0; j < 4; ++j) { tb[4 * lane + j] = base; nn[4 * lane + j] = n[j]; base += tl[j]; }
        if (lane == 63) { tb[NE] = base; nn[NE] = T; tb[NEX] = base + T / 256; }
    }
    __syncthreads();
}
__device__ __forceinline__ void ph_final(const MArgs& a, int G) {
    float* out = a.out; const unsigned char* ys8 = (const unsigned char*)(a.ws + WS_YS); const bf16* ysh = (const bf16*)(a.ws + WS_YSH); const float* mod = (const float*)(a.ws + WS_MOD);
    const float* ln2_g = a.in[20]; const float* ln2_b = a.in[21];
    const int tid = threadIdx.x, lane = tid & 63, wave = tid >> 6;
    for (int it = blockIdx.x; it < T / 128; it += G) {
        const int row0 = it * 128, b = row0 / S;
        f32x4 g2[4], lg[4], lb[4];
#pragma unroll
        for (int j = 0; j < 4; ++j) { const int col = 4 * lane + 256 * j; g2[j] = *(const f32x4*)(mod + b * 6144 + 5120 + col); lg[j] = *(const f32x4*)(ln2_g + col); lb[j] = *(const f32x4*)(ln2_b + col); }
        for (int rr = wave; rr < 128; rr += NWAVES) {
            const int row = row0 + rr;
            f32x4 v[4]; float s = 0.f;
#pragma unroll
            for (int j = 0; j < 4; ++j) { const int col = 4 * lane + 256 * j;
                f32x4 yr = {0.f, 0.f, 0.f, 0.f};
#pragma unroll
                for (int k = 0; k < 8; ++k) { const int w = *(const int*)(ys8 + ((size_t)row * 8 + k) * D + col);
                    const f32x2 lo = __builtin_amdgcn_cvt_pk_f32_fp8(w, false), hi = __builtin_amdgcn_cvt_pk_f32_fp8(w, true); yr = yr + (f32x4){lo.x, lo.y, hi.x, hi.y}; }
                const f32x4 y = ld_bf4(ysh + (size_t)row * D + col) + yr * (1.f / 16.f);
                v[j] = *(const f32x4*)(out + (size_t)row * D + col) * DN_ALPHA + g2[j] * y;
                s += (v[j].x + v[j].y) + (v[j].z + v[j].w); }
            const float mean = wave_sum(s) * (1.f / D); float s2 = 0.f;
#pragma unroll
            for (int j = 0; j < 4; ++j) { v[j] = v[j] - mean; s2 += (v[j].x * v[j].x + v[j].y * v[j].y) + (v[j].z * v[j].z + v[j].w * v[j].w); }
            const float rstd = 1.f / sqrtf(wave_sum(s2) * (1.f / D) + LN_EPS);
#pragma unroll
            for (int j = 0; j < 4; ++j) { const int col = 4 * lane + 256 * j;
                __builtin_nontemporal_store(v[j] * rstd * lg[j] + lb[j], (f32x4*)(out + (size_t)row * D + col)); }
        }
    }
}


typedef short s16x4 __attribute__((ext_vector_type(4)));
typedef short bf16x8v __attribute__((ext_vector_type(8)));
typedef float f32x16 __attribute__((ext_vector_type(16)));
constexpr int MLP = 320;
constexpr int NCH = S / 64;
constexpr int ST_ELEMS = 129 * 128;
constexpr size_t WS_CHK = WS_GATES + 1 * MiB;
constexpr size_t WS_MPREV = WS_GATES + 1 * MiB + 65536;
constexpr size_t WS_KC = WS_U2;
__device__ __forceinline__ s16x4 tr_read(const LAS unsigned char* p) { return __builtin_bit_cast(s16x4, __builtin_amdgcn_ds_read_tr16_b64_v4i16((LAS s16x4*)p)); }
__device__ __forceinline__ bf16x8v tr_frag(const LAS unsigned char* tile, int row0, int col0, int lane) {
    const int i = lane & 15; const LAS unsigned char* p = tile + (row0 + (i >> 2)) * MLP + (col0 + 4 * (i & 3)) * 2;
    const s16x4 lo = tr_read(p), hi = tr_read(p + 4 * MLP);
    return __builtin_shufflevector(lo, hi, 0, 1, 2, 3, 4, 5, 6, 7);
}
__device__ __forceinline__ bf16x8v tr_frag_perm(const LAS unsigned char* tile, int row0, int col0, int lane) {
    const int i = lane & 15; const LAS unsigned char* p = tile + (row0 + (i >> 2)) * MLP + (col0 + 4 * (i & 3)) * 2;
    const s16x4 lo = tr_read(p), hi = tr_read(p + 8 * MLP);
    return __builtin_shufflevector(lo, hi, 0, 1, 2, 3, 4, 5, 6, 7);
}
__device__ __forceinline__ float wave_incl_sum(float v, int lane) {
#pragma unroll
    for (int o = 1; o < 64; o <<= 1) { const float u = __shfl_up(v, o); if (lane >= o) v += u; }
    return v;
}
__device__ __forceinline__ float wave_incl_max(float v, int lane) {
#pragma unroll
    for (int o = 1; o < 64; o <<= 1) { const float u = __shfl_up(v, o); if (lane >= o) v = fmaxf(v, u); }
    return v;
}
__device__ __forceinline__ float wave_max(float v) {
#pragma unroll
    for (int o = 1; o < 64; o <<= 1) v = fmaxf(v, __shfl_xor(v, o));
    return v;
}
__device__ __forceinline__ void conv8(const bf16* __restrict__ rowp, int spos, const float* __restrict__ cw, const float* __restrict__ cb, float scale, float (&y)[8]) {
    const f32x4 b0 = *(const f32x4*)cb, b1 = *(const f32x4*)(cb + 4);
    y[0] = b0.x; y[1] = b0.y; y[2] = b0.z; y[3] = b0.w; y[4] = b1.x; y[5] = b1.y; y[6] = b1.z; y[7] = b1.w;
#pragma unroll
    for (int j = 0; j < 4; ++j) {
        if (spos - 3 + j >= 0) {
            const v4u xr = *(const v4u*)(rowp + (ptrdiff_t)(j - 3) * NPROJ);
            const f32x4 w0 = *(const f32x4*)(cw + j * 1024), w1 = *(const f32x4*)(cw + j * 1024 + 4);
            y[0] += w0.x * bf2f(xr.x & 0xffffu); y[1] += w0.y * bf2f(xr.x >> 16); y[2] += w0.z * bf2f(xr.y & 0xffffu); y[3] += w0.w * bf2f(xr.y >> 16);
            y[4] += w1.x * bf2f(xr.z & 0xffffu); y[5] += w1.y * bf2f(xr.z >> 16); y[6] += w1.z * bf2f(xr.w & 0xffffu); y[7] += w1.w * bf2f(xr.w >> 16);
        }
    }
#pragma unroll
    for (int e = 0; e < 8; ++e) y[e] = siluf_(y[e]) * scale;
}
__device__ __forceinline__ v4u pack8(const float (&y)[8]) { v4u o; o.x = pk2(y[0], y[1]); o.y = pk2(y[2], y[3]); o.z = pk2(y[4], y[5]); o.w = pk2(y[6], y[7]); return o; }

__device__ __forceinline__ void ml_phaseA(const MArgs& a, LAS unsigned char* lds, int vb0, int nvb) {
    const int tid = threadIdx.x, lane = tid & 63, wave = __builtin_amdgcn_readfirstlane(tid >> 6);
    const bf16* proj = (const bf16*)(a.ws + WS_PROJ); const float* conv_w = a.in[5]; const float* conv_b = a.in[6];
    const float* ipre = (const float*)(a.ws + WS_GATES); const float* logf = ipre + 16 * S;
    bf16* kcg = (bf16*)(a.ws + WS_KC); bf16* st = (bf16*)(a.ws + WS_STATES); float* chk = (float*)(a.ws + WS_CHK);
    LAS unsigned char* Kt = lds; LAS unsigned char* Vt = lds + 64 * MLP; LAS float* wkL = (LAS float*)(lds + 128 * MLP);
    for (int unit = vb0; unit < 16 * NCH; unit += nvb) {
        const int bh = unit >> 7, c = unit & (NCH - 1), b = bh >> 2, h = bh & 3, s0 = c * 64; const size_t row0 = (size_t)b * S + s0;
        if (wave == 0) {
            const float lf = logf[(size_t)bh * S + s0 + lane], ic = ipre[(size_t)bh * S + s0 + lane];
            const float bc = wave_incl_sum(lf, lane), g = ic - bc, gmax = wave_max(g), blast = __shfl(bc, 63);
            wkL[lane] = __expf(g - gmax);
            if (lane == 0) { chk[(size_t)unit * 2] = blast; chk[(size_t)unit * 2 + 1] = blast + gmax; }
        }
#pragma unroll
        for (int q = 0; q < 2; ++q) { const int it = tid + q * NTHR, tt = it >> 4, c8 = it & 15, ch = h * 128 + c8 * 8;
            float y[8]; conv8(proj + (row0 + tt) * NPROJ + C_MLK + ch, s0 + tt, conv_w + 512 + ch, conv_b + 512 + ch, 0.08838834764831845f, y);
            const v4u o = pack8(y);
            *(LAS v4u*)(Kt + tt * MLP + c8 * 16) = o; *(v4u*)(kcg + (row0 + tt) * 512 + ch) = o; }
        __syncthreads();
#pragma unroll
        for (int q = 0; q < 2; ++q) { const int it = tid + q * NTHR, tt = it >> 4, c8 = it & 15;
            const v4u xr = *(const v4u*)(proj + (row0 + tt) * NPROJ + C_MLV + h * 128 + c8 * 8); const float w = wkL[tt];
            float y[8] = {bf2f(xr.x & 0xffffu) * w, bf2f(xr.x >> 16) * w, bf2f(xr.y & 0xffffu) * w, bf2f(xr.y >> 16) * w, bf2f(xr.z & 0xffffu) * w, bf2f(xr.z >> 16) * w, bf2f(xr.w & 0xffffu) * w, bf2f(xr.w >> 16) * w};
            *(LAS v4u*)(Vt + tt * MLP + c8 * 16) = pack8(y); }
        __syncthreads();
        {
            const int dvb = wave >> 1, dkh = wave & 1, hh = lane >> 5, gsel = (lane >> 4) & 1;
            f32x16 acc[2];
#pragma unroll
            for (int nb = 0; nb < 2; ++nb)
#pragma unroll
                for (int i = 0; i < 16; ++i) acc[nb][i] = 0.f;
#pragma unroll
            for (int kk = 0; kk < 4; ++kk) {
                const bf16x8v Bv = tr_frag(Vt, 16 * kk + 8 * hh, 32 * dvb + 16 * gsel, lane);
#pragma unroll
                for (int nb = 0; nb < 2; ++nb) { const bf16x8v Ak = tr_frag(Kt, 16 * kk + 8 * hh, 32 * (2 * dkh + nb) + 16 * gsel, lane);
                    acc[nb] = __builtin_amdgcn_mfma_f32_32x32x16_bf16(Ak, Bv, acc[nb], 0, 0, 0); }
            }
            bf16* stc = st + (size_t)unit * ST_ELEMS;
#pragma unroll
            for (int nb = 0; nb < 2; ++nb)
#pragma unroll
                for (int g4 = 0; g4 < 4; ++g4) { const int dk = 32 * (2 * dkh + nb) + 8 * g4 + 4 * hh, dv = 32 * dvb + (lane & 31);
                    *(unsigned long long*)(stc + (size_t)dv * 128 + dk) = (unsigned long long)pk2(acc[nb][4 * g4], acc[nb][4 * g4 + 1]) | ((unsigned long long)pk2(acc[nb][4 * g4 + 2], acc[nb][4 * g4 + 3]) << 32); }
        }
        if (tid < 128) { float s = 0.f;
#pragma unroll 8
            for (int t = 0; t < 64; ++t) s += wkL[t] * bf2f(*(const LAS unsigned short*)(Kt + t * MLP + tid * 2));
            st[(size_t)unit * ST_ELEMS + 128 * 128 + tid] = (bf16)f2bf(s); }
        __syncthreads();
    }
}

__device__ __forceinline__ void ml_phaseB(const MArgs& a, LAS unsigned char* lds, int vb0, int nvb) {
    const int tid = threadIdx.x;
    bf16* st = (bf16*)(a.ws + WS_STATES); const float* chk = (const float*)(a.ws + WS_CHK); float* mprev = (float*)(a.ws + WS_MPREV);
    LAS float* al = (LAS float*)lds; LAS float* be = al + NCH;
    constexpr int NSL = 16, SLE = ST_ELEMS / NSL;
    for (int item = vb0; item < 16 * NSL; item += nvb) {
        const int bh = item / NSL, sl = item % NSL;
        __syncthreads();
        if (tid == 0) { float m = 0.f;
            for (int c = 0; c < NCH; ++c) { const float bl = chk[(size_t)(bh * NCH + c) * 2], M = chk[(size_t)(bh * NCH + c) * 2 + 1];
                const float mn = fmaxf(bl + m, M); al[c] = __expf(bl + m - mn); be[c] = __expf(M - mn);
                if (sl == 0) mprev[bh * NCH + c] = m;
                m = mn; } }
        __syncthreads();
        if (tid * 4 < SLE) {
            unsigned long long* p = (unsigned long long*)(st + (size_t)bh * NCH * ST_ELEMS + sl * SLE + tid * 4);
            float c0 = 0.f, c1 = 0.f, c2 = 0.f, c3 = 0.f;
            for (int cb = 0; cb < NCH; cb += 16) { unsigned long long d[16];
#pragma unroll
                for (int j = 0; j < 16; ++j) d[j] = p[(size_t)(cb + j) * (ST_ELEMS / 4)];
#pragma unroll
                for (int j = 0; j < 16; ++j) { p[(size_t)(cb + j) * (ST_ELEMS / 4)] = (unsigned long long)pk2(c0, c1) | ((unsigned long long)pk2(c2, c3) << 32);
                    const float A = al[cb + j], Bq = be[cb + j]; const unsigned lo = (unsigned)d[j], hi = (unsigned)(d[j] >> 32);
                    c0 = A * c0 + Bq * bf2f(lo & 0xffffu); c1 = A * c1 + Bq * bf2f(lo >> 16); c2 = A * c2 + Bq * bf2f(hi & 0xffffu); c3 = A * c3 + Bq * bf2f(hi >> 16); } }
        }
    }
}

__device__ __forceinline__ void ml_phaseC(const MArgs& a, LAS unsigned char* lds, int G) {
    const int tid = threadIdx.x, lane = tid & 63, wave = __builtin_amdgcn_readfirstlane(tid >> 6);
    const bf16* proj = (const bf16*)(a.ws + WS_PROJ); const float* conv_w = a.in[5]; const float* conv_b = a.in[6]; const float* norm_g = a.in[8];
    const float* ipre = (const float*)(a.ws + WS_GATES); const float* logf = ipre + 16 * S;
    const bf16* kcg = (const bf16*)(a.ws + WS_KC); const bf16* st = (const bf16*)(a.ws + WS_STATES); const float* mprev = (const float*)(a.ws + WS_MPREV);
    bf16* mix = (bf16*)(a.ws + WS_MIX);
    LAS unsigned char* Qt = lds; LAS unsigned char* Kt = lds + 64 * MLP; LAS unsigned char* Vt = lds + 128 * MLP; LAS unsigned char* Ct = lds + 192 * MLP;
    LAS float* sc = (LAS float*)(lds + 320 * MLP);
    LAS float* gL = sc; LAS float* mmL = sc + 64; LAS float* siL = sc + 128; LAS float* emL = sc + 192; LAS float* npv = sc + 256; LAS float* lnS = sc + 384;
    const int tb = wave >> 2, dvb = wave & 3, r = lane & 31, hh = lane >> 5, gsel = (lane >> 4) & 1;
    for (int unit = blockIdx.x; unit < 16 * NCH; unit += G) {
        const int bh = unit >> 7, c = unit & (NCH - 1), b = bh >> 2, h = bh & 3, s0 = c * 64; const size_t row0 = (size_t)b * S + s0;
        if (wave == 0) {
            const float lf = logf[(size_t)bh * S + s0 + lane], ic = ipre[(size_t)bh * S + s0 + lane], mp = mprev[unit];
            const float bc = wave_incl_sum(lf, lane), g = ic - bc, pm = wave_incl_max(g, lane), mm = fmaxf(mp, pm);
            gL[lane] = g; mmL[lane] = mm; siL[lane] = __expf(mp - mm); emL[lane] = __expf(-(bc + mm));
        }
        const bf16* stc = st + (size_t)unit * ST_ELEMS;
#pragma unroll
        for (int q = 0; q < 2; ++q) { const int it = tid + q * NTHR, tt = it >> 4, c8 = it & 15, ch = h * 128 + c8 * 8;
            float y[8]; conv8(proj + (row0 + tt) * NPROJ + C_MLQ + ch, s0 + tt, conv_w + ch, conv_b + ch, 1.f, y);
            *(LAS v4u*)(Qt + tt * MLP + c8 * 16) = pack8(y);
            *(LAS v4u*)(Kt + tt * MLP + c8 * 16) = *(const v4u*)(kcg + (row0 + tt) * 512 + ch);
            *(LAS v4u*)(Vt + tt * MLP + c8 * 16) = *(const v4u*)(proj + (row0 + tt) * NPROJ + C_MLV + ch); }
#pragma unroll
        for (int q = 0; q < 4; ++q) { const int it = tid + q * NTHR, dv = it >> 4, c8 = it & 15;
            *(LAS v4u*)(Ct + dv * MLP + c8 * 16) = *(const v4u*)(stc + dv * 128 + c8 * 8); }
        if (tid < 128) npv[tid] = bf2f(stc[128 * 128 + tid]);
        __syncthreads();
        bf16x8v qf[8];
#pragma unroll
        for (int kk = 0; kk < 8; ++kk) qf[kk] = *(const LAS bf16x8v*)(Qt + (32 * tb + r) * MLP + (16 * kk + 8 * hh) * 2);
        const float mm_t = mmL[32 * tb + r], si_t = siL[32 * tb + r], em_t = emL[32 * tb + r];
        float nq = 0.f;
#pragma unroll
        for (int kk = 0; kk < 8; ++kk) { const f32x4 n0 = *(const LAS f32x4*)(npv + 16 * kk + 8 * hh), n1 = *(const LAS f32x4*)(npv + 16 * kk + 8 * hh + 4);
            nq += n0.x * bf2f((unsigned short)qf[kk][0]) + n0.y * bf2f((unsigned short)qf[kk][1]) + n0.z * bf2f((unsigned short)qf[kk][2]) + n0.w * bf2f((unsigned short)qf[kk][3])
                + n1.x * bf2f((unsigned short)qf[kk][4]) + n1.y * bf2f((unsigned short)qf[kk][5]) + n1.z * bf2f((unsigned short)qf[kk][6]) + n1.w * bf2f((unsigned short)qf[kk][7]); }
        nq += __shfl_xor(nq, 32);
        f32x16 num;
#pragma unroll
        for (int i = 0; i < 16; ++i) num[i] = 0.f;
#pragma unroll
        for (int kk = 0; kk < 8; ++kk) { const bf16x8v Ac = *(const LAS bf16x8v*)(Ct + (32 * dvb + r) * MLP + (16 * kk + 8 * hh) * 2);
            num = __builtin_amdgcn_mfma_f32_32x32x16_bf16(Ac, qf[kk], num, 0, 0, 0); }
#pragma unroll
        for (int i = 0; i < 16; ++i) num[i] *= si_t;
        float wsum = 0.f;
        for (int sb = 0; sb <= tb; ++sb) {
            f32x16 sT;
#pragma unroll
            for (int i = 0; i < 16; ++i) sT[i] = 0.f;
#pragma unroll
            for (int kk = 0; kk < 8; ++kk) { const bf16x8v Ak = *(const LAS bf16x8v*)(Kt + (32 * sb + r) * MLP + (16 * kk + 8 * hh) * 2);
                sT = __builtin_amdgcn_mfma_f32_32x32x16_bf16(Ak, qf[kk], sT, 0, 0, 0); }
            unsigned wp[8];
#pragma unroll
            for (int g4 = 0; g4 < 4; ++g4) { const f32x4 gv = *(const LAS f32x4*)(gL + 32 * sb + 8 * g4 + 4 * hh);
                float w[4];
#pragma unroll
                for (int e = 0; e < 4; ++e) { const int srow = 32 * sb + 8 * g4 + 4 * hh + e; const bool valid = srow <= 32 * tb + r;
                    w[e] = valid ? sT[4 * g4 + e] * __expf(gv[e] - mm_t) : 0.f; wsum += w[e]; }
                wp[2 * g4] = pk2(w[0], w[1]); wp[2 * g4 + 1] = pk2(w[2], w[3]); }
#pragma unroll
            for (int s2 = 0; s2 < 2; ++s2) {
                const bf16x8v Av = tr_frag_perm(Vt, 32 * sb + 16 * s2 + 4 * hh, 32 * dvb + 16 * gsel, lane);
                v4u bw; bw.x = wp[4 * s2]; bw.y = wp[4 * s2 + 1]; bw.z = wp[4 * s2 + 2]; bw.w = wp[4 * s2 + 3];
                num = __builtin_amdgcn_mfma_f32_32x32x16_bf16(Av, __builtin_bit_cast(bf16x8v, bw), num, 0, 0, 0); }
        }
        wsum += __shfl_xor(wsum, 32);
        const float den = si_t * nq + wsum, rden = 1.f / fmaxf(fabsf(den), em_t);
        float ps = 0.f, pq = 0.f;
#pragma unroll
        for (int i = 0; i < 16; ++i) { num[i] *= rden; ps += num[i]; pq += num[i] * num[i]; }
        ps += __shfl_xor(ps, 32); pq += __shfl_xor(pq, 32);
        if (hh == 0) { lnS[((tb * 4 + dvb) * 32 + r) * 2] = ps; lnS[((tb * 4 + dvb) * 32 + r) * 2 + 1] = pq; }
        __syncthreads();
        float ts = 0.f, tq = 0.f;
#pragma unroll
        for (int d = 0; d < 4; ++d) { ts += lnS[((tb * 4 + d) * 32 + r) * 2]; tq += lnS[((tb * 4 + d) * 32 + r) * 2 + 1]; }
        const float mean = ts * (1.f / 128.f), rstd = 1.f / sqrtf(fmaxf(tq * (1.f / 128.f) - mean * mean, 0.f) + LN_EPS);
        const size_t trow = row0 + 32 * tb + r;
#pragma unroll
        for (int g4 = 0; g4 < 4; ++g4) { const int dv = 32 * dvb + 8 * g4 + 4 * hh;
            const f32x4 ng = *(const f32x4*)(norm_g + h * 128 + dv); const f32x4 og = ld_bf4(proj + trow * NPROJ + C_MLO + h * 128 + dv);
            float o[4];
#pragma unroll
            for (int e = 0; e < 4; ++e) o[e] = (num[4 * g4 + e] - mean) * rstd * ng[e] * sigmoidf_(og[e]);
            *(unsigned long long*)(mix + trow * D + 512 + h * 128 + dv) = (unsigned long long)pk2(o[0], o[1]) | ((unsigned long long)pk2(o[2], o[3]) << 32); }
        __syncthreads();
    }
}


constexpr int VTP = 192;
template <int PITCH> __device__ __forceinline__ bf16x8v tr_frag_perm_p(const LAS unsigned char* tile, int row0, int col0, int lane) {
    const int i = lane & 15; const LAS unsigned char* p = tile + (row0 + (i >> 2)) * PITCH + (col0 + 4 * (i & 3)) * 2;
    const s16x4 lo = tr_read(p), hi = tr_read(p + 8 * PITCH);
    return __builtin_shufflevector(lo, hi, 0, 1, 2, 3, 4, 5, 6, 7);
}
__device__ __forceinline__ void attn_phase(const bf16* __restrict__ proj, bf16* __restrict__ mix, LAS unsigned char* lds, int vb0, int nvb) {
    const int tid = threadIdx.x, lane = tid & 63, wave = __builtin_amdgcn_readfirstlane(tid >> 6);
    const int r = lane & 31, hh = lane >> 5, gsel = (lane >> 4) & 1;
    LAS unsigned char* Vt = lds + wave * (64 * VTP);
    bf16x8v ntri[2], nones;
#pragma unroll
    for (int s2 = 0; s2 < 2; ++s2)
#pragma unroll
        for (int j = 0; j < 8; ++j) { const int k = 16 * s2 + 8 * (j >> 2) + 4 * hh + (j & 3); ntri[s2][j] = (k >= r) ? (short)0xBF80 : (short)0; }
#pragma unroll
    for (int j = 0; j < 8; ++j) nones[j] = (short)0xBF80;
    for (int unit = vb0 * NWAVES + wave; unit < NB * 8 * (S / 32); unit += nvb * NWAVES) {
        const int bh = unit / (S / 32), qb = unit % (S / 32), b = bh >> 3, h = bh & 7, q0 = qb * 32;
        const bf16* base = proj + (size_t)b * S * NPROJ + h * 64;
        bf16x8v qf[4];
#pragma unroll
        for (int s = 0; s < 4; ++s) qf[s] = *(const bf16x8v*)(base + (size_t)(q0 + r) * NPROJ + C_SBQ + 16 * s + 8 * hh);
        f32x16 o[2];
#pragma unroll
        for (int d = 0; d < 2; ++d)
#pragma unroll
            for (int i = 0; i < 16; ++i) o[d][i] = 0.f;
        float carry = 0.f;
        const int qpos = q0 + r;
        for (int k0 = q0 - 32; ; k0 -= 64) {
            bf16x8v kf[2][4];
#pragma unroll
            for (int kb = 0; kb < 2; ++kb) { int key = k0 + 32 * kb + r; key = key < 0 ? 0 : key;
#pragma unroll
                for (int s = 0; s < 4; ++s) kf[kb][s] = *(const bf16x8v*)(base + (size_t)key * NPROJ + C_SBK + 16 * s + 8 * hh); }
#pragma unroll
            for (int i = 0; i < 8; ++i) { int key = k0 + (lane >> 3) + 8 * i; key = key < 0 ? 0 : key;
                *(LAS v4u*)(Vt + ((lane >> 3) + 8 * i) * VTP + (lane & 7) * 16) = *(const v4u*)(base + (size_t)key * NPROJ + C_SBV + (lane & 7) * 8); }
            f32x16 z[2];
#pragma unroll
            for (int kb = 0; kb < 2; ++kb) {
#pragma unroll
                for (int i = 0; i < 16; ++i) z[kb][i] = 0.f;
#pragma unroll
                for (int s = 0; s < 4; ++s) z[kb] = __builtin_amdgcn_mfma_f32_32x32x16_bf16(kf[kb][s], qf[s], z[kb], 0, 0, 0); }
            const bool need_mask = (k0 + 63 >= q0) || (k0 < 0);
            unsigned xp[2][8];
#pragma unroll
            for (int kb = 0; kb < 2; ++kb)
#pragma unroll
                for (int g4 = 0; g4 < 4; ++g4) { float sp[4];
#pragma unroll
                    for (int e = 0; e < 4; ++e) { const float zz = z[kb][4 * g4 + e];
                        float v = fmaxf(zz, 0.f) + __builtin_amdgcn_logf(1.f + __builtin_amdgcn_exp2f(-fabsf(zz)));
                        if (need_mask) { const int key = k0 + 32 * kb + 8 * g4 + 4 * hh + e; v = (key >= 0 && key < qpos) ? v : 0.f; }
                        sp[e] = v; }
                    xp[kb][2 * g4] = pk2(sp[0], sp[1]); xp[kb][2 * g4 + 1] = pk2(sp[2], sp[3]); }
            const float z00 = z[0][0];
#pragma unroll
            for (int s2 = 0; s2 < 2; ++s2) { v4u b1; b1.x = xp[1][4 * s2]; b1.y = xp[1][4 * s2 + 1]; b1.z = xp[1][4 * s2 + 2]; b1.w = xp[1][4 * s2 + 3];
                v4u b0; b0.x = xp[0][4 * s2]; b0.y = xp[0][4 * s2 + 1]; b0.z = xp[0][4 * s2 + 2]; b0.w = xp[0][4 * s2 + 3];
                z[1] = __builtin_amdgcn_mfma_f32_32x32x16_bf16(ntri[s2], __builtin_bit_cast(bf16x8v, b1), z[1], 0, 0, 0);
                z[0] = __builtin_amdgcn_mfma_f32_32x32x16_bf16(ntri[s2], __builtin_bit_cast(bf16x8v, b0), z[0], 0, 0, 0);
                z[0] = __builtin_amdgcn_mfma_f32_32x32x16_bf16(nones, __builtin_bit_cast(bf16x8v, b1), z[0], 0, 0, 0); }
            float tot = z00 - z[0][0];
            tot = __shfl(tot, r);
#pragma unroll
            for (int kb = 0; kb < 2; ++kb)
#pragma unroll
                for (int g4 = 0; g4 < 4; ++g4) { float p[4];
#pragma unroll
                    for (int e = 0; e < 4; ++e) { float v = __builtin_amdgcn_exp2f(z[kb][4 * g4 + e] - carry);
                        if (need_mask) { const int key = k0 + 32 * kb + 8 * g4 + 4 * hh + e; v = (key >= 0 && key < qpos) ? v : 0.f; }
                        p[e] = v; }
                    xp[kb][2 * g4] = pk2(p[0], p[1]); xp[kb][2 * g4 + 1] = pk2(p[2], p[3]); }
#pragma unroll
            for (int kb = 0; kb < 2; ++kb)
#pragma unroll
                for (int s2 = 0; s2 < 2; ++s2) { v4u bp; bp.x = xp[kb][4 * s2]; bp.y = xp[kb][4 * s2 + 1]; bp.z = xp[kb][4 * s2 + 2]; bp.w = xp[kb][4 * s2 + 3];
#pragma unroll
                    for (int d = 0; d < 2; ++d) { const bf16x8v Av = tr_frag_perm_p<VTP>(Vt, 32 * kb + 16 * s2 + 4 * hh, 32 * d + 16 * gsel, lane);
                        o[d] = __builtin_amdgcn_mfma_f32_32x32x16_bf16(Av, __builtin_bit_cast(bf16x8v, bp), o[d], 0, 0, 0); } }
            carry += tot;
            if (k0 <= 0) break;
            if (__all(carry > SB_THRESH)) break;
        }
        bf16* op = mix + (size_t)(b * S + q0 + r) * D + h * 64;
#pragma unroll
        for (int d = 0; d < 2; ++d)
#pragma unroll
            for (int g4 = 0; g4 < 4; ++g4)
                *(unsigned long long*)(op + 32 * d + 8 * g4 + 4 * hh) = (unsigned long long)pk2(o[d][4 * g4], o[d][4 * g4 + 1]) | ((unsigned long long)pk2(o[d][4 * g4 + 2], o[d][4 * g4 + 3]) << 32);
    }
}

__global__ void __launch_bounds__(NTHR, 2) mega_fwd(MArgs args) {
    extern __shared__ __attribute__((aligned(16))) unsigned char lds[];
    LAS unsigned char* ldsl = (LAS unsigned char*)lds;
    const int tid = threadIdx.x, G = gridDim.x;
    volatile LAS unsigned* MISC = (volatile LAS unsigned*)(ldsl + XTRA_OFF + X_MISC);
    LAS int* tb = (LAS int*)(ldsl + XTRA_OFF + X_TB); LAS int* nn = (LAS int*)(ldsl + XTRA_OFF + X_NN);
    for (int u = tid; u < (LDS_BYTES - XTRA_OFF) / 4; u += NTHR) ((LAS unsigned*)(ldsl + XTRA_OFF))[u] = 0u;
    __syncthreads();
    unsigned char* ws = args.ws;
    unsigned* ctl = (unsigned*)(ws + WS_CTL);
    XcdBarrier bar = xcd_barrier_post(ctl + CW_BAR, MISC + 8);
    const int lo = args.ph_lo, hi = args.ph_hi;
#define IN(k) (lo <= (k) && (k) < hi)
#ifndef REP_MASK
#define REP_MASK 0
#endif
#define PHASE(k, ...) do { if (IN(k)) { for (int rep_ = 0; rep_ < (((REP_MASK >> (k)) & 1) ? 2 : 1); ++rep_) { if (rep_) xcd_barrier(bar); __VA_ARGS__ } } if (IN(k) && IN((k) + 1)) xcd_barrier(bar); } while (0)
    int* cnt = (int*)ctl + CW_CNT; i32x2* list = (i32x2*)(ws + WS_ROUTE + 2 * MiB); float* topg = (float*)(ws + WS_ROUTE + 1 * MiB);
    PHASE(0, ph_mod_prep(args, lds, G););
    PHASE(1, ph_ln1(args, lds, G););
    PHASE(2, { pg8::StaticOrder So; So.init(ws + WS_U1, ws + WS_WTIN, T, NPROJ, D, G, blockIdx.x);
        pg8::EpiBf16 E{(bf16*)(ws + WS_PROJ), NPROJ, 2, QSCALE, 1.f / 64.f};
        pg8::gemm_phase<pg8::EpiBf16, pg8::StaticOrder, false, true>(ldsl, D, So, E); });
    PHASE(3, ml_phaseA(args, ldsl, blockIdx.x, G););
    PHASE(4, ml_phaseB(args, ldsl, blockIdx.x, G); __syncthreads(); attn_phase((const bf16*)(ws + WS_PROJ), (bf16*)(ws + WS_MIX), ldsl, blockIdx.x, G););
    PHASE(5, ml_phaseC(args, ldsl, G););
    PHASE(6, { pg8::StaticOrder So; So.init(ws + WS_MIX, ws + WS_WTOUT, T, D, 2 * D, G, blockIdx.x);
        pg8::EpiBf16 E{(bf16*)(ws + WS_MIXOUT), D, 0, 1.f, 1.f};
        pg8::gemm_phase<pg8::EpiBf16, pg8::StaticOrder, false, false>(ldsl, 2 * D, So, E); });
    PHASE(7, ph_ln2(args, G););
    PHASE(8, { pg8::StaticOrder So; So.init(ws + WS_U2, ws + WS_WTR, T, NE, 2 * D, G, blockIdx.x);
        pg8::EpiF32 E{(float*)(ws + WS_LOGITS), NE};
        pg8::gemm_phase<pg8::EpiF32, pg8::StaticOrder, false, false>(ldsl, 2 * D, So, E); });
    PHASE(9, { const int lane_ = tid & 63; const f32x4 bias4 = *(const f32x4*)(args.in[13] + 4 * lane_);
        for (int t = blockIdx.x * NWAVES + (tid >> 6); t < T; t += G * NWAVES) route_wave(t, lane_, (const float*)(ws + WS_LOGITS), bias4, (int*)(ws + WS_ROUTE), topg, cnt); });
    PHASE(10, { moe_tables(cnt, tb, nn); const int* tope = (const int*)(ws + WS_ROUTE); int* fill = (int*)ctl + CW_FILL;
        for (int id = blockIdx.x * NTHR + tid; id < T * TOPK; id += G * NTHR) { const int e = tope[id]; const int pos = atomicAdd(fill + e, 1);
            list[tb[e] * 256 + pos] = (i32x2){id, __float_as_int(topg[id])}; } });
    PHASE(11, { moe_tables(cnt, tb, nn);
        pg8::MoeOrder So{G, (int)blockIdx.x, tb[NEX] * 2, 1, tb, nn, list, (const char*)(ws + WS_U2F8), 0, (const char*)(ws + WS_WT13), (size_t)512 * D, (size_t)256 * D};
        pg8::EpiGlu E{(bf16*)(ws + WS_H), 1.f / 64.f};
        pg8::gemm_phase<pg8::EpiGlu, pg8::MoeOrder, true, true>(ldsl, D, So, E); });
    PHASE(12, { moe_tables(cnt, tb, nn);
        pg8::MoeOrder So{G, (int)blockIdx.x, tb[NEX] * 4, 2, tb, nn, list, (const char*)(ws + WS_H), (size_t)256 * FF * 2, (const char*)(ws + WS_WT2), (size_t)D * FF * 2, (size_t)256 * FF * 2};
        pg8::EpiScatter E{(unsigned char*)(ws + WS_YS), (bf16*)(ws + WS_YSH), list, nn};
        pg8::gemm_phase<pg8::EpiScatter, pg8::MoeOrder, false, false>(ldsl, 2 * FF, So, E); });
    PHASE(13, ph_final(args, G););
#undef PHASE
#undef IN
}

#ifndef MK_UPTO
#define MK_UPTO 14
#endif
__global__ void k_nan_fill(float* out, int n) { for (int i = blockIdx.x * blockDim.x + threadIdx.x; i < n; i += gridDim.x * blockDim.x) out[i] = __builtin_nanf(""); }
extern "C" void kernel_launch(void* const* d_in, const int* in_sizes, int n_in, void* d_out, int out_size, void* d_ws, size_t ws_size, hipStream_t stream) {
    static int grid = 0;
    if (grid == 0) {
        int dev = 0, cus = 0, per_cu = 0; grid = -1;
        if (n_in != 22 || out_size != T * D || ws_size < WS_END) fprintf(stderr, "kernel_launch: unexpected shapes (n_in %d out %d ws %zu, need %zu)\n", n_in, out_size, ws_size, (size_t)WS_END);
        else if (hipGetDevice(&dev) != hipSuccess || hipDeviceGetAttribute(&cus, hipDeviceAttributeMultiprocessorCount, dev) != hipSuccess) fprintf(stderr, "kernel_launch: device query failed\n");
        else if (hipFuncSetAttribute((const void*)mega_fwd, hipFuncAttributeMaxDynamicSharedMemorySize, LDS_BYTES) != hipSuccess) fprintf(stderr, "kernel_launch: hipFuncSetAttribute failed\n");
        else if (hipOccupancyMaxActiveBlocksPerMultiprocessor(&per_cu, (const void*)mega_fwd, NTHR, LDS_BYTES) != hipSuccess || per_cu < 1) fprintf(stderr, "kernel_launch: occupancy query says %d blocks per CU\n", per_cu);
        else grid = cus;
        (void)hipGetLastError();
    }
    if (grid < 0) { k_nan_fill<<<1024, 256, 0, stream>>>((float*)d_out, out_size); return; }
    const float* x = (const float*)d_in[0];
    const float* conv_w = (const float*)d_in[5]; const float* conv_b = (const float*)d_in[6];
    const float* norm_g = (const float*)d_in[8]; const float* ln1_g = (const float*)d_in[10]; const float* ln1_b = (const float*)d_in[11];
    const float* rbias = (const float*)d_in[13]; const float* ln2_g = (const float*)d_in[20]; const float* ln2_b = (const float*)d_in[21];
    char* ws = (char*)d_ws; float* out = (float*)d_out;
    float* mod = (float*)(ws + WS_MOD); bf16* wtin = (bf16*)(ws + WS_WTIN); bf16* wtout = (bf16*)(ws + WS_WTOUT); bf16* wtr = (bf16*)(ws + WS_WTR);
    bf16* wt13 = (bf16*)(ws + WS_WT13); bf16* wt2 = (bf16*)(ws + WS_WT2); int* plan = (int*)(ws + WS_PLAN);
    bf16* u1 = (bf16*)(ws + WS_U1); bf16* proj = (bf16*)(ws + WS_PROJ); float* ipre = (float*)(ws + WS_GATES); float* logf = ipre + 16 * S;
    float* hraw = (float*)(ws + WS_HRAW); bf16* mix = (bf16*)(ws + WS_MIX); bf16* mixout = (bf16*)(ws + WS_MIXOUT); bf16* u2 = (bf16*)(ws + WS_U2);
    float* logits = (float*)(ws + WS_LOGITS); int* tope = (int*)(ws + WS_ROUTE); float* topg = (float*)(ws + WS_ROUTE + 1 * MiB); i32x2* list = (i32x2*)(ws + WS_ROUTE + 2 * MiB);
    bf16* H = (bf16*)(ws + WS_H); bf16* ys = (bf16*)(ws + WS_YS); bf16* ysh = (bf16*)(ws + WS_YSH);
    int* cnt = (int*)(ws + WS_CTL) + CW_CNT;
    (void)hipMemsetAsync(ws + WS_CTL, 0, 1 * MiB, stream);
    if (MK_UPTO > 0) {
        MArgs a{};
        for (int i = 0; i < 22; ++i) a.in[i] = (const float*)d_in[i];
        a.out = out; a.ws = (unsigned char*)d_ws; a.ph_lo = 0; a.ph_hi = MK_UPTO;
        hipLaunchKernelGGL(mega_fwd, dim3(grid), dim3(NTHR), LDS_BYTES, stream, a);
    }
}
```

```cpp
#include <hip/hip_runtime.h>
#include <cstdio>
#include <cstdint>

typedef unsigned short bf16;
typedef unsigned v4u __attribute__((ext_vector_type(4)));
typedef float f32x4 __attribute__((ext_vector_type(4)));
typedef int i32x2 __attribute__((ext_vector_type(2)));
typedef float f32x2 __attribute__((ext_vector_type(2)));

constexpr int D = 1024, NB = 4, S = 8192, T = NB * S;
constexpr int NPROJ = 3584, WIN_LD = 3592;
constexpr int C_SBQ = 0, C_SBK = 512, C_SBV = 1024, C_MLQ = 1536, C_MLK = 2048, C_MLV = 2560, C_MLO = 3072, C_GATE = 3584;
constexpr int NE = 256, NEX = 257, TOPK = 8, FF = 256;
constexpr float LN_EPS = 1e-5f;
constexpr float DN_ALPHA = 1.189207115002721f;
constexpr float LOG2E = 1.4426950408889634f;
constexpr float QSCALE = 0.125f * LOG2E;
constexpr float SB_THRESH = 48.0f;

constexpr size_t MiB = 1u << 20;
constexpr size_t WS_CTL = 0;
constexpr size_t WS_MOD = 1 * MiB;
constexpr size_t WS_WTIN = 2 * MiB;
constexpr size_t WS_WTOUT = 10 * MiB;
constexpr size_t WS_WTR = 12 * MiB;
constexpr size_t WS_PLAN = 13 * MiB;
constexpr size_t WS_WT2 = 16 * MiB;
constexpr size_t WS_YS = 145 * MiB;
constexpr size_t WS_WT13 = 145 * MiB;
constexpr size_t WS_U2F8 = 274 * MiB;
constexpr size_t WS_PROJ = 402 * MiB;
constexpr size_t WS_GATES = 626 * MiB;
constexpr size_t WS_H = 657 * MiB;
constexpr size_t WS_STATES = 657 * MiB;
constexpr size_t WS_MIXOUT = 657 * MiB;
constexpr size_t WS_LOGITS = 657 * MiB;
constexpr size_t WS_U1 = 725 * MiB;
constexpr size_t WS_MIX = 725 * MiB;
constexpr size_t WS_U2 = 833 * MiB;
constexpr size_t WS_YSH = 833 * MiB;
constexpr size_t WS_HRAW = 833 * MiB;
constexpr size_t WS_ROUTE = 897 * MiB;
constexpr size_t WS_END = 902 * MiB;
constexpr int CW_CNT = 1024;
constexpr int CW_FILL = 1536;
constexpr int PL_SLOT = 0, PL_T64 = 512, PL_T256 = 1024;

__device__ __forceinline__ unsigned f2bf(float f) { unsigned u = __builtin_bit_cast(unsigned, f); return (u + 0x7fffu + ((u >> 16) & 1u)) >> 16; }
__device__ __forceinline__ float bf2f(unsigned b) { return __builtin_bit_cast(float, b << 16); }
__device__ __forceinline__ unsigned pk2(float lo, float hi) { return f2bf(lo) | (f2bf(hi) << 16); }
__device__ __forceinline__ unsigned pk4_fp8(float a, float b, float c, float d) { int w = 0; w = __builtin_amdgcn_cvt_pk_fp8_f32(a, b, w, false); w = __builtin_amdgcn_cvt_pk_fp8_f32(c, d, w, true); return (unsigned)w; }
__device__ __forceinline__ float wave_sum(float v) {
    v += __builtin_bit_cast(float, __builtin_amdgcn_update_dpp(0, __builtin_bit_cast(int, v), 0xB1, 0xF, 0xF, true));
    v += __builtin_bit_cast(float, __builtin_amdgcn_update_dpp(0, __builtin_bit_cast(int, v), 0x4E, 0xF, 0xF, true));
    v += __builtin_bit_cast(float, __builtin_amdgcn_update_dpp(0, __builtin_bit_cast(int, v), 0x141, 0xF, 0xF, true));
    v += __builtin_bit_cast(float, __builtin_amdgcn_update_dpp(0, __builtin_bit_cast(int, v), 0x140, 0xF, 0xF, true));
    const int iv = __builtin_bit_cast(int, v);
    const float r0 = __builtin_bit_cast(float, __builtin_amdgcn_readlane(iv, 0)), r1 = __builtin_bit_cast(float, __builtin_amdgcn_readlane(iv, 16));
    const float r2 = __builtin_bit_cast(float, __builtin_amdgcn_readlane(iv, 32)), r3 = __builtin_bit_cast(float, __builtin_amdgcn_readlane(iv, 48));
    return (r0 + r1) + (r2 + r3);
}
__device__ __forceinline__ float sigmoidf_(float x) { return 1.f / (1.f + __expf(-x)); }
__device__ __forceinline__ float siluf_(float x) { return x / (1.f + __expf(-x)); }


struct PrepArgs { const float *w_in, *w_out, *w_router, *w1, *w3, *w2, *sw1, *sw3, *sw2; unsigned char* wtin; bf16 *wtout, *wtr; unsigned char* wt13; unsigned char* wt2; };
struct PrepDesc { const float* src; unsigned char* dst; int ldw, ldt, k0, n0, rowmap, f8; };
constexpr int IT_IN = 16 * 56, IT_OUT = 16 * 16, IT_R = 16 * 4, IT_E = 192, IT_TOTAL = IT_IN + IT_OUT + IT_R + NEX * IT_E;
__device__ __forceinline__ PrepDesc prep_decode(const PrepArgs& a, int it) {
    if (it < IT_IN) return PrepDesc{a.w_in, a.wtin, WIN_LD, D, (it / 112) * 128, (it % 112) * 32, 0, 1}; it -= IT_IN;
    if (it < IT_OUT) return PrepDesc{a.w_out, (unsigned char*)a.wtout, D, D, (it / 16) * 64, (it % 16) * 64, 0, 0}; it -= IT_OUT;
    if (it < IT_R) return PrepDesc{a.w_router, (unsigned char*)a.wtr, NE, D, (it / 4) * 64, (it % 4) * 64, 0, 0}; it -= IT_R;
    const int e = it / IT_E, r = it % IT_E;
    if (r < 64) return PrepDesc{e < NE ? a.w1 + (size_t)e * D * FF : a.sw1, a.wt13 + (size_t)e * 512 * D, FF, D, (r / 8) * 128, (r % 8) * 32, 1, 1};
    if (r < 128) { const int q = r - 64; return PrepDesc{e < NE ? a.w3 + (size_t)e * D * FF : a.sw3, a.wt13 + (size_t)e * 512 * D, FF, D, (q / 8) * 128, (q % 8) * 32, 2, 1}; }
    const int q = r - 128; return PrepDesc{e < NE ? a.w2 + (size_t)e * FF * D : a.sw2, a.wt2 + (size_t)e * D * FF, D, FF, (q / 32) * 128, (q % 32) * 32, 0, 1};
}
__device__ __forceinline__ void prep_load(const PrepDesc& d, int lane, f32x4 (&v)[16]) {
    const int g = d.f8 ? (lane >> 3) : (lane >> 4), i = d.f8 ? (lane & 7) : (lane & 15);
#pragma unroll
    for (int r = 0; r < 16; ++r) v[r] = __builtin_nontemporal_load((const f32x4*)(d.src + (size_t)(d.k0 + 16 * g + r) * d.ldw + d.n0 + 4 * i));
}
__device__ __forceinline__ void prep_store(const PrepDesc& d, int lane, const f32x4 (&v)[16]) {
    const int g = d.f8 ? (lane >> 3) : (lane >> 4), i = d.f8 ? (lane & 7) : (lane & 15);
#pragma unroll
    for (int nn = 0; nn < 4; ++nn) {
        const int n = d.n0 + 4 * i + nn;
        const int dr = d.rowmap == 0 ? n : ((n >> 7) * 256 + (d.rowmap == 2 ? 128 : 0) + (n & 127));
        if (d.f8) {
            v4u o; o.x = pk4_fp8(v[0][nn] * 64.f, v[1][nn] * 64.f, v[2][nn] * 64.f, v[3][nn] * 64.f); o.y = pk4_fp8(v[4][nn] * 64.f, v[5][nn] * 64.f, v[6][nn] * 64.f, v[7][nn] * 64.f);
            o.z = pk4_fp8(v[8][nn] * 64.f, v[9][nn] * 64.f, v[10][nn] * 64.f, v[11][nn] * 64.f); o.w = pk4_fp8(v[12][nn] * 64.f, v[13][nn] * 64.f, v[14][nn] * 64.f, v[15][nn] * 64.f);
            *(v4u*)(d.dst + (size_t)dr * d.ldt + d.k0 + 16 * g) = o;
        } else {
            v4u o0, o1; o0.x = pk2(v[0][nn], v[1][nn]); o0.y = pk2(v[2][nn], v[3][nn]); o0.z = pk2(v[4][nn], v[5][nn]); o0.w = pk2(v[6][nn], v[7][nn]);
            o1.x = pk2(v[8][nn], v[9][nn]); o1.y = pk2(v[10][nn], v[11][nn]); o1.z = pk2(v[12][nn], v[13][nn]); o1.w = pk2(v[14][nn], v[15][nn]);
            v4u* dp = (v4u*)((bf16*)d.dst + (size_t)dr * d.ldt + d.k0 + 16 * g); dp[0] = o0; dp[1] = o1;
        }
    }
}
__device__ __forceinline__ void prep_run(const PrepArgs& a, int it0, int stride, int lane) {
    int it = it0; if (it >= IT_TOTAL) return;
    PrepDesc dA = prep_decode(a, it), dB = dA; f32x4 va[16], vb[16]; prep_load(dA, lane, va);
    for (;;) {
        const int itB = it + stride; const bool hasB = itB < IT_TOTAL;
        if (hasB) { dB = prep_decode(a, itB); prep_load(dB, lane, vb); }
        prep_store(dA, lane, va);
        if (!hasB) break;
        const int itA = itB + stride; const bool hasA = itA < IT_TOTAL;
        if (hasA) { dA = prep_decode(a, itA); prep_load(dA, lane, va); }
        prep_store(dB, lane, vb);
        if (!hasA) break;
        it = itA;
    }
}


__device__ __forceinline__ f32x4 ld_bf4(const bf16* p) { const unsigned long long w = *(const unsigned long long*)p;
    return (f32x4){bf2f((unsigned)w & 0xffffu), bf2f(((unsigned)w) >> 16), bf2f((unsigned)(w >> 32) & 0xffffu), bf2f((unsigned)(w >> 48))}; }

#define LAS __attribute__((address_space(3)))
#define GAS __attribute__((address_space(1)))
namespace pg8 {
typedef short bf16x8 __attribute__((ext_vector_type(8)));
constexpr int F8_SCALE_W = 121;
constexpr int BM = 256, BK = 64, HALF = 128, HTB = HALF * BK * 2, STAGE_BYTES = 8 * HTB, NXCD = 8, WGM = 8;
__host__ __device__ __forceinline__ int lds_byte(int r, int c) { const int st = (r >> 4) * 2 + (c >> 5), rr = r & 15, cc = c & 31, ob = rr * 64 + cc * 2; return st * 1024 + (ob ^ (((ob >> 9) & 1) << 5)); }
__host__ __device__ __forceinline__ void stage_rc(int b, int& R, int& C) { const int st = b / 1024, sb = b % 1024, swz = sb ^ (((sb >> 9) & 1) << 5); R = (st >> 1) * 16 + swz / 64; C = (st & 1) * 32 + (swz % 64) / 2; }
__host__ __device__ __forceinline__ int perm32(int rho) { const int n = rho >> 4, i = rho & 15; return 8 * (i >> 2) + 4 * n + (i & 3); }

struct Unit { int pm, pn, e, mt; const char* A; const char* B; };

__device__ __forceinline__ long unit_index(int i, int G, int c) { return (G % 8 == 0) ? ((long)(i * 8 + (c & 7)) * (G / 8) + (c >> 3)) : ((long)i * G + c); }

struct StaticOrder {
    int nM, nN, nwg, G, c; const char* A; const char* B; size_t tstep;
    __device__ void init(const void* A_, const void* B_, int M, int N, int Kb, int G_, int c_) { nM = M / BM; nN = N / BM; nwg = nM * nN; G = G_; c = c_; A = (const char*)A_; B = (const char*)B_; tstep = (size_t)BM * Kb; }
    __device__ __forceinline__ bool next(int i, Unit& u) const {
        const long L = (long)i * G + c; if (L >= nwg) return false;
        int wgid = (int)L; { const int q = nwg / NXCD, r = nwg % NXCD, xcd = wgid % NXCD, off = wgid / NXCD; wgid = (xcd < r ? xcd * (q + 1) : r * (q + 1) + (xcd - r) * q) + off; }
        const int nig = WGM * nN, gid = wgid / nig, fm = gid * WGM, gsz = (nM - fm) < WGM ? (nM - fm) : WGM;
        u.pm = fm + ((wgid % nig) % gsz); u.pn = (wgid % nig) / gsz; u.e = 0; u.mt = u.pm; u.A = A + (size_t)u.pm * tstep; u.B = B + (size_t)u.pn * tstep; return true;
    }
    __device__ __forceinline__ int row_token(const Unit&, int) const { return 0; }
};

struct MoeOrder {
    int G, c, total, shift; const LAS int* tb; const LAS int* nn; const i32x2* list;
    const char* Abase; size_t a_tile_stride; const char* Bbase; size_t b_exp_stride, b_pn_stride;
    __device__ __forceinline__ bool next(int i, Unit& u) const {
        const long L = unit_index(i, G, c); if (L >= total) return false;
        const int tile = (int)(L >> shift); u.pn = (int)(L & ((1 << shift) - 1));
        int lo = 0, hi = NEX; while (hi - lo > 1) { const int mid = (lo + hi) >> 1; if (tb[mid] <= tile) lo = mid; else hi = mid; }
        u.e = lo; u.mt = tile - tb[lo]; u.pm = tile;
        u.A = Abase + (size_t)tile * a_tile_stride; u.B = Bbase + (size_t)lo * b_exp_stride + (size_t)u.pn * b_pn_stride; return true;
    }
    __device__ __forceinline__ int row_token(const Unit& u, int row) const {
        const int rr = u.mt * 256 + row;
        const int tok = list[u.pm * 256 + row].x >> 3;
        return u.e >= NE ? rr : (rr < nn[u.e] ? tok : 0);
    }
};

__device__ __forceinline__ unsigned cvt_pk_bf16(float lo, float hi) { unsigned r; asm volatile("v_cvt_pk_bf16_f32 %0, %1, %2" : "=v"(r) : "v"(lo), "v"(hi)); return r; }

struct EpiBf16 {
    static constexpr bool PERM = true; bf16* O; int ldc; int scale_tiles; float scale; float gscale;
    __device__ __forceinline__ void operator()(const f32x4 (&acc)[2][2][4][2], const Unit& u, int wr, int wc, int fr, int fq) const {
        const int row0 = u.pm * BM + wr * 64 + fr, col0 = u.pn * BM + wc * 32 + 8 * fq; const float sc = (u.pn < scale_tiles ? scale : 1.f) * gscale;
#pragma unroll
        for (int ai = 0; ai < 2; ++ai)
#pragma unroll
            for (int m = 0; m < 4; ++m) { bf16* rowp = O + (size_t)(row0 + ai * HALF + m * 16) * ldc + col0;
#pragma unroll
                for (int bj = 0; bj < 2; ++bj) { const f32x4 v0 = acc[ai][bj][m][0] * sc, v1 = acc[ai][bj][m][1] * sc;
                    v4u w; w.x = cvt_pk_bf16(v0[0], v0[1]); w.y = cvt_pk_bf16(v0[2], v0[3]); w.z = cvt_pk_bf16(v1[0], v1[1]); w.w = cvt_pk_bf16(v1[2], v1[3]);
                    *(v4u*)(rowp + bj * HALF) = w; } }
    }
};
struct EpiF32 {
    static constexpr bool PERM = false; float* C; int ldc;
    __device__ __forceinline__ void operator()(const f32x4 (&acc)[2][2][4][2], const Unit& u, int wr, int wc, int fr, int fq) const {
        const int row0 = u.pm * BM + wr * 64 + fr, col0 = u.pn * BM + wc * 32 + 4 * fq;
#pragma unroll
        for (int ai = 0; ai < 2; ++ai)
#pragma unroll
            for (int m = 0; m < 4; ++m) { float* rowp = C + (size_t)(row0 + ai * HALF + m * 16) * ldc + col0;
#pragma unroll
                for (int bj = 0; bj < 2; ++bj)
#pragma unroll
                    for (int n = 0; n < 2; ++n) *(f32x4*)(rowp + bj * HALF + n * 16) = acc[ai][bj][m][n]; }
    }
};
struct EpiGlu {
    static constexpr bool PERM = true; unsigned char* H; float gscale;
    __device__ __forceinline__ void operator()(const f32x4 (&acc)[2][2][4][2], const Unit& u, int wr, int wc, int fr, int fq) const {
        const int row0 = u.pm * BM + wr * 64 + fr, col0 = u.pn * HALF + wc * 32 + 8 * fq;
#pragma unroll
        for (int ai = 0; ai < 2; ++ai)
#pragma unroll
            for (int m = 0; m < 4; ++m) { float h[8];
#pragma unroll
                for (int n = 0; n < 2; ++n)
#pragma unroll
                    for (int q = 0; q < 4; ++q) { const float a = acc[ai][0][m][n][q] * gscale; h[n * 4 + q] = a * __builtin_amdgcn_rcpf(1.f + __expf(-a)) * (acc[ai][1][m][n][q] * gscale); }
                *(unsigned long long*)(H + (size_t)(row0 + ai * HALF + m * 16) * FF + col0) = (unsigned long long)pk4_fp8(h[0], h[1], h[2], h[3]) | ((unsigned long long)pk4_fp8(h[4], h[5], h[6], h[7]) << 32); }
    }
};
struct EpiScatter {
    static constexpr bool PERM = true; unsigned char* ys8; bf16* ysh; const i32x2* list; const LAS int* nn;
    __device__ __forceinline__ void operator()(const f32x4 (&acc)[2][2][4][2], const Unit& u, int wr, int wc, int fr, int fq) const {
        const int col0 = u.pn * BM + wc * 32 + 8 * fq; const int n = nn[u.e]; const bool routed = u.e < NE;
        const i32x2* lp = list + (size_t)(u.pm - u.mt) * 256;
#pragma unroll
        for (int ai = 0; ai < 2; ++ai) {
            i32x2 en[4];
#pragma unroll
            for (int m = 0; m < 4; ++m) { const int rr = u.mt * 256 + ai * HALF + wr * 64 + m * 16 + fr; const i32x2 ld = lp[rr];
                en[m].x = routed ? ld.x : rr; en[m].y = routed ? ld.y : 0x3f800000; }
#pragma unroll
            for (int m = 0; m < 4; ++m) { const int rr = u.mt * 256 + ai * HALF + wr * 64 + m * 16 + fr;
                if (rr < n) {
                    if (routed) { unsigned char* dst = ys8 + (size_t)en[m].x * D + col0; const float g = __int_as_float(en[m].y) * (16.f / 64.f);
#pragma unroll
                        for (int bj = 0; bj < 2; ++bj) { const f32x4 v0 = acc[ai][bj][m][0] * g, v1 = acc[ai][bj][m][1] * g;
                            *(unsigned long long*)(dst + bj * HALF) = (unsigned long long)pk4_fp8(v0[0], v0[1], v0[2], v0[3]) | ((unsigned long long)pk4_fp8(v1[0], v1[1], v1[2], v1[3]) << 32); } }
                    else { bf16* dst = ysh + (size_t)rr * D + col0;
#pragma unroll
                        for (int bj = 0; bj < 2; ++bj) { const f32x4 v0 = acc[ai][bj][m][0] * (1.f / 64.f), v1 = acc[ai][bj][m][1] * (1.f / 64.f);
                            v4u w; w.x = cvt_pk_bf16(v0[0], v0[1]); w.y = cvt_pk_bf16(v0[2], v0[3]); w.z = cvt_pk_bf16(v1[0], v1[1]); w.w = cvt_pk_bf16(v1[2], v1[3]);
                            *(v4u*)(dst + bj * HALF) = w; } } } }
            __builtin_amdgcn_sched_barrier(0);
        }
    }
};

typedef int i32x8 __attribute__((ext_vector_type(8)));
typedef int i32x4 __attribute__((ext_vector_type(4)));
template <bool FP8> struct FragT { struct A4 { bf16x8 v[4][2]; }; struct B2 { bf16x8 v[2][2]; }; };
template <> struct FragT<true> { struct A4 { i32x8 v[4]; }; struct B2 { i32x8 v[2]; }; };
template <class Epi, class Sched, bool GATHER, bool FP8>
__device__ __forceinline__ void gemm_phase(LAS unsigned char* lds, const int Kb, const Sched& S, const Epi& E) {
    const int tid = threadIdx.x, wid = __builtin_amdgcn_readfirstlane(tid >> 6), lane = tid & 63, wr = wid >> 2, wc = wid & 3, fr = lane & 15, fq = lane >> 4;
    const int nt = Kb / 128;
    int sR[2], sC[2];
    unsigned voffA[2], voffB[2];
#pragma unroll
    for (int i = 0; i < 2; ++i) { stage_rc(tid * 16 + i * 8192, sR[i], sC[i]); const int Rb = Epi::PERM ? ((sR[i] & ~31) + perm32(sR[i] & 31)) : sR[i];
        voffA[i] = (unsigned)(sR[i] * Kb + sC[i] * 2); voffB[i] = (unsigned)(Rb * Kb + sC[i] * 2); }
    const size_t kstep = (size_t)(BK * 2);
    const size_t hstep = (size_t)HALF * Kb;
    const unsigned ldsw = (unsigned)wid * 1024u;
    const int aoff = lds_byte(wr * 64 + fr, fq * 8), boff = lds_byte(wc * 32 + fr, fq * 8);
    unsigned gc[2][2], gn[2][2];
#define PG8_SA(b, h) (((b) * 2 + (h)) * HTB)
#define PG8_SB(b, h) ((4 + (b) * 2 + (h)) * HTB)
#define PG8_GLDS(src, bufoff, i) __builtin_amdgcn_global_load_lds((const unsigned*)(src), (LAS unsigned*)(lds + (bufoff) + ldsw + (i) * 8192), 16, 0, 0)
#define PG8_STAGE_B(bufoff, gbase) do { PG8_GLDS((const char*)(gbase) + voffB[0], bufoff, 0); PG8_GLDS((const char*)(gbase) + voffB[1], bufoff, 1); } while (0)
#define PG8_STAGE_A(bufoff, gbase, h, nx) do { if constexpr (GATHER) { const unsigned _o0 = (nx) ? gn[h][0] : gc[h][0], _o1 = (nx) ? gn[h][1] : gc[h][1]; \
            PG8_GLDS((const char*)(gbase) + _o0, bufoff, 0); PG8_GLDS((const char*)(gbase) + _o1, bufoff, 1); } \
        else { PG8_GLDS((const char*)(gbase) + (h) * hstep + voffA[0], bufoff, 0); PG8_GLDS((const char*)(gbase) + (h) * hstep + voffA[1], bufoff, 1); } } while (0)
#define PG8_LD2(dstv, p) do { if constexpr (FP8) { const i32x4 _lo = *(const LAS i32x4*)(p), _hi = *(const LAS i32x4*)((p) + 1024); dstv = __builtin_shufflevector(_lo, _hi, 0, 1, 2, 3, 4, 5, 6, 7); } } while (0)
#define PG8_LDA(dst, b, h) do { _Pragma("unroll") for (int m = 0; m < 4; ++m) { if constexpr (FP8) { PG8_LD2(dst.v[m], lds + PG8_SA(b, h) + aoff + m * 2048); } \
        else { _Pragma("unroll") for (int k = 0; k < 2; ++k) dst.v[m][k] = *(const LAS bf16x8*)(lds + PG8_SA(b, h) + aoff + m * 2048 + k * 1024); } } } while (0)
#define PG8_LDB(dst, b, h) do { _Pragma("unroll") for (int n = 0; n < 2; ++n) { if constexpr (FP8) { PG8_LD2(dst.v[n], lds + PG8_SB(b, h) + boff + n * 2048); } \
        else { _Pragma("unroll") for (int k = 0; k < 2; ++k) dst.v[n][k] = *(const LAS bf16x8*)(lds + PG8_SB(b, h) + boff + n * 2048 + k * 1024); } } } while (0)
#define PG8_MMA(ai, bj, At, Bt) do { __builtin_amdgcn_s_setprio(1); _Pragma("unroll") for (int m = 0; m < 4; ++m) _Pragma("unroll") for (int n = 0; n < 2; ++n) { \
        if constexpr (FP8) asm volatile("s_nop 1\n\tv_mfma_scale_f32_16x16x128_f8f6f4 %0, %1, %2, %0, %3, %3 op_sel_hi:[0,0,0]" : "+v"(acc[ai][bj][m][n]) : "v"(Bt.v[n]), "v"(At.v[m]), "v"(f8scale)); \
        else { _Pragma("unroll") for (int k = 0; k < 2; ++k) acc[ai][bj][m][n] = __builtin_amdgcn_mfma_f32_16x16x32_bf16(Bt.v[n][k], At.v[m][k], acc[ai][bj][m][n], 0, 0, 0); } } \
        __builtin_amdgcn_s_setprio(0); } while (0)
#define PG8_WAIT_V(n) asm volatile("s_waitcnt vmcnt(" #n ")" ::: "memory")
#define PG8_WAIT_L(n) asm volatile("s_waitcnt lgkmcnt(" #n ")" ::: "memory")
#define PG8_BAR __builtin_amdgcn_s_barrier()
#define PG8_SCHED __builtin_amdgcn_sched_barrier(0)
#define PG8_GATHER(dst, u) do { _Pragma("unroll") for (int _h = 0; _h < 2; ++_h) _Pragma("unroll") for (int _i = 0; _i < 2; ++_i) \
        dst[_h][_i] = (unsigned)(S.row_token(u, _h * HALF + sR[_i]) * Kb + sC[_i] * 2); } while (0)
    Unit cur, nxt; int ui = 0;
    if (!S.next(0, cur)) return;
    f32x4 acc[2][2][4][2];
#pragma unroll
    for (int a = 0; a < 2; ++a)
#pragma unroll
        for (int b = 0; b < 2; ++b)
#pragma unroll
            for (int m = 0; m < 4; ++m)
#pragma unroll
                for (int n = 0; n < 2; ++n) acc[a][b][m][n] = (f32x4){0.f, 0.f, 0.f, 0.f};
    const int f8scale = 0x7f7f7f7f;
    typedef typename FragT<FP8>::A4 FragA; typedef typename FragT<FP8>::B2 FragB;
    FragA At; FragB B0, B1;
    const char* cA = cur.A; const char* cB = cur.B;
    if constexpr (GATHER) { PG8_GATHER(gc, cur); }
    PG8_STAGE_B(PG8_SB(0, 0), cB); PG8_STAGE_A(PG8_SA(0, 0), cA, 0, false); PG8_STAGE_B(PG8_SB(0, 1), cB + hstep); PG8_STAGE_A(PG8_SA(0, 1), cA, 1, false);
    if (wr == 1) PG8_BAR;
    PG8_WAIT_V(4); PG8_BAR;
    PG8_STAGE_B(PG8_SB(1, 0), cB + kstep); PG8_STAGE_A(PG8_SA(1, 0), cA + kstep, 0, false); PG8_STAGE_B(PG8_SB(1, 1), cB + hstep + kstep);
    PG8_WAIT_V(6); PG8_BAR;
    for (;;) {
        const bool has_next = S.next(ui + 1, nxt);
        const char* nA = has_next ? nxt.A : cA; const char* nB = has_next ? nxt.B : cB;
        if constexpr (GATHER) { if (has_next) { PG8_GATHER(gn, nxt); } else {
#pragma unroll
            for (int h = 0; h < 2; ++h) { gn[h][0] = gc[h][0]; gn[h][1] = gc[h][1]; } } }
#pragma unroll 1
        for (int t = 0; t < nt; t += 2) {
            const bool last = (t == nt - 2);
            const char* a1 = cA + (size_t)(t + 1) * kstep;
            const char* a2 = last ? nA : cA + (size_t)(t + 2) * kstep; const char* b2 = last ? nB : cB + (size_t)(t + 2) * kstep;
            const char* a3 = a2 + kstep; const char* b3 = b2 + kstep;
            PG8_LDB(B0, 0, 0); PG8_SCHED; PG8_LDA(At, 0, 0); PG8_STAGE_A(PG8_SA(1, 1), a1, 1, false);
            PG8_WAIT_L(8); PG8_BAR; PG8_WAIT_L(0); PG8_MMA(0, 0, At, B0); PG8_BAR; PG8_SCHED;
            PG8_LDB(B1, 0, 1); PG8_STAGE_B(PG8_SB(0, 0), b2);
            PG8_BAR; PG8_WAIT_L(0); PG8_MMA(0, 1, At, B1); PG8_BAR;
            PG8_LDA(At, 0, 1); PG8_STAGE_A(PG8_SA(0, 0), a2, 0, last);
            PG8_BAR; PG8_WAIT_L(0); PG8_MMA(1, 0, At, B0); PG8_BAR; PG8_SCHED;
            PG8_STAGE_B(PG8_SB(0, 1), b2 + hstep);
            PG8_WAIT_V(6); PG8_BAR; PG8_MMA(1, 1, At, B1); PG8_BAR;
            PG8_LDB(B0, 1, 0); PG8_SCHED; PG8_LDA(At, 1, 0); PG8_STAGE_A(PG8_SA(0, 1), a2, 1, last);
            PG8_WAIT_L(8); PG8_BAR; PG8_WAIT_L(0); PG8_MMA(0, 0, At, B0); PG8_BAR; PG8_SCHED;
            PG8_LDB(B1, 1, 1); PG8_STAGE_B(PG8_SB(1, 0), b3);
            PG8_BAR; PG8_WAIT_L(0); PG8_MMA(0, 1, At, B1); PG8_BAR;
            PG8_LDA(At, 1, 1); PG8_STAGE_A(PG8_SA(1, 0), a3, 0, last);
            PG8_BAR; PG8_WAIT_L(0); PG8_MMA(1, 0, At, B0); PG8_BAR; PG8_SCHED;
            PG8_STAGE_B(PG8_SB(1, 1), b3 + hstep);
            PG8_WAIT_V(6); PG8_BAR; PG8_MMA(1, 1, At, B1); PG8_BAR;
        }
        if (wr == 0) PG8_BAR;
        if constexpr (FP8) { __builtin_amdgcn_sched_barrier(0); asm volatile("s_nop 15\n\ts_nop 7" ::: "memory"); __builtin_amdgcn_sched_barrier(0); }
        E(acc, cur, wr, wc, fr, fq);
        if (!has_next) break;
#pragma unroll
        for (int a = 0; a < 2; ++a)
#pragma unroll
            for (int b = 0; b < 2; ++b)
#pragma unroll
                for (int m = 0; m < 4; ++m)
#pragma unroll
                    for (int n = 0; n < 2; ++n) acc[a][b][m][n] = (f32x4){0.f, 0.f, 0.f, 0.f};
        cur = nxt; cA = nA; cB = nB; ++ui;
        if (wr == 1) PG8_BAR;
        if constexpr (GATHER) {
#pragma unroll
            for (int h = 0; h < 2; ++h) { gc[h][0] = gn[h][0]; gc[h][1] = gn[h][1]; } }
    }
    PG8_WAIT_V(0);
    PG8_BAR;
#undef PG8_SA
#undef PG8_SB
#undef PG8_GLDS
#undef PG8_STAGE_A
#undef PG8_STAGE_B
#undef PG8_LDA
#undef PG8_LDB
#undef PG8_MMA
#undef PG8_WAIT_V
#undef PG8_WAIT_L
#undef PG8_BAR
#undef PG8_SCHED
#undef PG8_GATHER
}
}

#define XB_TMO      128
#define XB_XCNT(j)  (256  + 64 * (j))
#define XB_XSUB(j)  (1280 + 64 * (j))
#define XB_XGEN(j)  (2304 + 64 * (j))
#define XB_TOP      3328
#define XB_TOPGEN   3392
#define XCD_BAR_WORDS 3456
#define XB_SPIN_CAP (1u << 22)
__device__ __forceinline__ unsigned xb_ld(unsigned* p)              { return __hip_atomic_load(p, __ATOMIC_RELAXED, __HIP_MEMORY_SCOPE_AGENT); }
__device__ __forceinline__ unsigned xb_add(unsigned* p, unsigned v) { return __hip_atomic_fetch_add(p, v, __ATOMIC_RELAXED, __HIP_MEMORY_SCOPE_AGENT); }
__device__ __forceinline__ unsigned xb_xcc_id() { return (unsigned)__builtin_amdgcn_s_getreg((3 << 11) | 20) & 0xFu; }
#define XB_SPIN(cond, bar) do { unsigned _sp = 0; while (cond) { __builtin_amdgcn_s_sleep(1); \
    if ((++_sp & 255u) == 0u) { if (xb_ld(&(bar)[XB_TMO])) break; if (_sp > XB_SPIN_CAP) { atomicAdd(&(bar)[XB_TMO], 1u); break; } } } } while (0)
struct XcdBarrier { unsigned* bar; unsigned x; volatile LAS unsigned* st; };
__device__ __forceinline__ XcdBarrier xcd_barrier_post(unsigned* bar, volatile LAS unsigned* st) {
    XcdBarrier b; b.bar = bar; b.x = xb_xcc_id(); b.st = st;
    if (threadIdx.x == 0) (void)xb_add(&bar[XB_XCNT(b.x)], 1u);
    return b;
}
__device__ __forceinline__ void xcd_barrier_complete(unsigned* bar, unsigned x, unsigned& nloc, unsigned& nx) {
    const unsigned G = gridDim.x * gridDim.y * gridDim.z;
    unsigned sum, cnt, mine, sp = 0u;
    for (;;) {
        sum = 0u; cnt = 0u; mine = 0u;
#pragma unroll
        for (unsigned j = 0; j < 16; ++j) { const unsigned c = xb_ld(&bar[XB_XCNT(j)]); sum += c; cnt += (c > 0u) ? 1u : 0u; mine = (j == x) ? c : mine; }
        if (sum == G) break;
        __builtin_amdgcn_s_sleep(1);
        if ((++sp & 255u) == 0u) { if (xb_ld(&bar[XB_TMO])) break; if (sp > XB_SPIN_CAP) { atomicAdd(&bar[XB_TMO], 1u); break; } }
    }
    nloc = mine > 0u ? mine : 1u; nx = cnt > 0u ? cnt : 1u;
}
__device__ __forceinline__ void xcd_barrier(const XcdBarrier& b) {
    asm volatile("s_waitcnt vmcnt(0)" ::: "memory");
    __syncthreads();
    if (threadIdx.x == 0) {
        unsigned* bar = b.bar;
        __builtin_amdgcn_s_waitcnt(0);
        unsigned nloc = b.st[0], nx = b.st[1];
        if (nloc == 0u) { xcd_barrier_complete(bar, b.x, nloc, nx); b.st[0] = nloc; b.st[1] = nx; }
        const unsigned old = xb_add(&bar[XB_XSUB(b.x)], 1u);
        const unsigned gen = old / nloc;
        if (old + 1u == (gen + 1u) * nloc) {
            __builtin_amdgcn_fence(__ATOMIC_RELEASE, "agent");
            asm volatile("s_waitcnt vmcnt(0)" ::: "memory");
            const unsigned og = xb_add(&bar[XB_TOP], 1u);
            const unsigned tg = og / nx;
            if (og + 1u == (tg + 1u) * nx) xb_add(&bar[XB_TOPGEN], 1u);
            else XB_SPIN(xb_ld(&bar[XB_TOPGEN]) == tg, bar);
            __builtin_amdgcn_fence(__ATOMIC_ACQUIRE, "agent");
            xb_add(&bar[XB_XGEN(b.x)], 1u);
            asm volatile("s_waitcnt vmcnt(0)" ::: "memory");
        } else {
            XB_SPIN(xb_ld(&bar[XB_XGEN(b.x)]) == gen, bar);
            __builtin_amdgcn_fence(__ATOMIC_ACQUIRE, "agent");
            asm volatile("s_waitcnt vmcnt(0)" ::: "memory");
        }
    }
    __syncthreads();
}

constexpr int NWAVES = 8, NTHR = 512;
constexpr int RING_BYTES = 131072, XTRA_OFF = RING_BYTES, LDS_BYTES = 147456;
constexpr int X_MISC = 0, X_TB = 256, X_NN = 1536;
constexpr int CW_BAR = 4096;
constexpr int N_PHASES = 14;
struct MArgs { const float* in[22]; float* out; unsigned char* ws; int ph_lo, ph_hi; };

__device__ __forceinline__ void ph_mod_prep(const MArgs& a, unsigned char* smem, int G) {
    const int tid = threadIdx.x;
    unsigned char* ws = a.ws;
    if ((int)blockIdx.x < 192) {
        float* sc = (float*)smem; float* red = sc + NB * D;
        const float* c = a.in[1]; const float* w_ada = a.in[2]; const float* b_ada = a.in[3]; float* mod = (float*)(ws + WS_MOD);
        for (int i = tid; i < NB * D; i += NTHR) sc[i] = siluf_(c[i]);
        __syncthreads();
        for (int it = blockIdx.x; it < 192; it += G) {
            const int kq = tid >> 5, jl = tid & 31, j = it * 32 + jl;
            float a0 = 0.f, a1 = 0.f, a2 = 0.f, a3 = 0.f;
#pragma unroll 16
            for (int kk = 0; kk < 64; ++kk) { const int k = kq * 64 + kk; const float w = w_ada[(size_t)k * 6144 + j];
                a0 += sc[k] * w; a1 += sc[D + k] * w; a2 += sc[2 * D + k] * w; a3 += sc[3 * D + k] * w; }
            red[(kq * 4 + 0) * 32 + jl] = a0; red[(kq * 4 + 1) * 32 + jl] = a1; red[(kq * 4 + 2) * 32 + jl] = a2; red[(kq * 4 + 3) * 32 + jl] = a3;
            __syncthreads();
            if (tid < 128) { const int b = tid >> 5; float s = b_ada[j];
#pragma unroll
                for (int q = 0; q < 16; ++q) s += red[(q * 4 + b) * 32 + jl];
                mod[b * 6144 + j] = s; }
            __syncthreads();
        }
    }
    PrepArgs pa{a.in[4], a.in[9], a.in[12], a.in[14], a.in[15], a.in[16], a.in[17], a.in[18], a.in[19],
                (unsigned char*)(ws + WS_WTIN), (bf16*)(ws + WS_WTOUT), (bf16*)(ws + WS_WTR), (unsigned char*)(ws + WS_WT13), (unsigned char*)(ws + WS_WT2)};
    const int lane = tid & 63, gw = blockIdx.x * NWAVES + (tid >> 6), ngw = G * NWAVES;
    prep_run(pa, gw, ngw, lane);
}

__device__ __forceinline__ void ph_ln1(const MArgs& a, unsigned char* smem, int G) {
    const int tid = threadIdx.x, lane = tid & 63, wave = tid >> 6;
    const float* x = a.in[0]; const float* w_in = a.in[4]; const float* gate_b = a.in[7];
    const float* mod = (const float*)(a.ws + WS_MOD); unsigned char* u1 = (unsigned char*)(a.ws + WS_U1); float* ipre = (float*)(a.ws + WS_GATES); float* logf = ipre + 16 * S;
    float* wg = (float*)smem;
    for (int i = tid; i < D * 8; i += NTHR) wg[i] = w_in[(size_t)(i >> 3) * WIN_LD + C_GATE + (i & 7)];
    __syncthreads();
    for (int it = blockIdx.x; it < T / 128; it += G) {
        const int row0 = it * 128, b = row0 / S;
        f32x4 sh[4], sc[4];
#pragma unroll
        for (int j = 0; j < 4; ++j) { sh[j] = *(const f32x4*)(mod + b * 6144 + 4 * lane + 256 * j); sc[j] = *(const f32x4*)(mod + b * 6144 + 1024 + 4 * lane + 256 * j); }
        for (int rr = wave; rr < 128; rr += NWAVES) {
            const int row = row0 + rr;
            const f32x4* xr = (const f32x4*)(x + (size_t)row * D) + lane;
            f32x4 v[4]; float s = 0.f;
#pragma unroll
            for (int j = 0; j < 4; ++j) { v[j] = xr[64 * j]; s += (v[j].x + v[j].y) + (v[j].z + v[j].w); }
            const float mean = wave_sum(s) * (1.f / D); float s2 = 0.f;
#pragma unroll
            for (int j = 0; j < 4; ++j) { v[j] = v[j] - mean; s2 += (v[j].x * v[j].x + v[j].y * v[j].y) + (v[j].z * v[j].z + v[j].w * v[j].w); }
            const float rstd = 1.f / sqrtf(wave_sum(s2) * (1.f / D) + LN_EPS);
            float ga[8];
#pragma unroll
            for (int q = 0; q < 8; ++q) ga[q] = 0.f;
            unsigned* o4 = (unsigned*)(u1 + (size_t)row * D) + lane;
#pragma unroll
            for (int j = 0; j < 4; ++j) {
                const f32x4 u = v[j] * rstd * (sc[j] + 1.0f) + sh[j];
                o4[64 * j] = pk4_fp8(u.x, u.y, u.z, u.w);
#pragma unroll
                for (int e = 0; e < 4; ++e) { const int k = 4 * lane + 256 * j + e;
                    const f32x4 w0 = *(const f32x4*)(wg + k * 8), w1 = *(const f32x4*)(wg + k * 8 + 4);
                    ga[0] += u[e] * w0.x; ga[1] += u[e] * w0.y; ga[2] += u[e] * w0.z; ga[3] += u[e] * w0.w;
                    ga[4] += u[e] * w1.x; ga[5] += u[e] * w1.y; ga[6] += u[e] * w1.z; ga[7] += u[e] * w1.w; }
            }
#pragma unroll
            for (int q = 0; q < 8; ++q) ga[q] = wave_sum(ga[q]);
            if (lane < 8) {
                float gv = 0.f;
#pragma unroll
                for (int q = 0; q < 8; ++q) gv = (lane == q) ? ga[q] : gv;
                gv += gate_b[lane];
                const int h = lane & 3, s_ = row % S;
                if (lane < 4) ipre[(size_t)(b * 4 + h) * S + s_] = gv;
                else logf[(size_t)(b * 4 + h) * S + s_] = fminf(gv, 0.f) - log1pf(__expf(-fabsf(gv)));
            }
        }
    }
}

__device__ __forceinline__ void ph_ln2(const MArgs& a, int G) {
    const float* x = a.in[0]; const bf16* mixout = (const bf16*)(a.ws + WS_MIXOUT); const float* mod = (const float*)(a.ws + WS_MOD); const float* ln1_g = a.in[10]; const float* ln1_b = a.in[11];
    float* x1 = a.out; bf16* u2 = (bf16*)(a.ws + WS_U2); unsigned char* u2f8 = (unsigned char*)(a.ws + WS_U2F8);
    const int tid = threadIdx.x, lane = tid & 63, wave = tid >> 6;
    for (int it = blockIdx.x; it < T / 128; it += G) {
        const int row0 = it * 128, b = row0 / S;
        f32x4 g1[4], lg[4], lb[4], sc2[4], sh2[4];
#pragma unroll
        for (int j = 0; j < 4; ++j) { const int col = 4 * lane + 256 * j;
            g1[j] = *(const f32x4*)(mod + b * 6144 + 2048 + col); lg[j] = *(const f32x4*)(ln1_g + col); lb[j] = *(const f32x4*)(ln1_b + col);
            sc2[j] = *(const f32x4*)(mod + b * 6144 + 4096 + col) + 1.0f; sh2[j] = *(const f32x4*)(mod + b * 6144 + 3072 + col); }
        for (int rr = wave; rr < 128; rr += NWAVES) {
            const int row = row0 + rr;
            f32x4 v[4]; float s = 0.f;
#pragma unroll
            for (int j = 0; j < 4; ++j) {
                const int col = 4 * lane + 256 * j;
                const f32x4 xv = __builtin_nontemporal_load((const f32x4*)(x + (size_t)row * D + col));
                const f32x4 mo = ld_bf4(mixout + (size_t)row * D + col);
                v[j] = xv * DN_ALPHA + g1[j] * mo; s += (v[j].x + v[j].y) + (v[j].z + v[j].w);
            }
            float mean = wave_sum(s) * (1.f / D), s2 = 0.f;
#pragma unroll
            for (int j = 0; j < 4; ++j) { v[j] = v[j] - mean; s2 += (v[j].x * v[j].x + v[j].y * v[j].y) + (v[j].z * v[j].z + v[j].w * v[j].w); }
            float rstd = 1.f / sqrtf(wave_sum(s2) * (1.f / D) + LN_EPS);
            s = 0.f;
#pragma unroll
            for (int j = 0; j < 4; ++j) { const int col = 4 * lane + 256 * j;
                v[j] = v[j] * rstd * lg[j] + lb[j];
                *(f32x4*)(x1 + (size_t)row * D + col) = v[j]; s += (v[j].x + v[j].y) + (v[j].z + v[j].w); }
            mean = wave_sum(s) * (1.f / D); s2 = 0.f;
#pragma unroll
            for (int j = 0; j < 4; ++j) { v[j] = v[j] - mean; s2 += (v[j].x * v[j].x + v[j].y * v[j].y) + (v[j].z * v[j].z + v[j].w * v[j].w); }
            rstd = 1.f / sqrtf(wave_sum(s2) * (1.f / D) + LN_EPS);
#pragma unroll
            for (int j = 0; j < 4; ++j) { const int col = 4 * lane + 256 * j;
                const f32x4 u = v[j] * rstd * sc2[j] + sh2[j];
                *(unsigned long long*)(u2 + (size_t)row * D + col) = (unsigned long long)pk2(u.x, u.y) | ((unsigned long long)pk2(u.z, u.w) << 32);
                *(unsigned*)(u2f8 + (size_t)row * D + col) = pk4_fp8(u.x, u.y, u.z, u.w); }
        }
    }
}
__device__ __forceinline__ void route_wave(int t, int lane, const float* __restrict__ logits, const f32x4 bias4, int* __restrict__ tope, float* __restrict__ topg, int* __restrict__ cnt) {
    const f32x4 lg = *(const f32x4*)(logits + (size_t)t * NE + 4 * lane);
    float sc[4], v[4];
#pragma unroll
    for (int j = 0; j < 4; ++j) { sc[j] = 1.f / (1.f + __expf(-lg[j])); v[j] = sc[j] + bias4[j]; }
    float m1 = fmaxf(fmaxf(v[0], v[1]), fmaxf(v[2], v[3]));
    float m2; { const float a = fmaxf(v[0], v[1]), b = fminf(v[0], v[1]), c = fmaxf(v[2], v[3]), d = fminf(v[2], v[3]); m2 = fmaxf(fminf(a, c), fmaxf(b, d)); }
#pragma unroll
    for (int o = 1; o < 8; o <<= 1) { const float o1 = __shfl_xor(m1, o), o2 = __shfl_xor(m2, o); const float n1 = fmaxf(m1, o1); m2 = fmaxf(fminf(m1, o1), fmaxf(m2, o2)); m1 = n1; }
    const float gs = m1 + m2; const int myg = lane >> 3; int rank = 0;
#pragma unroll
    for (int gg = 0; gg < 8; ++gg) { const float og = __shfl(gs, gg * 8); rank += (og > gs || (og == gs && gg < myg)) ? 1 : 0; }
    if (rank >= 4) {
#pragma unroll
        for (int j = 0; j < 4; ++j) v[j] = -INFINITY; }
    int myE = 0; float myS = 0.f, gsum = 0.f;
#pragma unroll
    for (int rd = 0; rd < 8; ++rd) {
        float bv = v[0]; int bi = 4 * lane;
#pragma unroll
        for (int j = 1; j < 4; ++j) if (v[j] > bv) { bv = v[j]; bi = 4 * lane + j; }
#pragma unroll
        for (int o = 1; o < 64; o <<= 1) { const float ov = __shfl_xor(bv, o); const int oi = __shfl_xor(bi, o); if (ov > bv || (ov == bv && oi < bi)) { bv = ov; bi = oi; } }
        float ss = 0.f;
#pragma unroll
        for (int j = 0; j < 4; ++j) if (bi == 4 * lane + j) { ss = sc[j]; v[j] = -INFINITY; }
        ss = __shfl(ss, bi >> 2);
        gsum += ss;
        if (lane == rd) { myE = bi; myS = ss; }
    }
    if (lane < 8) { tope[t * 8 + lane] = myE; topg[t * 8 + lane] = myS * (2.5f / gsum); atomicAdd(cnt + myE, 1); }
}
__device__ __forceinline__ void moe_tables(const int* cnt, LAS int* tb, LAS int* nn) {
    if (threadIdx.x < 64) {
        const int lane = threadIdx.x; int n[4], tl[4], loc = 0;
#pragma unroll
        for (int j = 0; j < 4; ++j) { n[j] = cnt[4 * lane + j]; tl[j] = (n[j] + 255) >> 8; loc += tl[j]; }
        int inc = loc;
#pragma unroll
        for (int o = 1; o < 64; o <<= 1) { const int v = __shfl_up(inc, o); if (lane >= o) inc += v; }
        int base = inc - loc;
#pragma unroll
        for (int j = 0; j < 4; ++j) { tb[4 * lane + j] = base; nn[4 * lane + j] = n[j]; base += tl[j]; }
        if (lane == 63) { tb[NE] = base; nn[NE] = T; tb[NEX] = base + T / 256; }
    }
    __syncthreads();
}
__device__ __forceinline__ void ph_final(const MArgs& a, int G) {
    float* out = a.out; const unsigned char* ys8 = (const unsigned char*)(a.ws + WS_YS); const bf16* ysh = (const bf16*)(a.ws + WS_YSH); const float* mod = (const float*)(a.ws + WS_MOD);
    const float* ln2_g = a.in[20]; const float* ln2_b = a.in[21];
    const int tid = threadIdx.x, lane = tid & 63, wave = tid >> 6;
    for (int it = blockIdx.x; it < T / 128; it += G) {
        const int row0 = it * 128, b = row0 / S;
        f32x4 g2[4], lg[4], lb[4];
#pragma unroll
        for (int j = 0; j < 4; ++j) { const int col = 4 * lane + 256 * j; g2[j] = *(const f32x4*)(mod + b * 6144 + 5120 + col); lg[j] = *(const f32x4*)(ln2_g + col); lb[j] = *(const f32x4*)(ln2_b + col); }
        for (int rr = wave; rr < 128; rr += NWAVES) {
            const int row = row0 + rr;
            f32x4 v[4]; float s = 0.f;
#pragma unroll
            for (int j = 0; j < 4; ++j) { const int col = 4 * lane + 256 * j;
                f32x4 yr = {0.f, 0.f, 0.f, 0.f};
#pragma unroll
                for (int k = 0; k < 8; ++k) { const int w = *(const int*)(ys8 + ((size_t)row * 8 + k) * D + col);
                    const f32x2 lo = __builtin_amdgcn_cvt_pk_f32_fp8(w, false), hi = __builtin_amdgcn_cvt_pk_f32_fp8(w, true); yr = yr + (f32x4){lo.x, lo.y, hi.x, hi.y}; }
                const f32x4 y = ld_bf4(ysh + (size_t)row * D + col) + yr * (1.f / 16.f);
                v[j] = *(const f32x4*)(out + (size_t)row * D + col) * DN_ALPHA + g2[j] * y;
                s += (v[j].x + v[j].y) + (v[j].z + v[j].w); }
            const float mean = wave_sum(s) * (1.f / D); float s2 = 0.f;
#pragma unroll
            for (int j = 0; j < 4; ++j) { v[j] = v[j] - mean; s2 += (v[j].x * v[j].x + v[j].y * v[j].y) + (v[j].z * v[j].z + v[j].w * v[j].w); }
            const float rstd = 1.f / sqrtf(wave_sum(s2) * (1.f / D) + LN_EPS);
#pragma unroll
            for (int j = 0; j < 4; ++j) { const int col = 4 * lane + 256 * j;
                __builtin_nontemporal_store(v[j] * rstd * lg[j] + lb[j], (f32x4*)(out + (size_t)row * D + col)); }
        }
    }
}


typedef short s16x4 __attribute__((ext_vector_type(4)));
typedef short bf16x8v __attribute__((ext_vector_type(8)));
typedef float f32x16 __attribute__((ext_vector_type(16)));
constexpr int MLP = 320;
constexpr int NCH = S / 64;
constexpr int ST_ELEMS = 129 * 128;
constexpr size_t WS_CHK = WS_GATES + 1 * MiB;
constexpr size_t WS_MPREV = WS_GATES + 1 * MiB + 65536;
constexpr size_t WS_KC = WS_U2;
__device__ __forceinline__ s16x4 tr_read(const LAS unsigned char* p) { return __builtin_bit_cast(s16x4, __builtin_amdgcn_ds_read_tr16_b64_v4i16((LAS s16x4*)p)); }
__device__ __forceinline__ bf16x8v tr_frag(const LAS unsigned char* tile, int row0, int col0, int lane) {
    const int i = lane & 15; const LAS unsigned char* p = tile + (row0 + (i >> 2)) * MLP + (col0 + 4 * (i & 3)) * 2;
    const s16x4 lo = tr_read(p), hi = tr_read(p + 4 * MLP);
    return __builtin_shufflevector(lo, hi, 0, 1, 2, 3, 4, 5, 6, 7);
}
__device__ __forceinline__ bf16x8v tr_frag_perm(const LAS unsigned char* tile, int row0, int col0, int lane) {
    const int i = lane & 15; const LAS unsigned char* p = tile + (row0 + (i >> 2)) * MLP + (col0 + 4 * (i & 3)) * 2;
    const s16x4 lo = tr_read(p), hi = tr_read(p + 8 * MLP);
    return __builtin_shufflevector(lo, hi, 0, 1, 2, 3, 4, 5, 6, 7);
}
__device__ __forceinline__ float wave_incl_sum(float v, int lane) {
#pragma unroll
    for (int o = 1; o < 64; o <<= 1) { const float u = __shfl_up(v, o); if (lane >= o) v += u; }
    return v;
}
__device__ __forceinline__ float wave_incl_max(float v, int lane) {
#pragma unroll
    for (int o = 1; o < 64; o <<= 1) { const float u = __shfl_up(v, o); if (lane >= o) v = fmaxf(v, u); }
    return v;
}
__device__ __forceinline__ float wave_max(float v) {
#pragma unroll
    for (int o = 1; o < 64; o <<= 1) v = fmaxf(v, __shfl_xor(v, o));
    return v;
}
__device__ __forceinline__ void conv8(const bf16* __restrict__ rowp, int spos, const float* __restrict__ cw, const float* __restrict__ cb, float scale, float (&y)[8]) {
    const f32x4 b0 = *(const f32x4*)cb, b1 = *(const f32x4*)(cb + 4);
    y[0] = b0.x; y[1] = b0.y; y[2] = b0.z; y[3] = b0.w; y[4] = b1.x; y[5] = b1.y; y[6] = b1.z; y[7] = b1.w;
#pragma unroll
    for (int j = 0; j < 4; ++j) {
        if (spos - 3 + j >= 0) {
            const v4u xr = *(const v4u*)(rowp + (ptrdiff_t)(j - 3) * NPROJ);
            const f32x4 w0 = *(const f32x4*)(cw + j * 1024), w1 = *(const f32x4*)(cw + j * 1024 + 4);
            y[0] += w0.x * bf2f(xr.x & 0xffffu); y[1] += w0.y * bf2f(xr.x >> 16); y[2] += w0.z * bf2f(xr.y & 0xffffu); y[3] += w0.w * bf2f(xr.y >> 16);
            y[4] += w1.x * bf2f(xr.z & 0xffffu); y[5] += w1.y * bf2f(xr.z >> 16); y[6] += w1.z * bf2f(xr.w & 0xffffu); y[7] += w1.w * bf2f(xr.w >> 16);
        }
    }
#pragma unroll
    for (int e = 0; e < 8; ++e) y[e] = siluf_(y[e]) * scale;
}
__device__ __forceinline__ v4u pack8(const float (&y)[8]) { v4u o; o.x = pk2(y[0], y[1]); o.y = pk2(y[2], y[3]); o.z = pk2(y[4], y[5]); o.w = pk2(y[6], y[7]); return o; }

__device__ __forceinline__ void ml_phaseA(const MArgs& a, LAS unsigned char* lds, int vb0, int nvb) {
    const int tid = threadIdx.x, lane = tid & 63, wave = __builtin_amdgcn_readfirstlane(tid >> 6);
    const bf16* proj = (const bf16*)(a.ws + WS_PROJ); const float* conv_w = a.in[5]; const float* conv_b = a.in[6];
    const float* ipre = (const float*)(a.ws + WS_GATES); const float* logf = ipre + 16 * S;
    bf16* kcg = (bf16*)(a.ws + WS_KC); bf16* st = (bf16*)(a.ws + WS_STATES); float* chk = (float*)(a.ws + WS_CHK);
    LAS unsigned char* Kt = lds; LAS unsigned char* Vt = lds + 64 * MLP; LAS float* wkL = (LAS float*)(lds + 128 * MLP);
    for (int unit = vb0; unit < 16 * NCH; unit += nvb) {
        const int bh = unit >> 7, c = unit & (NCH - 1), b = bh >> 2, h = bh & 3, s0 = c * 64; const size_t row0 = (size_t)b * S + s0;
        if (wave == 0) {
            const float lf = logf[(size_t)bh * S + s0 + lane], ic = ipre[(size_t)bh * S + s0 + lane];
            const float bc = wave_incl_sum(lf, lane), g = ic - bc, gmax = wave_max(g), blast = __shfl(bc, 63);
            wkL[lane] = __expf(g - gmax);
            if (lane == 0) { chk[(size_t)unit * 2] = blast; chk[(size_t)unit * 2 + 1] = blast + gmax; }
        }
#pragma unroll
        for (int q = 0; q < 2; ++q) { const int it = tid + q * NTHR, tt = it >> 4, c8 = it & 15, ch = h * 128 + c8 * 8;
            float y[8]; conv8(proj + (row0 + tt) * NPROJ + C_MLK + ch, s0 + tt, conv_w + 512 + ch, conv_b + 512 + ch, 0.08838834764831845f, y);
            const v4u o = pack8(y);
            *(LAS v4u*)(Kt + tt * MLP + c8 * 16) = o; *(v4u*)(kcg + (row0 + tt) * 512 + ch) = o; }
        __syncthreads();
#pragma unroll
        for (int q = 0; q < 2; ++q) { const int it = tid + q * NTHR, tt = it >> 4, c8 = it & 15;
            const v4u xr = *(const v4u*)(proj + (row0 + tt) * NPROJ + C_MLV + h * 128 + c8 * 8); const float w = wkL[tt];
            float y[8] = {bf2f(xr.x & 0xffffu) * w, bf2f(xr.x >> 16) * w, bf2f(xr.y & 0xffffu) * w, bf2f(xr.y >> 16) * w, bf2f(xr.z & 0xffffu) * w, bf2f(xr.z >> 16) * w, bf2f(xr.w & 0xffffu) * w, bf2f(xr.w >> 16) * w};
            *(LAS v4u*)(Vt + tt * MLP + c8 * 16) = pack8(y); }
        __syncthreads();
        {
            const int dvb = wave >> 1, dkh = wave & 1, hh = lane >> 5, gsel = (lane >> 4) & 1;
            f32x16 acc[2];
#pragma unroll
            for (int nb = 0; nb < 2; ++nb)
#pragma unroll
                for (int i = 0; i < 16; ++i) acc[nb][i] = 0.f;
#pragma unroll
            for (int kk = 0; kk < 4; ++kk) {
                const bf16x8v Bv = tr_frag(Vt, 16 * kk + 8 * hh, 32 * dvb + 16 * gsel, lane);
#pragma unroll
                for (int nb = 0; nb < 2; ++nb) { const bf16x8v Ak = tr_frag(Kt, 16 * kk + 8 * hh, 32 * (2 * dkh + nb) + 16 * gsel, lane);
                    acc[nb] = __builtin_amdgcn_mfma_f32_32x32x16_bf16(Ak, Bv, acc[nb], 0, 0, 0); }
            }
            bf16* stc = st + (size_t)unit * ST_ELEMS;
#pragma unroll
            for (int nb = 0; nb < 2; ++nb)
#pragma unroll
                for (int g4 = 0; g4 < 4; ++g4) { const int dk = 32 * (2 * dkh + nb) + 8 * g4 + 4 * hh, dv = 32 * dvb + (lane & 31);
                    *(unsigned long long*)(stc + (size_t)dv * 128 + dk) = (unsigned long long)pk2(acc[nb][4 * g4], acc[nb][4 * g4 + 1]) | ((unsigned long long)pk2(acc[nb][4 * g4 + 2], acc[nb][4 * g4 + 3]) << 32); }
        }
        if (tid < 128) { float s = 0.f;
#pragma unroll 8
            for (int t = 0; t < 64; ++t) s += wkL[t] * bf2f(*(const LAS unsigned short*)(Kt + t * MLP + tid * 2));
            st[(size_t)unit * ST_ELEMS + 128 * 128 + tid] = (bf16)f2bf(s); }
        __syncthreads();
    }
}

__device__ __forceinline__ void ml_phaseB(const MArgs& a, LAS unsigned char* lds, int vb0, int nvb) {
    const int tid = threadIdx.x;
    bf16* st = (bf16*)(a.ws + WS_STATES); const float* chk = (const float*)(a.ws + WS_CHK); float* mprev = (float*)(a.ws + WS_MPREV);
    LAS float* al = (LAS float*)lds; LAS float* be = al + NCH;
    constexpr int NSL = 16, SLE = ST_ELEMS / NSL;
    for (int item = vb0; item < 16 * NSL; item += nvb) {
        const int bh = item / NSL, sl = item % NSL;
        __syncthreads();
        if (tid == 0) { float m = 0.f;
            for (int c = 0; c < NCH; ++c) { const float bl = chk[(size_t)(bh * NCH + c) * 2], M = chk[(size_t)(bh * NCH + c) * 2 + 1];
                const float mn = fmaxf(bl + m, M); al[c] = __expf(bl + m - mn); be[c] = __expf(M - mn);
                if (sl == 0) mprev[bh * NCH + c] = m;
                m = mn; } }
        __syncthreads();
        if (tid * 4 < SLE) {
            unsigned long long* p = (unsigned long long*)(st + (size_t)bh * NCH * ST_ELEMS + sl * SLE + tid * 4);
            float c0 = 0.f, c1 = 0.f, c2 = 0.f, c3 = 0.f;
            for (int cb = 0; cb < NCH; cb += 16) { unsigned long long d[16];
#pragma unroll
                for (int j = 0; j < 16; ++j) d[j] = p[(size_t)(cb + j) * (ST_ELEMS / 4)];
#pragma unroll
                for (int j = 0; j < 16; ++j) { p[(size_t)(cb + j) * (ST_ELEMS / 4)] = (unsigned long long)pk2(c0, c1) | ((unsigned long long)pk2(c2, c3) << 32);
                    const float A = al[cb + j], Bq = be[cb + j]; const unsigned lo = (unsigned)d[j], hi = (unsigned)(d[j] >> 32);
                    c0 = A * c0 + Bq * bf2f(lo & 0xffffu); c1 = A * c1 + Bq * bf2f(lo >> 16); c2 = A * c2 + Bq * bf2f(hi & 0xffffu); c3 = A * c3 + Bq * bf2f(hi >> 16); } }
        }
    }
}

__device__ __forceinline__ void ml_phaseC(const MArgs& a, LAS unsigned char* lds, int G) {
    const int tid = threadIdx.x, lane = tid & 63, wave = __builtin_amdgcn_readfirstlane(tid >> 6);
    const bf16* proj = (const bf16*)(a.ws + WS_PROJ); const float* conv_w = a.in[5]; const float* conv_b = a.in[6]; const float* norm_g = a.in[8];
    const float* ipre = (const float*)(a.ws + WS_GATES); const float* logf = ipre + 16 * S;
    const bf16* kcg = (const bf16*)(a.ws + WS_KC); const bf16* st = (const bf16*)(a.ws + WS_STATES); const float* mprev = (const float*)(a.ws + WS_MPREV);
    bf16* mix = (bf16*)(a.ws + WS_MIX);
    LAS unsigned char* Qt = lds; LAS unsigned char* Kt = lds + 64 * MLP; LAS unsigned char* Vt = lds + 128 * MLP; LAS unsigned char* Ct = lds + 192 * MLP;
    LAS float* sc = (LAS float*)(lds + 320 * MLP);
    LAS float* gL = sc; LAS float* mmL = sc + 64; LAS float* siL = sc + 128; LAS float* emL = sc + 192; LAS float* npv = sc + 256; LAS float* lnS = sc + 384;
    const int tb = wave >> 2, dvb = wave & 3, r = lane & 31, hh = lane >> 5, gsel = (lane >> 4) & 1;
    for (int unit = blockIdx.x; unit < 16 * NCH; unit += G) {
        const int bh = unit >> 7, c = unit & (NCH - 1), b = bh >> 2, h = bh & 3, s0 = c * 64; const size_t row0 = (size_t)b * S + s0;
        if (wave == 0) {
            const float lf = logf[(size_t)bh * S + s0 + lane], ic = ipre[(size_t)bh * S + s0 + lane], mp = mprev[unit];
            const float bc = wave_incl_sum(lf, lane), g = ic - bc, pm = wave_incl_max(g, lane), mm = fmaxf(mp, pm);
            gL[lane] = g; mmL[lane] = mm; siL[lane] = __expf(mp - mm); emL[lane] = __expf(-(bc + mm));
        }
        const bf16* stc = st + (size_t)unit * ST_ELEMS;
#pragma unroll
        for (int q = 0; q < 2; ++q) { const int it = tid + q * NTHR, tt = it >> 4, c8 = it & 15, ch = h * 128 + c8 * 8;
            float y[8]; conv8(proj + (row0 + tt) * NPROJ + C_MLQ + ch, s0 + tt, conv_w + ch, conv_b + ch, 1.f, y);
            *(LAS v4u*)(Qt + tt * MLP + c8 * 16) = pack8(y);
            *(LAS v4u*)(Kt + tt * MLP + c8 * 16) = *(const v4u*)(kcg + (row0 + tt) * 512 + ch);
            *(LAS v4u*)(Vt + tt * MLP + c8 * 16) = *(const v4u*)(proj + (row0 + tt) * NPROJ + C_MLV + ch); }
#pragma unroll
        for (int q = 0; q < 4; ++q) { const int it = tid + q * NTHR, dv = it >> 4, c8 = it & 15;
            *(LAS v4u*)(Ct + dv * MLP + c8 * 16) = *(const v4u*)(stc + dv * 128 + c8 * 8); }
        if (tid < 128) npv[tid] = bf2f(stc[128 * 128 + tid]);
        __syncthreads();
        bf16x8v qf[8];
#pragma unroll
        for (int kk = 0; kk < 8; ++kk) qf[kk] = *(const LAS bf16x8v*)(Qt + (32 * tb + r) * MLP + (16 * kk + 8 * hh) * 2);
        const float mm_t = mmL[32 * tb + r], si_t = siL[32 * tb + r], em_t = emL[32 * tb + r];
        float nq = 0.f;
#pragma unroll
        for (int kk = 0; kk < 8; ++kk) { const f32x4 n0 = *(const LAS f32x4*)(npv + 16 * kk + 8 * hh), n1 = *(const LAS f32x4*)(npv + 16 * kk + 8 * hh + 4);
            nq += n0.x * bf2f((unsigned short)qf[kk][0]) + n0.y * bf2f((unsigned short)qf[kk][1]) + n0.z * bf2f((unsigned short)qf[kk][2]) + n0.w * bf2f((unsigned short)qf[kk][3])
                + n1.x * bf2f((unsigned short)qf[kk][4]) + n1.y * bf2f((unsigned short)qf[kk][5]) + n1.z * bf2f((unsigned short)qf[kk][6]) + n1.w * bf2f((unsigned short)qf[kk][7]); }
        nq += __shfl_xor(nq, 32);
        f32x16 num;
#pragma unroll
        for (int i = 0; i < 16; ++i) num[i] = 0.f;
#pragma unroll
        for (int kk = 0; kk < 8; ++kk) { const bf16x8v Ac = *(const LAS bf16x8v*)(Ct + (32 * dvb + r) * MLP + (16 * kk + 8 * hh) * 2);
            num = __builtin_amdgcn_mfma_f32_32x32x16_bf16(Ac, qf[kk], num, 0, 0, 0); }
#pragma unroll
        for (int i = 0; i < 16; ++i) num[i] *= si_t;
        float wsum = 0.f;
        for (int sb = 0; sb <= tb; ++sb) {
            f32x16 sT;
#pragma unroll
            for (int i = 0; i < 16; ++i) sT[i] = 0.f;
#pragma unroll
            for (int kk = 0; kk < 8; ++kk) { const bf16x8v Ak = *(const LAS bf16x8v*)(Kt + (32 * sb + r) * MLP + (16 * kk + 8 * hh) * 2);
                sT = __builtin_amdgcn_mfma_f32_32x32x16_bf16(Ak, qf[kk], sT, 0, 0, 0); }
            unsigned wp[8];
#pragma unroll
            for (int g4 = 0; g4 < 4; ++g4) { const f32x4 gv = *(const LAS f32x4*)(gL + 32 * sb + 8 * g4 + 4 * hh);
                float w[4];
#pragma unroll
                for (int e = 0; e < 4; ++e) { const int srow = 32 * sb + 8 * g4 + 4 * hh + e; const bool valid = srow <= 32 * tb + r;
                    w[e] = valid ? sT[4 * g4 + e] * __expf(gv[e] - mm_t) : 0.f; wsum += w[e]; }
                wp[2 * g4] = pk2(w[0], w[1]); wp[2 * g4 + 1] = pk2(w[2], w[3]); }
#pragma unroll
            for (int s2 = 0; s2 < 2; ++s2) {
                const bf16x8v Av = tr_frag_perm(Vt, 32 * sb + 16 * s2 + 4 * hh, 32 * dvb + 16 * gsel, lane);
                v4u bw; bw.x = wp[4 * s2]; bw.y = wp[4 * s2 + 1]; bw.z = wp[4 * s2 + 2]; bw.w = wp[4 * s2 + 3];
                num = __builtin_amdgcn_mfma_f32_32x32x16_bf16(Av, __builtin_bit_cast(bf16x8v, bw), num, 0, 0, 0); }
        }
        wsum += __shfl_xor(wsum, 32);
        const float den = si_t * nq + wsum, rden = 1.f / fmaxf(fabsf(den), em_t);
        float ps = 0.f, pq = 0.f;
#pragma unroll
        for (int i = 0; i < 16; ++i) { num[i] *= rden; ps += num[i]; pq += num[i] * num[i]; }
        ps += __shfl_xor(ps, 32); pq += __shfl_xor(pq, 32);
        if (hh == 0) { lnS[((tb * 4 + dvb) * 32 + r) * 2] = ps; lnS[((tb * 4 + dvb) * 32 + r) * 2 + 1] = pq; }
        __syncthreads();
        float ts = 0.f, tq = 0.f;
#pragma unroll
        for (int d = 0; d < 4; ++d) { ts += lnS[((tb * 4 + d) * 32 + r) * 2]; tq += lnS[((tb * 4 + d) * 32 + r) * 2 + 1]; }
        const float mean = ts * (1.f / 128.f), rstd = 1.f / sqrtf(fmaxf(tq * (1.f / 128.f) - mean * mean, 0.f) + LN_EPS);
        const size_t trow = row0 + 32 * tb + r;
#pragma unroll
        for (int g4 = 0; g4 < 4; ++g4) { const int dv = 32 * dvb + 8 * g4 + 4 * hh;
            const f32x4 ng = *(const f32x4*)(norm_g + h * 128 + dv); const f32x4 og = ld_bf4(proj + trow * NPROJ + C_MLO + h * 128 + dv);
            float o[4];
#pragma unroll
            for (int e = 0; e < 4; ++e) o[e] = (num[4 * g4 + e] - mean) * rstd * ng[e] * sigmoidf_(og[e]);
            *(unsigned long long*)(mix + trow * D + 512 + h * 128 + dv) = (unsigned long long)pk2(o[0], o[1]) | ((unsigned long long)pk2(o[2], o[3]) << 32); }
        __syncthreads();
    }
}


constexpr int VTP = 192;
template <int PITCH> __device__ __forceinline__ bf16x8v tr_frag_perm_p(const LAS unsigned char* tile, int row0, int col0, int lane) {
    const int i = lane & 15; const LAS unsigned char* p = tile + (row0 + (i >> 2)) * PITCH + (col0 + 4 * (i & 3)) * 2;
    const s16x4 lo = tr_read(p), hi = tr_read(p + 8 * PITCH);
    return __builtin_shufflevector(lo, hi, 0, 1, 2, 3, 4, 5, 6, 7);
}
__device__ __forceinline__ void attn_phase(const bf16* __restrict__ proj, bf16* __restrict__ mix, LAS unsigned char* lds, int vb0, int nvb) {
    const int tid = threadIdx.x, lane = tid & 63, wave = __builtin_amdgcn_readfirstlane(tid >> 6);
    const int r = lane & 31, hh = lane >> 5, gsel = (lane >> 4) & 1;
    LAS unsigned char* Vt = lds + wave * (64 * VTP);
    bf16x8v ntri[2], nones;
#pragma unroll
    for (int s2 = 0; s2 < 2; ++s2)
#pragma unroll
        for (int j = 0; j < 8; ++j) { const int k = 16 * s2 + 8 * (j >> 2) + 4 * hh + (j & 3); ntri[s2][j] = (k >= r) ? (short)0xBF80 : (short)0; }
#pragma unroll
    for (int j = 0; j < 8; ++j) nones[j] = (short)0xBF80;
    for (int unit = vb0 * NWAVES + wave; unit < NB * 8 * (S / 32); unit += nvb * NWAVES) {
        const int bh = unit / (S / 32), qb = unit % (S / 32), b = bh >> 3, h = bh & 7, q0 = qb * 32;
        const bf16* base = proj + (size_t)b * S * NPROJ + h * 64;
        bf16x8v qf[4];
#pragma unroll
        for (int s = 0; s < 4; ++s) qf[s] = *(const bf16x8v*)(base + (size_t)(q0 + r) * NPROJ + C_SBQ + 16 * s + 8 * hh);
        f32x16 o[2];
#pragma unroll
        for (int d = 0; d < 2; ++d)
#pragma unroll
            for (int i = 0; i < 16; ++i) o[d][i] = 0.f;
        float carry = 0.f;
        const int qpos = q0 + r;
        for (int k0 = q0 - 32; ; k0 -= 64) {
            bf16x8v kf[2][4];
#pragma unroll
            for (int kb = 0; kb < 2; ++kb) { int key = k0 + 32 * kb + r; key = key < 0 ? 0 : key;
#pragma unroll
                for (int s = 0; s < 4; ++s) kf[kb][s] = *(const bf16x8v*)(base + (size_t)key * NPROJ + C_SBK + 16 * s + 8 * hh); }
#pragma unroll
            for (int i = 0; i < 8; ++i) { int key = k0 + (lane >> 3) + 8 * i; key = key < 0 ? 0 : key;
                *(LAS v4u*)(Vt + ((lane >> 3) + 8 * i) * VTP + (lane & 7) * 16) = *(const v4u*)(base + (size_t)key * NPROJ + C_SBV + (lane & 7) * 8); }
            f32x16 z[2];
#pragma unroll
            for (int kb = 0; kb < 2; ++kb) {
#pragma unroll
                for (int i = 0; i < 16; ++i) z[kb][i] = 0.f;
#pragma unroll
                for (int s = 0; s < 4; ++s) z[kb] = __builtin_amdgcn_mfma_f32_32x32x16_bf16(kf[kb][s], qf[s], z[kb], 0, 0, 0); }
            const bool need_mask = (k0 + 63 >= q0) || (k0 < 0);
            unsigned xp[2][8];
#pragma unroll
            for (int kb = 0; kb < 2; ++kb)
#pragma unroll
                for (int g4 = 0; g4 < 4; ++g4) { float sp[4];
#pragma unroll
                    for (int e = 0; e < 4; ++e) { const float zz = z[kb][4 * g4 + e];
                        float v = fmaxf(zz, 0.f) + __builtin_amdgcn_logf(1.f + __builtin_amdgcn_exp2f(-fabsf(zz)));
                        if (need_mask) { const int key = k0 + 32 * kb + 8 * g4 + 4 * hh + e; v = (key >= 0 && key < qpos) ? v : 0.f; }
                        sp[e] = v; }
                    xp[kb][2 * g4] = pk2(sp[0], sp[1]); xp[kb][2 * g4 + 1] = pk2(sp[2], sp[3]); }
            const float z00 = z[0][0];
#pragma unroll
            for (int s2 = 0; s2 < 2; ++s2) { v4u b1; b1.x = xp[1][4 * s2]; b1.y = xp[1][4 * s2 + 1]; b1.z = xp[1][4 * s2 + 2]; b1.w = xp[1][4 * s2 + 3];
                v4u b0; b0.x = xp[0][4 * s2]; b0.y = xp[0][4 * s2 + 1]; b0.z = xp[0][4 * s2 + 2]; b0.w = xp[0][4 * s2 + 3];
                z[1] = __builtin_amdgcn_mfma_f32_32x32x16_bf16(ntri[s2], __builtin_bit_cast(bf16x8v, b1), z[1], 0, 0, 0);
                z[0] = __builtin_amdgcn_mfma_f32_32x32x16_bf16(ntri[s2], __builtin_bit_cast(bf16x8v, b0), z[0], 0, 0, 0);
                z[0] = __builtin_amdgcn_mfma_f32_32x32x16_bf16(nones, __builtin_bit_cast(bf16x8v, b1), z[0], 0, 0, 0); }
            float tot = z00 - z[0][0];
            tot = __shfl(tot, r);
#pragma unroll
            for (int kb = 0; kb < 2; ++kb)
#pragma unroll
                for (int g4 = 0; g4 < 4; ++g4) { float p[4];
#pragma unroll
                    for (int e = 0; e < 4; ++e) { float v = __builtin_amdgcn_exp2f(z[kb][4 * g4 + e] - carry);
                        if (need_mask) { const int key = k0 + 32 * kb + 8 * g4 + 4 * hh + e; v = (key >= 0 && key < qpos) ? v : 0.f; }
                        p[e] = v; }
                    xp[kb][2 * g4] = pk2(p[0], p[1]); xp[kb][2 * g4 + 1] = pk2(p[2], p[3]); }
#pragma unroll
            for (int kb = 0; kb < 2; ++kb)
#pragma unroll
                for (int s2 = 0; s2 < 2; ++s2) { v4u bp; bp.x = xp[kb][4 * s2]; bp.y = xp[kb][4 * s2 + 1]; bp.z = xp[kb][4 * s2 + 2]; bp.w = xp[kb][4 * s2 + 3];
#pragma unroll
                    for (int d = 0; d < 2; ++d) { const bf16x8v Av = tr_frag_perm_p<VTP>(Vt, 32 * kb + 16 * s2 + 4 * hh, 32 * d + 16 * gsel, lane);
                        o[d] = __builtin_amdgcn_mfma_f32_32x32x16_bf16(Av, __builtin_bit_cast(bf16x8v, bp), o[d], 0, 0, 0); } }
            carry += tot;
            if (k0 <= 0) break;
            if (__all(carry > SB_THRESH)) break;
        }
        bf16* op = mix + (size_t)(b * S + q0 + r) * D + h * 64;
#pragma unroll
        for (int d = 0; d < 2; ++d)
#pragma unroll
            for (int g4 = 0; g4 < 4; ++g4)
                *(unsigned long long*)(op + 32 * d + 8 * g4 + 4 * hh) = (unsigned long long)pk2(o[d][4 * g4], o[d][4 * g4 + 1]) | ((unsigned long long)pk2(o[d][4 * g4 + 2], o[d][4 * g4 + 3]) << 32);
    }
}

__global__ void __launch_bounds__(NTHR, 2) mega_fwd(MArgs args) {
    extern __shared__ __attribute__((aligned(16))) unsigned char lds[];
    LAS unsigned char* ldsl = (LAS unsigned char*)lds;
    const int tid = threadIdx.x, G = gridDim.x;
    volatile LAS unsigned* MISC = (volatile LAS unsigned*)(ldsl + XTRA_OFF + X_MISC);
    LAS int* tb = (LAS int*)(ldsl + XTRA_OFF + X_TB); LAS int* nn = (LAS int*)(ldsl + XTRA_OFF + X_NN);
    for (int u = tid; u < (LDS_BYTES - XTRA_OFF) / 4; u += NTHR) ((LAS unsigned*)(ldsl + XTRA_OFF))[u] = 0u;
    __syncthreads();
    unsigned char* ws = args.ws;
    unsigned* ctl = (unsigned*)(ws + WS_CTL);
    XcdBarrier bar = xcd_barrier_post(ctl + CW_BAR, MISC + 8);
    const int lo = args.ph_lo, hi = args.ph_hi;
#define IN(k) (lo <= (k) && (k) < hi)
#ifndef REP_MASK
#define REP_MASK 0
#endif
#define PHASE(k, ...) do { if (IN(k)) { for (int rep_ = 0; rep_ < (((REP_MASK >> (k)) & 1) ? 2 : 1); ++rep_) { if (rep_) xcd_barrier(bar); __VA_ARGS__ } } if (IN(k) && IN((k) + 1)) xcd_barrier(bar); } while (0)
    int* cnt = (int*)ctl + CW_CNT; i32x2* list = (i32x2*)(ws + WS_ROUTE + 2 * MiB); float* topg = (float*)(ws + WS_ROUTE + 1 * MiB);
    PHASE(0, ph_mod_prep(args, lds, G););
    PHASE(1, ph_ln1(args, lds, G););
    PHASE(2, { pg8::StaticOrder So; So.init(ws + WS_U1, ws + WS_WTIN, T, NPROJ, D, G, blockIdx.x);
        pg8::EpiBf16 E{(bf16*)(ws + WS_PROJ), NPROJ, 2, QSCALE, 1.f / 64.f};
        pg8::gemm_phase<pg8::EpiBf16, pg8::StaticOrder, false, true>(ldsl, D, So, E); });
    PHASE(3, ml_phaseA(args, ldsl, blockIdx.x, G););
    PHASE(4, ml_phaseB(args, ldsl, blockIdx.x, G); __syncthreads(); attn_phase((const bf16*)(ws + WS_PROJ), (bf16*)(ws + WS_MIX), ldsl, blockIdx.x, G););
    PHASE(5, ml_phaseC(args, ldsl, G););
    PHASE(6, { pg8::StaticOrder So; So.init(ws + WS_MIX, ws + WS_WTOUT, T, D, 2 * D, G, blockIdx.x);
        pg8::EpiBf16 E{(bf16*)(ws + WS_MIXOUT), D, 0, 1.f, 1.f};
        pg8::gemm_phase<pg8::EpiBf16, pg8::StaticOrder, false, false>(ldsl, 2 * D, So, E); });
    PHASE(7, ph_ln2(args, G););
    PHASE(8, { pg8::StaticOrder So; So.init(ws + WS_U2, ws + WS_WTR, T, NE, 2 * D, G, blockIdx.x);
        pg8::EpiF32 E{(float*)(ws + WS_LOGITS), NE};
        pg8::gemm_phase<pg8::EpiF32, pg8::StaticOrder, false, false>(ldsl, 2 * D, So, E); });
    PHASE(9, { const int lane_ = tid & 63; const f32x4 bias4 = *(const f32x4*)(args.in[13] + 4 * lane_);
        for (int t = blockIdx.x * NWAVES + (tid >> 6); t < T; t += G * NWAVES) route_wave(t, lane_, (const float*)(ws + WS_LOGITS), bias4, (int*)(ws + WS_ROUTE), topg, cnt); });
    PHASE(10, { moe_tables(cnt, tb, nn); const int* tope = (const int*)(ws + WS_ROUTE); int* fill = (int*)ctl + CW_FILL;
        for (int id = blockIdx.x * NTHR + tid; id < T * TOPK; id += G * NTHR) { const int e = tope[id]; const int pos = atomicAdd(fill + e, 1);
            list[tb[e] * 256 + pos] = (i32x2){id, __float_as_int(topg[id])}; } });
    PHASE(11, { moe_tables(cnt, tb, nn);
        pg8::MoeOrder So{G, (int)blockIdx.x, tb[NEX] * 2, 1, tb, nn, list, (const char*)(ws + WS_U2F8), 0, (const char*)(ws + WS_WT13), (size_t)512 * D, (size_t)256 * D};
        pg8::EpiGlu E{(unsigned char*)(ws + WS_H), 1.f / 64.f};
        pg8::gemm_phase<pg8::EpiGlu, pg8::MoeOrder, true, true>(ldsl, D, So, E); });
    PHASE(12, { moe_tables(cnt, tb, nn);
        pg8::MoeOrder So{G, (int)blockIdx.x, tb[NEX] * 4, 2, tb, nn, list, (const char*)(ws + WS_H), (size_t)256 * FF, (const char*)(ws + WS_WT2), (size_t)D * FF, (size_t)256 * FF};
        pg8::EpiScatter E{(unsigned char*)(ws + WS_YS), (bf16*)(ws + WS_YSH), list, nn};
        pg8::gemm_phase<pg8::EpiScatter, pg8::MoeOrder, false, true>(ldsl, FF, So, E); });
    PHASE(13, ph_final(args, G););
#undef PHASE
#undef IN
}

#ifndef MK_UPTO
#define MK_UPTO 14
#endif
__global__ void k_nan_fill(float* out, int n) { for (int i = blockIdx.x * blockDim.x + threadIdx.x; i < n; i += gridDim.x * blockDim.x) out[i] = __builtin_nanf(""); }
extern "C" void kernel_launch(void* const* d_in, const int* in_sizes, int n_in, void* d_out, int out_size, void* d_ws, size_t ws_size, hipStream_t stream) {
    static int grid = 0;
    if (grid == 0) {
        int dev = 0, cus = 0, per_cu = 0; grid = -1;
        if (n_in != 22 || out_size != T * D || ws_size < WS_END) fprintf(stderr, "kernel_launch: unexpected shapes (n_in %d out %d ws %zu, need %zu)\n", n_in, out_size, ws_size, (size_t)WS_END);
        else if (hipGetDevice(&dev) != hipSuccess || hipDeviceGetAttribute(&cus, hipDeviceAttributeMultiprocessorCount, dev) != hipSuccess) fprintf(stderr, "kernel_launch: device query failed\n");
        else if (hipFuncSetAttribute((const void*)mega_fwd, hipFuncAttributeMaxDynamicSharedMemorySize, LDS_BYTES) != hipSuccess) fprintf(stderr, "kernel_launch: hipFuncSetAttribute failed\n");
        else if (hipOccupancyMaxActiveBlocksPerMultiprocessor(&per_cu, (const void*)mega_fwd, NTHR, LDS_BYTES) != hipSuccess || per_cu < 1) fprintf(stderr, "kernel_launch: occupancy query says %d blocks per CU\n", per_cu);
        else grid = cus;
        (void)hipGetLastError();
    }
    if (grid < 0) { k_nan_fill<<<1024, 256, 0, stream>>>((float*)d_out, out_size); return; }
    const float* x = (const float*)d_in[0];
    const float* conv_w = (const float*)d_in[5]; const float* conv_b = (const float*)d_in[6];
    const float* norm_g = (const float*)d_in[8]; const float* ln1_g = (const float*)d_in[10]; const float* ln1_b = (const float*)d_in[11];
    const float* rbias = (const float*)d_in[13]; const float* ln2_g = (const float*)d_in[20]; const float* ln2_b = (const float*)d_in[21];
    char* ws = (char*)d_ws; float* out = (float*)d_out;
    float* mod = (float*)(ws + WS_MOD); bf16* wtin = (bf16*)(ws + WS_WTIN); bf16* wtout = (bf16*)(ws + WS_WTOUT); bf16* wtr = (bf16*)(ws + WS_WTR);
    bf16* wt13 = (bf16*)(ws + WS_WT13); bf16* wt2 = (bf16*)(ws + WS_WT2); int* plan = (int*)(ws + WS_PLAN);
    bf16* u1 = (bf16*)(ws + WS_U1); bf16* proj = (bf16*)(ws + WS_PROJ); float* ipre = (float*)(ws + WS_GATES); float* logf = ipre + 16 * S;
    float* hraw = (float*)(ws + WS_HRAW); bf16* mix = (bf16*)(ws + WS_MIX); bf16* mixout = (bf16*)(ws + WS_MIXOUT); bf16* u2 = (bf16*)(ws + WS_U2);
    float* logits = (float*)(ws + WS_LOGITS); int* tope = (int*)(ws + WS_ROUTE); float* topg = (float*)(ws + WS_ROUTE + 1 * MiB); i32x2* list = (i32x2*)(ws + WS_ROUTE + 2 * MiB);
    bf16* H = (bf16*)(ws + WS_H); bf16* ys = (bf16*)(ws + WS_YS); bf16* ysh = (bf16*)(ws + WS_YSH);
    int* cnt = (int*)(ws + WS_CTL) + CW_CNT;
    (void)hipMemsetAsync(ws + WS_CTL, 0, 1 * MiB, stream);
    if (MK_UPTO > 0) {
        MArgs a{};
        for (int i = 0; i < 22; ++i) a.in[i] = (const float*)d_in[i];
        a.out = out; a.ws = (unsigned char*)d_ws; a.ph_lo = 0; a.ph_hi = MK_UPTO;
        hipLaunchKernelGGL(mega_fwd, dim3(grid), dim3(NTHR), LDS_BYTES, stream, a);
    }
}
```

```cpp
#include <hip/hip_runtime.h>
#include <cstdio>
#include <cstdint>

typedef unsigned short bf16;
typedef unsigned v4u __attribute__((ext_vector_type(4)));
typedef float f32x4 __attribute__((ext_vector_type(4)));
typedef int i32x2 __attribute__((ext_vector_type(2)));
typedef float f32x2 __attribute__((ext_vector_type(2)));

constexpr int D = 1024, NB = 4, S = 8192, T = NB * S;
constexpr int NPROJ = 3584, WIN_LD = 3592;
constexpr int C_SBQ = 0, C_SBK = 512, C_SBV = 1024, C_MLQ = 1536, C_MLK = 2048, C_MLV = 2560, C_MLO = 3072, C_GATE = 3584;
constexpr int NE = 256, NEX = 257, TOPK = 8, FF = 256;
constexpr float LN_EPS = 1e-5f;
constexpr float DN_ALPHA = 1.189207115002721f;
constexpr float LOG2E = 1.4426950408889634f;
constexpr float QSCALE = 0.125f * LOG2E;
constexpr float SB_THRESH = 48.0f;

constexpr size_t MiB = 1u << 20;
constexpr size_t WS_CTL = 0;
constexpr size_t WS_MOD = 1 * MiB;
constexpr size_t WS_WTIN = 2 * MiB;
constexpr size_t WS_WTOUT = 10 * MiB;
constexpr size_t WS_WTR = 12 * MiB;
constexpr size_t WS_PLAN = 13 * MiB;
constexpr size_t WS_WT2 = 16 * MiB;
constexpr size_t WS_YS = 145 * MiB;
constexpr size_t WS_WT13 = 145 * MiB;
constexpr size_t WS_U2F8 = 274 * MiB;
constexpr size_t WS_PROJ = 402 * MiB;
constexpr size_t WS_GATES = 626 * MiB;
constexpr size_t WS_H = 657 * MiB;
constexpr size_t WS_STATES = 657 * MiB;
constexpr size_t WS_MIXOUT = 657 * MiB;
constexpr size_t WS_LOGITS = 657 * MiB;
constexpr size_t WS_U1 = 725 * MiB;
constexpr size_t WS_MIX = 725 * MiB;
constexpr size_t WS_U2 = 833 * MiB;
constexpr size_t WS_YSH = 833 * MiB;
constexpr size_t WS_HRAW = 833 * MiB;
constexpr size_t WS_ROUTE = 897 * MiB;
constexpr size_t WS_END = 902 * MiB;
constexpr int CW_CNT = 1024;
constexpr int CW_FILL = 1536;
constexpr int PL_SLOT = 0, PL_T64 = 512, PL_T256 = 1024;

__device__ __forceinline__ unsigned f2bf(float f) { unsigned u = __builtin_bit_cast(unsigned, f); return (u + 0x7fffu + ((u >> 16) & 1u)) >> 16; }
__device__ __forceinline__ float bf2f(unsigned b) { return __builtin_bit_cast(float, b << 16); }
__device__ __forceinline__ unsigned pk2(float lo, float hi) { return f2bf(lo) | (f2bf(hi) << 16); }
__device__ __forceinline__ unsigned pk4_fp8(float a, float b, float c, float d) { int w = 0; w = __builtin_amdgcn_cvt_pk_fp8_f32(a, b, w, false); w = __builtin_amdgcn_cvt_pk_fp8_f32(c, d, w, true); return (unsigned)w; }
__device__ __forceinline__ float wave_sum(float v) {
    v += __builtin_bit_cast(float, __builtin_amdgcn_update_dpp(0, __builtin_bit_cast(int, v), 0xB1, 0xF, 0xF, true));
    v += __builtin_bit_cast(float, __builtin_amdgcn_update_dpp(0, __builtin_bit_cast(int, v), 0x4E, 0xF, 0xF, true));
    v += __builtin_bit_cast(float, __builtin_amdgcn_update_dpp(0, __builtin_bit_cast(int, v), 0x141, 0xF, 0xF, true));
    v += __builtin_bit_cast(float, __builtin_amdgcn_update_dpp(0, __builtin_bit_cast(int, v), 0x140, 0xF, 0xF, true));
    const int iv = __builtin_bit_cast(int, v);
    const float r0 = __builtin_bit_cast(float, __builtin_amdgcn_readlane(iv, 0)), r1 = __builtin_bit_cast(float, __builtin_amdgcn_readlane(iv, 16));
    const float r2 = __builtin_bit_cast(float, __builtin_amdgcn_readlane(iv, 32)), r3 = __builtin_bit_cast(float, __builtin_amdgcn_readlane(iv, 48));
    return (r0 + r1) + (r2 + r3);
}
__device__ __forceinline__ float sigmoidf_(float x) { return 1.f / (1.f + __expf(-x)); }
__device__ __forceinline__ float siluf_(float x) { return x / (1.f + __expf(-x)); }


struct PrepArgs { const float *w_in, *w_out, *w_router, *w1, *w3, *w2, *sw1, *sw3, *sw2; unsigned char* wtin; bf16 *wtout, *wtr; unsigned char* wt13; unsigned char* wt2; };
struct PrepDesc { const float* src; unsigned char* dst; int ldw, ldt, k0, n0, rowmap, f8; };
constexpr int IT_IN = 16 * 56, IT_OUT = 16 * 16, IT_R = 16 * 4, IT_E = 192, IT_TOTAL = IT_IN + IT_OUT + IT_R + NEX * IT_E;
__device__ __forceinline__ PrepDesc prep_decode(const PrepArgs& a, int it) {
    if (it < IT_IN) return PrepDesc{a.w_in, a.wtin, WIN_LD, D, (it / 112) * 128, (it % 112) * 32, 0, 1}; it -= IT_IN;
    if (it < IT_OUT) return PrepDesc{a.w_out, (unsigned char*)a.wtout, D, D, (it / 16) * 64, (it % 16) * 64, 0, 0}; it -= IT_OUT;
    if (it < IT_R) return PrepDesc{a.w_router, (unsigned char*)a.wtr, NE, D, (it / 4) * 64, (it % 4) * 64, 0, 0}; it -= IT_R;
    const int e = it / IT_E, r = it % IT_E;
    if (r < 64) return PrepDesc{e < NE ? a.w1 + (size_t)e * D * FF : a.sw1, a.wt13 + (size_t)e * 512 * D, FF, D, (r / 8) * 128, (r % 8) * 32, 1, 1};
    if (r < 128) { const int q = r - 64; return PrepDesc{e < NE ? a.w3 + (size_t)e * D * FF : a.sw3, a.wt13 + (size_t)e * 512 * D, FF, D, (q / 8) * 128, (q % 8) * 32, 2, 1}; }
    const int q = r - 128; return PrepDesc{e < NE ? a.w2 + (size_t)e * FF * D : a.sw2, a.wt2 + (size_t)e * D * FF, D, FF, (q / 32) * 128, (q % 32) * 32, 0, 1};
}
__device__ __forceinline__ void prep_load(const PrepDesc& d, int lane, f32x4 (&v)[16]) {
    const int g = d.f8 ? (lane >> 3) : (lane >> 4), i = d.f8 ? (lane & 7) : (lane & 15);
#pragma unroll
    for (int r = 0; r < 16; ++r) v[r] = __builtin_nontemporal_load((const f32x4*)(d.src + (size_t)(d.k0 + 16 * g + r) * d.ldw + d.n0 + 4 * i));
}
__device__ __forceinline__ void prep_store(const PrepDesc& d, int lane, const f32x4 (&v)[16]) {
    const int g = d.f8 ? (lane >> 3) : (lane >> 4), i = d.f8 ? (lane & 7) : (lane & 15);
#pragma unroll
    for (int nn = 0; nn < 4; ++nn) {
        const int n = d.n0 + 4 * i + nn;
        const int dr = d.rowmap == 0 ? n : ((n >> 7) * 256 + (d.rowmap == 2 ? 128 : 0) + (n & 127));
        if (d.f8) {
            v4u o; o.x = pk4_fp8(v[0][nn] * 64.f, v[1][nn] * 64.f, v[2][nn] * 64.f, v[3][nn] * 64.f); o.y = pk4_fp8(v[4][nn] * 64.f, v[5][nn] * 64.f, v[6][nn] * 64.f, v[7][nn] * 64.f);
            o.z = pk4_fp8(v[8][nn] * 64.f, v[9][nn] * 64.f, v[10][nn] * 64.f, v[11][nn] * 64.f); o.w = pk4_fp8(v[12][nn] * 64.f, v[13][nn] * 64.f, v[14][nn] * 64.f, v[15][nn] * 64.f);
            *(v4u*)(d.dst + (size_t)dr * d.ldt + d.k0 + 16 * g) = o;
        } else {
            v4u o0, o1; o0.x = pk2(v[0][nn], v[1][nn]); o0.y = pk2(v[2][nn], v[3][nn]); o0.z = pk2(v[4][nn], v[5][nn]); o0.w = pk2(v[6][nn], v[7][nn]);
            o1.x = pk2(v[8][nn], v[9][nn]); o1.y = pk2(v[10][nn], v[11][nn]); o1.z = pk2(v[12][nn], v[13][nn]); o1.w = pk2(v[14][nn], v[15][nn]);
            v4u* dp = (v4u*)((bf16*)d.dst + (size_t)dr * d.ldt + d.k0 + 16 * g); dp[0] = o0; dp[1] = o1;
        }
    }
}
constexpr int IT_SMALL = IT_IN + IT_OUT + IT_R;
constexpr int BG_A = 16 * (S / 64) * 8, BG_C = BG_A, BG_T = NB * 8 * (S / 32), BG_TOTAL = BG_A + BG_C + BG_T;
constexpr int IT_FG = IT_TOTAL - BG_TOTAL;
static_assert(IT_SMALL + BG_TOTAL <= IT_TOTAL, "background slots exceed the expert items");
__device__ __forceinline__ int prep_fg_item(int j) { return j < IT_SMALL ? j : j + BG_TOTAL; }
__device__ __forceinline__ void prep_run(const PrepArgs& a, int it0, int stride, int lane) {
    int it = it0; if (it >= IT_FG) return;
    PrepDesc dA = prep_decode(a, prep_fg_item(it)), dB = dA; f32x4 va[16], vb[16]; prep_load(dA, lane, va);
    for (;;) {
        const int itB = it + stride; const bool hasB = itB < IT_FG;
        if (hasB) { dB = prep_decode(a, prep_fg_item(itB)); prep_load(dB, lane, vb); }
        prep_store(dA, lane, va);
        if (!hasB) break;
        const int itA = itB + stride; const bool hasA = itA < IT_FG;
        if (hasA) { dA = prep_decode(a, prep_fg_item(itA)); prep_load(dA, lane, va); }
        prep_store(dB, lane, vb);
        if (!hasA) break;
        it = itA;
    }
}


__device__ __forceinline__ f32x4 ld_bf4(const bf16* p) { const unsigned long long w = *(const unsigned long long*)p;
    return (f32x4){bf2f((unsigned)w & 0xffffu), bf2f(((unsigned)w) >> 16), bf2f((unsigned)(w >> 32) & 0xffffu), bf2f((unsigned)(w >> 48))}; }

#define LAS __attribute__((address_space(3)))
#define GAS __attribute__((address_space(1)))
namespace pg8 {
typedef short bf16x8 __attribute__((ext_vector_type(8)));
constexpr int F8_SCALE_W = 121;
constexpr int BM = 256, BK = 64, HALF = 128, HTB = HALF * BK * 2, STAGE_BYTES = 8 * HTB, NXCD = 8, WGM = 8;
__host__ __device__ __forceinline__ int lds_byte(int r, int c) { const int st = (r >> 4) * 2 + (c >> 5), rr = r & 15, cc = c & 31, ob = rr * 64 + cc * 2; return st * 1024 + (ob ^ (((ob >> 9) & 1) << 5)); }
__host__ __device__ __forceinline__ void stage_rc(int b, int& R, int& C) { const int st = b / 1024, sb = b % 1024, swz = sb ^ (((sb >> 9) & 1) << 5); R = (st >> 1) * 16 + swz / 64; C = (st & 1) * 32 + (swz % 64) / 2; }
__host__ __device__ __forceinline__ int perm16x(int R) { return 64 * (R >> 5) + 16 * ((R & 15) >> 2) + 4 * ((R >> 4) & 1) + (R & 3); }
__host__ __device__ __forceinline__ int perm32(int rho) { const int n = rho >> 4, i = rho & 15; return 8 * (i >> 2) + 4 * n + (i & 3); }

struct Unit { int pm, pn, e, mt; const char* A; const char* B; };

__device__ __forceinline__ long unit_index(int i, int G, int c) { return (G % 8 == 0) ? ((long)(i * 8 + (c & 7)) * (G / 8) + (c >> 3)) : ((long)i * G + c); }

struct StaticOrder {
    int nM, nN, nwg, G, c; const char* A; const char* B; size_t tstep;
    __device__ void init(const void* A_, const void* B_, int M, int N, int Kb, int G_, int c_) { nM = M / BM; nN = N / BM; nwg = nM * nN; G = G_; c = c_; A = (const char*)A_; B = (const char*)B_; tstep = (size_t)BM * Kb; }
    __device__ __forceinline__ bool next(int i, Unit& u) const {
        const long L = (long)i * G + c; if (L >= nwg) return false;
        int wgid = (int)L; { const int q = nwg / NXCD, r = nwg % NXCD, xcd = wgid % NXCD, off = wgid / NXCD; wgid = (xcd < r ? xcd * (q + 1) : r * (q + 1) + (xcd - r) * q) + off; }
        const int nig = WGM * nN, gid = wgid / nig, fm = gid * WGM, gsz = (nM - fm) < WGM ? (nM - fm) : WGM;
        u.pm = fm + ((wgid % nig) % gsz); u.pn = (wgid % nig) / gsz; u.e = 0; u.mt = u.pm; u.A = A + (size_t)u.pm * tstep; u.B = B + (size_t)u.pn * tstep; return true;
    }
    __device__ __forceinline__ int row_token(const Unit&, int) const { return 0; }
};

struct MoeOrder {
    int G, c, total, shift; const LAS int* tb; const LAS int* nn; const i32x2* list;
    const char* Abase; size_t a_tile_stride; const char* Bbase; size_t b_exp_stride, b_pn_stride;
    __device__ __forceinline__ bool next(int i, Unit& u) const {
        const long L = unit_index(i, G, c); if (L >= total) return false;
        const int tile = (int)(L >> shift); u.pn = (int)(L & ((1 << shift) - 1));
        int lo = 0, hi = NEX; while (hi - lo > 1) { const int mid = (lo + hi) >> 1; if (tb[mid] <= tile) lo = mid; else hi = mid; }
        u.e = lo; u.mt = tile - tb[lo]; u.pm = tile;
        u.A = Abase + (size_t)tile * a_tile_stride; u.B = Bbase + (size_t)lo * b_exp_stride + (size_t)u.pn * b_pn_stride; return true;
    }
    __device__ __forceinline__ int row_token(const Unit& u, int row) const {
        const int rr = u.mt * 256 + row;
        const int tok = list[u.pm * 256 + row].x >> 3;
        return u.e >= NE ? rr : (rr < nn[u.e] ? tok : 0);
    }
};

__device__ __forceinline__ unsigned cvt_pk_bf16(float lo, float hi) { unsigned r; asm volatile("v_cvt_pk_bf16_f32 %0, %1, %2" : "=v"(r) : "v"(lo), "v"(hi)); return r; }

struct EpiBf16 {
    static constexpr int PERM = 2; bf16* O; int ldc; int scale_tiles; float scale; float gscale;
    __device__ __forceinline__ void operator()(const f32x4 (&acc)[2][2][4][2], const Unit& u, int wr, int wc, int fr, int fq) const {
        const int row0 = u.pm * BM + wr * 64 + fr, col0 = u.pn * BM + wc * 64 + 16 * fq; const float sc = (u.pn < scale_tiles ? scale : 1.f) * gscale;
#pragma unroll
        for (int ai = 0; ai < 2; ++ai)
#pragma unroll
            for (int m = 0; m < 4; ++m) { bf16* rowp = O + (size_t)(row0 + ai * HALF + m * 16) * ldc + col0;
#pragma unroll
                for (int bj = 0; bj < 2; ++bj) { const f32x4 v0 = acc[ai][bj][m][0] * sc, v1 = acc[ai][bj][m][1] * sc;
                    v4u w; w.x = cvt_pk_bf16(v0[0], v0[1]); w.y = cvt_pk_bf16(v0[2], v0[3]); w.z = cvt_pk_bf16(v1[0], v1[1]); w.w = cvt_pk_bf16(v1[2], v1[3]);
                    *(v4u*)(rowp + bj * 8) = w; } }
    }
};
struct EpiF32 {
    static constexpr int PERM = 0; float* C; int ldc;
    __device__ __forceinline__ void operator()(const f32x4 (&acc)[2][2][4][2], const Unit& u, int wr, int wc, int fr, int fq) const {
        const int row0 = u.pm * BM + wr * 64 + fr, col0 = u.pn * BM + wc * 32 + 4 * fq;
#pragma unroll
        for (int ai = 0; ai < 2; ++ai)
#pragma unroll
            for (int m = 0; m < 4; ++m) { float* rowp = C + (size_t)(row0 + ai * HALF + m * 16) * ldc + col0;
#pragma unroll
                for (int bj = 0; bj < 2; ++bj)
#pragma unroll
                    for (int n = 0; n < 2; ++n) *(f32x4*)(rowp + bj * HALF + n * 16) = acc[ai][bj][m][n]; }
    }
};
struct EpiGlu {
    static constexpr int PERM = 1; unsigned char* H; float gscale;
    __device__ __forceinline__ void operator()(const f32x4 (&acc)[2][2][4][2], const Unit& u, int wr, int wc, int fr, int fq) const {
        const int row0 = u.pm * BM + wr * 64 + fr, col0 = u.pn * HALF + wc * 32 + 8 * fq;
#pragma unroll
        for (int ai = 0; ai < 2; ++ai)
#pragma unroll
            for (int m = 0; m < 4; ++m) { float h[8];
#pragma unroll
                for (int n = 0; n < 2; ++n)
#pragma unroll
                    for (int q = 0; q < 4; ++q) { const float a = acc[ai][0][m][n][q] * gscale; h[n * 4 + q] = a * __builtin_amdgcn_rcpf(1.f + __expf(-a)) * (acc[ai][1][m][n][q] * gscale); }
                *(unsigned long long*)(H + (size_t)(row0 + ai * HALF + m * 16) * FF + col0) = (unsigned long long)pk4_fp8(h[0], h[1], h[2], h[3]) | ((unsigned long long)pk4_fp8(h[4], h[5], h[6], h[7]) << 32); }
    }
};
struct EpiScatter {
    static constexpr int PERM = 2; unsigned char* ys8; bf16* ysh; const i32x2* list; const LAS int* nn;
    __device__ __forceinline__ void operator()(const f32x4 (&acc)[2][2][4][2], const Unit& u, int wr, int wc, int fr, int fq) const {
        const int col0 = u.pn * BM + wc * 64 + 16 * fq; const int n = nn[u.e]; const bool routed = u.e < NE;
        const i32x2* lp = list + (size_t)(u.pm - u.mt) * 256;
#pragma unroll
        for (int ai = 0; ai < 2; ++ai) {
            i32x2 en[4];
#pragma unroll
            for (int m = 0; m < 4; ++m) { const int rr = u.mt * 256 + ai * HALF + wr * 64 + m * 16 + fr; const i32x2 ld = lp[rr];
                en[m].x = routed ? ld.x : rr; en[m].y = routed ? ld.y : 0x3f800000; }
#pragma unroll
            for (int m = 0; m < 4; ++m) { const int rr = u.mt * 256 + ai * HALF + wr * 64 + m * 16 + fr;
                if (rr < n) {
                    if (routed) { const float g = __int_as_float(en[m].y) * (16.f / 64.f);
                        const f32x4 a0 = acc[ai][0][m][0] * g, a1 = acc[ai][0][m][1] * g, b0 = acc[ai][1][m][0] * g, b1 = acc[ai][1][m][1] * g;
                        v4u w; w.x = pk4_fp8(a0[0], a0[1], a0[2], a0[3]); w.y = pk4_fp8(a1[0], a1[1], a1[2], a1[3]); w.z = pk4_fp8(b0[0], b0[1], b0[2], b0[3]); w.w = pk4_fp8(b1[0], b1[1], b1[2], b1[3]);
                        *(v4u*)(ys8 + (size_t)en[m].x * D + col0) = w; }
                    else { bf16* dst = ysh + (size_t)rr * D + col0;
#pragma unroll
                        for (int bj = 0; bj < 2; ++bj) { const f32x4 v0 = acc[ai][bj][m][0] * (1.f / 64.f), v1 = acc[ai][bj][m][1] * (1.f / 64.f);
                            v4u w; w.x = cvt_pk_bf16(v0[0], v0[1]); w.y = cvt_pk_bf16(v0[2], v0[3]); w.z = cvt_pk_bf16(v1[0], v1[1]); w.w = cvt_pk_bf16(v1[2], v1[3]);
                            *(v4u*)(dst + bj * 8) = w; } } } }
            __builtin_amdgcn_sched_barrier(0);
        }
    }
};

typedef int i32x8 __attribute__((ext_vector_type(8)));
typedef int i32x4 __attribute__((ext_vector_type(4)));
template <bool FP8> struct FragT { struct A4 { bf16x8 v[4][2]; }; struct B2 { bf16x8 v[2][2]; }; };
template <> struct FragT<true> { struct A4 { i32x8 v[4]; }; struct B2 { i32x8 v[2]; }; };
template <class Epi, class Sched, bool GATHER, bool FP8>
__device__ __forceinline__ void gemm_phase(LAS unsigned char* lds, const int Kb, const Sched& S, const Epi& E) {
    const int tid = threadIdx.x, wid = __builtin_amdgcn_readfirstlane(tid >> 6), lane = tid & 63, wr = wid >> 2, wc = wid & 3, fr = lane & 15, fq = lane >> 4;
    const int nt = Kb / 128;
    int sR[2], sC[2];
    unsigned voffA[2], voffB[2];
#pragma unroll
    for (int i = 0; i < 2; ++i) { stage_rc(tid * 16 + i * 8192, sR[i], sC[i]); const int Rb = Epi::PERM == 2 ? perm16x(sR[i]) : (Epi::PERM == 1 ? ((sR[i] & ~31) + perm32(sR[i] & 31)) : sR[i]);
        voffA[i] = (unsigned)(sR[i] * Kb + sC[i] * 2); voffB[i] = (unsigned)(Rb * Kb + sC[i] * 2); }
    const size_t kstep = (size_t)(BK * 2);
    const size_t hstep = (size_t)HALF * Kb;
    const size_t bhstep = Epi::PERM == 2 ? (size_t)8 * Kb : hstep;
    const unsigned ldsw = (unsigned)wid * 1024u;
    const int aoff = lds_byte(wr * 64 + fr, fq * 8), boff = lds_byte(wc * 32 + fr, fq * 8);
    unsigned gc[2][2], gn[2][2];
#define PG8_SA(b, h) (((b) * 2 + (h)) * HTB)
#define PG8_SB(b, h) ((4 + (b) * 2 + (h)) * HTB)
#define PG8_GLDS(src, bufoff, i) __builtin_amdgcn_global_load_lds((const unsigned*)(src), (LAS unsigned*)(lds + (bufoff) + ldsw + (i) * 8192), 16, 0, 0)
#define PG8_STAGE_B(bufoff, gbase) do { PG8_GLDS((const char*)(gbase) + voffB[0], bufoff, 0); PG8_GLDS((const char*)(gbase) + voffB[1], bufoff, 1); } while (0)
#define PG8_STAGE_A(bufoff, gbase, h, nx) do { if constexpr (GATHER) { const unsigned _o0 = (nx) ? gn[h][0] : gc[h][0], _o1 = (nx) ? gn[h][1] : gc[h][1]; \
            PG8_GLDS((const char*)(gbase) + _o0, bufoff, 0); PG8_GLDS((const char*)(gbase) + _o1, bufoff, 1); } \
        else { PG8_GLDS((const char*)(gbase) + (h) * hstep + voffA[0], bufoff, 0); PG8_GLDS((const char*)(gbase) + (h) * hstep + voffA[1], bufoff, 1); } } while (0)
#define PG8_LD2(dstv, p) do { if constexpr (FP8) { const i32x4 _lo = *(const LAS i32x4*)(p), _hi = *(const LAS i32x4*)((p) + 1024); dstv = __builtin_shufflevector(_lo, _hi, 0, 1, 2, 3, 4, 5, 6, 7); } } while (0)
#define PG8_LDA(dst, b, h) do { _Pragma("unroll") for (int m = 0; m < 4; ++m) { if constexpr (FP8) { PG8_LD2(dst.v[m], lds + PG8_SA(b, h) + aoff + m * 2048); } \
        else { _Pragma("unroll") for (int k = 0; k < 2; ++k) dst.v[m][k] = *(const LAS bf16x8*)(lds + PG8_SA(b, h) + aoff + m * 2048 + k * 1024); } } } while (0)
#define PG8_LDB(dst, b, h) do { _Pragma("unroll") for (int n = 0; n < 2; ++n) { if constexpr (FP8) { PG8_LD2(dst.v[n], lds + PG8_SB(b, h) + boff + n * 2048); } \
        else { _Pragma("unroll") for (int k = 0; k < 2; ++k) dst.v[n][k] = *(const LAS bf16x8*)(lds + PG8_SB(b, h) + boff + n * 2048 + k * 1024); } } } while (0)
#define PG8_MMA(ai, bj, At, Bt) do { __builtin_amdgcn_s_setprio(1); _Pragma("unroll") for (int m = 0; m < 4; ++m) _Pragma("unroll") for (int n = 0; n < 2; ++n) { \
        if constexpr (FP8) asm volatile("s_nop 1\n\tv_mfma_scale_f32_16x16x128_f8f6f4 %0, %1, %2, %0, %3, %3 op_sel_hi:[0,0,0]" : "+v"(acc[ai][bj][m][n]) : "v"(Bt.v[n]), "v"(At.v[m]), "v"(f8scale)); \
        else { _Pragma("unroll") for (int k = 0; k < 2; ++k) acc[ai][bj][m][n] = __builtin_amdgcn_mfma_f32_16x16x32_bf16(Bt.v[n][k], At.v[m][k], acc[ai][bj][m][n], 0, 0, 0); } } \
        __builtin_amdgcn_s_setprio(0); } while (0)
#define PG8_WAIT_V(n) asm volatile("s_waitcnt vmcnt(" #n ")" ::: "memory")
#define PG8_WAIT_L(n) asm volatile("s_waitcnt lgkmcnt(" #n ")" ::: "memory")
#define PG8_BAR __builtin_amdgcn_s_barrier()
#define PG8_SCHED __builtin_amdgcn_sched_barrier(0)
#define PG8_GATHER(dst, u) do { _Pragma("unroll") for (int _h = 0; _h < 2; ++_h) _Pragma("unroll") for (int _i = 0; _i < 2; ++_i) \
        dst[_h][_i] = (unsigned)(S.row_token(u, _h * HALF + sR[_i]) * Kb + sC[_i] * 2); } while (0)
    Unit cur, nxt; int ui = 0;
    if (!S.next(0, cur)) return;
    f32x4 acc[2][2][4][2];
#pragma unroll
    for (int a = 0; a < 2; ++a)
#pragma unroll
        for (int b = 0; b < 2; ++b)
#pragma unroll
            for (int m = 0; m < 4; ++m)
#pragma unroll
                for (int n = 0; n < 2; ++n) acc[a][b][m][n] = (f32x4){0.f, 0.f, 0.f, 0.f};
    const int f8scale = 0x7f7f7f7f;
    typedef typename FragT<FP8>::A4 FragA; typedef typename FragT<FP8>::B2 FragB;
    FragA At; FragB B0, B1;
    const char* cA = cur.A; const char* cB = cur.B;
    if constexpr (GATHER) { PG8_GATHER(gc, cur); }
    PG8_STAGE_B(PG8_SB(0, 0), cB); PG8_STAGE_A(PG8_SA(0, 0), cA, 0, false); PG8_STAGE_B(PG8_SB(0, 1), cB + bhstep); PG8_STAGE_A(PG8_SA(0, 1), cA, 1, false);
    if (wr == 1) PG8_BAR;
    PG8_WAIT_V(4); PG8_BAR;
    PG8_STAGE_B(PG8_SB(1, 0), cB + kstep); PG8_STAGE_A(PG8_SA(1, 0), cA + kstep, 0, false); PG8_STAGE_B(PG8_SB(1, 1), cB + bhstep + kstep);
    PG8_WAIT_V(6); PG8_BAR;
    for (;;) {
        const bool has_next = S.next(ui + 1, nxt);
        const char* nA = has_next ? nxt.A : cA; const char* nB = has_next ? nxt.B : cB;
        if constexpr (GATHER) { if (has_next) { PG8_GATHER(gn, nxt); } else {
#pragma unroll
            for (int h = 0; h < 2; ++h) { gn[h][0] = gc[h][0]; gn[h][1] = gc[h][1]; } } }
#pragma unroll 1
        for (int t = 0; t < nt; t += 2) {
            const bool last = (t == nt - 2);
            const char* a1 = cA + (size_t)(t + 1) * kstep;
            const char* a2 = last ? nA : cA + (size_t)(t + 2) * kstep; const char* b2 = last ? nB : cB + (size_t)(t + 2) * kstep;
            const char* a3 = a2 + kstep; const char* b3 = b2 + kstep;
            PG8_LDB(B0, 0, 0); PG8_SCHED; PG8_LDA(At, 0, 0); PG8_STAGE_A(PG8_SA(1, 1), a1, 1, false);
            PG8_WAIT_L(8); PG8_BAR; PG8_WAIT_L(0); PG8_MMA(0, 0, At, B0); PG8_BAR; PG8_SCHED;
            PG8_LDB(B1, 0, 1); PG8_STAGE_B(PG8_SB(0, 0), b2);
            PG8_BAR; PG8_WAIT_L(0); PG8_MMA(0, 1, At, B1); PG8_BAR;
            PG8_LDA(At, 0, 1); PG8_STAGE_A(PG8_SA(0, 0), a2, 0, last);
            PG8_BAR; PG8_WAIT_L(0); PG8_MMA(1, 0, At, B0); PG8_BAR; PG8_SCHED;
            PG8_STAGE_B(PG8_SB(0, 1), b2 + bhstep);
            PG8_WAIT_V(6); PG8_BAR; PG8_MMA(1, 1, At, B1); PG8_BAR;
            PG8_LDB(B0, 1, 0); PG8_SCHED; PG8_LDA(At, 1, 0); PG8_STAGE_A(PG8_SA(0, 1), a2, 1, last);
            PG8_WAIT_L(8); PG8_BAR; PG8_WAIT_L(0); PG8_MMA(0, 0, At, B0); PG8_BAR; PG8_SCHED;
            PG8_LDB(B1, 1, 1); PG8_STAGE_B(PG8_SB(1, 0), b3);
            PG8_BAR; PG8_WAIT_L(0); PG8_MMA(0, 1, At, B1); PG8_BAR;
            PG8_LDA(At, 1, 1); PG8_STAGE_A(PG8_SA(1, 0), a3, 0, last);
            PG8_BAR; PG8_WAIT_L(0); PG8_MMA(1, 0, At, B0); PG8_BAR; PG8_SCHED;
            PG8_STAGE_B(PG8_SB(1, 1), b3 + bhstep);
            PG8_WAIT_V(6); PG8_BAR; PG8_MMA(1, 1, At, B1); PG8_BAR;
        }
        if (wr == 0) PG8_BAR;
        if constexpr (FP8) { __builtin_amdgcn_sched_barrier(0); asm volatile("s_nop 15\n\ts_nop 7" ::: "memory"); __builtin_amdgcn_sched_barrier(0); }
        E(acc, cur, wr, wc, fr, fq);
        if (!has_next) break;
#pragma unroll
        for (int a = 0; a < 2; ++a)
#pragma unroll
            for (int b = 0; b < 2; ++b)
#pragma unroll
                for (int m = 0; m < 4; ++m)
#pragma unroll
                    for (int n = 0; n < 2; ++n) acc[a][b][m][n] = (f32x4){0.f, 0.f, 0.f, 0.f};
        cur = nxt; cA = nA; cB = nB; ++ui;
        if (wr == 1) PG8_BAR;
        if constexpr (GATHER) {
#pragma unroll
            for (int h = 0; h < 2; ++h) { gc[h][0] = gn[h][0]; gc[h][1] = gn[h][1]; } }
    }
    PG8_WAIT_V(0);
    PG8_BAR;
#undef PG8_SA
#undef PG8_SB
#undef PG8_GLDS
#undef PG8_STAGE_A
#undef PG8_STAGE_B
#undef PG8_LDA
#undef PG8_LDB
#undef PG8_MMA
#undef PG8_WAIT_V
#undef PG8_WAIT_L
#undef PG8_BAR
#undef PG8_SCHED
#undef PG8_GATHER
}
}

#define XB_TMO      128
#define XB_XCNT(j)  (256  + 64 * (j))
#define XB_XSUB(j)  (1280 + 64 * (j))
#define XB_XGEN(j)  (2304 + 64 * (j))
#define XB_TOP      3328
#define XB_TOPGEN   3392
#define XCD_BAR_WORDS 3456
#define XB_SPIN_CAP (1u << 22)
__device__ __forceinline__ unsigned xb_ld(unsigned* p)              { return __hip_atomic_load(p, __ATOMIC_RELAXED, __HIP_MEMORY_SCOPE_AGENT); }
__device__ __forceinline__ unsigned xb_add(unsigned* p, unsigned v) { return __hip_atomic_fetch_add(p, v, __ATOMIC_RELAXED, __HIP_MEMORY_SCOPE_AGENT); }
__device__ __forceinline__ unsigned xb_xcc_id() { return (unsigned)__builtin_amdgcn_s_getreg((3 << 11) | 20) & 0xFu; }
#define XB_SPIN(cond, bar) do { unsigned _sp = 0; while (cond) { __builtin_amdgcn_s_sleep(1); \
    if ((++_sp & 255u) == 0u) { if (xb_ld(&(bar)[XB_TMO])) break; if (_sp > XB_SPIN_CAP) { atomicAdd(&(bar)[XB_TMO], 1u); break; } } } } while (0)
struct XcdBarrier { unsigned* bar; unsigned x; volatile LAS unsigned* st; };
__device__ __forceinline__ XcdBarrier xcd_barrier_post(unsigned* bar, volatile LAS unsigned* st) {
    XcdBarrier b; b.bar = bar; b.x = xb_xcc_id(); b.st = st;
    if (threadIdx.x == 0) (void)xb_add(&bar[XB_XCNT(b.x)], 1u);
    return b;
}
__device__ __forceinline__ void xcd_barrier_complete(unsigned* bar, unsigned x, unsigned& nloc, unsigned& nx) {
    const unsigned G = gridDim.x * gridDim.y * gridDim.z;
    unsigned sum, cnt, mine, sp = 0u;
    for (;;) {
        sum = 0u; cnt = 0u; mine = 0u;
#pragma unroll
        for (unsigned j = 0; j < 16; ++j) { const unsigned c = xb_ld(&bar[XB_XCNT(j)]); sum += c; cnt += (c > 0u) ? 1u : 0u; mine = (j == x) ? c : mine; }
        if (sum == G) break;
        __builtin_amdgcn_s_sleep(1);
        if ((++sp & 255u) == 0u) { if (xb_ld(&bar[XB_TMO])) break; if (sp > XB_SPIN_CAP) { atomicAdd(&bar[XB_TMO], 1u); break; } }
    }
    nloc = mine > 0u ? mine : 1u; nx = cnt > 0u ? cnt : 1u;
}
__device__ __forceinline__ void xcd_barrier(const XcdBarrier& b) {
    asm volatile("s_waitcnt vmcnt(0)" ::: "memory");
    __syncthreads();
    if (threadIdx.x == 0) {
        unsigned* bar = b.bar;
        __builtin_amdgcn_s_waitcnt(0);
        unsigned nloc = b.st[0], nx = b.st[1];
        if (nloc == 0u) { xcd_barrier_complete(bar, b.x, nloc, nx); b.st[0] = nloc; b.st[1] = nx; }
        const unsigned old = xb_add(&bar[XB_XSUB(b.x)], 1u);
        const unsigned gen = old / nloc;
        if (old + 1u == (gen + 1u) * nloc) {
            __builtin_amdgcn_fence(__ATOMIC_RELEASE, "agent");
            asm volatile("s_waitcnt vmcnt(0)" ::: "memory");
            const unsigned og = xb_add(&bar[XB_TOP], 1u);
            const unsigned tg = og / nx;
            if (og + 1u == (tg + 1u) * nx) xb_add(&bar[XB_TOPGEN], 1u);
            else XB_SPIN(xb_ld(&bar[XB_TOPGEN]) == tg, bar);
            __builtin_amdgcn_fence(__ATOMIC_ACQUIRE, "agent");
            xb_add(&bar[XB_XGEN(b.x)], 1u);
            asm volatile("s_waitcnt vmcnt(0)" ::: "memory");
        } else {
            XB_SPIN(xb_ld(&bar[XB_XGEN(b.x)]) == gen, bar);
            __builtin_amdgcn_fence(__ATOMIC_ACQUIRE, "agent");
            asm volatile("s_waitcnt vmcnt(0)" ::: "memory");
        }
    }
    __syncthreads();
}

constexpr int NWAVES = 8, NTHR = 512;
constexpr int RING_BYTES = 131072, XTRA_OFF = RING_BYTES, LDS_BYTES = 147456;
constexpr int X_MISC = 0, X_TB = 256, X_NN = 1536;
constexpr int CW_BAR = 4096;
constexpr int N_PHASES = 14;
struct MArgs { const float* in[22]; float* out; unsigned char* ws; int ph_lo, ph_hi; };

#define MAKE_PREP_ARGS(a) PrepArgs{(a).in[4], (a).in[9], (a).in[12], (a).in[14], (a).in[15], (a).in[16], (a).in[17], (a).in[18], (a).in[19], \
    (unsigned char*)((a).ws + WS_WTIN), (bf16*)((a).ws + WS_WTOUT), (bf16*)((a).ws + WS_WTR), (unsigned char*)((a).ws + WS_WT13), (unsigned char*)((a).ws + WS_WT2)}
__device__ __forceinline__ void ph_mod_prep(const MArgs& a, unsigned char* smem, int G) {
    const int tid = threadIdx.x;
    unsigned char* ws = a.ws;
    if ((int)blockIdx.x < 192) {
        float* sc = (float*)smem; float* red = sc + NB * D;
        const float* c = a.in[1]; const float* w_ada = a.in[2]; const float* b_ada = a.in[3]; float* mod = (float*)(ws + WS_MOD);
        for (int i = tid; i < NB * D; i += NTHR) sc[i] = siluf_(c[i]);
        __syncthreads();
        for (int it = blockIdx.x; it < 192; it += G) {
            const int kq = tid >> 5, jl = tid & 31, j = it * 32 + jl;
            float a0 = 0.f, a1 = 0.f, a2 = 0.f, a3 = 0.f;
#pragma unroll 16
            for (int kk = 0; kk < 64; ++kk) { const int k = kq * 64 + kk; const float w = w_ada[(size_t)k * 6144 + j];
                a0 += sc[k] * w; a1 += sc[D + k] * w; a2 += sc[2 * D + k] * w; a3 += sc[3 * D + k] * w; }
            red[(kq * 4 + 0) * 32 + jl] = a0; red[(kq * 4 + 1) * 32 + jl] = a1; red[(kq * 4 + 2) * 32 + jl] = a2; red[(kq * 4 + 3) * 32 + jl] = a3;
            __syncthreads();
            if (tid < 128) { const int b = tid >> 5; float s = b_ada[j];
#pragma unroll
                for (int q = 0; q < 16; ++q) s += red[(q * 4 + b) * 32 + jl];
                mod[b * 6144 + j] = s; }
            __syncthreads();
        }
    }
    const PrepArgs pa = MAKE_PREP_ARGS(a);
    const int lane = tid & 63, gw = blockIdx.x * NWAVES + (tid >> 6), ngw = G * NWAVES;
    prep_run(pa, gw, ngw, lane);
}

__device__ __forceinline__ void ph_ln1(const MArgs& a, unsigned char* smem, int G) {
    const int tid = threadIdx.x, lane = tid & 63, wave = tid >> 6;
    const float* x = a.in[0]; const float* w_in = a.in[4]; const float* gate_b = a.in[7];
    const float* mod = (const float*)(a.ws + WS_MOD); unsigned char* u1 = (unsigned char*)(a.ws + WS_U1); float* ipre = (float*)(a.ws + WS_GATES); float* logf = ipre + 16 * S;
    float* wg = (float*)smem;
    for (int i = tid; i < D * 8; i += NTHR) wg[i] = w_in[(size_t)(i >> 3) * WIN_LD + C_GATE + (i & 7)];
    __syncthreads();
    for (int it = blockIdx.x; it < T / 128; it += G) {
        const int row0 = it * 128, b = row0 / S;
        f32x4 sh[4], sc[4];
#pragma unroll
        for (int j = 0; j < 4; ++j) { sh[j] = *(const f32x4*)(mod + b * 6144 + 4 * lane + 256 * j); sc[j] = *(const f32x4*)(mod + b * 6144 + 1024 + 4 * lane + 256 * j); }
        for (int rr = wave; rr < 128; rr += NWAVES) {
            const int row = row0 + rr;
            const f32x4* xr = (const f32x4*)(x + (size_t)row * D) + lane;
            f32x4 v[4]; float s = 0.f;
#pragma unroll
            for (int j = 0; j < 4; ++j) { v[j] = xr[64 * j]; s += (v[j].x + v[j].y) + (v[j].z + v[j].w); }
            const float mean = wave_sum(s) * (1.f / D); float s2 = 0.f;
#pragma unroll
            for (int j = 0; j < 4; ++j) { v[j] = v[j] - mean; s2 += (v[j].x * v[j].x + v[j].y * v[j].y) + (v[j].z * v[j].z + v[j].w * v[j].w); }
            const float rstd = 1.f / sqrtf(wave_sum(s2) * (1.f / D) + LN_EPS);
            float ga[8];
#pragma unroll
            for (int q = 0; q < 8; ++q) ga[q] = 0.f;
            unsigned* o4 = (unsigned*)(u1 + (size_t)row * D) + lane;
#pragma unroll
            for (int j = 0; j < 4; ++j) {
                const f32x4 u = v[j] * rstd * (sc[j] + 1.0f) + sh[j];
                o4[64 * j] = pk4_fp8(u.x, u.y, u.z, u.w);
#pragma unroll
                for (int e = 0; e < 4; ++e) { const int k = 4 * lane + 256 * j + e;
                    const f32x4 w0 = *(const f32x4*)(wg + k * 8), w1 = *(const f32x4*)(wg + k * 8 + 4);
                    ga[0] += u[e] * w0.x; ga[1] += u[e] * w0.y; ga[2] += u[e] * w0.z; ga[3] += u[e] * w0.w;
                    ga[4] += u[e] * w1.x; ga[5] += u[e] * w1.y; ga[6] += u[e] * w1.z; ga[7] += u[e] * w1.w; }
            }
#pragma unroll
            for (int q = 0; q < 8; ++q) ga[q] = wave_sum(ga[q]);
            if (lane < 8) {
                float gv = 0.f;
#pragma unroll
                for (int q = 0; q < 8; ++q) gv = (lane == q) ? ga[q] : gv;
                gv += gate_b[lane];
                const int h = lane & 3, s_ = row % S;
                if (lane < 4) ipre[(size_t)(b * 4 + h) * S + s_] = gv;
                else logf[(size_t)(b * 4 + h) * S + s_] = fminf(gv, 0.f) - log1pf(__expf(-fabsf(gv)));
            }
        }
    }
}

__device__ __forceinline__ void ph_ln2(const MArgs& a, int G) {
    const float* x = a.in[0]; const bf16* mixout = (const bf16*)(a.ws + WS_MIXOUT); const float* mod = (const float*)(a.ws + WS_MOD); const float* ln1_g = a.in[10]; const float* ln1_b = a.in[11];
    float* x1 = a.out; bf16* u2 = (bf16*)(a.ws + WS_U2); unsigned char* u2f8 = (unsigned char*)(a.ws + WS_U2F8);
    const int tid = threadIdx.x, lane = tid & 63, wave = tid >> 6;
    for (int it = blockIdx.x; it < T / 128; it += G) {
        const int row0 = it * 128, b = row0 / S;
        f32x4 g1[4], lg[4], lb[4], sc2[4], sh2[4];
#pragma unroll
        for (int j = 0; j < 4; ++j) { const int col = 4 * lane + 256 * j;
            g1[j] = *(const f32x4*)(mod + b * 6144 + 2048 + col); lg[j] = *(const f32x4*)(ln1_g + col); lb[j] = *(const f32x4*)(ln1_b + col);
            sc2[j] = *(const f32x4*)(mod + b * 6144 + 4096 + col) + 1.0f; sh2[j] = *(const f32x4*)(mod + b * 6144 + 3072 + col); }
        for (int rr = wave; rr < 128; rr += NWAVES) {
            const int row = row0 + rr;
            f32x4 v[4]; float s = 0.f;
#pragma unroll
            for (int j = 0; j < 4; ++j) {
                const int col = 4 * lane + 256 * j;
                const f32x4 xv = __builtin_nontemporal_load((const f32x4*)(x + (size_t)row * D + col));
                const f32x4 mo = ld_bf4(mixout + (size_t)row * D + col);
                v[j] = xv * DN_ALPHA + g1[j] * mo; s += (v[j].x + v[j].y) + (v[j].z + v[j].w);
            }
            float mean = wave_sum(s) * (1.f / D), s2 = 0.f;
#pragma unroll
            for (int j = 0; j < 4; ++j) { v[j] = v[j] - mean; s2 += (v[j].x * v[j].x + v[j].y * v[j].y) + (v[j].z * v[j].z + v[j].w * v[j].w); }
            float rstd = 1.f / sqrtf(wave_sum(s2) * (1.f / D) + LN_EPS);
            s = 0.f;
#pragma unroll
            for (int j = 0; j < 4; ++j) { const int col = 4 * lane + 256 * j;
                v[j] = v[j] * rstd * lg[j] + lb[j];
                *(f32x4*)(x1 + (size_t)row * D + col) = v[j]; s += (v[j].x + v[j].y) + (v[j].z + v[j].w); }
            mean = wave_sum(s) * (1.f / D); s2 = 0.f;
#pragma unroll
            for (int j = 0; j < 4; ++j) { v[j] = v[j] - mean; s2 += (v[j].x * v[j].x + v[j].y * v[j].y) + (v[j].z * v[j].z + v[j].w * v[j].w); }
            rstd = 1.f / sqrtf(wave_sum(s2) * (1.f / D) + LN_EPS);
#pragma unroll
            for (int j = 0; j < 4; ++j) { const int col = 4 * lane + 256 * j;
                const f32x4 u = v[j] * rstd * sc2[j] + sh2[j];
                *(unsigned long long*)(u2 + (size_t)row * D + col) = (unsigned long long)pk2(u.x, u.y) | ((unsigned long long)pk2(u.z, u.w) << 32);
                *(unsigned*)(u2f8 + (size_t)row * D + col) = pk4_fp8(u.x, u.y, u.z, u.w); }
        }
    }
}
#define DPPI(v, ctrl) __builtin_amdgcn_update_dpp(0, (v), (ctrl), 0xF, 0xF, true)
#define DPPF(v, ctrl) __builtin_bit_cast(float, __builtin_amdgcn_update_dpp(0, __builtin_bit_cast(int, (v)), (ctrl), 0xF, 0xF, true))
__device__ __forceinline__ void route_wave(int t, int lane, const float* __restrict__ logits, const f32x4 bias4, int* __restrict__ tope, float* __restrict__ topg, int* __restrict__ cnt) {
    const f32x4 lg = *(const f32x4*)(logits + (size_t)t * NE + 4 * lane);
    float sc[4], v[4];
#pragma unroll
    for (int j = 0; j < 4; ++j) { sc[j] = 1.f / (1.f + __expf(-lg[j])); v[j] = sc[j] + bias4[j]; }
    float m1 = fmaxf(fmaxf(v[0], v[1]), fmaxf(v[2], v[3]));
    float m2; { const float a = fmaxf(v[0], v[1]), b = fminf(v[0], v[1]), c = fmaxf(v[2], v[3]), d = fminf(v[2], v[3]); m2 = fmaxf(fminf(a, c), fmaxf(b, d)); }
#pragma unroll
    for (int st = 0; st < 3; ++st) { const float o1 = st == 0 ? DPPF(m1, 0xB1) : (st == 1 ? DPPF(m1, 0x4E) : DPPF(m1, 0x141)), o2 = st == 0 ? DPPF(m2, 0xB1) : (st == 1 ? DPPF(m2, 0x4E) : DPPF(m2, 0x141));
        const float n1 = fmaxf(m1, o1); m2 = fmaxf(fminf(m1, o1), fmaxf(m2, o2)); m1 = n1; }
    const float gs = m1 + m2; const int myg = lane >> 3; int rank = 0;
#pragma unroll
    for (int gg = 0; gg < 8; ++gg) { const float og = __builtin_bit_cast(float, __builtin_amdgcn_readlane(__builtin_bit_cast(int, gs), gg * 8)); rank += (og > gs || (og == gs && gg < myg)) ? 1 : 0; }
    unsigned kh[4];
#pragma unroll
    for (int j = 0; j < 4; ++j) { const unsigned u = __builtin_bit_cast(unsigned, v[j]); kh[j] = (rank >= 4) ? 0u : (u ^ ((u >> 31) ? 0xFFFFFFFFu : 0x80000000u)); }
    int myE = 0; float myS = 0.f, gsum = 0.f;
#pragma unroll
    for (int rd = 0; rd < 8; ++rd) {
        unsigned bh_ = kh[0]; int bl = 255 - 4 * lane;
#pragma unroll
        for (int j = 1; j < 4; ++j) if (kh[j] > bh_) { bh_ = kh[j]; bl = 255 - (4 * lane + j); }
#pragma unroll
        for (int st = 0; st < 4; ++st) {
            const int ctrl = st == 0 ? 0xB1 : (st == 1 ? 0x4E : (st == 2 ? 0x141 : 0x140));
            const unsigned oh = (unsigned)(st == 0 ? DPPI((int)bh_, 0xB1) : (st == 1 ? DPPI((int)bh_, 0x4E) : (st == 2 ? DPPI((int)bh_, 0x141) : DPPI((int)bh_, 0x140))));
            const int ol = st == 0 ? DPPI(bl, 0xB1) : (st == 1 ? DPPI(bl, 0x4E) : (st == 2 ? DPPI(bl, 0x141) : DPPI(bl, 0x140)));
            (void)ctrl; const bool take = (oh > bh_) || (oh == bh_ && ol > bl); bh_ = take ? oh : bh_; bl = take ? ol : bl; }
        unsigned wh = (unsigned)__builtin_amdgcn_readlane((int)bh_, 0); int wl = __builtin_amdgcn_readlane(bl, 0);
#pragma unroll
        for (int rw = 1; rw < 4; ++rw) { const unsigned oh = (unsigned)__builtin_amdgcn_readlane((int)bh_, 16 * rw); const int ol = __builtin_amdgcn_readlane(bl, 16 * rw);
            const bool take = (oh > wh) || (oh == wh && ol > wl); wh = take ? oh : wh; wl = take ? ol : wl; }
        const int bi = 255 - wl;
        float cand = 0.f;
#pragma unroll
        for (int j = 0; j < 4; ++j) if (bi == 4 * lane + j) { cand = sc[j]; kh[j] = 0u; }
        const float ss = __builtin_bit_cast(float, __builtin_amdgcn_readlane(__builtin_bit_cast(int, cand), bi >> 2));
        gsum += ss;
        if (lane == rd) { myE = bi; myS = ss; }
    }
    if (lane < 8) { tope[t * 8 + lane] = myE; topg[t * 8 + lane] = myS * (2.5f / gsum); atomicAdd(cnt + myE, 1); }
}
__device__ __forceinline__ void moe_tables(const int* cnt, LAS int* tb, LAS int* nn) {
    if (threadIdx.x < 64) {
        const int lane = threadIdx.x; int n[4], tl[4], loc = 0;
#pragma unroll
        for (int j = 0; j < 4; ++j) { n[j] = cnt[4 * lane + j]; tl[j] = (n[j] + 255) >> 8; loc += tl[j]; }
        int inc = loc;
#pragma unroll
        for (int o = 1; o < 64; o <<= 1) { const int v = __shfl_up(inc, o); if (lane >= o) inc += v; }
        int base = inc - loc;
#pragma unroll
        for (int j = 0; j < 4; ++j) { tb[4 * lane + j] = base; nn[4 * lane + j] = n[j]; base += tl[j]; }
        if (lane == 63) { tb[NE] = base; nn[NE] = T; tb[NEX] = base + T / 256; }
    }
    __syncthreads();
}
__device__ __forceinline__ void ph_final(const MArgs& a, int G) {
    float* out = a.out; const unsigned char* ys8 = (const unsigned char*)(a.ws + WS_YS); const bf16* ysh = (const bf16*)(a.ws + WS_YSH); const float* mod = (const float*)(a.ws + WS_MOD);
    const float* ln2_g = a.in[20]; const float* ln2_b = a.in[21];
    const int tid = threadIdx.x, lane = tid & 63, wave = tid >> 6;
    for (int it = blockIdx.x; it < T / 128; it += G) {
        const int row0 = it * 128, b = row0 / S;
        f32x4 g2[4], lg[4], lb[4];
#pragma unroll
        for (int j = 0; j < 4; ++j) { const int col = 4 * lane + 256 * j; g2[j] = *(const f32x4*)(mod + b * 6144 + 5120 + col); lg[j] = *(const f32x4*)(ln2_g + col); lb[j] = *(const f32x4*)(ln2_b + col); }
        for (int rr = wave; rr < 128; rr += NWAVES) {
            const int row = row0 + rr;
            f32x4 v[4]; float s = 0.f;
#pragma unroll
            for (int j = 0; j < 4; ++j) { const int col = 4 * lane + 256 * j;
                f32x4 yr = {0.f, 0.f, 0.f, 0.f};
#pragma unroll
                for (int k = 0; k < 8; ++k) { const int w = *(const int*)(ys8 + ((size_t)row * 8 + k) * D + col);
                    const f32x2 lo = __builtin_amdgcn_cvt_pk_f32_fp8(w, false), hi = __builtin_amdgcn_cvt_pk_f32_fp8(w, true); yr = yr + (f32x4){lo.x, lo.y, hi.x, hi.y}; }
                const f32x4 y = ld_bf4(ysh + (size_t)row * D + col) + yr * (1.f / 16.f);
                v[j] = *(const f32x4*)(out + (size_t)row * D + col) * DN_ALPHA + g2[j] * y;
                s += (v[j].x + v[j].y) + (v[j].z + v[j].w); }
            const float mean = wave_sum(s) * (1.f / D); float s2 = 0.f;
#pragma unroll
            for (int j = 0; j < 4; ++j) { v[j] = v[j] - mean; s2 += (v[j].x * v[j].x + v[j].y * v[j].y) + (v[j].z * v[j].z + v[j].w * v[j].w); }
            const float rstd = 1.f / sqrtf(wave_sum(s2) * (1.f / D) + LN_EPS);
#pragma unroll
            for (int j = 0; j < 4; ++j) { const int col = 4 * lane + 256 * j;
                __builtin_nontemporal_store(v[j] * rstd * lg[j] + lb[j], (f32x4*)(out + (size_t)row * D + col)); }
        }
    }
}


typedef short s16x4 __attribute__((ext_vector_type(4)));
typedef short bf16x8v __attribute__((ext_vector_type(8)));
typedef float f32x16 __attribute__((ext_vector_type(16)));
constexpr int MLP = 320;
constexpr int NCH = S / 64;
constexpr int ST_ELEMS = 129 * 128;
constexpr size_t WS_CHK = WS_GATES + 1 * MiB;
constexpr size_t WS_MPREV = WS_GATES + 1 * MiB + 65536;
constexpr size_t WS_KC = WS_U2;
__device__ __forceinline__ s16x4 tr_read(const LAS unsigned char* p) { return __builtin_bit_cast(s16x4, __builtin_amdgcn_ds_read_tr16_b64_v4i16((LAS s16x4*)p)); }
__device__ __forceinline__ bf16x8v tr_frag(const LAS unsigned char* tile, int row0, int col0, int lane) {
    const int i = lane & 15; const LAS unsigned char* p = tile + (row0 + (i >> 2)) * MLP + (col0 + 4 * (i & 3)) * 2;
    const s16x4 lo = tr_read(p), hi = tr_read(p + 4 * MLP);
    return __builtin_shufflevector(lo, hi, 0, 1, 2, 3, 4, 5, 6, 7);
}
__device__ __forceinline__ bf16x8v tr_frag_perm(const LAS unsigned char* tile, int row0, int col0, int lane) {
    const int i = lane & 15; const LAS unsigned char* p = tile + (row0 + (i >> 2)) * MLP + (col0 + 4 * (i & 3)) * 2;
    const s16x4 lo = tr_read(p), hi = tr_read(p + 8 * MLP);
    return __builtin_shufflevector(lo, hi, 0, 1, 2, 3, 4, 5, 6, 7);
}
__device__ __forceinline__ float wave_incl_sum(float v, int lane) {
#pragma unroll
    for (int o = 1; o < 64; o <<= 1) { const float u = __shfl_up(v, o); if (lane >= o) v += u; }
    return v;
}
__device__ __forceinline__ float wave_incl_max(float v, int lane) {
#pragma unroll
    for (int o = 1; o < 64; o <<= 1) { const float u = __shfl_up(v, o); if (lane >= o) v = fmaxf(v, u); }
    return v;
}
__device__ __forceinline__ float wave_max(float v) {
#pragma unroll
    for (int o = 1; o < 64; o <<= 1) v = fmaxf(v, __shfl_xor(v, o));
    return v;
}
__device__ __forceinline__ void conv8(const bf16* __restrict__ rowp, int spos, const float* __restrict__ cw, const float* __restrict__ cb, float scale, float (&y)[8]) {
    const f32x4 b0 = *(const f32x4*)cb, b1 = *(const f32x4*)(cb + 4);
    y[0] = b0.x; y[1] = b0.y; y[2] = b0.z; y[3] = b0.w; y[4] = b1.x; y[5] = b1.y; y[6] = b1.z; y[7] = b1.w;
#pragma unroll
    for (int j = 0; j < 4; ++j) {
        if (spos - 3 + j >= 0) {
            const v4u xr = *(const v4u*)(rowp + (ptrdiff_t)(j - 3) * NPROJ);
            const f32x4 w0 = *(const f32x4*)(cw + j * 1024), w1 = *(const f32x4*)(cw + j * 1024 + 4);
            y[0] += w0.x * bf2f(xr.x & 0xffffu); y[1] += w0.y * bf2f(xr.x >> 16); y[2] += w0.z * bf2f(xr.y & 0xffffu); y[3] += w0.w * bf2f(xr.y >> 16);
            y[4] += w1.x * bf2f(xr.z & 0xffffu); y[5] += w1.y * bf2f(xr.z >> 16); y[6] += w1.z * bf2f(xr.w & 0xffffu); y[7] += w1.w * bf2f(xr.w >> 16);
        }
    }
#pragma unroll
    for (int e = 0; e < 8; ++e) y[e] = siluf_(y[e]) * scale;
}
__device__ __forceinline__ v4u pack8(const float (&y)[8]) { v4u o; o.x = pk2(y[0], y[1]); o.y = pk2(y[2], y[3]); o.z = pk2(y[4], y[5]); o.w = pk2(y[6], y[7]); return o; }

__device__ __forceinline__ void ml_phaseA(const MArgs& a, LAS unsigned char* lds, int vb0, int nvb) {
    const int tid = threadIdx.x, lane = tid & 63, wave = __builtin_amdgcn_readfirstlane(tid >> 6);
    const bf16* proj = (const bf16*)(a.ws + WS_PROJ); const float* conv_w = a.in[5]; const float* conv_b = a.in[6];
    const float* ipre = (const float*)(a.ws + WS_GATES); const float* logf = ipre + 16 * S;
    bf16* kcg = (bf16*)(a.ws + WS_KC); bf16* st = (bf16*)(a.ws + WS_STATES); float* chk = (float*)(a.ws + WS_CHK);
    LAS unsigned char* Kt = lds; LAS unsigned char* Vt = lds + 64 * MLP; LAS float* wkL = (LAS float*)(lds + 128 * MLP); LAS unsigned char* Stg = lds + 132 * MLP;
    const PrepArgs pa = MAKE_PREP_ARGS(a);
    for (int unit = vb0; unit < 16 * NCH; unit += nvb) {
        const int bh = unit >> 7, c = unit & (NCH - 1), b = bh >> 2, h = bh & 3, s0 = c * 64; const size_t row0 = (size_t)b * S + s0;
        if (wave == 0) {
            const float lf = logf[(size_t)bh * S + s0 + lane], ic = ipre[(size_t)bh * S + s0 + lane];
            const float bc = wave_incl_sum(lf, lane), g = ic - bc, gmax = wave_max(g), blast = __shfl(bc, 63);
            wkL[lane] = __expf(g - gmax);
            if (lane == 0) { chk[(size_t)unit * 2] = blast; chk[(size_t)unit * 2 + 1] = blast + gmax; }
        }
#pragma unroll
        for (int q = 0; q < 2; ++q) { const int it = tid + q * NTHR, tt = it >> 4, c8 = it & 15, ch = h * 128 + c8 * 8;
            float y[8]; conv8(proj + (row0 + tt) * NPROJ + C_MLK + ch, s0 + tt, conv_w + 512 + ch, conv_b + 512 + ch, 0.08838834764831845f, y);
            const v4u o = pack8(y);
            *(LAS v4u*)(Kt + tt * MLP + c8 * 16) = o; *(v4u*)(kcg + (row0 + tt) * 512 + ch) = o; }
        __syncthreads();
        const PrepDesc bgd = prep_decode(pa, IT_SMALL + unit * NWAVES + wave); f32x4 bgv[16]; prep_load(bgd, lane, bgv);
#pragma unroll
        for (int q = 0; q < 2; ++q) { const int it = tid + q * NTHR, tt = it >> 4, c8 = it & 15;
            const v4u xr = *(const v4u*)(proj + (row0 + tt) * NPROJ + C_MLV + h * 128 + c8 * 8); const float w = wkL[tt];
            float y[8] = {bf2f(xr.x & 0xffffu) * w, bf2f(xr.x >> 16) * w, bf2f(xr.y & 0xffffu) * w, bf2f(xr.y >> 16) * w, bf2f(xr.z & 0xffffu) * w, bf2f(xr.z >> 16) * w, bf2f(xr.w & 0xffffu) * w, bf2f(xr.w >> 16) * w};
            *(LAS v4u*)(Vt + tt * MLP + c8 * 16) = pack8(y); }
        __syncthreads();
        {
            const int dvb = wave >> 1, dkh = wave & 1, hh = lane >> 5, gsel = (lane >> 4) & 1;
            f32x16 acc[2];
#pragma unroll
            for (int nb = 0; nb < 2; ++nb)
#pragma unroll
                for (int i = 0; i < 16; ++i) acc[nb][i] = 0.f;
#pragma unroll
            for (int kk = 0; kk < 4; ++kk) {
                const bf16x8v Bv = tr_frag(Vt, 16 * kk + 8 * hh, 32 * dvb + 16 * gsel, lane);
#pragma unroll
                for (int nb = 0; nb < 2; ++nb) { const bf16x8v Ak = tr_frag(Kt, 16 * kk + 8 * hh, 32 * (2 * dkh + nb) + 16 * gsel, lane);
                    acc[nb] = __builtin_amdgcn_mfma_f32_32x32x16_bf16(Ak, Bv, acc[nb], 0, 0, 0); }
            }
#pragma unroll
            for (int nb = 0; nb < 2; ++nb)
#pragma unroll
                for (int g4 = 0; g4 < 4; ++g4) { const int dk = 32 * (2 * dkh + nb) + 8 * g4 + 4 * hh, dv = 32 * dvb + (lane & 31);
                    *(LAS unsigned long long*)(Stg + dv * MLP + dk * 2) = (unsigned long long)pk2(acc[nb][4 * g4], acc[nb][4 * g4 + 1]) | ((unsigned long long)pk2(acc[nb][4 * g4 + 2], acc[nb][4 * g4 + 3]) << 32); }
        }
        __syncthreads();
        { bf16* stc = st + (size_t)unit * ST_ELEMS;
#pragma unroll
          for (int q = 0; q < 4; ++q) { const int it = tid + q * NTHR, dv = it >> 4, c8 = it & 15;
              *(v4u*)(stc + dv * 128 + c8 * 8) = *(const LAS v4u*)(Stg + dv * MLP + c8 * 16); }
        }
        if (tid < 128) { float s = 0.f;
#pragma unroll 8
            for (int t = 0; t < 64; ++t) s += wkL[t] * bf2f(*(const LAS unsigned short*)(Kt + t * MLP + tid * 2));
            st[(size_t)unit * ST_ELEMS + 128 * 128 + tid] = (bf16)f2bf(s); }
        prep_store(bgd, lane, bgv);
        __syncthreads();
    }
}

__device__ __forceinline__ void ml_phaseB(const MArgs& a, LAS unsigned char* lds, int vb0, int nvb) {
    const int tid = threadIdx.x;
    bf16* st = (bf16*)(a.ws + WS_STATES); const float* chk = (const float*)(a.ws + WS_CHK); float* mprev = (float*)(a.ws + WS_MPREV);
    LAS float* al = (LAS float*)lds; LAS float* be = al + NCH;
    constexpr int NSL = 16, SLE = ST_ELEMS / NSL;
    for (int item = vb0; item < 16 * NSL; item += nvb) {
        const int bh = item / NSL, sl = item % NSL;
        __syncthreads();
        if (tid < NCH) { al[tid] = chk[(size_t)(bh * NCH + tid) * 2]; be[tid] = chk[(size_t)(bh * NCH + tid) * 2 + 1]; }
        __syncthreads();
        if (tid == 0) { float m = 0.f;
            for (int c = 0; c < NCH; ++c) { const float bl = al[c], M = be[c];
                const float mn = fmaxf(bl + m, M); al[c] = __expf(bl + m - mn); be[c] = __expf(M - mn);
                if (sl == 0) mprev[bh * NCH + c] = m;
                m = mn; } }
        __syncthreads();
        if (tid * 4 < SLE) {
            unsigned long long* p = (unsigned long long*)(st + (size_t)bh * NCH * ST_ELEMS + sl * SLE + tid * 4);
            float c0 = 0.f, c1 = 0.f, c2 = 0.f, c3 = 0.f;
            for (int cb = 0; cb < NCH; cb += 16) { unsigned long long d[16];
#pragma unroll
                for (int j = 0; j < 16; ++j) d[j] = p[(size_t)(cb + j) * (ST_ELEMS / 4)];
#pragma unroll
                for (int j = 0; j < 16; ++j) { p[(size_t)(cb + j) * (ST_ELEMS / 4)] = (unsigned long long)pk2(c0, c1) | ((unsigned long long)pk2(c2, c3) << 32);
                    const float A = al[cb + j], Bq = be[cb + j]; const unsigned lo = (unsigned)d[j], hi = (unsigned)(d[j] >> 32);
                    c0 = A * c0 + Bq * bf2f(lo & 0xffffu); c1 = A * c1 + Bq * bf2f(lo >> 16); c2 = A * c2 + Bq * bf2f(hi & 0xffffu); c3 = A * c3 + Bq * bf2f(hi >> 16); } }
        }
    }
}

__device__ __forceinline__ void ml_phaseC(const MArgs& a, LAS unsigned char* lds, int G) {
    const int tid = threadIdx.x, lane = tid & 63, wave = __builtin_amdgcn_readfirstlane(tid >> 6);
    const bf16* proj = (const bf16*)(a.ws + WS_PROJ); const float* conv_w = a.in[5]; const float* conv_b = a.in[6]; const float* norm_g = a.in[8];
    const float* ipre = (const float*)(a.ws + WS_GATES); const float* logf = ipre + 16 * S;
    const bf16* kcg = (const bf16*)(a.ws + WS_KC); const bf16* st = (const bf16*)(a.ws + WS_STATES); const float* mprev = (const float*)(a.ws + WS_MPREV);
    bf16* mix = (bf16*)(a.ws + WS_MIX);
    LAS unsigned char* Qt = lds; LAS unsigned char* Kt = lds + 64 * MLP; LAS unsigned char* Vt = lds + 128 * MLP; LAS unsigned char* Ct = lds + 192 * MLP;
    LAS float* sc = (LAS float*)(lds + 320 * MLP);
    LAS float* gL = sc; LAS float* mmL = sc + 64; LAS float* siL = sc + 128; LAS float* emL = sc + 192; LAS float* npv = sc + 256; LAS float* lnS = sc + 384;
    const int tb = wave >> 2, dvb = wave & 3, r = lane & 31, hh = lane >> 5, gsel = (lane >> 4) & 1;
    const PrepArgs pa = MAKE_PREP_ARGS(a);
    for (int unit = blockIdx.x; unit < 16 * NCH; unit += G) {
        const int bh = unit >> 7, c = unit & (NCH - 1), b = bh >> 2, h = bh & 3, s0 = c * 64; const size_t row0 = (size_t)b * S + s0;
        if (wave == 0) {
            const float lf = logf[(size_t)bh * S + s0 + lane], ic = ipre[(size_t)bh * S + s0 + lane], mp = mprev[unit];
            const float bc = wave_incl_sum(lf, lane), g = ic - bc, pm = wave_incl_max(g, lane), mm = fmaxf(mp, pm);
            gL[lane] = g; mmL[lane] = mm; siL[lane] = __expf(mp - mm); emL[lane] = __expf(-(bc + mm));
        }
        const bf16* stc = st + (size_t)unit * ST_ELEMS;
#pragma unroll
        for (int q = 0; q < 2; ++q) { const int it = tid + q * NTHR, tt = it >> 4, c8 = it & 15, ch = h * 128 + c8 * 8;
            float y[8]; conv8(proj + (row0 + tt) * NPROJ + C_MLQ + ch, s0 + tt, conv_w + ch, conv_b + ch, 1.f, y);
            *(LAS v4u*)(Qt + tt * MLP + c8 * 16) = pack8(y);
            *(LAS v4u*)(Kt + tt * MLP + c8 * 16) = *(const v4u*)(kcg + (row0 + tt) * 512 + ch);
            *(LAS v4u*)(Vt + tt * MLP + c8 * 16) = *(const v4u*)(proj + (row0 + tt) * NPROJ + C_MLV + ch); }
#pragma unroll
        for (int q = 0; q < 4; ++q) { const int it = tid + q * NTHR, dv = it >> 4, c8 = it & 15;
            *(LAS v4u*)(Ct + dv * MLP + c8 * 16) = *(const v4u*)(stc + dv * 128 + c8 * 8); }
        if (tid < 128) npv[tid] = bf2f(stc[128 * 128 + tid]);
        __syncthreads();
        const PrepDesc bgd = prep_decode(pa, IT_SMALL + BG_A + unit * NWAVES + wave); f32x4 bgv[16]; prep_load(bgd, lane, bgv);
        bf16x8v qf[8];
#pragma unroll
        for (int kk = 0; kk < 8; ++kk) qf[kk] = *(const LAS bf16x8v*)(Qt + (32 * tb + r) * MLP + (16 * kk + 8 * hh) * 2);
        const float mm_t = mmL[32 * tb + r], si_t = siL[32 * tb + r], em_t = emL[32 * tb + r];
        float nq = 0.f;
#pragma unroll
        for (int kk = 0; kk < 8; ++kk) { const f32x4 n0 = *(const LAS f32x4*)(npv + 16 * kk + 8 * hh), n1 = *(const LAS f32x4*)(npv + 16 * kk + 8 * hh + 4);
            nq += n0.x * bf2f((unsigned short)qf[kk][0]) + n0.y * bf2f((unsigned short)qf[kk][1]) + n0.z * bf2f((unsigned short)qf[kk][2]) + n0.w * bf2f((unsigned short)qf[kk][3])
                + n1.x * bf2f((unsigned short)qf[kk][4]) + n1.y * bf2f((unsigned short)qf[kk][5]) + n1.z * bf2f((unsigned short)qf[kk][6]) + n1.w * bf2f((unsigned short)qf[kk][7]); }
        nq += __shfl_xor(nq, 32);
        f32x16 num;
#pragma unroll
        for (int i = 0; i < 16; ++i) num[i] = 0.f;
#pragma unroll
        for (int kk = 0; kk < 8; ++kk) { const bf16x8v Ac = *(const LAS bf16x8v*)(Ct + (32 * dvb + r) * MLP + (16 * kk + 8 * hh) * 2);
            num = __builtin_amdgcn_mfma_f32_32x32x16_bf16(Ac, qf[kk], num, 0, 0, 0); }
#pragma unroll
        for (int i = 0; i < 16; ++i) num[i] *= si_t;
        float wsum = 0.f;
        for (int sb = 0; sb <= tb; ++sb) {
            f32x16 sT;
#pragma unroll
            for (int i = 0; i < 16; ++i) sT[i] = 0.f;
#pragma unroll
            for (int kk = 0; kk < 8; ++kk) { const bf16x8v Ak = *(const LAS bf16x8v*)(Kt + (32 * sb + r) * MLP + (16 * kk + 8 * hh) * 2);
                sT = __builtin_amdgcn_mfma_f32_32x32x16_bf16(Ak, qf[kk], sT, 0, 0, 0); }
            unsigned wp[8];
#pragma unroll
            for (int g4 = 0; g4 < 4; ++g4) { const f32x4 gv = *(const LAS f32x4*)(gL + 32 * sb + 8 * g4 + 4 * hh);
                float w[4];
#pragma unroll
                for (int e = 0; e < 4; ++e) { const int srow = 32 * sb + 8 * g4 + 4 * hh + e; const bool valid = srow <= 32 * tb + r;
                    w[e] = valid ? sT[4 * g4 + e] * __expf(gv[e] - mm_t) : 0.f; wsum += w[e]; }
                wp[2 * g4] = pk2(w[0], w[1]); wp[2 * g4 + 1] = pk2(w[2], w[3]); }
#pragma unroll
            for (int s2 = 0; s2 < 2; ++s2) {
                const bf16x8v Av = tr_frag_perm(Vt, 32 * sb + 16 * s2 + 4 * hh, 32 * dvb + 16 * gsel, lane);
                v4u bw; bw.x = wp[4 * s2]; bw.y = wp[4 * s2 + 1]; bw.z = wp[4 * s2 + 2]; bw.w = wp[4 * s2 + 3];
                num = __builtin_amdgcn_mfma_f32_32x32x16_bf16(Av, __builtin_bit_cast(bf16x8v, bw), num, 0, 0, 0); }
        }
        wsum += __shfl_xor(wsum, 32);
        const float den = si_t * nq + wsum, rden = 1.f / fmaxf(fabsf(den), em_t);
        float ps = 0.f, pq = 0.f;
#pragma unroll
        for (int i = 0; i < 16; ++i) { num[i] *= rden; ps += num[i]; pq += num[i] * num[i]; }
        ps += __shfl_xor(ps, 32); pq += __shfl_xor(pq, 32);
        if (hh == 0) { lnS[((tb * 4 + dvb) * 32 + r) * 2] = ps; lnS[((tb * 4 + dvb) * 32 + r) * 2 + 1] = pq; }
        __syncthreads();
        float ts = 0.f, tq = 0.f;
#pragma unroll
        for (int d = 0; d < 4; ++d) { ts += lnS[((tb * 4 + d) * 32 + r) * 2]; tq += lnS[((tb * 4 + d) * 32 + r) * 2 + 1]; }
        const float mean = ts * (1.f / 128.f), rstd = 1.f / sqrtf(fmaxf(tq * (1.f / 128.f) - mean * mean, 0.f) + LN_EPS);
#pragma unroll
        for (int g4 = 0; g4 < 4; ++g4) { const int dv = 32 * dvb + 8 * g4 + 4 * hh;
            *(LAS unsigned long long*)(Qt + (32 * tb + r) * MLP + dv * 2) = (unsigned long long)pk2((num[4 * g4] - mean) * rstd, (num[4 * g4 + 1] - mean) * rstd) | ((unsigned long long)pk2((num[4 * g4 + 2] - mean) * rstd, (num[4 * g4 + 3] - mean) * rstd) << 32); }
        __syncthreads();
#pragma unroll
        for (int q = 0; q < 2; ++q) { const int it = tid + q * NTHR, tt = it >> 4, c8 = it & 15, dv = c8 * 8;
            const v4u hv = *(const LAS v4u*)(Qt + tt * MLP + c8 * 16); const v4u og = *(const v4u*)(proj + (row0 + tt) * NPROJ + C_MLO + h * 128 + dv);
            const f32x4 n0 = *(const f32x4*)(norm_g + h * 128 + dv), n1 = *(const f32x4*)(norm_g + h * 128 + dv + 4);
            float o[8];
            o[0] = bf2f(hv.x & 0xffffu) * n0.x * sigmoidf_(bf2f(og.x & 0xffffu)); o[1] = bf2f(hv.x >> 16) * n0.y * sigmoidf_(bf2f(og.x >> 16));
            o[2] = bf2f(hv.y & 0xffffu) * n0.z * sigmoidf_(bf2f(og.y & 0xffffu)); o[3] = bf2f(hv.y >> 16) * n0.w * sigmoidf_(bf2f(og.y >> 16));
            o[4] = bf2f(hv.z & 0xffffu) * n1.x * sigmoidf_(bf2f(og.z & 0xffffu)); o[5] = bf2f(hv.z >> 16) * n1.y * sigmoidf_(bf2f(og.z >> 16));
            o[6] = bf2f(hv.w & 0xffffu) * n1.z * sigmoidf_(bf2f(og.w & 0xffffu)); o[7] = bf2f(hv.w >> 16) * n1.w * sigmoidf_(bf2f(og.w >> 16));
            *(v4u*)(mix + (row0 + tt) * D + 512 + h * 128 + dv) = pack8(o); }
        prep_store(bgd, lane, bgv);
        __syncthreads();
    }
}

constexpr int VTP = 192;
template <int PITCH> __device__ __forceinline__ bf16x8v tr_frag_perm_p(const LAS unsigned char* tile, int row0, int col0, int lane) {
    const int i = lane & 15; const LAS unsigned char* p = tile + (row0 + (i >> 2)) * PITCH + (col0 + 4 * (i & 3)) * 2;
    const s16x4 lo = tr_read(p), hi = tr_read(p + 8 * PITCH);
    return __builtin_shufflevector(lo, hi, 0, 1, 2, 3, 4, 5, 6, 7);
}
__device__ __forceinline__ void attn_phase(const bf16* __restrict__ proj, bf16* __restrict__ mix, LAS unsigned char* lds, int vb0, int nvb, const PrepArgs pa) {
    const int tid = threadIdx.x, lane = tid & 63, wave = __builtin_amdgcn_readfirstlane(tid >> 6);
    const int r = lane & 31, hh = lane >> 5, gsel = (lane >> 4) & 1;
    LAS unsigned char* Vt = lds + wave * (64 * VTP);
    bf16x8v ntri[2], nones;
#pragma unroll
    for (int s2 = 0; s2 < 2; ++s2)
#pragma unroll
        for (int j = 0; j < 8; ++j) { const int k = 16 * s2 + 8 * (j >> 2) + 4 * hh + (j & 3); ntri[s2][j] = (k >= r) ? (short)0xBF80 : (short)0; }
#pragma unroll
    for (int j = 0; j < 8; ++j) nones[j] = (short)0xBF80;
    for (int unit = vb0 * NWAVES + wave; unit < NB * 8 * (S / 32); unit += nvb * NWAVES) {
        const int bh = unit / (S / 32), qb = unit % (S / 32), b = bh >> 3, h = bh & 7, q0 = qb * 32;
        const bf16* base = proj + (size_t)b * S * NPROJ + h * 64;
        bf16x8v qf[4];
#pragma unroll
        for (int s = 0; s < 4; ++s) qf[s] = *(const bf16x8v*)(base + (size_t)(q0 + r) * NPROJ + C_SBQ + 16 * s + 8 * hh);
        f32x16 o[2];
#pragma unroll
        for (int d = 0; d < 2; ++d)
#pragma unroll
            for (int i = 0; i < 16; ++i) o[d][i] = 0.f;
        float carry = 0.f;
        const int qpos = q0 + r;
        const PrepDesc bgd = prep_decode(pa, IT_SMALL + BG_A + BG_C + unit); f32x4 bgv[16]; prep_load(bgd, lane, bgv);
        for (int k0 = q0 - 32; ; k0 -= 64) {
            bf16x8v kf[2][4];
#pragma unroll
            for (int kb = 0; kb < 2; ++kb) { int key = k0 + 32 * kb + r; key = key < 0 ? 0 : key;
#pragma unroll
                for (int s = 0; s < 4; ++s) kf[kb][s] = *(const bf16x8v*)(base + (size_t)key * NPROJ + C_SBK + 16 * s + 8 * hh); }
#pragma unroll
            for (int i = 0; i < 8; ++i) { int key = k0 + (lane >> 3) + 8 * i; key = key < 0 ? 0 : key;
                *(LAS v4u*)(Vt + ((lane >> 3) + 8 * i) * VTP + (lane & 7) * 16) = *(const v4u*)(base + (size_t)key * NPROJ + C_SBV + (lane & 7) * 8); }
            f32x16 z[2];
#pragma unroll
            for (int kb = 0; kb < 2; ++kb) {
#pragma unroll
                for (int i = 0; i < 16; ++i) z[kb][i] = 0.f;
#pragma unroll
                for (int s = 0; s < 4; ++s) z[kb] = __builtin_amdgcn_mfma_f32_32x32x16_bf16(kf[kb][s], qf[s], z[kb], 0, 0, 0); }
            const bool need_mask = (k0 + 63 >= q0) || (k0 < 0);
            unsigned xp[2][8];
#pragma unroll
            for (int kb = 0; kb < 2; ++kb)
#pragma unroll
                for (int g4 = 0; g4 < 4; ++g4) { float sp[4];
#pragma unroll
                    for (int e = 0; e < 4; ++e) { const float zz = z[kb][4 * g4 + e];
                        float v = fmaxf(zz, 0.f) + __builtin_amdgcn_logf(1.f + __builtin_amdgcn_exp2f(-fabsf(zz)));
                        if (need_mask) { const int key = k0 + 32 * kb + 8 * g4 + 4 * hh + e; v = (key >= 0 && key < qpos) ? v : 0.f; }
                        sp[e] = v; }
                    xp[kb][2 * g4] = pk2(sp[0], sp[1]); xp[kb][2 * g4 + 1] = pk2(sp[2], sp[3]); }
            const float z00 = z[0][0];
#pragma unroll
            for (int s2 = 0; s2 < 2; ++s2) { v4u b1; b1.x = xp[1][4 * s2]; b1.y = xp[1][4 * s2 + 1]; b1.z = xp[1][4 * s2 + 2]; b1.w = xp[1][4 * s2 + 3];
                v4u b0; b0.x = xp[0][4 * s2]; b0.y = xp[0][4 * s2 + 1]; b0.z = xp[0][4 * s2 + 2]; b0.w = xp[0][4 * s2 + 3];
                z[1] = __builtin_amdgcn_mfma_f32_32x32x16_bf16(ntri[s2], __builtin_bit_cast(bf16x8v, b1), z[1], 0, 0, 0);
                z[0] = __builtin_amdgcn_mfma_f32_32x32x16_bf16(ntri[s2], __builtin_bit_cast(bf16x8v, b0), z[0], 0, 0, 0);
                z[0] = __builtin_amdgcn_mfma_f32_32x32x16_bf16(nones, __builtin_bit_cast(bf16x8v, b1), z[0], 0, 0, 0); }
            float tot = z00 - z[0][0];
            tot = __shfl(tot, r);
#pragma unroll
            for (int kb = 0; kb < 2; ++kb)
#pragma unroll
                for (int g4 = 0; g4 < 4; ++g4) { float p[4];
#pragma unroll
                    for (int e = 0; e < 4; ++e) { float v = __builtin_amdgcn_exp2f(z[kb][4 * g4 + e] - carry);
                        if (need_mask) { const int key = k0 + 32 * kb + 8 * g4 + 4 * hh + e; v = (key >= 0 && key < qpos) ? v : 0.f; }
                        p[e] = v; }
                    xp[kb][2 * g4] = pk2(p[0], p[1]); xp[kb][2 * g4 + 1] = pk2(p[2], p[3]); }
#pragma unroll
            for (int kb = 0; kb < 2; ++kb)
#pragma unroll
                for (int s2 = 0; s2 < 2; ++s2) { v4u bp; bp.x = xp[kb][4 * s2]; bp.y = xp[kb][4 * s2 + 1]; bp.z = xp[kb][4 * s2 + 2]; bp.w = xp[kb][4 * s2 + 3];
#pragma unroll
                    for (int d = 0; d < 2; ++d) { const bf16x8v Av = tr_frag_perm_p<VTP>(Vt, 32 * kb + 16 * s2 + 4 * hh, 32 * d + 16 * gsel, lane);
                        o[d] = __builtin_amdgcn_mfma_f32_32x32x16_bf16(Av, __builtin_bit_cast(bf16x8v, bp), o[d], 0, 0, 0); } }
            carry += tot;
            if (k0 <= 0) break;
            if (__all(carry > SB_THRESH)) break;
        }
#pragma unroll
        for (int d = 0; d < 2; ++d)
#pragma unroll
            for (int g4 = 0; g4 < 4; ++g4)
                *(LAS unsigned long long*)(Vt + r * 144 + (32 * d + 8 * g4 + 4 * hh) * 2) = (unsigned long long)pk2(o[d][4 * g4], o[d][4 * g4 + 1]) | ((unsigned long long)pk2(o[d][4 * g4 + 2], o[d][4 * g4 + 3]) << 32);
#pragma unroll
        for (int i = 0; i < 4; ++i) { const int row = (lane >> 3) + 8 * i;
            *(v4u*)(mix + (size_t)(b * S + q0 + row) * D + h * 64 + (lane & 7) * 8) = *(const LAS v4u*)(Vt + row * 144 + (lane & 7) * 16); }
        prep_store(bgd, lane, bgv);
    }
}

__global__ void __launch_bounds__(NTHR, 2) mega_fwd(MArgs args) {
    extern __shared__ __attribute__((aligned(16))) unsigned char lds[];
    LAS unsigned char* ldsl = (LAS unsigned char*)lds;
    const int tid = threadIdx.x, G = gridDim.x;
    volatile LAS unsigned* MISC = (volatile LAS unsigned*)(ldsl + XTRA_OFF + X_MISC);
    LAS int* tb = (LAS int*)(ldsl + XTRA_OFF + X_TB); LAS int* nn = (LAS int*)(ldsl + XTRA_OFF + X_NN);
    for (int u = tid; u < (LDS_BYTES - XTRA_OFF) / 4; u += NTHR) ((LAS unsigned*)(ldsl + XTRA_OFF))[u] = 0u;
    __syncthreads();
    unsigned char* ws = args.ws;
    unsigned* ctl = (unsigned*)(ws + WS_CTL);
    XcdBarrier bar = xcd_barrier_post(ctl + CW_BAR, MISC + 8);
    const int lo = args.ph_lo, hi = args.ph_hi;
#define IN(k) (lo <= (k) && (k) < hi)
#ifndef REP_MASK
#define REP_MASK 0
#endif
#define PHASE(k, ...) do { if (IN(k)) { for (int rep_ = 0; rep_ < (((REP_MASK >> (k)) & 1) ? 2 : 1); ++rep_) { if (rep_) xcd_barrier(bar); __VA_ARGS__ } } if (IN(k) && IN((k) + 1)) xcd_barrier(bar); } while (0)
    int* cnt = (int*)ctl + CW_CNT; i32x2* list = (i32x2*)(ws + WS_ROUTE + 2 * MiB); float* topg = (float*)(ws + WS_ROUTE + 1 * MiB);
    PHASE(0, ph_mod_prep(args, lds, G););
    PHASE(1, ph_ln1(args, lds, G););
    PHASE(2, { pg8::StaticOrder So; So.init(ws + WS_U1, ws + WS_WTIN, T, NPROJ, D, G, blockIdx.x);
        pg8::EpiBf16 E{(bf16*)(ws + WS_PROJ), NPROJ, 2, QSCALE, 1.f / 64.f};
        pg8::gemm_phase<pg8::EpiBf16, pg8::StaticOrder, false, true>(ldsl, D, So, E); });
    PHASE(3, ml_phaseA(args, ldsl, blockIdx.x, G););
    PHASE(4, ml_phaseB(args, ldsl, blockIdx.x, G); __syncthreads(); attn_phase((const bf16*)(ws + WS_PROJ), (bf16*)(ws + WS_MIX), ldsl, blockIdx.x, G, MAKE_PREP_ARGS(args)););
    PHASE(5, ml_phaseC(args, ldsl, G););
    PHASE(6, { pg8::StaticOrder So; So.init(ws + WS_MIX, ws + WS_WTOUT, T, D, 2 * D, G, blockIdx.x);
        pg8::EpiBf16 E{(bf16*)(ws + WS_MIXOUT), D, 0, 1.f, 1.f};
        pg8::gemm_phase<pg8::EpiBf16, pg8::StaticOrder, false, false>(ldsl, 2 * D, So, E); });
    PHASE(7, ph_ln2(args, G););
    PHASE(8, { pg8::StaticOrder So; So.init(ws + WS_U2, ws + WS_WTR, T, NE, 2 * D, G, blockIdx.x);
        pg8::EpiF32 E{(float*)(ws + WS_LOGITS), NE};
        pg8::gemm_phase<pg8::EpiF32, pg8::StaticOrder, false, false>(ldsl, 2 * D, So, E); });
    PHASE(9, { const int lane_ = tid & 63; const f32x4 bias4 = *(const f32x4*)(args.in[13] + 4 * lane_);
        for (int t = blockIdx.x * NWAVES + (tid >> 6); t < T; t += G * NWAVES) route_wave(t, lane_, (const float*)(ws + WS_LOGITS), bias4, (int*)(ws + WS_ROUTE), topg, cnt); });
    PHASE(10, { moe_tables(cnt, tb, nn); const int* tope = (const int*)(ws + WS_ROUTE); int* fill = (int*)ctl + CW_FILL;
        for (int id = blockIdx.x * NTHR + tid; id < T * TOPK; id += G * NTHR) { const int e = tope[id]; const int pos = atomicAdd(fill + e, 1);
            list[tb[e] * 256 + pos] = (i32x2){id, __float_as_int(topg[id])}; } });
    PHASE(11, { moe_tables(cnt, tb, nn);
        pg8::MoeOrder So{G, (int)blockIdx.x, tb[NEX] * 2, 1, tb, nn, list, (const char*)(ws + WS_U2F8), 0, (const char*)(ws + WS_WT13), (size_t)512 * D, (size_t)256 * D};
        pg8::EpiGlu E{(unsigned char*)(ws + WS_H), 1.f / 64.f};
        pg8::gemm_phase<pg8::EpiGlu, pg8::MoeOrder, true, true>(ldsl, D, So, E); });
    PHASE(12, { moe_tables(cnt, tb, nn);
        pg8::MoeOrder So{G, (int)blockIdx.x, tb[NEX] * 4, 2, tb, nn, list, (const char*)(ws + WS_H), (size_t)256 * FF, (const char*)(ws + WS_WT2), (size_t)D * FF, (size_t)256 * FF};
        pg8::EpiScatter E{(unsigned char*)(ws + WS_YS), (bf16*)(ws + WS_YSH), list, nn};
        pg8::gemm_phase<pg8::EpiScatter, pg8::MoeOrder, false, true>(ldsl, FF, So, E); });
    PHASE(13, ph_final(args, G););
#undef PHASE
#undef IN
}

#ifndef MK_UPTO
#define MK_UPTO 14
#endif
__global__ void k_nan_fill(float* out, int n) { for (int i = blockIdx.x * blockDim.x + threadIdx.x; i < n; i += gridDim.x * blockDim.x) out[i] = __builtin_nanf(""); }
extern "C" void kernel_launch(void* const* d_in, const int* in_sizes, int n_in, void* d_out, int out_size, void* d_ws, size_t ws_size, hipStream_t stream) {
    static int grid = 0;
    if (grid == 0) {
        int dev = 0, cus = 0, per_cu = 0; grid = -1;
        if (n_in != 22 || out_size != T * D || ws_size < WS_END) fprintf(stderr, "kernel_launch: unexpected shapes (n_in %d out %d ws %zu, need %zu)\n", n_in, out_size, ws_size, (size_t)WS_END);
        else if (hipGetDevice(&dev) != hipSuccess || hipDeviceGetAttribute(&cus, hipDeviceAttributeMultiprocessorCount, dev) != hipSuccess) fprintf(stderr, "kernel_launch: device query failed\n");
        else if (hipFuncSetAttribute((const void*)mega_fwd, hipFuncAttributeMaxDynamicSharedMemorySize, LDS_BYTES) != hipSuccess) fprintf(stderr, "kernel_launch: hipFuncSetAttribute failed\n");
        else if (hipOccupancyMaxActiveBlocksPerMultiprocessor(&per_cu, (const void*)mega_fwd, NTHR, LDS_BYTES) != hipSuccess || per_cu < 1) fprintf(stderr, "kernel_launch: occupancy query says %d blocks per CU\n", per_cu);
        else grid = cus;
        (void)hipGetLastError();
    }
    if (grid < 0) { k_nan_fill<<<1024, 256, 0, stream>>>((float*)d_out, out_size); return; }
    const float* x = (const float*)d_in[0];
    const float* conv_w = (const float*)d_in[5]; const float* conv_b = (const float*)d_in[6];
    const float* norm_g = (const float*)d_in[8]; const float* ln1_g = (const float*)d_in[10]; const float* ln1_b = (const float*)d_in[11];
    const float* rbias = (const float*)d_in[13]; const float* ln2_g = (const float*)d_in[20]; const float* ln2_b = (const float*)d_in[21];
    char* ws = (char*)d_ws; float* out = (float*)d_out;
    float* mod = (float*)(ws + WS_MOD); bf16* wtin = (bf16*)(ws + WS_WTIN); bf16* wtout = (bf16*)(ws + WS_WTOUT); bf16* wtr = (bf16*)(ws + WS_WTR);
    bf16* wt13 = (bf16*)(ws + WS_WT13); bf16* wt2 = (bf16*)(ws + WS_WT2); int* plan = (int*)(ws + WS_PLAN);
    bf16* u1 = (bf16*)(ws + WS_U1); bf16* proj = (bf16*)(ws + WS_PROJ); float* ipre = (float*)(ws + WS_GATES); float* logf = ipre + 16 * S;
    float* hraw = (float*)(ws + WS_HRAW); bf16* mix = (bf16*)(ws + WS_MIX); bf16* mixout = (bf16*)(ws + WS_MIXOUT); bf16* u2 = (bf16*)(ws + WS_U2);
    float* logits = (float*)(ws + WS_LOGITS); int* tope = (int*)(ws + WS_ROUTE); float* topg = (float*)(ws + WS_ROUTE + 1 * MiB); i32x2* list = (i32x2*)(ws + WS_ROUTE + 2 * MiB);
    bf16* H = (bf16*)(ws + WS_H); bf16* ys = (bf16*)(ws + WS_YS); bf16* ysh = (bf16*)(ws + WS_YSH);
    int* cnt = (int*)(ws + WS_CTL) + CW_CNT;
    (void)hipMemsetAsync(ws + WS_CTL, 0, 1 * MiB, stream);
    if (MK_UPTO > 0) {
        MArgs a{};
        for (int i = 0; i < 22; ++i) a.in[i] = (const float*)d_in[i];
        a.out = out; a.ws = (unsigned char*)d_ws; a.ph_lo = 0; a.ph_hi = MK_UPTO;
        hipLaunchKernelGGL(mega_fwd, dim3(grid), dim3(NTHR), LDS_BYTES, stream, a);
    }
}
```

```cpp
#include <hip/hip_runtime.h>
#include <cstdio>
#include <cstdint>

typedef unsigned short bf16;
typedef unsigned v4u __attribute__((ext_vector_type(4)));
typedef float f32x4 __attribute__((ext_vector_type(4)));
typedef int i32x2 __attribute__((ext_vector_type(2)));
typedef float f32x2 __attribute__((ext_vector_type(2)));

constexpr int D = 1024, NB = 4, S = 8192, T = NB * S;
constexpr int NPROJ = 3584, WIN_LD = 3592;
constexpr int C_SBQ = 0, C_SBK = 512, C_SBV = 1024, C_MLQ = 1536, C_MLK = 2048, C_MLV = 2560, C_MLO = 3072, C_GATE = 3584;
constexpr int NE = 256, NEX = 257, TOPK = 8, FF = 256;
constexpr float LN_EPS = 1e-5f;
constexpr float DN_ALPHA = 1.189207115002721f;
constexpr float LOG2E = 1.4426950408889634f;
constexpr float QSCALE = 0.125f * LOG2E;
constexpr float SB_THRESH = 48.0f;

constexpr size_t MiB = 1u << 20;
constexpr size_t WS_CTL = 0;
constexpr size_t WS_MOD = 1 * MiB;
constexpr size_t WS_WTIN = 2 * MiB;
constexpr size_t WS_WTOUT = 10 * MiB;
constexpr size_t WS_WTR = 12 * MiB;
constexpr size_t WS_PLAN = 13 * MiB;
constexpr size_t WS_WT2 = 16 * MiB;
constexpr size_t WS_YS = 145 * MiB;
constexpr size_t WS_WT13 = 145 * MiB;
constexpr size_t WS_U2F8 = 274 * MiB;
constexpr size_t WS_PROJ = 402 * MiB;
constexpr size_t WS_GATES = 626 * MiB;
constexpr size_t WS_H = 402 * MiB;
constexpr size_t WS_X1 = 757 * MiB;
constexpr size_t WS_STATES = 657 * MiB;
constexpr size_t WS_MIXOUT = 657 * MiB;
constexpr size_t WS_LOGITS = 657 * MiB;
constexpr size_t WS_U1 = 725 * MiB;
constexpr size_t WS_MIX = 725 * MiB;
constexpr size_t WS_U2 = 833 * MiB;
constexpr size_t WS_YSH = 833 * MiB;
constexpr size_t WS_HRAW = 833 * MiB;
constexpr size_t WS_ROUTE = 897 * MiB;
constexpr size_t WS_END = 902 * MiB;
constexpr int CW_CNT = 1024;
constexpr int CW_FILL = 1536;
constexpr int PL_SLOT = 0, PL_T64 = 512, PL_T256 = 1024;

__device__ __forceinline__ unsigned f2bf(float f) { unsigned u = __builtin_bit_cast(unsigned, f); return (u + 0x7fffu + ((u >> 16) & 1u)) >> 16; }
__device__ __forceinline__ float bf2f(unsigned b) { return __builtin_bit_cast(float, b << 16); }
__device__ __forceinline__ unsigned pk2(float lo, float hi) { return f2bf(lo) | (f2bf(hi) << 16); }
__device__ __forceinline__ unsigned pk4_fp8(float a, float b, float c, float d) { int w = 0; w = __builtin_amdgcn_cvt_pk_fp8_f32(a, b, w, false); w = __builtin_amdgcn_cvt_pk_fp8_f32(c, d, w, true); return (unsigned)w; }
__device__ __forceinline__ float wave_sum(float v) {
    v += __builtin_bit_cast(float, __builtin_amdgcn_update_dpp(0, __builtin_bit_cast(int, v), 0xB1, 0xF, 0xF, true));
    v += __builtin_bit_cast(float, __builtin_amdgcn_update_dpp(0, __builtin_bit_cast(int, v), 0x4E, 0xF, 0xF, true));
    v += __builtin_bit_cast(float, __builtin_amdgcn_update_dpp(0, __builtin_bit_cast(int, v), 0x141, 0xF, 0xF, true));
    v += __builtin_bit_cast(float, __builtin_amdgcn_update_dpp(0, __builtin_bit_cast(int, v), 0x140, 0xF, 0xF, true));
    const int iv = __builtin_bit_cast(int, v);
    const float r0 = __builtin_bit_cast(float, __builtin_amdgcn_readlane(iv, 0)), r1 = __builtin_bit_cast(float, __builtin_amdgcn_readlane(iv, 16));
    const float r2 = __builtin_bit_cast(float, __builtin_amdgcn_readlane(iv, 32)), r3 = __builtin_bit_cast(float, __builtin_amdgcn_readlane(iv, 48));
    return (r0 + r1) + (r2 + r3);
}
__device__ __forceinline__ float sigmoidf_(float x) { return 1.f / (1.f + __expf(-x)); }
__device__ __forceinline__ float siluf_(float x) { return x / (1.f + __expf(-x)); }


struct PrepArgs { const float *w_in, *w_out, *w_router, *w1, *w3, *w2, *sw1, *sw3, *sw2; unsigned char* wtin; bf16 *wtout, *wtr; unsigned char* wt13; unsigned char* wt2; };
struct PrepDesc { const float* src; unsigned char* dst; int ldw, ldt, k0, n0, rowmap, f8; };
constexpr int IT_IN = 16 * 56, IT_OUT = 16 * 16, IT_R = 16 * 4, IT_E = 192, IT_TOTAL = IT_IN + IT_OUT + IT_R + NEX * IT_E;
__device__ __forceinline__ PrepDesc prep_decode(const PrepArgs& a, int it) {
    if (it < IT_IN) return PrepDesc{a.w_in, a.wtin, WIN_LD, D, (it / 112) * 128, (it % 112) * 32, 0, 1}; it -= IT_IN;
    if (it < IT_OUT) return PrepDesc{a.w_out, (unsigned char*)a.wtout, D, D, (it / 32) * 128, (it % 32) * 32, 0, 1}; it -= IT_OUT;
    if (it < IT_R) return PrepDesc{a.w_router, (unsigned char*)a.wtr, NE, D, (it / 4) * 64, (it % 4) * 64, 0, 0}; it -= IT_R;
    const int e = it / IT_E, r = it % IT_E;
    if (r < 64) return PrepDesc{e < NE ? a.w1 + (size_t)e * D * FF : a.sw1, a.wt13 + (size_t)e * 512 * D, FF, D, (r / 8) * 128, (r % 8) * 32, 1, 1};
    if (r < 128) { const int q = r - 64; return PrepDesc{e < NE ? a.w3 + (size_t)e * D * FF : a.sw3, a.wt13 + (size_t)e * 512 * D, FF, D, (q / 8) * 128, (q % 8) * 32, 2, 1}; }
    const int q = r - 128; return PrepDesc{e < NE ? a.w2 + (size_t)e * FF * D : a.sw2, a.wt2 + (size_t)e * D * FF, D, FF, (q / 32) * 128, (q % 32) * 32, 0, 1};
}
__device__ __forceinline__ void prep_load(const PrepDesc& d, int lane, f32x4 (&v)[16]) {
    const int g = d.f8 ? (lane >> 3) : (lane >> 4), i = d.f8 ? (lane & 7) : (lane & 15);
#pragma unroll
    for (int r = 0; r < 16; ++r) v[r] = __builtin_nontemporal_load((const f32x4*)(d.src + (size_t)(d.k0 + 16 * g + r) * d.ldw + d.n0 + 4 * i));
}
__device__ __forceinline__ void prep_store(const PrepDesc& d, int lane, const f32x4 (&v)[16]) {
    const int g = d.f8 ? (lane >> 3) : (lane >> 4), i = d.f8 ? (lane & 7) : (lane & 15);
#pragma unroll
    for (int nn = 0; nn < 4; ++nn) {
        const int n = d.n0 + 4 * i + nn;
        const int dr = d.rowmap == 0 ? n : ((n >> 7) * 256 + (d.rowmap == 2 ? 128 : 0) + (n & 127));
        if (d.f8) {
            v4u o; o.x = pk4_fp8(v[0][nn] * 64.f, v[1][nn] * 64.f, v[2][nn] * 64.f, v[3][nn] * 64.f); o.y = pk4_fp8(v[4][nn] * 64.f, v[5][nn] * 64.f, v[6][nn] * 64.f, v[7][nn] * 64.f);
            o.z = pk4_fp8(v[8][nn] * 64.f, v[9][nn] * 64.f, v[10][nn] * 64.f, v[11][nn] * 64.f); o.w = pk4_fp8(v[12][nn] * 64.f, v[13][nn] * 64.f, v[14][nn] * 64.f, v[15][nn] * 64.f);
            *(v4u*)(d.dst + (size_t)dr * d.ldt + d.k0 + 16 * g) = o;
        } else {
            v4u o0, o1; o0.x = pk2(v[0][nn], v[1][nn]); o0.y = pk2(v[2][nn], v[3][nn]); o0.z = pk2(v[4][nn], v[5][nn]); o0.w = pk2(v[6][nn], v[7][nn]);
            o1.x = pk2(v[8][nn], v[9][nn]); o1.y = pk2(v[10][nn], v[11][nn]); o1.z = pk2(v[12][nn], v[13][nn]); o1.w = pk2(v[14][nn], v[15][nn]);
            v4u* dp = (v4u*)((bf16*)d.dst + (size_t)dr * d.ldt + d.k0 + 16 * g); dp[0] = o0; dp[1] = o1;
        }
    }
}
constexpr int IT_SMALL = IT_IN + IT_OUT + IT_R;
constexpr int BG_A = 16 * (S / 64) * 8, BG_C = BG_A, BG_T = NB * 8 * (S / 32), BG_TOTAL = BG_A + BG_C + BG_T;
constexpr int IT_FG = IT_TOTAL - BG_TOTAL;
static_assert(IT_SMALL + BG_TOTAL <= IT_TOTAL, "background slots exceed the expert items");
__device__ __forceinline__ int prep_fg_item(int j) { return j < IT_SMALL ? j : j + BG_TOTAL; }
__device__ __forceinline__ void prep_run(const PrepArgs& a, int it0, int stride, int lane) {
    int it = it0; if (it >= IT_FG) return;
    PrepDesc dA = prep_decode(a, prep_fg_item(it)), dB = dA; f32x4 va[16], vb[16]; prep_load(dA, lane, va);
    for (;;) {
        const int itB = it + stride; const bool hasB = itB < IT_FG;
        if (hasB) { dB = prep_decode(a, prep_fg_item(itB)); prep_load(dB, lane, vb); }
        prep_store(dA, lane, va);
        if (!hasB) break;
        const int itA = itB + stride; const bool hasA = itA < IT_FG;
        if (hasA) { dA = prep_decode(a, prep_fg_item(itA)); prep_load(dA, lane, va); }
        prep_store(dB, lane, vb);
        if (!hasA) break;
        it = itA;
    }
}


__device__ __forceinline__ f32x4 ld_bf4(const bf16* p) { const unsigned long long w = *(const unsigned long long*)p;
    return (f32x4){bf2f((unsigned)w & 0xffffu), bf2f(((unsigned)w) >> 16), bf2f((unsigned)(w >> 32) & 0xffffu), bf2f((unsigned)(w >> 48))}; }

#define LAS __attribute__((address_space(3)))
#define GAS __attribute__((address_space(1)))
namespace pg8 {
typedef short bf16x8 __attribute__((ext_vector_type(8)));
constexpr int F8_SCALE_W = 121;
constexpr int BM = 256, BK = 64, HALF = 128, HTB = HALF * BK * 2, STAGE_BYTES = 8 * HTB, NXCD = 8, WGM = 8;
__host__ __device__ __forceinline__ int lds_byte(int r, int c) { const int st = (r >> 4) * 2 + (c >> 5), rr = r & 15, cc = c & 31, ob = rr * 64 + cc * 2; return st * 1024 + (ob ^ (((ob >> 9) & 1) << 5)); }
__host__ __device__ __forceinline__ void stage_rc(int b, int& R, int& C) { const int st = b / 1024, sb = b % 1024, swz = sb ^ (((sb >> 9) & 1) << 5); R = (st >> 1) * 16 + swz / 64; C = (st & 1) * 32 + (swz % 64) / 2; }
__host__ __device__ __forceinline__ int perm16x(int R) { return 64 * (R >> 5) + 16 * ((R & 15) >> 2) + 4 * ((R >> 4) & 1) + (R & 3); }
__host__ __device__ __forceinline__ int perm32(int rho) { const int n = rho >> 4, i = rho & 15; return 8 * (i >> 2) + 4 * n + (i & 3); }

struct Unit { int pm, pn, e, mt; const char* A; const char* B; };

__device__ __forceinline__ long unit_index(int i, int G, int c) { return (G % 8 == 0) ? ((long)(i * 8 + (c & 7)) * (G / 8) + (c >> 3)) : ((long)i * G + c); }

struct StaticOrder {
    int nM, nN, nwg, G, c; const char* A; const char* B; size_t tstep;
    __device__ void init(const void* A_, const void* B_, int M, int N, int Kb, int G_, int c_) { nM = M / BM; nN = N / BM; nwg = nM * nN; G = G_; c = c_; A = (const char*)A_; B = (const char*)B_; tstep = (size_t)BM * Kb; }
    __device__ __forceinline__ bool next(int i, Unit& u) const {
        const long L = (long)i * G + c; if (L >= nwg) return false;
        int wgid = (int)L; { const int q = nwg / NXCD, r = nwg % NXCD, xcd = wgid % NXCD, off = wgid / NXCD; wgid = (xcd < r ? xcd * (q + 1) : r * (q + 1) + (xcd - r) * q) + off; }
        const int nig = WGM * nN, gid = wgid / nig, fm = gid * WGM, gsz = (nM - fm) < WGM ? (nM - fm) : WGM;
        u.pm = fm + ((wgid % nig) % gsz); u.pn = (wgid % nig) / gsz; u.e = 0; u.mt = u.pm; u.A = A + (size_t)u.pm * tstep; u.B = B + (size_t)u.pn * tstep; return true;
    }
    __device__ __forceinline__ int row_token(const Unit&, int) const { return 0; }
};

struct MoeOrder {
    int G, c, total, shift; const LAS int* tb; const LAS int* nn; const i32x2* list;
    const char* Abase; size_t a_tile_stride; const char* Bbase; size_t b_exp_stride, b_pn_stride;
    __device__ __forceinline__ bool next(int i, Unit& u) const {
        const long L = unit_index(i, G, c); if (L >= total) return false;
        const int tile = (int)(L >> shift); u.pn = (int)(L & ((1 << shift) - 1));
        int lo = 0, hi = NEX; while (hi - lo > 1) { const int mid = (lo + hi) >> 1; if (tb[mid] <= tile) lo = mid; else hi = mid; }
        u.e = lo; u.mt = tile - tb[lo]; u.pm = tile;
        u.A = Abase + (size_t)tile * a_tile_stride; u.B = Bbase + (size_t)lo * b_exp_stride + (size_t)u.pn * b_pn_stride; return true;
    }
    __device__ __forceinline__ int row_token(const Unit& u, int row) const {
        const int rr = u.mt * 256 + row;
        const int tok = list[u.pm * 256 + row].x >> 3;
        return u.e >= NE ? rr : (rr < nn[u.e] ? tok : 0);
    }
};

__device__ __forceinline__ unsigned cvt_pk_bf16(float lo, float hi) { unsigned r; asm volatile("v_cvt_pk_bf16_f32 %0, %1, %2" : "=v"(r) : "v"(lo), "v"(hi)); return r; }

struct EpiBf16 {
    static constexpr int PERM = 2; bf16* O; int ldc; int scale_tiles; float scale; float gscale;
    __device__ __forceinline__ void operator()(const f32x4 (&acc)[2][2][4][2], const Unit& u, int wr, int wc, int fr, int fq) const {
        const int row0 = u.pm * BM + wr * 64 + fr, col0 = u.pn * BM + wc * 64 + 16 * fq; const float sc = (u.pn < scale_tiles ? scale : 1.f) * gscale;
#pragma unroll
        for (int ai = 0; ai < 2; ++ai)
#pragma unroll
            for (int m = 0; m < 4; ++m) { bf16* rowp = O + (size_t)(row0 + ai * HALF + m * 16) * ldc + col0;
#pragma unroll
                for (int bj = 0; bj < 2; ++bj) { const f32x4 v0 = acc[ai][bj][m][0] * sc, v1 = acc[ai][bj][m][1] * sc;
                    v4u w; w.x = cvt_pk_bf16(v0[0], v0[1]); w.y = cvt_pk_bf16(v0[2], v0[3]); w.z = cvt_pk_bf16(v1[0], v1[1]); w.w = cvt_pk_bf16(v1[2], v1[3]);
                    *(v4u*)(rowp + bj * 8) = w; } }
    }
};
struct EpiF32 {
    static constexpr int PERM = 0; float* C; int ldc;
    __device__ __forceinline__ void operator()(const f32x4 (&acc)[2][2][4][2], const Unit& u, int wr, int wc, int fr, int fq) const {
        const int row0 = u.pm * BM + wr * 64 + fr, col0 = u.pn * BM + wc * 32 + 4 * fq;
#pragma unroll
        for (int ai = 0; ai < 2; ++ai)
#pragma unroll
            for (int m = 0; m < 4; ++m) { float* rowp = C + (size_t)(row0 + ai * HALF + m * 16) * ldc + col0;
#pragma unroll
                for (int bj = 0; bj < 2; ++bj)
#pragma unroll
                    for (int n = 0; n < 2; ++n) *(f32x4*)(rowp + bj * HALF + n * 16) = acc[ai][bj][m][n]; }
    }
};
struct EpiGlu {
    static constexpr int PERM = 1; unsigned char* H; float gscale;
    __device__ __forceinline__ void operator()(const f32x4 (&acc)[2][2][4][2], const Unit& u, int wr, int wc, int fr, int fq) const {
        const int row0 = u.pm * BM + wr * 64 + fr, col0 = u.pn * HALF + wc * 32 + 8 * fq;
#pragma unroll
        for (int ai = 0; ai < 2; ++ai)
#pragma unroll
            for (int m = 0; m < 4; ++m) { float h[8];
#pragma unroll
                for (int n = 0; n < 2; ++n)
#pragma unroll
                    for (int q = 0; q < 4; ++q) { const float a = acc[ai][0][m][n][q] * gscale; h[n * 4 + q] = a * __builtin_amdgcn_rcpf(1.f + __expf(-a)) * (acc[ai][1][m][n][q] * gscale); }
                *(unsigned long long*)(H + (size_t)(row0 + ai * HALF + m * 16) * FF + col0) = (unsigned long long)pk4_fp8(h[0], h[1], h[2], h[3]) | ((unsigned long long)pk4_fp8(h[4], h[5], h[6], h[7]) << 32); }
    }
};
struct EpiScatter {
    static constexpr int PERM = 2; unsigned char* ys8; bf16* ysh; const i32x2* list; const LAS int* nn;
    __device__ __forceinline__ void operator()(const f32x4 (&acc)[2][2][4][2], const Unit& u, int wr, int wc, int fr, int fq) const {
        const int col0 = u.pn * BM + wc * 64 + 16 * fq; const int n = nn[u.e]; const bool routed = u.e < NE;
        const i32x2* lp = list + (size_t)(u.pm - u.mt) * 256;
#pragma unroll
        for (int ai = 0; ai < 2; ++ai) {
            i32x2 en[4];
#pragma unroll
            for (int m = 0; m < 4; ++m) { const int rr = u.mt * 256 + ai * HALF + wr * 64 + m * 16 + fr; const i32x2 ld = lp[rr];
                en[m].x = routed ? ld.x : rr; en[m].y = routed ? ld.y : 0x3f800000; }
#pragma unroll
            for (int m = 0; m < 4; ++m) { const int rr = u.mt * 256 + ai * HALF + wr * 64 + m * 16 + fr;
                if (rr < n) {
                    if (routed) { const float g = __int_as_float(en[m].y) * (16.f / 64.f);
                        const f32x4 a0 = acc[ai][0][m][0] * g, a1 = acc[ai][0][m][1] * g, b0 = acc[ai][1][m][0] * g, b1 = acc[ai][1][m][1] * g;
                        v4u w; w.x = pk4_fp8(a0[0], a0[1], a0[2], a0[3]); w.y = pk4_fp8(a1[0], a1[1], a1[2], a1[3]); w.z = pk4_fp8(b0[0], b0[1], b0[2], b0[3]); w.w = pk4_fp8(b1[0], b1[1], b1[2], b1[3]);
                        *(v4u*)(ys8 + (size_t)en[m].x * D + col0) = w; }
                    else { bf16* dst = ysh + (size_t)rr * D + col0;
#pragma unroll
                        for (int bj = 0; bj < 2; ++bj) { const f32x4 v0 = acc[ai][bj][m][0] * (1.f / 64.f), v1 = acc[ai][bj][m][1] * (1.f / 64.f);
                            v4u w; w.x = cvt_pk_bf16(v0[0], v0[1]); w.y = cvt_pk_bf16(v0[2], v0[3]); w.z = cvt_pk_bf16(v1[0], v1[1]); w.w = cvt_pk_bf16(v1[2], v1[3]);
                            *(v4u*)(dst + bj * 8) = w; } } } }
            __builtin_amdgcn_sched_barrier(0);
        }
    }
};

typedef int i32x8 __attribute__((ext_vector_type(8)));
typedef int i32x4 __attribute__((ext_vector_type(4)));
template <bool FP8> struct FragT { struct A4 { bf16x8 v[4][2]; }; struct B2 { bf16x8 v[2][2]; }; };
template <> struct FragT<true> { struct A4 { i32x8 v[4]; }; struct B2 { i32x8 v[2]; }; };
template <class Epi, class Sched, bool GATHER, bool FP8>
__device__ __forceinline__ void gemm_phase(LAS unsigned char* lds, const int Kb, const Sched& S, const Epi& E) {
    const int tid = threadIdx.x, wid = __builtin_amdgcn_readfirstlane(tid >> 6), lane = tid & 63, wr = wid >> 2, wc = wid & 3, fr = lane & 15, fq = lane >> 4;
    const int nt = Kb / 128;
    int sR[2], sC[2];
    unsigned voffA[2], voffB[2];
#pragma unroll
    for (int i = 0; i < 2; ++i) { stage_rc(tid * 16 + i * 8192, sR[i], sC[i]); const int Rb = Epi::PERM == 2 ? perm16x(sR[i]) : (Epi::PERM == 1 ? ((sR[i] & ~31) + perm32(sR[i] & 31)) : sR[i]);
        voffA[i] = (unsigned)(sR[i] * Kb + sC[i] * 2); voffB[i] = (unsigned)(Rb * Kb + sC[i] * 2); }
    const size_t kstep = (size_t)(BK * 2);
    const size_t hstep = (size_t)HALF * Kb;
    const size_t bhstep = Epi::PERM == 2 ? (size_t)8 * Kb : hstep;
    const unsigned ldsw = (unsigned)wid * 1024u;
    const int aoff = lds_byte(wr * 64 + fr, fq * 8), boff = lds_byte(wc * 32 + fr, fq * 8);
    unsigned gc[2][2], gn[2][2];
#define PG8_SA(b, h) (((b) * 2 + (h)) * HTB)
#define PG8_SB(b, h) ((4 + (b) * 2 + (h)) * HTB)
#define PG8_GLDS(src, bufoff, i) __builtin_amdgcn_global_load_lds((const unsigned*)(src), (LAS unsigned*)(lds + (bufoff) + ldsw + (i) * 8192), 16, 0, 0)
#define PG8_STAGE_B(bufoff, gbase) do { PG8_GLDS((const char*)(gbase) + voffB[0], bufoff, 0); PG8_GLDS((const char*)(gbase) + voffB[1], bufoff, 1); } while (0)
#define PG8_STAGE_A(bufoff, gbase, h, nx) do { if constexpr (GATHER) { const unsigned _o0 = (nx) ? gn[h][0] : gc[h][0], _o1 = (nx) ? gn[h][1] : gc[h][1]; \
            PG8_GLDS((const char*)(gbase) + _o0, bufoff, 0); PG8_GLDS((const char*)(gbase) + _o1, bufoff, 1); } \
        else { PG8_GLDS((const char*)(gbase) + (h) * hstep + voffA[0], bufoff, 0); PG8_GLDS((const char*)(gbase) + (h) * hstep + voffA[1], bufoff, 1); } } while (0)
#define PG8_LD2(dstv, p) do { if constexpr (FP8) { const i32x4 _lo = *(const LAS i32x4*)(p), _hi = *(const LAS i32x4*)((p) + 1024); dstv = __builtin_shufflevector(_lo, _hi, 0, 1, 2, 3, 4, 5, 6, 7); } } while (0)
#define PG8_LDA(dst, b, h) do { _Pragma("unroll") for (int m = 0; m < 4; ++m) { if constexpr (FP8) { PG8_LD2(dst.v[m], lds + PG8_SA(b, h) + aoff + m * 2048); } \
        else { _Pragma("unroll") for (int k = 0; k < 2; ++k) dst.v[m][k] = *(const LAS bf16x8*)(lds + PG8_SA(b, h) + aoff + m * 2048 + k * 1024); } } } while (0)
#define PG8_LDB(dst, b, h) do { _Pragma("unroll") for (int n = 0; n < 2; ++n) { if constexpr (FP8) { PG8_LD2(dst.v[n], lds + PG8_SB(b, h) + boff + n * 2048); } \
        else { _Pragma("unroll") for (int k = 0; k < 2; ++k) dst.v[n][k] = *(const LAS bf16x8*)(lds + PG8_SB(b, h) + boff + n * 2048 + k * 1024); } } } while (0)
#define PG8_MMA(ai, bj, At, Bt) do { __builtin_amdgcn_s_setprio(1); _Pragma("unroll") for (int m = 0; m < 4; ++m) _Pragma("unroll") for (int n = 0; n < 2; ++n) { \
        if constexpr (FP8) asm volatile("s_nop 1\n\tv_mfma_scale_f32_16x16x128_f8f6f4 %0, %1, %2, %0, %3, %3 op_sel_hi:[0,0,0]" : "+v"(acc[ai][bj][m][n]) : "v"(Bt.v[n]), "v"(At.v[m]), "v"(f8scale)); \
        else { _Pragma("unroll") for (int k = 0; k < 2; ++k) acc[ai][bj][m][n] = __builtin_amdgcn_mfma_f32_16x16x32_bf16(Bt.v[n][k], At.v[m][k], acc[ai][bj][m][n], 0, 0, 0); } } \
        __builtin_amdgcn_s_setprio(0); } while (0)
#define PG8_WAIT_V(n) asm volatile("s_waitcnt vmcnt(" #n ")" ::: "memory")
#define PG8_WAIT_L(n) asm volatile("s_waitcnt lgkmcnt(" #n ")" ::: "memory")
#define PG8_BAR __builtin_amdgcn_s_barrier()
#define PG8_SCHED __builtin_amdgcn_sched_barrier(0)
#define PG8_GATHER(dst, u) do { _Pragma("unroll") for (int _h = 0; _h < 2; ++_h) _Pragma("unroll") for (int _i = 0; _i < 2; ++_i) \
        dst[_h][_i] = (unsigned)(S.row_token(u, _h * HALF + sR[_i]) * Kb + sC[_i] * 2); } while (0)
    Unit cur, nxt; int ui = 0;
    if (!S.next(0, cur)) return;
    f32x4 acc[2][2][4][2];
#pragma unroll
    for (int a = 0; a < 2; ++a)
#pragma unroll
        for (int b = 0; b < 2; ++b)
#pragma unroll
            for (int m = 0; m < 4; ++m)
#pragma unroll
                for (int n = 0; n < 2; ++n) acc[a][b][m][n] = (f32x4){0.f, 0.f, 0.f, 0.f};
    const int f8scale = 0x7f7f7f7f;
    typedef typename FragT<FP8>::A4 FragA; typedef typename FragT<FP8>::B2 FragB;
    FragA At; FragB B0, B1;
    const char* cA = cur.A; const char* cB = cur.B;
    if constexpr (GATHER) { PG8_GATHER(gc, cur); }
    PG8_STAGE_B(PG8_SB(0, 0), cB); PG8_STAGE_A(PG8_SA(0, 0), cA, 0, false); PG8_STAGE_B(PG8_SB(0, 1), cB + bhstep); PG8_STAGE_A(PG8_SA(0, 1), cA, 1, false);
    if (wr == 1) PG8_BAR;
    PG8_WAIT_V(4); PG8_BAR;
    PG8_STAGE_B(PG8_SB(1, 0), cB + kstep); PG8_STAGE_A(PG8_SA(1, 0), cA + kstep, 0, false); PG8_STAGE_B(PG8_SB(1, 1), cB + bhstep + kstep);
    PG8_WAIT_V(6); PG8_BAR;
    for (;;) {
        const bool has_next = S.next(ui + 1, nxt);
        const char* nA = has_next ? nxt.A : cA; const char* nB = has_next ? nxt.B : cB;
        if constexpr (GATHER) { if (has_next) { PG8_GATHER(gn, nxt); } else {
#pragma unroll
            for (int h = 0; h < 2; ++h) { gn[h][0] = gc[h][0]; gn[h][1] = gc[h][1]; } } }
#pragma unroll 1
        for (int t = 0; t < nt; t += 2) {
            const bool last = (t == nt - 2);
            const char* a1 = cA + (size_t)(t + 1) * kstep;
            const char* a2 = last ? nA : cA + (size_t)(t + 2) * kstep; const char* b2 = last ? nB : cB + (size_t)(t + 2) * kstep;
            const char* a3 = a2 + kstep; const char* b3 = b2 + kstep;
            PG8_LDB(B0, 0, 0); PG8_SCHED; PG8_LDA(At, 0, 0); PG8_STAGE_A(PG8_SA(1, 1), a1, 1, false);
            PG8_WAIT_L(8); PG8_BAR; PG8_WAIT_L(0); PG8_MMA(0, 0, At, B0); PG8_BAR; PG8_SCHED;
            PG8_LDB(B1, 0, 1); PG8_STAGE_B(PG8_SB(0, 0), b2);
            PG8_BAR; PG8_WAIT_L(0); PG8_MMA(0, 1, At, B1); PG8_BAR;
            PG8_LDA(At, 0, 1); PG8_STAGE_A(PG8_SA(0, 0), a2, 0, last);
            PG8_BAR; PG8_WAIT_L(0); PG8_MMA(1, 0, At, B0); PG8_BAR; PG8_SCHED;
            PG8_STAGE_B(PG8_SB(0, 1), b2 + bhstep);
            PG8_WAIT_V(6); PG8_BAR; PG8_MMA(1, 1, At, B1); PG8_BAR;
            PG8_LDB(B0, 1, 0); PG8_SCHED; PG8_LDA(At, 1, 0); PG8_STAGE_A(PG8_SA(0, 1), a2, 1, last);
            PG8_WAIT_L(8); PG8_BAR; PG8_WAIT_L(0); PG8_MMA(0, 0, At, B0); PG8_BAR; PG8_SCHED;
            PG8_LDB(B1, 1, 1); PG8_STAGE_B(PG8_SB(1, 0), b3);
            PG8_BAR; PG8_WAIT_L(0); PG8_MMA(0, 1, At, B1); PG8_BAR;
            PG8_LDA(At, 1, 1); PG8_STAGE_A(PG8_SA(1, 0), a3, 0, last);
            PG8_BAR; PG8_WAIT_L(0); PG8_MMA(1, 0, At, B0); PG8_BAR; PG8_SCHED;
            PG8_STAGE_B(PG8_SB(1, 1), b3 + bhstep);
            PG8_WAIT_V(6); PG8_BAR; PG8_MMA(1, 1, At, B1); PG8_BAR;
        }
        if (wr == 0) PG8_BAR;
        if constexpr (FP8) { __builtin_amdgcn_sched_barrier(0); asm volatile("s_nop 15\n\ts_nop 7" ::: "memory"); __builtin_amdgcn_sched_barrier(0); }
        E(acc, cur, wr, wc, fr, fq);
        if (!has_next) break;
#pragma unroll
        for (int a = 0; a < 2; ++a)
#pragma unroll
            for (int b = 0; b < 2; ++b)
#pragma unroll
                for (int m = 0; m < 4; ++m)
#pragma unroll
                    for (int n = 0; n < 2; ++n) acc[a][b][m][n] = (f32x4){0.f, 0.f, 0.f, 0.f};
        cur = nxt; cA = nA; cB = nB; ++ui;
        if (wr == 1) PG8_BAR;
        if constexpr (GATHER) {
#pragma unroll
            for (int h = 0; h < 2; ++h) { gc[h][0] = gn[h][0]; gc[h][1] = gn[h][1]; } }
    }
    PG8_WAIT_V(0);
    PG8_BAR;
#undef PG8_SA
#undef PG8_SB
#undef PG8_GLDS
#undef PG8_STAGE_A
#undef PG8_STAGE_B
#undef PG8_LDA
#undef PG8_LDB
#undef PG8_MMA
#undef PG8_WAIT_V
#undef PG8_WAIT_L
#undef PG8_BAR
#undef PG8_SCHED
#undef PG8_GATHER
}
}

#define XB_TMO      128
#define XB_XCNT(j)  (256  + 64 * (j))
#define XB_XSUB(j)  (1280 + 64 * (j))
#define XB_XGEN(j)  (2304 + 64 * (j))
#define XB_TOP      3328
#define XB_TOPGEN   3392
#define XCD_BAR_WORDS 3456
#define XB_SPIN_CAP (1u << 22)
__device__ __forceinline__ unsigned xb_ld(unsigned* p)              { return __hip_atomic_load(p, __ATOMIC_RELAXED, __HIP_MEMORY_SCOPE_AGENT); }
__device__ __forceinline__ unsigned xb_add(unsigned* p, unsigned v) { return __hip_atomic_fetch_add(p, v, __ATOMIC_RELAXED, __HIP_MEMORY_SCOPE_AGENT); }
__device__ __forceinline__ unsigned xb_xcc_id() { return (unsigned)__builtin_amdgcn_s_getreg((3 << 11) | 20) & 0xFu; }
#define XB_SPIN(cond, bar) do { unsigned _sp = 0; while (cond) { __builtin_amdgcn_s_sleep(1); \
    if ((++_sp & 255u) == 0u) { if (xb_ld(&(bar)[XB_TMO])) break; if (_sp > XB_SPIN_CAP) { atomicAdd(&(bar)[XB_TMO], 1u); break; } } } } while (0)
struct XcdBarrier { unsigned* bar; unsigned x; volatile LAS unsigned* st; };
__device__ __forceinline__ XcdBarrier xcd_barrier_post(unsigned* bar, volatile LAS unsigned* st) {
    XcdBarrier b; b.bar = bar; b.x = xb_xcc_id(); b.st = st;
    if (threadIdx.x == 0) (void)xb_add(&bar[XB_XCNT(b.x)], 1u);
    return b;
}
__device__ __forceinline__ void xcd_barrier_complete(unsigned* bar, unsigned x, unsigned& nloc, unsigned& nx) {
    const unsigned G = gridDim.x * gridDim.y * gridDim.z;
    unsigned sum, cnt, mine, sp = 0u;
    for (;;) {
        sum = 0u; cnt = 0u; mine = 0u;
#pragma unroll
        for (unsigned j = 0; j < 16; ++j) { const unsigned c = xb_ld(&bar[XB_XCNT(j)]); sum += c; cnt += (c > 0u) ? 1u : 0u; mine = (j == x) ? c : mine; }
        if (sum == G) break;
        __builtin_amdgcn_s_sleep(1);
        if ((++sp & 255u) == 0u) { if (xb_ld(&bar[XB_TMO])) break; if (sp > XB_SPIN_CAP) { atomicAdd(&bar[XB_TMO], 1u); break; } }
    }
    nloc = mine > 0u ? mine : 1u; nx = cnt > 0u ? cnt : 1u;
}
__device__ __forceinline__ void xcd_barrier(const XcdBarrier& b) {
    asm volatile("s_waitcnt vmcnt(0)" ::: "memory");
    __syncthreads();
    if (threadIdx.x == 0) {
        unsigned* bar = b.bar;
        __builtin_amdgcn_s_waitcnt(0);
        unsigned nloc = b.st[0], nx = b.st[1];
        if (nloc == 0u) { xcd_barrier_complete(bar, b.x, nloc, nx); b.st[0] = nloc; b.st[1] = nx; }
        const unsigned old = xb_add(&bar[XB_XSUB(b.x)], 1u);
        const unsigned gen = old / nloc;
        if (old + 1u == (gen + 1u) * nloc) {
            __builtin_amdgcn_fence(__ATOMIC_RELEASE, "agent");
            asm volatile("s_waitcnt vmcnt(0)" ::: "memory");
            const unsigned og = xb_add(&bar[XB_TOP], 1u);
            const unsigned tg = og / nx;
            if (og + 1u == (tg + 1u) * nx) xb_add(&bar[XB_TOPGEN], 1u);
            else XB_SPIN(xb_ld(&bar[XB_TOPGEN]) == tg, bar);
            __builtin_amdgcn_fence(__ATOMIC_ACQUIRE, "agent");
            xb_add(&bar[XB_XGEN(b.x)], 1u);
            asm volatile("s_waitcnt vmcnt(0)" ::: "memory");
        } else {
            XB_SPIN(xb_ld(&bar[XB_XGEN(b.x)]) == gen, bar);
            __builtin_amdgcn_fence(__ATOMIC_ACQUIRE, "agent");
            asm volatile("s_waitcnt vmcnt(0)" ::: "memory");
        }
    }
    __syncthreads();
}

constexpr int NWAVES = 8, NTHR = 512;
constexpr int RING_BYTES = 131072, XTRA_OFF = RING_BYTES, LDS_BYTES = 147456;
constexpr int X_MISC = 0, X_TB = 256, X_NN = 1536;
constexpr int CW_BAR = 4096;
constexpr int N_PHASES = 14;
struct MArgs { const float* in[22]; float* out; unsigned char* ws; int ph_lo, ph_hi; };

#define MAKE_PREP_ARGS(a) PrepArgs{(a).in[4], (a).in[9], (a).in[12], (a).in[14], (a).in[15], (a).in[16], (a).in[17], (a).in[18], (a).in[19], \
    (unsigned char*)((a).ws + WS_WTIN), (bf16*)((a).ws + WS_WTOUT), (bf16*)((a).ws + WS_WTR), (unsigned char*)((a).ws + WS_WT13), (unsigned char*)((a).ws + WS_WT2)}
__device__ __forceinline__ void ph_mod_prep(const MArgs& a, unsigned char* smem, int G) {
    const int tid = threadIdx.x;
    unsigned char* ws = a.ws;
    if ((int)blockIdx.x < 192) {
        float* sc = (float*)smem; float* red = sc + NB * D;
        const float* c = a.in[1]; const float* w_ada = a.in[2]; const float* b_ada = a.in[3]; float* mod = (float*)(ws + WS_MOD);
        for (int i = tid; i < NB * D; i += NTHR) sc[i] = siluf_(c[i]);
        __syncthreads();
        for (int it = blockIdx.x; it < 192; it += G) {
            const int kq = tid >> 5, jl = tid & 31, j = it * 32 + jl;
            float a0 = 0.f, a1 = 0.f, a2 = 0.f, a3 = 0.f;
#pragma unroll 16
            for (int kk = 0; kk < 64; ++kk) { const int k = kq * 64 + kk; const float w = w_ada[(size_t)k * 6144 + j];
                a0 += sc[k] * w; a1 += sc[D + k] * w; a2 += sc[2 * D + k] * w; a3 += sc[3 * D + k] * w; }
            red[(kq * 4 + 0) * 32 + jl] = a0; red[(kq * 4 + 1) * 32 + jl] = a1; red[(kq * 4 + 2) * 32 + jl] = a2; red[(kq * 4 + 3) * 32 + jl] = a3;
            __syncthreads();
            if (tid < 128) { const int b = tid >> 5; float s = b_ada[j];
#pragma unroll
                for (int q = 0; q < 16; ++q) s += red[(q * 4 + b) * 32 + jl];
                mod[b * 6144 + j] = s; }
            __syncthreads();
        }
    }
    const PrepArgs pa = MAKE_PREP_ARGS(a);
    const int lane = tid & 63, gw = blockIdx.x * NWAVES + (tid >> 6), ngw = G * NWAVES;
    prep_run(pa, gw, ngw, lane);
}

__device__ __forceinline__ void ph_ln1(const MArgs& a, unsigned char* smem, int G) {
    const int tid = threadIdx.x, lane = tid & 63, wave = tid >> 6;
    const float* x = a.in[0]; const float* w_in = a.in[4]; const float* gate_b = a.in[7];
    const float* mod = (const float*)(a.ws + WS_MOD); unsigned char* u1 = (unsigned char*)(a.ws + WS_U1); float* ipre = (float*)(a.ws + WS_GATES); float* logf = ipre + 16 * S;
    float* wg = (float*)smem;
    for (int i = tid; i < D * 8; i += NTHR) wg[i] = w_in[(size_t)(i >> 3) * WIN_LD + C_GATE + (i & 7)];
    __syncthreads();
    for (int it = blockIdx.x; it < T / 128; it += G) {
        const int row0 = it * 128, b = row0 / S;
        f32x4 sh[4], sc[4];
#pragma unroll
        for (int j = 0; j < 4; ++j) { sh[j] = *(const f32x4*)(mod + b * 6144 + 4 * lane + 256 * j); sc[j] = *(const f32x4*)(mod + b * 6144 + 1024 + 4 * lane + 256 * j); }
        for (int rr = wave; rr < 128; rr += NWAVES) {
            const int row = row0 + rr;
            const f32x4* xr = (const f32x4*)(x + (size_t)row * D) + lane;
            f32x4 v[4]; float s = 0.f;
#pragma unroll
            for (int j = 0; j < 4; ++j) { v[j] = xr[64 * j]; s += (v[j].x + v[j].y) + (v[j].z + v[j].w); }
            const float mean = wave_sum(s) * (1.f / D); float s2 = 0.f;
#pragma unroll
            for (int j = 0; j < 4; ++j) { v[j] = v[j] - mean; s2 += (v[j].x * v[j].x + v[j].y * v[j].y) + (v[j].z * v[j].z + v[j].w * v[j].w); }
            const float rstd = 1.f / sqrtf(wave_sum(s2) * (1.f / D) + LN_EPS);
            float ga[8];
#pragma unroll
            for (int q = 0; q < 8; ++q) ga[q] = 0.f;
            unsigned* o4 = (unsigned*)(u1 + (size_t)row * D) + lane;
#pragma unroll
            for (int j = 0; j < 4; ++j) {
                const f32x4 u = v[j] * rstd * (sc[j] + 1.0f) + sh[j];
                o4[64 * j] = pk4_fp8(u.x, u.y, u.z, u.w);
#pragma unroll
                for (int e = 0; e < 4; ++e) { const int k = 4 * lane + 256 * j + e;
                    const f32x4 w0 = *(const f32x4*)(wg + k * 8), w1 = *(const f32x4*)(wg + k * 8 + 4);
                    ga[0] += u[e] * w0.x; ga[1] += u[e] * w0.y; ga[2] += u[e] * w0.z; ga[3] += u[e] * w0.w;
                    ga[4] += u[e] * w1.x; ga[5] += u[e] * w1.y; ga[6] += u[e] * w1.z; ga[7] += u[e] * w1.w; }
            }
#pragma unroll
            for (int q = 0; q < 8; ++q) ga[q] = wave_sum(ga[q]);
            if (lane < 8) {
                float gv = 0.f;
#pragma unroll
                for (int q = 0; q < 8; ++q) gv = (lane == q) ? ga[q] : gv;
                gv += gate_b[lane];
                const int h = lane & 3, s_ = row % S;
                if (lane < 4) ipre[(size_t)(b * 4 + h) * S + s_] = gv;
                else logf[(size_t)(b * 4 + h) * S + s_] = fminf(gv, 0.f) - log1pf(__expf(-fabsf(gv)));
            }
        }
    }
}

__device__ __forceinline__ void ph_ln2(const MArgs& a, int G) {
    const float* x = a.in[0]; const bf16* mixout = (const bf16*)(a.ws + WS_MIXOUT); const float* mod = (const float*)(a.ws + WS_MOD); const float* ln1_g = a.in[10]; const float* ln1_b = a.in[11];
    bf16* x1 = (bf16*)(a.ws + WS_X1); bf16* u2 = (bf16*)(a.ws + WS_U2); unsigned char* u2f8 = (unsigned char*)(a.ws + WS_U2F8);
    const int tid = threadIdx.x, lane = tid & 63, wave = tid >> 6;
    for (int it = blockIdx.x; it < T / 128; it += G) {
        const int row0 = it * 128, b = row0 / S;
        f32x4 g1[4], lg[4], lb[4], sc2[4], sh2[4];
#pragma unroll
        for (int j = 0; j < 4; ++j) { const int col = 4 * lane + 256 * j;
            g1[j] = *(const f32x4*)(mod + b * 6144 + 2048 + col); lg[j] = *(const f32x4*)(ln1_g + col); lb[j] = *(const f32x4*)(ln1_b + col);
            sc2[j] = *(const f32x4*)(mod + b * 6144 + 4096 + col) + 1.0f; sh2[j] = *(const f32x4*)(mod + b * 6144 + 3072 + col); }
        for (int rr = wave; rr < 128; rr += NWAVES) {
            const int row = row0 + rr;
            f32x4 v[4]; float s = 0.f;
#pragma unroll
            for (int j = 0; j < 4; ++j) {
                const int col = 4 * lane + 256 * j;
                const f32x4 xv = __builtin_nontemporal_load((const f32x4*)(x + (size_t)row * D + col));
                const f32x4 mo = ld_bf4(mixout + (size_t)row * D + col);
                v[j] = xv * DN_ALPHA + g1[j] * mo; s += (v[j].x + v[j].y) + (v[j].z + v[j].w);
            }
            float mean = wave_sum(s) * (1.f / D), s2 = 0.f;
#pragma unroll
            for (int j = 0; j < 4; ++j) { v[j] = v[j] - mean; s2 += (v[j].x * v[j].x + v[j].y * v[j].y) + (v[j].z * v[j].z + v[j].w * v[j].w); }
            float rstd = 1.f / sqrtf(wave_sum(s2) * (1.f / D) + LN_EPS);
            s = 0.f;
#pragma unroll
            for (int j = 0; j < 4; ++j) { const int col = 4 * lane + 256 * j;
                v[j] = v[j] * rstd * lg[j] + lb[j];
                *(unsigned long long*)(x1 + (size_t)row * D + col) = (unsigned long long)pk2(v[j].x, v[j].y) | ((unsigned long long)pk2(v[j].z, v[j].w) << 32); s += (v[j].x + v[j].y) + (v[j].z + v[j].w); }
            mean = wave_sum(s) * (1.f / D); s2 = 0.f;
#pragma unroll
            for (int j = 0; j < 4; ++j) { v[j] = v[j] - mean; s2 += (v[j].x * v[j].x + v[j].y * v[j].y) + (v[j].z * v[j].z + v[j].w * v[j].w); }
            rstd = 1.f / sqrtf(wave_sum(s2) * (1.f / D) + LN_EPS);
#pragma unroll
            for (int j = 0; j < 4; ++j) { const int col = 4 * lane + 256 * j;
                const f32x4 u = v[j] * rstd * sc2[j] + sh2[j];
                *(unsigned long long*)(u2 + (size_t)row * D + col) = (unsigned long long)pk2(u.x, u.y) | ((unsigned long long)pk2(u.z, u.w) << 32);
                *(unsigned*)(u2f8 + (size_t)row * D + col) = pk4_fp8(u.x, u.y, u.z, u.w); }
        }
    }
}
#define DPPI(v, ctrl) __builtin_amdgcn_update_dpp(0, (v), (ctrl), 0xF, 0xF, true)
#define DPPF(v, ctrl) __builtin_bit_cast(float, __builtin_amdgcn_update_dpp(0, __builtin_bit_cast(int, (v)), (ctrl), 0xF, 0xF, true))
__device__ __forceinline__ void route_wave(int t, int lane, const float* __restrict__ logits, const f32x4 bias4, int* __restrict__ tope, float* __restrict__ topg, int* __restrict__ cnt) {
    const f32x4 lg = *(const f32x4*)(logits + (size_t)t * NE + 4 * lane);
    float sc[4], v[4];
#pragma unroll
    for (int j = 0; j < 4; ++j) { sc[j] = 1.f / (1.f + __expf(-lg[j])); v[j] = sc[j] + bias4[j]; }
    float m1 = fmaxf(fmaxf(v[0], v[1]), fmaxf(v[2], v[3]));
    float m2; { const float a = fmaxf(v[0], v[1]), b = fminf(v[0], v[1]), c = fmaxf(v[2], v[3]), d = fminf(v[2], v[3]); m2 = fmaxf(fminf(a, c), fmaxf(b, d)); }
#pragma unroll
    for (int st = 0; st < 3; ++st) { const float o1 = st == 0 ? DPPF(m1, 0xB1) : (st == 1 ? DPPF(m1, 0x4E) : DPPF(m1, 0x141)), o2 = st == 0 ? DPPF(m2, 0xB1) : (st == 1 ? DPPF(m2, 0x4E) : DPPF(m2, 0x141));
        const float n1 = fmaxf(m1, o1); m2 = fmaxf(fminf(m1, o1), fmaxf(m2, o2)); m1 = n1; }
    const float gs = m1 + m2; const int myg = lane >> 3; int rank = 0;
#pragma unroll
    for (int gg = 0; gg < 8; ++gg) { const float og = __builtin_bit_cast(float, __builtin_amdgcn_readlane(__builtin_bit_cast(int, gs), gg * 8)); rank += (og > gs || (og == gs && gg < myg)) ? 1 : 0; }
    unsigned kh[4];
#pragma unroll
    for (int j = 0; j < 4; ++j) { const unsigned u = __builtin_bit_cast(unsigned, v[j]); kh[j] = (rank >= 4) ? 0u : (u ^ ((u >> 31) ? 0xFFFFFFFFu : 0x80000000u)); }
    int myE = 0; float myS = 0.f, gsum = 0.f;
#pragma unroll
    for (int rd = 0; rd < 8; ++rd) {
        unsigned bh_ = kh[0]; int bl = 255 - 4 * lane;
#pragma unroll
        for (int j = 1; j < 4; ++j) if (kh[j] > bh_) { bh_ = kh[j]; bl = 255 - (4 * lane + j); }
#pragma unroll
        for (int st = 0; st < 4; ++st) {
            const int ctrl = st == 0 ? 0xB1 : (st == 1 ? 0x4E : (st == 2 ? 0x141 : 0x140));
            const unsigned oh = (unsigned)(st == 0 ? DPPI((int)bh_, 0xB1) : (st == 1 ? DPPI((int)bh_, 0x4E) : (st == 2 ? DPPI((int)bh_, 0x141) : DPPI((int)bh_, 0x140))));
            const int ol = st == 0 ? DPPI(bl, 0xB1) : (st == 1 ? DPPI(bl, 0x4E) : (st == 2 ? DPPI(bl, 0x141) : DPPI(bl, 0x140)));
            (void)ctrl; const bool take = (oh > bh_) || (oh == bh_ && ol > bl); bh_ = take ? oh : bh_; bl = take ? ol : bl; }
        unsigned wh = (unsigned)__builtin_amdgcn_readlane((int)bh_, 0); int wl = __builtin_amdgcn_readlane(bl, 0);
#pragma unroll
        for (int rw = 1; rw < 4; ++rw) { const unsigned oh = (unsigned)__builtin_amdgcn_readlane((int)bh_, 16 * rw); const int ol = __builtin_amdgcn_readlane(bl, 16 * rw);
            const bool take = (oh > wh) || (oh == wh && ol > wl); wh = take ? oh : wh; wl = take ? ol : wl; }
        const int bi = 255 - wl;
        float cand = 0.f;
#pragma unroll
        for (int j = 0; j < 4; ++j) if (bi == 4 * lane + j) { cand = sc[j]; kh[j] = 0u; }
        const float ss = __builtin_bit_cast(float, __builtin_amdgcn_readlane(__builtin_bit_cast(int, cand), bi >> 2));
        gsum += ss;
        if (lane == rd) { myE = bi; myS = ss; }
    }
    if (lane < 8) { tope[t * 8 + lane] = myE; topg[t * 8 + lane] = myS * (2.5f / gsum); atomicAdd(cnt + myE, 1); }
}
__device__ __forceinline__ void moe_tables(const int* cnt, LAS int* tb, LAS int* nn) {
    if (threadIdx.x < 64) {
        const int lane = threadIdx.x; int n[4], tl[4], loc = 0;
#pragma unroll
        for (int j = 0; j < 4; ++j) { n[j] = cnt[4 * lane + j]; tl[j] = (n[j] + 255) >> 8; loc += tl[j]; }
        int inc = loc;
#pragma unroll
        for (int o = 1; o < 64; o <<= 1) { const int v = __shfl_up(inc, o); if (lane >= o) inc += v; }
        int base = inc - loc;
#pragma unroll
        for (int j = 0; j < 4; ++j) { tb[4 * lane + j] = base; nn[4 * lane + j] = n[j]; base += tl[j]; }
        if (lane == 63) { tb[NE] = base; nn[NE] = T; tb[NEX] = base + T / 256; }
    }
    __syncthreads();
}
__device__ __forceinline__ void ph_final(const MArgs& a, int G) {
    float* out = a.out; const bf16* x1 = (const bf16*)(a.ws + WS_X1); const unsigned char* ys8 = (const unsigned char*)(a.ws + WS_YS); const bf16* ysh = (const bf16*)(a.ws + WS_YSH); const float* mod = (const float*)(a.ws + WS_MOD);
    const float* ln2_g = a.in[20]; const float* ln2_b = a.in[21];
    const int tid = threadIdx.x, lane = tid & 63, wave = tid >> 6;
    for (int it = blockIdx.x; it < T / 128; it += G) {
        const int row0 = it * 128, b = row0 / S;
        f32x4 g2[4], lg[4], lb[4];
#pragma unroll
        for (int j = 0; j < 4; ++j) { const int col = 4 * lane + 256 * j; g2[j] = *(const f32x4*)(mod + b * 6144 + 5120 + col); lg[j] = *(const f32x4*)(ln2_g + col); lb[j] = *(const f32x4*)(ln2_b + col); }
        for (int rr = wave; rr < 128; rr += NWAVES) {
            const int row = row0 + rr;
            f32x4 v[4]; float s = 0.f;
#pragma unroll
            for (int j = 0; j < 4; ++j) { const int col = 4 * lane + 256 * j;
                f32x4 yr = {0.f, 0.f, 0.f, 0.f};
#pragma unroll
                for (int k = 0; k < 8; ++k) { const int w = *(const int*)(ys8 + ((size_t)row * 8 + k) * D + col);
                    const f32x2 lo = __builtin_amdgcn_cvt_pk_f32_fp8(w, false), hi = __builtin_amdgcn_cvt_pk_f32_fp8(w, true); yr = yr + (f32x4){lo.x, lo.y, hi.x, hi.y}; }
                const f32x4 y = ld_bf4(ysh + (size_t)row * D + col) + yr * (1.f / 16.f);
                v[j] = ld_bf4(x1 + (size_t)row * D + col) * DN_ALPHA + g2[j] * y;
                s += (v[j].x + v[j].y) + (v[j].z + v[j].w); }
            const float mean = wave_sum(s) * (1.f / D); float s2 = 0.f;
#pragma unroll
            for (int j = 0; j < 4; ++j) { v[j] = v[j] - mean; s2 += (v[j].x * v[j].x + v[j].y * v[j].y) + (v[j].z * v[j].z + v[j].w * v[j].w); }
            const float rstd = 1.f / sqrtf(wave_sum(s2) * (1.f / D) + LN_EPS);
#pragma unroll
            for (int j = 0; j < 4; ++j) { const int col = 4 * lane + 256 * j;
                __builtin_nontemporal_store(v[j] * rstd * lg[j] + lb[j], (f32x4*)(out + (size_t)row * D + col)); }
        }
    }
}


typedef short s16x4 __attribute__((ext_vector_type(4)));
typedef short bf16x8v __attribute__((ext_vector_type(8)));
typedef float f32x16 __attribute__((ext_vector_type(16)));
constexpr int MLP = 320;
constexpr int NCH = S / 64;
constexpr int ST_ELEMS = 129 * 128;
constexpr size_t WS_CHK = WS_GATES + 1 * MiB;
constexpr size_t WS_MPREV = WS_GATES + 1 * MiB + 65536;
constexpr size_t WS_KC = WS_U2;
__device__ __forceinline__ s16x4 tr_read(const LAS unsigned char* p) { return __builtin_bit_cast(s16x4, __builtin_amdgcn_ds_read_tr16_b64_v4i16((LAS s16x4*)p)); }
__device__ __forceinline__ bf16x8v tr_frag(const LAS unsigned char* tile, int row0, int col0, int lane) {
    const int i = lane & 15; const LAS unsigned char* p = tile + (row0 + (i >> 2)) * MLP + (col0 + 4 * (i & 3)) * 2;
    const s16x4 lo = tr_read(p), hi = tr_read(p + 4 * MLP);
    return __builtin_shufflevector(lo, hi, 0, 1, 2, 3, 4, 5, 6, 7);
}
__device__ __forceinline__ bf16x8v tr_frag_perm(const LAS unsigned char* tile, int row0, int col0, int lane) {
    const int i = lane & 15; const LAS unsigned char* p = tile + (row0 + (i >> 2)) * MLP + (col0 + 4 * (i & 3)) * 2;
    const s16x4 lo = tr_read(p), hi = tr_read(p + 8 * MLP);
    return __builtin_shufflevector(lo, hi, 0, 1, 2, 3, 4, 5, 6, 7);
}
__device__ __forceinline__ float wave_incl_sum(float v, int lane) {
#pragma unroll
    for (int o = 1; o < 64; o <<= 1) { const float u = __shfl_up(v, o); if (lane >= o) v += u; }
    return v;
}
__device__ __forceinline__ float wave_incl_max(float v, int lane) {
#pragma unroll
    for (int o = 1; o < 64; o <<= 1) { const float u = __shfl_up(v, o); if (lane >= o) v = fmaxf(v, u); }
    return v;
}
__device__ __forceinline__ float wave_max(float v) {
#pragma unroll
    for (int o = 1; o < 64; o <<= 1) v = fmaxf(v, __shfl_xor(v, o));
    return v;
}
__device__ __forceinline__ void conv8(const bf16* __restrict__ rowp, int spos, const float* __restrict__ cw, const float* __restrict__ cb, float scale, float (&y)[8]) {
    const f32x4 b0 = *(const f32x4*)cb, b1 = *(const f32x4*)(cb + 4);
    y[0] = b0.x; y[1] = b0.y; y[2] = b0.z; y[3] = b0.w; y[4] = b1.x; y[5] = b1.y; y[6] = b1.z; y[7] = b1.w;
#pragma unroll
    for (int j = 0; j < 4; ++j) {
        if (spos - 3 + j >= 0) {
            const v4u xr = *(const v4u*)(rowp + (ptrdiff_t)(j - 3) * NPROJ);
            const f32x4 w0 = *(const f32x4*)(cw + j * 1024), w1 = *(const f32x4*)(cw + j * 1024 + 4);
            y[0] += w0.x * bf2f(xr.x & 0xffffu); y[1] += w0.y * bf2f(xr.x >> 16); y[2] += w0.z * bf2f(xr.y & 0xffffu); y[3] += w0.w * bf2f(xr.y >> 16);
            y[4] += w1.x * bf2f(xr.z & 0xffffu); y[5] += w1.y * bf2f(xr.z >> 16); y[6] += w1.z * bf2f(xr.w & 0xffffu); y[7] += w1.w * bf2f(xr.w >> 16);
        }
    }
#pragma unroll
    for (int e = 0; e < 8; ++e) y[e] = siluf_(y[e]) * scale;
}
__device__ __forceinline__ v4u pack8(const float (&y)[8]) { v4u o; o.x = pk2(y[0], y[1]); o.y = pk2(y[2], y[3]); o.z = pk2(y[4], y[5]); o.w = pk2(y[6], y[7]); return o; }

__device__ __forceinline__ void ml_phaseA(const MArgs& a, LAS unsigned char* lds, int vb0, int nvb) {
    const int tid = threadIdx.x, lane = tid & 63, wave = __builtin_amdgcn_readfirstlane(tid >> 6);
    const bf16* proj = (const bf16*)(a.ws + WS_PROJ); const float* conv_w = a.in[5]; const float* conv_b = a.in[6];
    const float* ipre = (const float*)(a.ws + WS_GATES); const float* logf = ipre + 16 * S;
    bf16* kcg = (bf16*)(a.ws + WS_KC); bf16* st = (bf16*)(a.ws + WS_STATES); float* chk = (float*)(a.ws + WS_CHK);
    LAS unsigned char* Kt = lds; LAS unsigned char* Vt = lds + 64 * MLP; LAS float* wkL = (LAS float*)(lds + 128 * MLP); LAS unsigned char* Stg = lds + 132 * MLP;
    const PrepArgs pa = MAKE_PREP_ARGS(a);
    for (int unit = vb0; unit < 16 * NCH; unit += nvb) {
        const int bh = unit >> 7, c = unit & (NCH - 1), b = bh >> 2, h = bh & 3, s0 = c * 64; const size_t row0 = (size_t)b * S + s0;
        if (wave == 0) {
            const float lf = logf[(size_t)bh * S + s0 + lane], ic = ipre[(size_t)bh * S + s0 + lane];
            const float bc = wave_incl_sum(lf, lane), g = ic - bc, gmax = wave_max(g), blast = __shfl(bc, 63);
            wkL[lane] = __expf(g - gmax);
            if (lane == 0) { chk[(size_t)unit * 2] = blast; chk[(size_t)unit * 2 + 1] = blast + gmax; }
        }
#pragma unroll
        for (int q = 0; q < 2; ++q) { const int it = tid + q * NTHR, tt = it >> 4, c8 = it & 15, ch = h * 128 + c8 * 8;
            float y[8]; conv8(proj + (row0 + tt) * NPROJ + C_MLK + ch, s0 + tt, conv_w + 512 + ch, conv_b + 512 + ch, 0.08838834764831845f, y);
            const v4u o = pack8(y);
            *(LAS v4u*)(Kt + tt * MLP + c8 * 16) = o; *(v4u*)(kcg + (row0 + tt) * 512 + ch) = o; }
        __syncthreads();
        const PrepDesc bgd = prep_decode(pa, IT_SMALL + unit * NWAVES + wave); f32x4 bgv[16]; prep_load(bgd, lane, bgv);
#pragma unroll
        for (int q = 0; q < 2; ++q) { const int it = tid + q * NTHR, tt = it >> 4, c8 = it & 15;
            const v4u xr = *(const v4u*)(proj + (row0 + tt) * NPROJ + C_MLV + h * 128 + c8 * 8); const float w = wkL[tt];
            float y[8] = {bf2f(xr.x & 0xffffu) * w, bf2f(xr.x >> 16) * w, bf2f(xr.y & 0xffffu) * w, bf2f(xr.y >> 16) * w, bf2f(xr.z & 0xffffu) * w, bf2f(xr.z >> 16) * w, bf2f(xr.w & 0xffffu) * w, bf2f(xr.w >> 16) * w};
            *(LAS v4u*)(Vt + tt * MLP + c8 * 16) = pack8(y); }
        __syncthreads();
        {
            const int dvb = wave >> 1, dkh = wave & 1, hh = lane >> 5, gsel = (lane >> 4) & 1;
            f32x16 acc[2];
#pragma unroll
            for (int nb = 0; nb < 2; ++nb)
#pragma unroll
                for (int i = 0; i < 16; ++i) acc[nb][i] = 0.f;
#pragma unroll
            for (int kk = 0; kk < 4; ++kk) {
                const bf16x8v Bv = tr_frag(Vt, 16 * kk + 8 * hh, 32 * dvb + 16 * gsel, lane);
#pragma unroll
                for (int nb = 0; nb < 2; ++nb) { const bf16x8v Ak = tr_frag(Kt, 16 * kk + 8 * hh, 32 * (2 * dkh + nb) + 16 * gsel, lane);
                    acc[nb] = __builtin_amdgcn_mfma_f32_32x32x16_bf16(Ak, Bv, acc[nb], 0, 0, 0); }
            }
#pragma unroll
            for (int nb = 0; nb < 2; ++nb)
#pragma unroll
                for (int g4 = 0; g4 < 4; ++g4) { const int dk = 32 * (2 * dkh + nb) + 8 * g4 + 4 * hh, dv = 32 * dvb + (lane & 31);
                    *(LAS unsigned long long*)(Stg + dv * MLP + dk * 2) = (unsigned long long)pk2(acc[nb][4 * g4], acc[nb][4 * g4 + 1]) | ((unsigned long long)pk2(acc[nb][4 * g4 + 2], acc[nb][4 * g4 + 3]) << 32); }
        }
        __syncthreads();
        { bf16* stc = st + (size_t)unit * ST_ELEMS;
#pragma unroll
          for (int q = 0; q < 4; ++q) { const int it = tid + q * NTHR, dv = it >> 4, c8 = it & 15;
              *(v4u*)(stc + dv * 128 + c8 * 8) = *(const LAS v4u*)(Stg + dv * MLP + c8 * 16); }
        }
        if (tid < 128) { float s = 0.f;
#pragma unroll 8
            for (int t = 0; t < 64; ++t) s += wkL[t] * bf2f(*(const LAS unsigned short*)(Kt + t * MLP + tid * 2));
            st[(size_t)unit * ST_ELEMS + 128 * 128 + tid] = (bf16)f2bf(s); }
        prep_store(bgd, lane, bgv);
        __syncthreads();
    }
}

__device__ __forceinline__ void ml_phaseB(const MArgs& a, LAS unsigned char* lds, int vb0, int nvb) {
    const int tid = threadIdx.x;
    bf16* st = (bf16*)(a.ws + WS_STATES); const float* chk = (const float*)(a.ws + WS_CHK); float* mprev = (float*)(a.ws + WS_MPREV);
    LAS float* al = (LAS float*)lds; LAS float* be = al + NCH;
    constexpr int NSL = 16, SLE = ST_ELEMS / NSL;
    for (int item = vb0; item < 16 * NSL; item += nvb) {
        const int bh = item / NSL, sl = item % NSL;
        __syncthreads();
        if (tid < NCH) { al[tid] = chk[(size_t)(bh * NCH + tid) * 2]; be[tid] = chk[(size_t)(bh * NCH + tid) * 2 + 1]; }
        __syncthreads();
        if (tid == 0) { float m = 0.f;
            for (int c = 0; c < NCH; ++c) { const float bl = al[c], M = be[c];
                const float mn = fmaxf(bl + m, M); al[c] = __expf(bl + m - mn); be[c] = __expf(M - mn);
                if (sl == 0) mprev[bh * NCH + c] = m;
                m = mn; } }
        __syncthreads();
        if (tid * 4 < SLE) {
            unsigned long long* p = (unsigned long long*)(st + (size_t)bh * NCH * ST_ELEMS + sl * SLE + tid * 4);
            float c0 = 0.f, c1 = 0.f, c2 = 0.f, c3 = 0.f;
            for (int cb = 0; cb < NCH; cb += 16) { unsigned long long d[16];
#pragma unroll
                for (int j = 0; j < 16; ++j) d[j] = p[(size_t)(cb + j) * (ST_ELEMS / 4)];
#pragma unroll
                for (int j = 0; j < 16; ++j) { p[(size_t)(cb + j) * (ST_ELEMS / 4)] = (unsigned long long)pk2(c0, c1) | ((unsigned long long)pk2(c2, c3) << 32);
                    const float A = al[cb + j], Bq = be[cb + j]; const unsigned lo = (unsigned)d[j], hi = (unsigned)(d[j] >> 32);
                    c0 = A * c0 + Bq * bf2f(lo & 0xffffu); c1 = A * c1 + Bq * bf2f(lo >> 16); c2 = A * c2 + Bq * bf2f(hi & 0xffffu); c3 = A * c3 + Bq * bf2f(hi >> 16); } }
        }
    }
}

__device__ __forceinline__ void ml_phaseC(const MArgs& a, LAS unsigned char* lds, int G) {
    const int tid = threadIdx.x, lane = tid & 63, wave = __builtin_amdgcn_readfirstlane(tid >> 6);
    const bf16* proj = (const bf16*)(a.ws + WS_PROJ); const float* conv_w = a.in[5]; const float* conv_b = a.in[6]; const float* norm_g = a.in[8];
    const float* ipre = (const float*)(a.ws + WS_GATES); const float* logf = ipre + 16 * S;
    const bf16* kcg = (const bf16*)(a.ws + WS_KC); const bf16* st = (const bf16*)(a.ws + WS_STATES); const float* mprev = (const float*)(a.ws + WS_MPREV);
    unsigned char* mix8 = (unsigned char*)(a.ws + WS_MIX);
    LAS unsigned char* Qt = lds; LAS unsigned char* Kt = lds + 64 * MLP; LAS unsigned char* Vt = lds + 128 * MLP; LAS unsigned char* Ct = lds + 192 * MLP;
    LAS float* sc = (LAS float*)(lds + 320 * MLP);
    LAS float* gL = sc; LAS float* mmL = sc + 64; LAS float* siL = sc + 128; LAS float* emL = sc + 192; LAS float* npv = sc + 256; LAS float* lnS = sc + 384;
    const int tb = wave >> 2, dvb = wave & 3, r = lane & 31, hh = lane >> 5, gsel = (lane >> 4) & 1;
    const PrepArgs pa = MAKE_PREP_ARGS(a);
    for (int unit = blockIdx.x; unit < 16 * NCH; unit += G) {
        const int bh = unit >> 7, c = unit & (NCH - 1), b = bh >> 2, h = bh & 3, s0 = c * 64; const size_t row0 = (size_t)b * S + s0;
        if (wave == 0) {
            const float lf = logf[(size_t)bh * S + s0 + lane], ic = ipre[(size_t)bh * S + s0 + lane], mp = mprev[unit];
            const float bc = wave_incl_sum(lf, lane), g = ic - bc, pm = wave_incl_max(g, lane), mm = fmaxf(mp, pm);
            gL[lane] = g; mmL[lane] = mm; siL[lane] = __expf(mp - mm); emL[lane] = __expf(-(bc + mm));
        }
        const bf16* stc = st + (size_t)unit * ST_ELEMS;
#pragma unroll
        for (int q = 0; q < 2; ++q) { const int it = tid + q * NTHR, tt = it >> 4, c8 = it & 15, ch = h * 128 + c8 * 8;
            float y[8]; conv8(proj + (row0 + tt) * NPROJ + C_MLQ + ch, s0 + tt, conv_w + ch, conv_b + ch, 1.f, y);
            *(LAS v4u*)(Qt + tt * MLP + c8 * 16) = pack8(y);
            *(LAS v4u*)(Kt + tt * MLP + c8 * 16) = *(const v4u*)(kcg + (row0 + tt) * 512 + ch);
            *(LAS v4u*)(Vt + tt * MLP + c8 * 16) = *(const v4u*)(proj + (row0 + tt) * NPROJ + C_MLV + ch); }
#pragma unroll
        for (int q = 0; q < 4; ++q) { const int it = tid + q * NTHR, dv = it >> 4, c8 = it & 15;
            *(LAS v4u*)(Ct + dv * MLP + c8 * 16) = *(const v4u*)(stc + dv * 128 + c8 * 8); }
        if (tid < 128) npv[tid] = bf2f(stc[128 * 128 + tid]);
        __syncthreads();
        const PrepDesc bgd = prep_decode(pa, IT_SMALL + BG_A + unit * NWAVES + wave); f32x4 bgv[16]; prep_load(bgd, lane, bgv);
        bf16x8v qf[8];
#pragma unroll
        for (int kk = 0; kk < 8; ++kk) qf[kk] = *(const LAS bf16x8v*)(Qt + (32 * tb + r) * MLP + (16 * kk + 8 * hh) * 2);
        const float mm_t = mmL[32 * tb + r], si_t = siL[32 * tb + r], em_t = emL[32 * tb + r];
        float nq = 0.f;
#pragma unroll
        for (int kk = 0; kk < 8; ++kk) { const f32x4 n0 = *(const LAS f32x4*)(npv + 16 * kk + 8 * hh), n1 = *(const LAS f32x4*)(npv + 16 * kk + 8 * hh + 4);
            nq += n0.x * bf2f((unsigned short)qf[kk][0]) + n0.y * bf2f((unsigned short)qf[kk][1]) + n0.z * bf2f((unsigned short)qf[kk][2]) + n0.w * bf2f((unsigned short)qf[kk][3])
                + n1.x * bf2f((unsigned short)qf[kk][4]) + n1.y * bf2f((unsigned short)qf[kk][5]) + n1.z * bf2f((unsigned short)qf[kk][6]) + n1.w * bf2f((unsigned short)qf[kk][7]); }
        nq += __shfl_xor(nq, 32);
        f32x16 num;
#pragma unroll
        for (int i = 0; i < 16; ++i) num[i] = 0.f;
#pragma unroll
        for (int kk = 0; kk < 8; ++kk) { const bf16x8v Ac = *(const LAS bf16x8v*)(Ct + (32 * dvb + r) * MLP + (16 * kk + 8 * hh) * 2);
            num = __builtin_amdgcn_mfma_f32_32x32x16_bf16(Ac, qf[kk], num, 0, 0, 0); }
#pragma unroll
        for (int i = 0; i < 16; ++i) num[i] *= si_t;
        float wsum = 0.f;
        for (int sb = 0; sb <= tb; ++sb) {
            f32x16 sT;
#pragma unroll
            for (int i = 0; i < 16; ++i) sT[i] = 0.f;
#pragma unroll
            for (int kk = 0; kk < 8; ++kk) { const bf16x8v Ak = *(const LAS bf16x8v*)(Kt + (32 * sb + r) * MLP + (16 * kk + 8 * hh) * 2);
                sT = __builtin_amdgcn_mfma_f32_32x32x16_bf16(Ak, qf[kk], sT, 0, 0, 0); }
            unsigned wp[8];
#pragma unroll
            for (int g4 = 0; g4 < 4; ++g4) { const f32x4 gv = *(const LAS f32x4*)(gL + 32 * sb + 8 * g4 + 4 * hh);
                float w[4];
#pragma unroll
                for (int e = 0; e < 4; ++e) { const int srow = 32 * sb + 8 * g4 + 4 * hh + e; const bool valid = srow <= 32 * tb + r;
                    w[e] = valid ? sT[4 * g4 + e] * __expf(gv[e] - mm_t) : 0.f; wsum += w[e]; }
                wp[2 * g4] = pk2(w[0], w[1]); wp[2 * g4 + 1] = pk2(w[2], w[3]); }
#pragma unroll
            for (int s2 = 0; s2 < 2; ++s2) {
                const bf16x8v Av = tr_frag_perm(Vt, 32 * sb + 16 * s2 + 4 * hh, 32 * dvb + 16 * gsel, lane);
                v4u bw; bw.x = wp[4 * s2]; bw.y = wp[4 * s2 + 1]; bw.z = wp[4 * s2 + 2]; bw.w = wp[4 * s2 + 3];
                num = __builtin_amdgcn_mfma_f32_32x32x16_bf16(Av, __builtin_bit_cast(bf16x8v, bw), num, 0, 0, 0); }
        }
        wsum += __shfl_xor(wsum, 32);
        const float den = si_t * nq + wsum, rden = 1.f / fmaxf(fabsf(den), em_t);
        float ps = 0.f, pq = 0.f;
#pragma unroll
        for (int i = 0; i < 16; ++i) { num[i] *= rden; ps += num[i]; pq += num[i] * num[i]; }
        ps += __shfl_xor(ps, 32); pq += __shfl_xor(pq, 32);
        if (hh == 0) { lnS[((tb * 4 + dvb) * 32 + r) * 2] = ps; lnS[((tb * 4 + dvb) * 32 + r) * 2 + 1] = pq; }
        __syncthreads();
        float ts = 0.f, tq = 0.f;
#pragma unroll
        for (int d = 0; d < 4; ++d) { ts += lnS[((tb * 4 + d) * 32 + r) * 2]; tq += lnS[((tb * 4 + d) * 32 + r) * 2 + 1]; }
        const float mean = ts * (1.f / 128.f), rstd = 1.f / sqrtf(fmaxf(tq * (1.f / 128.f) - mean * mean, 0.f) + LN_EPS);
#pragma unroll
        for (int g4 = 0; g4 < 4; ++g4) { const int dv = 32 * dvb + 8 * g4 + 4 * hh;
            *(LAS unsigned long long*)(Qt + (32 * tb + r) * MLP + dv * 2) = (unsigned long long)pk2((num[4 * g4] - mean) * rstd, (num[4 * g4 + 1] - mean) * rstd) | ((unsigned long long)pk2((num[4 * g4 + 2] - mean) * rstd, (num[4 * g4 + 3] - mean) * rstd) << 32); }
        __syncthreads();
#pragma unroll
        for (int q = 0; q < 2; ++q) { const int it = tid + q * NTHR, tt = it >> 4, c8 = it & 15, dv = c8 * 8;
            const v4u hv = *(const LAS v4u*)(Qt + tt * MLP + c8 * 16); const v4u og = *(const v4u*)(proj + (row0 + tt) * NPROJ + C_MLO + h * 128 + dv);
            const f32x4 n0 = *(const f32x4*)(norm_g + h * 128 + dv), n1 = *(const f32x4*)(norm_g + h * 128 + dv + 4);
            float o[8];
            o[0] = bf2f(hv.x & 0xffffu) * n0.x * sigmoidf_(bf2f(og.x & 0xffffu)); o[1] = bf2f(hv.x >> 16) * n0.y * sigmoidf_(bf2f(og.x >> 16));
            o[2] = bf2f(hv.y & 0xffffu) * n0.z * sigmoidf_(bf2f(og.y & 0xffffu)); o[3] = bf2f(hv.y >> 16) * n0.w * sigmoidf_(bf2f(og.y >> 16));
            o[4] = bf2f(hv.z & 0xffffu) * n1.x * sigmoidf_(bf2f(og.z & 0xffffu)); o[5] = bf2f(hv.z >> 16) * n1.y * sigmoidf_(bf2f(og.z >> 16));
            o[6] = bf2f(hv.w & 0xffffu) * n1.z * sigmoidf_(bf2f(og.w & 0xffffu)); o[7] = bf2f(hv.w >> 16) * n1.w * sigmoidf_(bf2f(og.w >> 16));
            *(unsigned long long*)(mix8 + (row0 + tt) * D + 512 + h * 128 + dv) = (unsigned long long)pk4_fp8(o[0], o[1], o[2], o[3]) | ((unsigned long long)pk4_fp8(o[4], o[5], o[6], o[7]) << 32); }
        prep_store(bgd, lane, bgv);
        __syncthreads();
    }
}

constexpr int VTP = 192;
template <int PITCH> __device__ __forceinline__ bf16x8v tr_frag_perm_p(const LAS unsigned char* tile, int row0, int col0, int lane) {
    const int i = lane & 15; const LAS unsigned char* p = tile + (row0 + (i >> 2)) * PITCH + (col0 + 4 * (i & 3)) * 2;
    const s16x4 lo = tr_read(p), hi = tr_read(p + 8 * PITCH);
    return __builtin_shufflevector(lo, hi, 0, 1, 2, 3, 4, 5, 6, 7);
}
__device__ __forceinline__ void attn_phase(const bf16* __restrict__ proj, unsigned char* __restrict__ mix8, LAS unsigned char* lds, int vb0, int nvb, const PrepArgs pa) {
    const int tid = threadIdx.x, lane = tid & 63, wave = __builtin_amdgcn_readfirstlane(tid >> 6);
    const int r = lane & 31, hh = lane >> 5, gsel = (lane >> 4) & 1;
    LAS unsigned char* Vt = lds + wave * (64 * VTP);
    bf16x8v ntri[2], nones;
#pragma unroll
    for (int s2 = 0; s2 < 2; ++s2)
#pragma unroll
        for (int j = 0; j < 8; ++j) { const int k = 16 * s2 + 8 * (j >> 2) + 4 * hh + (j & 3); ntri[s2][j] = (k >= r) ? (short)0xBF80 : (short)0; }
#pragma unroll
    for (int j = 0; j < 8; ++j) nones[j] = (short)0xBF80;
    for (int unit = vb0 * NWAVES + wave; unit < NB * 8 * (S / 32); unit += nvb * NWAVES) {
        const int bh = unit / (S / 32), qb = unit % (S / 32), b = bh >> 3, h = bh & 7, q0 = qb * 32;
        const bf16* base = proj + (size_t)b * S * NPROJ + h * 64;
        bf16x8v qf[4];
#pragma unroll
        for (int s = 0; s < 4; ++s) qf[s] = *(const bf16x8v*)(base + (size_t)(q0 + r) * NPROJ + C_SBQ + 16 * s + 8 * hh);
        f32x16 o[2];
#pragma unroll
        for (int d = 0; d < 2; ++d)
#pragma unroll
            for (int i = 0; i < 16; ++i) o[d][i] = 0.f;
        float carry = 0.f;
        const int qpos = q0 + r;
        const PrepDesc bgd = prep_decode(pa, IT_SMALL + BG_A + BG_C + unit); f32x4 bgv[16]; prep_load(bgd, lane, bgv);
        for (int k0 = q0 - 32; ; k0 -= 64) {
            bf16x8v kf[2][4];
#pragma unroll
            for (int kb = 0; kb < 2; ++kb) { int key = k0 + 32 * kb + r; key = key < 0 ? 0 : key;
#pragma unroll
                for (int s = 0; s < 4; ++s) kf[kb][s] = *(const bf16x8v*)(base + (size_t)key * NPROJ + C_SBK + 16 * s + 8 * hh); }
#pragma unroll
            for (int i = 0; i < 8; ++i) { int key = k0 + (lane >> 3) + 8 * i; key = key < 0 ? 0 : key;
                *(LAS v4u*)(Vt + ((lane >> 3) + 8 * i) * VTP + (lane & 7) * 16) = *(const v4u*)(base + (size_t)key * NPROJ + C_SBV + (lane & 7) * 8); }
            f32x16 z[2];
#pragma unroll
            for (int kb = 0; kb < 2; ++kb) {
#pragma unroll
                for (int i = 0; i < 16; ++i) z[kb][i] = 0.f;
#pragma unroll
                for (int s = 0; s < 4; ++s) z[kb] = __builtin_amdgcn_mfma_f32_32x32x16_bf16(kf[kb][s], qf[s], z[kb], 0, 0, 0); }
            const bool need_mask = (k0 + 63 >= q0) || (k0 < 0);
            unsigned xp[2][8];
#pragma unroll
            for (int kb = 0; kb < 2; ++kb)
#pragma unroll
                for (int g4 = 0; g4 < 4; ++g4) { float sp[4];
#pragma unroll
                    for (int e = 0; e < 4; ++e) { const float zz = z[kb][4 * g4 + e];
                        float v = fmaxf(zz, 0.f) + __builtin_amdgcn_logf(1.f + __builtin_amdgcn_exp2f(-fabsf(zz)));
                        if (need_mask) { const int key = k0 + 32 * kb + 8 * g4 + 4 * hh + e; v = (key >= 0 && key < qpos) ? v : 0.f; }
                        sp[e] = v; }
                    xp[kb][2 * g4] = pk2(sp[0], sp[1]); xp[kb][2 * g4 + 1] = pk2(sp[2], sp[3]); }
            const float z00 = z[0][0];
#pragma unroll
            for (int s2 = 0; s2 < 2; ++s2) { v4u b1; b1.x = xp[1][4 * s2]; b1.y = xp[1][4 * s2 + 1]; b1.z = xp[1][4 * s2 + 2]; b1.w = xp[1][4 * s2 + 3];
                v4u b0; b0.x = xp[0][4 * s2]; b0.y = xp[0][4 * s2 + 1]; b0.z = xp[0][4 * s2 + 2]; b0.w = xp[0][4 * s2 + 3];
                z[1] = __builtin_amdgcn_mfma_f32_32x32x16_bf16(ntri[s2], __builtin_bit_cast(bf16x8v, b1), z[1], 0, 0, 0);
                z[0] = __builtin_amdgcn_mfma_f32_32x32x16_bf16(ntri[s2], __builtin_bit_cast(bf16x8v, b0), z[0], 0, 0, 0);
                z[0] = __builtin_amdgcn_mfma_f32_32x32x16_bf16(nones, __builtin_bit_cast(bf16x8v, b1), z[0], 0, 0, 0); }
            float tot = z00 - z[0][0];
            tot = __shfl(tot, r);
#pragma unroll
            for (int kb = 0; kb < 2; ++kb)
#pragma unroll
                for (int g4 = 0; g4 < 4; ++g4) { float p[4];
#pragma unroll
                    for (int e = 0; e < 4; ++e) { float v = __builtin_amdgcn_exp2f(z[kb][4 * g4 + e] - carry);
                        if (need_mask) { const int key = k0 + 32 * kb + 8 * g4 + 4 * hh + e; v = (key >= 0 && key < qpos) ? v : 0.f; }
                        p[e] = v; }
                    xp[kb][2 * g4] = pk2(p[0], p[1]); xp[kb][2 * g4 + 1] = pk2(p[2], p[3]); }
#pragma unroll
            for (int kb = 0; kb < 2; ++kb)
#pragma unroll
                for (int s2 = 0; s2 < 2; ++s2) { v4u bp; bp.x = xp[kb][4 * s2]; bp.y = xp[kb][4 * s2 + 1]; bp.z = xp[kb][4 * s2 + 2]; bp.w = xp[kb][4 * s2 + 3];
#pragma unroll
                    for (int d = 0; d < 2; ++d) { const bf16x8v Av = tr_frag_perm_p<VTP>(Vt, 32 * kb + 16 * s2 + 4 * hh, 32 * d + 16 * gsel, lane);
                        o[d] = __builtin_amdgcn_mfma_f32_32x32x16_bf16(Av, __builtin_bit_cast(bf16x8v, bp), o[d], 0, 0, 0); } }
            carry += tot;
            if (k0 <= 0) break;
            if (__all(carry > SB_THRESH)) break;
        }
#pragma unroll
        for (int d = 0; d < 2; ++d)
#pragma unroll
            for (int g4 = 0; g4 < 4; ++g4)
                *(LAS unsigned long long*)(Vt + r * 144 + (32 * d + 8 * g4 + 4 * hh) * 2) = (unsigned long long)pk2(o[d][4 * g4], o[d][4 * g4 + 1]) | ((unsigned long long)pk2(o[d][4 * g4 + 2], o[d][4 * g4 + 3]) << 32);
#pragma unroll
        for (int i = 0; i < 4; ++i) { const int row = (lane >> 3) + 8 * i;
            const v4u ov = *(const LAS v4u*)(Vt + row * 144 + (lane & 7) * 16);
            *(unsigned long long*)(mix8 + (size_t)(b * S + q0 + row) * D + h * 64 + (lane & 7) * 8) = (unsigned long long)pk4_fp8(bf2f(ov.x & 0xffffu), bf2f(ov.x >> 16), bf2f(ov.y & 0xffffu), bf2f(ov.y >> 16))
                | ((unsigned long long)pk4_fp8(bf2f(ov.z & 0xffffu), bf2f(ov.z >> 16), bf2f(ov.w & 0xffffu), bf2f(ov.w >> 16)) << 32); }
        prep_store(bgd, lane, bgv);
    }
}

__global__ void __launch_bounds__(NTHR, 2) mega_fwd(MArgs args) {
    extern __shared__ __attribute__((aligned(16))) unsigned char lds[];
    LAS unsigned char* ldsl = (LAS unsigned char*)lds;
    const int tid = threadIdx.x, G = gridDim.x;
    volatile LAS unsigned* MISC = (volatile LAS unsigned*)(ldsl + XTRA_OFF + X_MISC);
    LAS int* tb = (LAS int*)(ldsl + XTRA_OFF + X_TB); LAS int* nn = (LAS int*)(ldsl + XTRA_OFF + X_NN);
    for (int u = tid; u < (LDS_BYTES - XTRA_OFF) / 4; u += NTHR) ((LAS unsigned*)(ldsl + XTRA_OFF))[u] = 0u;
    __syncthreads();
    unsigned char* ws = args.ws;
    unsigned* ctl = (unsigned*)(ws + WS_CTL);
    XcdBarrier bar = xcd_barrier_post(ctl + CW_BAR, MISC + 8);
    const int lo = args.ph_lo, hi = args.ph_hi;
#define IN(k) (lo <= (k) && (k) < hi)
#ifndef REP_MASK
#define REP_MASK 0
#endif
#define PHASE(k, ...) do { if (IN(k)) { for (int rep_ = 0; rep_ < (((REP_MASK >> (k)) & 1) ? 2 : 1); ++rep_) { if (rep_) xcd_barrier(bar); __VA_ARGS__ } } if (IN(k) && IN((k) + 1)) xcd_barrier(bar); } while (0)
    int* cnt = (int*)ctl + CW_CNT; i32x2* list = (i32x2*)(ws + WS_ROUTE + 2 * MiB); float* topg = (float*)(ws + WS_ROUTE + 1 * MiB);
    PHASE(0, ph_mod_prep(args, lds, G););
    PHASE(1, ph_ln1(args, lds, G););
    PHASE(2, { pg8::StaticOrder So; So.init(ws + WS_U1, ws + WS_WTIN, T, NPROJ, D, G, blockIdx.x);
        pg8::EpiBf16 E{(bf16*)(ws + WS_PROJ), NPROJ, 2, QSCALE, 1.f / 64.f};
        pg8::gemm_phase<pg8::EpiBf16, pg8::StaticOrder, false, true>(ldsl, D, So, E); });
    PHASE(3, ml_phaseA(args, ldsl, blockIdx.x, G););
    PHASE(4, ml_phaseB(args, ldsl, blockIdx.x, G); __syncthreads(); attn_phase((const bf16*)(ws + WS_PROJ), (unsigned char*)(ws + WS_MIX), ldsl, blockIdx.x, G, MAKE_PREP_ARGS(args)););
    PHASE(5, ml_phaseC(args, ldsl, G););
    PHASE(6, { pg8::StaticOrder So; So.init(ws + WS_MIX, ws + WS_WTOUT, T, D, D, G, blockIdx.x);
        pg8::EpiBf16 E{(bf16*)(ws + WS_MIXOUT), D, 0, 1.f, 1.f / 64.f};
        pg8::gemm_phase<pg8::EpiBf16, pg8::StaticOrder, false, true>(ldsl, D, So, E); });
    PHASE(7, ph_ln2(args, G););
    PHASE(8, { pg8::StaticOrder So; So.init(ws + WS_U2, ws + WS_WTR, T, NE, 2 * D, G, blockIdx.x);
        pg8::EpiF32 E{(float*)(ws + WS_LOGITS), NE};
        pg8::gemm_phase<pg8::EpiF32, pg8::StaticOrder, false, false>(ldsl, 2 * D, So, E); });
    PHASE(9, { const int lane_ = tid & 63; const f32x4 bias4 = *(const f32x4*)(args.in[13] + 4 * lane_);
        for (int t = blockIdx.x * NWAVES + (tid >> 6); t < T; t += G * NWAVES) route_wave(t, lane_, (const float*)(ws + WS_LOGITS), bias4, (int*)(ws + WS_ROUTE), topg, cnt); });
    PHASE(10, { moe_tables(cnt, tb, nn); const int* tope = (const int*)(ws + WS_ROUTE); int* fill = (int*)ctl + CW_FILL;
        for (int id = blockIdx.x * NTHR + tid; id < T * TOPK; id += G * NTHR) { const int e = tope[id]; const int pos = atomicAdd(fill + e, 1);
            list[tb[e] * 256 + pos] = (i32x2){id, __float_as_int(topg[id])}; } });
    PHASE(11, { moe_tables(cnt, tb, nn);
        pg8::MoeOrder So{G, (int)blockIdx.x, tb[NEX] * 2, 1, tb, nn, list, (const char*)(ws + WS_U2F8), 0, (const char*)(ws + WS_WT13), (size_t)512 * D, (size_t)256 * D};
        pg8::EpiGlu E{(unsigned char*)(ws + WS_H), 1.f / 64.f};
        pg8::gemm_phase<pg8::EpiGlu, pg8::MoeOrder, true, true>(ldsl, D, So, E); });
    PHASE(12, { moe_tables(cnt, tb, nn);
        pg8::MoeOrder So{G, (int)blockIdx.x, tb[NEX] * 4, 2, tb, nn, list, (const char*)(ws + WS_H), (size_t)256 * FF, (const char*)(ws + WS_WT2), (size_t)D * FF, (size_t)256 * FF};
        pg8::EpiScatter E{(unsigned char*)(ws + WS_YS), (bf16*)(ws + WS_YSH), list, nn};
        pg8::gemm_phase<pg8::EpiScatter, pg8::MoeOrder, false, true>(ldsl, FF, So, E); });
    PHASE(13, ph_final(args, G););
#undef PHASE
#undef IN
}

#ifndef MK_UPTO
#define MK_UPTO 14
#endif
__global__ void k_nan_fill(float* out, int n) { for (int i = blockIdx.x * blockDim.x + threadIdx.x; i < n; i += gridDim.x * blockDim.x) out[i] = __builtin_nanf(""); }
extern "C" void kernel_launch(void* const* d_in, const int* in_sizes, int n_in, void* d_out, int out_size, void* d_ws, size_t ws_size, hipStream_t stream) {
    static int grid = 0;
    if (grid == 0) {
        int dev = 0, cus = 0, per_cu = 0; grid = -1;
        if (n_in != 22 || out_size != T * D || ws_size < WS_END) fprintf(stderr, "kernel_launch: unexpected shapes (n_in %d out %d ws %zu, need %zu)\n", n_in, out_size, ws_size, (size_t)WS_END);
        else if (hipGetDevice(&dev) != hipSuccess || hipDeviceGetAttribute(&cus, hipDeviceAttributeMultiprocessorCount, dev) != hipSuccess) fprintf(stderr, "kernel_launch: device query failed\n");
        else if (hipFuncSetAttribute((const void*)mega_fwd, hipFuncAttributeMaxDynamicSharedMemorySize, LDS_BYTES) != hipSuccess) fprintf(stderr, "kernel_launch: hipFuncSetAttribute failed\n");
        else if (hipOccupancyMaxActiveBlocksPerMultiprocessor(&per_cu, (const void*)mega_fwd, NTHR, LDS_BYTES) != hipSuccess || per_cu < 1) fprintf(stderr, "kernel_launch: occupancy query says %d blocks per CU\n", per_cu);
        else grid = cus;
        (void)hipGetLastError();
    }
    if (grid < 0) { k_nan_fill<<<1024, 256, 0, stream>>>((float*)d_out, out_size); return; }
    const float* x = (const float*)d_in[0];
    const float* conv_w = (const float*)d_in[5]; const float* conv_b = (const float*)d_in[6];
    const float* norm_g = (const float*)d_in[8]; const float* ln1_g = (const float*)d_in[10]; const float* ln1_b = (const float*)d_in[11];
    const float* rbias = (const float*)d_in[13]; const float* ln2_g = (const float*)d_in[20]; const float* ln2_b = (const float*)d_in[21];
    char* ws = (char*)d_ws; float* out = (float*)d_out;
    float* mod = (float*)(ws + WS_MOD); bf16* wtin = (bf16*)(ws + WS_WTIN); bf16* wtout = (bf16*)(ws + WS_WTOUT); bf16* wtr = (bf16*)(ws + WS_WTR);
    bf16* wt13 = (bf16*)(ws + WS_WT13); bf16* wt2 = (bf16*)(ws + WS_WT2); int* plan = (int*)(ws + WS_PLAN);
    bf16* u1 = (bf16*)(ws + WS_U1); bf16* proj = (bf16*)(ws + WS_PROJ); float* ipre = (float*)(ws + WS_GATES); float* logf = ipre + 16 * S;
    float* hraw = (float*)(ws + WS_HRAW); bf16* mix = (bf16*)(ws + WS_MIX); bf16* mixout = (bf16*)(ws + WS_MIXOUT); bf16* u2 = (bf16*)(ws + WS_U2);
    float* logits = (float*)(ws + WS_LOGITS); int* tope = (int*)(ws + WS_ROUTE); float* topg = (float*)(ws + WS_ROUTE + 1 * MiB); i32x2* list = (i32x2*)(ws + WS_ROUTE + 2 * MiB);
    bf16* H = (bf16*)(ws + WS_H); bf16* ys = (bf16*)(ws + WS_YS); bf16* ysh = (bf16*)(ws + WS_YSH);
    int* cnt = (int*)(ws + WS_CTL) + CW_CNT;
    (void)hipMemsetAsync(ws + WS_CTL, 0, 1 * MiB, stream);
    if (MK_UPTO > 0) {
        MArgs a{};
        for (int i = 0; i < 22; ++i) a.in[i] = (const float*)d_in[i];
        a.out = out; a.ws = (unsigned char*)d_ws; a.ph_lo = 0; a.ph_hi = MK_UPTO;
        hipLaunchKernelGGL(mega_fwd, dim3(grid), dim3(NTHR), LDS_BYTES, stream, a);
    }
}
```

```cpp
#include <hip/hip_runtime.h>
#include <cstdio>
#include <cstdint>

typedef unsigned short bf16;
typedef unsigned v4u __attribute__((ext_vector_type(4)));
typedef float f32x4 __attribute__((ext_vector_type(4)));
typedef int i32x2 __attribute__((ext_vector_type(2)));
typedef float f32x2 __attribute__((ext_vector_type(2)));

constexpr int D = 1024, NB = 4, S = 8192, T = NB * S;
constexpr int NPROJ = 3584, WIN_LD = 3592;
constexpr int C_SBQ = 0, C_SBK = 512, C_SBV = 1024, C_MLQ = 1536, C_MLK = 2048, C_MLV = 2560, C_MLO = 3072, C_GATE = 3584;
constexpr int NE = 256, NEX = 257, TOPK = 8, FF = 256;
constexpr float LN_EPS = 1e-5f;
constexpr float DN_ALPHA = 1.189207115002721f;
constexpr float LOG2E = 1.4426950408889634f;
constexpr float QSCALE = 0.125f * LOG2E;
constexpr float SB_THRESH = 48.0f;

constexpr size_t MiB = 1u << 20;
constexpr size_t WS_CTL = 0;
constexpr size_t WS_MOD = 1 * MiB;
constexpr size_t WS_WTIN = 2 * MiB;
constexpr size_t WS_WTOUT = 10 * MiB;
constexpr size_t WS_WTR = 12 * MiB;
constexpr size_t WS_PLAN = 13 * MiB;
constexpr size_t WS_WT2 = 16 * MiB;
constexpr size_t WS_YS = 145 * MiB;
constexpr size_t WS_WT13 = 145 * MiB;
constexpr size_t WS_U2F8 = 274 * MiB;
constexpr size_t WS_PROJ = 402 * MiB;
constexpr size_t WS_GATES = 626 * MiB;
constexpr size_t WS_H = 402 * MiB;
constexpr size_t WS_X1 = 757 * MiB;
constexpr size_t WS_STATES = 657 * MiB;
constexpr size_t WS_MIXOUT = 657 * MiB;
constexpr size_t WS_LOGITS = 657 * MiB;
constexpr size_t WS_U1 = 725 * MiB;
constexpr size_t WS_MIX = 725 * MiB;
constexpr size_t WS_U2 = 833 * MiB;
constexpr size_t WS_YSH = 833 * MiB;
constexpr size_t WS_HRAW = 833 * MiB;
constexpr size_t WS_ROUTE = 897 * MiB;
constexpr size_t WS_END = 902 * MiB;
constexpr int CW_CNT = 1024;
constexpr int CW_FILL = 1536;
constexpr int PL_SLOT = 0, PL_T64 = 512, PL_T256 = 1024;

__device__ __forceinline__ unsigned f2bf(float f) { unsigned u = __builtin_bit_cast(unsigned, f); return (u + 0x7fffu + ((u >> 16) & 1u)) >> 16; }
__device__ __forceinline__ float bf2f(unsigned b) { return __builtin_bit_cast(float, b << 16); }
__device__ __forceinline__ unsigned pk2(float lo, float hi) { return f2bf(lo) | (f2bf(hi) << 16); }
__device__ __forceinline__ unsigned pk4_fp8(float a, float b, float c, float d) { int w = 0; w = __builtin_amdgcn_cvt_pk_fp8_f32(a, b, w, false); w = __builtin_amdgcn_cvt_pk_fp8_f32(c, d, w, true); return (unsigned)w; }
__device__ __forceinline__ float wave_sum(float v) {
    v += __builtin_bit_cast(float, __builtin_amdgcn_update_dpp(0, __builtin_bit_cast(int, v), 0xB1, 0xF, 0xF, true));
    v += __builtin_bit_cast(float, __builtin_amdgcn_update_dpp(0, __builtin_bit_cast(int, v), 0x4E, 0xF, 0xF, true));
    v += __builtin_bit_cast(float, __builtin_amdgcn_update_dpp(0, __builtin_bit_cast(int, v), 0x141, 0xF, 0xF, true));
    v += __builtin_bit_cast(float, __builtin_amdgcn_update_dpp(0, __builtin_bit_cast(int, v), 0x140, 0xF, 0xF, true));
    const int iv = __builtin_bit_cast(int, v);
    const float r0 = __builtin_bit_cast(float, __builtin_amdgcn_readlane(iv, 0)), r1 = __builtin_bit_cast(float, __builtin_amdgcn_readlane(iv, 16));
    const float r2 = __builtin_bit_cast(float, __builtin_amdgcn_readlane(iv, 32)), r3 = __builtin_bit_cast(float, __builtin_amdgcn_readlane(iv, 48));
    return (r0 + r1) + (r2 + r3);
}
__device__ __forceinline__ float sigmoidf_(float x) { return 1.f / (1.f + __expf(-x)); }
__device__ __forceinline__ float siluf_(float x) { return x / (1.f + __expf(-x)); }


struct PrepArgs { const float *w_in, *w_out, *w_router, *w1, *w3, *w2, *sw1, *sw3, *sw2; unsigned char* wtin; bf16 *wtout, *wtr; unsigned char* wt13; unsigned char* wt2; };
struct PrepDesc { const float* src; unsigned char* dst; int ldw, ldt, k0, n0, rowmap, f8; };
constexpr int IT_IN = 16 * 56, IT_OUT = 16 * 16, IT_R = 16 * 4, IT_E = 192, IT_TOTAL = IT_IN + IT_OUT + IT_R + NEX * IT_E;
__device__ __forceinline__ PrepDesc prep_decode(const PrepArgs& a, int it) {
    if (it < IT_IN) return PrepDesc{a.w_in, a.wtin, WIN_LD, D, (it / 112) * 128, (it % 112) * 32, 0, 1}; it -= IT_IN;
    if (it < IT_OUT) return PrepDesc{a.w_out, (unsigned char*)a.wtout, D, D, (it / 32) * 128, (it % 32) * 32, 0, 1}; it -= IT_OUT;
    if (it < IT_R) return PrepDesc{a.w_router, (unsigned char*)a.wtr, NE, D, (it / 4) * 64, (it % 4) * 64, 0, 0}; it -= IT_R;
    const int e = it / IT_E, r = it % IT_E;
    if (r < 64) return PrepDesc{e < NE ? a.w1 + (size_t)e * D * FF : a.sw1, a.wt13 + (size_t)e * 512 * D, FF, D, (r / 8) * 128, (r % 8) * 32, 1, 1};
    if (r < 128) { const int q = r - 64; return PrepDesc{e < NE ? a.w3 + (size_t)e * D * FF : a.sw3, a.wt13 + (size_t)e * 512 * D, FF, D, (q / 8) * 128, (q % 8) * 32, 2, 1}; }
    const int q = r - 128; return PrepDesc{e < NE ? a.w2 + (size_t)e * FF * D : a.sw2, a.wt2 + (size_t)e * D * FF, D, FF, (q / 32) * 128, (q % 32) * 32, 0, 1};
}
__device__ __forceinline__ void prep_load(const PrepDesc& d, int lane, f32x4 (&v)[16]) {
    const int g = d.f8 ? (lane >> 3) : (lane >> 4), i = d.f8 ? (lane & 7) : (lane & 15);
#pragma unroll
    for (int r = 0; r < 16; ++r) v[r] = __builtin_nontemporal_load((const f32x4*)(d.src + (size_t)(d.k0 + 16 * g + r) * d.ldw + d.n0 + 4 * i));
}
__device__ __forceinline__ void prep_store(const PrepDesc& d, int lane, const f32x4 (&v)[16]) {
    const int g = d.f8 ? (lane >> 3) : (lane >> 4), i = d.f8 ? (lane & 7) : (lane & 15);
#pragma unroll
    for (int nn = 0; nn < 4; ++nn) {
        const int n = d.n0 + 4 * i + nn;
        const int dr = d.rowmap == 0 ? n : ((n >> 7) * 256 + (d.rowmap == 2 ? 128 : 0) + (n & 127));
        if (d.f8) {
            v4u o; o.x = pk4_fp8(v[0][nn] * 64.f, v[1][nn] * 64.f, v[2][nn] * 64.f, v[3][nn] * 64.f); o.y = pk4_fp8(v[4][nn] * 64.f, v[5][nn] * 64.f, v[6][nn] * 64.f, v[7][nn] * 64.f);
            o.z = pk4_fp8(v[8][nn] * 64.f, v[9][nn] * 64.f, v[10][nn] * 64.f, v[11][nn] * 64.f); o.w = pk4_fp8(v[12][nn] * 64.f, v[13][nn] * 64.f, v[14][nn] * 64.f, v[15][nn] * 64.f);
            *(v4u*)(d.dst + (size_t)dr * d.ldt + d.k0 + 16 * g) = o;
        } else {
            v4u o0, o1; o0.x = pk2(v[0][nn], v[1][nn]); o0.y = pk2(v[2][nn], v[3][nn]); o0.z = pk2(v[4][nn], v[5][nn]); o0.w = pk2(v[6][nn], v[7][nn]);
            o1.x = pk2(v[8][nn], v[9][nn]); o1.y = pk2(v[10][nn], v[11][nn]); o1.z = pk2(v[12][nn], v[13][nn]); o1.w = pk2(v[14][nn], v[15][nn]);
            v4u* dp = (v4u*)((bf16*)d.dst + (size_t)dr * d.ldt + d.k0 + 16 * g); dp[0] = o0; dp[1] = o1;
        }
    }
}
constexpr int IT_SMALL = IT_IN + IT_OUT + IT_R;
constexpr int BG_A = 16 * (S / 64) * 8, BG_C = BG_A, BG_T = NB * 8 * (S / 32), BG_TOTAL = BG_A + BG_C + BG_T;
constexpr int IT_FG = IT_SMALL;
static_assert(IT_SMALL + BG_TOTAL <= IT_TOTAL, "background slots exceed the expert items");
__device__ __forceinline__ int prep_fg_item(int j) { return j < IT_SMALL ? j : j + BG_TOTAL; }
__device__ __forceinline__ void prep_run(const PrepArgs& a, int it0, int stride, int lane) {
    int it = it0; if (it >= IT_FG) return;
    PrepDesc dA = prep_decode(a, prep_fg_item(it)), dB = dA; f32x4 va[16], vb[16]; prep_load(dA, lane, va);
    for (;;) {
        const int itB = it + stride; const bool hasB = itB < IT_FG;
        if (hasB) { dB = prep_decode(a, prep_fg_item(itB)); prep_load(dB, lane, vb); }
        prep_store(dA, lane, va);
        if (!hasB) break;
        const int itA = itB + stride; const bool hasA = itA < IT_FG;
        if (hasA) { dA = prep_decode(a, prep_fg_item(itA)); prep_load(dA, lane, va); }
        prep_store(dB, lane, vb);
        if (!hasA) break;
        it = itA;
    }
}


__device__ __forceinline__ f32x4 ld_bf4(const bf16* p) { const unsigned long long w = *(const unsigned long long*)p;
    return (f32x4){bf2f((unsigned)w & 0xffffu), bf2f(((unsigned)w) >> 16), bf2f((unsigned)(w >> 32) & 0xffffu), bf2f((unsigned)(w >> 48))}; }

#define LAS __attribute__((address_space(3)))
#define GAS __attribute__((address_space(1)))
namespace pg8 {
typedef short bf16x8 __attribute__((ext_vector_type(8)));
constexpr int F8_SCALE_W = 121;
constexpr int BM = 256, BK = 64, HALF = 128, HTB = HALF * BK * 2, STAGE_BYTES = 8 * HTB, NXCD = 8, WGM = 8;
__host__ __device__ __forceinline__ int lds_byte(int r, int c) { const int st = (r >> 4) * 2 + (c >> 5), rr = r & 15, cc = c & 31, ob = rr * 64 + cc * 2; return st * 1024 + (ob ^ (((ob >> 9) & 1) << 5)); }
__host__ __device__ __forceinline__ void stage_rc(int b, int& R, int& C) { const int st = b / 1024, sb = b % 1024, swz = sb ^ (((sb >> 9) & 1) << 5); R = (st >> 1) * 16 + swz / 64; C = (st & 1) * 32 + (swz % 64) / 2; }
__host__ __device__ __forceinline__ int perm16x(int R) { return 64 * (R >> 5) + 16 * ((R & 15) >> 2) + 4 * ((R >> 4) & 1) + (R & 3); }
__host__ __device__ __forceinline__ int perm32(int rho) { const int n = rho >> 4, i = rho & 15; return 8 * (i >> 2) + 4 * n + (i & 3); }

struct Unit { int pm, pn, e, mt; const char* A; const char* B; };

__device__ __forceinline__ long unit_index(int i, int G, int c) { return (G % 8 == 0) ? ((long)(i * 8 + (c & 7)) * (G / 8) + (c >> 3)) : ((long)i * G + c); }

struct StaticOrder {
    int nM, nN, nwg, G, c; const char* A; const char* B; size_t tstep;
    __device__ void init(const void* A_, const void* B_, int M, int N, int Kb, int G_, int c_) { nM = M / BM; nN = N / BM; nwg = nM * nN; G = G_; c = c_; A = (const char*)A_; B = (const char*)B_; tstep = (size_t)BM * Kb; }
    __device__ __forceinline__ bool next(int i, Unit& u) const {
        const long L = (long)i * G + c; if (L >= nwg) return false;
        int wgid = (int)L; { const int q = nwg / NXCD, r = nwg % NXCD, xcd = wgid % NXCD, off = wgid / NXCD; wgid = (xcd < r ? xcd * (q + 1) : r * (q + 1) + (xcd - r) * q) + off; }
        const int nig = WGM * nN, gid = wgid / nig, fm = gid * WGM, gsz = (nM - fm) < WGM ? (nM - fm) : WGM;
        u.pm = fm + ((wgid % nig) % gsz); u.pn = (wgid % nig) / gsz; u.e = 0; u.mt = u.pm; u.A = A + (size_t)u.pm * tstep; u.B = B + (size_t)u.pn * tstep; return true;
    }
    __device__ __forceinline__ int row_token(const Unit&, int) const { return 0; }
};

struct MoeOrder {
    int G, c, total, shift; const LAS int* tb; const LAS int* nn; const i32x2* list;
    const char* Abase; size_t a_tile_stride; const char* Bbase; size_t b_exp_stride, b_pn_stride;
    __device__ __forceinline__ bool next(int i, Unit& u) const {
        const long L = unit_index(i, G, c); if (L >= total) return false;
        const int tile = (int)(L >> shift); u.pn = (int)(L & ((1 << shift) - 1));
        int lo = 0, hi = NEX; while (hi - lo > 1) { const int mid = (lo + hi) >> 1; if (tb[mid] <= tile) lo = mid; else hi = mid; }
        u.e = lo; u.mt = tile - tb[lo]; u.pm = tile;
        u.A = Abase + (size_t)tile * a_tile_stride; u.B = Bbase + (size_t)lo * b_exp_stride + (size_t)u.pn * b_pn_stride; return true;
    }
    __device__ __forceinline__ int row_token(const Unit& u, int row) const {
        const int rr = u.mt * 256 + row;
        const int tok = list[u.pm * 256 + row].x >> 3;
        return u.e >= NE ? rr : (rr < nn[u.e] ? tok : 0);
    }
};

__device__ __forceinline__ unsigned cvt_pk_bf16(float lo, float hi) { unsigned r; asm volatile("v_cvt_pk_bf16_f32 %0, %1, %2" : "=v"(r) : "v"(lo), "v"(hi)); return r; }

struct EpiBf16 {
    static constexpr int PERM = 2; bf16* O; int ldc; int scale_tiles; float scale; float gscale;
    __device__ __forceinline__ void operator()(const f32x4 (&acc)[2][2][4][2], const Unit& u, int wr, int wc, int fr, int fq) const {
        const int row0 = u.pm * BM + wr * 64 + fr, col0 = u.pn * BM + wc * 64 + 16 * fq; const float sc = (u.pn < scale_tiles ? scale : 1.f) * gscale;
#pragma unroll
        for (int ai = 0; ai < 2; ++ai)
#pragma unroll
            for (int m = 0; m < 4; ++m) { bf16* rowp = O + (size_t)(row0 + ai * HALF + m * 16) * ldc + col0;
#pragma unroll
                for (int bj = 0; bj < 2; ++bj) { const f32x4 v0 = acc[ai][bj][m][0] * sc, v1 = acc[ai][bj][m][1] * sc;
                    v4u w; w.x = cvt_pk_bf16(v0[0], v0[1]); w.y = cvt_pk_bf16(v0[2], v0[3]); w.z = cvt_pk_bf16(v1[0], v1[1]); w.w = cvt_pk_bf16(v1[2], v1[3]);
                    *(v4u*)(rowp + bj * 8) = w; } }
    }
};
struct EpiF32 {
    static constexpr int PERM = 0; float* C; int ldc;
    __device__ __forceinline__ void operator()(const f32x4 (&acc)[2][2][4][2], const Unit& u, int wr, int wc, int fr, int fq) const {
        const int row0 = u.pm * BM + wr * 64 + fr, col0 = u.pn * BM + wc * 32 + 4 * fq;
#pragma unroll
        for (int ai = 0; ai < 2; ++ai)
#pragma unroll
            for (int m = 0; m < 4; ++m) { float* rowp = C + (size_t)(row0 + ai * HALF + m * 16) * ldc + col0;
#pragma unroll
                for (int bj = 0; bj < 2; ++bj)
#pragma unroll
                    for (int n = 0; n < 2; ++n) *(f32x4*)(rowp + bj * HALF + n * 16) = acc[ai][bj][m][n]; }
    }
};
struct EpiGlu {
    static constexpr int PERM = 1; unsigned char* H; float gscale;
    __device__ __forceinline__ void operator()(const f32x4 (&acc)[2][2][4][2], const Unit& u, int wr, int wc, int fr, int fq) const {
        const int row0 = u.pm * BM + wr * 64 + fr, col0 = u.pn * HALF + wc * 32 + 8 * fq;
#pragma unroll
        for (int ai = 0; ai < 2; ++ai)
#pragma unroll
            for (int m = 0; m < 4; ++m) { float h[8];
#pragma unroll
                for (int n = 0; n < 2; ++n)
#pragma unroll
                    for (int q = 0; q < 4; ++q) { const float a = acc[ai][0][m][n][q] * gscale; h[n * 4 + q] = a * __builtin_amdgcn_rcpf(1.f + __expf(-a)) * (acc[ai][1][m][n][q] * gscale); }
                *(unsigned long long*)(H + (size_t)(row0 + ai * HALF + m * 16) * FF + col0) = (unsigned long long)pk4_fp8(h[0], h[1], h[2], h[3]) | ((unsigned long long)pk4_fp8(h[4], h[5], h[6], h[7]) << 32); }
    }
};
struct EpiScatter {
    static constexpr int PERM = 2; unsigned char* ys8; bf16* ysh; const i32x2* list; const LAS int* nn;
    __device__ __forceinline__ void operator()(const f32x4 (&acc)[2][2][4][2], const Unit& u, int wr, int wc, int fr, int fq) const {
        const int col0 = u.pn * BM + wc * 64 + 16 * fq; const int n = nn[u.e]; const bool routed = u.e < NE;
        const i32x2* lp = list + (size_t)(u.pm - u.mt) * 256;
#pragma unroll
        for (int ai = 0; ai < 2; ++ai) {
            i32x2 en[4];
#pragma unroll
            for (int m = 0; m < 4; ++m) { const int rr = u.mt * 256 + ai * HALF + wr * 64 + m * 16 + fr; const i32x2 ld = lp[rr];
                en[m].x = routed ? ld.x : rr; en[m].y = routed ? ld.y : 0x3f800000; }
#pragma unroll
            for (int m = 0; m < 4; ++m) { const int rr = u.mt * 256 + ai * HALF + wr * 64 + m * 16 + fr;
                if (rr < n) {
                    if (routed) { const float g = __int_as_float(en[m].y) * (16.f / 64.f);
                        const f32x4 a0 = acc[ai][0][m][0] * g, a1 = acc[ai][0][m][1] * g, b0 = acc[ai][1][m][0] * g, b1 = acc[ai][1][m][1] * g;
                        v4u w; w.x = pk4_fp8(a0[0], a0[1], a0[2], a0[3]); w.y = pk4_fp8(a1[0], a1[1], a1[2], a1[3]); w.z = pk4_fp8(b0[0], b0[1], b0[2], b0[3]); w.w = pk4_fp8(b1[0], b1[1], b1[2], b1[3]);
                        *(v4u*)(ys8 + (size_t)en[m].x * D + col0) = w; }
                    else { bf16* dst = ysh + (size_t)rr * D + col0;
#pragma unroll
                        for (int bj = 0; bj < 2; ++bj) { const f32x4 v0 = acc[ai][bj][m][0] * (1.f / 64.f), v1 = acc[ai][bj][m][1] * (1.f / 64.f);
                            v4u w; w.x = cvt_pk_bf16(v0[0], v0[1]); w.y = cvt_pk_bf16(v0[2], v0[3]); w.z = cvt_pk_bf16(v1[0], v1[1]); w.w = cvt_pk_bf16(v1[2], v1[3]);
                            *(v4u*)(dst + bj * 8) = w; } } } }
            __builtin_amdgcn_sched_barrier(0);
        }
    }
};

typedef int i32x8 __attribute__((ext_vector_type(8)));
typedef int i32x4 __attribute__((ext_vector_type(4)));
template <bool FP8> struct FragT { struct A4 { bf16x8 v[4][2]; }; struct B2 { bf16x8 v[2][2]; }; };
template <> struct FragT<true> { struct A4 { i32x8 v[4]; }; struct B2 { i32x8 v[2]; }; };
template <class Epi, class Sched, bool GATHER, bool FP8>
__device__ __forceinline__ void gemm_phase(LAS unsigned char* lds, const int Kb, const Sched& S, const Epi& E) {
    const int tid = threadIdx.x, wid = __builtin_amdgcn_readfirstlane(tid >> 6), lane = tid & 63, wr = wid >> 2, wc = wid & 3, fr = lane & 15, fq = lane >> 4;
    const int nt = Kb / 128;
    int sR[2], sC[2];
    unsigned voffA[2], voffB[2];
#pragma unroll
    for (int i = 0; i < 2; ++i) { stage_rc(tid * 16 + i * 8192, sR[i], sC[i]); const int Rb = Epi::PERM == 2 ? perm16x(sR[i]) : (Epi::PERM == 1 ? ((sR[i] & ~31) + perm32(sR[i] & 31)) : sR[i]);
        voffA[i] = (unsigned)(sR[i] * Kb + sC[i] * 2); voffB[i] = (unsigned)(Rb * Kb + sC[i] * 2); }
    const size_t kstep = (size_t)(BK * 2);
    const size_t hstep = (size_t)HALF * Kb;
    const size_t bhstep = Epi::PERM == 2 ? (size_t)8 * Kb : hstep;
    const unsigned ldsw = (unsigned)wid * 1024u;
    const int aoff = lds_byte(wr * 64 + fr, fq * 8), boff = lds_byte(wc * 32 + fr, fq * 8);
    unsigned gc[2][2], gn[2][2];
#define PG8_SA(b, h) (((b) * 2 + (h)) * HTB)
#define PG8_SB(b, h) ((4 + (b) * 2 + (h)) * HTB)
#define PG8_GLDS(src, bufoff, i) __builtin_amdgcn_global_load_lds((const unsigned*)(src), (LAS unsigned*)(lds + (bufoff) + ldsw + (i) * 8192), 16, 0, 0)
#define PG8_STAGE_B(bufoff, gbase) do { PG8_GLDS((const char*)(gbase) + voffB[0], bufoff, 0); PG8_GLDS((const char*)(gbase) + voffB[1], bufoff, 1); } while (0)
#define PG8_STAGE_A(bufoff, gbase, h, nx) do { if constexpr (GATHER) { const unsigned _o0 = (nx) ? gn[h][0] : gc[h][0], _o1 = (nx) ? gn[h][1] : gc[h][1]; \
            PG8_GLDS((const char*)(gbase) + _o0, bufoff, 0); PG8_GLDS((const char*)(gbase) + _o1, bufoff, 1); } \
        else { PG8_GLDS((const char*)(gbase) + (h) * hstep + voffA[0], bufoff, 0); PG8_GLDS((const char*)(gbase) + (h) * hstep + voffA[1], bufoff, 1); } } while (0)
#define PG8_LD2(dstv, p) do { if constexpr (FP8) { const i32x4 _lo = *(const LAS i32x4*)(p), _hi = *(const LAS i32x4*)((p) + 1024); dstv = __builtin_shufflevector(_lo, _hi, 0, 1, 2, 3, 4, 5, 6, 7); } } while (0)
#define PG8_LDA(dst, b, h) do { _Pragma("unroll") for (int m = 0; m < 4; ++m) { if constexpr (FP8) { PG8_LD2(dst.v[m], lds + PG8_SA(b, h) + aoff + m * 2048); } \
        else { _Pragma("unroll") for (int k = 0; k < 2; ++k) dst.v[m][k] = *(const LAS bf16x8*)(lds + PG8_SA(b, h) + aoff + m * 2048 + k * 1024); } } } while (0)
#define PG8_LDB(dst, b, h) do { _Pragma("unroll") for (int n = 0; n < 2; ++n) { if constexpr (FP8) { PG8_LD2(dst.v[n], lds + PG8_SB(b, h) + boff + n * 2048); } \
        else { _Pragma("unroll") for (int k = 0; k < 2; ++k) dst.v[n][k] = *(const LAS bf16x8*)(lds + PG8_SB(b, h) + boff + n * 2048 + k * 1024); } } } while (0)
#define PG8_MMA(ai, bj, At, Bt) do { __builtin_amdgcn_s_setprio(1); _Pragma("unroll") for (int m = 0; m < 4; ++m) _Pragma("unroll") for (int n = 0; n < 2; ++n) { \
        if constexpr (FP8) asm volatile("s_nop 1\n\tv_mfma_scale_f32_16x16x128_f8f6f4 %0, %1, %2, %0, %3, %3 op_sel_hi:[0,0,0]" : "+v"(acc[ai][bj][m][n]) : "v"(Bt.v[n]), "v"(At.v[m]), "v"(f8scale)); \
        else { _Pragma("unroll") for (int k = 0; k < 2; ++k) acc[ai][bj][m][n] = __builtin_amdgcn_mfma_f32_16x16x32_bf16(Bt.v[n][k], At.v[m][k], acc[ai][bj][m][n], 0, 0, 0); } } \
        __builtin_amdgcn_s_setprio(0); } while (0)
#define PG8_WAIT_V(n) asm volatile("s_waitcnt vmcnt(" #n ")" ::: "memory")
#define PG8_WAIT_L(n) asm volatile("s_waitcnt lgkmcnt(" #n ")" ::: "memory")
#define PG8_BAR __builtin_amdgcn_s_barrier()
#define PG8_SCHED __builtin_amdgcn_sched_barrier(0)
#define PG8_GATHER(dst, u) do { _Pragma("unroll") for (int _h = 0; _h < 2; ++_h) _Pragma("unroll") for (int _i = 0; _i < 2; ++_i) \
        dst[_h][_i] = (unsigned)(S.row_token(u, _h * HALF + sR[_i]) * Kb + sC[_i] * 2); } while (0)
    Unit cur, nxt; int ui = 0;
    if (!S.next(0, cur)) return;
    f32x4 acc[2][2][4][2];
#pragma unroll
    for (int a = 0; a < 2; ++a)
#pragma unroll
        for (int b = 0; b < 2; ++b)
#pragma unroll
            for (int m = 0; m < 4; ++m)
#pragma unroll
                for (int n = 0; n < 2; ++n) acc[a][b][m][n] = (f32x4){0.f, 0.f, 0.f, 0.f};
    const int f8scale = 0x7f7f7f7f;
    typedef typename FragT<FP8>::A4 FragA; typedef typename FragT<FP8>::B2 FragB;
    FragA At; FragB B0, B1;
    const char* cA = cur.A; const char* cB = cur.B;
    if constexpr (GATHER) { PG8_GATHER(gc, cur); }
    PG8_STAGE_B(PG8_SB(0, 0), cB); PG8_STAGE_A(PG8_SA(0, 0), cA, 0, false); PG8_STAGE_B(PG8_SB(0, 1), cB + bhstep); PG8_STAGE_A(PG8_SA(0, 1), cA, 1, false);
    if (wr == 1) PG8_BAR;
    PG8_WAIT_V(4); PG8_BAR;
    PG8_STAGE_B(PG8_SB(1, 0), cB + kstep); PG8_STAGE_A(PG8_SA(1, 0), cA + kstep, 0, false); PG8_STAGE_B(PG8_SB(1, 1), cB + bhstep + kstep);
    PG8_WAIT_V(6); PG8_BAR;
    for (;;) {
        const bool has_next = S.next(ui + 1, nxt);
        const char* nA = has_next ? nxt.A : cA; const char* nB = has_next ? nxt.B : cB;
        if constexpr (GATHER) { if (has_next) { PG8_GATHER(gn, nxt); } else {
#pragma unroll
            for (int h = 0; h < 2; ++h) { gn[h][0] = gc[h][0]; gn[h][1] = gc[h][1]; } } }
#pragma unroll 1
        for (int t = 0; t < nt; t += 2) {
            const bool last = (t == nt - 2);
            const char* a1 = cA + (size_t)(t + 1) * kstep;
            const char* a2 = last ? nA : cA + (size_t)(t + 2) * kstep; const char* b2 = last ? nB : cB + (size_t)(t + 2) * kstep;
            const char* a3 = a2 + kstep; const char* b3 = b2 + kstep;
            PG8_LDB(B0, 0, 0); PG8_SCHED; PG8_LDA(At, 0, 0); PG8_STAGE_A(PG8_SA(1, 1), a1, 1, false);
            PG8_WAIT_L(8); PG8_BAR; PG8_WAIT_L(0); PG8_MMA(0, 0, At, B0); PG8_BAR; PG8_SCHED;
            PG8_LDB(B1, 0, 1); PG8_STAGE_B(PG8_SB(0, 0), b2);
            PG8_BAR; PG8_WAIT_L(0); PG8_MMA(0, 1, At, B1); PG8_BAR;
            PG8_LDA(At, 0, 1); PG8_STAGE_A(PG8_SA(0, 0), a2, 0, last);
            PG8_BAR; PG8_WAIT_L(0); PG8_MMA(1, 0, At, B0); PG8_BAR; PG8_SCHED;
            PG8_STAGE_B(PG8_SB(0, 1), b2 + bhstep);
            PG8_WAIT_V(6); PG8_BAR; PG8_MMA(1, 1, At, B1); PG8_BAR;
            PG8_LDB(B0, 1, 0); PG8_SCHED; PG8_LDA(At, 1, 0); PG8_STAGE_A(PG8_SA(0, 1), a2, 1, last);
            PG8_WAIT_L(8); PG8_BAR; PG8_WAIT_L(0); PG8_MMA(0, 0, At, B0); PG8_BAR; PG8_SCHED;
            PG8_LDB(B1, 1, 1); PG8_STAGE_B(PG8_SB(1, 0), b3);
            PG8_BAR; PG8_WAIT_L(0); PG8_MMA(0, 1, At, B1); PG8_BAR;
            PG8_LDA(At, 1, 1); PG8_STAGE_A(PG8_SA(1, 0), a3, 0, last);
            PG8_BAR; PG8_WAIT_L(0); PG8_MMA(1, 0, At, B0); PG8_BAR; PG8_SCHED;
            PG8_STAGE_B(PG8_SB(1, 1), b3 + bhstep);
            PG8_WAIT_V(6); PG8_BAR; PG8_MMA(1, 1, At, B1); PG8_BAR;
        }
        if (wr == 0) PG8_BAR;
        if constexpr (FP8) { __builtin_amdgcn_sched_barrier(0); asm volatile("s_nop 15\n\ts_nop 7" ::: "memory"); __builtin_amdgcn_sched_barrier(0); }
        E(acc, cur, wr, wc, fr, fq);
        if (!has_next) break;
#pragma unroll
        for (int a = 0; a < 2; ++a)
#pragma unroll
            for (int b = 0; b < 2; ++b)
#pragma unroll
                for (int m = 0; m < 4; ++m)
#pragma unroll
                    for (int n = 0; n < 2; ++n) acc[a][b][m][n] = (f32x4){0.f, 0.f, 0.f, 0.f};
        cur = nxt; cA = nA; cB = nB; ++ui;
        if (wr == 1) PG8_BAR;
        if constexpr (GATHER) {
#pragma unroll
            for (int h = 0; h < 2; ++h) { gc[h][0] = gn[h][0]; gc[h][1] = gn[h][1]; } }
    }
    PG8_WAIT_V(0);
    PG8_BAR;
#undef PG8_SA
#undef PG8_SB
#undef PG8_GLDS
#undef PG8_STAGE_A
#undef PG8_STAGE_B
#undef PG8_LDA
#undef PG8_LDB
#undef PG8_MMA
#undef PG8_WAIT_V
#undef PG8_WAIT_L
#undef PG8_BAR
#undef PG8_SCHED
#undef PG8_GATHER
}
}

#define XB_TMO      128
#define XB_XCNT(j)  (256  + 64 * (j))
#define XB_XSUB(j)  (1280 + 64 * (j))
#define XB_XGEN(j)  (2304 + 64 * (j))
#define XB_TOP      3328
#define XB_TOPGEN   3392
#define XCD_BAR_WORDS 3456
#define XB_SPIN_CAP (1u << 22)
__device__ __forceinline__ unsigned xb_ld(unsigned* p)              { return __hip_atomic_load(p, __ATOMIC_RELAXED, __HIP_MEMORY_SCOPE_AGENT); }
__device__ __forceinline__ unsigned xb_add(unsigned* p, unsigned v) { return __hip_atomic_fetch_add(p, v, __ATOMIC_RELAXED, __HIP_MEMORY_SCOPE_AGENT); }
__device__ __forceinline__ unsigned xb_xcc_id() { return (unsigned)__builtin_amdgcn_s_getreg((3 << 11) | 20) & 0xFu; }
#define XB_SPIN(cond, bar) do { unsigned _sp = 0; while (cond) { __builtin_amdgcn_s_sleep(1); \
    if ((++_sp & 255u) == 0u) { if (xb_ld(&(bar)[XB_TMO])) break; if (_sp > XB_SPIN_CAP) { atomicAdd(&(bar)[XB_TMO], 1u); break; } } } } while (0)
struct XcdBarrier { unsigned* bar; unsigned x; volatile LAS unsigned* st; };
__device__ __forceinline__ XcdBarrier xcd_barrier_post(unsigned* bar, volatile LAS unsigned* st) {
    XcdBarrier b; b.bar = bar; b.x = xb_xcc_id(); b.st = st;
    if (threadIdx.x == 0) (void)xb_add(&bar[XB_XCNT(b.x)], 1u);
    return b;
}
__device__ __forceinline__ void xcd_barrier_complete(unsigned* bar, unsigned x, unsigned& nloc, unsigned& nx) {
    const unsigned G = gridDim.x * gridDim.y * gridDim.z;
    unsigned sum, cnt, mine, sp = 0u;
    for (;;) {
        sum = 0u; cnt = 0u; mine = 0u;
#pragma unroll
        for (unsigned j = 0; j < 16; ++j) { const unsigned c = xb_ld(&bar[XB_XCNT(j)]); sum += c; cnt += (c > 0u) ? 1u : 0u; mine = (j == x) ? c : mine; }
        if (sum == G) break;
        __builtin_amdgcn_s_sleep(1);
        if ((++sp & 255u) == 0u) { if (xb_ld(&bar[XB_TMO])) break; if (sp > XB_SPIN_CAP) { atomicAdd(&bar[XB_TMO], 1u); break; } }
    }
    nloc = mine > 0u ? mine : 1u; nx = cnt > 0u ? cnt : 1u;
}
__device__ __forceinline__ void xcd_barrier(const XcdBarrier& b) {
    asm volatile("s_waitcnt vmcnt(0)" ::: "memory");
    __syncthreads();
    if (threadIdx.x == 0) {
        unsigned* bar = b.bar;
        __builtin_amdgcn_s_waitcnt(0);
        unsigned nloc = b.st[0], nx = b.st[1];
        if (nloc == 0u) { xcd_barrier_complete(bar, b.x, nloc, nx); b.st[0] = nloc; b.st[1] = nx; }
        const unsigned old = xb_add(&bar[XB_XSUB(b.x)], 1u);
        const unsigned gen = old / nloc;
        if (old + 1u == (gen + 1u) * nloc) {
            __builtin_amdgcn_fence(__ATOMIC_RELEASE, "agent");
            asm volatile("s_waitcnt vmcnt(0)" ::: "memory");
            const unsigned og = xb_add(&bar[XB_TOP], 1u);
            const unsigned tg = og / nx;
            if (og + 1u == (tg + 1u) * nx) xb_add(&bar[XB_TOPGEN], 1u);
            else XB_SPIN(xb_ld(&bar[XB_TOPGEN]) == tg, bar);
            __builtin_amdgcn_fence(__ATOMIC_ACQUIRE, "agent");
            xb_add(&bar[XB_XGEN(b.x)], 1u);
            asm volatile("s_waitcnt vmcnt(0)" ::: "memory");
        } else {
            XB_SPIN(xb_ld(&bar[XB_XGEN(b.x)]) == gen, bar);
            __builtin_amdgcn_fence(__ATOMIC_ACQUIRE, "agent");
            asm volatile("s_waitcnt vmcnt(0)" ::: "memory");
        }
    }
    __syncthreads();
}

constexpr int NWAVES = 8, NTHR = 512;
constexpr int RING_BYTES = 131072, XTRA_OFF = RING_BYTES, LDS_BYTES = 147456;
constexpr int X_MISC = 0, X_TB = 256, X_NN = 1536;
constexpr int CW_BAR = 4096;
constexpr int N_PHASES = 14;
struct MArgs { const float* in[22]; float* out; unsigned char* ws; int ph_lo, ph_hi; };

#define MAKE_PREP_ARGS(a) PrepArgs{(a).in[4], (a).in[9], (a).in[12], (a).in[14], (a).in[15], (a).in[16], (a).in[17], (a).in[18], (a).in[19], \
    (unsigned char*)((a).ws + WS_WTIN), (bf16*)((a).ws + WS_WTOUT), (bf16*)((a).ws + WS_WTR), (unsigned char*)((a).ws + WS_WT13), (unsigned char*)((a).ws + WS_WT2)}
__device__ __forceinline__ void ph_mod_prep(const MArgs& a, unsigned char* smem, int G) {
    const int tid = threadIdx.x;
    unsigned char* ws = a.ws;
    if ((int)blockIdx.x < 192) {
        float* sc = (float*)smem; float* red = sc + NB * D;
        const float* c = a.in[1]; const float* w_ada = a.in[2]; const float* b_ada = a.in[3]; float* mod = (float*)(ws + WS_MOD);
        for (int i = tid; i < NB * D; i += NTHR) sc[i] = siluf_(c[i]);
        __syncthreads();
        for (int it = blockIdx.x; it < 192; it += G) {
            const int kq = tid >> 5, jl = tid & 31, j = it * 32 + jl;
            float a0 = 0.f, a1 = 0.f, a2 = 0.f, a3 = 0.f;
#pragma unroll 16
            for (int kk = 0; kk < 64; ++kk) { const int k = kq * 64 + kk; const float w = w_ada[(size_t)k * 6144 + j];
                a0 += sc[k] * w; a1 += sc[D + k] * w; a2 += sc[2 * D + k] * w; a3 += sc[3 * D + k] * w; }
            red[(kq * 4 + 0) * 32 + jl] = a0; red[(kq * 4 + 1) * 32 + jl] = a1; red[(kq * 4 + 2) * 32 + jl] = a2; red[(kq * 4 + 3) * 32 + jl] = a3;
            __syncthreads();
            if (tid < 128) { const int b = tid >> 5; float s = b_ada[j];
#pragma unroll
                for (int q = 0; q < 16; ++q) s += red[(q * 4 + b) * 32 + jl];
                mod[b * 6144 + j] = s; }
            __syncthreads();
        }
    }
    const PrepArgs pa = MAKE_PREP_ARGS(a);
    const int lane = tid & 63, gw = blockIdx.x * NWAVES + (tid >> 6), ngw = G * NWAVES;
    prep_run(pa, gw, ngw, lane);
}

__device__ __forceinline__ void ph_ln1(const MArgs& a, unsigned char* smem, int G) {
    const int tid = threadIdx.x, lane = tid & 63, wave = tid >> 6;
    const float* x = a.in[0]; const float* w_in = a.in[4]; const float* gate_b = a.in[7];
    const float* mod = (const float*)(a.ws + WS_MOD); unsigned char* u1 = (unsigned char*)(a.ws + WS_U1); float* ipre = (float*)(a.ws + WS_GATES); float* logf = ipre + 16 * S;
    float* wg = (float*)smem;
    for (int i = tid; i < D * 8; i += NTHR) wg[i] = w_in[(size_t)(i >> 3) * WIN_LD + C_GATE + (i & 7)];
    __syncthreads();
    for (int it = blockIdx.x; it < T / 128; it += G) {
        const int row0 = it * 128, b = row0 / S;
        f32x4 sh[4], sc[4];
#pragma unroll
        for (int j = 0; j < 4; ++j) { sh[j] = *(const f32x4*)(mod + b * 6144 + 4 * lane + 256 * j); sc[j] = *(const f32x4*)(mod + b * 6144 + 1024 + 4 * lane + 256 * j); }
        for (int rr = wave; rr < 128; rr += NWAVES) {
            const int row = row0 + rr;
            const f32x4* xr = (const f32x4*)(x + (size_t)row * D) + lane;
            f32x4 v[4]; float s = 0.f;
#pragma unroll
            for (int j = 0; j < 4; ++j) { v[j] = xr[64 * j]; s += (v[j].x + v[j].y) + (v[j].z + v[j].w); }
            const float mean = wave_sum(s) * (1.f / D); float s2 = 0.f;
#pragma unroll
            for (int j = 0; j < 4; ++j) { v[j] = v[j] - mean; s2 += (v[j].x * v[j].x + v[j].y * v[j].y) + (v[j].z * v[j].z + v[j].w * v[j].w); }
            const float rstd = 1.f / sqrtf(wave_sum(s2) * (1.f / D) + LN_EPS);
            float ga[8];
#pragma unroll
            for (int q = 0; q < 8; ++q) ga[q] = 0.f;
            unsigned* o4 = (unsigned*)(u1 + (size_t)row * D) + lane;
#pragma unroll
            for (int j = 0; j < 4; ++j) {
                const f32x4 u = v[j] * rstd * (sc[j] + 1.0f) + sh[j];
                o4[64 * j] = pk4_fp8(u.x, u.y, u.z, u.w);
#pragma unroll
                for (int e = 0; e < 4; ++e) { const int k = 4 * lane + 256 * j + e;
                    const f32x4 w0 = *(const f32x4*)(wg + k * 8), w1 = *(const f32x4*)(wg + k * 8 + 4);
                    ga[0] += u[e] * w0.x; ga[1] += u[e] * w0.y; ga[2] += u[e] * w0.z; ga[3] += u[e] * w0.w;
                    ga[4] += u[e] * w1.x; ga[5] += u[e] * w1.y; ga[6] += u[e] * w1.z; ga[7] += u[e] * w1.w; }
            }
#pragma unroll
            for (int q = 0; q < 8; ++q) ga[q] = wave_sum(ga[q]);
            if (lane < 8) {
                float gv = 0.f;
#pragma unroll
                for (int q = 0; q < 8; ++q) gv = (lane == q) ? ga[q] : gv;
                gv += gate_b[lane];
                const int h = lane & 3, s_ = row % S;
                if (lane < 4) ipre[(size_t)(b * 4 + h) * S + s_] = gv;
                else logf[(size_t)(b * 4 + h) * S + s_] = fminf(gv, 0.f) - log1pf(__expf(-fabsf(gv)));
            }
        }
    }
}

__device__ __forceinline__ void ph_ln2(const MArgs& a, int G) {
    const float* x = a.in[0]; const bf16* mixout = (const bf16*)(a.ws + WS_MIXOUT); const float* mod = (const float*)(a.ws + WS_MOD); const float* ln1_g = a.in[10]; const float* ln1_b = a.in[11];
    bf16* x1 = (bf16*)(a.ws + WS_X1); bf16* u2 = (bf16*)(a.ws + WS_U2); unsigned char* u2f8 = (unsigned char*)(a.ws + WS_U2F8);
    const int tid = threadIdx.x, lane = tid & 63, wave = tid >> 6;
    for (int it = blockIdx.x; it < T / 128; it += G) {
        const int row0 = it * 128, b = row0 / S;
        f32x4 g1[4], lg[4], lb[4], sc2[4], sh2[4];
#pragma unroll
        for (int j = 0; j < 4; ++j) { const int col = 4 * lane + 256 * j;
            g1[j] = *(const f32x4*)(mod + b * 6144 + 2048 + col); lg[j] = *(const f32x4*)(ln1_g + col); lb[j] = *(const f32x4*)(ln1_b + col);
            sc2[j] = *(const f32x4*)(mod + b * 6144 + 4096 + col) + 1.0f; sh2[j] = *(const f32x4*)(mod + b * 6144 + 3072 + col); }
        for (int rr = wave; rr < 128; rr += NWAVES) {
            const int row = row0 + rr;
            f32x4 v[4]; float s = 0.f;
#pragma unroll
            for (int j = 0; j < 4; ++j) {
                const int col = 4 * lane + 256 * j;
                const f32x4 xv = __builtin_nontemporal_load((const f32x4*)(x + (size_t)row * D + col));
                const f32x4 mo = ld_bf4(mixout + (size_t)row * D + col);
                v[j] = xv * DN_ALPHA + g1[j] * mo; s += (v[j].x + v[j].y) + (v[j].z + v[j].w);
            }
            float mean = wave_sum(s) * (1.f / D), s2 = 0.f;
#pragma unroll
            for (int j = 0; j < 4; ++j) { v[j] = v[j] - mean; s2 += (v[j].x * v[j].x + v[j].y * v[j].y) + (v[j].z * v[j].z + v[j].w * v[j].w); }
            float rstd = 1.f / sqrtf(wave_sum(s2) * (1.f / D) + LN_EPS);
            s = 0.f;
#pragma unroll
            for (int j = 0; j < 4; ++j) { const int col = 4 * lane + 256 * j;
                v[j] = v[j] * rstd * lg[j] + lb[j];
                *(unsigned long long*)(x1 + (size_t)row * D + col) = (unsigned long long)pk2(v[j].x, v[j].y) | ((unsigned long long)pk2(v[j].z, v[j].w) << 32); s += (v[j].x + v[j].y) + (v[j].z + v[j].w); }
            mean = wave_sum(s) * (1.f / D); s2 = 0.f;
#pragma unroll
            for (int j = 0; j < 4; ++j) { v[j] = v[j] - mean; s2 += (v[j].x * v[j].x + v[j].y * v[j].y) + (v[j].z * v[j].z + v[j].w * v[j].w); }
            rstd = 1.f / sqrtf(wave_sum(s2) * (1.f / D) + LN_EPS);
#pragma unroll
            for (int j = 0; j < 4; ++j) { const int col = 4 * lane + 256 * j;
                const f32x4 u = v[j] * rstd * sc2[j] + sh2[j];
                *(unsigned long long*)(u2 + (size_t)row * D + col) = (unsigned long long)pk2(u.x, u.y) | ((unsigned long long)pk2(u.z, u.w) << 32);
                *(unsigned*)(u2f8 + (size_t)row * D + col) = pk4_fp8(u.x, u.y, u.z, u.w); }
        }
    }
}
#define DPPI(v, ctrl) __builtin_amdgcn_update_dpp(0, (v), (ctrl), 0xF, 0xF, true)
#define DPPF(v, ctrl) __builtin_bit_cast(float, __builtin_amdgcn_update_dpp(0, __builtin_bit_cast(int, (v)), (ctrl), 0xF, 0xF, true))
__device__ __forceinline__ void route_wave(int t, int lane, const float* __restrict__ logits, const f32x4 bias4, int* __restrict__ tope, float* __restrict__ topg, int* __restrict__ cnt) {
    const f32x4 lg = *(const f32x4*)(logits + (size_t)t * NE + 4 * lane);
    float sc[4], v[4];
#pragma unroll
    for (int j = 0; j < 4; ++j) { sc[j] = 1.f / (1.f + __expf(-lg[j])); v[j] = sc[j] + bias4[j]; }
    float m1 = fmaxf(fmaxf(v[0], v[1]), fmaxf(v[2], v[3]));
    float m2; { const float a = fmaxf(v[0], v[1]), b = fminf(v[0], v[1]), c = fmaxf(v[2], v[3]), d = fminf(v[2], v[3]); m2 = fmaxf(fminf(a, c), fmaxf(b, d)); }
#pragma unroll
    for (int st = 0; st < 3; ++st) { const float o1 = st == 0 ? DPPF(m1, 0xB1) : (st == 1 ? DPPF(m1, 0x4E) : DPPF(m1, 0x141)), o2 = st == 0 ? DPPF(m2, 0xB1) : (st == 1 ? DPPF(m2, 0x4E) : DPPF(m2, 0x141));
        const float n1 = fmaxf(m1, o1); m2 = fmaxf(fminf(m1, o1), fmaxf(m2, o2)); m1 = n1; }
    const float gs = m1 + m2; const int myg = lane >> 3; int rank = 0;
#pragma unroll
    for (int gg = 0; gg < 8; ++gg) { const float og = __builtin_bit_cast(float, __builtin_amdgcn_readlane(__builtin_bit_cast(int, gs), gg * 8)); rank += (og > gs || (og == gs && gg < myg)) ? 1 : 0; }
    unsigned kh[4];
#pragma unroll
    for (int j = 0; j < 4; ++j) { const unsigned u = __builtin_bit_cast(unsigned, v[j]); kh[j] = (rank >= 4) ? 0u : (u ^ ((u >> 31) ? 0xFFFFFFFFu : 0x80000000u)); }
    int myE = 0; float myS = 0.f, gsum = 0.f;
#pragma unroll
    for (int rd = 0; rd < 8; ++rd) {
        unsigned bh_ = kh[0]; int bl = 255 - 4 * lane;
#pragma unroll
        for (int j = 1; j < 4; ++j) if (kh[j] > bh_) { bh_ = kh[j]; bl = 255 - (4 * lane + j); }
#pragma unroll
        for (int st = 0; st < 4; ++st) {
            const int ctrl = st == 0 ? 0xB1 : (st == 1 ? 0x4E : (st == 2 ? 0x141 : 0x140));
            const unsigned oh = (unsigned)(st == 0 ? DPPI((int)bh_, 0xB1) : (st == 1 ? DPPI((int)bh_, 0x4E) : (st == 2 ? DPPI((int)bh_, 0x141) : DPPI((int)bh_, 0x140))));
            const int ol = st == 0 ? DPPI(bl, 0xB1) : (st == 1 ? DPPI(bl, 0x4E) : (st == 2 ? DPPI(bl, 0x141) : DPPI(bl, 0x140)));
            (void)ctrl; const bool take = (oh > bh_) || (oh == bh_ && ol > bl); bh_ = take ? oh : bh_; bl = take ? ol : bl; }
        unsigned wh = (unsigned)__builtin_amdgcn_readlane((int)bh_, 0); int wl = __builtin_amdgcn_readlane(bl, 0);
#pragma unroll
        for (int rw = 1; rw < 4; ++rw) { const unsigned oh = (unsigned)__builtin_amdgcn_readlane((int)bh_, 16 * rw); const int ol = __builtin_amdgcn_readlane(bl, 16 * rw);
            const bool take = (oh > wh) || (oh == wh && ol > wl); wh = take ? oh : wh; wl = take ? ol : wl; }
        const int bi = 255 - wl;
        float cand = 0.f;
#pragma unroll
        for (int j = 0; j < 4; ++j) if (bi == 4 * lane + j) { cand = sc[j]; kh[j] = 0u; }
        const float ss = __builtin_bit_cast(float, __builtin_amdgcn_readlane(__builtin_bit_cast(int, cand), bi >> 2));
        gsum += ss;
        if (lane == rd) { myE = bi; myS = ss; }
    }
    if (lane < 8) { tope[t * 8 + lane] = myE; topg[t * 8 + lane] = myS * (2.5f / gsum); atomicAdd(cnt + myE, 1); }
}
__device__ __forceinline__ void moe_tables(const int* cnt, LAS int* tb, LAS int* nn) {
    if (threadIdx.x < 64) {
        const int lane = threadIdx.x; int n[4], tl[4], loc = 0;
#pragma unroll
        for (int j = 0; j < 4; ++j) { n[j] = cnt[4 * lane + j]; tl[j] = (n[j] + 255) >> 8; loc += tl[j]; }
        int inc = loc;
#pragma unroll
        for (int o = 1; o < 64; o <<= 1) { const int v = __shfl_up(inc, o); if (lane >= o) inc += v; }
        int base = inc - loc;
#pragma unroll
        for (int j = 0; j < 4; ++j) { tb[4 * lane + j] = base; nn[4 * lane + j] = n[j]; base += tl[j]; }
        if (lane == 63) { tb[NE] = base; nn[NE] = T; tb[NEX] = base + T / 256; }
    }
    __syncthreads();
}
__device__ __forceinline__ void ph_final(const MArgs& a, int G) {
    float* out = a.out; const bf16* x1 = (const bf16*)(a.ws + WS_X1); const unsigned char* ys8 = (const unsigned char*)(a.ws + WS_YS); const bf16* ysh = (const bf16*)(a.ws + WS_YSH); const float* mod = (const float*)(a.ws + WS_MOD);
    const float* ln2_g = a.in[20]; const float* ln2_b = a.in[21];
    const int tid = threadIdx.x, lane = tid & 63, wave = tid >> 6;
    for (int it = blockIdx.x; it < T / 128; it += G) {
        const int row0 = it * 128, b = row0 / S;
        f32x4 g2[4], lg[4], lb[4];
#pragma unroll
        for (int j = 0; j < 4; ++j) { const int col = 4 * lane + 256 * j; g2[j] = *(const f32x4*)(mod + b * 6144 + 5120 + col); lg[j] = *(const f32x4*)(ln2_g + col); lb[j] = *(const f32x4*)(ln2_b + col); }
        for (int rr = wave; rr < 128; rr += NWAVES) {
            const int row = row0 + rr;
            f32x4 v[4]; float s = 0.f;
#pragma unroll
            for (int j = 0; j < 4; ++j) { const int col = 4 * lane + 256 * j;
                f32x4 yr = {0.f, 0.f, 0.f, 0.f};
#pragma unroll
                for (int k = 0; k < 8; ++k) { const int w = *(const int*)(ys8 + ((size_t)row * 8 + k) * D + col);
                    const f32x2 lo = __builtin_amdgcn_cvt_pk_f32_fp8(w, false), hi = __builtin_amdgcn_cvt_pk_f32_fp8(w, true); yr = yr + (f32x4){lo.x, lo.y, hi.x, hi.y}; }
                const f32x4 y = ld_bf4(ysh + (size_t)row * D + col) + yr * (1.f / 16.f);
                v[j] = ld_bf4(x1 + (size_t)row * D + col) * DN_ALPHA + g2[j] * y;
                s += (v[j].x + v[j].y) + (v[j].z + v[j].w); }
            const float mean = wave_sum(s) * (1.f / D); float s2 = 0.f;
#pragma unroll
            for (int j = 0; j < 4; ++j) { v[j] = v[j] - mean; s2 += (v[j].x * v[j].x + v[j].y * v[j].y) + (v[j].z * v[j].z + v[j].w * v[j].w); }
            const float rstd = 1.f / sqrtf(wave_sum(s2) * (1.f / D) + LN_EPS);
#pragma unroll
            for (int j = 0; j < 4; ++j) { const int col = 4 * lane + 256 * j;
                __builtin_nontemporal_store(v[j] * rstd * lg[j] + lb[j], (f32x4*)(out + (size_t)row * D + col)); }
        }
    }
}


typedef short s16x4 __attribute__((ext_vector_type(4)));
typedef short bf16x8v __attribute__((ext_vector_type(8)));
typedef float f32x16 __attribute__((ext_vector_type(16)));
constexpr int MLP = 320;
constexpr int NCH = S / 64;
constexpr int ST_ELEMS = 129 * 128;
constexpr size_t WS_CHK = WS_GATES + 1 * MiB;
constexpr size_t WS_MPREV = WS_GATES + 1 * MiB + 65536;
constexpr size_t WS_KC = WS_U2;
__device__ __forceinline__ s16x4 tr_read(const LAS unsigned char* p) { return __builtin_bit_cast(s16x4, __builtin_amdgcn_ds_read_tr16_b64_v4i16((LAS s16x4*)p)); }
__device__ __forceinline__ bf16x8v tr_frag(const LAS unsigned char* tile, int row0, int col0, int lane) {
    const int i = lane & 15; const LAS unsigned char* p = tile + (row0 + (i >> 2)) * MLP + (col0 + 4 * (i & 3)) * 2;
    const s16x4 lo = tr_read(p), hi = tr_read(p + 4 * MLP);
    return __builtin_shufflevector(lo, hi, 0, 1, 2, 3, 4, 5, 6, 7);
}
__device__ __forceinline__ bf16x8v tr_frag_perm(const LAS unsigned char* tile, int row0, int col0, int lane) {
    const int i = lane & 15; const LAS unsigned char* p = tile + (row0 + (i >> 2)) * MLP + (col0 + 4 * (i & 3)) * 2;
    const s16x4 lo = tr_read(p), hi = tr_read(p + 8 * MLP);
    return __builtin_shufflevector(lo, hi, 0, 1, 2, 3, 4, 5, 6, 7);
}
__device__ __forceinline__ float wave_incl_sum(float v, int lane) {
#pragma unroll
    for (int o = 1; o < 64; o <<= 1) { const float u = __shfl_up(v, o); if (lane >= o) v += u; }
    return v;
}
__device__ __forceinline__ float wave_incl_max(float v, int lane) {
#pragma unroll
    for (int o = 1; o < 64; o <<= 1) { const float u = __shfl_up(v, o); if (lane >= o) v = fmaxf(v, u); }
    return v;
}
__device__ __forceinline__ float wave_max(float v) {
#pragma unroll
    for (int o = 1; o < 64; o <<= 1) v = fmaxf(v, __shfl_xor(v, o));
    return v;
}
__device__ __forceinline__ void conv8(const bf16* __restrict__ rowp, int spos, const float* __restrict__ cw, const float* __restrict__ cb, float scale, float (&y)[8]) {
    const f32x4 b0 = *(const f32x4*)cb, b1 = *(const f32x4*)(cb + 4);
    y[0] = b0.x; y[1] = b0.y; y[2] = b0.z; y[3] = b0.w; y[4] = b1.x; y[5] = b1.y; y[6] = b1.z; y[7] = b1.w;
#pragma unroll
    for (int j = 0; j < 4; ++j) {
        if (spos - 3 + j >= 0) {
            const v4u xr = *(const v4u*)(rowp + (ptrdiff_t)(j - 3) * NPROJ);
            const f32x4 w0 = *(const f32x4*)(cw + j * 1024), w1 = *(const f32x4*)(cw + j * 1024 + 4);
            y[0] += w0.x * bf2f(xr.x & 0xffffu); y[1] += w0.y * bf2f(xr.x >> 16); y[2] += w0.z * bf2f(xr.y & 0xffffu); y[3] += w0.w * bf2f(xr.y >> 16);
            y[4] += w1.x * bf2f(xr.z & 0xffffu); y[5] += w1.y * bf2f(xr.z >> 16); y[6] += w1.z * bf2f(xr.w & 0xffffu); y[7] += w1.w * bf2f(xr.w >> 16);
        }
    }
#pragma unroll
    for (int e = 0; e < 8; ++e) y[e] = siluf_(y[e]) * scale;
}
__device__ __forceinline__ v4u pack8(const float (&y)[8]) { v4u o; o.x = pk2(y[0], y[1]); o.y = pk2(y[2], y[3]); o.z = pk2(y[4], y[5]); o.w = pk2(y[6], y[7]); return o; }

__device__ __forceinline__ void ml_phaseA(const MArgs& a, LAS unsigned char* lds, int vb0, int nvb) {
    const int tid = threadIdx.x, lane = tid & 63, wave = __builtin_amdgcn_readfirstlane(tid >> 6);
    const bf16* proj = (const bf16*)(a.ws + WS_PROJ); const float* conv_w = a.in[5]; const float* conv_b = a.in[6];
    const float* ipre = (const float*)(a.ws + WS_GATES); const float* logf = ipre + 16 * S;
    bf16* kcg = (bf16*)(a.ws + WS_KC); bf16* st = (bf16*)(a.ws + WS_STATES); float* chk = (float*)(a.ws + WS_CHK);
    LAS unsigned char* Kt = lds; LAS unsigned char* Vt = lds + 64 * MLP; LAS float* wkL = (LAS float*)(lds + 128 * MLP); LAS unsigned char* Stg = lds + 132 * MLP;
    const PrepArgs pa = MAKE_PREP_ARGS(a);
    for (int unit = vb0; unit < 16 * NCH; unit += nvb) {
        const int bh = unit >> 7, c = unit & (NCH - 1), b = bh >> 2, h = bh & 3, s0 = c * 64; const size_t row0 = (size_t)b * S + s0;
        if (wave == 0) {
            const float lf = logf[(size_t)bh * S + s0 + lane], ic = ipre[(size_t)bh * S + s0 + lane];
            const float bc = wave_incl_sum(lf, lane), g = ic - bc, gmax = wave_max(g), blast = __shfl(bc, 63);
            wkL[lane] = __expf(g - gmax);
            if (lane == 0) { chk[(size_t)unit * 2] = blast; chk[(size_t)unit * 2 + 1] = blast + gmax; }
        }
#pragma unroll
        for (int q = 0; q < 2; ++q) { const int it = tid + q * NTHR, tt = it >> 4, c8 = it & 15, ch = h * 128 + c8 * 8;
            float y[8]; conv8(proj + (row0 + tt) * NPROJ + C_MLK + ch, s0 + tt, conv_w + 512 + ch, conv_b + 512 + ch, 0.08838834764831845f, y);
            const v4u o = pack8(y);
            *(LAS v4u*)(Kt + tt * MLP + c8 * 16) = o; *(v4u*)(kcg + (row0 + tt) * 512 + ch) = o; }
        __syncthreads();
        const PrepDesc bgd = prep_decode(pa, IT_SMALL + unit * NWAVES + wave); f32x4 bgv[16]; prep_load(bgd, lane, bgv);
#pragma unroll
        for (int q = 0; q < 2; ++q) { const int it = tid + q * NTHR, tt = it >> 4, c8 = it & 15;
            const v4u xr = *(const v4u*)(proj + (row0 + tt) * NPROJ + C_MLV + h * 128 + c8 * 8); const float w = wkL[tt];
            float y[8] = {bf2f(xr.x & 0xffffu) * w, bf2f(xr.x >> 16) * w, bf2f(xr.y & 0xffffu) * w, bf2f(xr.y >> 16) * w, bf2f(xr.z & 0xffffu) * w, bf2f(xr.z >> 16) * w, bf2f(xr.w & 0xffffu) * w, bf2f(xr.w >> 16) * w};
            *(LAS v4u*)(Vt + tt * MLP + c8 * 16) = pack8(y); }
        __syncthreads();
        {
            const int dvb = wave >> 1, dkh = wave & 1, hh = lane >> 5, gsel = (lane >> 4) & 1;
            f32x16 acc[2];
#pragma unroll
            for (int nb = 0; nb < 2; ++nb)
#pragma unroll
                for (int i = 0; i < 16; ++i) acc[nb][i] = 0.f;
#pragma unroll
            for (int kk = 0; kk < 4; ++kk) {
                const bf16x8v Bv = tr_frag(Vt, 16 * kk + 8 * hh, 32 * dvb + 16 * gsel, lane);
#pragma unroll
                for (int nb = 0; nb < 2; ++nb) { const bf16x8v Ak = tr_frag(Kt, 16 * kk + 8 * hh, 32 * (2 * dkh + nb) + 16 * gsel, lane);
                    acc[nb] = __builtin_amdgcn_mfma_f32_32x32x16_bf16(Ak, Bv, acc[nb], 0, 0, 0); }
            }
#pragma unroll
            for (int nb = 0; nb < 2; ++nb)
#pragma unroll
                for (int g4 = 0; g4 < 4; ++g4) { const int dk = 32 * (2 * dkh + nb) + 8 * g4 + 4 * hh, dv = 32 * dvb + (lane & 31);
                    *(LAS unsigned long long*)(Stg + dv * MLP + dk * 2) = (unsigned long long)pk2(acc[nb][4 * g4], acc[nb][4 * g4 + 1]) | ((unsigned long long)pk2(acc[nb][4 * g4 + 2], acc[nb][4 * g4 + 3]) << 32); }
        }
        __syncthreads();
        { bf16* stc = st + (size_t)unit * ST_ELEMS;
#pragma unroll
          for (int q = 0; q < 4; ++q) { const int it = tid + q * NTHR, dv = it >> 4, c8 = it & 15;
              *(v4u*)(stc + dv * 128 + c8 * 8) = *(const LAS v4u*)(Stg + dv * MLP + c8 * 16); }
        }
        if (tid < 128) { float s = 0.f;
#pragma unroll 8
            for (int t = 0; t < 64; ++t) s += wkL[t] * bf2f(*(const LAS unsigned short*)(Kt + t * MLP + tid * 2));
            st[(size_t)unit * ST_ELEMS + 128 * 128 + tid] = (bf16)f2bf(s); }
        prep_store(bgd, lane, bgv);
        __syncthreads();
    }
}

__device__ __forceinline__ void ml_phaseB(const MArgs& a, LAS unsigned char* lds, int vb0, int nvb) {
    const int tid = threadIdx.x;
    bf16* st = (bf16*)(a.ws + WS_STATES); const float* chk = (const float*)(a.ws + WS_CHK); float* mprev = (float*)(a.ws + WS_MPREV);
    LAS float* al = (LAS float*)lds; LAS float* be = al + NCH;
    constexpr int NSL = 16, SLE = ST_ELEMS / NSL;
    for (int item = vb0; item < 16 * NSL; item += nvb) {
        const int bh = item / NSL, sl = item % NSL;
        __syncthreads();
        if (tid < NCH) { al[tid] = chk[(size_t)(bh * NCH + tid) * 2]; be[tid] = chk[(size_t)(bh * NCH + tid) * 2 + 1]; }
        __syncthreads();
        if (tid == 0) { float m = 0.f;
            for (int c = 0; c < NCH; ++c) { const float bl = al[c], M = be[c];
                const float mn = fmaxf(bl + m, M); al[c] = __expf(bl + m - mn); be[c] = __expf(M - mn);
                if (sl == 0) mprev[bh * NCH + c] = m;
                m = mn; } }
        __syncthreads();
        if (tid * 4 < SLE) {
            unsigned long long* p = (unsigned long long*)(st + (size_t)bh * NCH * ST_ELEMS + sl * SLE + tid * 4);
            float c0 = 0.f, c1 = 0.f, c2 = 0.f, c3 = 0.f;
            for (int cb = 0; cb < NCH; cb += 16) { unsigned long long d[16];
#pragma unroll
                for (int j = 0; j < 16; ++j) d[j] = p[(size_t)(cb + j) * (ST_ELEMS / 4)];
#pragma unroll
                for (int j = 0; j < 16; ++j) { p[(size_t)(cb + j) * (ST_ELEMS / 4)] = (unsigned long long)pk2(c0, c1) | ((unsigned long long)pk2(c2, c3) << 32);
                    const float A = al[cb + j], Bq = be[cb + j]; const unsigned lo = (unsigned)d[j], hi = (unsigned)(d[j] >> 32);
                    c0 = A * c0 + Bq * bf2f(lo & 0xffffu); c1 = A * c1 + Bq * bf2f(lo >> 16); c2 = A * c2 + Bq * bf2f(hi & 0xffffu); c3 = A * c3 + Bq * bf2f(hi >> 16); } }
        }
    }
}

__device__ __forceinline__ void ml_phaseC(const MArgs& a, LAS unsigned char* lds, int G) {
    const int tid = threadIdx.x, lane = tid & 63, wave = __builtin_amdgcn_readfirstlane(tid >> 6);
    const bf16* proj = (const bf16*)(a.ws + WS_PROJ); const float* conv_w = a.in[5]; const float* conv_b = a.in[6]; const float* norm_g = a.in[8];
    const float* ipre = (const float*)(a.ws + WS_GATES); const float* logf = ipre + 16 * S;
    const bf16* kcg = (const bf16*)(a.ws + WS_KC); const bf16* st = (const bf16*)(a.ws + WS_STATES); const float* mprev = (const float*)(a.ws + WS_MPREV);
    unsigned char* mix8 = (unsigned char*)(a.ws + WS_MIX);
    LAS unsigned char* Qt = lds; LAS unsigned char* Kt = lds + 64 * MLP; LAS unsigned char* Vt = lds + 128 * MLP; LAS unsigned char* Ct = lds + 192 * MLP;
    LAS float* sc = (LAS float*)(lds + 320 * MLP);
    LAS float* gL = sc; LAS float* mmL = sc + 64; LAS float* siL = sc + 128; LAS float* emL = sc + 192; LAS float* npv = sc + 256; LAS float* lnS = sc + 384;
    const int tb = wave >> 2, dvb = wave & 3, r = lane & 31, hh = lane >> 5, gsel = (lane >> 4) & 1;
    const PrepArgs pa = MAKE_PREP_ARGS(a);
    for (int unit = blockIdx.x; unit < 16 * NCH; unit += G) {
        const int bh = unit >> 7, c = unit & (NCH - 1), b = bh >> 2, h = bh & 3, s0 = c * 64; const size_t row0 = (size_t)b * S + s0;
        if (wave == 0) {
            const float lf = logf[(size_t)bh * S + s0 + lane], ic = ipre[(size_t)bh * S + s0 + lane], mp = mprev[unit];
            const float bc = wave_incl_sum(lf, lane), g = ic - bc, pm = wave_incl_max(g, lane), mm = fmaxf(mp, pm);
            gL[lane] = g; mmL[lane] = mm; siL[lane] = __expf(mp - mm); emL[lane] = __expf(-(bc + mm));
        }
        const bf16* stc = st + (size_t)unit * ST_ELEMS;
#pragma unroll
        for (int q = 0; q < 2; ++q) { const int it = tid + q * NTHR, tt = it >> 4, c8 = it & 15, ch = h * 128 + c8 * 8;
            float y[8]; conv8(proj + (row0 + tt) * NPROJ + C_MLQ + ch, s0 + tt, conv_w + ch, conv_b + ch, 1.f, y);
            *(LAS v4u*)(Qt + tt * MLP + c8 * 16) = pack8(y);
            *(LAS v4u*)(Kt + tt * MLP + c8 * 16) = *(const v4u*)(kcg + (row0 + tt) * 512 + ch);
            *(LAS v4u*)(Vt + tt * MLP + c8 * 16) = *(const v4u*)(proj + (row0 + tt) * NPROJ + C_MLV + ch); }
#pragma unroll
        for (int q = 0; q < 4; ++q) { const int it = tid + q * NTHR, dv = it >> 4, c8 = it & 15;
            *(LAS v4u*)(Ct + dv * MLP + c8 * 16) = *(const v4u*)(stc + dv * 128 + c8 * 8); }
        if (tid < 128) npv[tid] = bf2f(stc[128 * 128 + tid]);
        __syncthreads();
        v4u ogp[2]; f32x4 ngp[2][2];
#pragma unroll
        for (int q = 0; q < 2; ++q) { const int it = tid + q * NTHR, tt = it >> 4, dv = (it & 15) * 8;
            ogp[q] = *(const v4u*)(proj + (row0 + tt) * NPROJ + C_MLO + h * 128 + dv); ngp[q][0] = *(const f32x4*)(norm_g + h * 128 + dv); ngp[q][1] = *(const f32x4*)(norm_g + h * 128 + dv + 4); }
        const PrepDesc bgd = prep_decode(pa, IT_SMALL + BG_A + unit * NWAVES + wave); f32x4 bgv[16]; prep_load(bgd, lane, bgv);
        bf16x8v qf[8];
#pragma unroll
        for (int kk = 0; kk < 8; ++kk) qf[kk] = *(const LAS bf16x8v*)(Qt + (32 * tb + r) * MLP + (16 * kk + 8 * hh) * 2);
        const float mm_t = mmL[32 * tb + r], si_t = siL[32 * tb + r], em_t = emL[32 * tb + r];
        float nq = 0.f;
#pragma unroll
        for (int kk = 0; kk < 8; ++kk) { const f32x4 n0 = *(const LAS f32x4*)(npv + 16 * kk + 8 * hh), n1 = *(const LAS f32x4*)(npv + 16 * kk + 8 * hh + 4);
            nq += n0.x * bf2f((unsigned short)qf[kk][0]) + n0.y * bf2f((unsigned short)qf[kk][1]) + n0.z * bf2f((unsigned short)qf[kk][2]) + n0.w * bf2f((unsigned short)qf[kk][3])
                + n1.x * bf2f((unsigned short)qf[kk][4]) + n1.y * bf2f((unsigned short)qf[kk][5]) + n1.z * bf2f((unsigned short)qf[kk][6]) + n1.w * bf2f((unsigned short)qf[kk][7]); }
        nq += __shfl_xor(nq, 32);
        f32x16 num;
#pragma unroll
        for (int i = 0; i < 16; ++i) num[i] = 0.f;
#pragma unroll
        for (int kk = 0; kk < 8; ++kk) { const bf16x8v Ac = *(const LAS bf16x8v*)(Ct + (32 * dvb + r) * MLP + (16 * kk + 8 * hh) * 2);
            num = __builtin_amdgcn_mfma_f32_32x32x16_bf16(Ac, qf[kk], num, 0, 0, 0); }
#pragma unroll
        for (int i = 0; i < 16; ++i) num[i] *= si_t;
        float wsum = 0.f;
        for (int sb = 0; sb <= tb; ++sb) {
            f32x16 sT;
#pragma unroll
            for (int i = 0; i < 16; ++i) sT[i] = 0.f;
#pragma unroll
            for (int kk = 0; kk < 8; ++kk) { const bf16x8v Ak = *(const LAS bf16x8v*)(Kt + (32 * sb + r) * MLP + (16 * kk + 8 * hh) * 2);
                sT = __builtin_amdgcn_mfma_f32_32x32x16_bf16(Ak, qf[kk], sT, 0, 0, 0); }
            unsigned wp[8];
#pragma unroll
            for (int g4 = 0; g4 < 4; ++g4) { const f32x4 gv = *(const LAS f32x4*)(gL + 32 * sb + 8 * g4 + 4 * hh);
                float w[4];
#pragma unroll
                for (int e = 0; e < 4; ++e) { const int srow = 32 * sb + 8 * g4 + 4 * hh + e; const bool valid = srow <= 32 * tb + r;
                    w[e] = valid ? sT[4 * g4 + e] * __expf(gv[e] - mm_t) : 0.f; wsum += w[e]; }
                wp[2 * g4] = pk2(w[0], w[1]); wp[2 * g4 + 1] = pk2(w[2], w[3]); }
#pragma unroll
            for (int s2 = 0; s2 < 2; ++s2) {
                const bf16x8v Av = tr_frag_perm(Vt, 32 * sb + 16 * s2 + 4 * hh, 32 * dvb + 16 * gsel, lane);
                v4u bw; bw.x = wp[4 * s2]; bw.y = wp[4 * s2 + 1]; bw.z = wp[4 * s2 + 2]; bw.w = wp[4 * s2 + 3];
                num = __builtin_amdgcn_mfma_f32_32x32x16_bf16(Av, __builtin_bit_cast(bf16x8v, bw), num, 0, 0, 0); }
        }
        wsum += __shfl_xor(wsum, 32);
        const float den = si_t * nq + wsum, rden = 1.f / fmaxf(fabsf(den), em_t);
        float ps = 0.f, pq = 0.f;
#pragma unroll
        for (int i = 0; i < 16; ++i) { num[i] *= rden; ps += num[i]; pq += num[i] * num[i]; }
        ps += __shfl_xor(ps, 32); pq += __shfl_xor(pq, 32);
        if (hh == 0) { lnS[((tb * 4 + dvb) * 32 + r) * 2] = ps; lnS[((tb * 4 + dvb) * 32 + r) * 2 + 1] = pq; }
        __syncthreads();
        float ts = 0.f, tq = 0.f;
#pragma unroll
        for (int d = 0; d < 4; ++d) { ts += lnS[((tb * 4 + d) * 32 + r) * 2]; tq += lnS[((tb * 4 + d) * 32 + r) * 2 + 1]; }
        const float mean = ts * (1.f / 128.f), rstd = 1.f / sqrtf(fmaxf(tq * (1.f / 128.f) - mean * mean, 0.f) + LN_EPS);
#pragma unroll
        for (int g4 = 0; g4 < 4; ++g4) { const int dv = 32 * dvb + 8 * g4 + 4 * hh;
            *(LAS unsigned long long*)(Qt + (32 * tb + r) * MLP + dv * 2) = (unsigned long long)pk2((num[4 * g4] - mean) * rstd, (num[4 * g4 + 1] - mean) * rstd) | ((unsigned long long)pk2((num[4 * g4 + 2] - mean) * rstd, (num[4 * g4 + 3] - mean) * rstd) << 32); }
        __syncthreads();
#pragma unroll
        for (int q = 0; q < 2; ++q) { const int it = tid + q * NTHR, tt = it >> 4, c8 = it & 15, dv = c8 * 8;
            const v4u hv = *(const LAS v4u*)(Qt + tt * MLP + c8 * 16); const v4u og = ogp[q];
            const f32x4 n0 = ngp[q][0], n1 = ngp[q][1];
            float o[8];
            o[0] = bf2f(hv.x & 0xffffu) * n0.x * sigmoidf_(bf2f(og.x & 0xffffu)); o[1] = bf2f(hv.x >> 16) * n0.y * sigmoidf_(bf2f(og.x >> 16));
            o[2] = bf2f(hv.y & 0xffffu) * n0.z * sigmoidf_(bf2f(og.y & 0xffffu)); o[3] = bf2f(hv.y >> 16) * n0.w * sigmoidf_(bf2f(og.y >> 16));
            o[4] = bf2f(hv.z & 0xffffu) * n1.x * sigmoidf_(bf2f(og.z & 0xffffu)); o[5] = bf2f(hv.z >> 16) * n1.y * sigmoidf_(bf2f(og.z >> 16));
            o[6] = bf2f(hv.w & 0xffffu) * n1.z * sigmoidf_(bf2f(og.w & 0xffffu)); o[7] = bf2f(hv.w >> 16) * n1.w * sigmoidf_(bf2f(og.w >> 16));
            *(unsigned long long*)(mix8 + (row0 + tt) * D + 512 + h * 128 + dv) = (unsigned long long)pk4_fp8(o[0], o[1], o[2], o[3]) | ((unsigned long long)pk4_fp8(o[4], o[5], o[6], o[7]) << 32); }
        prep_store(bgd, lane, bgv);
        __syncthreads();
    }
}

constexpr int VTP = 192;
template <int PITCH> __device__ __forceinline__ bf16x8v tr_frag_perm_p(const LAS unsigned char* tile, int row0, int col0, int lane) {
    const int i = lane & 15; const LAS unsigned char* p = tile + (row0 + (i >> 2)) * PITCH + (col0 + 4 * (i & 3)) * 2;
    const s16x4 lo = tr_read(p), hi = tr_read(p + 8 * PITCH);
    return __builtin_shufflevector(lo, hi, 0, 1, 2, 3, 4, 5, 6, 7);
}
__device__ __forceinline__ void attn_phase(const bf16* __restrict__ proj, unsigned char* __restrict__ mix8, LAS unsigned char* lds, int vb0, int nvb, const PrepArgs pa) {
    const int tid = threadIdx.x, lane = tid & 63, wave = __builtin_amdgcn_readfirstlane(tid >> 6);
    const int r = lane & 31, hh = lane >> 5, gsel = (lane >> 4) & 1;
    LAS unsigned char* Vt = lds + wave * (64 * VTP);
    bf16x8v ntri[2], nones;
#pragma unroll
    for (int s2 = 0; s2 < 2; ++s2)
#pragma unroll
        for (int j = 0; j < 8; ++j) { const int k = 16 * s2 + 8 * (j >> 2) + 4 * hh + (j & 3); ntri[s2][j] = (k >= r) ? (short)0xBF80 : (short)0; }
#pragma unroll
    for (int j = 0; j < 8; ++j) nones[j] = (short)0xBF80;
    for (int unit = vb0 * NWAVES + wave; unit < NB * 8 * (S / 32); unit += nvb * NWAVES) {
        const int bh = unit / (S / 32), qb = unit % (S / 32), b = bh >> 3, h = bh & 7, q0 = qb * 32;
        const bf16* base = proj + (size_t)b * S * NPROJ + h * 64;
        bf16x8v qf[4];
#pragma unroll
        for (int s = 0; s < 4; ++s) qf[s] = *(const bf16x8v*)(base + (size_t)(q0 + r) * NPROJ + C_SBQ + 16 * s + 8 * hh);
        f32x16 o[2];
#pragma unroll
        for (int d = 0; d < 2; ++d)
#pragma unroll
            for (int i = 0; i < 16; ++i) o[d][i] = 0.f;
        float carry = 0.f;
        const int qpos = q0 + r;
        const PrepDesc bgd = prep_decode(pa, IT_SMALL + BG_A + BG_C + unit); f32x4 bgv[16]; prep_load(bgd, lane, bgv);
        for (int k0 = q0 - 32; ; k0 -= 64) {
            bf16x8v kf[2][4];
#pragma unroll
            for (int kb = 0; kb < 2; ++kb) { int key = k0 + 32 * kb + r; key = key < 0 ? 0 : key;
#pragma unroll
                for (int s = 0; s < 4; ++s) kf[kb][s] = *(const bf16x8v*)(base + (size_t)key * NPROJ + C_SBK + 16 * s + 8 * hh); }
#pragma unroll
            for (int i = 0; i < 8; ++i) { int key = k0 + (lane >> 3) + 8 * i; key = key < 0 ? 0 : key;
                *(LAS v4u*)(Vt + ((lane >> 3) + 8 * i) * VTP + (lane & 7) * 16) = *(const v4u*)(base + (size_t)key * NPROJ + C_SBV + (lane & 7) * 8); }
            f32x16 z[2];
#pragma unroll
            for (int kb = 0; kb < 2; ++kb) {
#pragma unroll
                for (int i = 0; i < 16; ++i) z[kb][i] = 0.f;
#pragma unroll
                for (int s = 0; s < 4; ++s) z[kb] = __builtin_amdgcn_mfma_f32_32x32x16_bf16(kf[kb][s], qf[s], z[kb], 0, 0, 0); }
            const bool need_mask = (k0 + 63 >= q0) || (k0 < 0);
            unsigned xp[2][8];
#pragma unroll
            for (int kb = 0; kb < 2; ++kb)
#pragma unroll
                for (int g4 = 0; g4 < 4; ++g4) { float sp[4];
#pragma unroll
                    for (int e = 0; e < 4; ++e) { const float zz = z[kb][4 * g4 + e];
                        float v = fmaxf(zz, 0.f) + __builtin_amdgcn_logf(1.f + __builtin_amdgcn_exp2f(-fabsf(zz)));
                        if (need_mask) { const int key = k0 + 32 * kb + 8 * g4 + 4 * hh + e; v = (key >= 0 && key < qpos) ? v : 0.f; }
                        sp[e] = v; }
                    xp[kb][2 * g4] = pk2(sp[0], sp[1]); xp[kb][2 * g4 + 1] = pk2(sp[2], sp[3]); }
            const float z00 = z[0][0];
#pragma unroll
            for (int s2 = 0; s2 < 2; ++s2) { v4u b1; b1.x = xp[1][4 * s2]; b1.y = xp[1][4 * s2 + 1]; b1.z = xp[1][4 * s2 + 2]; b1.w = xp[1][4 * s2 + 3];
                v4u b0; b0.x = xp[0][4 * s2]; b0.y = xp[0][4 * s2 + 1]; b0.z = xp[0][4 * s2 + 2]; b0.w = xp[0][4 * s2 + 3];
                z[1] = __builtin_amdgcn_mfma_f32_32x32x16_bf16(ntri[s2], __builtin_bit_cast(bf16x8v, b1), z[1], 0, 0, 0);
                z[0] = __builtin_amdgcn_mfma_f32_32x32x16_bf16(ntri[s2], __builtin_bit_cast(bf16x8v, b0), z[0], 0, 0, 0);
                z[0] = __builtin_amdgcn_mfma_f32_32x32x16_bf16(nones, __builtin_bit_cast(bf16x8v, b1), z[0], 0, 0, 0); }
            float tot = z00 - z[0][0];
            tot = __shfl(tot, r);
#pragma unroll
            for (int kb = 0; kb < 2; ++kb)
#pragma unroll
                for (int g4 = 0; g4 < 4; ++g4) { float p[4];
#pragma unroll
                    for (int e = 0; e < 4; ++e) { float v = __builtin_amdgcn_exp2f(z[kb][4 * g4 + e] - carry);
                        if (need_mask) { const int key = k0 + 32 * kb + 8 * g4 + 4 * hh + e; v = (key >= 0 && key < qpos) ? v : 0.f; }
                        p[e] = v; }
                    xp[kb][2 * g4] = pk2(p[0], p[1]); xp[kb][2 * g4 + 1] = pk2(p[2], p[3]); }
#pragma unroll
            for (int kb = 0; kb < 2; ++kb)
#pragma unroll
                for (int s2 = 0; s2 < 2; ++s2) { v4u bp; bp.x = xp[kb][4 * s2]; bp.y = xp[kb][4 * s2 + 1]; bp.z = xp[kb][4 * s2 + 2]; bp.w = xp[kb][4 * s2 + 3];
#pragma unroll
                    for (int d = 0; d < 2; ++d) { const bf16x8v Av = tr_frag_perm_p<VTP>(Vt, 32 * kb + 16 * s2 + 4 * hh, 32 * d + 16 * gsel, lane);
                        o[d] = __builtin_amdgcn_mfma_f32_32x32x16_bf16(Av, __builtin_bit_cast(bf16x8v, bp), o[d], 0, 0, 0); } }
            carry += tot;
            if (k0 <= 0) break;
            if (__all(carry > SB_THRESH)) break;
        }
#pragma unroll
        for (int d = 0; d < 2; ++d)
#pragma unroll
            for (int g4 = 0; g4 < 4; ++g4)
                *(LAS unsigned long long*)(Vt + r * 144 + (32 * d + 8 * g4 + 4 * hh) * 2) = (unsigned long long)pk2(o[d][4 * g4], o[d][4 * g4 + 1]) | ((unsigned long long)pk2(o[d][4 * g4 + 2], o[d][4 * g4 + 3]) << 32);
#pragma unroll
        for (int i = 0; i < 4; ++i) { const int row = (lane >> 3) + 8 * i;
            const v4u ov = *(const LAS v4u*)(Vt + row * 144 + (lane & 7) * 16);
            *(unsigned long long*)(mix8 + (size_t)(b * S + q0 + row) * D + h * 64 + (lane & 7) * 8) = (unsigned long long)pk4_fp8(bf2f(ov.x & 0xffffu), bf2f(ov.x >> 16), bf2f(ov.y & 0xffffu), bf2f(ov.y >> 16))
                | ((unsigned long long)pk4_fp8(bf2f(ov.z & 0xffffu), bf2f(ov.z >> 16), bf2f(ov.w & 0xffffu), bf2f(ov.w >> 16)) << 32); }
        prep_store(bgd, lane, bgv);
    }
}

__global__ void __launch_bounds__(NTHR, 2) mega_fwd(MArgs args) {
    extern __shared__ __attribute__((aligned(16))) unsigned char lds[];
    LAS unsigned char* ldsl = (LAS unsigned char*)lds;
    const int tid = threadIdx.x, G = gridDim.x;
    volatile LAS unsigned* MISC = (volatile LAS unsigned*)(ldsl + XTRA_OFF + X_MISC);
    LAS int* tb = (LAS int*)(ldsl + XTRA_OFF + X_TB); LAS int* nn = (LAS int*)(ldsl + XTRA_OFF + X_NN);
    for (int u = tid; u < (LDS_BYTES - XTRA_OFF) / 4; u += NTHR) ((LAS unsigned*)(ldsl + XTRA_OFF))[u] = 0u;
    __syncthreads();
    unsigned char* ws = args.ws;
    unsigned* ctl = (unsigned*)(ws + WS_CTL);
    XcdBarrier bar = xcd_barrier_post(ctl + CW_BAR, MISC + 8);
    const int lo = args.ph_lo, hi = args.ph_hi;
#define IN(k) (lo <= (k) && (k) < hi)
#ifndef REP_MASK
#define REP_MASK 0
#endif
#define PHASE(k, ...) do { if (IN(k)) { for (int rep_ = 0; rep_ < (((REP_MASK >> (k)) & 1) ? 2 : 1); ++rep_) { if (rep_) xcd_barrier(bar); __VA_ARGS__ } } if (IN(k) && IN((k) + 1)) xcd_barrier(bar); } while (0)
    int* cnt = (int*)ctl + CW_CNT; i32x2* list = (i32x2*)(ws + WS_ROUTE + 2 * MiB); float* topg = (float*)(ws + WS_ROUTE + 1 * MiB);
    PHASE(0, ph_mod_prep(args, lds, G););
    PHASE(1, ph_ln1(args, lds, G););
    PHASE(2, { pg8::StaticOrder So; So.init(ws + WS_U1, ws + WS_WTIN, T, NPROJ, D, G, blockIdx.x);
        pg8::EpiBf16 E{(bf16*)(ws + WS_PROJ), NPROJ, 2, QSCALE, 1.f / 64.f};
        pg8::gemm_phase<pg8::EpiBf16, pg8::StaticOrder, false, true>(ldsl, D, So, E); });
    PHASE(3, ml_phaseA(args, ldsl, blockIdx.x, G););
    PHASE(4, ml_phaseB(args, ldsl, blockIdx.x, G); __syncthreads(); attn_phase((const bf16*)(ws + WS_PROJ), (unsigned char*)(ws + WS_MIX), ldsl, blockIdx.x, G, MAKE_PREP_ARGS(args)););
    PHASE(5, ml_phaseC(args, ldsl, G););
    PHASE(6, { pg8::StaticOrder So; So.init(ws + WS_MIX, ws + WS_WTOUT, T, D, D, G, blockIdx.x);
        pg8::EpiBf16 E{(bf16*)(ws + WS_MIXOUT), D, 0, 1.f, 1.f / 64.f};
        pg8::gemm_phase<pg8::EpiBf16, pg8::StaticOrder, false, true>(ldsl, D, So, E); });
    PHASE(7, ph_ln2(args, G););
    PHASE(8, { pg8::StaticOrder So; So.init(ws + WS_U2, ws + WS_WTR, T, NE, 2 * D, G, blockIdx.x);
        pg8::EpiF32 E{(float*)(ws + WS_LOGITS), NE};
        pg8::gemm_phase<pg8::EpiF32, pg8::StaticOrder, false, false>(ldsl, 2 * D, So, E); });
    PHASE(9, { const int lane_ = tid & 63; const f32x4 bias4 = *(const f32x4*)(args.in[13] + 4 * lane_); const PrepArgs pa = MAKE_PREP_ARGS(args);
        int bgit = IT_SMALL + BG_TOTAL + blockIdx.x * NWAVES + (tid >> 6);
        for (int t = blockIdx.x * NWAVES + (tid >> 6); t < T; t += G * NWAVES) {
            const bool bg = bgit < IT_TOTAL; PrepDesc bgd = prep_decode(pa, bg ? bgit : IT_SMALL); f32x4 bgv[16];
            if (bg) prep_load(bgd, lane_, bgv);
            route_wave(t, lane_, (const float*)(ws + WS_LOGITS), bias4, (int*)(ws + WS_ROUTE), topg, cnt);
            if (bg) prep_store(bgd, lane_, bgv);
            bgit += G * NWAVES; } });
    PHASE(10, { moe_tables(cnt, tb, nn); const int* tope = (const int*)(ws + WS_ROUTE); int* fill = (int*)ctl + CW_FILL;
        for (int id = blockIdx.x * NTHR + tid; id < T * TOPK; id += G * NTHR) { const int e = tope[id]; const int pos = atomicAdd(fill + e, 1);
            list[tb[e] * 256 + pos] = (i32x2){id, __float_as_int(topg[id])}; } });
    PHASE(11, { moe_tables(cnt, tb, nn);
        pg8::MoeOrder So{G, (int)blockIdx.x, tb[NEX] * 2, 1, tb, nn, list, (const char*)(ws + WS_U2F8), 0, (const char*)(ws + WS_WT13), (size_t)512 * D, (size_t)256 * D};
        pg8::EpiGlu E{(unsigned char*)(ws + WS_H), 1.f / 64.f};
        pg8::gemm_phase<pg8::EpiGlu, pg8::MoeOrder, true, true>(ldsl, D, So, E); });
    PHASE(12, { moe_tables(cnt, tb, nn);
        pg8::MoeOrder So{G, (int)blockIdx.x, tb[NEX] * 4, 2, tb, nn, list, (const char*)(ws + WS_H), (size_t)256 * FF, (const char*)(ws + WS_WT2), (size_t)D * FF, (size_t)256 * FF};
        pg8::EpiScatter E{(unsigned char*)(ws + WS_YS), (bf16*)(ws + WS_YSH), list, nn};
        pg8::gemm_phase<pg8::EpiScatter, pg8::MoeOrder, false, true>(ldsl, FF, So, E); });
    PHASE(13, ph_final(args, G););
#undef PHASE
#undef IN
}

#ifndef MK_UPTO
#define MK_UPTO 14
#endif
__global__ void k_nan_fill(float* out, int n) { for (int i = blockIdx.x * blockDim.x + threadIdx.x; i < n; i += gridDim.x * blockDim.x) out[i] = __builtin_nanf(""); }
extern "C" void kernel_launch(void* const* d_in, const int* in_sizes, int n_in, void* d_out, int out_size, void* d_ws, size_t ws_size, hipStream_t stream) {
    static int grid = 0;
    if (grid == 0) {
        int dev = 0, cus = 0, per_cu = 0; grid = -1;
        if (n_in != 22 || out_size != T * D || ws_size < WS_END) fprintf(stderr, "kernel_launch: unexpected shapes (n_in %d out %d ws %zu, need %zu)\n", n_in, out_size, ws_size, (size_t)WS_END);
        else if (hipGetDevice(&dev) != hipSuccess || hipDeviceGetAttribute(&cus, hipDeviceAttributeMultiprocessorCount, dev) != hipSuccess) fprintf(stderr, "kernel_launch: device query failed\n");
        else if (hipFuncSetAttribute((const void*)mega_fwd, hipFuncAttributeMaxDynamicSharedMemorySize, LDS_BYTES) != hipSuccess) fprintf(stderr, "kernel_launch: hipFuncSetAttribute failed\n");
        else if (hipOccupancyMaxActiveBlocksPerMultiprocessor(&per_cu, (const void*)mega_fwd, NTHR, LDS_BYTES) != hipSuccess || per_cu < 1) fprintf(stderr, "kernel_launch: occupancy query says %d blocks per CU\n", per_cu);
        else grid = cus;
        (void)hipGetLastError();
    }
    if (grid < 0) { k_nan_fill<<<1024, 256, 0, stream>>>((float*)d_out, out_size); return; }
    const float* x = (const float*)d_in[0];
    const float* conv_w = (const float*)d_in[5]; const float* conv_b = (const float*)d_in[6];
    const float* norm_g = (const float*)d_in[8]; const float* ln1_g = (const float*)d_in[10]; const float* ln1_b = (const float*)d_in[11];
    const float* rbias = (const float*)d_in[13]; const float* ln2_g = (const float*)d_in[20]; const float* ln2_b = (const float*)d_in[21];
    char* ws = (char*)d_ws; float* out = (float*)d_out;
    float* mod = (float*)(ws + WS_MOD); bf16* wtin = (bf16*)(ws + WS_WTIN); bf16* wtout = (bf16*)(ws + WS_WTOUT); bf16* wtr = (bf16*)(ws + WS_WTR);
    bf16* wt13 = (bf16*)(ws + WS_WT13); bf16* wt2 = (bf16*)(ws + WS_WT2); int* plan = (int*)(ws + WS_PLAN);
    bf16* u1 = (bf16*)(ws + WS_U1); bf16* proj = (bf16*)(ws + WS_PROJ); float* ipre = (float*)(ws + WS_GATES); float* logf = ipre + 16 * S;
    float* hraw = (float*)(ws + WS_HRAW); bf16* mix = (bf16*)(ws + WS_MIX); bf16* mixout = (bf16*)(ws + WS_MIXOUT); bf16* u2 = (bf16*)(ws + WS_U2);
    float* logits = (float*)(ws + WS_LOGITS); int* tope = (int*)(ws + WS_ROUTE); float* topg = (float*)(ws + WS_ROUTE + 1 * MiB); i32x2* list = (i32x2*)(ws + WS_ROUTE + 2 * MiB);
    bf16* H = (bf16*)(ws + WS_H); bf16* ys = (bf16*)(ws + WS_YS); bf16* ysh = (bf16*)(ws + WS_YSH);
    int* cnt = (int*)(ws + WS_CTL) + CW_CNT;
    (void)hipMemsetAsync(ws + WS_CTL, 0, 1 * MiB, stream);
    if (MK_UPTO > 0) {
        MArgs a{};
        for (int i = 0; i < 22; ++i) a.in[i] = (const float*)d_in[i];
        a.out = out; a.ws = (unsigned char*)d_ws; a.ph_lo = 0; a.ph_hi = MK_UPTO;
        hipLaunchKernelGGL(mega_fwd, dim3(grid), dim3(NTHR), LDS_BYTES, stream, a);
    }
}
```

```cpp
#include <hip/hip_runtime.h>
#include <cstdio>
#include <cstdint>

typedef unsigned short bf16;
typedef unsigned v4u __attribute__((ext_vector_type(4)));
typedef float f32x4 __attribute__((ext_vector_type(4)));
typedef int i32x2 __attribute__((ext_vector_type(2)));
typedef float f32x2 __attribute__((ext_vector_type(2)));

constexpr int D = 1024, NB = 4, S = 8192, T = NB * S;
constexpr int NPROJ = 3584, WIN_LD = 3592;
constexpr int C_SBQ = 0, C_SBK = 512, C_SBV = 1024, C_MLQ = 1536, C_MLK = 2048, C_MLV = 2560, C_MLO = 3072, C_GATE = 3584;
constexpr int NE = 256, NEX = 257, TOPK = 8, FF = 256;
constexpr float LN_EPS = 1e-5f;
constexpr float DN_ALPHA = 1.189207115002721f;
constexpr float LOG2E = 1.4426950408889634f;
constexpr float QSCALE = 0.125f * LOG2E;
constexpr float SB_THRESH = 48.0f;

constexpr size_t MiB = 1u << 20;
constexpr size_t WS_CTL = 0;
constexpr size_t WS_MOD = 1 * MiB;
constexpr size_t WS_WTIN = 2 * MiB;
constexpr size_t WS_WTOUT = 10 * MiB;
constexpr size_t WS_WTR = 12 * MiB;
constexpr size_t WS_PLAN = 13 * MiB;
constexpr size_t WS_WT2 = 16 * MiB;
constexpr size_t WS_YS = 145 * MiB;
constexpr size_t WS_WT13 = 145 * MiB;
constexpr size_t WS_U2F8 = 274 * MiB;
constexpr size_t WS_PROJ = 402 * MiB;
constexpr size_t WS_GATES = 626 * MiB;
constexpr size_t WS_H = 402 * MiB;
constexpr size_t WS_X1 = 757 * MiB;
constexpr size_t WS_STATES = 657 * MiB;
constexpr size_t WS_MIXOUT = 657 * MiB;
constexpr size_t WS_LOGITS = 657 * MiB;
constexpr size_t WS_U1 = 725 * MiB;
constexpr size_t WS_MIX = 725 * MiB;
constexpr size_t WS_U2 = 833 * MiB;
constexpr size_t WS_YSH = 833 * MiB;
constexpr size_t WS_HRAW = 833 * MiB;
constexpr size_t WS_ROUTE = 897 * MiB;
constexpr size_t WS_END = 902 * MiB;
constexpr int CW_CNT = 1024;
constexpr int CW_FILL = 1536;
constexpr int PL_SLOT = 0, PL_T64 = 512, PL_T256 = 1024;

__device__ __forceinline__ unsigned f2bf(float f) { unsigned u = __builtin_bit_cast(unsigned, f); return (u + 0x7fffu + ((u >> 16) & 1u)) >> 16; }
__device__ __forceinline__ float bf2f(unsigned b) { return __builtin_bit_cast(float, b << 16); }
__device__ __forceinline__ unsigned pk2(float lo, float hi) { return f2bf(lo) | (f2bf(hi) << 16); }
__device__ __forceinline__ unsigned pk4_fp8(float a, float b, float c, float d) { int w = 0; w = __builtin_amdgcn_cvt_pk_fp8_f32(a, b, w, false); w = __builtin_amdgcn_cvt_pk_fp8_f32(c, d, w, true); return (unsigned)w; }
__device__ __forceinline__ float wave_sum(float v) {
    v += __builtin_bit_cast(float, __builtin_amdgcn_update_dpp(0, __builtin_bit_cast(int, v), 0xB1, 0xF, 0xF, true));
    v += __builtin_bit_cast(float, __builtin_amdgcn_update_dpp(0, __builtin_bit_cast(int, v), 0x4E, 0xF, 0xF, true));
    v += __builtin_bit_cast(float, __builtin_amdgcn_update_dpp(0, __builtin_bit_cast(int, v), 0x141, 0xF, 0xF, true));
    v += __builtin_bit_cast(float, __builtin_amdgcn_update_dpp(0, __builtin_bit_cast(int, v), 0x140, 0xF, 0xF, true));
    const int iv = __builtin_bit_cast(int, v);
    const float r0 = __builtin_bit_cast(float, __builtin_amdgcn_readlane(iv, 0)), r1 = __builtin_bit_cast(float, __builtin_amdgcn_readlane(iv, 16));
    const float r2 = __builtin_bit_cast(float, __builtin_amdgcn_readlane(iv, 32)), r3 = __builtin_bit_cast(float, __builtin_amdgcn_readlane(iv, 48));
    return (r0 + r1) + (r2 + r3);
}
__device__ __forceinline__ float sigmoidf_(float x) { return 1.f / (1.f + __expf(-x)); }
__device__ __forceinline__ float siluf_(float x) { return x / (1.f + __expf(-x)); }


struct PrepArgs { const float *w_in, *w_out, *w_router, *w1, *w3, *w2, *sw1, *sw3, *sw2; unsigned char* wtin; bf16 *wtout, *wtr; unsigned char* wt13; unsigned char* wt2; };
struct PrepDesc { const float* src; unsigned char* dst; int ldw, ldt, k0, n0, rowmap, f8; };
constexpr int IT_IN = 16 * 56, IT_OUT = 16 * 16, IT_R = 16 * 4, IT_E = 192, IT_TOTAL = IT_IN + IT_OUT + IT_R + NEX * IT_E;
__device__ __forceinline__ PrepDesc prep_decode(const PrepArgs& a, int it) {
    if (it < IT_IN) return PrepDesc{a.w_in, a.wtin, WIN_LD, D, (it / 112) * 128, (it % 112) * 32, 0, 1}; it -= IT_IN;
    if (it < IT_OUT) return PrepDesc{a.w_out, (unsigned char*)a.wtout, D, D, (it / 32) * 128, (it % 32) * 32, 0, 1}; it -= IT_OUT;
    if (it < IT_R) return PrepDesc{a.w_router, (unsigned char*)a.wtr, NE, D, (it / 4) * 64, (it % 4) * 64, 0, 0}; it -= IT_R;
    const int e = it / IT_E, r = it % IT_E;
    if (r < 64) return PrepDesc{e < NE ? a.w1 + (size_t)e * D * FF : a.sw1, a.wt13 + (size_t)e * 512 * D, FF, D, (r / 8) * 128, (r % 8) * 32, 1, 1};
    if (r < 128) { const int q = r - 64; return PrepDesc{e < NE ? a.w3 + (size_t)e * D * FF : a.sw3, a.wt13 + (size_t)e * 512 * D, FF, D, (q / 8) * 128, (q % 8) * 32, 2, 1}; }
    const int q = r - 128; return PrepDesc{e < NE ? a.w2 + (size_t)e * FF * D : a.sw2, a.wt2 + (size_t)e * D * FF, D, FF, (q / 32) * 128, (q % 32) * 32, 0, 1};
}
__device__ __forceinline__ void prep_load(const PrepDesc& d, int lane, f32x4 (&v)[16]) {
    const int g = d.f8 ? (lane >> 3) : (lane >> 4), i = d.f8 ? (lane & 7) : (lane & 15);
#pragma unroll
    for (int r = 0; r < 16; ++r) v[r] = __builtin_nontemporal_load((const f32x4*)(d.src + (size_t)(d.k0 + 16 * g + r) * d.ldw + d.n0 + 4 * i));
}
__device__ __forceinline__ void prep_store(const PrepDesc& d, int lane, const f32x4 (&v)[16]) {
    const int g = d.f8 ? (lane >> 3) : (lane >> 4), i = d.f8 ? (lane & 7) : (lane & 15);
#pragma unroll
    for (int nn = 0; nn < 4; ++nn) {
        const int n = d.n0 + 4 * i + nn;
        const int dr = d.rowmap == 0 ? n : ((n >> 7) * 256 + (d.rowmap == 2 ? 128 : 0) + (n & 127));
        if (d.f8) {
            v4u o; o.x = pk4_fp8(v[0][nn] * 64.f, v[1][nn] * 64.f, v[2][nn] * 64.f, v[3][nn] * 64.f); o.y = pk4_fp8(v[4][nn] * 64.f, v[5][nn] * 64.f, v[6][nn] * 64.f, v[7][nn] * 64.f);
            o.z = pk4_fp8(v[8][nn] * 64.f, v[9][nn] * 64.f, v[10][nn] * 64.f, v[11][nn] * 64.f); o.w = pk4_fp8(v[12][nn] * 64.f, v[13][nn] * 64.f, v[14][nn] * 64.f, v[15][nn] * 64.f);
            *(v4u*)(d.dst + (size_t)dr * d.ldt + d.k0 + 16 * g) = o;
        } else {
            v4u o0, o1; o0.x = pk2(v[0][nn], v[1][nn]); o0.y = pk2(v[2][nn], v[3][nn]); o0.z = pk2(v[4][nn], v[5][nn]); o0.w = pk2(v[6][nn], v[7][nn]);
            o1.x = pk2(v[8][nn], v[9][nn]); o1.y = pk2(v[10][nn], v[11][nn]); o1.z = pk2(v[12][nn], v[13][nn]); o1.w = pk2(v[14][nn], v[15][nn]);
            v4u* dp = (v4u*)((bf16*)d.dst + (size_t)dr * d.ldt + d.k0 + 16 * g); dp[0] = o0; dp[1] = o1;
        }
    }
}
constexpr int IT_SMALL = IT_IN + IT_OUT + IT_R;
constexpr int BG_A = 16 * (S / 64) * 8, BG_C = BG_A, BG_T = NB * 8 * (S / 32), BG_TOTAL = BG_A + BG_C + BG_T;
constexpr int IT_FG = IT_SMALL;
static_assert(IT_SMALL + BG_TOTAL <= IT_TOTAL, "background slots exceed the expert items");
__device__ __forceinline__ int prep_fg_item(int j) { return j < IT_SMALL ? j : j + BG_TOTAL; }
__device__ __forceinline__ void prep_run(const PrepArgs& a, int it0, int stride, int lane) {
    int it = it0; if (it >= IT_FG) return;
    PrepDesc dA = prep_decode(a, prep_fg_item(it)), dB = dA; f32x4 va[16], vb[16]; prep_load(dA, lane, va);
    for (;;) {
        const int itB = it + stride; const bool hasB = itB < IT_FG;
        if (hasB) { dB = prep_decode(a, prep_fg_item(itB)); prep_load(dB, lane, vb); }
        prep_store(dA, lane, va);
        if (!hasB) break;
        const int itA = itB + stride; const bool hasA = itA < IT_FG;
        if (hasA) { dA = prep_decode(a, prep_fg_item(itA)); prep_load(dA, lane, va); }
        prep_store(dB, lane, vb);
        if (!hasA) break;
        it = itA;
    }
}


__device__ __forceinline__ f32x4 ld_bf4(const bf16* p) { const unsigned long long w = *(const unsigned long long*)p;
    return (f32x4){bf2f((unsigned)w & 0xffffu), bf2f(((unsigned)w) >> 16), bf2f((unsigned)(w >> 32) & 0xffffu), bf2f((unsigned)(w >> 48))}; }

#define LAS __attribute__((address_space(3)))
#define GAS __attribute__((address_space(1)))
namespace pg8 {
typedef short bf16x8 __attribute__((ext_vector_type(8)));
constexpr int F8_SCALE_W = 121;
constexpr int BM = 256, BK = 64, HALF = 128, HTB = HALF * BK * 2, STAGE_BYTES = 8 * HTB, NXCD = 8, WGM = 8;
__host__ __device__ __forceinline__ int lds_byte(int r, int c) { const int st = (r >> 4) * 2 + (c >> 5), rr = r & 15, cc = c & 31, ob = rr * 64 + cc * 2; return st * 1024 + (ob ^ (((ob >> 9) & 1) << 5)); }
__host__ __device__ __forceinline__ void stage_rc(int b, int& R, int& C) { const int st = b / 1024, sb = b % 1024, swz = sb ^ (((sb >> 9) & 1) << 5); R = (st >> 1) * 16 + swz / 64; C = (st & 1) * 32 + (swz % 64) / 2; }
__host__ __device__ __forceinline__ int perm16x(int R) { return 64 * (R >> 5) + 16 * ((R & 15) >> 2) + 4 * ((R >> 4) & 1) + (R & 3); }
__host__ __device__ __forceinline__ int perm32(int rho) { const int n = rho >> 4, i = rho & 15; return 8 * (i >> 2) + 4 * n + (i & 3); }

struct Unit { int pm, pn, e, mt; const char* A; const char* B; };

__device__ __forceinline__ long unit_index(int i, int G, int c) { return (G % 8 == 0) ? ((long)(i * 8 + (c & 7)) * (G / 8) + (c >> 3)) : ((long)i * G + c); }

struct StaticOrder {
    int nM, nN, nwg, G, c; const char* A; const char* B; size_t tstep;
    __device__ void init(const void* A_, const void* B_, int M, int N, int Kb, int G_, int c_) { nM = M / BM; nN = N / BM; nwg = nM * nN; G = G_; c = c_; A = (const char*)A_; B = (const char*)B_; tstep = (size_t)BM * Kb; }
    __device__ __forceinline__ bool next(int i, Unit& u) const {
        const long L = (long)i * G + c; if (L >= nwg) return false;
        int wgid = (int)L; { const int q = nwg / NXCD, r = nwg % NXCD, xcd = wgid % NXCD, off = wgid / NXCD; wgid = (xcd < r ? xcd * (q + 1) : r * (q + 1) + (xcd - r) * q) + off; }
        const int nig = WGM * nN, gid = wgid / nig, fm = gid * WGM, gsz = (nM - fm) < WGM ? (nM - fm) : WGM;
        u.pm = fm + ((wgid % nig) % gsz); u.pn = (wgid % nig) / gsz; u.e = 0; u.mt = u.pm; u.A = A + (size_t)u.pm * tstep; u.B = B + (size_t)u.pn * tstep; return true;
    }
    __device__ __forceinline__ int row_token(const Unit&, int) const { return 0; }
};

struct MoeOrder {
    int G, c, total, shift; const LAS int* tb; const LAS int* nn; const i32x2* list;
    const char* Abase; size_t a_tile_stride; const char* Bbase; size_t b_exp_stride, b_pn_stride;
    __device__ __forceinline__ bool next(int i, Unit& u) const {
        const long L = unit_index(i, G, c); if (L >= total) return false;
        const int tile = (int)(L >> shift); u.pn = (int)(L & ((1 << shift) - 1));
        int lo = 0, hi = NEX; while (hi - lo > 1) { const int mid = (lo + hi) >> 1; if (tb[mid] <= tile) lo = mid; else hi = mid; }
        u.e = lo; u.mt = tile - tb[lo]; u.pm = tile;
        u.A = Abase + (size_t)tile * a_tile_stride; u.B = Bbase + (size_t)lo * b_exp_stride + (size_t)u.pn * b_pn_stride; return true;
    }
    __device__ __forceinline__ int row_token(const Unit& u, int row) const {
        const int rr = u.mt * 256 + row;
        const int tok = list[u.pm * 256 + row].x >> 3;
        return u.e >= NE ? rr : (rr < nn[u.e] ? tok : 0);
    }
};

__device__ __forceinline__ unsigned cvt_pk_bf16(float lo, float hi) { unsigned r; asm volatile("v_cvt_pk_bf16_f32 %0, %1, %2" : "=v"(r) : "v"(lo), "v"(hi)); return r; }

struct EpiBf16 {
    static constexpr int PERM = 2; bf16* O; int ldc; int scale_tiles; float scale; float gscale;
    __device__ __forceinline__ void operator()(const f32x4 (&acc)[2][2][4][2], const Unit& u, int wr, int wc, int fr, int fq) const {
        const int row0 = u.pm * BM + wr * 64 + fr, col0 = u.pn * BM + wc * 64 + 16 * fq; const float sc = (u.pn < scale_tiles ? scale : 1.f) * gscale;
#pragma unroll
        for (int ai = 0; ai < 2; ++ai)
#pragma unroll
            for (int m = 0; m < 4; ++m) { bf16* rowp = O + (size_t)(row0 + ai * HALF + m * 16) * ldc + col0;
#pragma unroll
                for (int bj = 0; bj < 2; ++bj) { const f32x4 v0 = acc[ai][bj][m][0] * sc, v1 = acc[ai][bj][m][1] * sc;
                    v4u w; w.x = cvt_pk_bf16(v0[0], v0[1]); w.y = cvt_pk_bf16(v0[2], v0[3]); w.z = cvt_pk_bf16(v1[0], v1[1]); w.w = cvt_pk_bf16(v1[2], v1[3]);
                    *(v4u*)(rowp + bj * 8) = w; } }
    }
};
struct EpiF32 {
    static constexpr int PERM = 0; float* C; int ldc;
    __device__ __forceinline__ void operator()(const f32x4 (&acc)[2][2][4][2], const Unit& u, int wr, int wc, int fr, int fq) const {
        const int row0 = u.pm * BM + wr * 64 + fr, col0 = u.pn * BM + wc * 32 + 4 * fq;
#pragma unroll
        for (int ai = 0; ai < 2; ++ai)
#pragma unroll
            for (int m = 0; m < 4; ++m) { float* rowp = C + (size_t)(row0 + ai * HALF + m * 16) * ldc + col0;
#pragma unroll
                for (int bj = 0; bj < 2; ++bj)
#pragma unroll
                    for (int n = 0; n < 2; ++n) *(f32x4*)(rowp + bj * HALF + n * 16) = acc[ai][bj][m][n]; }
    }
};
struct EpiGlu {
    static constexpr int PERM = 1; unsigned char* H; float gscale;
    __device__ __forceinline__ void operator()(const f32x4 (&acc)[2][2][4][2], const Unit& u, int wr, int wc, int fr, int fq) const {
        const int row0 = u.pm * BM + wr * 64 + fr, col0 = u.pn * HALF + wc * 32 + 8 * fq;
#pragma unroll
        for (int ai = 0; ai < 2; ++ai)
#pragma unroll
            for (int m = 0; m < 4; ++m) { float h[8];
#pragma unroll
                for (int n = 0; n < 2; ++n)
#pragma unroll
                    for (int q = 0; q < 4; ++q) { const float a = acc[ai][0][m][n][q] * gscale; h[n * 4 + q] = a * __builtin_amdgcn_rcpf(1.f + __expf(-a)) * (acc[ai][1][m][n][q] * gscale); }
                *(unsigned long long*)(H + (size_t)(row0 + ai * HALF + m * 16) * FF + col0) = (unsigned long long)pk4_fp8(h[0], h[1], h[2], h[3]) | ((unsigned long long)pk4_fp8(h[4], h[5], h[6], h[7]) << 32); }
    }
};
struct EpiScatter {
    static constexpr int PERM = 2; unsigned char* ys8; unsigned char* ysh8; const i32x2* list; const LAS int* nn;
    __device__ __forceinline__ void operator()(const f32x4 (&acc)[2][2][4][2], const Unit& u, int wr, int wc, int fr, int fq) const {
        const int col0 = u.pn * BM + wc * 64 + 16 * fq; const int n = nn[u.e]; const bool routed = u.e < NE;
        const i32x2* lp = list + (size_t)(u.pm - u.mt) * 256;
#pragma unroll
        for (int ai = 0; ai < 2; ++ai) {
            i32x2 en[4];
#pragma unroll
            for (int m = 0; m < 4; ++m) { const int rr = u.mt * 256 + ai * HALF + wr * 64 + m * 16 + fr; const i32x2 ld = lp[rr];
                en[m].x = routed ? ld.x : rr; en[m].y = routed ? ld.y : 0x3f800000; }
#pragma unroll
            for (int m = 0; m < 4; ++m) { const int rr = u.mt * 256 + ai * HALF + wr * 64 + m * 16 + fr;
                if (rr < n) { const float g = __int_as_float(en[m].y) * (16.f / 64.f);
                    const f32x4 a0 = acc[ai][0][m][0] * g, a1 = acc[ai][0][m][1] * g, b0 = acc[ai][1][m][0] * g, b1 = acc[ai][1][m][1] * g;
                    v4u w; w.x = pk4_fp8(a0[0], a0[1], a0[2], a0[3]); w.y = pk4_fp8(a1[0], a1[1], a1[2], a1[3]); w.z = pk4_fp8(b0[0], b0[1], b0[2], b0[3]); w.w = pk4_fp8(b1[0], b1[1], b1[2], b1[3]);
                    *(v4u*)((routed ? ys8 : ysh8) + (size_t)en[m].x * D + col0) = w; } }
            __builtin_amdgcn_sched_barrier(0);
        }
    }
};

typedef int i32x8 __attribute__((ext_vector_type(8)));
typedef int i32x4 __attribute__((ext_vector_type(4)));
template <bool FP8> struct FragT { struct A4 { bf16x8 v[4][2]; }; struct B2 { bf16x8 v[2][2]; }; };
template <> struct FragT<true> { struct A4 { i32x8 v[4]; }; struct B2 { i32x8 v[2]; }; };
template <class Epi, class Sched, bool GATHER, bool FP8>
__device__ __forceinline__ void gemm_phase(LAS unsigned char* lds, const int Kb, const Sched& S, const Epi& E) {
    const int tid = threadIdx.x, wid = __builtin_amdgcn_readfirstlane(tid >> 6), lane = tid & 63, wr = wid >> 2, wc = wid & 3, fr = lane & 15, fq = lane >> 4;
    const int nt = Kb / 128;
    int sR[2], sC[2];
    unsigned voffA[2], voffB[2];
#pragma unroll
    for (int i = 0; i < 2; ++i) { stage_rc(tid * 16 + i * 8192, sR[i], sC[i]); const int Rb = Epi::PERM == 2 ? perm16x(sR[i]) : (Epi::PERM == 1 ? ((sR[i] & ~31) + perm32(sR[i] & 31)) : sR[i]);
        voffA[i] = (unsigned)(sR[i] * Kb + sC[i] * 2); voffB[i] = (unsigned)(Rb * Kb + sC[i] * 2); }
    const size_t kstep = (size_t)(BK * 2);
    const size_t hstep = (size_t)HALF * Kb;
    const size_t bhstep = Epi::PERM == 2 ? (size_t)8 * Kb : hstep;
    const unsigned ldsw = (unsigned)wid * 1024u;
    const int aoff = lds_byte(wr * 64 + fr, fq * 8), boff = lds_byte(wc * 32 + fr, fq * 8);
    unsigned gc[2][2], gn[2][2];
#define PG8_SA(b, h) (((b) * 2 + (h)) * HTB)
#define PG8_SB(b, h) ((4 + (b) * 2 + (h)) * HTB)
#define PG8_GLDS(src, bufoff, i) __builtin_amdgcn_global_load_lds((const unsigned*)(src), (LAS unsigned*)(lds + (bufoff) + ldsw + (i) * 8192), 16, 0, 0)
#define PG8_STAGE_B(bufoff, gbase) do { PG8_GLDS((const char*)(gbase) + voffB[0], bufoff, 0); PG8_GLDS((const char*)(gbase) + voffB[1], bufoff, 1); } while (0)
#define PG8_STAGE_A(bufoff, gbase, h, nx) do { if constexpr (GATHER) { const unsigned _o0 = (nx) ? gn[h][0] : gc[h][0], _o1 = (nx) ? gn[h][1] : gc[h][1]; \
            PG8_GLDS((const char*)(gbase) + _o0, bufoff, 0); PG8_GLDS((const char*)(gbase) + _o1, bufoff, 1); } \
        else { PG8_GLDS((const char*)(gbase) + (h) * hstep + voffA[0], bufoff, 0); PG8_GLDS((const char*)(gbase) + (h) * hstep + voffA[1], bufoff, 1); } } while (0)
#define PG8_LD2(dstv, p) do { if constexpr (FP8) { const i32x4 _lo = *(const LAS i32x4*)(p), _hi = *(const LAS i32x4*)((p) + 1024); dstv = __builtin_shufflevector(_lo, _hi, 0, 1, 2, 3, 4, 5, 6, 7); } } while (0)
#define PG8_LDA(dst, b, h) do { _Pragma("unroll") for (int m = 0; m < 4; ++m) { if constexpr (FP8) { PG8_LD2(dst.v[m], lds + PG8_SA(b, h) + aoff + m * 2048); } \
        else { _Pragma("unroll") for (int k = 0; k < 2; ++k) dst.v[m][k] = *(const LAS bf16x8*)(lds + PG8_SA(b, h) + aoff + m * 2048 + k * 1024); } } } while (0)
#define PG8_LDB(dst, b, h) do { _Pragma("unroll") for (int n = 0; n < 2; ++n) { if constexpr (FP8) { PG8_LD2(dst.v[n], lds + PG8_SB(b, h) + boff + n * 2048); } \
        else { _Pragma("unroll") for (int k = 0; k < 2; ++k) dst.v[n][k] = *(const LAS bf16x8*)(lds + PG8_SB(b, h) + boff + n * 2048 + k * 1024); } } } while (0)
#define PG8_MMA(ai, bj, At, Bt) do { __builtin_amdgcn_s_setprio(1); _Pragma("unroll") for (int m = 0; m < 4; ++m) _Pragma("unroll") for (int n = 0; n < 2; ++n) { \
        if constexpr (FP8) asm volatile("s_nop 1\n\tv_mfma_scale_f32_16x16x128_f8f6f4 %0, %1, %2, %0, %3, %3 op_sel_hi:[0,0,0]" : "+v"(acc[ai][bj][m][n]) : "v"(Bt.v[n]), "v"(At.v[m]), "v"(f8scale)); \
        else { _Pragma("unroll") for (int k = 0; k < 2; ++k) acc[ai][bj][m][n] = __builtin_amdgcn_mfma_f32_16x16x32_bf16(Bt.v[n][k], At.v[m][k], acc[ai][bj][m][n], 0, 0, 0); } } \
        __builtin_amdgcn_s_setprio(0); } while (0)
#define PG8_WAIT_V(n) asm volatile("s_waitcnt vmcnt(" #n ")" ::: "memory")
#define PG8_WAIT_L(n) asm volatile("s_waitcnt lgkmcnt(" #n ")" ::: "memory")
#define PG8_BAR __builtin_amdgcn_s_barrier()
#define PG8_SCHED __builtin_amdgcn_sched_barrier(0)
#define PG8_GATHER(dst, u) do { _Pragma("unroll") for (int _h = 0; _h < 2; ++_h) _Pragma("unroll") for (int _i = 0; _i < 2; ++_i) \
        dst[_h][_i] = (unsigned)(S.row_token(u, _h * HALF + sR[_i]) * Kb + sC[_i] * 2); } while (0)
    Unit cur, nxt; int ui = 0;
    if (!S.next(0, cur)) return;
    f32x4 acc[2][2][4][2];
#pragma unroll
    for (int a = 0; a < 2; ++a)
#pragma unroll
        for (int b = 0; b < 2; ++b)
#pragma unroll
            for (int m = 0; m < 4; ++m)
#pragma unroll
                for (int n = 0; n < 2; ++n) acc[a][b][m][n] = (f32x4){0.f, 0.f, 0.f, 0.f};
    const int f8scale = 0x7f7f7f7f;
    typedef typename FragT<FP8>::A4 FragA; typedef typename FragT<FP8>::B2 FragB;
    FragA At; FragB B0, B1;
    const char* cA = cur.A; const char* cB = cur.B;
    if constexpr (GATHER) { PG8_GATHER(gc, cur); }
    PG8_STAGE_B(PG8_SB(0, 0), cB); PG8_STAGE_A(PG8_SA(0, 0), cA, 0, false); PG8_STAGE_B(PG8_SB(0, 1), cB + bhstep); PG8_STAGE_A(PG8_SA(0, 1), cA, 1, false);
    if (wr == 1) PG8_BAR;
    PG8_WAIT_V(4); PG8_BAR;
    PG8_STAGE_B(PG8_SB(1, 0), cB + kstep); PG8_STAGE_A(PG8_SA(1, 0), cA + kstep, 0, false); PG8_STAGE_B(PG8_SB(1, 1), cB + bhstep + kstep);
    PG8_WAIT_V(6); PG8_BAR;
    for (;;) {
        const bool has_next = S.next(ui + 1, nxt);
        const char* nA = has_next ? nxt.A : cA; const char* nB = has_next ? nxt.B : cB;
        if constexpr (GATHER) { if (has_next) { PG8_GATHER(gn, nxt); } else {
#pragma unroll
            for (int h = 0; h < 2; ++h) { gn[h][0] = gc[h][0]; gn[h][1] = gc[h][1]; } } }
#pragma unroll 1
        for (int t = 0; t < nt; t += 2) {
            const bool last = (t == nt - 2);
            const char* a1 = cA + (size_t)(t + 1) * kstep;
            const char* a2 = last ? nA : cA + (size_t)(t + 2) * kstep; const char* b2 = last ? nB : cB + (size_t)(t + 2) * kstep;
            const char* a3 = a2 + kstep; const char* b3 = b2 + kstep;
            PG8_LDB(B0, 0, 0); PG8_SCHED; PG8_LDA(At, 0, 0); PG8_STAGE_A(PG8_SA(1, 1), a1, 1, false);
            PG8_WAIT_L(8); PG8_BAR; PG8_WAIT_L(0); PG8_MMA(0, 0, At, B0); PG8_BAR; PG8_SCHED;
            PG8_LDB(B1, 0, 1); PG8_STAGE_B(PG8_SB(0, 0), b2);
            PG8_BAR; PG8_WAIT_L(0); PG8_MMA(0, 1, At, B1); PG8_BAR;
            PG8_LDA(At, 0, 1); PG8_STAGE_A(PG8_SA(0, 0), a2, 0, last);
            PG8_BAR; PG8_WAIT_L(0); PG8_MMA(1, 0, At, B0); PG8_BAR; PG8_SCHED;
            PG8_STAGE_B(PG8_SB(0, 1), b2 + bhstep);
            PG8_WAIT_V(6); PG8_BAR; PG8_MMA(1, 1, At, B1); PG8_BAR;
            PG8_LDB(B0, 1, 0); PG8_SCHED; PG8_LDA(At, 1, 0); PG8_STAGE_A(PG8_SA(0, 1), a2, 1, last);
            PG8_WAIT_L(8); PG8_BAR; PG8_WAIT_L(0); PG8_MMA(0, 0, At, B0); PG8_BAR; PG8_SCHED;
            PG8_LDB(B1, 1, 1); PG8_STAGE_B(PG8_SB(1, 0), b3);
            PG8_BAR; PG8_WAIT_L(0); PG8_MMA(0, 1, At, B1); PG8_BAR;
            PG8_LDA(At, 1, 1); PG8_STAGE_A(PG8_SA(1, 0), a3, 0, last);
            PG8_BAR; PG8_WAIT_L(0); PG8_MMA(1, 0, At, B0); PG8_BAR; PG8_SCHED;
            PG8_STAGE_B(PG8_SB(1, 1), b3 + bhstep);
            PG8_WAIT_V(6); PG8_BAR; PG8_MMA(1, 1, At, B1); PG8_BAR;
        }
        if (wr == 0) PG8_BAR;
        if constexpr (FP8) { __builtin_amdgcn_sched_barrier(0); asm volatile("s_nop 15\n\ts_nop 7" ::: "memory"); __builtin_amdgcn_sched_barrier(0); }
        E(acc, cur, wr, wc, fr, fq);
        if (!has_next) break;
#pragma unroll
        for (int a = 0; a < 2; ++a)
#pragma unroll
            for (int b = 0; b < 2; ++b)
#pragma unroll
                for (int m = 0; m < 4; ++m)
#pragma unroll
                    for (int n = 0; n < 2; ++n) acc[a][b][m][n] = (f32x4){0.f, 0.f, 0.f, 0.f};
        cur = nxt; cA = nA; cB = nB; ++ui;
        if (wr == 1) PG8_BAR;
        if constexpr (GATHER) {
#pragma unroll
            for (int h = 0; h < 2; ++h) { gc[h][0] = gn[h][0]; gc[h][1] = gn[h][1]; } }
    }
    PG8_WAIT_V(0);
    PG8_BAR;
#undef PG8_SA
#undef PG8_SB
#undef PG8_GLDS
#undef PG8_STAGE_A
#undef PG8_STAGE_B
#undef PG8_LDA
#undef PG8_LDB
#undef PG8_MMA
#undef PG8_WAIT_V
#undef PG8_WAIT_L
#undef PG8_BAR
#undef PG8_SCHED
#undef PG8_GATHER
}
}

#define XB_TMO      128
#define XB_XCNT(j)  (256  + 64 * (j))
#define XB_XSUB(j)  (1280 + 64 * (j))
#define XB_XGEN(j)  (2304 + 64 * (j))
#define XB_TOP      3328
#define XB_TOPGEN   3392
#define XCD_BAR_WORDS 3456
#define XB_SPIN_CAP (1u << 22)
__device__ __forceinline__ unsigned xb_ld(unsigned* p)              { return __hip_atomic_load(p, __ATOMIC_RELAXED, __HIP_MEMORY_SCOPE_AGENT); }
__device__ __forceinline__ unsigned xb_add(unsigned* p, unsigned v) { return __hip_atomic_fetch_add(p, v, __ATOMIC_RELAXED, __HIP_MEMORY_SCOPE_AGENT); }
__device__ __forceinline__ unsigned xb_xcc_id() { return (unsigned)__builtin_amdgcn_s_getreg((3 << 11) | 20) & 0xFu; }
#define XB_SPIN(cond, bar) do { unsigned _sp = 0; while (cond) { __builtin_amdgcn_s_sleep(1); \
    if ((++_sp & 255u) == 0u) { if (xb_ld(&(bar)[XB_TMO])) break; if (_sp > XB_SPIN_CAP) { atomicAdd(&(bar)[XB_TMO], 1u); break; } } } } while (0)
struct XcdBarrier { unsigned* bar; unsigned x; volatile LAS unsigned* st; };
__device__ __forceinline__ XcdBarrier xcd_barrier_post(unsigned* bar, volatile LAS unsigned* st) {
    XcdBarrier b; b.bar = bar; b.x = xb_xcc_id(); b.st = st;
    if (threadIdx.x == 0) (void)xb_add(&bar[XB_XCNT(b.x)], 1u);
    return b;
}
__device__ __forceinline__ void xcd_barrier_complete(unsigned* bar, unsigned x, unsigned& nloc, unsigned& nx) {
    const unsigned G = gridDim.x * gridDim.y * gridDim.z;
    unsigned sum, cnt, mine, sp = 0u;
    for (;;) {
        sum = 0u; cnt = 0u; mine = 0u;
#pragma unroll
        for (unsigned j = 0; j < 16; ++j) { const unsigned c = xb_ld(&bar[XB_XCNT(j)]); sum += c; cnt += (c > 0u) ? 1u : 0u; mine = (j == x) ? c : mine; }
        if (sum == G) break;
        __builtin_amdgcn_s_sleep(1);
        if ((++sp & 255u) == 0u) { if (xb_ld(&bar[XB_TMO])) break; if (sp > XB_SPIN_CAP) { atomicAdd(&bar[XB_TMO], 1u); break; } }
    }
    nloc = mine > 0u ? mine : 1u; nx = cnt > 0u ? cnt : 1u;
}
__device__ __forceinline__ void xcd_barrier(const XcdBarrier& b) {
    asm volatile("s_waitcnt vmcnt(0)" ::: "memory");
    __syncthreads();
    if (threadIdx.x == 0) {
        unsigned* bar = b.bar;
        __builtin_amdgcn_s_waitcnt(0);
        unsigned nloc = b.st[0], nx = b.st[1];
        if (nloc == 0u) { xcd_barrier_complete(bar, b.x, nloc, nx); b.st[0] = nloc; b.st[1] = nx; }
        const unsigned old = xb_add(&bar[XB_XSUB(b.x)], 1u);
        const unsigned gen = old / nloc;
        if (old + 1u == (gen + 1u) * nloc) {
            __builtin_amdgcn_fence(__ATOMIC_RELEASE, "agent");
            asm volatile("s_waitcnt vmcnt(0)" ::: "memory");
            const unsigned og = xb_add(&bar[XB_TOP], 1u);
            const unsigned tg = og / nx;
            if (og + 1u == (tg + 1u) * nx) xb_add(&bar[XB_TOPGEN], 1u);
            else XB_SPIN(xb_ld(&bar[XB_TOPGEN]) == tg, bar);
            __builtin_amdgcn_fence(__ATOMIC_ACQUIRE, "agent");
            xb_add(&bar[XB_XGEN(b.x)], 1u);
            asm volatile("s_waitcnt vmcnt(0)" ::: "memory");
        } else {
            XB_SPIN(xb_ld(&bar[XB_XGEN(b.x)]) == gen, bar);
            __builtin_amdgcn_fence(__ATOMIC_ACQUIRE, "agent");
            asm volatile("s_waitcnt vmcnt(0)" ::: "memory");
        }
    }
    __syncthreads();
}

constexpr int NWAVES = 8, NTHR = 512;
constexpr int RING_BYTES = 131072, XTRA_OFF = RING_BYTES, LDS_BYTES = 147456;
constexpr int X_MISC = 0, X_TB = 256, X_NN = 1536;
constexpr int CW_BAR = 4096;
constexpr int N_PHASES = 14;
struct MArgs { const float* in[22]; float* out; unsigned char* ws; int ph_lo, ph_hi; };

#define MAKE_PREP_ARGS(a) PrepArgs{(a).in[4], (a).in[9], (a).in[12], (a).in[14], (a).in[15], (a).in[16], (a).in[17], (a).in[18], (a).in[19], \
    (unsigned char*)((a).ws + WS_WTIN), (bf16*)((a).ws + WS_WTOUT), (bf16*)((a).ws + WS_WTR), (unsigned char*)((a).ws + WS_WT13), (unsigned char*)((a).ws + WS_WT2)}
__device__ __forceinline__ void ph_mod_prep(const MArgs& a, unsigned char* smem, int G) {
    const int tid = threadIdx.x;
    unsigned char* ws = a.ws;
    if ((int)blockIdx.x < 192) {
        float* sc = (float*)smem; float* red = sc + NB * D;
        const float* c = a.in[1]; const float* w_ada = a.in[2]; const float* b_ada = a.in[3]; float* mod = (float*)(ws + WS_MOD);
        for (int i = tid; i < NB * D; i += NTHR) sc[i] = siluf_(c[i]);
        __syncthreads();
        for (int it = blockIdx.x; it < 192; it += G) {
            const int kq = tid >> 5, jl = tid & 31, j = it * 32 + jl;
            float a0 = 0.f, a1 = 0.f, a2 = 0.f, a3 = 0.f;
#pragma unroll 16
            for (int kk = 0; kk < 64; ++kk) { const int k = kq * 64 + kk; const float w = w_ada[(size_t)k * 6144 + j];
                a0 += sc[k] * w; a1 += sc[D + k] * w; a2 += sc[2 * D + k] * w; a3 += sc[3 * D + k] * w; }
            red[(kq * 4 + 0) * 32 + jl] = a0; red[(kq * 4 + 1) * 32 + jl] = a1; red[(kq * 4 + 2) * 32 + jl] = a2; red[(kq * 4 + 3) * 32 + jl] = a3;
            __syncthreads();
            if (tid < 128) { const int b = tid >> 5; float s = b_ada[j];
#pragma unroll
                for (int q = 0; q < 16; ++q) s += red[(q * 4 + b) * 32 + jl];
                mod[b * 6144 + j] = s; }
            __syncthreads();
        }
    }
    const PrepArgs pa = MAKE_PREP_ARGS(a);
    const int lane = tid & 63, gw = blockIdx.x * NWAVES + (tid >> 6), ngw = G * NWAVES;
    prep_run(pa, gw, ngw, lane);
}

__device__ __forceinline__ void ph_ln1(const MArgs& a, unsigned char* smem, int G) {
    const int tid = threadIdx.x, lane = tid & 63, wave = tid >> 6;
    const float* x = a.in[0]; const float* w_in = a.in[4]; const float* gate_b = a.in[7];
    const float* mod = (const float*)(a.ws + WS_MOD); unsigned char* u1 = (unsigned char*)(a.ws + WS_U1); float* ipre = (float*)(a.ws + WS_GATES); float* logf = ipre + 16 * S;
    float* wg = (float*)smem;
    for (int i = tid; i < D * 8; i += NTHR) wg[i] = w_in[(size_t)(i >> 3) * WIN_LD + C_GATE + (i & 7)];
    __syncthreads();
    for (int it = blockIdx.x; it < T / 128; it += G) {
        const int row0 = it * 128, b = row0 / S;
        f32x4 sh[4], sc[4];
#pragma unroll
        for (int j = 0; j < 4; ++j) { sh[j] = *(const f32x4*)(mod + b * 6144 + 4 * lane + 256 * j); sc[j] = *(const f32x4*)(mod + b * 6144 + 1024 + 4 * lane + 256 * j); }
        for (int rr = wave; rr < 128; rr += NWAVES) {
            const int row = row0 + rr;
            const f32x4* xr = (const f32x4*)(x + (size_t)row * D) + lane;
            f32x4 v[4]; float s = 0.f;
#pragma unroll
            for (int j = 0; j < 4; ++j) { v[j] = xr[64 * j]; s += (v[j].x + v[j].y) + (v[j].z + v[j].w); }
            const float mean = wave_sum(s) * (1.f / D); float s2 = 0.f;
#pragma unroll
            for (int j = 0; j < 4; ++j) { v[j] = v[j] - mean; s2 += (v[j].x * v[j].x + v[j].y * v[j].y) + (v[j].z * v[j].z + v[j].w * v[j].w); }
            const float rstd = 1.f / sqrtf(wave_sum(s2) * (1.f / D) + LN_EPS);
            float ga[8];
#pragma unroll
            for (int q = 0; q < 8; ++q) ga[q] = 0.f;
            unsigned* o4 = (unsigned*)(u1 + (size_t)row * D) + lane;
#pragma unroll
            for (int j = 0; j < 4; ++j) {
                const f32x4 u = v[j] * rstd * (sc[j] + 1.0f) + sh[j];
                o4[64 * j] = pk4_fp8(u.x, u.y, u.z, u.w);
#pragma unroll
                for (int e = 0; e < 4; ++e) { const int k = 4 * lane + 256 * j + e;
                    const f32x4 w0 = *(const f32x4*)(wg + k * 8), w1 = *(const f32x4*)(wg + k * 8 + 4);
                    ga[0] += u[e] * w0.x; ga[1] += u[e] * w0.y; ga[2] += u[e] * w0.z; ga[3] += u[e] * w0.w;
                    ga[4] += u[e] * w1.x; ga[5] += u[e] * w1.y; ga[6] += u[e] * w1.z; ga[7] += u[e] * w1.w; }
            }
#pragma unroll
            for (int q = 0; q < 8; ++q) ga[q] = wave_sum(ga[q]);
            if (lane < 8) {
                float gv = 0.f;
#pragma unroll
                for (int q = 0; q < 8; ++q) gv = (lane == q) ? ga[q] : gv;
                gv += gate_b[lane];
                const int h = lane & 3, s_ = row % S;
                if (lane < 4) ipre[(size_t)(b * 4 + h) * S + s_] = gv;
                else logf[(size_t)(b * 4 + h) * S + s_] = fminf(gv, 0.f) - log1pf(__expf(-fabsf(gv)));
            }
        }
    }
}

__device__ __forceinline__ void ph_ln2(const MArgs& a, int G) {
    const float* x = a.in[0]; const bf16* mixout = (const bf16*)(a.ws + WS_MIXOUT); const float* mod = (const float*)(a.ws + WS_MOD); const float* ln1_g = a.in[10]; const float* ln1_b = a.in[11];
    bf16* x1 = (bf16*)(a.ws + WS_X1); bf16* u2 = (bf16*)(a.ws + WS_U2); unsigned char* u2f8 = (unsigned char*)(a.ws + WS_U2F8);
    const int tid = threadIdx.x, lane = tid & 63, wave = tid >> 6;
    for (int it = blockIdx.x; it < T / 128; it += G) {
        const int row0 = it * 128, b = row0 / S;
        f32x4 g1[4], lg[4], lb[4], sc2[4], sh2[4];
#pragma unroll
        for (int j = 0; j < 4; ++j) { const int col = 4 * lane + 256 * j;
            g1[j] = *(const f32x4*)(mod + b * 6144 + 2048 + col); lg[j] = *(const f32x4*)(ln1_g + col); lb[j] = *(const f32x4*)(ln1_b + col);
            sc2[j] = *(const f32x4*)(mod + b * 6144 + 4096 + col) + 1.0f; sh2[j] = *(const f32x4*)(mod + b * 6144 + 3072 + col); }
        for (int rr = wave; rr < 128; rr += NWAVES) {
            const int row = row0 + rr;
            f32x4 v[4]; float s = 0.f;
#pragma unroll
            for (int j = 0; j < 4; ++j) {
                const int col = 4 * lane + 256 * j;
                const f32x4 xv = __builtin_nontemporal_load((const f32x4*)(x + (size_t)row * D + col));
                const f32x4 mo = ld_bf4(mixout + (size_t)row * D + col);
                v[j] = xv * DN_ALPHA + g1[j] * mo; s += (v[j].x + v[j].y) + (v[j].z + v[j].w);
            }
            float mean = wave_sum(s) * (1.f / D), s2 = 0.f;
#pragma unroll
            for (int j = 0; j < 4; ++j) { v[j] = v[j] - mean; s2 += (v[j].x * v[j].x + v[j].y * v[j].y) + (v[j].z * v[j].z + v[j].w * v[j].w); }
            float rstd = 1.f / sqrtf(wave_sum(s2) * (1.f / D) + LN_EPS);
            s = 0.f;
#pragma unroll
            for (int j = 0; j < 4; ++j) { const int col = 4 * lane + 256 * j;
                v[j] = v[j] * rstd * lg[j] + lb[j];
                *(unsigned long long*)(x1 + (size_t)row * D + col) = (unsigned long long)pk2(v[j].x, v[j].y) | ((unsigned long long)pk2(v[j].z, v[j].w) << 32); s += (v[j].x + v[j].y) + (v[j].z + v[j].w); }
            mean = wave_sum(s) * (1.f / D); s2 = 0.f;
#pragma unroll
            for (int j = 0; j < 4; ++j) { v[j] = v[j] - mean; s2 += (v[j].x * v[j].x + v[j].y * v[j].y) + (v[j].z * v[j].z + v[j].w * v[j].w); }
            rstd = 1.f / sqrtf(wave_sum(s2) * (1.f / D) + LN_EPS);
#pragma unroll
            for (int j = 0; j < 4; ++j) { const int col = 4 * lane + 256 * j;
                const f32x4 u = v[j] * rstd * sc2[j] + sh2[j];
                *(unsigned long long*)(u2 + (size_t)row * D + col) = (unsigned long long)pk2(u.x, u.y) | ((unsigned long long)pk2(u.z, u.w) << 32);
                *(unsigned*)(u2f8 + (size_t)row * D + col) = pk4_fp8(u.x, u.y, u.z, u.w); }
        }
    }
}
#define DPPI(v, ctrl) __builtin_amdgcn_update_dpp(0, (v), (ctrl), 0xF, 0xF, true)
#define DPPF(v, ctrl) __builtin_bit_cast(float, __builtin_amdgcn_update_dpp(0, __builtin_bit_cast(int, (v)), (ctrl), 0xF, 0xF, true))
__device__ __forceinline__ void route_wave(int t, int lane, const float* __restrict__ logits, const f32x4 bias4, int* __restrict__ tope, float* __restrict__ topg, int* __restrict__ cnt) {
    const f32x4 lg = *(const f32x4*)(logits + (size_t)t * NE + 4 * lane);
    float sc[4], v[4];
#pragma unroll
    for (int j = 0; j < 4; ++j) { sc[j] = 1.f / (1.f + __expf(-lg[j])); v[j] = sc[j] + bias4[j]; }
    float m1 = fmaxf(fmaxf(v[0], v[1]), fmaxf(v[2], v[3]));
    float m2; { const float a = fmaxf(v[0], v[1]), b = fminf(v[0], v[1]), c = fmaxf(v[2], v[3]), d = fminf(v[2], v[3]); m2 = fmaxf(fminf(a, c), fmaxf(b, d)); }
#pragma unroll
    for (int st = 0; st < 3; ++st) { const float o1 = st == 0 ? DPPF(m1, 0xB1) : (st == 1 ? DPPF(m1, 0x4E) : DPPF(m1, 0x141)), o2 = st == 0 ? DPPF(m2, 0xB1) : (st == 1 ? DPPF(m2, 0x4E) : DPPF(m2, 0x141));
        const float n1 = fmaxf(m1, o1); m2 = fmaxf(fminf(m1, o1), fmaxf(m2, o2)); m1 = n1; }
    const float gs = m1 + m2; const int myg = lane >> 3; int rank = 0;
#pragma unroll
    for (int gg = 0; gg < 8; ++gg) { const float og = __builtin_bit_cast(float, __builtin_amdgcn_readlane(__builtin_bit_cast(int, gs), gg * 8)); rank += (og > gs || (og == gs && gg < myg)) ? 1 : 0; }
    unsigned kh[4];
#pragma unroll
    for (int j = 0; j < 4; ++j) { const unsigned u = __builtin_bit_cast(unsigned, v[j]); kh[j] = (rank >= 4) ? 0u : (u ^ ((u >> 31) ? 0xFFFFFFFFu : 0x80000000u)); }
    int myE = 0; float myS = 0.f, gsum = 0.f;
#pragma unroll
    for (int rd = 0; rd < 8; ++rd) {
        unsigned bh_ = kh[0]; int bl = 255 - 4 * lane;
#pragma unroll
        for (int j = 1; j < 4; ++j) if (kh[j] > bh_) { bh_ = kh[j]; bl = 255 - (4 * lane + j); }
#pragma unroll
        for (int st = 0; st < 4; ++st) {
            const int ctrl = st == 0 ? 0xB1 : (st == 1 ? 0x4E : (st == 2 ? 0x141 : 0x140));
            const unsigned oh = (unsigned)(st == 0 ? DPPI((int)bh_, 0xB1) : (st == 1 ? DPPI((int)bh_, 0x4E) : (st == 2 ? DPPI((int)bh_, 0x141) : DPPI((int)bh_, 0x140))));
            const int ol = st == 0 ? DPPI(bl, 0xB1) : (st == 1 ? DPPI(bl, 0x4E) : (st == 2 ? DPPI(bl, 0x141) : DPPI(bl, 0x140)));
            (void)ctrl; const bool take = (oh > bh_) || (oh == bh_ && ol > bl); bh_ = take ? oh : bh_; bl = take ? ol : bl; }
        unsigned wh = (unsigned)__builtin_amdgcn_readlane((int)bh_, 0); int wl = __builtin_amdgcn_readlane(bl, 0);
#pragma unroll
        for (int rw = 1; rw < 4; ++rw) { const unsigned oh = (unsigned)__builtin_amdgcn_readlane((int)bh_, 16 * rw); const int ol = __builtin_amdgcn_readlane(bl, 16 * rw);
            const bool take = (oh > wh) || (oh == wh && ol > wl); wh = take ? oh : wh; wl = take ? ol : wl; }
        const int bi = 255 - wl;
        float cand = 0.f;
#pragma unroll
        for (int j = 0; j < 4; ++j) if (bi == 4 * lane + j) { cand = sc[j]; kh[j] = 0u; }
        const float ss = __builtin_bit_cast(float, __builtin_amdgcn_readlane(__builtin_bit_cast(int, cand), bi >> 2));
        gsum += ss;
        if (lane == rd) { myE = bi; myS = ss; }
    }
    if (lane < 8) { tope[t * 8 + lane] = myE; topg[t * 8 + lane] = myS * (2.5f / gsum); atomicAdd(cnt + myE, 1); }
}
__device__ __forceinline__ void moe_tables(const int* cnt, LAS int* tb, LAS int* nn) {
    if (threadIdx.x < 64) {
        const int lane = threadIdx.x; int n[4], tl[4], loc = 0;
#pragma unroll
        for (int j = 0; j < 4; ++j) { n[j] = cnt[4 * lane + j]; tl[j] = (n[j] + 255) >> 8; loc += tl[j]; }
        int inc = loc;
#pragma unroll
        for (int o = 1; o < 64; o <<= 1) { const int v = __shfl_up(inc, o); if (lane >= o) inc += v; }
        int base = inc - loc;
#pragma unroll
        for (int j = 0; j < 4; ++j) { tb[4 * lane + j] = base; nn[4 * lane + j] = n[j]; base += tl[j]; }
        if (lane == 63) { tb[NE] = base; nn[NE] = T; tb[NEX] = base + T / 256; }
    }
    __syncthreads();
}
__device__ __forceinline__ void ph_final(const MArgs& a, int G) {
    float* out = a.out; const bf16* x1 = (const bf16*)(a.ws + WS_X1); const unsigned char* ys8 = (const unsigned char*)(a.ws + WS_YS); const unsigned char* ysh8 = (const unsigned char*)(a.ws + WS_YSH); const float* mod = (const float*)(a.ws + WS_MOD);
    const float* ln2_g = a.in[20]; const float* ln2_b = a.in[21];
    const int tid = threadIdx.x, lane = tid & 63, wave = tid >> 6;
    for (int it = blockIdx.x; it < T / 128; it += G) {
        const int row0 = it * 128, b = row0 / S;
        f32x4 g2[4], lg[4], lb[4];
#pragma unroll
        for (int j = 0; j < 4; ++j) { const int col = 4 * lane + 256 * j; g2[j] = *(const f32x4*)(mod + b * 6144 + 5120 + col); lg[j] = *(const f32x4*)(ln2_g + col); lb[j] = *(const f32x4*)(ln2_b + col); }
        for (int rr = wave; rr < 128; rr += NWAVES) {
            const int row = row0 + rr;
            f32x4 v[4]; float s = 0.f;
#pragma unroll
            for (int j = 0; j < 4; ++j) { const int col = 4 * lane + 256 * j;
                f32x4 yr = {0.f, 0.f, 0.f, 0.f};
#pragma unroll
                for (int k = 0; k < 8; ++k) { const int w = *(const int*)(ys8 + ((size_t)row * 8 + k) * D + col);
                    const f32x2 lo = __builtin_amdgcn_cvt_pk_f32_fp8(w, false), hi = __builtin_amdgcn_cvt_pk_f32_fp8(w, true); yr = yr + (f32x4){lo.x, lo.y, hi.x, hi.y}; }
                { const int w = *(const int*)(ysh8 + (size_t)row * D + col); const f32x2 lo = __builtin_amdgcn_cvt_pk_f32_fp8(w, false), hi = __builtin_amdgcn_cvt_pk_f32_fp8(w, true); yr = yr + (f32x4){lo.x, lo.y, hi.x, hi.y}; }
                const f32x4 y = yr * (1.f / 16.f);
                v[j] = ld_bf4(x1 + (size_t)row * D + col) * DN_ALPHA + g2[j] * y;
                s += (v[j].x + v[j].y) + (v[j].z + v[j].w); }
            const float mean = wave_sum(s) * (1.f / D); float s2 = 0.f;
#pragma unroll
            for (int j = 0; j < 4; ++j) { v[j] = v[j] - mean; s2 += (v[j].x * v[j].x + v[j].y * v[j].y) + (v[j].z * v[j].z + v[j].w * v[j].w); }
            const float rstd = 1.f / sqrtf(wave_sum(s2) * (1.f / D) + LN_EPS);
#pragma unroll
            for (int j = 0; j < 4; ++j) { const int col = 4 * lane + 256 * j;
                __builtin_nontemporal_store(v[j] * rstd * lg[j] + lb[j], (f32x4*)(out + (size_t)row * D + col)); }
        }
    }
}


typedef short s16x4 __attribute__((ext_vector_type(4)));
typedef short bf16x8v __attribute__((ext_vector_type(8)));
typedef float f32x16 __attribute__((ext_vector_type(16)));
constexpr int MLP = 320;
constexpr int NCH = S / 64;
constexpr int ST_ELEMS = 129 * 128;
constexpr size_t WS_CHK = WS_GATES + 1 * MiB;
constexpr size_t WS_MPREV = WS_GATES + 1 * MiB + 65536;
constexpr size_t WS_KC = WS_U2;
__device__ __forceinline__ s16x4 tr_read(const LAS unsigned char* p) { return __builtin_bit_cast(s16x4, __builtin_amdgcn_ds_read_tr16_b64_v4i16((LAS s16x4*)p)); }
__device__ __forceinline__ bf16x8v tr_frag(const LAS unsigned char* tile, int row0, int col0, int lane) {
    const int i = lane & 15; const LAS unsigned char* p = tile + (row0 + (i >> 2)) * MLP + (col0 + 4 * (i & 3)) * 2;
    const s16x4 lo = tr_read(p), hi = tr_read(p + 4 * MLP);
    return __builtin_shufflevector(lo, hi, 0, 1, 2, 3, 4, 5, 6, 7);
}
__device__ __forceinline__ bf16x8v tr_frag_perm(const LAS unsigned char* tile, int row0, int col0, int lane) {
    const int i = lane & 15; const LAS unsigned char* p = tile + (row0 + (i >> 2)) * MLP + (col0 + 4 * (i & 3)) * 2;
    const s16x4 lo = tr_read(p), hi = tr_read(p + 8 * MLP);
    return __builtin_shufflevector(lo, hi, 0, 1, 2, 3, 4, 5, 6, 7);
}
__device__ __forceinline__ float wave_incl_sum(float v, int lane) {
#pragma unroll
    for (int o = 1; o < 64; o <<= 1) { const float u = __shfl_up(v, o); if (lane >= o) v += u; }
    return v;
}
__device__ __forceinline__ float wave_incl_max(float v, int lane) {
#pragma unroll
    for (int o = 1; o < 64; o <<= 1) { const float u = __shfl_up(v, o); if (lane >= o) v = fmaxf(v, u); }
    return v;
}
__device__ __forceinline__ float wave_max(float v) {
#pragma unroll
    for (int o = 1; o < 64; o <<= 1) v = fmaxf(v, __shfl_xor(v, o));
    return v;
}
__device__ __forceinline__ void conv8(const bf16* __restrict__ rowp, int spos, const float* __restrict__ cw, const float* __restrict__ cb, float scale, float (&y)[8]) {
    const f32x4 b0 = *(const f32x4*)cb, b1 = *(const f32x4*)(cb + 4);
    y[0] = b0.x; y[1] = b0.y; y[2] = b0.z; y[3] = b0.w; y[4] = b1.x; y[5] = b1.y; y[6] = b1.z; y[7] = b1.w;
#pragma unroll
    for (int j = 0; j < 4; ++j) {
        if (spos - 3 + j >= 0) {
            const v4u xr = *(const v4u*)(rowp + (ptrdiff_t)(j - 3) * NPROJ);
            const f32x4 w0 = *(const f32x4*)(cw + j * 1024), w1 = *(const f32x4*)(cw + j * 1024 + 4);
            y[0] += w0.x * bf2f(xr.x & 0xffffu); y[1] += w0.y * bf2f(xr.x >> 16); y[2] += w0.z * bf2f(xr.y & 0xffffu); y[3] += w0.w * bf2f(xr.y >> 16);
            y[4] += w1.x * bf2f(xr.z & 0xffffu); y[5] += w1.y * bf2f(xr.z >> 16); y[6] += w1.z * bf2f(xr.w & 0xffffu); y[7] += w1.w * bf2f(xr.w >> 16);
        }
    }
#pragma unroll
    for (int e = 0; e < 8; ++e) y[e] = siluf_(y[e]) * scale;
}
__device__ __forceinline__ v4u pack8(const float (&y)[8]) { v4u o; o.x = pk2(y[0], y[1]); o.y = pk2(y[2], y[3]); o.z = pk2(y[4], y[5]); o.w = pk2(y[6], y[7]); return o; }

__device__ __forceinline__ void ml_phaseA(const MArgs& a, LAS unsigned char* lds, int vb0, int nvb) {
    const int tid = threadIdx.x, lane = tid & 63, wave = __builtin_amdgcn_readfirstlane(tid >> 6);
    const bf16* proj = (const bf16*)(a.ws + WS_PROJ); const float* conv_w = a.in[5]; const float* conv_b = a.in[6];
    const float* ipre = (const float*)(a.ws + WS_GATES); const float* logf = ipre + 16 * S;
    bf16* kcg = (bf16*)(a.ws + WS_KC); bf16* st = (bf16*)(a.ws + WS_STATES); float* chk = (float*)(a.ws + WS_CHK);
    LAS unsigned char* Kt = lds; LAS unsigned char* Vt = lds + 64 * MLP; LAS float* wkL = (LAS float*)(lds + 128 * MLP); LAS unsigned char* Stg = lds + 132 * MLP;
    const PrepArgs pa = MAKE_PREP_ARGS(a);
    for (int unit = vb0; unit < 16 * NCH; unit += nvb) {
        const int bh = unit >> 7, c = unit & (NCH - 1), b = bh >> 2, h = bh & 3, s0 = c * 64; const size_t row0 = (size_t)b * S + s0;
        if (wave == 0) {
            const float lf = logf[(size_t)bh * S + s0 + lane], ic = ipre[(size_t)bh * S + s0 + lane];
            const float bc = wave_incl_sum(lf, lane), g = ic - bc, gmax = wave_max(g), blast = __shfl(bc, 63);
            wkL[lane] = __expf(g - gmax);
            if (lane == 0) { chk[(size_t)unit * 2] = blast; chk[(size_t)unit * 2 + 1] = blast + gmax; }
        }
#pragma unroll
        for (int q = 0; q < 2; ++q) { const int it = tid + q * NTHR, tt = it >> 4, c8 = it & 15, ch = h * 128 + c8 * 8;
            float y[8]; conv8(proj + (row0 + tt) * NPROJ + C_MLK + ch, s0 + tt, conv_w + 512 + ch, conv_b + 512 + ch, 0.08838834764831845f, y);
            const v4u o = pack8(y);
            *(LAS v4u*)(Kt + tt * MLP + c8 * 16) = o; *(v4u*)(kcg + (row0 + tt) * 512 + ch) = o; }
        __syncthreads();
        const PrepDesc bgd = prep_decode(pa, IT_SMALL + unit * NWAVES + wave); f32x4 bgv[16]; prep_load(bgd, lane, bgv);
#pragma unroll
        for (int q = 0; q < 2; ++q) { const int it = tid + q * NTHR, tt = it >> 4, c8 = it & 15;
            const v4u xr = *(const v4u*)(proj + (row0 + tt) * NPROJ + C_MLV + h * 128 + c8 * 8); const float w = wkL[tt];
            float y[8] = {bf2f(xr.x & 0xffffu) * w, bf2f(xr.x >> 16) * w, bf2f(xr.y & 0xffffu) * w, bf2f(xr.y >> 16) * w, bf2f(xr.z & 0xffffu) * w, bf2f(xr.z >> 16) * w, bf2f(xr.w & 0xffffu) * w, bf2f(xr.w >> 16) * w};
            *(LAS v4u*)(Vt + tt * MLP + c8 * 16) = pack8(y); }
        __syncthreads();
        {
            const int dvb = wave >> 1, dkh = wave & 1, hh = lane >> 5, gsel = (lane >> 4) & 1;
            f32x16 acc[2];
#pragma unroll
            for (int nb = 0; nb < 2; ++nb)
#pragma unroll
                for (int i = 0; i < 16; ++i) acc[nb][i] = 0.f;
#pragma unroll
            for (int kk = 0; kk < 4; ++kk) {
                const bf16x8v Bv = tr_frag(Vt, 16 * kk + 8 * hh, 32 * dvb + 16 * gsel, lane);
#pragma unroll
                for (int nb = 0; nb < 2; ++nb) { const bf16x8v Ak = tr_frag(Kt, 16 * kk + 8 * hh, 32 * (2 * dkh + nb) + 16 * gsel, lane);
                    acc[nb] = __builtin_amdgcn_mfma_f32_32x32x16_bf16(Ak, Bv, acc[nb], 0, 0, 0); }
            }
#pragma unroll
            for (int nb = 0; nb < 2; ++nb)
#pragma unroll
                for (int g4 = 0; g4 < 4; ++g4) { const int dk = 32 * (2 * dkh + nb) + 8 * g4 + 4 * hh, dv = 32 * dvb + (lane & 31);
                    *(LAS unsigned long long*)(Stg + dv * MLP + dk * 2) = (unsigned long long)pk2(acc[nb][4 * g4], acc[nb][4 * g4 + 1]) | ((unsigned long long)pk2(acc[nb][4 * g4 + 2], acc[nb][4 * g4 + 3]) << 32); }
        }
        __syncthreads();
        { bf16* stc = st + (size_t)unit * ST_ELEMS;
#pragma unroll
          for (int q = 0; q < 4; ++q) { const int it = tid + q * NTHR, dv = it >> 4, c8 = it & 15;
              *(v4u*)(stc + dv * 128 + c8 * 8) = *(const LAS v4u*)(Stg + dv * MLP + c8 * 16); }
        }
        if (tid < 128) { float s = 0.f;
#pragma unroll 8
            for (int t = 0; t < 64; ++t) s += wkL[t] * bf2f(*(const LAS unsigned short*)(Kt + t * MLP + tid * 2));
            st[(size_t)unit * ST_ELEMS + 128 * 128 + tid] = (bf16)f2bf(s); }
        prep_store(bgd, lane, bgv);
        __syncthreads();
    }
}

__device__ __forceinline__ void ml_phaseB(const MArgs& a, LAS unsigned char* lds, int vb0, int nvb) {
    const int tid = threadIdx.x;
    bf16* st = (bf16*)(a.ws + WS_STATES); const float* chk = (const float*)(a.ws + WS_CHK); float* mprev = (float*)(a.ws + WS_MPREV);
    LAS float* al = (LAS float*)lds; LAS float* be = al + NCH;
    constexpr int NSL = 16, SLE = ST_ELEMS / NSL;
    for (int item = vb0; item < 16 * NSL; item += nvb) {
        const int bh = item / NSL, sl = item % NSL;
        __syncthreads();
        if (tid < NCH) { al[tid] = chk[(size_t)(bh * NCH + tid) * 2]; be[tid] = chk[(size_t)(bh * NCH + tid) * 2 + 1]; }
        __syncthreads();
        if (tid == 0) { float m = 0.f;
            for (int c = 0; c < NCH; ++c) { const float bl = al[c], M = be[c];
                const float mn = fmaxf(bl + m, M); al[c] = __expf(bl + m - mn); be[c] = __expf(M - mn);
                if (sl == 0) mprev[bh * NCH + c] = m;
                m = mn; } }
        __syncthreads();
        if (tid * 4 < SLE) {
            unsigned long long* p = (unsigned long long*)(st + (size_t)bh * NCH * ST_ELEMS + sl * SLE + tid * 4);
            float c0 = 0.f, c1 = 0.f, c2 = 0.f, c3 = 0.f;
            for (int cb = 0; cb < NCH; cb += 16) { unsigned long long d[16];
#pragma unroll
                for (int j = 0; j < 16; ++j) d[j] = p[(size_t)(cb + j) * (ST_ELEMS / 4)];
#pragma unroll
                for (int j = 0; j < 16; ++j) { p[(size_t)(cb + j) * (ST_ELEMS / 4)] = (unsigned long long)pk2(c0, c1) | ((unsigned long long)pk2(c2, c3) << 32);
                    const float A = al[cb + j], Bq = be[cb + j]; const unsigned lo = (unsigned)d[j], hi = (unsigned)(d[j] >> 32);
                    c0 = A * c0 + Bq * bf2f(lo & 0xffffu); c1 = A * c1 + Bq * bf2f(lo >> 16); c2 = A * c2 + Bq * bf2f(hi & 0xffffu); c3 = A * c3 + Bq * bf2f(hi >> 16); } }
        }
    }
}

__device__ __forceinline__ void ml_phaseC(const MArgs& a, LAS unsigned char* lds, int G) {
    const int tid = threadIdx.x, lane = tid & 63, wave = __builtin_amdgcn_readfirstlane(tid >> 6);
    const bf16* proj = (const bf16*)(a.ws + WS_PROJ); const float* conv_w = a.in[5]; const float* conv_b = a.in[6]; const float* norm_g = a.in[8];
    const float* ipre = (const float*)(a.ws + WS_GATES); const float* logf = ipre + 16 * S;
    const bf16* kcg = (const bf16*)(a.ws + WS_KC); const bf16* st = (const bf16*)(a.ws + WS_STATES); const float* mprev = (const float*)(a.ws + WS_MPREV);
    unsigned char* mix8 = (unsigned char*)(a.ws + WS_MIX);
    LAS unsigned char* Qt = lds; LAS unsigned char* Kt = lds + 64 * MLP; LAS unsigned char* Vt = lds + 128 * MLP; LAS unsigned char* Ct = lds + 192 * MLP;
    LAS float* sc = (LAS float*)(lds + 320 * MLP);
    LAS float* gL = sc; LAS float* mmL = sc + 64; LAS float* siL = sc + 128; LAS float* emL = sc + 192; LAS float* npv = sc + 256; LAS float* lnS = sc + 384;
    const int tb = wave >> 2, dvb = wave & 3, r = lane & 31, hh = lane >> 5, gsel = (lane >> 4) & 1;
    const PrepArgs pa = MAKE_PREP_ARGS(a);
    for (int unit = blockIdx.x; unit < 16 * NCH; unit += G) {
        const int bh = unit >> 7, c = unit & (NCH - 1), b = bh >> 2, h = bh & 3, s0 = c * 64; const size_t row0 = (size_t)b * S + s0;
        if (wave == 0) {
            const float lf = logf[(size_t)bh * S + s0 + lane], ic = ipre[(size_t)bh * S + s0 + lane], mp = mprev[unit];
            const float bc = wave_incl_sum(lf, lane), g = ic - bc, pm = wave_incl_max(g, lane), mm = fmaxf(mp, pm);
            gL[lane] = g; mmL[lane] = mm; siL[lane] = __expf(mp - mm); emL[lane] = __expf(-(bc + mm));
        }
        const bf16* stc = st + (size_t)unit * ST_ELEMS;
#pragma unroll
        for (int q = 0; q < 2; ++q) { const int it = tid + q * NTHR, tt = it >> 4, c8 = it & 15, ch = h * 128 + c8 * 8;
            float y[8]; conv8(proj + (row0 + tt) * NPROJ + C_MLQ + ch, s0 + tt, conv_w + ch, conv_b + ch, 1.f, y);
            *(LAS v4u*)(Qt + tt * MLP + c8 * 16) = pack8(y);
            *(LAS v4u*)(Kt + tt * MLP + c8 * 16) = *(const v4u*)(kcg + (row0 + tt) * 512 + ch);
            *(LAS v4u*)(Vt + tt * MLP + c8 * 16) = *(const v4u*)(proj + (row0 + tt) * NPROJ + C_MLV + ch); }
#pragma unroll
        for (int q = 0; q < 4; ++q) { const int it = tid + q * NTHR, dv = it >> 4, c8 = it & 15;
            *(LAS v4u*)(Ct + dv * MLP + c8 * 16) = *(const v4u*)(stc + dv * 128 + c8 * 8); }
        if (tid < 128) npv[tid] = bf2f(stc[128 * 128 + tid]);
        __syncthreads();
        v4u ogp[2]; f32x4 ngp[2][2];
#pragma unroll
        for (int q = 0; q < 2; ++q) { const int it = tid + q * NTHR, tt = it >> 4, dv = (it & 15) * 8;
            ogp[q] = *(const v4u*)(proj + (row0 + tt) * NPROJ + C_MLO + h * 128 + dv); ngp[q][0] = *(const f32x4*)(norm_g + h * 128 + dv); ngp[q][1] = *(const f32x4*)(norm_g + h * 128 + dv + 4); }
        const PrepDesc bgd = prep_decode(pa, IT_SMALL + BG_A + unit * NWAVES + wave); f32x4 bgv[16]; prep_load(bgd, lane, bgv);
        bf16x8v qf[8];
#pragma unroll
        for (int kk = 0; kk < 8; ++kk) qf[kk] = *(const LAS bf16x8v*)(Qt + (32 * tb + r) * MLP + (16 * kk + 8 * hh) * 2);
        const float mm_t = mmL[32 * tb + r], si_t = siL[32 * tb + r], em_t = emL[32 * tb + r];
        float nq = 0.f;
#pragma unroll
        for (int kk = 0; kk < 8; ++kk) { const f32x4 n0 = *(const LAS f32x4*)(npv + 16 * kk + 8 * hh), n1 = *(const LAS f32x4*)(npv + 16 * kk + 8 * hh + 4);
            nq += n0.x * bf2f((unsigned short)qf[kk][0]) + n0.y * bf2f((unsigned short)qf[kk][1]) + n0.z * bf2f((unsigned short)qf[kk][2]) + n0.w * bf2f((unsigned short)qf[kk][3])
                + n1.x * bf2f((unsigned short)qf[kk][4]) + n1.y * bf2f((unsigned short)qf[kk][5]) + n1.z * bf2f((unsigned short)qf[kk][6]) + n1.w * bf2f((unsigned short)qf[kk][7]); }
        nq += __shfl_xor(nq, 32);
        f32x16 num;
#pragma unroll
        for (int i = 0; i < 16; ++i) num[i] = 0.f;
#pragma unroll
        for (int kk = 0; kk < 8; ++kk) { const bf16x8v Ac = *(const LAS bf16x8v*)(Ct + (32 * dvb + r) * MLP + (16 * kk + 8 * hh) * 2);
            num = __builtin_amdgcn_mfma_f32_32x32x16_bf16(Ac, qf[kk], num, 0, 0, 0); }
#pragma unroll
        for (int i = 0; i < 16; ++i) num[i] *= si_t;
        float wsum = 0.f;
        for (int sb = 0; sb <= tb; ++sb) {
            f32x16 sT;
#pragma unroll
            for (int i = 0; i < 16; ++i) sT[i] = 0.f;
#pragma unroll
            for (int kk = 0; kk < 8; ++kk) { const bf16x8v Ak = *(const LAS bf16x8v*)(Kt + (32 * sb + r) * MLP + (16 * kk + 8 * hh) * 2);
                sT = __builtin_amdgcn_mfma_f32_32x32x16_bf16(Ak, qf[kk], sT, 0, 0, 0); }
            unsigned wp[8];
#pragma unroll
            for (int g4 = 0; g4 < 4; ++g4) { const f32x4 gv = *(const LAS f32x4*)(gL + 32 * sb + 8 * g4 + 4 * hh);
                float w[4];
#pragma unroll
                for (int e = 0; e < 4; ++e) { const int srow = 32 * sb + 8 * g4 + 4 * hh + e; const bool valid = srow <= 32 * tb + r;
                    w[e] = valid ? sT[4 * g4 + e] * __expf(gv[e] - mm_t) : 0.f; wsum += w[e]; }
                wp[2 * g4] = pk2(w[0], w[1]); wp[2 * g4 + 1] = pk2(w[2], w[3]); }
#pragma unroll
            for (int s2 = 0; s2 < 2; ++s2) {
                const bf16x8v Av = tr_frag_perm(Vt, 32 * sb + 16 * s2 + 4 * hh, 32 * dvb + 16 * gsel, lane);
                v4u bw; bw.x = wp[4 * s2]; bw.y = wp[4 * s2 + 1]; bw.z = wp[4 * s2 + 2]; bw.w = wp[4 * s2 + 3];
                num = __builtin_amdgcn_mfma_f32_32x32x16_bf16(Av, __builtin_bit_cast(bf16x8v, bw), num, 0, 0, 0); }
        }
        wsum += __shfl_xor(wsum, 32);
        const float den = si_t * nq + wsum, rden = 1.f / fmaxf(fabsf(den), em_t);
        float ps = 0.f, pq = 0.f;
#pragma unroll
        for (int i = 0; i < 16; ++i) { num[i] *= rden; ps += num[i]; pq += num[i] * num[i]; }
        ps += __shfl_xor(ps, 32); pq += __shfl_xor(pq, 32);
        if (hh == 0) { lnS[((tb * 4 + dvb) * 32 + r) * 2] = ps; lnS[((tb * 4 + dvb) * 32 + r) * 2 + 1] = pq; }
        __syncthreads();
        float ts = 0.f, tq = 0.f;
#pragma unroll
        for (int d = 0; d < 4; ++d) { ts += lnS[((tb * 4 + d) * 32 + r) * 2]; tq += lnS[((tb * 4 + d) * 32 + r) * 2 + 1]; }
        const float mean = ts * (1.f / 128.f), rstd = 1.f / sqrtf(fmaxf(tq * (1.f / 128.f) - mean * mean, 0.f) + LN_EPS);
#pragma unroll
        for (int g4 = 0; g4 < 4; ++g4) { const int dv = 32 * dvb + 8 * g4 + 4 * hh;
            *(LAS unsigned long long*)(Qt + (32 * tb + r) * MLP + dv * 2) = (unsigned long long)pk2((num[4 * g4] - mean) * rstd, (num[4 * g4 + 1] - mean) * rstd) | ((unsigned long long)pk2((num[4 * g4 + 2] - mean) * rstd, (num[4 * g4 + 3] - mean) * rstd) << 32); }
        __syncthreads();
#pragma unroll
        for (int q = 0; q < 2; ++q) { const int it = tid + q * NTHR, tt = it >> 4, c8 = it & 15, dv = c8 * 8;
            const v4u hv = *(const LAS v4u*)(Qt + tt * MLP + c8 * 16); const v4u og = ogp[q];
            const f32x4 n0 = ngp[q][0], n1 = ngp[q][1];
            float o[8];
            o[0] = bf2f(hv.x & 0xffffu) * n0.x * sigmoidf_(bf2f(og.x & 0xffffu)); o[1] = bf2f(hv.x >> 16) * n0.y * sigmoidf_(bf2f(og.x >> 16));
            o[2] = bf2f(hv.y & 0xffffu) * n0.z * sigmoidf_(bf2f(og.y & 0xffffu)); o[3] = bf2f(hv.y >> 16) * n0.w * sigmoidf_(bf2f(og.y >> 16));
            o[4] = bf2f(hv.z & 0xffffu) * n1.x * sigmoidf_(bf2f(og.z & 0xffffu)); o[5] = bf2f(hv.z >> 16) * n1.y * sigmoidf_(bf2f(og.z >> 16));
            o[6] = bf2f(hv.w & 0xffffu) * n1.z * sigmoidf_(bf2f(og.w & 0xffffu)); o[7] = bf2f(hv.w >> 16) * n1.w * sigmoidf_(bf2f(og.w >> 16));
            *(unsigned long long*)(mix8 + (row0 + tt) * D + 512 + h * 128 + dv) = (unsigned long long)pk4_fp8(o[0], o[1], o[2], o[3]) | ((unsigned long long)pk4_fp8(o[4], o[5], o[6], o[7]) << 32); }
        prep_store(bgd, lane, bgv);
        __syncthreads();
    }
}

constexpr int VTP = 192;
template <int PITCH> __device__ __forceinline__ bf16x8v tr_frag_perm_p(const LAS unsigned char* tile, int row0, int col0, int lane) {
    const int i = lane & 15; const LAS unsigned char* p = tile + (row0 + (i >> 2)) * PITCH + (col0 + 4 * (i & 3)) * 2;
    const s16x4 lo = tr_read(p), hi = tr_read(p + 8 * PITCH);
    return __builtin_shufflevector(lo, hi, 0, 1, 2, 3, 4, 5, 6, 7);
}
__device__ __forceinline__ void attn_phase(const bf16* __restrict__ proj, unsigned char* __restrict__ mix8, LAS unsigned char* lds, int vb0, int nvb, const PrepArgs pa) {
    const int tid = threadIdx.x, lane = tid & 63, wave = __builtin_amdgcn_readfirstlane(tid >> 6);
    const int r = lane & 31, hh = lane >> 5, gsel = (lane >> 4) & 1;
    LAS unsigned char* Vt = lds + wave * (64 * VTP);
    bf16x8v ntri[2], nones;
#pragma unroll
    for (int s2 = 0; s2 < 2; ++s2)
#pragma unroll
        for (int j = 0; j < 8; ++j) { const int k = 16 * s2 + 8 * (j >> 2) + 4 * hh + (j & 3); ntri[s2][j] = (k >= r) ? (short)0xBF80 : (short)0; }
#pragma unroll
    for (int j = 0; j < 8; ++j) nones[j] = (short)0xBF80;
    for (int unit = vb0 * NWAVES + wave; unit < NB * 8 * (S / 32); unit += nvb * NWAVES) {
        const int bh = unit / (S / 32), qb = unit % (S / 32), b = bh >> 3, h = bh & 7, q0 = qb * 32;
        const bf16* base = proj + (size_t)b * S * NPROJ + h * 64;
        bf16x8v qf[4];
#pragma unroll
        for (int s = 0; s < 4; ++s) qf[s] = *(const bf16x8v*)(base + (size_t)(q0 + r) * NPROJ + C_SBQ + 16 * s + 8 * hh);
        f32x16 o[2];
#pragma unroll
        for (int d = 0; d < 2; ++d)
#pragma unroll
            for (int i = 0; i < 16; ++i) o[d][i] = 0.f;
        float carry = 0.f;
        const int qpos = q0 + r;
        const PrepDesc bgd = prep_decode(pa, IT_SMALL + BG_A + BG_C + unit); f32x4 bgv[16]; prep_load(bgd, lane, bgv);
        for (int k0 = q0 - 32; ; k0 -= 64) {
            bf16x8v kf[2][4];
#pragma unroll
            for (int kb = 0; kb < 2; ++kb) { int key = k0 + 32 * kb + r; key = key < 0 ? 0 : key;
#pragma unroll
                for (int s = 0; s < 4; ++s) kf[kb][s] = *(const bf16x8v*)(base + (size_t)key * NPROJ + C_SBK + 16 * s + 8 * hh); }
#pragma unroll
            for (int i = 0; i < 8; ++i) { int key = k0 + (lane >> 3) + 8 * i; key = key < 0 ? 0 : key;
                *(LAS v4u*)(Vt + ((lane >> 3) + 8 * i) * VTP + (lane & 7) * 16) = *(const v4u*)(base + (size_t)key * NPROJ + C_SBV + (lane & 7) * 8); }
            f32x16 z[2];
#pragma unroll
            for (int kb = 0; kb < 2; ++kb) {
#pragma unroll
                for (int i = 0; i < 16; ++i) z[kb][i] = 0.f;
#pragma unroll
                for (int s = 0; s < 4; ++s) z[kb] = __builtin_amdgcn_mfma_f32_32x32x16_bf16(kf[kb][s], qf[s], z[kb], 0, 0, 0); }
            const bool need_mask = (k0 + 63 >= q0) || (k0 < 0);
            unsigned xp[2][8];
#pragma unroll
            for (int kb = 0; kb < 2; ++kb)
#pragma unroll
                for (int g4 = 0; g4 < 4; ++g4) { float sp[4];
#pragma unroll
                    for (int e = 0; e < 4; ++e) { const float zz = z[kb][4 * g4 + e];
                        float v = fmaxf(zz, 0.f) + __builtin_amdgcn_logf(1.f + __builtin_amdgcn_exp2f(-fabsf(zz)));
                        if (need_mask) { const int key = k0 + 32 * kb + 8 * g4 + 4 * hh + e; v = (key >= 0 && key < qpos) ? v : 0.f; }
                        sp[e] = v; }
                    xp[kb][2 * g4] = pk2(sp[0], sp[1]); xp[kb][2 * g4 + 1] = pk2(sp[2], sp[3]); }
            const float z00 = z[0][0];
#pragma unroll
            for (int s2 = 0; s2 < 2; ++s2) { v4u b1; b1.x = xp[1][4 * s2]; b1.y = xp[1][4 * s2 + 1]; b1.z = xp[1][4 * s2 + 2]; b1.w = xp[1][4 * s2 + 3];
                v4u b0; b0.x = xp[0][4 * s2]; b0.y = xp[0][4 * s2 + 1]; b0.z = xp[0][4 * s2 + 2]; b0.w = xp[0][4 * s2 + 3];
                z[1] = __builtin_amdgcn_mfma_f32_32x32x16_bf16(ntri[s2], __builtin_bit_cast(bf16x8v, b1), z[1], 0, 0, 0);
                z[0] = __builtin_amdgcn_mfma_f32_32x32x16_bf16(ntri[s2], __builtin_bit_cast(bf16x8v, b0), z[0], 0, 0, 0);
                z[0] = __builtin_amdgcn_mfma_f32_32x32x16_bf16(nones, __builtin_bit_cast(bf16x8v, b1), z[0], 0, 0, 0); }
            float tot = z00 - z[0][0];
            tot = __shfl(tot, r);
#pragma unroll
            for (int kb = 0; kb < 2; ++kb)
#pragma unroll
                for (int g4 = 0; g4 < 4; ++g4) { float p[4];
#pragma unroll
                    for (int e = 0; e < 4; ++e) { float v = __builtin_amdgcn_exp2f(z[kb][4 * g4 + e] - carry);
                        if (need_mask) { const int key = k0 + 32 * kb + 8 * g4 + 4 * hh + e; v = (key >= 0 && key < qpos) ? v : 0.f; }
                        p[e] = v; }
                    xp[kb][2 * g4] = pk2(p[0], p[1]); xp[kb][2 * g4 + 1] = pk2(p[2], p[3]); }
#pragma unroll
            for (int kb = 0; kb < 2; ++kb)
#pragma unroll
                for (int s2 = 0; s2 < 2; ++s2) { v4u bp; bp.x = xp[kb][4 * s2]; bp.y = xp[kb][4 * s2 + 1]; bp.z = xp[kb][4 * s2 + 2]; bp.w = xp[kb][4 * s2 + 3];
#pragma unroll
                    for (int d = 0; d < 2; ++d) { const bf16x8v Av = tr_frag_perm_p<VTP>(Vt, 32 * kb + 16 * s2 + 4 * hh, 32 * d + 16 * gsel, lane);
                        o[d] = __builtin_amdgcn_mfma_f32_32x32x16_bf16(Av, __builtin_bit_cast(bf16x8v, bp), o[d], 0, 0, 0); } }
            carry += tot;
            if (k0 <= 0) break;
            if (__all(carry > SB_THRESH)) break;
        }
#pragma unroll
        for (int d = 0; d < 2; ++d)
#pragma unroll
            for (int g4 = 0; g4 < 4; ++g4)
                *(LAS unsigned long long*)(Vt + r * 144 + (32 * d + 8 * g4 + 4 * hh) * 2) = (unsigned long long)pk2(o[d][4 * g4], o[d][4 * g4 + 1]) | ((unsigned long long)pk2(o[d][4 * g4 + 2], o[d][4 * g4 + 3]) << 32);
#pragma unroll
        for (int i = 0; i < 4; ++i) { const int row = (lane >> 3) + 8 * i;
            const v4u ov = *(const LAS v4u*)(Vt + row * 144 + (lane & 7) * 16);
            *(unsigned long long*)(mix8 + (size_t)(b * S + q0 + row) * D + h * 64 + (lane & 7) * 8) = (unsigned long long)pk4_fp8(bf2f(ov.x & 0xffffu), bf2f(ov.x >> 16), bf2f(ov.y & 0xffffu), bf2f(ov.y >> 16))
                | ((unsigned long long)pk4_fp8(bf2f(ov.z & 0xffffu), bf2f(ov.z >> 16), bf2f(ov.w & 0xffffu), bf2f(ov.w >> 16)) << 32); }
        prep_store(bgd, lane, bgv);
    }
}

__global__ void __launch_bounds__(NTHR, 2) mega_fwd(MArgs args) {
    extern __shared__ __attribute__((aligned(16))) unsigned char lds[];
    LAS unsigned char* ldsl = (LAS unsigned char*)lds;
    const int tid = threadIdx.x, G = gridDim.x;
    volatile LAS unsigned* MISC = (volatile LAS unsigned*)(ldsl + XTRA_OFF + X_MISC);
    LAS int* tb = (LAS int*)(ldsl + XTRA_OFF + X_TB); LAS int* nn = (LAS int*)(ldsl + XTRA_OFF + X_NN);
    for (int u = tid; u < (LDS_BYTES - XTRA_OFF) / 4; u += NTHR) ((LAS unsigned*)(ldsl + XTRA_OFF))[u] = 0u;
    __syncthreads();
    unsigned char* ws = args.ws;
    unsigned* ctl = (unsigned*)(ws + WS_CTL);
    XcdBarrier bar = xcd_barrier_post(ctl + CW_BAR, MISC + 8);
    const int lo = args.ph_lo, hi = args.ph_hi;
#define IN(k) (lo <= (k) && (k) < hi)
#ifndef REP_MASK
#define REP_MASK 0
#endif
#define PHASE(k, ...) do { if (IN(k)) { for (int rep_ = 0; rep_ < (((REP_MASK >> (k)) & 1) ? 2 : 1); ++rep_) { if (rep_) xcd_barrier(bar); __VA_ARGS__ } } if (IN(k) && IN((k) + 1)) xcd_barrier(bar); } while (0)
    int* cnt = (int*)ctl + CW_CNT; i32x2* list = (i32x2*)(ws + WS_ROUTE + 2 * MiB); float* topg = (float*)(ws + WS_ROUTE + 1 * MiB);
    PHASE(0, ph_mod_prep(args, lds, G););
    PHASE(1, ph_ln1(args, lds, G););
    PHASE(2, { pg8::StaticOrder So; So.init(ws + WS_U1, ws + WS_WTIN, T, NPROJ, D, G, blockIdx.x);
        pg8::EpiBf16 E{(bf16*)(ws + WS_PROJ), NPROJ, 2, QSCALE, 1.f / 64.f};
        pg8::gemm_phase<pg8::EpiBf16, pg8::StaticOrder, false, true>(ldsl, D, So, E); });
    PHASE(3, ml_phaseA(args, ldsl, blockIdx.x, G););
    PHASE(4, ml_phaseB(args, ldsl, blockIdx.x, G); __syncthreads(); attn_phase((const bf16*)(ws + WS_PROJ), (unsigned char*)(ws + WS_MIX), ldsl, blockIdx.x, G, MAKE_PREP_ARGS(args)););
    PHASE(5, ml_phaseC(args, ldsl, G););
    PHASE(6, { pg8::StaticOrder So; So.init(ws + WS_MIX, ws + WS_WTOUT, T, D, D, G, blockIdx.x);
        pg8::EpiBf16 E{(bf16*)(ws + WS_MIXOUT), D, 0, 1.f, 1.f / 64.f};
        pg8::gemm_phase<pg8::EpiBf16, pg8::StaticOrder, false, true>(ldsl, D, So, E); });
    PHASE(7, ph_ln2(args, G););
    PHASE(8, { pg8::StaticOrder So; So.init(ws + WS_U2, ws + WS_WTR, T, NE, 2 * D, G, blockIdx.x);
        pg8::EpiF32 E{(float*)(ws + WS_LOGITS), NE};
        pg8::gemm_phase<pg8::EpiF32, pg8::StaticOrder, false, false>(ldsl, 2 * D, So, E); });
    PHASE(9, { const int lane_ = tid & 63; const f32x4 bias4 = *(const f32x4*)(args.in[13] + 4 * lane_); const PrepArgs pa = MAKE_PREP_ARGS(args);
        int bgit = IT_SMALL + BG_TOTAL + blockIdx.x * NWAVES + (tid >> 6);
        for (int t = blockIdx.x * NWAVES + (tid >> 6); t < T; t += G * NWAVES) {
            const bool bg = bgit < IT_TOTAL; PrepDesc bgd = prep_decode(pa, bg ? bgit : IT_SMALL); f32x4 bgv[16];
            if (bg) prep_load(bgd, lane_, bgv);
            route_wave(t, lane_, (const float*)(ws + WS_LOGITS), bias4, (int*)(ws + WS_ROUTE), topg, cnt);
            if (bg) prep_store(bgd, lane_, bgv);
            bgit += G * NWAVES; } });
    PHASE(10, { moe_tables(cnt, tb, nn); const int* tope = (const int*)(ws + WS_ROUTE); int* fill = (int*)ctl + CW_FILL;
        for (int id = blockIdx.x * NTHR + tid; id < T * TOPK; id += G * NTHR) { const int e = tope[id]; const int pos = atomicAdd(fill + e, 1);
            list[tb[e] * 256 + pos] = (i32x2){id, __float_as_int(topg[id])}; } });
    PHASE(11, { moe_tables(cnt, tb, nn);
        pg8::MoeOrder So{G, (int)blockIdx.x, tb[NEX] * 2, 1, tb, nn, list, (const char*)(ws + WS_U2F8), 0, (const char*)(ws + WS_WT13), (size_t)512 * D, (size_t)256 * D};
        pg8::EpiGlu E{(unsigned char*)(ws + WS_H), 1.f / 64.f};
        pg8::gemm_phase<pg8::EpiGlu, pg8::MoeOrder, true, true>(ldsl, D, So, E); });
    PHASE(12, { moe_tables(cnt, tb, nn);
        pg8::MoeOrder So{G, (int)blockIdx.x, tb[NEX] * 4, 2, tb, nn, list, (const char*)(ws + WS_H), (size_t)256 * FF, (const char*)(ws + WS_WT2), (size_t)D * FF, (size_t)256 * FF};
        pg8::EpiScatter E{(unsigned char*)(ws + WS_YS), (unsigned char*)(ws + WS_YSH), list, nn};
        pg8::gemm_phase<pg8::EpiScatter, pg8::MoeOrder, false, true>(ldsl, FF, So, E); });
    PHASE(13, ph_final(args, G););
#undef PHASE
#undef IN
}

#ifndef MK_UPTO
#define MK_UPTO 14
#endif
__global__ void k_nan_fill(float* out, int n) { for (int i = blockIdx.x * blockDim.x + threadIdx.x; i < n; i += gridDim.x * blockDim.x) out[i] = __builtin_nanf(""); }
extern "C" void kernel_launch(void* const* d_in, const int* in_sizes, int n_in, void* d_out, int out_size, void* d_ws, size_t ws_size, hipStream_t stream) {
    static int grid = 0;
    if (grid == 0) {
        int dev = 0, cus = 0, per_cu = 0; grid = -1;
        if (n_in != 22 || out_size != T * D || ws_size < WS_END) fprintf(stderr, "kernel_launch: unexpected shapes (n_in %d out %d ws %zu, need %zu)\n", n_in, out_size, ws_size, (size_t)WS_END);
        else if (hipGetDevice(&dev) != hipSuccess || hipDeviceGetAttribute(&cus, hipDeviceAttributeMultiprocessorCount, dev) != hipSuccess) fprintf(stderr, "kernel_launch: device query failed\n");
        else if (hipFuncSetAttribute((const void*)mega_fwd, hipFuncAttributeMaxDynamicSharedMemorySize, LDS_BYTES) != hipSuccess) fprintf(stderr, "kernel_launch: hipFuncSetAttribute failed\n");
        else if (hipOccupancyMaxActiveBlocksPerMultiprocessor(&per_cu, (const void*)mega_fwd, NTHR, LDS_BYTES) != hipSuccess || per_cu < 1) fprintf(stderr, "kernel_launch: occupancy query says %d blocks per CU\n", per_cu);
        else grid = cus;
        (void)hipGetLastError();
    }
    if (grid < 0) { k_nan_fill<<<1024, 256, 0, stream>>>((float*)d_out, out_size); return; }
    const float* x = (const float*)d_in[0];
    const float* conv_w = (const float*)d_in[5]; const float* conv_b = (const float*)d_in[6];
    const float* norm_g = (const float*)d_in[8]; const float* ln1_g = (const float*)d_in[10]; const float* ln1_b = (const float*)d_in[11];
    const float* rbias = (const float*)d_in[13]; const float* ln2_g = (const float*)d_in[20]; const float* ln2_b = (const float*)d_in[21];
    char* ws = (char*)d_ws; float* out = (float*)d_out;
    float* mod = (float*)(ws + WS_MOD); bf16* wtin = (bf16*)(ws + WS_WTIN); bf16* wtout = (bf16*)(ws + WS_WTOUT); bf16* wtr = (bf16*)(ws + WS_WTR);
    bf16* wt13 = (bf16*)(ws + WS_WT13); bf16* wt2 = (bf16*)(ws + WS_WT2); int* plan = (int*)(ws + WS_PLAN);
    bf16* u1 = (bf16*)(ws + WS_U1); bf16* proj = (bf16*)(ws + WS_PROJ); float* ipre = (float*)(ws + WS_GATES); float* logf = ipre + 16 * S;
    float* hraw = (float*)(ws + WS_HRAW); bf16* mix = (bf16*)(ws + WS_MIX); bf16* mixout = (bf16*)(ws + WS_MIXOUT); bf16* u2 = (bf16*)(ws + WS_U2);
    float* logits = (float*)(ws + WS_LOGITS); int* tope = (int*)(ws + WS_ROUTE); float* topg = (float*)(ws + WS_ROUTE + 1 * MiB); i32x2* list = (i32x2*)(ws + WS_ROUTE + 2 * MiB);
    bf16* H = (bf16*)(ws + WS_H); bf16* ys = (bf16*)(ws + WS_YS); bf16* ysh = (bf16*)(ws + WS_YSH);
    int* cnt = (int*)(ws + WS_CTL) + CW_CNT;
    (void)hipMemsetAsync(ws + WS_CTL, 0, 1 * MiB, stream);
    if (MK_UPTO > 0) {
        MArgs a{};
        for (int i = 0; i < 22; ++i) a.in[i] = (const float*)d_in[i];
        a.out = out; a.ws = (unsigned char*)d_ws; a.ph_lo = 0; a.ph_hi = MK_UPTO;
        hipLaunchKernelGGL(mega_fwd, dim3(grid), dim3(NTHR), LDS_BYTES, stream, a);
    }
}
```

```cpp
#include <hip/hip_runtime.h>
#include <cstdio>
#include <cstdint>

typedef unsigned short bf16;
typedef unsigned v4u __attribute__((ext_vector_type(4)));
typedef float f32x4 __attribute__((ext_vector_type(4)));
typedef int i32x2 __attribute__((ext_vector_type(2)));
typedef float f32x2 __attribute__((ext_vector_type(2)));

constexpr int D = 1024, NB = 4, S = 8192, T = NB * S;
constexpr int NPROJ = 3584, WIN_LD = 3592;
constexpr int C_SBQ = 0, C_SBK = 512, C_SBV = 1024, C_MLQ = 1536, C_MLK = 2048, C_MLV = 2560, C_MLO = 3072, C_GATE = 3584;
constexpr int NE = 256, NEX = 257, TOPK = 8, FF = 256;
constexpr float LN_EPS = 1e-5f;
constexpr float DN_ALPHA = 1.189207115002721f;
constexpr float LOG2E = 1.4426950408889634f;
constexpr float QSCALE = 0.125f * LOG2E;
constexpr float SB_THRESH = 48.0f;

constexpr size_t MiB = 1u << 20;
constexpr size_t WS_CTL = 0;
constexpr size_t WS_MOD = 1 * MiB;
constexpr size_t WS_WTIN = 2 * MiB;
constexpr size_t WS_WTOUT = 10 * MiB;
constexpr size_t WS_WTR = 12 * MiB;
constexpr size_t WS_WT2 = 16 * MiB;
constexpr size_t WS_YS = 145 * MiB;
constexpr size_t WS_WT13 = 145 * MiB;
constexpr size_t WS_U2F8 = 274 * MiB;
constexpr size_t WS_PROJ = 402 * MiB;
constexpr size_t WS_GATES = 626 * MiB;
constexpr size_t WS_H = 402 * MiB;
constexpr size_t WS_X1 = 757 * MiB;
constexpr size_t WS_STATES = 657 * MiB;
constexpr size_t WS_MIXOUT = 657 * MiB;
constexpr size_t WS_LOGITS = 657 * MiB;
constexpr size_t WS_U1 = 725 * MiB;
constexpr size_t WS_MIX = 725 * MiB;
constexpr size_t WS_U2 = 833 * MiB;
constexpr size_t WS_YSH = 833 * MiB;
constexpr size_t WS_ROUTE = 897 * MiB;
constexpr size_t WS_END = 902 * MiB;
constexpr int CW_CNT = 1024;
constexpr int CW_FILL = 1536;

__device__ __forceinline__ unsigned f2bf(float f) { unsigned u = __builtin_bit_cast(unsigned, f); return (u + 0x7fffu + ((u >> 16) & 1u)) >> 16; }
__device__ __forceinline__ float bf2f(unsigned b) { return __builtin_bit_cast(float, b << 16); }
__device__ __forceinline__ unsigned pk2(float lo, float hi) { return f2bf(lo) | (f2bf(hi) << 16); }
__device__ __forceinline__ unsigned pk4_fp8(float a, float b, float c, float d) { int w = 0; w = __builtin_amdgcn_cvt_pk_fp8_f32(a, b, w, false); w = __builtin_amdgcn_cvt_pk_fp8_f32(c, d, w, true); return (unsigned)w; }
__device__ __forceinline__ float wave_sum(float v) {
    v += __builtin_bit_cast(float, __builtin_amdgcn_update_dpp(0, __builtin_bit_cast(int, v), 0xB1, 0xF, 0xF, true));
    v += __builtin_bit_cast(float, __builtin_amdgcn_update_dpp(0, __builtin_bit_cast(int, v), 0x4E, 0xF, 0xF, true));
    v += __builtin_bit_cast(float, __builtin_amdgcn_update_dpp(0, __builtin_bit_cast(int, v), 0x141, 0xF, 0xF, true));
    v += __builtin_bit_cast(float, __builtin_amdgcn_update_dpp(0, __builtin_bit_cast(int, v), 0x140, 0xF, 0xF, true));
    const int iv = __builtin_bit_cast(int, v);
    const float r0 = __builtin_bit_cast(float, __builtin_amdgcn_readlane(iv, 0)), r1 = __builtin_bit_cast(float, __builtin_amdgcn_readlane(iv, 16));
    const float r2 = __builtin_bit_cast(float, __builtin_amdgcn_readlane(iv, 32)), r3 = __builtin_bit_cast(float, __builtin_amdgcn_readlane(iv, 48));
    return (r0 + r1) + (r2 + r3);
}
__device__ __forceinline__ float sigmoidf_(float x) { return 1.f / (1.f + __expf(-x)); }
__device__ __forceinline__ float siluf_(float x) { return x / (1.f + __expf(-x)); }


struct PrepArgs { const float *w_in, *w_out, *w_router, *w1, *w3, *w2, *sw1, *sw3, *sw2; unsigned char* wtin; bf16 *wtout, *wtr; unsigned char* wt13; unsigned char* wt2; };
struct PrepDesc { const float* src; unsigned char* dst; int ldw, ldt, k0, n0, rowmap, f8; };
constexpr int IT_IN = 16 * 56, IT_OUT = 16 * 16, IT_R = 16 * 4, IT_E = 192, IT_TOTAL = IT_IN + IT_OUT + IT_R + NEX * IT_E;
__device__ __forceinline__ PrepDesc prep_decode(const PrepArgs& a, int it) {
    if (it < IT_IN) return PrepDesc{a.w_in, a.wtin, WIN_LD, D, (it / 112) * 128, (it % 112) * 32, 0, 1}; it -= IT_IN;
    if (it < IT_OUT) return PrepDesc{a.w_out, (unsigned char*)a.wtout, D, D, (it / 32) * 128, (it % 32) * 32, 0, 1}; it -= IT_OUT;
    if (it < IT_R) return PrepDesc{a.w_router, (unsigned char*)a.wtr, NE, D, (it / 4) * 64, (it % 4) * 64, 0, 0}; it -= IT_R;
    const int e = it / IT_E, r = it % IT_E;
    if (r < 64) return PrepDesc{e < NE ? a.w1 + (size_t)e * D * FF : a.sw1, a.wt13 + (size_t)e * 512 * D, FF, D, (r / 8) * 128, (r % 8) * 32, 1, 1};
    if (r < 128) { const int q = r - 64; return PrepDesc{e < NE ? a.w3 + (size_t)e * D * FF : a.sw3, a.wt13 + (size_t)e * 512 * D, FF, D, (q / 8) * 128, (q % 8) * 32, 2, 1}; }
    const int q = r - 128; return PrepDesc{e < NE ? a.w2 + (size_t)e * FF * D : a.sw2, a.wt2 + (size_t)e * D * FF, D, FF, (q / 32) * 128, (q % 32) * 32, 0, 1};
}
__device__ __forceinline__ void prep_load(const PrepDesc& d, int lane, f32x4 (&v)[16]) {
    const int g = d.f8 ? (lane >> 3) : (lane >> 4), i = d.f8 ? (lane & 7) : (lane & 15);
#pragma unroll
    for (int r = 0; r < 16; ++r) v[r] = __builtin_nontemporal_load((const f32x4*)(d.src + (size_t)(d.k0 + 16 * g + r) * d.ldw + d.n0 + 4 * i));
}
__device__ __forceinline__ void prep_store(const PrepDesc& d, int lane, const f32x4 (&v)[16]) {
    const int g = d.f8 ? (lane >> 3) : (lane >> 4), i = d.f8 ? (lane & 7) : (lane & 15);
#pragma unroll
    for (int nn = 0; nn < 4; ++nn) {
        const int n = d.n0 + 4 * i + nn;
        const int dr = d.rowmap == 0 ? n : ((n >> 7) * 256 + (d.rowmap == 2 ? 128 : 0) + (n & 127));
        if (d.f8) {
            v4u o; o.x = pk4_fp8(v[0][nn] * 64.f, v[1][nn] * 64.f, v[2][nn] * 64.f, v[3][nn] * 64.f); o.y = pk4_fp8(v[4][nn] * 64.f, v[5][nn] * 64.f, v[6][nn] * 64.f, v[7][nn] * 64.f);
            o.z = pk4_fp8(v[8][nn] * 64.f, v[9][nn] * 64.f, v[10][nn] * 64.f, v[11][nn] * 64.f); o.w = pk4_fp8(v[12][nn] * 64.f, v[13][nn] * 64.f, v[14][nn] * 64.f, v[15][nn] * 64.f);
            *(v4u*)(d.dst + (size_t)dr * d.ldt + d.k0 + 16 * g) = o;
        } else {
            v4u o0, o1; o0.x = pk2(v[0][nn], v[1][nn]); o0.y = pk2(v[2][nn], v[3][nn]); o0.z = pk2(v[4][nn], v[5][nn]); o0.w = pk2(v[6][nn], v[7][nn]);
            o1.x = pk2(v[8][nn], v[9][nn]); o1.y = pk2(v[10][nn], v[11][nn]); o1.z = pk2(v[12][nn], v[13][nn]); o1.w = pk2(v[14][nn], v[15][nn]);
            v4u* dp = (v4u*)((bf16*)d.dst + (size_t)dr * d.ldt + d.k0 + 16 * g); dp[0] = o0; dp[1] = o1;
        }
    }
}
constexpr int IT_SMALL = IT_IN + IT_OUT + IT_R;
constexpr int BG_A = 16 * (S / 64) * 8, BG_C = BG_A, BG_T = NB * 8 * (S / 32), BG_TOTAL = BG_A + BG_C + BG_T;
constexpr int IT_FG = IT_SMALL;
static_assert(IT_SMALL + BG_TOTAL <= IT_TOTAL, "background slots exceed the expert items");
__device__ __forceinline__ int prep_fg_item(int j) { return j < IT_SMALL ? j : j + BG_TOTAL; }
__device__ __forceinline__ void prep_run(const PrepArgs& a, int it0, int stride, int lane) {
    int it = it0; if (it >= IT_FG) return;
    PrepDesc dA = prep_decode(a, prep_fg_item(it)), dB = dA; f32x4 va[16], vb[16]; prep_load(dA, lane, va);
    for (;;) {
        const int itB = it + stride; const bool hasB = itB < IT_FG;
        if (hasB) { dB = prep_decode(a, prep_fg_item(itB)); prep_load(dB, lane, vb); }
        prep_store(dA, lane, va);
        if (!hasB) break;
        const int itA = itB + stride; const bool hasA = itA < IT_FG;
        if (hasA) { dA = prep_decode(a, prep_fg_item(itA)); prep_load(dA, lane, va); }
        prep_store(dB, lane, vb);
        if (!hasA) break;
        it = itA;
    }
}


__device__ __forceinline__ f32x4 ld_bf4(const bf16* p) { const unsigned long long w = *(const unsigned long long*)p;
    return (f32x4){bf2f((unsigned)w & 0xffffu), bf2f(((unsigned)w) >> 16), bf2f((unsigned)(w >> 32) & 0xffffu), bf2f((unsigned)(w >> 48))}; }

#define LAS __attribute__((address_space(3)))
#define GAS __attribute__((address_space(1)))
namespace pg8 {
typedef short bf16x8 __attribute__((ext_vector_type(8)));
constexpr int F8_SCALE_W = 121;
constexpr int BM = 256, BK = 64, HALF = 128, HTB = HALF * BK * 2, STAGE_BYTES = 8 * HTB, NXCD = 8, WGM = 8;
__host__ __device__ __forceinline__ int lds_byte(int r, int c) { const int st = (r >> 4) * 2 + (c >> 5), rr = r & 15, cc = c & 31, ob = rr * 64 + cc * 2; return st * 1024 + (ob ^ (((ob >> 9) & 1) << 5)); }
__host__ __device__ __forceinline__ void stage_rc(int b, int& R, int& C) { const int st = b / 1024, sb = b % 1024, swz = sb ^ (((sb >> 9) & 1) << 5); R = (st >> 1) * 16 + swz / 64; C = (st & 1) * 32 + (swz % 64) / 2; }
__host__ __device__ __forceinline__ int perm16x(int R) { return 64 * (R >> 5) + 16 * ((R & 15) >> 2) + 4 * ((R >> 4) & 1) + (R & 3); }
__host__ __device__ __forceinline__ int perm32(int rho) { const int n = rho >> 4, i = rho & 15; return 8 * (i >> 2) + 4 * n + (i & 3); }

struct Unit { int pm, pn, e, mt; const char* A; const char* B; };

__device__ __forceinline__ long unit_index(int i, int G, int c) { return (G % 8 == 0) ? ((long)(i * 8 + (c & 7)) * (G / 8) + (c >> 3)) : ((long)i * G + c); }

struct StaticOrder {
    int nM, nN, nwg, G, c; const char* A; const char* B; size_t tstep;
    __device__ void init(const void* A_, const void* B_, int M, int N, int Kb, int G_, int c_) { nM = M / BM; nN = N / BM; nwg = nM * nN; G = G_; c = c_; A = (const char*)A_; B = (const char*)B_; tstep = (size_t)BM * Kb; }
    __device__ __forceinline__ bool next(int i, Unit& u) const {
        const long L = (long)i * G + c; if (L >= nwg) return false;
        int wgid = (int)L; { const int q = nwg / NXCD, r = nwg % NXCD, xcd = wgid % NXCD, off = wgid / NXCD; wgid = (xcd < r ? xcd * (q + 1) : r * (q + 1) + (xcd - r) * q) + off; }
        const int nig = WGM * nN, gid = wgid / nig, fm = gid * WGM, gsz = (nM - fm) < WGM ? (nM - fm) : WGM;
        u.pm = fm + ((wgid % nig) % gsz); u.pn = (wgid % nig) / gsz; u.e = 0; u.mt = u.pm; u.A = A + (size_t)u.pm * tstep; u.B = B + (size_t)u.pn * tstep; return true;
    }
    __device__ __forceinline__ int row_token(const Unit&, int) const { return 0; }
};

struct MoeOrder {
    int G, c, total, shift; const LAS int* tb; const LAS int* nn; const i32x2* list;
    const char* Abase; size_t a_tile_stride; const char* Bbase; size_t b_exp_stride, b_pn_stride;
    __device__ __forceinline__ bool next(int i, Unit& u) const {
        const long L = unit_index(i, G, c); if (L >= total) return false;
        const int tile = (int)(L >> shift); u.pn = (int)(L & ((1 << shift) - 1));
        int lo = 0, hi = NEX; while (hi - lo > 1) { const int mid = (lo + hi) >> 1; if (tb[mid] <= tile) lo = mid; else hi = mid; }
        u.e = lo; u.mt = tile - tb[lo]; u.pm = tile;
        u.A = Abase + (size_t)tile * a_tile_stride; u.B = Bbase + (size_t)lo * b_exp_stride + (size_t)u.pn * b_pn_stride; return true;
    }
    __device__ __forceinline__ int row_token(const Unit& u, int row) const {
        const int rr = u.mt * 256 + row;
        const int tok = list[u.pm * 256 + row].x >> 3;
        return u.e >= NE ? rr : (rr < nn[u.e] ? tok : 0);
    }
};

__device__ __forceinline__ unsigned cvt_pk_bf16(float lo, float hi) { unsigned r; asm volatile("v_cvt_pk_bf16_f32 %0, %1, %2" : "=v"(r) : "v"(lo), "v"(hi)); return r; }

struct EpiBf16 {
    static constexpr int PERM = 2; bf16* O; int ldc; int scale_tiles; float scale; float gscale;
    __device__ __forceinline__ void operator()(const f32x4 (&acc)[2][2][4][2], const Unit& u, int wr, int wc, int fr, int fq) const {
        const int row0 = u.pm * BM + wr * 64 + fr, col0 = u.pn * BM + wc * 64 + 16 * fq; const float sc = (u.pn < scale_tiles ? scale : 1.f) * gscale;
#pragma unroll
        for (int ai = 0; ai < 2; ++ai)
#pragma unroll
            for (int m = 0; m < 4; ++m) { bf16* rowp = O + (size_t)(row0 + ai * HALF + m * 16) * ldc + col0;
#pragma unroll
                for (int bj = 0; bj < 2; ++bj) { const f32x4 v0 = acc[ai][bj][m][0] * sc, v1 = acc[ai][bj][m][1] * sc;
                    v4u w; w.x = cvt_pk_bf16(v0[0], v0[1]); w.y = cvt_pk_bf16(v0[2], v0[3]); w.z = cvt_pk_bf16(v1[0], v1[1]); w.w = cvt_pk_bf16(v1[2], v1[3]);
                    *(v4u*)(rowp + bj * 8) = w; } }
    }
};
struct EpiF32 {
    static constexpr int PERM = 0; float* C; int ldc;
    __device__ __forceinline__ void operator()(const f32x4 (&acc)[2][2][4][2], const Unit& u, int wr, int wc, int fr, int fq) const {
        const int row0 = u.pm * BM + wr * 64 + fr, col0 = u.pn * BM + wc * 32 + 4 * fq;
#pragma unroll
        for (int ai = 0; ai < 2; ++ai)
#pragma unroll
            for (int m = 0; m < 4; ++m) { float* rowp = C + (size_t)(row0 + ai * HALF + m * 16) * ldc + col0;
#pragma unroll
                for (int bj = 0; bj < 2; ++bj)
#pragma unroll
                    for (int n = 0; n < 2; ++n) *(f32x4*)(rowp + bj * HALF + n * 16) = acc[ai][bj][m][n]; }
    }
};
struct EpiGlu {
    static constexpr int PERM = 1; unsigned char* H; float gscale;
    __device__ __forceinline__ void operator()(const f32x4 (&acc)[2][2][4][2], const Unit& u, int wr, int wc, int fr, int fq) const {
        const int row0 = u.pm * BM + wr * 64 + fr, col0 = u.pn * HALF + wc * 32 + 8 * fq;
#pragma unroll
        for (int ai = 0; ai < 2; ++ai)
#pragma unroll
            for (int m = 0; m < 4; ++m) { float h[8];
#pragma unroll
                for (int n = 0; n < 2; ++n)
#pragma unroll
                    for (int q = 0; q < 4; ++q) { const float a = acc[ai][0][m][n][q] * gscale; h[n * 4 + q] = a * __builtin_amdgcn_rcpf(1.f + __expf(-a)) * (acc[ai][1][m][n][q] * gscale); }
                *(unsigned long long*)(H + (size_t)(row0 + ai * HALF + m * 16) * FF + col0) = (unsigned long long)pk4_fp8(h[0], h[1], h[2], h[3]) | ((unsigned long long)pk4_fp8(h[4], h[5], h[6], h[7]) << 32); }
    }
};
struct EpiScatter {
    static constexpr int PERM = 2; unsigned char* ys8; unsigned char* ysh8; const i32x2* list; const LAS int* nn;
    __device__ __forceinline__ void operator()(const f32x4 (&acc)[2][2][4][2], const Unit& u, int wr, int wc, int fr, int fq) const {
        const int col0 = u.pn * BM + wc * 64 + 16 * fq; const int n = nn[u.e]; const bool routed = u.e < NE;
        const i32x2* lp = list + (size_t)(u.pm - u.mt) * 256;
#pragma unroll
        for (int ai = 0; ai < 2; ++ai) {
            i32x2 en[4];
#pragma unroll
            for (int m = 0; m < 4; ++m) { const int rr = u.mt * 256 + ai * HALF + wr * 64 + m * 16 + fr; const i32x2 ld = lp[rr];
                en[m].x = routed ? ld.x : rr; en[m].y = routed ? ld.y : 0x3f800000; }
#pragma unroll
            for (int m = 0; m < 4; ++m) { const int rr = u.mt * 256 + ai * HALF + wr * 64 + m * 16 + fr;
                if (rr < n) { const float g = __int_as_float(en[m].y) * (16.f / 64.f);
                    const f32x4 a0 = acc[ai][0][m][0] * g, a1 = acc[ai][0][m][1] * g, b0 = acc[ai][1][m][0] * g, b1 = acc[ai][1][m][1] * g;
                    v4u w; w.x = pk4_fp8(a0[0], a0[1], a0[2], a0[3]); w.y = pk4_fp8(a1[0], a1[1], a1[2], a1[3]); w.z = pk4_fp8(b0[0], b0[1], b0[2], b0[3]); w.w = pk4_fp8(b1[0], b1[1], b1[2], b1[3]);
                    *(v4u*)((routed ? ys8 : ysh8) + (size_t)en[m].x * D + col0) = w; } }
            __builtin_amdgcn_sched_barrier(0);
        }
    }
};

typedef int i32x8 __attribute__((ext_vector_type(8)));
typedef int i32x4 __attribute__((ext_vector_type(4)));
template <bool FP8> struct FragT { struct A4 { bf16x8 v[4][2]; }; struct B2 { bf16x8 v[2][2]; }; };
template <> struct FragT<true> { struct A4 { i32x8 v[4]; }; struct B2 { i32x8 v[2]; }; };
template <class Epi, class Sched, bool GATHER, bool FP8>
__device__ __forceinline__ void gemm_phase(LAS unsigned char* lds, const int Kb, const Sched& S, const Epi& E) {
    const int tid = threadIdx.x, wid = __builtin_amdgcn_readfirstlane(tid >> 6), lane = tid & 63, wr = wid >> 2, wc = wid & 3, fr = lane & 15, fq = lane >> 4;
    const int nt = Kb / 128;
    int sR[2], sC[2];
    unsigned voffA[2], voffB[2];
#pragma unroll
    for (int i = 0; i < 2; ++i) { stage_rc(tid * 16 + i * 8192, sR[i], sC[i]); const int Rb = Epi::PERM == 2 ? perm16x(sR[i]) : (Epi::PERM == 1 ? ((sR[i] & ~31) + perm32(sR[i] & 31)) : sR[i]);
        voffA[i] = (unsigned)(sR[i] * Kb + sC[i] * 2); voffB[i] = (unsigned)(Rb * Kb + sC[i] * 2); }
    const size_t kstep = (size_t)(BK * 2);
    const size_t hstep = (size_t)HALF * Kb;
    const size_t bhstep = Epi::PERM == 2 ? (size_t)8 * Kb : hstep;
    const unsigned ldsw = (unsigned)wid * 1024u;
    const int aoff = lds_byte(wr * 64 + fr, fq * 8), boff = lds_byte(wc * 32 + fr, fq * 8);
    unsigned gc[2][2], gn[2][2];
#define PG8_SA(b, h) (((b) * 2 + (h)) * HTB)
#define PG8_SB(b, h) ((4 + (b) * 2 + (h)) * HTB)
#define PG8_GLDS(src, bufoff, i) __builtin_amdgcn_global_load_lds((const unsigned*)(src), (LAS unsigned*)(lds + (bufoff) + ldsw + (i) * 8192), 16, 0, 0)
#define PG8_STAGE_B(bufoff, gbase) do { PG8_GLDS((const char*)(gbase) + voffB[0], bufoff, 0); PG8_GLDS((const char*)(gbase) + voffB[1], bufoff, 1); } while (0)
#define PG8_STAGE_A(bufoff, gbase, h, nx) do { if constexpr (GATHER) { const unsigned _o0 = (nx) ? gn[h][0] : gc[h][0], _o1 = (nx) ? gn[h][1] : gc[h][1]; \
            PG8_GLDS((const char*)(gbase) + _o0, bufoff, 0); PG8_GLDS((const char*)(gbase) + _o1, bufoff, 1); } \
        else { PG8_GLDS((const char*)(gbase) + (h) * hstep + voffA[0], bufoff, 0); PG8_GLDS((const char*)(gbase) + (h) * hstep + voffA[1], bufoff, 1); } } while (0)
#define PG8_LD2(dstv, p) do { if constexpr (FP8) { const i32x4 _lo = *(const LAS i32x4*)(p), _hi = *(const LAS i32x4*)((p) + 1024); dstv = __builtin_shufflevector(_lo, _hi, 0, 1, 2, 3, 4, 5, 6, 7); } } while (0)
#define PG8_LDA(dst, b, h) do { _Pragma("unroll") for (int m = 0; m < 4; ++m) { if constexpr (FP8) { PG8_LD2(dst.v[m], lds + PG8_SA(b, h) + aoff + m * 2048); } \
        else { _Pragma("unroll") for (int k = 0; k < 2; ++k) dst.v[m][k] = *(const LAS bf16x8*)(lds + PG8_SA(b, h) + aoff + m * 2048 + k * 1024); } } } while (0)
#define PG8_LDB(dst, b, h) do { _Pragma("unroll") for (int n = 0; n < 2; ++n) { if constexpr (FP8) { PG8_LD2(dst.v[n], lds + PG8_SB(b, h) + boff + n * 2048); } \
        else { _Pragma("unroll") for (int k = 0; k < 2; ++k) dst.v[n][k] = *(const LAS bf16x8*)(lds + PG8_SB(b, h) + boff + n * 2048 + k * 1024); } } } while (0)
#define PG8_MMA(ai, bj, At, Bt) do { __builtin_amdgcn_s_setprio(1); _Pragma("unroll") for (int m = 0; m < 4; ++m) _Pragma("unroll") for (int n = 0; n < 2; ++n) { \
        if constexpr (FP8) asm volatile("s_nop 1\n\tv_mfma_scale_f32_16x16x128_f8f6f4 %0, %1, %2, %0, %3, %3 op_sel_hi:[0,0,0]" : "+v"(acc[ai][bj][m][n]) : "v"(Bt.v[n]), "v"(At.v[m]), "v"(f8scale)); \
        else { _Pragma("unroll") for (int k = 0; k < 2; ++k) acc[ai][bj][m][n] = __builtin_amdgcn_mfma_f32_16x16x32_bf16(Bt.v[n][k], At.v[m][k], acc[ai][bj][m][n], 0, 0, 0); } } \
        __builtin_amdgcn_s_setprio(0); } while (0)
#define PG8_WAIT_V(n) asm volatile("s_waitcnt vmcnt(" #n ")" ::: "memory")
#define PG8_WAIT_L(n) asm volatile("s_waitcnt lgkmcnt(" #n ")" ::: "memory")
#define PG8_BAR __builtin_amdgcn_s_barrier()
#define PG8_SCHED __builtin_amdgcn_sched_barrier(0)
#define PG8_GATHER(dst, u) do { _Pragma("unroll") for (int _h = 0; _h < 2; ++_h) _Pragma("unroll") for (int _i = 0; _i < 2; ++_i) \
        dst[_h][_i] = (unsigned)(S.row_token(u, _h * HALF + sR[_i]) * Kb + sC[_i] * 2); } while (0)
    Unit cur, nxt; int ui = 0;
    if (!S.next(0, cur)) return;
    f32x4 acc[2][2][4][2];
#pragma unroll
    for (int a = 0; a < 2; ++a)
#pragma unroll
        for (int b = 0; b < 2; ++b)
#pragma unroll
            for (int m = 0; m < 4; ++m)
#pragma unroll
                for (int n = 0; n < 2; ++n) acc[a][b][m][n] = (f32x4){0.f, 0.f, 0.f, 0.f};
    const int f8scale = 0x7f7f7f7f;
    typedef typename FragT<FP8>::A4 FragA; typedef typename FragT<FP8>::B2 FragB;
    FragA At; FragB B0, B1;
    const char* cA = cur.A; const char* cB = cur.B;
    if constexpr (GATHER) { PG8_GATHER(gc, cur); }
    PG8_STAGE_B(PG8_SB(0, 0), cB); PG8_STAGE_A(PG8_SA(0, 0), cA, 0, false); PG8_STAGE_B(PG8_SB(0, 1), cB + bhstep); PG8_STAGE_A(PG8_SA(0, 1), cA, 1, false);
    if (wr == 1) PG8_BAR;
    PG8_WAIT_V(4); PG8_BAR;
    PG8_STAGE_B(PG8_SB(1, 0), cB + kstep); PG8_STAGE_A(PG8_SA(1, 0), cA + kstep, 0, false); PG8_STAGE_B(PG8_SB(1, 1), cB + bhstep + kstep);
    PG8_WAIT_V(6); PG8_BAR;
    for (;;) {
        const bool has_next = S.next(ui + 1, nxt);
        const char* nA = has_next ? nxt.A : cA; const char* nB = has_next ? nxt.B : cB;
        if constexpr (GATHER) { if (has_next) { PG8_GATHER(gn, nxt); } else {
#pragma unroll
            for (int h = 0; h < 2; ++h) { gn[h][0] = gc[h][0]; gn[h][1] = gc[h][1]; } } }
#pragma unroll 1
        for (int t = 0; t < nt; t += 2) {
            const bool last = (t == nt - 2);
            const char* a1 = cA + (size_t)(t + 1) * kstep;
            const char* a2 = last ? nA : cA + (size_t)(t + 2) * kstep; const char* b2 = last ? nB : cB + (size_t)(t + 2) * kstep;
            const char* a3 = a2 + kstep; const char* b3 = b2 + kstep;
            PG8_LDB(B0, 0, 0); PG8_SCHED; PG8_LDA(At, 0, 0); PG8_STAGE_A(PG8_SA(1, 1), a1, 1, false);
            PG8_WAIT_L(8); PG8_BAR; PG8_WAIT_L(0); PG8_MMA(0, 0, At, B0); PG8_BAR; PG8_SCHED;
            PG8_LDB(B1, 0, 1); PG8_STAGE_B(PG8_SB(0, 0), b2);
            PG8_BAR; PG8_WAIT_L(0); PG8_MMA(0, 1, At, B1); PG8_BAR;
            PG8_LDA(At, 0, 1); PG8_STAGE_A(PG8_SA(0, 0), a2, 0, last);
            PG8_BAR; PG8_WAIT_L(0); PG8_MMA(1, 0, At, B0); PG8_BAR; PG8_SCHED;
            PG8_STAGE_B(PG8_SB(0, 1), b2 + bhstep);
            PG8_WAIT_V(6); PG8_BAR; PG8_MMA(1, 1, At, B1); PG8_BAR;
            PG8_LDB(B0, 1, 0); PG8_SCHED; PG8_LDA(At, 1, 0); PG8_STAGE_A(PG8_SA(0, 1), a2, 1, last);
            PG8_WAIT_L(8); PG8_BAR; PG8_WAIT_L(0); PG8_MMA(0, 0, At, B0); PG8_BAR; PG8_SCHED;
            PG8_LDB(B1, 1, 1); PG8_STAGE_B(PG8_SB(1, 0), b3);
            PG8_BAR; PG8_WAIT_L(0); PG8_MMA(0, 1, At, B1); PG8_BAR;
            PG8_LDA(At, 1, 1); PG8_STAGE_A(PG8_SA(1, 0), a3, 0, last);
            PG8_BAR; PG8_WAIT_L(0); PG8_MMA(1, 0, At, B0); PG8_BAR; PG8_SCHED;
            PG8_STAGE_B(PG8_SB(1, 1), b3 + bhstep);
            PG8_WAIT_V(6); PG8_BAR; PG8_MMA(1, 1, At, B1); PG8_BAR;
        }
        if (wr == 0) PG8_BAR;
        if constexpr (FP8) { __builtin_amdgcn_sched_barrier(0); asm volatile("s_nop 15\n\ts_nop 7" ::: "memory"); __builtin_amdgcn_sched_barrier(0); }
        E(acc, cur, wr, wc, fr, fq);
        if (!has_next) break;
#pragma unroll
        for (int a = 0; a < 2; ++a)
#pragma unroll
            for (int b = 0; b < 2; ++b)
#pragma unroll
                for (int m = 0; m < 4; ++m)
#pragma unroll
                    for (int n = 0; n < 2; ++n) acc[a][b][m][n] = (f32x4){0.f, 0.f, 0.f, 0.f};
        cur = nxt; cA = nA; cB = nB; ++ui;
        if (wr == 1) PG8_BAR;
        if constexpr (GATHER) {
#pragma unroll
            for (int h = 0; h < 2; ++h) { gc[h][0] = gn[h][0]; gc[h][1] = gn[h][1]; } }
    }
    PG8_WAIT_V(0);
    PG8_BAR;
#undef PG8_SA
#undef PG8_SB
#undef PG8_GLDS
#undef PG8_STAGE_A
#undef PG8_STAGE_B
#undef PG8_LDA
#undef PG8_LDB
#undef PG8_MMA
#undef PG8_WAIT_V
#undef PG8_WAIT_L
#undef PG8_BAR
#undef PG8_SCHED
#undef PG8_GATHER
}
}

#define XB_TMO      128
#define XB_XCNT(j)  (256  + 64 * (j))
#define XB_XSUB(j)  (1280 + 64 * (j))
#define XB_XGEN(j)  (2304 + 64 * (j))
#define XB_TOP      3328
#define XB_TOPGEN   3392
#define XCD_BAR_WORDS 3456
#define XB_SPIN_CAP (1u << 22)
__device__ __forceinline__ unsigned xb_ld(unsigned* p)              { return __hip_atomic_load(p, __ATOMIC_RELAXED, __HIP_MEMORY_SCOPE_AGENT); }
__device__ __forceinline__ unsigned xb_add(unsigned* p, unsigned v) { return __hip_atomic_fetch_add(p, v, __ATOMIC_RELAXED, __HIP_MEMORY_SCOPE_AGENT); }
__device__ __forceinline__ unsigned xb_xcc_id() { return (unsigned)__builtin_amdgcn_s_getreg((3 << 11) | 20) & 0xFu; }
#define XB_SPIN(cond, bar) do { unsigned _sp = 0; while (cond) { __builtin_amdgcn_s_sleep(1); \
    if ((++_sp & 255u) == 0u) { if (xb_ld(&(bar)[XB_TMO])) break; if (_sp > XB_SPIN_CAP) { atomicAdd(&(bar)[XB_TMO], 1u); break; } } } } while (0)
struct XcdBarrier { unsigned* bar; unsigned x; volatile LAS unsigned* st; };
__device__ __forceinline__ XcdBarrier xcd_barrier_post(unsigned* bar, volatile LAS unsigned* st) {
    XcdBarrier b; b.bar = bar; b.x = xb_xcc_id(); b.st = st;
    if (threadIdx.x == 0) (void)xb_add(&bar[XB_XCNT(b.x)], 1u);
    return b;
}
__device__ __forceinline__ void xcd_barrier_complete(unsigned* bar, unsigned x, unsigned& nloc, unsigned& nx) {
    const unsigned G = gridDim.x * gridDim.y * gridDim.z;
    unsigned sum, cnt, mine, sp = 0u;
    for (;;) {
        sum = 0u; cnt = 0u; mine = 0u;
#pragma unroll
        for (unsigned j = 0; j < 16; ++j) { const unsigned c = xb_ld(&bar[XB_XCNT(j)]); sum += c; cnt += (c > 0u) ? 1u : 0u; mine = (j == x) ? c : mine; }
        if (sum == G) break;
        __builtin_amdgcn_s_sleep(1);
        if ((++sp & 255u) == 0u) { if (xb_ld(&bar[XB_TMO])) break; if (sp > XB_SPIN_CAP) { atomicAdd(&bar[XB_TMO], 1u); break; } }
    }
    nloc = mine > 0u ? mine : 1u; nx = cnt > 0u ? cnt : 1u;
}
__device__ __forceinline__ void xcd_barrier(const XcdBarrier& b) {
    asm volatile("s_waitcnt vmcnt(0)" ::: "memory");
    __syncthreads();
    if (threadIdx.x == 0) {
        unsigned* bar = b.bar;
        __builtin_amdgcn_s_waitcnt(0);
        unsigned nloc = b.st[0], nx = b.st[1];
        if (nloc == 0u) { xcd_barrier_complete(bar, b.x, nloc, nx); b.st[0] = nloc; b.st[1] = nx; }
        const unsigned old = xb_add(&bar[XB_XSUB(b.x)], 1u);
        const unsigned gen = old / nloc;
        if (old + 1u == (gen + 1u) * nloc) {
            __builtin_amdgcn_fence(__ATOMIC_RELEASE, "agent");
            asm volatile("s_waitcnt vmcnt(0)" ::: "memory");
            const unsigned og = xb_add(&bar[XB_TOP], 1u);
            const unsigned tg = og / nx;
            if (og + 1u == (tg + 1u) * nx) xb_add(&bar[XB_TOPGEN], 1u);
            else XB_SPIN(xb_ld(&bar[XB_TOPGEN]) == tg, bar);
            __builtin_amdgcn_fence(__ATOMIC_ACQUIRE, "agent");
            xb_add(&bar[XB_XGEN(b.x)], 1u);
            asm volatile("s_waitcnt vmcnt(0)" ::: "memory");
        } else {
            XB_SPIN(xb_ld(&bar[XB_XGEN(b.x)]) == gen, bar);
            __builtin_amdgcn_fence(__ATOMIC_ACQUIRE, "agent");
            asm volatile("s_waitcnt vmcnt(0)" ::: "memory");
        }
    }
    __syncthreads();
}

constexpr int NWAVES = 8, NTHR = 512;
constexpr int RING_BYTES = 131072, XTRA_OFF = RING_BYTES, LDS_BYTES = 147456;
constexpr int X_MISC = 0, X_TB = 256, X_NN = 1536;
constexpr int CW_BAR = 4096;
constexpr int N_PHASES = 14;
struct MArgs { const float* in[22]; float* out; unsigned char* ws; int ph_lo, ph_hi; };

#define MAKE_PREP_ARGS(a) PrepArgs{(a).in[4], (a).in[9], (a).in[12], (a).in[14], (a).in[15], (a).in[16], (a).in[17], (a).in[18], (a).in[19], \
    (unsigned char*)((a).ws + WS_WTIN), (bf16*)((a).ws + WS_WTOUT), (bf16*)((a).ws + WS_WTR), (unsigned char*)((a).ws + WS_WT13), (unsigned char*)((a).ws + WS_WT2)}
__device__ __forceinline__ void ph_mod_prep(const MArgs& a, unsigned char* smem, int G) {
    const int tid = threadIdx.x;
    unsigned char* ws = a.ws;
    if ((int)blockIdx.x < 192) {
        float* sc = (float*)smem; float* red = sc + NB * D;
        const float* c = a.in[1]; const float* w_ada = a.in[2]; const float* b_ada = a.in[3]; float* mod = (float*)(ws + WS_MOD);
        for (int i = tid; i < NB * D; i += NTHR) sc[i] = siluf_(c[i]);
        __syncthreads();
        for (int it = blockIdx.x; it < 192; it += G) {
            const int kq = tid >> 5, jl = tid & 31, j = it * 32 + jl;
            float a0 = 0.f, a1 = 0.f, a2 = 0.f, a3 = 0.f;
#pragma unroll 16
            for (int kk = 0; kk < 64; ++kk) { const int k = kq * 64 + kk; const float w = w_ada[(size_t)k * 6144 + j];
                a0 += sc[k] * w; a1 += sc[D + k] * w; a2 += sc[2 * D + k] * w; a3 += sc[3 * D + k] * w; }
            red[(kq * 4 + 0) * 32 + jl] = a0; red[(kq * 4 + 1) * 32 + jl] = a1; red[(kq * 4 + 2) * 32 + jl] = a2; red[(kq * 4 + 3) * 32 + jl] = a3;
            __syncthreads();
            if (tid < 128) { const int b = tid >> 5; float s = b_ada[j];
#pragma unroll
                for (int q = 0; q < 16; ++q) s += red[(q * 4 + b) * 32 + jl];
                mod[b * 6144 + j] = s; }
            __syncthreads();
        }
    }
    const PrepArgs pa = MAKE_PREP_ARGS(a);
    const int lane = tid & 63, gw = blockIdx.x * NWAVES + (tid >> 6), ngw = G * NWAVES;
    prep_run(pa, gw, ngw, lane);
}

__device__ __forceinline__ void ph_ln1(const MArgs& a, unsigned char* smem, int G) {
    const int tid = threadIdx.x, lane = tid & 63, wave = tid >> 6;
    const float* x = a.in[0]; const float* w_in = a.in[4]; const float* gate_b = a.in[7];
    const float* mod = (const float*)(a.ws + WS_MOD); unsigned char* u1 = (unsigned char*)(a.ws + WS_U1); float* ipre = (float*)(a.ws + WS_GATES); float* logf = ipre + 16 * S;
    float* wg = (float*)smem;
    for (int i = tid; i < D * 8; i += NTHR) wg[i] = w_in[(size_t)(i >> 3) * WIN_LD + C_GATE + (i & 7)];
    __syncthreads();
    for (int it = blockIdx.x; it < T / 128; it += G) {
        const int row0 = it * 128, b = row0 / S;
        f32x4 sh[4], sc[4];
#pragma unroll
        for (int j = 0; j < 4; ++j) { sh[j] = *(const f32x4*)(mod + b * 6144 + 4 * lane + 256 * j); sc[j] = *(const f32x4*)(mod + b * 6144 + 1024 + 4 * lane + 256 * j); }
        for (int rr = wave; rr < 128; rr += NWAVES) {
            const int row = row0 + rr;
            const f32x4* xr = (const f32x4*)(x + (size_t)row * D) + lane;
            f32x4 v[4]; float s = 0.f;
#pragma unroll
            for (int j = 0; j < 4; ++j) { v[j] = xr[64 * j]; s += (v[j].x + v[j].y) + (v[j].z + v[j].w); }
            const float mean = wave_sum(s) * (1.f / D); float s2 = 0.f;
#pragma unroll
            for (int j = 0; j < 4; ++j) { v[j] = v[j] - mean; s2 += (v[j].x * v[j].x + v[j].y * v[j].y) + (v[j].z * v[j].z + v[j].w * v[j].w); }
            const float rstd = 1.f / sqrtf(wave_sum(s2) * (1.f / D) + LN_EPS);
            float ga[8];
#pragma unroll
            for (int q = 0; q < 8; ++q) ga[q] = 0.f;
            unsigned* o4 = (unsigned*)(u1 + (size_t)row * D) + lane;
#pragma unroll
            for (int j = 0; j < 4; ++j) {
                const f32x4 u = v[j] * rstd * (sc[j] + 1.0f) + sh[j];
                o4[64 * j] = pk4_fp8(u.x, u.y, u.z, u.w);
#pragma unroll
                for (int e = 0; e < 4; ++e) { const int k = 4 * lane + 256 * j + e;
                    const f32x4 w0 = *(const f32x4*)(wg + k * 8), w1 = *(const f32x4*)(wg + k * 8 + 4);
                    ga[0] += u[e] * w0.x; ga[1] += u[e] * w0.y; ga[2] += u[e] * w0.z; ga[3] += u[e] * w0.w;
                    ga[4] += u[e] * w1.x; ga[5] += u[e] * w1.y; ga[6] += u[e] * w1.z; ga[7] += u[e] * w1.w; }
            }
#pragma unroll
            for (int q = 0; q < 8; ++q) ga[q] = wave_sum(ga[q]);
            if (lane < 8) {
                float gv = 0.f;
#pragma unroll
                for (int q = 0; q < 8; ++q) gv = (lane == q) ? ga[q] : gv;
                gv += gate_b[lane];
                const int h = lane & 3, s_ = row % S;
                if (lane < 4) ipre[(size_t)(b * 4 + h) * S + s_] = gv;
                else logf[(size_t)(b * 4 + h) * S + s_] = fminf(gv, 0.f) - log1pf(__expf(-fabsf(gv)));
            }
        }
    }
}

__device__ __forceinline__ void ph_ln2(const MArgs& a, int G) {
    const float* x = a.in[0]; const bf16* mixout = (const bf16*)(a.ws + WS_MIXOUT); const float* mod = (const float*)(a.ws + WS_MOD); const float* ln1_g = a.in[10]; const float* ln1_b = a.in[11];
    bf16* x1 = (bf16*)(a.ws + WS_X1); bf16* u2 = (bf16*)(a.ws + WS_U2); unsigned char* u2f8 = (unsigned char*)(a.ws + WS_U2F8);
    const int tid = threadIdx.x, lane = tid & 63, wave = tid >> 6;
    for (int it = blockIdx.x; it < T / 128; it += G) {
        const int row0 = it * 128, b = row0 / S;
        f32x4 g1[4], lg[4], lb[4], sc2[4], sh2[4];
#pragma unroll
        for (int j = 0; j < 4; ++j) { const int col = 4 * lane + 256 * j;
            g1[j] = *(const f32x4*)(mod + b * 6144 + 2048 + col); lg[j] = *(const f32x4*)(ln1_g + col); lb[j] = *(const f32x4*)(ln1_b + col);
            sc2[j] = *(const f32x4*)(mod + b * 6144 + 4096 + col) + 1.0f; sh2[j] = *(const f32x4*)(mod + b * 6144 + 3072 + col); }
        for (int rr = wave; rr < 128; rr += NWAVES) {
            const int row = row0 + rr;
            f32x4 v[4]; float s = 0.f;
#pragma unroll
            for (int j = 0; j < 4; ++j) {
                const int col = 4 * lane + 256 * j;
                const f32x4 xv = __builtin_nontemporal_load((const f32x4*)(x + (size_t)row * D + col));
                const f32x4 mo = ld_bf4(mixout + (size_t)row * D + col);
                v[j] = xv * DN_ALPHA + g1[j] * mo; s += (v[j].x + v[j].y) + (v[j].z + v[j].w);
            }
            float mean = wave_sum(s) * (1.f / D), s2 = 0.f;
#pragma unroll
            for (int j = 0; j < 4; ++j) { v[j] = v[j] - mean; s2 += (v[j].x * v[j].x + v[j].y * v[j].y) + (v[j].z * v[j].z + v[j].w * v[j].w); }
            float rstd = 1.f / sqrtf(wave_sum(s2) * (1.f / D) + LN_EPS);
            s = 0.f;
#pragma unroll
            for (int j = 0; j < 4; ++j) { const int col = 4 * lane + 256 * j;
                v[j] = v[j] * rstd * lg[j] + lb[j];
                *(unsigned long long*)(x1 + (size_t)row * D + col) = (unsigned long long)pk2(v[j].x, v[j].y) | ((unsigned long long)pk2(v[j].z, v[j].w) << 32); s += (v[j].x + v[j].y) + (v[j].z + v[j].w); }
            mean = wave_sum(s) * (1.f / D); s2 = 0.f;
#pragma unroll
            for (int j = 0; j < 4; ++j) { v[j] = v[j] - mean; s2 += (v[j].x * v[j].x + v[j].y * v[j].y) + (v[j].z * v[j].z + v[j].w * v[j].w); }
            rstd = 1.f / sqrtf(wave_sum(s2) * (1.f / D) + LN_EPS);
#pragma unroll
            for (int j = 0; j < 4; ++j) { const int col = 4 * lane + 256 * j;
                const f32x4 u = v[j] * rstd * sc2[j] + sh2[j];
                *(unsigned long long*)(u2 + (size_t)row * D + col) = (unsigned long long)pk2(u.x, u.y) | ((unsigned long long)pk2(u.z, u.w) << 32);
                *(unsigned*)(u2f8 + (size_t)row * D + col) = pk4_fp8(u.x, u.y, u.z, u.w); }
        }
    }
}
#define DPPI(v, ctrl) __builtin_amdgcn_update_dpp(0, (v), (ctrl), 0xF, 0xF, true)
#define DPPF(v, ctrl) __builtin_bit_cast(float, __builtin_amdgcn_update_dpp(0, __builtin_bit_cast(int, (v)), (ctrl), 0xF, 0xF, true))
__device__ __forceinline__ void route_wave(int t, int lane, const float* __restrict__ logits, const f32x4 bias4, int* __restrict__ tope, float* __restrict__ topg, int* __restrict__ cnt) {
    const f32x4 lg = *(const f32x4*)(logits + (size_t)t * NE + 4 * lane);
    float sc[4], v[4];
#pragma unroll
    for (int j = 0; j < 4; ++j) { sc[j] = 1.f / (1.f + __expf(-lg[j])); v[j] = sc[j] + bias4[j]; }
    float m1 = fmaxf(fmaxf(v[0], v[1]), fmaxf(v[2], v[3]));
    float m2; { const float a = fmaxf(v[0], v[1]), b = fminf(v[0], v[1]), c = fmaxf(v[2], v[3]), d = fminf(v[2], v[3]); m2 = fmaxf(fminf(a, c), fmaxf(b, d)); }
#pragma unroll
    for (int st = 0; st < 3; ++st) { const float o1 = st == 0 ? DPPF(m1, 0xB1) : (st == 1 ? DPPF(m1, 0x4E) : DPPF(m1, 0x141)), o2 = st == 0 ? DPPF(m2, 0xB1) : (st == 1 ? DPPF(m2, 0x4E) : DPPF(m2, 0x141));
        const float n1 = fmaxf(m1, o1); m2 = fmaxf(fminf(m1, o1), fmaxf(m2, o2)); m1 = n1; }
    const float gs = m1 + m2; const int myg = lane >> 3; int rank = 0;
#pragma unroll
    for (int gg = 0; gg < 8; ++gg) { const float og = __builtin_bit_cast(float, __builtin_amdgcn_readlane(__builtin_bit_cast(int, gs), gg * 8)); rank += (og > gs || (og == gs && gg < myg)) ? 1 : 0; }
    unsigned kh[4];
#pragma unroll
    for (int j = 0; j < 4; ++j) { const unsigned u = __builtin_bit_cast(unsigned, v[j]); kh[j] = (rank >= 4) ? 0u : (u ^ ((u >> 31) ? 0xFFFFFFFFu : 0x80000000u)); }
    int myE = 0; float myS = 0.f, gsum = 0.f;
#pragma unroll
    for (int rd = 0; rd < 8; ++rd) {
        unsigned bh_ = kh[0]; int bl = 255 - 4 * lane;
#pragma unroll
        for (int j = 1; j < 4; ++j) if (kh[j] > bh_) { bh_ = kh[j]; bl = 255 - (4 * lane + j); }
#pragma unroll
        for (int st = 0; st < 4; ++st) {
            const int ctrl = st == 0 ? 0xB1 : (st == 1 ? 0x4E : (st == 2 ? 0x141 : 0x140));
            const unsigned oh = (unsigned)(st == 0 ? DPPI((int)bh_, 0xB1) : (st == 1 ? DPPI((int)bh_, 0x4E) : (st == 2 ? DPPI((int)bh_, 0x141) : DPPI((int)bh_, 0x140))));
            const int ol = st == 0 ? DPPI(bl, 0xB1) : (st == 1 ? DPPI(bl, 0x4E) : (st == 2 ? DPPI(bl, 0x141) : DPPI(bl, 0x140)));
            (void)ctrl; const bool take = (oh > bh_) || (oh == bh_ && ol > bl); bh_ = take ? oh : bh_; bl = take ? ol : bl; }
        unsigned wh = (unsigned)__builtin_amdgcn_readlane((int)bh_, 0); int wl = __builtin_amdgcn_readlane(bl, 0);
#pragma unroll
        for (int rw = 1; rw < 4; ++rw) { const unsigned oh = (unsigned)__builtin_amdgcn_readlane((int)bh_, 16 * rw); const int ol = __builtin_amdgcn_readlane(bl, 16 * rw);
            const bool take = (oh > wh) || (oh == wh && ol > wl); wh = take ? oh : wh; wl = take ? ol : wl; }
        const int bi = 255 - wl;
        float cand = 0.f;
#pragma unroll
        for (int j = 0; j < 4; ++j) if (bi == 4 * lane + j) { cand = sc[j]; kh[j] = 0u; }
        const float ss = __builtin_bit_cast(float, __builtin_amdgcn_readlane(__builtin_bit_cast(int, cand), bi >> 2));
        gsum += ss;
        if (lane == rd) { myE = bi; myS = ss; }
    }
    if (lane < 8) { tope[t * 8 + lane] = myE; topg[t * 8 + lane] = myS * (2.5f / gsum); atomicAdd(cnt + myE, 1); }
}
__device__ __forceinline__ void moe_tables(const int* cnt, LAS int* tb, LAS int* nn) {
    if (threadIdx.x < 64) {
        const int lane = threadIdx.x; int n[4], tl[4], loc = 0;
#pragma unroll
        for (int j = 0; j < 4; ++j) { n[j] = cnt[4 * lane + j]; tl[j] = (n[j] + 255) >> 8; loc += tl[j]; }
        int inc = loc;
#pragma unroll
        for (int o = 1; o < 64; o <<= 1) { const int v = __shfl_up(inc, o); if (lane >= o) inc += v; }
        int base = inc - loc;
#pragma unroll
        for (int j = 0; j < 4; ++j) { tb[4 * lane + j] = base; nn[4 * lane + j] = n[j]; base += tl[j]; }
        if (lane == 63) { tb[NE] = base; nn[NE] = T; tb[NEX] = base + T / 256; }
    }
    __syncthreads();
}
__device__ __forceinline__ void ph_final(const MArgs& a, int G) {
    float* out = a.out; const bf16* x1 = (const bf16*)(a.ws + WS_X1); const unsigned char* ys8 = (const unsigned char*)(a.ws + WS_YS); const unsigned char* ysh8 = (const unsigned char*)(a.ws + WS_YSH); const float* mod = (const float*)(a.ws + WS_MOD);
    const float* ln2_g = a.in[20]; const float* ln2_b = a.in[21];
    const int tid = threadIdx.x, lane = tid & 63, wave = tid >> 6;
    for (int it = blockIdx.x; it < T / 128; it += G) {
        const int row0 = it * 128, b = row0 / S;
        f32x4 g2[4], lg[4], lb[4];
#pragma unroll
        for (int j = 0; j < 4; ++j) { const int col = 4 * lane + 256 * j; g2[j] = *(const f32x4*)(mod + b * 6144 + 5120 + col); lg[j] = *(const f32x4*)(ln2_g + col); lb[j] = *(const f32x4*)(ln2_b + col); }
        for (int rr = wave; rr < 128; rr += NWAVES) {
            const int row = row0 + rr;
            f32x4 v[4]; float s = 0.f;
#pragma unroll
            for (int j = 0; j < 4; ++j) { const int col = 4 * lane + 256 * j;
                f32x4 yr = {0.f, 0.f, 0.f, 0.f};
#pragma unroll
                for (int k = 0; k < 8; ++k) { const int w = *(const int*)(ys8 + ((size_t)row * 8 + k) * D + col);
                    const f32x2 lo = __builtin_amdgcn_cvt_pk_f32_fp8(w, false), hi = __builtin_amdgcn_cvt_pk_f32_fp8(w, true); yr = yr + (f32x4){lo.x, lo.y, hi.x, hi.y}; }
                { const int w = *(const int*)(ysh8 + (size_t)row * D + col); const f32x2 lo = __builtin_amdgcn_cvt_pk_f32_fp8(w, false), hi = __builtin_amdgcn_cvt_pk_f32_fp8(w, true); yr = yr + (f32x4){lo.x, lo.y, hi.x, hi.y}; }
                const f32x4 y = yr * (1.f / 16.f);
                v[j] = ld_bf4(x1 + (size_t)row * D + col) * DN_ALPHA + g2[j] * y;
                s += (v[j].x + v[j].y) + (v[j].z + v[j].w); }
            const float mean = wave_sum(s) * (1.f / D); float s2 = 0.f;
#pragma unroll
            for (int j = 0; j < 4; ++j) { v[j] = v[j] - mean; s2 += (v[j].x * v[j].x + v[j].y * v[j].y) + (v[j].z * v[j].z + v[j].w * v[j].w); }
            const float rstd = 1.f / sqrtf(wave_sum(s2) * (1.f / D) + LN_EPS);
#pragma unroll
            for (int j = 0; j < 4; ++j) { const int col = 4 * lane + 256 * j;
                __builtin_nontemporal_store(v[j] * rstd * lg[j] + lb[j], (f32x4*)(out + (size_t)row * D + col)); }
        }
    }
}


typedef short s16x4 __attribute__((ext_vector_type(4)));
typedef short bf16x8v __attribute__((ext_vector_type(8)));
typedef float f32x16 __attribute__((ext_vector_type(16)));
constexpr int MLP = 320;
constexpr int NCH = S / 64;
constexpr int ST_ELEMS = 129 * 128;
constexpr size_t WS_CHK = WS_GATES + 1 * MiB;
constexpr size_t WS_MPREV = WS_GATES + 1 * MiB + 65536;
constexpr size_t WS_KC = WS_U2;
__device__ __forceinline__ s16x4 tr_read(const LAS unsigned char* p) { return __builtin_bit_cast(s16x4, __builtin_amdgcn_ds_read_tr16_b64_v4i16((LAS s16x4*)p)); }
__device__ __forceinline__ bf16x8v tr_frag(const LAS unsigned char* tile, int row0, int col0, int lane) {
    const int i = lane & 15; const LAS unsigned char* p = tile + (row0 + (i >> 2)) * MLP + (col0 + 4 * (i & 3)) * 2;
    const s16x4 lo = tr_read(p), hi = tr_read(p + 4 * MLP);
    return __builtin_shufflevector(lo, hi, 0, 1, 2, 3, 4, 5, 6, 7);
}
__device__ __forceinline__ bf16x8v tr_frag_perm(const LAS unsigned char* tile, int row0, int col0, int lane) {
    const int i = lane & 15; const LAS unsigned char* p = tile + (row0 + (i >> 2)) * MLP + (col0 + 4 * (i & 3)) * 2;
    const s16x4 lo = tr_read(p), hi = tr_read(p + 8 * MLP);
    return __builtin_shufflevector(lo, hi, 0, 1, 2, 3, 4, 5, 6, 7);
}
__device__ __forceinline__ float wave_incl_sum(float v, int lane) {
#pragma unroll
    for (int o = 1; o < 64; o <<= 1) { const float u = __shfl_up(v, o); if (lane >= o) v += u; }
    return v;
}
__device__ __forceinline__ float wave_incl_max(float v, int lane) {
#pragma unroll
    for (int o = 1; o < 64; o <<= 1) { const float u = __shfl_up(v, o); if (lane >= o) v = fmaxf(v, u); }
    return v;
}
__device__ __forceinline__ float wave_max(float v) {
#pragma unroll
    for (int o = 1; o < 64; o <<= 1) v = fmaxf(v, __shfl_xor(v, o));
    return v;
}
__device__ __forceinline__ void conv8(const bf16* __restrict__ rowp, int spos, const float* __restrict__ cw, const float* __restrict__ cb, float scale, float (&y)[8]) {
    const f32x4 b0 = *(const f32x4*)cb, b1 = *(const f32x4*)(cb + 4);
    y[0] = b0.x; y[1] = b0.y; y[2] = b0.z; y[3] = b0.w; y[4] = b1.x; y[5] = b1.y; y[6] = b1.z; y[7] = b1.w;
#pragma unroll
    for (int j = 0; j < 4; ++j) {
        if (spos - 3 + j >= 0) {
            const v4u xr = *(const v4u*)(rowp + (ptrdiff_t)(j - 3) * NPROJ);
            const f32x4 w0 = *(const f32x4*)(cw + j * 1024), w1 = *(const f32x4*)(cw + j * 1024 + 4);
            y[0] += w0.x * bf2f(xr.x & 0xffffu); y[1] += w0.y * bf2f(xr.x >> 16); y[2] += w0.z * bf2f(xr.y & 0xffffu); y[3] += w0.w * bf2f(xr.y >> 16);
            y[4] += w1.x * bf2f(xr.z & 0xffffu); y[5] += w1.y * bf2f(xr.z >> 16); y[6] += w1.z * bf2f(xr.w & 0xffffu); y[7] += w1.w * bf2f(xr.w >> 16);
        }
    }
#pragma unroll
    for (int e = 0; e < 8; ++e) y[e] = siluf_(y[e]) * scale;
}
__device__ __forceinline__ v4u pack8(const float (&y)[8]) { v4u o; o.x = pk2(y[0], y[1]); o.y = pk2(y[2], y[3]); o.z = pk2(y[4], y[5]); o.w = pk2(y[6], y[7]); return o; }

__device__ __forceinline__ void ml_phaseA(const MArgs& a, LAS unsigned char* lds, int vb0, int nvb) {
    const int tid = threadIdx.x, lane = tid & 63, wave = __builtin_amdgcn_readfirstlane(tid >> 6);
    const bf16* proj = (const bf16*)(a.ws + WS_PROJ); const float* conv_w = a.in[5]; const float* conv_b = a.in[6];
    const float* ipre = (const float*)(a.ws + WS_GATES); const float* logf = ipre + 16 * S;
    bf16* kcg = (bf16*)(a.ws + WS_KC); bf16* st = (bf16*)(a.ws + WS_STATES); float* chk = (float*)(a.ws + WS_CHK);
    LAS unsigned char* Kt = lds; LAS unsigned char* Vt = lds + 64 * MLP; LAS float* wkL = (LAS float*)(lds + 128 * MLP); LAS unsigned char* Stg = lds + 132 * MLP;
    const PrepArgs pa = MAKE_PREP_ARGS(a);
    for (int unit = vb0; unit < 16 * NCH; unit += nvb) {
        const int bh = unit >> 7, c = unit & (NCH - 1), b = bh >> 2, h = bh & 3, s0 = c * 64; const size_t row0 = (size_t)b * S + s0;
        if (wave == 0) {
            const float lf = logf[(size_t)bh * S + s0 + lane], ic = ipre[(size_t)bh * S + s0 + lane];
            const float bc = wave_incl_sum(lf, lane), g = ic - bc, gmax = wave_max(g), blast = __shfl(bc, 63);
            wkL[lane] = __expf(g - gmax);
            if (lane == 0) { chk[(size_t)unit * 2] = blast; chk[(size_t)unit * 2 + 1] = blast + gmax; }
        }
#pragma unroll
        for (int q = 0; q < 2; ++q) { const int it = tid + q * NTHR, tt = it >> 4, c8 = it & 15, ch = h * 128 + c8 * 8;
            float y[8]; conv8(proj + (row0 + tt) * NPROJ + C_MLK + ch, s0 + tt, conv_w + 512 + ch, conv_b + 512 + ch, 0.08838834764831845f, y);
            const v4u o = pack8(y);
            *(LAS v4u*)(Kt + tt * MLP + c8 * 16) = o; *(v4u*)(kcg + (row0 + tt) * 512 + ch) = o; }
        __syncthreads();
        const PrepDesc bgd = prep_decode(pa, IT_SMALL + unit * NWAVES + wave); f32x4 bgv[16]; prep_load(bgd, lane, bgv);
#pragma unroll
        for (int q = 0; q < 2; ++q) { const int it = tid + q * NTHR, tt = it >> 4, c8 = it & 15;
            const v4u xr = *(const v4u*)(proj + (row0 + tt) * NPROJ + C_MLV + h * 128 + c8 * 8); const float w = wkL[tt];
            float y[8] = {bf2f(xr.x & 0xffffu) * w, bf2f(xr.x >> 16) * w, bf2f(xr.y & 0xffffu) * w, bf2f(xr.y >> 16) * w, bf2f(xr.z & 0xffffu) * w, bf2f(xr.z >> 16) * w, bf2f(xr.w & 0xffffu) * w, bf2f(xr.w >> 16) * w};
            *(LAS v4u*)(Vt + tt * MLP + c8 * 16) = pack8(y); }
        __syncthreads();
        {
            const int dvb = wave >> 1, dkh = wave & 1, hh = lane >> 5, gsel = (lane >> 4) & 1;
            f32x16 acc[2];
#pragma unroll
            for (int nb = 0; nb < 2; ++nb)
#pragma unroll
                for (int i = 0; i < 16; ++i) acc[nb][i] = 0.f;
#pragma unroll
            for (int kk = 0; kk < 4; ++kk) {
                const bf16x8v Bv = tr_frag(Vt, 16 * kk + 8 * hh, 32 * dvb + 16 * gsel, lane);
#pragma unroll
                for (int nb = 0; nb < 2; ++nb) { const bf16x8v Ak = tr_frag(Kt, 16 * kk + 8 * hh, 32 * (2 * dkh + nb) + 16 * gsel, lane);
                    acc[nb] = __builtin_amdgcn_mfma_f32_32x32x16_bf16(Ak, Bv, acc[nb], 0, 0, 0); }
            }
#pragma unroll
            for (int nb = 0; nb < 2; ++nb)
#pragma unroll
                for (int g4 = 0; g4 < 4; ++g4) { const int dk = 32 * (2 * dkh + nb) + 8 * g4 + 4 * hh, dv = 32 * dvb + (lane & 31);
                    *(LAS unsigned long long*)(Stg + dv * MLP + dk * 2) = (unsigned long long)pk2(acc[nb][4 * g4], acc[nb][4 * g4 + 1]) | ((unsigned long long)pk2(acc[nb][4 * g4 + 2], acc[nb][4 * g4 + 3]) << 32); }
        }
        __syncthreads();
        { bf16* stc = st + (size_t)unit * ST_ELEMS;
#pragma unroll
          for (int q = 0; q < 4; ++q) { const int it = tid + q * NTHR, dv = it >> 4, c8 = it & 15;
              *(v4u*)(stc + dv * 128 + c8 * 8) = *(const LAS v4u*)(Stg + dv * MLP + c8 * 16); }
        }
        if (tid < 128) { float s = 0.f;
#pragma unroll 8
            for (int t = 0; t < 64; ++t) s += wkL[t] * bf2f(*(const LAS unsigned short*)(Kt + t * MLP + tid * 2));
            st[(size_t)unit * ST_ELEMS + 128 * 128 + tid] = (bf16)f2bf(s); }
        prep_store(bgd, lane, bgv);
        __syncthreads();
    }
}

__device__ __forceinline__ void ml_phaseB(const MArgs& a, LAS unsigned char* lds, int vb0, int nvb) {
    const int tid = threadIdx.x;
    bf16* st = (bf16*)(a.ws + WS_STATES); const float* chk = (const float*)(a.ws + WS_CHK); float* mprev = (float*)(a.ws + WS_MPREV);
    LAS float* al = (LAS float*)lds; LAS float* be = al + NCH;
    constexpr int NSL = 16, SLE = ST_ELEMS / NSL;
    for (int item = vb0; item < 16 * NSL; item += nvb) {
        const int bh = item / NSL, sl = item % NSL;
        __syncthreads();
        if (tid < NCH) { al[tid] = chk[(size_t)(bh * NCH + tid) * 2]; be[tid] = chk[(size_t)(bh * NCH + tid) * 2 + 1]; }
        __syncthreads();
        if (tid == 0) { float m = 0.f;
            for (int c = 0; c < NCH; ++c) { const float bl = al[c], M = be[c];
                const float mn = fmaxf(bl + m, M); al[c] = __expf(bl + m - mn); be[c] = __expf(M - mn);
                if (sl == 0) mprev[bh * NCH + c] = m;
                m = mn; } }
        __syncthreads();
        if (tid * 4 < SLE) {
            unsigned long long* p = (unsigned long long*)(st + (size_t)bh * NCH * ST_ELEMS + sl * SLE + tid * 4);
            float c0 = 0.f, c1 = 0.f, c2 = 0.f, c3 = 0.f;
            for (int cb = 0; cb < NCH; cb += 16) { unsigned long long d[16];
#pragma unroll
                for (int j = 0; j < 16; ++j) d[j] = p[(size_t)(cb + j) * (ST_ELEMS / 4)];
#pragma unroll
                for (int j = 0; j < 16; ++j) { p[(size_t)(cb + j) * (ST_ELEMS / 4)] = (unsigned long long)pk2(c0, c1) | ((unsigned long long)pk2(c2, c3) << 32);
                    const float A = al[cb + j], Bq = be[cb + j]; const unsigned lo = (unsigned)d[j], hi = (unsigned)(d[j] >> 32);
                    c0 = A * c0 + Bq * bf2f(lo & 0xffffu); c1 = A * c1 + Bq * bf2f(lo >> 16); c2 = A * c2 + Bq * bf2f(hi & 0xffffu); c3 = A * c3 + Bq * bf2f(hi >> 16); } }
        }
    }
}

__device__ __forceinline__ void ml_phaseC(const MArgs& a, LAS unsigned char* lds, int G) {
    const int tid = threadIdx.x, lane = tid & 63, wave = __builtin_amdgcn_readfirstlane(tid >> 6);
    const bf16* proj = (const bf16*)(a.ws + WS_PROJ); const float* conv_w = a.in[5]; const float* conv_b = a.in[6]; const float* norm_g = a.in[8];
    const float* ipre = (const float*)(a.ws + WS_GATES); const float* logf = ipre + 16 * S;
    const bf16* kcg = (const bf16*)(a.ws + WS_KC); const bf16* st = (const bf16*)(a.ws + WS_STATES); const float* mprev = (const float*)(a.ws + WS_MPREV);
    unsigned char* mix8 = (unsigned char*)(a.ws + WS_MIX);
    LAS unsigned char* Qt = lds; LAS unsigned char* Kt = lds + 64 * MLP; LAS unsigned char* Vt = lds + 128 * MLP; LAS unsigned char* Ct = lds + 192 * MLP;
    LAS float* sc = (LAS float*)(lds + 320 * MLP);
    LAS float* gL = sc; LAS float* mmL = sc + 64; LAS float* siL = sc + 128; LAS float* emL = sc + 192; LAS float* npv = sc + 256; LAS float* lnS = sc + 384;
    const int tb = wave >> 2, dvb = wave & 3, r = lane & 31, hh = lane >> 5, gsel = (lane >> 4) & 1;
    const PrepArgs pa = MAKE_PREP_ARGS(a);
    for (int unit = blockIdx.x; unit < 16 * NCH; unit += G) {
        const int bh = unit >> 7, c = unit & (NCH - 1), b = bh >> 2, h = bh & 3, s0 = c * 64; const size_t row0 = (size_t)b * S + s0;
        if (wave == 0) {
            const float lf = logf[(size_t)bh * S + s0 + lane], ic = ipre[(size_t)bh * S + s0 + lane], mp = mprev[unit];
            const float bc = wave_incl_sum(lf, lane), g = ic - bc, pm = wave_incl_max(g, lane), mm = fmaxf(mp, pm);
            gL[lane] = g; mmL[lane] = mm; siL[lane] = __expf(mp - mm); emL[lane] = __expf(-(bc + mm));
        }
        const bf16* stc = st + (size_t)unit * ST_ELEMS;
#pragma unroll
        for (int q = 0; q < 2; ++q) { const int it = tid + q * NTHR, tt = it >> 4, c8 = it & 15, ch = h * 128 + c8 * 8;
            float y[8]; conv8(proj + (row0 + tt) * NPROJ + C_MLQ + ch, s0 + tt, conv_w + ch, conv_b + ch, 1.f, y);
            *(LAS v4u*)(Qt + tt * MLP + c8 * 16) = pack8(y);
            *(LAS v4u*)(Kt + tt * MLP + c8 * 16) = *(const v4u*)(kcg + (row0 + tt) * 512 + ch);
            *(LAS v4u*)(Vt + tt * MLP + c8 * 16) = *(const v4u*)(proj + (row0 + tt) * NPROJ + C_MLV + ch); }
#pragma unroll
        for (int q = 0; q < 4; ++q) { const int it = tid + q * NTHR, dv = it >> 4, c8 = it & 15;
            *(LAS v4u*)(Ct + dv * MLP + c8 * 16) = *(const v4u*)(stc + dv * 128 + c8 * 8); }
        if (tid < 128) npv[tid] = bf2f(stc[128 * 128 + tid]);
        __syncthreads();
        v4u ogp[2]; f32x4 ngp[2][2];
#pragma unroll
        for (int q = 0; q < 2; ++q) { const int it = tid + q * NTHR, tt = it >> 4, dv = (it & 15) * 8;
            ogp[q] = *(const v4u*)(proj + (row0 + tt) * NPROJ + C_MLO + h * 128 + dv); ngp[q][0] = *(const f32x4*)(norm_g + h * 128 + dv); ngp[q][1] = *(const f32x4*)(norm_g + h * 128 + dv + 4); }
        const PrepDesc bgd = prep_decode(pa, IT_SMALL + BG_A + unit * NWAVES + wave); f32x4 bgv[16]; prep_load(bgd, lane, bgv);
        bf16x8v qf[8];
#pragma unroll
        for (int kk = 0; kk < 8; ++kk) qf[kk] = *(const LAS bf16x8v*)(Qt + (32 * tb + r) * MLP + (16 * kk + 8 * hh) * 2);
        const float mm_t = mmL[32 * tb + r], si_t = siL[32 * tb + r], em_t = emL[32 * tb + r];
        float nq = 0.f;
#pragma unroll
        for (int kk = 0; kk < 8; ++kk) { const f32x4 n0 = *(const LAS f32x4*)(npv + 16 * kk + 8 * hh), n1 = *(const LAS f32x4*)(npv + 16 * kk + 8 * hh + 4);
            nq += n0.x * bf2f((unsigned short)qf[kk][0]) + n0.y * bf2f((unsigned short)qf[kk][1]) + n0.z * bf2f((unsigned short)qf[kk][2]) + n0.w * bf2f((unsigned short)qf[kk][3])
                + n1.x * bf2f((unsigned short)qf[kk][4]) + n1.y * bf2f((unsigned short)qf[kk][5]) + n1.z * bf2f((unsigned short)qf[kk][6]) + n1.w * bf2f((unsigned short)qf[kk][7]); }
        nq += __shfl_xor(nq, 32);
        f32x16 num;
#pragma unroll
        for (int i = 0; i < 16; ++i) num[i] = 0.f;
#pragma unroll
        for (int kk = 0; kk < 8; ++kk) { const bf16x8v Ac = *(const LAS bf16x8v*)(Ct + (32 * dvb + r) * MLP + (16 * kk + 8 * hh) * 2);
            num = __builtin_amdgcn_mfma_f32_32x32x16_bf16(Ac, qf[kk], num, 0, 0, 0); }
#pragma unroll
        for (int i = 0; i < 16; ++i) num[i] *= si_t;
        float wsum = 0.f;
        for (int sb = 0; sb <= tb; ++sb) {
            f32x16 sT;
#pragma unroll
            for (int i = 0; i < 16; ++i) sT[i] = 0.f;
#pragma unroll
            for (int kk = 0; kk < 8; ++kk) { const bf16x8v Ak = *(const LAS bf16x8v*)(Kt + (32 * sb + r) * MLP + (16 * kk + 8 * hh) * 2);
                sT = __builtin_amdgcn_mfma_f32_32x32x16_bf16(Ak, qf[kk], sT, 0, 0, 0); }
            unsigned wp[8];
#pragma unroll
            for (int g4 = 0; g4 < 4; ++g4) { const f32x4 gv = *(const LAS f32x4*)(gL + 32 * sb + 8 * g4 + 4 * hh);
                float w[4];
#pragma unroll
                for (int e = 0; e < 4; ++e) { const int srow = 32 * sb + 8 * g4 + 4 * hh + e; const bool valid = srow <= 32 * tb + r;
                    w[e] = valid ? sT[4 * g4 + e] * __expf(gv[e] - mm_t) : 0.f; wsum += w[e]; }
                wp[2 * g4] = pk2(w[0], w[1]); wp[2 * g4 + 1] = pk2(w[2], w[3]); }
#pragma unroll
            for (int s2 = 0; s2 < 2; ++s2) {
                const bf16x8v Av = tr_frag_perm(Vt, 32 * sb + 16 * s2 + 4 * hh, 32 * dvb + 16 * gsel, lane);
                v4u bw; bw.x = wp[4 * s2]; bw.y = wp[4 * s2 + 1]; bw.z = wp[4 * s2 + 2]; bw.w = wp[4 * s2 + 3];
                num = __builtin_amdgcn_mfma_f32_32x32x16_bf16(Av, __builtin_bit_cast(bf16x8v, bw), num, 0, 0, 0); }
        }
        wsum += __shfl_xor(wsum, 32);
        const float den = si_t * nq + wsum, rden = 1.f / fmaxf(fabsf(den), em_t);
        float ps = 0.f, pq = 0.f;
#pragma unroll
        for (int i = 0; i < 16; ++i) { num[i] *= rden; ps += num[i]; pq += num[i] * num[i]; }
        ps += __shfl_xor(ps, 32); pq += __shfl_xor(pq, 32);
        if (hh == 0) { lnS[((tb * 4 + dvb) * 32 + r) * 2] = ps; lnS[((tb * 4 + dvb) * 32 + r) * 2 + 1] = pq; }
        __syncthreads();
        float ts = 0.f, tq = 0.f;
#pragma unroll
        for (int d = 0; d < 4; ++d) { ts += lnS[((tb * 4 + d) * 32 + r) * 2]; tq += lnS[((tb * 4 + d) * 32 + r) * 2 + 1]; }
        const float mean = ts * (1.f / 128.f), rstd = 1.f / sqrtf(fmaxf(tq * (1.f / 128.f) - mean * mean, 0.f) + LN_EPS);
#pragma unroll
        for (int g4 = 0; g4 < 4; ++g4) { const int dv = 32 * dvb + 8 * g4 + 4 * hh;
            *(LAS unsigned long long*)(Qt + (32 * tb + r) * MLP + dv * 2) = (unsigned long long)pk2((num[4 * g4] - mean) * rstd, (num[4 * g4 + 1] - mean) * rstd) | ((unsigned long long)pk2((num[4 * g4 + 2] - mean) * rstd, (num[4 * g4 + 3] - mean) * rstd) << 32); }
        __syncthreads();
#pragma unroll
        for (int q = 0; q < 2; ++q) { const int it = tid + q * NTHR, tt = it >> 4, c8 = it & 15, dv = c8 * 8;
            const v4u hv = *(const LAS v4u*)(Qt + tt * MLP + c8 * 16); const v4u og = ogp[q];
            const f32x4 n0 = ngp[q][0], n1 = ngp[q][1];
            float o[8];
            o[0] = bf2f(hv.x & 0xffffu) * n0.x * sigmoidf_(bf2f(og.x & 0xffffu)); o[1] = bf2f(hv.x >> 16) * n0.y * sigmoidf_(bf2f(og.x >> 16));
            o[2] = bf2f(hv.y & 0xffffu) * n0.z * sigmoidf_(bf2f(og.y & 0xffffu)); o[3] = bf2f(hv.y >> 16) * n0.w * sigmoidf_(bf2f(og.y >> 16));
            o[4] = bf2f(hv.z & 0xffffu) * n1.x * sigmoidf_(bf2f(og.z & 0xffffu)); o[5] = bf2f(hv.z >> 16) * n1.y * sigmoidf_(bf2f(og.z >> 16));
            o[6] = bf2f(hv.w & 0xffffu) * n1.z * sigmoidf_(bf2f(og.w & 0xffffu)); o[7] = bf2f(hv.w >> 16) * n1.w * sigmoidf_(bf2f(og.w >> 16));
            *(unsigned long long*)(mix8 + (row0 + tt) * D + 512 + h * 128 + dv) = (unsigned long long)pk4_fp8(o[0], o[1], o[2], o[3]) | ((unsigned long long)pk4_fp8(o[4], o[5], o[6], o[7]) << 32); }
        prep_store(bgd, lane, bgv);
        __syncthreads();
    }
}

constexpr int VTP = 192;
template <int PITCH> __device__ __forceinline__ bf16x8v tr_frag_perm_p(const LAS unsigned char* tile, int row0, int col0, int lane) {
    const int i = lane & 15; const LAS unsigned char* p = tile + (row0 + (i >> 2)) * PITCH + (col0 + 4 * (i & 3)) * 2;
    const s16x4 lo = tr_read(p), hi = tr_read(p + 8 * PITCH);
    return __builtin_shufflevector(lo, hi, 0, 1, 2, 3, 4, 5, 6, 7);
}
__device__ __forceinline__ void attn_phase(const bf16* __restrict__ proj, unsigned char* __restrict__ mix8, LAS unsigned char* lds, int vb0, int nvb, const PrepArgs pa) {
    const int tid = threadIdx.x, lane = tid & 63, wave = __builtin_amdgcn_readfirstlane(tid >> 6);
    const int r = lane & 31, hh = lane >> 5, gsel = (lane >> 4) & 1;
    LAS unsigned char* Vt = lds + wave * (64 * VTP);
    bf16x8v ntri[2], nones;
#pragma unroll
    for (int s2 = 0; s2 < 2; ++s2)
#pragma unroll
        for (int j = 0; j < 8; ++j) { const int k = 16 * s2 + 8 * (j >> 2) + 4 * hh + (j & 3); ntri[s2][j] = (k >= r) ? (short)0xBF80 : (short)0; }
#pragma unroll
    for (int j = 0; j < 8; ++j) nones[j] = (short)0xBF80;
    for (int unit = vb0 * NWAVES + wave; unit < NB * 8 * (S / 32); unit += nvb * NWAVES) {
        const int bh = unit / (S / 32), qb = unit % (S / 32), b = bh >> 3, h = bh & 7, q0 = qb * 32;
        const bf16* base = proj + (size_t)b * S * NPROJ + h * 64;
        bf16x8v qf[4];
#pragma unroll
        for (int s = 0; s < 4; ++s) qf[s] = *(const bf16x8v*)(base + (size_t)(q0 + r) * NPROJ + C_SBQ + 16 * s + 8 * hh);
        f32x16 o[2];
#pragma unroll
        for (int d = 0; d < 2; ++d)
#pragma unroll
            for (int i = 0; i < 16; ++i) o[d][i] = 0.f;
        float carry = 0.f;
        const int qpos = q0 + r;
        const PrepDesc bgd = prep_decode(pa, IT_SMALL + BG_A + BG_C + unit); f32x4 bgv[16]; prep_load(bgd, lane, bgv);
        for (int k0 = q0 - 32; ; k0 -= 64) {
            bf16x8v kf[2][4];
#pragma unroll
            for (int kb = 0; kb < 2; ++kb) { int key = k0 + 32 * kb + r; key = key < 0 ? 0 : key;
#pragma unroll
                for (int s = 0; s < 4; ++s) kf[kb][s] = *(const bf16x8v*)(base + (size_t)key * NPROJ + C_SBK + 16 * s + 8 * hh); }
#pragma unroll
            for (int i = 0; i < 8; ++i) { int key = k0 + (lane >> 3) + 8 * i; key = key < 0 ? 0 : key;
                *(LAS v4u*)(Vt + ((lane >> 3) + 8 * i) * VTP + (lane & 7) * 16) = *(const v4u*)(base + (size_t)key * NPROJ + C_SBV + (lane & 7) * 8); }
            f32x16 z[2];
#pragma unroll
            for (int kb = 0; kb < 2; ++kb) {
#pragma unroll
                for (int i = 0; i < 16; ++i) z[kb][i] = 0.f;
#pragma unroll
                for (int s = 0; s < 4; ++s) z[kb] = __builtin_amdgcn_mfma_f32_32x32x16_bf16(kf[kb][s], qf[s], z[kb], 0, 0, 0); }
            const bool need_mask = (k0 + 63 >= q0) || (k0 < 0);
            unsigned xp[2][8];
#pragma unroll
            for (int kb = 0; kb < 2; ++kb)
#pragma unroll
                for (int g4 = 0; g4 < 4; ++g4) { float sp[4];
#pragma unroll
                    for (int e = 0; e < 4; ++e) { const float zz = z[kb][4 * g4 + e];
                        float v = fmaxf(zz, 0.f) + __builtin_amdgcn_logf(1.f + __builtin_amdgcn_exp2f(-fabsf(zz)));
                        if (need_mask) { const int key = k0 + 32 * kb + 8 * g4 + 4 * hh + e; v = (key >= 0 && key < qpos) ? v : 0.f; }
                        sp[e] = v; }
                    xp[kb][2 * g4] = pk2(sp[0], sp[1]); xp[kb][2 * g4 + 1] = pk2(sp[2], sp[3]); }
            const float z00 = z[0][0];
#pragma unroll
            for (int s2 = 0; s2 < 2; ++s2) { v4u b1; b1.x = xp[1][4 * s2]; b1.y = xp[1][4 * s2 + 1]; b1.z = xp[1][4 * s2 + 2]; b1.w = xp[1][4 * s2 + 3];
                v4u b0; b0.x = xp[0][4 * s2]; b0.y = xp[0][4 * s2 + 1]; b0.z = xp[0][4 * s2 + 2]; b0.w = xp[0][4 * s2 + 3];
                z[1] = __builtin_amdgcn_mfma_f32_32x32x16_bf16(ntri[s2], __builtin_bit_cast(bf16x8v, b1), z[1], 0, 0, 0);
                z[0] = __builtin_amdgcn_mfma_f32_32x32x16_bf16(ntri[s2], __builtin_bit_cast(bf16x8v, b0), z[0], 0, 0, 0);
                z[0] = __builtin_amdgcn_mfma_f32_32x32x16_bf16(nones, __builtin_bit_cast(bf16x8v, b1), z[0], 0, 0, 0); }
            float tot = z00 - z[0][0];
            tot = __shfl(tot, r);
#pragma unroll
            for (int kb = 0; kb < 2; ++kb)
#pragma unroll
                for (int g4 = 0; g4 < 4; ++g4) { float p[4];
#pragma unroll
                    for (int e = 0; e < 4; ++e) { float v = __builtin_amdgcn_exp2f(z[kb][4 * g4 + e] - carry);
                        if (need_mask) { const int key = k0 + 32 * kb + 8 * g4 + 4 * hh + e; v = (key >= 0 && key < qpos) ? v : 0.f; }
                        p[e] = v; }
                    xp[kb][2 * g4] = pk2(p[0], p[1]); xp[kb][2 * g4 + 1] = pk2(p[2], p[3]); }
#pragma unroll
            for (int kb = 0; kb < 2; ++kb)
#pragma unroll
                for (int s2 = 0; s2 < 2; ++s2) { v4u bp; bp.x = xp[kb][4 * s2]; bp.y = xp[kb][4 * s2 + 1]; bp.z = xp[kb][4 * s2 + 2]; bp.w = xp[kb][4 * s2 + 3];
#pragma unroll
                    for (int d = 0; d < 2; ++d) { const bf16x8v Av = tr_frag_perm_p<VTP>(Vt, 32 * kb + 16 * s2 + 4 * hh, 32 * d + 16 * gsel, lane);
                        o[d] = __builtin_amdgcn_mfma_f32_32x32x16_bf16(Av, __builtin_bit_cast(bf16x8v, bp), o[d], 0, 0, 0); } }
            carry += tot;
            if (k0 <= 0) break;
            if (__all(carry > SB_THRESH)) break;
        }
#pragma unroll
        for (int d = 0; d < 2; ++d)
#pragma unroll
            for (int g4 = 0; g4 < 4; ++g4)
                *(LAS unsigned long long*)(Vt + r * 144 + (32 * d + 8 * g4 + 4 * hh) * 2) = (unsigned long long)pk2(o[d][4 * g4], o[d][4 * g4 + 1]) | ((unsigned long long)pk2(o[d][4 * g4 + 2], o[d][4 * g4 + 3]) << 32);
#pragma unroll
        for (int i = 0; i < 4; ++i) { const int row = (lane >> 3) + 8 * i;
            const v4u ov = *(const LAS v4u*)(Vt + row * 144 + (lane & 7) * 16);
            *(unsigned long long*)(mix8 + (size_t)(b * S + q0 + row) * D + h * 64 + (lane & 7) * 8) = (unsigned long long)pk4_fp8(bf2f(ov.x & 0xffffu), bf2f(ov.x >> 16), bf2f(ov.y & 0xffffu), bf2f(ov.y >> 16))
                | ((unsigned long long)pk4_fp8(bf2f(ov.z & 0xffffu), bf2f(ov.z >> 16), bf2f(ov.w & 0xffffu), bf2f(ov.w >> 16)) << 32); }
        prep_store(bgd, lane, bgv);
    }
}

__global__ void __launch_bounds__(NTHR, 2) mega_fwd(MArgs args) {
    extern __shared__ __attribute__((aligned(16))) unsigned char lds[];
    LAS unsigned char* ldsl = (LAS unsigned char*)lds;
    const int tid = threadIdx.x, G = gridDim.x;
    volatile LAS unsigned* MISC = (volatile LAS unsigned*)(ldsl + XTRA_OFF + X_MISC);
    LAS int* tb = (LAS int*)(ldsl + XTRA_OFF + X_TB); LAS int* nn = (LAS int*)(ldsl + XTRA_OFF + X_NN);
    for (int u = tid; u < (LDS_BYTES - XTRA_OFF) / 4; u += NTHR) ((LAS unsigned*)(ldsl + XTRA_OFF))[u] = 0u;
    __syncthreads();
    unsigned char* ws = args.ws;
    unsigned* ctl = (unsigned*)(ws + WS_CTL);
    XcdBarrier bar = xcd_barrier_post(ctl + CW_BAR, MISC + 8);
    const int lo = args.ph_lo, hi = args.ph_hi;
#define IN(k) (lo <= (k) && (k) < hi)
#ifndef REP_MASK
#define REP_MASK 0
#endif
#define PHASE(k, ...) do { if (IN(k)) { for (int rep_ = 0; rep_ < (((REP_MASK >> (k)) & 1) ? 2 : 1); ++rep_) { if (rep_) xcd_barrier(bar); __VA_ARGS__ } } if (IN(k) && IN((k) + 1)) xcd_barrier(bar); } while (0)
    int* cnt = (int*)ctl + CW_CNT; i32x2* list = (i32x2*)(ws + WS_ROUTE + 2 * MiB); float* topg = (float*)(ws + WS_ROUTE + 1 * MiB);
    PHASE(0, ph_mod_prep(args, lds, G););
    PHASE(1, ph_ln1(args, lds, G););
    PHASE(2, { pg8::StaticOrder So; So.init(ws + WS_U1, ws + WS_WTIN, T, NPROJ, D, G, blockIdx.x);
        pg8::EpiBf16 E{(bf16*)(ws + WS_PROJ), NPROJ, 2, QSCALE, 1.f / 64.f};
        pg8::gemm_phase<pg8::EpiBf16, pg8::StaticOrder, false, true>(ldsl, D, So, E); });
    PHASE(3, ml_phaseA(args, ldsl, blockIdx.x, G););
    PHASE(4, ml_phaseB(args, ldsl, blockIdx.x, G); __syncthreads(); attn_phase((const bf16*)(ws + WS_PROJ), (unsigned char*)(ws + WS_MIX), ldsl, blockIdx.x, G, MAKE_PREP_ARGS(args)););
    PHASE(5, ml_phaseC(args, ldsl, G););
    PHASE(6, { pg8::StaticOrder So; So.init(ws + WS_MIX, ws + WS_WTOUT, T, D, D, G, blockIdx.x);
        pg8::EpiBf16 E{(bf16*)(ws + WS_MIXOUT), D, 0, 1.f, 1.f / 64.f};
        pg8::gemm_phase<pg8::EpiBf16, pg8::StaticOrder, false, true>(ldsl, D, So, E); });
    PHASE(7, ph_ln2(args, G););
    PHASE(8, { pg8::StaticOrder So; So.init(ws + WS_U2, ws + WS_WTR, T, NE, 2 * D, G, blockIdx.x);
        pg8::EpiF32 E{(float*)(ws + WS_LOGITS), NE};
        pg8::gemm_phase<pg8::EpiF32, pg8::StaticOrder, false, false>(ldsl, 2 * D, So, E); });
    PHASE(9, { const int lane_ = tid & 63; const f32x4 bias4 = *(const f32x4*)(args.in[13] + 4 * lane_); const PrepArgs pa = MAKE_PREP_ARGS(args);
        int bgit = IT_SMALL + BG_TOTAL + blockIdx.x * NWAVES + (tid >> 6);
        for (int t = blockIdx.x * NWAVES + (tid >> 6); t < T; t += G * NWAVES) {
            const bool bg = bgit < IT_TOTAL; PrepDesc bgd = prep_decode(pa, bg ? bgit : IT_SMALL); f32x4 bgv[16];
            if (bg) prep_load(bgd, lane_, bgv);
            route_wave(t, lane_, (const float*)(ws + WS_LOGITS), bias4, (int*)(ws + WS_ROUTE), topg, cnt);
            if (bg) prep_store(bgd, lane_, bgv);
            bgit += G * NWAVES; } });
    PHASE(10, { moe_tables(cnt, tb, nn); const int* tope = (const int*)(ws + WS_ROUTE); int* fill = (int*)ctl + CW_FILL;
        for (int id = blockIdx.x * NTHR + tid; id < T * TOPK; id += G * NTHR) { const int e = tope[id]; const int pos = atomicAdd(fill + e, 1);
            list[tb[e] * 256 + pos] = (i32x2){id, __float_as_int(topg[id])}; } });
    PHASE(11, { moe_tables(cnt, tb, nn);
        pg8::MoeOrder So{G, (int)blockIdx.x, tb[NEX] * 2, 1, tb, nn, list, (const char*)(ws + WS_U2F8), 0, (const char*)(ws + WS_WT13), (size_t)512 * D, (size_t)256 * D};
        pg8::EpiGlu E{(unsigned char*)(ws + WS_H), 1.f / 64.f};
        pg8::gemm_phase<pg8::EpiGlu, pg8::MoeOrder, true, true>(ldsl, D, So, E); });
    PHASE(12, { moe_tables(cnt, tb, nn);
        pg8::MoeOrder So{G, (int)blockIdx.x, tb[NEX] * 4, 2, tb, nn, list, (const char*)(ws + WS_H), (size_t)256 * FF, (const char*)(ws + WS_WT2), (size_t)D * FF, (size_t)256 * FF};
        pg8::EpiScatter E{(unsigned char*)(ws + WS_YS), (unsigned char*)(ws + WS_YSH), list, nn};
        pg8::gemm_phase<pg8::EpiScatter, pg8::MoeOrder, false, true>(ldsl, FF, So, E); });
    PHASE(13, ph_final(args, G););
#undef PHASE
#undef IN
}

__global__ void k_nan_fill(float* out, int n) { for (int i = blockIdx.x * blockDim.x + threadIdx.x; i < n; i += gridDim.x * blockDim.x) out[i] = __builtin_nanf(""); }
extern "C" void kernel_launch(void* const* d_in, const int* in_sizes, int n_in, void* d_out, int out_size, void* d_ws, size_t ws_size, hipStream_t stream) {
    static int grid = 0;
    if (grid == 0) {
        int dev = 0, cus = 0, per_cu = 0; grid = -1;
        if (n_in != 22 || out_size != T * D || ws_size < WS_END) fprintf(stderr, "kernel_launch: unexpected shapes (n_in %d out %d ws %zu, need %zu)\n", n_in, out_size, ws_size, (size_t)WS_END);
        else if (hipGetDevice(&dev) != hipSuccess || hipDeviceGetAttribute(&cus, hipDeviceAttributeMultiprocessorCount, dev) != hipSuccess) fprintf(stderr, "kernel_launch: device query failed\n");
        else if (hipFuncSetAttribute((const void*)mega_fwd, hipFuncAttributeMaxDynamicSharedMemorySize, LDS_BYTES) != hipSuccess) fprintf(stderr, "kernel_launch: hipFuncSetAttribute failed\n");
        else if (hipOccupancyMaxActiveBlocksPerMultiprocessor(&per_cu, (const void*)mega_fwd, NTHR, LDS_BYTES) != hipSuccess || per_cu < 1) fprintf(stderr, "kernel_launch: occupancy query says %d blocks per CU\n", per_cu);
        else grid = cus;
        (void)hipGetLastError();
    }
    if (grid < 0) { k_nan_fill<<<1024, 256, 0, stream>>>((float*)d_out, out_size); return; }
    char* ws = (char*)d_ws;
    (void)hipMemsetAsync(ws + WS_CTL, 0, 1 * MiB, stream);
    MArgs a{};
    for (int i = 0; i < 22; ++i) a.in[i] = (const float*)d_in[i];
    a.out = (float*)d_out; a.ws = (unsigned char*)d_ws; a.ph_lo = 0; a.ph_hi = N_PHASES;
    hipLaunchKernelGGL(mega_fwd, dim3(grid), dim3(NTHR), LDS_BYTES, stream, a);
}
```

```cpp
#include <hip/hip_runtime.h>
#include <cstdio>
#include <cstdint>

typedef unsigned short bf16;
typedef unsigned v4u __attribute__((ext_vector_type(4)));
typedef float f32x4 __attribute__((ext_vector_type(4)));
typedef int i32x2 __attribute__((ext_vector_type(2)));
typedef float f32x2 __attribute__((ext_vector_type(2)));

constexpr int D = 1024, NB = 4, S = 8192, T = NB * S;
constexpr int NPROJ = 3584, WIN_LD = 3592;
constexpr int C_SBQ = 0, C_SBK = 512, C_SBV = 1024, C_MLQ = 1536, C_MLK = 2048, C_MLV = 2560, C_MLO = 3072, C_GATE = 3584;
constexpr int NE = 256, NEX = 257, TOPK = 8, FF = 256;
constexpr float LN_EPS = 1e-5f;
constexpr float DN_ALPHA = 1.189207115002721f;
constexpr float LOG2E = 1.4426950408889634f;
constexpr float QSCALE = 0.125f * LOG2E;
constexpr float SB_THRESH = 48.0f;

constexpr size_t MiB = 1u << 20;
constexpr size_t WS_CTL = 0;
constexpr size_t WS_MOD = 1 * MiB;
constexpr size_t WS_WTIN = 2 * MiB;
constexpr size_t WS_WTOUT = 10 * MiB;
constexpr size_t WS_WTR = 12 * MiB;
constexpr size_t WS_WT2 = 16 * MiB;
constexpr size_t WS_YS = 145 * MiB;
constexpr size_t WS_WT13 = 145 * MiB;
constexpr size_t WS_U2F8 = 274 * MiB;
constexpr size_t WS_PROJ = 402 * MiB;
constexpr size_t WS_GATES = 626 * MiB;
constexpr size_t WS_H = 402 * MiB;
constexpr size_t WS_X1 = 757 * MiB;
constexpr size_t WS_STATES = 657 * MiB;
constexpr size_t WS_MIXOUT = 657 * MiB;
constexpr size_t WS_LOGITS = 657 * MiB;
constexpr size_t WS_U1 = 725 * MiB;
constexpr size_t WS_MIX = 725 * MiB;
constexpr size_t WS_U2 = 833 * MiB;
constexpr size_t WS_YSH = 833 * MiB;
constexpr size_t WS_ROUTE = 897 * MiB;
constexpr size_t WS_END = 902 * MiB;
constexpr int CSTR = 32;
constexpr int CW_CNT = 16384;
constexpr int CW_FILL = 32768;

__device__ __forceinline__ unsigned f2bf(float f) { unsigned u = __builtin_bit_cast(unsigned, f); return (u + 0x7fffu + ((u >> 16) & 1u)) >> 16; }
__device__ __forceinline__ float bf2f(unsigned b) { return __builtin_bit_cast(float, b << 16); }
__device__ __forceinline__ unsigned pk2(float lo, float hi) { return f2bf(lo) | (f2bf(hi) << 16); }
__device__ __forceinline__ unsigned pk4_fp8(float a, float b, float c, float d) { int w = 0; w = __builtin_amdgcn_cvt_pk_fp8_f32(a, b, w, false); w = __builtin_amdgcn_cvt_pk_fp8_f32(c, d, w, true); return (unsigned)w; }
__device__ __forceinline__ float wave_sum(float v) {
    v += __builtin_bit_cast(float, __builtin_amdgcn_update_dpp(0, __builtin_bit_cast(int, v), 0xB1, 0xF, 0xF, true));
    v += __builtin_bit_cast(float, __builtin_amdgcn_update_dpp(0, __builtin_bit_cast(int, v), 0x4E, 0xF, 0xF, true));
    v += __builtin_bit_cast(float, __builtin_amdgcn_update_dpp(0, __builtin_bit_cast(int, v), 0x141, 0xF, 0xF, true));
    v += __builtin_bit_cast(float, __builtin_amdgcn_update_dpp(0, __builtin_bit_cast(int, v), 0x140, 0xF, 0xF, true));
    const int iv = __builtin_bit_cast(int, v);
    const float r0 = __builtin_bit_cast(float, __builtin_amdgcn_readlane(iv, 0)), r1 = __builtin_bit_cast(float, __builtin_amdgcn_readlane(iv, 16));
    const float r2 = __builtin_bit_cast(float, __builtin_amdgcn_readlane(iv, 32)), r3 = __builtin_bit_cast(float, __builtin_amdgcn_readlane(iv, 48));
    return (r0 + r1) + (r2 + r3);
}
__device__ __forceinline__ float sigmoidf_(float x) { return 1.f / (1.f + __expf(-x)); }
__device__ __forceinline__ float siluf_(float x) { return x / (1.f + __expf(-x)); }


struct PrepArgs { const float *w_in, *w_out, *w_router, *w1, *w3, *w2, *sw1, *sw3, *sw2; unsigned char* wtin; bf16 *wtout, *wtr; unsigned char* wt13; unsigned char* wt2; };
struct PrepDesc { const float* src; unsigned char* dst; int ldw, ldt, k0, n0, rowmap, f8; };
constexpr int IT_IN = 16 * 56, IT_OUT = 16 * 16, IT_R = 16 * 4, IT_E = 192, IT_TOTAL = IT_IN + IT_OUT + IT_R + NEX * IT_E;
__device__ __forceinline__ PrepDesc prep_decode(const PrepArgs& a, int it) {
    if (it < IT_IN) return PrepDesc{a.w_in, a.wtin, WIN_LD, D, (it / 112) * 128, (it % 112) * 32, 0, 1}; it -= IT_IN;
    if (it < IT_OUT) return PrepDesc{a.w_out, (unsigned char*)a.wtout, D, D, (it / 32) * 128, (it % 32) * 32, 0, 1}; it -= IT_OUT;
    if (it < IT_R) return PrepDesc{a.w_router, (unsigned char*)a.wtr, NE, D, (it / 4) * 64, (it % 4) * 64, 0, 0}; it -= IT_R;
    const int e = it / IT_E, r = it % IT_E;
    if (r < 64) return PrepDesc{e < NE ? a.w1 + (size_t)e * D * FF : a.sw1, a.wt13 + (size_t)e * 512 * D, FF, D, (r / 8) * 128, (r % 8) * 32, 1, 1};
    if (r < 128) { const int q = r - 64; return PrepDesc{e < NE ? a.w3 + (size_t)e * D * FF : a.sw3, a.wt13 + (size_t)e * 512 * D, FF, D, (q / 8) * 128, (q % 8) * 32, 2, 1}; }
    const int q = r - 128; return PrepDesc{e < NE ? a.w2 + (size_t)e * FF * D : a.sw2, a.wt2 + (size_t)e * D * FF, D, FF, (q / 32) * 128, (q % 32) * 32, 0, 1};
}
__device__ __forceinline__ void prep_load(const PrepDesc& d, int lane, f32x4 (&v)[16]) {
    const int g = d.f8 ? (lane >> 3) : (lane >> 4), i = d.f8 ? (lane & 7) : (lane & 15);
#pragma unroll
    for (int r = 0; r < 16; ++r) v[r] = __builtin_nontemporal_load((const f32x4*)(d.src + (size_t)(d.k0 + 16 * g + r) * d.ldw + d.n0 + 4 * i));
}
__device__ __forceinline__ void prep_store(const PrepDesc& d, int lane, const f32x4 (&v)[16]) {
    const int g = d.f8 ? (lane >> 3) : (lane >> 4), i = d.f8 ? (lane & 7) : (lane & 15);
#pragma unroll
    for (int nn = 0; nn < 4; ++nn) {
        const int n = d.n0 + 4 * i + nn;
        const int dr = d.rowmap == 0 ? n : ((n >> 7) * 256 + (d.rowmap == 2 ? 128 : 0) + (n & 127));
        if (d.f8) {
            v4u o; o.x = pk4_fp8(v[0][nn] * 64.f, v[1][nn] * 64.f, v[2][nn] * 64.f, v[3][nn] * 64.f); o.y = pk4_fp8(v[4][nn] * 64.f, v[5][nn] * 64.f, v[6][nn] * 64.f, v[7][nn] * 64.f);
            o.z = pk4_fp8(v[8][nn] * 64.f, v[9][nn] * 64.f, v[10][nn] * 64.f, v[11][nn] * 64.f); o.w = pk4_fp8(v[12][nn] * 64.f, v[13][nn] * 64.f, v[14][nn] * 64.f, v[15][nn] * 64.f);
            *(v4u*)(d.dst + (size_t)dr * d.ldt + d.k0 + 16 * g) = o;
        } else {
            v4u o0, o1; o0.x = pk2(v[0][nn], v[1][nn]); o0.y = pk2(v[2][nn], v[3][nn]); o0.z = pk2(v[4][nn], v[5][nn]); o0.w = pk2(v[6][nn], v[7][nn]);
            o1.x = pk2(v[8][nn], v[9][nn]); o1.y = pk2(v[10][nn], v[11][nn]); o1.z = pk2(v[12][nn], v[13][nn]); o1.w = pk2(v[14][nn], v[15][nn]);
            v4u* dp = (v4u*)((bf16*)d.dst + (size_t)dr * d.ldt + d.k0 + 16 * g); dp[0] = o0; dp[1] = o1;
        }
    }
}
constexpr int IT_SMALL = IT_IN + IT_OUT + IT_R;
constexpr int BG_A = 16 * (S / 64) * 8, BG_C = BG_A, BG_T = NB * 8 * (S / 32), BG_TOTAL = BG_A + BG_C + BG_T;
constexpr int IT_FG = IT_SMALL;
static_assert(IT_SMALL + BG_TOTAL <= IT_TOTAL, "background slots exceed the expert items");
__device__ __forceinline__ int prep_fg_item(int j) { return j < IT_SMALL ? j : j + BG_TOTAL; }
__device__ __forceinline__ void prep_run(const PrepArgs& a, int it0, int stride, int lane) {
    int it = it0; if (it >= IT_FG) return;
    PrepDesc dA = prep_decode(a, prep_fg_item(it)), dB = dA; f32x4 va[16], vb[16]; prep_load(dA, lane, va);
    for (;;) {
        const int itB = it + stride; const bool hasB = itB < IT_FG;
        if (hasB) { dB = prep_decode(a, prep_fg_item(itB)); prep_load(dB, lane, vb); }
        prep_store(dA, lane, va);
        if (!hasB) break;
        const int itA = itB + stride; const bool hasA = itA < IT_FG;
        if (hasA) { dA = prep_decode(a, prep_fg_item(itA)); prep_load(dA, lane, va); }
        prep_store(dB, lane, vb);
        if (!hasA) break;
        it = itA;
    }
}


__device__ __forceinline__ f32x4 ld_bf4(const bf16* p) { const unsigned long long w = *(const unsigned long long*)p;
    return (f32x4){bf2f((unsigned)w & 0xffffu), bf2f(((unsigned)w) >> 16), bf2f((unsigned)(w >> 32) & 0xffffu), bf2f((unsigned)(w >> 48))}; }

#define LAS __attribute__((address_space(3)))
#define GAS __attribute__((address_space(1)))
namespace pg8 {
typedef short bf16x8 __attribute__((ext_vector_type(8)));
constexpr int F8_SCALE_W = 121;
constexpr int BM = 256, BK = 64, HALF = 128, HTB = HALF * BK * 2, STAGE_BYTES = 8 * HTB, NXCD = 8, WGM = 8;
__host__ __device__ __forceinline__ int lds_byte(int r, int c) { const int st = (r >> 4) * 2 + (c >> 5), rr = r & 15, cc = c & 31, ob = rr * 64 + cc * 2; return st * 1024 + (ob ^ (((ob >> 9) & 1) << 5)); }
__host__ __device__ __forceinline__ void stage_rc(int b, int& R, int& C) { const int st = b / 1024, sb = b % 1024, swz = sb ^ (((sb >> 9) & 1) << 5); R = (st >> 1) * 16 + swz / 64; C = (st & 1) * 32 + (swz % 64) / 2; }
__host__ __device__ __forceinline__ int perm16x(int R) { return 64 * (R >> 5) + 16 * ((R & 15) >> 2) + 4 * ((R >> 4) & 1) + (R & 3); }
__host__ __device__ __forceinline__ int perm32(int rho) { const int n = rho >> 4, i = rho & 15; return 8 * (i >> 2) + 4 * n + (i & 3); }

struct Unit { int pm, pn, e, mt; const char* A; const char* B; };

__device__ __forceinline__ long unit_index(int i, int G, int c) { return (G % 8 == 0) ? ((long)(i * 8 + (c & 7)) * (G / 8) + (c >> 3)) : ((long)i * G + c); }

struct StaticOrder {
    int nM, nN, nwg, G, c; const char* A; const char* B; size_t tstep;
    __device__ void init(const void* A_, const void* B_, int M, int N, int Kb, int G_, int c_) { nM = M / BM; nN = N / BM; nwg = nM * nN; G = G_; c = c_; A = (const char*)A_; B = (const char*)B_; tstep = (size_t)BM * Kb; }
    __device__ __forceinline__ bool next(int i, Unit& u) const {
        const long L = (long)i * G + c; if (L >= nwg) return false;
        int wgid = (int)L; { const int q = nwg / NXCD, r = nwg % NXCD, xcd = wgid % NXCD, off = wgid / NXCD; wgid = (xcd < r ? xcd * (q + 1) : r * (q + 1) + (xcd - r) * q) + off; }
        const int nig = WGM * nN, gid = wgid / nig, fm = gid * WGM, gsz = (nM - fm) < WGM ? (nM - fm) : WGM;
        u.pm = fm + ((wgid % nig) % gsz); u.pn = (wgid % nig) / gsz; u.e = 0; u.mt = u.pm; u.A = A + (size_t)u.pm * tstep; u.B = B + (size_t)u.pn * tstep; return true;
    }
    __device__ __forceinline__ int row_token(const Unit&, int) const { return 0; }
};

struct MoeOrder {
    int G, c, total, shift; const LAS int* tb; const LAS int* nn; const i32x2* list;
    const char* Abase; size_t a_tile_stride; const char* Bbase; size_t b_exp_stride, b_pn_stride;
    __device__ __forceinline__ bool next(int i, Unit& u) const {
        const long L = unit_index(i, G, c); if (L >= total) return false;
        const int tile = (int)(L >> shift); u.pn = (int)(L & ((1 << shift) - 1));
        int lo = 0, hi = NEX; while (hi - lo > 1) { const int mid = (lo + hi) >> 1; if (tb[mid] <= tile) lo = mid; else hi = mid; }
        u.e = lo; u.mt = tile - tb[lo]; u.pm = tile;
        u.A = Abase + (size_t)tile * a_tile_stride; u.B = Bbase + (size_t)lo * b_exp_stride + (size_t)u.pn * b_pn_stride; return true;
    }
    __device__ __forceinline__ int row_token(const Unit& u, int row) const {
        const int rr = u.mt * 256 + row;
        const int tok = list[u.pm * 256 + row].x >> 3;
        return u.e >= NE ? rr : (rr < nn[u.e] ? tok : 0);
    }
};

__device__ __forceinline__ unsigned cvt_pk_bf16(float lo, float hi) { unsigned r; asm volatile("v_cvt_pk_bf16_f32 %0, %1, %2" : "=v"(r) : "v"(lo), "v"(hi)); return r; }

struct EpiBf16 {
    static constexpr int PERM = 2; bf16* O; int ldc; int scale_tiles; float scale; float gscale;
    __device__ __forceinline__ void operator()(const f32x4 (&acc)[2][2][4][2], const Unit& u, int wr, int wc, int fr, int fq) const {
        const int row0 = u.pm * BM + wr * 64 + fr, col0 = u.pn * BM + wc * 64 + 16 * fq; const float sc = (u.pn < scale_tiles ? scale : 1.f) * gscale;
#pragma unroll
        for (int ai = 0; ai < 2; ++ai)
#pragma unroll
            for (int m = 0; m < 4; ++m) { bf16* rowp = O + (size_t)(row0 + ai * HALF + m * 16) * ldc + col0;
#pragma unroll
                for (int bj = 0; bj < 2; ++bj) { const f32x4 v0 = acc[ai][bj][m][0] * sc, v1 = acc[ai][bj][m][1] * sc;
                    v4u w; w.x = cvt_pk_bf16(v0[0], v0[1]); w.y = cvt_pk_bf16(v0[2], v0[3]); w.z = cvt_pk_bf16(v1[0], v1[1]); w.w = cvt_pk_bf16(v1[2], v1[3]);
                    *(v4u*)(rowp + bj * 8) = w; } }
    }
};
struct EpiF32 {
    static constexpr int PERM = 0; float* C; int ldc;
    __device__ __forceinline__ void operator()(const f32x4 (&acc)[2][2][4][2], const Unit& u, int wr, int wc, int fr, int fq) const {
        const int row0 = u.pm * BM + wr * 64 + fr, col0 = u.pn * BM + wc * 32 + 4 * fq;
#pragma unroll
        for (int ai = 0; ai < 2; ++ai)
#pragma unroll
            for (int m = 0; m < 4; ++m) { float* rowp = C + (size_t)(row0 + ai * HALF + m * 16) * ldc + col0;
#pragma unroll
                for (int bj = 0; bj < 2; ++bj)
#pragma unroll
                    for (int n = 0; n < 2; ++n) *(f32x4*)(rowp + bj * HALF + n * 16) = acc[ai][bj][m][n]; }
    }
};
struct EpiGlu {
    static constexpr int PERM = 1; unsigned char* H; float gscale;
    __device__ __forceinline__ void operator()(const f32x4 (&acc)[2][2][4][2], const Unit& u, int wr, int wc, int fr, int fq) const {
        const int row0 = u.pm * BM + wr * 64 + fr, col0 = u.pn * HALF + wc * 32 + 8 * fq;
#pragma unroll
        for (int ai = 0; ai < 2; ++ai)
#pragma unroll
            for (int m = 0; m < 4; ++m) { float h[8];
#pragma unroll
                for (int n = 0; n < 2; ++n)
#pragma unroll
                    for (int q = 0; q < 4; ++q) { const float a = acc[ai][0][m][n][q] * gscale; h[n * 4 + q] = a * __builtin_amdgcn_rcpf(1.f + __expf(-a)) * (acc[ai][1][m][n][q] * gscale); }
                *(unsigned long long*)(H + (size_t)(row0 + ai * HALF + m * 16) * FF + col0) = (unsigned long long)pk4_fp8(h[0], h[1], h[2], h[3]) | ((unsigned long long)pk4_fp8(h[4], h[5], h[6], h[7]) << 32); }
    }
};
struct EpiScatter {
    static constexpr int PERM = 2; unsigned char* ys8; unsigned char* ysh8; const i32x2* list; const LAS int* nn;
    __device__ __forceinline__ void operator()(const f32x4 (&acc)[2][2][4][2], const Unit& u, int wr, int wc, int fr, int fq) const {
        const int col0 = u.pn * BM + wc * 64 + 16 * fq; const int n = nn[u.e]; const bool routed = u.e < NE;
        const i32x2* lp = list + (size_t)(u.pm - u.mt) * 256;
#pragma unroll
        for (int ai = 0; ai < 2; ++ai) {
            i32x2 en[4];
#pragma unroll
            for (int m = 0; m < 4; ++m) { const int rr = u.mt * 256 + ai * HALF + wr * 64 + m * 16 + fr; const i32x2 ld = lp[rr];
                en[m].x = routed ? ld.x : rr; en[m].y = routed ? ld.y : 0x3f800000; }
#pragma unroll
            for (int m = 0; m < 4; ++m) { const int rr = u.mt * 256 + ai * HALF + wr * 64 + m * 16 + fr;
                if (rr < n) { const float g = __int_as_float(en[m].y) * (16.f / 64.f);
                    const f32x4 a0 = acc[ai][0][m][0] * g, a1 = acc[ai][0][m][1] * g, b0 = acc[ai][1][m][0] * g, b1 = acc[ai][1][m][1] * g;
                    v4u w; w.x = pk4_fp8(a0[0], a0[1], a0[2], a0[3]); w.y = pk4_fp8(a1[0], a1[1], a1[2], a1[3]); w.z = pk4_fp8(b0[0], b0[1], b0[2], b0[3]); w.w = pk4_fp8(b1[0], b1[1], b1[2], b1[3]);
                    *(v4u*)((routed ? ys8 : ysh8) + (size_t)en[m].x * D + col0) = w; } }
            __builtin_amdgcn_sched_barrier(0);
        }
    }
};

typedef int i32x8 __attribute__((ext_vector_type(8)));
typedef int i32x4 __attribute__((ext_vector_type(4)));
template <bool FP8> struct FragT { struct A4 { bf16x8 v[4][2]; }; struct B2 { bf16x8 v[2][2]; }; };
template <> struct FragT<true> { struct A4 { i32x8 v[4]; }; struct B2 { i32x8 v[2]; }; };
template <class Epi, class Sched, bool GATHER, bool FP8>
__device__ __forceinline__ void gemm_phase(LAS unsigned char* lds, const int Kb, const Sched& S, const Epi& E) {
    const int tid = threadIdx.x, wid = __builtin_amdgcn_readfirstlane(tid >> 6), lane = tid & 63, wr = wid >> 2, wc = wid & 3, fr = lane & 15, fq = lane >> 4;
    const int nt = Kb / 128;
    int sR[2], sC[2];
    unsigned voffA[2], voffB[2];
#pragma unroll
    for (int i = 0; i < 2; ++i) { stage_rc(tid * 16 + i * 8192, sR[i], sC[i]); const int Rb = Epi::PERM == 2 ? perm16x(sR[i]) : (Epi::PERM == 1 ? ((sR[i] & ~31) + perm32(sR[i] & 31)) : sR[i]);
        voffA[i] = (unsigned)(sR[i] * Kb + sC[i] * 2); voffB[i] = (unsigned)(Rb * Kb + sC[i] * 2); }
    const size_t kstep = (size_t)(BK * 2);
    const size_t hstep = (size_t)HALF * Kb;
    const size_t bhstep = Epi::PERM == 2 ? (size_t)8 * Kb : hstep;
    const unsigned ldsw = (unsigned)wid * 1024u;
    const int aoff = lds_byte(wr * 64 + fr, fq * 8), boff = lds_byte(wc * 32 + fr, fq * 8);
    unsigned gc[2][2], gn[2][2];
#define PG8_SA(b, h) (((b) * 2 + (h)) * HTB)
#define PG8_SB(b, h) ((4 + (b) * 2 + (h)) * HTB)
#define PG8_GLDS(src, bufoff, i) __builtin_amdgcn_global_load_lds((const unsigned*)(src), (LAS unsigned*)(lds + (bufoff) + ldsw + (i) * 8192), 16, 0, 0)
#define PG8_STAGE_B(bufoff, gbase) do { PG8_GLDS((const char*)(gbase) + voffB[0], bufoff, 0); PG8_GLDS((const char*)(gbase) + voffB[1], bufoff, 1); } while (0)
#define PG8_STAGE_A(bufoff, gbase, h, nx) do { if constexpr (GATHER) { const unsigned _o0 = (nx) ? gn[h][0] : gc[h][0], _o1 = (nx) ? gn[h][1] : gc[h][1]; \
            PG8_GLDS((const char*)(gbase) + _o0, bufoff, 0); PG8_GLDS((const char*)(gbase) + _o1, bufoff, 1); } \
        else { PG8_GLDS((const char*)(gbase) + (h) * hstep + voffA[0], bufoff, 0); PG8_GLDS((const char*)(gbase) + (h) * hstep + voffA[1], bufoff, 1); } } while (0)
#define PG8_LD2(dstv, p) do { if constexpr (FP8) { const i32x4 _lo = *(const LAS i32x4*)(p), _hi = *(const LAS i32x4*)((p) + 1024); dstv = __builtin_shufflevector(_lo, _hi, 0, 1, 2, 3, 4, 5, 6, 7); } } while (0)
#define PG8_LDA(dst, b, h) do { _Pragma("unroll") for (int m = 0; m < 4; ++m) { if constexpr (FP8) { PG8_LD2(dst.v[m], lds + PG8_SA(b, h) + aoff + m * 2048); } \
        else { _Pragma("unroll") for (int k = 0; k < 2; ++k) dst.v[m][k] = *(const LAS bf16x8*)(lds + PG8_SA(b, h) + aoff + m * 2048 + k * 1024); } } } while (0)
#define PG8_LDB(dst, b, h) do { _Pragma("unroll") for (int n = 0; n < 2; ++n) { if constexpr (FP8) { PG8_LD2(dst.v[n], lds + PG8_SB(b, h) + boff + n * 2048); } \
        else { _Pragma("unroll") for (int k = 0; k < 2; ++k) dst.v[n][k] = *(const LAS bf16x8*)(lds + PG8_SB(b, h) + boff + n * 2048 + k * 1024); } } } while (0)
#define PG8_MMA(ai, bj, At, Bt) do { __builtin_amdgcn_s_setprio(1); _Pragma("unroll") for (int m = 0; m < 4; ++m) _Pragma("unroll") for (int n = 0; n < 2; ++n) { \
        if constexpr (FP8) asm volatile("s_nop 1\n\tv_mfma_scale_f32_16x16x128_f8f6f4 %0, %1, %2, %0, %3, %3 op_sel_hi:[0,0,0]" : "+v"(acc[ai][bj][m][n]) : "v"(Bt.v[n]), "v"(At.v[m]), "v"(f8scale)); \
        else { _Pragma("unroll") for (int k = 0; k < 2; ++k) acc[ai][bj][m][n] = __builtin_amdgcn_mfma_f32_16x16x32_bf16(Bt.v[n][k], At.v[m][k], acc[ai][bj][m][n], 0, 0, 0); } } \
        __builtin_amdgcn_s_setprio(0); } while (0)
#define PG8_WAIT_V(n) asm volatile("s_waitcnt vmcnt(" #n ")" ::: "memory")
#define PG8_WAIT_L(n) asm volatile("s_waitcnt lgkmcnt(" #n ")" ::: "memory")
#define PG8_BAR __builtin_amdgcn_s_barrier()
#define PG8_SCHED __builtin_amdgcn_sched_barrier(0)
#define PG8_GATHER(dst, u) do { _Pragma("unroll") for (int _h = 0; _h < 2; ++_h) _Pragma("unroll") for (int _i = 0; _i < 2; ++_i) \
        dst[_h][_i] = (unsigned)(S.row_token(u, _h * HALF + sR[_i]) * Kb + sC[_i] * 2); } while (0)
    Unit cur, nxt; int ui = 0;
    if (!S.next(0, cur)) return;
    f32x4 acc[2][2][4][2];
#pragma unroll
    for (int a = 0; a < 2; ++a)
#pragma unroll
        for (int b = 0; b < 2; ++b)
#pragma unroll
            for (int m = 0; m < 4; ++m)
#pragma unroll
                for (int n = 0; n < 2; ++n) acc[a][b][m][n] = (f32x4){0.f, 0.f, 0.f, 0.f};
    const int f8scale = 0x7f7f7f7f;
    typedef typename FragT<FP8>::A4 FragA; typedef typename FragT<FP8>::B2 FragB;
    FragA At; FragB B0, B1;
    const char* cA = cur.A; const char* cB = cur.B;
    if constexpr (GATHER) { PG8_GATHER(gc, cur); }
    PG8_STAGE_B(PG8_SB(0, 0), cB); PG8_STAGE_A(PG8_SA(0, 0), cA, 0, false); PG8_STAGE_B(PG8_SB(0, 1), cB + bhstep); PG8_STAGE_A(PG8_SA(0, 1), cA, 1, false);
    if (wr == 1) PG8_BAR;
    PG8_WAIT_V(4); PG8_BAR;
    PG8_STAGE_B(PG8_SB(1, 0), cB + kstep); PG8_STAGE_A(PG8_SA(1, 0), cA + kstep, 0, false); PG8_STAGE_B(PG8_SB(1, 1), cB + bhstep + kstep);
    PG8_WAIT_V(6); PG8_BAR;
    for (;;) {
        const bool has_next = S.next(ui + 1, nxt);
        const char* nA = has_next ? nxt.A : cA; const char* nB = has_next ? nxt.B : cB;
        if constexpr (GATHER) { if (has_next) { PG8_GATHER(gn, nxt); } else {
#pragma unroll
            for (int h = 0; h < 2; ++h) { gn[h][0] = gc[h][0]; gn[h][1] = gc[h][1]; } } }
#pragma unroll 1
        for (int t = 0; t < nt; t += 2) {
            const bool last = (t == nt - 2);
            const char* a1 = cA + (size_t)(t + 1) * kstep;
            const char* a2 = last ? nA : cA + (size_t)(t + 2) * kstep; const char* b2 = last ? nB : cB + (size_t)(t + 2) * kstep;
            const char* a3 = a2 + kstep; const char* b3 = b2 + kstep;
            PG8_LDB(B0, 0, 0); PG8_SCHED; PG8_LDA(At, 0, 0); PG8_STAGE_A(PG8_SA(1, 1), a1, 1, false);
            PG8_WAIT_L(8); PG8_BAR; PG8_WAIT_L(0); PG8_MMA(0, 0, At, B0); PG8_BAR; PG8_SCHED;
            PG8_LDB(B1, 0, 1); PG8_STAGE_B(PG8_SB(0, 0), b2);
            PG8_BAR; PG8_WAIT_L(0); PG8_MMA(0, 1, At, B1); PG8_BAR;
            PG8_LDA(At, 0, 1); PG8_STAGE_A(PG8_SA(0, 0), a2, 0, last);
            PG8_BAR; PG8_WAIT_L(0); PG8_MMA(1, 0, At, B0); PG8_BAR; PG8_SCHED;
            PG8_STAGE_B(PG8_SB(0, 1), b2 + bhstep);
            PG8_WAIT_V(6); PG8_BAR; PG8_MMA(1, 1, At, B1); PG8_BAR;
            PG8_LDB(B0, 1, 0); PG8_SCHED; PG8_LDA(At, 1, 0); PG8_STAGE_A(PG8_SA(0, 1), a2, 1, last);
            PG8_WAIT_L(8); PG8_BAR; PG8_WAIT_L(0); PG8_MMA(0, 0, At, B0); PG8_BAR; PG8_SCHED;
            PG8_LDB(B1, 1, 1); PG8_STAGE_B(PG8_SB(1, 0), b3);
            PG8_BAR; PG8_WAIT_L(0); PG8_MMA(0, 1, At, B1); PG8_BAR;
            PG8_LDA(At, 1, 1); PG8_STAGE_A(PG8_SA(1, 0), a3, 0, last);
            PG8_BAR; PG8_WAIT_L(0); PG8_MMA(1, 0, At, B0); PG8_BAR; PG8_SCHED;
            PG8_STAGE_B(PG8_SB(1, 1), b3 + bhstep);
            PG8_WAIT_V(6); PG8_BAR; PG8_MMA(1, 1, At, B1); PG8_BAR;
        }
        if (wr == 0) PG8_BAR;
        if constexpr (FP8) { __builtin_amdgcn_sched_barrier(0); asm volatile("s_nop 15\n\ts_nop 7" ::: "memory"); __builtin_amdgcn_sched_barrier(0); }
        E(acc, cur, wr, wc, fr, fq);
        if (!has_next) break;
#pragma unroll
        for (int a = 0; a < 2; ++a)
#pragma unroll
            for (int b = 0; b < 2; ++b)
#pragma unroll
                for (int m = 0; m < 4; ++m)
#pragma unroll
                    for (int n = 0; n < 2; ++n) acc[a][b][m][n] = (f32x4){0.f, 0.f, 0.f, 0.f};
        cur = nxt; cA = nA; cB = nB; ++ui;
        if (wr == 1) PG8_BAR;
        if constexpr (GATHER) {
#pragma unroll
            for (int h = 0; h < 2; ++h) { gc[h][0] = gn[h][0]; gc[h][1] = gn[h][1]; } }
    }
    PG8_WAIT_V(0);
    PG8_BAR;
#undef PG8_SA
#undef PG8_SB
#undef PG8_GLDS
#undef PG8_STAGE_A
#undef PG8_STAGE_B
#undef PG8_LDA
#undef PG8_LDB
#undef PG8_MMA
#undef PG8_WAIT_V
#undef PG8_WAIT_L
#undef PG8_BAR
#undef PG8_SCHED
#undef PG8_GATHER
}
}

#define XB_TMO      128
#define XB_XCNT(j)  (256  + 64 * (j))
#define XB_XSUB(j)  (1280 + 64 * (j))
#define XB_XGEN(j)  (2304 + 64 * (j))
#define XB_TOP      3328
#define XB_TOPGEN   3392
#define XCD_BAR_WORDS 3456
#define XB_SPIN_CAP (1u << 22)
__device__ __forceinline__ unsigned xb_ld(unsigned* p)              { return __hip_atomic_load(p, __ATOMIC_RELAXED, __HIP_MEMORY_SCOPE_AGENT); }
__device__ __forceinline__ unsigned xb_add(unsigned* p, unsigned v) { return __hip_atomic_fetch_add(p, v, __ATOMIC_RELAXED, __HIP_MEMORY_SCOPE_AGENT); }
__device__ __forceinline__ unsigned xb_xcc_id() { return (unsigned)__builtin_amdgcn_s_getreg((3 << 11) | 20) & 0xFu; }
#define XB_SPIN(cond, bar) do { unsigned _sp = 0; while (cond) { __builtin_amdgcn_s_sleep(1); \
    if ((++_sp & 255u) == 0u) { if (xb_ld(&(bar)[XB_TMO])) break; if (_sp > XB_SPIN_CAP) { atomicAdd(&(bar)[XB_TMO], 1u); break; } } } } while (0)
struct XcdBarrier { unsigned* bar; unsigned x; volatile LAS unsigned* st; };
__device__ __forceinline__ XcdBarrier xcd_barrier_post(unsigned* bar, volatile LAS unsigned* st) {
    XcdBarrier b; b.bar = bar; b.x = xb_xcc_id(); b.st = st;
    if (threadIdx.x == 0) (void)xb_add(&bar[XB_XCNT(b.x)], 1u);
    return b;
}
__device__ __forceinline__ void xcd_barrier_complete(unsigned* bar, unsigned x, unsigned& nloc, unsigned& nx) {
    const unsigned G = gridDim.x * gridDim.y * gridDim.z;
    unsigned sum, cnt, mine, sp = 0u;
    for (;;) {
        sum = 0u; cnt = 0u; mine = 0u;
#pragma unroll
        for (unsigned j = 0; j < 16; ++j) { const unsigned c = xb_ld(&bar[XB_XCNT(j)]); sum += c; cnt += (c > 0u) ? 1u : 0u; mine = (j == x) ? c : mine; }
        if (sum == G) break;
        __builtin_amdgcn_s_sleep(1);
        if ((++sp & 255u) == 0u) { if (xb_ld(&bar[XB_TMO])) break; if (sp > XB_SPIN_CAP) { atomicAdd(&bar[XB_TMO], 1u); break; } }
    }
    nloc = mine > 0u ? mine : 1u; nx = cnt > 0u ? cnt : 1u;
}
__device__ __forceinline__ void xcd_barrier(const XcdBarrier& b) {
    asm volatile("s_waitcnt vmcnt(0)" ::: "memory");
    __syncthreads();
    if (threadIdx.x == 0) {
        unsigned* bar = b.bar;
        __builtin_amdgcn_s_waitcnt(0);
        unsigned nloc = b.st[0], nx = b.st[1];
        if (nloc == 0u) { xcd_barrier_complete(bar, b.x, nloc, nx); b.st[0] = nloc; b.st[1] = nx; }
        const unsigned old = xb_add(&bar[XB_XSUB(b.x)], 1u);
        const unsigned gen = old / nloc;
        if (old + 1u == (gen + 1u) * nloc) {
            __builtin_amdgcn_fence(__ATOMIC_RELEASE, "agent");
            asm volatile("s_waitcnt vmcnt(0)" ::: "memory");
            const unsigned og = xb_add(&bar[XB_TOP], 1u);
            const unsigned tg = og / nx;
            if (og + 1u == (tg + 1u) * nx) xb_add(&bar[XB_TOPGEN], 1u);
            else XB_SPIN(xb_ld(&bar[XB_TOPGEN]) == tg, bar);
            __builtin_amdgcn_fence(__ATOMIC_ACQUIRE, "agent");
            xb_add(&bar[XB_XGEN(b.x)], 1u);
            asm volatile("s_waitcnt vmcnt(0)" ::: "memory");
        } else {
            XB_SPIN(xb_ld(&bar[XB_XGEN(b.x)]) == gen, bar);
            __builtin_amdgcn_fence(__ATOMIC_ACQUIRE, "agent");
            asm volatile("s_waitcnt vmcnt(0)" ::: "memory");
        }
    }
    __syncthreads();
}

constexpr int NWAVES = 8, NTHR = 512;
constexpr int RING_BYTES = 131072, XTRA_OFF = RING_BYTES, LDS_BYTES = 147456;
constexpr int X_MISC = 0, X_TB = 256, X_NN = 1536;
constexpr int CW_BAR = 4096;
constexpr int N_PHASES = 14;
struct MArgs { const float* in[22]; float* out; unsigned char* ws; int ph_lo, ph_hi; };

#define MAKE_PREP_ARGS(a) PrepArgs{(a).in[4], (a).in[9], (a).in[12], (a).in[14], (a).in[15], (a).in[16], (a).in[17], (a).in[18], (a).in[19], \
    (unsigned char*)((a).ws + WS_WTIN), (bf16*)((a).ws + WS_WTOUT), (bf16*)((a).ws + WS_WTR), (unsigned char*)((a).ws + WS_WT13), (unsigned char*)((a).ws + WS_WT2)}
__device__ __forceinline__ void ph_mod_prep(const MArgs& a, unsigned char* smem, int G) {
    const int tid = threadIdx.x;
    unsigned char* ws = a.ws;
    if ((int)blockIdx.x < 192) {
        float* sc = (float*)smem; float* red = sc + NB * D;
        const float* c = a.in[1]; const float* w_ada = a.in[2]; const float* b_ada = a.in[3]; float* mod = (float*)(ws + WS_MOD);
        for (int i = tid; i < NB * D; i += NTHR) sc[i] = siluf_(c[i]);
        __syncthreads();
        for (int it = blockIdx.x; it < 192; it += G) {
            const int kq = tid >> 5, jl = tid & 31, j = it * 32 + jl;
            float a0 = 0.f, a1 = 0.f, a2 = 0.f, a3 = 0.f;
#pragma unroll 16
            for (int kk = 0; kk < 64; ++kk) { const int k = kq * 64 + kk; const float w = w_ada[(size_t)k * 6144 + j];
                a0 += sc[k] * w; a1 += sc[D + k] * w; a2 += sc[2 * D + k] * w; a3 += sc[3 * D + k] * w; }
            red[(kq * 4 + 0) * 32 + jl] = a0; red[(kq * 4 + 1) * 32 + jl] = a1; red[(kq * 4 + 2) * 32 + jl] = a2; red[(kq * 4 + 3) * 32 + jl] = a3;
            __syncthreads();
            if (tid < 128) { const int b = tid >> 5; float s = b_ada[j];
#pragma unroll
                for (int q = 0; q < 16; ++q) s += red[(q * 4 + b) * 32 + jl];
                mod[b * 6144 + j] = s; }
            __syncthreads();
        }
    }
    const PrepArgs pa = MAKE_PREP_ARGS(a);
    const int lane = tid & 63, gw = blockIdx.x * NWAVES + (tid >> 6), ngw = G * NWAVES;
    prep_run(pa, gw, ngw, lane);
}

__device__ __forceinline__ void ph_ln1(const MArgs& a, unsigned char* smem, int G) {
    const int tid = threadIdx.x, lane = tid & 63, wave = tid >> 6;
    const float* x = a.in[0]; const float* w_in = a.in[4]; const float* gate_b = a.in[7];
    const float* mod = (const float*)(a.ws + WS_MOD); unsigned char* u1 = (unsigned char*)(a.ws + WS_U1); float* ipre = (float*)(a.ws + WS_GATES); float* logf = ipre + 16 * S;
    float* wg = (float*)smem;
    for (int i = tid; i < D * 8; i += NTHR) wg[i] = w_in[(size_t)(i >> 3) * WIN_LD + C_GATE + (i & 7)];
    __syncthreads();
    for (int it = blockIdx.x; it < T / 128; it += G) {
        const int row0 = it * 128, b = row0 / S;
        f32x4 sh[4], sc[4];
#pragma unroll
        for (int j = 0; j < 4; ++j) { sh[j] = *(const f32x4*)(mod + b * 6144 + 4 * lane + 256 * j); sc[j] = *(const f32x4*)(mod + b * 6144 + 1024 + 4 * lane + 256 * j); }
        for (int rr = wave; rr < 128; rr += NWAVES) {
            const int row = row0 + rr;
            const f32x4* xr = (const f32x4*)(x + (size_t)row * D) + lane;
            f32x4 v[4]; float s = 0.f;
#pragma unroll
            for (int j = 0; j < 4; ++j) { v[j] = xr[64 * j]; s += (v[j].x + v[j].y) + (v[j].z + v[j].w); }
            const float mean = wave_sum(s) * (1.f / D); float s2 = 0.f;
#pragma unroll
            for (int j = 0; j < 4; ++j) { v[j] = v[j] - mean; s2 += (v[j].x * v[j].x + v[j].y * v[j].y) + (v[j].z * v[j].z + v[j].w * v[j].w); }
            const float rstd = 1.f / sqrtf(wave_sum(s2) * (1.f / D) + LN_EPS);
            float ga[8];
#pragma unroll
            for (int q = 0; q < 8; ++q) ga[q] = 0.f;
            unsigned* o4 = (unsigned*)(u1 + (size_t)row * D) + lane;
#pragma unroll
            for (int j = 0; j < 4; ++j) {
                const f32x4 u = v[j] * rstd * (sc[j] + 1.0f) + sh[j];
                o4[64 * j] = pk4_fp8(u.x, u.y, u.z, u.w);
#pragma unroll
                for (int e = 0; e < 4; ++e) { const int k = 4 * lane + 256 * j + e;
                    const f32x4 w0 = *(const f32x4*)(wg + k * 8), w1 = *(const f32x4*)(wg + k * 8 + 4);
                    ga[0] += u[e] * w0.x; ga[1] += u[e] * w0.y; ga[2] += u[e] * w0.z; ga[3] += u[e] * w0.w;
                    ga[4] += u[e] * w1.x; ga[5] += u[e] * w1.y; ga[6] += u[e] * w1.z; ga[7] += u[e] * w1.w; }
            }
#pragma unroll
            for (int q = 0; q < 8; ++q) ga[q] = wave_sum(ga[q]);
            if (lane < 8) {
                float gv = 0.f;
#pragma unroll
                for (int q = 0; q < 8; ++q) gv = (lane == q) ? ga[q] : gv;
                gv += gate_b[lane];
                const int h = lane & 3, s_ = row % S;
                if (lane < 4) ipre[(size_t)(b * 4 + h) * S + s_] = gv;
                else logf[(size_t)(b * 4 + h) * S + s_] = fminf(gv, 0.f) - log1pf(__expf(-fabsf(gv)));
            }
        }
    }
}

__device__ __forceinline__ void ph_ln2(const MArgs& a, int G) {
    const float* x = a.in[0]; const bf16* mixout = (const bf16*)(a.ws + WS_MIXOUT); const float* mod = (const float*)(a.ws + WS_MOD); const float* ln1_g = a.in[10]; const float* ln1_b = a.in[11];
    bf16* x1 = (bf16*)(a.ws + WS_X1); bf16* u2 = (bf16*)(a.ws + WS_U2); unsigned char* u2f8 = (unsigned char*)(a.ws + WS_U2F8);
    const int tid = threadIdx.x, lane = tid & 63, wave = tid >> 6;
    for (int it = blockIdx.x; it < T / 128; it += G) {
        const int row0 = it * 128, b = row0 / S;
        f32x4 g1[4], lg[4], lb[4], sc2[4], sh2[4];
#pragma unroll
        for (int j = 0; j < 4; ++j) { const int col = 4 * lane + 256 * j;
            g1[j] = *(const f32x4*)(mod + b * 6144 + 2048 + col); lg[j] = *(const f32x4*)(ln1_g + col); lb[j] = *(const f32x4*)(ln1_b + col);
            sc2[j] = *(const f32x4*)(mod + b * 6144 + 4096 + col) + 1.0f; sh2[j] = *(const f32x4*)(mod + b * 6144 + 3072 + col); }
        for (int rr = wave; rr < 128; rr += NWAVES) {
            const int row = row0 + rr;
            f32x4 v[4]; float s = 0.f;
#pragma unroll
            for (int j = 0; j < 4; ++j) {
                const int col = 4 * lane + 256 * j;
                const f32x4 xv = __builtin_nontemporal_load((const f32x4*)(x + (size_t)row * D + col));
                const f32x4 mo = ld_bf4(mixout + (size_t)row * D + col);
                v[j] = xv * DN_ALPHA + g1[j] * mo; s += (v[j].x + v[j].y) + (v[j].z + v[j].w);
            }
            float mean = wave_sum(s) * (1.f / D), s2 = 0.f;
#pragma unroll
            for (int j = 0; j < 4; ++j) { v[j] = v[j] - mean; s2 += (v[j].x * v[j].x + v[j].y * v[j].y) + (v[j].z * v[j].z + v[j].w * v[j].w); }
            float rstd = 1.f / sqrtf(wave_sum(s2) * (1.f / D) + LN_EPS);
            s = 0.f;
#pragma unroll
            for (int j = 0; j < 4; ++j) { const int col = 4 * lane + 256 * j;
                v[j] = v[j] * rstd * lg[j] + lb[j];
                *(unsigned long long*)(x1 + (size_t)row * D + col) = (unsigned long long)pk2(v[j].x, v[j].y) | ((unsigned long long)pk2(v[j].z, v[j].w) << 32); s += (v[j].x + v[j].y) + (v[j].z + v[j].w); }
            mean = wave_sum(s) * (1.f / D); s2 = 0.f;
#pragma unroll
            for (int j = 0; j < 4; ++j) { v[j] = v[j] - mean; s2 += (v[j].x * v[j].x + v[j].y * v[j].y) + (v[j].z * v[j].z + v[j].w * v[j].w); }
            rstd = 1.f / sqrtf(wave_sum(s2) * (1.f / D) + LN_EPS);
#pragma unroll
            for (int j = 0; j < 4; ++j) { const int col = 4 * lane + 256 * j;
                const f32x4 u = v[j] * rstd * sc2[j] + sh2[j];
                *(unsigned long long*)(u2 + (size_t)row * D + col) = (unsigned long long)pk2(u.x, u.y) | ((unsigned long long)pk2(u.z, u.w) << 32);
                *(unsigned*)(u2f8 + (size_t)row * D + col) = pk4_fp8(u.x, u.y, u.z, u.w); }
        }
    }
}
#define DPPI(v, ctrl) __builtin_amdgcn_update_dpp(0, (v), (ctrl), 0xF, 0xF, true)
#define DPPF(v, ctrl) __builtin_bit_cast(float, __builtin_amdgcn_update_dpp(0, __builtin_bit_cast(int, (v)), (ctrl), 0xF, 0xF, true))
__device__ __forceinline__ void route_wave(int t, int lane, const float* __restrict__ logits, const f32x4 bias4, int* __restrict__ tope, float* __restrict__ topg, LAS int* hist) {
    const f32x4 lg = *(const f32x4*)(logits + (size_t)t * NE + 4 * lane);
    float sc[4], v[4];
#pragma unroll
    for (int j = 0; j < 4; ++j) { sc[j] = 1.f / (1.f + __expf(-lg[j])); v[j] = sc[j] + bias4[j]; }
    float m1 = fmaxf(fmaxf(v[0], v[1]), fmaxf(v[2], v[3]));
    float m2; { const float a = fmaxf(v[0], v[1]), b = fminf(v[0], v[1]), c = fmaxf(v[2], v[3]), d = fminf(v[2], v[3]); m2 = fmaxf(fminf(a, c), fmaxf(b, d)); }
#pragma unroll
    for (int st = 0; st < 3; ++st) { const float o1 = st == 0 ? DPPF(m1, 0xB1) : (st == 1 ? DPPF(m1, 0x4E) : DPPF(m1, 0x141)), o2 = st == 0 ? DPPF(m2, 0xB1) : (st == 1 ? DPPF(m2, 0x4E) : DPPF(m2, 0x141));
        const float n1 = fmaxf(m1, o1); m2 = fmaxf(fminf(m1, o1), fmaxf(m2, o2)); m1 = n1; }
    const float gs = m1 + m2; const int myg = lane >> 3; int rank = 0;
#pragma unroll
    for (int gg = 0; gg < 8; ++gg) { const float og = __builtin_bit_cast(float, __builtin_amdgcn_readlane(__builtin_bit_cast(int, gs), gg * 8)); rank += (og > gs || (og == gs && gg < myg)) ? 1 : 0; }
    unsigned kh[4];
#pragma unroll
    for (int j = 0; j < 4; ++j) { const unsigned u = __builtin_bit_cast(unsigned, v[j]); kh[j] = (rank >= 4) ? 0u : (u ^ ((u >> 31) ? 0xFFFFFFFFu : 0x80000000u)); }
    int myE = 0; float myS = 0.f, gsum = 0.f;
#pragma unroll
    for (int rd = 0; rd < 8; ++rd) {
        unsigned bh_ = kh[0]; int bl = 255 - 4 * lane;
#pragma unroll
        for (int j = 1; j < 4; ++j) if (kh[j] > bh_) { bh_ = kh[j]; bl = 255 - (4 * lane + j); }
#pragma unroll
        for (int st = 0; st < 4; ++st) {
            const int ctrl = st == 0 ? 0xB1 : (st == 1 ? 0x4E : (st == 2 ? 0x141 : 0x140));
            const unsigned oh = (unsigned)(st == 0 ? DPPI((int)bh_, 0xB1) : (st == 1 ? DPPI((int)bh_, 0x4E) : (st == 2 ? DPPI((int)bh_, 0x141) : DPPI((int)bh_, 0x140))));
            const int ol = st == 0 ? DPPI(bl, 0xB1) : (st == 1 ? DPPI(bl, 0x4E) : (st == 2 ? DPPI(bl, 0x141) : DPPI(bl, 0x140)));
            (void)ctrl; const bool take = (oh > bh_) || (oh == bh_ && ol > bl); bh_ = take ? oh : bh_; bl = take ? ol : bl; }
        unsigned wh = (unsigned)__builtin_amdgcn_readlane((int)bh_, 0); int wl = __builtin_amdgcn_readlane(bl, 0);
#pragma unroll
        for (int rw = 1; rw < 4; ++rw) { const unsigned oh = (unsigned)__builtin_amdgcn_readlane((int)bh_, 16 * rw); const int ol = __builtin_amdgcn_readlane(bl, 16 * rw);
            const bool take = (oh > wh) || (oh == wh && ol > wl); wh = take ? oh : wh; wl = take ? ol : wl; }
        const int bi = 255 - wl;
        float cand = 0.f;
#pragma unroll
        for (int j = 0; j < 4; ++j) if (bi == 4 * lane + j) { cand = sc[j]; kh[j] = 0u; }
        const float ss = __builtin_bit_cast(float, __builtin_amdgcn_readlane(__builtin_bit_cast(int, cand), bi >> 2));
        gsum += ss;
        if (lane == rd) { myE = bi; myS = ss; }
    }
    if (lane < 8) { tope[t * 8 + lane] = myE; topg[t * 8 + lane] = myS * (2.5f / gsum); __hip_atomic_fetch_add(hist + myE, 1, __ATOMIC_RELAXED, __HIP_MEMORY_SCOPE_WORKGROUP); }
}
__device__ __forceinline__ void moe_tables(const int* cnt, LAS int* tb, LAS int* nn) {
    if (threadIdx.x < 64) {
        const int lane = threadIdx.x; int n[4], tl[4], loc = 0;
#pragma unroll
        for (int j = 0; j < 4; ++j) { n[j] = cnt[(4 * lane + j) * CSTR]; tl[j] = (n[j] + 255) >> 8; loc += tl[j]; }
        int inc = loc;
#pragma unroll
        for (int o = 1; o < 64; o <<= 1) { const int v = __shfl_up(inc, o); if (lane >= o) inc += v; }
        int base = inc - loc;
#pragma unroll
        for (int j = 0; j < 4; ++j) { tb[4 * lane + j] = base; nn[4 * lane + j] = n[j]; base += tl[j]; }
        if (lane == 63) { tb[NE] = base; nn[NE] = T; tb[NEX] = base + T / 256; }
    }
    __syncthreads();
}
__device__ __forceinline__ void ph_final(const MArgs& a, int G) {
    float* out = a.out; const bf16* x1 = (const bf16*)(a.ws + WS_X1); const unsigned char* ys8 = (const unsigned char*)(a.ws + WS_YS); const unsigned char* ysh8 = (const unsigned char*)(a.ws + WS_YSH); const float* mod = (const float*)(a.ws + WS_MOD);
    const float* ln2_g = a.in[20]; const float* ln2_b = a.in[21];
    const int tid = threadIdx.x, lane = tid & 63, wave = tid >> 6;
    for (int it = blockIdx.x; it < T / 128; it += G) {
        const int row0 = it * 128, b = row0 / S;
        f32x4 g2[4], lg[4], lb[4];
#pragma unroll
        for (int j = 0; j < 4; ++j) { const int col = 4 * lane + 256 * j; g2[j] = *(const f32x4*)(mod + b * 6144 + 5120 + col); lg[j] = *(const f32x4*)(ln2_g + col); lb[j] = *(const f32x4*)(ln2_b + col); }
        for (int rr = wave; rr < 128; rr += NWAVES) {
            const int row = row0 + rr;
            f32x4 v[4]; float s = 0.f;
#pragma unroll
            for (int j = 0; j < 4; ++j) { const int col = 4 * lane + 256 * j;
                f32x4 yr = {0.f, 0.f, 0.f, 0.f};
#pragma unroll
                for (int k = 0; k < 8; ++k) { const int w = *(const int*)(ys8 + ((size_t)row * 8 + k) * D + col);
                    const f32x2 lo = __builtin_amdgcn_cvt_pk_f32_fp8(w, false), hi = __builtin_amdgcn_cvt_pk_f32_fp8(w, true); yr = yr + (f32x4){lo.x, lo.y, hi.x, hi.y}; }
                { const int w = *(const int*)(ysh8 + (size_t)row * D + col); const f32x2 lo = __builtin_amdgcn_cvt_pk_f32_fp8(w, false), hi = __builtin_amdgcn_cvt_pk_f32_fp8(w, true); yr = yr + (f32x4){lo.x, lo.y, hi.x, hi.y}; }
                const f32x4 y = yr * (1.f / 16.f);
                v[j] = ld_bf4(x1 + (size_t)row * D + col) * DN_ALPHA + g2[j] * y;
                s += (v[j].x + v[j].y) + (v[j].z + v[j].w); }
            const float mean = wave_sum(s) * (1.f / D); float s2 = 0.f;
#pragma unroll
            for (int j = 0; j < 4; ++j) { v[j] = v[j] - mean; s2 += (v[j].x * v[j].x + v[j].y * v[j].y) + (v[j].z * v[j].z + v[j].w * v[j].w); }
            const float rstd = 1.f / sqrtf(wave_sum(s2) * (1.f / D) + LN_EPS);
#pragma unroll
            for (int j = 0; j < 4; ++j) { const int col = 4 * lane + 256 * j;
                __builtin_nontemporal_store(v[j] * rstd * lg[j] + lb[j], (f32x4*)(out + (size_t)row * D + col)); }
        }
    }
}


typedef short s16x4 __attribute__((ext_vector_type(4)));
typedef short bf16x8v __attribute__((ext_vector_type(8)));
typedef float f32x16 __attribute__((ext_vector_type(16)));
constexpr int MLP = 320;
constexpr int NCH = S / 64;
constexpr int ST_ELEMS = 129 * 128;
constexpr size_t WS_CHK = WS_GATES + 1 * MiB;
constexpr size_t WS_MPREV = WS_GATES + 1 * MiB + 65536;
constexpr size_t WS_KC = WS_U2;
__device__ __forceinline__ s16x4 tr_read(const LAS unsigned char* p) { return __builtin_bit_cast(s16x4, __builtin_amdgcn_ds_read_tr16_b64_v4i16((LAS s16x4*)p)); }
__device__ __forceinline__ bf16x8v tr_frag(const LAS unsigned char* tile, int row0, int col0, int lane) {
    const int i = lane & 15; const LAS unsigned char* p = tile + (row0 + (i >> 2)) * MLP + (col0 + 4 * (i & 3)) * 2;
    const s16x4 lo = tr_read(p), hi = tr_read(p + 4 * MLP);
    return __builtin_shufflevector(lo, hi, 0, 1, 2, 3, 4, 5, 6, 7);
}
__device__ __forceinline__ bf16x8v tr_frag_perm(const LAS unsigned char* tile, int row0, int col0, int lane) {
    const int i = lane & 15; const LAS unsigned char* p = tile + (row0 + (i >> 2)) * MLP + (col0 + 4 * (i & 3)) * 2;
    const s16x4 lo = tr_read(p), hi = tr_read(p + 8 * MLP);
    return __builtin_shufflevector(lo, hi, 0, 1, 2, 3, 4, 5, 6, 7);
}
__device__ __forceinline__ float wave_incl_sum(float v, int lane) {
#pragma unroll
    for (int o = 1; o < 64; o <<= 1) { const float u = __shfl_up(v, o); if (lane >= o) v += u; }
    return v;
}
__device__ __forceinline__ float wave_incl_max(float v, int lane) {
#pragma unroll
    for (int o = 1; o < 64; o <<= 1) { const float u = __shfl_up(v, o); if (lane >= o) v = fmaxf(v, u); }
    return v;
}
__device__ __forceinline__ float wave_max(float v) {
#pragma unroll
    for (int o = 1; o < 64; o <<= 1) v = fmaxf(v, __shfl_xor(v, o));
    return v;
}
__device__ __forceinline__ void conv8(const bf16* __restrict__ rowp, int spos, const float* __restrict__ cw, const float* __restrict__ cb, float scale, float (&y)[8]) {
    const f32x4 b0 = *(const f32x4*)cb, b1 = *(const f32x4*)(cb + 4);
    y[0] = b0.x; y[1] = b0.y; y[2] = b0.z; y[3] = b0.w; y[4] = b1.x; y[5] = b1.y; y[6] = b1.z; y[7] = b1.w;
    v4u xr[4];
#pragma unroll
    for (int j = 0; j < 4; ++j) { const int back = (spos - 3 + j >= 0) ? (j - 3) : 0; xr[j] = *(const v4u*)(rowp + (ptrdiff_t)back * NPROJ); }
#pragma unroll
    for (int j = 0; j < 4; ++j) {
        const float ok = (spos - 3 + j >= 0) ? 1.f : 0.f;
        const f32x4 w0 = *(const f32x4*)(cw + j * 1024) * ok, w1 = *(const f32x4*)(cw + j * 1024 + 4) * ok;
        y[0] += w0.x * bf2f(xr[j].x & 0xffffu); y[1] += w0.y * bf2f(xr[j].x >> 16); y[2] += w0.z * bf2f(xr[j].y & 0xffffu); y[3] += w0.w * bf2f(xr[j].y >> 16);
        y[4] += w1.x * bf2f(xr[j].z & 0xffffu); y[5] += w1.y * bf2f(xr[j].z >> 16); y[6] += w1.z * bf2f(xr[j].w & 0xffffu); y[7] += w1.w * bf2f(xr[j].w >> 16);
    }
#pragma unroll
    for (int e = 0; e < 8; ++e) y[e] = siluf_(y[e]) * scale;
}
__device__ __forceinline__ v4u pack8(const float (&y)[8]) { v4u o; o.x = pk2(y[0], y[1]); o.y = pk2(y[2], y[3]); o.z = pk2(y[4], y[5]); o.w = pk2(y[6], y[7]); return o; }

__device__ __forceinline__ void ml_phaseA(const MArgs& a, LAS unsigned char* lds, int vb0, int nvb) {
    const int tid = threadIdx.x, lane = tid & 63, wave = __builtin_amdgcn_readfirstlane(tid >> 6);
    const bf16* proj = (const bf16*)(a.ws + WS_PROJ); const float* conv_w = a.in[5]; const float* conv_b = a.in[6];
    const float* ipre = (const float*)(a.ws + WS_GATES); const float* logf = ipre + 16 * S;
    bf16* kcg = (bf16*)(a.ws + WS_KC); bf16* st = (bf16*)(a.ws + WS_STATES); float* chk = (float*)(a.ws + WS_CHK);
    LAS unsigned char* Kt = lds; LAS unsigned char* Vt = lds + 64 * MLP; LAS float* wkL = (LAS float*)(lds + 128 * MLP); LAS unsigned char* Stg = lds + 132 * MLP;
    const PrepArgs pa = MAKE_PREP_ARGS(a);
    for (int unit = vb0; unit < 16 * NCH; unit += nvb) {
        const int bh = unit >> 7, c = unit & (NCH - 1), b = bh >> 2, h = bh & 3, s0 = c * 64; const size_t row0 = (size_t)b * S + s0;
        float lf = 0.f, ic = 0.f;
        if (wave == 0) { lf = logf[(size_t)bh * S + s0 + lane]; ic = ipre[(size_t)bh * S + s0 + lane]; }
#pragma unroll
        for (int q = 0; q < 2; ++q) { const int it = tid + q * NTHR, tt = it >> 4, c8 = it & 15, ch = h * 128 + c8 * 8;
            float y[8]; conv8(proj + (row0 + tt) * NPROJ + C_MLK + ch, s0 + tt, conv_w + 512 + ch, conv_b + 512 + ch, 0.08838834764831845f, y);
            const v4u o = pack8(y);
            *(LAS v4u*)(Kt + tt * MLP + c8 * 16) = o; *(v4u*)(kcg + (row0 + tt) * 512 + ch) = o; }
        if (wave == 0) {
            const float bc = wave_incl_sum(lf, lane), g = ic - bc, gmax = wave_max(g), blast = __shfl(bc, 63);
            wkL[lane] = __expf(g - gmax);
            if (lane == 0) { chk[(size_t)unit * 2] = blast; chk[(size_t)unit * 2 + 1] = blast + gmax; }
        }
        __syncthreads();
        const PrepDesc bgd = prep_decode(pa, IT_SMALL + unit * NWAVES + wave); f32x4 bgv[16]; prep_load(bgd, lane, bgv);
#pragma unroll
        for (int q = 0; q < 2; ++q) { const int it = tid + q * NTHR, tt = it >> 4, c8 = it & 15;
            const v4u xr = *(const v4u*)(proj + (row0 + tt) * NPROJ + C_MLV + h * 128 + c8 * 8); const float w = wkL[tt];
            float y[8] = {bf2f(xr.x & 0xffffu) * w, bf2f(xr.x >> 16) * w, bf2f(xr.y & 0xffffu) * w, bf2f(xr.y >> 16) * w, bf2f(xr.z & 0xffffu) * w, bf2f(xr.z >> 16) * w, bf2f(xr.w & 0xffffu) * w, bf2f(xr.w >> 16) * w};
            *(LAS v4u*)(Vt + tt * MLP + c8 * 16) = pack8(y); }
        __syncthreads();
        {
            const int dvb = wave >> 1, dkh = wave & 1, hh = lane >> 5, gsel = (lane >> 4) & 1;
            f32x16 acc[2];
#pragma unroll
            for (int nb = 0; nb < 2; ++nb)
#pragma unroll
                for (int i = 0; i < 16; ++i) acc[nb][i] = 0.f;
#pragma unroll
            for (int kk = 0; kk < 4; ++kk) {
                const bf16x8v Bv = tr_frag(Vt, 16 * kk + 8 * hh, 32 * dvb + 16 * gsel, lane);
#pragma unroll
                for (int nb = 0; nb < 2; ++nb) { const bf16x8v Ak = tr_frag(Kt, 16 * kk + 8 * hh, 32 * (2 * dkh + nb) + 16 * gsel, lane);
                    acc[nb] = __builtin_amdgcn_mfma_f32_32x32x16_bf16(Ak, Bv, acc[nb], 0, 0, 0); }
            }
#pragma unroll
            for (int nb = 0; nb < 2; ++nb)
#pragma unroll
                for (int g4 = 0; g4 < 4; ++g4) { const int dk = 32 * (2 * dkh + nb) + 8 * g4 + 4 * hh, dv = 32 * dvb + (lane & 31);
                    *(LAS unsigned long long*)(Stg + dv * MLP + dk * 2) = (unsigned long long)pk2(acc[nb][4 * g4], acc[nb][4 * g4 + 1]) | ((unsigned long long)pk2(acc[nb][4 * g4 + 2], acc[nb][4 * g4 + 3]) << 32); }
        }
        __syncthreads();
        { bf16* stc = st + (size_t)unit * ST_ELEMS;
#pragma unroll
          for (int q = 0; q < 4; ++q) { const int it = tid + q * NTHR, dv = it >> 4, c8 = it & 15;
              *(v4u*)(stc + dv * 128 + c8 * 8) = *(const LAS v4u*)(Stg + dv * MLP + c8 * 16); }
        }
        if (tid < 128) { float s = 0.f;
#pragma unroll 8
            for (int t = 0; t < 64; ++t) s += wkL[t] * bf2f(*(const LAS unsigned short*)(Kt + t * MLP + tid * 2));
            st[(size_t)unit * ST_ELEMS + 128 * 128 + tid] = (bf16)f2bf(s); }
        prep_store(bgd, lane, bgv);
        __syncthreads();
    }
}

__device__ __forceinline__ void ml_phaseB(const MArgs& a, LAS unsigned char* lds, int vb0, int nvb) {
    const int tid = threadIdx.x;
    bf16* st = (bf16*)(a.ws + WS_STATES); const float* chk = (const float*)(a.ws + WS_CHK); float* mprev = (float*)(a.ws + WS_MPREV);
    LAS float* al = (LAS float*)lds; LAS float* be = al + NCH;
    constexpr int NSL = 16, SLE = ST_ELEMS / NSL;
    for (int item = vb0; item < 16 * NSL; item += nvb) {
        const int bh = item / NSL, sl = item % NSL;
        __syncthreads();
        if (tid < NCH) { al[tid] = chk[(size_t)(bh * NCH + tid) * 2]; be[tid] = chk[(size_t)(bh * NCH + tid) * 2 + 1]; }
        __syncthreads();
        if (tid == 0) { float m = 0.f;
            for (int c = 0; c < NCH; ++c) { const float bl = al[c], M = be[c];
                const float mn = fmaxf(bl + m, M); al[c] = __expf(bl + m - mn); be[c] = __expf(M - mn);
                if (sl == 0) mprev[bh * NCH + c] = m;
                m = mn; } }
        __syncthreads();
        if (tid * 4 < SLE) {
            unsigned long long* p = (unsigned long long*)(st + (size_t)bh * NCH * ST_ELEMS + sl * SLE + tid * 4);
            float c0 = 0.f, c1 = 0.f, c2 = 0.f, c3 = 0.f;
            for (int cb = 0; cb < NCH; cb += 16) { unsigned long long d[16];
#pragma unroll
                for (int j = 0; j < 16; ++j) d[j] = p[(size_t)(cb + j) * (ST_ELEMS / 4)];
#pragma unroll
                for (int j = 0; j < 16; ++j) { p[(size_t)(cb + j) * (ST_ELEMS / 4)] = (unsigned long long)pk2(c0, c1) | ((unsigned long long)pk2(c2, c3) << 32);
                    const float A = al[cb + j], Bq = be[cb + j]; const unsigned lo = (unsigned)d[j], hi = (unsigned)(d[j] >> 32);
                    c0 = A * c0 + Bq * bf2f(lo & 0xffffu); c1 = A * c1 + Bq * bf2f(lo >> 16); c2 = A * c2 + Bq * bf2f(hi & 0xffffu); c3 = A * c3 + Bq * bf2f(hi >> 16); } }
        }
    }
}

__device__ __forceinline__ void ml_phaseC(const MArgs& a, LAS unsigned char* lds, int G) {
    const int tid = threadIdx.x, lane = tid & 63, wave = __builtin_amdgcn_readfirstlane(tid >> 6);
    const bf16* proj = (const bf16*)(a.ws + WS_PROJ); const float* conv_w = a.in[5]; const float* conv_b = a.in[6]; const float* norm_g = a.in[8];
    const float* ipre = (const float*)(a.ws + WS_GATES); const float* logf = ipre + 16 * S;
    const bf16* kcg = (const bf16*)(a.ws + WS_KC); const bf16* st = (const bf16*)(a.ws + WS_STATES); const float* mprev = (const float*)(a.ws + WS_MPREV);
    unsigned char* mix8 = (unsigned char*)(a.ws + WS_MIX);
    LAS unsigned char* Qt = lds; LAS unsigned char* Kt = lds + 64 * MLP; LAS unsigned char* Vt = lds + 128 * MLP; LAS unsigned char* Ct = lds + 192 * MLP;
    LAS float* sc = (LAS float*)(lds + 320 * MLP);
    LAS float* gL = sc; LAS float* mmL = sc + 64; LAS float* siL = sc + 128; LAS float* emL = sc + 192; LAS float* npv = sc + 256; LAS float* lnS = sc + 384;
    const int tb = wave >> 2, dvb = wave & 3, r = lane & 31, hh = lane >> 5, gsel = (lane >> 4) & 1;
    const PrepArgs pa = MAKE_PREP_ARGS(a);
    for (int unit = blockIdx.x; unit < 16 * NCH; unit += G) {
        const int bh = unit >> 7, c = unit & (NCH - 1), b = bh >> 2, h = bh & 3, s0 = c * 64; const size_t row0 = (size_t)b * S + s0;
        float lf = 0.f, ic = 0.f, mp = 0.f;
        if (wave == 0) { lf = logf[(size_t)bh * S + s0 + lane]; ic = ipre[(size_t)bh * S + s0 + lane]; mp = mprev[unit]; }
        const bf16* stc = st + (size_t)unit * ST_ELEMS;
#pragma unroll
        for (int q = 0; q < 2; ++q) { const int it = tid + q * NTHR, tt = it >> 4, c8 = it & 15, ch = h * 128 + c8 * 8;
            float y[8]; conv8(proj + (row0 + tt) * NPROJ + C_MLQ + ch, s0 + tt, conv_w + ch, conv_b + ch, 1.f, y);
            *(LAS v4u*)(Qt + tt * MLP + c8 * 16) = pack8(y);
            *(LAS v4u*)(Kt + tt * MLP + c8 * 16) = *(const v4u*)(kcg + (row0 + tt) * 512 + ch);
            *(LAS v4u*)(Vt + tt * MLP + c8 * 16) = *(const v4u*)(proj + (row0 + tt) * NPROJ + C_MLV + ch); }
#pragma unroll
        for (int q = 0; q < 4; ++q) { const int it = tid + q * NTHR, dv = it >> 4, c8 = it & 15;
            *(LAS v4u*)(Ct + dv * MLP + c8 * 16) = *(const v4u*)(stc + dv * 128 + c8 * 8); }
        if (tid < 128) npv[tid] = bf2f(stc[128 * 128 + tid]);
        if (wave == 0) {
            const float bc = wave_incl_sum(lf, lane), g = ic - bc, pm = wave_incl_max(g, lane), mm = fmaxf(mp, pm);
            gL[lane] = g; mmL[lane] = mm; siL[lane] = __expf(mp - mm); emL[lane] = __expf(-(bc + mm));
        }
        __syncthreads();
        v4u ogp[2]; f32x4 ngp[2][2];
#pragma unroll
        for (int q = 0; q < 2; ++q) { const int it = tid + q * NTHR, tt = it >> 4, dv = (it & 15) * 8;
            ogp[q] = *(const v4u*)(proj + (row0 + tt) * NPROJ + C_MLO + h * 128 + dv); ngp[q][0] = *(const f32x4*)(norm_g + h * 128 + dv); ngp[q][1] = *(const f32x4*)(norm_g + h * 128 + dv + 4); }
        const PrepDesc bgd = prep_decode(pa, IT_SMALL + BG_A + unit * NWAVES + wave); f32x4 bgv[16]; prep_load(bgd, lane, bgv);
        bf16x8v qf[8];
#pragma unroll
        for (int kk = 0; kk < 8; ++kk) qf[kk] = *(const LAS bf16x8v*)(Qt + (32 * tb + r) * MLP + (16 * kk + 8 * hh) * 2);
        const float mm_t = mmL[32 * tb + r], si_t = siL[32 * tb + r], em_t = emL[32 * tb + r];
        float nq = 0.f;
#pragma unroll
        for (int kk = 0; kk < 8; ++kk) { const f32x4 n0 = *(const LAS f32x4*)(npv + 16 * kk + 8 * hh), n1 = *(const LAS f32x4*)(npv + 16 * kk + 8 * hh + 4);
            nq += n0.x * bf2f((unsigned short)qf[kk][0]) + n0.y * bf2f((unsigned short)qf[kk][1]) + n0.z * bf2f((unsigned short)qf[kk][2]) + n0.w * bf2f((unsigned short)qf[kk][3])
                + n1.x * bf2f((unsigned short)qf[kk][4]) + n1.y * bf2f((unsigned short)qf[kk][5]) + n1.z * bf2f((unsigned short)qf[kk][6]) + n1.w * bf2f((unsigned short)qf[kk][7]); }
        nq += __shfl_xor(nq, 32);
        f32x16 num;
#pragma unroll
        for (int i = 0; i < 16; ++i) num[i] = 0.f;
#pragma unroll
        for (int kk = 0; kk < 8; ++kk) { const bf16x8v Ac = *(const LAS bf16x8v*)(Ct + (32 * dvb + r) * MLP + (16 * kk + 8 * hh) * 2);
            num = __builtin_amdgcn_mfma_f32_32x32x16_bf16(Ac, qf[kk], num, 0, 0, 0); }
#pragma unroll
        for (int i = 0; i < 16; ++i) num[i] *= si_t;
        float wsum = 0.f;
        for (int sb = 0; sb <= tb; ++sb) {
            f32x16 sT;
#pragma unroll
            for (int i = 0; i < 16; ++i) sT[i] = 0.f;
#pragma unroll
            for (int kk = 0; kk < 8; ++kk) { const bf16x8v Ak = *(const LAS bf16x8v*)(Kt + (32 * sb + r) * MLP + (16 * kk + 8 * hh) * 2);
                sT = __builtin_amdgcn_mfma_f32_32x32x16_bf16(Ak, qf[kk], sT, 0, 0, 0); }
            unsigned wp[8];
#pragma unroll
            for (int g4 = 0; g4 < 4; ++g4) { const f32x4 gv = *(const LAS f32x4*)(gL + 32 * sb + 8 * g4 + 4 * hh);
                float w[4];
#pragma unroll
                for (int e = 0; e < 4; ++e) { const int srow = 32 * sb + 8 * g4 + 4 * hh + e; const bool valid = srow <= 32 * tb + r;
                    w[e] = valid ? sT[4 * g4 + e] * __expf(gv[e] - mm_t) : 0.f; wsum += w[e]; }
                wp[2 * g4] = pk2(w[0], w[1]); wp[2 * g4 + 1] = pk2(w[2], w[3]); }
#pragma unroll
            for (int s2 = 0; s2 < 2; ++s2) {
                const bf16x8v Av = tr_frag_perm(Vt, 32 * sb + 16 * s2 + 4 * hh, 32 * dvb + 16 * gsel, lane);
                v4u bw; bw.x = wp[4 * s2]; bw.y = wp[4 * s2 + 1]; bw.z = wp[4 * s2 + 2]; bw.w = wp[4 * s2 + 3];
                num = __builtin_amdgcn_mfma_f32_32x32x16_bf16(Av, __builtin_bit_cast(bf16x8v, bw), num, 0, 0, 0); }
        }
        wsum += __shfl_xor(wsum, 32);
        const float den = si_t * nq + wsum, rden = 1.f / fmaxf(fabsf(den), em_t);
        float ps = 0.f, pq = 0.f;
#pragma unroll
        for (int i = 0; i < 16; ++i) { num[i] *= rden; ps += num[i]; pq += num[i] * num[i]; }
        ps += __shfl_xor(ps, 32); pq += __shfl_xor(pq, 32);
        if (hh == 0) { lnS[((tb * 4 + dvb) * 32 + r) * 2] = ps; lnS[((tb * 4 + dvb) * 32 + r) * 2 + 1] = pq; }
        __syncthreads();
        float ts = 0.f, tq = 0.f;
#pragma unroll
        for (int d = 0; d < 4; ++d) { ts += lnS[((tb * 4 + d) * 32 + r) * 2]; tq += lnS[((tb * 4 + d) * 32 + r) * 2 + 1]; }
        const float mean = ts * (1.f / 128.f), rstd = 1.f / sqrtf(fmaxf(tq * (1.f / 128.f) - mean * mean, 0.f) + LN_EPS);
#pragma unroll
        for (int g4 = 0; g4 < 4; ++g4) { const int dv = 32 * dvb + 8 * g4 + 4 * hh;
            *(LAS unsigned long long*)(Qt + (32 * tb + r) * MLP + dv * 2) = (unsigned long long)pk2((num[4 * g4] - mean) * rstd, (num[4 * g4 + 1] - mean) * rstd) | ((unsigned long long)pk2((num[4 * g4 + 2] - mean) * rstd, (num[4 * g4 + 3] - mean) * rstd) << 32); }
        __syncthreads();
#pragma unroll
        for (int q = 0; q < 2; ++q) { const int it = tid + q * NTHR, tt = it >> 4, c8 = it & 15, dv = c8 * 8;
            const v4u hv = *(const LAS v4u*)(Qt + tt * MLP + c8 * 16); const v4u og = ogp[q];
            const f32x4 n0 = ngp[q][0], n1 = ngp[q][1];
            float o[8];
            o[0] = bf2f(hv.x & 0xffffu) * n0.x * sigmoidf_(bf2f(og.x & 0xffffu)); o[1] = bf2f(hv.x >> 16) * n0.y * sigmoidf_(bf2f(og.x >> 16));
            o[2] = bf2f(hv.y & 0xffffu) * n0.z * sigmoidf_(bf2f(og.y & 0xffffu)); o[3] = bf2f(hv.y >> 16) * n0.w * sigmoidf_(bf2f(og.y >> 16));
            o[4] = bf2f(hv.z & 0xffffu) * n1.x * sigmoidf_(bf2f(og.z & 0xffffu)); o[5] = bf2f(hv.z >> 16) * n1.y * sigmoidf_(bf2f(og.z >> 16));
            o[6] = bf2f(hv.w & 0xffffu) * n1.z * sigmoidf_(bf2f(og.w & 0xffffu)); o[7] = bf2f(hv.w >> 16) * n1.w * sigmoidf_(bf2f(og.w >> 16));
            *(unsigned long long*)(mix8 + (row0 + tt) * D + 512 + h * 128 + dv) = (unsigned long long)pk4_fp8(o[0], o[1], o[2], o[3]) | ((unsigned long long)pk4_fp8(o[4], o[5], o[6], o[7]) << 32); }
        prep_store(bgd, lane, bgv);
        __syncthreads();
    }
}

constexpr int VTP = 192;
template <int PITCH> __device__ __forceinline__ bf16x8v tr_frag_perm_p(const LAS unsigned char* tile, int row0, int col0, int lane) {
    const int i = lane & 15; const LAS unsigned char* p = tile + (row0 + (i >> 2)) * PITCH + (col0 + 4 * (i & 3)) * 2;
    const s16x4 lo = tr_read(p), hi = tr_read(p + 8 * PITCH);
    return __builtin_shufflevector(lo, hi, 0, 1, 2, 3, 4, 5, 6, 7);
}
__device__ __forceinline__ void attn_phase(const bf16* __restrict__ proj, unsigned char* __restrict__ mix8, LAS unsigned char* lds, int vb0, int nvb, const PrepArgs pa) {
    const int tid = threadIdx.x, lane = tid & 63, wave = __builtin_amdgcn_readfirstlane(tid >> 6);
    const int r = lane & 31, hh = lane >> 5, gsel = (lane >> 4) & 1;
    LAS unsigned char* Vt = lds + wave * (64 * VTP);
    bf16x8v ntri[2], nones;
#pragma unroll
    for (int s2 = 0; s2 < 2; ++s2)
#pragma unroll
        for (int j = 0; j < 8; ++j) { const int k = 16 * s2 + 8 * (j >> 2) + 4 * hh + (j & 3); ntri[s2][j] = (k >= r) ? (short)0xBF80 : (short)0; }
#pragma unroll
    for (int j = 0; j < 8; ++j) nones[j] = (short)0xBF80;
    for (int unit = vb0 * NWAVES + wave; unit < NB * 8 * (S / 32); unit += nvb * NWAVES) {
        const int bh = unit / (S / 32), qb = unit % (S / 32), b = bh >> 3, h = bh & 7, q0 = qb * 32;
        const bf16* base = proj + (size_t)b * S * NPROJ + h * 64;
        bf16x8v qf[4];
#pragma unroll
        for (int s = 0; s < 4; ++s) qf[s] = *(const bf16x8v*)(base + (size_t)(q0 + r) * NPROJ + C_SBQ + 16 * s + 8 * hh);
        f32x16 o[2];
#pragma unroll
        for (int d = 0; d < 2; ++d)
#pragma unroll
            for (int i = 0; i < 16; ++i) o[d][i] = 0.f;
        float carry = 0.f;
        const int qpos = q0 + r;
        const PrepDesc bgd = prep_decode(pa, IT_SMALL + BG_A + BG_C + unit); f32x4 bgv[16]; prep_load(bgd, lane, bgv);
        for (int k0 = q0 - 32; ; k0 -= 64) {
            bf16x8v kf[2][4];
#pragma unroll
            for (int kb = 0; kb < 2; ++kb) { int key = k0 + 32 * kb + r; key = key < 0 ? 0 : key;
#pragma unroll
                for (int s = 0; s < 4; ++s) kf[kb][s] = *(const bf16x8v*)(base + (size_t)key * NPROJ + C_SBK + 16 * s + 8 * hh); }
#pragma unroll
            for (int i = 0; i < 8; ++i) { int key = k0 + (lane >> 3) + 8 * i; key = key < 0 ? 0 : key;
                *(LAS v4u*)(Vt + ((lane >> 3) + 8 * i) * VTP + (lane & 7) * 16) = *(const v4u*)(base + (size_t)key * NPROJ + C_SBV + (lane & 7) * 8); }
            f32x16 z[2];
#pragma unroll
            for (int kb = 0; kb < 2; ++kb) {
#pragma unroll
                for (int i = 0; i < 16; ++i) z[kb][i] = 0.f;
#pragma unroll
                for (int s = 0; s < 4; ++s) z[kb] = __builtin_amdgcn_mfma_f32_32x32x16_bf16(kf[kb][s], qf[s], z[kb], 0, 0, 0); }
            const bool need_mask = (k0 + 63 >= q0) || (k0 < 0);
            unsigned xp[2][8];
#pragma unroll
            for (int kb = 0; kb < 2; ++kb)
#pragma unroll
                for (int g4 = 0; g4 < 4; ++g4) { float sp[4];
#pragma unroll
                    for (int e = 0; e < 4; ++e) { const float zz = z[kb][4 * g4 + e];
                        float v = fmaxf(zz, 0.f) + __builtin_amdgcn_logf(1.f + __builtin_amdgcn_exp2f(-fabsf(zz)));
                        if (need_mask) { const int key = k0 + 32 * kb + 8 * g4 + 4 * hh + e; v = (key >= 0 && key < qpos) ? v : 0.f; }
                        sp[e] = v; }
                    xp[kb][2 * g4] = pk2(sp[0], sp[1]); xp[kb][2 * g4 + 1] = pk2(sp[2], sp[3]); }
            const float z00 = z[0][0];
#pragma unroll
            for (int s2 = 0; s2 < 2; ++s2) { v4u b1; b1.x = xp[1][4 * s2]; b1.y = xp[1][4 * s2 + 1]; b1.z = xp[1][4 * s2 + 2]; b1.w = xp[1][4 * s2 + 3];
                v4u b0; b0.x = xp[0][4 * s2]; b0.y = xp[0][4 * s2 + 1]; b0.z = xp[0][4 * s2 + 2]; b0.w = xp[0][4 * s2 + 3];
                z[1] = __builtin_amdgcn_mfma_f32_32x32x16_bf16(ntri[s2], __builtin_bit_cast(bf16x8v, b1), z[1], 0, 0, 0);
                z[0] = __builtin_amdgcn_mfma_f32_32x32x16_bf16(ntri[s2], __builtin_bit_cast(bf16x8v, b0), z[0], 0, 0, 0);
                z[0] = __builtin_amdgcn_mfma_f32_32x32x16_bf16(nones, __builtin_bit_cast(bf16x8v, b1), z[0], 0, 0, 0); }
            float tot = z00 - z[0][0];
            tot = __shfl(tot, r);
#pragma unroll
            for (int kb = 0; kb < 2; ++kb)
#pragma unroll
                for (int g4 = 0; g4 < 4; ++g4) { float p[4];
#pragma unroll
                    for (int e = 0; e < 4; ++e) { float v = __builtin_amdgcn_exp2f(z[kb][4 * g4 + e] - carry);
                        if (need_mask) { const int key = k0 + 32 * kb + 8 * g4 + 4 * hh + e; v = (key >= 0 && key < qpos) ? v : 0.f; }
                        p[e] = v; }
                    xp[kb][2 * g4] = pk2(p[0], p[1]); xp[kb][2 * g4 + 1] = pk2(p[2], p[3]); }
#pragma unroll
            for (int kb = 0; kb < 2; ++kb)
#pragma unroll
                for (int s2 = 0; s2 < 2; ++s2) { v4u bp; bp.x = xp[kb][4 * s2]; bp.y = xp[kb][4 * s2 + 1]; bp.z = xp[kb][4 * s2 + 2]; bp.w = xp[kb][4 * s2 + 3];
#pragma unroll
                    for (int d = 0; d < 2; ++d) { const bf16x8v Av = tr_frag_perm_p<VTP>(Vt, 32 * kb + 16 * s2 + 4 * hh, 32 * d + 16 * gsel, lane);
                        o[d] = __builtin_amdgcn_mfma_f32_32x32x16_bf16(Av, __builtin_bit_cast(bf16x8v, bp), o[d], 0, 0, 0); } }
            carry += tot;
            if (k0 <= 0) break;
            if (__all(carry > SB_THRESH)) break;
        }
#pragma unroll
        for (int d = 0; d < 2; ++d)
#pragma unroll
            for (int g4 = 0; g4 < 4; ++g4)
                *(LAS unsigned long long*)(Vt + r * 144 + (32 * d + 8 * g4 + 4 * hh) * 2) = (unsigned long long)pk2(o[d][4 * g4], o[d][4 * g4 + 1]) | ((unsigned long long)pk2(o[d][4 * g4 + 2], o[d][4 * g4 + 3]) << 32);
#pragma unroll
        for (int i = 0; i < 4; ++i) { const int row = (lane >> 3) + 8 * i;
            const v4u ov = *(const LAS v4u*)(Vt + row * 144 + (lane & 7) * 16);
            *(unsigned long long*)(mix8 + (size_t)(b * S + q0 + row) * D + h * 64 + (lane & 7) * 8) = (unsigned long long)pk4_fp8(bf2f(ov.x & 0xffffu), bf2f(ov.x >> 16), bf2f(ov.y & 0xffffu), bf2f(ov.y >> 16))
                | ((unsigned long long)pk4_fp8(bf2f(ov.z & 0xffffu), bf2f(ov.z >> 16), bf2f(ov.w & 0xffffu), bf2f(ov.w >> 16)) << 32); }
        prep_store(bgd, lane, bgv);
    }
}

__global__ void __launch_bounds__(NTHR, 2) mega_fwd(MArgs args) {
    extern __shared__ __attribute__((aligned(16))) unsigned char lds[];
    LAS unsigned char* ldsl = (LAS unsigned char*)lds;
    const int tid = threadIdx.x, G = gridDim.x;
    volatile LAS unsigned* MISC = (volatile LAS unsigned*)(ldsl + XTRA_OFF + X_MISC);
    LAS int* tb = (LAS int*)(ldsl + XTRA_OFF + X_TB); LAS int* nn = (LAS int*)(ldsl + XTRA_OFF + X_NN);
    for (int u = tid; u < (LDS_BYTES - XTRA_OFF) / 4; u += NTHR) ((LAS unsigned*)(ldsl + XTRA_OFF))[u] = 0u;
    __syncthreads();
    unsigned char* ws = args.ws;
    unsigned* ctl = (unsigned*)(ws + WS_CTL);
    XcdBarrier bar = xcd_barrier_post(ctl + CW_BAR, MISC + 8);
    const int lo = args.ph_lo, hi = args.ph_hi;
#define IN(k) (lo <= (k) && (k) < hi)
#ifndef REP_MASK
#define REP_MASK 0
#endif
#define PHASE(k, ...) do { if (IN(k)) { for (int rep_ = 0; rep_ < (((REP_MASK >> (k)) & 1) ? 2 : 1); ++rep_) { if (rep_) xcd_barrier(bar); __VA_ARGS__ } } if (IN(k) && IN((k) + 1)) xcd_barrier(bar); } while (0)
    int* cnt = (int*)ctl + CW_CNT; i32x2* list = (i32x2*)(ws + WS_ROUTE + 2 * MiB); float* topg = (float*)(ws + WS_ROUTE + 1 * MiB);
    PHASE(0, ph_mod_prep(args, lds, G););
    PHASE(1, ph_ln1(args, lds, G););
    PHASE(2, { pg8::StaticOrder So; So.init(ws + WS_U1, ws + WS_WTIN, T, NPROJ, D, G, blockIdx.x);
        pg8::EpiBf16 E{(bf16*)(ws + WS_PROJ), NPROJ, 2, QSCALE, 1.f / 64.f};
        pg8::gemm_phase<pg8::EpiBf16, pg8::StaticOrder, false, true>(ldsl, D, So, E); });
    PHASE(3, ml_phaseA(args, ldsl, blockIdx.x, G););
    PHASE(4, ml_phaseB(args, ldsl, blockIdx.x, G); __syncthreads(); attn_phase((const bf16*)(ws + WS_PROJ), (unsigned char*)(ws + WS_MIX), ldsl, blockIdx.x, G, MAKE_PREP_ARGS(args)););
    PHASE(5, ml_phaseC(args, ldsl, G););
    PHASE(6, { pg8::StaticOrder So; So.init(ws + WS_MIX, ws + WS_WTOUT, T, D, D, G, blockIdx.x);
        pg8::EpiBf16 E{(bf16*)(ws + WS_MIXOUT), D, 0, 1.f, 1.f / 64.f};
        pg8::gemm_phase<pg8::EpiBf16, pg8::StaticOrder, false, true>(ldsl, D, So, E); });
    PHASE(7, ph_ln2(args, G););
    PHASE(8, { pg8::StaticOrder So; So.init(ws + WS_U2, ws + WS_WTR, T, NE, 2 * D, G, blockIdx.x);
        pg8::EpiF32 E{(float*)(ws + WS_LOGITS), NE};
        pg8::gemm_phase<pg8::EpiF32, pg8::StaticOrder, false, false>(ldsl, 2 * D, So, E); });
    PHASE(9, { const int lane_ = tid & 63; const f32x4 bias4 = *(const f32x4*)(args.in[13] + 4 * lane_); const PrepArgs pa = MAKE_PREP_ARGS(args);
        LAS int* hist = (LAS int*)ldsl;
        if (tid < NE) hist[tid] = 0;
        __syncthreads();
        int bgit = IT_SMALL + BG_TOTAL + blockIdx.x * NWAVES + (tid >> 6);
        for (int t = blockIdx.x * NWAVES + (tid >> 6); t < T; t += G * NWAVES) {
            const bool bg = bgit < IT_TOTAL; PrepDesc bgd = prep_decode(pa, bg ? bgit : IT_SMALL); f32x4 bgv[16];
            if (bg) prep_load(bgd, lane_, bgv);
            route_wave(t, lane_, (const float*)(ws + WS_LOGITS), bias4, (int*)(ws + WS_ROUTE), topg, hist);
            if (bg) prep_store(bgd, lane_, bgv);
            bgit += G * NWAVES; }
        __syncthreads();
        if (tid < NE) { const int hv = hist[tid]; if (hv) atomicAdd(cnt + tid * CSTR, hv); }
        __syncthreads(); });
    PHASE(10, { moe_tables(cnt, tb, nn); const int* tope = (const int*)(ws + WS_ROUTE); int* fill = (int*)ctl + CW_FILL;
        LAS int* hist = (LAS int*)ldsl; LAS int* hbase = hist + NE;
        for (int id0 = blockIdx.x * NTHR; id0 < T * TOPK; id0 += G * NTHR) {
            if (tid < NE) hist[tid] = 0;
            __syncthreads();
            const int id = id0 + tid; const int e = tope[id];
            const int rank = __hip_atomic_fetch_add(hist + e, 1, __ATOMIC_RELAXED, __HIP_MEMORY_SCOPE_WORKGROUP);
            __syncthreads();
            if (tid < NE) { const int hv = hist[tid]; hbase[tid] = hv ? atomicAdd(fill + tid * CSTR, hv) : 0; }
            __syncthreads();
            list[tb[e] * 256 + hbase[e] + rank] = (i32x2){id, __float_as_int(topg[id])};
            __syncthreads(); } });
    PHASE(11, { moe_tables(cnt, tb, nn);
        pg8::MoeOrder So{G, (int)blockIdx.x, tb[NEX] * 2, 1, tb, nn, list, (const char*)(ws + WS_U2F8), 0, (const char*)(ws + WS_WT13), (size_t)512 * D, (size_t)256 * D};
        pg8::EpiGlu E{(unsigned char*)(ws + WS_H), 1.f / 64.f};
        pg8::gemm_phase<pg8::EpiGlu, pg8::MoeOrder, true, true>(ldsl, D, So, E); });
    PHASE(12, { moe_tables(cnt, tb, nn);
        pg8::MoeOrder So{G, (int)blockIdx.x, tb[NEX] * 4, 2, tb, nn, list, (const char*)(ws + WS_H), (size_t)256 * FF, (const char*)(ws + WS_WT2), (size_t)D * FF, (size_t)256 * FF};
        pg8::EpiScatter E{(unsigned char*)(ws + WS_YS), (unsigned char*)(ws + WS_YSH), list, nn};
        pg8::gemm_phase<pg8::EpiScatter, pg8::MoeOrder, false, true>(ldsl, FF, So, E); });
    PHASE(13, ph_final(args, G););
#undef PHASE
#undef IN
}

__global__ void k_nan_fill(float* out, int n) { for (int i = blockIdx.x * blockDim.x + threadIdx.x; i < n; i += gridDim.x * blockDim.x) out[i] = __builtin_nanf(""); }
extern "C" void kernel_launch(void* const* d_in, const int* in_sizes, int n_in, void* d_out, int out_size, void* d_ws, size_t ws_size, hipStream_t stream) {
    static int grid = 0;
    if (grid == 0) {
        int dev = 0, cus = 0, per_cu = 0; grid = -1;
        if (n_in != 22 || out_size != T * D || ws_size < WS_END) fprintf(stderr, "kernel_launch: unexpected shapes (n_in %d out %d ws %zu, need %zu)\n", n_in, out_size, ws_size, (size_t)WS_END);
        else if (hipGetDevice(&dev) != hipSuccess || hipDeviceGetAttribute(&cus, hipDeviceAttributeMultiprocessorCount, dev) != hipSuccess) fprintf(stderr, "kernel_launch: device query failed\n");
        else if (hipFuncSetAttribute((const void*)mega_fwd, hipFuncAttributeMaxDynamicSharedMemorySize, LDS_BYTES) != hipSuccess) fprintf(stderr, "kernel_launch: hipFuncSetAttribute failed\n");
        else if (hipOccupancyMaxActiveBlocksPerMultiprocessor(&per_cu, (const void*)mega_fwd, NTHR, LDS_BYTES) != hipSuccess || per_cu < 1) fprintf(stderr, "kernel_launch: occupancy query says %d blocks per CU\n", per_cu);
        else grid = cus;
        (void)hipGetLastError();
    }
    if (grid < 0) { k_nan_fill<<<1024, 256, 0, stream>>>((float*)d_out, out_size); return; }
    char* ws = (char*)d_ws;
    (void)hipMemsetAsync(ws + WS_CTL, 0, 1 * MiB, stream);
    MArgs a{};
    for (int i = 0; i < 22; ++i) a.in[i] = (const float*)d_in[i];
    a.out = (float*)d_out; a.ws = (unsigned char*)d_ws; a.ph_lo = 0; a.ph_hi = N_PHASES;
    hipLaunchKernelGGL(mega_fwd, dim3(grid), dim3(NTHR), LDS_BYTES, stream, a);
}
```

```cpp
#include <hip/hip_runtime.h>
#include <cstdio>
#include <cstdint>

typedef unsigned short bf16;
typedef unsigned v4u __attribute__((ext_vector_type(4)));
typedef float f32x4 __attribute__((ext_vector_type(4)));
typedef int i32x2 __attribute__((ext_vector_type(2)));
typedef float f32x2 __attribute__((ext_vector_type(2)));

constexpr int D = 1024, NB = 4, S = 8192, T = NB * S;
constexpr int NPROJ = 3584, WIN_LD = 3592;
constexpr int C_SBQ = 0, C_SBK = 512, C_SBV = 1024, C_MLQ = 1536, C_MLK = 2048, C_MLV = 2560, C_MLO = 3072, C_GATE = 3584;
constexpr int NE = 256, NEX = 257, TOPK = 8, FF = 256;
constexpr float LN_EPS = 1e-5f;
constexpr float DN_ALPHA = 1.189207115002721f;
constexpr float LOG2E = 1.4426950408889634f;
constexpr float QSCALE = 0.125f * LOG2E;
constexpr float SB_THRESH = 48.0f;

constexpr size_t MiB = 1u << 20;
constexpr size_t WS_CTL = 0;
constexpr size_t WS_MOD = 1 * MiB;
constexpr size_t WS_WTIN = 2 * MiB;
constexpr size_t WS_WTOUT = 10 * MiB;
constexpr size_t WS_WTR = 12 * MiB;
constexpr size_t WS_WT2 = 16 * MiB;
constexpr size_t WS_YS = 145 * MiB;
constexpr size_t WS_WT13 = 145 * MiB;
constexpr size_t WS_U2F8 = 274 * MiB;
constexpr size_t WS_PROJ = 490 * MiB;
constexpr size_t WS_GATES = 626 * MiB;
constexpr size_t WS_H = 402 * MiB;
constexpr size_t WS_X1 = 757 * MiB;
constexpr size_t WS_STATES = 657 * MiB;
constexpr size_t WS_MIXOUT = 657 * MiB;
constexpr size_t WS_LOGITS = 657 * MiB;
constexpr size_t WS_U1 = 725 * MiB;
constexpr size_t WS_MIX = 725 * MiB;
constexpr size_t WS_U2 = 833 * MiB;
constexpr size_t WS_YSH = 833 * MiB;
constexpr size_t WS_ROUTE = 897 * MiB;
constexpr size_t WS_END = 902 * MiB;
constexpr int CSTR = 32;
constexpr int CW_CNT = 16384;
constexpr int CW_FILL = 32768;

__device__ __forceinline__ unsigned f2bf(float f) { unsigned u = __builtin_bit_cast(unsigned, f); return (u + 0x7fffu + ((u >> 16) & 1u)) >> 16; }
__device__ __forceinline__ float bf2f(unsigned b) { return __builtin_bit_cast(float, b << 16); }
__device__ __forceinline__ unsigned pk2(float lo, float hi) { return f2bf(lo) | (f2bf(hi) << 16); }
__device__ __forceinline__ unsigned pk4_fp8(float a, float b, float c, float d) { int w = 0; w = __builtin_amdgcn_cvt_pk_fp8_f32(a, b, w, false); w = __builtin_amdgcn_cvt_pk_fp8_f32(c, d, w, true); return (unsigned)w; }
__device__ __forceinline__ float wave_sum(float v) {
    v += __builtin_bit_cast(float, __builtin_amdgcn_update_dpp(0, __builtin_bit_cast(int, v), 0xB1, 0xF, 0xF, true));
    v += __builtin_bit_cast(float, __builtin_amdgcn_update_dpp(0, __builtin_bit_cast(int, v), 0x4E, 0xF, 0xF, true));
    v += __builtin_bit_cast(float, __builtin_amdgcn_update_dpp(0, __builtin_bit_cast(int, v), 0x141, 0xF, 0xF, true));
    v += __builtin_bit_cast(float, __builtin_amdgcn_update_dpp(0, __builtin_bit_cast(int, v), 0x140, 0xF, 0xF, true));
    const int iv = __builtin_bit_cast(int, v);
    const float r0 = __builtin_bit_cast(float, __builtin_amdgcn_readlane(iv, 0)), r1 = __builtin_bit_cast(float, __builtin_amdgcn_readlane(iv, 16));
    const float r2 = __builtin_bit_cast(float, __builtin_amdgcn_readlane(iv, 32)), r3 = __builtin_bit_cast(float, __builtin_amdgcn_readlane(iv, 48));
    return (r0 + r1) + (r2 + r3);
}
__device__ __forceinline__ float sigmoidf_(float x) { return 1.f / (1.f + __expf(-x)); }
__device__ __forceinline__ float siluf_(float x) { return x / (1.f + __expf(-x)); }


struct PrepArgs { const float *w_in, *w_out, *w_router, *w1, *w3, *w2, *sw1, *sw3, *sw2; unsigned char* wtin; bf16 *wtout, *wtr; unsigned char* wt13; unsigned char* wt2; };
struct PrepDesc { const float* src; unsigned char* dst; int ldw, ldt, k0, n0, rowmap, f8; };
constexpr int IT_IN = 16 * 56, IT_OUT = 16 * 16, IT_R = 16 * 4, IT_E = 192, IT_TOTAL = IT_IN + IT_OUT + IT_R + NEX * IT_E;
__device__ __forceinline__ PrepDesc prep_decode(const PrepArgs& a, int it) {
    if (it < IT_IN) return PrepDesc{a.w_in, a.wtin, WIN_LD, D, (it / 112) * 128, (it % 112) * 32, 0, 1}; it -= IT_IN;
    if (it < IT_OUT) return PrepDesc{a.w_out, (unsigned char*)a.wtout, D, D, (it / 32) * 128, (it % 32) * 32, 0, 1}; it -= IT_OUT;
    if (it < IT_R) return PrepDesc{a.w_router, (unsigned char*)a.wtr, NE, D, (it / 4) * 64, (it % 4) * 64, 0, 0}; it -= IT_R;
    const int e = it / IT_E, r = it % IT_E;
    if (r < 64) return PrepDesc{e < NE ? a.w1 + (size_t)e * D * FF : a.sw1, a.wt13 + (size_t)e * 512 * D, FF, D, (r / 8) * 128, (r % 8) * 32, 1, 1};
    if (r < 128) { const int q = r - 64; return PrepDesc{e < NE ? a.w3 + (size_t)e * D * FF : a.sw3, a.wt13 + (size_t)e * 512 * D, FF, D, (q / 8) * 128, (q % 8) * 32, 2, 1}; }
    const int q = r - 128; return PrepDesc{e < NE ? a.w2 + (size_t)e * FF * D : a.sw2, a.wt2 + (size_t)e * D * FF, D, FF, (q / 32) * 128, (q % 32) * 32, 0, 1};
}
__device__ __forceinline__ void prep_load(const PrepDesc& d, int lane, f32x4 (&v)[16]) {
    const int g = d.f8 ? (lane >> 3) : (lane >> 4), i = d.f8 ? (lane & 7) : (lane & 15);
#pragma unroll
    for (int r = 0; r < 16; ++r) v[r] = __builtin_nontemporal_load((const f32x4*)(d.src + (size_t)(d.k0 + 16 * g + r) * d.ldw + d.n0 + 4 * i));
}
__device__ __forceinline__ void prep_store(const PrepDesc& d, int lane, const f32x4 (&v)[16]) {
    const int g = d.f8 ? (lane >> 3) : (lane >> 4), i = d.f8 ? (lane & 7) : (lane & 15);
#pragma unroll
    for (int nn = 0; nn < 4; ++nn) {
        const int n = d.n0 + 4 * i + nn;
        const int dr = d.rowmap == 0 ? n : ((n >> 7) * 256 + (d.rowmap == 2 ? 128 : 0) + (n & 127));
        if (d.f8) {
            v4u o; o.x = pk4_fp8(v[0][nn] * 64.f, v[1][nn] * 64.f, v[2][nn] * 64.f, v[3][nn] * 64.f); o.y = pk4_fp8(v[4][nn] * 64.f, v[5][nn] * 64.f, v[6][nn] * 64.f, v[7][nn] * 64.f);
            o.z = pk4_fp8(v[8][nn] * 64.f, v[9][nn] * 64.f, v[10][nn] * 64.f, v[11][nn] * 64.f); o.w = pk4_fp8(v[12][nn] * 64.f, v[13][nn] * 64.f, v[14][nn] * 64.f, v[15][nn] * 64.f);
            *(v4u*)(d.dst + (size_t)dr * d.ldt + d.k0 + 16 * g) = o;
        } else {
            v4u o0, o1; o0.x = pk2(v[0][nn], v[1][nn]); o0.y = pk2(v[2][nn], v[3][nn]); o0.z = pk2(v[4][nn], v[5][nn]); o0.w = pk2(v[6][nn], v[7][nn]);
            o1.x = pk2(v[8][nn], v[9][nn]); o1.y = pk2(v[10][nn], v[11][nn]); o1.z = pk2(v[12][nn], v[13][nn]); o1.w = pk2(v[14][nn], v[15][nn]);
            v4u* dp = (v4u*)((bf16*)d.dst + (size_t)dr * d.ldt + d.k0 + 16 * g); dp[0] = o0; dp[1] = o1;
        }
    }
}
constexpr int IT_SMALL = IT_IN + IT_OUT + IT_R;
constexpr int BG_A = 16 * (S / 64) * 8, BG_C = BG_A, BG_T = NB * 8 * (S / 32), BG_TOTAL = BG_A + BG_C + BG_T;
constexpr int IT_FG = IT_SMALL;
static_assert(IT_SMALL + BG_TOTAL <= IT_TOTAL, "background slots exceed the expert items");
__device__ __forceinline__ int prep_fg_item(int j) { return j < IT_SMALL ? j : j + BG_TOTAL; }
__device__ __forceinline__ void prep_run(const PrepArgs& a, int it0, int stride, int lane) {
    int it = it0; if (it >= IT_FG) return;
    PrepDesc dA = prep_decode(a, prep_fg_item(it)), dB = dA; f32x4 va[16], vb[16]; prep_load(dA, lane, va);
    for (;;) {
        const int itB = it + stride; const bool hasB = itB < IT_FG;
        if (hasB) { dB = prep_decode(a, prep_fg_item(itB)); prep_load(dB, lane, vb); }
        prep_store(dA, lane, va);
        if (!hasB) break;
        const int itA = itB + stride; const bool hasA = itA < IT_FG;
        if (hasA) { dA = prep_decode(a, prep_fg_item(itA)); prep_load(dA, lane, va); }
        prep_store(dB, lane, vb);
        if (!hasA) break;
        it = itA;
    }
}


__device__ __forceinline__ f32x4 ld_bf4(const bf16* p) { const unsigned long long w = *(const unsigned long long*)p;
    return (f32x4){bf2f((unsigned)w & 0xffffu), bf2f(((unsigned)w) >> 16), bf2f((unsigned)(w >> 32) & 0xffffu), bf2f((unsigned)(w >> 48))}; }

#define LAS __attribute__((address_space(3)))
#define GAS __attribute__((address_space(1)))
namespace pg8 {
typedef short bf16x8 __attribute__((ext_vector_type(8)));
constexpr int F8_SCALE_W = 121;
constexpr int BM = 256, BK = 64, HALF = 128, HTB = HALF * BK * 2, STAGE_BYTES = 8 * HTB, NXCD = 8, WGM = 8;
__host__ __device__ __forceinline__ int lds_byte(int r, int c) { const int st = (r >> 4) * 2 + (c >> 5), rr = r & 15, cc = c & 31, ob = rr * 64 + cc * 2; return st * 1024 + (ob ^ (((ob >> 9) & 1) << 5)); }
__host__ __device__ __forceinline__ void stage_rc(int b, int& R, int& C) { const int st = b / 1024, sb = b % 1024, swz = sb ^ (((sb >> 9) & 1) << 5); R = (st >> 1) * 16 + swz / 64; C = (st & 1) * 32 + (swz % 64) / 2; }
__host__ __device__ __forceinline__ int perm16x(int R) { return 64 * (R >> 5) + 16 * ((R & 15) >> 2) + 4 * ((R >> 4) & 1) + (R & 3); }
__host__ __device__ __forceinline__ int perm32(int rho) { const int n = rho >> 4, i = rho & 15; return 8 * (i >> 2) + 4 * n + (i & 3); }

struct Unit { int pm, pn, e, mt; const char* A; const char* B; };

__device__ __forceinline__ long unit_index(int i, int G, int c) { return (G % 8 == 0) ? ((long)(i * 8 + (c & 7)) * (G / 8) + (c >> 3)) : ((long)i * G + c); }

struct StaticOrder {
    int nM, nN, nwg, G, c; const char* A; const char* B; size_t tstep;
    __device__ void init(const void* A_, const void* B_, int M, int N, int Kb, int G_, int c_) { nM = M / BM; nN = N / BM; nwg = nM * nN; G = G_; c = c_; A = (const char*)A_; B = (const char*)B_; tstep = (size_t)BM * Kb; }
    __device__ __forceinline__ bool next(int i, Unit& u) const {
        const long L = (long)i * G + c; if (L >= nwg) return false;
        int wgid = (int)L; { const int q = nwg / NXCD, r = nwg % NXCD, xcd = wgid % NXCD, off = wgid / NXCD; wgid = (xcd < r ? xcd * (q + 1) : r * (q + 1) + (xcd - r) * q) + off; }
        const int nig = WGM * nN, gid = wgid / nig, fm = gid * WGM, gsz = (nM - fm) < WGM ? (nM - fm) : WGM;
        u.pm = fm + ((wgid % nig) % gsz); u.pn = (wgid % nig) / gsz; u.e = 0; u.mt = u.pm; u.A = A + (size_t)u.pm * tstep; u.B = B + (size_t)u.pn * tstep; return true;
    }
    __device__ __forceinline__ int row_token(const Unit&, int) const { return 0; }
};

struct MoeOrder {
    int G, c, total, shift; const LAS int* tb; const LAS int* nn; const i32x2* list;
    const char* Abase; size_t a_tile_stride; const char* Bbase; size_t b_exp_stride, b_pn_stride;
    __device__ __forceinline__ bool next(int i, Unit& u) const {
        const long L = unit_index(i, G, c); if (L >= total) return false;
        const int tile = (int)(L >> shift); u.pn = (int)(L & ((1 << shift) - 1));
        int lo = 0, hi = NEX; while (hi - lo > 1) { const int mid = (lo + hi) >> 1; if (tb[mid] <= tile) lo = mid; else hi = mid; }
        u.e = lo; u.mt = tile - tb[lo]; u.pm = tile;
        u.A = Abase + (size_t)tile * a_tile_stride; u.B = Bbase + (size_t)lo * b_exp_stride + (size_t)u.pn * b_pn_stride; return true;
    }
    __device__ __forceinline__ int row_token(const Unit& u, int row) const {
        const int rr = u.mt * 256 + row;
        const int tok = list[u.pm * 256 + row].x >> 3;
        return u.e >= NE ? rr : (rr < nn[u.e] ? tok : 0);
    }
};

__device__ __forceinline__ unsigned cvt_pk_bf16(float lo, float hi) { unsigned r; asm volatile("v_cvt_pk_bf16_f32 %0, %1, %2" : "=v"(r) : "v"(lo), "v"(hi)); return r; }

struct EpiBf16 {
    static constexpr int PERM = 2; static constexpr bool PREFETCH = false; bf16* O; int ldc; int scale_tiles; float scale; float gscale;
    __device__ __forceinline__ void operator()(const f32x4 (&acc)[2][2][4][2], const Unit& u, int wr, int wc, int fr, int fq) const {
        const int row0 = u.pm * BM + wr * 64 + fr, col0 = u.pn * BM + wc * 64 + 16 * fq; const float sc = (u.pn < scale_tiles ? scale : 1.f) * gscale;
#pragma unroll
        for (int ai = 0; ai < 2; ++ai)
#pragma unroll
            for (int m = 0; m < 4; ++m) { bf16* rowp = O + (size_t)(row0 + ai * HALF + m * 16) * ldc + col0;
#pragma unroll
                for (int bj = 0; bj < 2; ++bj) { const f32x4 v0 = acc[ai][bj][m][0] * sc, v1 = acc[ai][bj][m][1] * sc;
                    v4u w; w.x = cvt_pk_bf16(v0[0], v0[1]); w.y = cvt_pk_bf16(v0[2], v0[3]); w.z = cvt_pk_bf16(v1[0], v1[1]); w.w = cvt_pk_bf16(v1[2], v1[3]);
                    *(v4u*)(rowp + bj * 8) = w; } }
    }
};
struct EpiF8 {
    static constexpr int PERM = 2; static constexpr bool PREFETCH = false; unsigned char* O; int ldc; int scale_tiles; float scale; float gscale;
    __device__ __forceinline__ void operator()(const f32x4 (&acc)[2][2][4][2], const Unit& u, int wr, int wc, int fr, int fq) const {
        const int row0 = u.pm * BM + wr * 64 + fr, col0 = u.pn * BM + wc * 64 + 16 * fq; const float sc = (u.pn < scale_tiles ? scale : 1.f) * gscale;
#pragma unroll
        for (int ai = 0; ai < 2; ++ai)
#pragma unroll
            for (int m = 0; m < 4; ++m) { const f32x4 a0 = acc[ai][0][m][0] * sc, a1 = acc[ai][0][m][1] * sc, b0 = acc[ai][1][m][0] * sc, b1 = acc[ai][1][m][1] * sc;
                v4u w; w.x = pk4_fp8(a0[0], a0[1], a0[2], a0[3]); w.y = pk4_fp8(a1[0], a1[1], a1[2], a1[3]); w.z = pk4_fp8(b0[0], b0[1], b0[2], b0[3]); w.w = pk4_fp8(b1[0], b1[1], b1[2], b1[3]);
                *(v4u*)(O + (size_t)(row0 + ai * HALF + m * 16) * ldc + col0) = w; }
    }
};
struct EpiF32 {
    static constexpr int PERM = 0; static constexpr bool PREFETCH = false; float* C; int ldc;
    __device__ __forceinline__ void operator()(const f32x4 (&acc)[2][2][4][2], const Unit& u, int wr, int wc, int fr, int fq) const {
        const int row0 = u.pm * BM + wr * 64 + fr, col0 = u.pn * BM + wc * 32 + 4 * fq;
#pragma unroll
        for (int ai = 0; ai < 2; ++ai)
#pragma unroll
            for (int m = 0; m < 4; ++m) { float* rowp = C + (size_t)(row0 + ai * HALF + m * 16) * ldc + col0;
#pragma unroll
                for (int bj = 0; bj < 2; ++bj)
#pragma unroll
                    for (int n = 0; n < 2; ++n) *(f32x4*)(rowp + bj * HALF + n * 16) = acc[ai][bj][m][n]; }
    }
};
struct EpiGlu {
    static constexpr int PERM = 1; static constexpr bool PREFETCH = false; unsigned char* H; float gscale;
    __device__ __forceinline__ void operator()(const f32x4 (&acc)[2][2][4][2], const Unit& u, int wr, int wc, int fr, int fq) const {
        const int row0 = u.pm * BM + wr * 64 + fr, col0 = u.pn * HALF + wc * 32 + 8 * fq;
#pragma unroll
        for (int ai = 0; ai < 2; ++ai)
#pragma unroll
            for (int m = 0; m < 4; ++m) { float h[8];
#pragma unroll
                for (int n = 0; n < 2; ++n)
#pragma unroll
                    for (int q = 0; q < 4; ++q) { const float a = acc[ai][0][m][n][q] * gscale; h[n * 4 + q] = a * __builtin_amdgcn_rcpf(1.f + __expf(-a)) * (acc[ai][1][m][n][q] * gscale); }
                *(unsigned long long*)(H + (size_t)(row0 + ai * HALF + m * 16) * FF + col0) = (unsigned long long)pk4_fp8(h[0], h[1], h[2], h[3]) | ((unsigned long long)pk4_fp8(h[4], h[5], h[6], h[7]) << 32); }
    }
};
struct EpiScatter {
    static constexpr int PERM = 2; static constexpr bool PREFETCH = true; unsigned char* ys8; unsigned char* ysh8; const i32x2* list; const LAS int* nn;
    __device__ __forceinline__ void prefetch(const Unit& u, int wr, int fr, i32x2 (&pf)[8]) const {
        const i32x2* lp = list + (size_t)(u.pm - u.mt) * 256;
#pragma unroll
        for (int q = 0; q < 8; ++q) pf[q] = lp[u.mt * 256 + (q >> 2) * HALF + wr * 64 + (q & 3) * 16 + fr];
    }
    __device__ __forceinline__ void operator()(const f32x4 (&acc)[2][2][4][2], const Unit& u, int wr, int wc, int fr, int fq, const i32x2 (&pf)[8]) const {
        const int col0 = u.pn * BM + wc * 64 + 16 * fq; const int n = nn[u.e]; const bool routed = u.e < NE;
#pragma unroll
        for (int ai = 0; ai < 2; ++ai)
#pragma unroll
            for (int m = 0; m < 4; ++m) { const int rr = u.mt * 256 + ai * HALF + wr * 64 + m * 16 + fr;
                if (rr < n) { const int id = routed ? pf[ai * 4 + m].x : rr; const float g = (routed ? __int_as_float(pf[ai * 4 + m].y) : 1.f) * (16.f / 64.f);
                    const f32x4 a0 = acc[ai][0][m][0] * g, a1 = acc[ai][0][m][1] * g, b0 = acc[ai][1][m][0] * g, b1 = acc[ai][1][m][1] * g;
                    v4u w; w.x = pk4_fp8(a0[0], a0[1], a0[2], a0[3]); w.y = pk4_fp8(a1[0], a1[1], a1[2], a1[3]); w.z = pk4_fp8(b0[0], b0[1], b0[2], b0[3]); w.w = pk4_fp8(b1[0], b1[1], b1[2], b1[3]);
                    *(v4u*)((routed ? ys8 : ysh8) + (size_t)id * D + col0) = w; } }
    }
};

typedef int i32x8 __attribute__((ext_vector_type(8)));
typedef int i32x4 __attribute__((ext_vector_type(4)));
template <bool FP8> struct FragT { struct A4 { bf16x8 v[4][2]; }; struct B2 { bf16x8 v[2][2]; }; };
template <> struct FragT<true> { struct A4 { i32x8 v[4]; }; struct B2 { i32x8 v[2]; }; };
template <class Epi, class Sched, bool GATHER, bool FP8>
__device__ __forceinline__ void gemm_phase(LAS unsigned char* lds, const int Kb, const Sched& S, const Epi& E) {
    const int tid = threadIdx.x, wid = __builtin_amdgcn_readfirstlane(tid >> 6), lane = tid & 63, wr = wid >> 2, wc = wid & 3, fr = lane & 15, fq = lane >> 4;
    const int nt = Kb / 128;
    int sR[2], sC[2];
    unsigned voffA[2], voffB[2];
#pragma unroll
    for (int i = 0; i < 2; ++i) { stage_rc(tid * 16 + i * 8192, sR[i], sC[i]); const int Rb = Epi::PERM == 2 ? perm16x(sR[i]) : (Epi::PERM == 1 ? ((sR[i] & ~31) + perm32(sR[i] & 31)) : sR[i]);
        voffA[i] = (unsigned)(sR[i] * Kb + sC[i] * 2); voffB[i] = (unsigned)(Rb * Kb + sC[i] * 2); }
    const size_t kstep = (size_t)(BK * 2);
    const size_t hstep = (size_t)HALF * Kb;
    const size_t bhstep = Epi::PERM == 2 ? (size_t)8 * Kb : hstep;
    const unsigned ldsw = (unsigned)wid * 1024u;
    const int aoff = lds_byte(wr * 64 + fr, fq * 8), boff = lds_byte(wc * 32 + fr, fq * 8);
    unsigned gc[2][2], gn[2][2];
#define PG8_SA(b, h) (((b) * 2 + (h)) * HTB)
#define PG8_SB(b, h) ((4 + (b) * 2 + (h)) * HTB)
#define PG8_GLDS(src, bufoff, i) __builtin_amdgcn_global_load_lds((const unsigned*)(src), (LAS unsigned*)(lds + (bufoff) + ldsw + (i) * 8192), 16, 0, 0)
#define PG8_STAGE_B(bufoff, gbase) do { PG8_GLDS((const char*)(gbase) + voffB[0], bufoff, 0); PG8_GLDS((const char*)(gbase) + voffB[1], bufoff, 1); } while (0)
#define PG8_STAGE_A(bufoff, gbase, h, nx) do { if constexpr (GATHER) { const unsigned _o0 = (nx) ? gn[h][0] : gc[h][0], _o1 = (nx) ? gn[h][1] : gc[h][1]; \
            PG8_GLDS((const char*)(gbase) + _o0, bufoff, 0); PG8_GLDS((const char*)(gbase) + _o1, bufoff, 1); } \
        else { PG8_GLDS((const char*)(gbase) + (h) * hstep + voffA[0], bufoff, 0); PG8_GLDS((const char*)(gbase) + (h) * hstep + voffA[1], bufoff, 1); } } while (0)
#define PG8_LD2(dstv, p) do { if constexpr (FP8) { const i32x4 _lo = *(const LAS i32x4*)(p), _hi = *(const LAS i32x4*)((p) + 1024); dstv = __builtin_shufflevector(_lo, _hi, 0, 1, 2, 3, 4, 5, 6, 7); } } while (0)
#define PG8_LDA(dst, b, h) do { _Pragma("unroll") for (int m = 0; m < 4; ++m) { if constexpr (FP8) { PG8_LD2(dst.v[m], lds + PG8_SA(b, h) + aoff + m * 2048); } \
        else { _Pragma("unroll") for (int k = 0; k < 2; ++k) dst.v[m][k] = *(const LAS bf16x8*)(lds + PG8_SA(b, h) + aoff + m * 2048 + k * 1024); } } } while (0)
#define PG8_LDB(dst, b, h) do { _Pragma("unroll") for (int n = 0; n < 2; ++n) { if constexpr (FP8) { PG8_LD2(dst.v[n], lds + PG8_SB(b, h) + boff + n * 2048); } \
        else { _Pragma("unroll") for (int k = 0; k < 2; ++k) dst.v[n][k] = *(const LAS bf16x8*)(lds + PG8_SB(b, h) + boff + n * 2048 + k * 1024); } } } while (0)
#define PG8_MMA(ai, bj, At, Bt) do { __builtin_amdgcn_s_setprio(1); _Pragma("unroll") for (int m = 0; m < 4; ++m) _Pragma("unroll") for (int n = 0; n < 2; ++n) { \
        if constexpr (FP8) asm volatile("s_nop 1\n\tv_mfma_scale_f32_16x16x128_f8f6f4 %0, %1, %2, %0, %3, %3 op_sel_hi:[0,0,0]" : "+v"(acc[ai][bj][m][n]) : "v"(Bt.v[n]), "v"(At.v[m]), "v"(f8scale)); \
        else { _Pragma("unroll") for (int k = 0; k < 2; ++k) acc[ai][bj][m][n] = __builtin_amdgcn_mfma_f32_16x16x32_bf16(Bt.v[n][k], At.v[m][k], acc[ai][bj][m][n], 0, 0, 0); } } \
        __builtin_amdgcn_s_setprio(0); } while (0)
#define PG8_WAIT_V(n) asm volatile("s_waitcnt vmcnt(" #n ")" ::: "memory")
#define PG8_WAIT_L(n) asm volatile("s_waitcnt lgkmcnt(" #n ")" ::: "memory")
#define PG8_BAR __builtin_amdgcn_s_barrier()
#define PG8_SCHED __builtin_amdgcn_sched_barrier(0)
#define PG8_GATHER(dst, u) do { _Pragma("unroll") for (int _h = 0; _h < 2; ++_h) _Pragma("unroll") for (int _i = 0; _i < 2; ++_i) \
        dst[_h][_i] = (unsigned)(S.row_token(u, _h * HALF + sR[_i]) * Kb + sC[_i] * 2); } while (0)
    Unit cur, nxt; int ui = 0;
    if (!S.next(0, cur)) return;
    f32x4 acc[2][2][4][2];
#pragma unroll
    for (int a = 0; a < 2; ++a)
#pragma unroll
        for (int b = 0; b < 2; ++b)
#pragma unroll
            for (int m = 0; m < 4; ++m)
#pragma unroll
                for (int n = 0; n < 2; ++n) acc[a][b][m][n] = (f32x4){0.f, 0.f, 0.f, 0.f};
    const int f8scale = 0x7f7f7f7f;
    typedef typename FragT<FP8>::A4 FragA; typedef typename FragT<FP8>::B2 FragB;
    FragA At; FragB B0, B1;
    const char* cA = cur.A; const char* cB = cur.B;
    i32x2 pf[8];
    if constexpr (Epi::PREFETCH) E.prefetch(cur, wr, fr, pf);
    if constexpr (GATHER) { PG8_GATHER(gc, cur); }
    PG8_STAGE_B(PG8_SB(0, 0), cB); PG8_STAGE_A(PG8_SA(0, 0), cA, 0, false); PG8_STAGE_B(PG8_SB(0, 1), cB + bhstep); PG8_STAGE_A(PG8_SA(0, 1), cA, 1, false);
    if (wr == 1) PG8_BAR;
    PG8_WAIT_V(4); PG8_BAR;
    PG8_STAGE_B(PG8_SB(1, 0), cB + kstep); PG8_STAGE_A(PG8_SA(1, 0), cA + kstep, 0, false); PG8_STAGE_B(PG8_SB(1, 1), cB + bhstep + kstep);
    PG8_WAIT_V(6); PG8_BAR;
    for (;;) {
        const bool has_next = S.next(ui + 1, nxt);
        const char* nA = has_next ? nxt.A : cA; const char* nB = has_next ? nxt.B : cB;
        if constexpr (GATHER) { if (has_next) { PG8_GATHER(gn, nxt); } else {
#pragma unroll
            for (int h = 0; h < 2; ++h) { gn[h][0] = gc[h][0]; gn[h][1] = gc[h][1]; } } }
#pragma unroll 1
        for (int t = 0; t < nt; t += 2) {
            const bool last = (t == nt - 2);
            const char* a1 = cA + (size_t)(t + 1) * kstep;
            const char* a2 = last ? nA : cA + (size_t)(t + 2) * kstep; const char* b2 = last ? nB : cB + (size_t)(t + 2) * kstep;
            const char* a3 = a2 + kstep; const char* b3 = b2 + kstep;
            PG8_LDB(B0, 0, 0); PG8_SCHED; PG8_LDA(At, 0, 0); PG8_STAGE_A(PG8_SA(1, 1), a1, 1, false);
            PG8_WAIT_L(8); PG8_BAR; PG8_WAIT_L(0); PG8_MMA(0, 0, At, B0); PG8_BAR; PG8_SCHED;
            PG8_LDB(B1, 0, 1); PG8_STAGE_B(PG8_SB(0, 0), b2);
            PG8_BAR; PG8_WAIT_L(0); PG8_MMA(0, 1, At, B1); PG8_BAR;
            PG8_LDA(At, 0, 1); PG8_STAGE_A(PG8_SA(0, 0), a2, 0, last);
            PG8_BAR; PG8_WAIT_L(0); PG8_MMA(1, 0, At, B0); PG8_BAR; PG8_SCHED;
            PG8_STAGE_B(PG8_SB(0, 1), b2 + bhstep);
            PG8_WAIT_V(6); PG8_BAR; PG8_MMA(1, 1, At, B1); PG8_BAR;
            PG8_LDB(B0, 1, 0); PG8_SCHED; PG8_LDA(At, 1, 0); PG8_STAGE_A(PG8_SA(0, 1), a2, 1, last);
            PG8_WAIT_L(8); PG8_BAR; PG8_WAIT_L(0); PG8_MMA(0, 0, At, B0); PG8_BAR; PG8_SCHED;
            PG8_LDB(B1, 1, 1); PG8_STAGE_B(PG8_SB(1, 0), b3);
            PG8_BAR; PG8_WAIT_L(0); PG8_MMA(0, 1, At, B1); PG8_BAR;
            PG8_LDA(At, 1, 1); PG8_STAGE_A(PG8_SA(1, 0), a3, 0, last);
            PG8_BAR; PG8_WAIT_L(0); PG8_MMA(1, 0, At, B0); PG8_BAR; PG8_SCHED;
            PG8_STAGE_B(PG8_SB(1, 1), b3 + bhstep);
            PG8_WAIT_V(6); PG8_BAR; PG8_MMA(1, 1, At, B1); PG8_BAR;
        }
        if (wr == 0) PG8_BAR;
        if constexpr (FP8) { __builtin_amdgcn_sched_barrier(0); asm volatile("s_nop 15\n\ts_nop 7" ::: "memory"); __builtin_amdgcn_sched_barrier(0); }
        if constexpr (Epi::PREFETCH) E(acc, cur, wr, wc, fr, fq, pf); else E(acc, cur, wr, wc, fr, fq);
        if (!has_next) break;
#pragma unroll
        for (int a = 0; a < 2; ++a)
#pragma unroll
            for (int b = 0; b < 2; ++b)
#pragma unroll
                for (int m = 0; m < 4; ++m)
#pragma unroll
                    for (int n = 0; n < 2; ++n) acc[a][b][m][n] = (f32x4){0.f, 0.f, 0.f, 0.f};
        cur = nxt; cA = nA; cB = nB; ++ui;
        if constexpr (Epi::PREFETCH) E.prefetch(cur, wr, fr, pf);
        if (wr == 1) PG8_BAR;
        if constexpr (GATHER) {
#pragma unroll
            for (int h = 0; h < 2; ++h) { gc[h][0] = gn[h][0]; gc[h][1] = gn[h][1]; } }
    }
    PG8_WAIT_V(0);
    PG8_BAR;
#undef PG8_SA
#undef PG8_SB
#undef PG8_GLDS
#undef PG8_STAGE_A
#undef PG8_STAGE_B
#undef PG8_LDA
#undef PG8_LDB
#undef PG8_MMA
#undef PG8_WAIT_V
#undef PG8_WAIT_L
#undef PG8_BAR
#undef PG8_SCHED
#undef PG8_GATHER
}
}

#define XB_TMO      128
#define XB_XCNT(j)  (256  + 64 * (j))
#define XB_XSUB(j)  (1280 + 64 * (j))
#define XB_XGEN(j)  (2304 + 64 * (j))
#define XB_TOP      3328
#define XB_TOPGEN   3392
#define XCD_BAR_WORDS 3456
#define XB_SPIN_CAP (1u << 22)
__device__ __forceinline__ unsigned xb_ld(unsigned* p)              { return __hip_atomic_load(p, __ATOMIC_RELAXED, __HIP_MEMORY_SCOPE_AGENT); }
__device__ __forceinline__ unsigned xb_add(unsigned* p, unsigned v) { return __hip_atomic_fetch_add(p, v, __ATOMIC_RELAXED, __HIP_MEMORY_SCOPE_AGENT); }
__device__ __forceinline__ unsigned xb_xcc_id() { return (unsigned)__builtin_amdgcn_s_getreg((3 << 11) | 20) & 0xFu; }
#define XB_SPIN(cond, bar) do { unsigned _sp = 0; while (cond) { __builtin_amdgcn_s_sleep(1); \
    if ((++_sp & 255u) == 0u) { if (xb_ld(&(bar)[XB_TMO])) break; if (_sp > XB_SPIN_CAP) { atomicAdd(&(bar)[XB_TMO], 1u); break; } } } } while (0)
struct XcdBarrier { unsigned* bar; unsigned x; volatile LAS unsigned* st; };
__device__ __forceinline__ XcdBarrier xcd_barrier_post(unsigned* bar, volatile LAS unsigned* st) {
    XcdBarrier b; b.bar = bar; b.x = xb_xcc_id(); b.st = st;
    if (threadIdx.x == 0) (void)xb_add(&bar[XB_XCNT(b.x)], 1u);
    return b;
}
__device__ __forceinline__ void xcd_barrier_complete(unsigned* bar, unsigned x, unsigned& nloc, unsigned& nx) {
    const unsigned G = gridDim.x * gridDim.y * gridDim.z;
    unsigned sum, cnt, mine, sp = 0u;
    for (;;) {
        sum = 0u; cnt = 0u; mine = 0u;
#pragma unroll
        for (unsigned j = 0; j < 16; ++j) { const unsigned c = xb_ld(&bar[XB_XCNT(j)]); sum += c; cnt += (c > 0u) ? 1u : 0u; mine = (j == x) ? c : mine; }
        if (sum == G) break;
        __builtin_amdgcn_s_sleep(1);
        if ((++sp & 255u) == 0u) { if (xb_ld(&bar[XB_TMO])) break; if (sp > XB_SPIN_CAP) { atomicAdd(&bar[XB_TMO], 1u); break; } }
    }
    nloc = mine > 0u ? mine : 1u; nx = cnt > 0u ? cnt : 1u;
}
__device__ __forceinline__ void xcd_barrier(const XcdBarrier& b) {
    asm volatile("s_waitcnt vmcnt(0)" ::: "memory");
    __syncthreads();
    if (threadIdx.x == 0) {
        unsigned* bar = b.bar;
        __builtin_amdgcn_s_waitcnt(0);
        unsigned nloc = b.st[0], nx = b.st[1];
        if (nloc == 0u) { xcd_barrier_complete(bar, b.x, nloc, nx); b.st[0] = nloc; b.st[1] = nx; }
        const unsigned old = xb_add(&bar[XB_XSUB(b.x)], 1u);
        const unsigned gen = old / nloc;
        if (old + 1u == (gen + 1u) * nloc) {
            __builtin_amdgcn_fence(__ATOMIC_RELEASE, "agent");
            asm volatile("s_waitcnt vmcnt(0)" ::: "memory");
            const unsigned og = xb_add(&bar[XB_TOP], 1u);
            const unsigned tg = og / nx;
            if (og + 1u == (tg + 1u) * nx) xb_add(&bar[XB_TOPGEN], 1u);
            else XB_SPIN(xb_ld(&bar[XB_TOPGEN]) == tg, bar);
            __builtin_amdgcn_fence(__ATOMIC_ACQUIRE, "agent");
            xb_add(&bar[XB_XGEN(b.x)], 1u);
            asm volatile("s_waitcnt vmcnt(0)" ::: "memory");
        } else {
            XB_SPIN(xb_ld(&bar[XB_XGEN(b.x)]) == gen, bar);
            __builtin_amdgcn_fence(__ATOMIC_ACQUIRE, "agent");
            asm volatile("s_waitcnt vmcnt(0)" ::: "memory");
        }
    }
    __syncthreads();
}

constexpr int NWAVES = 8, NTHR = 512;
constexpr int RING_BYTES = 131072, XTRA_OFF = RING_BYTES, LDS_BYTES = 147456;
constexpr int X_MISC = 0, X_TB = 256, X_NN = 1536;
constexpr int CW_BAR = 4096;
constexpr int N_PHASES = 14;
struct MArgs { const float* in[22]; float* out; unsigned char* ws; int ph_lo, ph_hi; };

#define MAKE_PREP_ARGS(a) PrepArgs{(a).in[4], (a).in[9], (a).in[12], (a).in[14], (a).in[15], (a).in[16], (a).in[17], (a).in[18], (a).in[19], \
    (unsigned char*)((a).ws + WS_WTIN), (bf16*)((a).ws + WS_WTOUT), (bf16*)((a).ws + WS_WTR), (unsigned char*)((a).ws + WS_WT13), (unsigned char*)((a).ws + WS_WT2)}
__device__ __forceinline__ void ph_mod_prep(const MArgs& a, unsigned char* smem, int G) {
    const int tid = threadIdx.x;
    unsigned char* ws = a.ws;
    if ((int)blockIdx.x < 192) {
        float* sc = (float*)smem; float* red = sc + NB * D;
        const float* c = a.in[1]; const float* w_ada = a.in[2]; const float* b_ada = a.in[3]; float* mod = (float*)(ws + WS_MOD);
        for (int i = tid; i < NB * D; i += NTHR) sc[i] = siluf_(c[i]);
        __syncthreads();
        for (int it = blockIdx.x; it < 192; it += G) {
            const int kq = tid >> 5, jl = tid & 31, j = it * 32 + jl;
            float a0 = 0.f, a1 = 0.f, a2 = 0.f, a3 = 0.f;
#pragma unroll 16
            for (int kk = 0; kk < 64; ++kk) { const int k = kq * 64 + kk; const float w = w_ada[(size_t)k * 6144 + j];
                a0 += sc[k] * w; a1 += sc[D + k] * w; a2 += sc[2 * D + k] * w; a3 += sc[3 * D + k] * w; }
            red[(kq * 4 + 0) * 32 + jl] = a0; red[(kq * 4 + 1) * 32 + jl] = a1; red[(kq * 4 + 2) * 32 + jl] = a2; red[(kq * 4 + 3) * 32 + jl] = a3;
            __syncthreads();
            if (tid < 128) { const int b = tid >> 5; float s = b_ada[j];
#pragma unroll
                for (int q = 0; q < 16; ++q) s += red[(q * 4 + b) * 32 + jl];
                mod[b * 6144 + j] = s; }
            __syncthreads();
        }
    }
    const PrepArgs pa = MAKE_PREP_ARGS(a);
    const int lane = tid & 63, gw = blockIdx.x * NWAVES + (tid >> 6), ngw = G * NWAVES;
    prep_run(pa, gw, ngw, lane);
}

__device__ __forceinline__ void ph_ln1(const MArgs& a, unsigned char* smem, int G) {
    const int tid = threadIdx.x, lane = tid & 63, wave = tid >> 6;
    const float* x = a.in[0]; const float* w_in = a.in[4]; const float* gate_b = a.in[7];
    const float* mod = (const float*)(a.ws + WS_MOD); unsigned char* u1 = (unsigned char*)(a.ws + WS_U1); float* ipre = (float*)(a.ws + WS_GATES); float* logf = ipre + 16 * S;
    float* wg = (float*)smem;
    for (int i = tid; i < D * 8; i += NTHR) wg[i] = w_in[(size_t)(i >> 3) * WIN_LD + C_GATE + (i & 7)];
    __syncthreads();
    for (int it = blockIdx.x; it < T / 128; it += G) {
        const int row0 = it * 128, b = row0 / S;
        f32x4 sh[4], sc[4];
#pragma unroll
        for (int j = 0; j < 4; ++j) { sh[j] = *(const f32x4*)(mod + b * 6144 + 4 * lane + 256 * j); sc[j] = *(const f32x4*)(mod + b * 6144 + 1024 + 4 * lane + 256 * j); }
        for (int rr = wave; rr < 128; rr += NWAVES) {
            const int row = row0 + rr;
            const f32x4* xr = (const f32x4*)(x + (size_t)row * D) + lane;
            f32x4 v[4]; float s = 0.f;
#pragma unroll
            for (int j = 0; j < 4; ++j) { v[j] = xr[64 * j]; s += (v[j].x + v[j].y) + (v[j].z + v[j].w); }
            const float mean = wave_sum(s) * (1.f / D); float s2 = 0.f;
#pragma unroll
            for (int j = 0; j < 4; ++j) { v[j] = v[j] - mean; s2 += (v[j].x * v[j].x + v[j].y * v[j].y) + (v[j].z * v[j].z + v[j].w * v[j].w); }
            const float rstd = 1.f / sqrtf(wave_sum(s2) * (1.f / D) + LN_EPS);
            float ga[8];
#pragma unroll
            for (int q = 0; q < 8; ++q) ga[q] = 0.f;
            unsigned* o4 = (unsigned*)(u1 + (size_t)row * D) + lane;
#pragma unroll
            for (int j = 0; j < 4; ++j) {
                const f32x4 u = v[j] * rstd * (sc[j] + 1.0f) + sh[j];
                o4[64 * j] = pk4_fp8(u.x, u.y, u.z, u.w);
#pragma unroll
                for (int e = 0; e < 4; ++e) { const int k = 4 * lane + 256 * j + e;
                    const f32x4 w0 = *(const f32x4*)(wg + k * 8), w1 = *(const f32x4*)(wg + k * 8 + 4);
                    ga[0] += u[e] * w0.x; ga[1] += u[e] * w0.y; ga[2] += u[e] * w0.z; ga[3] += u[e] * w0.w;
                    ga[4] += u[e] * w1.x; ga[5] += u[e] * w1.y; ga[6] += u[e] * w1.z; ga[7] += u[e] * w1.w; }
            }
#pragma unroll
            for (int q = 0; q < 8; ++q) ga[q] = wave_sum(ga[q]);
            if (lane < 8) {
                float gv = 0.f;
#pragma unroll
                for (int q = 0; q < 8; ++q) gv = (lane == q) ? ga[q] : gv;
                gv += gate_b[lane];
                const int h = lane & 3, s_ = row % S;
                if (lane < 4) ipre[(size_t)(b * 4 + h) * S + s_] = gv;
                else logf[(size_t)(b * 4 + h) * S + s_] = fminf(gv, 0.f) - log1pf(__expf(-fabsf(gv)));
            }
        }
    }
}

__device__ __forceinline__ void ph_ln2(const MArgs& a, int G) {
    const float* x = a.in[0]; const bf16* mixout = (const bf16*)(a.ws + WS_MIXOUT); const float* mod = (const float*)(a.ws + WS_MOD); const float* ln1_g = a.in[10]; const float* ln1_b = a.in[11];
    bf16* x1 = (bf16*)(a.ws + WS_X1); bf16* u2 = (bf16*)(a.ws + WS_U2); unsigned char* u2f8 = (unsigned char*)(a.ws + WS_U2F8);
    const int tid = threadIdx.x, lane = tid & 63, wave = tid >> 6;
    for (int it = blockIdx.x; it < T / 128; it += G) {
        const int row0 = it * 128, b = row0 / S;
        f32x4 g1[4], lg[4], lb[4], sc2[4], sh2[4];
#pragma unroll
        for (int j = 0; j < 4; ++j) { const int col = 4 * lane + 256 * j;
            g1[j] = *(const f32x4*)(mod + b * 6144 + 2048 + col); lg[j] = *(const f32x4*)(ln1_g + col); lb[j] = *(const f32x4*)(ln1_b + col);
            sc2[j] = *(const f32x4*)(mod + b * 6144 + 4096 + col) + 1.0f; sh2[j] = *(const f32x4*)(mod + b * 6144 + 3072 + col); }
        for (int rr = wave; rr < 128; rr += NWAVES) {
            const int row = row0 + rr;
            f32x4 v[4]; float s = 0.f;
#pragma unroll
            for (int j = 0; j < 4; ++j) {
                const int col = 4 * lane + 256 * j;
                const f32x4 xv = __builtin_nontemporal_load((const f32x4*)(x + (size_t)row * D + col));
                const f32x4 mo = ld_bf4(mixout + (size_t)row * D + col);
                v[j] = xv * DN_ALPHA + g1[j] * mo; s += (v[j].x + v[j].y) + (v[j].z + v[j].w);
            }
            float mean = wave_sum(s) * (1.f / D), s2 = 0.f;
#pragma unroll
            for (int j = 0; j < 4; ++j) { v[j] = v[j] - mean; s2 += (v[j].x * v[j].x + v[j].y * v[j].y) + (v[j].z * v[j].z + v[j].w * v[j].w); }
            float rstd = 1.f / sqrtf(wave_sum(s2) * (1.f / D) + LN_EPS);
            s = 0.f;
#pragma unroll
            for (int j = 0; j < 4; ++j) { const int col = 4 * lane + 256 * j;
                v[j] = v[j] * rstd * lg[j] + lb[j];
                *(unsigned long long*)(x1 + (size_t)row * D + col) = (unsigned long long)pk2(v[j].x, v[j].y) | ((unsigned long long)pk2(v[j].z, v[j].w) << 32); s += (v[j].x + v[j].y) + (v[j].z + v[j].w); }
            mean = wave_sum(s) * (1.f / D); s2 = 0.f;
#pragma unroll
            for (int j = 0; j < 4; ++j) { v[j] = v[j] - mean; s2 += (v[j].x * v[j].x + v[j].y * v[j].y) + (v[j].z * v[j].z + v[j].w * v[j].w); }
            rstd = 1.f / sqrtf(wave_sum(s2) * (1.f / D) + LN_EPS);
#pragma unroll
            for (int j = 0; j < 4; ++j) { const int col = 4 * lane + 256 * j;
                const f32x4 u = v[j] * rstd * sc2[j] + sh2[j];
                *(unsigned long long*)(u2 + (size_t)row * D + col) = (unsigned long long)pk2(u.x, u.y) | ((unsigned long long)pk2(u.z, u.w) << 32);
                *(unsigned*)(u2f8 + (size_t)row * D + col) = pk4_fp8(u.x, u.y, u.z, u.w); }
        }
    }
}
#define DPPI(v, ctrl) __builtin_amdgcn_update_dpp(0, (v), (ctrl), 0xF, 0xF, true)
#define DPPF(v, ctrl) __builtin_bit_cast(float, __builtin_amdgcn_update_dpp(0, __builtin_bit_cast(int, (v)), (ctrl), 0xF, 0xF, true))
__device__ __forceinline__ void route_wave(int t, int lane, const float* __restrict__ logits, const f32x4 bias4, int* __restrict__ tope, float* __restrict__ topg, LAS int* hist) {
    const f32x4 lg = *(const f32x4*)(logits + (size_t)t * NE + 4 * lane);
    float sc[4], v[4];
#pragma unroll
    for (int j = 0; j < 4; ++j) { sc[j] = 1.f / (1.f + __expf(-lg[j])); v[j] = sc[j] + bias4[j]; }
    float m1 = fmaxf(fmaxf(v[0], v[1]), fmaxf(v[2], v[3]));
    float m2; { const float a = fmaxf(v[0], v[1]), b = fminf(v[0], v[1]), c = fmaxf(v[2], v[3]), d = fminf(v[2], v[3]); m2 = fmaxf(fminf(a, c), fmaxf(b, d)); }
#pragma unroll
    for (int st = 0; st < 3; ++st) { const float o1 = st == 0 ? DPPF(m1, 0xB1) : (st == 1 ? DPPF(m1, 0x4E) : DPPF(m1, 0x141)), o2 = st == 0 ? DPPF(m2, 0xB1) : (st == 1 ? DPPF(m2, 0x4E) : DPPF(m2, 0x141));
        const float n1 = fmaxf(m1, o1); m2 = fmaxf(fminf(m1, o1), fmaxf(m2, o2)); m1 = n1; }
    const float gs = m1 + m2; const int myg = lane >> 3; int rank = 0;
#pragma unroll
    for (int gg = 0; gg < 8; ++gg) { const float og = __builtin_bit_cast(float, __builtin_amdgcn_readlane(__builtin_bit_cast(int, gs), gg * 8)); rank += (og > gs || (og == gs && gg < myg)) ? 1 : 0; }
    unsigned kh[4];
#pragma unroll
    for (int j = 0; j < 4; ++j) { const unsigned u = __builtin_bit_cast(unsigned, v[j]); kh[j] = (rank >= 4) ? 0u : (u ^ ((u >> 31) ? 0xFFFFFFFFu : 0x80000000u)); }
    int myE = 0; float myS = 0.f, gsum = 0.f;
#pragma unroll
    for (int rd = 0; rd < 8; ++rd) {
        unsigned bh_ = kh[0]; int bl = 255 - 4 * lane;
#pragma unroll
        for (int j = 1; j < 4; ++j) if (kh[j] > bh_) { bh_ = kh[j]; bl = 255 - (4 * lane + j); }
#pragma unroll
        for (int st = 0; st < 4; ++st) {
            const int ctrl = st == 0 ? 0xB1 : (st == 1 ? 0x4E : (st == 2 ? 0x141 : 0x140));
            const unsigned oh = (unsigned)(st == 0 ? DPPI((int)bh_, 0xB1) : (st == 1 ? DPPI((int)bh_, 0x4E) : (st == 2 ? DPPI((int)bh_, 0x141) : DPPI((int)bh_, 0x140))));
            const int ol = st == 0 ? DPPI(bl, 0xB1) : (st == 1 ? DPPI(bl, 0x4E) : (st == 2 ? DPPI(bl, 0x141) : DPPI(bl, 0x140)));
            (void)ctrl; const bool take = (oh > bh_) || (oh == bh_ && ol > bl); bh_ = take ? oh : bh_; bl = take ? ol : bl; }
        unsigned wh = (unsigned)__builtin_amdgcn_readlane((int)bh_, 0); int wl = __builtin_amdgcn_readlane(bl, 0);
#pragma unroll
        for (int rw = 1; rw < 4; ++rw) { const unsigned oh = (unsigned)__builtin_amdgcn_readlane((int)bh_, 16 * rw); const int ol = __builtin_amdgcn_readlane(bl, 16 * rw);
            const bool take = (oh > wh) || (oh == wh && ol > wl); wh = take ? oh : wh; wl = take ? ol : wl; }
        const int bi = 255 - wl;
        float cand = 0.f;
#pragma unroll
        for (int j = 0; j < 4; ++j) if (bi == 4 * lane + j) { cand = sc[j]; kh[j] = 0u; }
        const float ss = __builtin_bit_cast(float, __builtin_amdgcn_readlane(__builtin_bit_cast(int, cand), bi >> 2));
        gsum += ss;
        if (lane == rd) { myE = bi; myS = ss; }
    }
    if (lane < 8) { tope[t * 8 + lane] = myE; topg[t * 8 + lane] = myS * (2.5f / gsum); __hip_atomic_fetch_add(hist + myE, 1, __ATOMIC_RELAXED, __HIP_MEMORY_SCOPE_WORKGROUP); }
}
__device__ __forceinline__ void moe_tables(const int* cnt, LAS int* tb, LAS int* nn) {
    if (threadIdx.x < 64) {
        const int lane = threadIdx.x; int n[4], tl[4], loc = 0;
#pragma unroll
        for (int j = 0; j < 4; ++j) { n[j] = cnt[(4 * lane + j) * CSTR]; tl[j] = (n[j] + 255) >> 8; loc += tl[j]; }
        int inc = loc;
#pragma unroll
        for (int o = 1; o < 64; o <<= 1) { const int v = __shfl_up(inc, o); if (lane >= o) inc += v; }
        int base = inc - loc;
#pragma unroll
        for (int j = 0; j < 4; ++j) { tb[4 * lane + j] = base; nn[4 * lane + j] = n[j]; base += tl[j]; }
        if (lane == 63) { tb[NE] = base; nn[NE] = T; tb[NEX] = base + T / 256; }
    }
    __syncthreads();
}
__device__ __forceinline__ void ph_final(const MArgs& a, int G) {
    float* out = a.out; const bf16* x1 = (const bf16*)(a.ws + WS_X1); const unsigned char* ys8 = (const unsigned char*)(a.ws + WS_YS); const unsigned char* ysh8 = (const unsigned char*)(a.ws + WS_YSH); const float* mod = (const float*)(a.ws + WS_MOD);
    const float* ln2_g = a.in[20]; const float* ln2_b = a.in[21];
    const int tid = threadIdx.x, lane = tid & 63, wave = tid >> 6;
    for (int it = blockIdx.x; it < T / 128; it += G) {
        const int row0 = it * 128, b = row0 / S;
        f32x4 g2[4], lg[4], lb[4];
#pragma unroll
        for (int j = 0; j < 4; ++j) { const int col = 4 * lane + 256 * j; g2[j] = *(const f32x4*)(mod + b * 6144 + 5120 + col); lg[j] = *(const f32x4*)(ln2_g + col); lb[j] = *(const f32x4*)(ln2_b + col); }
        for (int rr = wave; rr < 128; rr += NWAVES) {
            const int row = row0 + rr;
            f32x4 v[4]; float s = 0.f;
#pragma unroll
            for (int j = 0; j < 4; ++j) { const int col = 4 * lane + 256 * j;
                f32x4 yr = {0.f, 0.f, 0.f, 0.f};
#pragma unroll
                for (int k = 0; k < 8; ++k) { const int w = *(const int*)(ys8 + ((size_t)row * 8 + k) * D + col);
                    const f32x2 lo = __builtin_amdgcn_cvt_pk_f32_fp8(w, false), hi = __builtin_amdgcn_cvt_pk_f32_fp8(w, true); yr = yr + (f32x4){lo.x, lo.y, hi.x, hi.y}; }
                { const int w = *(const int*)(ysh8 + (size_t)row * D + col); const f32x2 lo = __builtin_amdgcn_cvt_pk_f32_fp8(w, false), hi = __builtin_amdgcn_cvt_pk_f32_fp8(w, true); yr = yr + (f32x4){lo.x, lo.y, hi.x, hi.y}; }
                const f32x4 y = yr * (1.f / 16.f);
                v[j] = ld_bf4(x1 + (size_t)row * D + col) * DN_ALPHA + g2[j] * y;
                s += (v[j].x + v[j].y) + (v[j].z + v[j].w); }
            const float mean = wave_sum(s) * (1.f / D); float s2 = 0.f;
#pragma unroll
            for (int j = 0; j < 4; ++j) { v[j] = v[j] - mean; s2 += (v[j].x * v[j].x + v[j].y * v[j].y) + (v[j].z * v[j].z + v[j].w * v[j].w); }
            const float rstd = 1.f / sqrtf(wave_sum(s2) * (1.f / D) + LN_EPS);
#pragma unroll
            for (int j = 0; j < 4; ++j) { const int col = 4 * lane + 256 * j;
                __builtin_nontemporal_store(v[j] * rstd * lg[j] + lb[j], (f32x4*)(out + (size_t)row * D + col)); }
        }
    }
}


typedef short s16x4 __attribute__((ext_vector_type(4)));
typedef short bf16x8v __attribute__((ext_vector_type(8)));
typedef float f32x16 __attribute__((ext_vector_type(16)));
constexpr int MLP = 320;
constexpr int NCH = S / 64;
constexpr int ST_ELEMS = 129 * 128;
constexpr size_t WS_CHK = WS_GATES + 1 * MiB;
constexpr size_t WS_MPREV = WS_GATES + 1 * MiB + 65536;
constexpr size_t WS_KC = WS_U2;
__device__ __forceinline__ s16x4 tr_read(const LAS unsigned char* p) { return __builtin_bit_cast(s16x4, __builtin_amdgcn_ds_read_tr16_b64_v4i16((LAS s16x4*)p)); }
__device__ __forceinline__ bf16x8v tr_frag(const LAS unsigned char* tile, int row0, int col0, int lane) {
    const int i = lane & 15; const LAS unsigned char* p = tile + (row0 + (i >> 2)) * MLP + (col0 + 4 * (i & 3)) * 2;
    const s16x4 lo = tr_read(p), hi = tr_read(p + 4 * MLP);
    return __builtin_shufflevector(lo, hi, 0, 1, 2, 3, 4, 5, 6, 7);
}
__device__ __forceinline__ bf16x8v tr_frag_perm(const LAS unsigned char* tile, int row0, int col0, int lane) {
    const int i = lane & 15; const LAS unsigned char* p = tile + (row0 + (i >> 2)) * MLP + (col0 + 4 * (i & 3)) * 2;
    const s16x4 lo = tr_read(p), hi = tr_read(p + 8 * MLP);
    return __builtin_shufflevector(lo, hi, 0, 1, 2, 3, 4, 5, 6, 7);
}
__device__ __forceinline__ float wave_incl_sum(float v, int lane) {
#pragma unroll
    for (int o = 1; o < 64; o <<= 1) { const float u = __shfl_up(v, o); if (lane >= o) v += u; }
    return v;
}
__device__ __forceinline__ float wave_incl_max(float v, int lane) {
#pragma unroll
    for (int o = 1; o < 64; o <<= 1) { const float u = __shfl_up(v, o); if (lane >= o) v = fmaxf(v, u); }
    return v;
}
__device__ __forceinline__ float wave_max(float v) {
#pragma unroll
    for (int o = 1; o < 64; o <<= 1) v = fmaxf(v, __shfl_xor(v, o));
    return v;
}
__device__ __forceinline__ void cvt8_fp8(unsigned long long w, float (&f)[8]);
__device__ __forceinline__ void conv8(const unsigned char* __restrict__ rowp, int spos, const float* __restrict__ cw, const float* __restrict__ cb, float scale, float (&y)[8]) {
    const f32x4 b0 = *(const f32x4*)cb, b1 = *(const f32x4*)(cb + 4);
    y[0] = b0.x; y[1] = b0.y; y[2] = b0.z; y[3] = b0.w; y[4] = b1.x; y[5] = b1.y; y[6] = b1.z; y[7] = b1.w;
    unsigned long long xr[4];
#pragma unroll
    for (int j = 0; j < 4; ++j) { const int back = (spos - 3 + j >= 0) ? (j - 3) : 0; xr[j] = *(const unsigned long long*)(rowp + (ptrdiff_t)back * NPROJ); }
#pragma unroll
    for (int j = 0; j < 4; ++j) {
        const float ok = (spos - 3 + j >= 0) ? 1.f : 0.f; float xf[8]; cvt8_fp8(xr[j], xf);
        const f32x4 w0 = *(const f32x4*)(cw + j * 1024) * ok, w1 = *(const f32x4*)(cw + j * 1024 + 4) * ok;
        y[0] += w0.x * xf[0]; y[1] += w0.y * xf[1]; y[2] += w0.z * xf[2]; y[3] += w0.w * xf[3];
        y[4] += w1.x * xf[4]; y[5] += w1.y * xf[5]; y[6] += w1.z * xf[6]; y[7] += w1.w * xf[7];
    }
#pragma unroll
    for (int e = 0; e < 8; ++e) y[e] = siluf_(y[e]) * scale;
}
__device__ __forceinline__ void cvt8_fp8(unsigned long long w, float (&f)[8]) {
    const f32x2 a = __builtin_amdgcn_cvt_pk_f32_fp8((int)(unsigned)w, false), b = __builtin_amdgcn_cvt_pk_f32_fp8((int)(unsigned)w, true);
    const f32x2 c = __builtin_amdgcn_cvt_pk_f32_fp8((int)(unsigned)(w >> 32), false), d = __builtin_amdgcn_cvt_pk_f32_fp8((int)(unsigned)(w >> 32), true);
    f[0] = a.x; f[1] = a.y; f[2] = b.x; f[3] = b.y; f[4] = c.x; f[5] = c.y; f[6] = d.x; f[7] = d.y; }
__device__ __forceinline__ v4u pack8(const float (&y)[8]) { v4u o; o.x = pk2(y[0], y[1]); o.y = pk2(y[2], y[3]); o.z = pk2(y[4], y[5]); o.w = pk2(y[6], y[7]); return o; }

__device__ __forceinline__ void ml_phaseA(const MArgs& a, LAS unsigned char* lds, int vb0, int nvb) {
    const int tid = threadIdx.x, lane = tid & 63, wave = __builtin_amdgcn_readfirstlane(tid >> 6);
    const unsigned char* proj = (const unsigned char*)(a.ws + WS_PROJ); const float* conv_w = a.in[5]; const float* conv_b = a.in[6];
    const float* ipre = (const float*)(a.ws + WS_GATES); const float* logf = ipre + 16 * S;
    bf16* kcg = (bf16*)(a.ws + WS_KC); bf16* st = (bf16*)(a.ws + WS_STATES); float* chk = (float*)(a.ws + WS_CHK);
    LAS unsigned char* Kt = lds; LAS unsigned char* Vt = lds + 64 * MLP; LAS float* wkL = (LAS float*)(lds + 128 * MLP); LAS unsigned char* Stg = lds + 132 * MLP;
    const PrepArgs pa = MAKE_PREP_ARGS(a);
    for (int unit = vb0; unit < 16 * NCH; unit += nvb) {
        const int bh = unit >> 7, c = unit & (NCH - 1), b = bh >> 2, h = bh & 3, s0 = c * 64; const size_t row0 = (size_t)b * S + s0;
        float lf = 0.f, ic = 0.f;
        if (wave == 0) { lf = logf[(size_t)bh * S + s0 + lane]; ic = ipre[(size_t)bh * S + s0 + lane]; }
#pragma unroll
        for (int q = 0; q < 2; ++q) { const int it = tid + q * NTHR, tt = it >> 4, c8 = it & 15, ch = h * 128 + c8 * 8;
            float y[8]; conv8(proj + (row0 + tt) * NPROJ + C_MLK + ch, s0 + tt, conv_w + 512 + ch, conv_b + 512 + ch, 0.08838834764831845f, y);
            const v4u o = pack8(y);
            *(LAS v4u*)(Kt + tt * MLP + c8 * 16) = o; *(v4u*)(kcg + (row0 + tt) * 512 + ch) = o; }
        if (wave == 0) {
            const float bc = wave_incl_sum(lf, lane), g = ic - bc, gmax = wave_max(g), blast = __shfl(bc, 63);
            wkL[lane] = __expf(g - gmax);
            if (lane == 0) { chk[(size_t)unit * 2] = blast; chk[(size_t)unit * 2 + 1] = blast + gmax; }
        }
        __syncthreads();
        const PrepDesc bgd = prep_decode(pa, IT_SMALL + unit * NWAVES + wave); f32x4 bgv[16]; prep_load(bgd, lane, bgv);
#pragma unroll
        for (int q = 0; q < 2; ++q) { const int it = tid + q * NTHR, tt = it >> 4, c8 = it & 15;
            float y[8]; cvt8_fp8(*(const unsigned long long*)(proj + (row0 + tt) * NPROJ + C_MLV + h * 128 + c8 * 8), y); const float w = wkL[tt];
#pragma unroll
            for (int e = 0; e < 8; ++e) y[e] *= w;
            *(LAS v4u*)(Vt + tt * MLP + c8 * 16) = pack8(y); }
        __syncthreads();
        {
            const int dvb = wave >> 1, dkh = wave & 1, hh = lane >> 5, gsel = (lane >> 4) & 1;
            f32x16 acc[2];
#pragma unroll
            for (int nb = 0; nb < 2; ++nb)
#pragma unroll
                for (int i = 0; i < 16; ++i) acc[nb][i] = 0.f;
#pragma unroll
            for (int kk = 0; kk < 4; ++kk) {
                const bf16x8v Bv = tr_frag(Vt, 16 * kk + 8 * hh, 32 * dvb + 16 * gsel, lane);
#pragma unroll
                for (int nb = 0; nb < 2; ++nb) { const bf16x8v Ak = tr_frag(Kt, 16 * kk + 8 * hh, 32 * (2 * dkh + nb) + 16 * gsel, lane);
                    acc[nb] = __builtin_amdgcn_mfma_f32_32x32x16_bf16(Ak, Bv, acc[nb], 0, 0, 0); }
            }
#pragma unroll
            for (int nb = 0; nb < 2; ++nb)
#pragma unroll
                for (int g4 = 0; g4 < 4; ++g4) { const int dk = 32 * (2 * dkh + nb) + 8 * g4 + 4 * hh, dv = 32 * dvb + (lane & 31);
                    *(LAS unsigned long long*)(Stg + dv * MLP + dk * 2) = (unsigned long long)pk2(acc[nb][4 * g4], acc[nb][4 * g4 + 1]) | ((unsigned long long)pk2(acc[nb][4 * g4 + 2], acc[nb][4 * g4 + 3]) << 32); }
        }
        __syncthreads();
        { bf16* stc = st + (size_t)unit * ST_ELEMS;
#pragma unroll
          for (int q = 0; q < 4; ++q) { const int it = tid + q * NTHR, dv = it >> 4, c8 = it & 15;
              *(v4u*)(stc + dv * 128 + c8 * 8) = *(const LAS v4u*)(Stg + dv * MLP + c8 * 16); }
        }
        if (tid < 128) { float s = 0.f;
#pragma unroll 8
            for (int t = 0; t < 64; ++t) s += wkL[t] * bf2f(*(const LAS unsigned short*)(Kt + t * MLP + tid * 2));
            st[(size_t)unit * ST_ELEMS + 128 * 128 + tid] = (bf16)f2bf(s); }
        prep_store(bgd, lane, bgv);
        __syncthreads();
    }
}

__device__ __forceinline__ void ml_phaseB(const MArgs& a, LAS unsigned char* lds, int vb0, int nvb) {
    const int tid = threadIdx.x;
    bf16* st = (bf16*)(a.ws + WS_STATES); const float* chk = (const float*)(a.ws + WS_CHK); float* mprev = (float*)(a.ws + WS_MPREV);
    LAS float* al = (LAS float*)lds; LAS float* be = al + NCH;
    constexpr int NSL = 16, SLE = ST_ELEMS / NSL;
    for (int item = vb0; item < 16 * NSL; item += nvb) {
        const int bh = item / NSL, sl = item % NSL;
        __syncthreads();
        if (tid < NCH) { al[tid] = chk[(size_t)(bh * NCH + tid) * 2]; be[tid] = chk[(size_t)(bh * NCH + tid) * 2 + 1]; }
        __syncthreads();
        if (tid == 0) { float m = 0.f;
            for (int c = 0; c < NCH; ++c) { const float bl = al[c], M = be[c];
                const float mn = fmaxf(bl + m, M); al[c] = __expf(bl + m - mn); be[c] = __expf(M - mn);
                if (sl == 0) mprev[bh * NCH + c] = m;
                m = mn; } }
        __syncthreads();
        if (tid * 4 < SLE) {
            unsigned long long* p = (unsigned long long*)(st + (size_t)bh * NCH * ST_ELEMS + sl * SLE + tid * 4);
            float c0 = 0.f, c1 = 0.f, c2 = 0.f, c3 = 0.f;
            for (int cb = 0; cb < NCH; cb += 16) { unsigned long long d[16];
#pragma unroll
                for (int j = 0; j < 16; ++j) d[j] = p[(size_t)(cb + j) * (ST_ELEMS / 4)];
#pragma unroll
                for (int j = 0; j < 16; ++j) { p[(size_t)(cb + j) * (ST_ELEMS / 4)] = (unsigned long long)pk2(c0, c1) | ((unsigned long long)pk2(c2, c3) << 32);
                    const float A = al[cb + j], Bq = be[cb + j]; const unsigned lo = (unsigned)d[j], hi = (unsigned)(d[j] >> 32);
                    c0 = A * c0 + Bq * bf2f(lo & 0xffffu); c1 = A * c1 + Bq * bf2f(lo >> 16); c2 = A * c2 + Bq * bf2f(hi & 0xffffu); c3 = A * c3 + Bq * bf2f(hi >> 16); } }
        }
    }
}

__device__ __forceinline__ void ml_phaseC(const MArgs& a, LAS unsigned char* lds, int G) {
    const int tid = threadIdx.x, lane = tid & 63, wave = __builtin_amdgcn_readfirstlane(tid >> 6);
    const unsigned char* proj = (const unsigned char*)(a.ws + WS_PROJ); const float* conv_w = a.in[5]; const float* conv_b = a.in[6]; const float* norm_g = a.in[8];
    const float* ipre = (const float*)(a.ws + WS_GATES); const float* logf = ipre + 16 * S;
    const bf16* kcg = (const bf16*)(a.ws + WS_KC); const bf16* st = (const bf16*)(a.ws + WS_STATES); const float* mprev = (const float*)(a.ws + WS_MPREV);
    unsigned char* mix8 = (unsigned char*)(a.ws + WS_MIX);
    LAS unsigned char* Qt = lds; LAS unsigned char* Kt = lds + 64 * MLP; LAS unsigned char* Vt = lds + 128 * MLP; LAS unsigned char* Ct = lds + 192 * MLP;
    LAS float* sc = (LAS float*)(lds + 320 * MLP);
    LAS float* gL = sc; LAS float* mmL = sc + 64; LAS float* siL = sc + 128; LAS float* emL = sc + 192; LAS float* npv = sc + 256; LAS float* lnS = sc + 384;
    const int tb = wave >> 2, dvb = wave & 3, r = lane & 31, hh = lane >> 5, gsel = (lane >> 4) & 1;
    const PrepArgs pa = MAKE_PREP_ARGS(a);
    for (int unit = blockIdx.x; unit < 16 * NCH; unit += G) {
        const int bh = unit >> 7, c = unit & (NCH - 1), b = bh >> 2, h = bh & 3, s0 = c * 64; const size_t row0 = (size_t)b * S + s0;
        float lf = 0.f, ic = 0.f, mp = 0.f;
        if (wave == 0) { lf = logf[(size_t)bh * S + s0 + lane]; ic = ipre[(size_t)bh * S + s0 + lane]; mp = mprev[unit]; }
        const bf16* stc = st + (size_t)unit * ST_ELEMS;
#pragma unroll
        for (int q = 0; q < 2; ++q) { const int it = tid + q * NTHR, tt = it >> 4, c8 = it & 15, ch = h * 128 + c8 * 8;
            float y[8]; conv8(proj + (row0 + tt) * NPROJ + C_MLQ + ch, s0 + tt, conv_w + ch, conv_b + ch, 1.f, y);
            *(LAS v4u*)(Qt + tt * MLP + c8 * 16) = pack8(y);
            *(LAS v4u*)(Kt + tt * MLP + c8 * 16) = *(const v4u*)(kcg + (row0 + tt) * 512 + ch);
            { float vf[8]; cvt8_fp8(*(const unsigned long long*)(proj + (row0 + tt) * NPROJ + C_MLV + ch), vf); *(LAS v4u*)(Vt + tt * MLP + c8 * 16) = pack8(vf); } }
#pragma unroll
        for (int q = 0; q < 4; ++q) { const int it = tid + q * NTHR, dv = it >> 4, c8 = it & 15;
            *(LAS v4u*)(Ct + dv * MLP + c8 * 16) = *(const v4u*)(stc + dv * 128 + c8 * 8); }
        if (tid < 128) npv[tid] = bf2f(stc[128 * 128 + tid]);
        if (wave == 0) {
            const float bc = wave_incl_sum(lf, lane), g = ic - bc, pm = wave_incl_max(g, lane), mm = fmaxf(mp, pm);
            gL[lane] = g; mmL[lane] = mm; siL[lane] = __expf(mp - mm); emL[lane] = __expf(-(bc + mm));
        }
        __syncthreads();
        unsigned long long ogp[2]; f32x4 ngp[2][2];
#pragma unroll
        for (int q = 0; q < 2; ++q) { const int it = tid + q * NTHR, tt = it >> 4, dv = (it & 15) * 8;
            ogp[q] = *(const unsigned long long*)(proj + (row0 + tt) * NPROJ + C_MLO + h * 128 + dv); ngp[q][0] = *(const f32x4*)(norm_g + h * 128 + dv); ngp[q][1] = *(const f32x4*)(norm_g + h * 128 + dv + 4); }
        const PrepDesc bgd = prep_decode(pa, IT_SMALL + BG_A + unit * NWAVES + wave); f32x4 bgv[16]; prep_load(bgd, lane, bgv);
        bf16x8v qf[8];
#pragma unroll
        for (int kk = 0; kk < 8; ++kk) qf[kk] = *(const LAS bf16x8v*)(Qt + (32 * tb + r) * MLP + (16 * kk + 8 * hh) * 2);
        const float mm_t = mmL[32 * tb + r], si_t = siL[32 * tb + r], em_t = emL[32 * tb + r];
        float nq = 0.f;
#pragma unroll
        for (int kk = 0; kk < 8; ++kk) { const f32x4 n0 = *(const LAS f32x4*)(npv + 16 * kk + 8 * hh), n1 = *(const LAS f32x4*)(npv + 16 * kk + 8 * hh + 4);
            nq += n0.x * bf2f((unsigned short)qf[kk][0]) + n0.y * bf2f((unsigned short)qf[kk][1]) + n0.z * bf2f((unsigned short)qf[kk][2]) + n0.w * bf2f((unsigned short)qf[kk][3])
                + n1.x * bf2f((unsigned short)qf[kk][4]) + n1.y * bf2f((unsigned short)qf[kk][5]) + n1.z * bf2f((unsigned short)qf[kk][6]) + n1.w * bf2f((unsigned short)qf[kk][7]); }
        nq += __shfl_xor(nq, 32);
        f32x16 num;
#pragma unroll
        for (int i = 0; i < 16; ++i) num[i] = 0.f;
#pragma unroll
        for (int kk = 0; kk < 8; ++kk) { const bf16x8v Ac = *(const LAS bf16x8v*)(Ct + (32 * dvb + r) * MLP + (16 * kk + 8 * hh) * 2);
            num = __builtin_amdgcn_mfma_f32_32x32x16_bf16(Ac, qf[kk], num, 0, 0, 0); }
#pragma unroll
        for (int i = 0; i < 16; ++i) num[i] *= si_t;
        float wsum = 0.f;
        for (int sb = 0; sb <= tb; ++sb) {
            f32x16 sT;
#pragma unroll
            for (int i = 0; i < 16; ++i) sT[i] = 0.f;
#pragma unroll
            for (int kk = 0; kk < 8; ++kk) { const bf16x8v Ak = *(const LAS bf16x8v*)(Kt + (32 * sb + r) * MLP + (16 * kk + 8 * hh) * 2);
                sT = __builtin_amdgcn_mfma_f32_32x32x16_bf16(Ak, qf[kk], sT, 0, 0, 0); }
            unsigned wp[8];
#pragma unroll
            for (int g4 = 0; g4 < 4; ++g4) { const f32x4 gv = *(const LAS f32x4*)(gL + 32 * sb + 8 * g4 + 4 * hh);
                float w[4];
#pragma unroll
                for (int e = 0; e < 4; ++e) { const int srow = 32 * sb + 8 * g4 + 4 * hh + e; const bool valid = srow <= 32 * tb + r;
                    w[e] = valid ? sT[4 * g4 + e] * __expf(gv[e] - mm_t) : 0.f; wsum += w[e]; }
                wp[2 * g4] = pk2(w[0], w[1]); wp[2 * g4 + 1] = pk2(w[2], w[3]); }
#pragma unroll
            for (int s2 = 0; s2 < 2; ++s2) {
                const bf16x8v Av = tr_frag_perm(Vt, 32 * sb + 16 * s2 + 4 * hh, 32 * dvb + 16 * gsel, lane);
                v4u bw; bw.x = wp[4 * s2]; bw.y = wp[4 * s2 + 1]; bw.z = wp[4 * s2 + 2]; bw.w = wp[4 * s2 + 3];
                num = __builtin_amdgcn_mfma_f32_32x32x16_bf16(Av, __builtin_bit_cast(bf16x8v, bw), num, 0, 0, 0); }
        }
        wsum += __shfl_xor(wsum, 32);
        const float den = si_t * nq + wsum, rden = 1.f / fmaxf(fabsf(den), em_t);
        float ps = 0.f, pq = 0.f;
#pragma unroll
        for (int i = 0; i < 16; ++i) { num[i] *= rden; ps += num[i]; pq += num[i] * num[i]; }
        ps += __shfl_xor(ps, 32); pq += __shfl_xor(pq, 32);
        if (hh == 0) { lnS[((tb * 4 + dvb) * 32 + r) * 2] = ps; lnS[((tb * 4 + dvb) * 32 + r) * 2 + 1] = pq; }
        __syncthreads();
        float ts = 0.f, tq = 0.f;
#pragma unroll
        for (int d = 0; d < 4; ++d) { ts += lnS[((tb * 4 + d) * 32 + r) * 2]; tq += lnS[((tb * 4 + d) * 32 + r) * 2 + 1]; }
        const float mean = ts * (1.f / 128.f), rstd = 1.f / sqrtf(fmaxf(tq * (1.f / 128.f) - mean * mean, 0.f) + LN_EPS);
#pragma unroll
        for (int g4 = 0; g4 < 4; ++g4) { const int dv = 32 * dvb + 8 * g4 + 4 * hh;
            *(LAS unsigned long long*)(Qt + (32 * tb + r) * MLP + dv * 2) = (unsigned long long)pk2((num[4 * g4] - mean) * rstd, (num[4 * g4 + 1] - mean) * rstd) | ((unsigned long long)pk2((num[4 * g4 + 2] - mean) * rstd, (num[4 * g4 + 3] - mean) * rstd) << 32); }
        __syncthreads();
#pragma unroll
        for (int q = 0; q < 2; ++q) { const int it = tid + q * NTHR, tt = it >> 4, c8 = it & 15, dv = c8 * 8;
            const v4u hv = *(const LAS v4u*)(Qt + tt * MLP + c8 * 16); float og[8]; cvt8_fp8(ogp[q], og);
            const f32x4 n0 = ngp[q][0], n1 = ngp[q][1];
            float o[8];
            o[0] = bf2f(hv.x & 0xffffu) * n0.x * sigmoidf_(og[0]); o[1] = bf2f(hv.x >> 16) * n0.y * sigmoidf_(og[1]);
            o[2] = bf2f(hv.y & 0xffffu) * n0.z * sigmoidf_(og[2]); o[3] = bf2f(hv.y >> 16) * n0.w * sigmoidf_(og[3]);
            o[4] = bf2f(hv.z & 0xffffu) * n1.x * sigmoidf_(og[4]); o[5] = bf2f(hv.z >> 16) * n1.y * sigmoidf_(og[5]);
            o[6] = bf2f(hv.w & 0xffffu) * n1.z * sigmoidf_(og[6]); o[7] = bf2f(hv.w >> 16) * n1.w * sigmoidf_(og[7]);
            *(unsigned long long*)(mix8 + (row0 + tt) * D + 512 + h * 128 + dv) = (unsigned long long)pk4_fp8(o[0], o[1], o[2], o[3]) | ((unsigned long long)pk4_fp8(o[4], o[5], o[6], o[7]) << 32); }
        prep_store(bgd, lane, bgv);
        __syncthreads();
    }
}

constexpr int VTP = 192;
template <int PITCH> __device__ __forceinline__ bf16x8v tr_frag_perm_p(const LAS unsigned char* tile, int row0, int col0, int lane) {
    const int i = lane & 15; const LAS unsigned char* p = tile + (row0 + (i >> 2)) * PITCH + (col0 + 4 * (i & 3)) * 2;
    const s16x4 lo = tr_read(p), hi = tr_read(p + 8 * PITCH);
    return __builtin_shufflevector(lo, hi, 0, 1, 2, 3, 4, 5, 6, 7);
}
__device__ __forceinline__ void attn_phase(const unsigned char* __restrict__ proj, unsigned char* __restrict__ mix8, LAS unsigned char* lds, int vb0, int nvb, const PrepArgs pa) {
    const int tid = threadIdx.x, lane = tid & 63, wave = __builtin_amdgcn_readfirstlane(tid >> 6);
    const int r = lane & 31, hh = lane >> 5, gsel = (lane >> 4) & 1;
    LAS unsigned char* Vt = lds + wave * (64 * VTP);
    bf16x8v ntri[2], nones;
#pragma unroll
    for (int s2 = 0; s2 < 2; ++s2)
#pragma unroll
        for (int j = 0; j < 8; ++j) { const int k = 16 * s2 + 8 * (j >> 2) + 4 * hh + (j & 3); ntri[s2][j] = (k >= r) ? (short)0xBF80 : (short)0; }
#pragma unroll
    for (int j = 0; j < 8; ++j) nones[j] = (short)0xBF80;
    for (int unit = vb0 * NWAVES + wave; unit < NB * 8 * (S / 32); unit += nvb * NWAVES) {
        const int bh = unit / (S / 32), qb = unit % (S / 32), b = bh >> 3, h = bh & 7, q0 = qb * 32;
        const unsigned char* base = proj + (size_t)b * S * NPROJ + h * 64;
        long qf[4];
#pragma unroll
        for (int s = 0; s < 4; ++s) qf[s] = *(const long*)(base + (size_t)(q0 + r) * NPROJ + C_SBQ + 16 * s + 8 * hh);
        f32x16 o[2];
#pragma unroll
        for (int d = 0; d < 2; ++d)
#pragma unroll
            for (int i = 0; i < 16; ++i) o[d][i] = 0.f;
        float carry = 0.f;
        const int qpos = q0 + r;
        const PrepDesc bgd = prep_decode(pa, IT_SMALL + BG_A + BG_C + unit); f32x4 bgv[16]; prep_load(bgd, lane, bgv);
        for (int k0 = q0 - 32; ; k0 -= 64) {
            long kf[2][4];
#pragma unroll
            for (int kb = 0; kb < 2; ++kb) { int key = k0 + 32 * kb + r; key = key < 0 ? 0 : key;
#pragma unroll
                for (int s = 0; s < 4; ++s) kf[kb][s] = *(const long*)(base + (size_t)key * NPROJ + C_SBK + 16 * s + 8 * hh); }
            unsigned long long vraw[8];
#pragma unroll
            for (int i = 0; i < 8; ++i) { int key = k0 + (lane >> 3) + 8 * i; key = key < 0 ? 0 : key; vraw[i] = *(const unsigned long long*)(base + (size_t)key * NPROJ + C_SBV + (lane & 7) * 8); }
#pragma unroll
            for (int i = 0; i < 8; ++i) { float vf[8]; cvt8_fp8(vraw[i], vf); *(LAS v4u*)(Vt + ((lane >> 3) + 8 * i) * VTP + (lane & 7) * 16) = pack8(vf); }
            f32x16 z[2];
#pragma unroll
            for (int kb = 0; kb < 2; ++kb) {
#pragma unroll
                for (int i = 0; i < 16; ++i) z[kb][i] = 0.f;
#pragma unroll
                for (int s = 0; s < 4; ++s) z[kb] = __builtin_amdgcn_mfma_f32_32x32x16_fp8_fp8(kf[kb][s], qf[s], z[kb], 0, 0, 0); }
            const bool need_mask = (k0 + 63 >= q0) || (k0 < 0);
            unsigned xp[2][8];
#pragma unroll
            for (int kb = 0; kb < 2; ++kb)
#pragma unroll
                for (int g4 = 0; g4 < 4; ++g4) { float sp[4];
#pragma unroll
                    for (int e = 0; e < 4; ++e) { const float zz = z[kb][4 * g4 + e];
                        float v = fmaxf(zz, 0.f) + __builtin_amdgcn_logf(1.f + __builtin_amdgcn_exp2f(-fabsf(zz)));
                        if (need_mask) { const int key = k0 + 32 * kb + 8 * g4 + 4 * hh + e; v = (key >= 0 && key < qpos) ? v : 0.f; }
                        sp[e] = v; }
                    xp[kb][2 * g4] = pk2(sp[0], sp[1]); xp[kb][2 * g4 + 1] = pk2(sp[2], sp[3]); }
            const float z00 = z[0][0];
#pragma unroll
            for (int s2 = 0; s2 < 2; ++s2) { v4u b1; b1.x = xp[1][4 * s2]; b1.y = xp[1][4 * s2 + 1]; b1.z = xp[1][4 * s2 + 2]; b1.w = xp[1][4 * s2 + 3];
                v4u b0; b0.x = xp[0][4 * s2]; b0.y = xp[0][4 * s2 + 1]; b0.z = xp[0][4 * s2 + 2]; b0.w = xp[0][4 * s2 + 3];
                z[1] = __builtin_amdgcn_mfma_f32_32x32x16_bf16(ntri[s2], __builtin_bit_cast(bf16x8v, b1), z[1], 0, 0, 0);
                z[0] = __builtin_amdgcn_mfma_f32_32x32x16_bf16(ntri[s2], __builtin_bit_cast(bf16x8v, b0), z[0], 0, 0, 0);
                z[0] = __builtin_amdgcn_mfma_f32_32x32x16_bf16(nones, __builtin_bit_cast(bf16x8v, b1), z[0], 0, 0, 0); }
            float tot = z00 - z[0][0];
            tot = __shfl(tot, r);
#pragma unroll
            for (int kb = 0; kb < 2; ++kb)
#pragma unroll
                for (int g4 = 0; g4 < 4; ++g4) { float p[4];
#pragma unroll
                    for (int e = 0; e < 4; ++e) { float v = __builtin_amdgcn_exp2f(z[kb][4 * g4 + e] - carry);
                        if (need_mask) { const int key = k0 + 32 * kb + 8 * g4 + 4 * hh + e; v = (key >= 0 && key < qpos) ? v : 0.f; }
                        p[e] = v; }
                    xp[kb][2 * g4] = pk2(p[0], p[1]); xp[kb][2 * g4 + 1] = pk2(p[2], p[3]); }
#pragma unroll
            for (int kb = 0; kb < 2; ++kb)
#pragma unroll
                for (int s2 = 0; s2 < 2; ++s2) { v4u bp; bp.x = xp[kb][4 * s2]; bp.y = xp[kb][4 * s2 + 1]; bp.z = xp[kb][4 * s2 + 2]; bp.w = xp[kb][4 * s2 + 3];
#pragma unroll
                    for (int d = 0; d < 2; ++d) { const bf16x8v Av = tr_frag_perm_p<VTP>(Vt, 32 * kb + 16 * s2 + 4 * hh, 32 * d + 16 * gsel, lane);
                        o[d] = __builtin_amdgcn_mfma_f32_32x32x16_bf16(Av, __builtin_bit_cast(bf16x8v, bp), o[d], 0, 0, 0); } }
            carry += tot;
            if (k0 <= 0) break;
            if (__all(carry > SB_THRESH)) break;
        }
#pragma unroll
        for (int d = 0; d < 2; ++d)
#pragma unroll
            for (int g4 = 0; g4 < 4; ++g4)
                *(LAS unsigned long long*)(Vt + r * 144 + (32 * d + 8 * g4 + 4 * hh) * 2) = (unsigned long long)pk2(o[d][4 * g4], o[d][4 * g4 + 1]) | ((unsigned long long)pk2(o[d][4 * g4 + 2], o[d][4 * g4 + 3]) << 32);
#pragma unroll
        for (int i = 0; i < 4; ++i) { const int row = (lane >> 3) + 8 * i;
            const v4u ov = *(const LAS v4u*)(Vt + row * 144 + (lane & 7) * 16);
            *(unsigned long long*)(mix8 + (size_t)(b * S + q0 + row) * D + h * 64 + (lane & 7) * 8) = (unsigned long long)pk4_fp8(bf2f(ov.x & 0xffffu), bf2f(ov.x >> 16), bf2f(ov.y & 0xffffu), bf2f(ov.y >> 16))
                | ((unsigned long long)pk4_fp8(bf2f(ov.z & 0xffffu), bf2f(ov.z >> 16), bf2f(ov.w & 0xffffu), bf2f(ov.w >> 16)) << 32); }
        prep_store(bgd, lane, bgv);
    }
}

__global__ void __launch_bounds__(NTHR, 2) mega_fwd(MArgs args) {
    extern __shared__ __attribute__((aligned(16))) unsigned char lds[];
    LAS unsigned char* ldsl = (LAS unsigned char*)lds;
    const int tid = threadIdx.x, G = gridDim.x;
    volatile LAS unsigned* MISC = (volatile LAS unsigned*)(ldsl + XTRA_OFF + X_MISC);
    LAS int* tb = (LAS int*)(ldsl + XTRA_OFF + X_TB); LAS int* nn = (LAS int*)(ldsl + XTRA_OFF + X_NN);
    for (int u = tid; u < (LDS_BYTES - XTRA_OFF) / 4; u += NTHR) ((LAS unsigned*)(ldsl + XTRA_OFF))[u] = 0u;
    __syncthreads();
    unsigned char* ws = args.ws;
    unsigned* ctl = (unsigned*)(ws + WS_CTL);
    XcdBarrier bar = xcd_barrier_post(ctl + CW_BAR, MISC + 8);
    const int lo = args.ph_lo, hi = args.ph_hi;
#define IN(k) (lo <= (k) && (k) < hi)
#ifndef REP_MASK
#define REP_MASK 0
#endif
#define PHASE(k, ...) do { if (IN(k)) { for (int rep_ = 0; rep_ < (((REP_MASK >> (k)) & 1) ? 2 : 1); ++rep_) { if (rep_) xcd_barrier(bar); __VA_ARGS__ } } if (IN(k) && IN((k) + 1)) xcd_barrier(bar); } while (0)
    int* cnt = (int*)ctl + CW_CNT; i32x2* list = (i32x2*)(ws + WS_ROUTE + 2 * MiB); float* topg = (float*)(ws + WS_ROUTE + 1 * MiB);
    PHASE(0, ph_mod_prep(args, lds, G););
    PHASE(1, ph_ln1(args, lds, G););
    PHASE(2, { pg8::StaticOrder So; So.init(ws + WS_U1, ws + WS_WTIN, T, NPROJ, D, G, blockIdx.x);
        pg8::EpiF8 E{(unsigned char*)(ws + WS_PROJ), NPROJ, 2, QSCALE, 1.f / 64.f};
        pg8::gemm_phase<pg8::EpiF8, pg8::StaticOrder, false, true>(ldsl, D, So, E); });
    PHASE(3, ml_phaseA(args, ldsl, blockIdx.x, G););
    PHASE(4, ml_phaseB(args, ldsl, blockIdx.x, G); __syncthreads(); attn_phase((const unsigned char*)(ws + WS_PROJ), (unsigned char*)(ws + WS_MIX), ldsl, blockIdx.x, G, MAKE_PREP_ARGS(args)););
    PHASE(5, ml_phaseC(args, ldsl, G););
    PHASE(6, { pg8::StaticOrder So; So.init(ws + WS_MIX, ws + WS_WTOUT, T, D, D, G, blockIdx.x);
        pg8::EpiBf16 E{(bf16*)(ws + WS_MIXOUT), D, 0, 1.f, 1.f / 64.f};
        pg8::gemm_phase<pg8::EpiBf16, pg8::StaticOrder, false, true>(ldsl, D, So, E); });
    PHASE(7, ph_ln2(args, G););
    PHASE(8, { pg8::StaticOrder So; So.init(ws + WS_U2, ws + WS_WTR, T, NE, 2 * D, G, blockIdx.x);
        pg8::EpiF32 E{(float*)(ws + WS_LOGITS), NE};
        pg8::gemm_phase<pg8::EpiF32, pg8::StaticOrder, false, false>(ldsl, 2 * D, So, E); });
    PHASE(9, { const int lane_ = tid & 63; const f32x4 bias4 = *(const f32x4*)(args.in[13] + 4 * lane_); const PrepArgs pa = MAKE_PREP_ARGS(args);
        LAS int* hist = (LAS int*)ldsl;
        if (tid < NE) hist[tid] = 0;
        __syncthreads();
        int bgit = IT_SMALL + BG_TOTAL + blockIdx.x * NWAVES + (tid >> 6);
        for (int t = blockIdx.x * NWAVES + (tid >> 6); t < T; t += G * NWAVES) {
            const bool bg = bgit < IT_TOTAL; PrepDesc bgd = prep_decode(pa, bg ? bgit : IT_SMALL); f32x4 bgv[16];
            if (bg) prep_load(bgd, lane_, bgv);
            route_wave(t, lane_, (const float*)(ws + WS_LOGITS), bias4, (int*)(ws + WS_ROUTE), topg, hist);
            if (bg) prep_store(bgd, lane_, bgv);
            bgit += G * NWAVES; }
        __syncthreads();
        if (tid < NE) { const int hv = hist[tid]; if (hv) atomicAdd(cnt + tid * CSTR, hv); }
        __syncthreads(); });
    PHASE(10, { moe_tables(cnt, tb, nn); const int* tope = (const int*)(ws + WS_ROUTE); int* fill = (int*)ctl + CW_FILL;
        LAS int* hist = (LAS int*)ldsl; LAS int* hbase = hist + NE;
        for (int id0 = blockIdx.x * NTHR; id0 < T * TOPK; id0 += G * NTHR) {
            if (tid < NE) hist[tid] = 0;
            __syncthreads();
            const int id = id0 + tid; const int e = tope[id];
            const int rank = __hip_atomic_fetch_add(hist + e, 1, __ATOMIC_RELAXED, __HIP_MEMORY_SCOPE_WORKGROUP);
            __syncthreads();
            if (tid < NE) { const int hv = hist[tid]; hbase[tid] = hv ? atomicAdd(fill + tid * CSTR, hv) : 0; }
            __syncthreads();
            list[tb[e] * 256 + hbase[e] + rank] = (i32x2){id, __float_as_int(topg[id])};
            __syncthreads(); } });
    PHASE(11, { moe_tables(cnt, tb, nn);
        pg8::MoeOrder So{G, (int)blockIdx.x, tb[NEX] * 2, 1, tb, nn, list, (const char*)(ws + WS_U2F8), 0, (const char*)(ws + WS_WT13), (size_t)512 * D, (size_t)256 * D};
        pg8::EpiGlu E{(unsigned char*)(ws + WS_H), 1.f / 64.f};
        pg8::gemm_phase<pg8::EpiGlu, pg8::MoeOrder, true, true>(ldsl, D, So, E); });
    PHASE(12, { moe_tables(cnt, tb, nn);
        pg8::MoeOrder So{G, (int)blockIdx.x, tb[NEX] * 4, 2, tb, nn, list, (const char*)(ws + WS_H), (size_t)256 * FF, (const char*)(ws + WS_WT2), (size_t)D * FF, (size_t)256 * FF};
        pg8::EpiScatter E{(unsigned char*)(ws + WS_YS), (unsigned char*)(ws + WS_YSH), list, nn};
        pg8::gemm_phase<pg8::EpiScatter, pg8::MoeOrder, false, true>(ldsl, FF, So, E); });
    PHASE(13, ph_final(args, G););
#undef PHASE
#undef IN
}

__global__ void k_nan_fill(float* out, int n) { for (int i = blockIdx.x * blockDim.x + threadIdx.x; i < n; i += gridDim.x * blockDim.x) out[i] = __builtin_nanf(""); }
extern "C" void kernel_launch(void* const* d_in, const int* in_sizes, int n_in, void* d_out, int out_size, void* d_ws, size_t ws_size, hipStream_t stream) {
    static int grid = 0;
    if (grid == 0) {
        int dev = 0, cus = 0, per_cu = 0; grid = -1;
        if (n_in != 22 || out_size != T * D || ws_size < WS_END) fprintf(stderr, "kernel_launch: unexpected shapes (n_in %d out %d ws %zu, need %zu)\n", n_in, out_size, ws_size, (size_t)WS_END);
        else if (hipGetDevice(&dev) != hipSuccess || hipDeviceGetAttribute(&cus, hipDeviceAttributeMultiprocessorCount, dev) != hipSuccess) fprintf(stderr, "kernel_launch: device query failed\n");
        else if (hipFuncSetAttribute((const void*)mega_fwd, hipFuncAttributeMaxDynamicSharedMemorySize, LDS_BYTES) != hipSuccess) fprintf(stderr, "kernel_launch: hipFuncSetAttribute failed\n");
        else if (hipOccupancyMaxActiveBlocksPerMultiprocessor(&per_cu, (const void*)mega_fwd, NTHR, LDS_BYTES) != hipSuccess || per_cu < 1) fprintf(stderr, "kernel_launch: occupancy query says %d blocks per CU\n", per_cu);
        else grid = cus;
        (void)hipGetLastError();
    }
    if (grid < 0) { k_nan_fill<<<1024, 256, 0, stream>>>((float*)d_out, out_size); return; }
    char* ws = (char*)d_ws;
    (void)hipMemsetAsync(ws + WS_CTL, 0, 1 * MiB, stream);
    MArgs a{};
    for (int i = 0; i < 22; ++i) a.in[i] = (const float*)d_in[i];
    a.out = (float*)d_out; a.ws = (unsigned char*)d_ws; a.ph_lo = 0; a.ph_hi = N_PHASES;
    hipLaunchKernelGGL(mega_fwd, dim3(grid), dim3(NTHR), LDS_BYTES, stream, a);
}
```

```cpp
#include <hip/hip_runtime.h>
#include <cstdio>
#include <cstdint>

typedef unsigned short bf16;
typedef unsigned v4u __attribute__((ext_vector_type(4)));
typedef float f32x4 __attribute__((ext_vector_type(4)));
typedef int i32x2 __attribute__((ext_vector_type(2)));
typedef float f32x2 __attribute__((ext_vector_type(2)));

constexpr int D = 1024, NB = 4, S = 8192, T = NB * S;
constexpr int NPROJ = 3584, WIN_LD = 3592;
constexpr int C_SBQ = 0, C_SBK = 512, C_SBV = 1024, C_MLQ = 1536, C_MLK = 2048, C_MLV = 2560, C_MLO = 3072, C_GATE = 3584;
constexpr int NE = 256, NEX = 257, TOPK = 8, FF = 256;
constexpr float LN_EPS = 1e-5f;
constexpr float DN_ALPHA = 1.189207115002721f;
constexpr float LOG2E = 1.4426950408889634f;
constexpr float QSCALE = 0.125f * LOG2E;
constexpr float SB_THRESH = 48.0f;

constexpr size_t MiB = 1u << 20;
constexpr size_t WS_CTL = 0;
constexpr size_t WS_MOD = 1 * MiB;
constexpr size_t WS_WTIN = 2 * MiB;
constexpr size_t WS_WTOUT = 10 * MiB;
constexpr size_t WS_WTR = 12 * MiB;
constexpr size_t WS_WT2 = 16 * MiB;
constexpr size_t WS_YS = 145 * MiB;
constexpr size_t WS_WT13 = 145 * MiB;
constexpr size_t WS_U2F8 = 274 * MiB;
constexpr size_t WS_PROJ = 490 * MiB;
constexpr size_t WS_GATES = 626 * MiB;
constexpr size_t WS_H = 402 * MiB;
constexpr size_t WS_X1 = 757 * MiB;
constexpr size_t WS_STATES = 657 * MiB;
constexpr size_t WS_MIXOUT = 657 * MiB;
constexpr size_t WS_LOGITS = 657 * MiB;
constexpr size_t WS_U1 = 725 * MiB;
constexpr size_t WS_MIX = 725 * MiB;
constexpr size_t WS_U2 = 833 * MiB;
constexpr size_t WS_YSH = 833 * MiB;
constexpr size_t WS_ROUTE = 897 * MiB;
constexpr size_t WS_END = 902 * MiB;
constexpr int CSTR = 32;
constexpr int CW_CNT = 16384;
constexpr int CW_FILL = 32768;

__device__ __forceinline__ unsigned f2bf(float f) { unsigned u = __builtin_bit_cast(unsigned, f); return (u + 0x7fffu + ((u >> 16) & 1u)) >> 16; }
__device__ __forceinline__ float bf2f(unsigned b) { return __builtin_bit_cast(float, b << 16); }
__device__ __forceinline__ unsigned pk2(float lo, float hi) { return f2bf(lo) | (f2bf(hi) << 16); }
__device__ __forceinline__ unsigned pk4_fp8(float a, float b, float c, float d) { int w = 0; w = __builtin_amdgcn_cvt_pk_fp8_f32(a, b, w, false); w = __builtin_amdgcn_cvt_pk_fp8_f32(c, d, w, true); return (unsigned)w; }
__device__ __forceinline__ float wave_sum(float v) {
    v += __builtin_bit_cast(float, __builtin_amdgcn_update_dpp(0, __builtin_bit_cast(int, v), 0xB1, 0xF, 0xF, true));
    v += __builtin_bit_cast(float, __builtin_amdgcn_update_dpp(0, __builtin_bit_cast(int, v), 0x4E, 0xF, 0xF, true));
    v += __builtin_bit_cast(float, __builtin_amdgcn_update_dpp(0, __builtin_bit_cast(int, v), 0x141, 0xF, 0xF, true));
    v += __builtin_bit_cast(float, __builtin_amdgcn_update_dpp(0, __builtin_bit_cast(int, v), 0x140, 0xF, 0xF, true));
    const int iv = __builtin_bit_cast(int, v);
    const float r0 = __builtin_bit_cast(float, __builtin_amdgcn_readlane(iv, 0)), r1 = __builtin_bit_cast(float, __builtin_amdgcn_readlane(iv, 16));
    const float r2 = __builtin_bit_cast(float, __builtin_amdgcn_readlane(iv, 32)), r3 = __builtin_bit_cast(float, __builtin_amdgcn_readlane(iv, 48));
    return (r0 + r1) + (r2 + r3);
}
__device__ __forceinline__ float sigmoidf_(float x) { return 1.f / (1.f + __expf(-x)); }
__device__ __forceinline__ float siluf_(float x) { return x / (1.f + __expf(-x)); }


struct PrepArgs { const float *w_in, *w_out, *w_router, *w1, *w3, *w2, *sw1, *sw3, *sw2; unsigned char* wtin; bf16 *wtout, *wtr; unsigned char* wt13; unsigned char* wt2; };
struct PrepDesc { const float* src; unsigned char* dst; int ldw, ldt, k0, n0, rowmap, f8; };
constexpr int IT_IN = 16 * 56, IT_OUT = 16 * 16, IT_R = 16 * 4, IT_E = 192, IT_TOTAL = IT_IN + IT_OUT + IT_R + NEX * IT_E;
__device__ __forceinline__ PrepDesc prep_decode(const PrepArgs& a, int it) {
    if (it < IT_IN) return PrepDesc{a.w_in, a.wtin, WIN_LD, D, (it / 112) * 128, (it % 112) * 32, 0, 1}; it -= IT_IN;
    if (it < IT_OUT) return PrepDesc{a.w_out, (unsigned char*)a.wtout, D, D, (it / 32) * 128, (it % 32) * 32, 0, 1}; it -= IT_OUT;
    if (it < IT_R) return PrepDesc{a.w_router, (unsigned char*)a.wtr, NE, D, (it / 4) * 64, (it % 4) * 64, 0, 0}; it -= IT_R;
    const int e = it / IT_E, r = it % IT_E;
    if (r < 64) return PrepDesc{e < NE ? a.w1 + (size_t)e * D * FF : a.sw1, a.wt13 + (size_t)e * 512 * D, FF, D, (r / 8) * 128, (r % 8) * 32, 1, 1};
    if (r < 128) { const int q = r - 64; return PrepDesc{e < NE ? a.w3 + (size_t)e * D * FF : a.sw3, a.wt13 + (size_t)e * 512 * D, FF, D, (q / 8) * 128, (q % 8) * 32, 2, 1}; }
    const int q = r - 128; return PrepDesc{e < NE ? a.w2 + (size_t)e * FF * D : a.sw2, a.wt2 + (size_t)e * D * FF, D, FF, (q / 32) * 128, (q % 32) * 32, 0, 1};
}
__device__ __forceinline__ void prep_load(const PrepDesc& d, int lane, f32x4 (&v)[16]) {
    const int g = d.f8 ? (lane >> 3) : (lane >> 4), i = d.f8 ? (lane & 7) : (lane & 15);
#pragma unroll
    for (int r = 0; r < 16; ++r) v[r] = __builtin_nontemporal_load((const f32x4*)(d.src + (size_t)(d.k0 + 16 * g + r) * d.ldw + d.n0 + 4 * i));
}
__device__ __forceinline__ void prep_store(const PrepDesc& d, int lane, const f32x4 (&v)[16]) {
    const int g = d.f8 ? (lane >> 3) : (lane >> 4), i = d.f8 ? (lane & 7) : (lane & 15);
#pragma unroll
    for (int nn = 0; nn < 4; ++nn) {
        const int n = d.n0 + 4 * i + nn;
        const int dr = d.rowmap == 0 ? n : ((n >> 7) * 256 + (d.rowmap == 2 ? 128 : 0) + (n & 127));
        if (d.f8) {
            v4u o; o.x = pk4_fp8(v[0][nn] * 64.f, v[1][nn] * 64.f, v[2][nn] * 64.f, v[3][nn] * 64.f); o.y = pk4_fp8(v[4][nn] * 64.f, v[5][nn] * 64.f, v[6][nn] * 64.f, v[7][nn] * 64.f);
            o.z = pk4_fp8(v[8][nn] * 64.f, v[9][nn] * 64.f, v[10][nn] * 64.f, v[11][nn] * 64.f); o.w = pk4_fp8(v[12][nn] * 64.f, v[13][nn] * 64.f, v[14][nn] * 64.f, v[15][nn] * 64.f);
            *(v4u*)(d.dst + (size_t)dr * d.ldt + d.k0 + 16 * g) = o;
        } else {
            v4u o0, o1; o0.x = pk2(v[0][nn], v[1][nn]); o0.y = pk2(v[2][nn], v[3][nn]); o0.z = pk2(v[4][nn], v[5][nn]); o0.w = pk2(v[6][nn], v[7][nn]);
            o1.x = pk2(v[8][nn], v[9][nn]); o1.y = pk2(v[10][nn], v[11][nn]); o1.z = pk2(v[12][nn], v[13][nn]); o1.w = pk2(v[14][nn], v[15][nn]);
            v4u* dp = (v4u*)((bf16*)d.dst + (size_t)dr * d.ldt + d.k0 + 16 * g); dp[0] = o0; dp[1] = o1;
        }
    }
}
constexpr int IT_SMALL = IT_IN + IT_OUT + IT_R;
constexpr int BG_A = 16 * (S / 64) * 8, BG_C = BG_A, BG_T = NB * 8 * (S / 32), BG_TOTAL = BG_A + BG_C + BG_T;
constexpr int IT_FG = IT_SMALL;
static_assert(IT_SMALL + BG_TOTAL <= IT_TOTAL, "background slots exceed the expert items");
__device__ __forceinline__ int prep_fg_item(int j) { return j < IT_SMALL ? j : j + BG_TOTAL; }
__device__ __forceinline__ void prep_run(const PrepArgs& a, int it0, int stride, int lane) {
    int it = it0; if (it >= IT_FG) return;
    PrepDesc dA = prep_decode(a, prep_fg_item(it)), dB = dA; f32x4 va[16], vb[16]; prep_load(dA, lane, va);
    for (;;) {
        const int itB = it + stride; const bool hasB = itB < IT_FG;
        if (hasB) { dB = prep_decode(a, prep_fg_item(itB)); prep_load(dB, lane, vb); }
        prep_store(dA, lane, va);
        if (!hasB) break;
        const int itA = itB + stride; const bool hasA = itA < IT_FG;
        if (hasA) { dA = prep_decode(a, prep_fg_item(itA)); prep_load(dA, lane, va); }
        prep_store(dB, lane, vb);
        if (!hasA) break;
        it = itA;
    }
}


__device__ __forceinline__ f32x4 ld_bf4(const bf16* p) { const unsigned long long w = *(const unsigned long long*)p;
    return (f32x4){bf2f((unsigned)w & 0xffffu), bf2f(((unsigned)w) >> 16), bf2f((unsigned)(w >> 32) & 0xffffu), bf2f((unsigned)(w >> 48))}; }

#define LAS __attribute__((address_space(3)))
#define GAS __attribute__((address_space(1)))
namespace pg8 {
typedef short bf16x8 __attribute__((ext_vector_type(8)));
constexpr int F8_SCALE_W = 121;
constexpr int BM = 256, BK = 64, HALF = 128, HTB = HALF * BK * 2, STAGE_BYTES = 8 * HTB, NXCD = 8, WGM = 8;
__host__ __device__ __forceinline__ int lds_byte(int r, int c) { const int st = (r >> 4) * 2 + (c >> 5), rr = r & 15, cc = c & 31, ob = rr * 64 + cc * 2; return st * 1024 + (ob ^ (((ob >> 9) & 1) << 5)); }
__host__ __device__ __forceinline__ void stage_rc(int b, int& R, int& C) { const int st = b / 1024, sb = b % 1024, swz = sb ^ (((sb >> 9) & 1) << 5); R = (st >> 1) * 16 + swz / 64; C = (st & 1) * 32 + (swz % 64) / 2; }
__host__ __device__ __forceinline__ int perm16x(int R) { return 64 * (R >> 5) + 16 * ((R & 15) >> 2) + 4 * ((R >> 4) & 1) + (R & 3); }
__host__ __device__ __forceinline__ int perm32(int rho) { const int n = rho >> 4, i = rho & 15; return 8 * (i >> 2) + 4 * n + (i & 3); }

struct Unit { int pm, pn, e, mt; const char* A; const char* B; };

__device__ __forceinline__ long unit_index(int i, int G, int c) { return (G % 8 == 0) ? ((long)(i * 8 + (c & 7)) * (G / 8) + (c >> 3)) : ((long)i * G + c); }

struct StaticOrder {
    int nM, nN, nwg, G, c; const char* A; const char* B; size_t tstep;
    __device__ void init(const void* A_, const void* B_, int M, int N, int Kb, int G_, int c_) { nM = M / BM; nN = N / BM; nwg = nM * nN; G = G_; c = c_; A = (const char*)A_; B = (const char*)B_; tstep = (size_t)BM * Kb; }
    __device__ __forceinline__ bool next(int i, Unit& u) const {
        const long L = (long)i * G + c; if (L >= nwg) return false;
        int wgid = (int)L; { const int q = nwg / NXCD, r = nwg % NXCD, xcd = wgid % NXCD, off = wgid / NXCD; wgid = (xcd < r ? xcd * (q + 1) : r * (q + 1) + (xcd - r) * q) + off; }
        const int nig = WGM * nN, gid = wgid / nig, fm = gid * WGM, gsz = (nM - fm) < WGM ? (nM - fm) : WGM;
        u.pm = fm + ((wgid % nig) % gsz); u.pn = (wgid % nig) / gsz; u.e = 0; u.mt = u.pm; u.A = A + (size_t)u.pm * tstep; u.B = B + (size_t)u.pn * tstep; return true;
    }
    __device__ __forceinline__ int row_token(const Unit&, int) const { return 0; }
};

struct MoeOrder {
    int G, c, total, shift; const LAS int* tb; const LAS int* nn; const i32x2* list;
    const char* Abase; size_t a_tile_stride; const char* Bbase; size_t b_exp_stride, b_pn_stride;
    __device__ __forceinline__ bool next(int i, Unit& u) const {
        const long L = unit_index(i, G, c); if (L >= total) return false;
        const int tile = (int)(L >> shift); u.pn = (int)(L & ((1 << shift) - 1));
        int lo = 0, hi = NEX; while (hi - lo > 1) { const int mid = (lo + hi) >> 1; if (tb[mid] <= tile) lo = mid; else hi = mid; }
        u.e = lo; u.mt = tile - tb[lo]; u.pm = tile;
        u.A = Abase + (size_t)tile * a_tile_stride; u.B = Bbase + (size_t)lo * b_exp_stride + (size_t)u.pn * b_pn_stride; return true;
    }
    __device__ __forceinline__ int row_token(const Unit& u, int row) const {
        const int rr = u.mt * 256 + row;
        const int tok = list[u.pm * 256 + row].x >> 3;
        return u.e >= NE ? rr : (rr < nn[u.e] ? tok : 0);
    }
};

__device__ __forceinline__ unsigned cvt_pk_bf16(float lo, float hi) { unsigned r; asm volatile("v_cvt_pk_bf16_f32 %0, %1, %2" : "=v"(r) : "v"(lo), "v"(hi)); return r; }

struct EpiBf16 {
    static constexpr int PERM = 2; static constexpr bool PREFETCH = false; bf16* O; int ldc; int scale_tiles; float scale; float gscale;
    __device__ __forceinline__ void operator()(const f32x4 (&acc)[2][2][4][2], const Unit& u, int wr, int wc, int fr, int fq) const {
        const int row0 = u.pm * BM + wr * 64 + fr, col0 = u.pn * BM + wc * 64 + 16 * fq; const float sc = (u.pn < scale_tiles ? scale : 1.f) * gscale;
#pragma unroll
        for (int ai = 0; ai < 2; ++ai)
#pragma unroll
            for (int m = 0; m < 4; ++m) { bf16* rowp = O + (size_t)(row0 + ai * HALF + m * 16) * ldc + col0;
#pragma unroll
                for (int bj = 0; bj < 2; ++bj) { const f32x4 v0 = acc[ai][bj][m][0] * sc, v1 = acc[ai][bj][m][1] * sc;
                    v4u w; w.x = cvt_pk_bf16(v0[0], v0[1]); w.y = cvt_pk_bf16(v0[2], v0[3]); w.z = cvt_pk_bf16(v1[0], v1[1]); w.w = cvt_pk_bf16(v1[2], v1[3]);
                    *(v4u*)(rowp + bj * 8) = w; } }
    }
};
struct EpiF8 {
    static constexpr int PERM = 2; static constexpr bool PREFETCH = false; unsigned char* O; int ldc; int scale_tiles; float scale; float gscale;
    __device__ __forceinline__ void operator()(const f32x4 (&acc)[2][2][4][2], const Unit& u, int wr, int wc, int fr, int fq) const {
        const int row0 = u.pm * BM + wr * 64 + fr, col0 = u.pn * BM + wc * 64 + 16 * fq; const float sc = (u.pn < scale_tiles ? scale : 1.f) * gscale;
#pragma unroll
        for (int ai = 0; ai < 2; ++ai)
#pragma unroll
            for (int m = 0; m < 4; ++m) { const f32x4 a0 = acc[ai][0][m][0] * sc, a1 = acc[ai][0][m][1] * sc, b0 = acc[ai][1][m][0] * sc, b1 = acc[ai][1][m][1] * sc;
                v4u w; w.x = pk4_fp8(a0[0], a0[1], a0[2], a0[3]); w.y = pk4_fp8(a1[0], a1[1], a1[2], a1[3]); w.z = pk4_fp8(b0[0], b0[1], b0[2], b0[3]); w.w = pk4_fp8(b1[0], b1[1], b1[2], b1[3]);
                *(v4u*)(O + (size_t)(row0 + ai * HALF + m * 16) * ldc + col0) = w; }
    }
};
struct EpiF32 {
    static constexpr int PERM = 0; static constexpr bool PREFETCH = false; float* C; int ldc;
    __device__ __forceinline__ void operator()(const f32x4 (&acc)[2][2][4][2], const Unit& u, int wr, int wc, int fr, int fq) const {
        const int row0 = u.pm * BM + wr * 64 + fr, col0 = u.pn * BM + wc * 32 + 4 * fq;
#pragma unroll
        for (int ai = 0; ai < 2; ++ai)
#pragma unroll
            for (int m = 0; m < 4; ++m) { float* rowp = C + (size_t)(row0 + ai * HALF + m * 16) * ldc + col0;
#pragma unroll
                for (int bj = 0; bj < 2; ++bj)
#pragma unroll
                    for (int n = 0; n < 2; ++n) *(f32x4*)(rowp + bj * HALF + n * 16) = acc[ai][bj][m][n]; }
    }
};
struct EpiGlu {
    static constexpr int PERM = 1; static constexpr bool PREFETCH = false; unsigned char* H; float gscale;
    __device__ __forceinline__ void operator()(const f32x4 (&acc)[2][2][4][2], const Unit& u, int wr, int wc, int fr, int fq) const {
        const int row0 = u.pm * BM + wr * 64 + fr, col0 = u.pn * HALF + wc * 32 + 8 * fq;
#pragma unroll
        for (int ai = 0; ai < 2; ++ai)
#pragma unroll
            for (int m = 0; m < 4; ++m) { float h[8];
#pragma unroll
                for (int n = 0; n < 2; ++n)
#pragma unroll
                    for (int q = 0; q < 4; ++q) { const float a = acc[ai][0][m][n][q] * gscale; h[n * 4 + q] = a * __builtin_amdgcn_rcpf(1.f + __expf(-a)) * (acc[ai][1][m][n][q] * gscale); }
                *(unsigned long long*)(H + (size_t)(row0 + ai * HALF + m * 16) * FF + col0) = (unsigned long long)pk4_fp8(h[0], h[1], h[2], h[3]) | ((unsigned long long)pk4_fp8(h[4], h[5], h[6], h[7]) << 32); }
    }
};
struct EpiScatter {
    static constexpr int PERM = 2; static constexpr bool PREFETCH = true; unsigned char* ys8; unsigned char* ysh8; const i32x2* list; const LAS int* nn;
    __device__ __forceinline__ void prefetch(const Unit& u, int wr, int fr, i32x2 (&pf)[8]) const {
        const i32x2* lp = list + (size_t)(u.pm - u.mt) * 256;
#pragma unroll
        for (int q = 0; q < 8; ++q) pf[q] = lp[u.mt * 256 + (q >> 2) * HALF + wr * 64 + (q & 3) * 16 + fr];
    }
    __device__ __forceinline__ void operator()(const f32x4 (&acc)[2][2][4][2], const Unit& u, int wr, int wc, int fr, int fq, const i32x2 (&pf)[8]) const {
        const int col0 = u.pn * BM + wc * 64 + 16 * fq; const int n = nn[u.e]; const bool routed = u.e < NE;
#pragma unroll
        for (int ai = 0; ai < 2; ++ai)
#pragma unroll
            for (int m = 0; m < 4; ++m) { const int rr = u.mt * 256 + ai * HALF + wr * 64 + m * 16 + fr;
                if (rr < n) { const int id = routed ? pf[ai * 4 + m].x : rr; const float g = (routed ? __int_as_float(pf[ai * 4 + m].y) : 1.f) * (16.f / 64.f);
                    const f32x4 a0 = acc[ai][0][m][0] * g, a1 = acc[ai][0][m][1] * g, b0 = acc[ai][1][m][0] * g, b1 = acc[ai][1][m][1] * g;
                    v4u w; w.x = pk4_fp8(a0[0], a0[1], a0[2], a0[3]); w.y = pk4_fp8(a1[0], a1[1], a1[2], a1[3]); w.z = pk4_fp8(b0[0], b0[1], b0[2], b0[3]); w.w = pk4_fp8(b1[0], b1[1], b1[2], b1[3]);
                    *(v4u*)((routed ? ys8 : ysh8) + (size_t)id * D + col0) = w; } }
    }
};

typedef int i32x8 __attribute__((ext_vector_type(8)));
typedef int i32x4 __attribute__((ext_vector_type(4)));
template <bool FP8> struct FragT { struct A4 { bf16x8 v[4][2]; }; struct B2 { bf16x8 v[2][2]; }; };
template <> struct FragT<true> { struct A4 { i32x8 v[4]; }; struct B2 { i32x8 v[2]; }; };
template <class Epi, class Sched, bool GATHER, bool FP8>
__device__ __forceinline__ void gemm_phase(LAS unsigned char* lds, const int Kb, const Sched& S, const Epi& E) {
    const int tid = threadIdx.x, wid = __builtin_amdgcn_readfirstlane(tid >> 6), lane = tid & 63, wr = wid >> 2, wc = wid & 3, fr = lane & 15, fq = lane >> 4;
    const int nt = Kb / 128;
    int sR[2], sC[2];
    unsigned voffA[2], voffB[2];
#pragma unroll
    for (int i = 0; i < 2; ++i) { stage_rc(tid * 16 + i * 8192, sR[i], sC[i]); const int Rb = Epi::PERM == 2 ? perm16x(sR[i]) : (Epi::PERM == 1 ? ((sR[i] & ~31) + perm32(sR[i] & 31)) : sR[i]);
        voffA[i] = (unsigned)(sR[i] * Kb + sC[i] * 2); voffB[i] = (unsigned)(Rb * Kb + sC[i] * 2); }
    const size_t kstep = (size_t)(BK * 2);
    const size_t hstep = (size_t)HALF * Kb;
    const size_t bhstep = Epi::PERM == 2 ? (size_t)8 * Kb : hstep;
    const unsigned ldsw = (unsigned)wid * 1024u;
    const int aoff = lds_byte(wr * 64 + fr, fq * 8), boff = lds_byte(wc * 32 + fr, fq * 8);
    unsigned gc[2][2], gn[2][2];
#define PG8_SA(b, h) (((b) * 2 + (h)) * HTB)
#define PG8_SB(b, h) ((4 + (b) * 2 + (h)) * HTB)
#define PG8_GLDS(src, bufoff, i) __builtin_amdgcn_global_load_lds((const unsigned*)(src), (LAS unsigned*)(lds + (bufoff) + ldsw + (i) * 8192), 16, 0, 0)
#define PG8_STAGE_B(bufoff, gbase) do { PG8_GLDS((const char*)(gbase) + voffB[0], bufoff, 0); PG8_GLDS((const char*)(gbase) + voffB[1], bufoff, 1); } while (0)
#define PG8_STAGE_A(bufoff, gbase, h, nx) do { if constexpr (GATHER) { const unsigned _o0 = (nx) ? gn[h][0] : gc[h][0], _o1 = (nx) ? gn[h][1] : gc[h][1]; \
            PG8_GLDS((const char*)(gbase) + _o0, bufoff, 0); PG8_GLDS((const char*)(gbase) + _o1, bufoff, 1); } \
        else { PG8_GLDS((const char*)(gbase) + (h) * hstep + voffA[0], bufoff, 0); PG8_GLDS((const char*)(gbase) + (h) * hstep + voffA[1], bufoff, 1); } } while (0)
#define PG8_LD2(dstv, p) do { if constexpr (FP8) { const i32x4 _lo = *(const LAS i32x4*)(p), _hi = *(const LAS i32x4*)((p) + 1024); dstv = __builtin_shufflevector(_lo, _hi, 0, 1, 2, 3, 4, 5, 6, 7); } } while (0)
#define PG8_LDA(dst, b, h) do { _Pragma("unroll") for (int m = 0; m < 4; ++m) { if constexpr (FP8) { PG8_LD2(dst.v[m], lds + PG8_SA(b, h) + aoff + m * 2048); } \
        else { _Pragma("unroll") for (int k = 0; k < 2; ++k) dst.v[m][k] = *(const LAS bf16x8*)(lds + PG8_SA(b, h) + aoff + m * 2048 + k * 1024); } } } while (0)
#define PG8_LDB(dst, b, h) do { _Pragma("unroll") for (int n = 0; n < 2; ++n) { if constexpr (FP8) { PG8_LD2(dst.v[n], lds + PG8_SB(b, h) + boff + n * 2048); } \
        else { _Pragma("unroll") for (int k = 0; k < 2; ++k) dst.v[n][k] = *(const LAS bf16x8*)(lds + PG8_SB(b, h) + boff + n * 2048 + k * 1024); } } } while (0)
#define PG8_MMA(ai, bj, At, Bt) do { __builtin_amdgcn_s_setprio(1); _Pragma("unroll") for (int m = 0; m < 4; ++m) _Pragma("unroll") for (int n = 0; n < 2; ++n) { \
        if constexpr (FP8) asm volatile("s_nop 1\n\tv_mfma_scale_f32_16x16x128_f8f6f4 %0, %1, %2, %0, %3, %3 op_sel_hi:[0,0,0]" : "+v"(acc[ai][bj][m][n]) : "v"(Bt.v[n]), "v"(At.v[m]), "v"(f8scale)); \
        else { _Pragma("unroll") for (int k = 0; k < 2; ++k) acc[ai][bj][m][n] = __builtin_amdgcn_mfma_f32_16x16x32_bf16(Bt.v[n][k], At.v[m][k], acc[ai][bj][m][n], 0, 0, 0); } } \
        __builtin_amdgcn_s_setprio(0); } while (0)
#define PG8_WAIT_V(n) asm volatile("s_waitcnt vmcnt(" #n ")" ::: "memory")
#define PG8_WAIT_L(n) asm volatile("s_waitcnt lgkmcnt(" #n ")" ::: "memory")
#define PG8_BAR __builtin_amdgcn_s_barrier()
#define PG8_SCHED __builtin_amdgcn_sched_barrier(0)
#define PG8_GATHER(dst, u) do { _Pragma("unroll") for (int _h = 0; _h < 2; ++_h) _Pragma("unroll") for (int _i = 0; _i < 2; ++_i) \
        dst[_h][_i] = (unsigned)(S.row_token(u, _h * HALF + sR[_i]) * Kb + sC[_i] * 2); } while (0)
    Unit cur, nxt; int ui = 0;
    if (!S.next(0, cur)) return;
    f32x4 acc[2][2][4][2];
#pragma unroll
    for (int a = 0; a < 2; ++a)
#pragma unroll
        for (int b = 0; b < 2; ++b)
#pragma unroll
            for (int m = 0; m < 4; ++m)
#pragma unroll
                for (int n = 0; n < 2; ++n) acc[a][b][m][n] = (f32x4){0.f, 0.f, 0.f, 0.f};
    const int f8scale = 0x7f7f7f7f;
    typedef typename FragT<FP8>::A4 FragA; typedef typename FragT<FP8>::B2 FragB;
    FragA At; FragB B0, B1;
    const char* cA = cur.A; const char* cB = cur.B;
    i32x2 pf[8];
    if constexpr (Epi::PREFETCH) E.prefetch(cur, wr, fr, pf);
    if constexpr (GATHER) { PG8_GATHER(gc, cur); }
    PG8_STAGE_B(PG8_SB(0, 0), cB); PG8_STAGE_A(PG8_SA(0, 0), cA, 0, false); PG8_STAGE_B(PG8_SB(0, 1), cB + bhstep); PG8_STAGE_A(PG8_SA(0, 1), cA, 1, false);
    if (wr == 1) PG8_BAR;
    PG8_WAIT_V(4); PG8_BAR;
    PG8_STAGE_B(PG8_SB(1, 0), cB + kstep); PG8_STAGE_A(PG8_SA(1, 0), cA + kstep, 0, false); PG8_STAGE_B(PG8_SB(1, 1), cB + bhstep + kstep);
    PG8_WAIT_V(6); PG8_BAR;
    for (;;) {
        const bool has_next = S.next(ui + 1, nxt);
        const char* nA = has_next ? nxt.A : cA; const char* nB = has_next ? nxt.B : cB;
        if constexpr (GATHER) { if (has_next) { PG8_GATHER(gn, nxt); } else {
#pragma unroll
            for (int h = 0; h < 2; ++h) { gn[h][0] = gc[h][0]; gn[h][1] = gc[h][1]; } } }
#pragma unroll 1
        for (int t = 0; t < nt; t += 2) {
            const bool last = (t == nt - 2);
            const char* a1 = cA + (size_t)(t + 1) * kstep;
            const char* a2 = last ? nA : cA + (size_t)(t + 2) * kstep; const char* b2 = last ? nB : cB + (size_t)(t + 2) * kstep;
            const char* a3 = a2 + kstep; const char* b3 = b2 + kstep;
            PG8_LDB(B0, 0, 0); PG8_SCHED; PG8_LDA(At, 0, 0); PG8_STAGE_A(PG8_SA(1, 1), a1, 1, false);
            PG8_WAIT_L(8); PG8_BAR; PG8_WAIT_L(0); PG8_MMA(0, 0, At, B0); PG8_BAR; PG8_SCHED;
            PG8_LDB(B1, 0, 1); PG8_STAGE_B(PG8_SB(0, 0), b2);
            PG8_BAR; PG8_WAIT_L(0); PG8_MMA(0, 1, At, B1); PG8_BAR;
            PG8_LDA(At, 0, 1); PG8_STAGE_A(PG8_SA(0, 0), a2, 0, last);
            PG8_BAR; PG8_WAIT_L(0); PG8_MMA(1, 0, At, B0); PG8_BAR; PG8_SCHED;
            PG8_STAGE_B(PG8_SB(0, 1), b2 + bhstep);
            PG8_WAIT_V(6); PG8_BAR; PG8_MMA(1, 1, At, B1); PG8_BAR;
            PG8_LDB(B0, 1, 0); PG8_SCHED; PG8_LDA(At, 1, 0); PG8_STAGE_A(PG8_SA(0, 1), a2, 1, last);
            PG8_WAIT_L(8); PG8_BAR; PG8_WAIT_L(0); PG8_MMA(0, 0, At, B0); PG8_BAR; PG8_SCHED;
            PG8_LDB(B1, 1, 1); PG8_STAGE_B(PG8_SB(1, 0), b3);
            PG8_BAR; PG8_WAIT_L(0); PG8_MMA(0, 1, At, B1); PG8_BAR;
            PG8_LDA(At, 1, 1); PG8_STAGE_A(PG8_SA(1, 0), a3, 0, last);
            PG8_BAR; PG8_WAIT_L(0); PG8_MMA(1, 0, At, B0); PG8_BAR; PG8_SCHED;
            PG8_STAGE_B(PG8_SB(1, 1), b3 + bhstep);
            PG8_WAIT_V(6); PG8_BAR; PG8_MMA(1, 1, At, B1); PG8_BAR;
        }
        if (wr == 0) PG8_BAR;
        if constexpr (FP8) { __builtin_amdgcn_sched_barrier(0); asm volatile("s_nop 15\n\ts_nop 7" ::: "memory"); __builtin_amdgcn_sched_barrier(0); }
        if constexpr (Epi::PREFETCH) E(acc, cur, wr, wc, fr, fq, pf); else E(acc, cur, wr, wc, fr, fq);
        if (!has_next) break;
#pragma unroll
        for (int a = 0; a < 2; ++a)
#pragma unroll
            for (int b = 0; b < 2; ++b)
#pragma unroll
                for (int m = 0; m < 4; ++m)
#pragma unroll
                    for (int n = 0; n < 2; ++n) acc[a][b][m][n] = (f32x4){0.f, 0.f, 0.f, 0.f};
        cur = nxt; cA = nA; cB = nB; ++ui;
        if constexpr (Epi::PREFETCH) E.prefetch(cur, wr, fr, pf);
        if (wr == 1) PG8_BAR;
        if constexpr (GATHER) {
#pragma unroll
            for (int h = 0; h < 2; ++h) { gc[h][0] = gn[h][0]; gc[h][1] = gn[h][1]; } }
    }
    PG8_WAIT_V(0);
    PG8_BAR;
#undef PG8_SA
#undef PG8_SB
#undef PG8_GLDS
#undef PG8_STAGE_A
#undef PG8_STAGE_B
#undef PG8_LDA
#undef PG8_LDB
#undef PG8_MMA
#undef PG8_WAIT_V
#undef PG8_WAIT_L
#undef PG8_BAR
#undef PG8_SCHED
#undef PG8_GATHER
}
}

#define XB_TMO      128
#define XB_XCNT(j)  (256  + 64 * (j))
#define XB_XSUB(j)  (1280 + 64 * (j))
#define XB_XGEN(j)  (2304 + 64 * (j))
#define XB_TOP      3328
#define XB_TOPGEN   3392
#define XCD_BAR_WORDS 3456
#define XB_SPIN_CAP (1u << 22)
__device__ __forceinline__ unsigned xb_ld(unsigned* p)              { return __hip_atomic_load(p, __ATOMIC_RELAXED, __HIP_MEMORY_SCOPE_AGENT); }
__device__ __forceinline__ unsigned xb_add(unsigned* p, unsigned v) { return __hip_atomic_fetch_add(p, v, __ATOMIC_RELAXED, __HIP_MEMORY_SCOPE_AGENT); }
__device__ __forceinline__ unsigned xb_xcc_id() { return (unsigned)__builtin_amdgcn_s_getreg((3 << 11) | 20) & 0xFu; }
#define XB_SPIN(cond, bar) do { unsigned _sp = 0; while (cond) { __builtin_amdgcn_s_sleep(1); \
    if ((++_sp & 255u) == 0u) { if (xb_ld(&(bar)[XB_TMO])) break; if (_sp > XB_SPIN_CAP) { atomicAdd(&(bar)[XB_TMO], 1u); break; } } } } while (0)
struct XcdBarrier { unsigned* bar; unsigned x; volatile LAS unsigned* st; };
__device__ __forceinline__ XcdBarrier xcd_barrier_post(unsigned* bar, volatile LAS unsigned* st) {
    XcdBarrier b; b.bar = bar; b.x = xb_xcc_id(); b.st = st;
    if (threadIdx.x == 0) (void)xb_add(&bar[XB_XCNT(b.x)], 1u);
    return b;
}
__device__ __forceinline__ void xcd_barrier_complete(unsigned* bar, unsigned x, unsigned& nloc, unsigned& nx) {
    const unsigned G = gridDim.x * gridDim.y * gridDim.z;
    unsigned sum, cnt, mine, sp = 0u;
    for (;;) {
        sum = 0u; cnt = 0u; mine = 0u;
#pragma unroll
        for (unsigned j = 0; j < 16; ++j) { const unsigned c = xb_ld(&bar[XB_XCNT(j)]); sum += c; cnt += (c > 0u) ? 1u : 0u; mine = (j == x) ? c : mine; }
        if (sum == G) break;
        __builtin_amdgcn_s_sleep(1);
        if ((++sp & 255u) == 0u) { if (xb_ld(&bar[XB_TMO])) break; if (sp > XB_SPIN_CAP) { atomicAdd(&bar[XB_TMO], 1u); break; } }
    }
    nloc = mine > 0u ? mine : 1u; nx = cnt > 0u ? cnt : 1u;
}
__device__ __forceinline__ void xcd_barrier(const XcdBarrier& b) {
    asm volatile("s_waitcnt vmcnt(0)" ::: "memory");
    __syncthreads();
    if (threadIdx.x == 0) {
        unsigned* bar = b.bar;
        __builtin_amdgcn_s_waitcnt(0);
        unsigned nloc = b.st[0], nx = b.st[1];
        if (nloc == 0u) { xcd_barrier_complete(bar, b.x, nloc, nx); b.st[0] = nloc; b.st[1] = nx; }
        const unsigned old = xb_add(&bar[XB_XSUB(b.x)], 1u);
        const unsigned gen = old / nloc;
        if (old + 1u == (gen + 1u) * nloc) {
            __builtin_amdgcn_fence(__ATOMIC_RELEASE, "agent");
            asm volatile("s_waitcnt vmcnt(0)" ::: "memory");
            const unsigned og = xb_add(&bar[XB_TOP], 1u);
            const unsigned tg = og / nx;
            if (og + 1u == (tg + 1u) * nx) xb_add(&bar[XB_TOPGEN], 1u);
            else XB_SPIN(xb_ld(&bar[XB_TOPGEN]) == tg, bar);
            __builtin_amdgcn_fence(__ATOMIC_ACQUIRE, "agent");
            xb_add(&bar[XB_XGEN(b.x)], 1u);
            asm volatile("s_waitcnt vmcnt(0)" ::: "memory");
        } else {
            XB_SPIN(xb_ld(&bar[XB_XGEN(b.x)]) == gen, bar);
            __builtin_amdgcn_fence(__ATOMIC_ACQUIRE, "agent");
            asm volatile("s_waitcnt vmcnt(0)" ::: "memory");
        }
    }
    __syncthreads();
}

constexpr int NWAVES = 8, NTHR = 512;
constexpr int RING_BYTES = 131072, XTRA_OFF = RING_BYTES, LDS_BYTES = 147456;
constexpr int X_MISC = 0, X_TB = 256, X_NN = 1536;
constexpr int CW_BAR = 4096;
constexpr int N_PHASES = 14;
struct MArgs { const float* in[22]; float* out; unsigned char* ws; int ph_lo, ph_hi; };

#define MAKE_PREP_ARGS(a) PrepArgs{(a).in[4], (a).in[9], (a).in[12], (a).in[14], (a).in[15], (a).in[16], (a).in[17], (a).in[18], (a).in[19], \
    (unsigned char*)((a).ws + WS_WTIN), (bf16*)((a).ws + WS_WTOUT), (bf16*)((a).ws + WS_WTR), (unsigned char*)((a).ws + WS_WT13), (unsigned char*)((a).ws + WS_WT2)}
__device__ __forceinline__ void ph_mod_prep(const MArgs& a, unsigned char* smem, int G) {
    const int tid = threadIdx.x;
    unsigned char* ws = a.ws;
    if ((int)blockIdx.x < 192) {
        float* sc = (float*)smem; float* red = sc + NB * D;
        const float* c = a.in[1]; const float* w_ada = a.in[2]; const float* b_ada = a.in[3]; float* mod = (float*)(ws + WS_MOD);
        for (int i = tid; i < NB * D; i += NTHR) sc[i] = siluf_(c[i]);
        __syncthreads();
        for (int it = blockIdx.x; it < 192; it += G) {
            const int kq = tid >> 5, jl = tid & 31, j = it * 32 + jl;
            float a0 = 0.f, a1 = 0.f, a2 = 0.f, a3 = 0.f;
#pragma unroll 16
            for (int kk = 0; kk < 64; ++kk) { const int k = kq * 64 + kk; const float w = w_ada[(size_t)k * 6144 + j];
                a0 += sc[k] * w; a1 += sc[D + k] * w; a2 += sc[2 * D + k] * w; a3 += sc[3 * D + k] * w; }
            red[(kq * 4 + 0) * 32 + jl] = a0; red[(kq * 4 + 1) * 32 + jl] = a1; red[(kq * 4 + 2) * 32 + jl] = a2; red[(kq * 4 + 3) * 32 + jl] = a3;
            __syncthreads();
            if (tid < 128) { const int b = tid >> 5; float s = b_ada[j];
#pragma unroll
                for (int q = 0; q < 16; ++q) s += red[(q * 4 + b) * 32 + jl];
                mod[b * 6144 + j] = s; }
            __syncthreads();
        }
    }
    const PrepArgs pa = MAKE_PREP_ARGS(a);
    const int lane = tid & 63, gw = blockIdx.x * NWAVES + (tid >> 6), ngw = G * NWAVES;
    prep_run(pa, gw, ngw, lane);
}

__device__ __forceinline__ void ph_ln1(const MArgs& a, unsigned char* smem, int G) {
    const int tid = threadIdx.x, lane = tid & 63, wave = tid >> 6;
    const float* x = a.in[0]; const float* w_in = a.in[4]; const float* gate_b = a.in[7];
    const float* mod = (const float*)(a.ws + WS_MOD); unsigned char* u1 = (unsigned char*)(a.ws + WS_U1); float* ipre = (float*)(a.ws + WS_GATES); float* logf = ipre + 16 * S;
    float* wg = (float*)smem;
    for (int i = tid; i < D * 8; i += NTHR) wg[i] = w_in[(size_t)(i >> 3) * WIN_LD + C_GATE + (i & 7)];
    __syncthreads();
    for (int it = blockIdx.x; it < T / 128; it += G) {
        const int row0 = it * 128, b = row0 / S;
        f32x4 sh[4], sc[4];
#pragma unroll
        for (int j = 0; j < 4; ++j) { sh[j] = *(const f32x4*)(mod + b * 6144 + 4 * lane + 256 * j); sc[j] = *(const f32x4*)(mod + b * 6144 + 1024 + 4 * lane + 256 * j); }
        for (int rr = wave; rr < 128; rr += NWAVES) {
            const int row = row0 + rr;
            const f32x4* xr = (const f32x4*)(x + (size_t)row * D) + lane;
            f32x4 v[4]; float s = 0.f;
#pragma unroll
            for (int j = 0; j < 4; ++j) { v[j] = xr[64 * j]; s += (v[j].x + v[j].y) + (v[j].z + v[j].w); }
            const float mean = wave_sum(s) * (1.f / D); float s2 = 0.f;
#pragma unroll
            for (int j = 0; j < 4; ++j) { v[j] = v[j] - mean; s2 += (v[j].x * v[j].x + v[j].y * v[j].y) + (v[j].z * v[j].z + v[j].w * v[j].w); }
            const float rstd = 1.f / sqrtf(wave_sum(s2) * (1.f / D) + LN_EPS);
            float ga[8];
#pragma unroll
            for (int q = 0; q < 8; ++q) ga[q] = 0.f;
            unsigned* o4 = (unsigned*)(u1 + (size_t)row * D) + lane;
#pragma unroll
            for (int j = 0; j < 4; ++j) {
                const f32x4 u = v[j] * rstd * (sc[j] + 1.0f) + sh[j];
                o4[64 * j] = pk4_fp8(u.x, u.y, u.z, u.w);
#pragma unroll
                for (int e = 0; e < 4; ++e) { const int k = 4 * lane + 256 * j + e;
                    const f32x4 w0 = *(const f32x4*)(wg + k * 8), w1 = *(const f32x4*)(wg + k * 8 + 4);
                    ga[0] += u[e] * w0.x; ga[1] += u[e] * w0.y; ga[2] += u[e] * w0.z; ga[3] += u[e] * w0.w;
                    ga[4] += u[e] * w1.x; ga[5] += u[e] * w1.y; ga[6] += u[e] * w1.z; ga[7] += u[e] * w1.w; }
            }
#pragma unroll
            for (int q = 0; q < 8; ++q) ga[q] = wave_sum(ga[q]);
            if (lane < 8) {
                float gv = 0.f;
#pragma unroll
                for (int q = 0; q < 8; ++q) gv = (lane == q) ? ga[q] : gv;
                gv += gate_b[lane];
                const int h = lane & 3, s_ = row % S;
                if (lane < 4) ipre[(size_t)(b * 4 + h) * S + s_] = gv;
                else logf[(size_t)(b * 4 + h) * S + s_] = fminf(gv, 0.f) - log1pf(__expf(-fabsf(gv)));
            }
        }
    }
}

__device__ __forceinline__ void ph_ln2(const MArgs& a, int G) {
    const float* x = a.in[0]; const unsigned char* mixout8 = (const unsigned char*)(a.ws + WS_MIXOUT); const float* mod = (const float*)(a.ws + WS_MOD); const float* ln1_g = a.in[10]; const float* ln1_b = a.in[11];
    bf16* x1 = (bf16*)(a.ws + WS_X1); bf16* u2 = (bf16*)(a.ws + WS_U2); unsigned char* u2f8 = (unsigned char*)(a.ws + WS_U2F8);
    const int tid = threadIdx.x, lane = tid & 63, wave = tid >> 6;
    for (int it = blockIdx.x; it < T / 128; it += G) {
        const int row0 = it * 128, b = row0 / S;
        f32x4 g1[4], lg[4], lb[4], sc2[4], sh2[4];
#pragma unroll
        for (int j = 0; j < 4; ++j) { const int col = 4 * lane + 256 * j;
            g1[j] = *(const f32x4*)(mod + b * 6144 + 2048 + col); lg[j] = *(const f32x4*)(ln1_g + col); lb[j] = *(const f32x4*)(ln1_b + col);
            sc2[j] = *(const f32x4*)(mod + b * 6144 + 4096 + col) + 1.0f; sh2[j] = *(const f32x4*)(mod + b * 6144 + 3072 + col); }
        for (int rr = wave; rr < 128; rr += NWAVES) {
            const int row = row0 + rr;
            f32x4 v[4]; float s = 0.f;
#pragma unroll
            for (int j = 0; j < 4; ++j) {
                const int col = 4 * lane + 256 * j;
                const f32x4 xv = __builtin_nontemporal_load((const f32x4*)(x + (size_t)row * D + col));
                f32x4 mo; { const int w = *(const int*)(mixout8 + (size_t)row * D + col); const f32x2 lo = __builtin_amdgcn_cvt_pk_f32_fp8(w, false), hi = __builtin_amdgcn_cvt_pk_f32_fp8(w, true); mo = (f32x4){lo.x, lo.y, hi.x, hi.y}; }
                v[j] = xv * DN_ALPHA + g1[j] * mo; s += (v[j].x + v[j].y) + (v[j].z + v[j].w);
            }
            float mean = wave_sum(s) * (1.f / D), s2 = 0.f;
#pragma unroll
            for (int j = 0; j < 4; ++j) { v[j] = v[j] - mean; s2 += (v[j].x * v[j].x + v[j].y * v[j].y) + (v[j].z * v[j].z + v[j].w * v[j].w); }
            float rstd = 1.f / sqrtf(wave_sum(s2) * (1.f / D) + LN_EPS);
            s = 0.f;
#pragma unroll
            for (int j = 0; j < 4; ++j) { const int col = 4 * lane + 256 * j;
                v[j] = v[j] * rstd * lg[j] + lb[j];
                *(unsigned long long*)(x1 + (size_t)row * D + col) = (unsigned long long)pk2(v[j].x, v[j].y) | ((unsigned long long)pk2(v[j].z, v[j].w) << 32); s += (v[j].x + v[j].y) + (v[j].z + v[j].w); }
            mean = wave_sum(s) * (1.f / D); s2 = 0.f;
#pragma unroll
            for (int j = 0; j < 4; ++j) { v[j] = v[j] - mean; s2 += (v[j].x * v[j].x + v[j].y * v[j].y) + (v[j].z * v[j].z + v[j].w * v[j].w); }
            rstd = 1.f / sqrtf(wave_sum(s2) * (1.f / D) + LN_EPS);
#pragma unroll
            for (int j = 0; j < 4; ++j) { const int col = 4 * lane + 256 * j;
                const f32x4 u = v[j] * rstd * sc2[j] + sh2[j];
                *(unsigned long long*)(u2 + (size_t)row * D + col) = (unsigned long long)pk2(u.x, u.y) | ((unsigned long long)pk2(u.z, u.w) << 32);
                *(unsigned*)(u2f8 + (size_t)row * D + col) = pk4_fp8(u.x, u.y, u.z, u.w); }
        }
    }
}
#define DPPI(v, ctrl) __builtin_amdgcn_update_dpp(0, (v), (ctrl), 0xF, 0xF, true)
#define DPPF(v, ctrl) __builtin_bit_cast(float, __builtin_amdgcn_update_dpp(0, __builtin_bit_cast(int, (v)), (ctrl), 0xF, 0xF, true))
__device__ __forceinline__ void route_wave(int t, int lane, const float* __restrict__ logits, const f32x4 bias4, int* __restrict__ tope, float* __restrict__ topg, LAS int* hist) {
    const f32x4 lg = *(const f32x4*)(logits + (size_t)t * NE + 4 * lane);
    float sc[4], v[4];
#pragma unroll
    for (int j = 0; j < 4; ++j) { sc[j] = 1.f / (1.f + __expf(-lg[j])); v[j] = sc[j] + bias4[j]; }
    float m1 = fmaxf(fmaxf(v[0], v[1]), fmaxf(v[2], v[3]));
    float m2; { const float a = fmaxf(v[0], v[1]), b = fminf(v[0], v[1]), c = fmaxf(v[2], v[3]), d = fminf(v[2], v[3]); m2 = fmaxf(fminf(a, c), fmaxf(b, d)); }
#pragma unroll
    for (int st = 0; st < 3; ++st) { const float o1 = st == 0 ? DPPF(m1, 0xB1) : (st == 1 ? DPPF(m1, 0x4E) : DPPF(m1, 0x141)), o2 = st == 0 ? DPPF(m2, 0xB1) : (st == 1 ? DPPF(m2, 0x4E) : DPPF(m2, 0x141));
        const float n1 = fmaxf(m1, o1); m2 = fmaxf(fminf(m1, o1), fmaxf(m2, o2)); m1 = n1; }
    const float gs = m1 + m2; const int myg = lane >> 3; int rank = 0;
#pragma unroll
    for (int gg = 0; gg < 8; ++gg) { const float og = __builtin_bit_cast(float, __builtin_amdgcn_readlane(__builtin_bit_cast(int, gs), gg * 8)); rank += (og > gs || (og == gs && gg < myg)) ? 1 : 0; }
    unsigned kh[4];
#pragma unroll
    for (int j = 0; j < 4; ++j) { const unsigned u = __builtin_bit_cast(unsigned, v[j]); kh[j] = (rank >= 4) ? 0u : (u ^ ((u >> 31) ? 0xFFFFFFFFu : 0x80000000u)); }
    int myE = 0; float myS = 0.f, gsum = 0.f;
#pragma unroll
    for (int rd = 0; rd < 8; ++rd) {
        unsigned bh_ = kh[0]; int bl = 255 - 4 * lane;
#pragma unroll
        for (int j = 1; j < 4; ++j) if (kh[j] > bh_) { bh_ = kh[j]; bl = 255 - (4 * lane + j); }
#pragma unroll
        for (int st = 0; st < 4; ++st) {
            const int ctrl = st == 0 ? 0xB1 : (st == 1 ? 0x4E : (st == 2 ? 0x141 : 0x140));
            const unsigned oh = (unsigned)(st == 0 ? DPPI((int)bh_, 0xB1) : (st == 1 ? DPPI((int)bh_, 0x4E) : (st == 2 ? DPPI((int)bh_, 0x141) : DPPI((int)bh_, 0x140))));
            const int ol = st == 0 ? DPPI(bl, 0xB1) : (st == 1 ? DPPI(bl, 0x4E) : (st == 2 ? DPPI(bl, 0x141) : DPPI(bl, 0x140)));
            (void)ctrl; const bool take = (oh > bh_) || (oh == bh_ && ol > bl); bh_ = take ? oh : bh_; bl = take ? ol : bl; }
        unsigned wh = (unsigned)__builtin_amdgcn_readlane((int)bh_, 0); int wl = __builtin_amdgcn_readlane(bl, 0);
#pragma unroll
        for (int rw = 1; rw < 4; ++rw) { const unsigned oh = (unsigned)__builtin_amdgcn_readlane((int)bh_, 16 * rw); const int ol = __builtin_amdgcn_readlane(bl, 16 * rw);
            const bool take = (oh > wh) || (oh == wh && ol > wl); wh = take ? oh : wh; wl = take ? ol : wl; }
        const int bi = 255 - wl;
        float cand = 0.f;
#pragma unroll
        for (int j = 0; j < 4; ++j) if (bi == 4 * lane + j) { cand = sc[j]; kh[j] = 0u; }
        const float ss = __builtin_bit_cast(float, __builtin_amdgcn_readlane(__builtin_bit_cast(int, cand), bi >> 2));
        gsum += ss;
        if (lane == rd) { myE = bi; myS = ss; }
    }
    if (lane < 8) { tope[t * 8 + lane] = myE; topg[t * 8 + lane] = myS * (2.5f / gsum); __hip_atomic_fetch_add(hist + myE, 1, __ATOMIC_RELAXED, __HIP_MEMORY_SCOPE_WORKGROUP); }
}
__device__ __forceinline__ void moe_tables(const int* cnt, LAS int* tb, LAS int* nn) {
    if (threadIdx.x < 64) {
        const int lane = threadIdx.x; int n[4], tl[4], loc = 0;
#pragma unroll
        for (int j = 0; j < 4; ++j) { n[j] = cnt[(4 * lane + j) * CSTR]; tl[j] = (n[j] + 255) >> 8; loc += tl[j]; }
        int inc = loc;
#pragma unroll
        for (int o = 1; o < 64; o <<= 1) { const int v = __shfl_up(inc, o); if (lane >= o) inc += v; }
        int base = inc - loc;
#pragma unroll
        for (int j = 0; j < 4; ++j) { tb[4 * lane + j] = base; nn[4 * lane + j] = n[j]; base += tl[j]; }
        if (lane == 63) { tb[NE] = base; nn[NE] = T; tb[NEX] = base + T / 256; }
    }
    __syncthreads();
}
__device__ __forceinline__ void ph_final(const MArgs& a, int G) {
    float* out = a.out; const bf16* x1 = (const bf16*)(a.ws + WS_X1); const unsigned char* ys8 = (const unsigned char*)(a.ws + WS_YS); const unsigned char* ysh8 = (const unsigned char*)(a.ws + WS_YSH); const float* mod = (const float*)(a.ws + WS_MOD);
    const float* ln2_g = a.in[20]; const float* ln2_b = a.in[21];
    const int tid = threadIdx.x, lane = tid & 63, wave = tid >> 6;
    for (int it = blockIdx.x; it < T / 128; it += G) {
        const int row0 = it * 128, b = row0 / S;
        f32x4 g2[4], lg[4], lb[4];
#pragma unroll
        for (int j = 0; j < 4; ++j) { const int col = 4 * lane + 256 * j; g2[j] = *(const f32x4*)(mod + b * 6144 + 5120 + col); lg[j] = *(const f32x4*)(ln2_g + col); lb[j] = *(const f32x4*)(ln2_b + col); }
        for (int rr = wave; rr < 128; rr += NWAVES) {
            const int row = row0 + rr;
            f32x4 v[4]; float s = 0.f;
#pragma unroll
            for (int j = 0; j < 4; ++j) { const int col = 4 * lane + 256 * j;
                f32x4 yr = {0.f, 0.f, 0.f, 0.f};
#pragma unroll
                for (int k = 0; k < 8; ++k) { const int w = *(const int*)(ys8 + ((size_t)row * 8 + k) * D + col);
                    const f32x2 lo = __builtin_amdgcn_cvt_pk_f32_fp8(w, false), hi = __builtin_amdgcn_cvt_pk_f32_fp8(w, true); yr = yr + (f32x4){lo.x, lo.y, hi.x, hi.y}; }
                { const int w = *(const int*)(ysh8 + (size_t)row * D + col); const f32x2 lo = __builtin_amdgcn_cvt_pk_f32_fp8(w, false), hi = __builtin_amdgcn_cvt_pk_f32_fp8(w, true); yr = yr + (f32x4){lo.x, lo.y, hi.x, hi.y}; }
                const f32x4 y = yr * (1.f / 16.f);
                v[j] = ld_bf4(x1 + (size_t)row * D + col) * DN_ALPHA + g2[j] * y;
                s += (v[j].x + v[j].y) + (v[j].z + v[j].w); }
            const float mean = wave_sum(s) * (1.f / D); float s2 = 0.f;
#pragma unroll
            for (int j = 0; j < 4; ++j) { v[j] = v[j] - mean; s2 += (v[j].x * v[j].x + v[j].y * v[j].y) + (v[j].z * v[j].z + v[j].w * v[j].w); }
            const float rstd = 1.f / sqrtf(wave_sum(s2) * (1.f / D) + LN_EPS);
#pragma unroll
            for (int j = 0; j < 4; ++j) { const int col = 4 * lane + 256 * j;
                __builtin_nontemporal_store(v[j] * rstd * lg[j] + lb[j], (f32x4*)(out + (size_t)row * D + col)); }
        }
    }
}


typedef short s16x4 __attribute__((ext_vector_type(4)));
typedef short bf16x8v __attribute__((ext_vector_type(8)));
typedef float f32x16 __attribute__((ext_vector_type(16)));
constexpr int MLP = 320;
constexpr int NCH = S / 64;
constexpr int ST_ELEMS = 129 * 128;
constexpr size_t WS_CHK = WS_GATES + 1 * MiB;
constexpr size_t WS_MPREV = WS_GATES + 1 * MiB + 65536;
constexpr size_t WS_KC = WS_U2;
__device__ __forceinline__ s16x4 tr_read(const LAS unsigned char* p) { return __builtin_bit_cast(s16x4, __builtin_amdgcn_ds_read_tr16_b64_v4i16((LAS s16x4*)p)); }
__device__ __forceinline__ bf16x8v tr_frag(const LAS unsigned char* tile, int row0, int col0, int lane) {
    const int i = lane & 15; const LAS unsigned char* p = tile + (row0 + (i >> 2)) * MLP + (col0 + 4 * (i & 3)) * 2;
    const s16x4 lo = tr_read(p), hi = tr_read(p + 4 * MLP);
    return __builtin_shufflevector(lo, hi, 0, 1, 2, 3, 4, 5, 6, 7);
}
__device__ __forceinline__ bf16x8v tr_frag_perm(const LAS unsigned char* tile, int row0, int col0, int lane) {
    const int i = lane & 15; const LAS unsigned char* p = tile + (row0 + (i >> 2)) * MLP + (col0 + 4 * (i & 3)) * 2;
    const s16x4 lo = tr_read(p), hi = tr_read(p + 8 * MLP);
    return __builtin_shufflevector(lo, hi, 0, 1, 2, 3, 4, 5, 6, 7);
}
__device__ __forceinline__ float wave_incl_sum(float v, int lane) {
#pragma unroll
    for (int o = 1; o < 64; o <<= 1) { const float u = __shfl_up(v, o); if (lane >= o) v += u; }
    return v;
}
__device__ __forceinline__ float wave_incl_max(float v, int lane) {
#pragma unroll
    for (int o = 1; o < 64; o <<= 1) { const float u = __shfl_up(v, o); if (lane >= o) v = fmaxf(v, u); }
    return v;
}
__device__ __forceinline__ float wave_max(float v) {
#pragma unroll
    for (int o = 1; o < 64; o <<= 1) v = fmaxf(v, __shfl_xor(v, o));
    return v;
}
__device__ __forceinline__ void cvt8_fp8(unsigned long long w, float (&f)[8]);
__device__ __forceinline__ void conv8(const unsigned char* __restrict__ rowp, int spos, const float* __restrict__ cw, const float* __restrict__ cb, float scale, float (&y)[8]) {
    const f32x4 b0 = *(const f32x4*)cb, b1 = *(const f32x4*)(cb + 4);
    y[0] = b0.x; y[1] = b0.y; y[2] = b0.z; y[3] = b0.w; y[4] = b1.x; y[5] = b1.y; y[6] = b1.z; y[7] = b1.w;
    unsigned long long xr[4];
#pragma unroll
    for (int j = 0; j < 4; ++j) { const int back = (spos - 3 + j >= 0) ? (j - 3) : 0; xr[j] = *(const unsigned long long*)(rowp + (ptrdiff_t)back * NPROJ); }
#pragma unroll
    for (int j = 0; j < 4; ++j) {
        const float ok = (spos - 3 + j >= 0) ? 1.f : 0.f; float xf[8]; cvt8_fp8(xr[j], xf);
        const f32x4 w0 = *(const f32x4*)(cw + j * 1024) * ok, w1 = *(const f32x4*)(cw + j * 1024 + 4) * ok;
        y[0] += w0.x * xf[0]; y[1] += w0.y * xf[1]; y[2] += w0.z * xf[2]; y[3] += w0.w * xf[3];
        y[4] += w1.x * xf[4]; y[5] += w1.y * xf[5]; y[6] += w1.z * xf[6]; y[7] += w1.w * xf[7];
    }
#pragma unroll
    for (int e = 0; e < 8; ++e) y[e] = siluf_(y[e]) * scale;
}
__device__ __forceinline__ void cvt8_fp8(unsigned long long w, float (&f)[8]) {
    const f32x2 a = __builtin_amdgcn_cvt_pk_f32_fp8((int)(unsigned)w, false), b = __builtin_amdgcn_cvt_pk_f32_fp8((int)(unsigned)w, true);
    const f32x2 c = __builtin_amdgcn_cvt_pk_f32_fp8((int)(unsigned)(w >> 32), false), d = __builtin_amdgcn_cvt_pk_f32_fp8((int)(unsigned)(w >> 32), true);
    f[0] = a.x; f[1] = a.y; f[2] = b.x; f[3] = b.y; f[4] = c.x; f[5] = c.y; f[6] = d.x; f[7] = d.y; }
__device__ __forceinline__ v4u pack8(const float (&y)[8]) { v4u o; o.x = pk2(y[0], y[1]); o.y = pk2(y[2], y[3]); o.z = pk2(y[4], y[5]); o.w = pk2(y[6], y[7]); return o; }

__device__ __forceinline__ void ml_phaseA(const MArgs& a, LAS unsigned char* lds, int vb0, int nvb) {
    const int tid = threadIdx.x, lane = tid & 63, wave = __builtin_amdgcn_readfirstlane(tid >> 6);
    const unsigned char* proj = (const unsigned char*)(a.ws + WS_PROJ); const float* conv_w = a.in[5]; const float* conv_b = a.in[6];
    const float* ipre = (const float*)(a.ws + WS_GATES); const float* logf = ipre + 16 * S;
    bf16* kcg = (bf16*)(a.ws + WS_KC); bf16* st = (bf16*)(a.ws + WS_STATES); float* chk = (float*)(a.ws + WS_CHK);
    LAS unsigned char* Kt = lds; LAS unsigned char* Vt = lds + 64 * MLP; LAS float* wkL = (LAS float*)(lds + 128 * MLP); LAS unsigned char* Stg = lds + 132 * MLP;
    const PrepArgs pa = MAKE_PREP_ARGS(a);
    for (int unit = vb0; unit < 16 * NCH; unit += nvb) {
        const int bh = unit >> 7, c = unit & (NCH - 1), b = bh >> 2, h = bh & 3, s0 = c * 64; const size_t row0 = (size_t)b * S + s0;
        float lf = 0.f, ic = 0.f;
        if (wave == 0) { lf = logf[(size_t)bh * S + s0 + lane]; ic = ipre[(size_t)bh * S + s0 + lane]; }
#pragma unroll
        for (int q = 0; q < 2; ++q) { const int it = tid + q * NTHR, tt = it >> 4, c8 = it & 15, ch = h * 128 + c8 * 8;
            float y[8]; conv8(proj + (row0 + tt) * NPROJ + C_MLK + ch, s0 + tt, conv_w + 512 + ch, conv_b + 512 + ch, 0.08838834764831845f, y);
            const v4u o = pack8(y);
            *(LAS v4u*)(Kt + tt * MLP + c8 * 16) = o; *(v4u*)(kcg + (row0 + tt) * 512 + ch) = o; }
        if (wave == 0) {
            const float bc = wave_incl_sum(lf, lane), g = ic - bc, gmax = wave_max(g), blast = __shfl(bc, 63);
            wkL[lane] = __expf(g - gmax);
            if (lane == 0) { chk[(size_t)unit * 2] = blast; chk[(size_t)unit * 2 + 1] = blast + gmax; }
        }
        __syncthreads();
        const PrepDesc bgd = prep_decode(pa, IT_SMALL + unit * NWAVES + wave); f32x4 bgv[16]; prep_load(bgd, lane, bgv);
#pragma unroll
        for (int q = 0; q < 2; ++q) { const int it = tid + q * NTHR, tt = it >> 4, c8 = it & 15;
            float y[8]; cvt8_fp8(*(const unsigned long long*)(proj + (row0 + tt) * NPROJ + C_MLV + h * 128 + c8 * 8), y); const float w = wkL[tt];
#pragma unroll
            for (int e = 0; e < 8; ++e) y[e] *= w;
            *(LAS v4u*)(Vt + tt * MLP + c8 * 16) = pack8(y); }
        __syncthreads();
        {
            const int dvb = wave >> 1, dkh = wave & 1, hh = lane >> 5, gsel = (lane >> 4) & 1;
            f32x16 acc[2];
#pragma unroll
            for (int nb = 0; nb < 2; ++nb)
#pragma unroll
                for (int i = 0; i < 16; ++i) acc[nb][i] = 0.f;
#pragma unroll
            for (int kk = 0; kk < 4; ++kk) {
                const bf16x8v Bv = tr_frag(Vt, 16 * kk + 8 * hh, 32 * dvb + 16 * gsel, lane);
#pragma unroll
                for (int nb = 0; nb < 2; ++nb) { const bf16x8v Ak = tr_frag(Kt, 16 * kk + 8 * hh, 32 * (2 * dkh + nb) + 16 * gsel, lane);
                    acc[nb] = __builtin_amdgcn_mfma_f32_32x32x16_bf16(Ak, Bv, acc[nb], 0, 0, 0); }
            }
#pragma unroll
            for (int nb = 0; nb < 2; ++nb)
#pragma unroll
                for (int g4 = 0; g4 < 4; ++g4) { const int dk = 32 * (2 * dkh + nb) + 8 * g4 + 4 * hh, dv = 32 * dvb + (lane & 31);
                    *(LAS unsigned long long*)(Stg + dv * MLP + dk * 2) = (unsigned long long)pk2(acc[nb][4 * g4], acc[nb][4 * g4 + 1]) | ((unsigned long long)pk2(acc[nb][4 * g4 + 2], acc[nb][4 * g4 + 3]) << 32); }
        }
        __syncthreads();
        { bf16* stc = st + (size_t)unit * ST_ELEMS;
#pragma unroll
          for (int q = 0; q < 4; ++q) { const int it = tid + q * NTHR, dv = it >> 4, c8 = it & 15;
              *(v4u*)(stc + dv * 128 + c8 * 8) = *(const LAS v4u*)(Stg + dv * MLP + c8 * 16); }
        }
        if (tid < 128) { float s = 0.f;
#pragma unroll 8
            for (int t = 0; t < 64; ++t) s += wkL[t] * bf2f(*(const LAS unsigned short*)(Kt + t * MLP + tid * 2));
            st[(size_t)unit * ST_ELEMS + 128 * 128 + tid] = (bf16)f2bf(s); }
        prep_store(bgd, lane, bgv);
        __syncthreads();
    }
}

__device__ __forceinline__ void ml_phaseB(const MArgs& a, LAS unsigned char* lds, int vb0, int nvb) {
    const int tid = threadIdx.x;
    bf16* st = (bf16*)(a.ws + WS_STATES); const float* chk = (const float*)(a.ws + WS_CHK); float* mprev = (float*)(a.ws + WS_MPREV);
    LAS float* al = (LAS float*)lds; LAS float* be = al + NCH;
    constexpr int NSL = 16, SLE = ST_ELEMS / NSL;
    for (int item = vb0; item < 16 * NSL; item += nvb) {
        const int bh = item / NSL, sl = item % NSL;
        __syncthreads();
        if (tid < NCH) { al[tid] = chk[(size_t)(bh * NCH + tid) * 2]; be[tid] = chk[(size_t)(bh * NCH + tid) * 2 + 1]; }
        __syncthreads();
        if (tid == 0) { float m = 0.f;
            for (int c = 0; c < NCH; ++c) { const float bl = al[c], M = be[c];
                const float mn = fmaxf(bl + m, M); al[c] = __expf(bl + m - mn); be[c] = __expf(M - mn);
                if (sl == 0) mprev[bh * NCH + c] = m;
                m = mn; } }
        __syncthreads();
        if (tid * 4 < SLE) {
            unsigned long long* p = (unsigned long long*)(st + (size_t)bh * NCH * ST_ELEMS + sl * SLE + tid * 4);
            float c0 = 0.f, c1 = 0.f, c2 = 0.f, c3 = 0.f;
            for (int cb = 0; cb < NCH; cb += 16) { unsigned long long d[16];
#pragma unroll
                for (int j = 0; j < 16; ++j) d[j] = p[(size_t)(cb + j) * (ST_ELEMS / 4)];
#pragma unroll
                for (int j = 0; j < 16; ++j) { p[(size_t)(cb + j) * (ST_ELEMS / 4)] = (unsigned long long)pk2(c0, c1) | ((unsigned long long)pk2(c2, c3) << 32);
                    const float A = al[cb + j], Bq = be[cb + j]; const unsigned lo = (unsigned)d[j], hi = (unsigned)(d[j] >> 32);
                    c0 = A * c0 + Bq * bf2f(lo & 0xffffu); c1 = A * c1 + Bq * bf2f(lo >> 16); c2 = A * c2 + Bq * bf2f(hi & 0xffffu); c3 = A * c3 + Bq * bf2f(hi >> 16); } }
        }
    }
}

__device__ __forceinline__ void ml_phaseC(const MArgs& a, LAS unsigned char* lds, int G) {
    const int tid = threadIdx.x, lane = tid & 63, wave = __builtin_amdgcn_readfirstlane(tid >> 6);
    const unsigned char* proj = (const unsigned char*)(a.ws + WS_PROJ); const float* conv_w = a.in[5]; const float* conv_b = a.in[6]; const float* norm_g = a.in[8];
    const float* ipre = (const float*)(a.ws + WS_GATES); const float* logf = ipre + 16 * S;
    const bf16* kcg = (const bf16*)(a.ws + WS_KC); const bf16* st = (const bf16*)(a.ws + WS_STATES); const float* mprev = (const float*)(a.ws + WS_MPREV);
    unsigned char* mix8 = (unsigned char*)(a.ws + WS_MIX);
    LAS unsigned char* Qt = lds; LAS unsigned char* Kt = lds + 64 * MLP; LAS unsigned char* Vt = lds + 128 * MLP; LAS unsigned char* Ct = lds + 192 * MLP;
    LAS float* sc = (LAS float*)(lds + 320 * MLP);
    LAS float* gL = sc; LAS float* mmL = sc + 64; LAS float* siL = sc + 128; LAS float* emL = sc + 192; LAS float* npv = sc + 256; LAS float* lnS = sc + 384;
    const int tb = wave >> 2, dvb = wave & 3, r = lane & 31, hh = lane >> 5, gsel = (lane >> 4) & 1;
    const PrepArgs pa = MAKE_PREP_ARGS(a);
    for (int unit = blockIdx.x; unit < 16 * NCH; unit += G) {
        const int bh = unit >> 7, c = unit & (NCH - 1), b = bh >> 2, h = bh & 3, s0 = c * 64; const size_t row0 = (size_t)b * S + s0;
        float lf = 0.f, ic = 0.f, mp = 0.f;
        if (wave == 0) { lf = logf[(size_t)bh * S + s0 + lane]; ic = ipre[(size_t)bh * S + s0 + lane]; mp = mprev[unit]; }
        const bf16* stc = st + (size_t)unit * ST_ELEMS;
#pragma unroll
        for (int q = 0; q < 2; ++q) { const int it = tid + q * NTHR, tt = it >> 4, c8 = it & 15, ch = h * 128 + c8 * 8;
            float y[8]; conv8(proj + (row0 + tt) * NPROJ + C_MLQ + ch, s0 + tt, conv_w + ch, conv_b + ch, 1.f, y);
            *(LAS v4u*)(Qt + tt * MLP + c8 * 16) = pack8(y);
            *(LAS v4u*)(Kt + tt * MLP + c8 * 16) = *(const v4u*)(kcg + (row0 + tt) * 512 + ch);
            { float vf[8]; cvt8_fp8(*(const unsigned long long*)(proj + (row0 + tt) * NPROJ + C_MLV + ch), vf); *(LAS v4u*)(Vt + tt * MLP + c8 * 16) = pack8(vf); } }
#pragma unroll
        for (int q = 0; q < 4; ++q) { const int it = tid + q * NTHR, dv = it >> 4, c8 = it & 15;
            *(LAS v4u*)(Ct + dv * MLP + c8 * 16) = *(const v4u*)(stc + dv * 128 + c8 * 8); }
        if (tid < 128) npv[tid] = bf2f(stc[128 * 128 + tid]);
        if (wave == 0) {
            const float bc = wave_incl_sum(lf, lane), g = ic - bc, pm = wave_incl_max(g, lane), mm = fmaxf(mp, pm);
            gL[lane] = g; mmL[lane] = mm; siL[lane] = __expf(mp - mm); emL[lane] = __expf(-(bc + mm));
        }
        __syncthreads();
        unsigned long long ogp[2]; f32x4 ngp[2][2];
#pragma unroll
        for (int q = 0; q < 2; ++q) { const int it = tid + q * NTHR, tt = it >> 4, dv = (it & 15) * 8;
            ogp[q] = *(const unsigned long long*)(proj + (row0 + tt) * NPROJ + C_MLO + h * 128 + dv); ngp[q][0] = *(const f32x4*)(norm_g + h * 128 + dv); ngp[q][1] = *(const f32x4*)(norm_g + h * 128 + dv + 4); }
        const PrepDesc bgd = prep_decode(pa, IT_SMALL + BG_A + unit * NWAVES + wave); f32x4 bgv[16]; prep_load(bgd, lane, bgv);
        bf16x8v qf[8];
#pragma unroll
        for (int kk = 0; kk < 8; ++kk) qf[kk] = *(const LAS bf16x8v*)(Qt + (32 * tb + r) * MLP + (16 * kk + 8 * hh) * 2);
        const float mm_t = mmL[32 * tb + r], si_t = siL[32 * tb + r], em_t = emL[32 * tb + r];
        float nq = 0.f;
#pragma unroll
        for (int kk = 0; kk < 8; ++kk) { const f32x4 n0 = *(const LAS f32x4*)(npv + 16 * kk + 8 * hh), n1 = *(const LAS f32x4*)(npv + 16 * kk + 8 * hh + 4);
            nq += n0.x * bf2f((unsigned short)qf[kk][0]) + n0.y * bf2f((unsigned short)qf[kk][1]) + n0.z * bf2f((unsigned short)qf[kk][2]) + n0.w * bf2f((unsigned short)qf[kk][3])
                + n1.x * bf2f((unsigned short)qf[kk][4]) + n1.y * bf2f((unsigned short)qf[kk][5]) + n1.z * bf2f((unsigned short)qf[kk][6]) + n1.w * bf2f((unsigned short)qf[kk][7]); }
        nq += __shfl_xor(nq, 32);
        f32x16 num;
#pragma unroll
        for (int i = 0; i < 16; ++i) num[i] = 0.f;
#pragma unroll
        for (int kk = 0; kk < 8; ++kk) { const bf16x8v Ac = *(const LAS bf16x8v*)(Ct + (32 * dvb + r) * MLP + (16 * kk + 8 * hh) * 2);
            num = __builtin_amdgcn_mfma_f32_32x32x16_bf16(Ac, qf[kk], num, 0, 0, 0); }
#pragma unroll
        for (int i = 0; i < 16; ++i) num[i] *= si_t;
        float wsum = 0.f;
        for (int sb = 0; sb <= tb; ++sb) {
            f32x16 sT;
#pragma unroll
            for (int i = 0; i < 16; ++i) sT[i] = 0.f;
#pragma unroll
            for (int kk = 0; kk < 8; ++kk) { const bf16x8v Ak = *(const LAS bf16x8v*)(Kt + (32 * sb + r) * MLP + (16 * kk + 8 * hh) * 2);
                sT = __builtin_amdgcn_mfma_f32_32x32x16_bf16(Ak, qf[kk], sT, 0, 0, 0); }
            unsigned wp[8];
#pragma unroll
            for (int g4 = 0; g4 < 4; ++g4) { const f32x4 gv = *(const LAS f32x4*)(gL + 32 * sb + 8 * g4 + 4 * hh);
                float w[4];
#pragma unroll
                for (int e = 0; e < 4; ++e) { const int srow = 32 * sb + 8 * g4 + 4 * hh + e; const bool valid = srow <= 32 * tb + r;
                    w[e] = valid ? sT[4 * g4 + e] * __expf(gv[e] - mm_t) : 0.f; wsum += w[e]; }
                wp[2 * g4] = pk2(w[0], w[1]); wp[2 * g4 + 1] = pk2(w[2], w[3]); }
#pragma unroll
            for (int s2 = 0; s2 < 2; ++s2) {
                const bf16x8v Av = tr_frag_perm(Vt, 32 * sb + 16 * s2 + 4 * hh, 32 * dvb + 16 * gsel, lane);
                v4u bw; bw.x = wp[4 * s2]; bw.y = wp[4 * s2 + 1]; bw.z = wp[4 * s2 + 2]; bw.w = wp[4 * s2 + 3];
                num = __builtin_amdgcn_mfma_f32_32x32x16_bf16(Av, __builtin_bit_cast(bf16x8v, bw), num, 0, 0, 0); }
        }
        wsum += __shfl_xor(wsum, 32);
        const float den = si_t * nq + wsum, rden = 1.f / fmaxf(fabsf(den), em_t);
        float ps = 0.f, pq = 0.f;
#pragma unroll
        for (int i = 0; i < 16; ++i) { num[i] *= rden; ps += num[i]; pq += num[i] * num[i]; }
        ps += __shfl_xor(ps, 32); pq += __shfl_xor(pq, 32);
        if (hh == 0) { lnS[((tb * 4 + dvb) * 32 + r) * 2] = ps; lnS[((tb * 4 + dvb) * 32 + r) * 2 + 1] = pq; }
        __syncthreads();
        float ts = 0.f, tq = 0.f;
#pragma unroll
        for (int d = 0; d < 4; ++d) { ts += lnS[((tb * 4 + d) * 32 + r) * 2]; tq += lnS[((tb * 4 + d) * 32 + r) * 2 + 1]; }
        const float mean = ts * (1.f / 128.f), rstd = 1.f / sqrtf(fmaxf(tq * (1.f / 128.f) - mean * mean, 0.f) + LN_EPS);
#pragma unroll
        for (int g4 = 0; g4 < 4; ++g4) { const int dv = 32 * dvb + 8 * g4 + 4 * hh;
            *(LAS unsigned long long*)(Qt + (32 * tb + r) * MLP + dv * 2) = (unsigned long long)pk2((num[4 * g4] - mean) * rstd, (num[4 * g4 + 1] - mean) * rstd) | ((unsigned long long)pk2((num[4 * g4 + 2] - mean) * rstd, (num[4 * g4 + 3] - mean) * rstd) << 32); }
        __syncthreads();
#pragma unroll
        for (int q = 0; q < 2; ++q) { const int it = tid + q * NTHR, tt = it >> 4, c8 = it & 15, dv = c8 * 8;
            const v4u hv = *(const LAS v4u*)(Qt + tt * MLP + c8 * 16); float og[8]; cvt8_fp8(ogp[q], og);
            const f32x4 n0 = ngp[q][0], n1 = ngp[q][1];
            float o[8];
            o[0] = bf2f(hv.x & 0xffffu) * n0.x * sigmoidf_(og[0]); o[1] = bf2f(hv.x >> 16) * n0.y * sigmoidf_(og[1]);
            o[2] = bf2f(hv.y & 0xffffu) * n0.z * sigmoidf_(og[2]); o[3] = bf2f(hv.y >> 16) * n0.w * sigmoidf_(og[3]);
            o[4] = bf2f(hv.z & 0xffffu) * n1.x * sigmoidf_(og[4]); o[5] = bf2f(hv.z >> 16) * n1.y * sigmoidf_(og[5]);
            o[6] = bf2f(hv.w & 0xffffu) * n1.z * sigmoidf_(og[6]); o[7] = bf2f(hv.w >> 16) * n1.w * sigmoidf_(og[7]);
            *(unsigned long long*)(mix8 + (row0 + tt) * D + 512 + h * 128 + dv) = (unsigned long long)pk4_fp8(o[0], o[1], o[2], o[3]) | ((unsigned long long)pk4_fp8(o[4], o[5], o[6], o[7]) << 32); }
        prep_store(bgd, lane, bgv);
        __syncthreads();
    }
}

constexpr int VTP = 192;
template <int PITCH> __device__ __forceinline__ bf16x8v tr_frag_perm_p(const LAS unsigned char* tile, int row0, int col0, int lane) {
    const int i = lane & 15; const LAS unsigned char* p = tile + (row0 + (i >> 2)) * PITCH + (col0 + 4 * (i & 3)) * 2;
    const s16x4 lo = tr_read(p), hi = tr_read(p + 8 * PITCH);
    return __builtin_shufflevector(lo, hi, 0, 1, 2, 3, 4, 5, 6, 7);
}
__device__ __forceinline__ void attn_phase(const unsigned char* __restrict__ proj, unsigned char* __restrict__ mix8, LAS unsigned char* lds, int vb0, int nvb, const PrepArgs pa) {
    const int tid = threadIdx.x, lane = tid & 63, wave = __builtin_amdgcn_readfirstlane(tid >> 6);
    const int r = lane & 31, hh = lane >> 5, gsel = (lane >> 4) & 1;
    LAS unsigned char* Vt = lds + wave * (64 * VTP);
    bf16x8v ntri[2], nones;
#pragma unroll
    for (int s2 = 0; s2 < 2; ++s2)
#pragma unroll
        for (int j = 0; j < 8; ++j) { const int k = 16 * s2 + 8 * (j >> 2) + 4 * hh + (j & 3); ntri[s2][j] = (k >= r) ? (short)0xBF80 : (short)0; }
#pragma unroll
    for (int j = 0; j < 8; ++j) nones[j] = (short)0xBF80;
    for (int unit = vb0 * NWAVES + wave; unit < NB * 8 * (S / 32); unit += nvb * NWAVES) {
        const int bh = unit / (S / 32), qb = unit % (S / 32), b = bh >> 3, h = bh & 7, q0 = qb * 32;
        const unsigned char* base = proj + (size_t)b * S * NPROJ + h * 64;
        long qf[4];
#pragma unroll
        for (int s = 0; s < 4; ++s) qf[s] = *(const long*)(base + (size_t)(q0 + r) * NPROJ + C_SBQ + 16 * s + 8 * hh);
        f32x16 o[2];
#pragma unroll
        for (int d = 0; d < 2; ++d)
#pragma unroll
            for (int i = 0; i < 16; ++i) o[d][i] = 0.f;
        float carry = 0.f;
        const int qpos = q0 + r;
        const PrepDesc bgd = prep_decode(pa, IT_SMALL + BG_A + BG_C + unit); f32x4 bgv[16]; prep_load(bgd, lane, bgv);
        for (int k0 = q0 - 32; ; k0 -= 64) {
            long kf[2][4];
#pragma unroll
            for (int kb = 0; kb < 2; ++kb) { int key = k0 + 32 * kb + r; key = key < 0 ? 0 : key;
#pragma unroll
                for (int s = 0; s < 4; ++s) kf[kb][s] = *(const long*)(base + (size_t)key * NPROJ + C_SBK + 16 * s + 8 * hh); }
            unsigned long long vraw[8];
#pragma unroll
            for (int i = 0; i < 8; ++i) { int key = k0 + (lane >> 3) + 8 * i; key = key < 0 ? 0 : key; vraw[i] = *(const unsigned long long*)(base + (size_t)key * NPROJ + C_SBV + (lane & 7) * 8); }
#pragma unroll
            for (int i = 0; i < 8; ++i) { float vf[8]; cvt8_fp8(vraw[i], vf); *(LAS v4u*)(Vt + ((lane >> 3) + 8 * i) * VTP + (lane & 7) * 16) = pack8(vf); }
            f32x16 z[2];
#pragma unroll
            for (int kb = 0; kb < 2; ++kb) {
#pragma unroll
                for (int i = 0; i < 16; ++i) z[kb][i] = 0.f;
#pragma unroll
                for (int s = 0; s < 4; ++s) z[kb] = __builtin_amdgcn_mfma_f32_32x32x16_fp8_fp8(kf[kb][s], qf[s], z[kb], 0, 0, 0); }
            const bool need_mask = (k0 + 63 >= q0) || (k0 < 0);
            unsigned xp[2][8];
#pragma unroll
            for (int kb = 0; kb < 2; ++kb)
#pragma unroll
                for (int g4 = 0; g4 < 4; ++g4) { float sp[4];
#pragma unroll
                    for (int e = 0; e < 4; ++e) { const float zz = z[kb][4 * g4 + e];
                        float v = fmaxf(zz, 0.f) + __builtin_amdgcn_logf(1.f + __builtin_amdgcn_exp2f(-fabsf(zz)));
                        if (need_mask) { const int key = k0 + 32 * kb + 8 * g4 + 4 * hh + e; v = (key >= 0 && key < qpos) ? v : 0.f; }
                        sp[e] = v; }
                    xp[kb][2 * g4] = pk2(sp[0], sp[1]); xp[kb][2 * g4 + 1] = pk2(sp[2], sp[3]); }
            const float z00 = z[0][0];
#pragma unroll
            for (int s2 = 0; s2 < 2; ++s2) { v4u b1; b1.x = xp[1][4 * s2]; b1.y = xp[1][4 * s2 + 1]; b1.z = xp[1][4 * s2 + 2]; b1.w = xp[1][4 * s2 + 3];
                v4u b0; b0.x = xp[0][4 * s2]; b0.y = xp[0][4 * s2 + 1]; b0.z = xp[0][4 * s2 + 2]; b0.w = xp[0][4 * s2 + 3];
                z[1] = __builtin_amdgcn_mfma_f32_32x32x16_bf16(ntri[s2], __builtin_bit_cast(bf16x8v, b1), z[1], 0, 0, 0);
                z[0] = __builtin_amdgcn_mfma_f32_32x32x16_bf16(ntri[s2], __builtin_bit_cast(bf16x8v, b0), z[0], 0, 0, 0);
                z[0] = __builtin_amdgcn_mfma_f32_32x32x16_bf16(nones, __builtin_bit_cast(bf16x8v, b1), z[0], 0, 0, 0); }
            float tot = z00 - z[0][0];
            tot = __shfl(tot, r);
#pragma unroll
            for (int kb = 0; kb < 2; ++kb)
#pragma unroll
                for (int g4 = 0; g4 < 4; ++g4) { float p[4];
#pragma unroll
                    for (int e = 0; e < 4; ++e) { float v = __builtin_amdgcn_exp2f(z[kb][4 * g4 + e] - carry);
                        if (need_mask) { const int key = k0 + 32 * kb + 8 * g4 + 4 * hh + e; v = (key >= 0 && key < qpos) ? v : 0.f; }
                        p[e] = v; }
                    xp[kb][2 * g4] = pk2(p[0], p[1]); xp[kb][2 * g4 + 1] = pk2(p[2], p[3]); }
#pragma unroll
            for (int kb = 0; kb < 2; ++kb)
#pragma unroll
                for (int s2 = 0; s2 < 2; ++s2) { v4u bp; bp.x = xp[kb][4 * s2]; bp.y = xp[kb][4 * s2 + 1]; bp.z = xp[kb][4 * s2 + 2]; bp.w = xp[kb][4 * s2 + 3];
#pragma unroll
                    for (int d = 0; d < 2; ++d) { const bf16x8v Av = tr_frag_perm_p<VTP>(Vt, 32 * kb + 16 * s2 + 4 * hh, 32 * d + 16 * gsel, lane);
                        o[d] = __builtin_amdgcn_mfma_f32_32x32x16_bf16(Av, __builtin_bit_cast(bf16x8v, bp), o[d], 0, 0, 0); } }
            carry += tot;
            if (k0 <= 0) break;
            if (__all(carry > SB_THRESH)) break;
        }
#pragma unroll
        for (int d = 0; d < 2; ++d)
#pragma unroll
            for (int g4 = 0; g4 < 4; ++g4)
                *(LAS unsigned long long*)(Vt + r * 144 + (32 * d + 8 * g4 + 4 * hh) * 2) = (unsigned long long)pk2(o[d][4 * g4], o[d][4 * g4 + 1]) | ((unsigned long long)pk2(o[d][4 * g4 + 2], o[d][4 * g4 + 3]) << 32);
#pragma unroll
        for (int i = 0; i < 4; ++i) { const int row = (lane >> 3) + 8 * i;
            const v4u ov = *(const LAS v4u*)(Vt + row * 144 + (lane & 7) * 16);
            *(unsigned long long*)(mix8 + (size_t)(b * S + q0 + row) * D + h * 64 + (lane & 7) * 8) = (unsigned long long)pk4_fp8(bf2f(ov.x & 0xffffu), bf2f(ov.x >> 16), bf2f(ov.y & 0xffffu), bf2f(ov.y >> 16))
                | ((unsigned long long)pk4_fp8(bf2f(ov.z & 0xffffu), bf2f(ov.z >> 16), bf2f(ov.w & 0xffffu), bf2f(ov.w >> 16)) << 32); }
        prep_store(bgd, lane, bgv);
    }
}

__global__ void __launch_bounds__(NTHR, 2) mega_fwd(MArgs args) {
    extern __shared__ __attribute__((aligned(16))) unsigned char lds[];
    LAS unsigned char* ldsl = (LAS unsigned char*)lds;
    const int tid = threadIdx.x, G = gridDim.x;
    volatile LAS unsigned* MISC = (volatile LAS unsigned*)(ldsl + XTRA_OFF + X_MISC);
    LAS int* tb = (LAS int*)(ldsl + XTRA_OFF + X_TB); LAS int* nn = (LAS int*)(ldsl + XTRA_OFF + X_NN);
    for (int u = tid; u < (LDS_BYTES - XTRA_OFF) / 4; u += NTHR) ((LAS unsigned*)(ldsl + XTRA_OFF))[u] = 0u;
    __syncthreads();
    unsigned char* ws = args.ws;
    unsigned* ctl = (unsigned*)(ws + WS_CTL);
    XcdBarrier bar = xcd_barrier_post(ctl + CW_BAR, MISC + 8);
    const int lo = args.ph_lo, hi = args.ph_hi;
#define IN(k) (lo <= (k) && (k) < hi)
#ifndef REP_MASK
#define REP_MASK 0
#endif
#define PHASE(k, ...) do { if (IN(k)) { for (int rep_ = 0; rep_ < (((REP_MASK >> (k)) & 1) ? 2 : 1); ++rep_) { if (rep_) xcd_barrier(bar); __VA_ARGS__ } } if (IN(k) && IN((k) + 1)) xcd_barrier(bar); } while (0)
    int* cnt = (int*)ctl + CW_CNT; i32x2* list = (i32x2*)(ws + WS_ROUTE + 2 * MiB); float* topg = (float*)(ws + WS_ROUTE + 1 * MiB);
    PHASE(0, ph_mod_prep(args, lds, G););
    PHASE(1, ph_ln1(args, lds, G););
    PHASE(2, { pg8::StaticOrder So; So.init(ws + WS_U1, ws + WS_WTIN, T, NPROJ, D, G, blockIdx.x);
        pg8::EpiF8 E{(unsigned char*)(ws + WS_PROJ), NPROJ, 2, QSCALE, 1.f / 64.f};
        pg8::gemm_phase<pg8::EpiF8, pg8::StaticOrder, false, true>(ldsl, D, So, E); });
    PHASE(3, ml_phaseA(args, ldsl, blockIdx.x, G););
    PHASE(4, ml_phaseB(args, ldsl, blockIdx.x, G); __syncthreads(); attn_phase((const unsigned char*)(ws + WS_PROJ), (unsigned char*)(ws + WS_MIX), ldsl, blockIdx.x, G, MAKE_PREP_ARGS(args)););
    PHASE(5, ml_phaseC(args, ldsl, G););
    PHASE(6, { pg8::StaticOrder So; So.init(ws + WS_MIX, ws + WS_WTOUT, T, D, D, G, blockIdx.x);
        pg8::EpiF8 E{(unsigned char*)(ws + WS_MIXOUT), D, 0, 1.f, 1.f / 64.f};
        pg8::gemm_phase<pg8::EpiF8, pg8::StaticOrder, false, true>(ldsl, D, So, E); });
    PHASE(7, ph_ln2(args, G););
    PHASE(8, { pg8::StaticOrder So; So.init(ws + WS_U2, ws + WS_WTR, T, NE, 2 * D, G, blockIdx.x);
        pg8::EpiF32 E{(float*)(ws + WS_LOGITS), NE};
        pg8::gemm_phase<pg8::EpiF32, pg8::StaticOrder, false, false>(ldsl, 2 * D, So, E); });
    PHASE(9, { const int lane_ = tid & 63; const f32x4 bias4 = *(const f32x4*)(args.in[13] + 4 * lane_); const PrepArgs pa = MAKE_PREP_ARGS(args);
        LAS int* hist = (LAS int*)ldsl;
        if (tid < NE) hist[tid] = 0;
        __syncthreads();
        int bgit = IT_SMALL + BG_TOTAL + blockIdx.x * NWAVES + (tid >> 6);
        for (int t = blockIdx.x * NWAVES + (tid >> 6); t < T; t += G * NWAVES) {
            const bool bg = bgit < IT_TOTAL; PrepDesc bgd = prep_decode(pa, bg ? bgit : IT_SMALL); f32x4 bgv[16];
            if (bg) prep_load(bgd, lane_, bgv);
            route_wave(t, lane_, (const float*)(ws + WS_LOGITS), bias4, (int*)(ws + WS_ROUTE), topg, hist);
            if (bg) prep_store(bgd, lane_, bgv);
            bgit += G * NWAVES; }
        __syncthreads();
        if (tid < NE) { const int hv = hist[tid]; if (hv) atomicAdd(cnt + tid * CSTR, hv); }
        __syncthreads(); });
    PHASE(10, { moe_tables(cnt, tb, nn); const int* tope = (const int*)(ws + WS_ROUTE); int* fill = (int*)ctl + CW_FILL;
        LAS int* hist = (LAS int*)ldsl; LAS int* hbase = hist + NE;
        for (int id0 = blockIdx.x * NTHR; id0 < T * TOPK; id0 += G * NTHR) {
            if (tid < NE) hist[tid] = 0;
            __syncthreads();
            const int id = id0 + tid; const int e = tope[id];
            const int rank = __hip_atomic_fetch_add(hist + e, 1, __ATOMIC_RELAXED, __HIP_MEMORY_SCOPE_WORKGROUP);
            __syncthreads();
            if (tid < NE) { const int hv = hist[tid]; hbase[tid] = hv ? atomicAdd(fill + tid * CSTR, hv) : 0; }
            __syncthreads();
            list[tb[e] * 256 + hbase[e] + rank] = (i32x2){id, __float_as_int(topg[id])};
            __syncthreads(); } });
    PHASE(11, { moe_tables(cnt, tb, nn);
        pg8::MoeOrder So{G, (int)blockIdx.x, tb[NEX] * 2, 1, tb, nn, list, (const char*)(ws + WS_U2F8), 0, (const char*)(ws + WS_WT13), (size_t)512 * D, (size_t)256 * D};
        pg8::EpiGlu E{(unsigned char*)(ws + WS_H), 1.f / 64.f};
        pg8::gemm_phase<pg8::EpiGlu, pg8::MoeOrder, true, true>(ldsl, D, So, E); });
    PHASE(12, { moe_tables(cnt, tb, nn);
        pg8::MoeOrder So{G, (int)blockIdx.x, tb[NEX] * 4, 2, tb, nn, list, (const char*)(ws + WS_H), (size_t)256 * FF, (const char*)(ws + WS_WT2), (size_t)D * FF, (size_t)256 * FF};
        pg8::EpiScatter E{(unsigned char*)(ws + WS_YS), (unsigned char*)(ws + WS_YSH), list, nn};
        pg8::gemm_phase<pg8::EpiScatter, pg8::MoeOrder, false, true>(ldsl, FF, So, E); });
    PHASE(13, ph_final(args, G););
#undef PHASE
#undef IN
}

__global__ void k_nan_fill(float* out, int n) { for (int i = blockIdx.x * blockDim.x + threadIdx.x; i < n; i += gridDim.x * blockDim.x) out[i] = __builtin_nanf(""); }
extern "C" void kernel_launch(void* const* d_in, const int* in_sizes, int n_in, void* d_out, int out_size, void* d_ws, size_t ws_size, hipStream_t stream) {
    static int grid = 0;
    if (grid == 0) {
        int dev = 0, cus = 0, per_cu = 0; grid = -1;
        if (n_in != 22 || out_size != T * D || ws_size < WS_END) fprintf(stderr, "kernel_launch: unexpected shapes (n_in %d out %d ws %zu, need %zu)\n", n_in, out_size, ws_size, (size_t)WS_END);
        else if (hipGetDevice(&dev) != hipSuccess || hipDeviceGetAttribute(&cus, hipDeviceAttributeMultiprocessorCount, dev) != hipSuccess) fprintf(stderr, "kernel_launch: device query failed\n");
        else if (hipFuncSetAttribute((const void*)mega_fwd, hipFuncAttributeMaxDynamicSharedMemorySize, LDS_BYTES) != hipSuccess) fprintf(stderr, "kernel_launch: hipFuncSetAttribute failed\n");
        else if (hipOccupancyMaxActiveBlocksPerMultiprocessor(&per_cu, (const void*)mega_fwd, NTHR, LDS_BYTES) != hipSuccess || per_cu < 1) fprintf(stderr, "kernel_launch: occupancy query says %d blocks per CU\n", per_cu);
        else grid = cus;
        (void)hipGetLastError();
    }
    if (grid < 0) { k_nan_fill<<<1024, 256, 0, stream>>>((float*)d_out, out_size); return; }
    char* ws = (char*)d_ws;
    (void)hipMemsetAsync(ws + WS_CTL, 0, 1 * MiB, stream);
    MArgs a{};
    for (int i = 0; i < 22; ++i) a.in[i] = (const float*)d_in[i];
    a.out = (float*)d_out; a.ws = (unsigned char*)d_ws; a.ph_lo = 0; a.ph_hi = N_PHASES;
    hipLaunchKernelGGL(mega_fwd, dim3(grid), dim3(NTHR), LDS_BYTES, stream, a);
}
```

```cpp
#include <hip/hip_runtime.h>
#include <cstdio>
#include <cstdint>

typedef unsigned short bf16;
typedef unsigned v4u __attribute__((ext_vector_type(4)));
typedef float f32x4 __attribute__((ext_vector_type(4)));
typedef int i32x2 __attribute__((ext_vector_type(2)));
typedef float f32x2 __attribute__((ext_vector_type(2)));

constexpr int D = 1024, NB = 4, S = 8192, T = NB * S;
constexpr int NPROJ = 3584, WIN_LD = 3592;
constexpr int C_SBQ = 0, C_SBK = 512, C_SBV = 1024, C_MLQ = 1536, C_MLK = 2048, C_MLV = 2560, C_MLO = 3072, C_GATE = 3584;
constexpr int NE = 256, NEX = 257, TOPK = 8, FF = 256;
constexpr float LN_EPS = 1e-5f;
constexpr float DN_ALPHA = 1.189207115002721f;
constexpr float LOG2E = 1.4426950408889634f;
constexpr float QSCALE = 0.125f * LOG2E;
constexpr float SB_THRESH = 48.0f;

constexpr size_t MiB = 1u << 20;
constexpr size_t WS_CTL = 0;
constexpr size_t WS_MOD = 1 * MiB;
constexpr size_t WS_WTIN = 2 * MiB;
constexpr size_t WS_WTOUT = 10 * MiB;
constexpr size_t WS_WTR = 12 * MiB;
constexpr size_t WS_WT2 = 16 * MiB;
constexpr size_t WS_YS = 145 * MiB;
constexpr size_t WS_WT13 = 145 * MiB;
constexpr size_t WS_U2F8 = 274 * MiB;
constexpr size_t WS_PROJ = 490 * MiB;
constexpr size_t WS_GATES = 626 * MiB;
constexpr size_t WS_H = 402 * MiB;
constexpr size_t WS_HS = WS_H + 80 * MiB;
constexpr size_t WS_X1 = 757 * MiB;
constexpr size_t WS_STATES = 657 * MiB;
constexpr size_t WS_MIXOUT = 657 * MiB;
constexpr size_t WS_LOGITS = 657 * MiB;
constexpr size_t WS_U1 = 725 * MiB;
constexpr size_t WS_MIX = 725 * MiB;
constexpr size_t WS_U2 = 833 * MiB;
constexpr size_t WS_YSH = 833 * MiB;
constexpr size_t WS_ROUTE = 897 * MiB;
constexpr size_t WS_END = 902 * MiB;
constexpr int CSTR = 32;
constexpr int CW_CNT = 16384;
constexpr int CW_FILL = 32768;

__device__ __forceinline__ unsigned f2bf(float f) { unsigned u = __builtin_bit_cast(unsigned, f); return (u + 0x7fffu + ((u >> 16) & 1u)) >> 16; }
__device__ __forceinline__ float bf2f(unsigned b) { return __builtin_bit_cast(float, b << 16); }
__device__ __forceinline__ unsigned pk2(float lo, float hi) { return f2bf(lo) | (f2bf(hi) << 16); }
__device__ __forceinline__ unsigned pk4_fp8(float a, float b, float c, float d) { int w = 0; w = __builtin_amdgcn_cvt_pk_fp8_f32(a, b, w, false); w = __builtin_amdgcn_cvt_pk_fp8_f32(c, d, w, true); return (unsigned)w; }
__device__ __forceinline__ float wave_sum(float v) {
    v += __builtin_bit_cast(float, __builtin_amdgcn_update_dpp(0, __builtin_bit_cast(int, v), 0xB1, 0xF, 0xF, true));
    v += __builtin_bit_cast(float, __builtin_amdgcn_update_dpp(0, __builtin_bit_cast(int, v), 0x4E, 0xF, 0xF, true));
    v += __builtin_bit_cast(float, __builtin_amdgcn_update_dpp(0, __builtin_bit_cast(int, v), 0x141, 0xF, 0xF, true));
    v += __builtin_bit_cast(float, __builtin_amdgcn_update_dpp(0, __builtin_bit_cast(int, v), 0x140, 0xF, 0xF, true));
    const int iv = __builtin_bit_cast(int, v);
    const float r0 = __builtin_bit_cast(float, __builtin_amdgcn_readlane(iv, 0)), r1 = __builtin_bit_cast(float, __builtin_amdgcn_readlane(iv, 16));
    const float r2 = __builtin_bit_cast(float, __builtin_amdgcn_readlane(iv, 32)), r3 = __builtin_bit_cast(float, __builtin_amdgcn_readlane(iv, 48));
    return (r0 + r1) + (r2 + r3);
}
__device__ __forceinline__ float sigmoidf_(float x) { return 1.f / (1.f + __expf(-x)); }
__device__ __forceinline__ float siluf_(float x) { return x / (1.f + __expf(-x)); }


struct PrepArgs { const float *w_in, *w_out, *w_router, *w1, *w3, *w2, *sw1, *sw3, *sw2; unsigned char* wtin; bf16 *wtout, *wtr; unsigned char* wt13; unsigned char* wt2; };
struct PrepDesc { const float* src; unsigned char* dst; int ldw, ldt, k0, n0, rowmap, f8; };
constexpr int IT_IN = 16 * 56, IT_OUT = 16 * 16, IT_R = 16 * 4, IT_E = 192, IT_TOTAL = IT_IN + IT_OUT + IT_R + NEX * IT_E;
__device__ __forceinline__ PrepDesc prep_decode(const PrepArgs& a, int it) {
    if (it < IT_IN) return PrepDesc{a.w_in, a.wtin, WIN_LD, D, (it / 112) * 128, (it % 112) * 32, 0, 1}; it -= IT_IN;
    if (it < IT_OUT) return PrepDesc{a.w_out, (unsigned char*)a.wtout, D, D, (it / 32) * 128, (it % 32) * 32, 0, 1}; it -= IT_OUT;
    if (it < IT_R) return PrepDesc{a.w_router, (unsigned char*)a.wtr, NE, D, (it / 4) * 64, (it % 4) * 64, 0, 0}; it -= IT_R;
    const int e = it / IT_E, r = it % IT_E;
    if (r < 64) return PrepDesc{e < NE ? a.w1 + (size_t)e * D * FF : a.sw1, a.wt13 + (size_t)e * 512 * D, FF, D, (r / 8) * 128, (r % 8) * 32, 1, 1};
    if (r < 128) { const int q = r - 64; return PrepDesc{e < NE ? a.w3 + (size_t)e * D * FF : a.sw3, a.wt13 + (size_t)e * 512 * D, FF, D, (q / 8) * 128, (q % 8) * 32, 2, 1}; }
    const int q = r - 128; return PrepDesc{e < NE ? a.w2 + (size_t)e * FF * D : a.sw2, a.wt2 + (size_t)e * D * FF, D, FF, (q / 32) * 128, (q % 32) * 32, 0, 1};
}
__device__ __forceinline__ void prep_load(const PrepDesc& d, int lane, f32x4 (&v)[16]) {
    const int g = d.f8 ? (lane >> 3) : (lane >> 4), i = d.f8 ? (lane & 7) : (lane & 15);
#pragma unroll
    for (int r = 0; r < 16; ++r) v[r] = __builtin_nontemporal_load((const f32x4*)(d.src + (size_t)(d.k0 + 16 * g + r) * d.ldw + d.n0 + 4 * i));
}
__device__ __forceinline__ void prep_store(const PrepDesc& d, int lane, const f32x4 (&v)[16]) {
    const int g = d.f8 ? (lane >> 3) : (lane >> 4), i = d.f8 ? (lane & 7) : (lane & 15);
#pragma unroll
    for (int nn = 0; nn < 4; ++nn) {
        const int n = d.n0 + 4 * i + nn;
        const int dr = d.rowmap == 0 ? n : ((n >> 7) * 256 + (d.rowmap == 2 ? 128 : 0) + (n & 127));
        if (d.f8) {
            v4u o; o.x = pk4_fp8(v[0][nn] * 64.f, v[1][nn] * 64.f, v[2][nn] * 64.f, v[3][nn] * 64.f); o.y = pk4_fp8(v[4][nn] * 64.f, v[5][nn] * 64.f, v[6][nn] * 64.f, v[7][nn] * 64.f);
            o.z = pk4_fp8(v[8][nn] * 64.f, v[9][nn] * 64.f, v[10][nn] * 64.f, v[11][nn] * 64.f); o.w = pk4_fp8(v[12][nn] * 64.f, v[13][nn] * 64.f, v[14][nn] * 64.f, v[15][nn] * 64.f);
            __builtin_nontemporal_store(o, (v4u*)(d.dst + (size_t)dr * d.ldt + d.k0 + 16 * g));
        } else {
            v4u o0, o1; o0.x = pk2(v[0][nn], v[1][nn]); o0.y = pk2(v[2][nn], v[3][nn]); o0.z = pk2(v[4][nn], v[5][nn]); o0.w = pk2(v[6][nn], v[7][nn]);
            o1.x = pk2(v[8][nn], v[9][nn]); o1.y = pk2(v[10][nn], v[11][nn]); o1.z = pk2(v[12][nn], v[13][nn]); o1.w = pk2(v[14][nn], v[15][nn]);
            v4u* dp = (v4u*)((bf16*)d.dst + (size_t)dr * d.ldt + d.k0 + 16 * g); dp[0] = o0; dp[1] = o1;
        }
    }
}
constexpr int IT_SMALL = IT_IN + IT_OUT + IT_R;
constexpr int BG_A = 16 * (S / 64) * 8, BG_C = BG_A, BG_T = NB * 8 * (S / 32), BG_TOTAL = BG_A + BG_C + BG_T;
constexpr int IT_FG = IT_SMALL + IT_E;
static_assert(IT_SMALL + BG_TOTAL <= IT_TOTAL, "background slots exceed the expert items");
__device__ __forceinline__ int prep_fg_item(int j) { return j < IT_SMALL ? j : IT_TOTAL - IT_E + (j - IT_SMALL); }
__device__ __forceinline__ void prep_run(const PrepArgs& a, int it0, int stride, int lane) {
    int it = it0; if (it >= IT_FG) return;
    PrepDesc dA = prep_decode(a, prep_fg_item(it)), dB = dA; f32x4 va[16], vb[16]; prep_load(dA, lane, va);
    for (;;) {
        const int itB = it + stride; const bool hasB = itB < IT_FG;
        if (hasB) { dB = prep_decode(a, prep_fg_item(itB)); prep_load(dB, lane, vb); }
        prep_store(dA, lane, va);
        if (!hasB) break;
        const int itA = itB + stride; const bool hasA = itA < IT_FG;
        if (hasA) { dA = prep_decode(a, prep_fg_item(itA)); prep_load(dA, lane, va); }
        prep_store(dB, lane, vb);
        if (!hasA) break;
        it = itA;
    }
}
__device__ __forceinline__ void prep_run_range(const PrepArgs& a, int it0, int stride, int end, int lane) {
    int it = it0; if (it >= end) return;
    PrepDesc dA = prep_decode(a, it), dB = dA; f32x4 va[16], vb[16]; prep_load(dA, lane, va);
    for (;;) {
        const int itB = it + stride; const bool hasB = itB < end;
        if (hasB) { dB = prep_decode(a, itB); prep_load(dB, lane, vb); }
        prep_store(dA, lane, va);
        if (!hasB) break;
        const int itA = itB + stride; const bool hasA = itA < end;
        if (hasA) { dA = prep_decode(a, itA); prep_load(dA, lane, va); }
        prep_store(dB, lane, vb);
        if (!hasA) break;
        it = itA;
    }
}


__device__ __forceinline__ f32x4 ld_bf4(const bf16* p) { const unsigned long long w = *(const unsigned long long*)p;
    return (f32x4){bf2f((unsigned)w & 0xffffu), bf2f(((unsigned)w) >> 16), bf2f((unsigned)(w >> 32) & 0xffffu), bf2f((unsigned)(w >> 48))}; }

#define LAS __attribute__((address_space(3)))
#define GAS __attribute__((address_space(1)))
namespace pg8 {
typedef short bf16x8 __attribute__((ext_vector_type(8)));
constexpr int F8_SCALE_W = 121;
constexpr int BM = 256, BK = 64, HALF = 128, HTB = HALF * BK * 2, STAGE_BYTES = 8 * HTB, NXCD = 8, WGM = 8;
__host__ __device__ __forceinline__ int lds_byte(int r, int c) { const int st = (r >> 4) * 2 + (c >> 5), rr = r & 15, cc = c & 31, ob = rr * 64 + cc * 2; return st * 1024 + (ob ^ (((ob >> 9) & 1) << 5)); }
__host__ __device__ __forceinline__ void stage_rc(int b, int& R, int& C) { const int st = b / 1024, sb = b % 1024, swz = sb ^ (((sb >> 9) & 1) << 5); R = (st >> 1) * 16 + swz / 64; C = (st & 1) * 32 + (swz % 64) / 2; }
__host__ __device__ __forceinline__ int perm16x(int R) { return 64 * (R >> 5) + 16 * ((R & 15) >> 2) + 4 * ((R >> 4) & 1) + (R & 3); }
__host__ __device__ __forceinline__ int perm32(int rho) { const int n = rho >> 4, i = rho & 15; return 8 * (i >> 2) + 4 * n + (i & 3); }

struct Unit { int pm, pn, e, mt; const char* A; const char* B; };

__device__ __forceinline__ long unit_index(int i, int G, int c) { return (G % 8 == 0) ? ((long)(i * 8 + (c & 7)) * (G / 8) + (c >> 3)) : ((long)i * G + c); }

struct StaticOrder {
    static constexpr bool META = false; int nM, nN, nwg, G, c; const char* A; const char* B; size_t tstep;
    __device__ void init(const void* A_, const void* B_, int M, int N, int Kb, int G_, int c_) { nM = M / BM; nN = N / BM; nwg = nM * nN; G = G_; c = c_; A = (const char*)A_; B = (const char*)B_; tstep = (size_t)BM * Kb; }
    __device__ __forceinline__ bool next(int i, Unit& u) const {
        const long L = (long)i * G + c; if (L >= nwg) return false;
        int wgid = (int)L; { const int q = nwg / NXCD, r = nwg % NXCD, xcd = wgid % NXCD, off = wgid / NXCD; wgid = (xcd < r ? xcd * (q + 1) : r * (q + 1) + (xcd - r) * q) + off; }
        const int nig = WGM * nN, gid = wgid / nig, fm = gid * WGM, gsz = (nM - fm) < WGM ? (nM - fm) : WGM;
        u.pm = fm + ((wgid % nig) % gsz); u.pn = (wgid % nig) / gsz; u.e = 0; u.mt = u.pm; u.A = A + (size_t)u.pm * tstep; u.B = B + (size_t)u.pn * tstep; return true;
    }
    __device__ __forceinline__ int row_token(const Unit&, int, const LAS i32x2*) const { return 0; }
    __device__ __forceinline__ const char* meta_src(const Unit&) const { return nullptr; }
};

struct MoeOrder {
    static constexpr bool META = true;
    int G, c, total, shift; const LAS int* tb; const LAS int* nn; const i32x2* list;
    const char* Abase; size_t a_tile_stride; const char* Bbase; size_t b_exp_stride, b_pn_stride; const char* AbaseShared;
    __device__ __forceinline__ bool next(int i, Unit& u) const {
        const long L = unit_index(i, G, c); if (L >= total) return false;
        const int tile = (int)(L >> shift); u.pn = (int)(L & ((1 << shift) - 1));
        int lo = 0, hi = NEX; while (hi - lo > 1) { const int mid = (lo + hi) >> 1; if (tb[mid] <= tile) lo = mid; else hi = mid; }
        u.e = lo; u.mt = tile - tb[lo]; u.pm = tile;
        u.A = (lo >= NE && AbaseShared) ? AbaseShared + (size_t)u.mt * a_tile_stride : Abase + (size_t)tile * a_tile_stride; u.B = Bbase + (size_t)lo * b_exp_stride + (size_t)u.pn * b_pn_stride; return true;
    }
    __device__ __forceinline__ int row_token(const Unit& u, int row, const LAS i32x2* m) const {
        const int rr = u.mt * 256 + row;
        const int tok = m[row].x >> 3;
        return u.e >= NE ? rr : (rr < nn[u.e] ? tok : 0);
    }
    __device__ __forceinline__ const char* meta_src(const Unit& u) const { return (const char*)(list + (u.e < NE ? (size_t)u.e * T + (size_t)u.mt * 256 : (size_t)0)); }
};

struct SharedOrder {
    static constexpr bool META = false; int w, per, total; const char* A; const char* B;
    __device__ __forceinline__ bool next(int i, Unit& u) const {
        if (i >= per) return false; const int L = w * per + i; if (L >= total) return false;
        u.mt = L >> 1; u.pn = L & 1; u.pm = u.mt; u.e = NE; u.A = A + (size_t)u.mt * 256 * D; u.B = B + (size_t)u.pn * 256 * D; return true;
    }
    __device__ __forceinline__ int row_token(const Unit&, int, const LAS i32x2*) const { return 0; }
    __device__ __forceinline__ const char* meta_src(const Unit&) const { return nullptr; }
};

__device__ __forceinline__ unsigned cvt_pk_bf16(float lo, float hi) { unsigned r; asm volatile("v_cvt_pk_bf16_f32 %0, %1, %2" : "=v"(r) : "v"(lo), "v"(hi)); return r; }

struct EpiBf16 {
    static constexpr int PERM = 2; static constexpr bool PREFETCH = false; bf16* O; int ldc; int scale_tiles; float scale; float gscale;
    __device__ __forceinline__ void operator()(const f32x4 (&acc)[2][2][4][2], const Unit& u, int wr, int wc, int fr, int fq) const {
        const int row0 = u.pm * BM + wr * 64 + fr, col0 = u.pn * BM + wc * 64 + 16 * fq; const float sc = (u.pn < scale_tiles ? scale : 1.f) * gscale;
#pragma unroll
        for (int ai = 0; ai < 2; ++ai)
#pragma unroll
            for (int m = 0; m < 4; ++m) { bf16* rowp = O + (size_t)(row0 + ai * HALF + m * 16) * ldc + col0;
#pragma unroll
                for (int bj = 0; bj < 2; ++bj) { const f32x4 v0 = acc[ai][bj][m][0] * sc, v1 = acc[ai][bj][m][1] * sc;
                    v4u w; w.x = cvt_pk_bf16(v0[0], v0[1]); w.y = cvt_pk_bf16(v0[2], v0[3]); w.z = cvt_pk_bf16(v1[0], v1[1]); w.w = cvt_pk_bf16(v1[2], v1[3]);
                    *(v4u*)(rowp + bj * 8) = w; } }
    }
};
struct EpiF8 {
    static constexpr int PERM = 2; static constexpr bool PREFETCH = false; unsigned char* O; int ldc; int scale_tiles; float scale; float gscale;
    __device__ __forceinline__ void operator()(const f32x4 (&acc)[2][2][4][2], const Unit& u, int wr, int wc, int fr, int fq) const {
        const int row0 = u.pm * BM + wr * 64 + fr, col0 = u.pn * BM + wc * 64 + 16 * fq; const float sc = (u.pn < scale_tiles ? scale : 1.f) * gscale;
#pragma unroll
        for (int ai = 0; ai < 2; ++ai)
#pragma unroll
            for (int m = 0; m < 4; ++m) { const f32x4 a0 = acc[ai][0][m][0] * sc, a1 = acc[ai][0][m][1] * sc, b0 = acc[ai][1][m][0] * sc, b1 = acc[ai][1][m][1] * sc;
                v4u w; w.x = pk4_fp8(a0[0], a0[1], a0[2], a0[3]); w.y = pk4_fp8(a1[0], a1[1], a1[2], a1[3]); w.z = pk4_fp8(b0[0], b0[1], b0[2], b0[3]); w.w = pk4_fp8(b1[0], b1[1], b1[2], b1[3]);
                *(v4u*)(O + (size_t)(row0 + ai * HALF + m * 16) * ldc + col0) = w; }
    }
};
struct EpiF32 {
    static constexpr int PERM = 0; static constexpr bool PREFETCH = false; float* C; int ldc;
    __device__ __forceinline__ void operator()(const f32x4 (&acc)[2][2][4][2], const Unit& u, int wr, int wc, int fr, int fq) const {
        const int row0 = u.pm * BM + wr * 64 + fr, col0 = u.pn * BM + wc * 32 + 4 * fq;
#pragma unroll
        for (int ai = 0; ai < 2; ++ai)
#pragma unroll
            for (int m = 0; m < 4; ++m) { float* rowp = C + (size_t)(row0 + ai * HALF + m * 16) * ldc + col0;
#pragma unroll
                for (int bj = 0; bj < 2; ++bj)
#pragma unroll
                    for (int n = 0; n < 2; ++n) *(f32x4*)(rowp + bj * HALF + n * 16) = acc[ai][bj][m][n]; }
    }
};
struct EpiF32T {
    static constexpr int PERM = 0; static constexpr bool PREFETCH = false; float* C; int ldr;
    __device__ __forceinline__ void operator()(const f32x4 (&acc)[2][2][4][2], const Unit& u, int wr, int wc, int fr, int fq) const {
        const int row0 = u.pm * BM + wr * 64 + fr, col0 = u.pn * BM + wc * 32 + 4 * fq; float* base = C + ((size_t)(col0 >> 2) * ldr + row0) * 4;
#pragma unroll
        for (int bj = 0; bj < 2; ++bj)
#pragma unroll
            for (int n = 0; n < 2; ++n) { float* cp = base + (size_t)((bj * HALF + n * 16) >> 2) * ldr * 4;
#pragma unroll
                for (int ai = 0; ai < 2; ++ai)
#pragma unroll
                    for (int m = 0; m < 4; ++m) *(f32x4*)(cp + (ai * HALF + m * 16) * 4) = acc[ai][bj][m][n]; }
    }
};
struct EpiGlu {
    static constexpr int PERM = 1; static constexpr bool PREFETCH = false; unsigned char* H; float gscale;
    __device__ __forceinline__ void operator()(const f32x4 (&acc)[2][2][4][2], const Unit& u, int wr, int wc, int fr, int fq) const {
        const int row0 = u.pm * BM + wr * 64 + fr, col0 = u.pn * HALF + wc * 32 + 8 * fq;
#pragma unroll
        for (int ai = 0; ai < 2; ++ai)
#pragma unroll
            for (int m = 0; m < 4; ++m) { float h[8];
#pragma unroll
                for (int n = 0; n < 2; ++n)
#pragma unroll
                    for (int q = 0; q < 4; ++q) { const float a = acc[ai][0][m][n][q] * gscale; h[n * 4 + q] = a * __builtin_amdgcn_rcpf(1.f + __expf(-a)) * (acc[ai][1][m][n][q] * gscale); }
                *(unsigned long long*)(H + (size_t)(row0 + ai * HALF + m * 16) * FF + col0) = (unsigned long long)pk4_fp8(h[0], h[1], h[2], h[3]) | ((unsigned long long)pk4_fp8(h[4], h[5], h[6], h[7]) << 32); }
    }
};
struct EpiScatter {
    static constexpr int PERM = 2; static constexpr bool PREFETCH = true; unsigned char* ys8; unsigned char* ysh8; const LAS int* nn;
    __device__ __forceinline__ void operator()(const f32x4 (&acc)[2][2][4][2], const Unit& u, int wr, int wc, int fr, int fq, const LAS i32x2* meta) const {
        const int col0 = u.pn * BM + wc * 64 + 16 * fq; const int n = nn[u.e]; const bool routed = u.e < NE;
#pragma unroll
        for (int ai = 0; ai < 2; ++ai)
#pragma unroll
            for (int m = 0; m < 4; ++m) { const int row = ai * HALF + wr * 64 + m * 16 + fr, rr = u.mt * 256 + row; const i32x2 en = meta[row];
                if (rr < n) { const int id = routed ? en.x : rr; const float g = (routed ? __int_as_float(en.y) : 1.f) * (16.f / 64.f);
                    const f32x4 a0 = acc[ai][0][m][0] * g, a1 = acc[ai][0][m][1] * g, b0 = acc[ai][1][m][0] * g, b1 = acc[ai][1][m][1] * g;
                    v4u w; w.x = pk4_fp8(a0[0], a0[1], a0[2], a0[3]); w.y = pk4_fp8(a1[0], a1[1], a1[2], a1[3]); w.z = pk4_fp8(b0[0], b0[1], b0[2], b0[3]); w.w = pk4_fp8(b1[0], b1[1], b1[2], b1[3]);
                    *(v4u*)((routed ? ys8 : ysh8) + (size_t)id * D + col0) = w; } }
    }
};

typedef int i32x8 __attribute__((ext_vector_type(8)));
typedef int i32x4 __attribute__((ext_vector_type(4)));
template <bool FP8> struct FragT { struct A4 { bf16x8 v[4][2]; }; struct B2 { bf16x8 v[2][2]; }; };
template <> struct FragT<true> { struct A4 { i32x8 v[4]; }; struct B2 { i32x8 v[2]; }; };
template <class Epi, class Sched, bool GATHER, bool FP8>
__device__ __forceinline__ void gemm_phase(LAS unsigned char* lds, const int Kb, const Sched& S, const Epi& E, LAS unsigned char* meta = nullptr) {
    const int tid = threadIdx.x, wid = __builtin_amdgcn_readfirstlane(tid >> 6), lane = tid & 63, wr = wid >> 2, wc = wid & 3, fr = lane & 15, fq = lane >> 4;
    const int nt = Kb / 128;
    int sR[2], sC[2];
    unsigned voffA[2], voffB[2];
#pragma unroll
    for (int i = 0; i < 2; ++i) { stage_rc(tid * 16 + i * 8192, sR[i], sC[i]); const int Rb = Epi::PERM == 2 ? perm16x(sR[i]) : (Epi::PERM == 1 ? ((sR[i] & ~31) + perm32(sR[i] & 31)) : sR[i]);
        voffA[i] = (unsigned)(sR[i] * Kb + sC[i] * 2); voffB[i] = (unsigned)(Rb * Kb + sC[i] * 2); }
    const size_t kstep = (size_t)(BK * 2);
    const size_t hstep = (size_t)HALF * Kb;
    const size_t bhstep = Epi::PERM == 2 ? (size_t)8 * Kb : hstep;
    const unsigned ldsw = (unsigned)wid * 1024u;
    const int aoff = lds_byte(wr * 64 + fr, fq * 8), boff = lds_byte(wc * 32 + fr, fq * 8);
    unsigned gc[2][2], gn[2][2];
#define PG8_SA(b, h) (((b) * 2 + (h)) * HTB)
#define PG8_SB(b, h) ((4 + (b) * 2 + (h)) * HTB)
#define PG8_GLDS(src, bufoff, i) __builtin_amdgcn_global_load_lds((const unsigned*)(src), (LAS unsigned*)(lds + (bufoff) + ldsw + (i) * 8192), 16, 0, 0)
#define PG8_STAGE_B(bufoff, gbase) do { PG8_GLDS((const char*)(gbase) + voffB[0], bufoff, 0); PG8_GLDS((const char*)(gbase) + voffB[1], bufoff, 1); } while (0)
#define PG8_STAGE_A(bufoff, gbase, h, nx) do { if constexpr (GATHER) { const unsigned _o0 = (nx) ? gn[h][0] : gc[h][0], _o1 = (nx) ? gn[h][1] : gc[h][1]; \
            PG8_GLDS((const char*)(gbase) + _o0, bufoff, 0); PG8_GLDS((const char*)(gbase) + _o1, bufoff, 1); } \
        else { PG8_GLDS((const char*)(gbase) + (h) * hstep + voffA[0], bufoff, 0); PG8_GLDS((const char*)(gbase) + (h) * hstep + voffA[1], bufoff, 1); } } while (0)
#define PG8_LD2(dstv, p) do { if constexpr (FP8) { const i32x4 _lo = *(const LAS i32x4*)(p), _hi = *(const LAS i32x4*)((p) + 1024); dstv = __builtin_shufflevector(_lo, _hi, 0, 1, 2, 3, 4, 5, 6, 7); } } while (0)
#define PG8_LDA(dst, b, h) do { _Pragma("unroll") for (int m = 0; m < 4; ++m) { if constexpr (FP8) { PG8_LD2(dst.v[m], lds + PG8_SA(b, h) + aoff + m * 2048); } \
        else { _Pragma("unroll") for (int k = 0; k < 2; ++k) dst.v[m][k] = *(const LAS bf16x8*)(lds + PG8_SA(b, h) + aoff + m * 2048 + k * 1024); } } } while (0)
#define PG8_LDB(dst, b, h) do { _Pragma("unroll") for (int n = 0; n < 2; ++n) { if constexpr (FP8) { PG8_LD2(dst.v[n], lds + PG8_SB(b, h) + boff + n * 2048); } \
        else { _Pragma("unroll") for (int k = 0; k < 2; ++k) dst.v[n][k] = *(const LAS bf16x8*)(lds + PG8_SB(b, h) + boff + n * 2048 + k * 1024); } } } while (0)
#define PG8_MMA(ai, bj, At, Bt) do { __builtin_amdgcn_s_setprio(1); _Pragma("unroll") for (int m = 0; m < 4; ++m) _Pragma("unroll") for (int n = 0; n < 2; ++n) { \
        if constexpr (FP8) asm volatile("s_nop 1\n\tv_mfma_scale_f32_16x16x128_f8f6f4 %0, %1, %2, %0, %3, %3 op_sel_hi:[0,0,0]" : "+v"(acc[ai][bj][m][n]) : "v"(Bt.v[n]), "v"(At.v[m]), "v"(f8scale)); \
        else { _Pragma("unroll") for (int k = 0; k < 2; ++k) acc[ai][bj][m][n] = __builtin_amdgcn_mfma_f32_16x16x32_bf16(Bt.v[n][k], At.v[m][k], acc[ai][bj][m][n], 0, 0, 0); } } \
        __builtin_amdgcn_s_setprio(0); } while (0)
#define PG8_WAIT_V(n) asm volatile("s_waitcnt vmcnt(" #n ")" ::: "memory")
#define PG8_WAIT_L(n) asm volatile("s_waitcnt lgkmcnt(" #n ")" ::: "memory")
#define PG8_BAR __builtin_amdgcn_s_barrier()
#define PG8_SCHED __builtin_amdgcn_sched_barrier(0)
#define PG8_GATHER(dst, u, slot) do { _Pragma("unroll") for (int _h = 0; _h < 2; ++_h) _Pragma("unroll") for (int _i = 0; _i < 2; ++_i) \
        dst[_h][_i] = (unsigned)(S.row_token(u, _h * HALF + sR[_i], (const LAS i32x2*)(meta + (slot) * 2048)) * Kb + sC[_i] * 2); } while (0)
#define PG8_META(u, slot) do { if constexpr (Sched::META) __builtin_amdgcn_global_load_lds((const unsigned*)(S.meta_src(u) + wid * 256 + lane * 4), (LAS unsigned*)(meta + (slot) * 2048 + wid * 256), 4, 0, 0); } while (0)
    Unit cur, nxt; int ui = 0;
    if (!S.next(0, cur)) return;
    f32x4 acc[2][2][4][2];
#pragma unroll
    for (int a = 0; a < 2; ++a)
#pragma unroll
        for (int b = 0; b < 2; ++b)
#pragma unroll
            for (int m = 0; m < 4; ++m)
#pragma unroll
                for (int n = 0; n < 2; ++n) acc[a][b][m][n] = (f32x4){0.f, 0.f, 0.f, 0.f};
    const int f8scale = 0x7f7f7f7f;
    typedef typename FragT<FP8>::A4 FragA; typedef typename FragT<FP8>::B2 FragB;
    FragA At; FragB B0, B1;
    const char* cA = cur.A; const char* cB = cur.B;
    int ms = 0;
    PG8_META(cur, 0);
    if constexpr (GATHER) { PG8_WAIT_V(0); PG8_BAR; PG8_GATHER(gc, cur, 0); }
    PG8_STAGE_B(PG8_SB(0, 0), cB); PG8_STAGE_B(PG8_SB(0, 1), cB + bhstep); PG8_STAGE_A(PG8_SA(0, 0), cA, 0, false); PG8_STAGE_A(PG8_SA(0, 1), cA, 1, false);
    if (wr == 1) PG8_BAR;
    PG8_WAIT_V(2); PG8_BAR;
    PG8_STAGE_B(PG8_SB(1, 0), cB + kstep); PG8_STAGE_A(PG8_SA(1, 0), cA + kstep, 0, false); PG8_STAGE_B(PG8_SB(1, 1), cB + bhstep + kstep);
    PG8_WAIT_V(6); PG8_BAR;
    for (;;) {
        const bool has_next = S.next(ui + 1, nxt);
        const char* nA = has_next ? nxt.A : cA; const char* nB = has_next ? nxt.B : cB;
        const int mn = ms == 2 ? 0 : ms + 1;
        if (has_next) PG8_META(nxt, mn);
#pragma unroll 1
        for (int t = 0; t < nt; t += 2) {
            const bool last = (t == nt - 2);
            if constexpr (GATHER) { if (last) { if (has_next) { PG8_GATHER(gn, nxt, mn); } else {
#pragma unroll
                for (int h = 0; h < 2; ++h) { gn[h][0] = gc[h][0]; gn[h][1] = gc[h][1]; } } } }
            const char* a1 = cA + (size_t)(t + 1) * kstep;
            const char* a2 = last ? nA : cA + (size_t)(t + 2) * kstep; const char* b2 = last ? nB : cB + (size_t)(t + 2) * kstep;
            const char* a3 = a2 + kstep; const char* b3 = b2 + kstep;
            PG8_LDB(B0, 0, 0); PG8_LDB(B1, 0, 1); PG8_SCHED; PG8_LDA(At, 0, 0); PG8_STAGE_A(PG8_SA(1, 1), a1, 1, false);
            PG8_WAIT_V(8); PG8_WAIT_L(0); PG8_BAR; PG8_MMA(0, 0, At, B0); PG8_MMA(0, 1, At, B1); PG8_BAR; PG8_SCHED;
            PG8_LDA(At, 0, 1); PG8_STAGE_B(PG8_SB(0, 0), b2); PG8_STAGE_B(PG8_SB(0, 1), b2 + bhstep); PG8_STAGE_A(PG8_SA(0, 0), a2, 0, last);
            PG8_WAIT_V(8); PG8_WAIT_L(0); PG8_BAR; PG8_MMA(1, 0, At, B0); PG8_MMA(1, 1, At, B1); PG8_BAR; PG8_SCHED;
            PG8_LDB(B0, 1, 0); PG8_LDB(B1, 1, 1); PG8_SCHED; PG8_LDA(At, 1, 0); PG8_STAGE_A(PG8_SA(0, 1), a2, 1, last);
            PG8_WAIT_V(8); PG8_WAIT_L(0); PG8_BAR; PG8_MMA(0, 0, At, B0); PG8_MMA(0, 1, At, B1); PG8_BAR; PG8_SCHED;
            PG8_LDA(At, 1, 1); PG8_STAGE_B(PG8_SB(1, 0), b3); PG8_STAGE_B(PG8_SB(1, 1), b3 + bhstep); PG8_STAGE_A(PG8_SA(1, 0), a3, 0, last);
            PG8_WAIT_V(8); PG8_WAIT_L(0); PG8_BAR; PG8_MMA(1, 0, At, B0); PG8_MMA(1, 1, At, B1); PG8_BAR; PG8_SCHED;
        }
        if (wr == 0) PG8_BAR;
        if constexpr (FP8) { __builtin_amdgcn_sched_barrier(0); asm volatile("s_nop 15\n\ts_nop 7" ::: "memory"); __builtin_amdgcn_sched_barrier(0); }
        if constexpr (Epi::PREFETCH) E(acc, cur, wr, wc, fr, fq, (const LAS i32x2*)(meta + ms * 2048)); else E(acc, cur, wr, wc, fr, fq);
        if (!has_next) break;
#pragma unroll
        for (int a = 0; a < 2; ++a)
#pragma unroll
            for (int b = 0; b < 2; ++b)
#pragma unroll
                for (int m = 0; m < 4; ++m)
#pragma unroll
                    for (int n = 0; n < 2; ++n) acc[a][b][m][n] = (f32x4){0.f, 0.f, 0.f, 0.f};
        cur = nxt; cA = nA; cB = nB; ++ui; ms = mn;
        if (wr == 1) PG8_BAR;
        if constexpr (GATHER) {
#pragma unroll
            for (int h = 0; h < 2; ++h) { gc[h][0] = gn[h][0]; gc[h][1] = gn[h][1]; } }
    }
    PG8_WAIT_V(0);
    PG8_BAR;
#undef PG8_SA
#undef PG8_SB
#undef PG8_GLDS
#undef PG8_STAGE_A
#undef PG8_STAGE_B
#undef PG8_LDA
#undef PG8_LDB
#undef PG8_MMA
#undef PG8_WAIT_V
#undef PG8_WAIT_L
#undef PG8_BAR
#undef PG8_SCHED
#undef PG8_GATHER
#undef PG8_META
}
}

#define XB_TMO      128
#define XB_XCNT(j)  (256  + 64 * (j))
#define XB_XSUB(j)  (1280 + 64 * (j))
#define XB_XGEN(j)  (2304 + 64 * (j))
#define XB_TOP      3328
#define XB_TOPGEN   3392
#define XCD_BAR_WORDS 3456
#define XB_SPIN_CAP (1u << 22)
__device__ __forceinline__ unsigned xb_ld(unsigned* p)              { return __hip_atomic_load(p, __ATOMIC_RELAXED, __HIP_MEMORY_SCOPE_AGENT); }
__device__ __forceinline__ unsigned xb_add(unsigned* p, unsigned v) { return __hip_atomic_fetch_add(p, v, __ATOMIC_RELAXED, __HIP_MEMORY_SCOPE_AGENT); }
__device__ __forceinline__ unsigned xb_xcc_id() { return (unsigned)__builtin_amdgcn_s_getreg((3 << 11) | 20) & 0xFu; }
#define XB_SPIN(cond, bar) do { unsigned _sp = 0; while (cond) { __builtin_amdgcn_s_sleep(1); \
    if ((++_sp & 255u) == 0u) { if (xb_ld(&(bar)[XB_TMO])) break; if (_sp > XB_SPIN_CAP) { atomicAdd(&(bar)[XB_TMO], 1u); break; } } } } while (0)
struct XcdBarrier { unsigned* bar; unsigned x; volatile LAS unsigned* st; };
__device__ __forceinline__ XcdBarrier xcd_barrier_post(unsigned* bar, volatile LAS unsigned* st) {
    XcdBarrier b; b.bar = bar; b.x = xb_xcc_id(); b.st = st;
    if (threadIdx.x == 0) (void)xb_add(&bar[XB_XCNT(b.x)], 1u);
    return b;
}
__device__ __forceinline__ void xcd_barrier_complete(unsigned* bar, unsigned x, unsigned& nloc, unsigned& nx) {
    const unsigned G = gridDim.x * gridDim.y * gridDim.z;
    unsigned sum, cnt, mine, sp = 0u;
    for (;;) {
        sum = 0u; cnt = 0u; mine = 0u;
#pragma unroll
        for (unsigned j = 0; j < 16; ++j) { const unsigned c = xb_ld(&bar[XB_XCNT(j)]); sum += c; cnt += (c > 0u) ? 1u : 0u; mine = (j == x) ? c : mine; }
        if (sum == G) break;
        __builtin_amdgcn_s_sleep(1);
        if ((++sp & 255u) == 0u) { if (xb_ld(&bar[XB_TMO])) break; if (sp > XB_SPIN_CAP) { atomicAdd(&bar[XB_TMO], 1u); break; } }
    }
    nloc = mine > 0u ? mine : 1u; nx = cnt > 0u ? cnt : 1u;
}
__device__ __forceinline__ void xcd_barrier(const XcdBarrier& b) {
    asm volatile("s_waitcnt vmcnt(0)" ::: "memory");
    __syncthreads();
    if (threadIdx.x == 0) {
        unsigned* bar = b.bar;
        __builtin_amdgcn_s_waitcnt(0);
        unsigned nloc = b.st[0], nx = b.st[1];
        if (nloc == 0u) { xcd_barrier_complete(bar, b.x, nloc, nx); b.st[0] = nloc; b.st[1] = nx; }
        const unsigned old = xb_add(&bar[XB_XSUB(b.x)], 1u);
        const unsigned gen = old / nloc;
        if (old + 1u == (gen + 1u) * nloc) {
            __builtin_amdgcn_fence(__ATOMIC_RELEASE, "agent");
            asm volatile("s_waitcnt vmcnt(0)" ::: "memory");
            const unsigned og = xb_add(&bar[XB_TOP], 1u);
            const unsigned tg = og / nx;
            if (og + 1u == (tg + 1u) * nx) xb_add(&bar[XB_TOPGEN], 1u);
            else XB_SPIN(xb_ld(&bar[XB_TOPGEN]) == tg, bar);
            __builtin_amdgcn_fence(__ATOMIC_ACQUIRE, "agent");
            xb_add(&bar[XB_XGEN(b.x)], 1u);
            asm volatile("s_waitcnt vmcnt(0)" ::: "memory");
        } else {
            XB_SPIN(xb_ld(&bar[XB_XGEN(b.x)]) == gen, bar);
            __builtin_amdgcn_fence(__ATOMIC_ACQUIRE, "agent");
            asm volatile("s_waitcnt vmcnt(0)" ::: "memory");
        }
    }
    __syncthreads();
}

constexpr int NWAVES = 8, NTHR = 512;
constexpr int RING_BYTES = 131072, XTRA_OFF = RING_BYTES, LDS_BYTES = 147456;
constexpr int X_MISC = 0, X_TB = 256, X_NN = 1536, X_META = 4096, X_HIST = 10240, X_BIAS = 14336;
constexpr int CW_BAR = 4096;
constexpr int N_PHASES = 14;
struct MArgs { const float* in[22]; float* out; unsigned char* ws; int ph_lo, ph_hi; };

#define MAKE_PREP_ARGS(a) PrepArgs{(a).in[4], (a).in[9], (a).in[12], (a).in[14], (a).in[15], (a).in[16], (a).in[17], (a).in[18], (a).in[19], \
    (unsigned char*)((a).ws + WS_WTIN), (bf16*)((a).ws + WS_WTOUT), (bf16*)((a).ws + WS_WTR), (unsigned char*)((a).ws + WS_WT13), (unsigned char*)((a).ws + WS_WT2)}
__device__ __forceinline__ void ph_mod_prep(const MArgs& a, unsigned char* smem, int G) {
    const int tid = threadIdx.x;
    unsigned char* ws = a.ws;
    if ((int)blockIdx.x < 192) {
        float* sc = (float*)smem; float* red = sc + NB * D;
        const float* c = a.in[1]; const float* w_ada = a.in[2]; const float* b_ada = a.in[3]; float* mod = (float*)(ws + WS_MOD);
        for (int i = tid; i < NB * D; i += NTHR) sc[i] = siluf_(c[i]);
        __syncthreads();
        for (int it = blockIdx.x; it < 192; it += G) {
            const int kq = tid >> 5, jl = tid & 31, j = it * 32 + jl;
            float a0 = 0.f, a1 = 0.f, a2 = 0.f, a3 = 0.f;
#pragma unroll 16
            for (int kk = 0; kk < 64; ++kk) { const int k = kq * 64 + kk; const float w = w_ada[(size_t)k * 6144 + j];
                a0 += sc[k] * w; a1 += sc[D + k] * w; a2 += sc[2 * D + k] * w; a3 += sc[3 * D + k] * w; }
            red[(kq * 4 + 0) * 32 + jl] = a0; red[(kq * 4 + 1) * 32 + jl] = a1; red[(kq * 4 + 2) * 32 + jl] = a2; red[(kq * 4 + 3) * 32 + jl] = a3;
            __syncthreads();
            if (tid < 128) { const int b = tid >> 5; float s = b_ada[j];
#pragma unroll
                for (int q = 0; q < 16; ++q) s += red[(q * 4 + b) * 32 + jl];
                mod[b * 6144 + j] = s; }
            __syncthreads();
        }
    }
    const PrepArgs pa = MAKE_PREP_ARGS(a);
    const int lane = tid & 63, gw = blockIdx.x * NWAVES + (tid >> 6), ngw = G * NWAVES;
    prep_run(pa, gw, ngw, lane);
}

__device__ __forceinline__ void ph_ln1(const MArgs& a, unsigned char* smem, int G) {
    const int tid = threadIdx.x, lane = tid & 63, wave = tid >> 6;
    const float* x = a.in[0]; const float* w_in = a.in[4]; const float* gate_b = a.in[7];
    const float* mod = (const float*)(a.ws + WS_MOD); unsigned char* u1 = (unsigned char*)(a.ws + WS_U1); float* ipre = (float*)(a.ws + WS_GATES); float* logf = ipre + 16 * S;
    float* wg = (float*)smem;
    for (int i = tid; i < D * 2; i += NTHR) { const int k = i >> 1, half = i & 1, ln = (k & 255) >> 2, j = k >> 8, e = k & 3;
        *(f32x4*)(wg + half * 4096 + ((j * 4 + e) * 64 + ln) * 4) = *(const f32x4*)(w_in + (size_t)k * WIN_LD + C_GATE + 4 * half); }
    __syncthreads();
    for (int it = blockIdx.x; it < T / 128; it += G) {
        const int row0 = it * 128, b = row0 / S;
        f32x4 sh[4], sc[4];
#pragma unroll
        for (int j = 0; j < 4; ++j) { sh[j] = *(const f32x4*)(mod + b * 6144 + 4 * lane + 256 * j); sc[j] = *(const f32x4*)(mod + b * 6144 + 1024 + 4 * lane + 256 * j); }
        f32x4 nv[4];
#pragma unroll
        for (int j = 0; j < 4; ++j) nv[j] = __builtin_nontemporal_load((const f32x4*)(x + (size_t)(row0 + wave) * D) + lane + 64 * j);
        for (int rr = wave; rr < 128; rr += NWAVES) {
            const int row = row0 + rr;
            f32x4 v[4]; float s = 0.f;
#pragma unroll
            for (int j = 0; j < 4; ++j) { v[j] = nv[j]; s += (v[j].x + v[j].y) + (v[j].z + v[j].w); }
            if (rr + NWAVES < 128) {
#pragma unroll
                for (int j = 0; j < 4; ++j) nv[j] = __builtin_nontemporal_load((const f32x4*)(x + (size_t)(row + NWAVES) * D) + lane + 64 * j); }
            const float mean = wave_sum(s) * (1.f / D); float s2 = 0.f;
#pragma unroll
            for (int j = 0; j < 4; ++j) { v[j] = v[j] - mean; s2 += (v[j].x * v[j].x + v[j].y * v[j].y) + (v[j].z * v[j].z + v[j].w * v[j].w); }
            const float rstd = 1.f / sqrtf(wave_sum(s2) * (1.f / D) + LN_EPS);
            float ga[8];
#pragma unroll
            for (int q = 0; q < 8; ++q) ga[q] = 0.f;
            unsigned* o4 = (unsigned*)(u1 + (size_t)row * D) + lane;
#pragma unroll
            for (int j = 0; j < 4; ++j) {
                const f32x4 u = v[j] * rstd * (sc[j] + 1.0f) + sh[j];
                o4[64 * j] = pk4_fp8(u.x, u.y, u.z, u.w);
#pragma unroll
                for (int e = 0; e < 4; ++e) { const f32x4 w0 = *(const f32x4*)(wg + ((j * 4 + e) * 64 + lane) * 4), w1 = *(const f32x4*)(wg + 4096 + ((j * 4 + e) * 64 + lane) * 4);
                    ga[0] += u[e] * w0.x; ga[1] += u[e] * w0.y; ga[2] += u[e] * w0.z; ga[3] += u[e] * w0.w;
                    ga[4] += u[e] * w1.x; ga[5] += u[e] * w1.y; ga[6] += u[e] * w1.z; ga[7] += u[e] * w1.w; }
            }
#pragma unroll
            for (int q = 0; q < 8; ++q) ga[q] = wave_sum(ga[q]);
            if (lane < 8) {
                float gv = 0.f;
#pragma unroll
                for (int q = 0; q < 8; ++q) gv = (lane == q) ? ga[q] : gv;
                gv += gate_b[lane];
                const int h = lane & 3, s_ = row % S;
                if (lane < 4) ipre[(size_t)(b * 4 + h) * S + s_] = gv;
                else logf[(size_t)(b * 4 + h) * S + s_] = fminf(gv, 0.f) - log1pf(__expf(-fabsf(gv)));
            }
        }
    }
}

__device__ __forceinline__ void ph_ln2(const MArgs& a, int G) {
    const float* x = a.in[0]; const unsigned char* mixout8 = (const unsigned char*)(a.ws + WS_MIXOUT); const float* mod = (const float*)(a.ws + WS_MOD); const float* ln1_g = a.in[10]; const float* ln1_b = a.in[11];
    bf16* x1 = (bf16*)(a.ws + WS_X1); bf16* u2 = (bf16*)(a.ws + WS_U2); unsigned char* u2f8 = (unsigned char*)(a.ws + WS_U2F8);
    const int tid = threadIdx.x, lane = tid & 63, wave = tid >> 6;
    for (int it = blockIdx.x; it < T / 128; it += G) {
        const int row0 = it * 128, b = row0 / S;
        f32x4 g1[4], lg[4], lb[4], sc2[4], sh2[4];
#pragma unroll
        for (int j = 0; j < 4; ++j) { const int col = 4 * lane + 256 * j;
            g1[j] = *(const f32x4*)(mod + b * 6144 + 2048 + col); lg[j] = *(const f32x4*)(ln1_g + col); lb[j] = *(const f32x4*)(ln1_b + col);
            sc2[j] = *(const f32x4*)(mod + b * 6144 + 4096 + col) + 1.0f; sh2[j] = *(const f32x4*)(mod + b * 6144 + 3072 + col); }
        for (int rr = wave; rr < 128; rr += NWAVES) {
            const int row = row0 + rr;
            f32x4 v[4]; float s = 0.f;
#pragma unroll
            for (int j = 0; j < 4; ++j) {
                const int col = 4 * lane + 256 * j;
                const f32x4 xv = __builtin_nontemporal_load((const f32x4*)(x + (size_t)row * D + col));
                f32x4 mo; { const int w = *(const int*)(mixout8 + (size_t)row * D + col); const f32x2 lo = __builtin_amdgcn_cvt_pk_f32_fp8(w, false), hi = __builtin_amdgcn_cvt_pk_f32_fp8(w, true); mo = (f32x4){lo.x, lo.y, hi.x, hi.y}; }
                v[j] = xv * DN_ALPHA + g1[j] * mo; s += (v[j].x + v[j].y) + (v[j].z + v[j].w);
            }
            float mean = wave_sum(s) * (1.f / D), s2 = 0.f;
#pragma unroll
            for (int j = 0; j < 4; ++j) { v[j] = v[j] - mean; s2 += (v[j].x * v[j].x + v[j].y * v[j].y) + (v[j].z * v[j].z + v[j].w * v[j].w); }
            float rstd = 1.f / sqrtf(wave_sum(s2) * (1.f / D) + LN_EPS);
            s = 0.f;
#pragma unroll
            for (int j = 0; j < 4; ++j) { const int col = 4 * lane + 256 * j;
                v[j] = v[j] * rstd * lg[j] + lb[j];
                __builtin_nontemporal_store((unsigned long long)pk2(v[j].x, v[j].y) | ((unsigned long long)pk2(v[j].z, v[j].w) << 32), (unsigned long long*)(x1 + (size_t)row * D + col)); s += (v[j].x + v[j].y) + (v[j].z + v[j].w); }
            mean = wave_sum(s) * (1.f / D); s2 = 0.f;
#pragma unroll
            for (int j = 0; j < 4; ++j) { v[j] = v[j] - mean; s2 += (v[j].x * v[j].x + v[j].y * v[j].y) + (v[j].z * v[j].z + v[j].w * v[j].w); }
            rstd = 1.f / sqrtf(wave_sum(s2) * (1.f / D) + LN_EPS);
#pragma unroll
            for (int j = 0; j < 4; ++j) { const int col = 4 * lane + 256 * j;
                const f32x4 u = v[j] * rstd * sc2[j] + sh2[j];
                *(unsigned long long*)(u2 + (size_t)row * D + col) = (unsigned long long)pk2(u.x, u.y) | ((unsigned long long)pk2(u.z, u.w) << 32);
                *(unsigned*)(u2f8 + (size_t)row * D + col) = pk4_fp8(u.x, u.y, u.z, u.w); }
        }
    }
}
#define DPPI(v, ctrl) __builtin_amdgcn_update_dpp(0, (v), (ctrl), 0xF, 0xF, true)
#define DPPF(v, ctrl) __builtin_bit_cast(float, __builtin_amdgcn_update_dpp(0, __builtin_bit_cast(int, (v)), (ctrl), 0xF, 0xF, true))
__device__ __forceinline__ void route_tokens64(int t, int lane, const float* __restrict__ logitsT, const LAS float* bias, LAS unsigned char* sv, LAS int* hist, int* __restrict__ cnt, i32x2* __restrict__ list) {
    const float NINF = -__builtin_inff();
    float gs[8]; int es[8];
    *(LAS pg8::i32x4*)(hist + 4 * lane) = (pg8::i32x4){0, 0, 0, 0};
    const f32x4* lp = (const f32x4*)logitsT + t;
    f32x4 cur[8], nxt[8];
#pragma unroll
    for (int j = 0; j < 8; ++j) cur[j] = lp[(size_t)j * T];
#pragma unroll
    for (int g = 0; g < 8; ++g) { float m1 = NINF, m2 = NINF;
        if (g < 7) {
#pragma unroll
            for (int j = 0; j < 8; ++j) nxt[j] = lp[(size_t)((g + 1) * 8 + j) * T]; }
        __builtin_amdgcn_sched_barrier(0);
#pragma unroll
        for (int j4 = 0; j4 < 8; ++j4) { f32x4 v4; const f32x4 b4 = *(const LAS f32x4*)(bias + (g * 8 + j4) * 4);
#pragma unroll
            for (int q = 0; q < 4; ++q) { const float v = __builtin_amdgcn_rcpf(1.f + __expf(-cur[j4][q])) + b4[q]; v4[q] = v;
                m2 = fmaxf(m2, fminf(m1, v)); m1 = fmaxf(m1, v); }
            *(LAS f32x4*)(sv + ((g * 8 + j4) * 64 + lane) * 16) = v4; }
        gs[g] = m1 + m2;
        __builtin_amdgcn_sched_barrier(0);
#pragma unroll
        for (int j = 0; j < 8; ++j) cur[j] = nxt[j]; }
    int gid[4] = {0, 0, 0, 0}; int pos = 0;
#pragma unroll
    for (int g = 0; g < 8; ++g) { int rank = 0;
#pragma unroll
        for (int o = 0; o < 8; ++o) if (o != g) rank += (gs[o] > gs[g] || (gs[o] == gs[g] && o < g)) ? 1 : 0;
        const bool sel = rank < 4;
#pragma unroll
        for (int k = 0; k < 4; ++k) gid[k] = (sel && pos == k) ? g : gid[k];
        pos += sel ? 1 : 0; }
    int gb[4];
#pragma unroll
    for (int k = 0; k < 4; ++k) gb[k] = (gid[k] * 512 + lane) * 16;
#pragma unroll 1
    for (int r = 0; r < 8; ++r) { float bk[4]; int pk[4];
#pragma unroll
        for (int k = 0; k < 4; ++k) { bk[k] = NINF; pk[k] = k * 32; }
        f32x4 cq[4], nq[4];
#pragma unroll
        for (int k = 0; k < 4; ++k) cq[k] = *(const LAS f32x4*)(sv + gb[k]);
#pragma unroll
        for (int j4 = 0; j4 < 8; ++j4) {
            if (j4 < 7) {
#pragma unroll
                for (int k = 0; k < 4; ++k) nq[k] = *(const LAS f32x4*)(sv + gb[k] + (j4 + 1) * 1024); }
            __builtin_amdgcn_sched_barrier(0);
#pragma unroll
            for (int k = 0; k < 4; ++k)
#pragma unroll
                for (int q = 0; q < 4; ++q) { const bool gt = cq[k][q] > bk[k]; bk[k] = gt ? cq[k][q] : bk[k]; pk[k] = gt ? (k * 32 + j4 * 4 + q) : pk[k]; }
            __builtin_amdgcn_sched_barrier(0);
#pragma unroll
            for (int k = 0; k < 4; ++k) cq[k] = nq[k]; }
        float best = bk[0]; int bp = pk[0];
#pragma unroll
        for (int k = 1; k < 4; ++k) { const bool gt = bk[k] > best; best = gt ? bk[k] : best; bp = gt ? pk[k] : bp; }
        const int kk = bp >> 5, gk = kk == 0 ? gid[0] : (kk == 1 ? gid[1] : (kk == 2 ? gid[2] : gid[3])), e = gk * 32 + (bp & 31);
        *(LAS float*)(sv + ((e >> 2) * 64 + lane) * 16 + (e & 3) * 4) = NINF;
#pragma unroll
        for (int k = 0; k < 8; ++k) es[k] = (k == r) ? e : es[k]; }
    float sg[8]; float ssum = 0.f;
#pragma unroll
    for (int r = 0; r < 8; ++r) { sg[r] = __builtin_amdgcn_rcpf(1.f + __expf(-logitsT[((size_t)(es[r] >> 2) * T + t) * 4 + (es[r] & 3)])); ssum += sg[r]; }
    const float gscale = 2.5f / ssum; int rk[8];
#pragma unroll
    for (int r = 0; r < 8; ++r) rk[r] = __hip_atomic_fetch_add(hist + es[r], 1, __ATOMIC_RELAXED, __HIP_MEMORY_SCOPE_WORKGROUP);
    __builtin_amdgcn_fence(__ATOMIC_SEQ_CST, "workgroup");
    { LAS int* hbase = hist + NE;
#pragma unroll
      for (int j = 0; j < 4; ++j) { const int e = 4 * lane + j, hv = hist[e]; hbase[e] = atomicAdd(cnt + e * CSTR, hv); }
      __builtin_amdgcn_fence(__ATOMIC_SEQ_CST, "workgroup");
#pragma unroll
      for (int r = 0; r < 8; ++r) list[(size_t)es[r] * T + hbase[es[r]] + rk[r]] = (i32x2){t * 8 + r, __float_as_int(sg[r] * gscale)}; }
}
__device__ __forceinline__ void moe_tables(const int* cnt, LAS int* tb, LAS int* nn) {
    if (threadIdx.x < 64) {
        const int lane = threadIdx.x; int n[4], tl[4], loc = 0;
#pragma unroll
        for (int j = 0; j < 4; ++j) { n[j] = cnt[(4 * lane + j) * CSTR]; tl[j] = (n[j] + 255) >> 8; loc += tl[j]; }
        int inc = loc;
#pragma unroll
        for (int o = 1; o < 64; o <<= 1) { const int v = __shfl_up(inc, o); if (lane >= o) inc += v; }
        int base = inc - loc;
#pragma unroll
        for (int j = 0; j < 4; ++j) { tb[4 * lane + j] = base; nn[4 * lane + j] = n[j]; base += tl[j]; }
        if (lane == 63) { tb[NE] = base; nn[NE] = T; tb[NEX] = base + T / 256; }
    }
    __syncthreads();
}
__device__ __forceinline__ void ph_final(const MArgs& a, int G, float oscale = 1.f) {
    float* out = a.out; const bf16* x1 = (const bf16*)(a.ws + WS_X1); const unsigned char* ys8 = (const unsigned char*)(a.ws + WS_YS); const unsigned char* ysh8 = (const unsigned char*)(a.ws + WS_YSH); const float* mod = (const float*)(a.ws + WS_MOD);
    const float* ln2_g = a.in[20]; const float* ln2_b = a.in[21];
    const int tid = threadIdx.x, lane = tid & 63, wave = tid >> 6;
    for (int it = blockIdx.x; it < T / 128; it += G) {
        const int row0 = it * 128, b = row0 / S;
        f32x4 g2[4], lg[4], lb[4];
#pragma unroll
        for (int j = 0; j < 4; ++j) { const int col = 4 * lane + 256 * j; g2[j] = *(const f32x4*)(mod + b * 6144 + 5120 + col); lg[j] = *(const f32x4*)(ln2_g + col); lb[j] = *(const f32x4*)(ln2_b + col); }
        for (int rr = wave; rr < 128; rr += NWAVES) {
            const int row = row0 + rr;
            f32x4 v[4]; float s = 0.f;
#pragma unroll
            for (int j = 0; j < 4; ++j) { const int col = 4 * lane + 256 * j;
                f32x4 yr = {0.f, 0.f, 0.f, 0.f};
#pragma unroll
                for (int k = 0; k < 8; ++k) { const int w = *(const int*)(ys8 + ((size_t)row * 8 + k) * D + col);
                    const f32x2 lo = __builtin_amdgcn_cvt_pk_f32_fp8(w, false), hi = __builtin_amdgcn_cvt_pk_f32_fp8(w, true); yr = yr + (f32x4){lo.x, lo.y, hi.x, hi.y}; }
                { const int w = *(const int*)(ysh8 + (size_t)row * D + col); const f32x2 lo = __builtin_amdgcn_cvt_pk_f32_fp8(w, false), hi = __builtin_amdgcn_cvt_pk_f32_fp8(w, true); yr = yr + (f32x4){lo.x, lo.y, hi.x, hi.y}; }
                const f32x4 y = yr * (1.f / 16.f);
                v[j] = ld_bf4(x1 + (size_t)row * D + col) * DN_ALPHA + g2[j] * y;
                s += (v[j].x + v[j].y) + (v[j].z + v[j].w); }
            const float mean = wave_sum(s) * (1.f / D); float s2 = 0.f;
#pragma unroll
            for (int j = 0; j < 4; ++j) { v[j] = v[j] - mean; s2 += (v[j].x * v[j].x + v[j].y * v[j].y) + (v[j].z * v[j].z + v[j].w * v[j].w); }
            const float rstd = 1.f / sqrtf(wave_sum(s2) * (1.f / D) + LN_EPS);
#pragma unroll
            for (int j = 0; j < 4; ++j) { const int col = 4 * lane + 256 * j;
                __builtin_nontemporal_store((v[j] * rstd * lg[j] + lb[j]) * oscale, (f32x4*)(out + (size_t)row * D + col)); }
        }
    }
}


typedef short s16x4 __attribute__((ext_vector_type(4)));
typedef short bf16x8v __attribute__((ext_vector_type(8)));
typedef float f32x16 __attribute__((ext_vector_type(16)));
constexpr int MLP = 320;
constexpr int NCH = S / 64;
constexpr int ST_ELEMS = 129 * 128;
constexpr float ST_SCALE = 16.f;
constexpr size_t WS_CHK = WS_GATES + 1 * MiB;
constexpr size_t WS_MPREV = WS_GATES + 1 * MiB + 65536;
constexpr size_t WS_KC = WS_U2;
__device__ __forceinline__ s16x4 tr_read(const LAS unsigned char* p) { return __builtin_bit_cast(s16x4, __builtin_amdgcn_ds_read_tr16_b64_v4i16((LAS s16x4*)p)); }
__device__ __forceinline__ bf16x8v tr_frag(const LAS unsigned char* tile, int row0, int col0, int lane) {
    const int i = lane & 15; const LAS unsigned char* p = tile + (row0 + (i >> 2)) * MLP + (col0 + 4 * (i & 3)) * 2;
    const s16x4 lo = tr_read(p), hi = tr_read(p + 4 * MLP);
    return __builtin_shufflevector(lo, hi, 0, 1, 2, 3, 4, 5, 6, 7);
}
__device__ __forceinline__ bf16x8v tr_frag_perm(const LAS unsigned char* tile, int row0, int col0, int lane) {
    const int i = lane & 15; const LAS unsigned char* p = tile + (row0 + (i >> 2)) * MLP + (col0 + 4 * (i & 3)) * 2;
    const s16x4 lo = tr_read(p), hi = tr_read(p + 8 * MLP);
    return __builtin_shufflevector(lo, hi, 0, 1, 2, 3, 4, 5, 6, 7);
}
__device__ __forceinline__ float wave_incl_sum(float v, int lane) {
#pragma unroll
    for (int o = 1; o < 64; o <<= 1) { const float u = __shfl_up(v, o); if (lane >= o) v += u; }
    return v;
}
__device__ __forceinline__ float wave_incl_max(float v, int lane) {
#pragma unroll
    for (int o = 1; o < 64; o <<= 1) { const float u = __shfl_up(v, o); if (lane >= o) v = fmaxf(v, u); }
    return v;
}
__device__ __forceinline__ float wave_max(float v) {
#pragma unroll
    for (int o = 1; o < 64; o <<= 1) v = fmaxf(v, __shfl_xor(v, o));
    return v;
}
__device__ __forceinline__ void cvt8_fp8(unsigned long long w, float (&f)[8]);
__device__ __forceinline__ void conv8_load(const unsigned char* __restrict__ rowp, int spos, unsigned long long (&xr)[4]) {
#pragma unroll
    for (int j = 0; j < 4; ++j) { const int back = (spos - 3 + j >= 0) ? (j - 3) : 0; xr[j] = *(const unsigned long long*)(rowp + (ptrdiff_t)back * NPROJ); }
}
__device__ __forceinline__ void conv8_math(const unsigned long long (&xr)[4], int spos, const float* __restrict__ cw, const float* __restrict__ cb, float scale, float (&y)[8]) {
    const f32x4 b0 = *(const f32x4*)cb, b1 = *(const f32x4*)(cb + 4);
    y[0] = b0.x; y[1] = b0.y; y[2] = b0.z; y[3] = b0.w; y[4] = b1.x; y[5] = b1.y; y[6] = b1.z; y[7] = b1.w;
#pragma unroll
    for (int j = 0; j < 4; ++j) {
        const float ok = (spos - 3 + j >= 0) ? 1.f : 0.f; float xf[8]; cvt8_fp8(xr[j], xf);
        const f32x4 w0 = *(const f32x4*)(cw + j * 1024) * ok, w1 = *(const f32x4*)(cw + j * 1024 + 4) * ok;
        y[0] += w0.x * xf[0]; y[1] += w0.y * xf[1]; y[2] += w0.z * xf[2]; y[3] += w0.w * xf[3];
        y[4] += w1.x * xf[4]; y[5] += w1.y * xf[5]; y[6] += w1.z * xf[6]; y[7] += w1.w * xf[7];
    }
#pragma unroll
    for (int e = 0; e < 8; ++e) y[e] = siluf_(y[e]) * scale;
}
__device__ __forceinline__ void conv8(const unsigned char* __restrict__ rowp, int spos, const float* __restrict__ cw, const float* __restrict__ cb, float scale, float (&y)[8]) {
    unsigned long long xr[4]; conv8_load(rowp, spos, xr); conv8_math(xr, spos, cw, cb, scale, y);
}
__device__ __forceinline__ void cvt8_fp8(unsigned long long w, float (&f)[8]) {
    const f32x2 a = __builtin_amdgcn_cvt_pk_f32_fp8((int)(unsigned)w, false), b = __builtin_amdgcn_cvt_pk_f32_fp8((int)(unsigned)w, true);
    const f32x2 c = __builtin_amdgcn_cvt_pk_f32_fp8((int)(unsigned)(w >> 32), false), d = __builtin_amdgcn_cvt_pk_f32_fp8((int)(unsigned)(w >> 32), true);
    f[0] = a.x; f[1] = a.y; f[2] = b.x; f[3] = b.y; f[4] = c.x; f[5] = c.y; f[6] = d.x; f[7] = d.y; }
__device__ __forceinline__ v4u pack8(const float (&y)[8]) { v4u o; o.x = pk2(y[0], y[1]); o.y = pk2(y[2], y[3]); o.z = pk2(y[4], y[5]); o.w = pk2(y[6], y[7]); return o; }

__device__ __forceinline__ void ml_phaseA(const MArgs& a, LAS unsigned char* lds, int vb0, int nvb) {
    const int tid = threadIdx.x, lane = tid & 63, wave = __builtin_amdgcn_readfirstlane(tid >> 6);
    const unsigned char* proj = (const unsigned char*)(a.ws + WS_PROJ); const float* conv_w = a.in[5]; const float* conv_b = a.in[6];
    const float* ipre = (const float*)(a.ws + WS_GATES); const float* logf = ipre + 16 * S;
    bf16* kcg = (bf16*)(a.ws + WS_KC); unsigned char* st = (unsigned char*)(a.ws + WS_STATES); float* chk = (float*)(a.ws + WS_CHK);
    LAS unsigned char* Kt = lds; LAS unsigned char* Vt = lds + 64 * MLP; LAS float* wkL = (LAS float*)(lds + 128 * MLP); LAS unsigned char* Stg = lds + 132 * MLP;
    const PrepArgs pa = MAKE_PREP_ARGS(a);
    unsigned long long kx[2][4], vx[2]; float lf = 0.f, ic = 0.f;
#define MLA_ISSUE(U) do { const int bh_ = (U) >> 7, c_ = (U) & (NCH - 1), b_ = bh_ >> 2, h_ = bh_ & 3, s0_ = c_ * 64; const size_t row0_ = (size_t)b_ * S + s0_; \
        _Pragma("unroll") for (int q = 0; q < 2; ++q) { const int it = tid + q * NTHR, tt = it >> 4, c8 = it & 15, ch = h_ * 128 + c8 * 8; \
            conv8_load(proj + (row0_ + tt) * NPROJ + C_MLK + ch, s0_ + tt, kx[q]); vx[q] = *(const unsigned long long*)(proj + (row0_ + tt) * NPROJ + C_MLV + ch); } \
        if (wave == 0) { lf = logf[(size_t)bh_ * S + s0_ + lane]; ic = ipre[(size_t)bh_ * S + s0_ + lane]; } } while (0)
    if (vb0 < 16 * NCH) MLA_ISSUE(vb0);
    for (int unit = vb0; unit < 16 * NCH; unit += nvb) {
        const int bh = unit >> 7, c = unit & (NCH - 1), b = bh >> 2, h = bh & 3, s0 = c * 64; const size_t row0 = (size_t)b * S + s0;
#pragma unroll
        for (int q = 0; q < 2; ++q) { const int it = tid + q * NTHR, tt = it >> 4, c8 = it & 15, ch = h * 128 + c8 * 8;
            float y[8]; conv8_math(kx[q], s0 + tt, conv_w + 512 + ch, conv_b + 512 + ch, 0.08838834764831845f, y);
            const v4u o = pack8(y);
            *(LAS v4u*)(Kt + tt * MLP + c8 * 16) = o; *(v4u*)(kcg + (row0 + tt) * 512 + ch) = o; }
        const unsigned long long vcur0 = vx[0], vcur1 = vx[1];
        if (wave == 0) {
            const float bc = wave_incl_sum(lf, lane), g = ic - bc, gmax = wave_max(g), blast = __shfl(bc, 63);
            wkL[lane] = __expf(g - gmax);
            if (lane == 0) { chk[(size_t)unit * 2] = blast; chk[(size_t)unit * 2 + 1] = blast + gmax; }
        }
        __syncthreads();
        if (unit + nvb < 16 * NCH) MLA_ISSUE(unit + nvb);
        const PrepDesc bgd = prep_decode(pa, IT_SMALL + unit * NWAVES + wave); f32x4 bgv[16]; prep_load(bgd, lane, bgv);
#pragma unroll
        for (int q = 0; q < 2; ++q) { const int it = tid + q * NTHR, tt = it >> 4, c8 = it & 15;
            float y[8]; cvt8_fp8(q == 0 ? vcur0 : vcur1, y); const float w = wkL[tt];
#pragma unroll
            for (int e = 0; e < 8; ++e) y[e] *= w;
            *(LAS v4u*)(Vt + tt * MLP + c8 * 16) = pack8(y); }
        __syncthreads();
        {
            const int dvb = wave >> 1, dkh = wave & 1, hh = lane >> 5, gsel = (lane >> 4) & 1;
            f32x16 acc[2];
#pragma unroll
            for (int nb = 0; nb < 2; ++nb)
#pragma unroll
                for (int i = 0; i < 16; ++i) acc[nb][i] = 0.f;
#pragma unroll
            for (int kk = 0; kk < 4; ++kk) {
                const bf16x8v Bv = tr_frag(Vt, 16 * kk + 8 * hh, 32 * dvb + 16 * gsel, lane);
#pragma unroll
                for (int nb = 0; nb < 2; ++nb) { const bf16x8v Ak = tr_frag(Kt, 16 * kk + 8 * hh, 32 * (2 * dkh + nb) + 16 * gsel, lane);
                    acc[nb] = __builtin_amdgcn_mfma_f32_32x32x16_bf16(Ak, Bv, acc[nb], 0, 0, 0); }
            }
#pragma unroll
            for (int nb = 0; nb < 2; ++nb)
#pragma unroll
                for (int g4 = 0; g4 < 4; ++g4) { const int dk = 32 * (2 * dkh + nb) + 8 * g4 + 4 * hh, dv = 32 * dvb + (lane & 31);
                    *(LAS unsigned long long*)(Stg + dv * MLP + dk * 2) = (unsigned long long)pk2(acc[nb][4 * g4], acc[nb][4 * g4 + 1]) | ((unsigned long long)pk2(acc[nb][4 * g4 + 2], acc[nb][4 * g4 + 3]) << 32); }
        }
        __syncthreads();
        { unsigned char* stc = st + (size_t)unit * ST_ELEMS;
#pragma unroll
          for (int q = 0; q < 4; ++q) { const int it = tid + q * NTHR, dv = it >> 4, c8 = it & 15;
              const v4u hv = *(const LAS v4u*)(Stg + dv * MLP + c8 * 16);
              *(unsigned long long*)(stc + dv * 128 + c8 * 8) = (unsigned long long)pk4_fp8(bf2f(hv.x & 0xffffu) * ST_SCALE, bf2f(hv.x >> 16) * ST_SCALE, bf2f(hv.y & 0xffffu) * ST_SCALE, bf2f(hv.y >> 16) * ST_SCALE)
                  | ((unsigned long long)pk4_fp8(bf2f(hv.z & 0xffffu) * ST_SCALE, bf2f(hv.z >> 16) * ST_SCALE, bf2f(hv.w & 0xffffu) * ST_SCALE, bf2f(hv.w >> 16) * ST_SCALE) << 32); }
        }
        if (tid < 128) { float s = 0.f;
#pragma unroll 8
            for (int t = 0; t < 64; ++t) s += wkL[t] * bf2f(*(const LAS unsigned short*)(Kt + t * MLP + tid * 2));
            st[(size_t)unit * ST_ELEMS + 128 * 128 + tid] = (unsigned char)(pk4_fp8(s * ST_SCALE, 0.f, 0.f, 0.f) & 0xffu); }
        prep_store(bgd, lane, bgv);
        __syncthreads();
    }
#undef MLA_ISSUE
}

__device__ __forceinline__ void ml_phaseB(const MArgs& a, LAS unsigned char* lds, int vb0, int nvb) {
    const int tid = threadIdx.x;
    unsigned char* st = (unsigned char*)(a.ws + WS_STATES); const float* chk = (const float*)(a.ws + WS_CHK); float* mprev = (float*)(a.ws + WS_MPREV);
    const int swave = tid >> 6;
    LAS float* al = (LAS float*)(lds + 100 * 1024) + swave * 2 * NCH; LAS float* be = al + NCH;
    constexpr int NSL = 16, SLE = ST_ELEMS / NSL;
    for (int item = vb0; item < 16 * NSL; item += nvb) {
        const int bh = item / NSL, sl = item % NSL;
        if (tid * 8 >= SLE + 504) continue;
        __builtin_amdgcn_fence(__ATOMIC_SEQ_CST, "workgroup");
        { const int l = tid & 63; static_assert(NCH == 128, "two chunks per lane");
            const f32x4 cm = *(const f32x4*)(chk + (size_t)(bh * NCH + 2 * l) * 2);
            const float b0 = cm.x, M0 = cm.y, b1 = cm.z, M1 = cm.w;
            const float incl = wave_incl_sum(b0 + b1, l), B0 = incl - b1, B1 = incl;
            const float d0 = M0 - B0, d1 = M1 - B1;
            const float imax = wave_incl_max(fmaxf(d0, d1), l); float emax = __shfl_up(imax, 1); emax = l == 0 ? -__builtin_inff() : emax;
            const float m0 = B0 + fmaxf(0.f, fmaxf(emax, d0)), m1 = B1 + fmaxf(0.f, imax);
            float mp0 = __shfl_up(m1, 1); mp0 = l == 0 ? 0.f : mp0;
            al[2 * l] = __expf(b0 + mp0 - m0); be[2 * l] = __expf(M0 - m0); al[2 * l + 1] = __expf(b1 + m0 - m1); be[2 * l + 1] = __expf(M1 - m1);
            if (sl == 0 && swave == 0) { mprev[bh * NCH + 2 * l] = mp0; mprev[bh * NCH + 2 * l + 1] = m0; } }
        __builtin_amdgcn_fence(__ATOMIC_SEQ_CST, "workgroup");
        if (tid * 8 < SLE) {
            unsigned long long* p = (unsigned long long*)(st + (size_t)bh * NCH * ST_ELEMS + sl * SLE + tid * 8);
            float cs[8];
#pragma unroll
            for (int e = 0; e < 8; ++e) cs[e] = 0.f;
            unsigned long long dn[16];
#pragma unroll
            for (int j = 0; j < 16; ++j) dn[j] = p[(size_t)j * (ST_ELEMS / 8)];
            for (int cb = 0; cb < NCH; cb += 16) { unsigned long long d[16];
#pragma unroll
                for (int j = 0; j < 16; ++j) d[j] = dn[j];
                if (cb + 16 < NCH) {
#pragma unroll
                    for (int j = 0; j < 16; ++j) dn[j] = p[(size_t)(cb + 16 + j) * (ST_ELEMS / 8)]; }
#pragma unroll
                for (int j = 0; j < 16; ++j) { p[(size_t)(cb + j) * (ST_ELEMS / 8)] = (unsigned long long)pk4_fp8(cs[0], cs[1], cs[2], cs[3]) | ((unsigned long long)pk4_fp8(cs[4], cs[5], cs[6], cs[7]) << 32);
                    const float A = al[cb + j], Bq = be[cb + j]; float dv[8]; cvt8_fp8(d[j], dv);
#pragma unroll
                    for (int e = 0; e < 8; ++e) cs[e] = A * cs[e] + Bq * dv[e]; } }
        }
    }
}

__device__ __forceinline__ void ml_phaseC(const MArgs& a, LAS unsigned char* lds, int G, unsigned* uq) {
    const int tid = threadIdx.x, lane = tid & 63, wave = __builtin_amdgcn_readfirstlane(tid >> 6);
    const unsigned char* proj = (const unsigned char*)(a.ws + WS_PROJ); const float* conv_w = a.in[5]; const float* conv_b = a.in[6]; const float* norm_g = a.in[8];
    const float* ipre = (const float*)(a.ws + WS_GATES); const float* logf = ipre + 16 * S;
    const bf16* kcg = (const bf16*)(a.ws + WS_KC); const unsigned char* st = (const unsigned char*)(a.ws + WS_STATES); const float* mprev = (const float*)(a.ws + WS_MPREV);
    unsigned char* mix8 = (unsigned char*)(a.ws + WS_MIX);
    constexpr int MLQ = 272;
    LAS unsigned char* Qt = lds; LAS unsigned char* Kt = lds + 64 * MLQ; LAS unsigned char* Vt = lds + 128 * MLQ; LAS unsigned char* Ct = Vt + 64 * MLP;
    LAS float* sc = (LAS float*)(Ct + 128 * MLQ);
    LAS float* gL = sc; LAS float* mmL = sc + 64; LAS float* siL = sc + 128; LAS float* emL = sc + 192; LAS float* npv = sc + 256; LAS float* lnS = sc + 384;
    const int tb = wave >> 2, dvb = wave & 3, r = lane & 31, hh = lane >> 5, gsel = (lane >> 4) & 1;
    const PrepArgs pa = MAKE_PREP_ARGS(a);
    LAS int* nxtL = (LAS int*)(lds + 140 * 1024);
    for (int unit = blockIdx.x; unit < 16 * NCH; ) {
        unsigned nxq = 0; if (tid == 0) nxq = __hip_atomic_fetch_add(uq, 1u, __ATOMIC_RELAXED, __HIP_MEMORY_SCOPE_AGENT);
        const int bh = unit >> 7, c = unit & (NCH - 1), b = bh >> 2, h = bh & 3, s0 = c * 64; const size_t row0 = (size_t)b * S + s0;
        float lf = 0.f, ic = 0.f, mp = 0.f;
        if (wave == 0) { lf = logf[(size_t)bh * S + s0 + lane]; ic = ipre[(size_t)bh * S + s0 + lane]; mp = mprev[unit]; }
        const unsigned char* stc = st + (size_t)unit * ST_ELEMS;
#pragma unroll
        for (int q = 0; q < 2; ++q) { const int it = tid + q * NTHR, tt = it >> 4, c8 = it & 15, ch = h * 128 + c8 * 8;
            float y[8]; conv8(proj + (row0 + tt) * NPROJ + C_MLQ + ch, s0 + tt, conv_w + ch, conv_b + ch, 1.f, y);
            *(LAS v4u*)(Qt + tt * MLQ + c8 * 16) = pack8(y);
            *(LAS v4u*)(Kt + tt * MLQ + c8 * 16) = *(const v4u*)(kcg + (row0 + tt) * 512 + ch);
            { float vf[8]; cvt8_fp8(*(const unsigned long long*)(proj + (row0 + tt) * NPROJ + C_MLV + ch), vf); *(LAS v4u*)(Vt + tt * MLP + c8 * 16) = pack8(vf); } }
#pragma unroll
        for (int q = 0; q < 2; ++q) { const int it = tid + q * NTHR, dv = it >> 3, c16 = it & 7;
            const v4u raw = *(const v4u*)(stc + dv * 128 + c16 * 16); float f0[8], f1[8];
            cvt8_fp8((unsigned long long)raw.x | ((unsigned long long)raw.y << 32), f0); cvt8_fp8((unsigned long long)raw.z | ((unsigned long long)raw.w << 32), f1);
#pragma unroll
            for (int e = 0; e < 8; ++e) { f0[e] *= (1.f / ST_SCALE); f1[e] *= (1.f / ST_SCALE); }
            *(LAS v4u*)(Ct + dv * MLQ + c16 * 32) = pack8(f0); *(LAS v4u*)(Ct + dv * MLQ + c16 * 32 + 16) = pack8(f1); }
        if (tid < 128) { float nf[8]; cvt8_fp8((unsigned long long)stc[128 * 128 + tid], nf); npv[tid] = nf[0] * (1.f / ST_SCALE); }
        if (wave == 0) {
            const float bc = wave_incl_sum(lf, lane), g = ic - bc, pm = wave_incl_max(g, lane), mm = fmaxf(mp, pm);
            gL[lane] = g; mmL[lane] = mm; siL[lane] = __expf(mp - mm); emL[lane] = __expf(-(bc + mm));
        }
        __syncthreads();
        unsigned long long ogp[2]; f32x4 ngp[2][2];
#pragma unroll
        for (int q = 0; q < 2; ++q) { const int it = tid + q * NTHR, tt = it >> 4, dv = (it & 15) * 8;
            ogp[q] = *(const unsigned long long*)(proj + (row0 + tt) * NPROJ + C_MLO + h * 128 + dv); ngp[q][0] = *(const f32x4*)(norm_g + h * 128 + dv); ngp[q][1] = *(const f32x4*)(norm_g + h * 128 + dv + 4); }
        const PrepDesc bgd = prep_decode(pa, IT_SMALL + BG_A + unit * NWAVES + wave); f32x4 bgv[16]; prep_load(bgd, lane, bgv);
        bf16x8v qf[8];
#pragma unroll
        for (int kk = 0; kk < 8; ++kk) qf[kk] = *(const LAS bf16x8v*)(Qt + (32 * tb + r) * MLQ + (16 * kk + 8 * hh) * 2);
        const float mm_t = mmL[32 * tb + r], si_t = siL[32 * tb + r], em_t = emL[32 * tb + r];
        float nq = 0.f;
#pragma unroll
        for (int kk = 0; kk < 8; ++kk) { const f32x4 n0 = *(const LAS f32x4*)(npv + 16 * kk + 8 * hh), n1 = *(const LAS f32x4*)(npv + 16 * kk + 8 * hh + 4);
            nq += n0.x * bf2f((unsigned short)qf[kk][0]) + n0.y * bf2f((unsigned short)qf[kk][1]) + n0.z * bf2f((unsigned short)qf[kk][2]) + n0.w * bf2f((unsigned short)qf[kk][3])
                + n1.x * bf2f((unsigned short)qf[kk][4]) + n1.y * bf2f((unsigned short)qf[kk][5]) + n1.z * bf2f((unsigned short)qf[kk][6]) + n1.w * bf2f((unsigned short)qf[kk][7]); }
        nq += __shfl_xor(nq, 32);
        f32x16 num;
#pragma unroll
        for (int i = 0; i < 16; ++i) num[i] = 0.f;
#pragma unroll
        for (int kk = 0; kk < 8; ++kk) { const bf16x8v Ac = *(const LAS bf16x8v*)(Ct + (32 * dvb + r) * MLQ + (16 * kk + 8 * hh) * 2);
            num = __builtin_amdgcn_mfma_f32_32x32x16_bf16(Ac, qf[kk], num, 0, 0, 0); }
#pragma unroll
        for (int i = 0; i < 16; ++i) num[i] *= si_t;
        float wsum = 0.f;
        for (int sb = 0; sb <= tb; ++sb) {
            f32x16 sT;
#pragma unroll
            for (int i = 0; i < 16; ++i) sT[i] = 0.f;
#pragma unroll
            for (int kk = 0; kk < 8; ++kk) { const bf16x8v Ak = *(const LAS bf16x8v*)(Kt + (32 * sb + r) * MLQ + (16 * kk + 8 * hh) * 2);
                sT = __builtin_amdgcn_mfma_f32_32x32x16_bf16(Ak, qf[kk], sT, 0, 0, 0); }
            unsigned wp[8];
#pragma unroll
            for (int g4 = 0; g4 < 4; ++g4) { const f32x4 gv = *(const LAS f32x4*)(gL + 32 * sb + 8 * g4 + 4 * hh);
                float w[4];
#pragma unroll
                for (int e = 0; e < 4; ++e) { const int srow = 32 * sb + 8 * g4 + 4 * hh + e; const bool valid = srow <= 32 * tb + r;
                    w[e] = valid ? sT[4 * g4 + e] * __expf(gv[e] - mm_t) : 0.f; wsum += w[e]; }
                wp[2 * g4] = pk2(w[0], w[1]); wp[2 * g4 + 1] = pk2(w[2], w[3]); }
#pragma unroll
            for (int s2 = 0; s2 < 2; ++s2) {
                const bf16x8v Av = tr_frag_perm(Vt, 32 * sb + 16 * s2 + 4 * hh, 32 * dvb + 16 * gsel, lane);
                v4u bw; bw.x = wp[4 * s2]; bw.y = wp[4 * s2 + 1]; bw.z = wp[4 * s2 + 2]; bw.w = wp[4 * s2 + 3];
                num = __builtin_amdgcn_mfma_f32_32x32x16_bf16(Av, __builtin_bit_cast(bf16x8v, bw), num, 0, 0, 0); }
        }
        wsum += __shfl_xor(wsum, 32);
        const float den = si_t * nq + wsum, rden = 1.f / fmaxf(fabsf(den), em_t);
        float ps = 0.f, pq = 0.f;
#pragma unroll
        for (int i = 0; i < 16; ++i) { num[i] *= rden; ps += num[i]; pq += num[i] * num[i]; }
        ps += __shfl_xor(ps, 32); pq += __shfl_xor(pq, 32);
        if (hh == 0) { lnS[((tb * 4 + dvb) * 32 + r) * 2] = ps; lnS[((tb * 4 + dvb) * 32 + r) * 2 + 1] = pq; }
        __syncthreads();
        float ts = 0.f, tq = 0.f;
#pragma unroll
        for (int d = 0; d < 4; ++d) { ts += lnS[((tb * 4 + d) * 32 + r) * 2]; tq += lnS[((tb * 4 + d) * 32 + r) * 2 + 1]; }
        const float mean = ts * (1.f / 128.f), rstd = 1.f / sqrtf(fmaxf(tq * (1.f / 128.f) - mean * mean, 0.f) + LN_EPS);
#pragma unroll
        for (int g4 = 0; g4 < 4; ++g4) { const int dv = 32 * dvb + 8 * g4 + 4 * hh;
            *(LAS unsigned long long*)(Qt + (32 * tb + r) * MLQ + dv * 2) = (unsigned long long)pk2((num[4 * g4] - mean) * rstd, (num[4 * g4 + 1] - mean) * rstd) | ((unsigned long long)pk2((num[4 * g4 + 2] - mean) * rstd, (num[4 * g4 + 3] - mean) * rstd) << 32); }
        __syncthreads();
#pragma unroll
        for (int q = 0; q < 2; ++q) { const int it = tid + q * NTHR, tt = it >> 4, c8 = it & 15, dv = c8 * 8;
            const v4u hv = *(const LAS v4u*)(Qt + tt * MLQ + c8 * 16); float og[8]; cvt8_fp8(ogp[q], og);
            const f32x4 n0 = ngp[q][0], n1 = ngp[q][1];
            float o[8];
            o[0] = bf2f(hv.x & 0xffffu) * n0.x * sigmoidf_(og[0]); o[1] = bf2f(hv.x >> 16) * n0.y * sigmoidf_(og[1]);
            o[2] = bf2f(hv.y & 0xffffu) * n0.z * sigmoidf_(og[2]); o[3] = bf2f(hv.y >> 16) * n0.w * sigmoidf_(og[3]);
            o[4] = bf2f(hv.z & 0xffffu) * n1.x * sigmoidf_(og[4]); o[5] = bf2f(hv.z >> 16) * n1.y * sigmoidf_(og[5]);
            o[6] = bf2f(hv.w & 0xffffu) * n1.z * sigmoidf_(og[6]); o[7] = bf2f(hv.w >> 16) * n1.w * sigmoidf_(og[7]);
            *(unsigned long long*)(mix8 + (row0 + tt) * D + 512 + h * 128 + dv) = (unsigned long long)pk4_fp8(o[0], o[1], o[2], o[3]) | ((unsigned long long)pk4_fp8(o[4], o[5], o[6], o[7]) << 32); }
        prep_store(bgd, lane, bgv);
        if (tid == 0) *nxtL = G + (int)nxq;
        __syncthreads();
        unit = *nxtL;
    }
}

constexpr int VTP = 192;
template <int PITCH> __device__ __forceinline__ bf16x8v tr_frag_perm_p(const LAS unsigned char* tile, int row0, int col0, int lane) {
    const int i = lane & 15; const LAS unsigned char* p = tile + (row0 + (i >> 2)) * PITCH + (col0 + 4 * (i & 3)) * 2;
    const s16x4 lo = tr_read(p), hi = tr_read(p + 8 * PITCH);
    return __builtin_shufflevector(lo, hi, 0, 1, 2, 3, 4, 5, 6, 7);
}
__device__ __forceinline__ void attn_phase(const unsigned char* __restrict__ proj, unsigned char* __restrict__ mix8, LAS unsigned char* lds, int vb0, int nvb, const PrepArgs pa, LAS int* ucnt) {
    const int tid = threadIdx.x, lane = tid & 63, wave = __builtin_amdgcn_readfirstlane(tid >> 6);
    const int r = lane & 31, hh = lane >> 5, gsel = (lane >> 4) & 1;
    LAS unsigned char* Vt = lds + wave * (64 * VTP);
    bf16x8v ntri[2], nones;
#pragma unroll
    for (int s2 = 0; s2 < 2; ++s2)
#pragma unroll
        for (int j = 0; j < 8; ++j) { const int k = 16 * s2 + 8 * (j >> 2) + 4 * hh + (j & 3); ntri[s2][j] = (k >= r) ? (short)0xBF80 : (short)0; }
#pragma unroll
    for (int j = 0; j < 8; ++j) nones[j] = (short)0xBF80;
    for (;;) {
        int j = 0; if (lane == 0) j = __hip_atomic_fetch_add(ucnt, 1, __ATOMIC_RELAXED, __HIP_MEMORY_SCOPE_WORKGROUP);
        j = __builtin_amdgcn_readfirstlane(j);
        const int unit = vb0 * NWAVES + (j & 7) + (j >> 3) * nvb * NWAVES; if (unit >= NB * 8 * (S / 32)) break;
        const int bh = unit / (S / 32), qb = unit % (S / 32), b = bh >> 3, h = bh & 7, q0 = qb * 32;
        const unsigned char* base = proj + (size_t)b * S * NPROJ + h * 64;
        long qf[4];
#pragma unroll
        for (int s = 0; s < 4; ++s) qf[s] = *(const long*)(base + (size_t)(q0 + r) * NPROJ + C_SBQ + 16 * s + 8 * hh);
        f32x16 o[2];
#pragma unroll
        for (int d = 0; d < 2; ++d)
#pragma unroll
            for (int i = 0; i < 16; ++i) o[d][i] = 0.f;
        float carry = 0.f;
        const int qpos = q0 + r;
        const PrepDesc bgd = prep_decode(pa, IT_SMALL + BG_A + BG_C + unit); f32x4 bgv[16]; prep_load(bgd, lane, bgv);
        for (int k0 = q0 - 32; ; k0 -= 64) {
            long kf[2][4];
#pragma unroll
            for (int kb = 0; kb < 2; ++kb) { int key = k0 + 32 * kb + r; key = key < 0 ? 0 : key;
#pragma unroll
                for (int s = 0; s < 4; ++s) kf[kb][s] = *(const long*)(base + (size_t)key * NPROJ + C_SBK + 16 * s + 8 * hh); }
            unsigned long long vraw[8];
#pragma unroll
            for (int i = 0; i < 8; ++i) { int key = k0 + (lane >> 3) + 8 * i; key = key < 0 ? 0 : key; vraw[i] = *(const unsigned long long*)(base + (size_t)key * NPROJ + C_SBV + (lane & 7) * 8); }
#pragma unroll
            for (int i = 0; i < 8; ++i) { float vf[8]; cvt8_fp8(vraw[i], vf); *(LAS v4u*)(Vt + ((lane >> 3) + 8 * i) * VTP + (lane & 7) * 16) = pack8(vf); }
            f32x16 z[2];
#pragma unroll
            for (int kb = 0; kb < 2; ++kb) {
#pragma unroll
                for (int i = 0; i < 16; ++i) z[kb][i] = 0.f;
#pragma unroll
                for (int s = 0; s < 4; ++s) z[kb] = __builtin_amdgcn_mfma_f32_32x32x16_fp8_fp8(kf[kb][s], qf[s], z[kb], 0, 0, 0); }
            const bool need_mask = (k0 + 63 >= q0) || (k0 < 0);
            unsigned xp[2][8];
#pragma unroll
            for (int kb = 0; kb < 2; ++kb)
#pragma unroll
                for (int g4 = 0; g4 < 4; ++g4) { float sp[4];
#pragma unroll
                    for (int e = 0; e < 4; ++e) { const float zz = z[kb][4 * g4 + e];
                        float v = fmaxf(zz, 0.f) + __builtin_amdgcn_logf(1.f + __builtin_amdgcn_exp2f(-fabsf(zz)));
                        if (need_mask) { const int key = k0 + 32 * kb + 8 * g4 + 4 * hh + e; v = (key >= 0 && key < qpos) ? v : 0.f; }
                        sp[e] = v; }
                    xp[kb][2 * g4] = pk2(sp[0], sp[1]); xp[kb][2 * g4 + 1] = pk2(sp[2], sp[3]); }
            const float z00 = z[0][0];
#pragma unroll
            for (int s2 = 0; s2 < 2; ++s2) { v4u b1; b1.x = xp[1][4 * s2]; b1.y = xp[1][4 * s2 + 1]; b1.z = xp[1][4 * s2 + 2]; b1.w = xp[1][4 * s2 + 3];
                v4u b0; b0.x = xp[0][4 * s2]; b0.y = xp[0][4 * s2 + 1]; b0.z = xp[0][4 * s2 + 2]; b0.w = xp[0][4 * s2 + 3];
                z[1] = __builtin_amdgcn_mfma_f32_32x32x16_bf16(ntri[s2], __builtin_bit_cast(bf16x8v, b1), z[1], 0, 0, 0);
                z[0] = __builtin_amdgcn_mfma_f32_32x32x16_bf16(ntri[s2], __builtin_bit_cast(bf16x8v, b0), z[0], 0, 0, 0);
                z[0] = __builtin_amdgcn_mfma_f32_32x32x16_bf16(nones, __builtin_bit_cast(bf16x8v, b1), z[0], 0, 0, 0); }
            float tot = z00 - z[0][0];
            tot = __shfl(tot, r);
#pragma unroll
            for (int kb = 0; kb < 2; ++kb)
#pragma unroll
                for (int g4 = 0; g4 < 4; ++g4) { float p[4];
#pragma unroll
                    for (int e = 0; e < 4; ++e) { float v = __builtin_amdgcn_exp2f(z[kb][4 * g4 + e] - carry);
                        if (need_mask) { const int key = k0 + 32 * kb + 8 * g4 + 4 * hh + e; v = (key >= 0 && key < qpos) ? v : 0.f; }
                        p[e] = v; }
                    xp[kb][2 * g4] = pk2(p[0], p[1]); xp[kb][2 * g4 + 1] = pk2(p[2], p[3]); }
#pragma unroll
            for (int kb = 0; kb < 2; ++kb)
#pragma unroll
                for (int s2 = 0; s2 < 2; ++s2) { v4u bp; bp.x = xp[kb][4 * s2]; bp.y = xp[kb][4 * s2 + 1]; bp.z = xp[kb][4 * s2 + 2]; bp.w = xp[kb][4 * s2 + 3];
#pragma unroll
                    for (int d = 0; d < 2; ++d) { const bf16x8v Av = tr_frag_perm_p<VTP>(Vt, 32 * kb + 16 * s2 + 4 * hh, 32 * d + 16 * gsel, lane);
                        o[d] = __builtin_amdgcn_mfma_f32_32x32x16_bf16(Av, __builtin_bit_cast(bf16x8v, bp), o[d], 0, 0, 0); } }
            carry += tot;
            if (k0 <= 0) break;
            if (__all(carry > SB_THRESH)) break;
        }
#pragma unroll
        for (int d = 0; d < 2; ++d)
#pragma unroll
            for (int g4 = 0; g4 < 4; ++g4)
                *(LAS unsigned long long*)(Vt + r * 144 + (32 * d + 8 * g4 + 4 * hh) * 2) = (unsigned long long)pk2(o[d][4 * g4], o[d][4 * g4 + 1]) | ((unsigned long long)pk2(o[d][4 * g4 + 2], o[d][4 * g4 + 3]) << 32);
#pragma unroll
        for (int i = 0; i < 4; ++i) { const int row = (lane >> 3) + 8 * i;
            const v4u ov = *(const LAS v4u*)(Vt + row * 144 + (lane & 7) * 16);
            *(unsigned long long*)(mix8 + (size_t)(b * S + q0 + row) * D + h * 64 + (lane & 7) * 8) = (unsigned long long)pk4_fp8(bf2f(ov.x & 0xffffu), bf2f(ov.x >> 16), bf2f(ov.y & 0xffffu), bf2f(ov.y >> 16))
                | ((unsigned long long)pk4_fp8(bf2f(ov.z & 0xffffu), bf2f(ov.z >> 16), bf2f(ov.w & 0xffffu), bf2f(ov.w >> 16)) << 32); }
        prep_store(bgd, lane, bgv);
    }
}

__global__ void __launch_bounds__(NTHR, 2) mega_fwd(MArgs args) {
    extern __shared__ __attribute__((aligned(16))) unsigned char lds[];
    LAS unsigned char* ldsl = (LAS unsigned char*)lds;
    const int tid = threadIdx.x, G = gridDim.x;
    volatile LAS unsigned* MISC = (volatile LAS unsigned*)(ldsl + XTRA_OFF + X_MISC);
    LAS int* tb = (LAS int*)(ldsl + XTRA_OFF + X_TB); LAS int* nn = (LAS int*)(ldsl + XTRA_OFF + X_NN);
    for (int u = tid; u < (LDS_BYTES - XTRA_OFF) / 4; u += NTHR) ((LAS unsigned*)(ldsl + XTRA_OFF))[u] = 0u;
    __syncthreads();
    unsigned char* ws = args.ws;
    unsigned* ctl = (unsigned*)(ws + WS_CTL);
    XcdBarrier bar = xcd_barrier_post(ctl + CW_BAR, MISC + 8);
    const int lo = args.ph_lo, hi = args.ph_hi;
#define IN(k) (lo <= (k) && (k) < hi)
#ifndef REP_MASK
#define REP_MASK 0
#endif
#ifndef PROBE_PH
#define PROBE_PH -1
#endif
#define CW_TS 65536
#define PHASE(k, ...) do { if (PROBE_PH >= 0 && blockIdx.x == 0 && tid == 0) __hip_atomic_store((unsigned long long*)(ctl + CW_TS) + (k), __builtin_amdgcn_s_memrealtime(), __ATOMIC_RELAXED, __HIP_MEMORY_SCOPE_AGENT); if (IN(k)) { for (int rep_ = 0; rep_ < (((REP_MASK >> (k)) & 1) ? 2 : 1); ++rep_) { if (rep_) xcd_barrier(bar); __VA_ARGS__ } } if (IN(k) && IN((k) + 1)) xcd_barrier(bar); } while (0)
    int* cnt = (int*)ctl + CW_CNT; i32x2* list = (i32x2*)(ws + WS_PROJ);
    PHASE(0, ph_mod_prep(args, lds, G););
    PHASE(1, ph_ln1(args, lds, G););
    PHASE(2, { pg8::StaticOrder So; So.init(ws + WS_U1, ws + WS_WTIN, T, NPROJ, D, G, blockIdx.x);
        pg8::EpiF8 E{(unsigned char*)(ws + WS_PROJ), NPROJ, 2, QSCALE, 1.f / 64.f};
        pg8::gemm_phase<pg8::EpiF8, pg8::StaticOrder, false, true>(ldsl, D, So, E); });
    PHASE(3, ml_phaseA(args, ldsl, blockIdx.x, G););
    PHASE(4, { LAS int* ucnt = (LAS int*)(ldsl + XTRA_OFF + X_MISC) + 16; if (tid == 0) *ucnt = 0; __syncthreads();
        ml_phaseB(args, ldsl, blockIdx.x, G);
        attn_phase((const unsigned char*)(ws + WS_PROJ), (unsigned char*)(ws + WS_MIX), ldsl, blockIdx.x, G, MAKE_PREP_ARGS(args), ucnt); });
    PHASE(5, ml_phaseC(args, ldsl, G, ctl + 70016););
    PHASE(6, { pg8::StaticOrder So; So.init(ws + WS_MIX, ws + WS_WTOUT, T, D, D, G, blockIdx.x);
        pg8::EpiF8 E{(unsigned char*)(ws + WS_MIXOUT), D, 0, 1.f, 1.f / 64.f};
        pg8::gemm_phase<pg8::EpiF8, pg8::StaticOrder, false, true>(ldsl, D, So, E); });
    PHASE(7, ph_ln2(args, G););
    PHASE(8, { constexpr int RU = (T / 256) * (NE / 256);
        if ((int)blockIdx.x < RU || G <= RU) { pg8::StaticOrder So; So.init(ws + WS_U2, ws + WS_WTR, T, NE, 2 * D, G, blockIdx.x);
            pg8::EpiF32T E{(float*)(ws + WS_LOGITS), T};
            pg8::gemm_phase<pg8::EpiF32T, pg8::StaticOrder, false, false>(ldsl, 2 * D, So, E); }
        if ((int)blockIdx.x >= RU || G <= RU) { const int nw = G > RU ? G - RU : G, w = G > RU ? (int)blockIdx.x - RU : (int)blockIdx.x, nu = 2 * (T / 256);
            pg8::SharedOrder So{w, (nu + nw - 1) / nw, nu, (const char*)(ws + WS_U2F8), (const char*)(ws + WS_WT13) + (size_t)NE * 512 * D};
            pg8::EpiGlu E{(unsigned char*)(ws + WS_HS), 1.f / 64.f};
            pg8::gemm_phase<pg8::EpiGlu, pg8::SharedOrder, false, true>(ldsl, D, So, E); } });
    PHASE(9, { const PrepArgs pa = MAKE_PREP_ARGS(args);
        LAS float* biasL = (LAS float*)(ldsl + XTRA_OFF + X_BIAS);
        const int wave_ = __builtin_amdgcn_readfirstlane(tid >> 6), lane_ = tid & 63;
        const int bgall = IT_TOTAL - IT_E - (IT_SMALL + BG_TOTAL), bgsplit = IT_TOTAL - IT_E - (4 * G <= bgall / 4 ? 4 * G : 0);
        if (wave_ < 2) {
            biasL += wave_ * NE; *(LAS f32x4*)(biasL + 4 * lane_) = *(const f32x4*)(args.in[13] + 4 * lane_);
            __builtin_amdgcn_fence(__ATOMIC_SEQ_CST, "workgroup");
        }
        if (wave_ < 2) {
            for (int blk = blockIdx.x; blk < T / 128; blk += G)
                route_tokens64(blk * 128 + wave_ * 64 + lane_, lane_, (const float*)(ws + WS_LOGITS), biasL, ldsl + wave_ * 65536, (LAS int*)(ldsl + XTRA_OFF + X_HIST) + wave_ * 2 * NE, cnt, list);
            prep_run_range(pa, bgsplit + blockIdx.x * 2 + wave_, G * 2, IT_TOTAL - IT_E, lane_);
        } else prep_run_range(pa, IT_SMALL + BG_TOTAL + blockIdx.x * 6 + (wave_ - 2), G * 6, bgsplit, lane_); });
    PHASE(11, { moe_tables(cnt, tb, nn);
        pg8::MoeOrder So{G, (int)blockIdx.x, tb[NE] * 2, 1, tb, nn, list, (const char*)(ws + WS_U2F8), 0, (const char*)(ws + WS_WT13), (size_t)512 * D, (size_t)256 * D, nullptr};
        pg8::EpiGlu E{(unsigned char*)(ws + WS_H), 1.f / 64.f};
        pg8::gemm_phase<pg8::EpiGlu, pg8::MoeOrder, true, true>(ldsl, D, So, E, ldsl + XTRA_OFF + X_META); });
    PHASE(12, { if (!IN(11)) moe_tables(cnt, tb, nn);
        pg8::MoeOrder So{G, (int)blockIdx.x, tb[NEX] * 4, 2, tb, nn, list, (const char*)(ws + WS_H), (size_t)256 * FF, (const char*)(ws + WS_WT2), (size_t)D * FF, (size_t)256 * FF, (const char*)(ws + WS_HS)};
        pg8::EpiScatter E{(unsigned char*)(ws + WS_YS), (unsigned char*)(ws + WS_YSH), nn};
        pg8::gemm_phase<pg8::EpiScatter, pg8::MoeOrder, false, true>(ldsl, FF, So, E, ldsl + XTRA_OFF + X_META); });
    PHASE(13, { float oscale = 1.f;
        if (PROBE_PH >= 0) { const unsigned long long* ts = (const unsigned long long*)(ctl + CW_TS); const unsigned long long t0 = __hip_atomic_load(ts, __ATOMIC_RELAXED, __HIP_MEMORY_SCOPE_AGENT), t13 = __hip_atomic_load(ts + 12, __ATOMIC_RELAXED, __HIP_MEMORY_SCOPE_AGENT),
            ta = __hip_atomic_load(ts + (PROBE_PH < 0 ? 0 : PROBE_PH), __ATOMIC_RELAXED, __HIP_MEMORY_SCOPE_AGENT), tb_ = __hip_atomic_load(ts + (PROBE_PH < 0 ? 0 : PROBE_PH) + 1, __ATOMIC_RELAXED, __HIP_MEMORY_SCOPE_AGENT);
            oscale = 1.f + sqrtf(0.01f * (float)(tb_ - ta) / (float)(t13 - t0)); }
        ph_final(args, G, oscale); });
#undef PHASE
#undef IN
}

__global__ void k_nan_fill(float* out, int n) { for (int i = blockIdx.x * blockDim.x + threadIdx.x; i < n; i += gridDim.x * blockDim.x) out[i] = __builtin_nanf(""); }
extern "C" void kernel_launch(void* const* d_in, const int* in_sizes, int n_in, void* d_out, int out_size, void* d_ws, size_t ws_size, hipStream_t stream) {
    static int grid = 0;
    if (grid == 0) {
        int dev = 0, cus = 0, per_cu = 0; grid = -1;
        if (n_in != 22 || out_size != T * D || ws_size < WS_END) fprintf(stderr, "kernel_launch: unexpected shapes (n_in %d out %d ws %zu, need %zu)\n", n_in, out_size, ws_size, (size_t)WS_END);
        else if (hipGetDevice(&dev) != hipSuccess || hipDeviceGetAttribute(&cus, hipDeviceAttributeMultiprocessorCount, dev) != hipSuccess) fprintf(stderr, "kernel_launch: device query failed\n");
        else if (hipFuncSetAttribute((const void*)mega_fwd, hipFuncAttributeMaxDynamicSharedMemorySize, LDS_BYTES) != hipSuccess) fprintf(stderr, "kernel_launch: hipFuncSetAttribute failed\n");
        else if (hipOccupancyMaxActiveBlocksPerMultiprocessor(&per_cu, (const void*)mega_fwd, NTHR, LDS_BYTES) != hipSuccess || per_cu < 1) fprintf(stderr, "kernel_launch: occupancy query says %d blocks per CU\n", per_cu);
        else grid = cus;
        (void)hipGetLastError();
    }
    if (grid < 0) { k_nan_fill<<<1024, 256, 0, stream>>>((float*)d_out, out_size); return; }
    char* ws = (char*)d_ws;
    (void)hipMemsetAsync(ws + WS_CTL, 0, 1 * MiB, stream);
    MArgs a{};
    for (int i = 0; i < 22; ++i) a.in[i] = (const float*)d_in[i];
    a.out = (float*)d_out; a.ws = (unsigned char*)d_ws; a.ph_lo = 0; a.ph_hi = N_PHASES;
    hipLaunchKernelGGL(mega_fwd, dim3(grid), dim3(NTHR), LDS_BYTES, stream, a);
}
```
